# Optimizing an MI355X kernel written in HIP

```python
import math
import jax
import jax.numpy as jnp
from jax import lax
import numpy as np

D_MODEL = 2048
BATCH = 2
SEQ = 8192
DEPTH = 2

GRID_W = 64
CTX_LEN = 256
N_EVEN = (DEPTH + 1) // 2
N_ODD = DEPTH // 2
EPS = 1e-6

DIFF_QK = 64
DIFF_HEADS = D_MODEL // (4 * DIFF_QK)
DIFF_V = 2 * DIFF_QK
DIFF_WIDTH = DIFF_HEADS * DIFF_V
ROPE_BASE = 10000.0
Q_BLOCK = 128
POOL_WINDOWS = (2, 4, 8, 16)
POOL_WIDTH = D_MODEL - DIFF_WIDTH
POOL_GROUP = POOL_WIDTH // len(POOL_WINDOWS)
AB_IN = 2 * DIFF_HEADS * 2 * DIFF_QK + DIFF_WIDTH + POOL_WIDTH

HY_WIDTH = D_MODEL // 2
HY_ORDER = 2
HY_EMB = 33
HY_HIDDEN = 64
HY_FAST_DECAY = 0.3
HY_SLOW_DECAY = 1.5
HY_TARGET = 1e-2
S5_WIDTH = D_MODEL - HY_WIDTH
S5_GROUP = 16
S5_GROUPS = S5_WIDTH // S5_GROUP
S5_STATE = 64
CD_IN = (HY_ORDER + 1) * HY_WIDTH + S5_WIDTH

MOE_GROUPS = 8
MOE_PER_GROUP = 8
MOE_EXPERTS = MOE_GROUPS * MOE_PER_GROUP
MOE_TOPK = 2
D_EXPERT = 512
MOE_BLOCK = 256

kernel_name = "hybrid_diffattn_pool_hyena_s5_hmoe_dit"


def rmsnorm(x, g):
    xf = x.astype(jnp.float32)
    y = xf * lax.rsqrt(jnp.mean(xf * xf, axis=-1, keepdims=True) + EPS)
    return (y * g.astype(jnp.float32)).astype(x.dtype)


def modulate(x, shift, scale):
    return x * (1 + scale) + shift


def axial_rope_angles(L):
    rows = L // GRID_W
    row = jnp.repeat(jnp.arange(rows, dtype=jnp.float32), GRID_W)
    col = jnp.tile(jnp.arange(GRID_W, dtype=jnp.float32), rows)
    n_freq = DIFF_QK // 4
    inv = ROPE_BASE ** (-jnp.arange(n_freq, dtype=jnp.float32) / n_freq)
    return row[:, None] * inv, col[:, None] * inv


def apply_axial_rope(x, ang_r, ang_c):
    def rot(xp, ang):
        ang = ang[None, :, None, None, :]
        cos = jnp.cos(ang).astype(x.dtype)
        sin = jnp.sin(ang).astype(x.dtype)
        a, b = jnp.split(xp, 2, axis=-1)
        return jnp.concatenate([a * cos - b * sin, a * sin + b * cos], axis=-1)
    half = x.shape[-1] // 2
    return jnp.concatenate([rot(x[..., :half], ang_r), rot(x[..., half:], ang_c)], axis=-1)


def diff_attend(q, k, v, lam):
    s = jnp.einsum('bhmqd,bhmkd->bhmqk', q, k).astype(jnp.float32) * (DIFF_QK ** -0.5)
    p = jax.nn.softmax(s, axis=-1)
    a = p[:, :, 0] - lam * p[:, :, 1]
    return jnp.einsum('bhqk,bhkd->bhqd', a.astype(v.dtype), v)


def multiscale_pool(p, pool_w, pool_scale):
    B, L, _ = p.shape
    pg = p.reshape(B, L, len(POOL_WINDOWS), POOL_GROUP).astype(jnp.float32)
    cs = jnp.concatenate([jnp.zeros_like(pg[:, :1]), jnp.cumsum(pg, axis=1)], axis=1)
    t = jnp.arange(L)
    means = []
    for gi, w in enumerate(POOL_WINDOWS):
        lo = jnp.clip(t - w // 2, 0, L)
        hi = jnp.clip(t - w // 2 + w, 0, L)
        csg = cs[:, :, gi]
        means.append((csg[:, hi] - csg[:, lo]) / (hi - lo).astype(jnp.float32)[None, :, None])
    d = (jnp.stack(means, axis=2) - pg).astype(p.dtype)
    y = jnp.einsum('blgc,gcd->blgd', d, pool_w).reshape(B, L, POOL_WIDTH)
    return y * pool_scale


def diff_pool_mixer(h, hc, w_in, w_out, lam_vecs, subln_g, pool_w, pool_scale, lam_init, ctx_out):
    B, L, _ = h.shape
    C = hc.shape[1]
    H, d, dv = DIFF_HEADS, DIFF_QK, DIFF_V
    qw = H * 2 * d
    vw = H * dv
    proj = h @ w_in
    ang_r, ang_c = axial_rope_angles(L)
    q = apply_axial_rope(proj[..., :qw].reshape(B, L, H, 2, d), ang_r, ang_c)
    k = apply_axial_rope(proj[..., qw:2 * qw].reshape(B, L, H, 2, d), ang_r, ang_c)
    v = proj[..., 2 * qw:2 * qw + vw].reshape(B, L, H, dv)
    p = proj[..., 2 * qw + vw:]
    if ctx_out:
        projc = hc @ w_in
        kvc = projc[..., qw:2 * qw + vw]
    else:
        kvc = hc @ w_in[:, qw:2 * qw + vw]
    kc = kvc[..., :qw].reshape(B, C, H, 2, d)
    vc = kvc[..., qw:].reshape(B, C, H, dv)
    lv = lam_vecs.astype(jnp.float32)
    lam = jnp.exp(jnp.dot(lv[0], lv[1])) - jnp.exp(jnp.dot(lv[2], lv[3])) + lam_init
    k_all = jnp.concatenate([kc, k], axis=1).transpose(0, 2, 3, 1, 4)
    v_all = jnp.concatenate([vc, v], axis=1).transpose(0, 2, 1, 3)
    nb = L // Q_BLOCK
    qb = q.reshape(B, nb, Q_BLOCK, H, 2, d).transpose(1, 0, 3, 4, 2, 5)
    o = lax.map(lambda qq: diff_attend(qq, k_all, v_all, lam), qb)
    o = o.transpose(1, 0, 3, 2, 4).reshape(B, L, H, dv)

    def head_out(oh):
        return (rmsnorm(oh, subln_g) * (1 - lam_init)).reshape(oh.shape[0], oh.shape[1], H * dv)

    y = jnp.concatenate([head_out(o), multiscale_pool(p, pool_w, pool_scale)], axis=-1) @ w_out
    if not ctx_out:
        return y, None
    qc = projc[..., :qw].reshape(B, C, H, 2, d).transpose(0, 2, 3, 1, 4)
    oc = diff_attend(qc, kc.transpose(0, 2, 3, 1, 4), vc.transpose(0, 2, 1, 3), lam).transpose(0, 2, 1, 3)
    yc = jnp.concatenate([head_out(oc), multiscale_pool(projc[..., 2 * qw + vw:], pool_w, pool_scale)], axis=-1) @ w_out
    return y, yc


def short_conv(u, w, b):
    up = jnp.pad(u, ((0, 0), (1, 1), (0, 0)))
    return up[:, :-2] * w[0] + up[:, 1:-1] * w[1] + up[:, 2:] * w[2] + b


def hyena_filters(L, w1, b1, freq, w2, b2, w3):
    f32 = jnp.float32
    t = jnp.linspace(0.0, 1.0, L, dtype=f32)[:, None]
    bands = (HY_EMB - 1) // 2
    w = 2 * math.pi * jnp.arange(L, dtype=f32)[:, None] / L
    f = jnp.linspace(1e-4, bands - 1, bands, dtype=f32)[None, :]
    z = jnp.concatenate([t, jnp.cos(f * w), -jnp.sin(f * w)], axis=-1)
    fr = freq.astype(f32)
    hid = jnp.sin(fr[0] * (z @ w1.astype(f32) + b1.astype(f32)))
    hid = jnp.sin(fr[1] * (hid @ w2.astype(f32) + b2.astype(f32)))
    k = (hid @ w3.astype(f32)).reshape(L, HY_ORDER, 2, HY_WIDTH)
    max_decay = math.log(HY_TARGET) / HY_FAST_DECAY
    min_decay = math.log(HY_TARGET) / HY_SLOW_DECAY
    deltas = jnp.linspace(min_decay, max_decay, HY_WIDTH, dtype=f32)
    k = k * jnp.exp(-t * jnp.abs(deltas))[:, None, None, :]
    norm = jnp.sum(jnp.abs(k[:, :, 0]), axis=0) + jnp.sum(jnp.abs(k[1:, :, 1]), axis=0)
    return k / norm[None, :, None, :]


def long_conv(u, k_fwd, k_bwd, bias):
    L = u.shape[1]
    uf = u.astype(jnp.float32)
    k_full = jnp.concatenate([k_fwd, jnp.zeros_like(k_fwd[:1]), k_bwd[:0:-1]], axis=0)
    spec = jnp.fft.rfft(uf, n=2 * L, axis=1) * jnp.fft.rfft(k_full, axis=0)[None]
    y = jnp.fft.irfft(spec, n=2 * L, axis=1)[:, :L]
    return (y + uf * bias.astype(jnp.float32)).astype(u.dtype)


def hyena(u, conv_w, conv_b, f_w1, f_b1, f_freq, f_w2, f_b2, f_w3, hy_bias):
    L = u.shape[1]
    g = short_conv(u, conv_w, conv_b)
    v, x1, x2 = jnp.split(g, HY_ORDER + 1, axis=-1)
    k = hyena_filters(L, f_w1, f_b1, f_freq, f_w2, f_b2, f_w3)
    z = x1 * long_conv(v, k[:, 0, 0], k[:, 0, 1], hy_bias[0])
    return x2 * long_conv(z, k[:, 1, 0], k[:, 1, 1], hy_bias[1])


def s5_discretize(a_re, a_im, log_dt, b_re, b_im):
    f32 = jnp.float32
    lam = lax.complex(a_re.astype(f32), a_im.astype(f32))
    dt = jnp.exp(log_dt.astype(f32))[:, None]
    lam_bar = jnp.exp(lam * dt)
    b = lax.complex(b_re.astype(f32), b_im.astype(f32))
    b_bar = ((lam_bar - 1) / lam)[..., None] * b
    return lam_bar, b_bar


def s5_scan(u, lam_bar, b_bar, h0, reverse):
    bu = jnp.einsum('blgc,gpc->blgp', u.astype(jnp.complex64), b_bar)
    if h0 is not None:
        bu = bu.at[:, -1 if reverse else 0].add(lam_bar * h0)
    a = jnp.broadcast_to(lam_bar, (1,) + bu.shape[1:])

    def combine(e1, e2):
        a1, b1 = e1
        a2, b2 = e2
        return a1 * a2, a2 * b1 + b2

    _, s = lax.associative_scan(combine, (a, bu), reverse=reverse, axis=1)
    return s


def s5_bidir(u_lat, u_ctx, a_re, a_im, log_dt, b_re, b_im, c_re, c_im, s5_d, glu_w, glu_b, ctx_out):
    B, L, _ = u_lat.shape
    C = u_ctx.shape[1]
    ul = u_lat.astype(jnp.float32).reshape(B, L, S5_GROUPS, S5_GROUP)
    uc = u_ctx.astype(jnp.float32).reshape(B, C, S5_GROUPS, S5_GROUP)
    dd = s5_d.astype(jnp.float32).reshape(S5_GROUPS, S5_GROUP)
    y_lat = ul * dd
    y_ctx = uc * dd
    for di in range(2):
        rev = di == 1
        lam_bar, b_bar = s5_discretize(a_re[di], a_im[di], log_dt[di], b_re[di], b_im[di])
        cm = lax.complex(c_re[di].astype(jnp.float32), c_im[di].astype(jnp.float32))
        sc = s5_scan(uc, lam_bar, b_bar, None, rev)
        h0 = sc[:, 0] if rev else sc[:, -1]
        sl = s5_scan(ul, lam_bar, b_bar, h0, rev)
        y_lat = y_lat + jnp.real(jnp.einsum('blgp,gcp->blgc', sl, cm))
        if ctx_out:
            y_ctx = y_ctx + jnp.real(jnp.einsum('blgp,gcp->blgc', sc, cm))

    def glu(y, n):
        g = jax.nn.gelu(y.reshape(B, n, S5_WIDTH))
        return (g * jax.nn.sigmoid(g @ glu_w.astype(jnp.float32) + glu_b.astype(jnp.float32))).astype(u_lat.dtype)

    return glu(y_lat, L), (glu(y_ctx, C) if ctx_out else None)


def hyena_s5_mixer(h, hc, w_in, w_out, conv_w, conv_b, f_w1, f_b1, f_freq, f_w2, f_b2, f_w3, hy_bias,
                   a_re, a_im, log_dt, b_re, b_im, c_re, c_im, s5_d, glu_w, glu_b, ctx_out):
    hw = (HY_ORDER + 1) * HY_WIDTH
    hy_args = (conv_w, conv_b, f_w1, f_b1, f_freq, f_w2, f_b2, f_w3, hy_bias)
    proj = h @ w_in
    y_h = hyena(proj[..., :hw], *hy_args)
    if ctx_out:
        projc = hc @ w_in
        uc = projc[..., hw:]
    else:
        uc = hc @ w_in[:, hw:]
    y_s, y_sc = s5_bidir(proj[..., hw:], uc, a_re, a_im, log_dt, b_re, b_im, c_re, c_im, s5_d, glu_w, glu_b, ctx_out)
    y = jnp.concatenate([y_h, y_s], axis=-1) @ w_out
    if not ctx_out:
        return y, None
    yc = jnp.concatenate([hyena(projc[..., :hw], *hy_args), y_sc], axis=-1) @ w_out
    return y, yc


def hier_moe(h, w_rg, b_rg, w_re, b_re, w1, w3, w2):
    T, D = h.shape
    pg = jax.nn.softmax((h @ w_rg + b_rg).astype(jnp.float32), axis=-1)
    pg_top, g_idx = lax.top_k(pg, 1)
    el = (h @ w_re + b_re).astype(jnp.float32).reshape(T, MOE_GROUPS, MOE_PER_GROUP)
    el = el[jnp.arange(T), g_idx[:, 0]]
    pe_top, e_idx = lax.top_k(jax.nn.softmax(el, axis=-1), MOE_TOPK)
    gate = pg_top * pe_top / jnp.sum(pe_top, axis=-1, keepdims=True)
    expert = g_idx * MOE_PER_GROUP + e_idx
    S = T * MOE_TOPK
    M = MOE_BLOCK
    NB = -(-S // M) + MOE_EXPERTS
    flat_e = expert.reshape(S)
    order = jnp.argsort(flat_e)
    se = flat_e[order]
    stok = (order // MOE_TOPK).astype(jnp.int32)
    sw = gate.reshape(S)[order]
    counts = jnp.bincount(flat_e, length=MOE_EXPERTS)
    padded = ((counts + M - 1) // M) * M
    pad_end = jnp.cumsum(padded)
    dest = (pad_end - padded)[se] + jnp.arange(S) - (jnp.cumsum(counts) - counts)[se]
    buf_tok = jnp.full((NB * M,), T, dtype=jnp.int32).at[dest].set(stok)
    buf_w = jnp.zeros((NB * M,), jnp.float32).at[dest].set(sw)
    block_e = jnp.minimum(jnp.searchsorted(pad_end, jnp.arange(NB) * M, side='right'), MOE_EXPERTS - 1)
    h_pad = jnp.concatenate([h, jnp.zeros((1, D), h.dtype)], axis=0)

    def run(args):
        e, tok, w = args
        xb = h_pad[tok]
        y = (jax.nn.silu(xb @ w1[e]) * (xb @ w3[e])) @ w2[e]
        return y * w[:, None].astype(y.dtype)

    ys = lax.map(run, (block_e, buf_tok.reshape(NB, M), buf_w.reshape(NB, M)))
    out = jnp.zeros((T + 1, D), ys.dtype).at[buf_tok].add(ys.reshape(NB * M, D))
    return out[:T]


def setup_inputs(seed: int = 0) -> dict:
    key = jax.random.key(seed)
    ks = iter(jax.random.split(key, 64))
    D = D_MODEL

    def nrm(shape, std):
        return jax.random.normal(next(ks), shape, jnp.float32) * std

    G, P = S5_GROUPS, S5_STATE
    return {
        "x": nrm((BATCH, SEQ, D), 1.0),
        "c": nrm((BATCH, D), 1.0),
        "ctx": nrm((BATCH, CTX_LEN, D), 1.0),
        "c_ctx": nrm((D,), 1.0),
        "ada_w": nrm((DEPTH, D, 6 * D), 0.5 * D ** -0.5),
        "ada_b": nrm((DEPTH, 6 * D), 0.02),
        "norm_mix_g": 1.0 + nrm((DEPTH, D), 0.02),
        "norm_ffn_g": 1.0 + nrm((DEPTH, D), 0.02),
        "norm_out_g": 1.0 + nrm((D,), 0.02),
        "ab_w_in": nrm((N_EVEN, D, AB_IN), D ** -0.5),
        "ab_w_out": nrm((N_EVEN, DIFF_WIDTH + POOL_WIDTH, D), (DIFF_WIDTH + POOL_WIDTH) ** -0.5),
        "diff_lam": nrm((N_EVEN, 4, DIFF_QK), 0.1),
        "diff_subln_g": 1.0 + nrm((N_EVEN, DIFF_V), 0.02),
        "pool_w": nrm((N_EVEN, len(POOL_WINDOWS), POOL_GROUP, POOL_GROUP), POOL_GROUP ** -0.5),
        "pool_scale": 1.0 + nrm((N_EVEN, POOL_WIDTH), 0.02),
        "cd_w_in": nrm((N_ODD, D, CD_IN), D ** -0.5),
        "cd_w_out": nrm((N_ODD, HY_WIDTH + S5_WIDTH, D), (HY_WIDTH + S5_WIDTH) ** -0.5),
        "hy_conv_w": nrm((N_ODD, 3, (HY_ORDER + 1) * HY_WIDTH), 3 ** -0.5),
        "hy_conv_b": nrm((N_ODD, (HY_ORDER + 1) * HY_WIDTH), 0.02),
        "hy_f_w1": nrm((N_ODD, HY_EMB, HY_HIDDEN), 1.0),
        "hy_f_b1": nrm((N_ODD, HY_HIDDEN), 0.1),
        "hy_f_freq": 1.0 + nrm((N_ODD, 2, HY_HIDDEN), 0.1),
        "hy_f_w2": nrm((N_ODD, HY_HIDDEN, HY_HIDDEN), HY_HIDDEN ** -0.5),
        "hy_f_b2": nrm((N_ODD, HY_HIDDEN), 0.1),
        "hy_f_w3": nrm((N_ODD, HY_HIDDEN, HY_ORDER * 2 * HY_WIDTH), HY_HIDDEN ** -0.5),
        "hy_bias": nrm((N_ODD, HY_ORDER, HY_WIDTH), 1.0),
        "s5_a_re": -0.5 + nrm((N_ODD, 2, G, P), 0.01),
        "s5_a_im": jnp.pi * jnp.arange(P, dtype=jnp.float32) + nrm((N_ODD, 2, G, P), 0.01),
        "s5_log_dt": jax.random.uniform(next(ks), (N_ODD, 2, G), jnp.float32, math.log(1e-3), math.log(1e-1)),
        "s5_b_re": nrm((N_ODD, 2, G, P, S5_GROUP), (2 * S5_GROUP) ** -0.5),
        "s5_b_im": nrm((N_ODD, 2, G, P, S5_GROUP), (2 * S5_GROUP) ** -0.5),
        "s5_c_re": nrm((N_ODD, 2, G, S5_GROUP, P), P ** -0.5),
        "s5_c_im": nrm((N_ODD, 2, G, S5_GROUP, P), P ** -0.5),
        "s5_d": nrm((N_ODD, S5_WIDTH), 1.0),
        "glu_w": nrm((N_ODD, S5_WIDTH, S5_WIDTH), S5_WIDTH ** -0.5),
        "glu_b": nrm((N_ODD, S5_WIDTH), 0.02),
        "moe_w_rg": nrm((DEPTH, D, MOE_GROUPS), D ** -0.5),
        "moe_b_rg": nrm((DEPTH, MOE_GROUPS), 0.01),
        "moe_w_re": nrm((DEPTH, D, MOE_EXPERTS), D ** -0.5),
        "moe_b_re": nrm((DEPTH, MOE_EXPERTS), 0.01),
        "moe_w1": nrm((DEPTH, MOE_EXPERTS, D, D_EXPERT), D ** -0.5),
        "moe_w3": nrm((DEPTH, MOE_EXPERTS, D, D_EXPERT), D ** -0.5),
        "moe_w2": nrm((DEPTH, MOE_EXPERTS, D_EXPERT, D), D_EXPERT ** -0.5),
    }


def reference(x, c, ctx, c_ctx, ada_w, ada_b, norm_mix_g, norm_ffn_g, norm_out_g,
              ab_w_in, ab_w_out, diff_lam, diff_subln_g, pool_w, pool_scale,
              cd_w_in, cd_w_out, hy_conv_w, hy_conv_b, hy_f_w1, hy_f_b1, hy_f_freq, hy_f_w2, hy_f_b2, hy_f_w3, hy_bias,
              s5_a_re, s5_a_im, s5_log_dt, s5_b_re, s5_b_im, s5_c_re, s5_c_im, s5_d, glu_w, glu_b,
              moe_w_rg, moe_b_rg, moe_w_re, moe_b_re, moe_w1, moe_w3, moe_w2):
    D = D_MODEL
    B, L, _ = x.shape
    xc = ctx
    sc = jax.nn.silu(c)
    scc = jax.nn.silu(c_ctx)
    for l in range(DEPTH):
        last = l == DEPTH - 1
        mod = sc @ ada_w[l] + ada_b[l]
        sh1, sc1, g1, sh2, sc2, g2 = jnp.split(mod[:, None, :], 6, axis=-1)
        ncols = 2 * D if last else 6 * D
        modc = jnp.split(scc @ ada_w[l][:, :ncols] + ada_b[l][:ncols], ncols // D)
        h = modulate(rmsnorm(x, norm_mix_g[l]), sh1, sc1)
        hc = modulate(rmsnorm(xc, norm_mix_g[l]), modc[0], modc[1])
        i = l // 2
        if l % 2 == 0:
            y, yc = diff_pool_mixer(h, hc, ab_w_in[i], ab_w_out[i], diff_lam[i], diff_subln_g[i],
                                    pool_w[i], pool_scale[i], 0.8 - 0.6 * math.exp(-0.3 * l), not last)
        else:
            y, yc = hyena_s5_mixer(h, hc, cd_w_in[i], cd_w_out[i], hy_conv_w[i], hy_conv_b[i], hy_f_w1[i],
                                   hy_f_b1[i], hy_f_freq[i], hy_f_w2[i], hy_f_b2[i], hy_f_w3[i], hy_bias[i],
                                   s5_a_re[i], s5_a_im[i], s5_log_dt[i], s5_b_re[i], s5_b_im[i], s5_c_re[i],
                                   s5_c_im[i], s5_d[i], glu_w[i], glu_b[i], not last)
        x = x + g1 * y
        h2 = modulate(rmsnorm(x, norm_ffn_g[l]), sh2, sc2)
        moe_args = (moe_w_rg[l], moe_b_rg[l], moe_w_re[l], moe_b_re[l], moe_w1[l], moe_w3[l], moe_w2[l])
        if last:
            x = x + g2 * hier_moe(h2.reshape(B * L, D), *moe_args).reshape(B, L, D)
        else:
            xc = xc + modc[2] * yc
            h2c = modulate(rmsnorm(xc, norm_ffn_g[l]), modc[3], modc[4])
            out = hier_moe(jnp.concatenate([h2.reshape(B * L, D), h2c.reshape(-1, D)], axis=0), *moe_args)
            x = x + g2 * out[:B * L].reshape(B, L, D)
            xc = xc + modc[5] * out[B * L:].reshape(xc.shape)
    return rmsnorm(x, norm_out_g)
```

```cpp
#include <hip/hip_runtime.h>
#include <cstdio>
#include <cstdint>
#include <cmath>

#define GAS __attribute__((address_space(1)))
#define LAS __attribute__((address_space(3)))
typedef unsigned short bf16;
typedef unsigned v4u __attribute__((ext_vector_type(4)));
typedef unsigned v2u __attribute__((ext_vector_type(2)));
typedef float f32x4 __attribute__((ext_vector_type(4)));
typedef float f32x2 __attribute__((ext_vector_type(2)));
typedef float f32x16 __attribute__((ext_vector_type(16)));
typedef short bf16x8 __attribute__((ext_vector_type(8)));
#define LDS_WAIT() asm volatile("s_waitcnt lgkmcnt(0)" ::: "memory")
#define VM_WAIT() asm volatile("s_waitcnt vmcnt(0)" ::: "memory")

__device__ __forceinline__ unsigned f2bf(float f) { unsigned u = __builtin_bit_cast(unsigned, f); return (u + 0x7fffu + ((u >> 16) & 1u)) >> 16; }
__device__ __forceinline__ unsigned pk2(float lo, float hi) { return f2bf(lo) | (f2bf(hi) << 16); }
__device__ __forceinline__ unsigned cvt_pk_bf16(float lo, float hi) { unsigned r; asm volatile("v_cvt_pk_bf16_f32 %0, %1, %2" : "=v"(r) : "v"(lo), "v"(hi)); return r; }
__device__ __forceinline__ float bf2f(unsigned short b) { return __builtin_bit_cast(float, (unsigned)b << 16); }
__device__ __forceinline__ float bflo(unsigned w) { return __builtin_bit_cast(float, w << 16); }
__device__ __forceinline__ float bfhi(unsigned w) { return __builtin_bit_cast(float, w & 0xffff0000u); }
__device__ __forceinline__ float wave_sum(float v) {
#pragma unroll
    for (int o = 1; o < 64; o <<= 1) v += __shfl_xor(v, o);
    return v;
}

namespace pg8 {
typedef unsigned short bf16_t;
constexpr int BM = 256, BK = 64, HALF = 128, HTB = HALF * BK * 2, STAGE_BYTES = 8 * HTB;

__host__ __device__ __forceinline__ int lds_byte(int r, int c) { const int st = (r >> 4) * 2 + (c >> 5), rr = r & 15, cc = c & 31, ob = rr * 64 + cc * 2; return st * 1024 + (ob ^ (((ob >> 9) & 1) << 5)); }
__host__ __device__ __forceinline__ void stage_rc(int b, int& R, int& C) { const int st = b / 1024, sb = b % 1024, swz = sb ^ (((sb >> 9) & 1) << 5); R = (st >> 1) * 16 + swz / 64; C = (st & 1) * 32 + (swz % 64) / 2; }

struct Unit { int pm, pn; long aoff, boff; int e, idx0; };
struct Gemm { const bf16_t* A; const bf16_t* Bt; int lda, ldb, K; };

template <class Epi, class Sched, bool GATHER>
__device__ __forceinline__ void gemm_phase(LAS unsigned char* lds, const Gemm g, const Sched& S, const Epi& E) {
    const int tid = threadIdx.x, wid = __builtin_amdgcn_readfirstlane(tid >> 6), lane = tid & 63, wr = wid >> 2, wc = wid & 3, fr = lane & 15, fq = lane >> 4;
    const int K = g.K, nt = K / BK;
    unsigned voffA[2], voffB[2]; int RR[2], CC[2];
#pragma unroll
    for (int i = 0; i < 2; ++i) { int R, C; stage_rc(tid * 16 + i * 8192, R, C); RR[i] = R; CC[i] = C;
        voffA[i] = (unsigned)(R * g.lda + C) * 2u; voffB[i] = (unsigned)(R * g.ldb + C) * 2u; }
    const size_t kstep = (size_t)(BK * 2);
    const size_t hstepA = GATHER ? 0 : (size_t)HALF * g.lda * 2, hstepB = (size_t)HALF * g.ldb * 2;
    const unsigned ldsw = (unsigned)wid * 1024u;
    const int aoff = lds_byte(wr * 64 + fr, fq * 8), boff = lds_byte(wc * 32 + fr, fq * 8);
#define PG8_SA(b, h) (((b) * 2 + (h)) * HTB)
#define PG8_SB(b, h) ((4 + (b) * 2 + (h)) * HTB)
#define PG8_STAGE(bufoff, gbase, voff) do { _Pragma("unroll") for (int _i = 0; _i < 2; ++_i) \
        __builtin_amdgcn_global_load_lds((const unsigned*)((const char*)(gbase) + (voff)[_i]), (LAS unsigned*)(lds + (bufoff) + ldsw + _i * 8192), 16, 0, 0); } while (0)
#define PG8_STAGE_A(bufoff, gbase, h, nx) do { if constexpr (GATHER) { unsigned _tv[2]; _tv[0] = (nx) ? gvn[h][0] : gvc[h][0]; _tv[1] = (nx) ? gvn[h][1] : gvc[h][1]; PG8_STAGE(bufoff, gbase, _tv); } else { PG8_STAGE(bufoff, (gbase) + (h) * hstepA, voffA); } } while (0)
#define PG8_LDA(dst, b, h) do { _Pragma("unroll") for (int m = 0; m < 4; ++m) _Pragma("unroll") for (int k = 0; k < 2; ++k) dst[m][k] = *(const LAS bf16x8*)(lds + PG8_SA(b, h) + aoff + m * 2048 + k * 1024); } while (0)
#define PG8_LDB(dst, b, h) do { _Pragma("unroll") for (int n = 0; n < 2; ++n) _Pragma("unroll") for (int k = 0; k < 2; ++k) dst[n][k] = *(const LAS bf16x8*)(lds + PG8_SB(b, h) + boff + n * 2048 + k * 1024); } while (0)
#define PG8_MMA(ai, bj, At, Bt) do { __builtin_amdgcn_s_setprio(1); _Pragma("unroll") for (int m = 0; m < 4; ++m) _Pragma("unroll") for (int n = 0; n < 2; ++n) _Pragma("unroll") for (int k = 0; k < 2; ++k) \
        acc[ai][bj][m][n] = __builtin_amdgcn_mfma_f32_16x16x32_bf16(Bt[n][k], At[m][k], acc[ai][bj][m][n], 0, 0, 0); __builtin_amdgcn_s_setprio(0); } while (0)
#define PG8_WAIT_V(n) asm volatile("s_waitcnt vmcnt(" #n ")" ::: "memory")
#define PG8_WAIT_L(n) asm volatile("s_waitcnt lgkmcnt(" #n ")" ::: "memory")
#define PG8_BAR __builtin_amdgcn_s_barrier()
#define PG8_SCHED __builtin_amdgcn_sched_barrier(0)
    Unit cur, nxt; int ui = 0;
    if (!S.next(0, cur)) return;
    unsigned gvc[2][2], gvn[2][2];
    if constexpr (GATHER) {
#pragma unroll
        for (int h = 0; h < 2; ++h)
#pragma unroll
            for (int i = 0; i < 2; ++i) { gvc[h][i] = (unsigned)S.arow(cur, h * HALF + RR[i]) * (unsigned)(g.lda * 2) + (unsigned)(CC[i] * 2); gvn[h][i] = gvc[h][i]; }
    }
    f32x4 acc[2][2][4][2];
#pragma unroll
    for (int a = 0; a < 2; ++a)
#pragma unroll
        for (int b = 0; b < 2; ++b)
#pragma unroll
            for (int m = 0; m < 4; ++m)
#pragma unroll
                for (int n = 0; n < 2; ++n) acc[a][b][m][n] = (f32x4){0.f, 0.f, 0.f, 0.f};
    bf16x8 At[4][2], B0[2][2], B1[2][2];
    const char* cA = (const char*)g.A + cur.aoff; const char* cB = (const char*)g.Bt + cur.boff;
    PG8_STAGE(PG8_SB(0, 0), cB, voffB); PG8_STAGE(PG8_SB(0, 1), cB + hstepB, voffB); PG8_STAGE_A(PG8_SA(0, 0), cA, 0, false); PG8_STAGE_A(PG8_SA(0, 1), cA, 1, false);
    if (wr == 1) PG8_BAR;
    PG8_WAIT_V(2); PG8_BAR;
    PG8_STAGE(PG8_SB(1, 0), cB + kstep, voffB); PG8_STAGE_A(PG8_SA(1, 0), cA + kstep, 0, false); PG8_STAGE(PG8_SB(1, 1), cB + hstepB + kstep, voffB);
    PG8_WAIT_V(6); PG8_BAR;
    for (;;) {
        const bool has_next = S.next(ui + 1, nxt);
        if constexpr (GATHER) {
            if (has_next) {
#pragma unroll
                for (int h = 0; h < 2; ++h)
#pragma unroll
                    for (int i = 0; i < 2; ++i) gvn[h][i] = (unsigned)S.arow(nxt, h * HALF + RR[i]) * (unsigned)(g.lda * 2) + (unsigned)(CC[i] * 2);
            } else {
#pragma unroll
                for (int h = 0; h < 2; ++h)
#pragma unroll
                    for (int i = 0; i < 2; ++i) gvn[h][i] = gvc[h][i];
            }
        }
        const char* nA = has_next ? (const char*)g.A + nxt.aoff : cA; const char* nB = has_next ? (const char*)g.Bt + nxt.boff : cB;
#pragma nounroll
        for (int t = 0; t < nt; t += 2) {
            const bool last = (t == nt - 2);
            const char* a1 = cA + (size_t)(t + 1) * kstep;
            const char* a2 = last ? nA : cA + (size_t)(t + 2) * kstep; const char* b2 = last ? nB : cB + (size_t)(t + 2) * kstep;
            const char* a3 = a2 + kstep; const char* b3 = b2 + kstep;
            PG8_LDB(B0, 0, 0); PG8_LDB(B1, 0, 1); PG8_SCHED; PG8_LDA(At, 0, 0); PG8_STAGE_A(PG8_SA(1, 1), a1, 1, false);
            PG8_WAIT_V(8); PG8_WAIT_L(0); PG8_BAR; PG8_MMA(0, 0, At, B0); PG8_MMA(0, 1, At, B1); PG8_BAR; PG8_SCHED;
            PG8_LDA(At, 0, 1); PG8_STAGE(PG8_SB(0, 0), b2, voffB); PG8_STAGE(PG8_SB(0, 1), b2 + hstepB, voffB); PG8_STAGE_A(PG8_SA(0, 0), a2, 0, last);
            PG8_WAIT_V(8); PG8_WAIT_L(0); PG8_BAR; PG8_MMA(1, 0, At, B0); PG8_MMA(1, 1, At, B1); PG8_BAR; PG8_SCHED;
            PG8_LDB(B0, 1, 0); PG8_LDB(B1, 1, 1); PG8_SCHED; PG8_LDA(At, 1, 0); PG8_STAGE_A(PG8_SA(0, 1), a2, 1, last);
            PG8_WAIT_V(8); PG8_WAIT_L(0); PG8_BAR; PG8_MMA(0, 0, At, B0); PG8_MMA(0, 1, At, B1); PG8_BAR; PG8_SCHED;
            PG8_LDA(At, 1, 1); PG8_STAGE(PG8_SB(1, 0), b3, voffB); PG8_STAGE(PG8_SB(1, 1), b3 + hstepB, voffB); PG8_STAGE_A(PG8_SA(1, 0), a3, 0, last);
            PG8_WAIT_V(8); PG8_WAIT_L(0); PG8_BAR; PG8_MMA(1, 0, At, B0); PG8_MMA(1, 1, At, B1); PG8_BAR; PG8_SCHED;
        }
        if (wr == 0) PG8_BAR;
        E(acc, cur, wr, wc, fr, fq);
        if (!has_next) break;
#pragma unroll
        for (int a = 0; a < 2; ++a)
#pragma unroll
            for (int b = 0; b < 2; ++b)
#pragma unroll
                for (int m = 0; m < 4; ++m)
#pragma unroll
                    for (int n = 0; n < 2; ++n) acc[a][b][m][n] = (f32x4){0.f, 0.f, 0.f, 0.f};
        cur = nxt; cA = nA; cB = nB; ++ui;
        if constexpr (GATHER) {
#pragma unroll
            for (int h = 0; h < 2; ++h)
#pragma unroll
                for (int i = 0; i < 2; ++i) gvc[h][i] = gvn[h][i];
        }
        if (wr == 1) PG8_BAR;
    }
    PG8_WAIT_V(0);
    PG8_BAR;
#undef PG8_SA
#undef PG8_SB
#undef PG8_STAGE
#undef PG8_STAGE_A
#undef PG8_LDA
#undef PG8_LDB
#undef PG8_MMA
#undef PG8_WAIT_V
#undef PG8_WAIT_L
#undef PG8_BAR
#undef PG8_SCHED
}

struct StaticOrder {
    int nM, nN, nwg, G, c; long astride, apn, bstride;
    __device__ void init(int nM_, int nN_, int G_, int c_, long astride_, long apn_, long bstride_) { nM = nM_; nN = nN_; nwg = nM * nN; G = G_; c = c_; astride = astride_; apn = apn_; bstride = bstride_; }
    __device__ bool next(int i, Unit& u) const {
        const long Lx = (long)i * G + c; if (Lx >= nwg) return false;
        int wgid = (int)Lx; { const int q = nwg / 8, r = nwg % 8, xcd = wgid % 8, off = wgid / 8; wgid = (xcd < r ? xcd * (q + 1) : r * (q + 1) + (xcd - r) * q) + off; }
        const int nig = 8 * nN, gid = wgid / nig, fm = gid * 8, gsz = (nM - fm) < 8 ? (nM - fm) : 8;
        u.pm = fm + ((wgid % nig) % gsz); u.pn = (wgid % nig) / gsz; u.aoff = (long)u.pm * astride + (long)u.pn * apn; u.boff = (long)u.pn * bstride; u.e = 0; u.idx0 = 0; return true;
    }
    __device__ int arow(const Unit&, int) const { return 0; }
};
}

constexpr int DM = 2048, NBATCH = 2, SEQ = 8192, CTX = 256;
constexpr int TL = NBATCH * SEQ;
constexpr int TC = NBATCH * CTX;
constexpr int TT = TL + TC;
constexpr int KEYS = CTX + SEQ;
constexpr int NEXP = 64, DEXP = 512;
constexpr int LISTCAP = 2 * TT;
constexpr float EPS = 1e-6f;
constexpr float QSCALE = 0.125f * 1.4426950408889634f;
constexpr int NWAVES = 8, NTHREADS = 512;

constexpr size_t MiB = 1u << 20;
constexpr size_t WS_CTL = 0, CTL_BYTES = 1 * MiB;
constexpr size_t WS_WIN0 = 1 * MiB;
constexpr size_t WS_WOUT0 = WS_WIN0 + 16 * MiB;
constexpr size_t WS_WIN1 = WS_WOUT0 + 8 * MiB;
constexpr size_t WS_WOUT1 = WS_WIN1 + 16 * MiB;
constexpr size_t WS_WPOOL = WS_WOUT1 + 8 * MiB;
constexpr size_t WS_WGLU = WS_WPOOL + 1 * MiB;
constexpr size_t WS_WMOE = WS_WGLU + 2 * MiB;
constexpr size_t MOE_E_BYTES = 6 * MiB, MOE_L_BYTES = 64 * MOE_E_BYTES;
constexpr size_t WS_X = WS_WMOE + 2 * MOE_L_BYTES;
constexpr size_t WS_HA = WS_X + 132 * MiB;
constexpr size_t WS_Q = WS_HA + 67 * MiB;
constexpr size_t WS_K = WS_Q + 33 * MiB;
constexpr size_t WS_VT = WS_K + 33 * MiB;
constexpr size_t WS_P = WS_VT + 33 * MiB;
constexpr size_t WS_PROJ1 = WS_Q;
constexpr size_t WS_CAT = WS_P + 33 * MiB;
constexpr size_t WS_PD = WS_CAT + 66 * MiB;
constexpr size_t WS_H = WS_PD + 33 * MiB;
constexpr size_t WS_Y = WS_H + 49 * MiB;
constexpr size_t WS_GT = WS_Y + 132 * MiB;
constexpr size_t WS_KT = WS_GT + 192 * MiB;
constexpr size_t WS_YD = WS_KT + 128 * MiB;
constexpr size_t WS_MISC = WS_YD + 128 * MiB;
constexpr size_t WS_MOD = WS_MISC;
constexpr size_t WS_ADAP = WS_MOD + 1 * MiB;
constexpr size_t WS_ROPE = WS_ADAP + 10 * MiB;
constexpr size_t WS_NORMP = WS_ROPE + 1 * MiB;
constexpr size_t WS_INVN = WS_NORMP + 4 * MiB;
constexpr size_t WS_S5LAM = WS_INVN + 1 * MiB;
constexpr size_t WS_S5B = WS_S5LAM + 1 * MiB;
constexpr size_t WS_WRT = WS_S5B + 2 * MiB;
constexpr size_t WS_TOKL = WS_WRT + 2 * MiB;
constexpr size_t WS_GATEL = WS_TOKL + 9 * MiB;
constexpr size_t WS_END = WS_GATEL + 9 * MiB;
static_assert(WS_END <= 2040 * MiB, "d_ws map");
constexpr int CW_BAR = 1024;
constexpr int CW_CNT = 8192;

constexpr int LDS_PHASE = 131072;
constexpr int LDS_CTL = 147456 - 1024;
constexpr int LDS_BYTES = 147456;

#define XB_TMO      128
#define XB_XCNT(j)  (256  + 64 * (j))
#define XB_XSUB(j)  (1280 + 64 * (j))
#define XB_XGEN(j)  (2304 + 64 * (j))
#define XB_TOP      3328
#define XB_TOPGEN   3392
#define XCD_BAR_WORDS 3456
#define XB_SPIN_CAP (1u << 22)

__device__ __forceinline__ unsigned xb_ld(unsigned* p)              { return __hip_atomic_load(p, __ATOMIC_RELAXED, __HIP_MEMORY_SCOPE_AGENT); }
__device__ __forceinline__ unsigned xb_add(unsigned* p, unsigned v) { return __hip_atomic_fetch_add(p, v, __ATOMIC_RELAXED, __HIP_MEMORY_SCOPE_AGENT); }
__device__ __forceinline__ unsigned xb_xcc_id() { return (unsigned)__builtin_amdgcn_s_getreg((3 << 11) | 20) & 0xFu; }
#define XB_SPIN(cond, bar) do { unsigned _sp = 0; while (cond) { __builtin_amdgcn_s_sleep(1); \
    if ((++_sp & 255u) == 0u) { if (xb_ld(&(bar)[XB_TMO])) break; if (_sp > XB_SPIN_CAP) { atomicAdd(&(bar)[XB_TMO], 1u); break; } } } } while (0)

struct XcdBarrier { unsigned* bar; unsigned x; volatile LAS unsigned* st; };

__device__ __forceinline__ XcdBarrier xcd_barrier_post(unsigned* bar, volatile LAS unsigned* st) {
    XcdBarrier b; b.bar = bar; b.x = xb_xcc_id(); b.st = st;
    if (threadIdx.x == 0) (void)xb_add(&bar[XB_XCNT(b.x)], 1u);
    return b;
}
__device__ __forceinline__ void xcd_barrier_complete(unsigned* bar, unsigned x, unsigned& nloc, unsigned& nx) {
    const unsigned G = gridDim.x * gridDim.y * gridDim.z;
    unsigned sum, cnt, mine, sp = 0u;
    for (;;) {
        sum = 0u; cnt = 0u; mine = 0u;
#pragma unroll
        for (unsigned j = 0; j < 16; ++j) { const unsigned c = xb_ld(&bar[XB_XCNT(j)]); sum += c; cnt += (c > 0u) ? 1u : 0u; mine = (j == x) ? c : mine; }
        if (sum == G) break;
        __builtin_amdgcn_s_sleep(1);
        if ((++sp & 255u) == 0u) { if (xb_ld(&bar[XB_TMO])) break; if (sp > XB_SPIN_CAP) { atomicAdd(&bar[XB_TMO], 1u); break; } }
    }
    nloc = mine > 0u ? mine : 1u; nx = cnt > 0u ? cnt : 1u;
}
__device__ __forceinline__ void xcd_barrier(const XcdBarrier& b) {
    asm volatile("s_waitcnt vmcnt(0)" ::: "memory");
    __syncthreads();
    if (threadIdx.x == 0) {
        unsigned* bar = b.bar;
        __builtin_amdgcn_s_waitcnt(0);
        unsigned nloc = b.st[0], nx = b.st[1];
        if (nloc == 0u) { xcd_barrier_complete(bar, b.x, nloc, nx); b.st[0] = nloc; b.st[1] = nx; }
        const unsigned old = xb_add(&bar[XB_XSUB(b.x)], 1u);
        const unsigned gen = old / nloc;
        if (old + 1u == (gen + 1u) * nloc) {
            __builtin_amdgcn_fence(__ATOMIC_RELEASE, "agent");
            asm volatile("s_waitcnt vmcnt(0)" ::: "memory");
            const unsigned og = xb_add(&bar[XB_TOP], 1u);
            const unsigned tg = og / nx;
            if (og + 1u == (tg + 1u) * nx) xb_add(&bar[XB_TOPGEN], 1u);
            else XB_SPIN(xb_ld(&bar[XB_TOPGEN]) == tg, bar);
            __builtin_amdgcn_fence(__ATOMIC_ACQUIRE, "agent");
            xb_add(&bar[XB_XGEN(b.x)], 1u);
            asm volatile("s_waitcnt vmcnt(0)" ::: "memory");
        } else {
            XB_SPIN(xb_ld(&bar[XB_XGEN(b.x)]) == gen, bar);
            __builtin_amdgcn_fence(__ATOMIC_ACQUIRE, "agent");
            asm volatile("s_waitcnt vmcnt(0)" ::: "memory");
        }
    }
    __syncthreads();
}

__device__ __forceinline__ void sincos_2pi(double x, double& s, double& c) {
    const double q = __builtin_rint(x * 4.0);
    const double y = (x - q * 0.25) * 6.283185307179586476925;
    const double y2 = y * y;
    double sp = -7.6471637318198164759e-13; sp = sp * y2 + 1.6059043836821614599e-10; sp = sp * y2 - 2.5052108385441718775e-8; sp = sp * y2 + 2.7557319223985890653e-6;
    sp = sp * y2 - 1.9841269841269841270e-4; sp = sp * y2 + 8.3333333333333333333e-3; sp = sp * y2 - 1.6666666666666666667e-1; sp = sp * y2 * y + y;
    double cp = 4.7794773323873852974e-14; cp = cp * y2 - 1.1470745597729724714e-11; cp = cp * y2 + 2.0876756987868098979e-9; cp = cp * y2 - 2.7557319223985890653e-7;
    cp = cp * y2 + 2.4801587301587301587e-5; cp = cp * y2 - 1.3888888888888888889e-3; cp = cp * y2 + 4.1666666666666666667e-2; cp = cp * y2 - 0.5; cp = cp * y2 + 1.0;
    const int qi = ((int)q) & 3;
    s = (qi == 0) ? sp : (qi == 1) ? cp : (qi == 2) ? -sp : -cp;
    c = (qi == 0) ? cp : (qi == 1) ? -sp : (qi == 2) ? -cp : sp;
}
__device__ __forceinline__ void sincos_rad(double a, double& s, double& c) {
    double f = a * 0.15915494309189533576888; f -= __builtin_floor(f);
    if (f >= 1.0) f = 0.0;
    sincos_2pi(f, s, c);
}
__device__ __forceinline__ double exp_small(double x) {
    double r = 1.0 / 479001600.0;
    r = r * x + 1.0 / 39916800.0; r = r * x + 1.0 / 3628800.0; r = r * x + 1.0 / 362880.0; r = r * x + 1.0 / 40320.0; r = r * x + 1.0 / 5040.0;
    r = r * x + 1.0 / 720.0; r = r * x + 1.0 / 120.0; r = r * x + 1.0 / 24.0; r = r * x + 1.0 / 6.0; r = r * x + 0.5; r = r * x + 1.0; r = r * x + 1.0;
    return r;
}
__device__ __forceinline__ float fast_exp(float x) { return __builtin_amdgcn_exp2f(x * 1.4426950408889634f); }
__device__ __forceinline__ float sigmoidf_(float x) { return 1.0f / (1.0f + fast_exp(-x)); }
__device__ __forceinline__ float siluf_(float x) { return x * sigmoidf_(x); }
__device__ __forceinline__ float tanhf_(float x) { const float e = fast_exp(-2.0f * fabsf(x)); const float t = (1.0f - e) / (1.0f + e); return x < 0.f ? -t : t; }
__device__ __forceinline__ float gelu_tanh(float x) { return 0.5f * x * (1.0f + tanhf_(0.7978845608028654f * (x + 0.044715f * x * x * x))); }

struct Args { const float* in[43]; float* out; unsigned char* ws; int ph_lo, ph_hi; };

struct Frame {
    LAS unsigned char* lds; unsigned char* ws; int tid, lane, wave, bid, G, gw, NGW;
    const __attribute__((address_space(4))) unsigned long long* kin;
};
#define INP(i) ((const float*)F.kin[i])
#define WSP(T, off) ((T*)(F.ws + (off)))

__device__ __forceinline__ void tr_item(const float* W, int ldw, int N, bf16* WT, int ldt, int row_off, int rs16, LAS float* scr, int item, int lane) {
    const int nblk = N / 32, kb = item / nblk, nb = item % nblk, k0 = 64 * kb, n0 = 32 * nb;
#pragma unroll 8
    for (int i = 0; i < 32; ++i) { const int kk = 2 * i + (lane >> 5); scr[kk * 33 + (lane & 31)] = W[(size_t)(k0 + kk) * ldw + n0 + (lane & 31)]; }
    LDS_WAIT(); asm volatile("" ::: "memory");
    const int c = lane & 7;
#pragma unroll
    for (int j = 0; j < 4; ++j) { const int n = (lane >> 3) + 8 * j; const LAS float* s = scr + (8 * c) * 33 + n;
        v4u o; o.x = pk2(s[0 * 33], s[1 * 33]); o.y = pk2(s[2 * 33], s[3 * 33]); o.z = pk2(s[4 * 33], s[5 * 33]); o.w = pk2(s[6 * 33], s[7 * 33]);
        const int nn = n0 + n, drow = row_off + (nn >> 4) * rs16 + (nn & 15);
        *(v4u*)(WT + (size_t)drow * ldt + k0 + 8 * c) = o; }
    LDS_WAIT(); asm volatile("" ::: "memory");
}

__device__ __forceinline__ void hyfilt_item(Frame& F, int pb) {
    const float* w1 = INP(19); const float* b1 = INP(20); const float* fq = INP(21); const float* w2 = INP(22); const float* b2 = INP(23); const float* w3 = INP(24);
    LAS float* z = (LAS float*)F.lds;
    LAS float* h1 = z + 1088;
    LAS float* h2 = h1 + 2048;
    const int tid = F.tid;
    for (int idx = tid; idx < 32 * 33; idx += NTHREADS) {
        const int p = idx / 33, f = idx % 33, i = pb * 32 + p;
        float v;
        if (f == 0) v = (float)i * (1.0f / (float)(SEQ - 1));
        else { const int j = (f - 1) & 15; const float fj = 1e-4f + (float)j * ((15.0f - 1e-4f) / 15.0f);
            double fr = (double)fj * (double)i / (double)SEQ; fr -= __builtin_floor(fr); double s, c; sincos_2pi(fr, s, c); v = (f <= 16) ? (float)c : (float)(-s); }
        z[p * 33 + f] = v;
    }
    __syncthreads();
    for (int idx = tid; idx < 2048; idx += NTHREADS) {
        const int p = idx >> 6, j = idx & 63; float a = b1[j];
        for (int f = 0; f < 33; ++f) a += z[p * 33 + f] * w1[f * 64 + j];
        double s, c; sincos_rad((double)(fq[j] * a), s, c); h1[idx] = (float)s;
    }
    __syncthreads();
    for (int idx = tid; idx < 2048; idx += NTHREADS) {
        const int p = idx >> 6, j = idx & 63; float a = b2[j];
        for (int k = 0; k < 64; ++k) a += h1[p * 64 + k] * w2[k * 64 + j];
        double s, c; sincos_rad((double)(fq[64 + j] * a), s, c); h2[idx] = (float)s;
    }
    __syncthreads();
    float* kT = WSP(float, WS_KT); float* normp = WSP(float, WS_NORMP);
    for (int cc = 0; cc < 8; ++cc) {
        const int col = tid + NTHREADS * cc;
        float acc[32];
#pragma unroll
        for (int p = 0; p < 32; ++p) acc[p] = 0.f;
        for (int k = 0; k < 64; k += 4) {
            const float w0 = w3[(size_t)(k + 0) * 4096 + col], wA = w3[(size_t)(k + 1) * 4096 + col], wB = w3[(size_t)(k + 2) * 4096 + col], wC = w3[(size_t)(k + 3) * 4096 + col];
#pragma unroll
            for (int p = 0; p < 32; ++p) { const f32x4 hv = *(const LAS f32x4*)(h2 + p * 64 + k); acc[p] += hv.x * w0 + hv.y * wA + hv.z * wB + hv.w * wC; }
        }
        const int ch = col & 1023, dir = (col >> 10) & 1;
        const float adel = 3.0701134573253946f + (float)ch * ((15.350567286626972f - 3.0701134573253946f) / 1023.0f);
        float sabs = 0.f;
#pragma unroll
        for (int p = 0; p < 32; ++p) { const int i = pb * 32 + p; const float t = (float)i * (1.0f / (float)(SEQ - 1)); acc[p] *= fast_exp(-t * adel); if (!(dir == 1 && i == 0)) sabs += fabsf(acc[p]); }
        f32x4* dst = (f32x4*)(kT + (size_t)col * SEQ + pb * 32);
#pragma unroll
        for (int p = 0; p < 8; ++p) dst[p] = (f32x4){acc[4 * p], acc[4 * p + 1], acc[4 * p + 2], acc[4 * p + 3]};
        normp[(size_t)pb * 4096 + col] = sabs;
    }
    __syncthreads();
}

__device__ __forceinline__ void p0_prologue(Frame& F) {
    for (int pb = F.bid; pb < SEQ / 32; pb += F.G) hyfilt_item(F, pb);
    const int gt = F.bid * NTHREADS + F.tid, NGT = F.G * NTHREADS;
    {
        f32x2* rope = WSP(f32x2, WS_ROPE);
        for (int idx = gt; idx < 128 * 16; idx += NGT) { const int pos = idx >> 4, i = idx & 15;
            double inv = (i & 3) == 0 ? 1.0 : (i & 3) == 1 ? 0.56234132519034908 : (i & 3) == 2 ? 0.31622776601683794 : 0.17782794100389228;
            inv *= (i >> 2) == 0 ? 1.0 : (i >> 2) == 1 ? 0.1 : (i >> 2) == 2 ? 0.01 : 0.001;
            const float ang = (float)pos * (float)inv; double s, c; sincos_rad((double)ang, s, c); rope[idx] = (f32x2){(float)c, (float)s}; }
    }
    {
        const float* are = INP(26); const float* aim = INP(27); const float* ldt = INP(28); const float* bre = INP(29); const float* bim = INP(30);
        f32x2* lamb = WSP(f32x2, WS_S5LAM); f32x2* bb = WSP(f32x2, WS_S5B);
        for (int idx = gt; idx < 2 * 64 * 64; idx += NGT) { const int dg = idx >> 6;
            const float dt = expf(ldt[dg]); const float ar = are[idx], ai = aim[idx];
            const float zr = ar * dt, zi = ai * dt; double s, c; sincos_rad((double)zi, s, c); const double er = exp_small((double)zr);
            const double lr = er * c, li = er * s; lamb[idx] = (f32x2){(float)lr, (float)li};
            const double nr = lr - 1.0, ni = li, den = (double)ar * ar + (double)ai * ai; const double qr = (nr * ar + ni * ai) / den, qi = (ni * ar - nr * ai) / den;
            for (int cc = 0; cc < 16; ++cc) { const double br = bre[(size_t)idx * 16 + cc], bi = bim[(size_t)idx * 16 + cc]; bb[(size_t)idx * 16 + cc] = (f32x2){(float)(qr * br - qi * bi), (float)(qr * bi + qi * br)}; } }
    }
    {
        float* wrt = WSP(float, WS_WRT);
        for (int idx = gt; idx < 2 * 72 * 2048; idx += NGT) { const int l = idx / (72 * 2048), r = idx % (72 * 2048), n = r / 2048, k = r % 2048;
            wrt[idx] = n < 8 ? INP(36)[((size_t)l * 2048 + k) * 8 + n] : INP(38)[((size_t)l * 2048 + k) * 64 + (n - 8)]; }
    }
    {
        bf16* ha = WSP(bf16, WS_HA);
        for (int idx = gt; idx < 2048; idx += NGT) ha[(size_t)TT * 2048 + idx] = 0;
    }
    LAS float* scr = (LAS float*)(F.lds + F.wave * 16384);
    {
        const float* c = INP(1); const float* cctx = INP(3); const float* adaw = INP(4); float* part = WSP(float, WS_ADAP);
        for (int it = F.gw; it < 2 * 32 * 48; it += F.NGW) {
            const int l = it / (32 * 48), r = it % (32 * 48), ks = r / 48, jb = r % 48, k0 = ks * 64, j0 = jb * 256 + F.lane * 4;
            const float c0 = c[k0 + F.lane], c1 = c[2048 + k0 + F.lane], c2 = cctx[k0 + F.lane];
            const float s0 = c0 / (1.0f + expf(-c0)), s1 = c1 / (1.0f + expf(-c1)), s2 = c2 / (1.0f + expf(-c2));
            f32x4 a0 = {0.f, 0.f, 0.f, 0.f}, a1 = a0, a2 = a0;
            const float* wp = adaw + ((size_t)l * 2048 + k0) * 12288 + j0;
#pragma unroll 8
            for (int kk = 0; kk < 64; ++kk) { const f32x4 w = *(const f32x4*)(wp + (size_t)kk * 12288);
                const float t0 = __builtin_bit_cast(float, __builtin_amdgcn_readlane(__builtin_bit_cast(int, s0), kk));
                const float t1 = __builtin_bit_cast(float, __builtin_amdgcn_readlane(__builtin_bit_cast(int, s1), kk));
                const float t2 = __builtin_bit_cast(float, __builtin_amdgcn_readlane(__builtin_bit_cast(int, s2), kk));
                a0 += w * t0; a1 += w * t1; a2 += w * t2; }
            float* pp = part + ((size_t)(l * 32 + ks) * 3) * 12288 + j0;
            *(f32x4*)(pp) = a0; *(f32x4*)(pp + 12288) = a1; *(f32x4*)(pp + 2 * 12288) = a2;
        }
    }
    {
        constexpr int I0 = 2048, I1 = 1024, I2 = 1024, I3 = 2048, I4 = 4096, I5 = 2048, I6 = 128, I7 = 512, IE = 1536;
        constexpr int NSMALL = I0 + I1 + I2 + I3 + I4 + I5 + I6 + I7;
        const int NITEMS = NSMALL + 128 * IE;
        for (int it = F.gw; it < NITEMS; it += F.NGW) {
            int r = it;
            if (r < I0) { tr_item(INP(9), 4096, 2048, WSP(bf16, WS_WIN0), 2048, 0, 16, scr, r, F.lane); continue; } r -= I0;
            if (r < I1) { tr_item(INP(9) + 2048, 4096, 1024, WSP(bf16, WS_WIN0), 2048, 3072, 16, scr, r, F.lane); continue; } r -= I1;
            if (r < I2) { tr_item(INP(9) + 3072, 4096, 1024, WSP(bf16, WS_WIN0), 2048, 2048, 16, scr, r, F.lane); continue; } r -= I2;
            if (r < I3) { tr_item(INP(10), 2048, 2048, WSP(bf16, WS_WOUT0), 2048, 0, 16, scr, r, F.lane); continue; } r -= I3;
            if (r < I4) { tr_item(INP(15), 4096, 4096, WSP(bf16, WS_WIN1), 2048, 0, 16, scr, r, F.lane); continue; } r -= I4;
            if (r < I5) { tr_item(INP(16), 2048, 2048, WSP(bf16, WS_WOUT1), 2048, 0, 16, scr, r, F.lane); continue; } r -= I5;
            if (r < I6) { const int g = r / 32; tr_item(INP(13) + (size_t)g * 65536, 256, 256, WSP(bf16, WS_WPOOL), 256, g * 256, 16, scr, r % 32, F.lane); continue; } r -= I6;
            if (r < I7) { tr_item(INP(34), 1024, 1024, WSP(bf16, WS_WGLU), 1024, 0, 16, scr, r, F.lane); continue; } r -= I7;
            const int le = r / IE, q = r % IE;
            bf16* wc = (bf16*)(F.ws + WS_WMOE + (size_t)le * MOE_E_BYTES); bf16* w2t = wc + 1024 * 2048;
            if (q < 512) tr_item(INP(40) + (size_t)le * (2048 * 512), 512, 512, wc, 2048, 0, 32, scr, q, F.lane);
            else if (q < 1024) tr_item(INP(41) + (size_t)le * (2048 * 512), 512, 512, wc, 2048, 16, 32, scr, q - 512, F.lane);
            else tr_item(INP(42) + (size_t)le * (512 * 2048), 2048, 2048, w2t, 512, 0, 16, scr, q - 1024, F.lane);
        }
    }
}

__device__ __forceinline__ void p1_reduce(Frame& F) {
    const int gt = F.bid * NTHREADS + F.tid, NGT = F.G * NTHREADS;
    const float* part = WSP(float, WS_ADAP); float* mod = WSP(float, WS_MOD); const float* adab = INP(5);
    for (int idx = gt; idx < 2 * 3 * 12288; idx += NGT) { const int l = idx / (3 * 12288), r = idx % (3 * 12288), m = r / 12288, j = r % 12288;
        float a = adab[l * 12288 + j];
        for (int ks = 0; ks < 32; ++ks) a += part[((size_t)(l * 32 + ks) * 3 + m) * 12288 + j];
        mod[idx] = a; }
    const float* normp = WSP(float, WS_NORMP); float* invn = WSP(float, WS_INVN);
    for (int idx = gt; idx < 2048; idx += NGT) { const int o = idx >> 10, ch = idx & 1023; float a = 0.f;
        for (int pb = 0; pb < 256; ++pb) a += normp[(size_t)pb * 4096 + o * 2048 + ch] + normp[(size_t)pb * 4096 + o * 2048 + 1024 + ch];
        invn[idx] = 1.0f / a; }
}

__device__ __forceinline__ const float* modp(Frame& F, int l, int m, int c) { return WSP(float, WS_MOD) + ((size_t)(l * 3 + m) * 6 + c) * 2048; }
__device__ __forceinline__ int row_stream(int r) { return r < TL ? r / SEQ : 2; }

template <int MODE>
__device__ __forceinline__ void norm_phase(Frame& F, int l, float* dout) {
    const int nrows = (MODE == 3 || (MODE == 1 && l == 1)) ? TL : TT;
    float* xbuf = WSP(float, WS_X); bf16* ha = WSP(bf16, WS_HA); const bf16* Y = WSP(bf16, WS_Y);
    const float* gvec = (MODE == 0) ? INP(6) : (MODE == 1) ? INP(7) + l * 2048 : (MODE == 2) ? INP(6) + 2048 : INP(8);
    const int lane = F.lane;
    for (int r = F.gw; r < nrows; r += F.NGW) {
        const int m = row_stream(r);
        const float* src = (MODE == 0) ? (r < TL ? INP(0) + (size_t)r * 2048 : INP(2) + (size_t)(r - TL) * 2048) : xbuf + (size_t)r * 2048;
        f32x4 v[8]; float ss = 0.f;
#pragma unroll
        for (int j = 0; j < 8; ++j) v[j] = *(const f32x4*)(src + 4 * lane + 256 * j);
        if (MODE == 2 || MODE == 3) {
            const float* g2 = modp(F, MODE == 2 ? 0 : 1, m, 5);
            const bf16* y0 = Y + (size_t)(2 * r) * 2048; const bf16* y1 = y0 + 2048;
#pragma unroll
            for (int j = 0; j < 8; ++j) { const int c = 4 * lane + 256 * j; const v2u a = *(const v2u*)(y0 + c), b = *(const v2u*)(y1 + c); const f32x4 gg = *(const f32x4*)(g2 + c);
                v[j].x += gg.x * (bflo(a.x) + bflo(b.x)); v[j].y += gg.y * (bfhi(a.x) + bfhi(b.x)); v[j].z += gg.z * (bflo(a.y) + bflo(b.y)); v[j].w += gg.w * (bfhi(a.y) + bfhi(b.y)); }
            if (MODE == 2) {
#pragma unroll
                for (int j = 0; j < 8; ++j) *(f32x4*)(xbuf + (size_t)r * 2048 + 4 * lane + 256 * j) = v[j];
            }
        }
#pragma unroll
        for (int j = 0; j < 8; ++j) ss += (v[j].x * v[j].x + v[j].y * v[j].y) + (v[j].z * v[j].z + v[j].w * v[j].w);
        ss = wave_sum(ss);
        const float rs = 1.0f / sqrtf(ss * (1.0f / 2048.0f) + EPS);
        if (MODE == 3) {
#pragma unroll
            for (int j = 0; j < 8; ++j) { const int c = 4 * lane + 256 * j; const f32x4 gg = *(const f32x4*)(gvec + c); *(f32x4*)(dout + (size_t)r * 2048 + c) = v[j] * rs * gg; }
            continue;
        }
        const int lm = (MODE == 2) ? 1 : l;
        const float* sh = modp(F, lm, m, MODE == 1 ? 3 : 0); const float* sc = modp(F, lm, m, MODE == 1 ? 4 : 1);
#pragma unroll
        for (int j = 0; j < 8; ++j) { const int c = 4 * lane + 256 * j; const f32x4 gg = *(const f32x4*)(gvec + c), s1 = *(const f32x4*)(sc + c), s0 = *(const f32x4*)(sh + c);
            v[j] = (v[j] * rs * gg) * (1.0f + s1) + s0;
            v2u o; o.x = pk2(v[j].x, v[j].y); o.y = pk2(v[j].z, v[j].w); *(v2u*)(ha + (size_t)r * 2048 + c) = o; }
        if (MODE == 1) {
            const float* wrt = WSP(float, WS_WRT) + (size_t)l * 72 * 2048;
            float lgG = 0.f, lgE = 0.f;
#pragma nounroll
            for (int n = 0; n < 72; ++n) { const float* wn = wrt + (size_t)n * 2048; float a = 0.f;
#pragma unroll
                for (int j = 0; j < 8; ++j) { const f32x4 w = *(const f32x4*)(wn + 4 * lane + 256 * j); a += (v[j].x * w.x + v[j].y * w.y) + (v[j].z * w.z + v[j].w * w.w); }
                a = wave_sum(a);
                if (n < 8) { if (lane == n) lgG = a; } else { if (lane == n - 8) lgE = a; } }
            if (lane < 8) lgG += INP(37)[l * 8 + lane];
            lgE += INP(39)[l * 64 + lane];
            float gl[8]; float gmax = -INFINITY; int gi = 0;
#pragma unroll
            for (int j = 0; j < 8; ++j) { gl[j] = __shfl(lgG, j); if (gl[j] > gmax) { gmax = gl[j]; gi = j; } }
            float gsum = 0.f;
#pragma unroll
            for (int j = 0; j < 8; ++j) gsum += expf(gl[j] - gmax);
            const float pg_top = 1.0f / gsum;
            float el[8]; float emax = -INFINITY;
#pragma unroll
            for (int j = 0; j < 8; ++j) { el[j] = __shfl(lgE, gi * 8 + j); emax = fmaxf(emax, el[j]); }
            float esum = 0.f; float pe[8];
#pragma unroll
            for (int j = 0; j < 8; ++j) { pe[j] = expf(el[j] - emax); esum += pe[j]; }
            int e1 = 0; float p1 = -1.f;
#pragma unroll
            for (int j = 0; j < 8; ++j) { pe[j] /= esum; if (pe[j] > p1) { p1 = pe[j]; e1 = j; } }
            int e2 = 0; float p2 = -1.f;
#pragma unroll
            for (int j = 0; j < 8; ++j) { if (j != e1 && pe[j] > p2) { p2 = pe[j]; e2 = j; } }
            const float den = p1 + p2; const float g1 = pg_top * p1 / den, g2 = pg_top * p2 / den;
            if (lane == 0) {
                unsigned* cnt = WSP(unsigned, WS_CTL) + CW_CNT + l * 64; int* tokl = WSP(int, WS_TOKL); float* gatel = WSP(float, WS_GATEL);
                const int ex1 = gi * 8 + e1, ex2 = gi * 8 + e2;
                const unsigned k1 = atomicAdd(cnt + ex1, 1u); tokl[(size_t)ex1 * LISTCAP + k1] = 2 * r; gatel[(size_t)ex1 * LISTCAP + k1] = g1;
                const unsigned k2 = atomicAdd(cnt + ex2, 1u); tokl[(size_t)ex2 * LISTCAP + k2] = 2 * r + 1; gatel[(size_t)ex2 * LISTCAP + k2] = g2;
            }
        }
    }
}

#define EPI_ARGS const f32x4 (&acc)[2][2][4][2], const pg8::Unit& u, int wr, int wc, int fr, int fq
__device__ __forceinline__ void st_bf4(bf16* p, f32x4 v) { v2u o; o.x = cvt_pk_bf16(v.x, v.y); o.y = cvt_pk_bf16(v.z, v.w); *(v2u*)p = o; }

struct EpiQKP {
    bf16* Q; bf16* Kb; bf16* P; const f32x2* rope;
    __device__ __forceinline__ void operator()(EPI_ARGS) const {
        const int sect = u.pn >> 2, cb = (u.pn & 3) * 256; const bool latent = u.pm < TL / 256;
#pragma unroll
        for (int ai = 0; ai < 2; ++ai)
#pragma unroll
            for (int m = 0; m < 4; ++m) {
                const int r = u.pm * 256 + ai * 128 + wr * 64 + m * 16 + fr;
                int b, t; if (latent) { b = r / SEQ; t = r % SEQ; } else { b = (r - TL) / CTX; t = (r - TL) % CTX; }
                f32x4 cs0 = {1.f, 0.f, 1.f, 0.f}, cs1 = cs0;
                if (latent && sect < 2) { const int pos = (wc & 1) ? (t & 63) : (t >> 6); const f32x4* rp = (const f32x4*)(rope + pos * 16 + 4 * fq); cs0 = rp[0]; cs1 = rp[1]; }
#pragma unroll
                for (int bj = 0; bj < 2; ++bj) {
                    const int c0 = cb + bj * 128 + wc * 32 + 4 * fq;
                    f32x4 a = acc[ai][bj][m][0], bb = acc[ai][bj][m][1];
                    if (sect < 2) {
                        const f32x4 co = {cs0.x, cs0.z, cs1.x, cs1.z}, si = {cs0.y, cs0.w, cs1.y, cs1.w};
                        const f32x4 oa = a * co - bb * si, ob = a * si + bb * co; a = oa; bb = ob;
                    }
                    if (sect == 0) { a = a * QSCALE; bb = bb * QSCALE; bf16* d = Q + (size_t)r * 1024 + c0; st_bf4(d, a); st_bf4(d + 16, bb); }
                    else if (sect == 1) { const size_t kr = (size_t)b * KEYS + (latent ? CTX + t : t); bf16* d = Kb + kr * 1024 + c0; st_bf4(d, a); st_bf4(d + 16, bb); }
                    else { bf16* d = P + (size_t)r * 1024 + c0; st_bf4(d, a); st_bf4(d + 16, bb); }
                }
            }
    }
};
struct EpiVT {
    bf16* VT;
    __device__ __forceinline__ void operator()(EPI_ARGS) const {
        const bool latent = u.pn < TL / 256; const int b = latent ? u.pn / 32 : u.pn - TL / 256; const int key_t0 = latent ? CTX + (u.pn % 32) * 256 : 0;
        const int kperm = 8 * (fq & 1) + 4 * (fq >> 1);
#pragma unroll
        for (int ai = 0; ai < 2; ++ai)
#pragma unroll
            for (int m = 0; m < 4; ++m) {
                const int rr = u.pm * 256 + ai * 128 + wr * 64 + m * 16 + fr;
                bf16* rowp = VT + ((size_t)b * 1024 + rr) * KEYS + key_t0;
#pragma unroll
                for (int bj = 0; bj < 2; ++bj)
#pragma unroll
                    for (int n = 0; n < 2; ++n) st_bf4(rowp + bj * 128 + wc * 32 + 16 * n + kperm, acc[ai][bj][m][n]);
            }
    }
};
struct EpiScaleBf16 {
    bf16* O; int ldo, coff; const float* cscale;
    __device__ __forceinline__ void operator()(EPI_ARGS) const {
#pragma unroll
        for (int bj = 0; bj < 2; ++bj)
#pragma unroll
            for (int n = 0; n < 2; ++n) { const int c = u.pn * 256 + bj * 128 + wc * 32 + 16 * n + 4 * fq; const f32x4 sc = *(const f32x4*)(cscale + c);
#pragma unroll
                for (int ai = 0; ai < 2; ++ai)
#pragma unroll
                    for (int m = 0; m < 4; ++m) { const int r = u.pm * 256 + ai * 128 + wr * 64 + m * 16 + fr; st_bf4(O + (size_t)r * ldo + coff + c, acc[ai][bj][m][n] * sc); } }
    }
};
struct EpiBf16 {
    bf16* O; int ldo;
    __device__ __forceinline__ void operator()(EPI_ARGS) const {
#pragma unroll
        for (int ai = 0; ai < 2; ++ai)
#pragma unroll
            for (int m = 0; m < 4; ++m) { const int r = u.pm * 256 + ai * 128 + wr * 64 + m * 16 + fr; bf16* rowp = O + (size_t)r * ldo + u.pn * 256 + wc * 32 + 4 * fq;
#pragma unroll
                for (int bj = 0; bj < 2; ++bj)
#pragma unroll
                    for (int n = 0; n < 2; ++n) st_bf4(rowp + bj * 128 + 16 * n, acc[ai][bj][m][n]); }
    }
};
struct EpiRes {
    const float* xlat; const float* xctx; float* xout; const float* gate0;
    __device__ __forceinline__ void operator()(EPI_ARGS) const {
        const bool latent = u.pm < TL / 256;
#pragma unroll
        for (int ai = 0; ai < 2; ++ai)
#pragma unroll
            for (int m = 0; m < 4; ++m) { const int r = u.pm * 256 + ai * 128 + wr * 64 + m * 16 + fr; const int ms = latent ? r / SEQ : 2;
                const float* xi = latent ? xlat + (size_t)r * 2048 : xctx + (size_t)(r - TL) * 2048; const float* gp = gate0 + (size_t)ms * 12288;
#pragma unroll
                for (int bj = 0; bj < 2; ++bj)
#pragma unroll
                    for (int n = 0; n < 2; ++n) { const int c = u.pn * 256 + bj * 128 + wc * 32 + 16 * n + 4 * fq;
                        const f32x4 xv = *(const f32x4*)(xi + c), gv = *(const f32x4*)(gp + c); *(f32x4*)(xout + (size_t)r * 2048 + c) = xv + gv * acc[ai][bj][m][n]; } }
    }
};
struct EpiMoeUp {
    bf16* H;
    __device__ __forceinline__ void operator()(EPI_ARGS) const {
#pragma unroll
        for (int ai = 0; ai < 2; ++ai)
#pragma unroll
            for (int m = 0; m < 4; ++m) { const size_t r = (size_t)u.pm * 256 + ai * 128 + wr * 64 + m * 16 + fr;
#pragma unroll
                for (int bj = 0; bj < 2; ++bj) { const int hc = (u.pn * 256 + bj * 128 + wc * 32) / 2 + 4 * fq; const f32x4 a = acc[ai][bj][m][0], b = acc[ai][bj][m][1];
                    const f32x4 h = {siluf_(a.x) * b.x, siluf_(a.y) * b.y, siluf_(a.z) * b.z, siluf_(a.w) * b.w}; st_bf4(H + r * 512 + hc, h); } }
    }
};
struct EpiMoeDown {
    bf16* Y; const int* tokl; const float* gatel; const unsigned* cnt;
    __device__ __forceinline__ void operator()(EPI_ARGS) const {
        const int ce = (int)cnt[u.e];
#pragma unroll
        for (int ai = 0; ai < 2; ++ai)
#pragma unroll
            for (int m = 0; m < 4; ++m) { const int idx = u.idx0 + ai * 128 + wr * 64 + m * 16 + fr;
                if (idx < ce) { const int pair = tokl[(size_t)u.e * LISTCAP + idx]; const float gt = gatel[(size_t)u.e * LISTCAP + idx]; bf16* rowp = Y + (size_t)pair * 2048 + u.pn * 256 + wc * 32 + 4 * fq;
#pragma unroll
                    for (int bj = 0; bj < 2; ++bj)
#pragma unroll
                        for (int n = 0; n < 2; ++n) st_bf4(rowp + bj * 128 + 16 * n, acc[ai][bj][m][n] * gt); } }
    }
};
struct EpiGlu {
    bf16* O; int ldo, coff; const bf16* Gb; const float* bias;
    __device__ __forceinline__ void operator()(EPI_ARGS) const {
#pragma unroll
        for (int ai = 0; ai < 2; ++ai)
#pragma unroll
            for (int m = 0; m < 4; ++m) { const int r = u.pm * 256 + ai * 128 + wr * 64 + m * 16 + fr;
#pragma unroll
                for (int bj = 0; bj < 2; ++bj)
#pragma unroll
                    for (int n = 0; n < 2; ++n) { const int c = u.pn * 256 + bj * 128 + wc * 32 + 16 * n + 4 * fq; const f32x4 bv = *(const f32x4*)(bias + c); const v2u gw = *(const v2u*)(Gb + (size_t)r * 1024 + c);
                        const f32x4 a = acc[ai][bj][m][n] + bv; const f32x4 o = {bflo(gw.x) * sigmoidf_(a.x), bfhi(gw.x) * sigmoidf_(a.y), bflo(gw.y) * sigmoidf_(a.z), bfhi(gw.y) * sigmoidf_(a.w)};
                        st_bf4(O + (size_t)r * ldo + coff + c, o); } }
    }
};

struct MoeOrder {
    const LAS int* bstart;
    const unsigned* cnt; const int* tokl; int nN, G, c, nblk; long bstride, eoff; bool up;
    __device__ bool next(int i, pg8::Unit& u) const {
        const long Lx = (long)i * G + c; if (Lx >= (long)nblk * nN) return false;
        const int blk = (int)(Lx / nN); u.pn = (int)(Lx % nN); u.pm = blk;
        int e = 0;
        for (int j = 1; j < 64; ++j) e += (bstart[j] <= blk) ? 1 : 0;
        u.e = e; u.idx0 = (blk - bstart[e]) * 256;
        u.aoff = up ? 0 : (long)blk * 256 * 512 * 2;
        u.boff = (long)e * (long)MOE_E_BYTES + eoff + (long)u.pn * bstride;
        return true;
    }
    __device__ int arow(const pg8::Unit& u, int row) const { const int idx = u.idx0 + row; return idx < (int)cnt[u.e] ? (tokl[(size_t)u.e * LISTCAP + idx] >> 1) : TT; }
};

__device__ __forceinline__ void attn_phase(Frame& F) {
    const bf16* Q = WSP(bf16, WS_Q); const bf16* Kb = WSP(bf16, WS_K); const bf16* VT = WSP(bf16, WS_VT); bf16* cat = WSP(bf16, WS_CAT);
    LAS unsigned char* lds = F.lds;
    const int tid = F.tid, lane = F.lane, w = F.wave, sub = w & 1, qw = w >> 1, r32 = lane & 31, hi = lane >> 5;
    float lam;
    { const float* lv = INP(11); float a = lv[lane] * lv[64 + lane], b = lv[128 + lane] * lv[192 + lane]; a = wave_sum(a); b = wave_sum(b); lam = expf(a) - expf(b) + 0.2f; }
    const float* subg = INP(12);
    const int NU = 1024 + 32;
    const int xcd = F.bid & 7, jcu = F.bid >> 3;
    for (int it = 0;; ++it) {
        int uidx;
        if (F.G == 256) { if (it < 4) uidx = 128 * xcd + it * 32 + jcu; else if (it == 4 && F.bid < 32) uidx = 1024 + F.bid; else break; }
        else { uidx = it * F.G + F.bid; if (uidx >= NU) break; }
        int b, head, q0row, nt; size_t kbase;
        if (uidx < 1024) { const int combo = uidx >> 6, qb = uidx & 63; b = combo >> 3; head = combo & 7; q0row = b * SEQ + qb * 128; nt = KEYS / 64; }
        else { const int v = uidx - 1024; b = v >> 4; head = (v >> 1) & 7; q0row = TL + b * CTX + (v & 1) * 128; nt = CTX / 64; }
        kbase = (size_t)b * KEYS;
        bf16x8 qf[4];
        { const bf16* qp = Q + (size_t)(q0row + qw * 32 + r32) * 1024 + head * 128 + sub * 64 + hi * 8;
#pragma unroll
          for (int ks = 0; ks < 4; ++ks) qf[ks] = *(const bf16x8*)(qp + ks * 16); }
        const int srow = tid >> 3, sch = tid & 7;
        const bf16* gk0 = Kb + (kbase + srow) * 1024 + head * 128 + sch * 8;
        const bf16* gv0 = VT + ((size_t)(b * 8 + head) * 128 + srow) * KEYS + sch * 8;
        const int lk = srow * 128 + ((sch ^ ((srow >> 1) & 7)) * 16);
        v4u st0, st1, st2, st3;
#define ATT_LOAD(t) do { st0 = *(const v4u*)(gk0 + (size_t)(t) * 65536); st1 = *(const v4u*)(gk0 + (size_t)(t) * 65536 + 64); st2 = *(const v4u*)(gv0 + (t) * 64); st3 = *(const v4u*)(gv0 + (size_t)64 * KEYS + (t) * 64); } while (0)
#define ATT_STORE(buf) do { LAS unsigned char* bp = lds + (buf) * 32768; *(LAS v4u*)(bp + lk) = st0; *(LAS v4u*)(bp + 8192 + lk) = st1; *(LAS v4u*)(bp + 16384 + lk) = st2; *(LAS v4u*)(bp + 16384 + 8192 + lk) = st3; } while (0)
        ATT_LOAD(0); ATT_STORE(0);
        __syncthreads();
        f32x16 o[4];
#pragma unroll
        for (int d = 0; d < 4; ++d)
#pragma unroll
            for (int r = 0; r < 16; ++r) o[d][r] = 0.f;
        float mrow = -INFINITY, lrow = 0.f;
        const int rdoff = r32 * 128;
        const int swz = (r32 >> 1) & 7;
        for (int t = 0; t < nt; ++t) {
            if (t + 1 < nt) ATT_LOAD(t + 1);
            const LAS unsigned char* bp = lds + (t & 1) * 32768;
            const LAS unsigned char* kp = bp + sub * 8192;
            f32x16 s0, s1;
#pragma unroll
            for (int r = 0; r < 16; ++r) { s0[r] = 0.f; s1[r] = 0.f; }
#pragma unroll
            for (int ks = 0; ks < 4; ++ks) {
                const int ch = ((2 * ks + hi) ^ swz) * 16;
                const bf16x8 k0 = *(const LAS bf16x8*)(kp + rdoff + ch);
                const bf16x8 k1 = *(const LAS bf16x8*)(kp + 4096 + rdoff + ch);
                s0 = __builtin_amdgcn_mfma_f32_32x32x16_bf16(k0, qf[ks], s0, 0, 0, 0);
                s1 = __builtin_amdgcn_mfma_f32_32x32x16_bf16(k1, qf[ks], s1, 0, 0, 0);
            }
            float mx = s0[0];
#pragma unroll
            for (int r = 1; r < 16; ++r) mx = fmaxf(mx, s0[r]);
#pragma unroll
            for (int r = 0; r < 16; ++r) mx = fmaxf(mx, s1[r]);
            mx = fmaxf(mx, __shfl_xor(mx, 32));
            const float mnew = fmaxf(mrow, mx);
            const float alpha = __builtin_amdgcn_exp2f(mrow - mnew);
            mrow = mnew;
            float rs = 0.f;
#pragma unroll
            for (int r = 0; r < 16; ++r) { s0[r] = __builtin_amdgcn_exp2f(s0[r] - mnew); rs += s0[r]; }
#pragma unroll
            for (int r = 0; r < 16; ++r) { s1[r] = __builtin_amdgcn_exp2f(s1[r] - mnew); rs += s1[r]; }
            lrow = lrow * alpha + rs;
            if (__any(alpha != 1.0f)) {
#pragma unroll
                for (int d = 0; d < 4; ++d)
#pragma unroll
                    for (int r = 0; r < 16; ++r) o[d][r] *= alpha;
            }
            bf16x8 pf[4];
#pragma unroll
            for (int s = 0; s < 4; ++s) { v4u pw;
                if (s < 2) { pw.x = cvt_pk_bf16(s0[8 * s + 0], s0[8 * s + 1]); pw.y = cvt_pk_bf16(s0[8 * s + 2], s0[8 * s + 3]); pw.z = cvt_pk_bf16(s0[8 * s + 4], s0[8 * s + 5]); pw.w = cvt_pk_bf16(s0[8 * s + 6], s0[8 * s + 7]); }
                else { const int q = s - 2; pw.x = cvt_pk_bf16(s1[8 * q + 0], s1[8 * q + 1]); pw.y = cvt_pk_bf16(s1[8 * q + 2], s1[8 * q + 3]); pw.z = cvt_pk_bf16(s1[8 * q + 4], s1[8 * q + 5]); pw.w = cvt_pk_bf16(s1[8 * q + 6], s1[8 * q + 7]); }
                pf[s] = __builtin_bit_cast(bf16x8, pw); }
            const LAS unsigned char* vp = bp + 16384;
#pragma unroll
            for (int d = 0; d < 4; ++d)
#pragma unroll
                for (int s = 0; s < 4; ++s) {
                    const bf16x8 vf = *(const LAS bf16x8*)(vp + d * 4096 + rdoff + (((2 * s + hi) ^ swz) * 16));
                    o[d] = __builtin_amdgcn_mfma_f32_32x32x16_bf16(vf, pf[s], o[d], 0, 0, 0);
                }
            if (t + 1 < nt) ATT_STORE((t + 1) & 1);
            __syncthreads();
        }
#undef ATT_LOAD
#undef ATT_STORE
        const float ltot = lrow + __shfl_xor(lrow, 32); const float linv = 1.0f / ltot;
        LAS float* xch = (LAS float*)lds + (size_t)(qw * 32 + r32) * 132;
        if (sub == 1) {
#pragma unroll
            for (int d = 0; d < 4; ++d)
#pragma unroll
                for (int g = 0; g < 4; ++g) *(LAS f32x4*)(xch + 32 * d + 8 * g + 4 * hi) = (f32x4){o[d][4 * g] * linv, o[d][4 * g + 1] * linv, o[d][4 * g + 2] * linv, o[d][4 * g + 3] * linv};
        }
        __syncthreads();
        if (sub == 0) {
            float ss = 0.f;
#pragma unroll
            for (int d = 0; d < 4; ++d)
#pragma unroll
                for (int g = 0; g < 4; ++g) { const f32x4 o2 = *(const LAS f32x4*)(xch + 32 * d + 8 * g + 4 * hi);
#pragma unroll
                    for (int j = 0; j < 4; ++j) { const float v = o[d][4 * g + j] * linv - lam * o2[j]; o[d][4 * g + j] = v; ss += v * v; } }
            ss += __shfl_xor(ss, 32);
            const float rn = 0.8f / sqrtf(ss * (1.0f / 128.0f) + EPS);
            bf16* op = cat + (size_t)(q0row + qw * 32 + r32) * 2048 + head * 128;
#pragma unroll
            for (int d = 0; d < 4; ++d)
#pragma unroll
                for (int g = 0; g < 4; ++g) { const int dv = 32 * d + 8 * g + 4 * hi; const f32x4 gg = *(const f32x4*)(subg + dv);
                    st_bf4(op + dv, (f32x4){o[d][4 * g] * rn * gg.x, o[d][4 * g + 1] * rn * gg.y, o[d][4 * g + 2] * rn * gg.z, o[d][4 * g + 3] * rn * gg.w}); }
        }
        __syncthreads();
    }
}

__device__ __forceinline__ void poold_phase(Frame& F) {
    const bf16* P = WSP(bf16, WS_P); bf16* PD = WSP(bf16, WS_PD);
    const int gt = F.bid * NTHREADS + F.tid, NGT = F.G * NTHREADS;
    for (int idx = gt; idx < TT * 128; idx += NGT) {
        const int r = idx >> 7, cc = (idx & 127) * 8, g = cc >> 8, wdw = 2 << g;
        int sb, t, Ls; if (r < TL) { sb = (r / SEQ) * SEQ; t = r % SEQ; Ls = SEQ; } else { sb = TL + ((r - TL) / CTX) * CTX; t = (r - TL) % CTX; Ls = CTX; }
        int lo = t - wdw / 2, hi = lo + wdw; lo = lo < 0 ? 0 : lo; hi = hi > Ls ? Ls : hi;
        float a[8];
#pragma unroll
        for (int j = 0; j < 8; ++j) a[j] = 0.f;
        for (int s = lo; s < hi; ++s) { const v4u v = *(const v4u*)(P + (size_t)(sb + s) * 1024 + cc);
            a[0] += bflo(v.x); a[1] += bfhi(v.x); a[2] += bflo(v.y); a[3] += bfhi(v.y); a[4] += bflo(v.z); a[5] += bfhi(v.z); a[6] += bflo(v.w); a[7] += bfhi(v.w); }
        const float inv = 1.0f / (float)(hi - lo);
        const v4u me = *(const v4u*)(P + (size_t)r * 1024 + cc);
        v4u o; o.x = pk2(a[0] * inv - bflo(me.x), a[1] * inv - bfhi(me.x)); o.y = pk2(a[2] * inv - bflo(me.y), a[3] * inv - bfhi(me.y));
        o.z = pk2(a[4] * inv - bflo(me.z), a[5] * inv - bfhi(me.z)); o.w = pk2(a[6] * inv - bflo(me.w), a[7] * inv - bfhi(me.w));
        *(v4u*)(PD + (size_t)r * 1024 + cc) = o;
    }
}

__device__ __forceinline__ void shortconv_phase(Frame& F) {
    const bf16* PJ = WSP(bf16, WS_PROJ1); float* GT = WSP(float, WS_GT);
    const float* cw = INP(17); const float* cb = INP(18);
    LAS float* scr = (LAS float*)(F.lds + F.wave * 16896);
    const int lane = F.lane;
    for (int it = F.gw; it < 2 * 128 * 48; it += F.NGW) {
        const int cbk = it % 48, tb = (it / 48) % 128, b = it / (48 * 128), col = cbk * 64 + lane, t0 = tb * 64;
        const float w0 = cw[col], w1 = cw[3072 + col], w2 = cw[2 * 3072 + col], bias = cb[col];
        const bf16* base = PJ + ((size_t)b * SEQ) * 4096 + col;
        float prev = (t0 > 0) ? bf2f(base[(size_t)(t0 - 1) * 4096]) : 0.f;
        float cur = bf2f(base[(size_t)t0 * 4096]);
#pragma unroll 8
        for (int tt = 0; tt < 64; ++tt) { const int t = t0 + tt; const float nxt = (t + 1 < SEQ) ? bf2f(base[(size_t)(t + 1) * 4096]) : 0.f;
            scr[tt * 65 + lane] = prev * w0 + cur * w1 + nxt * w2 + bias; prev = cur; cur = nxt; }
        LDS_WAIT(); asm volatile("" ::: "memory");
        for (int c = 0; c < 64; ++c) GT[((size_t)(cbk * 64 + c) * 2 + b) * SEQ + t0 + lane] = scr[lane * 65 + c];
        LDS_WAIT(); asm volatile("" ::: "memory");
    }
}

__device__ __forceinline__ void s5_scan_phase(Frame& F) {
    const bf16* PJ = WSP(bf16, WS_PROJ1); float* YD = WSP(float, WS_YD);
    const f32x2* lamb = WSP(f32x2, WS_S5LAM); const f32x2* bbar = WSP(f32x2, WS_S5B);
    const float* cre = INP(31); const float* cim = INP(32);
    const int lane = F.lane;
    for (int task = F.wave * F.G + F.bid; task < 256; task += F.NGW) {
        const int di = task >> 7, b = (task >> 6) & 1, g = task & 63;
        const int dgp = (di * 64 + g) * 64 + lane;
        const f32x2 lam = lamb[dgp];
        float br[16], bi[16], cr[16], ci[16];
#pragma unroll
        for (int c = 0; c < 16; ++c) { const f32x2 bv = bbar[(size_t)dgp * 16 + c]; br[c] = bv.x; bi[c] = bv.y;
            cr[c] = cre[((size_t)(di * 64 + g) * 16 + c) * 64 + lane]; ci[c] = cim[((size_t)(di * 64 + g) * 16 + c) * 64 + lane]; }
        float sr = 0.f, si = 0.f;
        const int nsteps = CTX + SEQ;
        for (int st = 0; st < nsteps; st += 4) {
            const int stl = st + (lane >> 4);
            int row;
            if (stl < CTX) row = TL + b * CTX + (di == 0 ? stl : CTX - 1 - stl);
            else row = b * SEQ + (di == 0 ? stl - CTX : SEQ - 1 - (stl - CTX));
            const float uval = bf2f(PJ[(size_t)row * 4096 + 3072 + g * 16 + (lane & 15)]);
#pragma unroll
            for (int k = 0; k < 4; ++k) {
                float bur = 0.f, bui = 0.f;
#pragma unroll
                for (int c = 0; c < 16; ++c) { const float u = __builtin_bit_cast(float, __builtin_amdgcn_readlane(__builtin_bit_cast(int, uval), 16 * k + c)); bur += br[c] * u; bui += bi[c] * u; }
                const float nr = lam.x * sr - lam.y * si + bur, ni = lam.x * si + lam.y * sr + bui; sr = nr; si = ni;
                const int s2 = st + k;
                if (s2 >= CTX) {
                    const int t = (di == 0) ? s2 - CTX : SEQ - 1 - (s2 - CTX);
                    float outv = 0.f;
#pragma unroll
                    for (int c = 0; c < 16; ++c) { float v = cr[c] * sr - ci[c] * si; v = wave_sum(v); if (lane == c) outv = v; }
                    if (lane < 16) YD[((size_t)di * TL + (size_t)b * SEQ + t) * 1024 + g * 16 + lane] = outv;
                }
            }
        }
    }
}

__device__ __forceinline__ void hyena_naive_phase(Frame& F) {
    const float* GT = WSP(float, WS_GT); const float* kT = WSP(float, WS_KT); const float* invn = WSP(float, WS_INVN); bf16* cat = WSP(bf16, WS_CAT);
    const float* hyb = INP(25);
    LAS float* kf = (LAS float*)F.lds;
    LAS f32x2* ub = (LAS f32x2*)(F.lds + 65536);
    const int tid = F.tid;
    for (int ch = F.bid; ch < 1024; ch += F.G) {
        float res0[16], res1[16];
        for (int o = 0; o < 2; ++o) {
            const float inv = invn[o * 1024 + ch];
            const float* kfw = kT + (size_t)(o * 2048 + ch) * SEQ; const float* kbw = kT + (size_t)(o * 2048 + 1024 + ch) * SEQ;
            for (int n = tid; n < 16384; n += NTHREADS) { float v; if (n < SEQ) v = kfw[n]; else if (n == SEQ) v = 0.f; else v = kbw[16384 - n]; kf[n] = v * inv; }
            if (o == 0) { const float* v0 = GT + ((size_t)(0 * 1024 + ch) * 2) * SEQ; for (int n = tid; n < SEQ; n += NTHREADS) ub[n] = (f32x2){v0[n], v0[SEQ + n]}; }
            else {
#pragma unroll
                for (int j = 0; j < 16; ++j) ub[tid + NTHREADS * j] = (f32x2){res0[j], res1[j]}; }
            __syncthreads();
            float a0[16], a1[16];
#pragma unroll
            for (int j = 0; j < 16; ++j) { a0[j] = 0.f; a1[j] = 0.f; }
            for (int s = 0; s < SEQ; ++s) { const f32x2 u = ub[s];
#pragma unroll
                for (int j = 0; j < 16; ++j) { const float kk = kf[(tid + NTHREADS * j - s) & 16383]; a0[j] += u.x * kk; a1[j] += u.y * kk; } }
            const float bias = hyb[o * 1024 + ch];
            const float* xg = GT + ((size_t)((o + 1) * 1024 + ch) * 2) * SEQ;
#pragma unroll
            for (int j = 0; j < 16; ++j) { const int t = tid + NTHREADS * j; const f32x2 u = ub[t];
                res0[j] = xg[t] * (a0[j] + bias * u.x); res1[j] = xg[SEQ + t] * (a1[j] + bias * u.y); }
            __syncthreads();
        }
#pragma unroll
        for (int j = 0; j < 16; ++j) { const int t = tid + NTHREADS * j;
            cat[(size_t)t * 2048 + ch] = (bf16)f2bf(res0[j]); cat[((size_t)SEQ + t) * 2048 + ch] = (bf16)f2bf(res1[j]); }
    }
}

__device__ __forceinline__ void s5_gelu_phase(Frame& F) {
    const bf16* PJ = WSP(bf16, WS_PROJ1); const float* YD = WSP(float, WS_YD); bf16* Gb = WSP(bf16, WS_PD); const float* dd = INP(33);
    const int gt = F.bid * NTHREADS + F.tid, NGT = F.G * NTHREADS;
    for (int idx = gt; idx < TL * 256; idx += NGT) { const int r = idx >> 8, c = (idx & 255) * 4;
        const v2u uw = *(const v2u*)(PJ + (size_t)r * 4096 + 3072 + c); const f32x4 d4 = *(const f32x4*)(dd + c);
        const f32x4 y0 = *(const f32x4*)(YD + (size_t)r * 1024 + c), y1 = *(const f32x4*)(YD + ((size_t)TL + r) * 1024 + c);
        const f32x4 y = {bflo(uw.x) * d4.x + y0.x + y1.x, bfhi(uw.x) * d4.y + y0.y + y1.y, bflo(uw.y) * d4.z + y0.z + y1.z, bfhi(uw.y) * d4.w + y0.w + y1.w};
        st_bf4(Gb + (size_t)r * 1024 + c, (f32x4){gelu_tanh(y.x), gelu_tanh(y.y), gelu_tanh(y.z), gelu_tanh(y.w)}); }
}

constexpr int NPHASES = 21;
#ifndef MK_SINGLE
#define MK_SINGLE 0
#endif

__device__ __forceinline__ unsigned long long launder_u64(unsigned long long v) {
    unsigned lo = (unsigned)v, hi = (unsigned)(v >> 32);
    asm volatile("" : "+v"(lo), "+v"(hi));
    lo = __builtin_amdgcn_readfirstlane(lo); hi = __builtin_amdgcn_readfirstlane(hi);
    return ((unsigned long long)hi << 32) | lo;
}
__device__ __forceinline__ const void* launder_ptr(const void* p) {
    unsigned long long v = (unsigned long long)p; unsigned lo = (unsigned)v, hi = (unsigned)(v >> 32);
    asm volatile("" : "+v"(lo), "+v"(hi));
    lo = __builtin_amdgcn_readfirstlane(lo); hi = __builtin_amdgcn_readfirstlane(hi);
    return (const void*)(((unsigned long long)hi << 32) | lo);
}
__device__ __forceinline__ void moe_blocks(Frame& F, int l, LAS int* bstart) {
    __syncthreads();
    if (F.tid == 0) { const unsigned* cnt = WSP(unsigned, WS_CTL) + CW_CNT + l * 64; int acc = 0; for (int e = 0; e < 64; ++e) { bstart[e] = acc; acc += ((int)cnt[e] + 255) >> 8; } bstart[64] = acc; }
    __syncthreads();
}

template <int PHSEL>
__global__ void __launch_bounds__(NTHREADS, 2) mk_fwd(Args args) {
    extern __shared__ __attribute__((aligned(16))) unsigned char lds_raw[];
    Frame F;
    F.lds = (LAS unsigned char*)lds_raw; F.ws = args.ws; F.kin = (const __attribute__((address_space(4))) unsigned long long*)__builtin_amdgcn_kernarg_segment_ptr();
    F.tid = threadIdx.x; F.lane = F.tid & 63; F.wave = __builtin_amdgcn_readfirstlane(F.tid >> 6); F.bid = blockIdx.x; F.G = gridDim.x;
    F.gw = F.bid * NWAVES + F.wave; F.NGW = F.G * NWAVES;
    volatile LAS unsigned* lctl = (volatile LAS unsigned*)(F.lds + LDS_CTL);
    LAS int* bstart = (LAS int*)(F.lds + LDS_CTL + 64);
    if (F.tid < 4) lctl[F.tid] = 0u;
    __syncthreads();
    const int lo = args.ph_lo, hi = args.ph_hi;
    XcdBarrier bar; bar.bar = WSP(unsigned, WS_CTL) + CW_BAR; bar.x = 0; bar.st = lctl;
    if (hi - lo > 1) bar = xcd_barrier_post(WSP(unsigned, WS_CTL) + CW_BAR, lctl);
#define IN(k) ((PHSEL < 0 || PHSEL == (k)) && lo <= (k) && (k) < hi)
#define INL(j) ((PHSEL < 0 || PHSEL == 6 + (j)) && lo <= pb + (j) && pb + (j) < hi)
#define PH_END(k) do { if (PHSEL < 0 && lo <= (k) + 1 && (k) + 1 < hi) xcd_barrier(bar); } while (0)
#define PH_BEGIN() do { F.ws = (unsigned char*)launder_ptr((const void*)F.ws); F.kin = (const __attribute__((address_space(4))) unsigned long long*)launder_u64((unsigned long long)F.kin); } while (0)
    LAS unsigned char* lds = F.lds;
    const int G = F.G, bid = F.bid;
    constexpr long T2048 = 256L * 2048 * 2;

    if (IN(0)) { PH_BEGIN(); p0_prologue(F); PH_END(0); }
    if (IN(1)) { PH_BEGIN(); p1_reduce(F); PH_END(1); }
    for (int l = 0; l < 2; ++l) {
        if (l == 0) {
            if (IN(2)) { PH_BEGIN(); norm_phase<0>(F, 0, nullptr); PH_END(2); }
            if (IN(3)) { PH_BEGIN();
                { pg8::Gemm g{WSP(bf16, WS_HA), WSP(bf16, WS_WIN0), 2048, 2048, 2048}; pg8::StaticOrder S; S.init(TT / 256, 12, G, bid, T2048, 0, T2048);
                  EpiQKP E{WSP(bf16, WS_Q), WSP(bf16, WS_K), WSP(bf16, WS_P), WSP(f32x2, WS_ROPE)}; pg8::gemm_phase<EpiQKP, pg8::StaticOrder, false>(lds, g, S, E); }
                { pg8::Gemm g{WSP(bf16, WS_WIN0) + (size_t)3072 * 2048, WSP(bf16, WS_HA), 2048, 2048, 2048}; pg8::StaticOrder S; S.init(4, TT / 256, G, bid, T2048, 0, T2048);
                  EpiVT E{WSP(bf16, WS_VT)}; pg8::gemm_phase<EpiVT, pg8::StaticOrder, false>(lds, g, S, E); }
                PH_END(3);
            }
            if (IN(4)) { PH_BEGIN(); attn_phase(F); poold_phase(F); PH_END(4); }
            if (IN(5)) { PH_BEGIN();
                pg8::Gemm g{WSP(bf16, WS_PD), WSP(bf16, WS_WPOOL), 1024, 256, 256}; pg8::StaticOrder S; S.init(TT / 256, 4, G, bid, 256L * 1024 * 2, 256L * 2, 256L * 256 * 2);
                EpiScaleBf16 E{WSP(bf16, WS_CAT), 2048, 1024, INP(14)}; pg8::gemm_phase<EpiScaleBf16, pg8::StaticOrder, false>(lds, g, S, E);
                PH_END(5);
            }
        } else {
            if (IN(10)) { PH_BEGIN(); norm_phase<2>(F, 1, nullptr); PH_END(10); }
            if (IN(11)) { PH_BEGIN();
                pg8::Gemm g{WSP(bf16, WS_HA), WSP(bf16, WS_WIN1), 2048, 2048, 2048}; pg8::StaticOrder S; S.init(TT / 256, 16, G, bid, T2048, 0, T2048);
                EpiBf16 E{WSP(bf16, WS_PROJ1), 4096}; pg8::gemm_phase<EpiBf16, pg8::StaticOrder, false>(lds, g, S, E);
                PH_END(11);
            }
            if (IN(12)) { PH_BEGIN(); shortconv_phase(F); s5_scan_phase(F); PH_END(12); }
            if (IN(13)) { PH_BEGIN(); hyena_naive_phase(F); PH_END(13); }
            if (IN(14)) { PH_BEGIN(); s5_gelu_phase(F); PH_END(14); }
            if (IN(15)) { PH_BEGIN();
                pg8::Gemm g{WSP(bf16, WS_PD), WSP(bf16, WS_WGLU), 1024, 1024, 1024}; pg8::StaticOrder S; S.init(TL / 256, 4, G, bid, 256L * 1024 * 2, 0, 256L * 1024 * 2);
                EpiGlu E{WSP(bf16, WS_CAT), 2048, 1024, WSP(bf16, WS_PD), INP(35)}; pg8::gemm_phase<EpiGlu, pg8::StaticOrder, false>(lds, g, S, E);
                PH_END(15);
            }
        }
        const int pb = (l == 0) ? 6 : 16;
        if (INL(0)) { PH_BEGIN();
            float* xbuf = WSP(float, WS_X);
            pg8::Gemm g{WSP(bf16, WS_CAT), WSP(bf16, l == 0 ? WS_WOUT0 : WS_WOUT1), 2048, 2048, 2048}; pg8::StaticOrder S; S.init(l == 0 ? TT / 256 : TL / 256, 8, G, bid, T2048, 0, T2048);
            EpiRes E{l == 0 ? INP(0) : xbuf, l == 0 ? INP(2) : xbuf + (size_t)TL * 2048, xbuf, modp(F, l, 0, 2)}; pg8::gemm_phase<EpiRes, pg8::StaticOrder, false>(lds, g, S, E);
            PH_END(pb);
        }
        if (INL(1)) { PH_BEGIN(); norm_phase<1>(F, l, nullptr); PH_END(pb + 1); }
        if (INL(2)) { PH_BEGIN();
            moe_blocks(F, l, bstart);
            pg8::Gemm g{WSP(bf16, WS_HA), (const bf16*)(F.ws + WS_WMOE + (size_t)l * MOE_L_BYTES), 2048, 2048, 2048};
            MoeOrder S{bstart, WSP(unsigned, WS_CTL) + CW_CNT + l * 64, WSP(int, WS_TOKL), 4, G, bid, bstart[64], T2048, 0, true};
            EpiMoeUp E{WSP(bf16, WS_H)}; pg8::gemm_phase<EpiMoeUp, MoeOrder, true>(lds, g, S, E);
            PH_END(pb + 2);
        }
        if (INL(3)) { PH_BEGIN();
            moe_blocks(F, l, bstart);
            pg8::Gemm g{WSP(bf16, WS_H), (const bf16*)(F.ws + WS_WMOE + (size_t)l * MOE_L_BYTES), 512, 512, 512};
            MoeOrder S{bstart, WSP(unsigned, WS_CTL) + CW_CNT + l * 64, WSP(int, WS_TOKL), 8, G, bid, bstart[64], 256L * 512 * 2, (long)(4 * MiB), false};
            EpiMoeDown E{WSP(bf16, WS_Y), WSP(int, WS_TOKL), WSP(float, WS_GATEL), WSP(unsigned, WS_CTL) + CW_CNT + l * 64}; pg8::gemm_phase<EpiMoeDown, MoeOrder, false>(lds, g, S, E);
            PH_END(pb + 3);
        }
    }
    if (IN(20)) { PH_BEGIN(); norm_phase<3>(F, 1, args.out); }
#undef IN
#undef INL
#undef PH_END
}

typedef void (*kern_t)(Args);
template <int P> static void launch_phase(int grid, hipStream_t stream, Args a) { hipLaunchKernelGGL(mk_fwd<P>, dim3(grid), dim3(NTHREADS), LDS_BYTES, stream, a); }
template <int P> static bool prep_phase() { return hipFuncSetAttribute((const void*)mk_fwd<P>, hipFuncAttributeMaxDynamicSharedMemorySize, LDS_BYTES) == hipSuccess; }
extern "C" void kernel_launch(void* const* d_in, const int* in_sizes, int n_in, void* d_out, int out_size, void* d_ws, size_t ws_size, hipStream_t stream) {
    static int grid = 0;
    if (grid == 0) {
        if (n_in != 43 || out_size != TL * DM || ws_size < WS_END) { fprintf(stderr, "kernel_launch: unexpected shapes (n_in %d, out %d, ws %zu < %zu)\n", n_in, out_size, ws_size, (size_t)WS_END); grid = -1; return; }
        int dev = 0, cus = 0;
        if (hipGetDevice(&dev) != hipSuccess || hipDeviceGetAttribute(&cus, hipDeviceAttributeMultiprocessorCount, dev) != hipSuccess) { grid = -1; return; }
        bool ok = true;
#if MK_SINGLE
        ok = prep_phase<-1>();
#else
        ok = prep_phase<0>() && prep_phase<1>() && prep_phase<2>() && prep_phase<3>() && prep_phase<4>() && prep_phase<5>() && prep_phase<6>() && prep_phase<7>() && prep_phase<8>() && prep_phase<9>() &&
             prep_phase<10>() && prep_phase<11>() && prep_phase<12>() && prep_phase<13>() && prep_phase<14>() && prep_phase<15>() && prep_phase<20>();
#endif
        if (!ok) { fprintf(stderr, "kernel_launch: hipFuncSetAttribute failed\n"); grid = -1; return; }
        (void)hipGetLastError();
        grid = cus;
    }
    if (grid < 0) return;
    (void)hipMemsetAsync((char*)d_ws + WS_CTL, 0, CTL_BYTES, stream);
    Args a{};
    for (int i = 0; i < 43; ++i) a.in[i] = (const float*)d_in[i];
    a.out = (float*)d_out; a.ws = (unsigned char*)d_ws;
#if MK_SINGLE
    a.ph_lo = 0; a.ph_hi = NPHASES;
    launch_phase<-1>(grid, stream, a);
#else
#define LP(k, P) a.ph_lo = (k); a.ph_hi = (k) + 1; launch_phase<P>(grid, stream, a);
    LP(0, 0) LP(1, 1) LP(2, 2) LP(3, 3) LP(4, 4) LP(5, 5) LP(6, 6) LP(7, 7) LP(8, 8) LP(9, 9) LP(10, 10) LP(11, 11) LP(12, 12) LP(13, 13) LP(14, 14) LP(15, 15)
    LP(16, 6) LP(17, 7) LP(18, 8) LP(19, 9) LP(20, 20)
#undef LP
#endif
}
```

```cpp
#include <hip/hip_runtime.h>
#include <cstdio>
#include <cstdint>
#include <cmath>

#define GAS __attribute__((address_space(1)))
#define LAS __attribute__((address_space(3)))
typedef unsigned short bf16;
typedef unsigned v4u __attribute__((ext_vector_type(4)));
typedef unsigned v2u __attribute__((ext_vector_type(2)));
typedef float f32x4 __attribute__((ext_vector_type(4)));
typedef float f32x2 __attribute__((ext_vector_type(2)));
typedef float f32x16 __attribute__((ext_vector_type(16)));
typedef short bf16x8 __attribute__((ext_vector_type(8)));
#define LDS_WAIT() asm volatile("s_waitcnt lgkmcnt(0)" ::: "memory")
#define VM_WAIT() asm volatile("s_waitcnt vmcnt(0)" ::: "memory")

__device__ __forceinline__ unsigned f2bf(float f) { unsigned u = __builtin_bit_cast(unsigned, f); return (u + 0x7fffu + ((u >> 16) & 1u)) >> 16; }
__device__ __forceinline__ unsigned pk2(float lo, float hi) { return f2bf(lo) | (f2bf(hi) << 16); }
__device__ __forceinline__ unsigned cvt_pk_bf16(float lo, float hi) { unsigned r; asm volatile("v_cvt_pk_bf16_f32 %0, %1, %2" : "=v"(r) : "v"(lo), "v"(hi)); return r; }
__device__ __forceinline__ float bf2f(unsigned short b) { return __builtin_bit_cast(float, (unsigned)b << 16); }
__device__ __forceinline__ float bflo(unsigned w) { return __builtin_bit_cast(float, w << 16); }
__device__ __forceinline__ float bfhi(unsigned w) { return __builtin_bit_cast(float, w & 0xffff0000u); }
__device__ __forceinline__ float wave_sum(float v) {
#pragma unroll
    for (int o = 1; o < 64; o <<= 1) v += __shfl_xor(v, o);
    return v;
}

namespace pg8 {
typedef unsigned short bf16_t;
constexpr int BM = 256, BK = 64, HALF = 128, HTB = HALF * BK * 2, STAGE_BYTES = 8 * HTB;

__host__ __device__ __forceinline__ int lds_byte(int r, int c) { const int st = (r >> 4) * 2 + (c >> 5), rr = r & 15, cc = c & 31, ob = rr * 64 + cc * 2; return st * 1024 + (ob ^ (((ob >> 9) & 1) << 5)); }
__host__ __device__ __forceinline__ void stage_rc(int b, int& R, int& C) { const int st = b / 1024, sb = b % 1024, swz = sb ^ (((sb >> 9) & 1) << 5); R = (st >> 1) * 16 + swz / 64; C = (st & 1) * 32 + (swz % 64) / 2; }

struct Unit { int pm, pn; long aoff, boff; int e, idx0; };
struct Gemm { const bf16_t* A; const bf16_t* Bt; int lda, ldb, K; };

template <class Epi, class Sched, bool GATHER>
__device__ __forceinline__ void gemm_phase(LAS unsigned char* lds, const Gemm g, const Sched& S, const Epi& E) {
    const int tid = threadIdx.x, wid = __builtin_amdgcn_readfirstlane(tid >> 6), lane = tid & 63, wr = wid >> 2, wc = wid & 3, fr = lane & 15, fq = lane >> 4;
    const int K = g.K, nt = K / BK;
    unsigned voffA[2], voffB[2];
#pragma unroll
    for (int i = 0; i < 2; ++i) { int R, C; stage_rc(tid * 16 + i * 8192, R, C);
        voffA[i] = (unsigned)(R * g.lda + C) * 2u; voffB[i] = (unsigned)(R * g.ldb + C) * 2u; }
    const size_t kstep = (size_t)(BK * 2);
    const size_t hstepA = GATHER ? 0 : (size_t)HALF * g.lda * 2, hstepB = (size_t)HALF * g.ldb * 2;
    const unsigned ldsw = (unsigned)wid * 1024u;
    const int aoff = lds_byte(wr * 64 + fr, fq * 8), boff = lds_byte(wc * 32 + fr, fq * 8);
#define PG8_SA(b, h) (((b) * 2 + (h)) * HTB)
#define PG8_SB(b, h) ((4 + (b) * 2 + (h)) * HTB)
#define PG8_STAGE(bufoff, gbase, voff) do { _Pragma("unroll") for (int _i = 0; _i < 2; ++_i) \
        __builtin_amdgcn_global_load_lds((const unsigned*)((const char*)(gbase) + (voff)[_i]), (LAS unsigned*)(lds + (bufoff) + ldsw + _i * 8192), 16, 0, 0); } while (0)
#define PG8_STAGE_A(bufoff, gbase, h, nx) do { if constexpr (GATHER) { unsigned _tv[2]; \
        if (nx) { int _tz = tid; asm volatile("" : "+v"(_tz)); _Pragma("unroll") for (int _j = 0; _j < 2; ++_j) { int _R, _C; stage_rc(_tz * 16 + _j * 8192, _R, _C); _tv[_j] = (unsigned)S.arow(nxt, (h) * HALF + _R) * (unsigned)(g.lda * 2) + (unsigned)(_C * 2); } } \
        else { _tv[0] = gvc[h][0]; _tv[1] = gvc[h][1]; } \
        PG8_STAGE(bufoff, gbase, _tv); } else { PG8_STAGE(bufoff, (gbase) + (h) * hstepA, voffA); } } while (0)
#define PG8_LDA(dst, b, h) do { _Pragma("unroll") for (int m = 0; m < 4; ++m) _Pragma("unroll") for (int k = 0; k < 2; ++k) dst[m][k] = *(const LAS bf16x8*)(lds + PG8_SA(b, h) + aoff + m * 2048 + k * 1024); } while (0)
#define PG8_LDB(dst, b, h) do { _Pragma("unroll") for (int n = 0; n < 2; ++n) _Pragma("unroll") for (int k = 0; k < 2; ++k) dst[n][k] = *(const LAS bf16x8*)(lds + PG8_SB(b, h) + boff + n * 2048 + k * 1024); } while (0)
#define PG8_MMA(ai, bj, At, Bt) do { __builtin_amdgcn_s_setprio(1); _Pragma("unroll") for (int m = 0; m < 4; ++m) _Pragma("unroll") for (int n = 0; n < 2; ++n) _Pragma("unroll") for (int k = 0; k < 2; ++k) \
        acc[ai][bj][m][n] = __builtin_amdgcn_mfma_f32_16x16x32_bf16(Bt[n][k], At[m][k], acc[ai][bj][m][n], 0, 0, 0); __builtin_amdgcn_s_setprio(0); } while (0)
#define PG8_WAIT_V(n) asm volatile("s_waitcnt vmcnt(" #n ")" ::: "memory")
#define PG8_WAIT_L(n) asm volatile("s_waitcnt lgkmcnt(" #n ")" ::: "memory")
#define PG8_BAR __builtin_amdgcn_s_barrier()
#define PG8_SCHED __builtin_amdgcn_sched_barrier(0)
    Unit cur, nxt; int ui = 0;
    if (!S.next(0, cur)) return;
    unsigned gvc[2][2];
#define PG8_GV(unit) do { if constexpr (GATHER) { int _tz = tid; asm volatile("" : "+v"(_tz)); _Pragma("unroll") for (int _h = 0; _h < 2; ++_h) _Pragma("unroll") for (int _j = 0; _j < 2; ++_j) { int _R, _C; stage_rc(_tz * 16 + _j * 8192, _R, _C); \
        gvc[_h][_j] = (unsigned)S.arow(unit, _h * HALF + _R) * (unsigned)(g.lda * 2) + (unsigned)(_C * 2); } } } while (0)
    PG8_GV(cur);
    f32x4 acc[2][2][4][2];
#pragma unroll
    for (int a = 0; a < 2; ++a)
#pragma unroll
        for (int b = 0; b < 2; ++b)
#pragma unroll
            for (int m = 0; m < 4; ++m)
#pragma unroll
                for (int n = 0; n < 2; ++n) acc[a][b][m][n] = (f32x4){0.f, 0.f, 0.f, 0.f};
    bf16x8 At[4][2], B0[2][2], B1[2][2];
    const char* cA = (const char*)g.A + cur.aoff; const char* cB = (const char*)g.Bt + cur.boff;
    PG8_STAGE(PG8_SB(0, 0), cB, voffB); PG8_STAGE(PG8_SB(0, 1), cB + hstepB, voffB); PG8_STAGE_A(PG8_SA(0, 0), cA, 0, false); PG8_STAGE_A(PG8_SA(0, 1), cA, 1, false);
    if (wr == 1) PG8_BAR;
    PG8_WAIT_V(2); PG8_BAR;
    PG8_STAGE(PG8_SB(1, 0), cB + kstep, voffB); PG8_STAGE_A(PG8_SA(1, 0), cA + kstep, 0, false); PG8_STAGE(PG8_SB(1, 1), cB + hstepB + kstep, voffB);
    PG8_WAIT_V(6); PG8_BAR;
    for (;;) {
        const bool has_next = S.next(ui + 1, nxt);
        const char* nA = has_next ? (const char*)g.A + nxt.aoff : cA; const char* nB = has_next ? (const char*)g.Bt + nxt.boff : cB;
#pragma nounroll
        for (int t = 0; t < nt; t += 2) {
            const bool last = (t == nt - 2);
            const char* a1 = cA + (size_t)(t + 1) * kstep;
            const char* a2 = last ? nA : cA + (size_t)(t + 2) * kstep; const char* b2 = last ? nB : cB + (size_t)(t + 2) * kstep;
            const char* a3 = a2 + kstep; const char* b3 = b2 + kstep;
            PG8_LDB(B0, 0, 0); PG8_LDB(B1, 0, 1); PG8_SCHED; PG8_LDA(At, 0, 0); PG8_STAGE_A(PG8_SA(1, 1), a1, 1, false);
            PG8_WAIT_V(8); PG8_WAIT_L(0); PG8_BAR; PG8_MMA(0, 0, At, B0); PG8_MMA(0, 1, At, B1); PG8_BAR; PG8_SCHED;
            PG8_LDA(At, 0, 1); PG8_STAGE(PG8_SB(0, 0), b2, voffB); PG8_STAGE(PG8_SB(0, 1), b2 + hstepB, voffB); PG8_STAGE_A(PG8_SA(0, 0), a2, 0, last);
            PG8_WAIT_V(8); PG8_WAIT_L(0); PG8_BAR; PG8_MMA(1, 0, At, B0); PG8_MMA(1, 1, At, B1); PG8_BAR; PG8_SCHED;
            PG8_LDB(B0, 1, 0); PG8_LDB(B1, 1, 1); PG8_SCHED; PG8_LDA(At, 1, 0); PG8_STAGE_A(PG8_SA(0, 1), a2, 1, last);
            PG8_WAIT_V(8); PG8_WAIT_L(0); PG8_BAR; PG8_MMA(0, 0, At, B0); PG8_MMA(0, 1, At, B1); PG8_BAR; PG8_SCHED;
            PG8_LDA(At, 1, 1); PG8_STAGE(PG8_SB(1, 0), b3, voffB); PG8_STAGE(PG8_SB(1, 1), b3 + hstepB, voffB); PG8_STAGE_A(PG8_SA(1, 0), a3, 0, last);
            PG8_WAIT_V(8); PG8_WAIT_L(0); PG8_BAR; PG8_MMA(1, 0, At, B0); PG8_MMA(1, 1, At, B1); PG8_BAR; PG8_SCHED;
        }
        if (wr == 0) PG8_BAR;
        E(acc, cur, wr, wc, fr, fq);
        if (!has_next) break;
#pragma unroll
        for (int a = 0; a < 2; ++a)
#pragma unroll
            for (int b = 0; b < 2; ++b)
#pragma unroll
                for (int m = 0; m < 4; ++m)
#pragma unroll
                    for (int n = 0; n < 2; ++n) acc[a][b][m][n] = (f32x4){0.f, 0.f, 0.f, 0.f};
        cur = nxt; cA = nA; cB = nB; ++ui;
        PG8_GV(cur);
        if (wr == 1) PG8_BAR;
    }
    PG8_WAIT_V(0);
    PG8_BAR;
#undef PG8_SA
#undef PG8_SB
#undef PG8_STAGE
#undef PG8_STAGE_A
#undef PG8_GV
#undef PG8_LDA
#undef PG8_LDB
#undef PG8_MMA
#undef PG8_WAIT_V
#undef PG8_WAIT_L
#undef PG8_BAR
#undef PG8_SCHED
}

struct StaticOrder {
    int nM, nN, nwg, G, c; long astride, apn, bstride;
    __device__ void init(int nM_, int nN_, int G_, int c_, long astride_, long apn_, long bstride_) { nM = nM_; nN = nN_; nwg = nM * nN; G = G_; c = c_; astride = astride_; apn = apn_; bstride = bstride_; }
    __device__ bool next(int i, Unit& u) const {
        const long Lx = (long)i * G + c; if (Lx >= nwg) return false;
        int wgid = (int)Lx; { const int q = nwg / 8, r = nwg % 8, xcd = wgid % 8, off = wgid / 8; wgid = (xcd < r ? xcd * (q + 1) : r * (q + 1) + (xcd - r) * q) + off; }
        const int nig = 8 * nN, gid = wgid / nig, fm = gid * 8, gsz = (nM - fm) < 8 ? (nM - fm) : 8;
        u.pm = fm + ((wgid % nig) % gsz); u.pn = (wgid % nig) / gsz; u.aoff = (long)u.pm * astride + (long)u.pn * apn; u.boff = (long)u.pn * bstride; u.e = 0; u.idx0 = 0; return true;
    }
    __device__ int arow(const Unit&, int) const { return 0; }
};
}

constexpr int DM = 2048, NBATCH = 2, SEQ = 8192, CTX = 256;
constexpr int TL = NBATCH * SEQ;
constexpr int TC = NBATCH * CTX;
constexpr int TT = TL + TC;
constexpr int KEYS = CTX + SEQ;
constexpr int NEXP = 64, DEXP = 512;
constexpr int LISTCAP = 2 * TT;
constexpr float EPS = 1e-6f;
constexpr float QSCALE = 0.125f * 1.4426950408889634f;
constexpr int NWAVES = 8, NTHREADS = 512;

constexpr size_t MiB = 1u << 20;
constexpr size_t WS_CTL = 0, CTL_BYTES = 1 * MiB;
constexpr size_t WS_WIN0 = 1 * MiB;
constexpr size_t WS_WOUT0 = WS_WIN0 + 16 * MiB;
constexpr size_t WS_WIN1 = WS_WOUT0 + 8 * MiB;
constexpr size_t WS_WOUT1 = WS_WIN1 + 16 * MiB;
constexpr size_t WS_WPOOL = WS_WOUT1 + 8 * MiB;
constexpr size_t WS_WGLU = WS_WPOOL + 1 * MiB;
constexpr size_t WS_WMOE = WS_WGLU + 2 * MiB;
constexpr size_t MOE_E_BYTES = 6 * MiB, MOE_L_BYTES = 64 * MOE_E_BYTES;
constexpr size_t WS_X = WS_WMOE + 2 * MOE_L_BYTES;
constexpr size_t WS_HA = WS_X + 132 * MiB;
constexpr size_t WS_Q = WS_HA + 67 * MiB;
constexpr size_t WS_K = WS_Q + 33 * MiB;
constexpr size_t WS_VT = WS_K + 33 * MiB;
constexpr size_t WS_P = WS_VT + 33 * MiB;
constexpr size_t WS_PROJ1 = WS_Q;
constexpr size_t WS_CAT = WS_P + 33 * MiB;
constexpr size_t WS_PD = WS_CAT + 66 * MiB;
constexpr size_t WS_H = WS_PD + 33 * MiB;
constexpr size_t WS_Y = WS_H + 49 * MiB;
constexpr size_t WS_GT = WS_Y + 132 * MiB;
constexpr size_t WS_KT = WS_GT + 192 * MiB;
constexpr size_t WS_YD = WS_KT + 128 * MiB;
constexpr size_t WS_MISC = WS_YD + 128 * MiB;
constexpr size_t WS_MOD = WS_MISC;
constexpr size_t WS_ADAP = WS_MOD + 1 * MiB;
constexpr size_t WS_ROPE = WS_ADAP + 10 * MiB;
constexpr size_t WS_NORMP = WS_ROPE + 1 * MiB;
constexpr size_t WS_INVN = WS_NORMP + 4 * MiB;
constexpr size_t WS_S5LAM = WS_INVN + 1 * MiB;
constexpr size_t WS_S5B = WS_S5LAM + 1 * MiB;
constexpr size_t WS_WRT = WS_S5B + 2 * MiB;
constexpr size_t WS_TOKL = WS_WRT + 2 * MiB;
constexpr size_t WS_GATEL = WS_TOKL + 9 * MiB;
constexpr size_t WS_END = WS_GATEL + 9 * MiB;
static_assert(WS_END <= 2040 * MiB, "d_ws map");
constexpr int CW_BAR = 1024;
constexpr int CW_CNT = 8192;

constexpr int LDS_PHASE = 131072;
constexpr int LDS_CTL = 147456 - 2048;
constexpr int LDS_BYTES = 147456;

#define XB_TMO      128
#define XB_XCNT(j)  (256  + 64 * (j))
#define XB_XSUB(j)  (1280 + 64 * (j))
#define XB_XGEN(j)  (2304 + 64 * (j))
#define XB_TOP      3328
#define XB_TOPGEN   3392
#define XCD_BAR_WORDS 3456
#define XB_SPIN_CAP (1u << 22)

__device__ __forceinline__ unsigned xb_ld(unsigned* p)              { return __hip_atomic_load(p, __ATOMIC_RELAXED, __HIP_MEMORY_SCOPE_AGENT); }
__device__ __forceinline__ unsigned xb_add(unsigned* p, unsigned v) { return __hip_atomic_fetch_add(p, v, __ATOMIC_RELAXED, __HIP_MEMORY_SCOPE_AGENT); }
__device__ __forceinline__ unsigned xb_xcc_id() { return (unsigned)__builtin_amdgcn_s_getreg((3 << 11) | 20) & 0xFu; }
#define XB_SPIN(cond, bar) do { unsigned _sp = 0; while (cond) { __builtin_amdgcn_s_sleep(1); \
    if ((++_sp & 255u) == 0u) { if (xb_ld(&(bar)[XB_TMO])) break; if (_sp > XB_SPIN_CAP) { atomicAdd(&(bar)[XB_TMO], 1u); break; } } } } while (0)

struct XcdBarrier { unsigned* bar; unsigned x; volatile LAS unsigned* st; };

__device__ __forceinline__ XcdBarrier xcd_barrier_post(unsigned* bar, volatile LAS unsigned* st) {
    XcdBarrier b; b.bar = bar; b.x = xb_xcc_id(); b.st = st;
    if (threadIdx.x == 0) (void)xb_add(&bar[XB_XCNT(b.x)], 1u);
    return b;
}
__device__ __forceinline__ void xcd_barrier_complete(unsigned* bar, unsigned x, unsigned& nloc, unsigned& nx) {
    const unsigned G = gridDim.x * gridDim.y * gridDim.z;
    unsigned sum, cnt, mine, sp = 0u;
    for (;;) {
        sum = 0u; cnt = 0u; mine = 0u;
#pragma unroll
        for (unsigned j = 0; j < 16; ++j) { const unsigned c = xb_ld(&bar[XB_XCNT(j)]); sum += c; cnt += (c > 0u) ? 1u : 0u; mine = (j == x) ? c : mine; }
        if (sum == G) break;
        __builtin_amdgcn_s_sleep(1);
        if ((++sp & 255u) == 0u) { if (xb_ld(&bar[XB_TMO])) break; if (sp > XB_SPIN_CAP) { atomicAdd(&bar[XB_TMO], 1u); break; } }
    }
    nloc = mine > 0u ? mine : 1u; nx = cnt > 0u ? cnt : 1u;
}
__device__ __forceinline__ void xcd_barrier(const XcdBarrier& b) {
    asm volatile("s_waitcnt vmcnt(0)" ::: "memory");
    __syncthreads();
    if (threadIdx.x == 0) {
        unsigned* bar = b.bar;
        __builtin_amdgcn_s_waitcnt(0);
        unsigned nloc = b.st[0], nx = b.st[1];
        if (nloc == 0u) { xcd_barrier_complete(bar, b.x, nloc, nx); b.st[0] = nloc; b.st[1] = nx; }
        const unsigned old = xb_add(&bar[XB_XSUB(b.x)], 1u);
        const unsigned gen = old / nloc;
        if (old + 1u == (gen + 1u) * nloc) {
            __builtin_amdgcn_fence(__ATOMIC_RELEASE, "agent");
            asm volatile("s_waitcnt vmcnt(0)" ::: "memory");
            const unsigned og = xb_add(&bar[XB_TOP], 1u);
            const unsigned tg = og / nx;
            if (og + 1u == (tg + 1u) * nx) xb_add(&bar[XB_TOPGEN], 1u);
            else XB_SPIN(xb_ld(&bar[XB_TOPGEN]) == tg, bar);
            __builtin_amdgcn_fence(__ATOMIC_ACQUIRE, "agent");
            xb_add(&bar[XB_XGEN(b.x)], 1u);
            asm volatile("s_waitcnt vmcnt(0)" ::: "memory");
        } else {
            XB_SPIN(xb_ld(&bar[XB_XGEN(b.x)]) == gen, bar);
            __builtin_amdgcn_fence(__ATOMIC_ACQUIRE, "agent");
            asm volatile("s_waitcnt vmcnt(0)" ::: "memory");
        }
    }
    __syncthreads();
}

__device__ __forceinline__ void sincos_2pi(double x, double& s, double& c) {
    const double q = __builtin_rint(x * 4.0);
    const double y = (x - q * 0.25) * 6.283185307179586476925;
    const double y2 = y * y;
    double sp = -7.6471637318198164759e-13; sp = sp * y2 + 1.6059043836821614599e-10; sp = sp * y2 - 2.5052108385441718775e-8; sp = sp * y2 + 2.7557319223985890653e-6;
    sp = sp * y2 - 1.9841269841269841270e-4; sp = sp * y2 + 8.3333333333333333333e-3; sp = sp * y2 - 1.6666666666666666667e-1; sp = sp * y2 * y + y;
    double cp = 4.7794773323873852974e-14; cp = cp * y2 - 1.1470745597729724714e-11; cp = cp * y2 + 2.0876756987868098979e-9; cp = cp * y2 - 2.7557319223985890653e-7;
    cp = cp * y2 + 2.4801587301587301587e-5; cp = cp * y2 - 1.3888888888888888889e-3; cp = cp * y2 + 4.1666666666666666667e-2; cp = cp * y2 - 0.5; cp = cp * y2 + 1.0;
    const int qi = ((int)q) & 3;
    s = (qi == 0) ? sp : (qi == 1) ? cp : (qi == 2) ? -sp : -cp;
    c = (qi == 0) ? cp : (qi == 1) ? -sp : (qi == 2) ? -cp : sp;
}
__device__ __forceinline__ void sincos_rad(double a, double& s, double& c) {
    double f = a * 0.15915494309189533576888; f -= __builtin_floor(f);
    if (f >= 1.0) f = 0.0;
    sincos_2pi(f, s, c);
}
__device__ __forceinline__ double exp_small(double x) {
    double r = 1.0 / 479001600.0;
    r = r * x + 1.0 / 39916800.0; r = r * x + 1.0 / 3628800.0; r = r * x + 1.0 / 362880.0; r = r * x + 1.0 / 40320.0; r = r * x + 1.0 / 5040.0;
    r = r * x + 1.0 / 720.0; r = r * x + 1.0 / 120.0; r = r * x + 1.0 / 24.0; r = r * x + 1.0 / 6.0; r = r * x + 0.5; r = r * x + 1.0; r = r * x + 1.0;
    return r;
}
__device__ __forceinline__ float fast_exp(float x) { return __builtin_amdgcn_exp2f(x * 1.4426950408889634f); }
__device__ __forceinline__ float sigmoidf_(float x) { return 1.0f / (1.0f + fast_exp(-x)); }
__device__ __forceinline__ float siluf_(float x) { return x * sigmoidf_(x); }
__device__ __forceinline__ float tanhf_(float x) { const float e = fast_exp(-2.0f * fabsf(x)); const float t = (1.0f - e) / (1.0f + e); return x < 0.f ? -t : t; }
__device__ __forceinline__ float gelu_tanh(float x) { return 0.5f * x * (1.0f + tanhf_(0.7978845608028654f * (x + 0.044715f * x * x * x))); }

struct Args { const float* in[43]; float* out; unsigned char* ws; int ph_lo, ph_hi; };

struct Frame {
    LAS unsigned char* lds; unsigned char* ws; int tid, lane, wave, bid, G, gw, NGW;
    const __attribute__((address_space(4))) unsigned long long* kin;
};
#define INP(i) ((const float*)F.kin[i])
#define WSP(T, off) ((T*)(F.ws + (off)))

__device__ __forceinline__ void tr_item(const float* W, int ldw, int N, bf16* WT, int ldt, int row_off, int rs16, LAS float* scr, int item, int lane) {
    const int nblk = N / 32, kb = item / nblk, nb = item % nblk, k0 = 64 * kb, n0 = 32 * nb;
#pragma unroll 8
    for (int i = 0; i < 32; ++i) { const int kk = 2 * i + (lane >> 5); scr[kk * 33 + (lane & 31)] = W[(size_t)(k0 + kk) * ldw + n0 + (lane & 31)]; }
    LDS_WAIT(); asm volatile("" ::: "memory");
    const int c = lane & 7;
#pragma unroll
    for (int j = 0; j < 4; ++j) { const int n = (lane >> 3) + 8 * j; const LAS float* s = scr + (8 * c) * 33 + n;
        v4u o; o.x = pk2(s[0 * 33], s[1 * 33]); o.y = pk2(s[2 * 33], s[3 * 33]); o.z = pk2(s[4 * 33], s[5 * 33]); o.w = pk2(s[6 * 33], s[7 * 33]);
        const int nn = n0 + n, drow = row_off + (nn >> 4) * rs16 + (nn & 15);
        *(v4u*)(WT + (size_t)drow * ldt + k0 + 8 * c) = o; }
    LDS_WAIT(); asm volatile("" ::: "memory");
}

__device__ __forceinline__ void hyfilt_item(Frame& F, int pb) {
    const float* w1 = INP(19); const float* b1 = INP(20); const float* fq = INP(21); const float* w2 = INP(22); const float* b2 = INP(23); const float* w3 = INP(24);
    LAS float* z = (LAS float*)F.lds;
    LAS float* h1 = z + 1088;
    LAS float* h2 = h1 + 2048;
    const int tid = F.tid;
    for (int idx = tid; idx < 32 * 33; idx += NTHREADS) {
        const int p = idx / 33, f = idx % 33, i = pb * 32 + p;
        float v;
        if (f == 0) v = (float)i * (1.0f / (float)(SEQ - 1));
        else { const int j = (f - 1) & 15; const float fj = 1e-4f + (float)j * ((15.0f - 1e-4f) / 15.0f);
            double fr = (double)fj * (double)i / (double)SEQ; fr -= __builtin_floor(fr); double s, c; sincos_2pi(fr, s, c); v = (f <= 16) ? (float)c : (float)(-s); }
        z[p * 33 + f] = v;
    }
    __syncthreads();
    for (int idx = tid; idx < 2048; idx += NTHREADS) {
        const int p = idx >> 6, j = idx & 63; float a = b1[j];
        for (int f = 0; f < 33; ++f) a += z[p * 33 + f] * w1[f * 64 + j];
        double s, c; sincos_rad((double)(fq[j] * a), s, c); h1[idx] = (float)s;
    }
    __syncthreads();
    for (int idx = tid; idx < 2048; idx += NTHREADS) {
        const int p = idx >> 6, j = idx & 63; float a = b2[j];
        for (int k = 0; k < 64; ++k) a += h1[p * 64 + k] * w2[k * 64 + j];
        double s, c; sincos_rad((double)(fq[64 + j] * a), s, c); h2[idx] = (float)s;
    }
    __syncthreads();
    float* kT = WSP(float, WS_KT); float* normp = WSP(float, WS_NORMP);
    for (int cc = 0; cc < 8; ++cc) {
        const int col = tid + NTHREADS * cc;
        float acc[32];
#pragma unroll
        for (int p = 0; p < 32; ++p) acc[p] = 0.f;
        for (int k = 0; k < 64; k += 4) {
            const float w0 = w3[(size_t)(k + 0) * 4096 + col], wA = w3[(size_t)(k + 1) * 4096 + col], wB = w3[(size_t)(k + 2) * 4096 + col], wC = w3[(size_t)(k + 3) * 4096 + col];
#pragma unroll
            for (int p = 0; p < 32; ++p) { const f32x4 hv = *(const LAS f32x4*)(h2 + p * 64 + k); acc[p] += hv.x * w0 + hv.y * wA + hv.z * wB + hv.w * wC; }
        }
        const int ch = col & 1023, dir = (col >> 10) & 1;
        const float adel = 3.0701134573253946f + (float)ch * ((15.350567286626972f - 3.0701134573253946f) / 1023.0f);
        float sabs = 0.f;
#pragma unroll
        for (int p = 0; p < 32; ++p) { const int i = pb * 32 + p; const float t = (float)i * (1.0f / (float)(SEQ - 1)); acc[p] *= fast_exp(-t * adel); if (!(dir == 1 && i == 0)) sabs += fabsf(acc[p]); }
        f32x4* dst = (f32x4*)(kT + (size_t)col * SEQ + pb * 32);
#pragma unroll
        for (int p = 0; p < 8; ++p) dst[p] = (f32x4){acc[4 * p], acc[4 * p + 1], acc[4 * p + 2], acc[4 * p + 3]};
        normp[(size_t)pb * 4096 + col] = sabs;
    }
    __syncthreads();
}

__device__ __forceinline__ void p0_prologue(Frame& F) {
    for (int pb = F.bid; pb < SEQ / 32; pb += F.G) hyfilt_item(F, pb);
    const int gt = F.bid * NTHREADS + F.tid, NGT = F.G * NTHREADS;
    {
        f32x2* rope = WSP(f32x2, WS_ROPE);
        for (int idx = gt; idx < 128 * 16; idx += NGT) { const int pos = idx >> 4, i = idx & 15;
            double inv = (i & 3) == 0 ? 1.0 : (i & 3) == 1 ? 0.56234132519034908 : (i & 3) == 2 ? 0.31622776601683794 : 0.17782794100389228;
            inv *= (i >> 2) == 0 ? 1.0 : (i >> 2) == 1 ? 0.1 : (i >> 2) == 2 ? 0.01 : 0.001;
            const float ang = (float)pos * (float)inv; double s, c; sincos_rad((double)ang, s, c); rope[idx] = (f32x2){(float)c, (float)s}; }
    }
    {
        const float* are = INP(26); const float* aim = INP(27); const float* ldt = INP(28); const float* bre = INP(29); const float* bim = INP(30);
        f32x2* lamb = WSP(f32x2, WS_S5LAM); f32x2* bb = WSP(f32x2, WS_S5B);
        for (int idx = gt; idx < 2 * 64 * 64; idx += NGT) { const int dg = idx >> 6;
            const float dt = expf(ldt[dg]); const float ar = are[idx], ai = aim[idx];
            const float zr = ar * dt, zi = ai * dt; double s, c; sincos_rad((double)zi, s, c); const double er = exp_small((double)zr);
            const double lr = er * c, li = er * s; lamb[idx] = (f32x2){(float)lr, (float)li};
            const double nr = lr - 1.0, ni = li, den = (double)ar * ar + (double)ai * ai; const double qr = (nr * ar + ni * ai) / den, qi = (ni * ar - nr * ai) / den;
            for (int cc = 0; cc < 16; ++cc) { const double br = bre[(size_t)idx * 16 + cc], bi = bim[(size_t)idx * 16 + cc]; bb[(size_t)idx * 16 + cc] = (f32x2){(float)(qr * br - qi * bi), (float)(qr * bi + qi * br)}; } }
    }
    {
        float* wrt = WSP(float, WS_WRT);
        for (int idx = gt; idx < 2 * 72 * 2048; idx += NGT) { const int l = idx / (72 * 2048), r = idx % (72 * 2048), n = r / 2048, k = r % 2048;
            wrt[idx] = n < 8 ? INP(36)[((size_t)l * 2048 + k) * 8 + n] : INP(38)[((size_t)l * 2048 + k) * 64 + (n - 8)]; }
    }
    {
        bf16* ha = WSP(bf16, WS_HA);
        for (int idx = gt; idx < 2048; idx += NGT) ha[(size_t)TT * 2048 + idx] = 0;
    }
    LAS float* scr = (LAS float*)(F.lds + F.wave * 16384);
    {
        const float* c = INP(1); const float* cctx = INP(3); const float* adaw = INP(4); float* part = WSP(float, WS_ADAP);
        for (int it = F.gw; it < 2 * 32 * 48; it += F.NGW) {
            const int l = it / (32 * 48), r = it % (32 * 48), ks = r / 48, jb = r % 48, k0 = ks * 64, j0 = jb * 256 + F.lane * 4;
            const float c0 = c[k0 + F.lane], c1 = c[2048 + k0 + F.lane], c2 = cctx[k0 + F.lane];
            const float s0 = c0 / (1.0f + expf(-c0)), s1 = c1 / (1.0f + expf(-c1)), s2 = c2 / (1.0f + expf(-c2));
            f32x4 a0 = {0.f, 0.f, 0.f, 0.f}, a1 = a0, a2 = a0;
            const float* wp = adaw + ((size_t)l * 2048 + k0) * 12288 + j0;
#pragma unroll 8
            for (int kk = 0; kk < 64; ++kk) { const f32x4 w = *(const f32x4*)(wp + (size_t)kk * 12288);
                const float t0 = __builtin_bit_cast(float, __builtin_amdgcn_readlane(__builtin_bit_cast(int, s0), kk));
                const float t1 = __builtin_bit_cast(float, __builtin_amdgcn_readlane(__builtin_bit_cast(int, s1), kk));
                const float t2 = __builtin_bit_cast(float, __builtin_amdgcn_readlane(__builtin_bit_cast(int, s2), kk));
                a0 += w * t0; a1 += w * t1; a2 += w * t2; }
            float* pp = part + ((size_t)(l * 32 + ks) * 3) * 12288 + j0;
            *(f32x4*)(pp) = a0; *(f32x4*)(pp + 12288) = a1; *(f32x4*)(pp + 2 * 12288) = a2;
        }
    }
    {
        constexpr int I0 = 2048, I1 = 1024, I2 = 1024, I3 = 2048, I4 = 4096, I5 = 2048, I6 = 128, I7 = 512, IE = 1536;
        constexpr int NSMALL = I0 + I1 + I2 + I3 + I4 + I5 + I6 + I7;
        const int NITEMS = NSMALL + 128 * IE;
        for (int it = F.gw; it < NITEMS; it += F.NGW) {
            int r = it;
            if (r < I0) { tr_item(INP(9), 4096, 2048, WSP(bf16, WS_WIN0), 2048, 0, 16, scr, r, F.lane); continue; } r -= I0;
            if (r < I1) { tr_item(INP(9) + 2048, 4096, 1024, WSP(bf16, WS_WIN0), 2048, 3072, 16, scr, r, F.lane); continue; } r -= I1;
            if (r < I2) { tr_item(INP(9) + 3072, 4096, 1024, WSP(bf16, WS_WIN0), 2048, 2048, 16, scr, r, F.lane); continue; } r -= I2;
            if (r < I3) { tr_item(INP(10), 2048, 2048, WSP(bf16, WS_WOUT0), 2048, 0, 16, scr, r, F.lane); continue; } r -= I3;
            if (r < I4) { tr_item(INP(15), 4096, 4096, WSP(bf16, WS_WIN1), 2048, 0, 16, scr, r, F.lane); continue; } r -= I4;
            if (r < I5) { tr_item(INP(16), 2048, 2048, WSP(bf16, WS_WOUT1), 2048, 0, 16, scr, r, F.lane); continue; } r -= I5;
            if (r < I6) { const int g = r / 32; tr_item(INP(13) + (size_t)g * 65536, 256, 256, WSP(bf16, WS_WPOOL), 256, g * 256, 16, scr, r % 32, F.lane); continue; } r -= I6;
            if (r < I7) { tr_item(INP(34), 1024, 1024, WSP(bf16, WS_WGLU), 1024, 0, 16, scr, r, F.lane); continue; } r -= I7;
            const int le = r / IE, q = r % IE;
            bf16* wc = (bf16*)(F.ws + WS_WMOE + (size_t)le * MOE_E_BYTES); bf16* w2t = wc + 1024 * 2048;
            if (q < 512) tr_item(INP(40) + (size_t)le * (2048 * 512), 512, 512, wc, 2048, 0, 32, scr, q, F.lane);
            else if (q < 1024) tr_item(INP(41) + (size_t)le * (2048 * 512), 512, 512, wc, 2048, 16, 32, scr, q - 512, F.lane);
            else tr_item(INP(42) + (size_t)le * (512 * 2048), 2048, 2048, w2t, 512, 0, 16, scr, q - 1024, F.lane);
        }
    }
}

__device__ __forceinline__ void p1_reduce(Frame& F) {
    const int gt = F.bid * NTHREADS + F.tid, NGT = F.G * NTHREADS;
    const float* part = WSP(float, WS_ADAP); float* mod = WSP(float, WS_MOD); const float* adab = INP(5);
    for (int idx = gt; idx < 2 * 3 * 12288; idx += NGT) { const int l = idx / (3 * 12288), r = idx % (3 * 12288), m = r / 12288, j = r % 12288;
        float a = adab[l * 12288 + j];
        for (int ks = 0; ks < 32; ++ks) a += part[((size_t)(l * 32 + ks) * 3 + m) * 12288 + j];
        mod[idx] = a; }
    const float* normp = WSP(float, WS_NORMP); float* invn = WSP(float, WS_INVN);
    for (int idx = gt; idx < 2048; idx += NGT) { const int o = idx >> 10, ch = idx & 1023; float a = 0.f;
        for (int pb = 0; pb < 256; ++pb) a += normp[(size_t)pb * 4096 + o * 2048 + ch] + normp[(size_t)pb * 4096 + o * 2048 + 1024 + ch];
        invn[idx] = 1.0f / a; }
}

__device__ __forceinline__ const float* modp(Frame& F, int l, int m, int c) { return WSP(float, WS_MOD) + ((size_t)(l * 3 + m) * 6 + c) * 2048; }
__device__ __forceinline__ int row_stream(int r) { return r < TL ? r / SEQ : 2; }

template <int MODE>
__device__ __forceinline__ void norm_phase(Frame& F, int l, float* dout) {
    const int nrows = (MODE == 3 || (MODE == 1 && l == 1)) ? TL : TT;
    float* xbuf = WSP(float, WS_X); bf16* ha = WSP(bf16, WS_HA); const bf16* Y = WSP(bf16, WS_Y);
    const float* gvec = (MODE == 0) ? INP(6) : (MODE == 1) ? INP(7) + l * 2048 : (MODE == 2) ? INP(6) + 2048 : INP(8);
    const int lane = F.lane;
    for (int r = F.gw; r < nrows; r += F.NGW) {
        const int m = row_stream(r);
        const float* src = (MODE == 0) ? (r < TL ? INP(0) + (size_t)r * 2048 : INP(2) + (size_t)(r - TL) * 2048) : xbuf + (size_t)r * 2048;
        f32x4 v[8]; float ss = 0.f;
#pragma unroll
        for (int j = 0; j < 8; ++j) v[j] = *(const f32x4*)(src + 4 * lane + 256 * j);
        if (MODE == 2 || MODE == 3) {
            const float* g2 = modp(F, MODE == 2 ? 0 : 1, m, 5);
            const bf16* y0 = Y + (size_t)(2 * r) * 2048; const bf16* y1 = y0 + 2048;
#pragma unroll
            for (int j = 0; j < 8; ++j) { const int c = 4 * lane + 256 * j; const v2u a = *(const v2u*)(y0 + c), b = *(const v2u*)(y1 + c); const f32x4 gg = *(const f32x4*)(g2 + c);
                v[j].x += gg.x * (bflo(a.x) + bflo(b.x)); v[j].y += gg.y * (bfhi(a.x) + bfhi(b.x)); v[j].z += gg.z * (bflo(a.y) + bflo(b.y)); v[j].w += gg.w * (bfhi(a.y) + bfhi(b.y)); }
            if (MODE == 2) {
#pragma unroll
                for (int j = 0; j < 8; ++j) *(f32x4*)(xbuf + (size_t)r * 2048 + 4 * lane + 256 * j) = v[j];
            }
        }
#pragma unroll
        for (int j = 0; j < 8; ++j) ss += (v[j].x * v[j].x + v[j].y * v[j].y) + (v[j].z * v[j].z + v[j].w * v[j].w);
        ss = wave_sum(ss);
        const float rs = 1.0f / sqrtf(ss * (1.0f / 2048.0f) + EPS);
        if (MODE == 3) {
#pragma unroll
            for (int j = 0; j < 8; ++j) { const int c = 4 * lane + 256 * j; const f32x4 gg = *(const f32x4*)(gvec + c); *(f32x4*)(dout + (size_t)r * 2048 + c) = v[j] * rs * gg; }
            continue;
        }
        const int lm = (MODE == 2) ? 1 : l;
        const float* sh = modp(F, lm, m, MODE == 1 ? 3 : 0); const float* sc = modp(F, lm, m, MODE == 1 ? 4 : 1);
#pragma unroll
        for (int j = 0; j < 8; ++j) { const int c = 4 * lane + 256 * j; const f32x4 gg = *(const f32x4*)(gvec + c), s1 = *(const f32x4*)(sc + c), s0 = *(const f32x4*)(sh + c);
            v[j] = (v[j] * rs * gg) * (1.0f + s1) + s0;
            v2u o; o.x = pk2(v[j].x, v[j].y); o.y = pk2(v[j].z, v[j].w); *(v2u*)(ha + (size_t)r * 2048 + c) = o; }
        if (MODE == 1) {
            const float* wrt = WSP(float, WS_WRT) + (size_t)l * 72 * 2048;
            float lgG = 0.f, lgE = 0.f;
#pragma nounroll
            for (int n = 0; n < 72; ++n) { const float* wn = wrt + (size_t)n * 2048; float a = 0.f;
#pragma unroll
                for (int j = 0; j < 8; ++j) { const f32x4 w = *(const f32x4*)(wn + 4 * lane + 256 * j); a += (v[j].x * w.x + v[j].y * w.y) + (v[j].z * w.z + v[j].w * w.w); }
                a = wave_sum(a);
                if (n < 8) { if (lane == n) lgG = a; } else { if (lane == n - 8) lgE = a; } }
            if (lane < 8) lgG += INP(37)[l * 8 + lane];
            lgE += INP(39)[l * 64 + lane];
            float gl[8]; float gmax = -INFINITY; int gi = 0;
#pragma unroll
            for (int j = 0; j < 8; ++j) { gl[j] = __shfl(lgG, j); if (gl[j] > gmax) { gmax = gl[j]; gi = j; } }
            float gsum = 0.f;
#pragma unroll
            for (int j = 0; j < 8; ++j) gsum += expf(gl[j] - gmax);
            const float pg_top = 1.0f / gsum;
            float el[8]; float emax = -INFINITY;
#pragma unroll
            for (int j = 0; j < 8; ++j) { el[j] = __shfl(lgE, gi * 8 + j); emax = fmaxf(emax, el[j]); }
            float esum = 0.f; float pe[8];
#pragma unroll
            for (int j = 0; j < 8; ++j) { pe[j] = expf(el[j] - emax); esum += pe[j]; }
            int e1 = 0; float p1 = -1.f;
#pragma unroll
            for (int j = 0; j < 8; ++j) { pe[j] /= esum; if (pe[j] > p1) { p1 = pe[j]; e1 = j; } }
            int e2 = 0; float p2 = -1.f;
#pragma unroll
            for (int j = 0; j < 8; ++j) { if (j != e1 && pe[j] > p2) { p2 = pe[j]; e2 = j; } }
            const float den = p1 + p2; const float g1 = pg_top * p1 / den, g2 = pg_top * p2 / den;
            if (lane == 0) {
                unsigned* cnt = WSP(unsigned, WS_CTL) + CW_CNT + l * 64; int* tokl = WSP(int, WS_TOKL); float* gatel = WSP(float, WS_GATEL);
                const int ex1 = gi * 8 + e1, ex2 = gi * 8 + e2;
                const unsigned k1 = atomicAdd(cnt + ex1, 1u); tokl[(size_t)ex1 * LISTCAP + k1] = 2 * r; gatel[(size_t)ex1 * LISTCAP + k1] = g1;
                const unsigned k2 = atomicAdd(cnt + ex2, 1u); tokl[(size_t)ex2 * LISTCAP + k2] = 2 * r + 1; gatel[(size_t)ex2 * LISTCAP + k2] = g2;
            }
        }
    }
}

#define EPI_ARGS const f32x4 (&acc)[2][2][4][2], const pg8::Unit& u, int wr, int wc, int fr, int fq
__device__ __forceinline__ void st_bf4(bf16* p, f32x4 v) { v2u o; o.x = cvt_pk_bf16(v.x, v.y); o.y = cvt_pk_bf16(v.z, v.w); *(v2u*)p = o; }

struct EpiQKP {
    bf16* Q; bf16* Kb; bf16* P; const f32x2* rope;
    __device__ __forceinline__ void operator()(EPI_ARGS) const {
        const int sect = u.pn >> 2, cb = (u.pn & 3) * 256; const bool latent = u.pm < TL / 256;
#pragma unroll
        for (int ai = 0; ai < 2; ++ai)
#pragma unroll
            for (int m = 0; m < 4; ++m) {
                const int r = u.pm * 256 + ai * 128 + wr * 64 + m * 16 + fr;
                int b, t; if (latent) { b = r / SEQ; t = r % SEQ; } else { b = (r - TL) / CTX; t = (r - TL) % CTX; }
                f32x4 cs0 = {1.f, 0.f, 1.f, 0.f}, cs1 = cs0;
                if (latent && sect < 2) { const int pos = (wc & 1) ? (t & 63) : (t >> 6); const f32x4* rp = (const f32x4*)(rope + pos * 16 + 4 * fq); cs0 = rp[0]; cs1 = rp[1]; }
#pragma unroll
                for (int bj = 0; bj < 2; ++bj) {
                    const int c0 = cb + bj * 128 + wc * 32 + 4 * fq;
                    f32x4 a = acc[ai][bj][m][0], bb = acc[ai][bj][m][1];
                    if (sect < 2) {
                        const f32x4 co = {cs0.x, cs0.z, cs1.x, cs1.z}, si = {cs0.y, cs0.w, cs1.y, cs1.w};
                        const f32x4 oa = a * co - bb * si, ob = a * si + bb * co; a = oa; bb = ob;
                    }
                    if (sect == 0) { a = a * QSCALE; bb = bb * QSCALE; bf16* d = Q + (size_t)r * 1024 + c0; st_bf4(d, a); st_bf4(d + 16, bb); }
                    else if (sect == 1) { const size_t kr = (size_t)b * KEYS + (latent ? CTX + t : t); bf16* d = Kb + kr * 1024 + c0; st_bf4(d, a); st_bf4(d + 16, bb); }
                    else { bf16* d = P + (size_t)r * 1024 + c0; st_bf4(d, a); st_bf4(d + 16, bb); }
                }
            }
    }
};
struct EpiVT {
    bf16* VT;
    __device__ __forceinline__ void operator()(EPI_ARGS) const {
        const bool latent = u.pn < TL / 256; const int b = latent ? u.pn / 32 : u.pn - TL / 256; const int key_t0 = latent ? CTX + (u.pn % 32) * 256 : 0;
        const int kperm = 8 * (fq & 1) + 4 * (fq >> 1);
#pragma unroll
        for (int ai = 0; ai < 2; ++ai)
#pragma unroll
            for (int m = 0; m < 4; ++m) {
                const int rr = u.pm * 256 + ai * 128 + wr * 64 + m * 16 + fr;
                bf16* rowp = VT + ((size_t)b * 1024 + rr) * KEYS + key_t0;
#pragma unroll
                for (int bj = 0; bj < 2; ++bj)
#pragma unroll
                    for (int n = 0; n < 2; ++n) st_bf4(rowp + bj * 128 + wc * 32 + 16 * n + kperm, acc[ai][bj][m][n]);
            }
    }
};
struct EpiScaleBf16 {
    bf16* O; int ldo, coff; const float* cscale;
    __device__ __forceinline__ void operator()(EPI_ARGS) const {
#pragma unroll
        for (int bj = 0; bj < 2; ++bj)
#pragma unroll
            for (int n = 0; n < 2; ++n) { const int c = u.pn * 256 + bj * 128 + wc * 32 + 16 * n + 4 * fq; const f32x4 sc = *(const f32x4*)(cscale + c);
#pragma unroll
                for (int ai = 0; ai < 2; ++ai)
#pragma unroll
                    for (int m = 0; m < 4; ++m) { const int r = u.pm * 256 + ai * 128 + wr * 64 + m * 16 + fr; st_bf4(O + (size_t)r * ldo + coff + c, acc[ai][bj][m][n] * sc); } }
    }
};
struct EpiBf16 {
    bf16* O; int ldo;
    __device__ __forceinline__ void operator()(EPI_ARGS) const {
#pragma unroll
        for (int ai = 0; ai < 2; ++ai)
#pragma unroll
            for (int m = 0; m < 4; ++m) { const int r = u.pm * 256 + ai * 128 + wr * 64 + m * 16 + fr; bf16* rowp = O + (size_t)r * ldo + u.pn * 256 + wc * 32 + 4 * fq;
#pragma unroll
                for (int bj = 0; bj < 2; ++bj)
#pragma unroll
                    for (int n = 0; n < 2; ++n) st_bf4(rowp + bj * 128 + 16 * n, acc[ai][bj][m][n]); }
    }
};
struct EpiRes {
    const float* xlat; const float* xctx; float* xout; const float* gate0;
    __device__ __forceinline__ void operator()(EPI_ARGS) const {
        const bool latent = u.pm < TL / 256;
#pragma unroll
        for (int ai = 0; ai < 2; ++ai)
#pragma unroll
            for (int m = 0; m < 4; ++m) { const int r = u.pm * 256 + ai * 128 + wr * 64 + m * 16 + fr; const int ms = latent ? r / SEQ : 2;
                const float* xi = latent ? xlat + (size_t)r * 2048 : xctx + (size_t)(r - TL) * 2048; const float* gp = gate0 + (size_t)ms * 12288;
#pragma unroll
                for (int bj = 0; bj < 2; ++bj)
#pragma unroll
                    for (int n = 0; n < 2; ++n) { const int c = u.pn * 256 + bj * 128 + wc * 32 + 16 * n + 4 * fq;
                        const f32x4 xv = *(const f32x4*)(xi + c), gv = *(const f32x4*)(gp + c); *(f32x4*)(xout + (size_t)r * 2048 + c) = xv + gv * acc[ai][bj][m][n]; } }
    }
};
struct EpiMoeUp {
    bf16* H;
    __device__ __forceinline__ void operator()(EPI_ARGS) const {
#pragma unroll
        for (int ai = 0; ai < 2; ++ai)
#pragma unroll
            for (int m = 0; m < 4; ++m) { const size_t r = (size_t)u.pm * 256 + ai * 128 + wr * 64 + m * 16 + fr;
#pragma unroll
                for (int bj = 0; bj < 2; ++bj) { const int hc = (u.pn * 256 + bj * 128 + wc * 32) / 2 + 4 * fq; const f32x4 a = acc[ai][bj][m][0], b = acc[ai][bj][m][1];
                    const f32x4 h = {siluf_(a.x) * b.x, siluf_(a.y) * b.y, siluf_(a.z) * b.z, siluf_(a.w) * b.w}; st_bf4(H + r * 512 + hc, h); } }
    }
};
struct EpiMoeDown {
    bf16* Y; const int* tokl; const float* gatel; const unsigned* cnt;
    __device__ __forceinline__ void operator()(EPI_ARGS) const {
        const int ce = (int)cnt[u.e];
#pragma unroll
        for (int ai = 0; ai < 2; ++ai)
#pragma unroll
            for (int m = 0; m < 4; ++m) { const int idx = u.idx0 + ai * 128 + wr * 64 + m * 16 + fr;
                if (idx < ce) { const int pair = tokl[(size_t)u.e * LISTCAP + idx]; const float gt = gatel[(size_t)u.e * LISTCAP + idx]; bf16* rowp = Y + (size_t)pair * 2048 + u.pn * 256 + wc * 32 + 4 * fq;
#pragma unroll
                    for (int bj = 0; bj < 2; ++bj)
#pragma unroll
                        for (int n = 0; n < 2; ++n) st_bf4(rowp + bj * 128 + 16 * n, acc[ai][bj][m][n] * gt); } }
    }
};
struct EpiGlu {
    bf16* O; int ldo, coff; const bf16* Gb; const float* bias;
    __device__ __forceinline__ void operator()(EPI_ARGS) const {
#pragma unroll
        for (int ai = 0; ai < 2; ++ai)
#pragma unroll
            for (int m = 0; m < 4; ++m) { const int r = u.pm * 256 + ai * 128 + wr * 64 + m * 16 + fr;
#pragma unroll
                for (int bj = 0; bj < 2; ++bj)
#pragma unroll
                    for (int n = 0; n < 2; ++n) { const int c = u.pn * 256 + bj * 128 + wc * 32 + 16 * n + 4 * fq; const f32x4 bv = *(const f32x4*)(bias + c); const v2u gw = *(const v2u*)(Gb + (size_t)r * 1024 + c);
                        const f32x4 a = acc[ai][bj][m][n] + bv; const f32x4 o = {bflo(gw.x) * sigmoidf_(a.x), bfhi(gw.x) * sigmoidf_(a.y), bflo(gw.y) * sigmoidf_(a.z), bfhi(gw.y) * sigmoidf_(a.w)};
                        st_bf4(O + (size_t)r * ldo + coff + c, o); } }
    }
};

struct MoeOrder {
    const LAS int* bstart;
    const unsigned* cnt; const int* tokl; int nN, G, c, nblk; long bstride, eoff; bool up;
    __device__ bool next(int i, pg8::Unit& u) const {
        const long Lx = (long)i * G + c; if (Lx >= (long)nblk * nN) return false;
        const int blk = (int)(Lx / nN); u.pn = (int)(Lx % nN); u.pm = blk;
        const int e = bstart[65 + blk];
        u.e = e; u.idx0 = (blk - bstart[e]) * 256;
        u.aoff = up ? 0 : (long)blk * 256 * 512 * 2;
        u.boff = (long)e * (long)MOE_E_BYTES + eoff + (long)u.pn * bstride;
        return true;
    }
    __device__ int arow(const pg8::Unit& u, int row) const { const int idx = u.idx0 + row; return idx < (int)cnt[u.e] ? (tokl[(size_t)u.e * LISTCAP + idx] >> 1) : TT; }
};

__device__ __forceinline__ void attn_phase(Frame& F) {
    const bf16* Q = WSP(bf16, WS_Q); const bf16* Kb = WSP(bf16, WS_K); const bf16* VT = WSP(bf16, WS_VT); bf16* cat = WSP(bf16, WS_CAT);
    LAS unsigned char* lds = F.lds;
    const int tid = F.tid, lane = F.lane, w = F.wave, sub = w & 1, qw = w >> 1, r32 = lane & 31, hi = lane >> 5;
    float lam;
    { const float* lv = INP(11); float a = lv[lane] * lv[64 + lane], b = lv[128 + lane] * lv[192 + lane]; a = wave_sum(a); b = wave_sum(b); lam = expf(a) - expf(b) + 0.2f; }
    const float* subg = INP(12);
    const int NU = 1024 + 32;
    const int xcd = F.bid & 7, jcu = F.bid >> 3;
    for (int it = 0;; ++it) {
        int uidx;
        if (F.G == 256) { if (it < 4) uidx = 128 * xcd + it * 32 + jcu; else if (it == 4 && F.bid < 32) uidx = 1024 + F.bid; else break; }
        else { uidx = it * F.G + F.bid; if (uidx >= NU) break; }
        int b, head, q0row, nt; size_t kbase;
        if (uidx < 1024) { const int combo = uidx >> 6, qb = uidx & 63; b = combo >> 3; head = combo & 7; q0row = b * SEQ + qb * 128; nt = KEYS / 64; }
        else { const int v = uidx - 1024; b = v >> 4; head = (v >> 1) & 7; q0row = TL + b * CTX + (v & 1) * 128; nt = CTX / 64; }
        kbase = (size_t)b * KEYS;
        bf16x8 qf[4];
        { const bf16* qp = Q + (size_t)(q0row + qw * 32 + r32) * 1024 + head * 128 + sub * 64 + hi * 8;
#pragma unroll
          for (int ks = 0; ks < 4; ++ks) qf[ks] = *(const bf16x8*)(qp + ks * 16); }
        const int srow = tid >> 3, sch = tid & 7;
        const bf16* gk0 = Kb + (kbase + srow) * 1024 + head * 128 + sch * 8;
        const bf16* gv0 = VT + ((size_t)(b * 8 + head) * 128 + srow) * KEYS + sch * 8;
        const int lk = srow * 128 + ((sch ^ ((srow >> 1) & 7)) * 16);
        v4u st0, st1, st2, st3;
#define ATT_LOAD(t) do { st0 = *(const v4u*)(gk0 + (size_t)(t) * 65536); st1 = *(const v4u*)(gk0 + (size_t)(t) * 65536 + 64); st2 = *(const v4u*)(gv0 + (t) * 64); st3 = *(const v4u*)(gv0 + (size_t)64 * KEYS + (t) * 64); } while (0)
#define ATT_STORE(buf) do { LAS unsigned char* bp = lds + (buf) * 32768; *(LAS v4u*)(bp + lk) = st0; *(LAS v4u*)(bp + 8192 + lk) = st1; *(LAS v4u*)(bp + 16384 + lk) = st2; *(LAS v4u*)(bp + 16384 + 8192 + lk) = st3; } while (0)
        ATT_LOAD(0); ATT_STORE(0);
        __syncthreads();
        f32x16 o[4];
#pragma unroll
        for (int d = 0; d < 4; ++d)
#pragma unroll
            for (int r = 0; r < 16; ++r) o[d][r] = 0.f;
        float mrow = -INFINITY, lrow = 0.f;
        const int rdoff = r32 * 128;
        const int swz = (r32 >> 1) & 7;
        for (int t = 0; t < nt; ++t) {
            if (t + 1 < nt) ATT_LOAD(t + 1);
            const LAS unsigned char* bp = lds + (t & 1) * 32768;
            const LAS unsigned char* kp = bp + sub * 8192;
            f32x16 s0, s1;
#pragma unroll
            for (int r = 0; r < 16; ++r) { s0[r] = 0.f; s1[r] = 0.f; }
#pragma unroll
            for (int ks = 0; ks < 4; ++ks) {
                const int ch = ((2 * ks + hi) ^ swz) * 16;
                const bf16x8 k0 = *(const LAS bf16x8*)(kp + rdoff + ch);
                const bf16x8 k1 = *(const LAS bf16x8*)(kp + 4096 + rdoff + ch);
                s0 = __builtin_amdgcn_mfma_f32_32x32x16_bf16(k0, qf[ks], s0, 0, 0, 0);
                s1 = __builtin_amdgcn_mfma_f32_32x32x16_bf16(k1, qf[ks], s1, 0, 0, 0);
            }
            float mx = s0[0];
#pragma unroll
            for (int r = 1; r < 16; ++r) mx = fmaxf(mx, s0[r]);
#pragma unroll
            for (int r = 0; r < 16; ++r) mx = fmaxf(mx, s1[r]);
            mx = fmaxf(mx, __shfl_xor(mx, 32));
            const float mnew = fmaxf(mrow, mx);
            const float alpha = __builtin_amdgcn_exp2f(mrow - mnew);
            mrow = mnew;
            float rs = 0.f;
#pragma unroll
            for (int r = 0; r < 16; ++r) { s0[r] = __builtin_amdgcn_exp2f(s0[r] - mnew); rs += s0[r]; }
#pragma unroll
            for (int r = 0; r < 16; ++r) { s1[r] = __builtin_amdgcn_exp2f(s1[r] - mnew); rs += s1[r]; }
            lrow = lrow * alpha + rs;
            if (__any(alpha != 1.0f)) {
#pragma unroll
                for (int d = 0; d < 4; ++d)
#pragma unroll
                    for (int r = 0; r < 16; ++r) o[d][r] *= alpha;
            }
            bf16x8 pf[4];
#pragma unroll
            for (int s = 0; s < 4; ++s) { v4u pw;
                if (s < 2) { pw.x = cvt_pk_bf16(s0[8 * s + 0], s0[8 * s + 1]); pw.y = cvt_pk_bf16(s0[8 * s + 2], s0[8 * s + 3]); pw.z = cvt_pk_bf16(s0[8 * s + 4], s0[8 * s + 5]); pw.w = cvt_pk_bf16(s0[8 * s + 6], s0[8 * s + 7]); }
                else { const int q = s - 2; pw.x = cvt_pk_bf16(s1[8 * q + 0], s1[8 * q + 1]); pw.y = cvt_pk_bf16(s1[8 * q + 2], s1[8 * q + 3]); pw.z = cvt_pk_bf16(s1[8 * q + 4], s1[8 * q + 5]); pw.w = cvt_pk_bf16(s1[8 * q + 6], s1[8 * q + 7]); }
                pf[s] = __builtin_bit_cast(bf16x8, pw); }
            const LAS unsigned char* vp = bp + 16384;
#pragma unroll
            for (int d = 0; d < 4; ++d)
#pragma unroll
                for (int s = 0; s < 4; ++s) {
                    const bf16x8 vf = *(const LAS bf16x8*)(vp + d * 4096 + rdoff + (((2 * s + hi) ^ swz) * 16));
                    o[d] = __builtin_amdgcn_mfma_f32_32x32x16_bf16(vf, pf[s], o[d], 0, 0, 0);
                }
            if (t + 1 < nt) ATT_STORE((t + 1) & 1);
            __syncthreads();
        }
#undef ATT_LOAD
#undef ATT_STORE
        const float ltot = lrow + __shfl_xor(lrow, 32); const float linv = 1.0f / ltot;
        LAS float* xch = (LAS float*)lds + (size_t)(qw * 32 + r32) * 132;
        if (sub == 1) {
#pragma unroll
            for (int d = 0; d < 4; ++d)
#pragma unroll
                for (int g = 0; g < 4; ++g) *(LAS f32x4*)(xch + 32 * d + 8 * g + 4 * hi) = (f32x4){o[d][4 * g] * linv, o[d][4 * g + 1] * linv, o[d][4 * g + 2] * linv, o[d][4 * g + 3] * linv};
        }
        __syncthreads();
        if (sub == 0) {
            float ss = 0.f;
#pragma unroll
            for (int d = 0; d < 4; ++d)
#pragma unroll
                for (int g = 0; g < 4; ++g) { const f32x4 o2 = *(const LAS f32x4*)(xch + 32 * d + 8 * g + 4 * hi);
#pragma unroll
                    for (int j = 0; j < 4; ++j) { const float v = o[d][4 * g + j] * linv - lam * o2[j]; o[d][4 * g + j] = v; ss += v * v; } }
            ss += __shfl_xor(ss, 32);
            const float rn = 0.8f / sqrtf(ss * (1.0f / 128.0f) + EPS);
            bf16* op = cat + (size_t)(q0row + qw * 32 + r32) * 2048 + head * 128;
#pragma unroll
            for (int d = 0; d < 4; ++d)
#pragma unroll
                for (int g = 0; g < 4; ++g) { const int dv = 32 * d + 8 * g + 4 * hi; const f32x4 gg = *(const f32x4*)(subg + dv);
                    st_bf4(op + dv, (f32x4){o[d][4 * g] * rn * gg.x, o[d][4 * g + 1] * rn * gg.y, o[d][4 * g + 2] * rn * gg.z, o[d][4 * g + 3] * rn * gg.w}); }
        }
        __syncthreads();
    }
}

__device__ __forceinline__ void poold_phase(Frame& F) {
    const bf16* P = WSP(bf16, WS_P); bf16* PD = WSP(bf16, WS_PD);
    const int gt = F.bid * NTHREADS + F.tid, NGT = F.G * NTHREADS;
    for (int idx = gt; idx < TT * 128; idx += NGT) {
        const int r = idx >> 7, cc = (idx & 127) * 8, g = cc >> 8, wdw = 2 << g;
        int sb, t, Ls; if (r < TL) { sb = (r / SEQ) * SEQ; t = r % SEQ; Ls = SEQ; } else { sb = TL + ((r - TL) / CTX) * CTX; t = (r - TL) % CTX; Ls = CTX; }
        int lo = t - wdw / 2, hi = lo + wdw; lo = lo < 0 ? 0 : lo; hi = hi > Ls ? Ls : hi;
        float a[8];
#pragma unroll
        for (int j = 0; j < 8; ++j) a[j] = 0.f;
        for (int s = lo; s < hi; ++s) { const v4u v = *(const v4u*)(P + (size_t)(sb + s) * 1024 + cc);
            a[0] += bflo(v.x); a[1] += bfhi(v.x); a[2] += bflo(v.y); a[3] += bfhi(v.y); a[4] += bflo(v.z); a[5] += bfhi(v.z); a[6] += bflo(v.w); a[7] += bfhi(v.w); }
        const float inv = 1.0f / (float)(hi - lo);
        const v4u me = *(const v4u*)(P + (size_t)r * 1024 + cc);
        v4u o; o.x = pk2(a[0] * inv - bflo(me.x), a[1] * inv - bfhi(me.x)); o.y = pk2(a[2] * inv - bflo(me.y), a[3] * inv - bfhi(me.y));
        o.z = pk2(a[4] * inv - bflo(me.z), a[5] * inv - bfhi(me.z)); o.w = pk2(a[6] * inv - bflo(me.w), a[7] * inv - bfhi(me.w));
        *(v4u*)(PD + (size_t)r * 1024 + cc) = o;
    }
}

__device__ __forceinline__ void shortconv_phase(Frame& F) {
    const bf16* PJ = WSP(bf16, WS_PROJ1); float* GT = WSP(float, WS_GT);
    const float* cw = INP(17); const float* cb = INP(18);
    LAS float* scr = (LAS float*)(F.lds + F.wave * 16896);
    const int lane = F.lane;
    for (int it = F.gw; it < 2 * 128 * 48; it += F.NGW) {
        const int cbk = it % 48, tb = (it / 48) % 128, b = it / (48 * 128), col = cbk * 64 + lane, t0 = tb * 64;
        const float w0 = cw[col], w1 = cw[3072 + col], w2 = cw[2 * 3072 + col], bias = cb[col];
        const bf16* base = PJ + ((size_t)b * SEQ) * 4096 + col;
        float prev = (t0 > 0) ? bf2f(base[(size_t)(t0 - 1) * 4096]) : 0.f;
        float cur = bf2f(base[(size_t)t0 * 4096]);
#pragma unroll 8
        for (int tt = 0; tt < 64; ++tt) { const int t = t0 + tt; const float nxt = (t + 1 < SEQ) ? bf2f(base[(size_t)(t + 1) * 4096]) : 0.f;
            scr[tt * 65 + lane] = prev * w0 + cur * w1 + nxt * w2 + bias; prev = cur; cur = nxt; }
        LDS_WAIT(); asm volatile("" ::: "memory");
        for (int c = 0; c < 64; ++c) GT[((size_t)(cbk * 64 + c) * 2 + b) * SEQ + t0 + lane] = scr[lane * 65 + c];
        LDS_WAIT(); asm volatile("" ::: "memory");
    }
}

__device__ __forceinline__ void s5_scan_phase(Frame& F) {
    const bf16* PJ = WSP(bf16, WS_PROJ1); float* YD = WSP(float, WS_YD);
    const f32x2* lamb = WSP(f32x2, WS_S5LAM); const f32x2* bbar = WSP(f32x2, WS_S5B);
    const float* cre = INP(31); const float* cim = INP(32);
    const int lane = F.lane;
    for (int task = F.wave * F.G + F.bid; task < 256; task += F.NGW) {
        const int di = task >> 7, b = (task >> 6) & 1, g = task & 63;
        const int dgp = (di * 64 + g) * 64 + lane;
        const f32x2 lam = lamb[dgp];
        float br[16], bi[16], cr[16], ci[16];
#pragma unroll
        for (int c = 0; c < 16; ++c) { const f32x2 bv = bbar[(size_t)dgp * 16 + c]; br[c] = bv.x; bi[c] = bv.y;
            cr[c] = cre[((size_t)(di * 64 + g) * 16 + c) * 64 + lane]; ci[c] = cim[((size_t)(di * 64 + g) * 16 + c) * 64 + lane]; }
        float sr = 0.f, si = 0.f;
        const int nsteps = CTX + SEQ;
        for (int st = 0; st < nsteps; st += 4) {
            const int stl = st + (lane >> 4);
            int row;
            if (stl < CTX) row = TL + b * CTX + (di == 0 ? stl : CTX - 1 - stl);
            else row = b * SEQ + (di == 0 ? stl - CTX : SEQ - 1 - (stl - CTX));
            const float uval = bf2f(PJ[(size_t)row * 4096 + 3072 + g * 16 + (lane & 15)]);
#pragma unroll
            for (int k = 0; k < 4; ++k) {
                float bur = 0.f, bui = 0.f;
#pragma unroll
                for (int c = 0; c < 16; ++c) { const float u = __builtin_bit_cast(float, __builtin_amdgcn_readlane(__builtin_bit_cast(int, uval), 16 * k + c)); bur += br[c] * u; bui += bi[c] * u; }
                const float nr = lam.x * sr - lam.y * si + bur, ni = lam.x * si + lam.y * sr + bui; sr = nr; si = ni;
                const int s2 = st + k;
                if (s2 >= CTX) {
                    const int t = (di == 0) ? s2 - CTX : SEQ - 1 - (s2 - CTX);
                    float outv = 0.f;
#pragma unroll
                    for (int c = 0; c < 16; ++c) { float v = cr[c] * sr - ci[c] * si; v = wave_sum(v); if (lane == c) outv = v; }
                    if (lane < 16) YD[((size_t)di * TL + (size_t)b * SEQ + t) * 1024 + g * 16 + lane] = outv;
                }
            }
        }
    }
}

__device__ __forceinline__ void hyena_naive_phase(Frame& F) {
    const float* GT = WSP(float, WS_GT); const float* kT = WSP(float, WS_KT); const float* invn = WSP(float, WS_INVN); bf16* cat = WSP(bf16, WS_CAT);
    const float* hyb = INP(25);
    LAS float* kf = (LAS float*)F.lds;
    LAS f32x2* ub = (LAS f32x2*)(F.lds + 65536);
    const int tid = F.tid;
    for (int ch = F.bid; ch < 1024; ch += F.G) {
        float res0[16], res1[16];
        for (int o = 0; o < 2; ++o) {
            const float inv = invn[o * 1024 + ch];
            const float* kfw = kT + (size_t)(o * 2048 + ch) * SEQ; const float* kbw = kT + (size_t)(o * 2048 + 1024 + ch) * SEQ;
            for (int n = tid; n < 16384; n += NTHREADS) { float v; if (n < SEQ) v = kfw[n]; else if (n == SEQ) v = 0.f; else v = kbw[16384 - n]; kf[n] = v * inv; }
            if (o == 0) { const float* v0 = GT + ((size_t)(0 * 1024 + ch) * 2) * SEQ; for (int n = tid; n < SEQ; n += NTHREADS) ub[n] = (f32x2){v0[n], v0[SEQ + n]}; }
            else {
#pragma unroll
                for (int j = 0; j < 16; ++j) ub[tid + NTHREADS * j] = (f32x2){res0[j], res1[j]}; }
            __syncthreads();
            float a0[16], a1[16];
#pragma unroll
            for (int j = 0; j < 16; ++j) { a0[j] = 0.f; a1[j] = 0.f; }
            for (int s = 0; s < SEQ; ++s) { const f32x2 u = ub[s];
#pragma unroll
                for (int j = 0; j < 16; ++j) { const float kk = kf[(tid + NTHREADS * j - s) & 16383]; a0[j] += u.x * kk; a1[j] += u.y * kk; } }
            const float bias = hyb[o * 1024 + ch];
            const float* xg = GT + ((size_t)((o + 1) * 1024 + ch) * 2) * SEQ;
#pragma unroll
            for (int j = 0; j < 16; ++j) { const int t = tid + NTHREADS * j; const f32x2 u = ub[t];
                res0[j] = xg[t] * (a0[j] + bias * u.x); res1[j] = xg[SEQ + t] * (a1[j] + bias * u.y); }
            __syncthreads();
        }
#pragma unroll
        for (int j = 0; j < 16; ++j) { const int t = tid + NTHREADS * j;
            cat[(size_t)t * 2048 + ch] = (bf16)f2bf(res0[j]); cat[((size_t)SEQ + t) * 2048 + ch] = (bf16)f2bf(res1[j]); }
    }
}

__device__ __forceinline__ void s5_gelu_phase(Frame& F) {
    const bf16* PJ = WSP(bf16, WS_PROJ1); const float* YD = WSP(float, WS_YD); bf16* Gb = WSP(bf16, WS_PD); const float* dd = INP(33);
    const int gt = F.bid * NTHREADS + F.tid, NGT = F.G * NTHREADS;
    for (int idx = gt; idx < TL * 256; idx += NGT) { const int r = idx >> 8, c = (idx & 255) * 4;
        const v2u uw = *(const v2u*)(PJ + (size_t)r * 4096 + 3072 + c); const f32x4 d4 = *(const f32x4*)(dd + c);
        const f32x4 y0 = *(const f32x4*)(YD + (size_t)r * 1024 + c), y1 = *(const f32x4*)(YD + ((size_t)TL + r) * 1024 + c);
        const f32x4 y = {bflo(uw.x) * d4.x + y0.x + y1.x, bfhi(uw.x) * d4.y + y0.y + y1.y, bflo(uw.y) * d4.z + y0.z + y1.z, bfhi(uw.y) * d4.w + y0.w + y1.w};
        st_bf4(Gb + (size_t)r * 1024 + c, (f32x4){gelu_tanh(y.x), gelu_tanh(y.y), gelu_tanh(y.z), gelu_tanh(y.w)}); }
}

constexpr int NPHASES = 21;
#ifndef MK_SINGLE
#define MK_SINGLE 1
#endif

__device__ __forceinline__ unsigned long long launder_u64(unsigned long long v) {
    unsigned lo = (unsigned)v, hi = (unsigned)(v >> 32);
    asm volatile("" : "+v"(lo), "+v"(hi));
    lo = __builtin_amdgcn_readfirstlane(lo); hi = __builtin_amdgcn_readfirstlane(hi);
    return ((unsigned long long)hi << 32) | lo;
}
__device__ __forceinline__ const void* launder_ptr(const void* p) {
    unsigned long long v = (unsigned long long)p; unsigned lo = (unsigned)v, hi = (unsigned)(v >> 32);
    asm volatile("" : "+v"(lo), "+v"(hi));
    lo = __builtin_amdgcn_readfirstlane(lo); hi = __builtin_amdgcn_readfirstlane(hi);
    return (const void*)(((unsigned long long)hi << 32) | lo);
}
__device__ __forceinline__ void moe_blocks(Frame& F, int l, LAS int* bstart) {
    __syncthreads();
    if (F.tid == 0) { const unsigned* cnt = WSP(unsigned, WS_CTL) + CW_CNT + l * 64; int acc = 0;
        for (int e = 0; e < 64; ++e) { bstart[e] = acc; const int nb = ((int)cnt[e] + 255) >> 8; for (int j = 0; j < nb; ++j) bstart[65 + acc + j] = e; acc += nb; } bstart[64] = acc; }
    __syncthreads();
}

template <int PHSEL>
__global__ void __launch_bounds__(NTHREADS, 2) mk_fwd(Args args) {
    extern __shared__ __attribute__((aligned(16))) unsigned char lds_raw[];
    Frame F;
    F.lds = (LAS unsigned char*)lds_raw; F.ws = args.ws; F.kin = (const __attribute__((address_space(4))) unsigned long long*)__builtin_amdgcn_kernarg_segment_ptr();
    F.tid = threadIdx.x; F.lane = F.tid & 63; F.wave = __builtin_amdgcn_readfirstlane(F.tid >> 6); F.bid = blockIdx.x; F.G = gridDim.x;
    F.gw = F.bid * NWAVES + F.wave; F.NGW = F.G * NWAVES;
    volatile LAS unsigned* lctl = (volatile LAS unsigned*)(F.lds + LDS_CTL);
    LAS int* bstart = (LAS int*)(F.lds + LDS_CTL + 64);
    if (F.tid < 4) lctl[F.tid] = 0u;
    __syncthreads();
    const int lo = args.ph_lo, hi = args.ph_hi;
    XcdBarrier bar; bar.bar = WSP(unsigned, WS_CTL) + CW_BAR; bar.x = 0; bar.st = lctl;
    if (PHSEL < 0) bar = xcd_barrier_post(WSP(unsigned, WS_CTL) + CW_BAR, lctl);
#ifndef PH_MASK
#define PH_MASK 0xffffffffu
#endif
#define IN(k) (((PH_MASK >> (k)) & 1u) && (PHSEL < 0 || PHSEL == (k)))
#define INL(j) (((PH_MASK >> (6 + (j))) & 1u) && (PHSEL < 0 || (PHSEL == 6 + (j) && lo == pb + (j))))
#define PH_END(k) do { if (PHSEL < 0) xcd_barrier(bar); } while (0)
#define PH_BEGIN() do { F.ws = (unsigned char*)launder_ptr((const void*)F.ws); F.kin = (const __attribute__((address_space(4))) unsigned long long*)launder_u64((unsigned long long)F.kin); \
    { int _t = threadIdx.x; asm volatile("" : "+v"(_t)); F.tid = _t; F.lane = _t & 63; F.wave = __builtin_amdgcn_readfirstlane(_t >> 6); \
      int _b = blockIdx.x; asm volatile("" : "+v"(_b)); F.bid = __builtin_amdgcn_readfirstlane(_b); F.gw = F.bid * NWAVES + F.wave; } } while (0)
    LAS unsigned char* lds = F.lds;
    const int G = F.G, bid = F.bid;
    constexpr long T2048 = 256L * 2048 * 2;

    if (IN(0)) { PH_BEGIN(); p0_prologue(F); PH_END(0); }
    if (IN(1)) { PH_BEGIN(); p1_reduce(F); PH_END(1); }
        if (IN(2)) { PH_BEGIN(); norm_phase<0>(F, 0, nullptr); PH_END(2); }
        if (IN(3)) { PH_BEGIN();
            { pg8::Gemm g{WSP(bf16, WS_HA), WSP(bf16, WS_WIN0), 2048, 2048, 2048}; pg8::StaticOrder S; S.init(TT / 256, 12, G, bid, T2048, 0, T2048);
              EpiQKP E{WSP(bf16, WS_Q), WSP(bf16, WS_K), WSP(bf16, WS_P), WSP(f32x2, WS_ROPE)}; pg8::gemm_phase<EpiQKP, pg8::StaticOrder, false>(lds, g, S, E); }
            { pg8::Gemm g{WSP(bf16, WS_WIN0) + (size_t)3072 * 2048, WSP(bf16, WS_HA), 2048, 2048, 2048}; pg8::StaticOrder S; S.init(4, TT / 256, G, bid, T2048, 0, T2048);
              EpiVT E{WSP(bf16, WS_VT)}; pg8::gemm_phase<EpiVT, pg8::StaticOrder, false>(lds, g, S, E); }
            PH_END(3);
        }
        if (IN(4)) { PH_BEGIN(); attn_phase(F); poold_phase(F); PH_END(4); }
        if (IN(5)) { PH_BEGIN();
            pg8::Gemm g{WSP(bf16, WS_PD), WSP(bf16, WS_WPOOL), 1024, 256, 256}; pg8::StaticOrder S; S.init(TT / 256, 4, G, bid, 256L * 1024 * 2, 256L * 2, 256L * 256 * 2);
            EpiScaleBf16 E{WSP(bf16, WS_CAT), 2048, 1024, INP(14)}; pg8::gemm_phase<EpiScaleBf16, pg8::StaticOrder, false>(lds, g, S, E);
            PH_END(5);
        }
    {
    constexpr int pb = 6; constexpr int l = 0;
    if (INL(0)) { PH_BEGIN();
        float* xbuf = WSP(float, WS_X);
        pg8::Gemm g{WSP(bf16, WS_CAT), WSP(bf16, l == 0 ? WS_WOUT0 : WS_WOUT1), 2048, 2048, 2048}; pg8::StaticOrder S; S.init(l == 0 ? TT / 256 : TL / 256, 8, G, bid, T2048, 0, T2048);
        EpiRes E{l == 0 ? INP(0) : xbuf, l == 0 ? INP(2) : xbuf + (size_t)TL * 2048, xbuf, modp(F, l, 0, 2)}; pg8::gemm_phase<EpiRes, pg8::StaticOrder, false>(lds, g, S, E);
        PH_END(pb);
    }
    if (INL(1)) { PH_BEGIN(); norm_phase<1>(F, l, nullptr); PH_END(pb + 1); }
    if (INL(2)) { PH_BEGIN();
        moe_blocks(F, l, bstart);
        pg8::Gemm g{WSP(bf16, WS_HA), (const bf16*)(F.ws + WS_WMOE + (size_t)l * MOE_L_BYTES), 2048, 2048, 2048};
        MoeOrder S{bstart, WSP(unsigned, WS_CTL) + CW_CNT + l * 64, WSP(int, WS_TOKL), 4, G, bid, bstart[64], T2048, 0, true};
        EpiMoeUp E{WSP(bf16, WS_H)}; pg8::gemm_phase<EpiMoeUp, MoeOrder, true>(lds, g, S, E);
        PH_END(pb + 2);
    }
    if (INL(3)) { PH_BEGIN();
        moe_blocks(F, l, bstart);
        pg8::Gemm g{WSP(bf16, WS_H), (const bf16*)(F.ws + WS_WMOE + (size_t)l * MOE_L_BYTES), 512, 512, 512};
        MoeOrder S{bstart, WSP(unsigned, WS_CTL) + CW_CNT + l * 64, WSP(int, WS_TOKL), 8, G, bid, bstart[64], 256L * 512 * 2, (long)(4 * MiB), false};
        EpiMoeDown E{WSP(bf16, WS_Y), WSP(int, WS_TOKL), WSP(float, WS_GATEL), WSP(unsigned, WS_CTL) + CW_CNT + l * 64}; pg8::gemm_phase<EpiMoeDown, MoeOrder, false>(lds, g, S, E);
        PH_END(pb + 3);
    }
    }
        if (IN(10)) { PH_BEGIN(); norm_phase<2>(F, 1, nullptr); PH_END(10); }
        if (IN(11)) { PH_BEGIN();
            pg8::Gemm g{WSP(bf16, WS_HA), WSP(bf16, WS_WIN1), 2048, 2048, 2048}; pg8::StaticOrder S; S.init(TT / 256, 16, G, bid, T2048, 0, T2048);
            EpiBf16 E{WSP(bf16, WS_PROJ1), 4096}; pg8::gemm_phase<EpiBf16, pg8::StaticOrder, false>(lds, g, S, E);
            PH_END(11);
        }
        if (IN(12)) { PH_BEGIN(); shortconv_phase(F); s5_scan_phase(F); PH_END(12); }
        if (IN(13)) { PH_BEGIN(); hyena_naive_phase(F); PH_END(13); }
        if (IN(14)) { PH_BEGIN(); s5_gelu_phase(F); PH_END(14); }
        if (IN(15)) { PH_BEGIN();
            pg8::Gemm g{WSP(bf16, WS_PD), WSP(bf16, WS_WGLU), 1024, 1024, 1024}; pg8::StaticOrder S; S.init(TL / 256, 4, G, bid, 256L * 1024 * 2, 0, 256L * 1024 * 2);
            EpiGlu E{WSP(bf16, WS_CAT), 2048, 1024, WSP(bf16, WS_PD), INP(35)}; pg8::gemm_phase<EpiGlu, pg8::StaticOrder, false>(lds, g, S, E);
            PH_END(15);
        }
    {
    constexpr int pb = 16; constexpr int l = 1;
    if (INL(0)) { PH_BEGIN();
        float* xbuf = WSP(float, WS_X);
        pg8::Gemm g{WSP(bf16, WS_CAT), WSP(bf16, l == 0 ? WS_WOUT0 : WS_WOUT1), 2048, 2048, 2048}; pg8::StaticOrder S; S.init(l == 0 ? TT / 256 : TL / 256, 8, G, bid, T2048, 0, T2048);
        EpiRes E{l == 0 ? INP(0) : xbuf, l == 0 ? INP(2) : xbuf + (size_t)TL * 2048, xbuf, modp(F, l, 0, 2)}; pg8::gemm_phase<EpiRes, pg8::StaticOrder, false>(lds, g, S, E);
        PH_END(pb);
    }
    if (INL(1)) { PH_BEGIN(); norm_phase<1>(F, l, nullptr); PH_END(pb + 1); }
    if (INL(2)) { PH_BEGIN();
        moe_blocks(F, l, bstart);
        pg8::Gemm g{WSP(bf16, WS_HA), (const bf16*)(F.ws + WS_WMOE + (size_t)l * MOE_L_BYTES), 2048, 2048, 2048};
        MoeOrder S{bstart, WSP(unsigned, WS_CTL) + CW_CNT + l * 64, WSP(int, WS_TOKL), 4, G, bid, bstart[64], T2048, 0, true};
        EpiMoeUp E{WSP(bf16, WS_H)}; pg8::gemm_phase<EpiMoeUp, MoeOrder, true>(lds, g, S, E);
        PH_END(pb + 2);
    }
    if (INL(3)) { PH_BEGIN();
        moe_blocks(F, l, bstart);
        pg8::Gemm g{WSP(bf16, WS_H), (const bf16*)(F.ws + WS_WMOE + (size_t)l * MOE_L_BYTES), 512, 512, 512};
        MoeOrder S{bstart, WSP(unsigned, WS_CTL) + CW_CNT + l * 64, WSP(int, WS_TOKL), 8, G, bid, bstart[64], 256L * 512 * 2, (long)(4 * MiB), false};
        EpiMoeDown E{WSP(bf16, WS_Y), WSP(int, WS_TOKL), WSP(float, WS_GATEL), WSP(unsigned, WS_CTL) + CW_CNT + l * 64}; pg8::gemm_phase<EpiMoeDown, MoeOrder, false>(lds, g, S, E);
        PH_END(pb + 3);
    }
    }
    if (IN(20)) { PH_BEGIN(); norm_phase<3>(F, 1, args.out); }
#undef IN
#undef INL
#undef PH_END
}

typedef void (*kern_t)(Args);
template <int P> static void launch_phase(int grid, hipStream_t stream, Args a) { hipLaunchKernelGGL(mk_fwd<P>, dim3(grid), dim3(NTHREADS), LDS_BYTES, stream, a); }
template <int P> static bool prep_phase() { return hipFuncSetAttribute((const void*)mk_fwd<P>, hipFuncAttributeMaxDynamicSharedMemorySize, LDS_BYTES) == hipSuccess; }
extern "C" void kernel_launch(void* const* d_in, const int* in_sizes, int n_in, void* d_out, int out_size, void* d_ws, size_t ws_size, hipStream_t stream) {
    static int grid = 0;
    if (grid == 0) {
        if (n_in != 43 || out_size != TL * DM || ws_size < WS_END) { fprintf(stderr, "kernel_launch: unexpected shapes (n_in %d, out %d, ws %zu < %zu)\n", n_in, out_size, ws_size, (size_t)WS_END); grid = -1; return; }
        int dev = 0, cus = 0;
        if (hipGetDevice(&dev) != hipSuccess || hipDeviceGetAttribute(&cus, hipDeviceAttributeMultiprocessorCount, dev) != hipSuccess) { grid = -1; return; }
        bool ok = true;
#if MK_SINGLE
        ok = prep_phase<-1>();
#else
        ok = prep_phase<0>() && prep_phase<1>() && prep_phase<2>() && prep_phase<3>() && prep_phase<4>() && prep_phase<5>() && prep_phase<6>() && prep_phase<7>() && prep_phase<8>() && prep_phase<9>() &&
             prep_phase<10>() && prep_phase<11>() && prep_phase<12>() && prep_phase<13>() && prep_phase<14>() && prep_phase<15>() && prep_phase<20>();
#endif
        if (!ok) { fprintf(stderr, "kernel_launch: hipFuncSetAttribute failed\n"); grid = -1; return; }
        (void)hipGetLastError();
        grid = cus;
    }
    if (grid < 0) return;
    (void)hipMemsetAsync((char*)d_ws + WS_CTL, 0, CTL_BYTES, stream);
    Args a{};
    for (int i = 0; i < 43; ++i) a.in[i] = (const float*)d_in[i];
    a.out = (float*)d_out; a.ws = (unsigned char*)d_ws;
#if MK_SINGLE
    a.ph_lo = 0; a.ph_hi = NPHASES;
    launch_phase<-1>(grid, stream, a);
#else
#define LP(k, P) a.ph_lo = (k); a.ph_hi = (k) + 1; launch_phase<P>(grid, stream, a);
    LP(0, 0) LP(1, 1) LP(2, 2) LP(3, 3) LP(4, 4) LP(5, 5) LP(6, 6) LP(7, 7) LP(8, 8) LP(9, 9) LP(10, 10) LP(11, 11) LP(12, 12) LP(13, 13) LP(14, 14) LP(15, 15)
    LP(16, 6) LP(17, 7) LP(18, 8) LP(19, 9) LP(20, 20)
#undef LP
#endif
}
```

```cpp
#include <hip/hip_runtime.h>
#include <cstdio>
#include <cstdint>
#include <cmath>

#define GAS __attribute__((address_space(1)))
#define LAS __attribute__((address_space(3)))
typedef unsigned short bf16;
typedef unsigned v4u __attribute__((ext_vector_type(4)));
typedef unsigned v2u __attribute__((ext_vector_type(2)));
typedef float f32x4 __attribute__((ext_vector_type(4)));
typedef float f32x2 __attribute__((ext_vector_type(2)));
typedef float f32x16 __attribute__((ext_vector_type(16)));
typedef short bf16x8 __attribute__((ext_vector_type(8)));
#define LDS_WAIT() asm volatile("s_waitcnt lgkmcnt(0)" ::: "memory")
#define VM_WAIT() asm volatile("s_waitcnt vmcnt(0)" ::: "memory")

__device__ __forceinline__ unsigned f2bf(float f) { unsigned u = __builtin_bit_cast(unsigned, f); return (u + 0x7fffu + ((u >> 16) & 1u)) >> 16; }
__device__ __forceinline__ unsigned pk2(float lo, float hi) { return f2bf(lo) | (f2bf(hi) << 16); }
__device__ __forceinline__ unsigned cvt_pk_bf16(float lo, float hi) { unsigned r; asm volatile("v_cvt_pk_bf16_f32 %0, %1, %2" : "=v"(r) : "v"(lo), "v"(hi)); return r; }
__device__ __forceinline__ float bf2f(unsigned short b) { return __builtin_bit_cast(float, (unsigned)b << 16); }
__device__ __forceinline__ float bflo(unsigned w) { return __builtin_bit_cast(float, w << 16); }
__device__ __forceinline__ float bfhi(unsigned w) { return __builtin_bit_cast(float, w & 0xffff0000u); }
__device__ __forceinline__ float wave_sum(float v) {
#pragma unroll
    for (int o = 1; o < 64; o <<= 1) v += __shfl_xor(v, o);
    return v;
}

namespace pg8 {
typedef unsigned short bf16_t;
constexpr int BM = 256, BK = 64, HALF = 128, HTB = HALF * BK * 2, STAGE_BYTES = 8 * HTB;

__host__ __device__ __forceinline__ int lds_byte(int r, int c) { const int st = (r >> 4) * 2 + (c >> 5), rr = r & 15, cc = c & 31, ob = rr * 64 + cc * 2; return st * 1024 + (ob ^ (((ob >> 9) & 1) << 5)); }
__host__ __device__ __forceinline__ void stage_rc(int b, int& R, int& C) { const int st = b / 1024, sb = b % 1024, swz = sb ^ (((sb >> 9) & 1) << 5); R = (st >> 1) * 16 + swz / 64; C = (st & 1) * 32 + (swz % 64) / 2; }

struct Unit { int pm, pn; long aoff, boff; int e, idx0; };
struct Gemm { const bf16_t* A; const bf16_t* Bt; int lda, ldb, K; };

template <class Epi, class Sched, bool GATHER>
__device__ __forceinline__ void gemm_phase(LAS unsigned char* lds, const Gemm g, const Sched& S, const Epi& E) {
    const int tid = threadIdx.x, wid = __builtin_amdgcn_readfirstlane(tid >> 6), lane = tid & 63, wr = wid >> 2, wc = wid & 3, fr = lane & 15, fq = lane >> 4;
    const int K = g.K, nt = K / BK;
    unsigned voffA[2], voffB[2];
#pragma unroll
    for (int i = 0; i < 2; ++i) { int R, C; stage_rc(tid * 16 + i * 8192, R, C);
        voffA[i] = (unsigned)(R * g.lda + C) * 2u; voffB[i] = (unsigned)(R * g.ldb + C) * 2u; }
    const size_t kstep = (size_t)(BK * 2);
    const size_t hstepA = GATHER ? 0 : (size_t)HALF * g.lda * 2, hstepB = (size_t)HALF * g.ldb * 2;
    const unsigned ldsw = (unsigned)wid * 1024u;
    const int aoff = lds_byte(wr * 64 + fr, fq * 8), boff = lds_byte(wc * 32 + fr, fq * 8);
#define PG8_SA(b, h) (((b) * 2 + (h)) * HTB)
#define PG8_SB(b, h) ((4 + (b) * 2 + (h)) * HTB)
#define PG8_STAGE(bufoff, gbase, voff) do { _Pragma("unroll") for (int _i = 0; _i < 2; ++_i) \
        __builtin_amdgcn_global_load_lds((const unsigned*)((const char*)(gbase) + (voff)[_i]), (LAS unsigned*)(lds + (bufoff) + ldsw + _i * 8192), 16, 0, 0); } while (0)
#define PG8_STAGE_A(bufoff, gbase, h, nx) do { if constexpr (GATHER) { unsigned _tv[2]; \
        if (nx) { int _tz = tid; asm volatile("" : "+v"(_tz)); _Pragma("unroll") for (int _j = 0; _j < 2; ++_j) { int _R, _C; stage_rc(_tz * 16 + _j * 8192, _R, _C); _tv[_j] = (unsigned)S.arow(nxt, (h) * HALF + _R) * (unsigned)(g.lda * 2) + (unsigned)(_C * 2); } } \
        else { _tv[0] = gvc[h][0]; _tv[1] = gvc[h][1]; } \
        PG8_STAGE(bufoff, gbase, _tv); } else { PG8_STAGE(bufoff, (gbase) + (h) * hstepA, voffA); } } while (0)
#define PG8_LDA(dst, b, h) do { _Pragma("unroll") for (int m = 0; m < 4; ++m) _Pragma("unroll") for (int k = 0; k < 2; ++k) dst[m][k] = *(const LAS bf16x8*)(lds + PG8_SA(b, h) + aoff + m * 2048 + k * 1024); } while (0)
#define PG8_LDB(dst, b, h) do { _Pragma("unroll") for (int n = 0; n < 2; ++n) _Pragma("unroll") for (int k = 0; k < 2; ++k) dst[n][k] = *(const LAS bf16x8*)(lds + PG8_SB(b, h) + boff + n * 2048 + k * 1024); } while (0)
#define PG8_MMA(ai, bj, At, Bt) do { __builtin_amdgcn_s_setprio(1); _Pragma("unroll") for (int m = 0; m < 4; ++m) _Pragma("unroll") for (int n = 0; n < 2; ++n) _Pragma("unroll") for (int k = 0; k < 2; ++k) \
        acc[ai][bj][m][n] = __builtin_amdgcn_mfma_f32_16x16x32_bf16(Bt[n][k], At[m][k], acc[ai][bj][m][n], 0, 0, 0); __builtin_amdgcn_s_setprio(0); } while (0)
#define PG8_WAIT_V(n) asm volatile("s_waitcnt vmcnt(" #n ")" ::: "memory")
#define PG8_WAIT_L(n) asm volatile("s_waitcnt lgkmcnt(" #n ")" ::: "memory")
#define PG8_BAR __builtin_amdgcn_s_barrier()
#define PG8_SCHED __builtin_amdgcn_sched_barrier(0)
    Unit cur, nxt; int ui = 0;
    if (!S.next(0, cur)) return;
    unsigned gvc[2][2];
#define PG8_GV(unit) do { if constexpr (GATHER) { int _tz = tid; asm volatile("" : "+v"(_tz)); _Pragma("unroll") for (int _h = 0; _h < 2; ++_h) _Pragma("unroll") for (int _j = 0; _j < 2; ++_j) { int _R, _C; stage_rc(_tz * 16 + _j * 8192, _R, _C); \
        gvc[_h][_j] = (unsigned)S.arow(unit, _h * HALF + _R) * (unsigned)(g.lda * 2) + (unsigned)(_C * 2); } } } while (0)
    PG8_GV(cur);
    f32x4 acc[2][2][4][2];
#pragma unroll
    for (int a = 0; a < 2; ++a)
#pragma unroll
        for (int b = 0; b < 2; ++b)
#pragma unroll
            for (int m = 0; m < 4; ++m)
#pragma unroll
                for (int n = 0; n < 2; ++n) acc[a][b][m][n] = (f32x4){0.f, 0.f, 0.f, 0.f};
    bf16x8 At[4][2], B0[2][2], B1[2][2];
    const char* cA = (const char*)g.A + cur.aoff; const char* cB = (const char*)g.Bt + cur.boff;
    PG8_STAGE(PG8_SB(0, 0), cB, voffB); PG8_STAGE(PG8_SB(0, 1), cB + hstepB, voffB); PG8_STAGE_A(PG8_SA(0, 0), cA, 0, false); PG8_STAGE_A(PG8_SA(0, 1), cA, 1, false);
    if (wr == 1) PG8_BAR;
    PG8_WAIT_V(2); PG8_BAR;
    PG8_STAGE(PG8_SB(1, 0), cB + kstep, voffB); PG8_STAGE_A(PG8_SA(1, 0), cA + kstep, 0, false); PG8_STAGE(PG8_SB(1, 1), cB + hstepB + kstep, voffB);
    PG8_WAIT_V(6); PG8_BAR;
    for (;;) {
        const bool has_next = S.next(ui + 1, nxt);
        const char* nA = has_next ? (const char*)g.A + nxt.aoff : cA; const char* nB = has_next ? (const char*)g.Bt + nxt.boff : cB;
#pragma nounroll
        for (int t = 0; t < nt; t += 2) {
            const bool last = (t == nt - 2);
            const char* a1 = cA + (size_t)(t + 1) * kstep;
            const char* a2 = last ? nA : cA + (size_t)(t + 2) * kstep; const char* b2 = last ? nB : cB + (size_t)(t + 2) * kstep;
            const char* a3 = a2 + kstep; const char* b3 = b2 + kstep;
            PG8_LDB(B0, 0, 0); PG8_LDB(B1, 0, 1); PG8_SCHED; PG8_LDA(At, 0, 0); PG8_STAGE_A(PG8_SA(1, 1), a1, 1, false);
            PG8_WAIT_V(8); PG8_WAIT_L(0); PG8_BAR; PG8_MMA(0, 0, At, B0); PG8_MMA(0, 1, At, B1); PG8_BAR; PG8_SCHED;
            PG8_LDA(At, 0, 1); PG8_STAGE(PG8_SB(0, 0), b2, voffB); PG8_STAGE(PG8_SB(0, 1), b2 + hstepB, voffB); PG8_STAGE_A(PG8_SA(0, 0), a2, 0, last);
            PG8_WAIT_V(8); PG8_WAIT_L(0); PG8_BAR; PG8_MMA(1, 0, At, B0); PG8_MMA(1, 1, At, B1); PG8_BAR; PG8_SCHED;
            PG8_LDB(B0, 1, 0); PG8_LDB(B1, 1, 1); PG8_SCHED; PG8_LDA(At, 1, 0); PG8_STAGE_A(PG8_SA(0, 1), a2, 1, last);
            PG8_WAIT_V(8); PG8_WAIT_L(0); PG8_BAR; PG8_MMA(0, 0, At, B0); PG8_MMA(0, 1, At, B1); PG8_BAR; PG8_SCHED;
            PG8_LDA(At, 1, 1); PG8_STAGE(PG8_SB(1, 0), b3, voffB); PG8_STAGE(PG8_SB(1, 1), b3 + hstepB, voffB); PG8_STAGE_A(PG8_SA(1, 0), a3, 0, last);
            PG8_WAIT_V(8); PG8_WAIT_L(0); PG8_BAR; PG8_MMA(1, 0, At, B0); PG8_MMA(1, 1, At, B1); PG8_BAR; PG8_SCHED;
        }
        if (wr == 0) PG8_BAR;
        E(acc, cur, wr, wc, fr, fq);
        if (!has_next) break;
#pragma unroll
        for (int a = 0; a < 2; ++a)
#pragma unroll
            for (int b = 0; b < 2; ++b)
#pragma unroll
                for (int m = 0; m < 4; ++m)
#pragma unroll
                    for (int n = 0; n < 2; ++n) acc[a][b][m][n] = (f32x4){0.f, 0.f, 0.f, 0.f};
        cur = nxt; cA = nA; cB = nB; ++ui;
        PG8_GV(cur);
        if (wr == 1) PG8_BAR;
    }
    PG8_WAIT_V(0);
    PG8_BAR;
#undef PG8_SA
#undef PG8_SB
#undef PG8_STAGE
#undef PG8_STAGE_A
#undef PG8_GV
#undef PG8_LDA
#undef PG8_LDB
#undef PG8_MMA
#undef PG8_WAIT_V
#undef PG8_WAIT_L
#undef PG8_BAR
#undef PG8_SCHED
}

struct StaticOrder {
    int nM, nN, nwg, G, c; long astride, apn, bstride;
    __device__ void init(int nM_, int nN_, int G_, int c_, long astride_, long apn_, long bstride_) { nM = nM_; nN = nN_; nwg = nM * nN; G = G_; c = c_; astride = astride_; apn = apn_; bstride = bstride_; }
    __device__ bool next(int i, Unit& u) const {
        const long Lx = (long)i * G + c; if (Lx >= nwg) return false;
        int wgid = (int)Lx; { const int q = nwg / 8, r = nwg % 8, xcd = wgid % 8, off = wgid / 8; wgid = (xcd < r ? xcd * (q + 1) : r * (q + 1) + (xcd - r) * q) + off; }
        const int nig = 8 * nN, gid = wgid / nig, fm = gid * 8, gsz = (nM - fm) < 8 ? (nM - fm) : 8;
        u.pm = fm + ((wgid % nig) % gsz); u.pn = (wgid % nig) / gsz; u.aoff = (long)u.pm * astride + (long)u.pn * apn; u.boff = (long)u.pn * bstride; u.e = 0; u.idx0 = 0; return true;
    }
    __device__ int arow(const Unit&, int) const { return 0; }
};
}

constexpr int DM = 2048, NBATCH = 2, SEQ = 8192, CTX = 256;
constexpr int TL = NBATCH * SEQ;
constexpr int TC = NBATCH * CTX;
constexpr int TT = TL + TC;
constexpr int KEYS = CTX + SEQ;
constexpr int NEXP = 64, DEXP = 512;
constexpr int LISTCAP = 2 * TT;
constexpr float EPS = 1e-6f;
constexpr float QSCALE = 0.125f * 1.4426950408889634f;
constexpr int NWAVES = 8, NTHREADS = 512;

constexpr size_t MiB = 1u << 20;
constexpr size_t WS_CTL = 0, CTL_BYTES = 1 * MiB;
constexpr size_t WS_WIN0 = 1 * MiB;
constexpr size_t WS_WOUT0 = WS_WIN0 + 16 * MiB;
constexpr size_t WS_WIN1 = WS_WOUT0 + 8 * MiB;
constexpr size_t WS_WOUT1 = WS_WIN1 + 16 * MiB;
constexpr size_t WS_WPOOL = WS_WOUT1 + 8 * MiB;
constexpr size_t WS_WGLU = WS_WPOOL + 1 * MiB;
constexpr size_t WS_WMOE = WS_WGLU + 2 * MiB;
constexpr size_t MOE_E_BYTES = 6 * MiB, MOE_L_BYTES = 64 * MOE_E_BYTES;
constexpr size_t WS_X = WS_WMOE + 2 * MOE_L_BYTES;
constexpr size_t WS_HA = WS_X + 132 * MiB;
constexpr size_t WS_Q = WS_HA + 67 * MiB;
constexpr size_t WS_K = WS_Q + 33 * MiB;
constexpr size_t WS_VT = WS_K + 33 * MiB;
constexpr size_t WS_P = WS_VT + 33 * MiB;
constexpr size_t WS_PROJ1 = WS_Q;
constexpr size_t WS_CAT = WS_P + 33 * MiB;
constexpr size_t WS_PD = WS_CAT + 66 * MiB;
constexpr size_t WS_H = WS_PD + 33 * MiB;
constexpr size_t WS_Y = WS_H + 49 * MiB;
constexpr size_t WS_GT = WS_Y + 132 * MiB;
constexpr size_t WS_KT = WS_GT + 192 * MiB;
constexpr size_t WS_YD = WS_KT + 128 * MiB;
constexpr size_t WS_MISC = WS_YD + 128 * MiB;
constexpr size_t WS_MOD = WS_MISC;
constexpr size_t WS_ADAP = WS_MOD + 1 * MiB;
constexpr size_t WS_ROPE = WS_ADAP + 10 * MiB;
constexpr size_t WS_NORMP = WS_ROPE + 1 * MiB;
constexpr size_t WS_INVN = WS_NORMP + 4 * MiB;
constexpr size_t WS_S5LAM = WS_INVN + 1 * MiB;
constexpr size_t WS_S5B = WS_S5LAM + 1 * MiB;
constexpr size_t WS_WRT = WS_S5B + 2 * MiB;
constexpr size_t WS_TOKL = WS_WRT + 2 * MiB;
constexpr size_t WS_GATEL = WS_TOKL + 9 * MiB;
constexpr size_t WS_TW = WS_GATEL + 9 * MiB;
constexpr size_t WS_FFTW = WS_TW + 1 * MiB;
constexpr size_t WS_END = WS_FFTW + 32 * MiB;
static_assert(WS_END <= 2040 * MiB, "d_ws map");
constexpr int CW_BAR = 1024;
constexpr int CW_CNT = 8192;

constexpr int LDS_PHASE = 131072;
constexpr int LDS_CTL = 147456 - 2048;
constexpr int LDS_BYTES = 147456;

#define XB_TMO      128
#define XB_XCNT(j)  (256  + 64 * (j))
#define XB_XSUB(j)  (1280 + 64 * (j))
#define XB_XGEN(j)  (2304 + 64 * (j))
#define XB_TOP      3328
#define XB_TOPGEN   3392
#define XCD_BAR_WORDS 3456
#define XB_SPIN_CAP (1u << 22)

__device__ __forceinline__ unsigned xb_ld(unsigned* p)              { return __hip_atomic_load(p, __ATOMIC_RELAXED, __HIP_MEMORY_SCOPE_AGENT); }
__device__ __forceinline__ unsigned xb_add(unsigned* p, unsigned v) { return __hip_atomic_fetch_add(p, v, __ATOMIC_RELAXED, __HIP_MEMORY_SCOPE_AGENT); }
__device__ __forceinline__ unsigned xb_xcc_id() { return (unsigned)__builtin_amdgcn_s_getreg((3 << 11) | 20) & 0xFu; }
#define XB_SPIN(cond, bar) do { unsigned _sp = 0; while (cond) { __builtin_amdgcn_s_sleep(1); \
    if ((++_sp & 255u) == 0u) { if (xb_ld(&(bar)[XB_TMO])) break; if (_sp > XB_SPIN_CAP) { atomicAdd(&(bar)[XB_TMO], 1u); break; } } } } while (0)

struct XcdBarrier { unsigned* bar; unsigned x; volatile LAS unsigned* st; };

__device__ __forceinline__ XcdBarrier xcd_barrier_post(unsigned* bar, volatile LAS unsigned* st) {
    XcdBarrier b; b.bar = bar; b.x = xb_xcc_id(); b.st = st;
    if (threadIdx.x == 0) (void)xb_add(&bar[XB_XCNT(b.x)], 1u);
    return b;
}
__device__ __forceinline__ void xcd_barrier_complete(unsigned* bar, unsigned x, unsigned& nloc, unsigned& nx) {
    const unsigned G = gridDim.x * gridDim.y * gridDim.z;
    unsigned sum, cnt, mine, sp = 0u;
    for (;;) {
        sum = 0u; cnt = 0u; mine = 0u;
#pragma unroll
        for (unsigned j = 0; j < 16; ++j) { const unsigned c = xb_ld(&bar[XB_XCNT(j)]); sum += c; cnt += (c > 0u) ? 1u : 0u; mine = (j == x) ? c : mine; }
        if (sum == G) break;
        __builtin_amdgcn_s_sleep(1);
        if ((++sp & 255u) == 0u) { if (xb_ld(&bar[XB_TMO])) break; if (sp > XB_SPIN_CAP) { atomicAdd(&bar[XB_TMO], 1u); break; } }
    }
    nloc = mine > 0u ? mine : 1u; nx = cnt > 0u ? cnt : 1u;
}
__device__ __forceinline__ void xcd_barrier(const XcdBarrier& b) {
    asm volatile("s_waitcnt vmcnt(0)" ::: "memory");
    __syncthreads();
    if (threadIdx.x == 0) {
        unsigned* bar = b.bar;
        __builtin_amdgcn_s_waitcnt(0);
        unsigned nloc = b.st[0], nx = b.st[1];
        if (nloc == 0u) { xcd_barrier_complete(bar, b.x, nloc, nx); b.st[0] = nloc; b.st[1] = nx; }
        const unsigned old = xb_add(&bar[XB_XSUB(b.x)], 1u);
        const unsigned gen = old / nloc;
        if (old + 1u == (gen + 1u) * nloc) {
            __builtin_amdgcn_fence(__ATOMIC_RELEASE, "agent");
            asm volatile("s_waitcnt vmcnt(0)" ::: "memory");
            const unsigned og = xb_add(&bar[XB_TOP], 1u);
            const unsigned tg = og / nx;
            if (og + 1u == (tg + 1u) * nx) xb_add(&bar[XB_TOPGEN], 1u);
            else XB_SPIN(xb_ld(&bar[XB_TOPGEN]) == tg, bar);
            __builtin_amdgcn_fence(__ATOMIC_ACQUIRE, "agent");
            xb_add(&bar[XB_XGEN(b.x)], 1u);
            asm volatile("s_waitcnt vmcnt(0)" ::: "memory");
        } else {
            XB_SPIN(xb_ld(&bar[XB_XGEN(b.x)]) == gen, bar);
            __builtin_amdgcn_fence(__ATOMIC_ACQUIRE, "agent");
            asm volatile("s_waitcnt vmcnt(0)" ::: "memory");
        }
    }
    __syncthreads();
}

__device__ __forceinline__ void sincos_2pi(double x, double& s, double& c) {
    const double q = __builtin_rint(x * 4.0);
    const double y = (x - q * 0.25) * 6.283185307179586476925;
    const double y2 = y * y;
    double sp = -7.6471637318198164759e-13; sp = sp * y2 + 1.6059043836821614599e-10; sp = sp * y2 - 2.5052108385441718775e-8; sp = sp * y2 + 2.7557319223985890653e-6;
    sp = sp * y2 - 1.9841269841269841270e-4; sp = sp * y2 + 8.3333333333333333333e-3; sp = sp * y2 - 1.6666666666666666667e-1; sp = sp * y2 * y + y;
    double cp = 4.7794773323873852974e-14; cp = cp * y2 - 1.1470745597729724714e-11; cp = cp * y2 + 2.0876756987868098979e-9; cp = cp * y2 - 2.7557319223985890653e-7;
    cp = cp * y2 + 2.4801587301587301587e-5; cp = cp * y2 - 1.3888888888888888889e-3; cp = cp * y2 + 4.1666666666666666667e-2; cp = cp * y2 - 0.5; cp = cp * y2 + 1.0;
    const int qi = ((int)q) & 3;
    s = (qi == 0) ? sp : (qi == 1) ? cp : (qi == 2) ? -sp : -cp;
    c = (qi == 0) ? cp : (qi == 1) ? -sp : (qi == 2) ? -cp : sp;
}
__device__ __forceinline__ void sincos_rad(double a, double& s, double& c) {
    double f = a * 0.15915494309189533576888; f -= __builtin_floor(f);
    if (f >= 1.0) f = 0.0;
    sincos_2pi(f, s, c);
}
__device__ __forceinline__ double exp_small(double x) {
    double r = 1.0 / 479001600.0;
    r = r * x + 1.0 / 39916800.0; r = r * x + 1.0 / 3628800.0; r = r * x + 1.0 / 362880.0; r = r * x + 1.0 / 40320.0; r = r * x + 1.0 / 5040.0;
    r = r * x + 1.0 / 720.0; r = r * x + 1.0 / 120.0; r = r * x + 1.0 / 24.0; r = r * x + 1.0 / 6.0; r = r * x + 0.5; r = r * x + 1.0; r = r * x + 1.0;
    return r;
}
__device__ __forceinline__ float fast_exp(float x) { return __builtin_amdgcn_exp2f(x * 1.4426950408889634f); }
__device__ __forceinline__ float sigmoidf_(float x) { return 1.0f / (1.0f + fast_exp(-x)); }
__device__ __forceinline__ float siluf_(float x) { return x * sigmoidf_(x); }
__device__ __forceinline__ float tanhf_(float x) { const float e = fast_exp(-2.0f * fabsf(x)); const float t = (1.0f - e) / (1.0f + e); return x < 0.f ? -t : t; }
__device__ __forceinline__ float gelu_tanh(float x) { return 0.5f * x * (1.0f + tanhf_(0.7978845608028654f * (x + 0.044715f * x * x * x))); }

struct Args { const float* in[43]; float* out; unsigned char* ws; int ph_lo, ph_hi; };

struct Frame {
    LAS unsigned char* lds; unsigned char* ws; int tid, lane, wave, bid, G, gw, NGW;
    const __attribute__((address_space(4))) unsigned long long* kin;
};
#define INP(i) ((const float*)F.kin[i])
#define WSP(T, off) ((T*)(F.ws + (off)))

__device__ __forceinline__ void tr_item(const float* W, int ldw, int N, bf16* WT, int ldt, int row_off, int rs16, LAS float* scr, int item, int lane) {
    const int nblk = N / 32, kb = item / nblk, nb = item % nblk, k0 = 64 * kb, n0 = 32 * nb;
#pragma unroll 8
    for (int i = 0; i < 32; ++i) { const int kk = 2 * i + (lane >> 5); scr[kk * 33 + (lane & 31)] = W[(size_t)(k0 + kk) * ldw + n0 + (lane & 31)]; }
    LDS_WAIT(); asm volatile("" ::: "memory");
    const int c = lane & 7;
#pragma unroll
    for (int j = 0; j < 4; ++j) { const int n = (lane >> 3) + 8 * j; const LAS float* s = scr + (8 * c) * 33 + n;
        v4u o; o.x = pk2(s[0 * 33], s[1 * 33]); o.y = pk2(s[2 * 33], s[3 * 33]); o.z = pk2(s[4 * 33], s[5 * 33]); o.w = pk2(s[6 * 33], s[7 * 33]);
        const int nn = n0 + n, drow = row_off + (nn >> 4) * rs16 + (nn & 15);
        *(v4u*)(WT + (size_t)drow * ldt + k0 + 8 * c) = o; }
    LDS_WAIT(); asm volatile("" ::: "memory");
}

__device__ __forceinline__ void hyfilt_item(Frame& F, int pb) {
    const float* w1 = INP(19); const float* b1 = INP(20); const float* fq = INP(21); const float* w2 = INP(22); const float* b2 = INP(23); const float* w3 = INP(24);
    LAS float* z = (LAS float*)F.lds;
    LAS float* h1 = z + 1088;
    LAS float* h2 = h1 + 2048;
    const int tid = F.tid;
    for (int idx = tid; idx < 32 * 33; idx += NTHREADS) {
        const int p = idx / 33, f = idx % 33, i = pb * 32 + p;
        float v;
        if (f == 0) v = (float)i * (1.0f / (float)(SEQ - 1));
        else { const int j = (f - 1) & 15; const float fj = 1e-4f + (float)j * ((15.0f - 1e-4f) / 15.0f);
            double fr = (double)fj * (double)i / (double)SEQ; fr -= __builtin_floor(fr); double s, c; sincos_2pi(fr, s, c); v = (f <= 16) ? (float)c : (float)(-s); }
        z[p * 33 + f] = v;
    }
    __syncthreads();
    for (int idx = tid; idx < 2048; idx += NTHREADS) {
        const int p = idx >> 6, j = idx & 63; float a = b1[j];
        for (int f = 0; f < 33; ++f) a += z[p * 33 + f] * w1[f * 64 + j];
        double s, c; sincos_rad((double)(fq[j] * a), s, c); h1[idx] = (float)s;
    }
    __syncthreads();
    for (int idx = tid; idx < 2048; idx += NTHREADS) {
        const int p = idx >> 6, j = idx & 63; float a = b2[j];
        for (int k = 0; k < 64; ++k) a += h1[p * 64 + k] * w2[k * 64 + j];
        double s, c; sincos_rad((double)(fq[64 + j] * a), s, c); h2[idx] = (float)s;
    }
    __syncthreads();
    float* kT = WSP(float, WS_KT); float* normp = WSP(float, WS_NORMP);
    for (int cc = 0; cc < 8; ++cc) {
        const int col = tid + NTHREADS * cc;
        float acc[32];
#pragma unroll
        for (int p = 0; p < 32; ++p) acc[p] = 0.f;
        for (int k = 0; k < 64; k += 4) {
            const float w0 = w3[(size_t)(k + 0) * 4096 + col], wA = w3[(size_t)(k + 1) * 4096 + col], wB = w3[(size_t)(k + 2) * 4096 + col], wC = w3[(size_t)(k + 3) * 4096 + col];
#pragma unroll
            for (int p = 0; p < 32; ++p) { const f32x4 hv = *(const LAS f32x4*)(h2 + p * 64 + k); acc[p] += hv.x * w0 + hv.y * wA + hv.z * wB + hv.w * wC; }
        }
        const int ch = col & 1023, dir = (col >> 10) & 1;
        const float adel = 3.0701134573253946f + (float)ch * ((15.350567286626972f - 3.0701134573253946f) / 1023.0f);
        float sabs = 0.f;
#pragma unroll
        for (int p = 0; p < 32; ++p) { const int i = pb * 32 + p; const float t = (float)i * (1.0f / (float)(SEQ - 1)); acc[p] *= fast_exp(-t * adel); if (!(dir == 1 && i == 0)) sabs += fabsf(acc[p]); }
        f32x4* dst = (f32x4*)(kT + (size_t)col * SEQ + pb * 32);
#pragma unroll
        for (int p = 0; p < 8; ++p) dst[p] = (f32x4){acc[4 * p], acc[4 * p + 1], acc[4 * p + 2], acc[4 * p + 3]};
        normp[(size_t)pb * 4096 + col] = sabs;
    }
    __syncthreads();
}

__device__ __forceinline__ void p0_prologue(Frame& F) {
    for (int pb = F.bid; pb < SEQ / 32; pb += F.G) hyfilt_item(F, pb);
    const int gt = F.bid * NTHREADS + F.tid, NGT = F.G * NTHREADS;
    {
        f32x2* rope = WSP(f32x2, WS_ROPE);
        for (int idx = gt; idx < 128 * 16; idx += NGT) { const int pos = idx >> 4, i = idx & 15;
            double inv = (i & 3) == 0 ? 1.0 : (i & 3) == 1 ? 0.56234132519034908 : (i & 3) == 2 ? 0.31622776601683794 : 0.17782794100389228;
            inv *= (i >> 2) == 0 ? 1.0 : (i >> 2) == 1 ? 0.1 : (i >> 2) == 2 ? 0.01 : 0.001;
            const float ang = (float)pos * (float)inv; double s, c; sincos_rad((double)ang, s, c); rope[idx] = (f32x2){(float)c, (float)s}; }
    }
    {
        f32x2* tw = WSP(f32x2, WS_TW);
        for (int idx = gt; idx < 16384; idx += NGT) { double s, c; sincos_2pi((double)idx * (1.0 / 16384.0), s, c); tw[idx] = (f32x2){(float)c, (float)(-s)}; }
    }
    {
        const float* are = INP(26); const float* aim = INP(27); const float* ldt = INP(28); const float* bre = INP(29); const float* bim = INP(30);
        f32x2* lamb = WSP(f32x2, WS_S5LAM); f32x2* bb = WSP(f32x2, WS_S5B);
        for (int idx = gt; idx < 2 * 64 * 64; idx += NGT) { const int dg = idx >> 6;
            const float dt = expf(ldt[dg]); const float ar = are[idx], ai = aim[idx];
            const float zr = ar * dt, zi = ai * dt; double s, c; sincos_rad((double)zi, s, c); const double er = exp_small((double)zr);
            const double lr = er * c, li = er * s; lamb[idx] = (f32x2){(float)lr, (float)li};
            const double nr = lr - 1.0, ni = li, den = (double)ar * ar + (double)ai * ai; const double qr = (nr * ar + ni * ai) / den, qi = (ni * ar - nr * ai) / den;
            for (int cc = 0; cc < 16; ++cc) { const double br = bre[(size_t)idx * 16 + cc], bi = bim[(size_t)idx * 16 + cc]; bb[(size_t)idx * 16 + cc] = (f32x2){(float)(qr * br - qi * bi), (float)(qr * bi + qi * br)}; } }
    }
    {
        float* wrt = WSP(float, WS_WRT);
        for (int idx = gt; idx < 2 * 72 * 2048; idx += NGT) { const int l = idx / (72 * 2048), r = idx % (72 * 2048), n = r / 2048, k = r % 2048;
            wrt[idx] = n < 8 ? INP(36)[((size_t)l * 2048 + k) * 8 + n] : INP(38)[((size_t)l * 2048 + k) * 64 + (n - 8)]; }
    }
    {
        bf16* ha = WSP(bf16, WS_HA);
        for (int idx = gt; idx < 2048; idx += NGT) ha[(size_t)TT * 2048 + idx] = 0;
    }
    LAS float* scr = (LAS float*)(F.lds + F.wave * 16384);
    {
        const float* c = INP(1); const float* cctx = INP(3); const float* adaw = INP(4); float* part = WSP(float, WS_ADAP);
        for (int it = F.gw; it < 2 * 32 * 48; it += F.NGW) {
            const int l = it / (32 * 48), r = it % (32 * 48), ks = r / 48, jb = r % 48, k0 = ks * 64, j0 = jb * 256 + F.lane * 4;
            const float c0 = c[k0 + F.lane], c1 = c[2048 + k0 + F.lane], c2 = cctx[k0 + F.lane];
            const float s0 = c0 / (1.0f + expf(-c0)), s1 = c1 / (1.0f + expf(-c1)), s2 = c2 / (1.0f + expf(-c2));
            f32x4 a0 = {0.f, 0.f, 0.f, 0.f}, a1 = a0, a2 = a0;
            const float* wp = adaw + ((size_t)l * 2048 + k0) * 12288 + j0;
#pragma unroll 8
            for (int kk = 0; kk < 64; ++kk) { const f32x4 w = *(const f32x4*)(wp + (size_t)kk * 12288);
                const float t0 = __builtin_bit_cast(float, __builtin_amdgcn_readlane(__builtin_bit_cast(int, s0), kk));
                const float t1 = __builtin_bit_cast(float, __builtin_amdgcn_readlane(__builtin_bit_cast(int, s1), kk));
                const float t2 = __builtin_bit_cast(float, __builtin_amdgcn_readlane(__builtin_bit_cast(int, s2), kk));
                a0 += w * t0; a1 += w * t1; a2 += w * t2; }
            float* pp = part + ((size_t)(l * 32 + ks) * 3) * 12288 + j0;
            *(f32x4*)(pp) = a0; *(f32x4*)(pp + 12288) = a1; *(f32x4*)(pp + 2 * 12288) = a2;
        }
    }
    {
        constexpr int I0 = 2048, I1 = 1024, I2 = 1024, I3 = 2048, I4 = 4096, I5 = 2048, I6 = 128, I7 = 512, IE = 1536;
        constexpr int NSMALL = I0 + I1 + I2 + I3 + I4 + I5 + I6 + I7;
        const int NITEMS = NSMALL + 128 * IE;
        for (int it = F.gw; it < NITEMS; it += F.NGW) {
            int r = it;
            if (r < I0) { tr_item(INP(9), 4096, 2048, WSP(bf16, WS_WIN0), 2048, 0, 16, scr, r, F.lane); continue; } r -= I0;
            if (r < I1) { tr_item(INP(9) + 2048, 4096, 1024, WSP(bf16, WS_WIN0), 2048, 3072, 16, scr, r, F.lane); continue; } r -= I1;
            if (r < I2) { tr_item(INP(9) + 3072, 4096, 1024, WSP(bf16, WS_WIN0), 2048, 2048, 16, scr, r, F.lane); continue; } r -= I2;
            if (r < I3) { tr_item(INP(10), 2048, 2048, WSP(bf16, WS_WOUT0), 2048, 0, 16, scr, r, F.lane); continue; } r -= I3;
            if (r < I4) { tr_item(INP(15), 4096, 4096, WSP(bf16, WS_WIN1), 2048, 0, 16, scr, r, F.lane); continue; } r -= I4;
            if (r < I5) { tr_item(INP(16), 2048, 2048, WSP(bf16, WS_WOUT1), 2048, 0, 16, scr, r, F.lane); continue; } r -= I5;
            if (r < I6) { const int g = r / 32; tr_item(INP(13) + (size_t)g * 65536, 256, 256, WSP(bf16, WS_WPOOL), 256, g * 256, 16, scr, r % 32, F.lane); continue; } r -= I6;
            if (r < I7) { tr_item(INP(34), 1024, 1024, WSP(bf16, WS_WGLU), 1024, 0, 16, scr, r, F.lane); continue; } r -= I7;
            const int le = r / IE, q = r % IE;
            bf16* wc = (bf16*)(F.ws + WS_WMOE + (size_t)le * MOE_E_BYTES); bf16* w2t = wc + 1024 * 2048;
            if (q < 512) tr_item(INP(40) + (size_t)le * (2048 * 512), 512, 512, wc, 2048, 0, 32, scr, q, F.lane);
            else if (q < 1024) tr_item(INP(41) + (size_t)le * (2048 * 512), 512, 512, wc, 2048, 16, 32, scr, q - 512, F.lane);
            else tr_item(INP(42) + (size_t)le * (512 * 2048), 2048, 2048, w2t, 512, 0, 16, scr, q - 1024, F.lane);
        }
    }
}

__device__ __forceinline__ void p1_reduce(Frame& F) {
    const int gt = F.bid * NTHREADS + F.tid, NGT = F.G * NTHREADS;
    const float* part = WSP(float, WS_ADAP); float* mod = WSP(float, WS_MOD); const float* adab = INP(5);
    for (int idx = gt; idx < 2 * 3 * 12288; idx += NGT) { const int l = idx / (3 * 12288), r = idx % (3 * 12288), m = r / 12288, j = r % 12288;
        float a = adab[l * 12288 + j];
        for (int ks = 0; ks < 32; ++ks) a += part[((size_t)(l * 32 + ks) * 3 + m) * 12288 + j];
        mod[idx] = a; }
    const float* normp = WSP(float, WS_NORMP); float* invn = WSP(float, WS_INVN);
    for (int idx = gt; idx < 2048; idx += NGT) { const int o = idx >> 10, ch = idx & 1023; float a = 0.f;
        for (int pb = 0; pb < 256; ++pb) a += normp[(size_t)pb * 4096 + o * 2048 + ch] + normp[(size_t)pb * 4096 + o * 2048 + 1024 + ch];
        invn[idx] = 1.0f / a; }
}

__device__ __forceinline__ const float* modp(Frame& F, int l, int m, int c) { return WSP(float, WS_MOD) + ((size_t)(l * 3 + m) * 6 + c) * 2048; }
__device__ __forceinline__ int row_stream(int r) { return r < TL ? r / SEQ : 2; }

template <int MODE>
__device__ __forceinline__ void norm_phase(Frame& F, int l, float* dout) {
    const int nrows = (MODE == 3 || (MODE == 1 && l == 1)) ? TL : TT;
    float* xbuf = WSP(float, WS_X); bf16* ha = WSP(bf16, WS_HA); const bf16* Y = WSP(bf16, WS_Y);
    const float* gvec = (MODE == 0) ? INP(6) : (MODE == 1) ? INP(7) + l * 2048 : (MODE == 2) ? INP(6) + 2048 : INP(8);
    const int lane = F.lane;
    for (int r = F.gw; r < nrows; r += F.NGW) {
        const int m = row_stream(r);
        const float* src = (MODE == 0) ? (r < TL ? INP(0) + (size_t)r * 2048 : INP(2) + (size_t)(r - TL) * 2048) : xbuf + (size_t)r * 2048;
        f32x4 v[8]; float ss = 0.f;
#pragma unroll
        for (int j = 0; j < 8; ++j) v[j] = *(const f32x4*)(src + 4 * lane + 256 * j);
        if (MODE == 2 || MODE == 3) {
            const float* g2 = modp(F, MODE == 2 ? 0 : 1, m, 5);
            const bf16* y0 = Y + (size_t)(2 * r) * 2048; const bf16* y1 = y0 + 2048;
#pragma unroll
            for (int j = 0; j < 8; ++j) { const int c = 4 * lane + 256 * j; const v2u a = *(const v2u*)(y0 + c), b = *(const v2u*)(y1 + c); const f32x4 gg = *(const f32x4*)(g2 + c);
                v[j].x += gg.x * (bflo(a.x) + bflo(b.x)); v[j].y += gg.y * (bfhi(a.x) + bfhi(b.x)); v[j].z += gg.z * (bflo(a.y) + bflo(b.y)); v[j].w += gg.w * (bfhi(a.y) + bfhi(b.y)); }
            if (MODE == 2) {
#pragma unroll
                for (int j = 0; j < 8; ++j) *(f32x4*)(xbuf + (size_t)r * 2048 + 4 * lane + 256 * j) = v[j];
            }
        }
#pragma unroll
        for (int j = 0; j < 8; ++j) ss += (v[j].x * v[j].x + v[j].y * v[j].y) + (v[j].z * v[j].z + v[j].w * v[j].w);
        ss = wave_sum(ss);
        const float rs = 1.0f / sqrtf(ss * (1.0f / 2048.0f) + EPS);
        if (MODE == 3) {
#pragma unroll
            for (int j = 0; j < 8; ++j) { const int c = 4 * lane + 256 * j; const f32x4 gg = *(const f32x4*)(gvec + c); *(f32x4*)(dout + (size_t)r * 2048 + c) = v[j] * rs * gg; }
            continue;
        }
        const int lm = (MODE == 2) ? 1 : l;
        const float* sh = modp(F, lm, m, MODE == 1 ? 3 : 0); const float* sc = modp(F, lm, m, MODE == 1 ? 4 : 1);
#pragma unroll
        for (int j = 0; j < 8; ++j) { const int c = 4 * lane + 256 * j; const f32x4 gg = *(const f32x4*)(gvec + c), s1 = *(const f32x4*)(sc + c), s0 = *(const f32x4*)(sh + c);
            v[j] = (v[j] * rs * gg) * (1.0f + s1) + s0;
            v2u o; o.x = pk2(v[j].x, v[j].y); o.y = pk2(v[j].z, v[j].w); *(v2u*)(ha + (size_t)r * 2048 + c) = o; }
        if (MODE == 1) {
            const float* wrt = WSP(float, WS_WRT) + (size_t)l * 72 * 2048;
            float lgG = 0.f, lgE = 0.f;
#pragma nounroll
            for (int n = 0; n < 72; ++n) { const float* wn = wrt + (size_t)n * 2048; float a = 0.f;
#pragma unroll
                for (int j = 0; j < 8; ++j) { const f32x4 w = *(const f32x4*)(wn + 4 * lane + 256 * j); a += (v[j].x * w.x + v[j].y * w.y) + (v[j].z * w.z + v[j].w * w.w); }
                a = wave_sum(a);
                if (n < 8) { if (lane == n) lgG = a; } else { if (lane == n - 8) lgE = a; } }
            if (lane < 8) lgG += INP(37)[l * 8 + lane];
            lgE += INP(39)[l * 64 + lane];
            float gl[8]; float gmax = -INFINITY; int gi = 0;
#pragma unroll
            for (int j = 0; j < 8; ++j) { gl[j] = __shfl(lgG, j); if (gl[j] > gmax) { gmax = gl[j]; gi = j; } }
            float gsum = 0.f;
#pragma unroll
            for (int j = 0; j < 8; ++j) gsum += expf(gl[j] - gmax);
            const float pg_top = 1.0f / gsum;
            float el[8]; float emax = -INFINITY;
#pragma unroll
            for (int j = 0; j < 8; ++j) { el[j] = __shfl(lgE, gi * 8 + j); emax = fmaxf(emax, el[j]); }
            float esum = 0.f; float pe[8];
#pragma unroll
            for (int j = 0; j < 8; ++j) { pe[j] = expf(el[j] - emax); esum += pe[j]; }
            int e1 = 0; float p1 = -1.f;
#pragma unroll
            for (int j = 0; j < 8; ++j) { pe[j] /= esum; if (pe[j] > p1) { p1 = pe[j]; e1 = j; } }
            int e2 = 0; float p2 = -1.f;
#pragma unroll
            for (int j = 0; j < 8; ++j) { if (j != e1 && pe[j] > p2) { p2 = pe[j]; e2 = j; } }
            const float den = p1 + p2; const float g1 = pg_top * p1 / den, g2 = pg_top * p2 / den;
            if (lane == 0) {
                unsigned* cnt = WSP(unsigned, WS_CTL) + CW_CNT + l * 64; int* tokl = WSP(int, WS_TOKL); float* gatel = WSP(float, WS_GATEL);
                const int ex1 = gi * 8 + e1, ex2 = gi * 8 + e2;
                const unsigned k1 = atomicAdd(cnt + ex1, 1u); tokl[(size_t)ex1 * LISTCAP + k1] = 2 * r; gatel[(size_t)ex1 * LISTCAP + k1] = g1;
                const unsigned k2 = atomicAdd(cnt + ex2, 1u); tokl[(size_t)ex2 * LISTCAP + k2] = 2 * r + 1; gatel[(size_t)ex2 * LISTCAP + k2] = g2;
            }
        }
    }
}

#define EPI_ARGS const f32x4 (&acc)[2][2][4][2], const pg8::Unit& u, int wr, int wc, int fr, int fq
__device__ __forceinline__ void st_bf4(bf16* p, f32x4 v) { v2u o; o.x = cvt_pk_bf16(v.x, v.y); o.y = cvt_pk_bf16(v.z, v.w); *(v2u*)p = o; }

struct EpiQKP {
    bf16* Q; bf16* Kb; bf16* P; const f32x2* rope;
    __device__ __forceinline__ void operator()(EPI_ARGS) const {
        const int sect = u.pn >> 2, cb = (u.pn & 3) * 256; const bool latent = u.pm < TL / 256;
#pragma unroll
        for (int ai = 0; ai < 2; ++ai)
#pragma unroll
            for (int m = 0; m < 4; ++m) {
                const int r = u.pm * 256 + ai * 128 + wr * 64 + m * 16 + fr;
                int b, t; if (latent) { b = r / SEQ; t = r % SEQ; } else { b = (r - TL) / CTX; t = (r - TL) % CTX; }
                f32x4 cs0 = {1.f, 0.f, 1.f, 0.f}, cs1 = cs0;
                if (latent && sect < 2) { const int pos = (wc & 1) ? (t & 63) : (t >> 6); const f32x4* rp = (const f32x4*)(rope + pos * 16 + 4 * fq); cs0 = rp[0]; cs1 = rp[1]; }
#pragma unroll
                for (int bj = 0; bj < 2; ++bj) {
                    const int c0 = cb + bj * 128 + wc * 32 + 4 * fq;
                    f32x4 a = acc[ai][bj][m][0], bb = acc[ai][bj][m][1];
                    if (sect < 2) {
                        const f32x4 co = {cs0.x, cs0.z, cs1.x, cs1.z}, si = {cs0.y, cs0.w, cs1.y, cs1.w};
                        const f32x4 oa = a * co - bb * si, ob = a * si + bb * co; a = oa; bb = ob;
                    }
                    if (sect == 0) { a = a * QSCALE; bb = bb * QSCALE; bf16* d = Q + (size_t)r * 1024 + c0; st_bf4(d, a); st_bf4(d + 16, bb); }
                    else if (sect == 1) { const size_t kr = (size_t)b * KEYS + (latent ? CTX + t : t); bf16* d = Kb + kr * 1024 + c0; st_bf4(d, a); st_bf4(d + 16, bb); }
                    else { bf16* d = P + (size_t)r * 1024 + c0; st_bf4(d, a); st_bf4(d + 16, bb); }
                }
            }
    }
};
struct EpiVT {
    bf16* VT;
    __device__ __forceinline__ void operator()(EPI_ARGS) const {
        const bool latent = u.pn < TL / 256; const int b = latent ? u.pn / 32 : u.pn - TL / 256; const int key_t0 = latent ? CTX + (u.pn % 32) * 256 : 0;
        const int kperm = 8 * (fq & 1) + 4 * (fq >> 1);
#pragma unroll
        for (int ai = 0; ai < 2; ++ai)
#pragma unroll
            for (int m = 0; m < 4; ++m) {
                const int rr = u.pm * 256 + ai * 128 + wr * 64 + m * 16 + fr;
                bf16* rowp = VT + ((size_t)b * 1024 + rr) * KEYS + key_t0;
#pragma unroll
                for (int bj = 0; bj < 2; ++bj)
#pragma unroll
                    for (int n = 0; n < 2; ++n) st_bf4(rowp + bj * 128 + wc * 32 + 16 * n + kperm, acc[ai][bj][m][n]);
            }
    }
};
struct EpiScaleBf16 {
    bf16* O; int ldo, coff; const float* cscale;
    __device__ __forceinline__ void operator()(EPI_ARGS) const {
#pragma unroll
        for (int bj = 0; bj < 2; ++bj)
#pragma unroll
            for (int n = 0; n < 2; ++n) { const int c = u.pn * 256 + bj * 128 + wc * 32 + 16 * n + 4 * fq; const f32x4 sc = *(const f32x4*)(cscale + c);
#pragma unroll
                for (int ai = 0; ai < 2; ++ai)
#pragma unroll
                    for (int m = 0; m < 4; ++m) { const int r = u.pm * 256 + ai * 128 + wr * 64 + m * 16 + fr; st_bf4(O + (size_t)r * ldo + coff + c, acc[ai][bj][m][n] * sc); } }
    }
};
struct EpiBf16 {
    bf16* O; int ldo;
    __device__ __forceinline__ void operator()(EPI_ARGS) const {
#pragma unroll
        for (int ai = 0; ai < 2; ++ai)
#pragma unroll
            for (int m = 0; m < 4; ++m) { const int r = u.pm * 256 + ai * 128 + wr * 64 + m * 16 + fr; bf16* rowp = O + (size_t)r * ldo + u.pn * 256 + wc * 32 + 4 * fq;
#pragma unroll
                for (int bj = 0; bj < 2; ++bj)
#pragma unroll
                    for (int n = 0; n < 2; ++n) st_bf4(rowp + bj * 128 + 16 * n, acc[ai][bj][m][n]); }
    }
};
struct EpiRes {
    const float* xlat; const float* xctx; float* xout; const float* gate0;
    __device__ __forceinline__ void operator()(EPI_ARGS) const {
        const bool latent = u.pm < TL / 256;
#pragma unroll
        for (int ai = 0; ai < 2; ++ai)
#pragma unroll
            for (int m = 0; m < 4; ++m) { const int r = u.pm * 256 + ai * 128 + wr * 64 + m * 16 + fr; const int ms = latent ? r / SEQ : 2;
                const float* xi = latent ? xlat + (size_t)r * 2048 : xctx + (size_t)(r - TL) * 2048; const float* gp = gate0 + (size_t)ms * 12288;
#pragma unroll
                for (int bj = 0; bj < 2; ++bj)
#pragma unroll
                    for (int n = 0; n < 2; ++n) { const int c = u.pn * 256 + bj * 128 + wc * 32 + 16 * n + 4 * fq;
                        const f32x4 xv = *(const f32x4*)(xi + c), gv = *(const f32x4*)(gp + c); *(f32x4*)(xout + (size_t)r * 2048 + c) = xv + gv * acc[ai][bj][m][n]; } }
    }
};
struct EpiMoeUp {
    bf16* H;
    __device__ __forceinline__ void operator()(EPI_ARGS) const {
#pragma unroll
        for (int ai = 0; ai < 2; ++ai)
#pragma unroll
            for (int m = 0; m < 4; ++m) { const size_t r = (size_t)u.pm * 256 + ai * 128 + wr * 64 + m * 16 + fr;
#pragma unroll
                for (int bj = 0; bj < 2; ++bj) { const int hc = (u.pn * 256 + bj * 128 + wc * 32) / 2 + 4 * fq; const f32x4 a = acc[ai][bj][m][0], b = acc[ai][bj][m][1];
                    const f32x4 h = {siluf_(a.x) * b.x, siluf_(a.y) * b.y, siluf_(a.z) * b.z, siluf_(a.w) * b.w}; st_bf4(H + r * 512 + hc, h); } }
    }
};
struct EpiMoeDown {
    bf16* Y; const int* tokl; const float* gatel; const unsigned* cnt;
    __device__ __forceinline__ void operator()(EPI_ARGS) const {
        const int ce = (int)cnt[u.e];
#pragma unroll
        for (int ai = 0; ai < 2; ++ai)
#pragma unroll
            for (int m = 0; m < 4; ++m) { const int idx = u.idx0 + ai * 128 + wr * 64 + m * 16 + fr;
                if (idx < ce) { const int pair = tokl[(size_t)u.e * LISTCAP + idx]; const float gt = gatel[(size_t)u.e * LISTCAP + idx]; bf16* rowp = Y + (size_t)pair * 2048 + u.pn * 256 + wc * 32 + 4 * fq;
#pragma unroll
                    for (int bj = 0; bj < 2; ++bj)
#pragma unroll
                        for (int n = 0; n < 2; ++n) st_bf4(rowp + bj * 128 + 16 * n, acc[ai][bj][m][n] * gt); } }
    }
};
struct EpiGlu {
    bf16* O; int ldo, coff; const bf16* Gb; const float* bias;
    __device__ __forceinline__ void operator()(EPI_ARGS) const {
#pragma unroll
        for (int ai = 0; ai < 2; ++ai)
#pragma unroll
            for (int m = 0; m < 4; ++m) { const int r = u.pm * 256 + ai * 128 + wr * 64 + m * 16 + fr;
#pragma unroll
                for (int bj = 0; bj < 2; ++bj)
#pragma unroll
                    for (int n = 0; n < 2; ++n) { const int c = u.pn * 256 + bj * 128 + wc * 32 + 16 * n + 4 * fq; const f32x4 bv = *(const f32x4*)(bias + c); const v2u gw = *(const v2u*)(Gb + (size_t)r * 1024 + c);
                        const f32x4 a = acc[ai][bj][m][n] + bv; const f32x4 o = {bflo(gw.x) * sigmoidf_(a.x), bfhi(gw.x) * sigmoidf_(a.y), bflo(gw.y) * sigmoidf_(a.z), bfhi(gw.y) * sigmoidf_(a.w)};
                        st_bf4(O + (size_t)r * ldo + coff + c, o); } }
    }
};

struct MoeOrder {
    const LAS int* bstart;
    const unsigned* cnt; const int* tokl; int nN, G, c, nblk; long bstride, eoff; bool up;
    __device__ bool next(int i, pg8::Unit& u) const {
        const long Lx = (long)i * G + c; if (Lx >= (long)nblk * nN) return false;
        const int blk = (int)(Lx / nN); u.pn = (int)(Lx % nN); u.pm = blk;
        const int e = bstart[65 + blk];
        u.e = e; u.idx0 = (blk - bstart[e]) * 256;
        u.aoff = up ? 0 : (long)blk * 256 * 512 * 2;
        u.boff = (long)e * (long)MOE_E_BYTES + eoff + (long)u.pn * bstride;
        return true;
    }
    __device__ int arow(const pg8::Unit& u, int row) const { const int idx = u.idx0 + row; return idx < (int)cnt[u.e] ? (tokl[(size_t)u.e * LISTCAP + idx] >> 1) : TT; }
};

__device__ __forceinline__ void attn_phase(Frame& F) {
    const bf16* Q = WSP(bf16, WS_Q); const bf16* Kb = WSP(bf16, WS_K); const bf16* VT = WSP(bf16, WS_VT); bf16* cat = WSP(bf16, WS_CAT);
    LAS unsigned char* lds = F.lds;
    const int tid = F.tid, lane = F.lane, w = F.wave, sub = w & 1, qw = w >> 1, r32 = lane & 31, hi = lane >> 5;
    float lam;
    { const float* lv = INP(11); float a = lv[lane] * lv[64 + lane], b = lv[128 + lane] * lv[192 + lane]; a = wave_sum(a); b = wave_sum(b); lam = expf(a) - expf(b) + 0.2f; }
    const float* subg = INP(12);
    const int NU = 1024 + 32;
    const int xcd = F.bid & 7, jcu = F.bid >> 3;
    for (int it = 0;; ++it) {
        int uidx;
        if (F.G == 256) { if (it < 4) uidx = 128 * xcd + it * 32 + jcu; else if (it == 4 && F.bid < 32) uidx = 1024 + F.bid; else break; }
        else { uidx = it * F.G + F.bid; if (uidx >= NU) break; }
        int b, head, q0row, nt; size_t kbase;
        if (uidx < 1024) { const int combo = uidx >> 6, qb = uidx & 63; b = combo >> 3; head = combo & 7; q0row = b * SEQ + qb * 128; nt = KEYS / 64; }
        else { const int v = uidx - 1024; b = v >> 4; head = (v >> 1) & 7; q0row = TL + b * CTX + (v & 1) * 128; nt = CTX / 64; }
        kbase = (size_t)b * KEYS;
        bf16x8 qf[4];
        { const bf16* qp = Q + (size_t)(q0row + qw * 32 + r32) * 1024 + head * 128 + sub * 64 + hi * 8;
#pragma unroll
          for (int ks = 0; ks < 4; ++ks) qf[ks] = *(const bf16x8*)(qp + ks * 16); }
        const int srow = tid >> 3, sch = tid & 7;
        const bf16* gk0 = Kb + (kbase + srow) * 1024 + head * 128 + sch * 8;
        const bf16* gv0 = VT + ((size_t)(b * 8 + head) * 128 + srow) * KEYS + sch * 8;
        const int lk = srow * 128 + ((sch ^ ((srow >> 1) & 7)) * 16);
        v4u st0, st1, st2, st3;
#define ATT_LOAD(t) do { st0 = *(const v4u*)(gk0 + (size_t)(t) * 65536); st1 = *(const v4u*)(gk0 + (size_t)(t) * 65536 + 64); st2 = *(const v4u*)(gv0 + (t) * 64); st3 = *(const v4u*)(gv0 + (size_t)64 * KEYS + (t) * 64); } while (0)
#define ATT_STORE(buf) do { LAS unsigned char* bp = lds + (buf) * 32768; *(LAS v4u*)(bp + lk) = st0; *(LAS v4u*)(bp + 8192 + lk) = st1; *(LAS v4u*)(bp + 16384 + lk) = st2; *(LAS v4u*)(bp + 16384 + 8192 + lk) = st3; } while (0)
        ATT_LOAD(0); ATT_STORE(0);
        __syncthreads();
        f32x16 o[4];
#pragma unroll
        for (int d = 0; d < 4; ++d)
#pragma unroll
            for (int r = 0; r < 16; ++r) o[d][r] = 0.f;
        float mrow = -INFINITY, lrow = 0.f;
        const int rdoff = r32 * 128;
        const int swz = (r32 >> 1) & 7;
        for (int t = 0; t < nt; ++t) {
            if (t + 1 < nt) ATT_LOAD(t + 1);
            const LAS unsigned char* bp = lds + (t & 1) * 32768;
            const LAS unsigned char* kp = bp + sub * 8192;
            f32x16 s0, s1;
#pragma unroll
            for (int r = 0; r < 16; ++r) { s0[r] = 0.f; s1[r] = 0.f; }
#pragma unroll
            for (int ks = 0; ks < 4; ++ks) {
                const int ch = ((2 * ks + hi) ^ swz) * 16;
                const bf16x8 k0 = *(const LAS bf16x8*)(kp + rdoff + ch);
                const bf16x8 k1 = *(const LAS bf16x8*)(kp + 4096 + rdoff + ch);
                s0 = __builtin_amdgcn_mfma_f32_32x32x16_bf16(k0, qf[ks], s0, 0, 0, 0);
                s1 = __builtin_amdgcn_mfma_f32_32x32x16_bf16(k1, qf[ks], s1, 0, 0, 0);
            }
            float mx = s0[0];
#pragma unroll
            for (int r = 1; r < 16; ++r) mx = fmaxf(mx, s0[r]);
#pragma unroll
            for (int r = 0; r < 16; ++r) mx = fmaxf(mx, s1[r]);
            mx = fmaxf(mx, __shfl_xor(mx, 32));
            const float mnew = fmaxf(mrow, mx);
            const float alpha = __builtin_amdgcn_exp2f(mrow - mnew);
            mrow = mnew;
            float rs = 0.f;
#pragma unroll
            for (int r = 0; r < 16; ++r) { s0[r] = __builtin_amdgcn_exp2f(s0[r] - mnew); rs += s0[r]; }
#pragma unroll
            for (int r = 0; r < 16; ++r) { s1[r] = __builtin_amdgcn_exp2f(s1[r] - mnew); rs += s1[r]; }
            lrow = lrow * alpha + rs;
            if (__any(alpha != 1.0f)) {
#pragma unroll
                for (int d = 0; d < 4; ++d)
#pragma unroll
                    for (int r = 0; r < 16; ++r) o[d][r] *= alpha;
            }
            bf16x8 pf[4];
#pragma unroll
            for (int s = 0; s < 4; ++s) { v4u pw;
                if (s < 2) { pw.x = cvt_pk_bf16(s0[8 * s + 0], s0[8 * s + 1]); pw.y = cvt_pk_bf16(s0[8 * s + 2], s0[8 * s + 3]); pw.z = cvt_pk_bf16(s0[8 * s + 4], s0[8 * s + 5]); pw.w = cvt_pk_bf16(s0[8 * s + 6], s0[8 * s + 7]); }
                else { const int q = s - 2; pw.x = cvt_pk_bf16(s1[8 * q + 0], s1[8 * q + 1]); pw.y = cvt_pk_bf16(s1[8 * q + 2], s1[8 * q + 3]); pw.z = cvt_pk_bf16(s1[8 * q + 4], s1[8 * q + 5]); pw.w = cvt_pk_bf16(s1[8 * q + 6], s1[8 * q + 7]); }
                pf[s] = __builtin_bit_cast(bf16x8, pw); }
            const LAS unsigned char* vp = bp + 16384;
#pragma unroll
            for (int d = 0; d < 4; ++d)
#pragma unroll
                for (int s = 0; s < 4; ++s) {
                    const bf16x8 vf = *(const LAS bf16x8*)(vp + d * 4096 + rdoff + (((2 * s + hi) ^ swz) * 16));
                    o[d] = __builtin_amdgcn_mfma_f32_32x32x16_bf16(vf, pf[s], o[d], 0, 0, 0);
                }
            if (t + 1 < nt) ATT_STORE((t + 1) & 1);
            __syncthreads();
        }
#undef ATT_LOAD
#undef ATT_STORE
        const float ltot = lrow + __shfl_xor(lrow, 32); const float linv = 1.0f / ltot;
        LAS float* xch = (LAS float*)lds + (size_t)(qw * 32 + r32) * 132;
        if (sub == 1) {
#pragma unroll
            for (int d = 0; d < 4; ++d)
#pragma unroll
                for (int g = 0; g < 4; ++g) *(LAS f32x4*)(xch + 32 * d + 8 * g + 4 * hi) = (f32x4){o[d][4 * g] * linv, o[d][4 * g + 1] * linv, o[d][4 * g + 2] * linv, o[d][4 * g + 3] * linv};
        }
        __syncthreads();
        if (sub == 0) {
            float ss = 0.f;
#pragma unroll
            for (int d = 0; d < 4; ++d)
#pragma unroll
                for (int g = 0; g < 4; ++g) { const f32x4 o2 = *(const LAS f32x4*)(xch + 32 * d + 8 * g + 4 * hi);
#pragma unroll
                    for (int j = 0; j < 4; ++j) { const float v = o[d][4 * g + j] * linv - lam * o2[j]; o[d][4 * g + j] = v; ss += v * v; } }
            ss += __shfl_xor(ss, 32);
            const float rn = 0.8f / sqrtf(ss * (1.0f / 128.0f) + EPS);
            bf16* op = cat + (size_t)(q0row + qw * 32 + r32) * 2048 + head * 128;
#pragma unroll
            for (int d = 0; d < 4; ++d)
#pragma unroll
                for (int g = 0; g < 4; ++g) { const int dv = 32 * d + 8 * g + 4 * hi; const f32x4 gg = *(const f32x4*)(subg + dv);
                    st_bf4(op + dv, (f32x4){o[d][4 * g] * rn * gg.x, o[d][4 * g + 1] * rn * gg.y, o[d][4 * g + 2] * rn * gg.z, o[d][4 * g + 3] * rn * gg.w}); }
        }
        __syncthreads();
    }
}

__device__ __forceinline__ void poold_phase(Frame& F) {
    const bf16* P = WSP(bf16, WS_P); bf16* PD = WSP(bf16, WS_PD);
    const int gt = F.bid * NTHREADS + F.tid, NGT = F.G * NTHREADS;
    for (int idx = gt; idx < TT * 128; idx += NGT) {
        const int r = idx >> 7, cc = (idx & 127) * 8, g = cc >> 8, wdw = 2 << g;
        int sb, t, Ls; if (r < TL) { sb = (r / SEQ) * SEQ; t = r % SEQ; Ls = SEQ; } else { sb = TL + ((r - TL) / CTX) * CTX; t = (r - TL) % CTX; Ls = CTX; }
        int lo = t - wdw / 2, hi = lo + wdw; lo = lo < 0 ? 0 : lo; hi = hi > Ls ? Ls : hi;
        float a[8];
#pragma unroll
        for (int j = 0; j < 8; ++j) a[j] = 0.f;
        for (int s = lo; s < hi; ++s) { const v4u v = *(const v4u*)(P + (size_t)(sb + s) * 1024 + cc);
            a[0] += bflo(v.x); a[1] += bfhi(v.x); a[2] += bflo(v.y); a[3] += bfhi(v.y); a[4] += bflo(v.z); a[5] += bfhi(v.z); a[6] += bflo(v.w); a[7] += bfhi(v.w); }
        const float inv = 1.0f / (float)(hi - lo);
        const v4u me = *(const v4u*)(P + (size_t)r * 1024 + cc);
        v4u o; o.x = pk2(a[0] * inv - bflo(me.x), a[1] * inv - bfhi(me.x)); o.y = pk2(a[2] * inv - bflo(me.y), a[3] * inv - bfhi(me.y));
        o.z = pk2(a[4] * inv - bflo(me.z), a[5] * inv - bfhi(me.z)); o.w = pk2(a[6] * inv - bflo(me.w), a[7] * inv - bfhi(me.w));
        *(v4u*)(PD + (size_t)r * 1024 + cc) = o;
    }
}

__device__ __forceinline__ void shortconv_phase(Frame& F) {
    const bf16* PJ = WSP(bf16, WS_PROJ1); float* GT = WSP(float, WS_GT);
    const float* cw = INP(17); const float* cb = INP(18);
    LAS float* scr = (LAS float*)(F.lds + F.wave * 16896);
    const int lane = F.lane;
    for (int it = F.gw; it < 2 * 128 * 48; it += F.NGW) {
        const int cbk = it % 48, tb = (it / 48) % 128, b = it / (48 * 128), col = cbk * 64 + lane, t0 = tb * 64;
        const float w0 = cw[col], w1 = cw[3072 + col], w2 = cw[2 * 3072 + col], bias = cb[col];
        const bf16* base = PJ + ((size_t)b * SEQ) * 4096 + col;
        float prev = (t0 > 0) ? bf2f(base[(size_t)(t0 - 1) * 4096]) : 0.f;
        float cur = bf2f(base[(size_t)t0 * 4096]);
#pragma unroll 8
        for (int tt = 0; tt < 64; ++tt) { const int t = t0 + tt; const float nxt = (t + 1 < SEQ) ? bf2f(base[(size_t)(t + 1) * 4096]) : 0.f;
            scr[tt * 65 + lane] = prev * w0 + cur * w1 + nxt * w2 + bias; prev = cur; cur = nxt; }
        LDS_WAIT(); asm volatile("" ::: "memory");
        for (int c = 0; c < 64; ++c) GT[((size_t)(cbk * 64 + c) * 2 + b) * SEQ + t0 + lane] = scr[lane * 65 + c];
        LDS_WAIT(); asm volatile("" ::: "memory");
    }
}

__device__ __forceinline__ void s5_scan_phase(Frame& F) {
    const bf16* PJ = WSP(bf16, WS_PROJ1); float* YD = WSP(float, WS_YD);
    const f32x2* lamb = WSP(f32x2, WS_S5LAM); const f32x2* bbar = WSP(f32x2, WS_S5B);
    const float* cre = INP(31); const float* cim = INP(32);
    const int lane = F.lane;
    for (int task = F.wave * F.G + F.bid; task < 256; task += F.NGW) {
        const int di = task >> 7, b = (task >> 6) & 1, g = task & 63;
        const int dgp = (di * 64 + g) * 64 + lane;
        const f32x2 lam = lamb[dgp];
        float br[16], bi[16], cr[16], ci[16];
#pragma unroll
        for (int c = 0; c < 16; ++c) { const f32x2 bv = bbar[(size_t)dgp * 16 + c]; br[c] = bv.x; bi[c] = bv.y;
            cr[c] = cre[((size_t)(di * 64 + g) * 16 + c) * 64 + lane]; ci[c] = cim[((size_t)(di * 64 + g) * 16 + c) * 64 + lane]; }
        float sr = 0.f, si = 0.f;
        const int nsteps = CTX + SEQ;
        for (int st = 0; st < nsteps; st += 4) {
            const int stl = st + (lane >> 4);
            int row;
            if (stl < CTX) row = TL + b * CTX + (di == 0 ? stl : CTX - 1 - stl);
            else row = b * SEQ + (di == 0 ? stl - CTX : SEQ - 1 - (stl - CTX));
            const float uval = bf2f(PJ[(size_t)row * 4096 + 3072 + g * 16 + (lane & 15)]);
#pragma unroll
            for (int k = 0; k < 4; ++k) {
                float bur = 0.f, bui = 0.f;
#pragma unroll
                for (int c = 0; c < 16; ++c) { const float u = __builtin_bit_cast(float, __builtin_amdgcn_readlane(__builtin_bit_cast(int, uval), 16 * k + c)); bur += br[c] * u; bui += bi[c] * u; }
                const float nr = lam.x * sr - lam.y * si + bur, ni = lam.x * si + lam.y * sr + bui; sr = nr; si = ni;
                const int s2 = st + k;
                if (s2 >= CTX) {
                    const int t = (di == 0) ? s2 - CTX : SEQ - 1 - (s2 - CTX);
                    float outv = 0.f;
#pragma unroll
                    for (int c = 0; c < 16; ++c) { float v = cr[c] * sr - ci[c] * si; v = wave_sum(v); if (lane == c) outv = v; }
                    if (lane < 16) YD[((size_t)di * TL + (size_t)b * SEQ + t) * 1024 + g * 16 + lane] = outv;
                }
            }
        }
    }
}

__device__ __forceinline__ void hyena_naive_phase(Frame& F) {
    const float* GT = WSP(float, WS_GT); const float* kT = WSP(float, WS_KT); const float* invn = WSP(float, WS_INVN); bf16* cat = WSP(bf16, WS_CAT);
    const float* hyb = INP(25);
    LAS float* kf = (LAS float*)F.lds;
    LAS f32x2* ub = (LAS f32x2*)(F.lds + 65536);
    const int tid = F.tid;
    for (int ch = F.bid; ch < 1024; ch += F.G) {
        float res0[16], res1[16];
        for (int o = 0; o < 2; ++o) {
            const float inv = invn[o * 1024 + ch];
            const float* kfw = kT + (size_t)(o * 2048 + ch) * SEQ; const float* kbw = kT + (size_t)(o * 2048 + 1024 + ch) * SEQ;
            for (int n = tid; n < 16384; n += NTHREADS) { float v; if (n < SEQ) v = kfw[n]; else if (n == SEQ) v = 0.f; else v = kbw[16384 - n]; kf[n] = v * inv; }
            if (o == 0) { const float* v0 = GT + ((size_t)(0 * 1024 + ch) * 2) * SEQ; for (int n = tid; n < SEQ; n += NTHREADS) ub[n] = (f32x2){v0[n], v0[SEQ + n]}; }
            else {
#pragma unroll
                for (int j = 0; j < 16; ++j) ub[tid + NTHREADS * j] = (f32x2){res0[j], res1[j]}; }
            __syncthreads();
            float a0[16], a1[16];
#pragma unroll
            for (int j = 0; j < 16; ++j) { a0[j] = 0.f; a1[j] = 0.f; }
            for (int s = 0; s < SEQ; ++s) { const f32x2 u = ub[s];
#pragma unroll
                for (int j = 0; j < 16; ++j) { const float kk = kf[(tid + NTHREADS * j - s) & 16383]; a0[j] += u.x * kk; a1[j] += u.y * kk; } }
            const float bias = hyb[o * 1024 + ch];
            const float* xg = GT + ((size_t)((o + 1) * 1024 + ch) * 2) * SEQ;
#pragma unroll
            for (int j = 0; j < 16; ++j) { const int t = tid + NTHREADS * j; const f32x2 u = ub[t];
                res0[j] = xg[t] * (a0[j] + bias * u.x); res1[j] = xg[SEQ + t] * (a1[j] + bias * u.y); }
            __syncthreads();
        }
#pragma unroll
        for (int j = 0; j < 16; ++j) { const int t = tid + NTHREADS * j;
            cat[(size_t)t * 2048 + ch] = (bf16)f2bf(res0[j]); cat[((size_t)SEQ + t) * 2048 + ch] = (bf16)f2bf(res1[j]); }
    }
}

__device__ __forceinline__ void s5_gelu_phase(Frame& F) {
    const bf16* PJ = WSP(bf16, WS_PROJ1); const float* YD = WSP(float, WS_YD); bf16* Gb = WSP(bf16, WS_PD); const float* dd = INP(33);
    const int gt = F.bid * NTHREADS + F.tid, NGT = F.G * NTHREADS;
    for (int idx = gt; idx < TL * 256; idx += NGT) { const int r = idx >> 8, c = (idx & 255) * 4;
        const v2u uw = *(const v2u*)(PJ + (size_t)r * 4096 + 3072 + c); const f32x4 d4 = *(const f32x4*)(dd + c);
        const f32x4 y0 = *(const f32x4*)(YD + (size_t)r * 1024 + c), y1 = *(const f32x4*)(YD + ((size_t)TL + r) * 1024 + c);
        const f32x4 y = {bflo(uw.x) * d4.x + y0.x + y1.x, bfhi(uw.x) * d4.y + y0.y + y1.y, bflo(uw.y) * d4.z + y0.z + y1.z, bfhi(uw.y) * d4.w + y0.w + y1.w};
        st_bf4(Gb + (size_t)r * 1024 + c, (f32x4){gelu_tanh(y.x), gelu_tanh(y.y), gelu_tanh(y.z), gelu_tanh(y.w)}); }
}

__device__ __forceinline__ f32x2 cmulf(f32x2 a, f32x2 b) { return (f32x2){a.x * b.x - a.y * b.y, a.x * b.y + a.y * b.x}; }
__device__ __forceinline__ int drev14(int p) { const unsigned r = __builtin_bitreverse32((unsigned)p) >> 18; return (int)(((r & 0x2AAAu) >> 1) | ((r & 0x1555u) << 1)); }
__device__ __forceinline__ void fft_fwd(LAS f32x2* X, const f32x2* tw, int tid) {
#pragma nounroll
    for (int L = 4096; L >= 1; L >>= 2) {
        const int tws = 4096 / L;
#pragma unroll 2
        for (int i = 0; i < 8; ++i) {
            const int b = tid + NTHREADS * i, j = b & (L - 1), i0 = (b - j) * 4 + j;
            const f32x2 x0 = X[i0], x1 = X[i0 + L], x2 = X[i0 + 2 * L], x3 = X[i0 + 3 * L];
            const f32x2 w1 = tw[j * tws], w2 = cmulf(w1, w1), w3 = cmulf(w2, w1);
            const f32x2 a = x0 + x2, bb = x0 - x2, c = x1 + x3, d = x1 - x3;
            const f32x2 t1 = {bb.x + d.y, bb.y - d.x}, t3 = {bb.x - d.y, bb.y + d.x};
            X[i0] = a + c; X[i0 + L] = cmulf(t1, w1); X[i0 + 2 * L] = cmulf(a - c, w2); X[i0 + 3 * L] = cmulf(t3, w3);
        }
        __syncthreads();
    }
}
__device__ __forceinline__ void fft_inv(LAS f32x2* X, const f32x2* tw, int tid) {
#pragma nounroll
    for (int L = 1; L <= 4096; L <<= 2) {
        const int tws = 4096 / L;
#pragma unroll 2
        for (int i = 0; i < 8; ++i) {
            const int b = tid + NTHREADS * i, j = b & (L - 1), i0 = (b - j) * 4 + j;
            f32x2 w1 = tw[j * tws]; w1.y = -w1.y; const f32x2 w2 = cmulf(w1, w1), w3 = cmulf(w2, w1);
            const f32x2 x0 = X[i0], x1 = cmulf(X[i0 + L], w1), x2 = cmulf(X[i0 + 2 * L], w2), x3 = cmulf(X[i0 + 3 * L], w3);
            const f32x2 a = x0 + x2, bb = x0 - x2, c = x1 + x3, d = x1 - x3;
            X[i0] = a + c; X[i0 + L] = (f32x2){bb.x - d.y, bb.y + d.x}; X[i0 + 2 * L] = a - c; X[i0 + 3 * L] = (f32x2){bb.x + d.y, bb.y - d.x};
        }
        __syncthreads();
    }
}
__device__ __forceinline__ void fft_pointwise(LAS f32x2* X, const f32x2* Wg, int o, float scale, int tid) {
    const float hs = 0.5f * scale;
#pragma unroll 4
    for (int i = 0; i < 32; ++i) {
        const int p = tid + NTHREADS * i, f = drev14(p), pm = drev14((16384 - f) & 16383);
        const unsigned long long ua = __hip_atomic_load((const unsigned long long*)(Wg + p), __ATOMIC_RELAXED, __HIP_MEMORY_SCOPE_AGENT);
        const unsigned long long ub = __hip_atomic_load((const unsigned long long*)(Wg + pm), __ATOMIC_RELAXED, __HIP_MEMORY_SCOPE_AGENT);
        const f32x2 A = __builtin_bit_cast(f32x2, ua), B = __builtin_bit_cast(f32x2, ub);
        f32x2 K;
        if (o == 0) K = (f32x2){(A.x + B.x) * hs, (A.y - B.y) * hs};
        else { const f32x2 dd = {A.x - B.x, A.y + B.y}; K = (f32x2){dd.y * hs, -dd.x * hs}; }
        X[p] = cmulf(X[p], K);
    }
    __syncthreads();
}
__device__ __forceinline__ void hyena_fft_phase(Frame& F) {
    float* GT = WSP(float, WS_GT); const float* kT = WSP(float, WS_KT); const float* invn = WSP(float, WS_INVN); const f32x2* tw = WSP(f32x2, WS_TW);
    f32x2* Wg = WSP(f32x2, WS_FFTW) + (size_t)F.bid * 16384;
    const float* hyb = INP(25);
    LAS f32x2* X = (LAS f32x2*)F.lds;
    const int tid = F.tid;
    for (int ch = F.bid; ch < 1024; ch += F.G) {
        { const float* f0 = kT + (size_t)ch * SEQ; const float* b0 = kT + (size_t)(1024 + ch) * SEQ; const float* f1 = kT + (size_t)(2048 + ch) * SEQ; const float* b1 = kT + (size_t)(3072 + ch) * SEQ;
          for (int n = tid; n < SEQ; n += NTHREADS) { X[n] = (f32x2){f0[n], f1[n]}; X[SEQ + n] = (n == 0) ? (f32x2){0.f, 0.f} : (f32x2){b0[SEQ - n], b1[SEQ - n]}; } }
        __syncthreads();
        fft_fwd(X, tw, tid);
        for (int n = tid; n < 16384; n += NTHREADS) Wg[n] = X[n];
        __syncthreads();
        float* v0 = GT + ((size_t)ch * 2) * SEQ;
        const float* x1 = GT + ((size_t)(1024 + ch) * 2) * SEQ; const float* x2 = GT + ((size_t)(2048 + ch) * 2) * SEQ;
        float z0[16], z1[16];
#pragma unroll
        for (int j = 0; j < 16; ++j) { const int n = tid + NTHREADS * j; z0[j] = v0[n]; z1[j] = v0[SEQ + n]; }
#pragma unroll
        for (int o = 0; o < 2; ++o) {
#pragma unroll
            for (int j = 0; j < 16; ++j) { const int n = tid + NTHREADS * j; X[n] = (f32x2){z0[j], z1[j]}; X[SEQ + n] = (f32x2){0.f, 0.f}; }
            __syncthreads();
            fft_fwd(X, tw, tid);
            fft_pointwise(X, Wg, o, invn[o * 1024 + ch] * (1.0f / 16384.0f), tid);
            fft_inv(X, tw, tid);
            const float bias = hyb[o * 1024 + ch]; const float* xg = (o == 0) ? x1 : x2;
#pragma unroll
            for (int j = 0; j < 16; ++j) { const int n = tid + NTHREADS * j; const f32x2 y = X[n]; z0[j] = xg[n] * (y.x + bias * z0[j]); z1[j] = xg[SEQ + n] * (y.y + bias * z1[j]); }
            __syncthreads();
        }
#pragma unroll
        for (int j = 0; j < 16; ++j) { const int n = tid + NTHREADS * j; v0[n] = z0[j]; v0[SEQ + n] = z1[j]; }
    }
}
__device__ __forceinline__ void hyena_out_transpose(Frame& F) {
    const float* GT = WSP(float, WS_GT); bf16* cat = WSP(bf16, WS_CAT);
    LAS float* scr = (LAS float*)(F.lds + F.wave * 16896);
    const int lane = F.lane;
    for (int it = F.gw; it < 2 * 128 * 16; it += F.NGW) {
        const int cbk = it & 15, tb = (it >> 4) & 127, b = it >> 11, t0 = tb * 64;
        for (int c = 0; c < 64; ++c) scr[c * 65 + lane] = GT[((size_t)(cbk * 64 + c) * 2 + b) * SEQ + t0 + lane];
        LDS_WAIT(); asm volatile("" ::: "memory");
        for (int tt = 0; tt < 64; ++tt) cat[((size_t)b * SEQ + t0 + tt) * 2048 + cbk * 64 + lane] = (bf16)f2bf(scr[lane * 65 + tt]);
        LDS_WAIT(); asm volatile("" ::: "memory");
    }
}

constexpr int NPHASES = 21;
#ifndef MK_SINGLE
#define MK_SINGLE 1
#endif

__device__ __forceinline__ unsigned long long launder_u64(unsigned long long v) {
    unsigned lo = (unsigned)v, hi = (unsigned)(v >> 32);
    asm volatile("" : "+v"(lo), "+v"(hi));
    lo = __builtin_amdgcn_readfirstlane(lo); hi = __builtin_amdgcn_readfirstlane(hi);
    return ((unsigned long long)hi << 32) | lo;
}
__device__ __forceinline__ const void* launder_ptr(const void* p) {
    unsigned long long v = (unsigned long long)p; unsigned lo = (unsigned)v, hi = (unsigned)(v >> 32);
    asm volatile("" : "+v"(lo), "+v"(hi));
    lo = __builtin_amdgcn_readfirstlane(lo); hi = __builtin_amdgcn_readfirstlane(hi);
    return (const void*)(((unsigned long long)hi << 32) | lo);
}
__device__ __forceinline__ void moe_blocks(Frame& F, int l, LAS int* bstart) {
    __syncthreads();
    if (F.tid == 0) { const unsigned* cnt = WSP(unsigned, WS_CTL) + CW_CNT + l * 64; int acc = 0;
        for (int e = 0; e < 64; ++e) { bstart[e] = acc; const int nb = ((int)cnt[e] + 255) >> 8; for (int j = 0; j < nb; ++j) bstart[65 + acc + j] = e; acc += nb; } bstart[64] = acc; }
    __syncthreads();
}

template <int PHSEL>
__global__ void __launch_bounds__(NTHREADS, 2) mk_fwd(Args args) {
    extern __shared__ __attribute__((aligned(16))) unsigned char lds_raw[];
    Frame F;
    F.lds = (LAS unsigned char*)lds_raw; F.ws = args.ws; F.kin = (const __attribute__((address_space(4))) unsigned long long*)__builtin_amdgcn_kernarg_segment_ptr();
    F.tid = threadIdx.x; F.lane = F.tid & 63; F.wave = __builtin_amdgcn_readfirstlane(F.tid >> 6); F.bid = blockIdx.x; F.G = gridDim.x;
    F.gw = F.bid * NWAVES + F.wave; F.NGW = F.G * NWAVES;
    volatile LAS unsigned* lctl = (volatile LAS unsigned*)(F.lds + LDS_CTL);
    LAS int* bstart = (LAS int*)(F.lds + LDS_CTL + 64);
    if (F.tid < 4) lctl[F.tid] = 0u;
    __syncthreads();
    const int lo = args.ph_lo, hi = args.ph_hi;
    XcdBarrier bar; bar.bar = WSP(unsigned, WS_CTL) + CW_BAR; bar.x = 0; bar.st = lctl;
    if (PHSEL < 0) bar = xcd_barrier_post(WSP(unsigned, WS_CTL) + CW_BAR, lctl);
#ifndef PH_MASK
#define PH_MASK 0xffffffffu
#endif
#define IN(k) (((PH_MASK >> (k)) & 1u) && (PHSEL < 0 || PHSEL == (k)))
#define INL(j) (((PH_MASK >> (6 + (j))) & 1u) && (PHSEL < 0 || (PHSEL == 6 + (j) && lo == pb + (j))))
#define PH_END(k) do { if (PHSEL < 0) xcd_barrier(bar); } while (0)
#define PH_BEGIN() do { F.ws = (unsigned char*)launder_ptr((const void*)F.ws); F.kin = (const __attribute__((address_space(4))) unsigned long long*)launder_u64((unsigned long long)F.kin); \
    { int _t = threadIdx.x; asm volatile("" : "+v"(_t)); F.tid = _t; F.lane = _t & 63; F.wave = __builtin_amdgcn_readfirstlane(_t >> 6); \
      int _b = blockIdx.x; asm volatile("" : "+v"(_b)); F.bid = __builtin_amdgcn_readfirstlane(_b); F.gw = F.bid * NWAVES + F.wave; } } while (0)
    LAS unsigned char* lds = F.lds;
    const int G = F.G, bid = F.bid;
    constexpr long T2048 = 256L * 2048 * 2;

    if (IN(0)) { PH_BEGIN(); p0_prologue(F); PH_END(0); }
    if (IN(1)) { PH_BEGIN(); p1_reduce(F); PH_END(1); }
        if (IN(2)) { PH_BEGIN(); norm_phase<0>(F, 0, nullptr); PH_END(2); }
        if (IN(3)) { PH_BEGIN();
            { pg8::Gemm g{WSP(bf16, WS_HA), WSP(bf16, WS_WIN0), 2048, 2048, 2048}; pg8::StaticOrder S; S.init(TT / 256, 12, G, bid, T2048, 0, T2048);
              EpiQKP E{WSP(bf16, WS_Q), WSP(bf16, WS_K), WSP(bf16, WS_P), WSP(f32x2, WS_ROPE)}; pg8::gemm_phase<EpiQKP, pg8::StaticOrder, false>(lds, g, S, E); }
            { pg8::Gemm g{WSP(bf16, WS_WIN0) + (size_t)3072 * 2048, WSP(bf16, WS_HA), 2048, 2048, 2048}; pg8::StaticOrder S; S.init(4, TT / 256, G, bid, T2048, 0, T2048);
              EpiVT E{WSP(bf16, WS_VT)}; pg8::gemm_phase<EpiVT, pg8::StaticOrder, false>(lds, g, S, E); }
            PH_END(3);
        }
        if (IN(4)) { PH_BEGIN(); attn_phase(F); poold_phase(F); PH_END(4); }
        if (IN(5)) { PH_BEGIN();
            pg8::Gemm g{WSP(bf16, WS_PD), WSP(bf16, WS_WPOOL), 1024, 256, 256}; pg8::StaticOrder S; S.init(TT / 256, 4, G, bid, 256L * 1024 * 2, 256L * 2, 256L * 256 * 2);
            EpiScaleBf16 E{WSP(bf16, WS_CAT), 2048, 1024, INP(14)}; pg8::gemm_phase<EpiScaleBf16, pg8::StaticOrder, false>(lds, g, S, E);
            PH_END(5);
        }
    {
    constexpr int pb = 6; constexpr int l = 0;
    if (INL(0)) { PH_BEGIN();
        float* xbuf = WSP(float, WS_X);
        pg8::Gemm g{WSP(bf16, WS_CAT), WSP(bf16, l == 0 ? WS_WOUT0 : WS_WOUT1), 2048, 2048, 2048}; pg8::StaticOrder S; S.init(l == 0 ? TT / 256 : TL / 256, 8, G, bid, T2048, 0, T2048);
        EpiRes E{l == 0 ? INP(0) : xbuf, l == 0 ? INP(2) : xbuf + (size_t)TL * 2048, xbuf, modp(F, l, 0, 2)}; pg8::gemm_phase<EpiRes, pg8::StaticOrder, false>(lds, g, S, E);
        PH_END(pb);
    }
    if (INL(1)) { PH_BEGIN(); norm_phase<1>(F, l, nullptr); PH_END(pb + 1); }
    if (INL(2)) { PH_BEGIN();
        moe_blocks(F, l, bstart);
        pg8::Gemm g{WSP(bf16, WS_HA), (const bf16*)(F.ws + WS_WMOE + (size_t)l * MOE_L_BYTES), 2048, 2048, 2048};
        MoeOrder S{bstart, WSP(unsigned, WS_CTL) + CW_CNT + l * 64, WSP(int, WS_TOKL), 4, G, bid, bstart[64], T2048, 0, true};
        EpiMoeUp E{WSP(bf16, WS_H)}; pg8::gemm_phase<EpiMoeUp, MoeOrder, true>(lds, g, S, E);
        PH_END(pb + 2);
    }
    if (INL(3)) { PH_BEGIN();
        moe_blocks(F, l, bstart);
        pg8::Gemm g{WSP(bf16, WS_H), (const bf16*)(F.ws + WS_WMOE + (size_t)l * MOE_L_BYTES), 512, 512, 512};
        MoeOrder S{bstart, WSP(unsigned, WS_CTL) + CW_CNT + l * 64, WSP(int, WS_TOKL), 8, G, bid, bstart[64], 256L * 512 * 2, (long)(4 * MiB), false};
        EpiMoeDown E{WSP(bf16, WS_Y), WSP(int, WS_TOKL), WSP(float, WS_GATEL), WSP(unsigned, WS_CTL) + CW_CNT + l * 64}; pg8::gemm_phase<EpiMoeDown, MoeOrder, false>(lds, g, S, E);
        PH_END(pb + 3);
    }
    }
        if (IN(10)) { PH_BEGIN(); norm_phase<2>(F, 1, nullptr); PH_END(10); }
        if (IN(11)) { PH_BEGIN();
            pg8::Gemm g{WSP(bf16, WS_HA), WSP(bf16, WS_WIN1), 2048, 2048, 2048}; pg8::StaticOrder S; S.init(TT / 256, 16, G, bid, T2048, 0, T2048);
            EpiBf16 E{WSP(bf16, WS_PROJ1), 4096}; pg8::gemm_phase<EpiBf16, pg8::StaticOrder, false>(lds, g, S, E);
            PH_END(11);
        }
        if (IN(12)) { PH_BEGIN(); shortconv_phase(F); s5_scan_phase(F); PH_END(12); }
        if (IN(13)) { PH_BEGIN(); hyena_fft_phase(F); PH_END(13); }
        if (IN(14)) { PH_BEGIN(); s5_gelu_phase(F); hyena_out_transpose(F); PH_END(14); }
        if (IN(15)) { PH_BEGIN();
            pg8::Gemm g{WSP(bf16, WS_PD), WSP(bf16, WS_WGLU), 1024, 1024, 1024}; pg8::StaticOrder S; S.init(TL / 256, 4, G, bid, 256L * 1024 * 2, 0, 256L * 1024 * 2);
            EpiGlu E{WSP(bf16, WS_CAT), 2048, 1024, WSP(bf16, WS_PD), INP(35)}; pg8::gemm_phase<EpiGlu, pg8::StaticOrder, false>(lds, g, S, E);
            PH_END(15);
        }
    {
    constexpr int pb = 16; constexpr int l = 1;
    if (INL(0)) { PH_BEGIN();
        float* xbuf = WSP(float, WS_X);
        pg8::Gemm g{WSP(bf16, WS_CAT), WSP(bf16, l == 0 ? WS_WOUT0 : WS_WOUT1), 2048, 2048, 2048}; pg8::StaticOrder S; S.init(l == 0 ? TT / 256 : TL / 256, 8, G, bid, T2048, 0, T2048);
        EpiRes E{l == 0 ? INP(0) : xbuf, l == 0 ? INP(2) : xbuf + (size_t)TL * 2048, xbuf, modp(F, l, 0, 2)}; pg8::gemm_phase<EpiRes, pg8::StaticOrder, false>(lds, g, S, E);
        PH_END(pb);
    }
    if (INL(1)) { PH_BEGIN(); norm_phase<1>(F, l, nullptr); PH_END(pb + 1); }
    if (INL(2)) { PH_BEGIN();
        moe_blocks(F, l, bstart);
        pg8::Gemm g{WSP(bf16, WS_HA), (const bf16*)(F.ws + WS_WMOE + (size_t)l * MOE_L_BYTES), 2048, 2048, 2048};
        MoeOrder S{bstart, WSP(unsigned, WS_CTL) + CW_CNT + l * 64, WSP(int, WS_TOKL), 4, G, bid, bstart[64], T2048, 0, true};
        EpiMoeUp E{WSP(bf16, WS_H)}; pg8::gemm_phase<EpiMoeUp, MoeOrder, true>(lds, g, S, E);
        PH_END(pb + 2);
    }
    if (INL(3)) { PH_BEGIN();
        moe_blocks(F, l, bstart);
        pg8::Gemm g{WSP(bf16, WS_H), (const bf16*)(F.ws + WS_WMOE + (size_t)l * MOE_L_BYTES), 512, 512, 512};
        MoeOrder S{bstart, WSP(unsigned, WS_CTL) + CW_CNT + l * 64, WSP(int, WS_TOKL), 8, G, bid, bstart[64], 256L * 512 * 2, (long)(4 * MiB), false};
        EpiMoeDown E{WSP(bf16, WS_Y), WSP(int, WS_TOKL), WSP(float, WS_GATEL), WSP(unsigned, WS_CTL) + CW_CNT + l * 64}; pg8::gemm_phase<EpiMoeDown, MoeOrder, false>(lds, g, S, E);
        PH_END(pb + 3);
    }
    }
    if (IN(20)) { PH_BEGIN(); norm_phase<3>(F, 1, args.out); }
#undef IN
#undef INL
#undef PH_END
}

typedef void (*kern_t)(Args);
template <int P> static void launch_phase(int grid, hipStream_t stream, Args a) { hipLaunchKernelGGL(mk_fwd<P>, dim3(grid), dim3(NTHREADS), LDS_BYTES, stream, a); }
template <int P> static bool prep_phase() { return hipFuncSetAttribute((const void*)mk_fwd<P>, hipFuncAttributeMaxDynamicSharedMemorySize, LDS_BYTES) == hipSuccess; }
extern "C" void kernel_launch(void* const* d_in, const int* in_sizes, int n_in, void* d_out, int out_size, void* d_ws, size_t ws_size, hipStream_t stream) {
    static int grid = 0;
    if (grid == 0) {
        if (n_in != 43 || out_size != TL * DM || ws_size < WS_END) { fprintf(stderr, "kernel_launch: unexpected shapes (n_in %d, out %d, ws %zu < %zu)\n", n_in, out_size, ws_size, (size_t)WS_END); grid = -1; return; }
        int dev = 0, cus = 0;
        if (hipGetDevice(&dev) != hipSuccess || hipDeviceGetAttribute(&cus, hipDeviceAttributeMultiprocessorCount, dev) != hipSuccess) { grid = -1; return; }
        bool ok = true;
#if MK_SINGLE
        ok = prep_phase<-1>();
#else
        ok = prep_phase<0>() && prep_phase<1>() && prep_phase<2>() && prep_phase<3>() && prep_phase<4>() && prep_phase<5>() && prep_phase<6>() && prep_phase<7>() && prep_phase<8>() && prep_phase<9>() &&
             prep_phase<10>() && prep_phase<11>() && prep_phase<12>() && prep_phase<13>() && prep_phase<14>() && prep_phase<15>() && prep_phase<20>();
#endif
        if (!ok) { fprintf(stderr, "kernel_launch: hipFuncSetAttribute failed\n"); grid = -1; return; }
        (void)hipGetLastError();
        grid = cus;
    }
    if (grid < 0) return;
    (void)hipMemsetAsync((char*)d_ws + WS_CTL, 0, CTL_BYTES, stream);
    Args a{};
    for (int i = 0; i < 43; ++i) a.in[i] = (const float*)d_in[i];
    a.out = (float*)d_out; a.ws = (unsigned char*)d_ws;
#if MK_SINGLE
    a.ph_lo = 0; a.ph_hi = NPHASES;
    launch_phase<-1>(grid, stream, a);
#else
#define LP(k, P) a.ph_lo = (k); a.ph_hi = (k) + 1; launch_phase<P>(grid, stream, a);
    LP(0, 0) LP(1, 1) LP(2, 2) LP(3, 3) LP(4, 4) LP(5, 5) LP(6, 6) LP(7, 7) LP(8, 8) LP(9, 9) LP(10, 10) LP(11, 11) LP(12, 12) LP(13, 13) LP(14, 14) LP(15, 15)
    LP(16, 6) LP(17, 7) LP(18, 8) LP(19, 9) LP(20, 20)
#undef LP
#endif
}
```

```cpp
#include <hip/hip_runtime.h>
#include <cstdio>
#include <cstdint>
#include <cmath>

#define GAS __attribute__((address_space(1)))
#define LAS __attribute__((address_space(3)))
typedef unsigned short bf16;
typedef unsigned v4u __attribute__((ext_vector_type(4)));
typedef unsigned v2u __attribute__((ext_vector_type(2)));
typedef float f32x4 __attribute__((ext_vector_type(4)));
typedef float f32x2 __attribute__((ext_vector_type(2)));
typedef float f32x16 __attribute__((ext_vector_type(16)));
typedef short bf16x8 __attribute__((ext_vector_type(8)));
#define LDS_WAIT() asm volatile("s_waitcnt lgkmcnt(0)" ::: "memory")
#define VM_WAIT() asm volatile("s_waitcnt vmcnt(0)" ::: "memory")

__device__ __forceinline__ unsigned f2bf(float f) { unsigned u = __builtin_bit_cast(unsigned, f); return (u + 0x7fffu + ((u >> 16) & 1u)) >> 16; }
__device__ __forceinline__ unsigned pk2(float lo, float hi) { return f2bf(lo) | (f2bf(hi) << 16); }
__device__ __forceinline__ unsigned cvt_pk_bf16(float lo, float hi) { unsigned r; asm volatile("v_cvt_pk_bf16_f32 %0, %1, %2" : "=v"(r) : "v"(lo), "v"(hi)); return r; }
__device__ __forceinline__ float bf2f(unsigned short b) { return __builtin_bit_cast(float, (unsigned)b << 16); }
__device__ __forceinline__ float bflo(unsigned w) { return __builtin_bit_cast(float, w << 16); }
__device__ __forceinline__ float bfhi(unsigned w) { return __builtin_bit_cast(float, w & 0xffff0000u); }
__device__ __forceinline__ float wave_sum(float v) {
#pragma unroll
    for (int o = 1; o < 64; o <<= 1) v += __shfl_xor(v, o);
    return v;
}

namespace pg8 {
typedef unsigned short bf16_t;
constexpr int BM = 256, BK = 64, HALF = 128, HTB = HALF * BK * 2, STAGE_BYTES = 8 * HTB;

__host__ __device__ __forceinline__ int lds_byte(int r, int c) { const int st = (r >> 4) * 2 + (c >> 5), rr = r & 15, cc = c & 31, ob = rr * 64 + cc * 2; return st * 1024 + (ob ^ (((ob >> 9) & 1) << 5)); }
__host__ __device__ __forceinline__ void stage_rc(int b, int& R, int& C) { const int st = b / 1024, sb = b % 1024, swz = sb ^ (((sb >> 9) & 1) << 5); R = (st >> 1) * 16 + swz / 64; C = (st & 1) * 32 + (swz % 64) / 2; }

struct Unit { int pm, pn; long aoff, boff; int e, idx0; };
struct Gemm { const bf16_t* A; const bf16_t* Bt; int lda, ldb, K; };

template <class Epi, class Sched, bool GATHER>
__device__ __forceinline__ void gemm_phase(LAS unsigned char* lds, const Gemm g, const Sched& S, const Epi& E) {
    const int tid = threadIdx.x, wid = __builtin_amdgcn_readfirstlane(tid >> 6), lane = tid & 63, wr = wid >> 2, wc = wid & 3, fr = lane & 15, fq = lane >> 4;
    const int K = g.K, nt = K / BK;
    unsigned voffA[2], voffB[2];
#pragma unroll
    for (int i = 0; i < 2; ++i) { int R, C; stage_rc(tid * 16 + i * 8192, R, C);
        voffA[i] = (unsigned)(R * g.lda + C) * 2u; voffB[i] = (unsigned)(R * g.ldb + C) * 2u; }
    const size_t kstep = (size_t)(BK * 2);
    const size_t hstepA = GATHER ? 0 : (size_t)HALF * g.lda * 2, hstepB = (size_t)HALF * g.ldb * 2;
    const unsigned ldsw = (unsigned)wid * 1024u;
    const int aoff = lds_byte(wr * 64 + fr, fq * 8), boff = lds_byte(wc * 32 + fr, fq * 8);
#define PG8_SA(b, h) (((b) * 2 + (h)) * HTB)
#define PG8_SB(b, h) ((4 + (b) * 2 + (h)) * HTB)
#define PG8_STAGE(bufoff, gbase, voff) do { _Pragma("unroll") for (int _i = 0; _i < 2; ++_i) \
        __builtin_amdgcn_global_load_lds((const unsigned*)((const char*)(gbase) + (voff)[_i]), (LAS unsigned*)(lds + (bufoff) + ldsw + _i * 8192), 16, 0, 0); } while (0)
#define PG8_STAGE_A(bufoff, gbase, h, nx) do { if constexpr (GATHER) { unsigned _tv[2]; \
        if (nx) { int _tz = tid; asm volatile("" : "+v"(_tz)); _Pragma("unroll") for (int _j = 0; _j < 2; ++_j) { int _R, _C; stage_rc(_tz * 16 + _j * 8192, _R, _C); _tv[_j] = (unsigned)S.arow(nxt, (h) * HALF + _R) * (unsigned)(g.lda * 2) + (unsigned)(_C * 2); } } \
        else { _tv[0] = gvc[h][0]; _tv[1] = gvc[h][1]; } \
        PG8_STAGE(bufoff, gbase, _tv); } else { PG8_STAGE(bufoff, (gbase) + (h) * hstepA, voffA); } } while (0)
#define PG8_LDA(dst, b, h) do { _Pragma("unroll") for (int m = 0; m < 4; ++m) _Pragma("unroll") for (int k = 0; k < 2; ++k) dst[m][k] = *(const LAS bf16x8*)(lds + PG8_SA(b, h) + aoff + m * 2048 + k * 1024); } while (0)
#define PG8_LDB(dst, b, h) do { _Pragma("unroll") for (int n = 0; n < 2; ++n) _Pragma("unroll") for (int k = 0; k < 2; ++k) dst[n][k] = *(const LAS bf16x8*)(lds + PG8_SB(b, h) + boff + n * 2048 + k * 1024); } while (0)
#define PG8_MMA(ai, bj, At, Bt) do { __builtin_amdgcn_s_setprio(1); _Pragma("unroll") for (int m = 0; m < 4; ++m) _Pragma("unroll") for (int n = 0; n < 2; ++n) _Pragma("unroll") for (int k = 0; k < 2; ++k) \
        acc[ai][bj][m][n] = __builtin_amdgcn_mfma_f32_16x16x32_bf16(Bt[n][k], At[m][k], acc[ai][bj][m][n], 0, 0, 0); __builtin_amdgcn_s_setprio(0); } while (0)
#define PG8_WAIT_V(n) asm volatile("s_waitcnt vmcnt(" #n ")" ::: "memory")
#define PG8_WAIT_L(n) asm volatile("s_waitcnt lgkmcnt(" #n ")" ::: "memory")
#define PG8_BAR __builtin_amdgcn_s_barrier()
#define PG8_SCHED __builtin_amdgcn_sched_barrier(0)
    Unit cur, nxt; int ui = 0;
    if (!S.next(0, cur)) return;
    unsigned gvc[2][2];
#define PG8_GV(unit) do { if constexpr (GATHER) { int _tz = tid; asm volatile("" : "+v"(_tz)); _Pragma("unroll") for (int _h = 0; _h < 2; ++_h) _Pragma("unroll") for (int _j = 0; _j < 2; ++_j) { int _R, _C; stage_rc(_tz * 16 + _j * 8192, _R, _C); \
        gvc[_h][_j] = (unsigned)S.arow(unit, _h * HALF + _R) * (unsigned)(g.lda * 2) + (unsigned)(_C * 2); } } } while (0)
    PG8_GV(cur);
    f32x4 acc[2][2][4][2];
#pragma unroll
    for (int a = 0; a < 2; ++a)
#pragma unroll
        for (int b = 0; b < 2; ++b)
#pragma unroll
            for (int m = 0; m < 4; ++m)
#pragma unroll
                for (int n = 0; n < 2; ++n) acc[a][b][m][n] = (f32x4){0.f, 0.f, 0.f, 0.f};
    bf16x8 At[4][2], B0[2][2], B1[2][2];
    const char* cA = (const char*)g.A + cur.aoff; const char* cB = (const char*)g.Bt + cur.boff;
    PG8_STAGE(PG8_SB(0, 0), cB, voffB); PG8_STAGE(PG8_SB(0, 1), cB + hstepB, voffB); PG8_STAGE_A(PG8_SA(0, 0), cA, 0, false); PG8_STAGE_A(PG8_SA(0, 1), cA, 1, false);
    if (wr == 1) PG8_BAR;
    PG8_WAIT_V(2); PG8_BAR;
    PG8_STAGE(PG8_SB(1, 0), cB + kstep, voffB); PG8_STAGE_A(PG8_SA(1, 0), cA + kstep, 0, false); PG8_STAGE(PG8_SB(1, 1), cB + hstepB + kstep, voffB);
    PG8_WAIT_V(6); PG8_BAR;
    for (;;) {
        const bool has_next = S.next(ui + 1, nxt);
        const char* nA = has_next ? (const char*)g.A + nxt.aoff : cA; const char* nB = has_next ? (const char*)g.Bt + nxt.boff : cB;
#pragma nounroll
        for (int t = 0; t < nt; t += 2) {
            const bool last = (t == nt - 2);
            const char* a1 = cA + (size_t)(t + 1) * kstep;
            const char* a2 = last ? nA : cA + (size_t)(t + 2) * kstep; const char* b2 = last ? nB : cB + (size_t)(t + 2) * kstep;
            const char* a3 = a2 + kstep; const char* b3 = b2 + kstep;
            PG8_LDB(B0, 0, 0); PG8_LDB(B1, 0, 1); PG8_SCHED; PG8_LDA(At, 0, 0); PG8_STAGE_A(PG8_SA(1, 1), a1, 1, false);
            PG8_WAIT_V(8); PG8_WAIT_L(0); PG8_BAR; PG8_MMA(0, 0, At, B0); PG8_MMA(0, 1, At, B1); PG8_BAR; PG8_SCHED;
            PG8_LDA(At, 0, 1); PG8_STAGE(PG8_SB(0, 0), b2, voffB); PG8_STAGE(PG8_SB(0, 1), b2 + hstepB, voffB); PG8_STAGE_A(PG8_SA(0, 0), a2, 0, last);
            PG8_WAIT_V(8); PG8_WAIT_L(0); PG8_BAR; PG8_MMA(1, 0, At, B0); PG8_MMA(1, 1, At, B1); PG8_BAR; PG8_SCHED;
            PG8_LDB(B0, 1, 0); PG8_LDB(B1, 1, 1); PG8_SCHED; PG8_LDA(At, 1, 0); PG8_STAGE_A(PG8_SA(0, 1), a2, 1, last);
            PG8_WAIT_V(8); PG8_WAIT_L(0); PG8_BAR; PG8_MMA(0, 0, At, B0); PG8_MMA(0, 1, At, B1); PG8_BAR; PG8_SCHED;
            PG8_LDA(At, 1, 1); PG8_STAGE(PG8_SB(1, 0), b3, voffB); PG8_STAGE(PG8_SB(1, 1), b3 + hstepB, voffB); PG8_STAGE_A(PG8_SA(1, 0), a3, 0, last);
            PG8_WAIT_V(8); PG8_WAIT_L(0); PG8_BAR; PG8_MMA(1, 0, At, B0); PG8_MMA(1, 1, At, B1); PG8_BAR; PG8_SCHED;
        }
        if (wr == 0) PG8_BAR;
        E(acc, cur, wr, wc, fr, fq);
        if (!has_next) break;
#pragma unroll
        for (int a = 0; a < 2; ++a)
#pragma unroll
            for (int b = 0; b < 2; ++b)
#pragma unroll
                for (int m = 0; m < 4; ++m)
#pragma unroll
                    for (int n = 0; n < 2; ++n) acc[a][b][m][n] = (f32x4){0.f, 0.f, 0.f, 0.f};
        cur = nxt; cA = nA; cB = nB; ++ui;
        PG8_GV(cur);
        if (wr == 1) PG8_BAR;
    }
    PG8_WAIT_V(0);
    PG8_BAR;
#undef PG8_SA
#undef PG8_SB
#undef PG8_STAGE
#undef PG8_STAGE_A
#undef PG8_GV
#undef PG8_LDA
#undef PG8_LDB
#undef PG8_MMA
#undef PG8_WAIT_V
#undef PG8_WAIT_L
#undef PG8_BAR
#undef PG8_SCHED
}

struct StaticOrder {
    int nM, nN, nwg, G, c; long astride, apn, bstride;
    __device__ void init(int nM_, int nN_, int G_, int c_, long astride_, long apn_, long bstride_) { nM = nM_; nN = nN_; nwg = nM * nN; G = G_; c = c_; astride = astride_; apn = apn_; bstride = bstride_; }
    __device__ bool next(int i, Unit& u) const {
        const long Lx = (long)i * G + c; if (Lx >= nwg) return false;
        int wgid = (int)Lx; { const int q = nwg / 8, r = nwg % 8, xcd = wgid % 8, off = wgid / 8; wgid = (xcd < r ? xcd * (q + 1) : r * (q + 1) + (xcd - r) * q) + off; }
        const int nig = 8 * nN, gid = wgid / nig, fm = gid * 8, gsz = (nM - fm) < 8 ? (nM - fm) : 8;
        u.pm = fm + ((wgid % nig) % gsz); u.pn = (wgid % nig) / gsz; u.aoff = (long)u.pm * astride + (long)u.pn * apn; u.boff = (long)u.pn * bstride; u.e = 0; u.idx0 = 0; return true;
    }
    __device__ int arow(const Unit&, int) const { return 0; }
};
}

constexpr int DM = 2048, NBATCH = 2, SEQ = 8192, CTX = 256;
constexpr int TL = NBATCH * SEQ;
constexpr int TC = NBATCH * CTX;
constexpr int TT = TL + TC;
constexpr int KEYS = CTX + SEQ;
constexpr int NEXP = 64, DEXP = 512;
constexpr int LISTCAP = 2 * TT;
constexpr float EPS = 1e-6f;
constexpr float QSCALE = 0.125f * 1.4426950408889634f;
constexpr int NWAVES = 8, NTHREADS = 512;

constexpr size_t MiB = 1u << 20;
constexpr size_t WS_CTL = 0, CTL_BYTES = 1 * MiB;
constexpr size_t WS_WIN0 = 1 * MiB;
constexpr size_t WS_WOUT0 = WS_WIN0 + 16 * MiB;
constexpr size_t WS_WIN1 = WS_WOUT0 + 8 * MiB;
constexpr size_t WS_WOUT1 = WS_WIN1 + 16 * MiB;
constexpr size_t WS_WPOOL = WS_WOUT1 + 8 * MiB;
constexpr size_t WS_WGLU = WS_WPOOL + 1 * MiB;
constexpr size_t WS_WMOE = WS_WGLU + 2 * MiB;
constexpr size_t MOE_E_BYTES = 6 * MiB, MOE_L_BYTES = 64 * MOE_E_BYTES;
constexpr size_t WS_X = WS_WMOE + 2 * MOE_L_BYTES;
constexpr size_t WS_HA = WS_X + 132 * MiB;
constexpr size_t WS_Q = WS_HA + 67 * MiB;
constexpr size_t WS_K = WS_Q + 33 * MiB;
constexpr size_t WS_VT = WS_K + 33 * MiB;
constexpr size_t WS_P = WS_VT + 33 * MiB;
constexpr size_t WS_PROJ1 = WS_Q;
constexpr size_t WS_CAT = WS_P + 33 * MiB;
constexpr size_t WS_PD = WS_CAT + 66 * MiB;
constexpr size_t WS_H = WS_PD + 33 * MiB;
constexpr size_t WS_Y = WS_H + 49 * MiB;
constexpr size_t WS_GT = WS_Y + 132 * MiB;
constexpr size_t WS_KT = WS_GT + 192 * MiB;
constexpr size_t WS_YD = WS_KT + 128 * MiB;
constexpr size_t WS_MISC = WS_YD + 128 * MiB;
constexpr size_t WS_MOD = WS_MISC;
constexpr size_t WS_ADAP = WS_MOD + 1 * MiB;
constexpr size_t WS_ROPE = WS_ADAP + 10 * MiB;
constexpr size_t WS_NORMP = WS_ROPE + 1 * MiB;
constexpr size_t WS_INVN = WS_NORMP + 4 * MiB;
constexpr size_t WS_S5LAM = WS_INVN + 1 * MiB;
constexpr size_t WS_S5B = WS_S5LAM + 1 * MiB;
constexpr size_t WS_WRT = WS_S5B + 2 * MiB;
constexpr size_t WS_TOKL = WS_WRT + 2 * MiB;
constexpr size_t WS_GATEL = WS_TOKL + 9 * MiB;
constexpr size_t WS_TW = WS_GATEL + 9 * MiB;
constexpr size_t WS_FFTW = WS_TW + 1 * MiB;
constexpr size_t WS_S5L256 = WS_FFTW + 32 * MiB;
constexpr size_t WS_S5E = WS_S5L256 + 1 * MiB;
constexpr size_t WS_END = WS_S5E + 4 * MiB;
static_assert(WS_END <= 2040 * MiB, "d_ws map");
constexpr int CW_BAR = 1024;
constexpr int CW_CNT = 8192;

constexpr int LDS_PHASE = 131072;
constexpr int LDS_CTL = 147456 - 2048;
constexpr int LDS_BYTES = 147456;

#define XB_TMO      128
#define XB_XCNT(j)  (256  + 64 * (j))
#define XB_XSUB(j)  (1280 + 64 * (j))
#define XB_XGEN(j)  (2304 + 64 * (j))
#define XB_TOP      3328
#define XB_TOPGEN   3392
#define XCD_BAR_WORDS 3456
#define XB_SPIN_CAP (1u << 22)

__device__ __forceinline__ unsigned xb_ld(unsigned* p)              { return __hip_atomic_load(p, __ATOMIC_RELAXED, __HIP_MEMORY_SCOPE_AGENT); }
__device__ __forceinline__ unsigned xb_add(unsigned* p, unsigned v) { return __hip_atomic_fetch_add(p, v, __ATOMIC_RELAXED, __HIP_MEMORY_SCOPE_AGENT); }
__device__ __forceinline__ unsigned xb_xcc_id() { return (unsigned)__builtin_amdgcn_s_getreg((3 << 11) | 20) & 0xFu; }
#define XB_SPIN(cond, bar) do { unsigned _sp = 0; while (cond) { __builtin_amdgcn_s_sleep(1); \
    if ((++_sp & 255u) == 0u) { if (xb_ld(&(bar)[XB_TMO])) break; if (_sp > XB_SPIN_CAP) { atomicAdd(&(bar)[XB_TMO], 1u); break; } } } } while (0)

struct XcdBarrier { unsigned* bar; unsigned x; volatile LAS unsigned* st; };

__device__ __forceinline__ XcdBarrier xcd_barrier_post(unsigned* bar, volatile LAS unsigned* st) {
    XcdBarrier b; b.bar = bar; b.x = xb_xcc_id(); b.st = st;
    if (threadIdx.x == 0) (void)xb_add(&bar[XB_XCNT(b.x)], 1u);
    return b;
}
__device__ __forceinline__ void xcd_barrier_complete(unsigned* bar, unsigned x, unsigned& nloc, unsigned& nx) {
    const unsigned G = gridDim.x * gridDim.y * gridDim.z;
    unsigned sum, cnt, mine, sp = 0u;
    for (;;) {
        sum = 0u; cnt = 0u; mine = 0u;
#pragma unroll
        for (unsigned j = 0; j < 16; ++j) { const unsigned c = xb_ld(&bar[XB_XCNT(j)]); sum += c; cnt += (c > 0u) ? 1u : 0u; mine = (j == x) ? c : mine; }
        if (sum == G) break;
        __builtin_amdgcn_s_sleep(1);
        if ((++sp & 255u) == 0u) { if (xb_ld(&bar[XB_TMO])) break; if (sp > XB_SPIN_CAP) { atomicAdd(&bar[XB_TMO], 1u); break; } }
    }
    nloc = mine > 0u ? mine : 1u; nx = cnt > 0u ? cnt : 1u;
}
__device__ __forceinline__ void xcd_barrier(const XcdBarrier& b) {
    asm volatile("s_waitcnt vmcnt(0)" ::: "memory");
    __syncthreads();
    if (threadIdx.x == 0) {
        unsigned* bar = b.bar;
        __builtin_amdgcn_s_waitcnt(0);
        unsigned nloc = b.st[0], nx = b.st[1];
        if (nloc == 0u) { xcd_barrier_complete(bar, b.x, nloc, nx); b.st[0] = nloc; b.st[1] = nx; }
        const unsigned old = xb_add(&bar[XB_XSUB(b.x)], 1u);
        const unsigned gen = old / nloc;
        if (old + 1u == (gen + 1u) * nloc) {
            __builtin_amdgcn_fence(__ATOMIC_RELEASE, "agent");
            asm volatile("s_waitcnt vmcnt(0)" ::: "memory");
            const unsigned og = xb_add(&bar[XB_TOP], 1u);
            const unsigned tg = og / nx;
            if (og + 1u == (tg + 1u) * nx) xb_add(&bar[XB_TOPGEN], 1u);
            else XB_SPIN(xb_ld(&bar[XB_TOPGEN]) == tg, bar);
            __builtin_amdgcn_fence(__ATOMIC_ACQUIRE, "agent");
            xb_add(&bar[XB_XGEN(b.x)], 1u);
            asm volatile("s_waitcnt vmcnt(0)" ::: "memory");
        } else {
            XB_SPIN(xb_ld(&bar[XB_XGEN(b.x)]) == gen, bar);
            __builtin_amdgcn_fence(__ATOMIC_ACQUIRE, "agent");
            asm volatile("s_waitcnt vmcnt(0)" ::: "memory");
        }
    }
    __syncthreads();
}

__device__ __forceinline__ void sincos_2pi(double x, double& s, double& c) {
    const double q = __builtin_rint(x * 4.0);
    const double y = (x - q * 0.25) * 6.283185307179586476925;
    const double y2 = y * y;
    double sp = -7.6471637318198164759e-13; sp = sp * y2 + 1.6059043836821614599e-10; sp = sp * y2 - 2.5052108385441718775e-8; sp = sp * y2 + 2.7557319223985890653e-6;
    sp = sp * y2 - 1.9841269841269841270e-4; sp = sp * y2 + 8.3333333333333333333e-3; sp = sp * y2 - 1.6666666666666666667e-1; sp = sp * y2 * y + y;
    double cp = 4.7794773323873852974e-14; cp = cp * y2 - 1.1470745597729724714e-11; cp = cp * y2 + 2.0876756987868098979e-9; cp = cp * y2 - 2.7557319223985890653e-7;
    cp = cp * y2 + 2.4801587301587301587e-5; cp = cp * y2 - 1.3888888888888888889e-3; cp = cp * y2 + 4.1666666666666666667e-2; cp = cp * y2 - 0.5; cp = cp * y2 + 1.0;
    const int qi = ((int)q) & 3;
    s = (qi == 0) ? sp : (qi == 1) ? cp : (qi == 2) ? -sp : -cp;
    c = (qi == 0) ? cp : (qi == 1) ? -sp : (qi == 2) ? -cp : sp;
}
__device__ __forceinline__ void sincos_rad(double a, double& s, double& c) {
    double f = a * 0.15915494309189533576888; f -= __builtin_floor(f);
    if (f >= 1.0) f = 0.0;
    sincos_2pi(f, s, c);
}
__device__ __forceinline__ double exp_small(double x) {
    double r = 1.0 / 479001600.0;
    r = r * x + 1.0 / 39916800.0; r = r * x + 1.0 / 3628800.0; r = r * x + 1.0 / 362880.0; r = r * x + 1.0 / 40320.0; r = r * x + 1.0 / 5040.0;
    r = r * x + 1.0 / 720.0; r = r * x + 1.0 / 120.0; r = r * x + 1.0 / 24.0; r = r * x + 1.0 / 6.0; r = r * x + 0.5; r = r * x + 1.0; r = r * x + 1.0;
    return r;
}
__device__ __forceinline__ float fast_exp(float x) { return __builtin_amdgcn_exp2f(x * 1.4426950408889634f); }
__device__ __forceinline__ float sigmoidf_(float x) { return 1.0f / (1.0f + fast_exp(-x)); }
__device__ __forceinline__ float siluf_(float x) { return x * sigmoidf_(x); }
__device__ __forceinline__ float tanhf_(float x) { const float e = fast_exp(-2.0f * fabsf(x)); const float t = (1.0f - e) / (1.0f + e); return x < 0.f ? -t : t; }
__device__ __forceinline__ float gelu_tanh(float x) { return 0.5f * x * (1.0f + tanhf_(0.7978845608028654f * (x + 0.044715f * x * x * x))); }

struct Args { const float* in[43]; float* out; unsigned char* ws; int ph_lo, ph_hi; };

struct Frame {
    LAS unsigned char* lds; unsigned char* ws; int tid, lane, wave, bid, G, gw, NGW;
    const __attribute__((address_space(4))) unsigned long long* kin;
};
#define INP(i) ((const float*)F.kin[i])
#define WSP(T, off) ((T*)(F.ws + (off)))

__device__ __forceinline__ void tr_item(const float* W, int ldw, int N, bf16* WT, int ldt, int row_off, int rs16, LAS float* scr, int item, int lane) {
    const int nblk = N / 32, kb = item / nblk, nb = item % nblk, k0 = 64 * kb, n0 = 32 * nb;
#pragma unroll 8
    for (int i = 0; i < 32; ++i) { const int kk = 2 * i + (lane >> 5); scr[kk * 33 + (lane & 31)] = W[(size_t)(k0 + kk) * ldw + n0 + (lane & 31)]; }
    LDS_WAIT(); asm volatile("" ::: "memory");
    const int c = lane & 7;
#pragma unroll
    for (int j = 0; j < 4; ++j) { const int n = (lane >> 3) + 8 * j; const LAS float* s = scr + (8 * c) * 33 + n;
        v4u o; o.x = pk2(s[0 * 33], s[1 * 33]); o.y = pk2(s[2 * 33], s[3 * 33]); o.z = pk2(s[4 * 33], s[5 * 33]); o.w = pk2(s[6 * 33], s[7 * 33]);
        const int nn = n0 + n, drow = row_off + (nn >> 4) * rs16 + (nn & 15);
        *(v4u*)(WT + (size_t)drow * ldt + k0 + 8 * c) = o; }
    LDS_WAIT(); asm volatile("" ::: "memory");
}

__device__ __forceinline__ void hyfilt_item(Frame& F, int pb) {
    const float* w1 = INP(19); const float* b1 = INP(20); const float* fq = INP(21); const float* w2 = INP(22); const float* b2 = INP(23); const float* w3 = INP(24);
    LAS float* z = (LAS float*)F.lds;
    LAS float* h1 = z + 1088;
    LAS float* h2 = h1 + 2048;
    const int tid = F.tid;
    for (int idx = tid; idx < 32 * 33; idx += NTHREADS) {
        const int p = idx / 33, f = idx % 33, i = pb * 32 + p;
        float v;
        if (f == 0) v = (float)i * (1.0f / (float)(SEQ - 1));
        else { const int j = (f - 1) & 15; const float fj = 1e-4f + (float)j * ((15.0f - 1e-4f) / 15.0f);
            double fr = (double)fj * (double)i / (double)SEQ; fr -= __builtin_floor(fr); double s, c; sincos_2pi(fr, s, c); v = (f <= 16) ? (float)c : (float)(-s); }
        z[p * 33 + f] = v;
    }
    __syncthreads();
    for (int idx = tid; idx < 2048; idx += NTHREADS) {
        const int p = idx >> 6, j = idx & 63; float a = b1[j];
        for (int f = 0; f < 33; ++f) a += z[p * 33 + f] * w1[f * 64 + j];
        double s, c; sincos_rad((double)(fq[j] * a), s, c); h1[idx] = (float)s;
    }
    __syncthreads();
    for (int idx = tid; idx < 2048; idx += NTHREADS) {
        const int p = idx >> 6, j = idx & 63; float a = b2[j];
        for (int k = 0; k < 64; ++k) a += h1[p * 64 + k] * w2[k * 64 + j];
        double s, c; sincos_rad((double)(fq[64 + j] * a), s, c); h2[idx] = (float)s;
    }
    __syncthreads();
    float* kT = WSP(float, WS_KT); float* normp = WSP(float, WS_NORMP);
    for (int cc = 0; cc < 8; ++cc) {
        const int col = tid + NTHREADS * cc;
        float acc[32];
#pragma unroll
        for (int p = 0; p < 32; ++p) acc[p] = 0.f;
        for (int k = 0; k < 64; k += 4) {
            const float w0 = w3[(size_t)(k + 0) * 4096 + col], wA = w3[(size_t)(k + 1) * 4096 + col], wB = w3[(size_t)(k + 2) * 4096 + col], wC = w3[(size_t)(k + 3) * 4096 + col];
#pragma unroll
            for (int p = 0; p < 32; ++p) { const f32x4 hv = *(const LAS f32x4*)(h2 + p * 64 + k); acc[p] += hv.x * w0 + hv.y * wA + hv.z * wB + hv.w * wC; }
        }
        const int ch = col & 1023, dir = (col >> 10) & 1;
        const float adel = 3.0701134573253946f + (float)ch * ((15.350567286626972f - 3.0701134573253946f) / 1023.0f);
        float sabs = 0.f;
#pragma unroll
        for (int p = 0; p < 32; ++p) { const int i = pb * 32 + p; const float t = (float)i * (1.0f / (float)(SEQ - 1)); acc[p] *= fast_exp(-t * adel); if (!(dir == 1 && i == 0)) sabs += fabsf(acc[p]); }
        f32x4* dst = (f32x4*)(kT + (size_t)col * SEQ + pb * 32);
#pragma unroll
        for (int p = 0; p < 8; ++p) dst[p] = (f32x4){acc[4 * p], acc[4 * p + 1], acc[4 * p + 2], acc[4 * p + 3]};
        normp[(size_t)pb * 4096 + col] = sabs;
    }
    __syncthreads();
}

__device__ __forceinline__ void p0_prologue(Frame& F) {
    for (int pb = F.bid; pb < SEQ / 32; pb += F.G) hyfilt_item(F, pb);
    const int gt = F.bid * NTHREADS + F.tid, NGT = F.G * NTHREADS;
    {
        f32x2* rope = WSP(f32x2, WS_ROPE);
        for (int idx = gt; idx < 128 * 16; idx += NGT) { const int pos = idx >> 4, i = idx & 15;
            double inv = (i & 3) == 0 ? 1.0 : (i & 3) == 1 ? 0.56234132519034908 : (i & 3) == 2 ? 0.31622776601683794 : 0.17782794100389228;
            inv *= (i >> 2) == 0 ? 1.0 : (i >> 2) == 1 ? 0.1 : (i >> 2) == 2 ? 0.01 : 0.001;
            const float ang = (float)pos * (float)inv; double s, c; sincos_rad((double)ang, s, c); rope[idx] = (f32x2){(float)c, (float)s}; }
    }
    {
        f32x2* tw = WSP(f32x2, WS_TW);
        for (int idx = gt; idx < 16384; idx += NGT) { double s, c; sincos_2pi((double)idx * (1.0 / 16384.0), s, c); tw[idx] = (f32x2){(float)c, (float)(-s)}; }
    }
    {
        const float* are = INP(26); const float* aim = INP(27); const float* ldt = INP(28); const float* bre = INP(29); const float* bim = INP(30);
        f32x2* lamb = WSP(f32x2, WS_S5LAM); f32x2* bb = WSP(f32x2, WS_S5B); f32x2* l256 = WSP(f32x2, WS_S5L256);
        for (int idx = gt; idx < 2 * 64 * 64; idx += NGT) { const int dg = idx >> 6;
            const float dt = expf(ldt[dg]); const float ar = are[idx], ai = aim[idx];
            const float zr = ar * dt, zi = ai * dt; double s, c; sincos_rad((double)zi, s, c); const double er = exp_small((double)zr);
            const double lr = er * c, li = er * s; lamb[idx] = (f32x2){(float)lr, (float)li};
            { double pr = lr, pi = li; for (int q = 0; q < 8; ++q) { const double tr = pr * pr - pi * pi, ti = 2.0 * pr * pi; pr = tr; pi = ti; } l256[idx] = (f32x2){(float)pr, (float)pi}; }
            const double nr = lr - 1.0, ni = li, den = (double)ar * ar + (double)ai * ai; const double qr = (nr * ar + ni * ai) / den, qi = (ni * ar - nr * ai) / den;
            for (int cc = 0; cc < 16; ++cc) { const double br = bre[(size_t)idx * 16 + cc], bi = bim[(size_t)idx * 16 + cc]; bb[(size_t)idx * 16 + cc] = (f32x2){(float)(qr * br - qi * bi), (float)(qr * bi + qi * br)}; } }
    }
    {
        float* wrt = WSP(float, WS_WRT);
        for (int idx = gt; idx < 2 * 72 * 2048; idx += NGT) { const int l = idx / (72 * 2048), r = idx % (72 * 2048), n = r / 2048, k = r % 2048;
            wrt[idx] = n < 8 ? INP(36)[((size_t)l * 2048 + k) * 8 + n] : INP(38)[((size_t)l * 2048 + k) * 64 + (n - 8)]; }
    }
    {
        bf16* ha = WSP(bf16, WS_HA);
        for (int idx = gt; idx < 2048; idx += NGT) ha[(size_t)TT * 2048 + idx] = 0;
    }
    LAS float* scr = (LAS float*)(F.lds + F.wave * 16384);
    {
        const float* c = INP(1); const float* cctx = INP(3); const float* adaw = INP(4); float* part = WSP(float, WS_ADAP);
        for (int it = F.gw; it < 2 * 32 * 48; it += F.NGW) {
            const int l = it / (32 * 48), r = it % (32 * 48), ks = r / 48, jb = r % 48, k0 = ks * 64, j0 = jb * 256 + F.lane * 4;
            const float c0 = c[k0 + F.lane], c1 = c[2048 + k0 + F.lane], c2 = cctx[k0 + F.lane];
            const float s0 = c0 / (1.0f + expf(-c0)), s1 = c1 / (1.0f + expf(-c1)), s2 = c2 / (1.0f + expf(-c2));
            f32x4 a0 = {0.f, 0.f, 0.f, 0.f}, a1 = a0, a2 = a0;
            const float* wp = adaw + ((size_t)l * 2048 + k0) * 12288 + j0;
#pragma unroll 8
            for (int kk = 0; kk < 64; ++kk) { const f32x4 w = *(const f32x4*)(wp + (size_t)kk * 12288);
                const float t0 = __builtin_bit_cast(float, __builtin_amdgcn_readlane(__builtin_bit_cast(int, s0), kk));
                const float t1 = __builtin_bit_cast(float, __builtin_amdgcn_readlane(__builtin_bit_cast(int, s1), kk));
                const float t2 = __builtin_bit_cast(float, __builtin_amdgcn_readlane(__builtin_bit_cast(int, s2), kk));
                a0 += w * t0; a1 += w * t1; a2 += w * t2; }
            float* pp = part + ((size_t)(l * 32 + ks) * 3) * 12288 + j0;
            *(f32x4*)(pp) = a0; *(f32x4*)(pp + 12288) = a1; *(f32x4*)(pp + 2 * 12288) = a2;
        }
    }
    {
        constexpr int I0 = 2048, I1 = 1024, I2 = 1024, I3 = 2048, I4 = 4096, I5 = 2048, I6 = 128, I7 = 512, IE = 1536;
        constexpr int NSMALL = I0 + I1 + I2 + I3 + I4 + I5 + I6 + I7;
        const int NITEMS = NSMALL + 128 * IE;
        for (int it = F.gw; it < NITEMS; it += F.NGW) {
            int r = it;
            if (r < I0) { tr_item(INP(9), 4096, 2048, WSP(bf16, WS_WIN0), 2048, 0, 16, scr, r, F.lane); continue; } r -= I0;
            if (r < I1) { tr_item(INP(9) + 2048, 4096, 1024, WSP(bf16, WS_WIN0), 2048, 3072, 16, scr, r, F.lane); continue; } r -= I1;
            if (r < I2) { tr_item(INP(9) + 3072, 4096, 1024, WSP(bf16, WS_WIN0), 2048, 2048, 16, scr, r, F.lane); continue; } r -= I2;
            if (r < I3) { tr_item(INP(10), 2048, 2048, WSP(bf16, WS_WOUT0), 2048, 0, 16, scr, r, F.lane); continue; } r -= I3;
            if (r < I4) { tr_item(INP(15), 4096, 4096, WSP(bf16, WS_WIN1), 2048, 0, 16, scr, r, F.lane); continue; } r -= I4;
            if (r < I5) { tr_item(INP(16), 2048, 2048, WSP(bf16, WS_WOUT1), 2048, 0, 16, scr, r, F.lane); continue; } r -= I5;
            if (r < I6) { const int g = r / 32; tr_item(INP(13) + (size_t)g * 65536, 256, 256, WSP(bf16, WS_WPOOL), 256, g * 256, 16, scr, r % 32, F.lane); continue; } r -= I6;
            if (r < I7) { tr_item(INP(34), 1024, 1024, WSP(bf16, WS_WGLU), 1024, 0, 16, scr, r, F.lane); continue; } r -= I7;
            const int le = r / IE, q = r % IE;
            bf16* wc = (bf16*)(F.ws + WS_WMOE + (size_t)le * MOE_E_BYTES); bf16* w2t = wc + 1024 * 2048;
            if (q < 512) tr_item(INP(40) + (size_t)le * (2048 * 512), 512, 512, wc, 2048, 0, 32, scr, q, F.lane);
            else if (q < 1024) tr_item(INP(41) + (size_t)le * (2048 * 512), 512, 512, wc, 2048, 16, 32, scr, q - 512, F.lane);
            else tr_item(INP(42) + (size_t)le * (512 * 2048), 2048, 2048, w2t, 512, 0, 16, scr, q - 1024, F.lane);
        }
    }
}

__device__ __forceinline__ void p1_reduce(Frame& F) {
    const int gt = F.bid * NTHREADS + F.tid, NGT = F.G * NTHREADS;
    const float* part = WSP(float, WS_ADAP); float* mod = WSP(float, WS_MOD); const float* adab = INP(5);
    for (int idx = gt; idx < 2 * 3 * 12288; idx += NGT) { const int l = idx / (3 * 12288), r = idx % (3 * 12288), m = r / 12288, j = r % 12288;
        float a = adab[l * 12288 + j];
        for (int ks = 0; ks < 32; ++ks) a += part[((size_t)(l * 32 + ks) * 3 + m) * 12288 + j];
        mod[idx] = a; }
    const float* normp = WSP(float, WS_NORMP); float* invn = WSP(float, WS_INVN);
    for (int idx = gt; idx < 2048; idx += NGT) { const int o = idx >> 10, ch = idx & 1023; float a = 0.f;
        for (int pb = 0; pb < 256; ++pb) a += normp[(size_t)pb * 4096 + o * 2048 + ch] + normp[(size_t)pb * 4096 + o * 2048 + 1024 + ch];
        invn[idx] = 1.0f / a; }
}

__device__ __forceinline__ const float* modp(Frame& F, int l, int m, int c) { return WSP(float, WS_MOD) + ((size_t)(l * 3 + m) * 6 + c) * 2048; }
__device__ __forceinline__ int row_stream(int r) { return r < TL ? r / SEQ : 2; }

template <int MODE>
__device__ __forceinline__ void norm_phase(Frame& F, int l, float* dout) {
    const int nrows = (MODE == 3 || (MODE == 1 && l == 1)) ? TL : TT;
    float* xbuf = WSP(float, WS_X); bf16* ha = WSP(bf16, WS_HA); const bf16* Y = WSP(bf16, WS_Y);
    const float* gvec = (MODE == 0) ? INP(6) : (MODE == 1) ? INP(7) + l * 2048 : (MODE == 2) ? INP(6) + 2048 : INP(8);
    const int lane = F.lane;
    for (int r = F.gw; r < nrows; r += F.NGW) {
        const int m = row_stream(r);
        const float* src = (MODE == 0) ? (r < TL ? INP(0) + (size_t)r * 2048 : INP(2) + (size_t)(r - TL) * 2048) : xbuf + (size_t)r * 2048;
        f32x4 v[8]; float ss = 0.f;
#pragma unroll
        for (int j = 0; j < 8; ++j) v[j] = *(const f32x4*)(src + 4 * lane + 256 * j);
        if (MODE == 2 || MODE == 3) {
            const float* g2 = modp(F, MODE == 2 ? 0 : 1, m, 5);
            const bf16* y0 = Y + (size_t)(2 * r) * 2048; const bf16* y1 = y0 + 2048;
#pragma unroll
            for (int j = 0; j < 8; ++j) { const int c = 4 * lane + 256 * j; const v2u a = *(const v2u*)(y0 + c), b = *(const v2u*)(y1 + c); const f32x4 gg = *(const f32x4*)(g2 + c);
                v[j].x += gg.x * (bflo(a.x) + bflo(b.x)); v[j].y += gg.y * (bfhi(a.x) + bfhi(b.x)); v[j].z += gg.z * (bflo(a.y) + bflo(b.y)); v[j].w += gg.w * (bfhi(a.y) + bfhi(b.y)); }
            if (MODE == 2) {
#pragma unroll
                for (int j = 0; j < 8; ++j) *(f32x4*)(xbuf + (size_t)r * 2048 + 4 * lane + 256 * j) = v[j];
            }
        }
#pragma unroll
        for (int j = 0; j < 8; ++j) ss += (v[j].x * v[j].x + v[j].y * v[j].y) + (v[j].z * v[j].z + v[j].w * v[j].w);
        ss = wave_sum(ss);
        const float rs = 1.0f / sqrtf(ss * (1.0f / 2048.0f) + EPS);
        if (MODE == 3) {
#pragma unroll
            for (int j = 0; j < 8; ++j) { const int c = 4 * lane + 256 * j; const f32x4 gg = *(const f32x4*)(gvec + c); *(f32x4*)(dout + (size_t)r * 2048 + c) = v[j] * rs * gg; }
            continue;
        }
        const int lm = (MODE == 2) ? 1 : l;
        const float* sh = modp(F, lm, m, MODE == 1 ? 3 : 0); const float* sc = modp(F, lm, m, MODE == 1 ? 4 : 1);
#pragma unroll
        for (int j = 0; j < 8; ++j) { const int c = 4 * lane + 256 * j; const f32x4 gg = *(const f32x4*)(gvec + c), s1 = *(const f32x4*)(sc + c), s0 = *(const f32x4*)(sh + c);
            v[j] = (v[j] * rs * gg) * (1.0f + s1) + s0;
            v2u o; o.x = pk2(v[j].x, v[j].y); o.y = pk2(v[j].z, v[j].w); *(v2u*)(ha + (size_t)r * 2048 + c) = o; }
        if (MODE == 1) {
            const float* wrt = WSP(float, WS_WRT) + (size_t)l * 72 * 2048;
            float lgG = 0.f, lgE = 0.f;
#pragma nounroll
            for (int n = 0; n < 72; ++n) { const float* wn = wrt + (size_t)n * 2048; float a = 0.f;
#pragma unroll
                for (int j = 0; j < 8; ++j) { const f32x4 w = *(const f32x4*)(wn + 4 * lane + 256 * j); a += (v[j].x * w.x + v[j].y * w.y) + (v[j].z * w.z + v[j].w * w.w); }
                a = wave_sum(a);
                if (n < 8) { if (lane == n) lgG = a; } else { if (lane == n - 8) lgE = a; } }
            if (lane < 8) lgG += INP(37)[l * 8 + lane];
            lgE += INP(39)[l * 64 + lane];
            float gl[8]; float gmax = -INFINITY; int gi = 0;
#pragma unroll
            for (int j = 0; j < 8; ++j) { gl[j] = __shfl(lgG, j); if (gl[j] > gmax) { gmax = gl[j]; gi = j; } }
            float gsum = 0.f;
#pragma unroll
            for (int j = 0; j < 8; ++j) gsum += expf(gl[j] - gmax);
            const float pg_top = 1.0f / gsum;
            float el[8]; float emax = -INFINITY;
#pragma unroll
            for (int j = 0; j < 8; ++j) { el[j] = __shfl(lgE, gi * 8 + j); emax = fmaxf(emax, el[j]); }
            float esum = 0.f; float pe[8];
#pragma unroll
            for (int j = 0; j < 8; ++j) { pe[j] = expf(el[j] - emax); esum += pe[j]; }
            int e1 = 0; float p1 = -1.f;
#pragma unroll
            for (int j = 0; j < 8; ++j) { pe[j] /= esum; if (pe[j] > p1) { p1 = pe[j]; e1 = j; } }
            int e2 = 0; float p2 = -1.f;
#pragma unroll
            for (int j = 0; j < 8; ++j) { if (j != e1 && pe[j] > p2) { p2 = pe[j]; e2 = j; } }
            const float den = p1 + p2; const float g1 = pg_top * p1 / den, g2 = pg_top * p2 / den;
            if (lane == 0) {
                unsigned* cnt = WSP(unsigned, WS_CTL) + CW_CNT + l * 64; int* tokl = WSP(int, WS_TOKL); float* gatel = WSP(float, WS_GATEL);
                const int ex1 = gi * 8 + e1, ex2 = gi * 8 + e2;
                const unsigned k1 = atomicAdd(cnt + ex1, 1u); tokl[(size_t)ex1 * LISTCAP + k1] = 2 * r; gatel[(size_t)ex1 * LISTCAP + k1] = g1;
                const unsigned k2 = atomicAdd(cnt + ex2, 1u); tokl[(size_t)ex2 * LISTCAP + k2] = 2 * r + 1; gatel[(size_t)ex2 * LISTCAP + k2] = g2;
            }
        }
    }
}

#define EPI_ARGS const f32x4 (&acc)[2][2][4][2], const pg8::Unit& u, int wr, int wc, int fr, int fq
__device__ __forceinline__ void st_bf4(bf16* p, f32x4 v) { v2u o; o.x = cvt_pk_bf16(v.x, v.y); o.y = cvt_pk_bf16(v.z, v.w); *(v2u*)p = o; }

struct EpiQKP {
    bf16* Q; bf16* Kb; bf16* P; const f32x2* rope;
    __device__ __forceinline__ void operator()(EPI_ARGS) const {
        const int sect = u.pn >> 2, cb = (u.pn & 3) * 256; const bool latent = u.pm < TL / 256;
#pragma unroll
        for (int ai = 0; ai < 2; ++ai)
#pragma unroll
            for (int m = 0; m < 4; ++m) {
                const int r = u.pm * 256 + ai * 128 + wr * 64 + m * 16 + fr;
                int b, t; if (latent) { b = r / SEQ; t = r % SEQ; } else { b = (r - TL) / CTX; t = (r - TL) % CTX; }
                f32x4 cs0 = {1.f, 0.f, 1.f, 0.f}, cs1 = cs0;
                if (latent && sect < 2) { const int pos = (wc & 1) ? (t & 63) : (t >> 6); const f32x4* rp = (const f32x4*)(rope + pos * 16 + 4 * fq); cs0 = rp[0]; cs1 = rp[1]; }
#pragma unroll
                for (int bj = 0; bj < 2; ++bj) {
                    const int c0 = cb + bj * 128 + wc * 32 + 4 * fq;
                    f32x4 a = acc[ai][bj][m][0], bb = acc[ai][bj][m][1];
                    if (sect < 2) {
                        const f32x4 co = {cs0.x, cs0.z, cs1.x, cs1.z}, si = {cs0.y, cs0.w, cs1.y, cs1.w};
                        const f32x4 oa = a * co - bb * si, ob = a * si + bb * co; a = oa; bb = ob;
                    }
                    if (sect == 0) { a = a * QSCALE; bb = bb * QSCALE; bf16* d = Q + (size_t)r * 1024 + c0; st_bf4(d, a); st_bf4(d + 16, bb); }
                    else if (sect == 1) { const size_t kr = (size_t)b * KEYS + (latent ? CTX + t : t); bf16* d = Kb + kr * 1024 + c0; st_bf4(d, a); st_bf4(d + 16, bb); }
                    else { bf16* d = P + (size_t)r * 1024 + c0; st_bf4(d, a); st_bf4(d + 16, bb); }
                }
            }
    }
};
struct EpiVT {
    bf16* VT;
    __device__ __forceinline__ void operator()(EPI_ARGS) const {
        const bool latent = u.pn < TL / 256; const int b = latent ? u.pn / 32 : u.pn - TL / 256; const int key_t0 = latent ? CTX + (u.pn % 32) * 256 : 0;
        const int kperm = 8 * (fq & 1) + 4 * (fq >> 1);
#pragma unroll
        for (int ai = 0; ai < 2; ++ai)
#pragma unroll
            for (int m = 0; m < 4; ++m) {
                const int rr = u.pm * 256 + ai * 128 + wr * 64 + m * 16 + fr;
                bf16* rowp = VT + ((size_t)b * 1024 + rr) * KEYS + key_t0;
#pragma unroll
                for (int bj = 0; bj < 2; ++bj)
#pragma unroll
                    for (int n = 0; n < 2; ++n) st_bf4(rowp + bj * 128 + wc * 32 + 16 * n + kperm, acc[ai][bj][m][n]);
            }
    }
};
struct EpiScaleBf16 {
    bf16* O; int ldo, coff; const float* cscale;
    __device__ __forceinline__ void operator()(EPI_ARGS) const {
#pragma unroll
        for (int bj = 0; bj < 2; ++bj)
#pragma unroll
            for (int n = 0; n < 2; ++n) { const int c = u.pn * 256 + bj * 128 + wc * 32 + 16 * n + 4 * fq; const f32x4 sc = *(const f32x4*)(cscale + c);
#pragma unroll
                for (int ai = 0; ai < 2; ++ai)
#pragma unroll
                    for (int m = 0; m < 4; ++m) { const int r = u.pm * 256 + ai * 128 + wr * 64 + m * 16 + fr; st_bf4(O + (size_t)r * ldo + coff + c, acc[ai][bj][m][n] * sc); } }
    }
};
struct EpiBf16 {
    bf16* O; int ldo;
    __device__ __forceinline__ void operator()(EPI_ARGS) const {
#pragma unroll
        for (int ai = 0; ai < 2; ++ai)
#pragma unroll
            for (int m = 0; m < 4; ++m) { const int r = u.pm * 256 + ai * 128 + wr * 64 + m * 16 + fr; bf16* rowp = O + (size_t)r * ldo + u.pn * 256 + wc * 32 + 4 * fq;
#pragma unroll
                for (int bj = 0; bj < 2; ++bj)
#pragma unroll
                    for (int n = 0; n < 2; ++n) st_bf4(rowp + bj * 128 + 16 * n, acc[ai][bj][m][n]); }
    }
};
struct EpiRes {
    const float* xlat; const float* xctx; float* xout; const float* gate0;
    __device__ __forceinline__ void operator()(EPI_ARGS) const {
        const bool latent = u.pm < TL / 256;
#pragma unroll
        for (int ai = 0; ai < 2; ++ai)
#pragma unroll
            for (int m = 0; m < 4; ++m) { const int r = u.pm * 256 + ai * 128 + wr * 64 + m * 16 + fr; const int ms = latent ? r / SEQ : 2;
                const float* xi = latent ? xlat + (size_t)r * 2048 : xctx + (size_t)(r - TL) * 2048; const float* gp = gate0 + (size_t)ms * 12288;
#pragma unroll
                for (int bj = 0; bj < 2; ++bj)
#pragma unroll
                    for (int n = 0; n < 2; ++n) { const int c = u.pn * 256 + bj * 128 + wc * 32 + 16 * n + 4 * fq;
                        const f32x4 xv = *(const f32x4*)(xi + c), gv = *(const f32x4*)(gp + c); *(f32x4*)(xout + (size_t)r * 2048 + c) = xv + gv * acc[ai][bj][m][n]; } }
    }
};
struct EpiMoeUp {
    bf16* H;
    __device__ __forceinline__ void operator()(EPI_ARGS) const {
#pragma unroll
        for (int ai = 0; ai < 2; ++ai)
#pragma unroll
            for (int m = 0; m < 4; ++m) { const size_t r = (size_t)u.pm * 256 + ai * 128 + wr * 64 + m * 16 + fr;
#pragma unroll
                for (int bj = 0; bj < 2; ++bj) { const int hc = (u.pn * 256 + bj * 128 + wc * 32) / 2 + 4 * fq; const f32x4 a = acc[ai][bj][m][0], b = acc[ai][bj][m][1];
                    const f32x4 h = {siluf_(a.x) * b.x, siluf_(a.y) * b.y, siluf_(a.z) * b.z, siluf_(a.w) * b.w}; st_bf4(H + r * 512 + hc, h); } }
    }
};
struct EpiMoeDown {
    bf16* Y; const int* tokl; const float* gatel; const unsigned* cnt;
    __device__ __forceinline__ void operator()(EPI_ARGS) const {
        const int ce = (int)cnt[u.e];
#pragma unroll
        for (int ai = 0; ai < 2; ++ai)
#pragma unroll
            for (int m = 0; m < 4; ++m) { const int idx = u.idx0 + ai * 128 + wr * 64 + m * 16 + fr;
                if (idx < ce) { const int pair = tokl[(size_t)u.e * LISTCAP + idx]; const float gt = gatel[(size_t)u.e * LISTCAP + idx]; bf16* rowp = Y + (size_t)pair * 2048 + u.pn * 256 + wc * 32 + 4 * fq;
#pragma unroll
                    for (int bj = 0; bj < 2; ++bj)
#pragma unroll
                        for (int n = 0; n < 2; ++n) st_bf4(rowp + bj * 128 + 16 * n, acc[ai][bj][m][n] * gt); } }
    }
};
struct EpiGlu {
    bf16* O; int ldo, coff; const bf16* Gb; const float* bias;
    __device__ __forceinline__ void operator()(EPI_ARGS) const {
#pragma unroll
        for (int ai = 0; ai < 2; ++ai)
#pragma unroll
            for (int m = 0; m < 4; ++m) { const int r = u.pm * 256 + ai * 128 + wr * 64 + m * 16 + fr;
#pragma unroll
                for (int bj = 0; bj < 2; ++bj)
#pragma unroll
                    for (int n = 0; n < 2; ++n) { const int c = u.pn * 256 + bj * 128 + wc * 32 + 16 * n + 4 * fq; const f32x4 bv = *(const f32x4*)(bias + c); const v2u gw = *(const v2u*)(Gb + (size_t)r * 1024 + c);
                        const f32x4 a = acc[ai][bj][m][n] + bv; const f32x4 o = {bflo(gw.x) * sigmoidf_(a.x), bfhi(gw.x) * sigmoidf_(a.y), bflo(gw.y) * sigmoidf_(a.z), bfhi(gw.y) * sigmoidf_(a.w)};
                        st_bf4(O + (size_t)r * ldo + coff + c, o); } }
    }
};

struct MoeOrder {
    const LAS int* bstart;
    const unsigned* cnt; const int* tokl; int nN, G, c, nblk; long bstride, eoff; bool up;
    __device__ bool next(int i, pg8::Unit& u) const {
        const long Lx = (long)i * G + c; if (Lx >= (long)nblk * nN) return false;
        const int blk = (int)(Lx / nN); u.pn = (int)(Lx % nN); u.pm = blk;
        const int e = bstart[65 + blk];
        u.e = e; u.idx0 = (blk - bstart[e]) * 256;
        u.aoff = up ? 0 : (long)blk * 256 * 512 * 2;
        u.boff = (long)e * (long)MOE_E_BYTES + eoff + (long)u.pn * bstride;
        return true;
    }
    __device__ int arow(const pg8::Unit& u, int row) const { const int idx = u.idx0 + row; return idx < (int)cnt[u.e] ? (tokl[(size_t)u.e * LISTCAP + idx] >> 1) : TT; }
};

__device__ __forceinline__ void attn_phase(Frame& F) {
    const bf16* Q = WSP(bf16, WS_Q); const bf16* Kb = WSP(bf16, WS_K); const bf16* VT = WSP(bf16, WS_VT); bf16* cat = WSP(bf16, WS_CAT);
    LAS unsigned char* lds = F.lds;
    const int tid = F.tid, lane = F.lane, w = F.wave, sub = w & 1, qw = w >> 1, r32 = lane & 31, hi = lane >> 5;
    float lam;
    { const float* lv = INP(11); float a = lv[lane] * lv[64 + lane], b = lv[128 + lane] * lv[192 + lane]; a = wave_sum(a); b = wave_sum(b); lam = expf(a) - expf(b) + 0.2f; }
    const float* subg = INP(12);
    const int NU = 1024 + 32;
    const int xcd = F.bid & 7, jcu = F.bid >> 3;
    for (int it = 0;; ++it) {
        int uidx;
        if (F.G == 256) { if (it < 4) uidx = 128 * xcd + it * 32 + jcu; else if (it == 4 && F.bid < 32) uidx = 1024 + F.bid; else break; }
        else { uidx = it * F.G + F.bid; if (uidx >= NU) break; }
        int b, head, q0row, nt; size_t kbase;
        if (uidx < 1024) { const int combo = uidx >> 6, qb = uidx & 63; b = combo >> 3; head = combo & 7; q0row = b * SEQ + qb * 128; nt = KEYS / 64; }
        else { const int v = uidx - 1024; b = v >> 4; head = (v >> 1) & 7; q0row = TL + b * CTX + (v & 1) * 128; nt = CTX / 64; }
        kbase = (size_t)b * KEYS;
        bf16x8 qf[4];
        { const bf16* qp = Q + (size_t)(q0row + qw * 32 + r32) * 1024 + head * 128 + sub * 64 + hi * 8;
#pragma unroll
          for (int ks = 0; ks < 4; ++ks) qf[ks] = *(const bf16x8*)(qp + ks * 16); }
        const int srow = tid >> 3, sch = tid & 7;
        const bf16* gk0 = Kb + (kbase + srow) * 1024 + head * 128 + sch * 8;
        const bf16* gv0 = VT + ((size_t)(b * 8 + head) * 128 + srow) * KEYS + sch * 8;
        const int lk = srow * 128 + ((sch ^ ((srow >> 1) & 7)) * 16);
        v4u st0, st1, st2, st3;
#define ATT_LOAD(t) do { st0 = *(const v4u*)(gk0 + (size_t)(t) * 65536); st1 = *(const v4u*)(gk0 + (size_t)(t) * 65536 + 64); st2 = *(const v4u*)(gv0 + (t) * 64); st3 = *(const v4u*)(gv0 + (size_t)64 * KEYS + (t) * 64); } while (0)
#define ATT_STORE(buf) do { LAS unsigned char* bp = lds + (buf) * 32768; *(LAS v4u*)(bp + lk) = st0; *(LAS v4u*)(bp + 8192 + lk) = st1; *(LAS v4u*)(bp + 16384 + lk) = st2; *(LAS v4u*)(bp + 16384 + 8192 + lk) = st3; } while (0)
        ATT_LOAD(0); ATT_STORE(0);
        __syncthreads();
        f32x16 o[4];
#pragma unroll
        for (int d = 0; d < 4; ++d)
#pragma unroll
            for (int r = 0; r < 16; ++r) o[d][r] = 0.f;
        float mrow = -INFINITY, lrow = 0.f;
        const int rdoff = r32 * 128;
        const int swz = (r32 >> 1) & 7;
        for (int t = 0; t < nt; ++t) {
            if (t + 1 < nt) ATT_LOAD(t + 1);
            const LAS unsigned char* bp = lds + (t & 1) * 32768;
            const LAS unsigned char* kp = bp + sub * 8192;
            f32x16 s0, s1;
#pragma unroll
            for (int r = 0; r < 16; ++r) { s0[r] = 0.f; s1[r] = 0.f; }
#pragma unroll
            for (int ks = 0; ks < 4; ++ks) {
                const int ch = ((2 * ks + hi) ^ swz) * 16;
                const bf16x8 k0 = *(const LAS bf16x8*)(kp + rdoff + ch);
                const bf16x8 k1 = *(const LAS bf16x8*)(kp + 4096 + rdoff + ch);
                s0 = __builtin_amdgcn_mfma_f32_32x32x16_bf16(k0, qf[ks], s0, 0, 0, 0);
                s1 = __builtin_amdgcn_mfma_f32_32x32x16_bf16(k1, qf[ks], s1, 0, 0, 0);
            }
            float mx = s0[0];
#pragma unroll
            for (int r = 1; r < 16; ++r) mx = fmaxf(mx, s0[r]);
#pragma unroll
            for (int r = 0; r < 16; ++r) mx = fmaxf(mx, s1[r]);
            mx = fmaxf(mx, __shfl_xor(mx, 32));
            const float mnew = fmaxf(mrow, mx);
            const float alpha = __builtin_amdgcn_exp2f(mrow - mnew);
            mrow = mnew;
            float rs = 0.f;
#pragma unroll
            for (int r = 0; r < 16; ++r) { s0[r] = __builtin_amdgcn_exp2f(s0[r] - mnew); rs += s0[r]; }
#pragma unroll
            for (int r = 0; r < 16; ++r) { s1[r] = __builtin_amdgcn_exp2f(s1[r] - mnew); rs += s1[r]; }
            lrow = lrow * alpha + rs;
            if (__any(alpha != 1.0f)) {
#pragma unroll
                for (int d = 0; d < 4; ++d)
#pragma unroll
                    for (int r = 0; r < 16; ++r) o[d][r] *= alpha;
            }
            bf16x8 pf[4];
#pragma unroll
            for (int s = 0; s < 4; ++s) { v4u pw;
                if (s < 2) { pw.x = cvt_pk_bf16(s0[8 * s + 0], s0[8 * s + 1]); pw.y = cvt_pk_bf16(s0[8 * s + 2], s0[8 * s + 3]); pw.z = cvt_pk_bf16(s0[8 * s + 4], s0[8 * s + 5]); pw.w = cvt_pk_bf16(s0[8 * s + 6], s0[8 * s + 7]); }
                else { const int q = s - 2; pw.x = cvt_pk_bf16(s1[8 * q + 0], s1[8 * q + 1]); pw.y = cvt_pk_bf16(s1[8 * q + 2], s1[8 * q + 3]); pw.z = cvt_pk_bf16(s1[8 * q + 4], s1[8 * q + 5]); pw.w = cvt_pk_bf16(s1[8 * q + 6], s1[8 * q + 7]); }
                pf[s] = __builtin_bit_cast(bf16x8, pw); }
            const LAS unsigned char* vp = bp + 16384;
#pragma unroll
            for (int d = 0; d < 4; ++d)
#pragma unroll
                for (int s = 0; s < 4; ++s) {
                    const bf16x8 vf = *(const LAS bf16x8*)(vp + d * 4096 + rdoff + (((2 * s + hi) ^ swz) * 16));
                    o[d] = __builtin_amdgcn_mfma_f32_32x32x16_bf16(vf, pf[s], o[d], 0, 0, 0);
                }
            if (t + 1 < nt) ATT_STORE((t + 1) & 1);
            __syncthreads();
        }
#undef ATT_LOAD
#undef ATT_STORE
        const float ltot = lrow + __shfl_xor(lrow, 32); const float linv = 1.0f / ltot;
        LAS float* xch = (LAS float*)lds + (size_t)(qw * 32 + r32) * 132;
        if (sub == 1) {
#pragma unroll
            for (int d = 0; d < 4; ++d)
#pragma unroll
                for (int g = 0; g < 4; ++g) *(LAS f32x4*)(xch + 32 * d + 8 * g + 4 * hi) = (f32x4){o[d][4 * g] * linv, o[d][4 * g + 1] * linv, o[d][4 * g + 2] * linv, o[d][4 * g + 3] * linv};
        }
        __syncthreads();
        if (sub == 0) {
            float ss = 0.f;
#pragma unroll
            for (int d = 0; d < 4; ++d)
#pragma unroll
                for (int g = 0; g < 4; ++g) { const f32x4 o2 = *(const LAS f32x4*)(xch + 32 * d + 8 * g + 4 * hi);
#pragma unroll
                    for (int j = 0; j < 4; ++j) { const float v = o[d][4 * g + j] * linv - lam * o2[j]; o[d][4 * g + j] = v; ss += v * v; } }
            ss += __shfl_xor(ss, 32);
            const float rn = 0.8f / sqrtf(ss * (1.0f / 128.0f) + EPS);
            bf16* op = cat + (size_t)(q0row + qw * 32 + r32) * 2048 + head * 128;
#pragma unroll
            for (int d = 0; d < 4; ++d)
#pragma unroll
                for (int g = 0; g < 4; ++g) { const int dv = 32 * d + 8 * g + 4 * hi; const f32x4 gg = *(const f32x4*)(subg + dv);
                    st_bf4(op + dv, (f32x4){o[d][4 * g] * rn * gg.x, o[d][4 * g + 1] * rn * gg.y, o[d][4 * g + 2] * rn * gg.z, o[d][4 * g + 3] * rn * gg.w}); }
        }
        __syncthreads();
    }
}

__device__ __forceinline__ void poold_phase(Frame& F) {
    const bf16* P = WSP(bf16, WS_P); bf16* PD = WSP(bf16, WS_PD);
    const int gt = F.bid * NTHREADS + F.tid, NGT = F.G * NTHREADS;
    for (int idx = gt; idx < TT * 128; idx += NGT) {
        const int r = idx >> 7, cc = (idx & 127) * 8, g = cc >> 8, wdw = 2 << g;
        int sb, t, Ls; if (r < TL) { sb = (r / SEQ) * SEQ; t = r % SEQ; Ls = SEQ; } else { sb = TL + ((r - TL) / CTX) * CTX; t = (r - TL) % CTX; Ls = CTX; }
        int lo = t - wdw / 2, hi = lo + wdw; lo = lo < 0 ? 0 : lo; hi = hi > Ls ? Ls : hi;
        float a[8];
#pragma unroll
        for (int j = 0; j < 8; ++j) a[j] = 0.f;
        for (int s = lo; s < hi; ++s) { const v4u v = *(const v4u*)(P + (size_t)(sb + s) * 1024 + cc);
            a[0] += bflo(v.x); a[1] += bfhi(v.x); a[2] += bflo(v.y); a[3] += bfhi(v.y); a[4] += bflo(v.z); a[5] += bfhi(v.z); a[6] += bflo(v.w); a[7] += bfhi(v.w); }
        const float inv = 1.0f / (float)(hi - lo);
        const v4u me = *(const v4u*)(P + (size_t)r * 1024 + cc);
        v4u o; o.x = pk2(a[0] * inv - bflo(me.x), a[1] * inv - bfhi(me.x)); o.y = pk2(a[2] * inv - bflo(me.y), a[3] * inv - bfhi(me.y));
        o.z = pk2(a[4] * inv - bflo(me.z), a[5] * inv - bfhi(me.z)); o.w = pk2(a[6] * inv - bflo(me.w), a[7] * inv - bfhi(me.w));
        *(v4u*)(PD + (size_t)r * 1024 + cc) = o;
    }
}

__device__ __forceinline__ void shortconv_phase(Frame& F) {
    const bf16* PJ = WSP(bf16, WS_PROJ1); float* GT = WSP(float, WS_GT);
    const float* cw = INP(17); const float* cb = INP(18);
    LAS float* scr = (LAS float*)(F.lds + F.wave * 16896);
    const int lane = F.lane;
    for (int it = F.gw; it < 2 * 128 * 48; it += F.NGW) {
        const int cbk = it % 48, tb = (it / 48) % 128, b = it / (48 * 128), col = cbk * 64 + lane, t0 = tb * 64;
        const float w0 = cw[col], w1 = cw[3072 + col], w2 = cw[2 * 3072 + col], bias = cb[col];
        const bf16* base = PJ + ((size_t)b * SEQ) * 4096 + col;
        float prev = (t0 > 0) ? bf2f(base[(size_t)(t0 - 1) * 4096]) : 0.f;
        float cur = bf2f(base[(size_t)t0 * 4096]);
#pragma unroll 8
        for (int tt = 0; tt < 64; ++tt) { const int t = t0 + tt; const float nxt = (t + 1 < SEQ) ? bf2f(base[(size_t)(t + 1) * 4096]) : 0.f;
            scr[tt * 65 + lane] = prev * w0 + cur * w1 + nxt * w2 + bias; prev = cur; cur = nxt; }
        LDS_WAIT(); asm volatile("" ::: "memory");
        for (int c = 0; c < 64; ++c) GT[((size_t)(cbk * 64 + c) * 2 + b) * SEQ + t0 + lane] = scr[lane * 65 + c];
        LDS_WAIT(); asm volatile("" ::: "memory");
    }
}

__device__ __forceinline__ void s5_scan_phase(Frame& F) {
    const bf16* PJ = WSP(bf16, WS_PROJ1); float* YD = WSP(float, WS_YD);
    const f32x2* lamb = WSP(f32x2, WS_S5LAM); const f32x2* bbar = WSP(f32x2, WS_S5B);
    const float* cre = INP(31); const float* cim = INP(32);
    const int lane = F.lane;
    for (int task = F.wave * F.G + F.bid; task < 256; task += F.NGW) {
        const int di = task >> 7, b = (task >> 6) & 1, g = task & 63;
        const int dgp = (di * 64 + g) * 64 + lane;
        const f32x2 lam = lamb[dgp];
        float br[16], bi[16], cr[16], ci[16];
#pragma unroll
        for (int c = 0; c < 16; ++c) { const f32x2 bv = bbar[(size_t)dgp * 16 + c]; br[c] = bv.x; bi[c] = bv.y;
            cr[c] = cre[((size_t)(di * 64 + g) * 16 + c) * 64 + lane]; ci[c] = cim[((size_t)(di * 64 + g) * 16 + c) * 64 + lane]; }
        float sr = 0.f, si = 0.f;
        const int nsteps = CTX + SEQ;
        for (int st = 0; st < nsteps; st += 4) {
            const int stl = st + (lane >> 4);
            int row;
            if (stl < CTX) row = TL + b * CTX + (di == 0 ? stl : CTX - 1 - stl);
            else row = b * SEQ + (di == 0 ? stl - CTX : SEQ - 1 - (stl - CTX));
            const float uval = bf2f(PJ[(size_t)row * 4096 + 3072 + g * 16 + (lane & 15)]);
#pragma unroll
            for (int k = 0; k < 4; ++k) {
                float bur = 0.f, bui = 0.f;
#pragma unroll
                for (int c = 0; c < 16; ++c) { const float u = __builtin_bit_cast(float, __builtin_amdgcn_readlane(__builtin_bit_cast(int, uval), 16 * k + c)); bur += br[c] * u; bui += bi[c] * u; }
                const float nr = lam.x * sr - lam.y * si + bur, ni = lam.x * si + lam.y * sr + bui; sr = nr; si = ni;
                const int s2 = st + k;
                if (s2 >= CTX) {
                    const int t = (di == 0) ? s2 - CTX : SEQ - 1 - (s2 - CTX);
                    float outv = 0.f;
#pragma unroll
                    for (int c = 0; c < 16; ++c) { float v = cr[c] * sr - ci[c] * si; v = wave_sum(v); if (lane == c) outv = v; }
                    if (lane < 16) YD[((size_t)di * TL + (size_t)b * SEQ + t) * 1024 + g * 16 + lane] = outv;
                }
            }
        }
    }
}

__device__ __forceinline__ void hyena_naive_phase(Frame& F) {
    const float* GT = WSP(float, WS_GT); const float* kT = WSP(float, WS_KT); const float* invn = WSP(float, WS_INVN); bf16* cat = WSP(bf16, WS_CAT);
    const float* hyb = INP(25);
    LAS float* kf = (LAS float*)F.lds;
    LAS f32x2* ub = (LAS f32x2*)(F.lds + 65536);
    const int tid = F.tid;
    for (int ch = F.bid; ch < 1024; ch += F.G) {
        float res0[16], res1[16];
        for (int o = 0; o < 2; ++o) {
            const float inv = invn[o * 1024 + ch];
            const float* kfw = kT + (size_t)(o * 2048 + ch) * SEQ; const float* kbw = kT + (size_t)(o * 2048 + 1024 + ch) * SEQ;
            for (int n = tid; n < 16384; n += NTHREADS) { float v; if (n < SEQ) v = kfw[n]; else if (n == SEQ) v = 0.f; else v = kbw[16384 - n]; kf[n] = v * inv; }
            if (o == 0) { const float* v0 = GT + ((size_t)(0 * 1024 + ch) * 2) * SEQ; for (int n = tid; n < SEQ; n += NTHREADS) ub[n] = (f32x2){v0[n], v0[SEQ + n]}; }
            else {
#pragma unroll
                for (int j = 0; j < 16; ++j) ub[tid + NTHREADS * j] = (f32x2){res0[j], res1[j]}; }
            __syncthreads();
            float a0[16], a1[16];
#pragma unroll
            for (int j = 0; j < 16; ++j) { a0[j] = 0.f; a1[j] = 0.f; }
            for (int s = 0; s < SEQ; ++s) { const f32x2 u = ub[s];
#pragma unroll
                for (int j = 0; j < 16; ++j) { const float kk = kf[(tid + NTHREADS * j - s) & 16383]; a0[j] += u.x * kk; a1[j] += u.y * kk; } }
            const float bias = hyb[o * 1024 + ch];
            const float* xg = GT + ((size_t)((o + 1) * 1024 + ch) * 2) * SEQ;
#pragma unroll
            for (int j = 0; j < 16; ++j) { const int t = tid + NTHREADS * j; const f32x2 u = ub[t];
                res0[j] = xg[t] * (a0[j] + bias * u.x); res1[j] = xg[SEQ + t] * (a1[j] + bias * u.y); }
            __syncthreads();
        }
#pragma unroll
        for (int j = 0; j < 16; ++j) { const int t = tid + NTHREADS * j;
            cat[(size_t)t * 2048 + ch] = (bf16)f2bf(res0[j]); cat[((size_t)SEQ + t) * 2048 + ch] = (bf16)f2bf(res1[j]); }
    }
}

__device__ __forceinline__ void s5_gelu_phase(Frame& F) {
    const bf16* PJ = WSP(bf16, WS_PROJ1); const float* YD = WSP(float, WS_YD); bf16* Gb = WSP(bf16, WS_PD); const float* dd = INP(33);
    const int gt = F.bid * NTHREADS + F.tid, NGT = F.G * NTHREADS;
    for (int idx = gt; idx < TL * 256; idx += NGT) { const int r = idx >> 8, c = (idx & 255) * 4;
        const v2u uw = *(const v2u*)(PJ + (size_t)r * 4096 + 3072 + c); const f32x4 d4 = *(const f32x4*)(dd + c);
        const f32x4 y0 = *(const f32x4*)(YD + (size_t)r * 1024 + c), y1 = *(const f32x4*)(YD + ((size_t)TL + r) * 1024 + c);
        const f32x4 y = {bflo(uw.x) * d4.x + y0.x + y1.x, bfhi(uw.x) * d4.y + y0.y + y1.y, bflo(uw.y) * d4.z + y0.z + y1.z, bfhi(uw.y) * d4.w + y0.w + y1.w};
        st_bf4(Gb + (size_t)r * 1024 + c, (f32x4){gelu_tanh(y.x), gelu_tanh(y.y), gelu_tanh(y.z), gelu_tanh(y.w)}); }
}

__device__ __forceinline__ f32x2 cmulf(f32x2 a, f32x2 b) { return (f32x2){a.x * b.x - a.y * b.y, a.x * b.y + a.y * b.x}; }
__device__ __forceinline__ int drev14(int p) { const unsigned r = __builtin_bitreverse32((unsigned)p) >> 18; return (int)(((r & 0x2AAAu) >> 1) | ((r & 0x1555u) << 1)); }
__device__ __forceinline__ void fft_fwd(LAS f32x2* X, const f32x2* tw, int tid) {
#pragma nounroll
    for (int L = 4096; L >= 1; L >>= 2) {
        const int tws = 4096 / L;
#pragma unroll 2
        for (int i = 0; i < 8; ++i) {
            const int b = tid + NTHREADS * i, j = b & (L - 1), i0 = (b - j) * 4 + j;
            const f32x2 x0 = X[i0], x1 = X[i0 + L], x2 = X[i0 + 2 * L], x3 = X[i0 + 3 * L];
            const f32x2 w1 = tw[j * tws], w2 = cmulf(w1, w1), w3 = cmulf(w2, w1);
            const f32x2 a = x0 + x2, bb = x0 - x2, c = x1 + x3, d = x1 - x3;
            const f32x2 t1 = {bb.x + d.y, bb.y - d.x}, t3 = {bb.x - d.y, bb.y + d.x};
            X[i0] = a + c; X[i0 + L] = cmulf(t1, w1); X[i0 + 2 * L] = cmulf(a - c, w2); X[i0 + 3 * L] = cmulf(t3, w3);
        }
        __syncthreads();
    }
}
__device__ __forceinline__ void fft_inv(LAS f32x2* X, const f32x2* tw, int tid) {
#pragma nounroll
    for (int L = 1; L <= 4096; L <<= 2) {
        const int tws = 4096 / L;
#pragma unroll 2
        for (int i = 0; i < 8; ++i) {
            const int b = tid + NTHREADS * i, j = b & (L - 1), i0 = (b - j) * 4 + j;
            f32x2 w1 = tw[j * tws]; w1.y = -w1.y; const f32x2 w2 = cmulf(w1, w1), w3 = cmulf(w2, w1);
            const f32x2 x0 = X[i0], x1 = cmulf(X[i0 + L], w1), x2 = cmulf(X[i0 + 2 * L], w2), x3 = cmulf(X[i0 + 3 * L], w3);
            const f32x2 a = x0 + x2, bb = x0 - x2, c = x1 + x3, d = x1 - x3;
            X[i0] = a + c; X[i0 + L] = (f32x2){bb.x - d.y, bb.y + d.x}; X[i0 + 2 * L] = a - c; X[i0 + 3 * L] = (f32x2){bb.x + d.y, bb.y - d.x};
        }
        __syncthreads();
    }
}
__device__ __forceinline__ void fft_pointwise(LAS f32x2* X, const f32x2* Wg, int o, float scale, int tid) {
    const float hs = 0.5f * scale;
#pragma unroll 4
    for (int i = 0; i < 32; ++i) {
        const int p = tid + NTHREADS * i, f = drev14(p), pm = drev14((16384 - f) & 16383);
        const unsigned long long ua = __hip_atomic_load((const unsigned long long*)(Wg + p), __ATOMIC_RELAXED, __HIP_MEMORY_SCOPE_AGENT);
        const unsigned long long ub = __hip_atomic_load((const unsigned long long*)(Wg + pm), __ATOMIC_RELAXED, __HIP_MEMORY_SCOPE_AGENT);
        const f32x2 A = __builtin_bit_cast(f32x2, ua), B = __builtin_bit_cast(f32x2, ub);
        f32x2 K;
        if (o == 0) K = (f32x2){(A.x + B.x) * hs, (A.y - B.y) * hs};
        else { const f32x2 dd = {A.x - B.x, A.y + B.y}; K = (f32x2){dd.y * hs, -dd.x * hs}; }
        X[p] = cmulf(X[p], K);
    }
    __syncthreads();
}
__device__ __forceinline__ void hyena_fft_phase(Frame& F) {
    float* GT = WSP(float, WS_GT); const float* kT = WSP(float, WS_KT); const float* invn = WSP(float, WS_INVN); const f32x2* tw = WSP(f32x2, WS_TW);
    f32x2* Wg = WSP(f32x2, WS_FFTW) + (size_t)F.bid * 16384;
    const float* hyb = INP(25);
    LAS f32x2* X = (LAS f32x2*)F.lds;
    const int tid = F.tid;
    for (int ch = F.bid; ch < 1024; ch += F.G) {
        { const float* f0 = kT + (size_t)ch * SEQ; const float* b0 = kT + (size_t)(1024 + ch) * SEQ; const float* f1 = kT + (size_t)(2048 + ch) * SEQ; const float* b1 = kT + (size_t)(3072 + ch) * SEQ;
          for (int n = tid; n < SEQ; n += NTHREADS) { X[n] = (f32x2){f0[n], f1[n]}; X[SEQ + n] = (n == 0) ? (f32x2){0.f, 0.f} : (f32x2){b0[SEQ - n], b1[SEQ - n]}; } }
        __syncthreads();
        fft_fwd(X, tw, tid);
        for (int n = tid; n < 16384; n += NTHREADS) Wg[n] = X[n];
        __syncthreads();
        float* v0 = GT + ((size_t)ch * 2) * SEQ;
        const float* x1 = GT + ((size_t)(1024 + ch) * 2) * SEQ; const float* x2 = GT + ((size_t)(2048 + ch) * 2) * SEQ;
        float z0[16], z1[16];
#pragma unroll
        for (int j = 0; j < 16; ++j) { const int n = tid + NTHREADS * j; z0[j] = v0[n]; z1[j] = v0[SEQ + n]; }
#pragma unroll
        for (int o = 0; o < 2; ++o) {
#pragma unroll
            for (int j = 0; j < 16; ++j) { const int n = tid + NTHREADS * j; X[n] = (f32x2){z0[j], z1[j]}; X[SEQ + n] = (f32x2){0.f, 0.f}; }
            __syncthreads();
            fft_fwd(X, tw, tid);
            fft_pointwise(X, Wg, o, invn[o * 1024 + ch] * (1.0f / 16384.0f), tid);
            fft_inv(X, tw, tid);
            const float bias = hyb[o * 1024 + ch]; const float* xg = (o == 0) ? x1 : x2;
#pragma unroll
            for (int j = 0; j < 16; ++j) { const int n = tid + NTHREADS * j; const f32x2 y = X[n]; z0[j] = xg[n] * (y.x + bias * z0[j]); z1[j] = xg[SEQ + n] * (y.y + bias * z1[j]); }
            __syncthreads();
        }
#pragma unroll
        for (int j = 0; j < 16; ++j) { const int n = tid + NTHREADS * j; v0[n] = z0[j]; v0[SEQ + n] = z1[j]; }
    }
}
__device__ __forceinline__ void hyena_out_transpose(Frame& F) {
    const float* GT = WSP(float, WS_GT); bf16* cat = WSP(bf16, WS_CAT);
    LAS float* scr = (LAS float*)(F.lds + F.wave * 16896);
    const int lane = F.lane;
    for (int it = F.gw; it < 2 * 128 * 16; it += F.NGW) {
        const int cbk = it & 15, tb = (it >> 4) & 127, b = it >> 11, t0 = tb * 64;
        for (int c = 0; c < 64; ++c) scr[c * 65 + lane] = GT[((size_t)(cbk * 64 + c) * 2 + b) * SEQ + t0 + lane];
        LDS_WAIT(); asm volatile("" ::: "memory");
        for (int tt = 0; tt < 64; ++tt) cat[((size_t)b * SEQ + t0 + tt) * 2048 + cbk * 64 + lane] = (bf16)f2bf(scr[lane * 65 + tt]);
        LDS_WAIT(); asm volatile("" ::: "memory");
    }
}

__device__ __forceinline__ int s5_row(int di, int b, int s) {
    return (s < CTX) ? TL + b * CTX + (di == 0 ? s : CTX - 1 - s) : b * SEQ + (di == 0 ? s - CTX : SEQ - 1 - (s - CTX));
}
template <bool OUTPUT>
__device__ __forceinline__ void s5_seg_phase(Frame& F) {
    const bf16* PJ = WSP(bf16, WS_PROJ1); float* YD = WSP(float, WS_YD);
    const f32x2* lamb = WSP(f32x2, WS_S5LAM); const f32x2* bbar = WSP(f32x2, WS_S5B); const f32x2* l256 = WSP(f32x2, WS_S5L256); f32x2* Eb = WSP(f32x2, WS_S5E);
    const float* cre = INP(31); const float* cim = INP(32);
    const int lane = F.lane;
    for (int task = F.wave * F.G + F.bid; task < 256 * 32; task += F.NGW) {
        const int dbg = task >> 5, seg = (task & 31) + (OUTPUT ? 1 : 0);
        const int di = dbg >> 7, b = (dbg >> 6) & 1, g = dbg & 63;
        const int dgp = (di * 64 + g) * 64 + lane;
        const f32x2 lam = lamb[dgp];
        float br[16], bi[16];
#pragma unroll
        for (int c = 0; c < 16; ++c) { const f32x2 bv = bbar[(size_t)dgp * 16 + c]; br[c] = bv.x; bi[c] = bv.y; }
        float cr[16], ci[16];
        if (OUTPUT) {
#pragma unroll
            for (int c = 0; c < 16; ++c) { cr[c] = cre[((size_t)(di * 64 + g) * 16 + c) * 64 + lane]; ci[c] = cim[((size_t)(di * 64 + g) * 16 + c) * 64 + lane]; }
        }
        float sr = 0.f, si = 0.f;
        if (OUTPUT) {
            const f32x2 l2 = l256[dgp]; const f32x2* ep = Eb + ((size_t)dbg * 32) * 64 + lane;
            for (int k = 0; k < seg; ++k) { const f32x2 e = ep[(size_t)k * 64]; const float nr = l2.x * sr - l2.y * si + e.x, ni = l2.x * si + l2.y * sr + e.y; sr = nr; si = ni; }
        }
        const int s0 = seg * 256;
#pragma nounroll
        for (int st = 0; st < 256; st += 4) {
            const int row = s5_row(di, b, s0 + st + (lane >> 4));
            const float uval = bf2f(PJ[(size_t)row * 4096 + 3072 + g * 16 + (lane & 15)]);
#pragma unroll
            for (int k = 0; k < 4; ++k) {
                float bur = 0.f, bui = 0.f;
#pragma unroll
                for (int c = 0; c < 16; ++c) { const float u = __builtin_bit_cast(float, __builtin_amdgcn_readlane(__builtin_bit_cast(int, uval), 16 * k + c)); bur += br[c] * u; bui += bi[c] * u; }
                const float nr = lam.x * sr - lam.y * si + bur, ni = lam.x * si + lam.y * sr + bui; sr = nr; si = ni;
                if (OUTPUT) {
                    float v8[8], v4[4], v2[2], v1;
                    const bool b5 = (lane & 32) != 0, b4 = (lane & 16) != 0, b3 = (lane & 8) != 0, b2 = (lane & 4) != 0;
#pragma unroll
                    for (int i = 0; i < 8; ++i) { const float lo = cr[i] * sr - ci[i] * si, hi = cr[i + 8] * sr - ci[i + 8] * si; const float keep = b5 ? hi : lo, send = b5 ? lo : hi; v8[i] = keep + __shfl_xor(send, 32); }
#pragma unroll
                    for (int i = 0; i < 4; ++i) { const float keep = b4 ? v8[i + 4] : v8[i], send = b4 ? v8[i] : v8[i + 4]; v4[i] = keep + __shfl_xor(send, 16); }
#pragma unroll
                    for (int i = 0; i < 2; ++i) { const float keep = b3 ? v4[i + 2] : v4[i], send = b3 ? v4[i] : v4[i + 2]; v2[i] = keep + __shfl_xor(send, 8); }
                    { const float keep = b2 ? v2[1] : v2[0], send = b2 ? v2[0] : v2[1]; v1 = keep + __shfl_xor(send, 4); }
                    v1 += __shfl_xor(v1, 2); v1 += __shfl_xor(v1, 1);
                    const int s = s0 + st + k, t = (di == 0) ? s - CTX : SEQ - 1 - (s - CTX);
                    if ((lane & 3) == 0) YD[((size_t)di * TL + (size_t)b * SEQ + t) * 1024 + g * 16 + (lane >> 2)] = v1;
                }
            }
        }
        if (!OUTPUT) Eb[((size_t)dbg * 32 + seg) * 64 + lane] = (f32x2){sr, si};
    }
}

constexpr int NPHASES = 21;
#ifndef MK_SINGLE
#define MK_SINGLE 1
#endif

__device__ __forceinline__ unsigned long long launder_u64(unsigned long long v) {
    unsigned lo = (unsigned)v, hi = (unsigned)(v >> 32);
    asm volatile("" : "+v"(lo), "+v"(hi));
    lo = __builtin_amdgcn_readfirstlane(lo); hi = __builtin_amdgcn_readfirstlane(hi);
    return ((unsigned long long)hi << 32) | lo;
}
__device__ __forceinline__ const void* launder_ptr(const void* p) {
    unsigned long long v = (unsigned long long)p; unsigned lo = (unsigned)v, hi = (unsigned)(v >> 32);
    asm volatile("" : "+v"(lo), "+v"(hi));
    lo = __builtin_amdgcn_readfirstlane(lo); hi = __builtin_amdgcn_readfirstlane(hi);
    return (const void*)(((unsigned long long)hi << 32) | lo);
}
__device__ __forceinline__ void moe_blocks(Frame& F, int l, LAS int* bstart) {
    __syncthreads();
    if (F.tid == 0) { const unsigned* cnt = WSP(unsigned, WS_CTL) + CW_CNT + l * 64; int acc = 0;
        for (int e = 0; e < 64; ++e) { bstart[e] = acc; const int nb = ((int)cnt[e] + 255) >> 8; for (int j = 0; j < nb; ++j) bstart[65 + acc + j] = e; acc += nb; } bstart[64] = acc; }
    __syncthreads();
}

template <int PHSEL>
__global__ void __launch_bounds__(NTHREADS, 2) mk_fwd(Args args) {
    extern __shared__ __attribute__((aligned(16))) unsigned char lds_raw[];
    Frame F;
    F.lds = (LAS unsigned char*)lds_raw; F.ws = args.ws; F.kin = (const __attribute__((address_space(4))) unsigned long long*)__builtin_amdgcn_kernarg_segment_ptr();
    F.tid = threadIdx.x; F.lane = F.tid & 63; F.wave = __builtin_amdgcn_readfirstlane(F.tid >> 6); F.bid = blockIdx.x; F.G = gridDim.x;
    F.gw = F.bid * NWAVES + F.wave; F.NGW = F.G * NWAVES;
    volatile LAS unsigned* lctl = (volatile LAS unsigned*)(F.lds + LDS_CTL);
    LAS int* bstart = (LAS int*)(F.lds + LDS_CTL + 64);
    if (F.tid < 4) lctl[F.tid] = 0u;
    __syncthreads();
    const int lo = args.ph_lo, hi = args.ph_hi;
    XcdBarrier bar; bar.bar = WSP(unsigned, WS_CTL) + CW_BAR; bar.x = 0; bar.st = lctl;
    if (PHSEL < 0) bar = xcd_barrier_post(WSP(unsigned, WS_CTL) + CW_BAR, lctl);
#ifndef PH_MASK
#define PH_MASK 0xffffffffu
#endif
#define IN(k) (((PH_MASK >> (k)) & 1u) && (PHSEL < 0 || PHSEL == (k)))
#define INL(j) (((PH_MASK >> (6 + (j))) & 1u) && (PHSEL < 0 || (PHSEL == 6 + (j) && lo == pb + (j))))
#define PH_END(k) do { if (PHSEL < 0) xcd_barrier(bar); } while (0)
#define PH_BEGIN() do { F.ws = (unsigned char*)launder_ptr((const void*)F.ws); F.kin = (const __attribute__((address_space(4))) unsigned long long*)launder_u64((unsigned long long)F.kin); \
    { int _t = threadIdx.x; asm volatile("" : "+v"(_t)); F.tid = _t; F.lane = _t & 63; F.wave = __builtin_amdgcn_readfirstlane(_t >> 6); \
      int _b = blockIdx.x; asm volatile("" : "+v"(_b)); F.bid = __builtin_amdgcn_readfirstlane(_b); F.gw = F.bid * NWAVES + F.wave; } } while (0)
    LAS unsigned char* lds = F.lds;
    const int G = F.G, bid = F.bid;
    constexpr long T2048 = 256L * 2048 * 2;

    if (IN(0)) { PH_BEGIN(); p0_prologue(F); PH_END(0); }
    if (IN(1)) { PH_BEGIN(); p1_reduce(F); PH_END(1); }
        if (IN(2)) { PH_BEGIN(); norm_phase<0>(F, 0, nullptr); PH_END(2); }
        if (IN(3)) { PH_BEGIN();
            { pg8::Gemm g{WSP(bf16, WS_HA), WSP(bf16, WS_WIN0), 2048, 2048, 2048}; pg8::StaticOrder S; S.init(TT / 256, 12, G, bid, T2048, 0, T2048);
              EpiQKP E{WSP(bf16, WS_Q), WSP(bf16, WS_K), WSP(bf16, WS_P), WSP(f32x2, WS_ROPE)}; pg8::gemm_phase<EpiQKP, pg8::StaticOrder, false>(lds, g, S, E); }
            { pg8::Gemm g{WSP(bf16, WS_WIN0) + (size_t)3072 * 2048, WSP(bf16, WS_HA), 2048, 2048, 2048}; pg8::StaticOrder S; S.init(4, TT / 256, G, bid, T2048, 0, T2048);
              EpiVT E{WSP(bf16, WS_VT)}; pg8::gemm_phase<EpiVT, pg8::StaticOrder, false>(lds, g, S, E); }
            PH_END(3);
        }
        if (IN(4)) { PH_BEGIN(); attn_phase(F); poold_phase(F); PH_END(4); }
        if (IN(5)) { PH_BEGIN();
            pg8::Gemm g{WSP(bf16, WS_PD), WSP(bf16, WS_WPOOL), 1024, 256, 256}; pg8::StaticOrder S; S.init(TT / 256, 4, G, bid, 256L * 1024 * 2, 256L * 2, 256L * 256 * 2);
            EpiScaleBf16 E{WSP(bf16, WS_CAT), 2048, 1024, INP(14)}; pg8::gemm_phase<EpiScaleBf16, pg8::StaticOrder, false>(lds, g, S, E);
            PH_END(5);
        }
    {
    constexpr int pb = 6; constexpr int l = 0;
    if (INL(0)) { PH_BEGIN();
        float* xbuf = WSP(float, WS_X);
        pg8::Gemm g{WSP(bf16, WS_CAT), WSP(bf16, l == 0 ? WS_WOUT0 : WS_WOUT1), 2048, 2048, 2048}; pg8::StaticOrder S; S.init(l == 0 ? TT / 256 : TL / 256, 8, G, bid, T2048, 0, T2048);
        EpiRes E{l == 0 ? INP(0) : xbuf, l == 0 ? INP(2) : xbuf + (size_t)TL * 2048, xbuf, modp(F, l, 0, 2)}; pg8::gemm_phase<EpiRes, pg8::StaticOrder, false>(lds, g, S, E);
        PH_END(pb);
    }
    if (INL(1)) { PH_BEGIN(); norm_phase<1>(F, l, nullptr); PH_END(pb + 1); }
    if (INL(2)) { PH_BEGIN();
        moe_blocks(F, l, bstart);
        pg8::Gemm g{WSP(bf16, WS_HA), (const bf16*)(F.ws + WS_WMOE + (size_t)l * MOE_L_BYTES), 2048, 2048, 2048};
        MoeOrder S{bstart, WSP(unsigned, WS_CTL) + CW_CNT + l * 64, WSP(int, WS_TOKL), 4, G, bid, bstart[64], T2048, 0, true};
        EpiMoeUp E{WSP(bf16, WS_H)}; pg8::gemm_phase<EpiMoeUp, MoeOrder, true>(lds, g, S, E);
        PH_END(pb + 2);
    }
    if (INL(3)) { PH_BEGIN();
        moe_blocks(F, l, bstart);
        pg8::Gemm g{WSP(bf16, WS_H), (const bf16*)(F.ws + WS_WMOE + (size_t)l * MOE_L_BYTES), 512, 512, 512};
        MoeOrder S{bstart, WSP(unsigned, WS_CTL) + CW_CNT + l * 64, WSP(int, WS_TOKL), 8, G, bid, bstart[64], 256L * 512 * 2, (long)(4 * MiB), false};
        EpiMoeDown E{WSP(bf16, WS_Y), WSP(int, WS_TOKL), WSP(float, WS_GATEL), WSP(unsigned, WS_CTL) + CW_CNT + l * 64}; pg8::gemm_phase<EpiMoeDown, MoeOrder, false>(lds, g, S, E);
        PH_END(pb + 3);
    }
    }
        if (IN(10)) { PH_BEGIN(); norm_phase<2>(F, 1, nullptr); PH_END(10); }
        if (IN(11)) { PH_BEGIN();
            pg8::Gemm g{WSP(bf16, WS_HA), WSP(bf16, WS_WIN1), 2048, 2048, 2048}; pg8::StaticOrder S; S.init(TT / 256, 16, G, bid, T2048, 0, T2048);
            EpiBf16 E{WSP(bf16, WS_PROJ1), 4096}; pg8::gemm_phase<EpiBf16, pg8::StaticOrder, false>(lds, g, S, E);
            PH_END(11);
        }
        if (IN(12)) { PH_BEGIN(); shortconv_phase(F); s5_seg_phase<false>(F); PH_END(12); }
        if (IN(13)) { PH_BEGIN(); s5_seg_phase<true>(F); hyena_fft_phase(F); PH_END(13); }
        if (IN(14)) { PH_BEGIN(); s5_gelu_phase(F); hyena_out_transpose(F); PH_END(14); }
        if (IN(15)) { PH_BEGIN();
            pg8::Gemm g{WSP(bf16, WS_PD), WSP(bf16, WS_WGLU), 1024, 1024, 1024}; pg8::StaticOrder S; S.init(TL / 256, 4, G, bid, 256L * 1024 * 2, 0, 256L * 1024 * 2);
            EpiGlu E{WSP(bf16, WS_CAT), 2048, 1024, WSP(bf16, WS_PD), INP(35)}; pg8::gemm_phase<EpiGlu, pg8::StaticOrder, false>(lds, g, S, E);
            PH_END(15);
        }
    {
    constexpr int pb = 16; constexpr int l = 1;
    if (INL(0)) { PH_BEGIN();
        float* xbuf = WSP(float, WS_X);
        pg8::Gemm g{WSP(bf16, WS_CAT), WSP(bf16, l == 0 ? WS_WOUT0 : WS_WOUT1), 2048, 2048, 2048}; pg8::StaticOrder S; S.init(l == 0 ? TT / 256 : TL / 256, 8, G, bid, T2048, 0, T2048);
        EpiRes E{l == 0 ? INP(0) : xbuf, l == 0 ? INP(2) : xbuf + (size_t)TL * 2048, xbuf, modp(F, l, 0, 2)}; pg8::gemm_phase<EpiRes, pg8::StaticOrder, false>(lds, g, S, E);
        PH_END(pb);
    }
    if (INL(1)) { PH_BEGIN(); norm_phase<1>(F, l, nullptr); PH_END(pb + 1); }
    if (INL(2)) { PH_BEGIN();
        moe_blocks(F, l, bstart);
        pg8::Gemm g{WSP(bf16, WS_HA), (const bf16*)(F.ws + WS_WMOE + (size_t)l * MOE_L_BYTES), 2048, 2048, 2048};
        MoeOrder S{bstart, WSP(unsigned, WS_CTL) + CW_CNT + l * 64, WSP(int, WS_TOKL), 4, G, bid, bstart[64], T2048, 0, true};
        EpiMoeUp E{WSP(bf16, WS_H)}; pg8::gemm_phase<EpiMoeUp, MoeOrder, true>(lds, g, S, E);
        PH_END(pb + 2);
    }
    if (INL(3)) { PH_BEGIN();
        moe_blocks(F, l, bstart);
        pg8::Gemm g{WSP(bf16, WS_H), (const bf16*)(F.ws + WS_WMOE + (size_t)l * MOE_L_BYTES), 512, 512, 512};
        MoeOrder S{bstart, WSP(unsigned, WS_CTL) + CW_CNT + l * 64, WSP(int, WS_TOKL), 8, G, bid, bstart[64], 256L * 512 * 2, (long)(4 * MiB), false};
        EpiMoeDown E{WSP(bf16, WS_Y), WSP(int, WS_TOKL), WSP(float, WS_GATEL), WSP(unsigned, WS_CTL) + CW_CNT + l * 64}; pg8::gemm_phase<EpiMoeDown, MoeOrder, false>(lds, g, S, E);
        PH_END(pb + 3);
    }
    }
    if (IN(20)) { PH_BEGIN(); norm_phase<3>(F, 1, args.out); }
#undef IN
#undef INL
#undef PH_END
}

typedef void (*kern_t)(Args);
template <int P> static void launch_phase(int grid, hipStream_t stream, Args a) { hipLaunchKernelGGL(mk_fwd<P>, dim3(grid), dim3(NTHREADS), LDS_BYTES, stream, a); }
template <int P> static bool prep_phase() { return hipFuncSetAttribute((const void*)mk_fwd<P>, hipFuncAttributeMaxDynamicSharedMemorySize, LDS_BYTES) == hipSuccess; }
extern "C" void kernel_launch(void* const* d_in, const int* in_sizes, int n_in, void* d_out, int out_size, void* d_ws, size_t ws_size, hipStream_t stream) {
    static int grid = 0;
    if (grid == 0) {
        if (n_in != 43 || out_size != TL * DM || ws_size < WS_END) { fprintf(stderr, "kernel_launch: unexpected shapes (n_in %d, out %d, ws %zu < %zu)\n", n_in, out_size, ws_size, (size_t)WS_END); grid = -1; return; }
        int dev = 0, cus = 0;
        if (hipGetDevice(&dev) != hipSuccess || hipDeviceGetAttribute(&cus, hipDeviceAttributeMultiprocessorCount, dev) != hipSuccess) { grid = -1; return; }
        bool ok = true;
#if MK_SINGLE
        ok = prep_phase<-1>();
#else
        ok = prep_phase<0>() && prep_phase<1>() && prep_phase<2>() && prep_phase<3>() && prep_phase<4>() && prep_phase<5>() && prep_phase<6>() && prep_phase<7>() && prep_phase<8>() && prep_phase<9>() &&
             prep_phase<10>() && prep_phase<11>() && prep_phase<12>() && prep_phase<13>() && prep_phase<14>() && prep_phase<15>() && prep_phase<20>();
#endif
        if (!ok) { fprintf(stderr, "kernel_launch: hipFuncSetAttribute failed\n"); grid = -1; return; }
        (void)hipGetLastError();
        grid = cus;
    }
    if (grid < 0) return;
    (void)hipMemsetAsync((char*)d_ws + WS_CTL, 0, CTL_BYTES, stream);
    Args a{};
    for (int i = 0; i < 43; ++i) a.in[i] = (const float*)d_in[i];
    a.out = (float*)d_out; a.ws = (unsigned char*)d_ws;
#if MK_SINGLE
    a.ph_lo = 0; a.ph_hi = NPHASES;
    launch_phase<-1>(grid, stream, a);
#else
#define LP(k, P) a.ph_lo = (k); a.ph_hi = (k) + 1; launch_phase<P>(grid, stream, a);
    LP(0, 0) LP(1, 1) LP(2, 2) LP(3, 3) LP(4, 4) LP(5, 5) LP(6, 6) LP(7, 7) LP(8, 8) LP(9, 9) LP(10, 10) LP(11, 11) LP(12, 12) LP(13, 13) LP(14, 14) LP(15, 15)
    LP(16, 6) LP(17, 7) LP(18, 8) LP(19, 9) LP(20, 20)
#undef LP
#endif
}
```

```cpp
#include <hip/hip_runtime.h>
#include <cstdio>
#include <cstdint>
#include <cmath>

#define GAS __attribute__((address_space(1)))
#define LAS __attribute__((address_space(3)))
typedef unsigned short bf16;
typedef unsigned v4u __attribute__((ext_vector_type(4)));
typedef unsigned v2u __attribute__((ext_vector_type(2)));
typedef float f32x4 __attribute__((ext_vector_type(4)));
typedef float f32x2 __attribute__((ext_vector_type(2)));
typedef float f32x16 __attribute__((ext_vector_type(16)));
typedef short bf16x8 __attribute__((ext_vector_type(8)));
#define LDS_WAIT() asm volatile("s_waitcnt lgkmcnt(0)" ::: "memory")
#define VM_WAIT() asm volatile("s_waitcnt vmcnt(0)" ::: "memory")

__device__ __forceinline__ unsigned f2bf(float f) { unsigned u = __builtin_bit_cast(unsigned, f); return (u + 0x7fffu + ((u >> 16) & 1u)) >> 16; }
__device__ __forceinline__ unsigned pk2(float lo, float hi) { return f2bf(lo) | (f2bf(hi) << 16); }
__device__ __forceinline__ unsigned cvt_pk_bf16(float lo, float hi) { unsigned r; asm volatile("v_cvt_pk_bf16_f32 %0, %1, %2" : "=v"(r) : "v"(lo), "v"(hi)); return r; }
__device__ __forceinline__ float bf2f(unsigned short b) { return __builtin_bit_cast(float, (unsigned)b << 16); }
__device__ __forceinline__ float bflo(unsigned w) { return __builtin_bit_cast(float, w << 16); }
__device__ __forceinline__ float bfhi(unsigned w) { return __builtin_bit_cast(float, w & 0xffff0000u); }
__device__ __forceinline__ float wave_sum(float v) {
#pragma unroll
    for (int o = 1; o < 64; o <<= 1) v += __shfl_xor(v, o);
    return v;
}

namespace pg8 {
typedef unsigned short bf16_t;
constexpr int BM = 256, BK = 64, HALF = 128, HTB = HALF * BK * 2, STAGE_BYTES = 8 * HTB;

__host__ __device__ __forceinline__ int lds_byte(int r, int c) { const int st = (r >> 4) * 2 + (c >> 5), rr = r & 15, cc = c & 31, ob = rr * 64 + cc * 2; return st * 1024 + (ob ^ (((ob >> 9) & 1) << 5)); }
__host__ __device__ __forceinline__ void stage_rc(int b, int& R, int& C) { const int st = b / 1024, sb = b % 1024, swz = sb ^ (((sb >> 9) & 1) << 5); R = (st >> 1) * 16 + swz / 64; C = (st & 1) * 32 + (swz % 64) / 2; }

struct Unit { int pm, pn; long aoff, boff; int e, idx0; };
struct Gemm { const bf16_t* A; const bf16_t* Bt; int lda, ldb, K; };

template <class Epi, class Sched, bool GATHER>
__device__ __forceinline__ void gemm_phase(LAS unsigned char* lds, const Gemm g, const Sched& S, const Epi& E) {
    const int tid = threadIdx.x, wid = __builtin_amdgcn_readfirstlane(tid >> 6), lane = tid & 63, wr = wid >> 2, wc = wid & 3, fr = lane & 15, fq = lane >> 4;
    const int K = g.K, nt = K / BK;
    unsigned voffA[2], voffB[2];
#pragma unroll
    for (int i = 0; i < 2; ++i) { int R, C; stage_rc(tid * 16 + i * 8192, R, C);
        voffA[i] = (unsigned)(R * g.lda + C) * 2u; voffB[i] = (unsigned)(R * g.ldb + C) * 2u; }
    const size_t kstep = (size_t)(BK * 2);
    const size_t hstepA = GATHER ? 0 : (size_t)HALF * g.lda * 2, hstepB = (size_t)HALF * g.ldb * 2;
    const unsigned ldsw = (unsigned)wid * 1024u;
    const int aoff = lds_byte(wr * 64 + fr, fq * 8), boff = lds_byte(wc * 32 + fr, fq * 8);
#define PG8_SA(b, h) (((b) * 2 + (h)) * HTB)
#define PG8_SB(b, h) ((4 + (b) * 2 + (h)) * HTB)
#define PG8_STAGE(bufoff, gbase, voff) do { _Pragma("unroll") for (int _i = 0; _i < 2; ++_i) \
        __builtin_amdgcn_global_load_lds((const unsigned*)((const char*)(gbase) + (voff)[_i]), (LAS unsigned*)(lds + (bufoff) + ldsw + _i * 8192), 16, 0, 0); } while (0)
#define PG8_STAGE_A(bufoff, gbase, h, nx) do { if constexpr (GATHER) { unsigned _tv[2]; \
        if (nx) { int _tz = tid; asm volatile("" : "+v"(_tz)); _Pragma("unroll") for (int _j = 0; _j < 2; ++_j) { int _R, _C; stage_rc(_tz * 16 + _j * 8192, _R, _C); _tv[_j] = (unsigned)S.arow(nxt, (h) * HALF + _R) * (unsigned)(g.lda * 2) + (unsigned)(_C * 2); } } \
        else { _tv[0] = gvc[h][0]; _tv[1] = gvc[h][1]; } \
        PG8_STAGE(bufoff, gbase, _tv); } else { PG8_STAGE(bufoff, (gbase) + (h) * hstepA, voffA); } } while (0)
#define PG8_LDA(dst, b, h) do { _Pragma("unroll") for (int m = 0; m < 4; ++m) _Pragma("unroll") for (int k = 0; k < 2; ++k) dst[m][k] = *(const LAS bf16x8*)(lds + PG8_SA(b, h) + aoff + m * 2048 + k * 1024); } while (0)
#define PG8_LDB(dst, b, h) do { _Pragma("unroll") for (int n = 0; n < 2; ++n) _Pragma("unroll") for (int k = 0; k < 2; ++k) dst[n][k] = *(const LAS bf16x8*)(lds + PG8_SB(b, h) + boff + n * 2048 + k * 1024); } while (0)
#define PG8_MMA(ai, bj, At, Bt) do { __builtin_amdgcn_s_setprio(1); _Pragma("unroll") for (int m = 0; m < 4; ++m) _Pragma("unroll") for (int n = 0; n < 2; ++n) _Pragma("unroll") for (int k = 0; k < 2; ++k) \
        acc[ai][bj][m][n] = __builtin_amdgcn_mfma_f32_16x16x32_bf16(Bt[n][k], At[m][k], acc[ai][bj][m][n], 0, 0, 0); __builtin_amdgcn_s_setprio(0); } while (0)
#define PG8_WAIT_V(n) asm volatile("s_waitcnt vmcnt(" #n ")" ::: "memory")
#define PG8_WAIT_L(n) asm volatile("s_waitcnt lgkmcnt(" #n ")" ::: "memory")
#define PG8_BAR __builtin_amdgcn_s_barrier()
#define PG8_SCHED __builtin_amdgcn_sched_barrier(0)
    Unit cur, nxt; int ui = 0;
    if (!S.next(0, cur)) return;
    unsigned gvc[2][2];
#define PG8_GV(unit) do { if constexpr (GATHER) { int _tz = tid; asm volatile("" : "+v"(_tz)); _Pragma("unroll") for (int _h = 0; _h < 2; ++_h) _Pragma("unroll") for (int _j = 0; _j < 2; ++_j) { int _R, _C; stage_rc(_tz * 16 + _j * 8192, _R, _C); \
        gvc[_h][_j] = (unsigned)S.arow(unit, _h * HALF + _R) * (unsigned)(g.lda * 2) + (unsigned)(_C * 2); } } } while (0)
    PG8_GV(cur);
    f32x4 acc[2][2][4][2];
#pragma unroll
    for (int a = 0; a < 2; ++a)
#pragma unroll
        for (int b = 0; b < 2; ++b)
#pragma unroll
            for (int m = 0; m < 4; ++m)
#pragma unroll
                for (int n = 0; n < 2; ++n) acc[a][b][m][n] = (f32x4){0.f, 0.f, 0.f, 0.f};
    bf16x8 At[4][2], B0[2][2], B1[2][2];
    const char* cA = (const char*)g.A + cur.aoff; const char* cB = (const char*)g.Bt + cur.boff;
    PG8_STAGE(PG8_SB(0, 0), cB, voffB); PG8_STAGE(PG8_SB(0, 1), cB + hstepB, voffB); PG8_STAGE_A(PG8_SA(0, 0), cA, 0, false); PG8_STAGE_A(PG8_SA(0, 1), cA, 1, false);
    if (wr == 1) PG8_BAR;
    PG8_WAIT_V(2); PG8_BAR;
    PG8_STAGE(PG8_SB(1, 0), cB + kstep, voffB); PG8_STAGE_A(PG8_SA(1, 0), cA + kstep, 0, false); PG8_STAGE(PG8_SB(1, 1), cB + hstepB + kstep, voffB);
    PG8_WAIT_V(6); PG8_BAR;
    for (;;) {
        const bool has_next = S.next(ui + 1, nxt);
        const char* nA = has_next ? (const char*)g.A + nxt.aoff : cA; const char* nB = has_next ? (const char*)g.Bt + nxt.boff : cB;
#pragma nounroll
        for (int t = 0; t < nt; t += 2) {
            const bool last = (t == nt - 2);
            const char* a1 = cA + (size_t)(t + 1) * kstep;
            const char* a2 = last ? nA : cA + (size_t)(t + 2) * kstep; const char* b2 = last ? nB : cB + (size_t)(t + 2) * kstep;
            const char* a3 = a2 + kstep; const char* b3 = b2 + kstep;
            PG8_LDB(B0, 0, 0); PG8_LDB(B1, 0, 1); PG8_SCHED; PG8_LDA(At, 0, 0); PG8_STAGE_A(PG8_SA(1, 1), a1, 1, false);
            PG8_WAIT_V(8); PG8_WAIT_L(0); PG8_BAR; PG8_MMA(0, 0, At, B0); PG8_MMA(0, 1, At, B1); PG8_BAR; PG8_SCHED;
            PG8_LDA(At, 0, 1); PG8_STAGE(PG8_SB(0, 0), b2, voffB); PG8_STAGE(PG8_SB(0, 1), b2 + hstepB, voffB); PG8_STAGE_A(PG8_SA(0, 0), a2, 0, last);
            PG8_WAIT_V(8); PG8_WAIT_L(0); PG8_BAR; PG8_MMA(1, 0, At, B0); PG8_MMA(1, 1, At, B1); PG8_BAR; PG8_SCHED;
            PG8_LDB(B0, 1, 0); PG8_LDB(B1, 1, 1); PG8_SCHED; PG8_LDA(At, 1, 0); PG8_STAGE_A(PG8_SA(0, 1), a2, 1, last);
            PG8_WAIT_V(8); PG8_WAIT_L(0); PG8_BAR; PG8_MMA(0, 0, At, B0); PG8_MMA(0, 1, At, B1); PG8_BAR; PG8_SCHED;
            PG8_LDA(At, 1, 1); PG8_STAGE(PG8_SB(1, 0), b3, voffB); PG8_STAGE(PG8_SB(1, 1), b3 + hstepB, voffB); PG8_STAGE_A(PG8_SA(1, 0), a3, 0, last);
            PG8_WAIT_V(8); PG8_WAIT_L(0); PG8_BAR; PG8_MMA(1, 0, At, B0); PG8_MMA(1, 1, At, B1); PG8_BAR; PG8_SCHED;
        }
        if (wr == 0) PG8_BAR;
        E(acc, cur, wr, wc, fr, fq);
        if (!has_next) break;
#pragma unroll
        for (int a = 0; a < 2; ++a)
#pragma unroll
            for (int b = 0; b < 2; ++b)
#pragma unroll
                for (int m = 0; m < 4; ++m)
#pragma unroll
                    for (int n = 0; n < 2; ++n) acc[a][b][m][n] = (f32x4){0.f, 0.f, 0.f, 0.f};
        cur = nxt; cA = nA; cB = nB; ++ui;
        PG8_GV(cur);
        if (wr == 1) PG8_BAR;
    }
    PG8_WAIT_V(0);
    PG8_BAR;
#undef PG8_SA
#undef PG8_SB
#undef PG8_STAGE
#undef PG8_STAGE_A
#undef PG8_GV
#undef PG8_LDA
#undef PG8_LDB
#undef PG8_MMA
#undef PG8_WAIT_V
#undef PG8_WAIT_L
#undef PG8_BAR
#undef PG8_SCHED
}

struct StaticOrder {
    int nM, nN, nwg, G, c; long astride, apn, bstride;
    __device__ void init(int nM_, int nN_, int G_, int c_, long astride_, long apn_, long bstride_) { nM = nM_; nN = nN_; nwg = nM * nN; G = G_; c = c_; astride = astride_; apn = apn_; bstride = bstride_; }
    __device__ bool next(int i, Unit& u) const {
        const long Lx = (long)i * G + c; if (Lx >= nwg) return false;
        int wgid = (int)Lx; { const int q = nwg / 8, r = nwg % 8, xcd = wgid % 8, off = wgid / 8; wgid = (xcd < r ? xcd * (q + 1) : r * (q + 1) + (xcd - r) * q) + off; }
        const int nig = 8 * nN, gid = wgid / nig, fm = gid * 8, gsz = (nM - fm) < 8 ? (nM - fm) : 8;
        u.pm = fm + ((wgid % nig) % gsz); u.pn = (wgid % nig) / gsz; u.aoff = (long)u.pm * astride + (long)u.pn * apn; u.boff = (long)u.pn * bstride; u.e = 0; u.idx0 = 0; return true;
    }
    __device__ int arow(const Unit&, int) const { return 0; }
};
}

constexpr int DM = 2048, NBATCH = 2, SEQ = 8192, CTX = 256;
constexpr int TL = NBATCH * SEQ;
constexpr int TC = NBATCH * CTX;
constexpr int TT = TL + TC;
constexpr int KEYS = CTX + SEQ;
constexpr int NEXP = 64, DEXP = 512;
constexpr int LISTCAP = 2 * TT;
constexpr float EPS = 1e-6f;
constexpr float QSCALE = 0.125f * 1.4426950408889634f;
constexpr int NWAVES = 8, NTHREADS = 512;

constexpr size_t MiB = 1u << 20;
constexpr size_t WS_CTL = 0, CTL_BYTES = 1 * MiB;
constexpr size_t WS_WIN0 = 1 * MiB;
constexpr size_t WS_WOUT0 = WS_WIN0 + 16 * MiB;
constexpr size_t WS_WIN1 = WS_WOUT0 + 8 * MiB;
constexpr size_t WS_WOUT1 = WS_WIN1 + 16 * MiB;
constexpr size_t WS_WPOOL = WS_WOUT1 + 8 * MiB;
constexpr size_t WS_WGLU = WS_WPOOL + 1 * MiB;
constexpr size_t WS_WMOE = WS_WGLU + 2 * MiB;
constexpr size_t MOE_E_BYTES = 6 * MiB, MOE_L_BYTES = 64 * MOE_E_BYTES;
constexpr size_t WS_X = WS_WMOE + 2 * MOE_L_BYTES;
constexpr size_t WS_HA = WS_X + 132 * MiB;
constexpr size_t WS_Q = WS_HA + 67 * MiB;
constexpr size_t WS_K = WS_Q + 33 * MiB;
constexpr size_t WS_VT = WS_K + 33 * MiB;
constexpr size_t WS_P = WS_VT + 33 * MiB;
constexpr size_t WS_PROJ1 = WS_Q;
constexpr size_t WS_CAT = WS_P + 33 * MiB;
constexpr size_t WS_PD = WS_CAT + 66 * MiB;
constexpr size_t WS_H = WS_PD + 33 * MiB;
constexpr size_t WS_Y = WS_H + 49 * MiB;
constexpr size_t WS_GT = WS_Y + 132 * MiB;
constexpr size_t WS_KT = WS_GT + 192 * MiB;
constexpr size_t WS_YD = WS_KT + 128 * MiB;
constexpr size_t WS_MISC = WS_YD + 128 * MiB;
constexpr size_t WS_MOD = WS_MISC;
constexpr size_t WS_ADAP = WS_MOD + 1 * MiB;
constexpr size_t WS_ROPE = WS_ADAP + 10 * MiB;
constexpr size_t WS_NORMP = WS_ROPE + 1 * MiB;
constexpr size_t WS_INVN = WS_NORMP + 4 * MiB;
constexpr size_t WS_S5LAM = WS_INVN + 1 * MiB;
constexpr size_t WS_S5B = WS_S5LAM + 1 * MiB;
constexpr size_t WS_WRT = WS_S5B + 2 * MiB;
constexpr size_t WS_TOKL = WS_WRT + 2 * MiB;
constexpr size_t WS_GATEL = WS_TOKL + 9 * MiB;
constexpr size_t WS_TW = WS_GATEL + 9 * MiB;
constexpr size_t WS_FFTW = WS_TW + 1 * MiB;
constexpr size_t WS_S5L256 = WS_FFTW + 32 * MiB;
constexpr size_t WS_S5E = WS_S5L256 + 1 * MiB;
constexpr size_t WS_END = WS_S5E + 4 * MiB;
static_assert(WS_END <= 2040 * MiB, "d_ws map");
constexpr int CW_BAR = 1024;
constexpr int CW_CNT = 8192;

constexpr int LDS_PHASE = 131072;
constexpr int LDS_CTL = 147456 - 2048;
constexpr int LDS_BYTES = 147456;

#define XB_TMO      128
#define XB_XCNT(j)  (256  + 64 * (j))
#define XB_XSUB(j)  (1280 + 64 * (j))
#define XB_XGEN(j)  (2304 + 64 * (j))
#define XB_TOP      3328
#define XB_TOPGEN   3392
#define XCD_BAR_WORDS 3456
#define XB_SPIN_CAP (1u << 22)

__device__ __forceinline__ unsigned xb_ld(unsigned* p)              { return __hip_atomic_load(p, __ATOMIC_RELAXED, __HIP_MEMORY_SCOPE_AGENT); }
__device__ __forceinline__ unsigned xb_add(unsigned* p, unsigned v) { return __hip_atomic_fetch_add(p, v, __ATOMIC_RELAXED, __HIP_MEMORY_SCOPE_AGENT); }
__device__ __forceinline__ unsigned xb_xcc_id() { return (unsigned)__builtin_amdgcn_s_getreg((3 << 11) | 20) & 0xFu; }
#define XB_SPIN(cond, bar) do { unsigned _sp = 0; while (cond) { __builtin_amdgcn_s_sleep(1); \
    if ((++_sp & 255u) == 0u) { if (xb_ld(&(bar)[XB_TMO])) break; if (_sp > XB_SPIN_CAP) { atomicAdd(&(bar)[XB_TMO], 1u); break; } } } } while (0)

struct XcdBarrier { unsigned* bar; unsigned x; volatile LAS unsigned* st; };

__device__ __forceinline__ XcdBarrier xcd_barrier_post(unsigned* bar, volatile LAS unsigned* st) {
    XcdBarrier b; b.bar = bar; b.x = xb_xcc_id(); b.st = st;
    if (threadIdx.x == 0) (void)xb_add(&bar[XB_XCNT(b.x)], 1u);
    return b;
}
__device__ __forceinline__ void xcd_barrier_complete(unsigned* bar, unsigned x, unsigned& nloc, unsigned& nx) {
    const unsigned G = gridDim.x * gridDim.y * gridDim.z;
    unsigned sum, cnt, mine, sp = 0u;
    for (;;) {
        sum = 0u; cnt = 0u; mine = 0u;
#pragma unroll
        for (unsigned j = 0; j < 16; ++j) { const unsigned c = xb_ld(&bar[XB_XCNT(j)]); sum += c; cnt += (c > 0u) ? 1u : 0u; mine = (j == x) ? c : mine; }
        if (sum == G) break;
        __builtin_amdgcn_s_sleep(1);
        if ((++sp & 255u) == 0u) { if (xb_ld(&bar[XB_TMO])) break; if (sp > XB_SPIN_CAP) { atomicAdd(&bar[XB_TMO], 1u); break; } }
    }
    nloc = mine > 0u ? mine : 1u; nx = cnt > 0u ? cnt : 1u;
}
__device__ __forceinline__ void xcd_barrier(const XcdBarrier& b) {
    asm volatile("s_waitcnt vmcnt(0)" ::: "memory");
    __syncthreads();
    if (threadIdx.x == 0) {
        unsigned* bar = b.bar;
        __builtin_amdgcn_s_waitcnt(0);
        unsigned nloc = b.st[0], nx = b.st[1];
        if (nloc == 0u) { xcd_barrier_complete(bar, b.x, nloc, nx); b.st[0] = nloc; b.st[1] = nx; }
        const unsigned old = xb_add(&bar[XB_XSUB(b.x)], 1u);
        const unsigned gen = old / nloc;
        if (old + 1u == (gen + 1u) * nloc) {
            __builtin_amdgcn_fence(__ATOMIC_RELEASE, "agent");
            asm volatile("s_waitcnt vmcnt(0)" ::: "memory");
            const unsigned og = xb_add(&bar[XB_TOP], 1u);
            const unsigned tg = og / nx;
            if (og + 1u == (tg + 1u) * nx) xb_add(&bar[XB_TOPGEN], 1u);
            else XB_SPIN(xb_ld(&bar[XB_TOPGEN]) == tg, bar);
            __builtin_amdgcn_fence(__ATOMIC_ACQUIRE, "agent");
            xb_add(&bar[XB_XGEN(b.x)], 1u);
            asm volatile("s_waitcnt vmcnt(0)" ::: "memory");
        } else {
            XB_SPIN(xb_ld(&bar[XB_XGEN(b.x)]) == gen, bar);
            __builtin_amdgcn_fence(__ATOMIC_ACQUIRE, "agent");
            asm volatile("s_waitcnt vmcnt(0)" ::: "memory");
        }
    }
    __syncthreads();
}

__device__ __forceinline__ void sincos_2pi(double x, double& s, double& c) {
    const double q = __builtin_rint(x * 4.0);
    const double y = (x - q * 0.25) * 6.283185307179586476925;
    const double y2 = y * y;
    double sp = -7.6471637318198164759e-13; sp = sp * y2 + 1.6059043836821614599e-10; sp = sp * y2 - 2.5052108385441718775e-8; sp = sp * y2 + 2.7557319223985890653e-6;
    sp = sp * y2 - 1.9841269841269841270e-4; sp = sp * y2 + 8.3333333333333333333e-3; sp = sp * y2 - 1.6666666666666666667e-1; sp = sp * y2 * y + y;
    double cp = 4.7794773323873852974e-14; cp = cp * y2 - 1.1470745597729724714e-11; cp = cp * y2 + 2.0876756987868098979e-9; cp = cp * y2 - 2.7557319223985890653e-7;
    cp = cp * y2 + 2.4801587301587301587e-5; cp = cp * y2 - 1.3888888888888888889e-3; cp = cp * y2 + 4.1666666666666666667e-2; cp = cp * y2 - 0.5; cp = cp * y2 + 1.0;
    const int qi = ((int)q) & 3;
    s = (qi == 0) ? sp : (qi == 1) ? cp : (qi == 2) ? -sp : -cp;
    c = (qi == 0) ? cp : (qi == 1) ? -sp : (qi == 2) ? -cp : sp;
}
__device__ __forceinline__ void sincos_rad(double a, double& s, double& c) {
    double f = a * 0.15915494309189533576888; f -= __builtin_floor(f);
    if (f >= 1.0) f = 0.0;
    sincos_2pi(f, s, c);
}
__device__ __forceinline__ double exp_small(double x) {
    double r = 1.0 / 479001600.0;
    r = r * x + 1.0 / 39916800.0; r = r * x + 1.0 / 3628800.0; r = r * x + 1.0 / 362880.0; r = r * x + 1.0 / 40320.0; r = r * x + 1.0 / 5040.0;
    r = r * x + 1.0 / 720.0; r = r * x + 1.0 / 120.0; r = r * x + 1.0 / 24.0; r = r * x + 1.0 / 6.0; r = r * x + 0.5; r = r * x + 1.0; r = r * x + 1.0;
    return r;
}
__device__ __forceinline__ float fast_exp(float x) { return __builtin_amdgcn_exp2f(x * 1.4426950408889634f); }
__device__ __forceinline__ float sigmoidf_(float x) { return 1.0f / (1.0f + fast_exp(-x)); }
__device__ __forceinline__ float siluf_(float x) { return x * sigmoidf_(x); }
__device__ __forceinline__ float tanhf_(float x) { const float e = fast_exp(-2.0f * fabsf(x)); const float t = (1.0f - e) / (1.0f + e); return x < 0.f ? -t : t; }
__device__ __forceinline__ float gelu_tanh(float x) { return 0.5f * x * (1.0f + tanhf_(0.7978845608028654f * (x + 0.044715f * x * x * x))); }

struct Args { const float* in[43]; float* out; unsigned char* ws; int ph_lo, ph_hi; };

struct Frame {
    LAS unsigned char* lds; unsigned char* ws; int tid, lane, wave, bid, G, gw, NGW;
    const __attribute__((address_space(4))) unsigned long long* kin;
};
#define INP(i) ((const float*)F.kin[i])
#define WSP(T, off) ((T*)(F.ws + (off)))

__device__ __forceinline__ void tr_item(const float* W, int ldw, int N, bf16* WT, int ldt, int row_off, int rs16, LAS float* scr, int item, int lane) {
    const int nblk = N / 64, kb = item / nblk, nb = item % nblk, k0 = 64 * kb, n0 = 64 * nb;
    const int la = lane & 15, lb = lane >> 4;
    f32x4 v[16];
#pragma unroll
    for (int i = 0; i < 16; ++i) v[i] = *(const f32x4*)(W + (size_t)(k0 + 4 * i + lb) * ldw + n0 + 4 * la);
#pragma unroll
    for (int i = 0; i < 16; ++i) { const int kk = 4 * i + lb; LAS float* d = scr + (4 * la) * 65 + kk; d[0] = v[i].x; d[65] = v[i].y; d[130] = v[i].z; d[195] = v[i].w; }
    LDS_WAIT(); asm volatile("" ::: "memory");
    const int c = lane & 7;
#pragma unroll
    for (int j = 0; j < 8; ++j) { const int n = (lane >> 3) + 8 * j; const LAS float* s = scr + n * 65 + 8 * c;
        v4u o; o.x = pk2(s[0], s[1]); o.y = pk2(s[2], s[3]); o.z = pk2(s[4], s[5]); o.w = pk2(s[6], s[7]);
        const int nn = n0 + n, drow = row_off + (nn >> 4) * rs16 + (nn & 15);
        *(v4u*)(WT + (size_t)drow * ldt + k0 + 8 * c) = o; }
    LDS_WAIT(); asm volatile("" ::: "memory");
}

__device__ __forceinline__ void hyfilt_item(Frame& F, int pb) {
    const float* w1 = INP(19); const float* b1 = INP(20); const float* fq = INP(21); const float* w2 = INP(22); const float* b2 = INP(23); const float* w3 = INP(24);
    LAS float* z = (LAS float*)F.lds;
    LAS float* h1 = z + 1088;
    LAS float* h2 = h1 + 2048;
    const int tid = F.tid;
    for (int idx = tid; idx < 32 * 33; idx += NTHREADS) {
        const int p = idx / 33, f = idx % 33, i = pb * 32 + p;
        float v;
        if (f == 0) v = (float)i * (1.0f / (float)(SEQ - 1));
        else { const int j = (f - 1) & 15; const float fj = 1e-4f + (float)j * ((15.0f - 1e-4f) / 15.0f);
            double fr = (double)fj * (double)i / (double)SEQ; fr -= __builtin_floor(fr); double s, c; sincos_2pi(fr, s, c); v = (f <= 16) ? (float)c : (float)(-s); }
        z[p * 33 + f] = v;
    }
    __syncthreads();
    for (int idx = tid; idx < 2048; idx += NTHREADS) {
        const int p = idx >> 6, j = idx & 63; float a = b1[j];
        for (int f = 0; f < 33; ++f) a += z[p * 33 + f] * w1[f * 64 + j];
        double s, c; sincos_rad((double)(fq[j] * a), s, c); h1[idx] = (float)s;
    }
    __syncthreads();
    for (int idx = tid; idx < 2048; idx += NTHREADS) {
        const int p = idx >> 6, j = idx & 63; float a = b2[j];
        for (int k = 0; k < 64; ++k) a += h1[p * 64 + k] * w2[k * 64 + j];
        double s, c; sincos_rad((double)(fq[64 + j] * a), s, c); h2[idx] = (float)s;
    }
    __syncthreads();
    float* kT = WSP(float, WS_KT); float* normp = WSP(float, WS_NORMP);
    for (int cc = 0; cc < 8; ++cc) {
        const int col = tid + NTHREADS * cc;
        float acc[32];
#pragma unroll
        for (int p = 0; p < 32; ++p) acc[p] = 0.f;
        for (int k = 0; k < 64; k += 4) {
            const float w0 = w3[(size_t)(k + 0) * 4096 + col], wA = w3[(size_t)(k + 1) * 4096 + col], wB = w3[(size_t)(k + 2) * 4096 + col], wC = w3[(size_t)(k + 3) * 4096 + col];
#pragma unroll
            for (int p = 0; p < 32; ++p) { const f32x4 hv = *(const LAS f32x4*)(h2 + p * 64 + k); acc[p] += hv.x * w0 + hv.y * wA + hv.z * wB + hv.w * wC; }
        }
        const int ch = col & 1023, dir = (col >> 10) & 1;
        const float adel = 3.0701134573253946f + (float)ch * ((15.350567286626972f - 3.0701134573253946f) / 1023.0f);
        float sabs = 0.f;
#pragma unroll
        for (int p = 0; p < 32; ++p) { const int i = pb * 32 + p; const float t = (float)i * (1.0f / (float)(SEQ - 1)); acc[p] *= fast_exp(-t * adel); if (!(dir == 1 && i == 0)) sabs += fabsf(acc[p]); }
        f32x4* dst = (f32x4*)(kT + (size_t)col * SEQ + pb * 32);
#pragma unroll
        for (int p = 0; p < 8; ++p) dst[p] = (f32x4){acc[4 * p], acc[4 * p + 1], acc[4 * p + 2], acc[4 * p + 3]};
        normp[(size_t)pb * 4096 + col] = sabs;
    }
    __syncthreads();
}

__device__ __forceinline__ void p0_prologue(Frame& F) {
    for (int pb = F.bid; pb < SEQ / 32; pb += F.G) hyfilt_item(F, pb);
    const int gt = F.bid * NTHREADS + F.tid, NGT = F.G * NTHREADS;
    {
        f32x2* rope = WSP(f32x2, WS_ROPE);
        for (int idx = gt; idx < 128 * 16; idx += NGT) { const int pos = idx >> 4, i = idx & 15;
            double inv = (i & 3) == 0 ? 1.0 : (i & 3) == 1 ? 0.56234132519034908 : (i & 3) == 2 ? 0.31622776601683794 : 0.17782794100389228;
            inv *= (i >> 2) == 0 ? 1.0 : (i >> 2) == 1 ? 0.1 : (i >> 2) == 2 ? 0.01 : 0.001;
            const float ang = (float)pos * (float)inv; double s, c; sincos_rad((double)ang, s, c); rope[idx] = (f32x2){(float)c, (float)s}; }
    }
    {
        f32x2* tw = WSP(f32x2, WS_TW);
        for (int idx = gt; idx < 16384; idx += NGT) { double s, c; sincos_2pi((double)idx * (1.0 / 16384.0), s, c); tw[idx] = (f32x2){(float)c, (float)(-s)}; }
    }
    {
        const float* are = INP(26); const float* aim = INP(27); const float* ldt = INP(28); const float* bre = INP(29); const float* bim = INP(30);
        f32x2* lamb = WSP(f32x2, WS_S5LAM); f32x2* bb = WSP(f32x2, WS_S5B); f32x2* l256 = WSP(f32x2, WS_S5L256);
        for (int idx = gt; idx < 2 * 64 * 64; idx += NGT) { const int dg = idx >> 6;
            const float dt = expf(ldt[dg]); const float ar = are[idx], ai = aim[idx];
            const float zr = ar * dt, zi = ai * dt; double s, c; sincos_rad((double)zi, s, c); const double er = exp_small((double)zr);
            const double lr = er * c, li = er * s; lamb[idx] = (f32x2){(float)lr, (float)li};
            { double pr = lr, pi = li; for (int q = 0; q < 8; ++q) { const double tr = pr * pr - pi * pi, ti = 2.0 * pr * pi; pr = tr; pi = ti; } l256[idx] = (f32x2){(float)pr, (float)pi}; }
            const double nr = lr - 1.0, ni = li, den = (double)ar * ar + (double)ai * ai; const double qr = (nr * ar + ni * ai) / den, qi = (ni * ar - nr * ai) / den;
            for (int cc = 0; cc < 16; ++cc) { const double br = bre[(size_t)idx * 16 + cc], bi = bim[(size_t)idx * 16 + cc]; bb[(size_t)idx * 16 + cc] = (f32x2){(float)(qr * br - qi * bi), (float)(qr * bi + qi * br)}; } }
    }
    {
        float* wrt = WSP(float, WS_WRT);
        for (int idx = gt; idx < 2 * 72 * 2048; idx += NGT) { const int l = idx / (72 * 2048), r = idx % (72 * 2048), n = r / 2048, k = r % 2048;
            wrt[idx] = n < 8 ? INP(36)[((size_t)l * 2048 + k) * 8 + n] : INP(38)[((size_t)l * 2048 + k) * 64 + (n - 8)]; }
    }
    {
        bf16* ha = WSP(bf16, WS_HA);
        for (int idx = gt; idx < 2048; idx += NGT) ha[(size_t)TT * 2048 + idx] = 0;
    }
    LAS float* scr = (LAS float*)(F.lds + F.wave * 16896);
    {
        const float* c = INP(1); const float* cctx = INP(3); const float* adaw = INP(4); float* part = WSP(float, WS_ADAP);
        for (int it = F.gw; it < 2 * 32 * 48; it += F.NGW) {
            const int l = it / (32 * 48), r = it % (32 * 48), ks = r / 48, jb = r % 48, k0 = ks * 64, j0 = jb * 256 + F.lane * 4;
            const float c0 = c[k0 + F.lane], c1 = c[2048 + k0 + F.lane], c2 = cctx[k0 + F.lane];
            const float s0 = c0 / (1.0f + expf(-c0)), s1 = c1 / (1.0f + expf(-c1)), s2 = c2 / (1.0f + expf(-c2));
            f32x4 a0 = {0.f, 0.f, 0.f, 0.f}, a1 = a0, a2 = a0;
            const float* wp = adaw + ((size_t)l * 2048 + k0) * 12288 + j0;
#pragma unroll 8
            for (int kk = 0; kk < 64; ++kk) { const f32x4 w = *(const f32x4*)(wp + (size_t)kk * 12288);
                const float t0 = __builtin_bit_cast(float, __builtin_amdgcn_readlane(__builtin_bit_cast(int, s0), kk));
                const float t1 = __builtin_bit_cast(float, __builtin_amdgcn_readlane(__builtin_bit_cast(int, s1), kk));
                const float t2 = __builtin_bit_cast(float, __builtin_amdgcn_readlane(__builtin_bit_cast(int, s2), kk));
                a0 += w * t0; a1 += w * t1; a2 += w * t2; }
            float* pp = part + ((size_t)(l * 32 + ks) * 3) * 12288 + j0;
            *(f32x4*)(pp) = a0; *(f32x4*)(pp + 12288) = a1; *(f32x4*)(pp + 2 * 12288) = a2;
        }
    }
    {
        constexpr int I0 = 1024, I1 = 512, I2 = 512, I3 = 1024, I4 = 2048, I5 = 1024, I6 = 64, I7 = 256, IE = 768;
        constexpr int NSMALL = I0 + I1 + I2 + I3 + I4 + I5 + I6 + I7;
        const int NITEMS = NSMALL + 128 * IE;
        for (int it = F.gw; it < NITEMS; it += F.NGW) {
            int r = it;
            if (r < I0) { tr_item(INP(9), 4096, 2048, WSP(bf16, WS_WIN0), 2048, 0, 16, scr, r, F.lane); continue; } r -= I0;
            if (r < I1) { tr_item(INP(9) + 2048, 4096, 1024, WSP(bf16, WS_WIN0), 2048, 3072, 16, scr, r, F.lane); continue; } r -= I1;
            if (r < I2) { tr_item(INP(9) + 3072, 4096, 1024, WSP(bf16, WS_WIN0), 2048, 2048, 16, scr, r, F.lane); continue; } r -= I2;
            if (r < I3) { tr_item(INP(10), 2048, 2048, WSP(bf16, WS_WOUT0), 2048, 0, 16, scr, r, F.lane); continue; } r -= I3;
            if (r < I4) { tr_item(INP(15), 4096, 4096, WSP(bf16, WS_WIN1), 2048, 0, 16, scr, r, F.lane); continue; } r -= I4;
            if (r < I5) { tr_item(INP(16), 2048, 2048, WSP(bf16, WS_WOUT1), 2048, 0, 16, scr, r, F.lane); continue; } r -= I5;
            if (r < I6) { const int g = r / 16; tr_item(INP(13) + (size_t)g * 65536, 256, 256, WSP(bf16, WS_WPOOL), 256, g * 256, 16, scr, r % 16, F.lane); continue; } r -= I6;
            if (r < I7) { tr_item(INP(34), 1024, 1024, WSP(bf16, WS_WGLU), 1024, 0, 16, scr, r, F.lane); continue; } r -= I7;
            const int le = r / IE, q = r % IE;
            bf16* wc = (bf16*)(F.ws + WS_WMOE + (size_t)le * MOE_E_BYTES); bf16* w2t = wc + 1024 * 2048;
            if (q < 256) tr_item(INP(40) + (size_t)le * (2048 * 512), 512, 512, wc, 2048, 0, 32, scr, q, F.lane);
            else if (q < 512) tr_item(INP(41) + (size_t)le * (2048 * 512), 512, 512, wc, 2048, 16, 32, scr, q - 256, F.lane);
            else tr_item(INP(42) + (size_t)le * (512 * 2048), 2048, 2048, w2t, 512, 0, 16, scr, q - 512, F.lane);
        }
    }
}

__device__ __forceinline__ void p1_reduce(Frame& F) {
    const int gt = F.bid * NTHREADS + F.tid, NGT = F.G * NTHREADS;
    const float* part = WSP(float, WS_ADAP); float* mod = WSP(float, WS_MOD); const float* adab = INP(5);
    for (int idx = gt; idx < 2 * 3 * 12288; idx += NGT) { const int l = idx / (3 * 12288), r = idx % (3 * 12288), m = r / 12288, j = r % 12288;
        float a = adab[l * 12288 + j];
        for (int ks = 0; ks < 32; ++ks) a += part[((size_t)(l * 32 + ks) * 3 + m) * 12288 + j];
        mod[idx] = a; }
    const float* normp = WSP(float, WS_NORMP); float* invn = WSP(float, WS_INVN);
    for (int idx = gt; idx < 2048; idx += NGT) { const int o = idx >> 10, ch = idx & 1023; float a = 0.f;
        for (int pb = 0; pb < 256; ++pb) a += normp[(size_t)pb * 4096 + o * 2048 + ch] + normp[(size_t)pb * 4096 + o * 2048 + 1024 + ch];
        invn[idx] = 1.0f / a; }
}

__device__ __forceinline__ const float* modp(Frame& F, int l, int m, int c) { return WSP(float, WS_MOD) + ((size_t)(l * 3 + m) * 6 + c) * 2048; }
__device__ __forceinline__ int row_stream(int r) { return r < TL ? r / SEQ : 2; }

template <int MODE>
__device__ __forceinline__ void norm_phase(Frame& F, int l, float* dout) {
    const int nrows = (MODE == 3 || (MODE == 1 && l == 1)) ? TL : TT;
    float* xbuf = WSP(float, WS_X); bf16* ha = WSP(bf16, WS_HA); const bf16* Y = WSP(bf16, WS_Y);
    const float* gvec = (MODE == 0) ? INP(6) : (MODE == 1) ? INP(7) + l * 2048 : (MODE == 2) ? INP(6) + 2048 : INP(8);
    const int lane = F.lane;
    for (int r = F.gw; r < nrows; r += F.NGW) {
        const int m = row_stream(r);
        const float* src = (MODE == 0) ? (r < TL ? INP(0) + (size_t)r * 2048 : INP(2) + (size_t)(r - TL) * 2048) : xbuf + (size_t)r * 2048;
        f32x4 v[8]; float ss = 0.f;
#pragma unroll
        for (int j = 0; j < 8; ++j) v[j] = *(const f32x4*)(src + 4 * lane + 256 * j);
        if (MODE == 2 || MODE == 3) {
            const float* g2 = modp(F, MODE == 2 ? 0 : 1, m, 5);
            const bf16* y0 = Y + (size_t)(2 * r) * 2048; const bf16* y1 = y0 + 2048;
#pragma unroll
            for (int j = 0; j < 8; ++j) { const int c = 4 * lane + 256 * j; const v2u a = *(const v2u*)(y0 + c), b = *(const v2u*)(y1 + c); const f32x4 gg = *(const f32x4*)(g2 + c);
                v[j].x += gg.x * (bflo(a.x) + bflo(b.x)); v[j].y += gg.y * (bfhi(a.x) + bfhi(b.x)); v[j].z += gg.z * (bflo(a.y) + bflo(b.y)); v[j].w += gg.w * (bfhi(a.y) + bfhi(b.y)); }
            if (MODE == 2) {
#pragma unroll
                for (int j = 0; j < 8; ++j) *(f32x4*)(xbuf + (size_t)r * 2048 + 4 * lane + 256 * j) = v[j];
            }
        }
#pragma unroll
        for (int j = 0; j < 8; ++j) ss += (v[j].x * v[j].x + v[j].y * v[j].y) + (v[j].z * v[j].z + v[j].w * v[j].w);
        ss = wave_sum(ss);
        const float rs = 1.0f / sqrtf(ss * (1.0f / 2048.0f) + EPS);
        if (MODE == 3) {
#pragma unroll
            for (int j = 0; j < 8; ++j) { const int c = 4 * lane + 256 * j; const f32x4 gg = *(const f32x4*)(gvec + c); *(f32x4*)(dout + (size_t)r * 2048 + c) = v[j] * rs * gg; }
            continue;
        }
        const int lm = (MODE == 2) ? 1 : l;
        const float* sh = modp(F, lm, m, MODE == 1 ? 3 : 0); const float* sc = modp(F, lm, m, MODE == 1 ? 4 : 1);
#pragma unroll
        for (int j = 0; j < 8; ++j) { const int c = 4 * lane + 256 * j; const f32x4 gg = *(const f32x4*)(gvec + c), s1 = *(const f32x4*)(sc + c), s0 = *(const f32x4*)(sh + c);
            v[j] = (v[j] * rs * gg) * (1.0f + s1) + s0;
            v2u o; o.x = pk2(v[j].x, v[j].y); o.y = pk2(v[j].z, v[j].w); *(v2u*)(ha + (size_t)r * 2048 + c) = o; }
        if (MODE == 1) {
            const float* wrt = WSP(float, WS_WRT) + (size_t)l * 72 * 2048;
            float lgG = 0.f, lgE = 0.f;
#pragma nounroll
            for (int n = 0; n < 72; ++n) { const float* wn = wrt + (size_t)n * 2048; float a = 0.f;
#pragma unroll
                for (int j = 0; j < 8; ++j) { const f32x4 w = *(const f32x4*)(wn + 4 * lane + 256 * j); a += (v[j].x * w.x + v[j].y * w.y) + (v[j].z * w.z + v[j].w * w.w); }
                a = wave_sum(a);
                if (n < 8) { if (lane == n) lgG = a; } else { if (lane == n - 8) lgE = a; } }
            if (lane < 8) lgG += INP(37)[l * 8 + lane];
            lgE += INP(39)[l * 64 + lane];
            float gl[8]; float gmax = -INFINITY; int gi = 0;
#pragma unroll
            for (int j = 0; j < 8; ++j) { gl[j] = __shfl(lgG, j); if (gl[j] > gmax) { gmax = gl[j]; gi = j; } }
            float gsum = 0.f;
#pragma unroll
            for (int j = 0; j < 8; ++j) gsum += expf(gl[j] - gmax);
            const float pg_top = 1.0f / gsum;
            float el[8]; float emax = -INFINITY;
#pragma unroll
            for (int j = 0; j < 8; ++j) { el[j] = __shfl(lgE, gi * 8 + j); emax = fmaxf(emax, el[j]); }
            float esum = 0.f; float pe[8];
#pragma unroll
            for (int j = 0; j < 8; ++j) { pe[j] = expf(el[j] - emax); esum += pe[j]; }
            int e1 = 0; float p1 = -1.f;
#pragma unroll
            for (int j = 0; j < 8; ++j) { pe[j] /= esum; if (pe[j] > p1) { p1 = pe[j]; e1 = j; } }
            int e2 = 0; float p2 = -1.f;
#pragma unroll
            for (int j = 0; j < 8; ++j) { if (j != e1 && pe[j] > p2) { p2 = pe[j]; e2 = j; } }
            const float den = p1 + p2; const float g1 = pg_top * p1 / den, g2 = pg_top * p2 / den;
            if (lane == 0) {
                unsigned* cnt = WSP(unsigned, WS_CTL) + CW_CNT + l * 64; int* tokl = WSP(int, WS_TOKL); float* gatel = WSP(float, WS_GATEL);
                const int ex1 = gi * 8 + e1, ex2 = gi * 8 + e2;
                const unsigned k1 = atomicAdd(cnt + ex1, 1u); tokl[(size_t)ex1 * LISTCAP + k1] = 2 * r; gatel[(size_t)ex1 * LISTCAP + k1] = g1;
                const unsigned k2 = atomicAdd(cnt + ex2, 1u); tokl[(size_t)ex2 * LISTCAP + k2] = 2 * r + 1; gatel[(size_t)ex2 * LISTCAP + k2] = g2;
            }
        }
    }
}

#define EPI_ARGS const f32x4 (&acc)[2][2][4][2], const pg8::Unit& u, int wr, int wc, int fr, int fq
__device__ __forceinline__ void st_bf4(bf16* p, f32x4 v) { v2u o; o.x = cvt_pk_bf16(v.x, v.y); o.y = cvt_pk_bf16(v.z, v.w); *(v2u*)p = o; }

struct EpiQKP {
    bf16* Q; bf16* Kb; bf16* P; const f32x2* rope;
    __device__ __forceinline__ void operator()(EPI_ARGS) const {
        const int sect = u.pn >> 2, cb = (u.pn & 3) * 256; const bool latent = u.pm < TL / 256;
#pragma unroll
        for (int ai = 0; ai < 2; ++ai)
#pragma unroll
            for (int m = 0; m < 4; ++m) {
                const int r = u.pm * 256 + ai * 128 + wr * 64 + m * 16 + fr;
                int b, t; if (latent) { b = r / SEQ; t = r % SEQ; } else { b = (r - TL) / CTX; t = (r - TL) % CTX; }
                f32x4 cs0 = {1.f, 0.f, 1.f, 0.f}, cs1 = cs0;
                if (latent && sect < 2) { const int pos = (wc & 1) ? (t & 63) : (t >> 6); const f32x4* rp = (const f32x4*)(rope + pos * 16 + 4 * fq); cs0 = rp[0]; cs1 = rp[1]; }
#pragma unroll
                for (int bj = 0; bj < 2; ++bj) {
                    const int c0 = cb + bj * 128 + wc * 32 + 4 * fq;
                    f32x4 a = acc[ai][bj][m][0], bb = acc[ai][bj][m][1];
                    if (sect < 2) {
                        const f32x4 co = {cs0.x, cs0.z, cs1.x, cs1.z}, si = {cs0.y, cs0.w, cs1.y, cs1.w};
                        const f32x4 oa = a * co - bb * si, ob = a * si + bb * co; a = oa; bb = ob;
                    }
                    if (sect == 0) { a = a * QSCALE; bb = bb * QSCALE; bf16* d = Q + (size_t)r * 1024 + c0; st_bf4(d, a); st_bf4(d + 16, bb); }
                    else if (sect == 1) { const size_t kr = (size_t)b * KEYS + (latent ? CTX + t : t); bf16* d = Kb + kr * 1024 + c0; st_bf4(d, a); st_bf4(d + 16, bb); }
                    else { bf16* d = P + (size_t)r * 1024 + c0; st_bf4(d, a); st_bf4(d + 16, bb); }
                }
            }
    }
};
struct EpiVT {
    bf16* VT;
    __device__ __forceinline__ void operator()(EPI_ARGS) const {
        const bool latent = u.pn < TL / 256; const int b = latent ? u.pn / 32 : u.pn - TL / 256; const int key_t0 = latent ? CTX + (u.pn % 32) * 256 : 0;
        const int kperm = 8 * (fq & 1) + 4 * (fq >> 1);
#pragma unroll
        for (int ai = 0; ai < 2; ++ai)
#pragma unroll
            for (int m = 0; m < 4; ++m) {
                const int rr = u.pm * 256 + ai * 128 + wr * 64 + m * 16 + fr;
                bf16* rowp = VT + ((size_t)b * 1024 + rr) * KEYS + key_t0;
#pragma unroll
                for (int bj = 0; bj < 2; ++bj)
#pragma unroll
                    for (int n = 0; n < 2; ++n) st_bf4(rowp + bj * 128 + wc * 32 + 16 * n + kperm, acc[ai][bj][m][n]);
            }
    }
};
struct EpiScaleBf16 {
    bf16* O; int ldo, coff; const float* cscale;
    __device__ __forceinline__ void operator()(EPI_ARGS) const {
#pragma unroll
        for (int bj = 0; bj < 2; ++bj)
#pragma unroll
            for (int n = 0; n < 2; ++n) { const int c = u.pn * 256 + bj * 128 + wc * 32 + 16 * n + 4 * fq; const f32x4 sc = *(const f32x4*)(cscale + c);
#pragma unroll
                for (int ai = 0; ai < 2; ++ai)
#pragma unroll
                    for (int m = 0; m < 4; ++m) { const int r = u.pm * 256 + ai * 128 + wr * 64 + m * 16 + fr; st_bf4(O + (size_t)r * ldo + coff + c, acc[ai][bj][m][n] * sc); } }
    }
};
struct EpiBf16 {
    bf16* O; int ldo;
    __device__ __forceinline__ void operator()(EPI_ARGS) const {
#pragma unroll
        for (int ai = 0; ai < 2; ++ai)
#pragma unroll
            for (int m = 0; m < 4; ++m) { const int r = u.pm * 256 + ai * 128 + wr * 64 + m * 16 + fr; bf16* rowp = O + (size_t)r * ldo + u.pn * 256 + wc * 32 + 4 * fq;
#pragma unroll
                for (int bj = 0; bj < 2; ++bj)
#pragma unroll
                    for (int n = 0; n < 2; ++n) st_bf4(rowp + bj * 128 + 16 * n, acc[ai][bj][m][n]); }
    }
};
struct EpiRes {
    const float* xlat; const float* xctx; float* xout; const float* gate0;
    __device__ __forceinline__ void operator()(EPI_ARGS) const {
        const bool latent = u.pm < TL / 256;
#pragma unroll
        for (int ai = 0; ai < 2; ++ai)
#pragma unroll
            for (int m = 0; m < 4; ++m) { const int r = u.pm * 256 + ai * 128 + wr * 64 + m * 16 + fr; const int ms = latent ? r / SEQ : 2;
                const float* xi = latent ? xlat + (size_t)r * 2048 : xctx + (size_t)(r - TL) * 2048; const float* gp = gate0 + (size_t)ms * 12288;
#pragma unroll
                for (int bj = 0; bj < 2; ++bj)
#pragma unroll
                    for (int n = 0; n < 2; ++n) { const int c = u.pn * 256 + bj * 128 + wc * 32 + 16 * n + 4 * fq;
                        const f32x4 xv = *(const f32x4*)(xi + c), gv = *(const f32x4*)(gp + c); *(f32x4*)(xout + (size_t)r * 2048 + c) = xv + gv * acc[ai][bj][m][n]; } }
    }
};
struct EpiMoeUp {
    bf16* H;
    __device__ __forceinline__ void operator()(EPI_ARGS) const {
#pragma unroll
        for (int ai = 0; ai < 2; ++ai)
#pragma unroll
            for (int m = 0; m < 4; ++m) { const size_t r = (size_t)u.pm * 256 + ai * 128 + wr * 64 + m * 16 + fr;
#pragma unroll
                for (int bj = 0; bj < 2; ++bj) { const int hc = (u.pn * 256 + bj * 128 + wc * 32) / 2 + 4 * fq; const f32x4 a = acc[ai][bj][m][0], b = acc[ai][bj][m][1];
                    const f32x4 h = {siluf_(a.x) * b.x, siluf_(a.y) * b.y, siluf_(a.z) * b.z, siluf_(a.w) * b.w}; st_bf4(H + r * 512 + hc, h); } }
    }
};
struct EpiMoeDown {
    bf16* Y; const int* tokl; const float* gatel; const unsigned* cnt;
    __device__ __forceinline__ void operator()(EPI_ARGS) const {
        const int ce = (int)cnt[u.e];
#pragma unroll
        for (int ai = 0; ai < 2; ++ai)
#pragma unroll
            for (int m = 0; m < 4; ++m) { const int idx = u.idx0 + ai * 128 + wr * 64 + m * 16 + fr;
                if (idx < ce) { const int pair = tokl[(size_t)u.e * LISTCAP + idx]; const float gt = gatel[(size_t)u.e * LISTCAP + idx]; bf16* rowp = Y + (size_t)pair * 2048 + u.pn * 256 + wc * 32 + 4 * fq;
#pragma unroll
                    for (int bj = 0; bj < 2; ++bj)
#pragma unroll
                        for (int n = 0; n < 2; ++n) st_bf4(rowp + bj * 128 + 16 * n, acc[ai][bj][m][n] * gt); } }
    }
};
struct EpiGlu {
    bf16* O; int ldo, coff; const bf16* Gb; const float* bias;
    __device__ __forceinline__ void operator()(EPI_ARGS) const {
#pragma unroll
        for (int ai = 0; ai < 2; ++ai)
#pragma unroll
            for (int m = 0; m < 4; ++m) { const int r = u.pm * 256 + ai * 128 + wr * 64 + m * 16 + fr;
#pragma unroll
                for (int bj = 0; bj < 2; ++bj)
#pragma unroll
                    for (int n = 0; n < 2; ++n) { const int c = u.pn * 256 + bj * 128 + wc * 32 + 16 * n + 4 * fq; const f32x4 bv = *(const f32x4*)(bias + c); const v2u gw = *(const v2u*)(Gb + (size_t)r * 1024 + c);
                        const f32x4 a = acc[ai][bj][m][n] + bv; const f32x4 o = {bflo(gw.x) * sigmoidf_(a.x), bfhi(gw.x) * sigmoidf_(a.y), bflo(gw.y) * sigmoidf_(a.z), bfhi(gw.y) * sigmoidf_(a.w)};
                        st_bf4(O + (size_t)r * ldo + coff + c, o); } }
    }
};

struct MoeOrder {
    const LAS int* bstart;
    const unsigned* cnt; const int* tokl; int nN, G, c, nblk; long bstride, eoff; bool up;
    __device__ bool next(int i, pg8::Unit& u) const {
        const long Lx = (long)i * G + c; if (Lx >= (long)nblk * nN) return false;
        const int blk = (int)(Lx / nN); u.pn = (int)(Lx % nN); u.pm = blk;
        const int e = bstart[65 + blk];
        u.e = e; u.idx0 = (blk - bstart[e]) * 256;
        u.aoff = up ? 0 : (long)blk * 256 * 512 * 2;
        u.boff = (long)e * (long)MOE_E_BYTES + eoff + (long)u.pn * bstride;
        return true;
    }
    __device__ int arow(const pg8::Unit& u, int row) const { const int idx = u.idx0 + row; return idx < (int)cnt[u.e] ? (tokl[(size_t)u.e * LISTCAP + idx] >> 1) : TT; }
};

__device__ __forceinline__ void attn_phase(Frame& F) {
    const bf16* Q = WSP(bf16, WS_Q); const bf16* Kb = WSP(bf16, WS_K); const bf16* VT = WSP(bf16, WS_VT); bf16* cat = WSP(bf16, WS_CAT);
    LAS unsigned char* lds = F.lds;
    const int tid = F.tid, lane = F.lane, w = F.wave, sub = w & 1, qw = w >> 1, r32 = lane & 31, hi = lane >> 5;
    float lam;
    { const float* lv = INP(11); float a = lv[lane] * lv[64 + lane], b = lv[128 + lane] * lv[192 + lane]; a = wave_sum(a); b = wave_sum(b); lam = expf(a) - expf(b) + 0.2f; }
    const float* subg = INP(12);
    const int NU = 1024 + 32;
    const int xcd = F.bid & 7, jcu = F.bid >> 3;
    for (int it = 0;; ++it) {
        int uidx;
        if (F.G == 256) { if (it < 4) uidx = 128 * xcd + it * 32 + jcu; else if (it == 4 && F.bid < 32) uidx = 1024 + F.bid; else break; }
        else { uidx = it * F.G + F.bid; if (uidx >= NU) break; }
        int b, head, q0row, nt; size_t kbase;
        if (uidx < 1024) { const int combo = uidx >> 6, qb = uidx & 63; b = combo >> 3; head = combo & 7; q0row = b * SEQ + qb * 128; nt = KEYS / 64; }
        else { const int v = uidx - 1024; b = v >> 4; head = (v >> 1) & 7; q0row = TL + b * CTX + (v & 1) * 128; nt = CTX / 64; }
        kbase = (size_t)b * KEYS;
        bf16x8 qf[4];
        { const bf16* qp = Q + (size_t)(q0row + qw * 32 + r32) * 1024 + head * 128 + sub * 64 + hi * 8;
#pragma unroll
          for (int ks = 0; ks < 4; ++ks) qf[ks] = *(const bf16x8*)(qp + ks * 16); }
        const int srow = tid >> 3, sch = tid & 7;
        const bf16* gk0 = Kb + (kbase + srow) * 1024 + head * 128 + sch * 8;
        const bf16* gv0 = VT + ((size_t)(b * 8 + head) * 128 + srow) * KEYS + sch * 8;
        const int lk = srow * 128 + ((sch ^ ((srow >> 1) & 7)) * 16);
        v4u st0, st1, st2, st3;
#define ATT_LOAD(t) do { st0 = *(const v4u*)(gk0 + (size_t)(t) * 65536); st1 = *(const v4u*)(gk0 + (size_t)(t) * 65536 + 64); st2 = *(const v4u*)(gv0 + (t) * 64); st3 = *(const v4u*)(gv0 + (size_t)64 * KEYS + (t) * 64); } while (0)
#define ATT_STORE(buf) do { LAS unsigned char* bp = lds + (buf) * 32768; *(LAS v4u*)(bp + lk) = st0; *(LAS v4u*)(bp + 8192 + lk) = st1; *(LAS v4u*)(bp + 16384 + lk) = st2; *(LAS v4u*)(bp + 16384 + 8192 + lk) = st3; } while (0)
        ATT_LOAD(0); ATT_STORE(0);
        __syncthreads();
        f32x16 o[4];
#pragma unroll
        for (int d = 0; d < 4; ++d)
#pragma unroll
            for (int r = 0; r < 16; ++r) o[d][r] = 0.f;
        float mrow = -INFINITY, lrow = 0.f;
        const int rdoff = r32 * 128;
        const int swz = (r32 >> 1) & 7;
        for (int t = 0; t < nt; ++t) {
            if (t + 1 < nt) ATT_LOAD(t + 1);
            const LAS unsigned char* bp = lds + (t & 1) * 32768;
            const LAS unsigned char* kp = bp + sub * 8192;
            f32x16 s0, s1;
#pragma unroll
            for (int r = 0; r < 16; ++r) { s0[r] = 0.f; s1[r] = 0.f; }
#pragma unroll
            for (int ks = 0; ks < 4; ++ks) {
                const int ch = ((2 * ks + hi) ^ swz) * 16;
                const bf16x8 k0 = *(const LAS bf16x8*)(kp + rdoff + ch);
                const bf16x8 k1 = *(const LAS bf16x8*)(kp + 4096 + rdoff + ch);
                s0 = __builtin_amdgcn_mfma_f32_32x32x16_bf16(k0, qf[ks], s0, 0, 0, 0);
                s1 = __builtin_amdgcn_mfma_f32_32x32x16_bf16(k1, qf[ks], s1, 0, 0, 0);
            }
            float mx = s0[0];
#pragma unroll
            for (int r = 1; r < 16; ++r) mx = fmaxf(mx, s0[r]);
#pragma unroll
            for (int r = 0; r < 16; ++r) mx = fmaxf(mx, s1[r]);
            mx = fmaxf(mx, __shfl_xor(mx, 32));
            const float mnew = fmaxf(mrow, mx);
            const float alpha = __builtin_amdgcn_exp2f(mrow - mnew);
            mrow = mnew;
            float rs = 0.f;
#pragma unroll
            for (int r = 0; r < 16; ++r) { s0[r] = __builtin_amdgcn_exp2f(s0[r] - mnew); rs += s0[r]; }
#pragma unroll
            for (int r = 0; r < 16; ++r) { s1[r] = __builtin_amdgcn_exp2f(s1[r] - mnew); rs += s1[r]; }
            lrow = lrow * alpha + rs;
            if (__any(alpha != 1.0f)) {
#pragma unroll
                for (int d = 0; d < 4; ++d)
#pragma unroll
                    for (int r = 0; r < 16; ++r) o[d][r] *= alpha;
            }
            bf16x8 pf[4];
#pragma unroll
            for (int s = 0; s < 4; ++s) { v4u pw;
                if (s < 2) { pw.x = cvt_pk_bf16(s0[8 * s + 0], s0[8 * s + 1]); pw.y = cvt_pk_bf16(s0[8 * s + 2], s0[8 * s + 3]); pw.z = cvt_pk_bf16(s0[8 * s + 4], s0[8 * s + 5]); pw.w = cvt_pk_bf16(s0[8 * s + 6], s0[8 * s + 7]); }
                else { const int q = s - 2; pw.x = cvt_pk_bf16(s1[8 * q + 0], s1[8 * q + 1]); pw.y = cvt_pk_bf16(s1[8 * q + 2], s1[8 * q + 3]); pw.z = cvt_pk_bf16(s1[8 * q + 4], s1[8 * q + 5]); pw.w = cvt_pk_bf16(s1[8 * q + 6], s1[8 * q + 7]); }
                pf[s] = __builtin_bit_cast(bf16x8, pw); }
            const LAS unsigned char* vp = bp + 16384;
#pragma unroll
            for (int d = 0; d < 4; ++d)
#pragma unroll
                for (int s = 0; s < 4; ++s) {
                    const bf16x8 vf = *(const LAS bf16x8*)(vp + d * 4096 + rdoff + (((2 * s + hi) ^ swz) * 16));
                    o[d] = __builtin_amdgcn_mfma_f32_32x32x16_bf16(vf, pf[s], o[d], 0, 0, 0);
                }
            if (t + 1 < nt) ATT_STORE((t + 1) & 1);
            __syncthreads();
        }
#undef ATT_LOAD
#undef ATT_STORE
        const float ltot = lrow + __shfl_xor(lrow, 32); const float linv = 1.0f / ltot;
        LAS float* xch = (LAS float*)lds + (size_t)(qw * 32 + r32) * 132;
        if (sub == 1) {
#pragma unroll
            for (int d = 0; d < 4; ++d)
#pragma unroll
                for (int g = 0; g < 4; ++g) *(LAS f32x4*)(xch + 32 * d + 8 * g + 4 * hi) = (f32x4){o[d][4 * g] * linv, o[d][4 * g + 1] * linv, o[d][4 * g + 2] * linv, o[d][4 * g + 3] * linv};
        }
        __syncthreads();
        if (sub == 0) {
            float ss = 0.f;
#pragma unroll
            for (int d = 0; d < 4; ++d)
#pragma unroll
                for (int g = 0; g < 4; ++g) { const f32x4 o2 = *(const LAS f32x4*)(xch + 32 * d + 8 * g + 4 * hi);
#pragma unroll
                    for (int j = 0; j < 4; ++j) { const float v = o[d][4 * g + j] * linv - lam * o2[j]; o[d][4 * g + j] = v; ss += v * v; } }
            ss += __shfl_xor(ss, 32);
            const float rn = 0.8f / sqrtf(ss * (1.0f / 128.0f) + EPS);
            bf16* op = cat + (size_t)(q0row + qw * 32 + r32) * 2048 + head * 128;
#pragma unroll
            for (int d = 0; d < 4; ++d)
#pragma unroll
                for (int g = 0; g < 4; ++g) { const int dv = 32 * d + 8 * g + 4 * hi; const f32x4 gg = *(const f32x4*)(subg + dv);
                    st_bf4(op + dv, (f32x4){o[d][4 * g] * rn * gg.x, o[d][4 * g + 1] * rn * gg.y, o[d][4 * g + 2] * rn * gg.z, o[d][4 * g + 3] * rn * gg.w}); }
        }
        __syncthreads();
    }
}

__device__ __forceinline__ void poold_phase(Frame& F) {
    const bf16* P = WSP(bf16, WS_P); bf16* PD = WSP(bf16, WS_PD);
    const int gt = F.bid * NTHREADS + F.tid, NGT = F.G * NTHREADS;
    for (int idx = gt; idx < TT * 128; idx += NGT) {
        const int r = idx >> 7, cc = (idx & 127) * 8, g = cc >> 8, wdw = 2 << g;
        int sb, t, Ls; if (r < TL) { sb = (r / SEQ) * SEQ; t = r % SEQ; Ls = SEQ; } else { sb = TL + ((r - TL) / CTX) * CTX; t = (r - TL) % CTX; Ls = CTX; }
        int lo = t - wdw / 2, hi = lo + wdw; lo = lo < 0 ? 0 : lo; hi = hi > Ls ? Ls : hi;
        float a[8];
#pragma unroll
        for (int j = 0; j < 8; ++j) a[j] = 0.f;
        for (int s = lo; s < hi; ++s) { const v4u v = *(const v4u*)(P + (size_t)(sb + s) * 1024 + cc);
            a[0] += bflo(v.x); a[1] += bfhi(v.x); a[2] += bflo(v.y); a[3] += bfhi(v.y); a[4] += bflo(v.z); a[5] += bfhi(v.z); a[6] += bflo(v.w); a[7] += bfhi(v.w); }
        const float inv = 1.0f / (float)(hi - lo);
        const v4u me = *(const v4u*)(P + (size_t)r * 1024 + cc);
        v4u o; o.x = pk2(a[0] * inv - bflo(me.x), a[1] * inv - bfhi(me.x)); o.y = pk2(a[2] * inv - bflo(me.y), a[3] * inv - bfhi(me.y));
        o.z = pk2(a[4] * inv - bflo(me.z), a[5] * inv - bfhi(me.z)); o.w = pk2(a[6] * inv - bflo(me.w), a[7] * inv - bfhi(me.w));
        *(v4u*)(PD + (size_t)r * 1024 + cc) = o;
    }
}

__device__ __forceinline__ void shortconv_phase(Frame& F) {
    const bf16* PJ = WSP(bf16, WS_PROJ1); float* GT = WSP(float, WS_GT);
    const float* cw = INP(17); const float* cb = INP(18);
    LAS float* scr = (LAS float*)(F.lds + F.wave * 16896);
    const int lane = F.lane;
    for (int it = F.gw; it < 2 * 128 * 48; it += F.NGW) {
        const int cbk = it % 48, tb = (it / 48) % 128, b = it / (48 * 128), col = cbk * 64 + lane, t0 = tb * 64;
        const float w0 = cw[col], w1 = cw[3072 + col], w2 = cw[2 * 3072 + col], bias = cb[col];
        const bf16* base = PJ + ((size_t)b * SEQ) * 4096 + col;
        float prev = (t0 > 0) ? bf2f(base[(size_t)(t0 - 1) * 4096]) : 0.f;
        float cur = bf2f(base[(size_t)t0 * 4096]);
#pragma unroll 8
        for (int tt = 0; tt < 64; ++tt) { const int t = t0 + tt; const float nxt = (t + 1 < SEQ) ? bf2f(base[(size_t)(t + 1) * 4096]) : 0.f;
            scr[tt * 65 + lane] = prev * w0 + cur * w1 + nxt * w2 + bias; prev = cur; cur = nxt; }
        LDS_WAIT(); asm volatile("" ::: "memory");
        for (int c = 0; c < 64; ++c) GT[((size_t)(cbk * 64 + c) * 2 + b) * SEQ + t0 + lane] = scr[lane * 65 + c];
        LDS_WAIT(); asm volatile("" ::: "memory");
    }
}

__device__ __forceinline__ void s5_scan_phase(Frame& F) {
    const bf16* PJ = WSP(bf16, WS_PROJ1); float* YD = WSP(float, WS_YD);
    const f32x2* lamb = WSP(f32x2, WS_S5LAM); const f32x2* bbar = WSP(f32x2, WS_S5B);
    const float* cre = INP(31); const float* cim = INP(32);
    const int lane = F.lane;
    for (int task = F.wave * F.G + F.bid; task < 256; task += F.NGW) {
        const int di = task >> 7, b = (task >> 6) & 1, g = task & 63;
        const int dgp = (di * 64 + g) * 64 + lane;
        const f32x2 lam = lamb[dgp];
        float br[16], bi[16], cr[16], ci[16];
#pragma unroll
        for (int c = 0; c < 16; ++c) { const f32x2 bv = bbar[(size_t)dgp * 16 + c]; br[c] = bv.x; bi[c] = bv.y;
            cr[c] = cre[((size_t)(di * 64 + g) * 16 + c) * 64 + lane]; ci[c] = cim[((size_t)(di * 64 + g) * 16 + c) * 64 + lane]; }
        float sr = 0.f, si = 0.f;
        const int nsteps = CTX + SEQ;
        for (int st = 0; st < nsteps; st += 4) {
            const int stl = st + (lane >> 4);
            int row;
            if (stl < CTX) row = TL + b * CTX + (di == 0 ? stl : CTX - 1 - stl);
            else row = b * SEQ + (di == 0 ? stl - CTX : SEQ - 1 - (stl - CTX));
            const float uval = bf2f(PJ[(size_t)row * 4096 + 3072 + g * 16 + (lane & 15)]);
#pragma unroll
            for (int k = 0; k < 4; ++k) {
                float bur = 0.f, bui = 0.f;
#pragma unroll
                for (int c = 0; c < 16; ++c) { const float u = __builtin_bit_cast(float, __builtin_amdgcn_readlane(__builtin_bit_cast(int, uval), 16 * k + c)); bur += br[c] * u; bui += bi[c] * u; }
                const float nr = lam.x * sr - lam.y * si + bur, ni = lam.x * si + lam.y * sr + bui; sr = nr; si = ni;
                const int s2 = st + k;
                if (s2 >= CTX) {
                    const int t = (di == 0) ? s2 - CTX : SEQ - 1 - (s2 - CTX);
                    float outv = 0.f;
#pragma unroll
                    for (int c = 0; c < 16; ++c) { float v = cr[c] * sr - ci[c] * si; v = wave_sum(v); if (lane == c) outv = v; }
                    if (lane < 16) YD[((size_t)di * TL + (size_t)b * SEQ + t) * 1024 + g * 16 + lane] = outv;
                }
            }
        }
    }
}

__device__ __forceinline__ void hyena_naive_phase(Frame& F) {
    const float* GT = WSP(float, WS_GT); const float* kT = WSP(float, WS_KT); const float* invn = WSP(float, WS_INVN); bf16* cat = WSP(bf16, WS_CAT);
    const float* hyb = INP(25);
    LAS float* kf = (LAS float*)F.lds;
    LAS f32x2* ub = (LAS f32x2*)(F.lds + 65536);
    const int tid = F.tid;
    for (int ch = F.bid; ch < 1024; ch += F.G) {
        float res0[16], res1[16];
        for (int o = 0; o < 2; ++o) {
            const float inv = invn[o * 1024 + ch];
            const float* kfw = kT + (size_t)(o * 2048 + ch) * SEQ; const float* kbw = kT + (size_t)(o * 2048 + 1024 + ch) * SEQ;
            for (int n = tid; n < 16384; n += NTHREADS) { float v; if (n < SEQ) v = kfw[n]; else if (n == SEQ) v = 0.f; else v = kbw[16384 - n]; kf[n] = v * inv; }
            if (o == 0) { const float* v0 = GT + ((size_t)(0 * 1024 + ch) * 2) * SEQ; for (int n = tid; n < SEQ; n += NTHREADS) ub[n] = (f32x2){v0[n], v0[SEQ + n]}; }
            else {
#pragma unroll
                for (int j = 0; j < 16; ++j) ub[tid + NTHREADS * j] = (f32x2){res0[j], res1[j]}; }
            __syncthreads();
            float a0[16], a1[16];
#pragma unroll
            for (int j = 0; j < 16; ++j) { a0[j] = 0.f; a1[j] = 0.f; }
            for (int s = 0; s < SEQ; ++s) { const f32x2 u = ub[s];
#pragma unroll
                for (int j = 0; j < 16; ++j) { const float kk = kf[(tid + NTHREADS * j - s) & 16383]; a0[j] += u.x * kk; a1[j] += u.y * kk; } }
            const float bias = hyb[o * 1024 + ch];
            const float* xg = GT + ((size_t)((o + 1) * 1024 + ch) * 2) * SEQ;
#pragma unroll
            for (int j = 0; j < 16; ++j) { const int t = tid + NTHREADS * j; const f32x2 u = ub[t];
                res0[j] = xg[t] * (a0[j] + bias * u.x); res1[j] = xg[SEQ + t] * (a1[j] + bias * u.y); }
            __syncthreads();
        }
#pragma unroll
        for (int j = 0; j < 16; ++j) { const int t = tid + NTHREADS * j;
            cat[(size_t)t * 2048 + ch] = (bf16)f2bf(res0[j]); cat[((size_t)SEQ + t) * 2048 + ch] = (bf16)f2bf(res1[j]); }
    }
}

__device__ __forceinline__ void s5_gelu_phase(Frame& F) {
    const bf16* PJ = WSP(bf16, WS_PROJ1); const float* YD = WSP(float, WS_YD); bf16* Gb = WSP(bf16, WS_PD); const float* dd = INP(33);
    const int gt = F.bid * NTHREADS + F.tid, NGT = F.G * NTHREADS;
    for (int idx = gt; idx < TL * 256; idx += NGT) { const int r = idx >> 8, c = (idx & 255) * 4;
        const v2u uw = *(const v2u*)(PJ + (size_t)r * 4096 + 3072 + c); const f32x4 d4 = *(const f32x4*)(dd + c);
        const f32x4 y0 = *(const f32x4*)(YD + (size_t)r * 1024 + c), y1 = *(const f32x4*)(YD + ((size_t)TL + r) * 1024 + c);
        const f32x4 y = {bflo(uw.x) * d4.x + y0.x + y1.x, bfhi(uw.x) * d4.y + y0.y + y1.y, bflo(uw.y) * d4.z + y0.z + y1.z, bfhi(uw.y) * d4.w + y0.w + y1.w};
        st_bf4(Gb + (size_t)r * 1024 + c, (f32x4){gelu_tanh(y.x), gelu_tanh(y.y), gelu_tanh(y.z), gelu_tanh(y.w)}); }
}

__device__ __forceinline__ f32x2 cmulf(f32x2 a, f32x2 b) { return (f32x2){a.x * b.x - a.y * b.y, a.x * b.y + a.y * b.x}; }
__device__ __forceinline__ int drev14(int p) { const unsigned r = __builtin_bitreverse32((unsigned)p) >> 18; return (int)(((r & 0x2AAAu) >> 1) | ((r & 0x1555u) << 1)); }
__device__ __forceinline__ void fft_fwd(LAS f32x2* X, const f32x2* tw, int tid) {
#pragma nounroll
    for (int L = 4096; L >= 1; L >>= 2) {
        const int tws = 4096 / L;
#pragma unroll 2
        for (int i = 0; i < 8; ++i) {
            const int b = tid + NTHREADS * i, j = b & (L - 1), i0 = (b - j) * 4 + j;
            const f32x2 x0 = X[i0], x1 = X[i0 + L], x2 = X[i0 + 2 * L], x3 = X[i0 + 3 * L];
            const f32x2 w1 = tw[j * tws], w2 = cmulf(w1, w1), w3 = cmulf(w2, w1);
            const f32x2 a = x0 + x2, bb = x0 - x2, c = x1 + x3, d = x1 - x3;
            const f32x2 t1 = {bb.x + d.y, bb.y - d.x}, t3 = {bb.x - d.y, bb.y + d.x};
            X[i0] = a + c; X[i0 + L] = cmulf(t1, w1); X[i0 + 2 * L] = cmulf(a - c, w2); X[i0 + 3 * L] = cmulf(t3, w3);
        }
        __syncthreads();
    }
}
__device__ __forceinline__ void fft_inv(LAS f32x2* X, const f32x2* tw, int tid) {
#pragma nounroll
    for (int L = 1; L <= 4096; L <<= 2) {
        const int tws = 4096 / L;
#pragma unroll 2
        for (int i = 0; i < 8; ++i) {
            const int b = tid + NTHREADS * i, j = b & (L - 1), i0 = (b - j) * 4 + j;
            f32x2 w1 = tw[j * tws]; w1.y = -w1.y; const f32x2 w2 = cmulf(w1, w1), w3 = cmulf(w2, w1);
            const f32x2 x0 = X[i0], x1 = cmulf(X[i0 + L], w1), x2 = cmulf(X[i0 + 2 * L], w2), x3 = cmulf(X[i0 + 3 * L], w3);
            const f32x2 a = x0 + x2, bb = x0 - x2, c = x1 + x3, d = x1 - x3;
            X[i0] = a + c; X[i0 + L] = (f32x2){bb.x - d.y, bb.y + d.x}; X[i0 + 2 * L] = a - c; X[i0 + 3 * L] = (f32x2){bb.x + d.y, bb.y - d.x};
        }
        __syncthreads();
    }
}
__device__ __forceinline__ void fft_pointwise(LAS f32x2* X, const f32x2* Wg, int o, float scale, int tid) {
    const float hs = 0.5f * scale;
#pragma unroll 4
    for (int i = 0; i < 32; ++i) {
        const int p = tid + NTHREADS * i, f = drev14(p), pm = drev14((16384 - f) & 16383);
        const unsigned long long ua = __hip_atomic_load((const unsigned long long*)(Wg + p), __ATOMIC_RELAXED, __HIP_MEMORY_SCOPE_AGENT);
        const unsigned long long ub = __hip_atomic_load((const unsigned long long*)(Wg + pm), __ATOMIC_RELAXED, __HIP_MEMORY_SCOPE_AGENT);
        const f32x2 A = __builtin_bit_cast(f32x2, ua), B = __builtin_bit_cast(f32x2, ub);
        f32x2 K;
        if (o == 0) K = (f32x2){(A.x + B.x) * hs, (A.y - B.y) * hs};
        else { const f32x2 dd = {A.x - B.x, A.y + B.y}; K = (f32x2){dd.y * hs, -dd.x * hs}; }
        X[p] = cmulf(X[p], K);
    }
    __syncthreads();
}
__device__ __forceinline__ void hyena_fft_phase(Frame& F) {
    float* GT = WSP(float, WS_GT); const float* kT = WSP(float, WS_KT); const float* invn = WSP(float, WS_INVN); const f32x2* tw = WSP(f32x2, WS_TW);
    f32x2* Wg = WSP(f32x2, WS_FFTW) + (size_t)F.bid * 16384;
    const float* hyb = INP(25);
    LAS f32x2* X = (LAS f32x2*)F.lds;
    const int tid = F.tid;
    for (int ch = F.bid; ch < 1024; ch += F.G) {
        { const float* f0 = kT + (size_t)ch * SEQ; const float* b0 = kT + (size_t)(1024 + ch) * SEQ; const float* f1 = kT + (size_t)(2048 + ch) * SEQ; const float* b1 = kT + (size_t)(3072 + ch) * SEQ;
          for (int n = tid; n < SEQ; n += NTHREADS) { X[n] = (f32x2){f0[n], f1[n]}; X[SEQ + n] = (n == 0) ? (f32x2){0.f, 0.f} : (f32x2){b0[SEQ - n], b1[SEQ - n]}; } }
        __syncthreads();
        fft_fwd(X, tw, tid);
        for (int n = tid; n < 16384; n += NTHREADS) Wg[n] = X[n];
        __syncthreads();
        float* v0 = GT + ((size_t)ch * 2) * SEQ;
        const float* x1 = GT + ((size_t)(1024 + ch) * 2) * SEQ; const float* x2 = GT + ((size_t)(2048 + ch) * 2) * SEQ;
        float z0[16], z1[16];
#pragma unroll
        for (int j = 0; j < 16; ++j) { const int n = tid + NTHREADS * j; z0[j] = v0[n]; z1[j] = v0[SEQ + n]; }
#pragma unroll
        for (int o = 0; o < 2; ++o) {
#pragma unroll
            for (int j = 0; j < 16; ++j) { const int n = tid + NTHREADS * j; X[n] = (f32x2){z0[j], z1[j]}; X[SEQ + n] = (f32x2){0.f, 0.f}; }
            __syncthreads();
            fft_fwd(X, tw, tid);
            fft_pointwise(X, Wg, o, invn[o * 1024 + ch] * (1.0f / 16384.0f), tid);
            fft_inv(X, tw, tid);
            const float bias = hyb[o * 1024 + ch]; const float* xg = (o == 0) ? x1 : x2;
#pragma unroll
            for (int j = 0; j < 16; ++j) { const int n = tid + NTHREADS * j; const f32x2 y = X[n]; z0[j] = xg[n] * (y.x + bias * z0[j]); z1[j] = xg[SEQ + n] * (y.y + bias * z1[j]); }
            __syncthreads();
        }
#pragma unroll
        for (int j = 0; j < 16; ++j) { const int n = tid + NTHREADS * j; v0[n] = z0[j]; v0[SEQ + n] = z1[j]; }
    }
}
__device__ __forceinline__ void hyena_out_transpose(Frame& F) {
    const float* GT = WSP(float, WS_GT); bf16* cat = WSP(bf16, WS_CAT);
    LAS float* scr = (LAS float*)(F.lds + F.wave * 16896);
    const int lane = F.lane;
    for (int it = F.gw; it < 2 * 128 * 16; it += F.NGW) {
        const int cbk = it & 15, tb = (it >> 4) & 127, b = it >> 11, t0 = tb * 64;
        for (int c = 0; c < 64; ++c) scr[c * 65 + lane] = GT[((size_t)(cbk * 64 + c) * 2 + b) * SEQ + t0 + lane];
        LDS_WAIT(); asm volatile("" ::: "memory");
        for (int tt = 0; tt < 64; ++tt) cat[((size_t)b * SEQ + t0 + tt) * 2048 + cbk * 64 + lane] = (bf16)f2bf(scr[lane * 65 + tt]);
        LDS_WAIT(); asm volatile("" ::: "memory");
    }
}

__device__ __forceinline__ int s5_row(int di, int b, int s) {
    return (s < CTX) ? TL + b * CTX + (di == 0 ? s : CTX - 1 - s) : b * SEQ + (di == 0 ? s - CTX : SEQ - 1 - (s - CTX));
}
template <bool OUTPUT>
__device__ __forceinline__ void s5_seg_phase(Frame& F) {
    const bf16* PJ = WSP(bf16, WS_PROJ1); float* YD = WSP(float, WS_YD);
    const f32x2* lamb = WSP(f32x2, WS_S5LAM); const f32x2* bbar = WSP(f32x2, WS_S5B); const f32x2* l256 = WSP(f32x2, WS_S5L256); f32x2* Eb = WSP(f32x2, WS_S5E);
    const float* cre = INP(31); const float* cim = INP(32);
    const int lane = F.lane;
    for (int task = F.wave * F.G + F.bid; task < 256 * 32; task += F.NGW) {
        const int dbg = task >> 5, seg = (task & 31) + (OUTPUT ? 1 : 0);
        const int di = dbg >> 7, b = (dbg >> 6) & 1, g = dbg & 63;
        const int dgp = (di * 64 + g) * 64 + lane;
        const f32x2 lam = lamb[dgp];
        float br[16], bi[16];
#pragma unroll
        for (int c = 0; c < 16; ++c) { const f32x2 bv = bbar[(size_t)dgp * 16 + c]; br[c] = bv.x; bi[c] = bv.y; }
        float cr[16], ci[16];
        if (OUTPUT) {
#pragma unroll
            for (int c = 0; c < 16; ++c) { cr[c] = cre[((size_t)(di * 64 + g) * 16 + c) * 64 + lane]; ci[c] = cim[((size_t)(di * 64 + g) * 16 + c) * 64 + lane]; }
        }
        float sr = 0.f, si = 0.f;
        if (OUTPUT) {
            const f32x2 l2 = l256[dgp]; const f32x2* ep = Eb + ((size_t)dbg * 32) * 64 + lane;
            for (int k = 0; k < seg; ++k) { const f32x2 e = ep[(size_t)k * 64]; const float nr = l2.x * sr - l2.y * si + e.x, ni = l2.x * si + l2.y * sr + e.y; sr = nr; si = ni; }
        }
        const int s0 = seg * 256;
#pragma nounroll
        for (int st = 0; st < 256; st += 4) {
            const int row = s5_row(di, b, s0 + st + (lane >> 4));
            const float uval = bf2f(PJ[(size_t)row * 4096 + 3072 + g * 16 + (lane & 15)]);
#pragma unroll
            for (int k = 0; k < 4; ++k) {
                float bur = 0.f, bui = 0.f;
#pragma unroll
                for (int c = 0; c < 16; ++c) { const float u = __builtin_bit_cast(float, __builtin_amdgcn_readlane(__builtin_bit_cast(int, uval), 16 * k + c)); bur += br[c] * u; bui += bi[c] * u; }
                const float nr = lam.x * sr - lam.y * si + bur, ni = lam.x * si + lam.y * sr + bui; sr = nr; si = ni;
                if (OUTPUT) {
                    float v8[8], v4[4], v2[2], v1;
                    const bool b5 = (lane & 32) != 0, b4 = (lane & 16) != 0, b3 = (lane & 8) != 0, b2 = (lane & 4) != 0;
#pragma unroll
                    for (int i = 0; i < 8; ++i) { const float lo = cr[i] * sr - ci[i] * si, hi = cr[i + 8] * sr - ci[i + 8] * si; const float keep = b5 ? hi : lo, send = b5 ? lo : hi; v8[i] = keep + __shfl_xor(send, 32); }
#pragma unroll
                    for (int i = 0; i < 4; ++i) { const float keep = b4 ? v8[i + 4] : v8[i], send = b4 ? v8[i] : v8[i + 4]; v4[i] = keep + __shfl_xor(send, 16); }
#pragma unroll
                    for (int i = 0; i < 2; ++i) { const float keep = b3 ? v4[i + 2] : v4[i], send = b3 ? v4[i] : v4[i + 2]; v2[i] = keep + __shfl_xor(send, 8); }
                    { const float keep = b2 ? v2[1] : v2[0], send = b2 ? v2[0] : v2[1]; v1 = keep + __shfl_xor(send, 4); }
                    v1 += __shfl_xor(v1, 2); v1 += __shfl_xor(v1, 1);
                    const int s = s0 + st + k, t = (di == 0) ? s - CTX : SEQ - 1 - (s - CTX);
                    if ((lane & 3) == 0) YD[((size_t)di * TL + (size_t)b * SEQ + t) * 1024 + g * 16 + (lane >> 2)] = v1;
                }
            }
        }
        if (!OUTPUT) Eb[((size_t)dbg * 32 + seg) * 64 + lane] = (f32x2){sr, si};
    }
}

constexpr int NPHASES = 21;
#ifndef MK_SINGLE
#define MK_SINGLE 1
#endif

__device__ __forceinline__ unsigned long long launder_u64(unsigned long long v) {
    unsigned lo = (unsigned)v, hi = (unsigned)(v >> 32);
    asm volatile("" : "+v"(lo), "+v"(hi));
    lo = __builtin_amdgcn_readfirstlane(lo); hi = __builtin_amdgcn_readfirstlane(hi);
    return ((unsigned long long)hi << 32) | lo;
}
__device__ __forceinline__ const void* launder_ptr(const void* p) {
    unsigned long long v = (unsigned long long)p; unsigned lo = (unsigned)v, hi = (unsigned)(v >> 32);
    asm volatile("" : "+v"(lo), "+v"(hi));
    lo = __builtin_amdgcn_readfirstlane(lo); hi = __builtin_amdgcn_readfirstlane(hi);
    return (const void*)(((unsigned long long)hi << 32) | lo);
}
__device__ __forceinline__ void moe_blocks(Frame& F, int l, LAS int* bstart) {
    __syncthreads();
    if (F.tid == 0) { const unsigned* cnt = WSP(unsigned, WS_CTL) + CW_CNT + l * 64; int acc = 0;
        for (int e = 0; e < 64; ++e) { bstart[e] = acc; const int nb = ((int)cnt[e] + 255) >> 8; for (int j = 0; j < nb; ++j) bstart[65 + acc + j] = e; acc += nb; } bstart[64] = acc; }
    __syncthreads();
}

template <int PHSEL>
__global__ void __launch_bounds__(NTHREADS, 2) mk_fwd(Args args) {
    extern __shared__ __attribute__((aligned(16))) unsigned char lds_raw[];
    Frame F;
    F.lds = (LAS unsigned char*)lds_raw; F.ws = args.ws; F.kin = (const __attribute__((address_space(4))) unsigned long long*)__builtin_amdgcn_kernarg_segment_ptr();
    F.tid = threadIdx.x; F.lane = F.tid & 63; F.wave = __builtin_amdgcn_readfirstlane(F.tid >> 6); F.bid = blockIdx.x; F.G = gridDim.x;
    F.gw = F.bid * NWAVES + F.wave; F.NGW = F.G * NWAVES;
    volatile LAS unsigned* lctl = (volatile LAS unsigned*)(F.lds + LDS_CTL);
    LAS int* bstart = (LAS int*)(F.lds + LDS_CTL + 64);
    if (F.tid < 4) lctl[F.tid] = 0u;
    __syncthreads();
    const int lo = args.ph_lo, hi = args.ph_hi;
    XcdBarrier bar; bar.bar = WSP(unsigned, WS_CTL) + CW_BAR; bar.x = 0; bar.st = lctl;
    if (PHSEL < 0) bar = xcd_barrier_post(WSP(unsigned, WS_CTL) + CW_BAR, lctl);
#ifndef PH_MASK
#define PH_MASK 0xffffffffu
#endif
#define IN(k) (((PH_MASK >> (k)) & 1u) && (PHSEL < 0 || PHSEL == (k)))
#define INL(j) (((PH_MASK >> (6 + (j))) & 1u) && (PHSEL < 0 || (PHSEL == 6 + (j) && lo == pb + (j))))
#define PH_END(k) do { if (PHSEL < 0) xcd_barrier(bar); } while (0)
#ifndef PH_REPEAT
#define PH_REPEAT 0u
#endif
#define REP(k) for (int _rep = 0; _rep < (((PH_REPEAT >> (k)) & 1u) ? 2 : 1); ++_rep)
#define PH_BEGIN() do { F.ws = (unsigned char*)launder_ptr((const void*)F.ws); F.kin = (const __attribute__((address_space(4))) unsigned long long*)launder_u64((unsigned long long)F.kin); \
    { int _t = threadIdx.x; asm volatile("" : "+v"(_t)); F.tid = _t; F.lane = _t & 63; F.wave = __builtin_amdgcn_readfirstlane(_t >> 6); \
      int _b = blockIdx.x; asm volatile("" : "+v"(_b)); F.bid = __builtin_amdgcn_readfirstlane(_b); F.gw = F.bid * NWAVES + F.wave; } } while (0)
    LAS unsigned char* lds = F.lds;
    const int G = F.G, bid = F.bid;
    constexpr long T2048 = 256L * 2048 * 2;

    if (IN(0)) { PH_BEGIN(); REP(0) { p0_prologue(F); __syncthreads(); } PH_END(0); }
    if (IN(1)) { PH_BEGIN(); p1_reduce(F); PH_END(1); }
        if (IN(2)) { PH_BEGIN(); REP(2) norm_phase<0>(F, 0, nullptr); PH_END(2); }
        if (IN(3)) { PH_BEGIN(); REP(3) {
            { pg8::Gemm g{WSP(bf16, WS_HA), WSP(bf16, WS_WIN0), 2048, 2048, 2048}; pg8::StaticOrder S; S.init(TT / 256, 12, G, bid, T2048, 0, T2048);
              EpiQKP E{WSP(bf16, WS_Q), WSP(bf16, WS_K), WSP(bf16, WS_P), WSP(f32x2, WS_ROPE)}; pg8::gemm_phase<EpiQKP, pg8::StaticOrder, false>(lds, g, S, E); }
            { pg8::Gemm g{WSP(bf16, WS_WIN0) + (size_t)3072 * 2048, WSP(bf16, WS_HA), 2048, 2048, 2048}; pg8::StaticOrder S; S.init(4, TT / 256, G, bid, T2048, 0, T2048);
              EpiVT E{WSP(bf16, WS_VT)}; pg8::gemm_phase<EpiVT, pg8::StaticOrder, false>(lds, g, S, E); } }
            PH_END(3);
        }
        if (IN(4)) { PH_BEGIN(); REP(4) attn_phase(F); REP(21) poold_phase(F); PH_END(4); }
        if (IN(5)) { PH_BEGIN();
            pg8::Gemm g{WSP(bf16, WS_PD), WSP(bf16, WS_WPOOL), 1024, 256, 256}; pg8::StaticOrder S; S.init(TT / 256, 4, G, bid, 256L * 1024 * 2, 256L * 2, 256L * 256 * 2);
            EpiScaleBf16 E{WSP(bf16, WS_CAT), 2048, 1024, INP(14)}; pg8::gemm_phase<EpiScaleBf16, pg8::StaticOrder, false>(lds, g, S, E);
            PH_END(5);
        }
    {
    constexpr int pb = 6; constexpr int l = 0;
    if (INL(0)) { PH_BEGIN();
        float* xbuf = WSP(float, WS_X);
        pg8::Gemm g{WSP(bf16, WS_CAT), WSP(bf16, l == 0 ? WS_WOUT0 : WS_WOUT1), 2048, 2048, 2048}; pg8::StaticOrder S; S.init(l == 0 ? TT / 256 : TL / 256, 8, G, bid, T2048, 0, T2048);
        EpiRes E{l == 0 ? INP(0) : xbuf, l == 0 ? INP(2) : xbuf + (size_t)TL * 2048, xbuf, modp(F, l, 0, 2)}; pg8::gemm_phase<EpiRes, pg8::StaticOrder, false>(lds, g, S, E);
        PH_END(pb);
    }
    if (INL(1)) { PH_BEGIN(); norm_phase<1>(F, l, nullptr); PH_END(pb + 1); }
    if (INL(2)) { PH_BEGIN(); REP(8) {
        moe_blocks(F, l, bstart);
        pg8::Gemm g{WSP(bf16, WS_HA), (const bf16*)(F.ws + WS_WMOE + (size_t)l * MOE_L_BYTES), 2048, 2048, 2048};
        MoeOrder S{bstart, WSP(unsigned, WS_CTL) + CW_CNT + l * 64, WSP(int, WS_TOKL), 4, G, bid, bstart[64], T2048, 0, true};
        EpiMoeUp E{WSP(bf16, WS_H)}; pg8::gemm_phase<EpiMoeUp, MoeOrder, true>(lds, g, S, E); }
        PH_END(pb + 2);
    }
    if (INL(3)) { PH_BEGIN(); REP(9) {
        moe_blocks(F, l, bstart);
        pg8::Gemm g{WSP(bf16, WS_H), (const bf16*)(F.ws + WS_WMOE + (size_t)l * MOE_L_BYTES), 512, 512, 512};
        MoeOrder S{bstart, WSP(unsigned, WS_CTL) + CW_CNT + l * 64, WSP(int, WS_TOKL), 8, G, bid, bstart[64], 256L * 512 * 2, (long)(4 * MiB), false};
        EpiMoeDown E{WSP(bf16, WS_Y), WSP(int, WS_TOKL), WSP(float, WS_GATEL), WSP(unsigned, WS_CTL) + CW_CNT + l * 64}; pg8::gemm_phase<EpiMoeDown, MoeOrder, false>(lds, g, S, E); }
        PH_END(pb + 3);
    }
    }
        if (IN(10)) { PH_BEGIN(); norm_phase<2>(F, 1, nullptr); PH_END(10); }
        if (IN(11)) { PH_BEGIN(); REP(11) {
            pg8::Gemm g{WSP(bf16, WS_HA), WSP(bf16, WS_WIN1), 2048, 2048, 2048}; pg8::StaticOrder S; S.init(TT / 256, 16, G, bid, T2048, 0, T2048);
            EpiBf16 E{WSP(bf16, WS_PROJ1), 4096}; pg8::gemm_phase<EpiBf16, pg8::StaticOrder, false>(lds, g, S, E); }
            PH_END(11);
        }
        if (IN(12)) { PH_BEGIN(); REP(12) shortconv_phase(F); REP(22) s5_seg_phase<false>(F); PH_END(12); }
        if (IN(13)) { PH_BEGIN(); REP(23) s5_seg_phase<true>(F); REP(13) hyena_fft_phase(F); PH_END(13); }
        if (IN(14)) { PH_BEGIN(); REP(14) { s5_gelu_phase(F); hyena_out_transpose(F); } PH_END(14); }
        if (IN(15)) { PH_BEGIN();
            pg8::Gemm g{WSP(bf16, WS_PD), WSP(bf16, WS_WGLU), 1024, 1024, 1024}; pg8::StaticOrder S; S.init(TL / 256, 4, G, bid, 256L * 1024 * 2, 0, 256L * 1024 * 2);
            EpiGlu E{WSP(bf16, WS_CAT), 2048, 1024, WSP(bf16, WS_PD), INP(35)}; pg8::gemm_phase<EpiGlu, pg8::StaticOrder, false>(lds, g, S, E);
            PH_END(15);
        }
    {
    constexpr int pb = 16; constexpr int l = 1;
    if (INL(0)) { PH_BEGIN();
        float* xbuf = WSP(float, WS_X);
        pg8::Gemm g{WSP(bf16, WS_CAT), WSP(bf16, l == 0 ? WS_WOUT0 : WS_WOUT1), 2048, 2048, 2048}; pg8::StaticOrder S; S.init(l == 0 ? TT / 256 : TL / 256, 8, G, bid, T2048, 0, T2048);
        EpiRes E{l == 0 ? INP(0) : xbuf, l == 0 ? INP(2) : xbuf + (size_t)TL * 2048, xbuf, modp(F, l, 0, 2)}; pg8::gemm_phase<EpiRes, pg8::StaticOrder, false>(lds, g, S, E);
        PH_END(pb);
    }
    if (INL(1)) { PH_BEGIN(); norm_phase<1>(F, l, nullptr); PH_END(pb + 1); }
    if (INL(2)) { PH_BEGIN(); REP(8) {
        moe_blocks(F, l, bstart);
        pg8::Gemm g{WSP(bf16, WS_HA), (const bf16*)(F.ws + WS_WMOE + (size_t)l * MOE_L_BYTES), 2048, 2048, 2048};
        MoeOrder S{bstart, WSP(unsigned, WS_CTL) + CW_CNT + l * 64, WSP(int, WS_TOKL), 4, G, bid, bstart[64], T2048, 0, true};
        EpiMoeUp E{WSP(bf16, WS_H)}; pg8::gemm_phase<EpiMoeUp, MoeOrder, true>(lds, g, S, E); }
        PH_END(pb + 2);
    }
    if (INL(3)) { PH_BEGIN(); REP(9) {
        moe_blocks(F, l, bstart);
        pg8::Gemm g{WSP(bf16, WS_H), (const bf16*)(F.ws + WS_WMOE + (size_t)l * MOE_L_BYTES), 512, 512, 512};
        MoeOrder S{bstart, WSP(unsigned, WS_CTL) + CW_CNT + l * 64, WSP(int, WS_TOKL), 8, G, bid, bstart[64], 256L * 512 * 2, (long)(4 * MiB), false};
        EpiMoeDown E{WSP(bf16, WS_Y), WSP(int, WS_TOKL), WSP(float, WS_GATEL), WSP(unsigned, WS_CTL) + CW_CNT + l * 64}; pg8::gemm_phase<EpiMoeDown, MoeOrder, false>(lds, g, S, E); }
        PH_END(pb + 3);
    }
    }
    if (IN(20)) { PH_BEGIN(); norm_phase<3>(F, 1, args.out); }
#undef IN
#undef INL
#undef PH_END
}

typedef void (*kern_t)(Args);
template <int P> static void launch_phase(int grid, hipStream_t stream, Args a) { hipLaunchKernelGGL(mk_fwd<P>, dim3(grid), dim3(NTHREADS), LDS_BYTES, stream, a); }
template <int P> static bool prep_phase() { return hipFuncSetAttribute((const void*)mk_fwd<P>, hipFuncAttributeMaxDynamicSharedMemorySize, LDS_BYTES) == hipSuccess; }
extern "C" void kernel_launch(void* const* d_in, const int* in_sizes, int n_in, void* d_out, int out_size, void* d_ws, size_t ws_size, hipStream_t stream) {
    static int grid = 0;
    if (grid == 0) {
        if (n_in != 43 || out_size != TL * DM || ws_size < WS_END) { fprintf(stderr, "kernel_launch: unexpected shapes (n_in %d, out %d, ws %zu < %zu)\n", n_in, out_size, ws_size, (size_t)WS_END); grid = -1; return; }
        int dev = 0, cus = 0;
        if (hipGetDevice(&dev) != hipSuccess || hipDeviceGetAttribute(&cus, hipDeviceAttributeMultiprocessorCount, dev) != hipSuccess) { grid = -1; return; }
        bool ok = true;
#if MK_SINGLE
        ok = prep_phase<-1>();
#else
        ok = prep_phase<0>() && prep_phase<1>() && prep_phase<2>() && prep_phase<3>() && prep_phase<4>() && prep_phase<5>() && prep_phase<6>() && prep_phase<7>() && prep_phase<8>() && prep_phase<9>() &&
             prep_phase<10>() && prep_phase<11>() && prep_phase<12>() && prep_phase<13>() && prep_phase<14>() && prep_phase<15>() && prep_phase<20>();
#endif
        if (!ok) { fprintf(stderr, "kernel_launch: hipFuncSetAttribute failed\n"); grid = -1; return; }
        (void)hipGetLastError();
        grid = cus;
    }
    if (grid < 0) return;
    (void)hipMemsetAsync((char*)d_ws + WS_CTL, 0, CTL_BYTES, stream);
    Args a{};
    for (int i = 0; i < 43; ++i) a.in[i] = (const float*)d_in[i];
    a.out = (float*)d_out; a.ws = (unsigned char*)d_ws;
#if MK_SINGLE
    a.ph_lo = 0; a.ph_hi = NPHASES;
    launch_phase<-1>(grid, stream, a);
#else
#define LP(k, P) a.ph_lo = (k); a.ph_hi = (k) + 1; launch_phase<P>(grid, stream, a);
    LP(0, 0) LP(1, 1) LP(2, 2) LP(3, 3) LP(4, 4) LP(5, 5) LP(6, 6) LP(7, 7) LP(8, 8) LP(9, 9) LP(10, 10) LP(11, 11) LP(12, 12) LP(13, 13) LP(14, 14) LP(15, 15)
    LP(16, 6) LP(17, 7) LP(18, 8) LP(19, 9) LP(20, 20)
#undef LP
#endif
}
```

```cpp
#include <hip/hip_runtime.h>
#include <cstdio>
#include <cstdint>
#include <cmath>

#define GAS __attribute__((address_space(1)))
#define LAS __attribute__((address_space(3)))
typedef unsigned short bf16;
typedef unsigned v4u __attribute__((ext_vector_type(4)));
typedef unsigned v2u __attribute__((ext_vector_type(2)));
typedef float f32x4 __attribute__((ext_vector_type(4)));
typedef float f32x2 __attribute__((ext_vector_type(2)));
typedef float f32x16 __attribute__((ext_vector_type(16)));
typedef short bf16x8 __attribute__((ext_vector_type(8)));
#define LDS_WAIT() asm volatile("s_waitcnt lgkmcnt(0)" ::: "memory")
#define VM_WAIT() asm volatile("s_waitcnt vmcnt(0)" ::: "memory")

__device__ __forceinline__ unsigned f2bf(float f) { unsigned u = __builtin_bit_cast(unsigned, f); return (u + 0x7fffu + ((u >> 16) & 1u)) >> 16; }
__device__ __forceinline__ unsigned pk2(float lo, float hi) { return f2bf(lo) | (f2bf(hi) << 16); }
__device__ __forceinline__ unsigned cvt_pk_bf16(float lo, float hi) { unsigned r; asm volatile("v_cvt_pk_bf16_f32 %0, %1, %2" : "=v"(r) : "v"(lo), "v"(hi)); return r; }
__device__ __forceinline__ float bf2f(unsigned short b) { return __builtin_bit_cast(float, (unsigned)b << 16); }
__device__ __forceinline__ float bflo(unsigned w) { return __builtin_bit_cast(float, w << 16); }
__device__ __forceinline__ float bfhi(unsigned w) { return __builtin_bit_cast(float, w & 0xffff0000u); }
__device__ __forceinline__ float wave_sum(float v) {
#pragma unroll
    for (int o = 1; o < 64; o <<= 1) v += __shfl_xor(v, o);
    return v;
}

namespace pg8 {
typedef unsigned short bf16_t;
constexpr int BM = 256, BK = 64, HALF = 128, HTB = HALF * BK * 2, STAGE_BYTES = 8 * HTB;

__host__ __device__ __forceinline__ int lds_byte(int r, int c) { const int st = (r >> 4) * 2 + (c >> 5), rr = r & 15, cc = c & 31, ob = rr * 64 + cc * 2; return st * 1024 + (ob ^ (((ob >> 9) & 1) << 5)); }
__host__ __device__ __forceinline__ void stage_rc(int b, int& R, int& C) { const int st = b / 1024, sb = b % 1024, swz = sb ^ (((sb >> 9) & 1) << 5); R = (st >> 1) * 16 + swz / 64; C = (st & 1) * 32 + (swz % 64) / 2; }

struct Unit { int pm, pn; long aoff, boff; int e, idx0; };
struct Gemm { const bf16_t* A; const bf16_t* Bt; int lda, ldb, K; };

template <class Epi, class Sched, bool GATHER>
__device__ __forceinline__ void gemm_phase(LAS unsigned char* lds, const Gemm g, const Sched& S, const Epi& E) {
    const int tid = threadIdx.x, wid = __builtin_amdgcn_readfirstlane(tid >> 6), lane = tid & 63, wr = wid >> 2, wc = wid & 3, fr = lane & 15, fq = lane >> 4;
    const int K = g.K, nt = K / BK;
    unsigned voffA[2], voffB[2];
#pragma unroll
    for (int i = 0; i < 2; ++i) { int R, C; stage_rc(tid * 16 + i * 8192, R, C);
        voffA[i] = (unsigned)(R * g.lda + C) * 2u; voffB[i] = (unsigned)(R * g.ldb + C) * 2u; }
    const size_t kstep = (size_t)(BK * 2);
    const size_t hstepA = GATHER ? 0 : (size_t)HALF * g.lda * 2, hstepB = (size_t)HALF * g.ldb * 2;
    const unsigned ldsw = (unsigned)wid * 1024u;
    const int aoff = lds_byte(wr * 64 + fr, fq * 8), boff = lds_byte(wc * 32 + fr, fq * 8);
#define PG8_SA(b, h) (((b) * 2 + (h)) * HTB)
#define PG8_SB(b, h) ((4 + (b) * 2 + (h)) * HTB)
#define PG8_STAGE(bufoff, gbase, voff) do { _Pragma("unroll") for (int _i = 0; _i < 2; ++_i) \
        __builtin_amdgcn_global_load_lds((const unsigned*)((const char*)(gbase) + (voff)[_i]), (LAS unsigned*)(lds + (bufoff) + ldsw + _i * 8192), 16, 0, 0); } while (0)
#define PG8_STAGE_A(bufoff, gbase, h, nx) do { if constexpr (GATHER) { unsigned _tv[2]; \
        if (nx) { int _tz = tid; asm volatile("" : "+v"(_tz)); _Pragma("unroll") for (int _j = 0; _j < 2; ++_j) { int _R, _C; stage_rc(_tz * 16 + _j * 8192, _R, _C); _tv[_j] = (unsigned)S.arow(nxt, (h) * HALF + _R) * (unsigned)(g.lda * 2) + (unsigned)(_C * 2); } } \
        else { _tv[0] = gvc[h][0]; _tv[1] = gvc[h][1]; } \
        PG8_STAGE(bufoff, gbase, _tv); } else { PG8_STAGE(bufoff, (gbase) + (h) * hstepA, voffA); } } while (0)
#define PG8_LDA(dst, b, h) do { _Pragma("unroll") for (int m = 0; m < 4; ++m) _Pragma("unroll") for (int k = 0; k < 2; ++k) dst[m][k] = *(const LAS bf16x8*)(lds + PG8_SA(b, h) + aoff + m * 2048 + k * 1024); } while (0)
#define PG8_LDB(dst, b, h) do { _Pragma("unroll") for (int n = 0; n < 2; ++n) _Pragma("unroll") for (int k = 0; k < 2; ++k) dst[n][k] = *(const LAS bf16x8*)(lds + PG8_SB(b, h) + boff + n * 2048 + k * 1024); } while (0)
#define PG8_MMA(ai, bj, At, Bt) do { __builtin_amdgcn_s_setprio(1); _Pragma("unroll") for (int m = 0; m < 4; ++m) _Pragma("unroll") for (int n = 0; n < 2; ++n) _Pragma("unroll") for (int k = 0; k < 2; ++k) \
        acc[ai][bj][m][n] = __builtin_amdgcn_mfma_f32_16x16x32_bf16(Bt[n][k], At[m][k], acc[ai][bj][m][n], 0, 0, 0); __builtin_amdgcn_s_setprio(0); } while (0)
#define PG8_WAIT_V(n) asm volatile("s_waitcnt vmcnt(" #n ")" ::: "memory")
#define PG8_WAIT_L(n) asm volatile("s_waitcnt lgkmcnt(" #n ")" ::: "memory")
#define PG8_BAR __builtin_amdgcn_s_barrier()
#define PG8_SCHED __builtin_amdgcn_sched_barrier(0)
    Unit cur, nxt; int ui = 0;
    if (!S.next(0, cur)) return;
    unsigned gvc[2][2];
#define PG8_GV(unit) do { if constexpr (GATHER) { int _tz = tid; asm volatile("" : "+v"(_tz)); _Pragma("unroll") for (int _h = 0; _h < 2; ++_h) _Pragma("unroll") for (int _j = 0; _j < 2; ++_j) { int _R, _C; stage_rc(_tz * 16 + _j * 8192, _R, _C); \
        gvc[_h][_j] = (unsigned)S.arow(unit, _h * HALF + _R) * (unsigned)(g.lda * 2) + (unsigned)(_C * 2); } } } while (0)
    PG8_GV(cur);
    f32x4 acc[2][2][4][2];
#pragma unroll
    for (int a = 0; a < 2; ++a)
#pragma unroll
        for (int b = 0; b < 2; ++b)
#pragma unroll
            for (int m = 0; m < 4; ++m)
#pragma unroll
                for (int n = 0; n < 2; ++n) acc[a][b][m][n] = (f32x4){0.f, 0.f, 0.f, 0.f};
    bf16x8 At[4][2], B0[2][2], B1[2][2];
    const char* cA = (const char*)g.A + cur.aoff; const char* cB = (const char*)g.Bt + cur.boff;
    PG8_STAGE(PG8_SB(0, 0), cB, voffB); PG8_STAGE(PG8_SB(0, 1), cB + hstepB, voffB); PG8_STAGE_A(PG8_SA(0, 0), cA, 0, false); PG8_STAGE_A(PG8_SA(0, 1), cA, 1, false);
    if (wr == 1) PG8_BAR;
    PG8_WAIT_V(2); PG8_BAR;
    PG8_STAGE(PG8_SB(1, 0), cB + kstep, voffB); PG8_STAGE_A(PG8_SA(1, 0), cA + kstep, 0, false); PG8_STAGE(PG8_SB(1, 1), cB + hstepB + kstep, voffB);
    PG8_WAIT_V(6); PG8_BAR;
    for (;;) {
        const bool has_next = S.next(ui + 1, nxt);
        const char* nA = has_next ? (const char*)g.A + nxt.aoff : cA; const char* nB = has_next ? (const char*)g.Bt + nxt.boff : cB;
#pragma nounroll
        for (int t = 0; t < nt; t += 2) {
            const bool last = (t == nt - 2);
            const char* a1 = cA + (size_t)(t + 1) * kstep;
            const char* a2 = last ? nA : cA + (size_t)(t + 2) * kstep; const char* b2 = last ? nB : cB + (size_t)(t + 2) * kstep;
            const char* a3 = a2 + kstep; const char* b3 = b2 + kstep;
            PG8_LDB(B0, 0, 0); PG8_LDB(B1, 0, 1); PG8_SCHED; PG8_LDA(At, 0, 0); PG8_STAGE_A(PG8_SA(1, 1), a1, 1, false);
            PG8_WAIT_V(8); PG8_WAIT_L(0); PG8_BAR; PG8_MMA(0, 0, At, B0); PG8_MMA(0, 1, At, B1); PG8_BAR; PG8_SCHED;
            PG8_LDA(At, 0, 1); PG8_STAGE(PG8_SB(0, 0), b2, voffB); PG8_STAGE(PG8_SB(0, 1), b2 + hstepB, voffB); PG8_STAGE_A(PG8_SA(0, 0), a2, 0, last);
            PG8_WAIT_V(8); PG8_WAIT_L(0); PG8_BAR; PG8_MMA(1, 0, At, B0); PG8_MMA(1, 1, At, B1); PG8_BAR; PG8_SCHED;
            PG8_LDB(B0, 1, 0); PG8_LDB(B1, 1, 1); PG8_SCHED; PG8_LDA(At, 1, 0); PG8_STAGE_A(PG8_SA(0, 1), a2, 1, last);
            PG8_WAIT_V(8); PG8_WAIT_L(0); PG8_BAR; PG8_MMA(0, 0, At, B0); PG8_MMA(0, 1, At, B1); PG8_BAR; PG8_SCHED;
            PG8_LDA(At, 1, 1); PG8_STAGE(PG8_SB(1, 0), b3, voffB); PG8_STAGE(PG8_SB(1, 1), b3 + hstepB, voffB); PG8_STAGE_A(PG8_SA(1, 0), a3, 0, last);
            PG8_WAIT_V(8); PG8_WAIT_L(0); PG8_BAR; PG8_MMA(1, 0, At, B0); PG8_MMA(1, 1, At, B1); PG8_BAR; PG8_SCHED;
        }
        if (wr == 0) PG8_BAR;
        E(acc, cur, wr, wc, fr, fq);
        if (!has_next) break;
#pragma unroll
        for (int a = 0; a < 2; ++a)
#pragma unroll
            for (int b = 0; b < 2; ++b)
#pragma unroll
                for (int m = 0; m < 4; ++m)
#pragma unroll
                    for (int n = 0; n < 2; ++n) acc[a][b][m][n] = (f32x4){0.f, 0.f, 0.f, 0.f};
        cur = nxt; cA = nA; cB = nB; ++ui;
        PG8_GV(cur);
        if (wr == 1) PG8_BAR;
    }
    PG8_WAIT_V(0);
    PG8_BAR;
#undef PG8_SA
#undef PG8_SB
#undef PG8_STAGE
#undef PG8_STAGE_A
#undef PG8_GV
#undef PG8_LDA
#undef PG8_LDB
#undef PG8_MMA
#undef PG8_WAIT_V
#undef PG8_WAIT_L
#undef PG8_BAR
#undef PG8_SCHED
}

struct StaticOrder {
    int nM, nN, nwg, G, c; long astride, apn, bstride;
    __device__ void init(int nM_, int nN_, int G_, int c_, long astride_, long apn_, long bstride_) { nM = nM_; nN = nN_; nwg = nM * nN; G = G_; c = c_; astride = astride_; apn = apn_; bstride = bstride_; }
    __device__ bool next(int i, Unit& u) const {
        const long Lx = (long)i * G + c; if (Lx >= nwg) return false;
        int wgid = (int)Lx; { const int q = nwg / 8, r = nwg % 8, xcd = wgid % 8, off = wgid / 8; wgid = (xcd < r ? xcd * (q + 1) : r * (q + 1) + (xcd - r) * q) + off; }
        const int nig = 8 * nN, gid = wgid / nig, fm = gid * 8, gsz = (nM - fm) < 8 ? (nM - fm) : 8;
        u.pm = fm + ((wgid % nig) % gsz); u.pn = (wgid % nig) / gsz; u.aoff = (long)u.pm * astride + (long)u.pn * apn; u.boff = (long)u.pn * bstride; u.e = 0; u.idx0 = 0; return true;
    }
    __device__ int arow(const Unit&, int) const { return 0; }
};
}

constexpr int DM = 2048, NBATCH = 2, SEQ = 8192, CTX = 256;
constexpr int TL = NBATCH * SEQ;
constexpr int TC = NBATCH * CTX;
constexpr int TT = TL + TC;
constexpr int KEYS = CTX + SEQ;
constexpr int NEXP = 64, DEXP = 512;
constexpr int LISTCAP = 2 * TT;
constexpr float EPS = 1e-6f;
constexpr float QSCALE = 0.125f * 1.4426950408889634f;
constexpr int NWAVES = 8, NTHREADS = 512;

constexpr size_t MiB = 1u << 20;
constexpr size_t WS_CTL = 0, CTL_BYTES = 1 * MiB;
constexpr size_t WS_WIN0 = 1 * MiB;
constexpr size_t WS_WOUT0 = WS_WIN0 + 16 * MiB;
constexpr size_t WS_WIN1 = WS_WOUT0 + 8 * MiB;
constexpr size_t WS_WOUT1 = WS_WIN1 + 16 * MiB;
constexpr size_t WS_WPOOL = WS_WOUT1 + 8 * MiB;
constexpr size_t WS_WGLU = WS_WPOOL + 1 * MiB;
constexpr size_t WS_WMOE = WS_WGLU + 2 * MiB;
constexpr size_t MOE_E_BYTES = 6 * MiB, MOE_L_BYTES = 64 * MOE_E_BYTES;
constexpr size_t WS_X = WS_WMOE + 2 * MOE_L_BYTES;
constexpr size_t WS_HA = WS_X + 132 * MiB;
constexpr size_t WS_Q = WS_HA + 67 * MiB;
constexpr size_t WS_K = WS_Q + 33 * MiB;
constexpr size_t WS_VT = WS_K + 33 * MiB;
constexpr size_t WS_P = WS_VT + 33 * MiB;
constexpr size_t WS_PROJ1 = WS_Q;
constexpr size_t WS_CAT = WS_P + 33 * MiB;
constexpr size_t WS_PD = WS_CAT + 66 * MiB;
constexpr size_t WS_H = WS_PD + 33 * MiB;
constexpr size_t WS_Y = WS_H + 49 * MiB;
constexpr size_t WS_GT = WS_Y + 132 * MiB;
constexpr size_t WS_KT = WS_GT + 192 * MiB;
constexpr size_t WS_YD = WS_KT + 128 * MiB;
constexpr size_t WS_MISC = WS_YD + 128 * MiB;
constexpr size_t WS_MOD = WS_MISC;
constexpr size_t WS_ADAP = WS_MOD + 1 * MiB;
constexpr size_t WS_ROPE = WS_ADAP + 10 * MiB;
constexpr size_t WS_NORMP = WS_ROPE + 1 * MiB;
constexpr size_t WS_INVN = WS_NORMP + 4 * MiB;
constexpr size_t WS_S5LAM = WS_INVN + 1 * MiB;
constexpr size_t WS_S5B = WS_S5LAM + 1 * MiB;
constexpr size_t WS_WRT = WS_S5B + 2 * MiB;
constexpr size_t WS_TOKL = WS_WRT + 2 * MiB;
constexpr size_t WS_GATEL = WS_TOKL + 9 * MiB;
constexpr size_t WS_TW = WS_GATEL + 9 * MiB;
constexpr size_t WS_FFTW = WS_TW + 1 * MiB;
constexpr size_t WS_S5L256 = WS_FFTW + 32 * MiB;
constexpr size_t WS_S5E = WS_S5L256 + 1 * MiB;
constexpr size_t WS_END = WS_S5E + 4 * MiB;
static_assert(WS_END <= 2040 * MiB, "d_ws map");
constexpr int CW_BAR = 1024;
constexpr int CW_CNT = 8192;

constexpr int LDS_PHASE = 131072;
constexpr int LDS_CTL = 147456 - 2048;
constexpr int LDS_BYTES = 147456;

#define XB_TMO      128
#define XB_XCNT(j)  (256  + 64 * (j))
#define XB_XSUB(j)  (1280 + 64 * (j))
#define XB_XGEN(j)  (2304 + 64 * (j))
#define XB_TOP      3328
#define XB_TOPGEN   3392
#define XCD_BAR_WORDS 3456
#define XB_SPIN_CAP (1u << 22)

__device__ __forceinline__ unsigned xb_ld(unsigned* p)              { return __hip_atomic_load(p, __ATOMIC_RELAXED, __HIP_MEMORY_SCOPE_AGENT); }
__device__ __forceinline__ unsigned xb_add(unsigned* p, unsigned v) { return __hip_atomic_fetch_add(p, v, __ATOMIC_RELAXED, __HIP_MEMORY_SCOPE_AGENT); }
__device__ __forceinline__ unsigned xb_xcc_id() { return (unsigned)__builtin_amdgcn_s_getreg((3 << 11) | 20) & 0xFu; }
#define XB_SPIN(cond, bar) do { unsigned _sp = 0; while (cond) { __builtin_amdgcn_s_sleep(1); \
    if ((++_sp & 255u) == 0u) { if (xb_ld(&(bar)[XB_TMO])) break; if (_sp > XB_SPIN_CAP) { atomicAdd(&(bar)[XB_TMO], 1u); break; } } } } while (0)

struct XcdBarrier { unsigned* bar; unsigned x; volatile LAS unsigned* st; };

__device__ __forceinline__ XcdBarrier xcd_barrier_post(unsigned* bar, volatile LAS unsigned* st) {
    XcdBarrier b; b.bar = bar; b.x = xb_xcc_id(); b.st = st;
    if (threadIdx.x == 0) (void)xb_add(&bar[XB_XCNT(b.x)], 1u);
    return b;
}
__device__ __forceinline__ void xcd_barrier_complete(unsigned* bar, unsigned x, unsigned& nloc, unsigned& nx) {
    const unsigned G = gridDim.x * gridDim.y * gridDim.z;
    unsigned sum, cnt, mine, sp = 0u;
    for (;;) {
        sum = 0u; cnt = 0u; mine = 0u;
#pragma unroll
        for (unsigned j = 0; j < 16; ++j) { const unsigned c = xb_ld(&bar[XB_XCNT(j)]); sum += c; cnt += (c > 0u) ? 1u : 0u; mine = (j == x) ? c : mine; }
        if (sum == G) break;
        __builtin_amdgcn_s_sleep(1);
        if ((++sp & 255u) == 0u) { if (xb_ld(&bar[XB_TMO])) break; if (sp > XB_SPIN_CAP) { atomicAdd(&bar[XB_TMO], 1u); break; } }
    }
    nloc = mine > 0u ? mine : 1u; nx = cnt > 0u ? cnt : 1u;
}
__device__ __forceinline__ void xcd_barrier(const XcdBarrier& b) {
    asm volatile("s_waitcnt vmcnt(0)" ::: "memory");
    __syncthreads();
    if (threadIdx.x == 0) {
        unsigned* bar = b.bar;
        __builtin_amdgcn_s_waitcnt(0);
        unsigned nloc = b.st[0], nx = b.st[1];
        if (nloc == 0u) { xcd_barrier_complete(bar, b.x, nloc, nx); b.st[0] = nloc; b.st[1] = nx; }
        const unsigned old = xb_add(&bar[XB_XSUB(b.x)], 1u);
        const unsigned gen = old / nloc;
        if (old + 1u == (gen + 1u) * nloc) {
            __builtin_amdgcn_fence(__ATOMIC_RELEASE, "agent");
            asm volatile("s_waitcnt vmcnt(0)" ::: "memory");
            const unsigned og = xb_add(&bar[XB_TOP], 1u);
            const unsigned tg = og / nx;
            if (og + 1u == (tg + 1u) * nx) xb_add(&bar[XB_TOPGEN], 1u);
            else XB_SPIN(xb_ld(&bar[XB_TOPGEN]) == tg, bar);
            __builtin_amdgcn_fence(__ATOMIC_ACQUIRE, "agent");
            xb_add(&bar[XB_XGEN(b.x)], 1u);
            asm volatile("s_waitcnt vmcnt(0)" ::: "memory");
        } else {
            XB_SPIN(xb_ld(&bar[XB_XGEN(b.x)]) == gen, bar);
            __builtin_amdgcn_fence(__ATOMIC_ACQUIRE, "agent");
            asm volatile("s_waitcnt vmcnt(0)" ::: "memory");
        }
    }
    __syncthreads();
}

__device__ __forceinline__ void sincos_2pi(double x, double& s, double& c) {
    const double q = __builtin_rint(x * 4.0);
    const double y = (x - q * 0.25) * 6.283185307179586476925;
    const double y2 = y * y;
    double sp = -7.6471637318198164759e-13; sp = sp * y2 + 1.6059043836821614599e-10; sp = sp * y2 - 2.5052108385441718775e-8; sp = sp * y2 + 2.7557319223985890653e-6;
    sp = sp * y2 - 1.9841269841269841270e-4; sp = sp * y2 + 8.3333333333333333333e-3; sp = sp * y2 - 1.6666666666666666667e-1; sp = sp * y2 * y + y;
    double cp = 4.7794773323873852974e-14; cp = cp * y2 - 1.1470745597729724714e-11; cp = cp * y2 + 2.0876756987868098979e-9; cp = cp * y2 - 2.7557319223985890653e-7;
    cp = cp * y2 + 2.4801587301587301587e-5; cp = cp * y2 - 1.3888888888888888889e-3; cp = cp * y2 + 4.1666666666666666667e-2; cp = cp * y2 - 0.5; cp = cp * y2 + 1.0;
    const int qi = ((int)q) & 3;
    s = (qi == 0) ? sp : (qi == 1) ? cp : (qi == 2) ? -sp : -cp;
    c = (qi == 0) ? cp : (qi == 1) ? -sp : (qi == 2) ? -cp : sp;
}
__device__ __forceinline__ void sincos_rad(double a, double& s, double& c) {
    double f = a * 0.15915494309189533576888; f -= __builtin_floor(f);
    if (f >= 1.0) f = 0.0;
    sincos_2pi(f, s, c);
}
__device__ __forceinline__ double exp_small(double x) {
    double r = 1.0 / 479001600.0;
    r = r * x + 1.0 / 39916800.0; r = r * x + 1.0 / 3628800.0; r = r * x + 1.0 / 362880.0; r = r * x + 1.0 / 40320.0; r = r * x + 1.0 / 5040.0;
    r = r * x + 1.0 / 720.0; r = r * x + 1.0 / 120.0; r = r * x + 1.0 / 24.0; r = r * x + 1.0 / 6.0; r = r * x + 0.5; r = r * x + 1.0; r = r * x + 1.0;
    return r;
}
__device__ __forceinline__ float fast_exp(float x) { return __builtin_amdgcn_exp2f(x * 1.4426950408889634f); }
__device__ __forceinline__ float sigmoidf_(float x) { return 1.0f / (1.0f + fast_exp(-x)); }
__device__ __forceinline__ float siluf_(float x) { return x * sigmoidf_(x); }
__device__ __forceinline__ float tanhf_(float x) { const float e = fast_exp(-2.0f * fabsf(x)); const float t = (1.0f - e) / (1.0f + e); return x < 0.f ? -t : t; }
__device__ __forceinline__ float gelu_tanh(float x) { return 0.5f * x * (1.0f + tanhf_(0.7978845608028654f * (x + 0.044715f * x * x * x))); }

struct Args { const float* in[43]; float* out; unsigned char* ws; int ph_lo, ph_hi; };

struct Frame {
    LAS unsigned char* lds; unsigned char* ws; int tid, lane, wave, bid, G, gw, NGW;
    const __attribute__((address_space(4))) unsigned long long* kin;
};
#define INP(i) ((const float*)F.kin[i])
#define WSP(T, off) ((T*)(F.ws + (off)))

__device__ __forceinline__ void tr_item(const float* W, int ldw, int N, bf16* WT, int ldt, int row_off, int rs16, LAS float* scr, int item, int lane) {
    const int nblk = N / 64, kb = item / nblk, nb = item % nblk, k0 = 64 * kb, n0 = 64 * nb;
    const int la = lane & 15, lb = lane >> 4;
    f32x4 v[16];
#pragma unroll
    for (int i = 0; i < 16; ++i) v[i] = *(const f32x4*)(W + (size_t)(k0 + 4 * i + lb) * ldw + n0 + 4 * la);
#pragma unroll
    for (int i = 0; i < 16; ++i) { const int kk = 4 * i + lb; LAS float* d = scr + (4 * la) * 65 + kk; d[0] = v[i].x; d[65] = v[i].y; d[130] = v[i].z; d[195] = v[i].w; }
    LDS_WAIT(); asm volatile("" ::: "memory");
    const int c = lane & 7;
#pragma unroll
    for (int j = 0; j < 8; ++j) { const int n = (lane >> 3) + 8 * j; const LAS float* s = scr + n * 65 + 8 * c;
        v4u o; o.x = pk2(s[0], s[1]); o.y = pk2(s[2], s[3]); o.z = pk2(s[4], s[5]); o.w = pk2(s[6], s[7]);
        const int nn = n0 + n, drow = row_off + (nn >> 4) * rs16 + (nn & 15);
        *(v4u*)(WT + (size_t)drow * ldt + k0 + 8 * c) = o; }
    LDS_WAIT(); asm volatile("" ::: "memory");
}

__device__ __forceinline__ void hyfilt_item(Frame& F, int pb) {
    const float* w1 = INP(19); const float* b1 = INP(20); const float* fq = INP(21); const float* w2 = INP(22); const float* b2 = INP(23); const float* w3 = INP(24);
    LAS float* z = (LAS float*)F.lds;
    LAS float* h1 = z + 1088;
    LAS float* h2 = h1 + 2048;
    const int tid = F.tid;
    for (int idx = tid; idx < 32 * 33; idx += NTHREADS) {
        const int p = idx / 33, f = idx % 33, i = pb * 32 + p;
        float v;
        if (f == 0) v = (float)i * (1.0f / (float)(SEQ - 1));
        else { const int j = (f - 1) & 15; const float fj = 1e-4f + (float)j * ((15.0f - 1e-4f) / 15.0f);
            double fr = (double)fj * (double)i / (double)SEQ; fr -= __builtin_floor(fr); double s, c; sincos_2pi(fr, s, c); v = (f <= 16) ? (float)c : (float)(-s); }
        z[p * 33 + f] = v;
    }
    __syncthreads();
    for (int idx = tid; idx < 2048; idx += NTHREADS) {
        const int p = idx >> 6, j = idx & 63; float a = b1[j];
        for (int f = 0; f < 33; ++f) a += z[p * 33 + f] * w1[f * 64 + j];
        double s, c; sincos_rad((double)(fq[j] * a), s, c); h1[idx] = (float)s;
    }
    __syncthreads();
    for (int idx = tid; idx < 2048; idx += NTHREADS) {
        const int p = idx >> 6, j = idx & 63; float a = b2[j];
        for (int k = 0; k < 64; ++k) a += h1[p * 64 + k] * w2[k * 64 + j];
        double s, c; sincos_rad((double)(fq[64 + j] * a), s, c); h2[idx] = (float)s;
    }
    __syncthreads();
    float* kT = WSP(float, WS_KT); float* normp = WSP(float, WS_NORMP);
    for (int cc = 0; cc < 8; ++cc) {
        const int col = tid + NTHREADS * cc;
        float acc[32];
#pragma unroll
        for (int p = 0; p < 32; ++p) acc[p] = 0.f;
        for (int k = 0; k < 64; k += 4) {
            const float w0 = w3[(size_t)(k + 0) * 4096 + col], wA = w3[(size_t)(k + 1) * 4096 + col], wB = w3[(size_t)(k + 2) * 4096 + col], wC = w3[(size_t)(k + 3) * 4096 + col];
#pragma unroll
            for (int p = 0; p < 32; ++p) { const f32x4 hv = *(const LAS f32x4*)(h2 + p * 64 + k); acc[p] += hv.x * w0 + hv.y * wA + hv.z * wB + hv.w * wC; }
        }
        const int ch = col & 1023, dir = (col >> 10) & 1;
        const float adel = 3.0701134573253946f + (float)ch * ((15.350567286626972f - 3.0701134573253946f) / 1023.0f);
        float sabs = 0.f;
#pragma unroll
        for (int p = 0; p < 32; ++p) { const int i = pb * 32 + p; const float t = (float)i * (1.0f / (float)(SEQ - 1)); acc[p] *= fast_exp(-t * adel); if (!(dir == 1 && i == 0)) sabs += fabsf(acc[p]); }
        f32x4* dst = (f32x4*)(kT + (size_t)col * SEQ + pb * 32);
#pragma unroll
        for (int p = 0; p < 8; ++p) dst[p] = (f32x4){acc[4 * p], acc[4 * p + 1], acc[4 * p + 2], acc[4 * p + 3]};
        normp[(size_t)pb * 4096 + col] = sabs;
    }
    __syncthreads();
}

__device__ __forceinline__ void p0_prologue(Frame& F) {
    for (int pb = F.bid; pb < SEQ / 32; pb += F.G) hyfilt_item(F, pb);
    const int gt = F.bid * NTHREADS + F.tid, NGT = F.G * NTHREADS;
    {
        f32x2* rope = WSP(f32x2, WS_ROPE);
        for (int idx = gt; idx < 128 * 16; idx += NGT) { const int pos = idx >> 4, i = idx & 15;
            double inv = (i & 3) == 0 ? 1.0 : (i & 3) == 1 ? 0.56234132519034908 : (i & 3) == 2 ? 0.31622776601683794 : 0.17782794100389228;
            inv *= (i >> 2) == 0 ? 1.0 : (i >> 2) == 1 ? 0.1 : (i >> 2) == 2 ? 0.01 : 0.001;
            const float ang = (float)pos * (float)inv; double s, c; sincos_rad((double)ang, s, c); rope[idx] = (f32x2){(float)c, (float)s}; }
    }
    {
        f32x2* tw = WSP(f32x2, WS_TW);
        for (int idx = gt; idx < 16384; idx += NGT) { double s, c; sincos_2pi((double)idx * (1.0 / 16384.0), s, c); tw[idx] = (f32x2){(float)c, (float)(-s)}; }
    }
    {
        const float* are = INP(26); const float* aim = INP(27); const float* ldt = INP(28); const float* bre = INP(29); const float* bim = INP(30);
        f32x2* lamb = WSP(f32x2, WS_S5LAM); f32x2* bb = WSP(f32x2, WS_S5B); f32x2* l256 = WSP(f32x2, WS_S5L256);
        for (int idx = gt; idx < 2 * 64 * 64; idx += NGT) { const int dg = idx >> 6;
            const float dt = expf(ldt[dg]); const float ar = are[idx], ai = aim[idx];
            const float zr = ar * dt, zi = ai * dt; double s, c; sincos_rad((double)zi, s, c); const double er = exp_small((double)zr);
            const double lr = er * c, li = er * s; lamb[idx] = (f32x2){(float)lr, (float)li};
            { double pr = lr, pi = li; for (int q = 0; q < 8; ++q) { const double tr = pr * pr - pi * pi, ti = 2.0 * pr * pi; pr = tr; pi = ti; } l256[idx] = (f32x2){(float)pr, (float)pi}; }
            const double nr = lr - 1.0, ni = li, den = (double)ar * ar + (double)ai * ai; const double qr = (nr * ar + ni * ai) / den, qi = (ni * ar - nr * ai) / den;
            for (int cc = 0; cc < 16; ++cc) { const double br = bre[(size_t)idx * 16 + cc], bi = bim[(size_t)idx * 16 + cc]; bb[(size_t)idx * 16 + cc] = (f32x2){(float)(qr * br - qi * bi), (float)(qr * bi + qi * br)}; } }
    }
    {
        float* wrt = WSP(float, WS_WRT);
        for (int idx = gt; idx < 2 * 72 * 2048; idx += NGT) { const int l = idx / (72 * 2048), r = idx % (72 * 2048), n = r / 2048, k = r % 2048;
            wrt[idx] = n < 8 ? INP(36)[((size_t)l * 2048 + k) * 8 + n] : INP(38)[((size_t)l * 2048 + k) * 64 + (n - 8)]; }
    }
    {
        bf16* ha = WSP(bf16, WS_HA);
        for (int idx = gt; idx < 2048; idx += NGT) ha[(size_t)TT * 2048 + idx] = 0;
    }
    LAS float* scr = (LAS float*)(F.lds + F.wave * 16896);
    {
        const float* c = INP(1); const float* cctx = INP(3); const float* adaw = INP(4); float* part = WSP(float, WS_ADAP);
        for (int it = F.gw; it < 2 * 32 * 48; it += F.NGW) {
            const int l = it / (32 * 48), r = it % (32 * 48), ks = r / 48, jb = r % 48, k0 = ks * 64, j0 = jb * 256 + F.lane * 4;
            const float c0 = c[k0 + F.lane], c1 = c[2048 + k0 + F.lane], c2 = cctx[k0 + F.lane];
            const float s0 = c0 / (1.0f + expf(-c0)), s1 = c1 / (1.0f + expf(-c1)), s2 = c2 / (1.0f + expf(-c2));
            f32x4 a0 = {0.f, 0.f, 0.f, 0.f}, a1 = a0, a2 = a0;
            const float* wp = adaw + ((size_t)l * 2048 + k0) * 12288 + j0;
#pragma unroll 8
            for (int kk = 0; kk < 64; ++kk) { const f32x4 w = *(const f32x4*)(wp + (size_t)kk * 12288);
                const float t0 = __builtin_bit_cast(float, __builtin_amdgcn_readlane(__builtin_bit_cast(int, s0), kk));
                const float t1 = __builtin_bit_cast(float, __builtin_amdgcn_readlane(__builtin_bit_cast(int, s1), kk));
                const float t2 = __builtin_bit_cast(float, __builtin_amdgcn_readlane(__builtin_bit_cast(int, s2), kk));
                a0 += w * t0; a1 += w * t1; a2 += w * t2; }
            float* pp = part + ((size_t)(l * 32 + ks) * 3) * 12288 + j0;
            *(f32x4*)(pp) = a0; *(f32x4*)(pp + 12288) = a1; *(f32x4*)(pp + 2 * 12288) = a2;
        }
    }
    {
        constexpr int I0 = 1024, I1 = 512, I2 = 512, I3 = 1024, I4 = 2048, I5 = 1024, I6 = 64, I7 = 256, IE = 768;
        constexpr int NSMALL = I0 + I1 + I2 + I3 + I4 + I5 + I6 + I7;
        const int NITEMS = NSMALL + 128 * IE;
        for (int it = F.gw; it < NITEMS; it += F.NGW) {
            int r = it;
            if (r < I0) { tr_item(INP(9), 4096, 2048, WSP(bf16, WS_WIN0), 2048, 0, 16, scr, r, F.lane); continue; } r -= I0;
            if (r < I1) { tr_item(INP(9) + 2048, 4096, 1024, WSP(bf16, WS_WIN0), 2048, 3072, 16, scr, r, F.lane); continue; } r -= I1;
            if (r < I2) { tr_item(INP(9) + 3072, 4096, 1024, WSP(bf16, WS_WIN0), 2048, 2048, 16, scr, r, F.lane); continue; } r -= I2;
            if (r < I3) { tr_item(INP(10), 2048, 2048, WSP(bf16, WS_WOUT0), 2048, 0, 16, scr, r, F.lane); continue; } r -= I3;
            if (r < I4) { tr_item(INP(15), 4096, 4096, WSP(bf16, WS_WIN1), 2048, 0, 16, scr, r, F.lane); continue; } r -= I4;
            if (r < I5) { tr_item(INP(16), 2048, 2048, WSP(bf16, WS_WOUT1), 2048, 0, 16, scr, r, F.lane); continue; } r -= I5;
            if (r < I6) { const int g = r / 16; tr_item(INP(13) + (size_t)g * 65536, 256, 256, WSP(bf16, WS_WPOOL), 256, g * 256, 16, scr, r % 16, F.lane); continue; } r -= I6;
            if (r < I7) { tr_item(INP(34), 1024, 1024, WSP(bf16, WS_WGLU), 1024, 0, 16, scr, r, F.lane); continue; } r -= I7;
            const int le = r / IE, q = r % IE;
            bf16* wc = (bf16*)(F.ws + WS_WMOE + (size_t)le * MOE_E_BYTES); bf16* w2t = wc + 1024 * 2048;
            if (q < 256) tr_item(INP(40) + (size_t)le * (2048 * 512), 512, 512, wc, 2048, 0, 32, scr, q, F.lane);
            else if (q < 512) tr_item(INP(41) + (size_t)le * (2048 * 512), 512, 512, wc, 2048, 16, 32, scr, q - 256, F.lane);
            else tr_item(INP(42) + (size_t)le * (512 * 2048), 2048, 2048, w2t, 512, 0, 16, scr, q - 512, F.lane);
        }
    }
}

__device__ __forceinline__ void p1_reduce(Frame& F) {
    const int gt = F.bid * NTHREADS + F.tid, NGT = F.G * NTHREADS;
    const float* part = WSP(float, WS_ADAP); float* mod = WSP(float, WS_MOD); const float* adab = INP(5);
    for (int idx = gt; idx < 2 * 3 * 12288; idx += NGT) { const int l = idx / (3 * 12288), r = idx % (3 * 12288), m = r / 12288, j = r % 12288;
        float a = adab[l * 12288 + j];
        for (int ks = 0; ks < 32; ++ks) a += part[((size_t)(l * 32 + ks) * 3 + m) * 12288 + j];
        mod[idx] = a; }
    const float* normp = WSP(float, WS_NORMP); float* invn = WSP(float, WS_INVN);
    for (int idx = gt; idx < 2048; idx += NGT) { const int o = idx >> 10, ch = idx & 1023; float a = 0.f;
        for (int pb = 0; pb < 256; ++pb) a += normp[(size_t)pb * 4096 + o * 2048 + ch] + normp[(size_t)pb * 4096 + o * 2048 + 1024 + ch];
        invn[idx] = 1.0f / a; }
}

__device__ __forceinline__ const float* modp(Frame& F, int l, int m, int c) { return WSP(float, WS_MOD) + ((size_t)(l * 3 + m) * 6 + c) * 2048; }
__device__ __forceinline__ int row_stream(int r) { return r < TL ? r / SEQ : 2; }

template <int MODE>
__device__ __forceinline__ void norm_phase(Frame& F, int l, float* dout) {
    const int nrows = (MODE == 3 || (MODE == 1 && l == 1)) ? TL : TT;
    float* xbuf = WSP(float, WS_X); bf16* ha = WSP(bf16, WS_HA); const bf16* Y = WSP(bf16, WS_Y);
    const float* gvec = (MODE == 0) ? INP(6) : (MODE == 1) ? INP(7) + l * 2048 : (MODE == 2) ? INP(6) + 2048 : INP(8);
    const int lane = F.lane;
    for (int r = F.gw; r < nrows; r += F.NGW) {
        const int m = row_stream(r);
        const float* src = (MODE == 0) ? (r < TL ? INP(0) + (size_t)r * 2048 : INP(2) + (size_t)(r - TL) * 2048) : xbuf + (size_t)r * 2048;
        f32x4 v[8]; float ss = 0.f;
#pragma unroll
        for (int j = 0; j < 8; ++j) v[j] = *(const f32x4*)(src + 4 * lane + 256 * j);
        if (MODE == 2 || MODE == 3) {
            const float* g2 = modp(F, MODE == 2 ? 0 : 1, m, 5);
            const bf16* y0 = Y + (size_t)(2 * r) * 2048; const bf16* y1 = y0 + 2048;
#pragma unroll
            for (int j = 0; j < 8; ++j) { const int c = 4 * lane + 256 * j; const v2u a = *(const v2u*)(y0 + c), b = *(const v2u*)(y1 + c); const f32x4 gg = *(const f32x4*)(g2 + c);
                v[j].x += gg.x * (bflo(a.x) + bflo(b.x)); v[j].y += gg.y * (bfhi(a.x) + bfhi(b.x)); v[j].z += gg.z * (bflo(a.y) + bflo(b.y)); v[j].w += gg.w * (bfhi(a.y) + bfhi(b.y)); }
            if (MODE == 2) {
#pragma unroll
                for (int j = 0; j < 8; ++j) *(f32x4*)(xbuf + (size_t)r * 2048 + 4 * lane + 256 * j) = v[j];
            }
        }
#pragma unroll
        for (int j = 0; j < 8; ++j) ss += (v[j].x * v[j].x + v[j].y * v[j].y) + (v[j].z * v[j].z + v[j].w * v[j].w);
        ss = wave_sum(ss);
        const float rs = 1.0f / sqrtf(ss * (1.0f / 2048.0f) + EPS);
        if (MODE == 3) {
#pragma unroll
            for (int j = 0; j < 8; ++j) { const int c = 4 * lane + 256 * j; const f32x4 gg = *(const f32x4*)(gvec + c); *(f32x4*)(dout + (size_t)r * 2048 + c) = v[j] * rs * gg; }
            continue;
        }
        const int lm = (MODE == 2) ? 1 : l;
        const float* sh = modp(F, lm, m, MODE == 1 ? 3 : 0); const float* sc = modp(F, lm, m, MODE == 1 ? 4 : 1);
#pragma unroll
        for (int j = 0; j < 8; ++j) { const int c = 4 * lane + 256 * j; const f32x4 gg = *(const f32x4*)(gvec + c), s1 = *(const f32x4*)(sc + c), s0 = *(const f32x4*)(sh + c);
            v[j] = (v[j] * rs * gg) * (1.0f + s1) + s0;
            v2u o; o.x = pk2(v[j].x, v[j].y); o.y = pk2(v[j].z, v[j].w); *(v2u*)(ha + (size_t)r * 2048 + c) = o; }
    }
}

__device__ __forceinline__ void ffn_norm_router_phase(Frame& F, int l) {
    const int nrows = (l == 1) ? TL : TT;
    const float* xbuf = WSP(float, WS_X); bf16* ha = WSP(bf16, WS_HA);
    const float* gvec = INP(7) + l * 2048;
    const float* wrt = WSP(float, WS_WRT) + (size_t)l * 72 * 2048;
    LAS float* lg = (LAS float*)(F.lds + F.wave * 2048);
    const int lane = F.lane;
    for (int r0 = F.gw * 4; r0 < nrows; r0 += F.NGW * 4) {
        f32x4 v[4][8];
#pragma unroll
        for (int rr = 0; rr < 4; ++rr) {
            const int r = r0 + rr, m = row_stream(r);
            const float* src = xbuf + (size_t)r * 2048; float ss = 0.f;
#pragma unroll
            for (int j = 0; j < 8; ++j) { v[rr][j] = *(const f32x4*)(src + 4 * lane + 256 * j); ss += (v[rr][j].x * v[rr][j].x + v[rr][j].y * v[rr][j].y) + (v[rr][j].z * v[rr][j].z + v[rr][j].w * v[rr][j].w); }
            ss = wave_sum(ss);
            const float rs = 1.0f / sqrtf(ss * (1.0f / 2048.0f) + EPS);
            const float* sh = modp(F, l, m, 3); const float* sc = modp(F, l, m, 4);
#pragma unroll
            for (int j = 0; j < 8; ++j) { const int c = 4 * lane + 256 * j; const f32x4 gg = *(const f32x4*)(gvec + c), s1 = *(const f32x4*)(sc + c), s0 = *(const f32x4*)(sh + c);
                v[rr][j] = (v[rr][j] * rs * gg) * (1.0f + s1) + s0;
                v2u o; o.x = pk2(v[rr][j].x, v[rr][j].y); o.y = pk2(v[rr][j].z, v[rr][j].w); *(v2u*)(ha + (size_t)r * 2048 + c) = o; }
        }
        const bool b5 = (lane & 32) != 0, b4 = (lane & 16) != 0, b3 = (lane & 8) != 0, b2 = (lane & 4) != 0, b1 = (lane & 2) != 0;
#pragma nounroll
        for (int q = 0; q < 9; ++q) {
            float a[32];
#pragma unroll
            for (int nn = 0; nn < 8; ++nn) { const float* wn = wrt + (size_t)(q * 8 + nn) * 2048 + 4 * lane; float s0 = 0.f, s1 = 0.f, s2 = 0.f, s3 = 0.f;
#pragma unroll
                for (int j = 0; j < 8; ++j) { const f32x4 w = *(const f32x4*)(wn + 256 * j);
                    s0 += (v[0][j].x * w.x + v[0][j].y * w.y) + (v[0][j].z * w.z + v[0][j].w * w.w); s1 += (v[1][j].x * w.x + v[1][j].y * w.y) + (v[1][j].z * w.z + v[1][j].w * w.w);
                    s2 += (v[2][j].x * w.x + v[2][j].y * w.y) + (v[2][j].z * w.z + v[2][j].w * w.w); s3 += (v[3][j].x * w.x + v[3][j].y * w.y) + (v[3][j].z * w.z + v[3][j].w * w.w); }
                a[nn] = s0; a[8 + nn] = s1; a[16 + nn] = s2; a[24 + nn] = s3; }
            float c16[16], c8[8], c4[4], c2[2], c1;
#pragma unroll
            for (int i = 0; i < 16; ++i) { const float keep = b5 ? a[i + 16] : a[i], send = b5 ? a[i] : a[i + 16]; c16[i] = keep + __shfl_xor(send, 32); }
#pragma unroll
            for (int i = 0; i < 8; ++i) { const float keep = b4 ? c16[i + 8] : c16[i], send = b4 ? c16[i] : c16[i + 8]; c8[i] = keep + __shfl_xor(send, 16); }
#pragma unroll
            for (int i = 0; i < 4; ++i) { const float keep = b3 ? c8[i + 4] : c8[i], send = b3 ? c8[i] : c8[i + 4]; c4[i] = keep + __shfl_xor(send, 8); }
#pragma unroll
            for (int i = 0; i < 2; ++i) { const float keep = b2 ? c4[i + 2] : c4[i], send = b2 ? c4[i] : c4[i + 2]; c2[i] = keep + __shfl_xor(send, 4); }
            { const float keep = b1 ? c2[1] : c2[0], send = b1 ? c2[0] : c2[1]; c1 = keep + __shfl_xor(send, 2); }
            c1 += __shfl_xor(c1, 1);
            if ((lane & 1) == 0) { const int i = lane >> 1; lg[(i >> 3) * 80 + q * 8 + (i & 7)] = c1; }
        }
        LDS_WAIT(); asm volatile("" ::: "memory");
        if (lane < 4) {
            const int r = r0 + lane; const LAS float* L = lg + lane * 80;
            float gl[8]; float gmax = -INFINITY; int gi = 0;
#pragma unroll
            for (int j = 0; j < 8; ++j) { gl[j] = L[j] + INP(37)[l * 8 + j]; if (gl[j] > gmax) { gmax = gl[j]; gi = j; } }
            float gsum = 0.f;
#pragma unroll
            for (int j = 0; j < 8; ++j) gsum += expf(gl[j] - gmax);
            const float pg_top = 1.0f / gsum;
            float pe[8]; float emax = -INFINITY;
#pragma unroll
            for (int j = 0; j < 8; ++j) { pe[j] = L[8 + gi * 8 + j] + INP(39)[l * 64 + gi * 8 + j]; emax = fmaxf(emax, pe[j]); }
            float esum = 0.f;
#pragma unroll
            for (int j = 0; j < 8; ++j) { pe[j] = expf(pe[j] - emax); esum += pe[j]; }
            int e1 = 0; float p1 = -1.f;
#pragma unroll
            for (int j = 0; j < 8; ++j) { pe[j] /= esum; if (pe[j] > p1) { p1 = pe[j]; e1 = j; } }
            int e2 = 0; float p2 = -1.f;
#pragma unroll
            for (int j = 0; j < 8; ++j) { if (j != e1 && pe[j] > p2) { p2 = pe[j]; e2 = j; } }
            const float den = p1 + p2; const float g1 = pg_top * p1 / den, g2 = pg_top * p2 / den;
            unsigned* cnt = WSP(unsigned, WS_CTL) + CW_CNT + l * 64; int* tokl = WSP(int, WS_TOKL); float* gatel = WSP(float, WS_GATEL);
            const int ex1 = gi * 8 + e1, ex2 = gi * 8 + e2;
            const unsigned k1 = atomicAdd(cnt + ex1, 1u); tokl[(size_t)ex1 * LISTCAP + k1] = 2 * r; gatel[(size_t)ex1 * LISTCAP + k1] = g1;
            const unsigned k2 = atomicAdd(cnt + ex2, 1u); tokl[(size_t)ex2 * LISTCAP + k2] = 2 * r + 1; gatel[(size_t)ex2 * LISTCAP + k2] = g2;
        }
        LDS_WAIT(); asm volatile("" ::: "memory");
    }
}

#define EPI_ARGS const f32x4 (&acc)[2][2][4][2], const pg8::Unit& u, int wr, int wc, int fr, int fq
__device__ __forceinline__ void st_bf4(bf16* p, f32x4 v) { v2u o; o.x = cvt_pk_bf16(v.x, v.y); o.y = cvt_pk_bf16(v.z, v.w); *(v2u*)p = o; }

struct EpiQKP {
    bf16* Q; bf16* Kb; bf16* P; const f32x2* rope;
    __device__ __forceinline__ void operator()(EPI_ARGS) const {
        const int sect = u.pn >> 2, cb = (u.pn & 3) * 256; const bool latent = u.pm < TL / 256;
#pragma unroll
        for (int ai = 0; ai < 2; ++ai)
#pragma unroll
            for (int m = 0; m < 4; ++m) {
                const int r = u.pm * 256 + ai * 128 + wr * 64 + m * 16 + fr;
                int b, t; if (latent) { b = r / SEQ; t = r % SEQ; } else { b = (r - TL) / CTX; t = (r - TL) % CTX; }
                f32x4 cs0 = {1.f, 0.f, 1.f, 0.f}, cs1 = cs0;
                if (latent && sect < 2) { const int pos = (wc & 1) ? (t & 63) : (t >> 6); const f32x4* rp = (const f32x4*)(rope + pos * 16 + 4 * fq); cs0 = rp[0]; cs1 = rp[1]; }
#pragma unroll
                for (int bj = 0; bj < 2; ++bj) {
                    const int c0 = cb + bj * 128 + wc * 32 + 4 * fq;
                    f32x4 a = acc[ai][bj][m][0], bb = acc[ai][bj][m][1];
                    if (sect < 2) {
                        const f32x4 co = {cs0.x, cs0.z, cs1.x, cs1.z}, si = {cs0.y, cs0.w, cs1.y, cs1.w};
                        const f32x4 oa = a * co - bb * si, ob = a * si + bb * co; a = oa; bb = ob;
                    }
                    if (sect == 0) { a = a * QSCALE; bb = bb * QSCALE; bf16* d = Q + (size_t)r * 1024 + c0; st_bf4(d, a); st_bf4(d + 16, bb); }
                    else if (sect == 1) { const size_t kr = (size_t)b * KEYS + (latent ? CTX + t : t); bf16* d = Kb + kr * 1024 + c0; st_bf4(d, a); st_bf4(d + 16, bb); }
                    else { bf16* d = P + (size_t)r * 1024 + c0; st_bf4(d, a); st_bf4(d + 16, bb); }
                }
            }
    }
};
struct EpiVT {
    bf16* VT;
    __device__ __forceinline__ void operator()(EPI_ARGS) const {
        const bool latent = u.pn < TL / 256; const int b = latent ? u.pn / 32 : u.pn - TL / 256; const int key_t0 = latent ? CTX + (u.pn % 32) * 256 : 0;
        const int kperm = 8 * (fq & 1) + 4 * (fq >> 1);
#pragma unroll
        for (int ai = 0; ai < 2; ++ai)
#pragma unroll
            for (int m = 0; m < 4; ++m) {
                const int rr = u.pm * 256 + ai * 128 + wr * 64 + m * 16 + fr;
                bf16* rowp = VT + ((size_t)b * 1024 + rr) * KEYS + key_t0;
#pragma unroll
                for (int bj = 0; bj < 2; ++bj)
#pragma unroll
                    for (int n = 0; n < 2; ++n) st_bf4(rowp + bj * 128 + wc * 32 + 16 * n + kperm, acc[ai][bj][m][n]);
            }
    }
};
struct EpiScaleBf16 {
    bf16* O; int ldo, coff; const float* cscale;
    __device__ __forceinline__ void operator()(EPI_ARGS) const {
#pragma unroll
        for (int bj = 0; bj < 2; ++bj)
#pragma unroll
            for (int n = 0; n < 2; ++n) { const int c = u.pn * 256 + bj * 128 + wc * 32 + 16 * n + 4 * fq; const f32x4 sc = *(const f32x4*)(cscale + c);
#pragma unroll
                for (int ai = 0; ai < 2; ++ai)
#pragma unroll
                    for (int m = 0; m < 4; ++m) { const int r = u.pm * 256 + ai * 128 + wr * 64 + m * 16 + fr; st_bf4(O + (size_t)r * ldo + coff + c, acc[ai][bj][m][n] * sc); } }
    }
};
struct EpiBf16 {
    bf16* O; int ldo;
    __device__ __forceinline__ void operator()(EPI_ARGS) const {
#pragma unroll
        for (int ai = 0; ai < 2; ++ai)
#pragma unroll
            for (int m = 0; m < 4; ++m) { const int r = u.pm * 256 + ai * 128 + wr * 64 + m * 16 + fr; bf16* rowp = O + (size_t)r * ldo + u.pn * 256 + wc * 32 + 4 * fq;
#pragma unroll
                for (int bj = 0; bj < 2; ++bj)
#pragma unroll
                    for (int n = 0; n < 2; ++n) st_bf4(rowp + bj * 128 + 16 * n, acc[ai][bj][m][n]); }
    }
};
struct EpiRes {
    const float* xlat; const float* xctx; float* xout; const float* gate0;
    __device__ __forceinline__ void operator()(EPI_ARGS) const {
        const bool latent = u.pm < TL / 256;
#pragma unroll
        for (int ai = 0; ai < 2; ++ai)
#pragma unroll
            for (int m = 0; m < 4; ++m) { const int r = u.pm * 256 + ai * 128 + wr * 64 + m * 16 + fr; const int ms = latent ? r / SEQ : 2;
                const float* xi = latent ? xlat + (size_t)r * 2048 : xctx + (size_t)(r - TL) * 2048; const float* gp = gate0 + (size_t)ms * 12288;
#pragma unroll
                for (int bj = 0; bj < 2; ++bj)
#pragma unroll
                    for (int n = 0; n < 2; ++n) { const int c = u.pn * 256 + bj * 128 + wc * 32 + 16 * n + 4 * fq;
                        const f32x4 xv = *(const f32x4*)(xi + c), gv = *(const f32x4*)(gp + c); *(f32x4*)(xout + (size_t)r * 2048 + c) = xv + gv * acc[ai][bj][m][n]; } }
    }
};
struct EpiMoeUp {
    bf16* H;
    __device__ __forceinline__ void operator()(EPI_ARGS) const {
#pragma unroll
        for (int ai = 0; ai < 2; ++ai)
#pragma unroll
            for (int m = 0; m < 4; ++m) { const size_t r = (size_t)u.pm * 256 + ai * 128 + wr * 64 + m * 16 + fr;
#pragma unroll
                for (int bj = 0; bj < 2; ++bj) { const int hc = (u.pn * 256 + bj * 128 + wc * 32) / 2 + 4 * fq; const f32x4 a = acc[ai][bj][m][0], b = acc[ai][bj][m][1];
                    const f32x4 h = {siluf_(a.x) * b.x, siluf_(a.y) * b.y, siluf_(a.z) * b.z, siluf_(a.w) * b.w}; st_bf4(H + r * 512 + hc, h); } }
    }
};
struct EpiMoeDown {
    bf16* Y; const int* tokl; const float* gatel; const unsigned* cnt;
    __device__ __forceinline__ void operator()(EPI_ARGS) const {
        const int ce = (int)cnt[u.e];
#pragma unroll
        for (int ai = 0; ai < 2; ++ai)
#pragma unroll
            for (int m = 0; m < 4; ++m) { const int idx = u.idx0 + ai * 128 + wr * 64 + m * 16 + fr;
                if (idx < ce) { const int pair = tokl[(size_t)u.e * LISTCAP + idx]; const float gt = gatel[(size_t)u.e * LISTCAP + idx]; bf16* rowp = Y + (size_t)pair * 2048 + u.pn * 256 + wc * 32 + 4 * fq;
#pragma unroll
                    for (int bj = 0; bj < 2; ++bj)
#pragma unroll
                        for (int n = 0; n < 2; ++n) st_bf4(rowp + bj * 128 + 16 * n, acc[ai][bj][m][n] * gt); } }
    }
};
struct EpiGlu {
    bf16* O; int ldo, coff; const bf16* Gb; const float* bias;
    __device__ __forceinline__ void operator()(EPI_ARGS) const {
#pragma unroll
        for (int ai = 0; ai < 2; ++ai)
#pragma unroll
            for (int m = 0; m < 4; ++m) { const int r = u.pm * 256 + ai * 128 + wr * 64 + m * 16 + fr;
#pragma unroll
                for (int bj = 0; bj < 2; ++bj)
#pragma unroll
                    for (int n = 0; n < 2; ++n) { const int c = u.pn * 256 + bj * 128 + wc * 32 + 16 * n + 4 * fq; const f32x4 bv = *(const f32x4*)(bias + c); const v2u gw = *(const v2u*)(Gb + (size_t)r * 1024 + c);
                        const f32x4 a = acc[ai][bj][m][n] + bv; const f32x4 o = {bflo(gw.x) * sigmoidf_(a.x), bfhi(gw.x) * sigmoidf_(a.y), bflo(gw.y) * sigmoidf_(a.z), bfhi(gw.y) * sigmoidf_(a.w)};
                        st_bf4(O + (size_t)r * ldo + coff + c, o); } }
    }
};

struct MoeOrder {
    const LAS int* bstart;
    const unsigned* cnt; const int* tokl; int nN, G, c, nblk; long bstride, eoff; bool up;
    __device__ bool next(int i, pg8::Unit& u) const {
        const long Lx = (long)i * G + c; if (Lx >= (long)nblk * nN) return false;
        const int blk = (int)(Lx / nN); u.pn = (int)(Lx % nN); u.pm = blk;
        const int e = bstart[65 + blk];
        u.e = e; u.idx0 = (blk - bstart[e]) * 256;
        u.aoff = up ? 0 : (long)blk * 256 * 512 * 2;
        u.boff = (long)e * (long)MOE_E_BYTES + eoff + (long)u.pn * bstride;
        return true;
    }
    __device__ int arow(const pg8::Unit& u, int row) const { const int idx = u.idx0 + row; return idx < (int)cnt[u.e] ? (tokl[(size_t)u.e * LISTCAP + idx] >> 1) : TT; }
};

__device__ __forceinline__ void attn_phase(Frame& F) {
    const bf16* Q = WSP(bf16, WS_Q); const bf16* Kb = WSP(bf16, WS_K); const bf16* VT = WSP(bf16, WS_VT); bf16* cat = WSP(bf16, WS_CAT);
    LAS unsigned char* lds = F.lds;
    const int tid = F.tid, lane = F.lane, w = F.wave, sub = w & 1, qw = w >> 1, r32 = lane & 31, hi = lane >> 5;
    float lam;
    { const float* lv = INP(11); float a = lv[lane] * lv[64 + lane], b = lv[128 + lane] * lv[192 + lane]; a = wave_sum(a); b = wave_sum(b); lam = expf(a) - expf(b) + 0.2f; }
    const float* subg = INP(12);
    const int NU = 1024 + 32;
    const int xcd = F.bid & 7, jcu = F.bid >> 3;
    for (int it = 0;; ++it) {
        int uidx;
        if (F.G == 256) { if (it < 4) uidx = 128 * xcd + it * 32 + jcu; else if (it == 4 && F.bid < 32) uidx = 1024 + F.bid; else break; }
        else { uidx = it * F.G + F.bid; if (uidx >= NU) break; }
        int b, head, q0row, nt; size_t kbase;
        if (uidx < 1024) { const int combo = uidx >> 6, qb = uidx & 63; b = combo >> 3; head = combo & 7; q0row = b * SEQ + qb * 128; nt = KEYS / 64; }
        else { const int v = uidx - 1024; b = v >> 4; head = (v >> 1) & 7; q0row = TL + b * CTX + (v & 1) * 128; nt = CTX / 64; }
        kbase = (size_t)b * KEYS;
        bf16x8 qf[4];
        { const bf16* qp = Q + (size_t)(q0row + qw * 32 + r32) * 1024 + head * 128 + sub * 64 + hi * 8;
#pragma unroll
          for (int ks = 0; ks < 4; ++ks) qf[ks] = *(const bf16x8*)(qp + ks * 16); }
        const int srow = tid >> 3, sch = tid & 7;
        const bf16* gk0 = Kb + (kbase + srow) * 1024 + head * 128 + sch * 8;
        const bf16* gv0 = VT + ((size_t)(b * 8 + head) * 128 + srow) * KEYS + sch * 8;
        const int lk = srow * 128 + ((sch ^ ((srow >> 1) & 7)) * 16);
        v4u st0, st1, st2, st3;
#define ATT_LOAD(t) do { st0 = *(const v4u*)(gk0 + (size_t)(t) * 65536); st1 = *(const v4u*)(gk0 + (size_t)(t) * 65536 + 64); st2 = *(const v4u*)(gv0 + (t) * 64); st3 = *(const v4u*)(gv0 + (size_t)64 * KEYS + (t) * 64); } while (0)
#define ATT_STORE(buf) do { LAS unsigned char* bp = lds + (buf) * 32768; *(LAS v4u*)(bp + lk) = st0; *(LAS v4u*)(bp + 8192 + lk) = st1; *(LAS v4u*)(bp + 16384 + lk) = st2; *(LAS v4u*)(bp + 16384 + 8192 + lk) = st3; } while (0)
        ATT_LOAD(0); ATT_STORE(0);
        __syncthreads();
        f32x16 o[4];
#pragma unroll
        for (int d = 0; d < 4; ++d)
#pragma unroll
            for (int r = 0; r < 16; ++r) o[d][r] = 0.f;
        float mrow = -INFINITY, lrow = 0.f;
        const int rdoff = r32 * 128;
        const int swz = (r32 >> 1) & 7;
        for (int t = 0; t < nt; ++t) {
            if (t + 1 < nt) ATT_LOAD(t + 1);
            const LAS unsigned char* bp = lds + (t & 1) * 32768;
            const LAS unsigned char* kp = bp + sub * 8192;
            f32x16 s0, s1;
#pragma unroll
            for (int r = 0; r < 16; ++r) { s0[r] = 0.f; s1[r] = 0.f; }
#pragma unroll
            for (int ks = 0; ks < 4; ++ks) {
                const int ch = ((2 * ks + hi) ^ swz) * 16;
                const bf16x8 k0 = *(const LAS bf16x8*)(kp + rdoff + ch);
                const bf16x8 k1 = *(const LAS bf16x8*)(kp + 4096 + rdoff + ch);
                s0 = __builtin_amdgcn_mfma_f32_32x32x16_bf16(k0, qf[ks], s0, 0, 0, 0);
                s1 = __builtin_amdgcn_mfma_f32_32x32x16_bf16(k1, qf[ks], s1, 0, 0, 0);
            }
            float mx = s0[0];
#pragma unroll
            for (int r = 1; r < 16; ++r) mx = fmaxf(mx, s0[r]);
#pragma unroll
            for (int r = 0; r < 16; ++r) mx = fmaxf(mx, s1[r]);
            mx = fmaxf(mx, __shfl_xor(mx, 32));
            const float mnew = fmaxf(mrow, mx);
            const float alpha = __builtin_amdgcn_exp2f(mrow - mnew);
            mrow = mnew;
            float rs = 0.f;
#pragma unroll
            for (int r = 0; r < 16; ++r) { s0[r] = __builtin_amdgcn_exp2f(s0[r] - mnew); rs += s0[r]; }
#pragma unroll
            for (int r = 0; r < 16; ++r) { s1[r] = __builtin_amdgcn_exp2f(s1[r] - mnew); rs += s1[r]; }
            lrow = lrow * alpha + rs;
            if (__any(alpha != 1.0f)) {
#pragma unroll
                for (int d = 0; d < 4; ++d)
#pragma unroll
                    for (int r = 0; r < 16; ++r) o[d][r] *= alpha;
            }
            bf16x8 pf[4];
#pragma unroll
            for (int s = 0; s < 4; ++s) { v4u pw;
                if (s < 2) { pw.x = cvt_pk_bf16(s0[8 * s + 0], s0[8 * s + 1]); pw.y = cvt_pk_bf16(s0[8 * s + 2], s0[8 * s + 3]); pw.z = cvt_pk_bf16(s0[8 * s + 4], s0[8 * s + 5]); pw.w = cvt_pk_bf16(s0[8 * s + 6], s0[8 * s + 7]); }
                else { const int q = s - 2; pw.x = cvt_pk_bf16(s1[8 * q + 0], s1[8 * q + 1]); pw.y = cvt_pk_bf16(s1[8 * q + 2], s1[8 * q + 3]); pw.z = cvt_pk_bf16(s1[8 * q + 4], s1[8 * q + 5]); pw.w = cvt_pk_bf16(s1[8 * q + 6], s1[8 * q + 7]); }
                pf[s] = __builtin_bit_cast(bf16x8, pw); }
            const LAS unsigned char* vp = bp + 16384;
#pragma unroll
            for (int d = 0; d < 4; ++d)
#pragma unroll
                for (int s = 0; s < 4; ++s) {
                    const bf16x8 vf = *(const LAS bf16x8*)(vp + d * 4096 + rdoff + (((2 * s + hi) ^ swz) * 16));
                    o[d] = __builtin_amdgcn_mfma_f32_32x32x16_bf16(vf, pf[s], o[d], 0, 0, 0);
                }
            if (t + 1 < nt) ATT_STORE((t + 1) & 1);
            __syncthreads();
        }
#undef ATT_LOAD
#undef ATT_STORE
        const float ltot = lrow + __shfl_xor(lrow, 32); const float linv = 1.0f / ltot;
        LAS float* xch = (LAS float*)lds + (size_t)(qw * 32 + r32) * 132;
        if (sub == 1) {
#pragma unroll
            for (int d = 0; d < 4; ++d)
#pragma unroll
                for (int g = 0; g < 4; ++g) *(LAS f32x4*)(xch + 32 * d + 8 * g + 4 * hi) = (f32x4){o[d][4 * g] * linv, o[d][4 * g + 1] * linv, o[d][4 * g + 2] * linv, o[d][4 * g + 3] * linv};
        }
        __syncthreads();
        if (sub == 0) {
            float ss = 0.f;
#pragma unroll
            for (int d = 0; d < 4; ++d)
#pragma unroll
                for (int g = 0; g < 4; ++g) { const f32x4 o2 = *(const LAS f32x4*)(xch + 32 * d + 8 * g + 4 * hi);
#pragma unroll
                    for (int j = 0; j < 4; ++j) { const float v = o[d][4 * g + j] * linv - lam * o2[j]; o[d][4 * g + j] = v; ss += v * v; } }
            ss += __shfl_xor(ss, 32);
            const float rn = 0.8f / sqrtf(ss * (1.0f / 128.0f) + EPS);
            bf16* op = cat + (size_t)(q0row + qw * 32 + r32) * 2048 + head * 128;
#pragma unroll
            for (int d = 0; d < 4; ++d)
#pragma unroll
                for (int g = 0; g < 4; ++g) { const int dv = 32 * d + 8 * g + 4 * hi; const f32x4 gg = *(const f32x4*)(subg + dv);
                    st_bf4(op + dv, (f32x4){o[d][4 * g] * rn * gg.x, o[d][4 * g + 1] * rn * gg.y, o[d][4 * g + 2] * rn * gg.z, o[d][4 * g + 3] * rn * gg.w}); }
        }
        __syncthreads();
    }
}

__device__ __forceinline__ void poold_phase(Frame& F) {
    const bf16* P = WSP(bf16, WS_P); bf16* PD = WSP(bf16, WS_PD);
    const int gt = F.bid * NTHREADS + F.tid, NGT = F.G * NTHREADS;
    for (int idx = gt; idx < TT * 128; idx += NGT) {
        const int r = idx >> 7, cc = (idx & 127) * 8, g = cc >> 8, wdw = 2 << g;
        int sb, t, Ls; if (r < TL) { sb = (r / SEQ) * SEQ; t = r % SEQ; Ls = SEQ; } else { sb = TL + ((r - TL) / CTX) * CTX; t = (r - TL) % CTX; Ls = CTX; }
        int lo = t - wdw / 2, hi = lo + wdw; lo = lo < 0 ? 0 : lo; hi = hi > Ls ? Ls : hi;
        float a[8];
#pragma unroll
        for (int j = 0; j < 8; ++j) a[j] = 0.f;
        for (int s = lo; s < hi; ++s) { const v4u v = *(const v4u*)(P + (size_t)(sb + s) * 1024 + cc);
            a[0] += bflo(v.x); a[1] += bfhi(v.x); a[2] += bflo(v.y); a[3] += bfhi(v.y); a[4] += bflo(v.z); a[5] += bfhi(v.z); a[6] += bflo(v.w); a[7] += bfhi(v.w); }
        const float inv = 1.0f / (float)(hi - lo);
        const v4u me = *(const v4u*)(P + (size_t)r * 1024 + cc);
        v4u o; o.x = pk2(a[0] * inv - bflo(me.x), a[1] * inv - bfhi(me.x)); o.y = pk2(a[2] * inv - bflo(me.y), a[3] * inv - bfhi(me.y));
        o.z = pk2(a[4] * inv - bflo(me.z), a[5] * inv - bfhi(me.z)); o.w = pk2(a[6] * inv - bflo(me.w), a[7] * inv - bfhi(me.w));
        *(v4u*)(PD + (size_t)r * 1024 + cc) = o;
    }
}

__device__ __forceinline__ void shortconv_phase(Frame& F) {
    const bf16* PJ = WSP(bf16, WS_PROJ1); float* GT = WSP(float, WS_GT);
    const float* cw = INP(17); const float* cb = INP(18);
    LAS float* scr = (LAS float*)(F.lds + F.wave * 16896);
    const int lane = F.lane;
    for (int it = F.gw; it < 2 * 128 * 48; it += F.NGW) {
        const int cbk = it % 48, tb = (it / 48) % 128, b = it / (48 * 128), col = cbk * 64 + lane, t0 = tb * 64;
        const float w0 = cw[col], w1 = cw[3072 + col], w2 = cw[2 * 3072 + col], bias = cb[col];
        const bf16* base = PJ + ((size_t)b * SEQ) * 4096 + col;
        float prev = (t0 > 0) ? bf2f(base[(size_t)(t0 - 1) * 4096]) : 0.f;
        float cur = bf2f(base[(size_t)t0 * 4096]);
#pragma unroll 8
        for (int tt = 0; tt < 64; ++tt) { const int t = t0 + tt; const float nxt = (t + 1 < SEQ) ? bf2f(base[(size_t)(t + 1) * 4096]) : 0.f;
            scr[tt * 65 + lane] = prev * w0 + cur * w1 + nxt * w2 + bias; prev = cur; cur = nxt; }
        LDS_WAIT(); asm volatile("" ::: "memory");
        for (int c = 0; c < 64; ++c) GT[((size_t)(cbk * 64 + c) * 2 + b) * SEQ + t0 + lane] = scr[lane * 65 + c];
        LDS_WAIT(); asm volatile("" ::: "memory");
    }
}

__device__ __forceinline__ void s5_scan_phase(Frame& F) {
    const bf16* PJ = WSP(bf16, WS_PROJ1); float* YD = WSP(float, WS_YD);
    const f32x2* lamb = WSP(f32x2, WS_S5LAM); const f32x2* bbar = WSP(f32x2, WS_S5B);
    const float* cre = INP(31); const float* cim = INP(32);
    const int lane = F.lane;
    for (int task = F.wave * F.G + F.bid; task < 256; task += F.NGW) {
        const int di = task >> 7, b = (task >> 6) & 1, g = task & 63;
        const int dgp = (di * 64 + g) * 64 + lane;
        const f32x2 lam = lamb[dgp];
        float br[16], bi[16], cr[16], ci[16];
#pragma unroll
        for (int c = 0; c < 16; ++c) { const f32x2 bv = bbar[(size_t)dgp * 16 + c]; br[c] = bv.x; bi[c] = bv.y;
            cr[c] = cre[((size_t)(di * 64 + g) * 16 + c) * 64 + lane]; ci[c] = cim[((size_t)(di * 64 + g) * 16 + c) * 64 + lane]; }
        float sr = 0.f, si = 0.f;
        const int nsteps = CTX + SEQ;
        for (int st = 0; st < nsteps; st += 4) {
            const int stl = st + (lane >> 4);
            int row;
            if (stl < CTX) row = TL + b * CTX + (di == 0 ? stl : CTX - 1 - stl);
            else row = b * SEQ + (di == 0 ? stl - CTX : SEQ - 1 - (stl - CTX));
            const float uval = bf2f(PJ[(size_t)row * 4096 + 3072 + g * 16 + (lane & 15)]);
#pragma unroll
            for (int k = 0; k < 4; ++k) {
                float bur = 0.f, bui = 0.f;
#pragma unroll
                for (int c = 0; c < 16; ++c) { const float u = __builtin_bit_cast(float, __builtin_amdgcn_readlane(__builtin_bit_cast(int, uval), 16 * k + c)); bur += br[c] * u; bui += bi[c] * u; }
                const float nr = lam.x * sr - lam.y * si + bur, ni = lam.x * si + lam.y * sr + bui; sr = nr; si = ni;
                const int s2 = st + k;
                if (s2 >= CTX) {
                    const int t = (di == 0) ? s2 - CTX : SEQ - 1 - (s2 - CTX);
                    float outv = 0.f;
#pragma unroll
                    for (int c = 0; c < 16; ++c) { float v = cr[c] * sr - ci[c] * si; v = wave_sum(v); if (lane == c) outv = v; }
                    if (lane < 16) YD[((size_t)di * TL + (size_t)b * SEQ + t) * 1024 + g * 16 + lane] = outv;
                }
            }
        }
    }
}

__device__ __forceinline__ void hyena_naive_phase(Frame& F) {
    const float* GT = WSP(float, WS_GT); const float* kT = WSP(float, WS_KT); const float* invn = WSP(float, WS_INVN); bf16* cat = WSP(bf16, WS_CAT);
    const float* hyb = INP(25);
    LAS float* kf = (LAS float*)F.lds;
    LAS f32x2* ub = (LAS f32x2*)(F.lds + 65536);
    const int tid = F.tid;
    for (int ch = F.bid; ch < 1024; ch += F.G) {
        float res0[16], res1[16];
        for (int o = 0; o < 2; ++o) {
            const float inv = invn[o * 1024 + ch];
            const float* kfw = kT + (size_t)(o * 2048 + ch) * SEQ; const float* kbw = kT + (size_t)(o * 2048 + 1024 + ch) * SEQ;
            for (int n = tid; n < 16384; n += NTHREADS) { float v; if (n < SEQ) v = kfw[n]; else if (n == SEQ) v = 0.f; else v = kbw[16384 - n]; kf[n] = v * inv; }
            if (o == 0) { const float* v0 = GT + ((size_t)(0 * 1024 + ch) * 2) * SEQ; for (int n = tid; n < SEQ; n += NTHREADS) ub[n] = (f32x2){v0[n], v0[SEQ + n]}; }
            else {
#pragma unroll
                for (int j = 0; j < 16; ++j) ub[tid + NTHREADS * j] = (f32x2){res0[j], res1[j]}; }
            __syncthreads();
            float a0[16], a1[16];
#pragma unroll
            for (int j = 0; j < 16; ++j) { a0[j] = 0.f; a1[j] = 0.f; }
            for (int s = 0; s < SEQ; ++s) { const f32x2 u = ub[s];
#pragma unroll
                for (int j = 0; j < 16; ++j) { const float kk = kf[(tid + NTHREADS * j - s) & 16383]; a0[j] += u.x * kk; a1[j] += u.y * kk; } }
            const float bias = hyb[o * 1024 + ch];
            const float* xg = GT + ((size_t)((o + 1) * 1024 + ch) * 2) * SEQ;
#pragma unroll
            for (int j = 0; j < 16; ++j) { const int t = tid + NTHREADS * j; const f32x2 u = ub[t];
                res0[j] = xg[t] * (a0[j] + bias * u.x); res1[j] = xg[SEQ + t] * (a1[j] + bias * u.y); }
            __syncthreads();
        }
#pragma unroll
        for (int j = 0; j < 16; ++j) { const int t = tid + NTHREADS * j;
            cat[(size_t)t * 2048 + ch] = (bf16)f2bf(res0[j]); cat[((size_t)SEQ + t) * 2048 + ch] = (bf16)f2bf(res1[j]); }
    }
}

__device__ __forceinline__ void s5_gelu_phase(Frame& F) {
    const bf16* PJ = WSP(bf16, WS_PROJ1); const float* YD = WSP(float, WS_YD); bf16* Gb = WSP(bf16, WS_PD); const float* dd = INP(33);
    const int gt = F.bid * NTHREADS + F.tid, NGT = F.G * NTHREADS;
    for (int idx = gt; idx < TL * 256; idx += NGT) { const int r = idx >> 8, c = (idx & 255) * 4;
        const v2u uw = *(const v2u*)(PJ + (size_t)r * 4096 + 3072 + c); const f32x4 d4 = *(const f32x4*)(dd + c);
        const f32x4 y0 = *(const f32x4*)(YD + (size_t)r * 1024 + c), y1 = *(const f32x4*)(YD + ((size_t)TL + r) * 1024 + c);
        const f32x4 y = {bflo(uw.x) * d4.x + y0.x + y1.x, bfhi(uw.x) * d4.y + y0.y + y1.y, bflo(uw.y) * d4.z + y0.z + y1.z, bfhi(uw.y) * d4.w + y0.w + y1.w};
        st_bf4(Gb + (size_t)r * 1024 + c, (f32x4){gelu_tanh(y.x), gelu_tanh(y.y), gelu_tanh(y.z), gelu_tanh(y.w)}); }
}

__device__ __forceinline__ f32x2 cmulf(f32x2 a, f32x2 b) { return (f32x2){a.x * b.x - a.y * b.y, a.x * b.y + a.y * b.x}; }
__device__ __forceinline__ int drev14(int p) { const unsigned r = __builtin_bitreverse32((unsigned)p) >> 18; return (int)(((r & 0x2AAAu) >> 1) | ((r & 0x1555u) << 1)); }
__device__ __forceinline__ void fft_fwd(LAS f32x2* X, const f32x2* tw, int tid) {
#pragma nounroll
    for (int L = 4096; L >= 1; L >>= 2) {
        const int tws = 4096 / L;
#pragma unroll 2
        for (int i = 0; i < 8; ++i) {
            const int b = tid + NTHREADS * i, j = b & (L - 1), i0 = (b - j) * 4 + j;
            const f32x2 x0 = X[i0], x1 = X[i0 + L], x2 = X[i0 + 2 * L], x3 = X[i0 + 3 * L];
            const f32x2 w1 = tw[j * tws], w2 = cmulf(w1, w1), w3 = cmulf(w2, w1);
            const f32x2 a = x0 + x2, bb = x0 - x2, c = x1 + x3, d = x1 - x3;
            const f32x2 t1 = {bb.x + d.y, bb.y - d.x}, t3 = {bb.x - d.y, bb.y + d.x};
            X[i0] = a + c; X[i0 + L] = cmulf(t1, w1); X[i0 + 2 * L] = cmulf(a - c, w2); X[i0 + 3 * L] = cmulf(t3, w3);
        }
        __syncthreads();
    }
}
__device__ __forceinline__ void fft_inv(LAS f32x2* X, const f32x2* tw, int tid) {
#pragma nounroll
    for (int L = 1; L <= 4096; L <<= 2) {
        const int tws = 4096 / L;
#pragma unroll 2
        for (int i = 0; i < 8; ++i) {
            const int b = tid + NTHREADS * i, j = b & (L - 1), i0 = (b - j) * 4 + j;
            f32x2 w1 = tw[j * tws]; w1.y = -w1.y; const f32x2 w2 = cmulf(w1, w1), w3 = cmulf(w2, w1);
            const f32x2 x0 = X[i0], x1 = cmulf(X[i0 + L], w1), x2 = cmulf(X[i0 + 2 * L], w2), x3 = cmulf(X[i0 + 3 * L], w3);
            const f32x2 a = x0 + x2, bb = x0 - x2, c = x1 + x3, d = x1 - x3;
            X[i0] = a + c; X[i0 + L] = (f32x2){bb.x - d.y, bb.y + d.x}; X[i0 + 2 * L] = a - c; X[i0 + 3 * L] = (f32x2){bb.x + d.y, bb.y - d.x};
        }
        __syncthreads();
    }
}
__device__ __forceinline__ void fft_pointwise(LAS f32x2* X, const f32x2* Wg, int o, float scale, int tid) {
    const float hs = 0.5f * scale;
#pragma unroll 4
    for (int i = 0; i < 32; ++i) {
        const int p = tid + NTHREADS * i, f = drev14(p), pm = drev14((16384 - f) & 16383);
        const unsigned long long ua = __hip_atomic_load((const unsigned long long*)(Wg + p), __ATOMIC_RELAXED, __HIP_MEMORY_SCOPE_AGENT);
        const unsigned long long ub = __hip_atomic_load((const unsigned long long*)(Wg + pm), __ATOMIC_RELAXED, __HIP_MEMORY_SCOPE_AGENT);
        const f32x2 A = __builtin_bit_cast(f32x2, ua), B = __builtin_bit_cast(f32x2, ub);
        f32x2 K;
        if (o == 0) K = (f32x2){(A.x + B.x) * hs, (A.y - B.y) * hs};
        else { const f32x2 dd = {A.x - B.x, A.y + B.y}; K = (f32x2){dd.y * hs, -dd.x * hs}; }
        X[p] = cmulf(X[p], K);
    }
    __syncthreads();
}
__device__ __forceinline__ void hyena_fft_phase(Frame& F) {
    float* GT = WSP(float, WS_GT); const float* kT = WSP(float, WS_KT); const float* invn = WSP(float, WS_INVN); const f32x2* tw = WSP(f32x2, WS_TW);
    f32x2* Wg = WSP(f32x2, WS_FFTW) + (size_t)F.bid * 16384;
    const float* hyb = INP(25);
    LAS f32x2* X = (LAS f32x2*)F.lds;
    const int tid = F.tid;
    for (int ch = F.bid; ch < 1024; ch += F.G) {
        { const float* f0 = kT + (size_t)ch * SEQ; const float* b0 = kT + (size_t)(1024 + ch) * SEQ; const float* f1 = kT + (size_t)(2048 + ch) * SEQ; const float* b1 = kT + (size_t)(3072 + ch) * SEQ;
          for (int n = tid; n < SEQ; n += NTHREADS) { X[n] = (f32x2){f0[n], f1[n]}; X[SEQ + n] = (n == 0) ? (f32x2){0.f, 0.f} : (f32x2){b0[SEQ - n], b1[SEQ - n]}; } }
        __syncthreads();
        fft_fwd(X, tw, tid);
        for (int n = tid; n < 16384; n += NTHREADS) Wg[n] = X[n];
        __syncthreads();
        float* v0 = GT + ((size_t)ch * 2) * SEQ;
        const float* x1 = GT + ((size_t)(1024 + ch) * 2) * SEQ; const float* x2 = GT + ((size_t)(2048 + ch) * 2) * SEQ;
        float z0[16], z1[16];
#pragma unroll
        for (int j = 0; j < 16; ++j) { const int n = tid + NTHREADS * j; z0[j] = v0[n]; z1[j] = v0[SEQ + n]; }
#pragma unroll
        for (int o = 0; o < 2; ++o) {
#pragma unroll
            for (int j = 0; j < 16; ++j) { const int n = tid + NTHREADS * j; X[n] = (f32x2){z0[j], z1[j]}; X[SEQ + n] = (f32x2){0.f, 0.f}; }
            __syncthreads();
            fft_fwd(X, tw, tid);
            fft_pointwise(X, Wg, o, invn[o * 1024 + ch] * (1.0f / 16384.0f), tid);
            fft_inv(X, tw, tid);
            const float bias = hyb[o * 1024 + ch]; const float* xg = (o == 0) ? x1 : x2;
#pragma unroll
            for (int j = 0; j < 16; ++j) { const int n = tid + NTHREADS * j; const f32x2 y = X[n]; z0[j] = xg[n] * (y.x + bias * z0[j]); z1[j] = xg[SEQ + n] * (y.y + bias * z1[j]); }
            __syncthreads();
        }
#pragma unroll
        for (int j = 0; j < 16; ++j) { const int n = tid + NTHREADS * j; v0[n] = z0[j]; v0[SEQ + n] = z1[j]; }
    }
}
__device__ __forceinline__ void hyena_out_transpose(Frame& F) {
    const float* GT = WSP(float, WS_GT); bf16* cat = WSP(bf16, WS_CAT);
    LAS float* scr = (LAS float*)(F.lds + F.wave * 16896);
    const int lane = F.lane;
    for (int it = F.gw; it < 2 * 128 * 16; it += F.NGW) {
        const int cbk = it & 15, tb = (it >> 4) & 127, b = it >> 11, t0 = tb * 64;
        for (int c = 0; c < 64; ++c) scr[c * 65 + lane] = GT[((size_t)(cbk * 64 + c) * 2 + b) * SEQ + t0 + lane];
        LDS_WAIT(); asm volatile("" ::: "memory");
        for (int tt = 0; tt < 64; ++tt) cat[((size_t)b * SEQ + t0 + tt) * 2048 + cbk * 64 + lane] = (bf16)f2bf(scr[lane * 65 + tt]);
        LDS_WAIT(); asm volatile("" ::: "memory");
    }
}

__device__ __forceinline__ int s5_row(int di, int b, int s) {
    return (s < CTX) ? TL + b * CTX + (di == 0 ? s : CTX - 1 - s) : b * SEQ + (di == 0 ? s - CTX : SEQ - 1 - (s - CTX));
}
template <bool OUTPUT>
__device__ __forceinline__ void s5_seg_phase(Frame& F) {
    const bf16* PJ = WSP(bf16, WS_PROJ1); float* YD = WSP(float, WS_YD);
    const f32x2* lamb = WSP(f32x2, WS_S5LAM); const f32x2* bbar = WSP(f32x2, WS_S5B); const f32x2* l256 = WSP(f32x2, WS_S5L256); f32x2* Eb = WSP(f32x2, WS_S5E);
    const float* cre = INP(31); const float* cim = INP(32);
    const int lane = F.lane;
    for (int task = F.wave * F.G + F.bid; task < 256 * 32; task += F.NGW) {
        const int dbg = task >> 5, seg = (task & 31) + (OUTPUT ? 1 : 0);
        const int di = dbg >> 7, b = (dbg >> 6) & 1, g = dbg & 63;
        const int dgp = (di * 64 + g) * 64 + lane;
        const f32x2 lam = lamb[dgp];
        float br[16], bi[16];
#pragma unroll
        for (int c = 0; c < 16; ++c) { const f32x2 bv = bbar[(size_t)dgp * 16 + c]; br[c] = bv.x; bi[c] = bv.y; }
        float cr[16], ci[16];
        if (OUTPUT) {
#pragma unroll
            for (int c = 0; c < 16; ++c) { cr[c] = cre[((size_t)(di * 64 + g) * 16 + c) * 64 + lane]; ci[c] = cim[((size_t)(di * 64 + g) * 16 + c) * 64 + lane]; }
        }
        float sr = 0.f, si = 0.f;
        if (OUTPUT) {
            const f32x2 l2 = l256[dgp]; const f32x2* ep = Eb + ((size_t)dbg * 32) * 64 + lane;
            for (int k = 0; k < seg; ++k) { const f32x2 e = ep[(size_t)k * 64]; const float nr = l2.x * sr - l2.y * si + e.x, ni = l2.x * si + l2.y * sr + e.y; sr = nr; si = ni; }
        }
        const int s0 = seg * 256;
#pragma nounroll
        for (int st = 0; st < 256; st += 4) {
            const int row = s5_row(di, b, s0 + st + (lane >> 4));
            const float uval = bf2f(PJ[(size_t)row * 4096 + 3072 + g * 16 + (lane & 15)]);
#pragma unroll
            for (int k = 0; k < 4; ++k) {
                float bur = 0.f, bui = 0.f;
#pragma unroll
                for (int c = 0; c < 16; ++c) { const float u = __builtin_bit_cast(float, __builtin_amdgcn_readlane(__builtin_bit_cast(int, uval), 16 * k + c)); bur += br[c] * u; bui += bi[c] * u; }
                const float nr = lam.x * sr - lam.y * si + bur, ni = lam.x * si + lam.y * sr + bui; sr = nr; si = ni;
                if (OUTPUT) {
                    float v8[8], v4[4], v2[2], v1;
                    const bool b5 = (lane & 32) != 0, b4 = (lane & 16) != 0, b3 = (lane & 8) != 0, b2 = (lane & 4) != 0;
#pragma unroll
                    for (int i = 0; i < 8; ++i) { const float lo = cr[i] * sr - ci[i] * si, hi = cr[i + 8] * sr - ci[i + 8] * si; const float keep = b5 ? hi : lo, send = b5 ? lo : hi; v8[i] = keep + __shfl_xor(send, 32); }
#pragma unroll
                    for (int i = 0; i < 4; ++i) { const float keep = b4 ? v8[i + 4] : v8[i], send = b4 ? v8[i] : v8[i + 4]; v4[i] = keep + __shfl_xor(send, 16); }
#pragma unroll
                    for (int i = 0; i < 2; ++i) { const float keep = b3 ? v4[i + 2] : v4[i], send = b3 ? v4[i] : v4[i + 2]; v2[i] = keep + __shfl_xor(send, 8); }
                    { const float keep = b2 ? v2[1] : v2[0], send = b2 ? v2[0] : v2[1]; v1 = keep + __shfl_xor(send, 4); }
                    v1 += __shfl_xor(v1, 2); v1 += __shfl_xor(v1, 1);
                    const int s = s0 + st + k, t = (di == 0) ? s - CTX : SEQ - 1 - (s - CTX);
                    if ((lane & 3) == 0) YD[((size_t)di * TL + (size_t)b * SEQ + t) * 1024 + g * 16 + (lane >> 2)] = v1;
                }
            }
        }
        if (!OUTPUT) Eb[((size_t)dbg * 32 + seg) * 64 + lane] = (f32x2){sr, si};
    }
}

constexpr int NPHASES = 21;
#ifndef MK_SINGLE
#define MK_SINGLE 1
#endif

__device__ __forceinline__ unsigned long long launder_u64(unsigned long long v) {
    unsigned lo = (unsigned)v, hi = (unsigned)(v >> 32);
    asm volatile("" : "+v"(lo), "+v"(hi));
    lo = __builtin_amdgcn_readfirstlane(lo); hi = __builtin_amdgcn_readfirstlane(hi);
    return ((unsigned long long)hi << 32) | lo;
}
__device__ __forceinline__ const void* launder_ptr(const void* p) {
    unsigned long long v = (unsigned long long)p; unsigned lo = (unsigned)v, hi = (unsigned)(v >> 32);
    asm volatile("" : "+v"(lo), "+v"(hi));
    lo = __builtin_amdgcn_readfirstlane(lo); hi = __builtin_amdgcn_readfirstlane(hi);
    return (const void*)(((unsigned long long)hi << 32) | lo);
}
__device__ __forceinline__ void moe_blocks(Frame& F, int l, LAS int* bstart) {
    __syncthreads();
    if (F.tid == 0) { const unsigned* cnt = WSP(unsigned, WS_CTL) + CW_CNT + l * 64; int acc = 0;
        for (int e = 0; e < 64; ++e) { bstart[e] = acc; const int nb = ((int)cnt[e] + 255) >> 8; for (int j = 0; j < nb; ++j) bstart[65 + acc + j] = e; acc += nb; } bstart[64] = acc; }
    __syncthreads();
}

template <int PHSEL>
__global__ void __launch_bounds__(NTHREADS, 2) mk_fwd(Args args) {
    extern __shared__ __attribute__((aligned(16))) unsigned char lds_raw[];
    Frame F;
    F.lds = (LAS unsigned char*)lds_raw; F.ws = args.ws; F.kin = (const __attribute__((address_space(4))) unsigned long long*)__builtin_amdgcn_kernarg_segment_ptr();
    F.tid = threadIdx.x; F.lane = F.tid & 63; F.wave = __builtin_amdgcn_readfirstlane(F.tid >> 6); F.bid = blockIdx.x; F.G = gridDim.x;
    F.gw = F.bid * NWAVES + F.wave; F.NGW = F.G * NWAVES;
    volatile LAS unsigned* lctl = (volatile LAS unsigned*)(F.lds + LDS_CTL);
    LAS int* bstart = (LAS int*)(F.lds + LDS_CTL + 64);
    if (F.tid < 4) lctl[F.tid] = 0u;
    __syncthreads();
    const int lo = args.ph_lo, hi = args.ph_hi;
    XcdBarrier bar; bar.bar = WSP(unsigned, WS_CTL) + CW_BAR; bar.x = 0; bar.st = lctl;
    if (PHSEL < 0) bar = xcd_barrier_post(WSP(unsigned, WS_CTL) + CW_BAR, lctl);
#ifndef PH_MASK
#define PH_MASK 0xffffffffu
#endif
#define IN(k) (((PH_MASK >> (k)) & 1u) && (PHSEL < 0 || PHSEL == (k)))
#define INL(j) (((PH_MASK >> (6 + (j))) & 1u) && (PHSEL < 0 || (PHSEL == 6 + (j) && lo == pb + (j))))
#define PH_END(k) do { if (PHSEL < 0) xcd_barrier(bar); } while (0)
#ifndef PH_REPEAT
#define PH_REPEAT 0u
#endif
#define REP(k) for (int _rep = 0; _rep < (((PH_REPEAT >> (k)) & 1u) ? 2 : 1); ++_rep)
#define PH_BEGIN() do { F.ws = (unsigned char*)launder_ptr((const void*)F.ws); F.kin = (const __attribute__((address_space(4))) unsigned long long*)launder_u64((unsigned long long)F.kin); \
    { int _t = threadIdx.x; asm volatile("" : "+v"(_t)); F.tid = _t; F.lane = _t & 63; F.wave = __builtin_amdgcn_readfirstlane(_t >> 6); \
      int _b = blockIdx.x; asm volatile("" : "+v"(_b)); F.bid = __builtin_amdgcn_readfirstlane(_b); F.gw = F.bid * NWAVES + F.wave; } } while (0)
    LAS unsigned char* lds = F.lds;
    const int G = F.G, bid = F.bid;
    constexpr long T2048 = 256L * 2048 * 2;

    if (IN(0)) { PH_BEGIN(); REP(0) { p0_prologue(F); __syncthreads(); } PH_END(0); }
    if (IN(1)) { PH_BEGIN(); p1_reduce(F); PH_END(1); }
        if (IN(2)) { PH_BEGIN(); REP(2) norm_phase<0>(F, 0, nullptr); PH_END(2); }
        if (IN(3)) { PH_BEGIN(); REP(3) {
            { pg8::Gemm g{WSP(bf16, WS_HA), WSP(bf16, WS_WIN0), 2048, 2048, 2048}; pg8::StaticOrder S; S.init(TT / 256, 12, G, bid, T2048, 0, T2048);
              EpiQKP E{WSP(bf16, WS_Q), WSP(bf16, WS_K), WSP(bf16, WS_P), WSP(f32x2, WS_ROPE)}; pg8::gemm_phase<EpiQKP, pg8::StaticOrder, false>(lds, g, S, E); }
            { pg8::Gemm g{WSP(bf16, WS_WIN0) + (size_t)3072 * 2048, WSP(bf16, WS_HA), 2048, 2048, 2048}; pg8::StaticOrder S; S.init(4, TT / 256, G, bid, T2048, 0, T2048);
              EpiVT E{WSP(bf16, WS_VT)}; pg8::gemm_phase<EpiVT, pg8::StaticOrder, false>(lds, g, S, E); } }
            PH_END(3);
        }
        if (IN(4)) { PH_BEGIN(); REP(4) attn_phase(F); REP(21) poold_phase(F); PH_END(4); }
        if (IN(5)) { PH_BEGIN();
            pg8::Gemm g{WSP(bf16, WS_PD), WSP(bf16, WS_WPOOL), 1024, 256, 256}; pg8::StaticOrder S; S.init(TT / 256, 4, G, bid, 256L * 1024 * 2, 256L * 2, 256L * 256 * 2);
            EpiScaleBf16 E{WSP(bf16, WS_CAT), 2048, 1024, INP(14)}; pg8::gemm_phase<EpiScaleBf16, pg8::StaticOrder, false>(lds, g, S, E);
            PH_END(5);
        }
    {
    constexpr int pb = 6; constexpr int l = 0;
    if (INL(0)) { PH_BEGIN();
        float* xbuf = WSP(float, WS_X);
        pg8::Gemm g{WSP(bf16, WS_CAT), WSP(bf16, l == 0 ? WS_WOUT0 : WS_WOUT1), 2048, 2048, 2048}; pg8::StaticOrder S; S.init(l == 0 ? TT / 256 : TL / 256, 8, G, bid, T2048, 0, T2048);
        EpiRes E{l == 0 ? INP(0) : xbuf, l == 0 ? INP(2) : xbuf + (size_t)TL * 2048, xbuf, modp(F, l, 0, 2)}; pg8::gemm_phase<EpiRes, pg8::StaticOrder, false>(lds, g, S, E);
        PH_END(pb);
    }
    if (INL(1)) { PH_BEGIN(); ffn_norm_router_phase(F, l); PH_END(pb + 1); }
    if (INL(2)) { PH_BEGIN(); REP(8) {
        moe_blocks(F, l, bstart);
        pg8::Gemm g{WSP(bf16, WS_HA), (const bf16*)(F.ws + WS_WMOE + (size_t)l * MOE_L_BYTES), 2048, 2048, 2048};
        MoeOrder S{bstart, WSP(unsigned, WS_CTL) + CW_CNT + l * 64, WSP(int, WS_TOKL), 4, G, bid, bstart[64], T2048, 0, true};
        EpiMoeUp E{WSP(bf16, WS_H)}; pg8::gemm_phase<EpiMoeUp, MoeOrder, true>(lds, g, S, E); }
        PH_END(pb + 2);
    }
    if (INL(3)) { PH_BEGIN(); REP(9) {
        moe_blocks(F, l, bstart);
        pg8::Gemm g{WSP(bf16, WS_H), (const bf16*)(F.ws + WS_WMOE + (size_t)l * MOE_L_BYTES), 512, 512, 512};
        MoeOrder S{bstart, WSP(unsigned, WS_CTL) + CW_CNT + l * 64, WSP(int, WS_TOKL), 8, G, bid, bstart[64], 256L * 512 * 2, (long)(4 * MiB), false};
        EpiMoeDown E{WSP(bf16, WS_Y), WSP(int, WS_TOKL), WSP(float, WS_GATEL), WSP(unsigned, WS_CTL) + CW_CNT + l * 64}; pg8::gemm_phase<EpiMoeDown, MoeOrder, false>(lds, g, S, E); }
        PH_END(pb + 3);
    }
    }
        if (IN(10)) { PH_BEGIN(); norm_phase<2>(F, 1, nullptr); PH_END(10); }
        if (IN(11)) { PH_BEGIN(); REP(11) {
            pg8::Gemm g{WSP(bf16, WS_HA), WSP(bf16, WS_WIN1), 2048, 2048, 2048}; pg8::StaticOrder S; S.init(TT / 256, 16, G, bid, T2048, 0, T2048);
            EpiBf16 E{WSP(bf16, WS_PROJ1), 4096}; pg8::gemm_phase<EpiBf16, pg8::StaticOrder, false>(lds, g, S, E); }
            PH_END(11);
        }
        if (IN(12)) { PH_BEGIN(); REP(12) shortconv_phase(F); REP(22) s5_seg_phase<false>(F); PH_END(12); }
        if (IN(13)) { PH_BEGIN(); REP(23) s5_seg_phase<true>(F); REP(13) hyena_fft_phase(F); PH_END(13); }
        if (IN(14)) { PH_BEGIN(); REP(14) { s5_gelu_phase(F); hyena_out_transpose(F); } PH_END(14); }
        if (IN(15)) { PH_BEGIN();
            pg8::Gemm g{WSP(bf16, WS_PD), WSP(bf16, WS_WGLU), 1024, 1024, 1024}; pg8::StaticOrder S; S.init(TL / 256, 4, G, bid, 256L * 1024 * 2, 0, 256L * 1024 * 2);
            EpiGlu E{WSP(bf16, WS_CAT), 2048, 1024, WSP(bf16, WS_PD), INP(35)}; pg8::gemm_phase<EpiGlu, pg8::StaticOrder, false>(lds, g, S, E);
            PH_END(15);
        }
    {
    constexpr int pb = 16; constexpr int l = 1;
    if (INL(0)) { PH_BEGIN();
        float* xbuf = WSP(float, WS_X);
        pg8::Gemm g{WSP(bf16, WS_CAT), WSP(bf16, l == 0 ? WS_WOUT0 : WS_WOUT1), 2048, 2048, 2048}; pg8::StaticOrder S; S.init(l == 0 ? TT / 256 : TL / 256, 8, G, bid, T2048, 0, T2048);
        EpiRes E{l == 0 ? INP(0) : xbuf, l == 0 ? INP(2) : xbuf + (size_t)TL * 2048, xbuf, modp(F, l, 0, 2)}; pg8::gemm_phase<EpiRes, pg8::StaticOrder, false>(lds, g, S, E);
        PH_END(pb);
    }
    if (INL(1)) { PH_BEGIN(); ffn_norm_router_phase(F, l); PH_END(pb + 1); }
    if (INL(2)) { PH_BEGIN(); REP(8) {
        moe_blocks(F, l, bstart);
        pg8::Gemm g{WSP(bf16, WS_HA), (const bf16*)(F.ws + WS_WMOE + (size_t)l * MOE_L_BYTES), 2048, 2048, 2048};
        MoeOrder S{bstart, WSP(unsigned, WS_CTL) + CW_CNT + l * 64, WSP(int, WS_TOKL), 4, G, bid, bstart[64], T2048, 0, true};
        EpiMoeUp E{WSP(bf16, WS_H)}; pg8::gemm_phase<EpiMoeUp, MoeOrder, true>(lds, g, S, E); }
        PH_END(pb + 2);
    }
    if (INL(3)) { PH_BEGIN(); REP(9) {
        moe_blocks(F, l, bstart);
        pg8::Gemm g{WSP(bf16, WS_H), (const bf16*)(F.ws + WS_WMOE + (size_t)l * MOE_L_BYTES), 512, 512, 512};
        MoeOrder S{bstart, WSP(unsigned, WS_CTL) + CW_CNT + l * 64, WSP(int, WS_TOKL), 8, G, bid, bstart[64], 256L * 512 * 2, (long)(4 * MiB), false};
        EpiMoeDown E{WSP(bf16, WS_Y), WSP(int, WS_TOKL), WSP(float, WS_GATEL), WSP(unsigned, WS_CTL) + CW_CNT + l * 64}; pg8::gemm_phase<EpiMoeDown, MoeOrder, false>(lds, g, S, E); }
        PH_END(pb + 3);
    }
    }
    if (IN(20)) { PH_BEGIN(); norm_phase<3>(F, 1, args.out); }
#undef IN
#undef INL
#undef PH_END
}

typedef void (*kern_t)(Args);
template <int P> static void launch_phase(int grid, hipStream_t stream, Args a) { hipLaunchKernelGGL(mk_fwd<P>, dim3(grid), dim3(NTHREADS), LDS_BYTES, stream, a); }
template <int P> static bool prep_phase() { return hipFuncSetAttribute((const void*)mk_fwd<P>, hipFuncAttributeMaxDynamicSharedMemorySize, LDS_BYTES) == hipSuccess; }
extern "C" void kernel_launch(void* const* d_in, const int* in_sizes, int n_in, void* d_out, int out_size, void* d_ws, size_t ws_size, hipStream_t stream) {
    static int grid = 0;
    if (grid == 0) {
        if (n_in != 43 || out_size != TL * DM || ws_size < WS_END) { fprintf(stderr, "kernel_launch: unexpected shapes (n_in %d, out %d, ws %zu < %zu)\n", n_in, out_size, ws_size, (size_t)WS_END); grid = -1; return; }
        int dev = 0, cus = 0;
        if (hipGetDevice(&dev) != hipSuccess || hipDeviceGetAttribute(&cus, hipDeviceAttributeMultiprocessorCount, dev) != hipSuccess) { grid = -1; return; }
        bool ok = true;
#if MK_SINGLE
        ok = prep_phase<-1>();
#else
        ok = prep_phase<0>() && prep_phase<1>() && prep_phase<2>() && prep_phase<3>() && prep_phase<4>() && prep_phase<5>() && prep_phase<6>() && prep_phase<7>() && prep_phase<8>() && prep_phase<9>() &&
             prep_phase<10>() && prep_phase<11>() && prep_phase<12>() && prep_phase<13>() && prep_phase<14>() && prep_phase<15>() && prep_phase<20>();
#endif
        if (!ok) { fprintf(stderr, "kernel_launch: hipFuncSetAttribute failed\n"); grid = -1; return; }
        (void)hipGetLastError();
        grid = cus;
    }
    if (grid < 0) return;
    (void)hipMemsetAsync((char*)d_ws + WS_CTL, 0, CTL_BYTES, stream);
    Args a{};
    for (int i = 0; i < 43; ++i) a.in[i] = (const float*)d_in[i];
    a.out = (float*)d_out; a.ws = (unsigned char*)d_ws;
#if MK_SINGLE
    a.ph_lo = 0; a.ph_hi = NPHASES;
    launch_phase<-1>(grid, stream, a);
#else
#define LP(k, P) a.ph_lo = (k); a.ph_hi = (k) + 1; launch_phase<P>(grid, stream, a);
    LP(0, 0) LP(1, 1) LP(2, 2) LP(3, 3) LP(4, 4) LP(5, 5) LP(6, 6) LP(7, 7) LP(8, 8) LP(9, 9) LP(10, 10) LP(11, 11) LP(12, 12) LP(13, 13) LP(14, 14) LP(15, 15)
    LP(16, 6) LP(17, 7) LP(18, 8) LP(19, 9) LP(20, 20)
#undef LP
#endif
}
```

```cpp
#include <hip/hip_runtime.h>
#include <cstdio>
#include <cstdint>
#include <cmath>

#define GAS __attribute__((address_space(1)))
#define LAS __attribute__((address_space(3)))
typedef unsigned short bf16;
typedef unsigned v4u __attribute__((ext_vector_type(4)));
typedef unsigned v2u __attribute__((ext_vector_type(2)));
typedef float f32x4 __attribute__((ext_vector_type(4)));
typedef float f32x2 __attribute__((ext_vector_type(2)));
typedef float f32x16 __attribute__((ext_vector_type(16)));
typedef short bf16x8 __attribute__((ext_vector_type(8)));
#define LDS_WAIT() asm volatile("s_waitcnt lgkmcnt(0)" ::: "memory")
#define VM_WAIT() asm volatile("s_waitcnt vmcnt(0)" ::: "memory")

__device__ __forceinline__ unsigned f2bf(float f) { unsigned u = __builtin_bit_cast(unsigned, f); return (u + 0x7fffu + ((u >> 16) & 1u)) >> 16; }
__device__ __forceinline__ unsigned pk2(float lo, float hi) { return f2bf(lo) | (f2bf(hi) << 16); }
__device__ __forceinline__ unsigned cvt_pk_bf16(float lo, float hi) { unsigned r; asm volatile("v_cvt_pk_bf16_f32 %0, %1, %2" : "=v"(r) : "v"(lo), "v"(hi)); return r; }
__device__ __forceinline__ float bf2f(unsigned short b) { return __builtin_bit_cast(float, (unsigned)b << 16); }
__device__ __forceinline__ float bflo(unsigned w) { return __builtin_bit_cast(float, w << 16); }
__device__ __forceinline__ float bfhi(unsigned w) { return __builtin_bit_cast(float, w & 0xffff0000u); }
__device__ __forceinline__ float wave_sum(float v) {
#pragma unroll
    for (int o = 1; o < 64; o <<= 1) v += __shfl_xor(v, o);
    return v;
}

namespace pg8 {
typedef unsigned short bf16_t;
constexpr int BM = 256, BK = 64, HALF = 128, HTB = HALF * BK * 2, STAGE_BYTES = 8 * HTB;

__host__ __device__ __forceinline__ int lds_byte(int r, int c) { const int st = (r >> 4) * 2 + (c >> 5), rr = r & 15, cc = c & 31, ob = rr * 64 + cc * 2; return st * 1024 + (ob ^ (((ob >> 9) & 1) << 5)); }
__host__ __device__ __forceinline__ void stage_rc(int b, int& R, int& C) { const int st = b / 1024, sb = b % 1024, swz = sb ^ (((sb >> 9) & 1) << 5); R = (st >> 1) * 16 + swz / 64; C = (st & 1) * 32 + (swz % 64) / 2; }

struct Unit { int pm, pn; long aoff, boff; int e, idx0; };
struct Gemm { const bf16_t* A; const bf16_t* Bt; int lda, ldb, K; };

template <class Epi, class Sched, bool GATHER>
__device__ __forceinline__ void gemm_phase(LAS unsigned char* lds, const Gemm g, const Sched& S, const Epi& E) {
    const int tid = threadIdx.x, wid = __builtin_amdgcn_readfirstlane(tid >> 6), lane = tid & 63, wr = wid >> 2, wc = wid & 3, fr = lane & 15, fq = lane >> 4;
    const int K = g.K, nt = K / BK;
    unsigned voffA[2], voffB[2];
#pragma unroll
    for (int i = 0; i < 2; ++i) { int R, C; stage_rc(tid * 16 + i * 8192, R, C);
        voffA[i] = (unsigned)(R * g.lda + C) * 2u; voffB[i] = (unsigned)(R * g.ldb + C) * 2u; }
    const size_t kstep = (size_t)(BK * 2);
    const size_t hstepA = GATHER ? 0 : (size_t)HALF * g.lda * 2, hstepB = (size_t)HALF * g.ldb * 2;
    const unsigned ldsw = (unsigned)wid * 1024u;
    const int aoff = lds_byte(wr * 64 + fr, fq * 8), boff = lds_byte(wc * 32 + fr, fq * 8);
#define PG8_SA(b, h) (((b) * 2 + (h)) * HTB)
#define PG8_SB(b, h) ((4 + (b) * 2 + (h)) * HTB)
#define PG8_STAGE(bufoff, gbase, voff) do { _Pragma("unroll") for (int _i = 0; _i < 2; ++_i) \
        __builtin_amdgcn_global_load_lds((const unsigned*)((const char*)(gbase) + (voff)[_i]), (LAS unsigned*)(lds + (bufoff) + ldsw + _i * 8192), 16, 0, 0); } while (0)
#define PG8_STAGE_A(bufoff, gbase, h, nx) do { if constexpr (GATHER) { unsigned _tv[2]; \
        if (nx) { int _tz = tid; asm volatile("" : "+v"(_tz)); _Pragma("unroll") for (int _j = 0; _j < 2; ++_j) { int _R, _C; stage_rc(_tz * 16 + _j * 8192, _R, _C); _tv[_j] = (unsigned)S.arow(nxt, (h) * HALF + _R) * (unsigned)(g.lda * 2) + (unsigned)(_C * 2); } } \
        else { _tv[0] = gvc[h][0]; _tv[1] = gvc[h][1]; } \
        PG8_STAGE(bufoff, gbase, _tv); } else { PG8_STAGE(bufoff, (gbase) + (h) * hstepA, voffA); } } while (0)
#define PG8_LDA(dst, b, h) do { _Pragma("unroll") for (int m = 0; m < 4; ++m) _Pragma("unroll") for (int k = 0; k < 2; ++k) dst[m][k] = *(const LAS bf16x8*)(lds + PG8_SA(b, h) + aoff + m * 2048 + k * 1024); } while (0)
#define PG8_LDB(dst, b, h) do { _Pragma("unroll") for (int n = 0; n < 2; ++n) _Pragma("unroll") for (int k = 0; k < 2; ++k) dst[n][k] = *(const LAS bf16x8*)(lds + PG8_SB(b, h) + boff + n * 2048 + k * 1024); } while (0)
#define PG8_MMA(ai, bj, At, Bt) do { __builtin_amdgcn_s_setprio(1); _Pragma("unroll") for (int m = 0; m < 4; ++m) _Pragma("unroll") for (int n = 0; n < 2; ++n) _Pragma("unroll") for (int k = 0; k < 2; ++k) \
        acc[ai][bj][m][n] = __builtin_amdgcn_mfma_f32_16x16x32_bf16(Bt[n][k], At[m][k], acc[ai][bj][m][n], 0, 0, 0); __builtin_amdgcn_s_setprio(0); } while (0)
#define PG8_WAIT_V(n) asm volatile("s_waitcnt vmcnt(" #n ")" ::: "memory")
#define PG8_WAIT_L(n) asm volatile("s_waitcnt lgkmcnt(" #n ")" ::: "memory")
#define PG8_BAR __builtin_amdgcn_s_barrier()
#define PG8_SCHED __builtin_amdgcn_sched_barrier(0)
    Unit cur, nxt; int ui = 0;
    if (!S.next(0, cur)) return;
    unsigned gvc[2][2];
#define PG8_GV(unit) do { if constexpr (GATHER) { int _tz = tid; asm volatile("" : "+v"(_tz)); _Pragma("unroll") for (int _h = 0; _h < 2; ++_h) _Pragma("unroll") for (int _j = 0; _j < 2; ++_j) { int _R, _C; stage_rc(_tz * 16 + _j * 8192, _R, _C); \
        gvc[_h][_j] = (unsigned)S.arow(unit, _h * HALF + _R) * (unsigned)(g.lda * 2) + (unsigned)(_C * 2); } } } while (0)
    PG8_GV(cur);
    f32x4 acc[2][2][4][2];
#pragma unroll
    for (int a = 0; a < 2; ++a)
#pragma unroll
        for (int b = 0; b < 2; ++b)
#pragma unroll
            for (int m = 0; m < 4; ++m)
#pragma unroll
                for (int n = 0; n < 2; ++n) acc[a][b][m][n] = (f32x4){0.f, 0.f, 0.f, 0.f};
    bf16x8 At[4][2], B0[2][2], B1[2][2];
    const char* cA = (const char*)g.A + cur.aoff; const char* cB = (const char*)g.Bt + cur.boff;
    PG8_STAGE(PG8_SB(0, 0), cB, voffB); PG8_STAGE(PG8_SB(0, 1), cB + hstepB, voffB); PG8_STAGE_A(PG8_SA(0, 0), cA, 0, false); PG8_STAGE_A(PG8_SA(0, 1), cA, 1, false);
    if (wr == 1) PG8_BAR;
    PG8_WAIT_V(2); PG8_BAR;
    PG8_STAGE(PG8_SB(1, 0), cB + kstep, voffB); PG8_STAGE_A(PG8_SA(1, 0), cA + kstep, 0, false); PG8_STAGE(PG8_SB(1, 1), cB + hstepB + kstep, voffB);
    PG8_WAIT_V(6); PG8_BAR;
    for (;;) {
        const bool has_next = S.next(ui + 1, nxt);
        const char* nA = has_next ? (const char*)g.A + nxt.aoff : cA; const char* nB = has_next ? (const char*)g.Bt + nxt.boff : cB;
#pragma nounroll
        for (int t = 0; t < nt; t += 2) {
            const bool last = (t == nt - 2);
            const char* a1 = cA + (size_t)(t + 1) * kstep;
            const char* a2 = last ? nA : cA + (size_t)(t + 2) * kstep; const char* b2 = last ? nB : cB + (size_t)(t + 2) * kstep;
            const char* a3 = a2 + kstep; const char* b3 = b2 + kstep;
            PG8_LDB(B0, 0, 0); PG8_LDB(B1, 0, 1); PG8_SCHED; PG8_LDA(At, 0, 0); PG8_STAGE_A(PG8_SA(1, 1), a1, 1, false);
            PG8_WAIT_V(8); PG8_WAIT_L(0); PG8_BAR; PG8_MMA(0, 0, At, B0); PG8_MMA(0, 1, At, B1); PG8_BAR; PG8_SCHED;
            PG8_LDA(At, 0, 1); PG8_STAGE(PG8_SB(0, 0), b2, voffB); PG8_STAGE(PG8_SB(0, 1), b2 + hstepB, voffB); PG8_STAGE_A(PG8_SA(0, 0), a2, 0, last);
            PG8_WAIT_V(8); PG8_WAIT_L(0); PG8_BAR; PG8_MMA(1, 0, At, B0); PG8_MMA(1, 1, At, B1); PG8_BAR; PG8_SCHED;
            PG8_LDB(B0, 1, 0); PG8_LDB(B1, 1, 1); PG8_SCHED; PG8_LDA(At, 1, 0); PG8_STAGE_A(PG8_SA(0, 1), a2, 1, last);
            PG8_WAIT_V(8); PG8_WAIT_L(0); PG8_BAR; PG8_MMA(0, 0, At, B0); PG8_MMA(0, 1, At, B1); PG8_BAR; PG8_SCHED;
            PG8_LDA(At, 1, 1); PG8_STAGE(PG8_SB(1, 0), b3, voffB); PG8_STAGE(PG8_SB(1, 1), b3 + hstepB, voffB); PG8_STAGE_A(PG8_SA(1, 0), a3, 0, last);
            PG8_WAIT_V(8); PG8_WAIT_L(0); PG8_BAR; PG8_MMA(1, 0, At, B0); PG8_MMA(1, 1, At, B1); PG8_BAR; PG8_SCHED;
        }
        if (wr == 0) PG8_BAR;
        E(acc, cur, wr, wc, fr, fq);
        if (!has_next) break;
#pragma unroll
        for (int a = 0; a < 2; ++a)
#pragma unroll
            for (int b = 0; b < 2; ++b)
#pragma unroll
                for (int m = 0; m < 4; ++m)
#pragma unroll
                    for (int n = 0; n < 2; ++n) acc[a][b][m][n] = (f32x4){0.f, 0.f, 0.f, 0.f};
        cur = nxt; cA = nA; cB = nB; ++ui;
        PG8_GV(cur);
        if (wr == 1) PG8_BAR;
    }
    PG8_WAIT_V(0);
    PG8_BAR;
#undef PG8_SA
#undef PG8_SB
#undef PG8_STAGE
#undef PG8_STAGE_A
#undef PG8_GV
#undef PG8_LDA
#undef PG8_LDB
#undef PG8_MMA
#undef PG8_WAIT_V
#undef PG8_WAIT_L
#undef PG8_BAR
#undef PG8_SCHED
}

struct StaticOrder {
    int nM, nN, nwg, G, c; long astride, apn, bstride;
    __device__ void init(int nM_, int nN_, int G_, int c_, long astride_, long apn_, long bstride_) { nM = nM_; nN = nN_; nwg = nM * nN; G = G_; c = c_; astride = astride_; apn = apn_; bstride = bstride_; }
    __device__ bool next(int i, Unit& u) const {
        const long Lx = (long)i * G + c; if (Lx >= nwg) return false;
        int wgid = (int)Lx; { const int q = nwg / 8, r = nwg % 8, xcd = wgid % 8, off = wgid / 8; wgid = (xcd < r ? xcd * (q + 1) : r * (q + 1) + (xcd - r) * q) + off; }
        const int nig = 8 * nN, gid = wgid / nig, fm = gid * 8, gsz = (nM - fm) < 8 ? (nM - fm) : 8;
        u.pm = fm + ((wgid % nig) % gsz); u.pn = (wgid % nig) / gsz; u.aoff = (long)u.pm * astride + (long)u.pn * apn; u.boff = (long)u.pn * bstride; u.e = 0; u.idx0 = 0; return true;
    }
    __device__ int arow(const Unit&, int) const { return 0; }
};
}

constexpr int DM = 2048, NBATCH = 2, SEQ = 8192, CTX = 256;
constexpr int TL = NBATCH * SEQ;
constexpr int TC = NBATCH * CTX;
constexpr int TT = TL + TC;
constexpr int KEYS = CTX + SEQ;
constexpr int NEXP = 64, DEXP = 512;
constexpr int LISTCAP = 2 * TT;
constexpr float EPS = 1e-6f;
constexpr float QSCALE = 0.125f * 1.4426950408889634f;
constexpr int NWAVES = 8, NTHREADS = 512;

constexpr size_t MiB = 1u << 20;
constexpr size_t WS_CTL = 0, CTL_BYTES = 1 * MiB;
constexpr size_t WS_WIN0 = 1 * MiB;
constexpr size_t WS_WOUT0 = WS_WIN0 + 16 * MiB;
constexpr size_t WS_WIN1 = WS_WOUT0 + 8 * MiB;
constexpr size_t WS_WOUT1 = WS_WIN1 + 16 * MiB;
constexpr size_t WS_WPOOL = WS_WOUT1 + 8 * MiB;
constexpr size_t WS_WGLU = WS_WPOOL + 1 * MiB;
constexpr size_t WS_WMOE = WS_WGLU + 2 * MiB;
constexpr size_t MOE_E_BYTES = 6 * MiB, MOE_L_BYTES = 64 * MOE_E_BYTES;
constexpr size_t WS_X = WS_WMOE + 2 * MOE_L_BYTES;
constexpr size_t WS_HA = WS_X + 132 * MiB;
constexpr size_t WS_Q = WS_HA + 67 * MiB;
constexpr size_t WS_K = WS_Q + 33 * MiB;
constexpr size_t WS_VT = WS_K + 33 * MiB;
constexpr size_t WS_P = WS_VT + 33 * MiB;
constexpr size_t WS_PROJ1 = WS_Q;
constexpr size_t WS_CAT = WS_P + 33 * MiB;
constexpr size_t WS_PD = WS_CAT + 66 * MiB;
constexpr size_t WS_H = WS_PD + 33 * MiB;
constexpr size_t WS_Y = WS_H + 49 * MiB;
constexpr size_t WS_GT = WS_Y + 132 * MiB;
constexpr size_t WS_KT = WS_GT + 192 * MiB;
constexpr size_t WS_YD = WS_KT + 128 * MiB;
constexpr size_t WS_MISC = WS_YD + 128 * MiB;
constexpr size_t WS_MOD = WS_MISC;
constexpr size_t WS_ADAP = WS_MOD + 1 * MiB;
constexpr size_t WS_ROPE = WS_ADAP + 10 * MiB;
constexpr size_t WS_NORMP = WS_ROPE + 1 * MiB;
constexpr size_t WS_INVN = WS_NORMP + 4 * MiB;
constexpr size_t WS_S5LAM = WS_INVN + 1 * MiB;
constexpr size_t WS_S5B = WS_S5LAM + 1 * MiB;
constexpr size_t WS_WRT = WS_S5B + 2 * MiB;
constexpr size_t WS_TOKL = WS_WRT + 2 * MiB;
constexpr size_t WS_GATEL = WS_TOKL + 9 * MiB;
constexpr size_t WS_TW = WS_GATEL + 9 * MiB;
constexpr size_t WS_FFTW = WS_TW + 1 * MiB;
constexpr size_t WS_S5L256 = WS_FFTW + 32 * MiB;
constexpr size_t WS_S5E = WS_S5L256 + 1 * MiB;
constexpr size_t WS_END = WS_S5E + 4 * MiB;
static_assert(WS_END <= 2040 * MiB, "d_ws map");
constexpr int CW_BAR = 1024;
constexpr int CW_CNT = 8192;

constexpr int LDS_PHASE = 131072;
constexpr int LDS_CTL = 147456 - 2048;
constexpr int LDS_BYTES = 147456;

#define XB_TMO      128
#define XB_XCNT(j)  (256  + 64 * (j))
#define XB_XSUB(j)  (1280 + 64 * (j))
#define XB_XGEN(j)  (2304 + 64 * (j))
#define XB_TOP      3328
#define XB_TOPGEN   3392
#define XCD_BAR_WORDS 3456
#define XB_SPIN_CAP (1u << 22)

__device__ __forceinline__ unsigned xb_ld(unsigned* p)              { return __hip_atomic_load(p, __ATOMIC_RELAXED, __HIP_MEMORY_SCOPE_AGENT); }
__device__ __forceinline__ unsigned xb_add(unsigned* p, unsigned v) { return __hip_atomic_fetch_add(p, v, __ATOMIC_RELAXED, __HIP_MEMORY_SCOPE_AGENT); }
__device__ __forceinline__ unsigned xb_xcc_id() { return (unsigned)__builtin_amdgcn_s_getreg((3 << 11) | 20) & 0xFu; }
#define XB_SPIN(cond, bar) do { unsigned _sp = 0; while (cond) { __builtin_amdgcn_s_sleep(1); \
    if ((++_sp & 255u) == 0u) { if (xb_ld(&(bar)[XB_TMO])) break; if (_sp > XB_SPIN_CAP) { atomicAdd(&(bar)[XB_TMO], 1u); break; } } } } while (0)

struct XcdBarrier { unsigned* bar; unsigned x; volatile LAS unsigned* st; };

__device__ __forceinline__ XcdBarrier xcd_barrier_post(unsigned* bar, volatile LAS unsigned* st) {
    XcdBarrier b; b.bar = bar; b.x = xb_xcc_id(); b.st = st;
    if (threadIdx.x == 0) (void)xb_add(&bar[XB_XCNT(b.x)], 1u);
    return b;
}
__device__ __forceinline__ void xcd_barrier_complete(unsigned* bar, unsigned x, unsigned& nloc, unsigned& nx) {
    const unsigned G = gridDim.x * gridDim.y * gridDim.z;
    unsigned sum, cnt, mine, sp = 0u;
    for (;;) {
        sum = 0u; cnt = 0u; mine = 0u;
#pragma unroll
        for (unsigned j = 0; j < 16; ++j) { const unsigned c = xb_ld(&bar[XB_XCNT(j)]); sum += c; cnt += (c > 0u) ? 1u : 0u; mine = (j == x) ? c : mine; }
        if (sum == G) break;
        __builtin_amdgcn_s_sleep(1);
        if ((++sp & 255u) == 0u) { if (xb_ld(&bar[XB_TMO])) break; if (sp > XB_SPIN_CAP) { atomicAdd(&bar[XB_TMO], 1u); break; } }
    }
    nloc = mine > 0u ? mine : 1u; nx = cnt > 0u ? cnt : 1u;
}
__device__ __forceinline__ void xcd_barrier(const XcdBarrier& b) {
    asm volatile("s_waitcnt vmcnt(0)" ::: "memory");
    __syncthreads();
    if (threadIdx.x == 0) {
        unsigned* bar = b.bar;
        __builtin_amdgcn_s_waitcnt(0);
        unsigned nloc = b.st[0], nx = b.st[1];
        if (nloc == 0u) { xcd_barrier_complete(bar, b.x, nloc, nx); b.st[0] = nloc; b.st[1] = nx; }
        const unsigned old = xb_add(&bar[XB_XSUB(b.x)], 1u);
        const unsigned gen = old / nloc;
        if (old + 1u == (gen + 1u) * nloc) {
            __builtin_amdgcn_fence(__ATOMIC_RELEASE, "agent");
            asm volatile("s_waitcnt vmcnt(0)" ::: "memory");
            const unsigned og = xb_add(&bar[XB_TOP], 1u);
            const unsigned tg = og / nx;
            if (og + 1u == (tg + 1u) * nx) xb_add(&bar[XB_TOPGEN], 1u);
            else XB_SPIN(xb_ld(&bar[XB_TOPGEN]) == tg, bar);
            __builtin_amdgcn_fence(__ATOMIC_ACQUIRE, "agent");
            xb_add(&bar[XB_XGEN(b.x)], 1u);
            asm volatile("s_waitcnt vmcnt(0)" ::: "memory");
        } else {
            XB_SPIN(xb_ld(&bar[XB_XGEN(b.x)]) == gen, bar);
            __builtin_amdgcn_fence(__ATOMIC_ACQUIRE, "agent");
            asm volatile("s_waitcnt vmcnt(0)" ::: "memory");
        }
    }
    __syncthreads();
}

__device__ __forceinline__ void sincos_2pi(double x, double& s, double& c) {
    const double q = __builtin_rint(x * 4.0);
    const double y = (x - q * 0.25) * 6.283185307179586476925;
    const double y2 = y * y;
    double sp = -7.6471637318198164759e-13; sp = sp * y2 + 1.6059043836821614599e-10; sp = sp * y2 - 2.5052108385441718775e-8; sp = sp * y2 + 2.7557319223985890653e-6;
    sp = sp * y2 - 1.9841269841269841270e-4; sp = sp * y2 + 8.3333333333333333333e-3; sp = sp * y2 - 1.6666666666666666667e-1; sp = sp * y2 * y + y;
    double cp = 4.7794773323873852974e-14; cp = cp * y2 - 1.1470745597729724714e-11; cp = cp * y2 + 2.0876756987868098979e-9; cp = cp * y2 - 2.7557319223985890653e-7;
    cp = cp * y2 + 2.4801587301587301587e-5; cp = cp * y2 - 1.3888888888888888889e-3; cp = cp * y2 + 4.1666666666666666667e-2; cp = cp * y2 - 0.5; cp = cp * y2 + 1.0;
    const int qi = ((int)q) & 3;
    s = (qi == 0) ? sp : (qi == 1) ? cp : (qi == 2) ? -sp : -cp;
    c = (qi == 0) ? cp : (qi == 1) ? -sp : (qi == 2) ? -cp : sp;
}
__device__ __forceinline__ void sincos_rad(double a, double& s, double& c) {
    double f = a * 0.15915494309189533576888; f -= __builtin_floor(f);
    if (f >= 1.0) f = 0.0;
    sincos_2pi(f, s, c);
}
__device__ __forceinline__ double exp_small(double x) {
    double r = 1.0 / 479001600.0;
    r = r * x + 1.0 / 39916800.0; r = r * x + 1.0 / 3628800.0; r = r * x + 1.0 / 362880.0; r = r * x + 1.0 / 40320.0; r = r * x + 1.0 / 5040.0;
    r = r * x + 1.0 / 720.0; r = r * x + 1.0 / 120.0; r = r * x + 1.0 / 24.0; r = r * x + 1.0 / 6.0; r = r * x + 0.5; r = r * x + 1.0; r = r * x + 1.0;
    return r;
}
__device__ __forceinline__ float fast_exp(float x) { return __builtin_amdgcn_exp2f(x * 1.4426950408889634f); }
__device__ __forceinline__ float sigmoidf_(float x) { return 1.0f / (1.0f + fast_exp(-x)); }
__device__ __forceinline__ float siluf_(float x) { return x * sigmoidf_(x); }
__device__ __forceinline__ float tanhf_(float x) { const float e = fast_exp(-2.0f * fabsf(x)); const float t = (1.0f - e) / (1.0f + e); return x < 0.f ? -t : t; }
__device__ __forceinline__ float gelu_tanh(float x) { return 0.5f * x * (1.0f + tanhf_(0.7978845608028654f * (x + 0.044715f * x * x * x))); }

struct Args { const float* in[43]; float* out; unsigned char* ws; int ph_lo, ph_hi; };

struct Frame {
    LAS unsigned char* lds; unsigned char* ws; int tid, lane, wave, bid, G, gw, NGW;
    const __attribute__((address_space(4))) unsigned long long* kin;
};
#define INP(i) ((const float*)F.kin[i])
#define WSP(T, off) ((T*)(F.ws + (off)))

__device__ __forceinline__ void tr_item(const float* W, int ldw, int N, bf16* WT, int ldt, int row_off, int rs16, LAS float* scr, int item, int lane) {
    const int nblk = N / 64, kb = item / nblk, nb = item % nblk, k0 = 64 * kb, n0 = 64 * nb;
    const int la = lane & 15, lb = lane >> 4;
    f32x4 v[16];
#pragma unroll
    for (int i = 0; i < 16; ++i) v[i] = *(const f32x4*)(W + (size_t)(k0 + 4 * i + lb) * ldw + n0 + 4 * la);
#pragma unroll
    for (int i = 0; i < 16; ++i) { const int kk = 4 * i + lb; LAS float* d = scr + (4 * la) * 65 + kk; d[0] = v[i].x; d[65] = v[i].y; d[130] = v[i].z; d[195] = v[i].w; }
    LDS_WAIT(); asm volatile("" ::: "memory");
    const int c = lane & 7;
#pragma unroll
    for (int j = 0; j < 8; ++j) { const int n = (lane >> 3) + 8 * j; const LAS float* s = scr + n * 65 + 8 * c;
        v4u o; o.x = pk2(s[0], s[1]); o.y = pk2(s[2], s[3]); o.z = pk2(s[4], s[5]); o.w = pk2(s[6], s[7]);
        const int nn = n0 + n, drow = row_off + (nn >> 4) * rs16 + (nn & 15);
        *(v4u*)(WT + (size_t)drow * ldt + k0 + 8 * c) = o; }
    LDS_WAIT(); asm volatile("" ::: "memory");
}

__device__ __forceinline__ void hyfilt_item(Frame& F, int pb) {
    const float* w1 = INP(19); const float* b1 = INP(20); const float* fq = INP(21); const float* w2 = INP(22); const float* b2 = INP(23); const float* w3 = INP(24);
    LAS float* z = (LAS float*)F.lds;
    LAS float* h1 = z + 1088;
    LAS float* h2 = h1 + 2048;
    const int tid = F.tid;
    for (int idx = tid; idx < 32 * 33; idx += NTHREADS) {
        const int p = idx / 33, f = idx % 33, i = pb * 32 + p;
        float v;
        if (f == 0) v = (float)i * (1.0f / (float)(SEQ - 1));
        else { const int j = (f - 1) & 15; const float fj = 1e-4f + (float)j * ((15.0f - 1e-4f) / 15.0f);
            double fr = (double)fj * (double)i / (double)SEQ; fr -= __builtin_floor(fr); double s, c; sincos_2pi(fr, s, c); v = (f <= 16) ? (float)c : (float)(-s); }
        z[p * 33 + f] = v;
    }
    __syncthreads();
    for (int idx = tid; idx < 2048; idx += NTHREADS) {
        const int p = idx >> 6, j = idx & 63; float a = b1[j];
        for (int f = 0; f < 33; ++f) a += z[p * 33 + f] * w1[f * 64 + j];
        double s, c; sincos_rad((double)(fq[j] * a), s, c); h1[idx] = (float)s;
    }
    __syncthreads();
    for (int idx = tid; idx < 2048; idx += NTHREADS) {
        const int p = idx >> 6, j = idx & 63; float a = b2[j];
        for (int k = 0; k < 64; ++k) a += h1[p * 64 + k] * w2[k * 64 + j];
        double s, c; sincos_rad((double)(fq[64 + j] * a), s, c); h2[idx] = (float)s;
    }
    __syncthreads();
    float* kT = WSP(float, WS_KT); float* normp = WSP(float, WS_NORMP);
    for (int cc = 0; cc < 8; ++cc) {
        const int col = tid + NTHREADS * cc;
        float acc[32];
#pragma unroll
        for (int p = 0; p < 32; ++p) acc[p] = 0.f;
        for (int k = 0; k < 64; k += 4) {
            const float w0 = w3[(size_t)(k + 0) * 4096 + col], wA = w3[(size_t)(k + 1) * 4096 + col], wB = w3[(size_t)(k + 2) * 4096 + col], wC = w3[(size_t)(k + 3) * 4096 + col];
#pragma unroll
            for (int p = 0; p < 32; ++p) { const f32x4 hv = *(const LAS f32x4*)(h2 + p * 64 + k); acc[p] += hv.x * w0 + hv.y * wA + hv.z * wB + hv.w * wC; }
        }
        const int ch = col & 1023, dir = (col >> 10) & 1;
        const float adel = 3.0701134573253946f + (float)ch * ((15.350567286626972f - 3.0701134573253946f) / 1023.0f);
        float sabs = 0.f;
#pragma unroll
        for (int p = 0; p < 32; ++p) { const int i = pb * 32 + p; const float t = (float)i * (1.0f / (float)(SEQ - 1)); acc[p] *= fast_exp(-t * adel); if (!(dir == 1 && i == 0)) sabs += fabsf(acc[p]); }
        f32x4* dst = (f32x4*)(kT + (size_t)col * SEQ + pb * 32);
#pragma unroll
        for (int p = 0; p < 8; ++p) dst[p] = (f32x4){acc[4 * p], acc[4 * p + 1], acc[4 * p + 2], acc[4 * p + 3]};
        normp[(size_t)pb * 4096 + col] = sabs;
    }
    __syncthreads();
}

__device__ __forceinline__ void p0_prologue(Frame& F) {
    for (int pb = F.bid; pb < SEQ / 32; pb += F.G) hyfilt_item(F, pb);
    const int gt = F.bid * NTHREADS + F.tid, NGT = F.G * NTHREADS;
    {
        f32x2* rope = WSP(f32x2, WS_ROPE);
        for (int idx = gt; idx < 128 * 16; idx += NGT) { const int pos = idx >> 4, i = idx & 15;
            double inv = (i & 3) == 0 ? 1.0 : (i & 3) == 1 ? 0.56234132519034908 : (i & 3) == 2 ? 0.31622776601683794 : 0.17782794100389228;
            inv *= (i >> 2) == 0 ? 1.0 : (i >> 2) == 1 ? 0.1 : (i >> 2) == 2 ? 0.01 : 0.001;
            const float ang = (float)pos * (float)inv; double s, c; sincos_rad((double)ang, s, c); rope[idx] = (f32x2){(float)c, (float)s}; }
    }
    {
        f32x2* tw = WSP(f32x2, WS_TW);
        for (int idx = gt; idx < 16384; idx += NGT) { double s, c; sincos_2pi((double)idx * (1.0 / 16384.0), s, c); tw[idx] = (f32x2){(float)c, (float)(-s)}; }
    }
    {
        const float* are = INP(26); const float* aim = INP(27); const float* ldt = INP(28); const float* bre = INP(29); const float* bim = INP(30);
        f32x2* lamb = WSP(f32x2, WS_S5LAM); f32x2* bb = WSP(f32x2, WS_S5B); f32x2* l256 = WSP(f32x2, WS_S5L256);
        for (int idx = gt; idx < 2 * 64 * 64; idx += NGT) { const int dg = idx >> 6;
            const float dt = expf(ldt[dg]); const float ar = are[idx], ai = aim[idx];
            const float zr = ar * dt, zi = ai * dt; double s, c; sincos_rad((double)zi, s, c); const double er = exp_small((double)zr);
            const double lr = er * c, li = er * s; lamb[idx] = (f32x2){(float)lr, (float)li};
            { double pr = lr, pi = li; for (int q = 0; q < 8; ++q) { const double tr = pr * pr - pi * pi, ti = 2.0 * pr * pi; pr = tr; pi = ti; } l256[idx] = (f32x2){(float)pr, (float)pi}; }
            const double nr = lr - 1.0, ni = li, den = (double)ar * ar + (double)ai * ai; const double qr = (nr * ar + ni * ai) / den, qi = (ni * ar - nr * ai) / den;
            for (int cc = 0; cc < 16; ++cc) { const double br = bre[(size_t)idx * 16 + cc], bi = bim[(size_t)idx * 16 + cc]; bb[(size_t)idx * 16 + cc] = (f32x2){(float)(qr * br - qi * bi), (float)(qr * bi + qi * br)}; } }
    }
    {
        float* wrt = WSP(float, WS_WRT);
        for (int idx = gt; idx < 2 * 72 * 2048; idx += NGT) { const int l = idx / (72 * 2048), r = idx % (72 * 2048), n = r / 2048, k = r % 2048;
            wrt[idx] = n < 8 ? INP(36)[((size_t)l * 2048 + k) * 8 + n] : INP(38)[((size_t)l * 2048 + k) * 64 + (n - 8)]; }
    }
    {
        bf16* ha = WSP(bf16, WS_HA);
        for (int idx = gt; idx < 2048; idx += NGT) ha[(size_t)TT * 2048 + idx] = 0;
    }
    LAS float* scr = (LAS float*)(F.lds + F.wave * 16896);
    {
        const float* c = INP(1); const float* cctx = INP(3); const float* adaw = INP(4); float* part = WSP(float, WS_ADAP);
        for (int it = F.gw; it < 2 * 32 * 48; it += F.NGW) {
            const int l = it / (32 * 48), r = it % (32 * 48), ks = r / 48, jb = r % 48, k0 = ks * 64, j0 = jb * 256 + F.lane * 4;
            const float c0 = c[k0 + F.lane], c1 = c[2048 + k0 + F.lane], c2 = cctx[k0 + F.lane];
            const float s0 = c0 / (1.0f + expf(-c0)), s1 = c1 / (1.0f + expf(-c1)), s2 = c2 / (1.0f + expf(-c2));
            f32x4 a0 = {0.f, 0.f, 0.f, 0.f}, a1 = a0, a2 = a0;
            const float* wp = adaw + ((size_t)l * 2048 + k0) * 12288 + j0;
#pragma unroll 8
            for (int kk = 0; kk < 64; ++kk) { const f32x4 w = *(const f32x4*)(wp + (size_t)kk * 12288);
                const float t0 = __builtin_bit_cast(float, __builtin_amdgcn_readlane(__builtin_bit_cast(int, s0), kk));
                const float t1 = __builtin_bit_cast(float, __builtin_amdgcn_readlane(__builtin_bit_cast(int, s1), kk));
                const float t2 = __builtin_bit_cast(float, __builtin_amdgcn_readlane(__builtin_bit_cast(int, s2), kk));
                a0 += w * t0; a1 += w * t1; a2 += w * t2; }
            float* pp = part + ((size_t)(l * 32 + ks) * 3) * 12288 + j0;
            *(f32x4*)(pp) = a0; *(f32x4*)(pp + 12288) = a1; *(f32x4*)(pp + 2 * 12288) = a2;
        }
    }
    {
        constexpr int I0 = 1024, I1 = 512, I2 = 512, I3 = 1024, I4 = 2048, I5 = 1024, I6 = 64, I7 = 256, IE = 768;
        constexpr int NSMALL = I0 + I1 + I2 + I3 + I4 + I5 + I6 + I7;
        const int NITEMS = NSMALL + 128 * IE;
        for (int it = F.gw; it < NITEMS; it += F.NGW) {
            int r = it;
            if (r < I0) { tr_item(INP(9), 4096, 2048, WSP(bf16, WS_WIN0), 2048, 0, 16, scr, r, F.lane); continue; } r -= I0;
            if (r < I1) { tr_item(INP(9) + 2048, 4096, 1024, WSP(bf16, WS_WIN0), 2048, 3072, 16, scr, r, F.lane); continue; } r -= I1;
            if (r < I2) { tr_item(INP(9) + 3072, 4096, 1024, WSP(bf16, WS_WIN0), 2048, 2048, 16, scr, r, F.lane); continue; } r -= I2;
            if (r < I3) { tr_item(INP(10), 2048, 2048, WSP(bf16, WS_WOUT0), 2048, 0, 16, scr, r, F.lane); continue; } r -= I3;
            if (r < I4) { tr_item(INP(15), 4096, 4096, WSP(bf16, WS_WIN1), 2048, 0, 16, scr, r, F.lane); continue; } r -= I4;
            if (r < I5) { tr_item(INP(16), 2048, 2048, WSP(bf16, WS_WOUT1), 2048, 0, 16, scr, r, F.lane); continue; } r -= I5;
            if (r < I6) { const int g = r / 16; tr_item(INP(13) + (size_t)g * 65536, 256, 256, WSP(bf16, WS_WPOOL), 256, g * 256, 16, scr, r % 16, F.lane); continue; } r -= I6;
            if (r < I7) { tr_item(INP(34), 1024, 1024, WSP(bf16, WS_WGLU), 1024, 0, 16, scr, r, F.lane); continue; } r -= I7;
            const int le = r / IE, q = r % IE;
            bf16* wc = (bf16*)(F.ws + WS_WMOE + (size_t)le * MOE_E_BYTES); bf16* w2t = wc + 1024 * 2048;
            if (q < 256) tr_item(INP(40) + (size_t)le * (2048 * 512), 512, 512, wc, 2048, 0, 32, scr, q, F.lane);
            else if (q < 512) tr_item(INP(41) + (size_t)le * (2048 * 512), 512, 512, wc, 2048, 16, 32, scr, q - 256, F.lane);
            else tr_item(INP(42) + (size_t)le * (512 * 2048), 2048, 2048, w2t, 512, 0, 16, scr, q - 512, F.lane);
        }
    }
}

__device__ __forceinline__ void p1_reduce(Frame& F) {
    const int gt = F.bid * NTHREADS + F.tid, NGT = F.G * NTHREADS;
    const float* part = WSP(float, WS_ADAP); float* mod = WSP(float, WS_MOD); const float* adab = INP(5);
    for (int idx = gt; idx < 2 * 3 * 12288; idx += NGT) { const int l = idx / (3 * 12288), r = idx % (3 * 12288), m = r / 12288, j = r % 12288;
        float a = adab[l * 12288 + j];
        for (int ks = 0; ks < 32; ++ks) a += part[((size_t)(l * 32 + ks) * 3 + m) * 12288 + j];
        mod[idx] = a; }
    const float* normp = WSP(float, WS_NORMP); float* invn = WSP(float, WS_INVN);
    for (int idx = gt; idx < 2048; idx += NGT) { const int o = idx >> 10, ch = idx & 1023; float a = 0.f;
        for (int pb = 0; pb < 256; ++pb) a += normp[(size_t)pb * 4096 + o * 2048 + ch] + normp[(size_t)pb * 4096 + o * 2048 + 1024 + ch];
        invn[idx] = 1.0f / a; }
}

__device__ __forceinline__ const float* modp(Frame& F, int l, int m, int c) { return WSP(float, WS_MOD) + ((size_t)(l * 3 + m) * 6 + c) * 2048; }
__device__ __forceinline__ int row_stream(int r) { return r < TL ? r / SEQ : 2; }

template <int MODE>
__device__ __forceinline__ void norm_phase(Frame& F, int l, float* dout) {
    const int nrows = (MODE == 3 || (MODE == 1 && l == 1)) ? TL : TT;
    float* xbuf = WSP(float, WS_X); bf16* ha = WSP(bf16, WS_HA); const bf16* Y = WSP(bf16, WS_Y);
    const float* gvec = (MODE == 0) ? INP(6) : (MODE == 1) ? INP(7) + l * 2048 : (MODE == 2) ? INP(6) + 2048 : INP(8);
    const int lane = F.lane;
    for (int r = F.gw; r < nrows; r += F.NGW) {
        const int m = row_stream(r);
        const float* src = (MODE == 0) ? (r < TL ? INP(0) + (size_t)r * 2048 : INP(2) + (size_t)(r - TL) * 2048) : xbuf + (size_t)r * 2048;
        f32x4 v[8]; float ss = 0.f;
#pragma unroll
        for (int j = 0; j < 8; ++j) v[j] = *(const f32x4*)(src + 4 * lane + 256 * j);
        if (MODE == 2 || MODE == 3) {
            const float* g2 = modp(F, MODE == 2 ? 0 : 1, m, 5);
            const bf16* y0 = Y + (size_t)(2 * r) * 2048; const bf16* y1 = y0 + 2048;
#pragma unroll
            for (int j = 0; j < 8; ++j) { const int c = 4 * lane + 256 * j; const v2u a = *(const v2u*)(y0 + c), b = *(const v2u*)(y1 + c); const f32x4 gg = *(const f32x4*)(g2 + c);
                v[j].x += gg.x * (bflo(a.x) + bflo(b.x)); v[j].y += gg.y * (bfhi(a.x) + bfhi(b.x)); v[j].z += gg.z * (bflo(a.y) + bflo(b.y)); v[j].w += gg.w * (bfhi(a.y) + bfhi(b.y)); }
            if (MODE == 2) {
#pragma unroll
                for (int j = 0; j < 8; ++j) *(f32x4*)(xbuf + (size_t)r * 2048 + 4 * lane + 256 * j) = v[j];
            }
        }
#pragma unroll
        for (int j = 0; j < 8; ++j) ss += (v[j].x * v[j].x + v[j].y * v[j].y) + (v[j].z * v[j].z + v[j].w * v[j].w);
        ss = wave_sum(ss);
        const float rs = 1.0f / sqrtf(ss * (1.0f / 2048.0f) + EPS);
        if (MODE == 3) {
#pragma unroll
            for (int j = 0; j < 8; ++j) { const int c = 4 * lane + 256 * j; const f32x4 gg = *(const f32x4*)(gvec + c); *(f32x4*)(dout + (size_t)r * 2048 + c) = v[j] * rs * gg; }
            continue;
        }
        const int lm = (MODE == 2) ? 1 : l;
        const float* sh = modp(F, lm, m, MODE == 1 ? 3 : 0); const float* sc = modp(F, lm, m, MODE == 1 ? 4 : 1);
#pragma unroll
        for (int j = 0; j < 8; ++j) { const int c = 4 * lane + 256 * j; const f32x4 gg = *(const f32x4*)(gvec + c), s1 = *(const f32x4*)(sc + c), s0 = *(const f32x4*)(sh + c);
            v[j] = (v[j] * rs * gg) * (1.0f + s1) + s0;
            v2u o; o.x = pk2(v[j].x, v[j].y); o.y = pk2(v[j].z, v[j].w); *(v2u*)(ha + (size_t)r * 2048 + c) = o; }
    }
}

__device__ __forceinline__ void ffn_norm_router_phase(Frame& F, int l) {
    const int nrows = (l == 1) ? TL : TT;
    const float* xbuf = WSP(float, WS_X); bf16* ha = WSP(bf16, WS_HA);
    const float* gvec = INP(7) + l * 2048;
    const float* wrt = WSP(float, WS_WRT) + (size_t)l * 72 * 2048;
    LAS float* lg = (LAS float*)(F.lds + F.wave * 2048);
    const int lane = F.lane;
    for (int r0 = F.gw * 4; r0 < nrows; r0 += F.NGW * 4) {
        f32x4 v[4][8];
#pragma unroll
        for (int rr = 0; rr < 4; ++rr) {
            const int r = r0 + rr, m = row_stream(r);
            const float* src = xbuf + (size_t)r * 2048; float ss = 0.f;
#pragma unroll
            for (int j = 0; j < 8; ++j) { v[rr][j] = *(const f32x4*)(src + 4 * lane + 256 * j); ss += (v[rr][j].x * v[rr][j].x + v[rr][j].y * v[rr][j].y) + (v[rr][j].z * v[rr][j].z + v[rr][j].w * v[rr][j].w); }
            ss = wave_sum(ss);
            const float rs = 1.0f / sqrtf(ss * (1.0f / 2048.0f) + EPS);
            const float* sh = modp(F, l, m, 3); const float* sc = modp(F, l, m, 4);
#pragma unroll
            for (int j = 0; j < 8; ++j) { const int c = 4 * lane + 256 * j; const f32x4 gg = *(const f32x4*)(gvec + c), s1 = *(const f32x4*)(sc + c), s0 = *(const f32x4*)(sh + c);
                v[rr][j] = (v[rr][j] * rs * gg) * (1.0f + s1) + s0;
                v2u o; o.x = pk2(v[rr][j].x, v[rr][j].y); o.y = pk2(v[rr][j].z, v[rr][j].w); *(v2u*)(ha + (size_t)r * 2048 + c) = o; }
        }
        const bool b5 = (lane & 32) != 0, b4 = (lane & 16) != 0, b3 = (lane & 8) != 0, b2 = (lane & 4) != 0, b1 = (lane & 2) != 0;
#pragma nounroll
        for (int q = 0; q < 9; ++q) {
            float a[32];
#pragma unroll
            for (int nn = 0; nn < 8; ++nn) { const float* wn = wrt + (size_t)(q * 8 + nn) * 2048 + 4 * lane; float s0 = 0.f, s1 = 0.f, s2 = 0.f, s3 = 0.f;
#pragma unroll
                for (int j = 0; j < 8; ++j) { const f32x4 w = *(const f32x4*)(wn + 256 * j);
                    s0 += (v[0][j].x * w.x + v[0][j].y * w.y) + (v[0][j].z * w.z + v[0][j].w * w.w); s1 += (v[1][j].x * w.x + v[1][j].y * w.y) + (v[1][j].z * w.z + v[1][j].w * w.w);
                    s2 += (v[2][j].x * w.x + v[2][j].y * w.y) + (v[2][j].z * w.z + v[2][j].w * w.w); s3 += (v[3][j].x * w.x + v[3][j].y * w.y) + (v[3][j].z * w.z + v[3][j].w * w.w); }
                a[nn] = s0; a[8 + nn] = s1; a[16 + nn] = s2; a[24 + nn] = s3; }
            float c16[16], c8[8], c4[4], c2[2], c1;
#pragma unroll
            for (int i = 0; i < 16; ++i) { const float keep = b5 ? a[i + 16] : a[i], send = b5 ? a[i] : a[i + 16]; c16[i] = keep + __shfl_xor(send, 32); }
#pragma unroll
            for (int i = 0; i < 8; ++i) { const float keep = b4 ? c16[i + 8] : c16[i], send = b4 ? c16[i] : c16[i + 8]; c8[i] = keep + __shfl_xor(send, 16); }
#pragma unroll
            for (int i = 0; i < 4; ++i) { const float keep = b3 ? c8[i + 4] : c8[i], send = b3 ? c8[i] : c8[i + 4]; c4[i] = keep + __shfl_xor(send, 8); }
#pragma unroll
            for (int i = 0; i < 2; ++i) { const float keep = b2 ? c4[i + 2] : c4[i], send = b2 ? c4[i] : c4[i + 2]; c2[i] = keep + __shfl_xor(send, 4); }
            { const float keep = b1 ? c2[1] : c2[0], send = b1 ? c2[0] : c2[1]; c1 = keep + __shfl_xor(send, 2); }
            c1 += __shfl_xor(c1, 1);
            if ((lane & 1) == 0) { const int i = lane >> 1; lg[(i >> 3) * 80 + q * 8 + (i & 7)] = c1; }
        }
        LDS_WAIT(); asm volatile("" ::: "memory");
        if (lane < 4) {
            const int r = r0 + lane; const LAS float* L = lg + lane * 80;
            float gl[8]; float gmax = -INFINITY; int gi = 0;
#pragma unroll
            for (int j = 0; j < 8; ++j) { gl[j] = L[j] + INP(37)[l * 8 + j]; if (gl[j] > gmax) { gmax = gl[j]; gi = j; } }
            float gsum = 0.f;
#pragma unroll
            for (int j = 0; j < 8; ++j) gsum += expf(gl[j] - gmax);
            const float pg_top = 1.0f / gsum;
            float pe[8]; float emax = -INFINITY;
#pragma unroll
            for (int j = 0; j < 8; ++j) { pe[j] = L[8 + gi * 8 + j] + INP(39)[l * 64 + gi * 8 + j]; emax = fmaxf(emax, pe[j]); }
            float esum = 0.f;
#pragma unroll
            for (int j = 0; j < 8; ++j) { pe[j] = expf(pe[j] - emax); esum += pe[j]; }
            int e1 = 0; float p1 = -1.f;
#pragma unroll
            for (int j = 0; j < 8; ++j) { pe[j] /= esum; if (pe[j] > p1) { p1 = pe[j]; e1 = j; } }
            int e2 = 0; float p2 = -1.f;
#pragma unroll
            for (int j = 0; j < 8; ++j) { if (j != e1 && pe[j] > p2) { p2 = pe[j]; e2 = j; } }
            const float den = p1 + p2; const float g1 = pg_top * p1 / den, g2 = pg_top * p2 / den;
            unsigned* cnt = WSP(unsigned, WS_CTL) + CW_CNT + l * 64; int* tokl = WSP(int, WS_TOKL); float* gatel = WSP(float, WS_GATEL);
            const int ex1 = gi * 8 + e1, ex2 = gi * 8 + e2;
            const unsigned k1 = atomicAdd(cnt + ex1, 1u); tokl[(size_t)ex1 * LISTCAP + k1] = 2 * r; gatel[(size_t)ex1 * LISTCAP + k1] = g1;
            const unsigned k2 = atomicAdd(cnt + ex2, 1u); tokl[(size_t)ex2 * LISTCAP + k2] = 2 * r + 1; gatel[(size_t)ex2 * LISTCAP + k2] = g2;
        }
        LDS_WAIT(); asm volatile("" ::: "memory");
    }
}

#define EPI_ARGS const f32x4 (&acc)[2][2][4][2], const pg8::Unit& u, int wr, int wc, int fr, int fq
__device__ __forceinline__ void st_bf4(bf16* p, f32x4 v) { v2u o; o.x = cvt_pk_bf16(v.x, v.y); o.y = cvt_pk_bf16(v.z, v.w); *(v2u*)p = o; }

struct EpiQKP {
    bf16* Q; bf16* Kb; bf16* P; const f32x2* rope;
    __device__ __forceinline__ void operator()(EPI_ARGS) const {
        const int sect = u.pn >> 2, cb = (u.pn & 3) * 256; const bool latent = u.pm < TL / 256;
#pragma unroll
        for (int ai = 0; ai < 2; ++ai)
#pragma unroll
            for (int m = 0; m < 4; ++m) {
                const int r = u.pm * 256 + ai * 128 + wr * 64 + m * 16 + fr;
                int b, t; if (latent) { b = r / SEQ; t = r % SEQ; } else { b = (r - TL) / CTX; t = (r - TL) % CTX; }
                f32x4 cs0 = {1.f, 0.f, 1.f, 0.f}, cs1 = cs0;
                if (latent && sect < 2) { const int pos = (wc & 1) ? (t & 63) : (t >> 6); const f32x4* rp = (const f32x4*)(rope + pos * 16 + 4 * fq); cs0 = rp[0]; cs1 = rp[1]; }
#pragma unroll
                for (int bj = 0; bj < 2; ++bj) {
                    const int c0 = cb + bj * 128 + wc * 32 + 4 * fq;
                    f32x4 a = acc[ai][bj][m][0], bb = acc[ai][bj][m][1];
                    if (sect < 2) {
                        const f32x4 co = {cs0.x, cs0.z, cs1.x, cs1.z}, si = {cs0.y, cs0.w, cs1.y, cs1.w};
                        const f32x4 oa = a * co - bb * si, ob = a * si + bb * co; a = oa; bb = ob;
                    }
                    if (sect == 0) { a = a * QSCALE; bb = bb * QSCALE; bf16* d = Q + (size_t)r * 1024 + c0; st_bf4(d, a); st_bf4(d + 16, bb); }
                    else if (sect == 1) { const size_t kr = (size_t)b * KEYS + (latent ? CTX + t : t); bf16* d = Kb + kr * 1024 + c0; st_bf4(d, a); st_bf4(d + 16, bb); }
                    else { bf16* d = P + (size_t)r * 1024 + c0; st_bf4(d, a); st_bf4(d + 16, bb); }
                }
            }
    }
};
struct EpiVT {
    bf16* VT;
    __device__ __forceinline__ void operator()(EPI_ARGS) const {
        const bool latent = u.pn < TL / 256; const int b = latent ? u.pn / 32 : u.pn - TL / 256; const int key_t0 = latent ? CTX + (u.pn % 32) * 256 : 0;
        const int kperm = 8 * (fq & 1) + 4 * (fq >> 1);
#pragma unroll
        for (int ai = 0; ai < 2; ++ai)
#pragma unroll
            for (int m = 0; m < 4; ++m) {
                const int rr = u.pm * 256 + ai * 128 + wr * 64 + m * 16 + fr;
                bf16* rowp = VT + ((size_t)b * 1024 + rr) * KEYS + key_t0;
#pragma unroll
                for (int bj = 0; bj < 2; ++bj)
#pragma unroll
                    for (int n = 0; n < 2; ++n) st_bf4(rowp + bj * 128 + wc * 32 + 16 * n + kperm, acc[ai][bj][m][n]);
            }
    }
};
struct EpiScaleBf16 {
    bf16* O; int ldo, coff; const float* cscale;
    __device__ __forceinline__ void operator()(EPI_ARGS) const {
#pragma unroll
        for (int bj = 0; bj < 2; ++bj)
#pragma unroll
            for (int n = 0; n < 2; ++n) { const int c = u.pn * 256 + bj * 128 + wc * 32 + 16 * n + 4 * fq; const f32x4 sc = *(const f32x4*)(cscale + c);
#pragma unroll
                for (int ai = 0; ai < 2; ++ai)
#pragma unroll
                    for (int m = 0; m < 4; ++m) { const int r = u.pm * 256 + ai * 128 + wr * 64 + m * 16 + fr; st_bf4(O + (size_t)r * ldo + coff + c, acc[ai][bj][m][n] * sc); } }
    }
};
struct EpiBf16 {
    bf16* O; int ldo;
    __device__ __forceinline__ void operator()(EPI_ARGS) const {
#pragma unroll
        for (int ai = 0; ai < 2; ++ai)
#pragma unroll
            for (int m = 0; m < 4; ++m) { const int r = u.pm * 256 + ai * 128 + wr * 64 + m * 16 + fr; bf16* rowp = O + (size_t)r * ldo + u.pn * 256 + wc * 32 + 4 * fq;
#pragma unroll
                for (int bj = 0; bj < 2; ++bj)
#pragma unroll
                    for (int n = 0; n < 2; ++n) st_bf4(rowp + bj * 128 + 16 * n, acc[ai][bj][m][n]); }
    }
};
struct EpiRes {
    const float* xlat; const float* xctx; float* xout; const float* gate0;
    __device__ __forceinline__ void operator()(EPI_ARGS) const {
        const bool latent = u.pm < TL / 256;
#pragma unroll
        for (int ai = 0; ai < 2; ++ai)
#pragma unroll
            for (int m = 0; m < 4; ++m) { const int r = u.pm * 256 + ai * 128 + wr * 64 + m * 16 + fr; const int ms = latent ? r / SEQ : 2;
                const float* xi = latent ? xlat + (size_t)r * 2048 : xctx + (size_t)(r - TL) * 2048; const float* gp = gate0 + (size_t)ms * 12288;
#pragma unroll
                for (int bj = 0; bj < 2; ++bj)
#pragma unroll
                    for (int n = 0; n < 2; ++n) { const int c = u.pn * 256 + bj * 128 + wc * 32 + 16 * n + 4 * fq;
                        const f32x4 xv = *(const f32x4*)(xi + c), gv = *(const f32x4*)(gp + c); *(f32x4*)(xout + (size_t)r * 2048 + c) = xv + gv * acc[ai][bj][m][n]; } }
    }
};
struct EpiMoeUp {
    bf16* H;
    __device__ __forceinline__ void operator()(EPI_ARGS) const {
#pragma unroll
        for (int ai = 0; ai < 2; ++ai)
#pragma unroll
            for (int m = 0; m < 4; ++m) { const size_t r = (size_t)u.pm * 256 + ai * 128 + wr * 64 + m * 16 + fr;
#pragma unroll
                for (int bj = 0; bj < 2; ++bj) { const int hc = (u.pn * 256 + bj * 128 + wc * 32) / 2 + 4 * fq; const f32x4 a = acc[ai][bj][m][0], b = acc[ai][bj][m][1];
                    const f32x4 h = {siluf_(a.x) * b.x, siluf_(a.y) * b.y, siluf_(a.z) * b.z, siluf_(a.w) * b.w}; st_bf4(H + r * 512 + hc, h); } }
    }
};
struct EpiMoeDown {
    bf16* Y; const int* tokl; const float* gatel; const unsigned* cnt;
    __device__ __forceinline__ void operator()(EPI_ARGS) const {
        const int ce = (int)cnt[u.e];
#pragma unroll
        for (int ai = 0; ai < 2; ++ai)
#pragma unroll
            for (int m = 0; m < 4; ++m) { const int idx = u.idx0 + ai * 128 + wr * 64 + m * 16 + fr;
                if (idx < ce) { const int pair = tokl[(size_t)u.e * LISTCAP + idx]; const float gt = gatel[(size_t)u.e * LISTCAP + idx]; bf16* rowp = Y + (size_t)pair * 2048 + u.pn * 256 + wc * 32 + 4 * fq;
#pragma unroll
                    for (int bj = 0; bj < 2; ++bj)
#pragma unroll
                        for (int n = 0; n < 2; ++n) st_bf4(rowp + bj * 128 + 16 * n, acc[ai][bj][m][n] * gt); } }
    }
};
struct EpiGlu {
    bf16* O; int ldo, coff; const bf16* Gb; const float* bias;
    __device__ __forceinline__ void operator()(EPI_ARGS) const {
#pragma unroll
        for (int ai = 0; ai < 2; ++ai)
#pragma unroll
            for (int m = 0; m < 4; ++m) { const int r = u.pm * 256 + ai * 128 + wr * 64 + m * 16 + fr;
#pragma unroll
                for (int bj = 0; bj < 2; ++bj)
#pragma unroll
                    for (int n = 0; n < 2; ++n) { const int c = u.pn * 256 + bj * 128 + wc * 32 + 16 * n + 4 * fq; const f32x4 bv = *(const f32x4*)(bias + c); const v2u gw = *(const v2u*)(Gb + (size_t)r * 1024 + c);
                        const f32x4 a = acc[ai][bj][m][n] + bv; const f32x4 o = {bflo(gw.x) * sigmoidf_(a.x), bfhi(gw.x) * sigmoidf_(a.y), bflo(gw.y) * sigmoidf_(a.z), bfhi(gw.y) * sigmoidf_(a.w)};
                        st_bf4(O + (size_t)r * ldo + coff + c, o); } }
    }
};

struct MoeOrder {
    const LAS int* bstart;
    const unsigned* cnt; const int* tokl; int nN, G, c, nblk; long bstride, eoff; bool up;
    __device__ bool next(int i, pg8::Unit& u) const {
        const long Lx = (long)i * G + c; if (Lx >= (long)nblk * nN) return false;
        const int blk = (int)(Lx / nN); u.pn = (int)(Lx % nN); u.pm = blk;
        const int e = bstart[65 + blk];
        u.e = e; u.idx0 = (blk - bstart[e]) * 256;
        u.aoff = up ? 0 : (long)blk * 256 * 512 * 2;
        u.boff = (long)e * (long)MOE_E_BYTES + eoff + (long)u.pn * bstride;
        return true;
    }
    __device__ int arow(const pg8::Unit& u, int row) const { const int idx = u.idx0 + row; return idx < (int)cnt[u.e] ? (tokl[(size_t)u.e * LISTCAP + idx] >> 1) : TT; }
};

__device__ __forceinline__ void attn_phase(Frame& F) {
    const bf16* Q = WSP(bf16, WS_Q); const bf16* Kb = WSP(bf16, WS_K); const bf16* VT = WSP(bf16, WS_VT); bf16* cat = WSP(bf16, WS_CAT);
    LAS unsigned char* lds = F.lds;
    const int tid = F.tid, lane = F.lane, w = F.wave, sub = w & 1, qw = w >> 1, r32 = lane & 31, hi = lane >> 5;
    float lam;
    { const float* lv = INP(11); float a = lv[lane] * lv[64 + lane], b = lv[128 + lane] * lv[192 + lane]; a = wave_sum(a); b = wave_sum(b); lam = expf(a) - expf(b) + 0.2f; }
    const float* subg = INP(12);
    const int NU = 1024 + 32;
    const int xcd = F.bid & 7, jcu = F.bid >> 3;
    for (int it = 0;; ++it) {
        int uidx;
        if (F.G == 256) { if (it < 4) uidx = 128 * xcd + it * 32 + jcu; else if (it == 4 && F.bid < 32) uidx = 1024 + F.bid; else break; }
        else { uidx = it * F.G + F.bid; if (uidx >= NU) break; }
        int b, head, q0row, nt; size_t kbase;
        if (uidx < 1024) { const int combo = uidx >> 6, qb = uidx & 63; b = combo >> 3; head = combo & 7; q0row = b * SEQ + qb * 128; nt = KEYS / 64; }
        else { const int v = uidx - 1024; b = v >> 4; head = (v >> 1) & 7; q0row = TL + b * CTX + (v & 1) * 128; nt = CTX / 64; }
        kbase = (size_t)b * KEYS;
        bf16x8 qf[4];
        { const bf16* qp = Q + (size_t)(q0row + qw * 32 + r32) * 1024 + head * 128 + sub * 64 + hi * 8;
#pragma unroll
          for (int ks = 0; ks < 4; ++ks) qf[ks] = *(const bf16x8*)(qp + ks * 16); }
        const int srow = tid >> 3, sch = tid & 7;
        const bf16* gk0 = Kb + (kbase + srow) * 1024 + head * 128 + sch * 8;
        const bf16* gv0 = VT + ((size_t)(b * 8 + head) * 128 + srow) * KEYS + sch * 8;
        const int lk = srow * 128 + ((sch ^ ((srow >> 1) & 7)) * 16);
        v4u st0, st1, st2, st3;
#define ATT_LOAD(t) do { st0 = *(const v4u*)(gk0 + (size_t)(t) * 65536); st1 = *(const v4u*)(gk0 + (size_t)(t) * 65536 + 64); st2 = *(const v4u*)(gv0 + (t) * 64); st3 = *(const v4u*)(gv0 + (size_t)64 * KEYS + (t) * 64); } while (0)
#define ATT_STORE(buf) do { LAS unsigned char* bp = lds + (buf) * 32768; *(LAS v4u*)(bp + lk) = st0; *(LAS v4u*)(bp + 8192 + lk) = st1; *(LAS v4u*)(bp + 16384 + lk) = st2; *(LAS v4u*)(bp + 16384 + 8192 + lk) = st3; } while (0)
        ATT_LOAD(0); ATT_STORE(0);
        __syncthreads();
        f32x16 o[4];
#pragma unroll
        for (int d = 0; d < 4; ++d)
#pragma unroll
            for (int r = 0; r < 16; ++r) o[d][r] = 0.f;
        float mrow = -INFINITY, lrow = 0.f;
        const int rdoff = r32 * 128;
        const int swz = (r32 >> 1) & 7;
        for (int t = 0; t < nt; ++t) {
            if (t + 1 < nt) ATT_LOAD(t + 1);
            const LAS unsigned char* bp = lds + (t & 1) * 32768;
            const LAS unsigned char* kp = bp + sub * 8192;
            f32x16 s0, s1;
#pragma unroll
            for (int r = 0; r < 16; ++r) { s0[r] = 0.f; s1[r] = 0.f; }
#pragma unroll
            for (int ks = 0; ks < 4; ++ks) {
                const int ch = ((2 * ks + hi) ^ swz) * 16;
                const bf16x8 k0 = *(const LAS bf16x8*)(kp + rdoff + ch);
                const bf16x8 k1 = *(const LAS bf16x8*)(kp + 4096 + rdoff + ch);
                s0 = __builtin_amdgcn_mfma_f32_32x32x16_bf16(k0, qf[ks], s0, 0, 0, 0);
                s1 = __builtin_amdgcn_mfma_f32_32x32x16_bf16(k1, qf[ks], s1, 0, 0, 0);
            }
            float mx = s0[0];
#pragma unroll
            for (int r = 1; r < 16; ++r) mx = fmaxf(mx, s0[r]);
#pragma unroll
            for (int r = 0; r < 16; ++r) mx = fmaxf(mx, s1[r]);
            mx = fmaxf(mx, __shfl_xor(mx, 32));
            const float mnew = fmaxf(mrow, mx);
            const float alpha = __builtin_amdgcn_exp2f(mrow - mnew);
            mrow = mnew;
            float rs = 0.f;
#pragma unroll
            for (int r = 0; r < 16; ++r) { s0[r] = __builtin_amdgcn_exp2f(s0[r] - mnew); rs += s0[r]; }
#pragma unroll
            for (int r = 0; r < 16; ++r) { s1[r] = __builtin_amdgcn_exp2f(s1[r] - mnew); rs += s1[r]; }
            lrow = lrow * alpha + rs;
            if (__any(alpha != 1.0f)) {
#pragma unroll
                for (int d = 0; d < 4; ++d)
#pragma unroll
                    for (int r = 0; r < 16; ++r) o[d][r] *= alpha;
            }
            bf16x8 pf[4];
#pragma unroll
            for (int s = 0; s < 4; ++s) { v4u pw;
                if (s < 2) { pw.x = cvt_pk_bf16(s0[8 * s + 0], s0[8 * s + 1]); pw.y = cvt_pk_bf16(s0[8 * s + 2], s0[8 * s + 3]); pw.z = cvt_pk_bf16(s0[8 * s + 4], s0[8 * s + 5]); pw.w = cvt_pk_bf16(s0[8 * s + 6], s0[8 * s + 7]); }
                else { const int q = s - 2; pw.x = cvt_pk_bf16(s1[8 * q + 0], s1[8 * q + 1]); pw.y = cvt_pk_bf16(s1[8 * q + 2], s1[8 * q + 3]); pw.z = cvt_pk_bf16(s1[8 * q + 4], s1[8 * q + 5]); pw.w = cvt_pk_bf16(s1[8 * q + 6], s1[8 * q + 7]); }
                pf[s] = __builtin_bit_cast(bf16x8, pw); }
            const LAS unsigned char* vp = bp + 16384;
#pragma unroll
            for (int d = 0; d < 4; ++d)
#pragma unroll
                for (int s = 0; s < 4; ++s) {
                    const bf16x8 vf = *(const LAS bf16x8*)(vp + d * 4096 + rdoff + (((2 * s + hi) ^ swz) * 16));
                    o[d] = __builtin_amdgcn_mfma_f32_32x32x16_bf16(vf, pf[s], o[d], 0, 0, 0);
                }
            if (t + 1 < nt) ATT_STORE((t + 1) & 1);
            __syncthreads();
        }
#undef ATT_LOAD
#undef ATT_STORE
        const float ltot = lrow + __shfl_xor(lrow, 32); const float linv = 1.0f / ltot;
        LAS float* xch = (LAS float*)lds + (size_t)(qw * 32 + r32) * 132;
        if (sub == 1) {
#pragma unroll
            for (int d = 0; d < 4; ++d)
#pragma unroll
                for (int g = 0; g < 4; ++g) *(LAS f32x4*)(xch + 32 * d + 8 * g + 4 * hi) = (f32x4){o[d][4 * g] * linv, o[d][4 * g + 1] * linv, o[d][4 * g + 2] * linv, o[d][4 * g + 3] * linv};
        }
        __syncthreads();
        if (sub == 0) {
            float ss = 0.f;
#pragma unroll
            for (int d = 0; d < 4; ++d)
#pragma unroll
                for (int g = 0; g < 4; ++g) { const f32x4 o2 = *(const LAS f32x4*)(xch + 32 * d + 8 * g + 4 * hi);
#pragma unroll
                    for (int j = 0; j < 4; ++j) { const float v = o[d][4 * g + j] * linv - lam * o2[j]; o[d][4 * g + j] = v; ss += v * v; } }
            ss += __shfl_xor(ss, 32);
            const float rn = 0.8f / sqrtf(ss * (1.0f / 128.0f) + EPS);
            bf16* op = cat + (size_t)(q0row + qw * 32 + r32) * 2048 + head * 128;
#pragma unroll
            for (int d = 0; d < 4; ++d)
#pragma unroll
                for (int g = 0; g < 4; ++g) { const int dv = 32 * d + 8 * g + 4 * hi; const f32x4 gg = *(const f32x4*)(subg + dv);
                    st_bf4(op + dv, (f32x4){o[d][4 * g] * rn * gg.x, o[d][4 * g + 1] * rn * gg.y, o[d][4 * g + 2] * rn * gg.z, o[d][4 * g + 3] * rn * gg.w}); }
        }
        __syncthreads();
    }
}

__device__ __forceinline__ void poold_phase(Frame& F) {
    const bf16* P = WSP(bf16, WS_P); bf16* PD = WSP(bf16, WS_PD);
    const int gt = F.bid * NTHREADS + F.tid, NGT = F.G * NTHREADS;
    for (int idx = gt; idx < TT * 128; idx += NGT) {
        const int r = idx >> 7, cc = (idx & 127) * 8, g = cc >> 8, wdw = 2 << g;
        int sb, t, Ls; if (r < TL) { sb = (r / SEQ) * SEQ; t = r % SEQ; Ls = SEQ; } else { sb = TL + ((r - TL) / CTX) * CTX; t = (r - TL) % CTX; Ls = CTX; }
        int lo = t - wdw / 2, hi = lo + wdw; lo = lo < 0 ? 0 : lo; hi = hi > Ls ? Ls : hi;
        float a[8];
#pragma unroll
        for (int j = 0; j < 8; ++j) a[j] = 0.f;
        for (int s = lo; s < hi; ++s) { const v4u v = *(const v4u*)(P + (size_t)(sb + s) * 1024 + cc);
            a[0] += bflo(v.x); a[1] += bfhi(v.x); a[2] += bflo(v.y); a[3] += bfhi(v.y); a[4] += bflo(v.z); a[5] += bfhi(v.z); a[6] += bflo(v.w); a[7] += bfhi(v.w); }
        const float inv = 1.0f / (float)(hi - lo);
        const v4u me = *(const v4u*)(P + (size_t)r * 1024 + cc);
        v4u o; o.x = pk2(a[0] * inv - bflo(me.x), a[1] * inv - bfhi(me.x)); o.y = pk2(a[2] * inv - bflo(me.y), a[3] * inv - bfhi(me.y));
        o.z = pk2(a[4] * inv - bflo(me.z), a[5] * inv - bfhi(me.z)); o.w = pk2(a[6] * inv - bflo(me.w), a[7] * inv - bfhi(me.w));
        *(v4u*)(PD + (size_t)r * 1024 + cc) = o;
    }
}

__device__ __forceinline__ void shortconv_phase(Frame& F) {
    const bf16* PJ = WSP(bf16, WS_PROJ1); float* GT = WSP(float, WS_GT);
    const float* cw = INP(17); const float* cb = INP(18);
    LAS float* scr = (LAS float*)(F.lds + F.wave * 16896);
    const int lane = F.lane;
    for (int it = F.gw; it < 2 * 128 * 48; it += F.NGW) {
        const int cbk = it % 48, tb = (it / 48) % 128, b = it / (48 * 128), col = cbk * 64 + lane, t0 = tb * 64;
        const float w0 = cw[col], w1 = cw[3072 + col], w2 = cw[2 * 3072 + col], bias = cb[col];
        const bf16* base = PJ + ((size_t)b * SEQ) * 4096 + col;
        float prev = (t0 > 0) ? bf2f(base[(size_t)(t0 - 1) * 4096]) : 0.f;
        float cur = bf2f(base[(size_t)t0 * 4096]);
#pragma unroll 8
        for (int tt = 0; tt < 64; ++tt) { const int t = t0 + tt; const float nxt = (t + 1 < SEQ) ? bf2f(base[(size_t)(t + 1) * 4096]) : 0.f;
            scr[tt * 65 + lane] = prev * w0 + cur * w1 + nxt * w2 + bias; prev = cur; cur = nxt; }
        LDS_WAIT(); asm volatile("" ::: "memory");
        for (int c = 0; c < 64; ++c) GT[((size_t)(cbk * 64 + c) * 2 + b) * SEQ + t0 + lane] = scr[lane * 65 + c];
        LDS_WAIT(); asm volatile("" ::: "memory");
    }
}

__device__ __forceinline__ void s5_scan_phase(Frame& F) {
    const bf16* PJ = WSP(bf16, WS_PROJ1); float* YD = WSP(float, WS_YD);
    const f32x2* lamb = WSP(f32x2, WS_S5LAM); const f32x2* bbar = WSP(f32x2, WS_S5B);
    const float* cre = INP(31); const float* cim = INP(32);
    const int lane = F.lane;
    for (int task = F.wave * F.G + F.bid; task < 256; task += F.NGW) {
        const int di = task >> 7, b = (task >> 6) & 1, g = task & 63;
        const int dgp = (di * 64 + g) * 64 + lane;
        const f32x2 lam = lamb[dgp];
        float br[16], bi[16], cr[16], ci[16];
#pragma unroll
        for (int c = 0; c < 16; ++c) { const f32x2 bv = bbar[(size_t)dgp * 16 + c]; br[c] = bv.x; bi[c] = bv.y;
            cr[c] = cre[((size_t)(di * 64 + g) * 16 + c) * 64 + lane]; ci[c] = cim[((size_t)(di * 64 + g) * 16 + c) * 64 + lane]; }
        float sr = 0.f, si = 0.f;
        const int nsteps = CTX + SEQ;
        for (int st = 0; st < nsteps; st += 4) {
            const int stl = st + (lane >> 4);
            int row;
            if (stl < CTX) row = TL + b * CTX + (di == 0 ? stl : CTX - 1 - stl);
            else row = b * SEQ + (di == 0 ? stl - CTX : SEQ - 1 - (stl - CTX));
            const float uval = bf2f(PJ[(size_t)row * 4096 + 3072 + g * 16 + (lane & 15)]);
#pragma unroll
            for (int k = 0; k < 4; ++k) {
                float bur = 0.f, bui = 0.f;
#pragma unroll
                for (int c = 0; c < 16; ++c) { const float u = __builtin_bit_cast(float, __builtin_amdgcn_readlane(__builtin_bit_cast(int, uval), 16 * k + c)); bur += br[c] * u; bui += bi[c] * u; }
                const float nr = lam.x * sr - lam.y * si + bur, ni = lam.x * si + lam.y * sr + bui; sr = nr; si = ni;
                const int s2 = st + k;
                if (s2 >= CTX) {
                    const int t = (di == 0) ? s2 - CTX : SEQ - 1 - (s2 - CTX);
                    float outv = 0.f;
#pragma unroll
                    for (int c = 0; c < 16; ++c) { float v = cr[c] * sr - ci[c] * si; v = wave_sum(v); if (lane == c) outv = v; }
                    if (lane < 16) YD[((size_t)di * TL + (size_t)b * SEQ + t) * 1024 + g * 16 + lane] = outv;
                }
            }
        }
    }
}

__device__ __forceinline__ void hyena_naive_phase(Frame& F) {
    const float* GT = WSP(float, WS_GT); const float* kT = WSP(float, WS_KT); const float* invn = WSP(float, WS_INVN); bf16* cat = WSP(bf16, WS_CAT);
    const float* hyb = INP(25);
    LAS float* kf = (LAS float*)F.lds;
    LAS f32x2* ub = (LAS f32x2*)(F.lds + 65536);
    const int tid = F.tid;
    for (int ch = F.bid; ch < 1024; ch += F.G) {
        float res0[16], res1[16];
        for (int o = 0; o < 2; ++o) {
            const float inv = invn[o * 1024 + ch];
            const float* kfw = kT + (size_t)(o * 2048 + ch) * SEQ; const float* kbw = kT + (size_t)(o * 2048 + 1024 + ch) * SEQ;
            for (int n = tid; n < 16384; n += NTHREADS) { float v; if (n < SEQ) v = kfw[n]; else if (n == SEQ) v = 0.f; else v = kbw[16384 - n]; kf[n] = v * inv; }
            if (o == 0) { const float* v0 = GT + ((size_t)(0 * 1024 + ch) * 2) * SEQ; for (int n = tid; n < SEQ; n += NTHREADS) ub[n] = (f32x2){v0[n], v0[SEQ + n]}; }
            else {
#pragma unroll
                for (int j = 0; j < 16; ++j) ub[tid + NTHREADS * j] = (f32x2){res0[j], res1[j]}; }
            __syncthreads();
            float a0[16], a1[16];
#pragma unroll
            for (int j = 0; j < 16; ++j) { a0[j] = 0.f; a1[j] = 0.f; }
            for (int s = 0; s < SEQ; ++s) { const f32x2 u = ub[s];
#pragma unroll
                for (int j = 0; j < 16; ++j) { const float kk = kf[(tid + NTHREADS * j - s) & 16383]; a0[j] += u.x * kk; a1[j] += u.y * kk; } }
            const float bias = hyb[o * 1024 + ch];
            const float* xg = GT + ((size_t)((o + 1) * 1024 + ch) * 2) * SEQ;
#pragma unroll
            for (int j = 0; j < 16; ++j) { const int t = tid + NTHREADS * j; const f32x2 u = ub[t];
                res0[j] = xg[t] * (a0[j] + bias * u.x); res1[j] = xg[SEQ + t] * (a1[j] + bias * u.y); }
            __syncthreads();
        }
#pragma unroll
        for (int j = 0; j < 16; ++j) { const int t = tid + NTHREADS * j;
            cat[(size_t)t * 2048 + ch] = (bf16)f2bf(res0[j]); cat[((size_t)SEQ + t) * 2048 + ch] = (bf16)f2bf(res1[j]); }
    }
}

__device__ __forceinline__ void s5_gelu_phase(Frame& F) {
    const bf16* PJ = WSP(bf16, WS_PROJ1); const float* YD = WSP(float, WS_YD); bf16* Gb = WSP(bf16, WS_PD); const float* dd = INP(33);
    const int gt = F.bid * NTHREADS + F.tid, NGT = F.G * NTHREADS;
    for (int idx = gt; idx < TL * 256; idx += NGT) { const int r = idx >> 8, c = (idx & 255) * 4;
        const v2u uw = *(const v2u*)(PJ + (size_t)r * 4096 + 3072 + c); const f32x4 d4 = *(const f32x4*)(dd + c);
        const f32x4 y0 = *(const f32x4*)(YD + (size_t)r * 1024 + c), y1 = *(const f32x4*)(YD + ((size_t)TL + r) * 1024 + c);
        const f32x4 y = {bflo(uw.x) * d4.x + y0.x + y1.x, bfhi(uw.x) * d4.y + y0.y + y1.y, bflo(uw.y) * d4.z + y0.z + y1.z, bfhi(uw.y) * d4.w + y0.w + y1.w};
        st_bf4(Gb + (size_t)r * 1024 + c, (f32x4){gelu_tanh(y.x), gelu_tanh(y.y), gelu_tanh(y.z), gelu_tanh(y.w)}); }
}

__device__ __forceinline__ f32x2 cmulf(f32x2 a, f32x2 b) { return (f32x2){a.x * b.x - a.y * b.y, a.x * b.y + a.y * b.x}; }
__device__ __forceinline__ int drev14(int p) { const unsigned r = __builtin_bitreverse32((unsigned)p) >> 18; return (int)(((r & 0x2AAAu) >> 1) | ((r & 0x1555u) << 1)); }
__device__ __forceinline__ void fft_fwd(LAS f32x2* X, const f32x2* tw, int tid) {
#pragma nounroll
    for (int L = 4096; L >= 1; L >>= 2) {
        const int tws = 4096 / L;
#pragma unroll 2
        for (int i = 0; i < 8; ++i) {
            const int b = tid + NTHREADS * i, j = b & (L - 1), i0 = (b - j) * 4 + j;
            const f32x2 x0 = X[i0], x1 = X[i0 + L], x2 = X[i0 + 2 * L], x3 = X[i0 + 3 * L];
            const f32x2 w1 = tw[j * tws], w2 = cmulf(w1, w1), w3 = cmulf(w2, w1);
            const f32x2 a = x0 + x2, bb = x0 - x2, c = x1 + x3, d = x1 - x3;
            const f32x2 t1 = {bb.x + d.y, bb.y - d.x}, t3 = {bb.x - d.y, bb.y + d.x};
            X[i0] = a + c; X[i0 + L] = cmulf(t1, w1); X[i0 + 2 * L] = cmulf(a - c, w2); X[i0 + 3 * L] = cmulf(t3, w3);
        }
        __syncthreads();
    }
}
__device__ __forceinline__ void fft_inv(LAS f32x2* X, const f32x2* tw, int tid) {
#pragma nounroll
    for (int L = 1; L <= 4096; L <<= 2) {
        const int tws = 4096 / L;
#pragma unroll 2
        for (int i = 0; i < 8; ++i) {
            const int b = tid + NTHREADS * i, j = b & (L - 1), i0 = (b - j) * 4 + j;
            f32x2 w1 = tw[j * tws]; w1.y = -w1.y; const f32x2 w2 = cmulf(w1, w1), w3 = cmulf(w2, w1);
            const f32x2 x0 = X[i0], x1 = cmulf(X[i0 + L], w1), x2 = cmulf(X[i0 + 2 * L], w2), x3 = cmulf(X[i0 + 3 * L], w3);
            const f32x2 a = x0 + x2, bb = x0 - x2, c = x1 + x3, d = x1 - x3;
            X[i0] = a + c; X[i0 + L] = (f32x2){bb.x - d.y, bb.y + d.x}; X[i0 + 2 * L] = a - c; X[i0 + 3 * L] = (f32x2){bb.x + d.y, bb.y - d.x};
        }
        __syncthreads();
    }
}
__device__ __forceinline__ void fft_pointwise(LAS f32x2* X, const f32x2* Wg, int o, float scale, int tid) {
    const float hs = 0.5f * scale;
#pragma unroll 4
    for (int i = 0; i < 32; ++i) {
        const int p = tid + NTHREADS * i, f = drev14(p), pm = drev14((16384 - f) & 16383);
        const unsigned long long ua = __hip_atomic_load((const unsigned long long*)(Wg + p), __ATOMIC_RELAXED, __HIP_MEMORY_SCOPE_AGENT);
        const unsigned long long ub = __hip_atomic_load((const unsigned long long*)(Wg + pm), __ATOMIC_RELAXED, __HIP_MEMORY_SCOPE_AGENT);
        const f32x2 A = __builtin_bit_cast(f32x2, ua), B = __builtin_bit_cast(f32x2, ub);
        f32x2 K;
        if (o == 0) K = (f32x2){(A.x + B.x) * hs, (A.y - B.y) * hs};
        else { const f32x2 dd = {A.x - B.x, A.y + B.y}; K = (f32x2){dd.y * hs, -dd.x * hs}; }
        X[p] = cmulf(X[p], K);
    }
    __syncthreads();
}
__device__ __forceinline__ void hyena_fft_phase(Frame& F) {
    float* GT = WSP(float, WS_GT); const float* kT = WSP(float, WS_KT); const float* invn = WSP(float, WS_INVN); const f32x2* tw = WSP(f32x2, WS_TW);
    f32x2* Wg = WSP(f32x2, WS_FFTW) + (size_t)F.bid * 16384;
    const float* hyb = INP(25);
    LAS f32x2* X = (LAS f32x2*)F.lds;
    const int tid = F.tid;
    for (int ch = F.bid; ch < 1024; ch += F.G) {
        { const float* f0 = kT + (size_t)ch * SEQ; const float* b0 = kT + (size_t)(1024 + ch) * SEQ; const float* f1 = kT + (size_t)(2048 + ch) * SEQ; const float* b1 = kT + (size_t)(3072 + ch) * SEQ;
          for (int n = tid; n < SEQ; n += NTHREADS) { X[n] = (f32x2){f0[n], f1[n]}; X[SEQ + n] = (n == 0) ? (f32x2){0.f, 0.f} : (f32x2){b0[SEQ - n], b1[SEQ - n]}; } }
        __syncthreads();
        fft_fwd(X, tw, tid);
        for (int n = tid; n < 16384; n += NTHREADS) Wg[n] = X[n];
        __syncthreads();
        float* v0 = GT + ((size_t)ch * 2) * SEQ;
        const float* x1 = GT + ((size_t)(1024 + ch) * 2) * SEQ; const float* x2 = GT + ((size_t)(2048 + ch) * 2) * SEQ;
        float z0[16], z1[16];
#pragma unroll
        for (int j = 0; j < 16; ++j) { const int n = tid + NTHREADS * j; z0[j] = v0[n]; z1[j] = v0[SEQ + n]; }
#pragma unroll
        for (int o = 0; o < 2; ++o) {
#pragma unroll
            for (int j = 0; j < 16; ++j) { const int n = tid + NTHREADS * j; X[n] = (f32x2){z0[j], z1[j]}; X[SEQ + n] = (f32x2){0.f, 0.f}; }
            __syncthreads();
            fft_fwd(X, tw, tid);
            fft_pointwise(X, Wg, o, invn[o * 1024 + ch] * (1.0f / 16384.0f), tid);
            fft_inv(X, tw, tid);
            const float bias = hyb[o * 1024 + ch]; const float* xg = (o == 0) ? x1 : x2;
#pragma unroll
            for (int j = 0; j < 16; ++j) { const int n = tid + NTHREADS * j; const f32x2 y = X[n]; z0[j] = xg[n] * (y.x + bias * z0[j]); z1[j] = xg[SEQ + n] * (y.y + bias * z1[j]); }
            __syncthreads();
        }
#pragma unroll
        for (int j = 0; j < 16; ++j) { const int n = tid + NTHREADS * j; v0[n] = z0[j]; v0[SEQ + n] = z1[j]; }
    }
}
__device__ __forceinline__ void hyena_out_transpose(Frame& F) {
    const float* GT = WSP(float, WS_GT); bf16* cat = WSP(bf16, WS_CAT);
    LAS float* scr = (LAS float*)(F.lds + F.wave * 16896);
    const int lane = F.lane;
    for (int it = F.gw; it < 2 * 128 * 16; it += F.NGW) {
        const int cbk = it & 15, tb = (it >> 4) & 127, b = it >> 11, t0 = tb * 64;
        for (int c = 0; c < 64; ++c) scr[c * 65 + lane] = GT[((size_t)(cbk * 64 + c) * 2 + b) * SEQ + t0 + lane];
        LDS_WAIT(); asm volatile("" ::: "memory");
        for (int tt = 0; tt < 64; ++tt) cat[((size_t)b * SEQ + t0 + tt) * 2048 + cbk * 64 + lane] = (bf16)f2bf(scr[lane * 65 + tt]);
        LDS_WAIT(); asm volatile("" ::: "memory");
    }
}

__device__ __forceinline__ int s5_row(int di, int b, int s) {
    return (s < CTX) ? TL + b * CTX + (di == 0 ? s : CTX - 1 - s) : b * SEQ + (di == 0 ? s - CTX : SEQ - 1 - (s - CTX));
}
template <bool OUTPUT>
__device__ __forceinline__ void s5_seg_phase(Frame& F) {
    const bf16* PJ = WSP(bf16, WS_PROJ1); float* YD = WSP(float, WS_YD);
    const f32x2* lamb = WSP(f32x2, WS_S5LAM); const f32x2* bbar = WSP(f32x2, WS_S5B); const f32x2* l256 = WSP(f32x2, WS_S5L256); f32x2* Eb = WSP(f32x2, WS_S5E);
    const float* cre = INP(31); const float* cim = INP(32);
    const int lane = F.lane;
    for (int task = F.wave * F.G + F.bid; task < 256 * 32; task += F.NGW) {
        const int dbg = task >> 5, seg = (task & 31) + (OUTPUT ? 1 : 0);
        const int di = dbg >> 7, b = (dbg >> 6) & 1, g = dbg & 63;
        const int dgp = (di * 64 + g) * 64 + lane;
        const f32x2 lam = lamb[dgp];
        float br[16], bi[16];
#pragma unroll
        for (int c = 0; c < 16; ++c) { const f32x2 bv = bbar[(size_t)dgp * 16 + c]; br[c] = bv.x; bi[c] = bv.y; }
        float cr[16], ci[16];
        if (OUTPUT) {
#pragma unroll
            for (int c = 0; c < 16; ++c) { cr[c] = cre[((size_t)(di * 64 + g) * 16 + c) * 64 + lane]; ci[c] = cim[((size_t)(di * 64 + g) * 16 + c) * 64 + lane]; }
        }
        float sr = 0.f, si = 0.f;
        if (OUTPUT) {
            const f32x2 l2 = l256[dgp]; const f32x2* ep = Eb + ((size_t)dbg * 32) * 64 + lane;
            for (int k = 0; k < seg; ++k) { const f32x2 e = ep[(size_t)k * 64]; const float nr = l2.x * sr - l2.y * si + e.x, ni = l2.x * si + l2.y * sr + e.y; sr = nr; si = ni; }
        }
        const int s0 = seg * 256;
#pragma nounroll
        for (int st = 0; st < 256; st += 4) {
            const int row = s5_row(di, b, s0 + st + (lane >> 4));
            const float uval = bf2f(PJ[(size_t)row * 4096 + 3072 + g * 16 + (lane & 15)]);
#pragma unroll
            for (int k = 0; k < 4; ++k) {
                float bur = 0.f, bui = 0.f;
#pragma unroll
                for (int c = 0; c < 16; ++c) { const float u = __builtin_bit_cast(float, __builtin_amdgcn_readlane(__builtin_bit_cast(int, uval), 16 * k + c)); bur += br[c] * u; bui += bi[c] * u; }
                const float nr = lam.x * sr - lam.y * si + bur, ni = lam.x * si + lam.y * sr + bui; sr = nr; si = ni;
                if (OUTPUT) {
                    float v8[8], v4[4], v2[2], v1;
                    const bool b5 = (lane & 32) != 0, b4 = (lane & 16) != 0, b3 = (lane & 8) != 0, b2 = (lane & 4) != 0;
#pragma unroll
                    for (int i = 0; i < 8; ++i) { const float lo = cr[i] * sr - ci[i] * si, hi = cr[i + 8] * sr - ci[i + 8] * si; const float keep = b5 ? hi : lo, send = b5 ? lo : hi; v8[i] = keep + __shfl_xor(send, 32); }
#pragma unroll
                    for (int i = 0; i < 4; ++i) { const float keep = b4 ? v8[i + 4] : v8[i], send = b4 ? v8[i] : v8[i + 4]; v4[i] = keep + __shfl_xor(send, 16); }
#pragma unroll
                    for (int i = 0; i < 2; ++i) { const float keep = b3 ? v4[i + 2] : v4[i], send = b3 ? v4[i] : v4[i + 2]; v2[i] = keep + __shfl_xor(send, 8); }
                    { const float keep = b2 ? v2[1] : v2[0], send = b2 ? v2[0] : v2[1]; v1 = keep + __shfl_xor(send, 4); }
                    v1 += __shfl_xor(v1, 2); v1 += __shfl_xor(v1, 1);
                    const int s = s0 + st + k, t = (di == 0) ? s - CTX : SEQ - 1 - (s - CTX);
                    if ((lane & 3) == 0) YD[((size_t)di * TL + (size_t)b * SEQ + t) * 1024 + g * 16 + (lane >> 2)] = v1;
                }
            }
        }
        if (!OUTPUT) Eb[((size_t)dbg * 32 + seg) * 64 + lane] = (f32x2){sr, si};
    }
}

typedef float f32x4_t __attribute__((ext_vector_type(4)));
template <bool OUTPUT>
__device__ __forceinline__ void s5_mfma_phase(Frame& F) {
    const bf16* PJ = WSP(bf16, WS_PROJ1); float* YD = WSP(float, WS_YD);
    const f32x2* lamb = WSP(f32x2, WS_S5LAM); const f32x2* bbar = WSP(f32x2, WS_S5B); const f32x2* l256 = WSP(f32x2, WS_S5L256); f32x2* Eb = WSP(f32x2, WS_S5E);
    const float* cre = INP(31); const float* cim = INP(32);
    const int lane = F.lane, fr = lane & 15, fq = lane >> 4;
    LAS unsigned* Xl = (LAS unsigned*)(F.lds + F.wave * 4608);
    for (int task = F.wave * F.G + F.bid; task < 256 * 32; task += F.NGW) {
        const int dbg = task >> 5, seg = (task & 31) + (OUTPUT ? 1 : 0);
        const int di = dbg >> 7, b = (dbg >> 6) & 1, g = dbg & 63;
        const int dg = di * 64 + g;
        f32x2 l1[4], l2[4], l3[4], l4[4];
        bf16x8 bfr[8];
#pragma unroll
        for (int t = 0; t < 4; ++t) { const int dgp = dg * 64 + 16 * t + fr; l1[t] = lamb[dgp]; l2[t] = cmulf(l1[t], l1[t]); l3[t] = cmulf(l2[t], l1[t]); l4[t] = cmulf(l2[t], l2[t]);
            v4u wre = {0u, 0u, 0u, 0u}, wim = {0u, 0u, 0u, 0u};
            if (fq < 2) { const f32x4* bp = (const f32x4*)(bbar + (size_t)dgp * 16 + 8 * fq); const f32x4 q0 = bp[0], q1 = bp[1], q2 = bp[2], q3 = bp[3];
                wre.x = cvt_pk_bf16(q0.x, q0.z); wre.y = cvt_pk_bf16(q1.x, q1.z); wre.z = cvt_pk_bf16(q2.x, q2.z); wre.w = cvt_pk_bf16(q3.x, q3.z);
                wim.x = cvt_pk_bf16(q0.y, q0.w); wim.y = cvt_pk_bf16(q1.y, q1.w); wim.z = cvt_pk_bf16(q2.y, q2.w); wim.w = cvt_pk_bf16(q3.y, q3.w); }
            bfr[t] = __builtin_bit_cast(bf16x8, wre); bfr[4 + t] = __builtin_bit_cast(bf16x8, wim); }
        bf16x8 cfr[4];
        if (OUTPUT) {
#pragma unroll
            for (int ks = 0; ks < 4; ++ks) { const size_t cb = ((size_t)dg * 16 + fr) * 64 + 16 * ks + 4 * fq; const f32x4 r4 = *(const f32x4*)(cre + cb), i4 = *(const f32x4*)(cim + cb);
                v4u w; w.x = cvt_pk_bf16(r4.x, -i4.x); w.y = cvt_pk_bf16(r4.y, -i4.y); w.z = cvt_pk_bf16(r4.z, -i4.z); w.w = cvt_pk_bf16(r4.w, -i4.w); cfr[ks] = __builtin_bit_cast(bf16x8, w); }
        }
        f32x2 st[4];
#pragma unroll
        for (int t = 0; t < 4; ++t) st[t] = (f32x2){0.f, 0.f};
        if (OUTPUT) {
#pragma unroll
            for (int t = 0; t < 4; ++t) { const f32x2 lq = l256[dg * 64 + 16 * t + fr]; const f32x2* ep = Eb + ((size_t)dbg * 32) * 64 + 16 * t + fr;
                for (int k = 0; k < seg; ++k) { const f32x2 e = ep[(size_t)k * 64]; st[t] = cmulf(lq, st[t]) + e; } }
        }
        const int s0 = seg * 256;
        v4u unext = {0u, 0u, 0u, 0u};
        if (fq < 2) unext = *(const v4u*)(PJ + (size_t)s5_row(di, b, s0 + fr) * 4096 + 3072 + g * 16 + 8 * fq);
#pragma nounroll
        for (int blk = 0; blk < 16; ++blk) {
            const bf16x8 ufr = __builtin_bit_cast(bf16x8, unext);
            if (blk + 1 < 16 && fq < 2) unext = *(const v4u*)(PJ + (size_t)s5_row(di, b, s0 + 16 * (blk + 1) + fr) * 4096 + 3072 + g * 16 + 8 * fq);
            f32x4 bu[8];
#pragma unroll
            for (int nt = 0; nt < 8; ++nt) bu[nt] = __builtin_amdgcn_mfma_f32_16x16x32_bf16(ufr, bfr[nt], (f32x4){0.f, 0.f, 0.f, 0.f}, 0, 0, 0);
            f32x2 xs[4][4];
#pragma unroll
            for (int t = 0; t < 4; ++t) {
                f32x2 x0 = {bu[t][0], bu[4 + t][0]}, x1 = cmulf(l1[t], x0) + (f32x2){bu[t][1], bu[4 + t][1]}, x2 = cmulf(l1[t], x1) + (f32x2){bu[t][2], bu[4 + t][2]}, x3 = cmulf(l1[t], x2) + (f32x2){bu[t][3], bu[4 + t][3]};
                f32x2 sin = st[t];
                f32x2 fin = x3 + cmulf(l4[t], (fq == 0) ? sin : (f32x2){0.f, 0.f});
#pragma unroll
                for (int rd = 1; rd < 4; ++rd) { const float vr = __shfl(fin.x, lane - 16), vi = __shfl(fin.y, lane - 16);
                    if (fq == rd) { sin = (f32x2){vr, vi}; fin = x3 + cmulf(l4[t], sin); } }
                xs[t][0] = x0 + cmulf(l1[t], sin); xs[t][1] = x1 + cmulf(l2[t], sin); xs[t][2] = x2 + cmulf(l3[t], sin); xs[t][3] = x3 + cmulf(l4[t], sin);
                st[t] = (f32x2){__shfl(xs[t][3].x, 48 + fr), __shfl(xs[t][3].y, 48 + fr)};
            }
            if (OUTPUT) {
#pragma unroll
                for (int t = 0; t < 4; ++t)
#pragma unroll
                    for (int r = 0; r < 4; ++r) Xl[(4 * fq + r) * 68 + 16 * t + fr] = cvt_pk_bf16(xs[t][r].x, xs[t][r].y);
                LDS_WAIT(); asm volatile("" ::: "memory");
                f32x4 y = {0.f, 0.f, 0.f, 0.f};
#pragma unroll
                for (int ks = 0; ks < 4; ++ks) { const bf16x8 xa = *(const LAS bf16x8*)(Xl + fr * 68 + 16 * ks + 4 * fq); y = __builtin_amdgcn_mfma_f32_16x16x32_bf16(xa, cfr[ks], y, 0, 0, 0); }
                LDS_WAIT(); asm volatile("" ::: "memory");
#pragma unroll
                for (int r = 0; r < 4; ++r) { const int s = s0 + 16 * blk + 4 * fq + r, tl = (di == 0) ? s - CTX : SEQ - 1 - (s - CTX);
                    YD[((size_t)di * TL + (size_t)b * SEQ + tl) * 1024 + g * 16 + fr] = y[r]; }
            }
        }
        if (!OUTPUT) { if (fq == 0) {
#pragma unroll
            for (int t = 0; t < 4; ++t) Eb[((size_t)dbg * 32 + seg) * 64 + 16 * t + fr] = st[t]; } }
    }
}

constexpr int NPHASES = 21;
#ifndef MK_SINGLE
#define MK_SINGLE 1
#endif

__device__ __forceinline__ unsigned long long launder_u64(unsigned long long v) {
    unsigned lo = (unsigned)v, hi = (unsigned)(v >> 32);
    asm volatile("" : "+v"(lo), "+v"(hi));
    lo = __builtin_amdgcn_readfirstlane(lo); hi = __builtin_amdgcn_readfirstlane(hi);
    return ((unsigned long long)hi << 32) | lo;
}
__device__ __forceinline__ const void* launder_ptr(const void* p) {
    unsigned long long v = (unsigned long long)p; unsigned lo = (unsigned)v, hi = (unsigned)(v >> 32);
    asm volatile("" : "+v"(lo), "+v"(hi));
    lo = __builtin_amdgcn_readfirstlane(lo); hi = __builtin_amdgcn_readfirstlane(hi);
    return (const void*)(((unsigned long long)hi << 32) | lo);
}
__device__ __forceinline__ void moe_blocks(Frame& F, int l, LAS int* bstart) {
    __syncthreads();
    if (F.tid == 0) { const unsigned* cnt = WSP(unsigned, WS_CTL) + CW_CNT + l * 64; int acc = 0;
        for (int e = 0; e < 64; ++e) { bstart[e] = acc; const int nb = ((int)cnt[e] + 255) >> 8; for (int j = 0; j < nb; ++j) bstart[65 + acc + j] = e; acc += nb; } bstart[64] = acc; }
    __syncthreads();
}

template <int PHSEL>
__global__ void __launch_bounds__(NTHREADS, 2) mk_fwd(Args args) {
    extern __shared__ __attribute__((aligned(16))) unsigned char lds_raw[];
    Frame F;
    F.lds = (LAS unsigned char*)lds_raw; F.ws = args.ws; F.kin = (const __attribute__((address_space(4))) unsigned long long*)__builtin_amdgcn_kernarg_segment_ptr();
    F.tid = threadIdx.x; F.lane = F.tid & 63; F.wave = __builtin_amdgcn_readfirstlane(F.tid >> 6); F.bid = blockIdx.x; F.G = gridDim.x;
    F.gw = F.bid * NWAVES + F.wave; F.NGW = F.G * NWAVES;
    volatile LAS unsigned* lctl = (volatile LAS unsigned*)(F.lds + LDS_CTL);
    LAS int* bstart = (LAS int*)(F.lds + LDS_CTL + 64);
    if (F.tid < 4) lctl[F.tid] = 0u;
    __syncthreads();
    const int lo = args.ph_lo, hi = args.ph_hi;
    XcdBarrier bar; bar.bar = WSP(unsigned, WS_CTL) + CW_BAR; bar.x = 0; bar.st = lctl;
    if (PHSEL < 0) bar = xcd_barrier_post(WSP(unsigned, WS_CTL) + CW_BAR, lctl);
#ifndef PH_MASK
#define PH_MASK 0xffffffffu
#endif
#define IN(k) (((PH_MASK >> (k)) & 1u) && (PHSEL < 0 || PHSEL == (k)))
#define INL(j) (((PH_MASK >> (6 + (j))) & 1u) && (PHSEL < 0 || (PHSEL == 6 + (j) && lo == pb + (j))))
#define PH_END(k) do { if (PHSEL < 0) xcd_barrier(bar); } while (0)
#ifndef PH_REPEAT
#define PH_REPEAT 0u
#endif
#define REP(k) for (int _rep = 0; _rep < (((PH_REPEAT >> (k)) & 1u) ? 2 : 1); ++_rep)
#define PH_BEGIN() do { F.ws = (unsigned char*)launder_ptr((const void*)F.ws); F.kin = (const __attribute__((address_space(4))) unsigned long long*)launder_u64((unsigned long long)F.kin); \
    { int _t = threadIdx.x; asm volatile("" : "+v"(_t)); F.tid = _t; F.lane = _t & 63; F.wave = __builtin_amdgcn_readfirstlane(_t >> 6); \
      int _b = blockIdx.x; asm volatile("" : "+v"(_b)); F.bid = __builtin_amdgcn_readfirstlane(_b); F.gw = F.bid * NWAVES + F.wave; } } while (0)
    LAS unsigned char* lds = F.lds;
    const int G = F.G, bid = F.bid;
    constexpr long T2048 = 256L * 2048 * 2;

    if (IN(0)) { PH_BEGIN(); REP(0) { p0_prologue(F); __syncthreads(); } PH_END(0); }
    if (IN(1)) { PH_BEGIN(); p1_reduce(F); PH_END(1); }
        if (IN(2)) { PH_BEGIN(); REP(2) norm_phase<0>(F, 0, nullptr); PH_END(2); }
        if (IN(3)) { PH_BEGIN(); REP(3) {
            { pg8::Gemm g{WSP(bf16, WS_HA), WSP(bf16, WS_WIN0), 2048, 2048, 2048}; pg8::StaticOrder S; S.init(TT / 256, 12, G, bid, T2048, 0, T2048);
              EpiQKP E{WSP(bf16, WS_Q), WSP(bf16, WS_K), WSP(bf16, WS_P), WSP(f32x2, WS_ROPE)}; pg8::gemm_phase<EpiQKP, pg8::StaticOrder, false>(lds, g, S, E); }
            { pg8::Gemm g{WSP(bf16, WS_WIN0) + (size_t)3072 * 2048, WSP(bf16, WS_HA), 2048, 2048, 2048}; pg8::StaticOrder S; S.init(4, TT / 256, G, bid, T2048, 0, T2048);
              EpiVT E{WSP(bf16, WS_VT)}; pg8::gemm_phase<EpiVT, pg8::StaticOrder, false>(lds, g, S, E); } }
            PH_END(3);
        }
        if (IN(4)) { PH_BEGIN(); REP(4) attn_phase(F); REP(21) poold_phase(F); PH_END(4); }
        if (IN(5)) { PH_BEGIN();
            pg8::Gemm g{WSP(bf16, WS_PD), WSP(bf16, WS_WPOOL), 1024, 256, 256}; pg8::StaticOrder S; S.init(TT / 256, 4, G, bid, 256L * 1024 * 2, 256L * 2, 256L * 256 * 2);
            EpiScaleBf16 E{WSP(bf16, WS_CAT), 2048, 1024, INP(14)}; pg8::gemm_phase<EpiScaleBf16, pg8::StaticOrder, false>(lds, g, S, E);
            PH_END(5);
        }
    {
    constexpr int pb = 6; constexpr int l = 0;
    if (INL(0)) { PH_BEGIN();
        float* xbuf = WSP(float, WS_X);
        pg8::Gemm g{WSP(bf16, WS_CAT), WSP(bf16, l == 0 ? WS_WOUT0 : WS_WOUT1), 2048, 2048, 2048}; pg8::StaticOrder S; S.init(l == 0 ? TT / 256 : TL / 256, 8, G, bid, T2048, 0, T2048);
        EpiRes E{l == 0 ? INP(0) : xbuf, l == 0 ? INP(2) : xbuf + (size_t)TL * 2048, xbuf, modp(F, l, 0, 2)}; pg8::gemm_phase<EpiRes, pg8::StaticOrder, false>(lds, g, S, E);
        PH_END(pb);
    }
    if (INL(1)) { PH_BEGIN(); ffn_norm_router_phase(F, l); PH_END(pb + 1); }
    if (INL(2)) { PH_BEGIN(); REP(8) {
        moe_blocks(F, l, bstart);
        pg8::Gemm g{WSP(bf16, WS_HA), (const bf16*)(F.ws + WS_WMOE + (size_t)l * MOE_L_BYTES), 2048, 2048, 2048};
        MoeOrder S{bstart, WSP(unsigned, WS_CTL) + CW_CNT + l * 64, WSP(int, WS_TOKL), 4, G, bid, bstart[64], T2048, 0, true};
        EpiMoeUp E{WSP(bf16, WS_H)}; pg8::gemm_phase<EpiMoeUp, MoeOrder, true>(lds, g, S, E); }
        PH_END(pb + 2);
    }
    if (INL(3)) { PH_BEGIN(); REP(9) {
        moe_blocks(F, l, bstart);
        pg8::Gemm g{WSP(bf16, WS_H), (const bf16*)(F.ws + WS_WMOE + (size_t)l * MOE_L_BYTES), 512, 512, 512};
        MoeOrder S{bstart, WSP(unsigned, WS_CTL) + CW_CNT + l * 64, WSP(int, WS_TOKL), 8, G, bid, bstart[64], 256L * 512 * 2, (long)(4 * MiB), false};
        EpiMoeDown E{WSP(bf16, WS_Y), WSP(int, WS_TOKL), WSP(float, WS_GATEL), WSP(unsigned, WS_CTL) + CW_CNT + l * 64}; pg8::gemm_phase<EpiMoeDown, MoeOrder, false>(lds, g, S, E); }
        PH_END(pb + 3);
    }
    }
        if (IN(10)) { PH_BEGIN(); norm_phase<2>(F, 1, nullptr); PH_END(10); }
        if (IN(11)) { PH_BEGIN(); REP(11) {
            pg8::Gemm g{WSP(bf16, WS_HA), WSP(bf16, WS_WIN1), 2048, 2048, 2048}; pg8::StaticOrder S; S.init(TT / 256, 16, G, bid, T2048, 0, T2048);
            EpiBf16 E{WSP(bf16, WS_PROJ1), 4096}; pg8::gemm_phase<EpiBf16, pg8::StaticOrder, false>(lds, g, S, E); }
            PH_END(11);
        }
        if (IN(12)) { PH_BEGIN(); REP(12) shortconv_phase(F); REP(22) s5_mfma_phase<false>(F); PH_END(12); }
        if (IN(13)) { PH_BEGIN(); REP(23) s5_mfma_phase<true>(F); __syncthreads(); REP(13) hyena_fft_phase(F); PH_END(13); }
        if (IN(14)) { PH_BEGIN(); REP(14) { s5_gelu_phase(F); hyena_out_transpose(F); } PH_END(14); }
        if (IN(15)) { PH_BEGIN();
            pg8::Gemm g{WSP(bf16, WS_PD), WSP(bf16, WS_WGLU), 1024, 1024, 1024}; pg8::StaticOrder S; S.init(TL / 256, 4, G, bid, 256L * 1024 * 2, 0, 256L * 1024 * 2);
            EpiGlu E{WSP(bf16, WS_CAT), 2048, 1024, WSP(bf16, WS_PD), INP(35)}; pg8::gemm_phase<EpiGlu, pg8::StaticOrder, false>(lds, g, S, E);
            PH_END(15);
        }
    {
    constexpr int pb = 16; constexpr int l = 1;
    if (INL(0)) { PH_BEGIN();
        float* xbuf = WSP(float, WS_X);
        pg8::Gemm g{WSP(bf16, WS_CAT), WSP(bf16, l == 0 ? WS_WOUT0 : WS_WOUT1), 2048, 2048, 2048}; pg8::StaticOrder S; S.init(l == 0 ? TT / 256 : TL / 256, 8, G, bid, T2048, 0, T2048);
        EpiRes E{l == 0 ? INP(0) : xbuf, l == 0 ? INP(2) : xbuf + (size_t)TL * 2048, xbuf, modp(F, l, 0, 2)}; pg8::gemm_phase<EpiRes, pg8::StaticOrder, false>(lds, g, S, E);
        PH_END(pb);
    }
    if (INL(1)) { PH_BEGIN(); ffn_norm_router_phase(F, l); PH_END(pb + 1); }
    if (INL(2)) { PH_BEGIN(); REP(8) {
        moe_blocks(F, l, bstart);
        pg8::Gemm g{WSP(bf16, WS_HA), (const bf16*)(F.ws + WS_WMOE + (size_t)l * MOE_L_BYTES), 2048, 2048, 2048};
        MoeOrder S{bstart, WSP(unsigned, WS_CTL) + CW_CNT + l * 64, WSP(int, WS_TOKL), 4, G, bid, bstart[64], T2048, 0, true};
        EpiMoeUp E{WSP(bf16, WS_H)}; pg8::gemm_phase<EpiMoeUp, MoeOrder, true>(lds, g, S, E); }
        PH_END(pb + 2);
    }
    if (INL(3)) { PH_BEGIN(); REP(9) {
        moe_blocks(F, l, bstart);
        pg8::Gemm g{WSP(bf16, WS_H), (const bf16*)(F.ws + WS_WMOE + (size_t)l * MOE_L_BYTES), 512, 512, 512};
        MoeOrder S{bstart, WSP(unsigned, WS_CTL) + CW_CNT + l * 64, WSP(int, WS_TOKL), 8, G, bid, bstart[64], 256L * 512 * 2, (long)(4 * MiB), false};
        EpiMoeDown E{WSP(bf16, WS_Y), WSP(int, WS_TOKL), WSP(float, WS_GATEL), WSP(unsigned, WS_CTL) + CW_CNT + l * 64}; pg8::gemm_phase<EpiMoeDown, MoeOrder, false>(lds, g, S, E); }
        PH_END(pb + 3);
    }
    }
    if (IN(20)) { PH_BEGIN(); norm_phase<3>(F, 1, args.out); }
#undef IN
#undef INL
#undef PH_END
}

typedef void (*kern_t)(Args);
template <int P> static void launch_phase(int grid, hipStream_t stream, Args a) { hipLaunchKernelGGL(mk_fwd<P>, dim3(grid), dim3(NTHREADS), LDS_BYTES, stream, a); }
template <int P> static bool prep_phase() { return hipFuncSetAttribute((const void*)mk_fwd<P>, hipFuncAttributeMaxDynamicSharedMemorySize, LDS_BYTES) == hipSuccess; }
extern "C" void kernel_launch(void* const* d_in, const int* in_sizes, int n_in, void* d_out, int out_size, void* d_ws, size_t ws_size, hipStream_t stream) {
    static int grid = 0;
    if (grid == 0) {
        if (n_in != 43 || out_size != TL * DM || ws_size < WS_END) { fprintf(stderr, "kernel_launch: unexpected shapes (n_in %d, out %d, ws %zu < %zu)\n", n_in, out_size, ws_size, (size_t)WS_END); grid = -1; return; }
        int dev = 0, cus = 0;
        if (hipGetDevice(&dev) != hipSuccess || hipDeviceGetAttribute(&cus, hipDeviceAttributeMultiprocessorCount, dev) != hipSuccess) { grid = -1; return; }
        bool ok = true;
#if MK_SINGLE
        ok = prep_phase<-1>();
#else
        ok = prep_phase<0>() && prep_phase<1>() && prep_phase<2>() && prep_phase<3>() && prep_phase<4>() && prep_phase<5>() && prep_phase<6>() && prep_phase<7>() && prep_phase<8>() && prep_phase<9>() &&
             prep_phase<10>() && prep_phase<11>() && prep_phase<12>() && prep_phase<13>() && prep_phase<14>() && prep_phase<15>() && prep_phase<20>();
#endif
        if (!ok) { fprintf(stderr, "kernel_launch: hipFuncSetAttribute failed\n"); grid = -1; return; }
        (void)hipGetLastError();
        grid = cus;
    }
    if (grid < 0) return;
    (void)hipMemsetAsync((char*)d_ws + WS_CTL, 0, CTL_BYTES, stream);
    Args a{};
    for (int i = 0; i < 43; ++i) a.in[i] = (const float*)d_in[i];
    a.out = (float*)d_out; a.ws = (unsigned char*)d_ws;
#if MK_SINGLE
    a.ph_lo = 0; a.ph_hi = NPHASES;
    launch_phase<-1>(grid, stream, a);
#else
#define LP(k, P) a.ph_lo = (k); a.ph_hi = (k) + 1; launch_phase<P>(grid, stream, a);
    LP(0, 0) LP(1, 1) LP(2, 2) LP(3, 3) LP(4, 4) LP(5, 5) LP(6, 6) LP(7, 7) LP(8, 8) LP(9, 9) LP(10, 10) LP(11, 11) LP(12, 12) LP(13, 13) LP(14, 14) LP(15, 15)
    LP(16, 6) LP(17, 7) LP(18, 8) LP(19, 9) LP(20, 20)
#undef LP
#endif
}
```

```cpp
#include <hip/hip_runtime.h>
#include <cstdio>
#include <cstdint>
#include <cmath>

#define GAS __attribute__((address_space(1)))
#define LAS __attribute__((address_space(3)))
typedef unsigned short bf16;
typedef unsigned v4u __attribute__((ext_vector_type(4)));
typedef unsigned v2u __attribute__((ext_vector_type(2)));
typedef float f32x4 __attribute__((ext_vector_type(4)));
typedef float f32x2 __attribute__((ext_vector_type(2)));
typedef float f32x16 __attribute__((ext_vector_type(16)));
typedef short bf16x8 __attribute__((ext_vector_type(8)));
#define LDS_WAIT() asm volatile("s_waitcnt lgkmcnt(0)" ::: "memory")
#define VM_WAIT() asm volatile("s_waitcnt vmcnt(0)" ::: "memory")

__device__ __forceinline__ unsigned f2bf(float f) { unsigned u = __builtin_bit_cast(unsigned, f); return (u + 0x7fffu + ((u >> 16) & 1u)) >> 16; }
__device__ __forceinline__ unsigned pk2(float lo, float hi) { return f2bf(lo) | (f2bf(hi) << 16); }
__device__ __forceinline__ unsigned cvt_pk_bf16(float lo, float hi) { unsigned r; asm volatile("v_cvt_pk_bf16_f32 %0, %1, %2" : "=v"(r) : "v"(lo), "v"(hi)); return r; }
__device__ __forceinline__ float bf2f(unsigned short b) { return __builtin_bit_cast(float, (unsigned)b << 16); }
__device__ __forceinline__ float bflo(unsigned w) { return __builtin_bit_cast(float, w << 16); }
__device__ __forceinline__ float bfhi(unsigned w) { return __builtin_bit_cast(float, w & 0xffff0000u); }
__device__ __forceinline__ float wave_sum(float v) {
#pragma unroll
    for (int o = 1; o < 64; o <<= 1) v += __shfl_xor(v, o);
    return v;
}

namespace pg8 {
typedef unsigned short bf16_t;
constexpr int BM = 256, BK = 64, HALF = 128, HTB = HALF * BK * 2, STAGE_BYTES = 8 * HTB;

__host__ __device__ __forceinline__ int lds_byte(int r, int c) { const int st = (r >> 4) * 2 + (c >> 5), rr = r & 15, cc = c & 31, ob = rr * 64 + cc * 2; return st * 1024 + (ob ^ (((ob >> 9) & 1) << 5)); }
__host__ __device__ __forceinline__ void stage_rc(int b, int& R, int& C) { const int st = b / 1024, sb = b % 1024, swz = sb ^ (((sb >> 9) & 1) << 5); R = (st >> 1) * 16 + swz / 64; C = (st & 1) * 32 + (swz % 64) / 2; }

struct Unit { int pm, pn; long aoff, boff; int e, idx0; };
struct Gemm { const bf16_t* A; const bf16_t* Bt; int lda, ldb, K; };

template <class Epi, class Sched, bool GATHER>
__device__ __forceinline__ void gemm_phase(LAS unsigned char* lds, const Gemm g, const Sched& S, const Epi& E) {
    const int tid = threadIdx.x, wid = __builtin_amdgcn_readfirstlane(tid >> 6), lane = tid & 63, wr = wid >> 2, wc = wid & 3, fr = lane & 15, fq = lane >> 4;
    const int K = g.K, nt = K / BK;
    unsigned voffA[2], voffB[2];
#pragma unroll
    for (int i = 0; i < 2; ++i) { int R, C; stage_rc(tid * 16 + i * 8192, R, C);
        voffA[i] = (unsigned)(R * g.lda + C) * 2u; voffB[i] = (unsigned)(R * g.ldb + C) * 2u; }
    const size_t kstep = (size_t)(BK * 2);
    const size_t hstepA = GATHER ? 0 : (size_t)HALF * g.lda * 2, hstepB = (size_t)HALF * g.ldb * 2;
    const unsigned ldsw = (unsigned)wid * 1024u;
    const int aoff = lds_byte(wr * 64 + fr, fq * 8), boff = lds_byte(wc * 32 + fr, fq * 8);
#define PG8_SA(b, h) (((b) * 2 + (h)) * HTB)
#define PG8_SB(b, h) ((4 + (b) * 2 + (h)) * HTB)
#define PG8_STAGE(bufoff, gbase, voff) do { _Pragma("unroll") for (int _i = 0; _i < 2; ++_i) \
        __builtin_amdgcn_global_load_lds((const unsigned*)((const char*)(gbase) + (voff)[_i]), (LAS unsigned*)(lds + (bufoff) + ldsw + _i * 8192), 16, 0, 0); } while (0)
#define PG8_STAGE_A(bufoff, gbase, h, nx) do { if constexpr (GATHER) { unsigned _tv[2]; \
        if (nx) { int _tz = tid; asm volatile("" : "+v"(_tz)); _Pragma("unroll") for (int _j = 0; _j < 2; ++_j) { int _R, _C; stage_rc(_tz * 16 + _j * 8192, _R, _C); _tv[_j] = (unsigned)S.arow(nxt, (h) * HALF + _R) * (unsigned)(g.lda * 2) + (unsigned)(_C * 2); } } \
        else { _tv[0] = gvc[h][0]; _tv[1] = gvc[h][1]; } \
        PG8_STAGE(bufoff, gbase, _tv); } else { PG8_STAGE(bufoff, (gbase) + (h) * hstepA, voffA); } } while (0)
#define PG8_LDA(dst, b, h) do { _Pragma("unroll") for (int m = 0; m < 4; ++m) _Pragma("unroll") for (int k = 0; k < 2; ++k) dst[m][k] = *(const LAS bf16x8*)(lds + PG8_SA(b, h) + aoff + m * 2048 + k * 1024); } while (0)
#define PG8_LDB(dst, b, h) do { _Pragma("unroll") for (int n = 0; n < 2; ++n) _Pragma("unroll") for (int k = 0; k < 2; ++k) dst[n][k] = *(const LAS bf16x8*)(lds + PG8_SB(b, h) + boff + n * 2048 + k * 1024); } while (0)
#define PG8_MMA(ai, bj, At, Bt) do { __builtin_amdgcn_s_setprio(1); _Pragma("unroll") for (int m = 0; m < 4; ++m) _Pragma("unroll") for (int n = 0; n < 2; ++n) _Pragma("unroll") for (int k = 0; k < 2; ++k) \
        acc[ai][bj][m][n] = __builtin_amdgcn_mfma_f32_16x16x32_bf16(Bt[n][k], At[m][k], acc[ai][bj][m][n], 0, 0, 0); __builtin_amdgcn_s_setprio(0); } while (0)
#define PG8_WAIT_V(n) asm volatile("s_waitcnt vmcnt(" #n ")" ::: "memory")
#define PG8_WAIT_L(n) asm volatile("s_waitcnt lgkmcnt(" #n ")" ::: "memory")
#define PG8_BAR __builtin_amdgcn_s_barrier()
#define PG8_SCHED __builtin_amdgcn_sched_barrier(0)
    Unit cur, nxt; int ui = 0;
    if (!S.next(0, cur)) return;
    unsigned gvc[2][2];
#define PG8_GV(unit) do { if constexpr (GATHER) { int _tz = tid; asm volatile("" : "+v"(_tz)); _Pragma("unroll") for (int _h = 0; _h < 2; ++_h) _Pragma("unroll") for (int _j = 0; _j < 2; ++_j) { int _R, _C; stage_rc(_tz * 16 + _j * 8192, _R, _C); \
        gvc[_h][_j] = (unsigned)S.arow(unit, _h * HALF + _R) * (unsigned)(g.lda * 2) + (unsigned)(_C * 2); } } } while (0)
    PG8_GV(cur);
    f32x4 acc[2][2][4][2];
#pragma unroll
    for (int a = 0; a < 2; ++a)
#pragma unroll
        for (int b = 0; b < 2; ++b)
#pragma unroll
            for (int m = 0; m < 4; ++m)
#pragma unroll
                for (int n = 0; n < 2; ++n) acc[a][b][m][n] = (f32x4){0.f, 0.f, 0.f, 0.f};
    bf16x8 At[4][2], B0[2][2], B1[2][2];
    const char* cA = (const char*)g.A + cur.aoff; const char* cB = (const char*)g.Bt + cur.boff;
    PG8_STAGE(PG8_SB(0, 0), cB, voffB); PG8_STAGE(PG8_SB(0, 1), cB + hstepB, voffB); PG8_STAGE_A(PG8_SA(0, 0), cA, 0, false); PG8_STAGE_A(PG8_SA(0, 1), cA, 1, false);
    if (wr == 1) PG8_BAR;
    PG8_WAIT_V(2); PG8_BAR;
    PG8_STAGE(PG8_SB(1, 0), cB + kstep, voffB); PG8_STAGE_A(PG8_SA(1, 0), cA + kstep, 0, false); PG8_STAGE(PG8_SB(1, 1), cB + hstepB + kstep, voffB);
    PG8_WAIT_V(6); PG8_BAR;
    for (;;) {
        const bool has_next = S.next(ui + 1, nxt);
        const char* nA = has_next ? (const char*)g.A + nxt.aoff : cA; const char* nB = has_next ? (const char*)g.Bt + nxt.boff : cB;
#pragma nounroll
        for (int t = 0; t < nt; t += 2) {
            const bool last = (t == nt - 2);
            const char* a1 = cA + (size_t)(t + 1) * kstep;
            const char* a2 = last ? nA : cA + (size_t)(t + 2) * kstep; const char* b2 = last ? nB : cB + (size_t)(t + 2) * kstep;
            const char* a3 = a2 + kstep; const char* b3 = b2 + kstep;
            PG8_LDB(B0, 0, 0); PG8_LDB(B1, 0, 1); PG8_SCHED; PG8_LDA(At, 0, 0); PG8_STAGE_A(PG8_SA(1, 1), a1, 1, false);
            PG8_WAIT_V(8); PG8_WAIT_L(0); PG8_BAR; PG8_MMA(0, 0, At, B0); PG8_MMA(0, 1, At, B1); PG8_BAR; PG8_SCHED;
            PG8_LDA(At, 0, 1); PG8_STAGE(PG8_SB(0, 0), b2, voffB); PG8_STAGE(PG8_SB(0, 1), b2 + hstepB, voffB); PG8_STAGE_A(PG8_SA(0, 0), a2, 0, last);
            PG8_WAIT_V(8); PG8_WAIT_L(0); PG8_BAR; PG8_MMA(1, 0, At, B0); PG8_MMA(1, 1, At, B1); PG8_BAR; PG8_SCHED;
            PG8_LDB(B0, 1, 0); PG8_LDB(B1, 1, 1); PG8_SCHED; PG8_LDA(At, 1, 0); PG8_STAGE_A(PG8_SA(0, 1), a2, 1, last);
            PG8_WAIT_V(8); PG8_WAIT_L(0); PG8_BAR; PG8_MMA(0, 0, At, B0); PG8_MMA(0, 1, At, B1); PG8_BAR; PG8_SCHED;
            PG8_LDA(At, 1, 1); PG8_STAGE(PG8_SB(1, 0), b3, voffB); PG8_STAGE(PG8_SB(1, 1), b3 + hstepB, voffB); PG8_STAGE_A(PG8_SA(1, 0), a3, 0, last);
            PG8_WAIT_V(8); PG8_WAIT_L(0); PG8_BAR; PG8_MMA(1, 0, At, B0); PG8_MMA(1, 1, At, B1); PG8_BAR; PG8_SCHED;
        }
        if (wr == 0) PG8_BAR;
        E(acc, cur, wr, wc, fr, fq);
        if (!has_next) break;
#pragma unroll
        for (int a = 0; a < 2; ++a)
#pragma unroll
            for (int b = 0; b < 2; ++b)
#pragma unroll
                for (int m = 0; m < 4; ++m)
#pragma unroll
                    for (int n = 0; n < 2; ++n) acc[a][b][m][n] = (f32x4){0.f, 0.f, 0.f, 0.f};
        cur = nxt; cA = nA; cB = nB; ++ui;
        PG8_GV(cur);
        if (wr == 1) PG8_BAR;
    }
    PG8_WAIT_V(0);
    PG8_BAR;
#undef PG8_SA
#undef PG8_SB
#undef PG8_STAGE
#undef PG8_STAGE_A
#undef PG8_GV
#undef PG8_LDA
#undef PG8_LDB
#undef PG8_MMA
#undef PG8_WAIT_V
#undef PG8_WAIT_L
#undef PG8_BAR
#undef PG8_SCHED
}

struct StaticOrder {
    int nM, nN, nwg, G, c; long astride, apn, bstride;
    __device__ void init(int nM_, int nN_, int G_, int c_, long astride_, long apn_, long bstride_) { nM = nM_; nN = nN_; nwg = nM * nN; G = G_; c = c_; astride = astride_; apn = apn_; bstride = bstride_; }
    __device__ bool next(int i, Unit& u) const {
        const long Lx = (long)i * G + c; if (Lx >= nwg) return false;
        int wgid = (int)Lx; { const int q = nwg / 8, r = nwg % 8, xcd = wgid % 8, off = wgid / 8; wgid = (xcd < r ? xcd * (q + 1) : r * (q + 1) + (xcd - r) * q) + off; }
        const int nig = 8 * nN, gid = wgid / nig, fm = gid * 8, gsz = (nM - fm) < 8 ? (nM - fm) : 8;
        u.pm = fm + ((wgid % nig) % gsz); u.pn = (wgid % nig) / gsz; u.aoff = (long)u.pm * astride + (long)u.pn * apn; u.boff = (long)u.pn * bstride; u.e = 0; u.idx0 = 0; return true;
    }
    __device__ int arow(const Unit&, int) const { return 0; }
};
}

constexpr int DM = 2048, NBATCH = 2, SEQ = 8192, CTX = 256;
constexpr int TL = NBATCH * SEQ;
constexpr int TC = NBATCH * CTX;
constexpr int TT = TL + TC;
constexpr int KEYS = CTX + SEQ;
constexpr int NEXP = 64, DEXP = 512;
constexpr int LISTCAP = 2 * TT;
constexpr float EPS = 1e-6f;
constexpr float QSCALE = 0.125f * 1.4426950408889634f;
constexpr int NWAVES = 8, NTHREADS = 512;

constexpr size_t MiB = 1u << 20;
constexpr size_t WS_CTL = 0, CTL_BYTES = 1 * MiB;
constexpr size_t WS_WIN0 = 1 * MiB;
constexpr size_t WS_WOUT0 = WS_WIN0 + 16 * MiB;
constexpr size_t WS_WIN1 = WS_WOUT0 + 8 * MiB;
constexpr size_t WS_WOUT1 = WS_WIN1 + 16 * MiB;
constexpr size_t WS_WPOOL = WS_WOUT1 + 8 * MiB;
constexpr size_t WS_WGLU = WS_WPOOL + 1 * MiB;
constexpr size_t WS_WMOE = WS_WGLU + 2 * MiB;
constexpr size_t MOE_E_BYTES = 6 * MiB, MOE_L_BYTES = 64 * MOE_E_BYTES;
constexpr size_t WS_X = WS_WMOE + 2 * MOE_L_BYTES;
constexpr size_t WS_HA = WS_X + 132 * MiB;
constexpr size_t WS_Q = WS_HA + 67 * MiB;
constexpr size_t WS_K = WS_Q + 33 * MiB;
constexpr size_t WS_VT = WS_K + 33 * MiB;
constexpr size_t WS_P = WS_VT + 33 * MiB;
constexpr size_t WS_PROJ1 = WS_Q;
constexpr size_t WS_CAT = WS_P + 33 * MiB;
constexpr size_t WS_PD = WS_CAT + 66 * MiB;
constexpr size_t WS_H = WS_PD + 33 * MiB;
constexpr size_t WS_Y = WS_H + 49 * MiB;
constexpr size_t WS_GT = WS_Y + 132 * MiB;
constexpr size_t WS_KT = WS_GT + 192 * MiB;
constexpr size_t WS_YD = WS_KT + 128 * MiB;
constexpr size_t WS_MISC = WS_YD + 128 * MiB;
constexpr size_t WS_MOD = WS_MISC;
constexpr size_t WS_ADAP = WS_MOD + 1 * MiB;
constexpr size_t WS_ROPE = WS_ADAP + 10 * MiB;
constexpr size_t WS_NORMP = WS_ROPE + 1 * MiB;
constexpr size_t WS_INVN = WS_NORMP + 4 * MiB;
constexpr size_t WS_S5LAM = WS_INVN + 1 * MiB;
constexpr size_t WS_S5B = WS_S5LAM + 1 * MiB;
constexpr size_t WS_WRT = WS_S5B + 2 * MiB;
constexpr size_t WS_TOKL = WS_WRT + 2 * MiB;
constexpr size_t WS_GATEL = WS_TOKL + 9 * MiB;
constexpr size_t WS_TW = WS_GATEL + 9 * MiB;
constexpr size_t WS_FFTW = WS_TW + 1 * MiB;
constexpr size_t WS_S5L256 = WS_FFTW + 32 * MiB;
constexpr size_t WS_S5E = WS_S5L256 + 1 * MiB;
constexpr size_t WS_YHT = WS_S5E + 4 * MiB;
constexpr size_t WS_END = WS_YHT + 64 * MiB;
static_assert(WS_END <= 2040 * MiB, "d_ws map");
constexpr int CW_BAR = 1024;
constexpr int CW_CNT = 8192;

constexpr int LDS_PHASE = 131072;
constexpr int LDS_CTL = 147456 - 2048;
constexpr int LDS_BYTES = 147456;

#define XB_TMO      128
#define XB_XCNT(j)  (256  + 64 * (j))
#define XB_XSUB(j)  (1280 + 64 * (j))
#define XB_XGEN(j)  (2304 + 64 * (j))
#define XB_TOP      3328
#define XB_TOPGEN   3392
#define XCD_BAR_WORDS 3456
#define XB_SPIN_CAP (1u << 22)

__device__ __forceinline__ unsigned xb_ld(unsigned* p)              { return __hip_atomic_load(p, __ATOMIC_RELAXED, __HIP_MEMORY_SCOPE_AGENT); }
__device__ __forceinline__ unsigned xb_add(unsigned* p, unsigned v) { return __hip_atomic_fetch_add(p, v, __ATOMIC_RELAXED, __HIP_MEMORY_SCOPE_AGENT); }
__device__ __forceinline__ unsigned xb_xcc_id() { return (unsigned)__builtin_amdgcn_s_getreg((3 << 11) | 20) & 0xFu; }
#define XB_SPIN(cond, bar) do { unsigned _sp = 0; while (cond) { __builtin_amdgcn_s_sleep(1); \
    if ((++_sp & 255u) == 0u) { if (xb_ld(&(bar)[XB_TMO])) break; if (_sp > XB_SPIN_CAP) { atomicAdd(&(bar)[XB_TMO], 1u); break; } } } } while (0)

struct XcdBarrier { unsigned* bar; unsigned x; volatile LAS unsigned* st; };

__device__ __forceinline__ XcdBarrier xcd_barrier_post(unsigned* bar, volatile LAS unsigned* st) {
    XcdBarrier b; b.bar = bar; b.x = xb_xcc_id(); b.st = st;
    if (threadIdx.x == 0) (void)xb_add(&bar[XB_XCNT(b.x)], 1u);
    return b;
}
__device__ __forceinline__ void xcd_barrier_complete(unsigned* bar, unsigned x, unsigned& nloc, unsigned& nx) {
    const unsigned G = gridDim.x * gridDim.y * gridDim.z;
    unsigned sum, cnt, mine, sp = 0u;
    for (;;) {
        sum = 0u; cnt = 0u; mine = 0u;
#pragma unroll
        for (unsigned j = 0; j < 16; ++j) { const unsigned c = xb_ld(&bar[XB_XCNT(j)]); sum += c; cnt += (c > 0u) ? 1u : 0u; mine = (j == x) ? c : mine; }
        if (sum == G) break;
        __builtin_amdgcn_s_sleep(1);
        if ((++sp & 255u) == 0u) { if (xb_ld(&bar[XB_TMO])) break; if (sp > XB_SPIN_CAP) { atomicAdd(&bar[XB_TMO], 1u); break; } }
    }
    nloc = mine > 0u ? mine : 1u; nx = cnt > 0u ? cnt : 1u;
}
__device__ __forceinline__ void xcd_barrier(const XcdBarrier& b) {
    asm volatile("s_waitcnt vmcnt(0)" ::: "memory");
    __syncthreads();
    if (threadIdx.x == 0) {
        unsigned* bar = b.bar;
        __builtin_amdgcn_s_waitcnt(0);
        unsigned nloc = b.st[0], nx = b.st[1];
        if (nloc == 0u) { xcd_barrier_complete(bar, b.x, nloc, nx); b.st[0] = nloc; b.st[1] = nx; }
        const unsigned old = xb_add(&bar[XB_XSUB(b.x)], 1u);
        const unsigned gen = old / nloc;
        if (old + 1u == (gen + 1u) * nloc) {
            __builtin_amdgcn_fence(__ATOMIC_RELEASE, "agent");
            asm volatile("s_waitcnt vmcnt(0)" ::: "memory");
            const unsigned og = xb_add(&bar[XB_TOP], 1u);
            const unsigned tg = og / nx;
            if (og + 1u == (tg + 1u) * nx) xb_add(&bar[XB_TOPGEN], 1u);
            else XB_SPIN(xb_ld(&bar[XB_TOPGEN]) == tg, bar);
            __builtin_amdgcn_fence(__ATOMIC_ACQUIRE, "agent");
            xb_add(&bar[XB_XGEN(b.x)], 1u);
            asm volatile("s_waitcnt vmcnt(0)" ::: "memory");
        } else {
            XB_SPIN(xb_ld(&bar[XB_XGEN(b.x)]) == gen, bar);
            __builtin_amdgcn_fence(__ATOMIC_ACQUIRE, "agent");
            asm volatile("s_waitcnt vmcnt(0)" ::: "memory");
        }
    }
    __syncthreads();
}

__device__ __forceinline__ void sincos_2pi(double x, double& s, double& c) {
    const double q = __builtin_rint(x * 4.0);
    const double y = (x - q * 0.25) * 6.283185307179586476925;
    const double y2 = y * y;
    double sp = -7.6471637318198164759e-13; sp = sp * y2 + 1.6059043836821614599e-10; sp = sp * y2 - 2.5052108385441718775e-8; sp = sp * y2 + 2.7557319223985890653e-6;
    sp = sp * y2 - 1.9841269841269841270e-4; sp = sp * y2 + 8.3333333333333333333e-3; sp = sp * y2 - 1.6666666666666666667e-1; sp = sp * y2 * y + y;
    double cp = 4.7794773323873852974e-14; cp = cp * y2 - 1.1470745597729724714e-11; cp = cp * y2 + 2.0876756987868098979e-9; cp = cp * y2 - 2.7557319223985890653e-7;
    cp = cp * y2 + 2.4801587301587301587e-5; cp = cp * y2 - 1.3888888888888888889e-3; cp = cp * y2 + 4.1666666666666666667e-2; cp = cp * y2 - 0.5; cp = cp * y2 + 1.0;
    const int qi = ((int)q) & 3;
    s = (qi == 0) ? sp : (qi == 1) ? cp : (qi == 2) ? -sp : -cp;
    c = (qi == 0) ? cp : (qi == 1) ? -sp : (qi == 2) ? -cp : sp;
}
__device__ __forceinline__ void sincos_rad(double a, double& s, double& c) {
    double f = a * 0.15915494309189533576888; f -= __builtin_floor(f);
    if (f >= 1.0) f = 0.0;
    sincos_2pi(f, s, c);
}
__device__ __forceinline__ double exp_small(double x) {
    double r = 1.0 / 479001600.0;
    r = r * x + 1.0 / 39916800.0; r = r * x + 1.0 / 3628800.0; r = r * x + 1.0 / 362880.0; r = r * x + 1.0 / 40320.0; r = r * x + 1.0 / 5040.0;
    r = r * x + 1.0 / 720.0; r = r * x + 1.0 / 120.0; r = r * x + 1.0 / 24.0; r = r * x + 1.0 / 6.0; r = r * x + 0.5; r = r * x + 1.0; r = r * x + 1.0;
    return r;
}
__device__ __forceinline__ float fast_exp(float x) { return __builtin_amdgcn_exp2f(x * 1.4426950408889634f); }
__device__ __forceinline__ float sigmoidf_(float x) { return 1.0f / (1.0f + fast_exp(-x)); }
__device__ __forceinline__ float siluf_(float x) { return x * sigmoidf_(x); }
__device__ __forceinline__ float tanhf_(float x) { const float e = fast_exp(-2.0f * fabsf(x)); const float t = (1.0f - e) / (1.0f + e); return x < 0.f ? -t : t; }
__device__ __forceinline__ float gelu_tanh(float x) { return 0.5f * x * (1.0f + tanhf_(0.7978845608028654f * (x + 0.044715f * x * x * x))); }

#ifndef PH_REPEAT
#define PH_REPEAT 0u
#endif
struct Args { const float* in[43]; float* out; unsigned char* ws; int ph_lo, ph_hi; };

struct Frame {
    LAS unsigned char* lds; unsigned char* ws; int tid, lane, wave, bid, G, gw, NGW;
    const __attribute__((address_space(4))) unsigned long long* kin;
};
#define INP(i) ((const float*)F.kin[i])
#define WSP(T, off) ((T*)(F.ws + (off)))

__device__ __forceinline__ void tr_item(const float* W, int ldw, int N, bf16* WT, int ldt, int row_off, int rs16, LAS float* scr, int item, int lane) {
    const int nblk = N / 64, kb = item / nblk, nb = item % nblk, k0 = 64 * kb, n0 = 64 * nb;
    const int la = lane & 15, lb = lane >> 4;
    f32x4 v[16];
#pragma unroll
    for (int i = 0; i < 16; ++i) v[i] = *(const f32x4*)(W + (size_t)(k0 + 4 * i + lb) * ldw + n0 + 4 * la);
#pragma unroll
    for (int i = 0; i < 16; ++i) { const int kk = 4 * i + lb; LAS float* d = scr + (4 * la) * 65 + kk; d[0] = v[i].x; d[65] = v[i].y; d[130] = v[i].z; d[195] = v[i].w; }
    LDS_WAIT(); asm volatile("" ::: "memory");
    const int c = lane & 7;
#pragma unroll
    for (int j = 0; j < 8; ++j) { const int n = (lane >> 3) + 8 * j; const LAS float* s = scr + n * 65 + 8 * c;
        v4u o; o.x = cvt_pk_bf16(s[0], s[1]); o.y = cvt_pk_bf16(s[2], s[3]); o.z = cvt_pk_bf16(s[4], s[5]); o.w = cvt_pk_bf16(s[6], s[7]);
        const int nn = n0 + n, drow = row_off + (nn >> 4) * rs16 + (nn & 15);
        *(v4u*)(WT + (size_t)drow * ldt + k0 + 8 * c) = o; }
    LDS_WAIT(); asm volatile("" ::: "memory");
}

__device__ __forceinline__ void hyfilt_item(Frame& F, int pb) {
    const float* w1 = INP(19); const float* b1 = INP(20); const float* fq = INP(21); const float* w2 = INP(22); const float* b2 = INP(23); const float* w3 = INP(24);
    LAS float* z = (LAS float*)F.lds;
    LAS float* h1 = z + 1088;
    LAS float* h2 = h1 + 2048;
    const int tid = F.tid;
    for (int idx = tid; idx < 32 * 33; idx += NTHREADS) {
        const int p = idx / 33, f = idx % 33, i = pb * 32 + p;
        float v;
        if (f == 0) v = (float)i * (1.0f / (float)(SEQ - 1));
        else { const int j = (f - 1) & 15; const float fj = 1e-4f + (float)j * ((15.0f - 1e-4f) / 15.0f);
            double fr = (double)fj * (double)i / (double)SEQ; fr -= __builtin_floor(fr); double s, c; sincos_2pi(fr, s, c); v = (f <= 16) ? (float)c : (float)(-s); }
        z[p * 33 + f] = v;
    }
    __syncthreads();
    for (int idx = tid; idx < 2048; idx += NTHREADS) {
        const int p = idx >> 6, j = idx & 63; float a = b1[j];
        for (int f = 0; f < 33; ++f) a += z[p * 33 + f] * w1[f * 64 + j];
        double s, c; sincos_rad((double)(fq[j] * a), s, c); h1[idx] = (float)s;
    }
    __syncthreads();
    for (int idx = tid; idx < 2048; idx += NTHREADS) {
        const int p = idx >> 6, j = idx & 63; float a = b2[j];
        for (int k = 0; k < 64; ++k) a += h1[p * 64 + k] * w2[k * 64 + j];
        double s, c; sincos_rad((double)(fq[64 + j] * a), s, c); h2[idx] = (float)s;
    }
    __syncthreads();
    float* kT = WSP(float, WS_KT); float* normp = WSP(float, WS_NORMP);
    {
        const int lane = F.lane, l31 = lane & 31, lh = lane >> 5;
        float af[32];
#pragma unroll
        for (int s = 0; s < 32; ++s) af[s] = h2[l31 * 64 + 2 * s + lh];
        for (int ct = F.wave; ct < 128; ct += NWAVES) {
            const int col = ct * 32 + l31;
            f32x16 acc;
#pragma unroll
            for (int r = 0; r < 16; ++r) acc[r] = 0.f;
            float bv[32];
#pragma unroll
            for (int s = 0; s < 32; ++s) bv[s] = w3[(size_t)(2 * s + lh) * 4096 + col];
#pragma unroll
            for (int s = 0; s < 32; ++s) acc = __builtin_amdgcn_mfma_f32_32x32x2f32(af[s], bv[s], acc, 0, 0, 0);
            const int ch = col & 1023, dir = (col >> 10) & 1;
            const float adel = 3.0701134573253946f + (float)ch * ((15.350567286626972f - 3.0701134573253946f) / 1023.0f);
            float sabs = 0.f;
#pragma unroll
            for (int r = 0; r < 16; ++r) { const int i = pb * 32 + (r & 3) + 8 * (r >> 2) + 4 * lh; const float t = (float)i * (1.0f / (float)(SEQ - 1)); acc[r] *= fast_exp(-t * adel); if (!(dir == 1 && i == 0)) sabs += fabsf(acc[r]); }
            sabs += __shfl_xor(sabs, 32);
#pragma unroll
            for (int q = 0; q < 4; ++q) *(f32x4*)(kT + (size_t)col * SEQ + pb * 32 + 8 * q + 4 * lh) = (f32x4){acc[4 * q], acc[4 * q + 1], acc[4 * q + 2], acc[4 * q + 3]};
            if (lh == 0) normp[(size_t)pb * 4096 + col] = sabs;
        }
    }
    __syncthreads();
}

__device__ __forceinline__ void tr_wg_item(Frame& F, const float* W, int ldw, bf16* WT, int ldt, int row_off, int rs16, int k0, int n0) {
    LAS float* T = (LAS float*)F.lds;
    const int t = F.tid;
    f32x4 v[16];
#pragma unroll
    for (int i = 0; i < 16; ++i) v[i] = *(const f32x4*)(W + (size_t)(k0 + 4 * i + (t >> 7)) * ldw + n0 + 4 * (t & 127));
#pragma unroll
    for (int i = 0; i < 16; ++i) { const int k = 4 * i + (t >> 7); *(LAS f32x4*)(T + k * 516 + ((4 * (t & 127) + 8 * (k >> 3)) & 511)) = v[i]; }
    __syncthreads();
    const int c = (t >> 3) & 7, nl = (t & 7) | ((t >> 6) << 3);
#pragma unroll
    for (int q = 0; q < 8; ++q) { const int n = 64 * q + nl; const LAS float* s = T + (8 * c) * 516 + ((n + 8 * c) & 511);
        v4u o; o.x = cvt_pk_bf16(s[0], s[516]); o.y = cvt_pk_bf16(s[2 * 516], s[3 * 516]); o.z = cvt_pk_bf16(s[4 * 516], s[5 * 516]); o.w = cvt_pk_bf16(s[6 * 516], s[7 * 516]);
        const int nn = n0 + n, drow = row_off + (nn >> 4) * rs16 + (nn & 15);
        *(v4u*)(WT + (size_t)drow * ldt + k0 + 8 * c) = o; }
    __syncthreads();
}

__device__ __forceinline__ void p0_prologue(Frame& F) {
    for (int rep = 0; rep < (((PH_REPEAT >> 25) & 1u) ? 2 : 1); ++rep)
    for (int pb = F.bid; pb < SEQ / 32; pb += F.G) hyfilt_item(F, pb);
    for (int rep = 0; rep < (((PH_REPEAT >> 24) & 1u) ? 2 : 1); ++rep)
    for (int it = F.bid; it < 128 * 96; it += F.G) {
        const int le = it / 96, q = it % 96;
        bf16* wc = (bf16*)(F.ws + WS_WMOE + (size_t)le * MOE_E_BYTES); bf16* w2t = wc + 1024 * 2048;
        if (q < 32) tr_wg_item(F, INP(40) + (size_t)le * (2048 * 512), 512, wc, 2048, 0, 32, 64 * q, 0);
        else if (q < 64) tr_wg_item(F, INP(41) + (size_t)le * (2048 * 512), 512, wc, 2048, 16, 32, 64 * (q - 32), 0);
        else { const int r = q - 64; tr_wg_item(F, INP(42) + (size_t)le * (512 * 2048), 2048, w2t, 512, 0, 16, 64 * (r >> 2), 512 * (r & 3)); }
    }
    const int gt = F.bid * NTHREADS + F.tid, NGT = F.G * NTHREADS;
    {
        f32x2* rope = WSP(f32x2, WS_ROPE);
        for (int idx = gt; idx < 128 * 16; idx += NGT) { const int pos = idx >> 4, i = idx & 15;
            double inv = (i & 3) == 0 ? 1.0 : (i & 3) == 1 ? 0.56234132519034908 : (i & 3) == 2 ? 0.31622776601683794 : 0.17782794100389228;
            inv *= (i >> 2) == 0 ? 1.0 : (i >> 2) == 1 ? 0.1 : (i >> 2) == 2 ? 0.01 : 0.001;
            const float ang = (float)pos * (float)inv; double s, c; sincos_rad((double)ang, s, c); rope[idx] = (f32x2){(float)c, (float)s}; }
    }
    {
        f32x2* tw = WSP(f32x2, WS_TW);
        for (int idx = gt; idx < 16384; idx += NGT) { double s, c; sincos_2pi((double)idx * (1.0 / 16384.0), s, c); tw[idx] = (f32x2){(float)c, (float)(-s)}; }
    }
    {
        const float* are = INP(26); const float* aim = INP(27); const float* ldt = INP(28); const float* bre = INP(29); const float* bim = INP(30);
        f32x2* lamb = WSP(f32x2, WS_S5LAM); f32x2* bb = WSP(f32x2, WS_S5B); f32x2* l256 = WSP(f32x2, WS_S5L256);
        for (int idx = gt; idx < 2 * 64 * 64; idx += NGT) { const int dg = idx >> 6;
            const float dt = expf(ldt[dg]); const float ar = are[idx], ai = aim[idx];
            const float zr = ar * dt, zi = ai * dt; double s, c; sincos_rad((double)zi, s, c); const double er = exp_small((double)zr);
            const double lr = er * c, li = er * s; lamb[idx] = (f32x2){(float)lr, (float)li};
            { double pr = lr, pi = li; for (int q = 0; q < 8; ++q) { const double tr = pr * pr - pi * pi, ti = 2.0 * pr * pi; pr = tr; pi = ti; } l256[idx] = (f32x2){(float)pr, (float)pi}; }
            const double nr = lr - 1.0, ni = li, den = (double)ar * ar + (double)ai * ai; const double qr = (nr * ar + ni * ai) / den, qi = (ni * ar - nr * ai) / den;
            for (int cc = 0; cc < 16; ++cc) { const double br = bre[(size_t)idx * 16 + cc], bi = bim[(size_t)idx * 16 + cc]; bb[(size_t)idx * 16 + cc] = (f32x2){(float)(qr * br - qi * bi), (float)(qr * bi + qi * br)}; } }
    }
    {
        float* wrt = WSP(float, WS_WRT);
        for (int idx = gt; idx < 2 * 72 * 2048; idx += NGT) { const int l = idx / (72 * 2048), r = idx % (72 * 2048), n = r / 2048, k = r % 2048;
            wrt[idx] = n < 8 ? INP(36)[((size_t)l * 2048 + k) * 8 + n] : INP(38)[((size_t)l * 2048 + k) * 64 + (n - 8)]; }
    }
    {
        bf16* ha = WSP(bf16, WS_HA);
        for (int idx = gt; idx < 2048; idx += NGT) ha[(size_t)TT * 2048 + idx] = 0;
    }
    LAS float* scr = (LAS float*)(F.lds + F.wave * 16896);
    {
        const float* c = INP(1); const float* cctx = INP(3); const float* adaw = INP(4); float* part = WSP(float, WS_ADAP);
        for (int rep = 0; rep < (((PH_REPEAT >> 26) & 1u) ? 2 : 1); ++rep)
        for (int it = F.gw; it < 2 * 32 * 48; it += F.NGW) {
            const int l = it / (32 * 48), r = it % (32 * 48), ks = r / 48, jb = r % 48, k0 = ks * 64, j0 = jb * 256 + F.lane * 4;
            const float c0 = c[k0 + F.lane], c1 = c[2048 + k0 + F.lane], c2 = cctx[k0 + F.lane];
            const float s0 = c0 / (1.0f + expf(-c0)), s1 = c1 / (1.0f + expf(-c1)), s2 = c2 / (1.0f + expf(-c2));
            f32x4 a0 = {0.f, 0.f, 0.f, 0.f}, a1 = a0, a2 = a0;
            const float* wp = adaw + ((size_t)l * 2048 + k0) * 12288 + j0;
#pragma unroll 8
            for (int kk = 0; kk < 64; ++kk) { const f32x4 w = *(const f32x4*)(wp + (size_t)kk * 12288);
                const float t0 = __builtin_bit_cast(float, __builtin_amdgcn_readlane(__builtin_bit_cast(int, s0), kk));
                const float t1 = __builtin_bit_cast(float, __builtin_amdgcn_readlane(__builtin_bit_cast(int, s1), kk));
                const float t2 = __builtin_bit_cast(float, __builtin_amdgcn_readlane(__builtin_bit_cast(int, s2), kk));
                a0 += w * t0; a1 += w * t1; a2 += w * t2; }
            float* pp = part + ((size_t)(l * 32 + ks) * 3) * 12288 + j0;
            *(f32x4*)(pp) = a0; *(f32x4*)(pp + 12288) = a1; *(f32x4*)(pp + 2 * 12288) = a2;
        }
    }
    {
        constexpr int I0 = 1024, I1 = 512, I2 = 512, I3 = 1024, I4 = 2048, I5 = 1024, I6 = 64, I7 = 256, IE = 768;
        constexpr int NSMALL = I0 + I1 + I2 + I3 + I4 + I5 + I6 + I7;
        const int NITEMS = NSMALL;
        for (int rep = 0; rep < (((PH_REPEAT >> 27) & 1u) ? 2 : 1); ++rep)
        for (int it = F.gw; it < NITEMS; it += F.NGW) {
            int r = it;
            if (r < I0) { tr_item(INP(9), 4096, 2048, WSP(bf16, WS_WIN0), 2048, 0, 16, scr, r, F.lane); continue; } r -= I0;
            if (r < I1) { tr_item(INP(9) + 2048, 4096, 1024, WSP(bf16, WS_WIN0), 2048, 3072, 16, scr, r, F.lane); continue; } r -= I1;
            if (r < I2) { tr_item(INP(9) + 3072, 4096, 1024, WSP(bf16, WS_WIN0), 2048, 2048, 16, scr, r, F.lane); continue; } r -= I2;
            if (r < I3) { tr_item(INP(10), 2048, 2048, WSP(bf16, WS_WOUT0), 2048, 0, 16, scr, r, F.lane); continue; } r -= I3;
            if (r < I4) { tr_item(INP(15), 4096, 4096, WSP(bf16, WS_WIN1), 2048, 0, 16, scr, r, F.lane); continue; } r -= I4;
            if (r < I5) { tr_item(INP(16), 2048, 2048, WSP(bf16, WS_WOUT1), 2048, 0, 16, scr, r, F.lane); continue; } r -= I5;
            if (r < I6) { const int g = r / 16; tr_item(INP(13) + (size_t)g * 65536, 256, 256, WSP(bf16, WS_WPOOL), 256, g * 256, 16, scr, r % 16, F.lane); continue; } r -= I6;
            if (r < I7) { tr_item(INP(34), 1024, 1024, WSP(bf16, WS_WGLU), 1024, 0, 16, scr, r, F.lane); continue; } r -= I7;
        }
    }
}

__device__ __forceinline__ void p1_reduce(Frame& F) {
    const int gt = F.bid * NTHREADS + F.tid, NGT = F.G * NTHREADS;
    const float* part = WSP(float, WS_ADAP); float* mod = WSP(float, WS_MOD); const float* adab = INP(5);
    for (int idx = gt; idx < 2 * 3 * 12288; idx += NGT) { const int l = idx / (3 * 12288), r = idx % (3 * 12288), m = r / 12288, j = r % 12288;
        float a = adab[l * 12288 + j];
        for (int ks = 0; ks < 32; ++ks) a += part[((size_t)(l * 32 + ks) * 3 + m) * 12288 + j];
        mod[idx] = a; }
    const float* normp = WSP(float, WS_NORMP); float* invn = WSP(float, WS_INVN);
    for (int idx = gt; idx < 2048; idx += NGT) { const int o = idx >> 10, ch = idx & 1023; float a = 0.f;
        for (int pb = 0; pb < 256; ++pb) a += normp[(size_t)pb * 4096 + o * 2048 + ch] + normp[(size_t)pb * 4096 + o * 2048 + 1024 + ch];
        invn[idx] = 1.0f / a; }
}

__device__ __forceinline__ const float* modp(Frame& F, int l, int m, int c) { return WSP(float, WS_MOD) + ((size_t)(l * 3 + m) * 6 + c) * 2048; }
__device__ __forceinline__ int row_stream(int r) { return r < TL ? r / SEQ : 2; }

template <int MODE>
__device__ __forceinline__ void norm_phase(Frame& F, int l, float* dout) {
    const int nrows = (MODE == 3 || (MODE == 1 && l == 1)) ? TL : TT;
    float* xbuf = WSP(float, WS_X); bf16* ha = WSP(bf16, WS_HA); const bf16* Y = WSP(bf16, WS_Y);
    const float* gvec = (MODE == 0) ? INP(6) : (MODE == 1) ? INP(7) + l * 2048 : (MODE == 2) ? INP(6) + 2048 : INP(8);
    const int lane = F.lane;
    for (int r = F.gw; r < nrows; r += F.NGW) {
        const int m = row_stream(r);
        const float* src = (MODE == 0) ? (r < TL ? INP(0) + (size_t)r * 2048 : INP(2) + (size_t)(r - TL) * 2048) : xbuf + (size_t)r * 2048;
        f32x4 v[8]; float ss = 0.f;
#pragma unroll
        for (int j = 0; j < 8; ++j) v[j] = *(const f32x4*)(src + 4 * lane + 256 * j);
        if (MODE == 2 || MODE == 3) {
            const float* g2 = modp(F, MODE == 2 ? 0 : 1, m, 5);
            const bf16* y0 = Y + (size_t)(2 * r) * 2048; const bf16* y1 = y0 + 2048;
#pragma unroll
            for (int j = 0; j < 8; ++j) { const int c = 4 * lane + 256 * j; const v2u a = *(const v2u*)(y0 + c), b = *(const v2u*)(y1 + c); const f32x4 gg = *(const f32x4*)(g2 + c);
                v[j].x += gg.x * (bflo(a.x) + bflo(b.x)); v[j].y += gg.y * (bfhi(a.x) + bfhi(b.x)); v[j].z += gg.z * (bflo(a.y) + bflo(b.y)); v[j].w += gg.w * (bfhi(a.y) + bfhi(b.y)); }
            if (MODE == 2) {
#pragma unroll
                for (int j = 0; j < 8; ++j) *(f32x4*)(xbuf + (size_t)r * 2048 + 4 * lane + 256 * j) = v[j];
            }
        }
#pragma unroll
        for (int j = 0; j < 8; ++j) ss += (v[j].x * v[j].x + v[j].y * v[j].y) + (v[j].z * v[j].z + v[j].w * v[j].w);
        ss = wave_sum(ss);
        const float rs = 1.0f / sqrtf(ss * (1.0f / 2048.0f) + EPS);
        if (MODE == 3) {
#pragma unroll
            for (int j = 0; j < 8; ++j) { const int c = 4 * lane + 256 * j; const f32x4 gg = *(const f32x4*)(gvec + c); *(f32x4*)(dout + (size_t)r * 2048 + c) = v[j] * rs * gg; }
            continue;
        }
        const int lm = (MODE == 2) ? 1 : l;
        const float* sh = modp(F, lm, m, MODE == 1 ? 3 : 0); const float* sc = modp(F, lm, m, MODE == 1 ? 4 : 1);
#pragma unroll
        for (int j = 0; j < 8; ++j) { const int c = 4 * lane + 256 * j; const f32x4 gg = *(const f32x4*)(gvec + c), s1 = *(const f32x4*)(sc + c), s0 = *(const f32x4*)(sh + c);
            v[j] = (v[j] * rs * gg) * (1.0f + s1) + s0;
            v2u o; o.x = pk2(v[j].x, v[j].y); o.y = pk2(v[j].z, v[j].w); *(v2u*)(ha + (size_t)r * 2048 + c) = o; }
    }
}

__device__ __forceinline__ void ffn_norm_router_phase(Frame& F, int l) {
    const int nrows = (l == 1) ? TL : TT;
    const float* xbuf = WSP(float, WS_X); bf16* ha = WSP(bf16, WS_HA);
    const float* gvec = INP(7) + l * 2048;
    const float* wrt = WSP(float, WS_WRT) + (size_t)l * 72 * 2048;
    LAS float* lg = (LAS float*)(F.lds + F.wave * 2048);
    const int lane = F.lane;
    for (int r0 = F.gw * 4; r0 < nrows; r0 += F.NGW * 4) {
        f32x4 v[4][8];
#pragma unroll
        for (int rr = 0; rr < 4; ++rr) {
            const int r = r0 + rr, m = row_stream(r);
            const float* src = xbuf + (size_t)r * 2048; float ss = 0.f;
#pragma unroll
            for (int j = 0; j < 8; ++j) { v[rr][j] = *(const f32x4*)(src + 4 * lane + 256 * j); ss += (v[rr][j].x * v[rr][j].x + v[rr][j].y * v[rr][j].y) + (v[rr][j].z * v[rr][j].z + v[rr][j].w * v[rr][j].w); }
            ss = wave_sum(ss);
            const float rs = 1.0f / sqrtf(ss * (1.0f / 2048.0f) + EPS);
            const float* sh = modp(F, l, m, 3); const float* sc = modp(F, l, m, 4);
#pragma unroll
            for (int j = 0; j < 8; ++j) { const int c = 4 * lane + 256 * j; const f32x4 gg = *(const f32x4*)(gvec + c), s1 = *(const f32x4*)(sc + c), s0 = *(const f32x4*)(sh + c);
                v[rr][j] = (v[rr][j] * rs * gg) * (1.0f + s1) + s0;
                v2u o; o.x = pk2(v[rr][j].x, v[rr][j].y); o.y = pk2(v[rr][j].z, v[rr][j].w); *(v2u*)(ha + (size_t)r * 2048 + c) = o; }
        }
        const bool b5 = (lane & 32) != 0, b4 = (lane & 16) != 0, b3 = (lane & 8) != 0, b2 = (lane & 4) != 0, b1 = (lane & 2) != 0;
#pragma nounroll
        for (int q = 0; q < 9; ++q) {
            float a[32];
#pragma unroll
            for (int nn = 0; nn < 8; ++nn) { const float* wn = wrt + (size_t)(q * 8 + nn) * 2048 + 4 * lane; float s0 = 0.f, s1 = 0.f, s2 = 0.f, s3 = 0.f;
#pragma unroll
                for (int j = 0; j < 8; ++j) { const f32x4 w = *(const f32x4*)(wn + 256 * j);
                    s0 += (v[0][j].x * w.x + v[0][j].y * w.y) + (v[0][j].z * w.z + v[0][j].w * w.w); s1 += (v[1][j].x * w.x + v[1][j].y * w.y) + (v[1][j].z * w.z + v[1][j].w * w.w);
                    s2 += (v[2][j].x * w.x + v[2][j].y * w.y) + (v[2][j].z * w.z + v[2][j].w * w.w); s3 += (v[3][j].x * w.x + v[3][j].y * w.y) + (v[3][j].z * w.z + v[3][j].w * w.w); }
                a[nn] = s0; a[8 + nn] = s1; a[16 + nn] = s2; a[24 + nn] = s3; }
            float c16[16], c8[8], c4[4], c2[2], c1;
#pragma unroll
            for (int i = 0; i < 16; ++i) { const float keep = b5 ? a[i + 16] : a[i], send = b5 ? a[i] : a[i + 16]; c16[i] = keep + __shfl_xor(send, 32); }
#pragma unroll
            for (int i = 0; i < 8; ++i) { const float keep = b4 ? c16[i + 8] : c16[i], send = b4 ? c16[i] : c16[i + 8]; c8[i] = keep + __shfl_xor(send, 16); }
#pragma unroll
            for (int i = 0; i < 4; ++i) { const float keep = b3 ? c8[i + 4] : c8[i], send = b3 ? c8[i] : c8[i + 4]; c4[i] = keep + __shfl_xor(send, 8); }
#pragma unroll
            for (int i = 0; i < 2; ++i) { const float keep = b2 ? c4[i + 2] : c4[i], send = b2 ? c4[i] : c4[i + 2]; c2[i] = keep + __shfl_xor(send, 4); }
            { const float keep = b1 ? c2[1] : c2[0], send = b1 ? c2[0] : c2[1]; c1 = keep + __shfl_xor(send, 2); }
            c1 += __shfl_xor(c1, 1);
            if ((lane & 1) == 0) { const int i = lane >> 1; lg[(i >> 3) * 80 + q * 8 + (i & 7)] = c1; }
        }
        LDS_WAIT(); asm volatile("" ::: "memory");
        if (lane < 4) {
            const int r = r0 + lane; const LAS float* L = lg + lane * 80;
            float gl[8]; float gmax = -INFINITY; int gi = 0;
#pragma unroll
            for (int j = 0; j < 8; ++j) { gl[j] = L[j] + INP(37)[l * 8 + j]; if (gl[j] > gmax) { gmax = gl[j]; gi = j; } }
            float gsum = 0.f;
#pragma unroll
            for (int j = 0; j < 8; ++j) gsum += expf(gl[j] - gmax);
            const float pg_top = 1.0f / gsum;
            float pe[8]; float emax = -INFINITY;
#pragma unroll
            for (int j = 0; j < 8; ++j) { pe[j] = L[8 + gi * 8 + j] + INP(39)[l * 64 + gi * 8 + j]; emax = fmaxf(emax, pe[j]); }
            float esum = 0.f;
#pragma unroll
            for (int j = 0; j < 8; ++j) { pe[j] = expf(pe[j] - emax); esum += pe[j]; }
            int e1 = 0; float p1 = -1.f;
#pragma unroll
            for (int j = 0; j < 8; ++j) { pe[j] /= esum; if (pe[j] > p1) { p1 = pe[j]; e1 = j; } }
            int e2 = 0; float p2 = -1.f;
#pragma unroll
            for (int j = 0; j < 8; ++j) { if (j != e1 && pe[j] > p2) { p2 = pe[j]; e2 = j; } }
            const float den = p1 + p2; const float g1 = pg_top * p1 / den, g2 = pg_top * p2 / den;
            unsigned* cnt = WSP(unsigned, WS_CTL) + CW_CNT + l * 64; int* tokl = WSP(int, WS_TOKL); float* gatel = WSP(float, WS_GATEL);
            const int ex1 = gi * 8 + e1, ex2 = gi * 8 + e2;
            const unsigned k1 = atomicAdd(cnt + ex1, 1u); tokl[(size_t)ex1 * LISTCAP + k1] = 2 * r; gatel[(size_t)ex1 * LISTCAP + k1] = g1;
            const unsigned k2 = atomicAdd(cnt + ex2, 1u); tokl[(size_t)ex2 * LISTCAP + k2] = 2 * r + 1; gatel[(size_t)ex2 * LISTCAP + k2] = g2;
        }
        LDS_WAIT(); asm volatile("" ::: "memory");
    }
}

#define EPI_ARGS const f32x4 (&acc)[2][2][4][2], const pg8::Unit& u, int wr, int wc, int fr, int fq
__device__ __forceinline__ void st_bf4(bf16* p, f32x4 v) { v2u o; o.x = cvt_pk_bf16(v.x, v.y); o.y = cvt_pk_bf16(v.z, v.w); *(v2u*)p = o; }

struct EpiQKP {
    bf16* Q; bf16* Kb; bf16* P; const f32x2* rope;
    __device__ __forceinline__ void operator()(EPI_ARGS) const {
        const int sect = u.pn >> 2, cb = (u.pn & 3) * 256; const bool latent = u.pm < TL / 256;
#pragma unroll
        for (int ai = 0; ai < 2; ++ai)
#pragma unroll
            for (int m = 0; m < 4; ++m) {
                const int r = u.pm * 256 + ai * 128 + wr * 64 + m * 16 + fr;
                int b, t; if (latent) { b = r / SEQ; t = r % SEQ; } else { b = (r - TL) / CTX; t = (r - TL) % CTX; }
                f32x4 cs0 = {1.f, 0.f, 1.f, 0.f}, cs1 = cs0;
                if (latent && sect < 2) { const int pos = (wc & 1) ? (t & 63) : (t >> 6); const f32x4* rp = (const f32x4*)(rope + pos * 16 + 4 * fq); cs0 = rp[0]; cs1 = rp[1]; }
#pragma unroll
                for (int bj = 0; bj < 2; ++bj) {
                    const int c0 = cb + bj * 128 + wc * 32 + 4 * fq;
                    f32x4 a = acc[ai][bj][m][0], bb = acc[ai][bj][m][1];
                    if (sect < 2) {
                        const f32x4 co = {cs0.x, cs0.z, cs1.x, cs1.z}, si = {cs0.y, cs0.w, cs1.y, cs1.w};
                        const f32x4 oa = a * co - bb * si, ob = a * si + bb * co; a = oa; bb = ob;
                    }
                    if (sect == 0) { a = a * QSCALE; bb = bb * QSCALE; bf16* d = Q + (size_t)r * 1024 + c0; st_bf4(d, a); st_bf4(d + 16, bb); }
                    else if (sect == 1) { const size_t kr = (size_t)b * KEYS + (latent ? CTX + t : t); bf16* d = Kb + kr * 1024 + c0; st_bf4(d, a); st_bf4(d + 16, bb); }
                    else { bf16* d = P + (size_t)r * 1024 + c0; st_bf4(d, a); st_bf4(d + 16, bb); }
                }
            }
    }
};
struct EpiVT {
    bf16* VT;
    __device__ __forceinline__ void operator()(EPI_ARGS) const {
        const bool latent = u.pn < TL / 256; const int b = latent ? u.pn / 32 : u.pn - TL / 256; const int key_t0 = latent ? CTX + (u.pn % 32) * 256 : 0;
        const int kperm = 8 * (fq & 1) + 4 * (fq >> 1);
#pragma unroll
        for (int ai = 0; ai < 2; ++ai)
#pragma unroll
            for (int m = 0; m < 4; ++m) {
                const int rr = u.pm * 256 + ai * 128 + wr * 64 + m * 16 + fr;
                bf16* rowp = VT + ((size_t)b * 1024 + rr) * KEYS + key_t0;
#pragma unroll
                for (int bj = 0; bj < 2; ++bj)
#pragma unroll
                    for (int n = 0; n < 2; ++n) st_bf4(rowp + bj * 128 + wc * 32 + 16 * n + kperm, acc[ai][bj][m][n]);
            }
    }
};
struct EpiScaleBf16 {
    bf16* O; int ldo, coff; const float* cscale;
    __device__ __forceinline__ void operator()(EPI_ARGS) const {
#pragma unroll
        for (int bj = 0; bj < 2; ++bj)
#pragma unroll
            for (int n = 0; n < 2; ++n) { const int c = u.pn * 256 + bj * 128 + wc * 32 + 16 * n + 4 * fq; const f32x4 sc = *(const f32x4*)(cscale + c);
#pragma unroll
                for (int ai = 0; ai < 2; ++ai)
#pragma unroll
                    for (int m = 0; m < 4; ++m) { const int r = u.pm * 256 + ai * 128 + wr * 64 + m * 16 + fr; st_bf4(O + (size_t)r * ldo + coff + c, acc[ai][bj][m][n] * sc); } }
    }
};
struct EpiBf16 {
    bf16* O; int ldo;
    __device__ __forceinline__ void operator()(EPI_ARGS) const {
#pragma unroll
        for (int ai = 0; ai < 2; ++ai)
#pragma unroll
            for (int m = 0; m < 4; ++m) { const int r = u.pm * 256 + ai * 128 + wr * 64 + m * 16 + fr; bf16* rowp = O + (size_t)r * ldo + u.pn * 256 + wc * 32 + 4 * fq;
#pragma unroll
                for (int bj = 0; bj < 2; ++bj)
#pragma unroll
                    for (int n = 0; n < 2; ++n) st_bf4(rowp + bj * 128 + 16 * n, acc[ai][bj][m][n]); }
    }
};
struct EpiRes {
    const float* xlat; const float* xctx; float* xout; const float* gate0;
    __device__ __forceinline__ void operator()(EPI_ARGS) const {
        const bool latent = u.pm < TL / 256;
#pragma unroll
        for (int ai = 0; ai < 2; ++ai)
#pragma unroll
            for (int m = 0; m < 4; ++m) { const int r = u.pm * 256 + ai * 128 + wr * 64 + m * 16 + fr; const int ms = latent ? r / SEQ : 2;
                const float* xi = latent ? xlat + (size_t)r * 2048 : xctx + (size_t)(r - TL) * 2048; const float* gp = gate0 + (size_t)ms * 12288;
#pragma unroll
                for (int bj = 0; bj < 2; ++bj)
#pragma unroll
                    for (int n = 0; n < 2; ++n) { const int c = u.pn * 256 + bj * 128 + wc * 32 + 16 * n + 4 * fq;
                        const f32x4 xv = *(const f32x4*)(xi + c), gv = *(const f32x4*)(gp + c); *(f32x4*)(xout + (size_t)r * 2048 + c) = xv + gv * acc[ai][bj][m][n]; } }
    }
};
struct EpiMoeUp {
    bf16* H;
    __device__ __forceinline__ void operator()(EPI_ARGS) const {
#pragma unroll
        for (int ai = 0; ai < 2; ++ai)
#pragma unroll
            for (int m = 0; m < 4; ++m) { const size_t r = (size_t)u.pm * 256 + ai * 128 + wr * 64 + m * 16 + fr;
#pragma unroll
                for (int bj = 0; bj < 2; ++bj) { const int hc = (u.pn * 256 + bj * 128 + wc * 32) / 2 + 4 * fq; const f32x4 a = acc[ai][bj][m][0], b = acc[ai][bj][m][1];
                    const f32x4 h = {siluf_(a.x) * b.x, siluf_(a.y) * b.y, siluf_(a.z) * b.z, siluf_(a.w) * b.w}; st_bf4(H + r * 512 + hc, h); } }
    }
};
struct EpiMoeDown {
    bf16* Y; const int* tokl; const float* gatel; const unsigned* cnt;
    __device__ __forceinline__ void operator()(EPI_ARGS) const {
        const int ce = (int)cnt[u.e];
#pragma unroll
        for (int ai = 0; ai < 2; ++ai)
#pragma unroll
            for (int m = 0; m < 4; ++m) { const int idx = u.idx0 + ai * 128 + wr * 64 + m * 16 + fr;
                if (idx < ce) { const int pair = tokl[(size_t)u.e * LISTCAP + idx]; const float gt = gatel[(size_t)u.e * LISTCAP + idx]; bf16* rowp = Y + (size_t)pair * 2048 + u.pn * 256 + wc * 32 + 4 * fq;
#pragma unroll
                    for (int bj = 0; bj < 2; ++bj)
#pragma unroll
                        for (int n = 0; n < 2; ++n) st_bf4(rowp + bj * 128 + 16 * n, acc[ai][bj][m][n] * gt); } }
    }
};
struct EpiGlu {
    bf16* O; int ldo, coff; const bf16* Gb; const float* bias;
    __device__ __forceinline__ void operator()(EPI_ARGS) const {
#pragma unroll
        for (int ai = 0; ai < 2; ++ai)
#pragma unroll
            for (int m = 0; m < 4; ++m) { const int r = u.pm * 256 + ai * 128 + wr * 64 + m * 16 + fr;
#pragma unroll
                for (int bj = 0; bj < 2; ++bj)
#pragma unroll
                    for (int n = 0; n < 2; ++n) { const int c = u.pn * 256 + bj * 128 + wc * 32 + 16 * n + 4 * fq; const f32x4 bv = *(const f32x4*)(bias + c); const v2u gw = *(const v2u*)(Gb + (size_t)r * 1024 + c);
                        const f32x4 a = acc[ai][bj][m][n] + bv; const f32x4 o = {bflo(gw.x) * sigmoidf_(a.x), bfhi(gw.x) * sigmoidf_(a.y), bflo(gw.y) * sigmoidf_(a.z), bfhi(gw.y) * sigmoidf_(a.w)};
                        st_bf4(O + (size_t)r * ldo + coff + c, o); } }
    }
};

struct MoeOrder {
    const LAS int* bstart;
    const unsigned* cnt; const int* tokl; int nN, G, c, nblk; long bstride, eoff; bool up;
    __device__ bool next(int i, pg8::Unit& u) const {
        const long Lx = (long)i * G + c; if (Lx >= (long)nblk * nN) return false;
        const int blk = (int)(Lx / nN); u.pn = (int)(Lx % nN); u.pm = blk;
        const int e = bstart[65 + blk];
        u.e = e; u.idx0 = (blk - bstart[e]) * 256;
        u.aoff = up ? 0 : (long)blk * 256 * 512 * 2;
        u.boff = (long)e * (long)MOE_E_BYTES + eoff + (long)u.pn * bstride;
        return true;
    }
    __device__ int arow(const pg8::Unit& u, int row) const { const int idx = u.idx0 + row; return idx < (int)cnt[u.e] ? (tokl[(size_t)u.e * LISTCAP + idx] >> 1) : TT; }
};

__device__ __forceinline__ void attn_phase(Frame& F) {
    const bf16* Q = WSP(bf16, WS_Q); const bf16* Kb = WSP(bf16, WS_K); const bf16* VT = WSP(bf16, WS_VT); bf16* cat = WSP(bf16, WS_CAT);
    LAS unsigned char* lds = F.lds;
    const int tid = F.tid, lane = F.lane, w = F.wave, sub = w & 1, qw = w >> 1, r32 = lane & 31, hi = lane >> 5;
    float lam;
    { const float* lv = INP(11); float a = lv[lane] * lv[64 + lane], b = lv[128 + lane] * lv[192 + lane]; a = wave_sum(a); b = wave_sum(b); lam = expf(a) - expf(b) + 0.2f; }
    const float* subg = INP(12);
    const int NU = 1024 + 32;
    const int xcd = F.bid & 7, jcu = F.bid >> 3;
    for (int it = 0;; ++it) {
        int uidx;
        if (F.G == 256) { if (it < 4) uidx = 128 * xcd + it * 32 + jcu; else if (it == 4 && F.bid < 32) uidx = 1024 + F.bid; else break; }
        else { uidx = it * F.G + F.bid; if (uidx >= NU) break; }
        int b, head, q0row, nt; size_t kbase;
        if (uidx < 1024) { const int combo = uidx >> 6, qb = uidx & 63; b = combo >> 3; head = combo & 7; q0row = b * SEQ + qb * 128; nt = KEYS / 64; }
        else { const int v = uidx - 1024; b = v >> 4; head = (v >> 1) & 7; q0row = TL + b * CTX + (v & 1) * 128; nt = CTX / 64; }
        kbase = (size_t)b * KEYS;
        bf16x8 qf[4];
        { const bf16* qp = Q + (size_t)(q0row + qw * 32 + r32) * 1024 + head * 128 + sub * 64 + hi * 8;
#pragma unroll
          for (int ks = 0; ks < 4; ++ks) qf[ks] = *(const bf16x8*)(qp + ks * 16); }
        const int srow = tid >> 3, sch = tid & 7;
        const bf16* gk0 = Kb + (kbase + srow) * 1024 + head * 128 + sch * 8;
        const bf16* gv0 = VT + ((size_t)(b * 8 + head) * 128 + srow) * KEYS + sch * 8;
        const int lk = srow * 128 + ((sch ^ ((srow >> 1) & 7)) * 16);
        v4u st0, st1, st2, st3;
#define ATT_LOAD(t) do { st0 = *(const v4u*)(gk0 + (size_t)(t) * 65536); st1 = *(const v4u*)(gk0 + (size_t)(t) * 65536 + 64); st2 = *(const v4u*)(gv0 + (t) * 64); st3 = *(const v4u*)(gv0 + (size_t)64 * KEYS + (t) * 64); } while (0)
#define ATT_STORE(buf) do { LAS unsigned char* bp = lds + (buf) * 32768; *(LAS v4u*)(bp + lk) = st0; *(LAS v4u*)(bp + 8192 + lk) = st1; *(LAS v4u*)(bp + 16384 + lk) = st2; *(LAS v4u*)(bp + 16384 + 8192 + lk) = st3; } while (0)
        ATT_LOAD(0); ATT_STORE(0);
        __syncthreads();
        f32x16 o[4];
#pragma unroll
        for (int d = 0; d < 4; ++d)
#pragma unroll
            for (int r = 0; r < 16; ++r) o[d][r] = 0.f;
        float mrow = -INFINITY, lrow = 0.f;
        const int rdoff = r32 * 128;
        const int swz = (r32 >> 1) & 7;
        for (int t = 0; t < nt; ++t) {
            if (t + 1 < nt) ATT_LOAD(t + 1);
            const LAS unsigned char* bp = lds + (t & 1) * 32768;
            const LAS unsigned char* kp = bp + sub * 8192;
            f32x16 s0, s1;
#pragma unroll
            for (int r = 0; r < 16; ++r) { s0[r] = 0.f; s1[r] = 0.f; }
#pragma unroll
            for (int ks = 0; ks < 4; ++ks) {
                const int ch = ((2 * ks + hi) ^ swz) * 16;
                const bf16x8 k0 = *(const LAS bf16x8*)(kp + rdoff + ch);
                const bf16x8 k1 = *(const LAS bf16x8*)(kp + 4096 + rdoff + ch);
                s0 = __builtin_amdgcn_mfma_f32_32x32x16_bf16(k0, qf[ks], s0, 0, 0, 0);
                s1 = __builtin_amdgcn_mfma_f32_32x32x16_bf16(k1, qf[ks], s1, 0, 0, 0);
            }
            float mx = s0[0];
#pragma unroll
            for (int r = 1; r < 16; ++r) mx = fmaxf(mx, s0[r]);
#pragma unroll
            for (int r = 0; r < 16; ++r) mx = fmaxf(mx, s1[r]);
            mx = fmaxf(mx, __shfl_xor(mx, 32));
            const float mnew = fmaxf(mrow, mx);
            const float alpha = __builtin_amdgcn_exp2f(mrow - mnew);
            mrow = mnew;
            float rs = 0.f;
#pragma unroll
            for (int r = 0; r < 16; ++r) { s0[r] = __builtin_amdgcn_exp2f(s0[r] - mnew); rs += s0[r]; }
#pragma unroll
            for (int r = 0; r < 16; ++r) { s1[r] = __builtin_amdgcn_exp2f(s1[r] - mnew); rs += s1[r]; }
            lrow = lrow * alpha + rs;
            if (__any(alpha != 1.0f)) {
#pragma unroll
                for (int d = 0; d < 4; ++d)
#pragma unroll
                    for (int r = 0; r < 16; ++r) o[d][r] *= alpha;
            }
            bf16x8 pf[4];
#pragma unroll
            for (int s = 0; s < 4; ++s) { v4u pw;
                if (s < 2) { pw.x = cvt_pk_bf16(s0[8 * s + 0], s0[8 * s + 1]); pw.y = cvt_pk_bf16(s0[8 * s + 2], s0[8 * s + 3]); pw.z = cvt_pk_bf16(s0[8 * s + 4], s0[8 * s + 5]); pw.w = cvt_pk_bf16(s0[8 * s + 6], s0[8 * s + 7]); }
                else { const int q = s - 2; pw.x = cvt_pk_bf16(s1[8 * q + 0], s1[8 * q + 1]); pw.y = cvt_pk_bf16(s1[8 * q + 2], s1[8 * q + 3]); pw.z = cvt_pk_bf16(s1[8 * q + 4], s1[8 * q + 5]); pw.w = cvt_pk_bf16(s1[8 * q + 6], s1[8 * q + 7]); }
                pf[s] = __builtin_bit_cast(bf16x8, pw); }
            const LAS unsigned char* vp = bp + 16384;
#pragma unroll
            for (int d = 0; d < 4; ++d)
#pragma unroll
                for (int s = 0; s < 4; ++s) {
                    const bf16x8 vf = *(const LAS bf16x8*)(vp + d * 4096 + rdoff + (((2 * s + hi) ^ swz) * 16));
                    o[d] = __builtin_amdgcn_mfma_f32_32x32x16_bf16(vf, pf[s], o[d], 0, 0, 0);
                }
            if (t + 1 < nt) ATT_STORE((t + 1) & 1);
            __syncthreads();
        }
#undef ATT_LOAD
#undef ATT_STORE
        const float ltot = lrow + __shfl_xor(lrow, 32); const float linv = 1.0f / ltot;
        LAS float* xch = (LAS float*)lds + (size_t)(qw * 32 + r32) * 132;
        if (sub == 1) {
#pragma unroll
            for (int d = 0; d < 4; ++d)
#pragma unroll
                for (int g = 0; g < 4; ++g) *(LAS f32x4*)(xch + 32 * d + 8 * g + 4 * hi) = (f32x4){o[d][4 * g] * linv, o[d][4 * g + 1] * linv, o[d][4 * g + 2] * linv, o[d][4 * g + 3] * linv};
        }
        __syncthreads();
        if (sub == 0) {
            float ss = 0.f;
#pragma unroll
            for (int d = 0; d < 4; ++d)
#pragma unroll
                for (int g = 0; g < 4; ++g) { const f32x4 o2 = *(const LAS f32x4*)(xch + 32 * d + 8 * g + 4 * hi);
#pragma unroll
                    for (int j = 0; j < 4; ++j) { const float v = o[d][4 * g + j] * linv - lam * o2[j]; o[d][4 * g + j] = v; ss += v * v; } }
            ss += __shfl_xor(ss, 32);
            const float rn = 0.8f / sqrtf(ss * (1.0f / 128.0f) + EPS);
            bf16* op = cat + (size_t)(q0row + qw * 32 + r32) * 2048 + head * 128;
#pragma unroll
            for (int d = 0; d < 4; ++d)
#pragma unroll
                for (int g = 0; g < 4; ++g) { const int dv = 32 * d + 8 * g + 4 * hi; const f32x4 gg = *(const f32x4*)(subg + dv);
                    st_bf4(op + dv, (f32x4){o[d][4 * g] * rn * gg.x, o[d][4 * g + 1] * rn * gg.y, o[d][4 * g + 2] * rn * gg.z, o[d][4 * g + 3] * rn * gg.w}); }
        }
        __syncthreads();
    }
}

__device__ __forceinline__ void poold_phase(Frame& F) {
    const bf16* P = WSP(bf16, WS_P); bf16* PD = WSP(bf16, WS_PD);
    const int gt = F.bid * NTHREADS + F.tid, NGT = F.G * NTHREADS;
    for (int idx = gt; idx < TT * 128; idx += NGT) {
        const int r = idx >> 7, cc = (idx & 127) * 8, g = cc >> 8, wdw = 2 << g;
        int sb, t, Ls; if (r < TL) { sb = (r / SEQ) * SEQ; t = r % SEQ; Ls = SEQ; } else { sb = TL + ((r - TL) / CTX) * CTX; t = (r - TL) % CTX; Ls = CTX; }
        int lo = t - wdw / 2, hi = lo + wdw; lo = lo < 0 ? 0 : lo; hi = hi > Ls ? Ls : hi;
        float a[8];
#pragma unroll
        for (int j = 0; j < 8; ++j) a[j] = 0.f;
        for (int s = lo; s < hi; ++s) { const v4u v = *(const v4u*)(P + (size_t)(sb + s) * 1024 + cc);
            a[0] += bflo(v.x); a[1] += bfhi(v.x); a[2] += bflo(v.y); a[3] += bfhi(v.y); a[4] += bflo(v.z); a[5] += bfhi(v.z); a[6] += bflo(v.w); a[7] += bfhi(v.w); }
        const float inv = 1.0f / (float)(hi - lo);
        const v4u me = *(const v4u*)(P + (size_t)r * 1024 + cc);
        v4u o; o.x = pk2(a[0] * inv - bflo(me.x), a[1] * inv - bfhi(me.x)); o.y = pk2(a[2] * inv - bflo(me.y), a[3] * inv - bfhi(me.y));
        o.z = pk2(a[4] * inv - bflo(me.z), a[5] * inv - bfhi(me.z)); o.w = pk2(a[6] * inv - bflo(me.w), a[7] * inv - bfhi(me.w));
        *(v4u*)(PD + (size_t)r * 1024 + cc) = o;
    }
}

__device__ __forceinline__ void shortconv_phase(Frame& F) {
    const bf16* PJ = WSP(bf16, WS_PROJ1); float* GT = WSP(float, WS_GT);
    const float* cw = INP(17); const float* cb = INP(18);
    LAS float* scr = (LAS float*)(F.lds + F.wave * 16896);
    const int lane = F.lane;
    for (int it = F.gw; it < 2 * 128 * 48; it += F.NGW) {
        const int cbk = it % 48, tb = (it / 48) % 128, b = it / (48 * 128), col = cbk * 64 + lane, t0 = tb * 64;
        const float w0 = cw[col], w1 = cw[3072 + col], w2 = cw[2 * 3072 + col], bias = cb[col];
        const bf16* base = PJ + ((size_t)b * SEQ) * 4096 + col;
        float prev = (t0 > 0) ? bf2f(base[(size_t)(t0 - 1) * 4096]) : 0.f;
        float cur = bf2f(base[(size_t)t0 * 4096]);
#pragma unroll 8
        for (int tt = 0; tt < 64; ++tt) { const int t = t0 + tt; const float nxt = (t + 1 < SEQ) ? bf2f(base[(size_t)(t + 1) * 4096]) : 0.f;
            scr[tt * 65 + lane] = prev * w0 + cur * w1 + nxt * w2 + bias; prev = cur; cur = nxt; }
        LDS_WAIT(); asm volatile("" ::: "memory");
        for (int c = 0; c < 64; ++c) GT[((size_t)(cbk * 64 + c) * 2 + b) * SEQ + t0 + lane] = scr[lane * 65 + c];
        LDS_WAIT(); asm volatile("" ::: "memory");
    }
}

__device__ __forceinline__ void s5_scan_phase(Frame& F) {
    const bf16* PJ = WSP(bf16, WS_PROJ1); float* YD = WSP(float, WS_YD);
    const f32x2* lamb = WSP(f32x2, WS_S5LAM); const f32x2* bbar = WSP(f32x2, WS_S5B);
    const float* cre = INP(31); const float* cim = INP(32);
    const int lane = F.lane;
    for (int task = F.wave * F.G + F.bid; task < 256; task += F.NGW) {
        const int di = task >> 7, b = (task >> 6) & 1, g = task & 63;
        const int dgp = (di * 64 + g) * 64 + lane;
        const f32x2 lam = lamb[dgp];
        float br[16], bi[16], cr[16], ci[16];
#pragma unroll
        for (int c = 0; c < 16; ++c) { const f32x2 bv = bbar[(size_t)dgp * 16 + c]; br[c] = bv.x; bi[c] = bv.y;
            cr[c] = cre[((size_t)(di * 64 + g) * 16 + c) * 64 + lane]; ci[c] = cim[((size_t)(di * 64 + g) * 16 + c) * 64 + lane]; }
        float sr = 0.f, si = 0.f;
        const int nsteps = CTX + SEQ;
        for (int st = 0; st < nsteps; st += 4) {
            const int stl = st + (lane >> 4);
            int row;
            if (stl < CTX) row = TL + b * CTX + (di == 0 ? stl : CTX - 1 - stl);
            else row = b * SEQ + (di == 0 ? stl - CTX : SEQ - 1 - (stl - CTX));
            const float uval = bf2f(PJ[(size_t)row * 4096 + 3072 + g * 16 + (lane & 15)]);
#pragma unroll
            for (int k = 0; k < 4; ++k) {
                float bur = 0.f, bui = 0.f;
#pragma unroll
                for (int c = 0; c < 16; ++c) { const float u = __builtin_bit_cast(float, __builtin_amdgcn_readlane(__builtin_bit_cast(int, uval), 16 * k + c)); bur += br[c] * u; bui += bi[c] * u; }
                const float nr = lam.x * sr - lam.y * si + bur, ni = lam.x * si + lam.y * sr + bui; sr = nr; si = ni;
                const int s2 = st + k;
                if (s2 >= CTX) {
                    const int t = (di == 0) ? s2 - CTX : SEQ - 1 - (s2 - CTX);
                    float outv = 0.f;
#pragma unroll
                    for (int c = 0; c < 16; ++c) { float v = cr[c] * sr - ci[c] * si; v = wave_sum(v); if (lane == c) outv = v; }
                    if (lane < 16) YD[((size_t)di * TL + (size_t)b * SEQ + t) * 1024 + g * 16 + lane] = outv;
                }
            }
        }
    }
}

__device__ __forceinline__ void hyena_naive_phase(Frame& F) {
    const float* GT = WSP(float, WS_GT); const float* kT = WSP(float, WS_KT); const float* invn = WSP(float, WS_INVN); bf16* cat = WSP(bf16, WS_CAT);
    const float* hyb = INP(25);
    LAS float* kf = (LAS float*)F.lds;
    LAS f32x2* ub = (LAS f32x2*)(F.lds + 65536);
    const int tid = F.tid;
    for (int ch = F.bid; ch < 1024; ch += F.G) {
        float res0[16], res1[16];
        for (int o = 0; o < 2; ++o) {
            const float inv = invn[o * 1024 + ch];
            const float* kfw = kT + (size_t)(o * 2048 + ch) * SEQ; const float* kbw = kT + (size_t)(o * 2048 + 1024 + ch) * SEQ;
            for (int n = tid; n < 16384; n += NTHREADS) { float v; if (n < SEQ) v = kfw[n]; else if (n == SEQ) v = 0.f; else v = kbw[16384 - n]; kf[n] = v * inv; }
            if (o == 0) { const float* v0 = GT + ((size_t)(0 * 1024 + ch) * 2) * SEQ; for (int n = tid; n < SEQ; n += NTHREADS) ub[n] = (f32x2){v0[n], v0[SEQ + n]}; }
            else {
#pragma unroll
                for (int j = 0; j < 16; ++j) ub[tid + NTHREADS * j] = (f32x2){res0[j], res1[j]}; }
            __syncthreads();
            float a0[16], a1[16];
#pragma unroll
            for (int j = 0; j < 16; ++j) { a0[j] = 0.f; a1[j] = 0.f; }
            for (int s = 0; s < SEQ; ++s) { const f32x2 u = ub[s];
#pragma unroll
                for (int j = 0; j < 16; ++j) { const float kk = kf[(tid + NTHREADS * j - s) & 16383]; a0[j] += u.x * kk; a1[j] += u.y * kk; } }
            const float bias = hyb[o * 1024 + ch];
            const float* xg = GT + ((size_t)((o + 1) * 1024 + ch) * 2) * SEQ;
#pragma unroll
            for (int j = 0; j < 16; ++j) { const int t = tid + NTHREADS * j; const f32x2 u = ub[t];
                res0[j] = xg[t] * (a0[j] + bias * u.x); res1[j] = xg[SEQ + t] * (a1[j] + bias * u.y); }
            __syncthreads();
        }
#pragma unroll
        for (int j = 0; j < 16; ++j) { const int t = tid + NTHREADS * j;
            cat[(size_t)t * 2048 + ch] = (bf16)f2bf(res0[j]); cat[((size_t)SEQ + t) * 2048 + ch] = (bf16)f2bf(res1[j]); }
    }
}

__device__ __forceinline__ void s5_gelu_phase(Frame& F) {
    const bf16* PJ = WSP(bf16, WS_PROJ1); const float* YD = WSP(float, WS_YD); bf16* Gb = WSP(bf16, WS_PD); const float* dd = INP(33);
    const int gt = F.bid * NTHREADS + F.tid, NGT = F.G * NTHREADS;
    for (int idx = gt; idx < TL * 256; idx += NGT) { const int r = idx >> 8, c = (idx & 255) * 4;
        const v2u uw = *(const v2u*)(PJ + (size_t)r * 4096 + 3072 + c); const f32x4 d4 = *(const f32x4*)(dd + c);
        const f32x4 y0 = *(const f32x4*)(YD + (size_t)r * 1024 + c), y1 = *(const f32x4*)(YD + ((size_t)TL + r) * 1024 + c);
        const f32x4 y = {bflo(uw.x) * d4.x + y0.x + y1.x, bfhi(uw.x) * d4.y + y0.y + y1.y, bflo(uw.y) * d4.z + y0.z + y1.z, bfhi(uw.y) * d4.w + y0.w + y1.w};
        st_bf4(Gb + (size_t)r * 1024 + c, (f32x4){gelu_tanh(y.x), gelu_tanh(y.y), gelu_tanh(y.z), gelu_tanh(y.w)}); }
}

__device__ __forceinline__ f32x2 cmulf(f32x2 a, f32x2 b) { return (f32x2){a.x * b.x - a.y * b.y, a.x * b.y + a.y * b.x}; }
__device__ __forceinline__ int drev14(int p) { const unsigned r = __builtin_bitreverse32((unsigned)p) >> 18; return (int)(((r & 0x2AAAu) >> 1) | ((r & 0x1555u) << 1)); }
__device__ __forceinline__ void fft_fwd(LAS f32x2* X, const f32x2* tw, int tid) {
#pragma nounroll
    for (int L = 4096; L >= 1; L >>= 2) {
        const int tws = 4096 / L;
#pragma unroll 2
        for (int i = 0; i < 8; ++i) {
            const int b = tid + NTHREADS * i, j = b & (L - 1), i0 = (b - j) * 4 + j;
            const f32x2 x0 = X[i0], x1 = X[i0 + L], x2 = X[i0 + 2 * L], x3 = X[i0 + 3 * L];
            const f32x2 w1 = tw[j * tws], w2 = cmulf(w1, w1), w3 = cmulf(w2, w1);
            const f32x2 a = x0 + x2, bb = x0 - x2, c = x1 + x3, d = x1 - x3;
            const f32x2 t1 = {bb.x + d.y, bb.y - d.x}, t3 = {bb.x - d.y, bb.y + d.x};
            X[i0] = a + c; X[i0 + L] = cmulf(t1, w1); X[i0 + 2 * L] = cmulf(a - c, w2); X[i0 + 3 * L] = cmulf(t3, w3);
        }
        __syncthreads();
    }
}
__device__ __forceinline__ void fft_inv(LAS f32x2* X, const f32x2* tw, int tid) {
#pragma nounroll
    for (int L = 1; L <= 4096; L <<= 2) {
        const int tws = 4096 / L;
#pragma unroll 2
        for (int i = 0; i < 8; ++i) {
            const int b = tid + NTHREADS * i, j = b & (L - 1), i0 = (b - j) * 4 + j;
            f32x2 w1 = tw[j * tws]; w1.y = -w1.y; const f32x2 w2 = cmulf(w1, w1), w3 = cmulf(w2, w1);
            const f32x2 x0 = X[i0], x1 = cmulf(X[i0 + L], w1), x2 = cmulf(X[i0 + 2 * L], w2), x3 = cmulf(X[i0 + 3 * L], w3);
            const f32x2 a = x0 + x2, bb = x0 - x2, c = x1 + x3, d = x1 - x3;
            X[i0] = a + c; X[i0 + L] = (f32x2){bb.x - d.y, bb.y + d.x}; X[i0 + 2 * L] = a - c; X[i0 + 3 * L] = (f32x2){bb.x + d.y, bb.y - d.x};
        }
        __syncthreads();
    }
}
__device__ __forceinline__ void fft_pointwise(LAS f32x2* X, const f32x2* Wg, int o, float scale, int tid) {
    const float hs = 0.5f * scale;
#pragma unroll 4
    for (int i = 0; i < 32; ++i) {
        const int p = tid + NTHREADS * i, f = drev14(p), pm = drev14((16384 - f) & 16383);
        const unsigned long long ua = __hip_atomic_load((const unsigned long long*)(Wg + p), __ATOMIC_RELAXED, __HIP_MEMORY_SCOPE_AGENT);
        const unsigned long long ub = __hip_atomic_load((const unsigned long long*)(Wg + pm), __ATOMIC_RELAXED, __HIP_MEMORY_SCOPE_AGENT);
        const f32x2 A = __builtin_bit_cast(f32x2, ua), B = __builtin_bit_cast(f32x2, ub);
        f32x2 K;
        if (o == 0) K = (f32x2){(A.x + B.x) * hs, (A.y - B.y) * hs};
        else { const f32x2 dd = {A.x - B.x, A.y + B.y}; K = (f32x2){dd.y * hs, -dd.x * hs}; }
        X[p] = cmulf(X[p], K);
    }
    __syncthreads();
}
__device__ __forceinline__ void hyena_fft_phase(Frame& F) {
    float* GT = WSP(float, WS_GT); const float* kT = WSP(float, WS_KT); const float* invn = WSP(float, WS_INVN); const f32x2* tw = WSP(f32x2, WS_TW);
    f32x2* Wg = WSP(f32x2, WS_FFTW) + (size_t)F.bid * 16384;
    const float* hyb = INP(25);
    LAS f32x2* X = (LAS f32x2*)F.lds;
    const int tid = F.tid;
    for (int ch = F.bid; ch < 1024; ch += F.G) {
        { const float* f0 = kT + (size_t)ch * SEQ; const float* b0 = kT + (size_t)(1024 + ch) * SEQ; const float* f1 = kT + (size_t)(2048 + ch) * SEQ; const float* b1 = kT + (size_t)(3072 + ch) * SEQ;
          for (int n = tid; n < SEQ; n += NTHREADS) { X[n] = (f32x2){f0[n], f1[n]}; X[SEQ + n] = (n == 0) ? (f32x2){0.f, 0.f} : (f32x2){b0[SEQ - n], b1[SEQ - n]}; } }
        __syncthreads();
        fft_fwd(X, tw, tid);
        for (int n = tid; n < 16384; n += NTHREADS) Wg[n] = X[n];
        __syncthreads();
        const float* v0 = GT + ((size_t)ch * 2) * SEQ; float* yo = WSP(float, WS_YHT) + ((size_t)ch * 2) * SEQ;
        const float* x1 = GT + ((size_t)(1024 + ch) * 2) * SEQ; const float* x2 = GT + ((size_t)(2048 + ch) * 2) * SEQ;
        float z0[16], z1[16];
#pragma unroll
        for (int j = 0; j < 16; ++j) { const int n = tid + NTHREADS * j; z0[j] = v0[n]; z1[j] = v0[SEQ + n]; }
#pragma unroll
        for (int o = 0; o < 2; ++o) {
#pragma unroll
            for (int j = 0; j < 16; ++j) { const int n = tid + NTHREADS * j; X[n] = (f32x2){z0[j], z1[j]}; X[SEQ + n] = (f32x2){0.f, 0.f}; }
            __syncthreads();
            fft_fwd(X, tw, tid);
            fft_pointwise(X, Wg, o, invn[o * 1024 + ch] * (1.0f / 16384.0f), tid);
            fft_inv(X, tw, tid);
            const float bias = hyb[o * 1024 + ch]; const float* xg = (o == 0) ? x1 : x2;
#pragma unroll
            for (int j = 0; j < 16; ++j) { const int n = tid + NTHREADS * j; const f32x2 y = X[n]; z0[j] = xg[n] * (y.x + bias * z0[j]); z1[j] = xg[SEQ + n] * (y.y + bias * z1[j]); }
            __syncthreads();
        }
#pragma unroll
        for (int j = 0; j < 16; ++j) { const int n = tid + NTHREADS * j; yo[n] = z0[j]; yo[SEQ + n] = z1[j]; }
    }
}
__device__ __forceinline__ void hyena_out_transpose(Frame& F) {
    const float* GT = WSP(float, WS_YHT); bf16* cat = WSP(bf16, WS_CAT);
    LAS float* scr = (LAS float*)(F.lds + F.wave * 16896);
    const int lane = F.lane;
    for (int it = F.gw; it < 2 * 128 * 16; it += F.NGW) {
        const int cbk = it & 15, tb = (it >> 4) & 127, b = it >> 11, t0 = tb * 64;
        for (int c = 0; c < 64; ++c) scr[c * 65 + lane] = GT[((size_t)(cbk * 64 + c) * 2 + b) * SEQ + t0 + lane];
        LDS_WAIT(); asm volatile("" ::: "memory");
        for (int tt = 0; tt < 64; ++tt) cat[((size_t)b * SEQ + t0 + tt) * 2048 + cbk * 64 + lane] = (bf16)f2bf(scr[lane * 65 + tt]);
        LDS_WAIT(); asm volatile("" ::: "memory");
    }
}

__device__ __forceinline__ int s5_row(int di, int b, int s) {
    return (s < CTX) ? TL + b * CTX + (di == 0 ? s : CTX - 1 - s) : b * SEQ + (di == 0 ? s - CTX : SEQ - 1 - (s - CTX));
}
template <bool OUTPUT>
__device__ __forceinline__ void s5_seg_phase(Frame& F) {
    const bf16* PJ = WSP(bf16, WS_PROJ1); float* YD = WSP(float, WS_YD);
    const f32x2* lamb = WSP(f32x2, WS_S5LAM); const f32x2* bbar = WSP(f32x2, WS_S5B); const f32x2* l256 = WSP(f32x2, WS_S5L256); f32x2* Eb = WSP(f32x2, WS_S5E);
    const float* cre = INP(31); const float* cim = INP(32);
    const int lane = F.lane;
    for (int task = F.wave * F.G + F.bid; task < 256 * 32; task += F.NGW) {
        const int dbg = task >> 5, seg = (task & 31) + (OUTPUT ? 1 : 0);
        const int di = dbg >> 7, b = (dbg >> 6) & 1, g = dbg & 63;
        const int dgp = (di * 64 + g) * 64 + lane;
        const f32x2 lam = lamb[dgp];
        float br[16], bi[16];
#pragma unroll
        for (int c = 0; c < 16; ++c) { const f32x2 bv = bbar[(size_t)dgp * 16 + c]; br[c] = bv.x; bi[c] = bv.y; }
        float cr[16], ci[16];
        if (OUTPUT) {
#pragma unroll
            for (int c = 0; c < 16; ++c) { cr[c] = cre[((size_t)(di * 64 + g) * 16 + c) * 64 + lane]; ci[c] = cim[((size_t)(di * 64 + g) * 16 + c) * 64 + lane]; }
        }
        float sr = 0.f, si = 0.f;
        if (OUTPUT) {
            const f32x2 l2 = l256[dgp]; const f32x2* ep = Eb + ((size_t)dbg * 32) * 64 + lane;
            for (int k = 0; k < seg; ++k) { const f32x2 e = ep[(size_t)k * 64]; const float nr = l2.x * sr - l2.y * si + e.x, ni = l2.x * si + l2.y * sr + e.y; sr = nr; si = ni; }
        }
        const int s0 = seg * 256;
#pragma nounroll
        for (int st = 0; st < 256; st += 4) {
            const int row = s5_row(di, b, s0 + st + (lane >> 4));
            const float uval = bf2f(PJ[(size_t)row * 4096 + 3072 + g * 16 + (lane & 15)]);
#pragma unroll
            for (int k = 0; k < 4; ++k) {
                float bur = 0.f, bui = 0.f;
#pragma unroll
                for (int c = 0; c < 16; ++c) { const float u = __builtin_bit_cast(float, __builtin_amdgcn_readlane(__builtin_bit_cast(int, uval), 16 * k + c)); bur += br[c] * u; bui += bi[c] * u; }
                const float nr = lam.x * sr - lam.y * si + bur, ni = lam.x * si + lam.y * sr + bui; sr = nr; si = ni;
                if (OUTPUT) {
                    float v8[8], v4[4], v2[2], v1;
                    const bool b5 = (lane & 32) != 0, b4 = (lane & 16) != 0, b3 = (lane & 8) != 0, b2 = (lane & 4) != 0;
#pragma unroll
                    for (int i = 0; i < 8; ++i) { const float lo = cr[i] * sr - ci[i] * si, hi = cr[i + 8] * sr - ci[i + 8] * si; const float keep = b5 ? hi : lo, send = b5 ? lo : hi; v8[i] = keep + __shfl_xor(send, 32); }
#pragma unroll
                    for (int i = 0; i < 4; ++i) { const float keep = b4 ? v8[i + 4] : v8[i], send = b4 ? v8[i] : v8[i + 4]; v4[i] = keep + __shfl_xor(send, 16); }
#pragma unroll
                    for (int i = 0; i < 2; ++i) { const float keep = b3 ? v4[i + 2] : v4[i], send = b3 ? v4[i] : v4[i + 2]; v2[i] = keep + __shfl_xor(send, 8); }
                    { const float keep = b2 ? v2[1] : v2[0], send = b2 ? v2[0] : v2[1]; v1 = keep + __shfl_xor(send, 4); }
                    v1 += __shfl_xor(v1, 2); v1 += __shfl_xor(v1, 1);
                    const int s = s0 + st + k, t = (di == 0) ? s - CTX : SEQ - 1 - (s - CTX);
                    if ((lane & 3) == 0) YD[((size_t)di * TL + (size_t)b * SEQ + t) * 1024 + g * 16 + (lane >> 2)] = v1;
                }
            }
        }
        if (!OUTPUT) Eb[((size_t)dbg * 32 + seg) * 64 + lane] = (f32x2){sr, si};
    }
}

typedef float f32x4_t __attribute__((ext_vector_type(4)));
template <bool OUTPUT>
__device__ __forceinline__ void s5_mfma_phase(Frame& F) {
    const bf16* PJ = WSP(bf16, WS_PROJ1); float* YD = WSP(float, WS_YD);
    const f32x2* lamb = WSP(f32x2, WS_S5LAM); const f32x2* bbar = WSP(f32x2, WS_S5B); const f32x2* l256 = WSP(f32x2, WS_S5L256); f32x2* Eb = WSP(f32x2, WS_S5E);
    const float* cre = INP(31); const float* cim = INP(32);
    const int lane = F.lane, fr = lane & 15, fq = lane >> 4;
    LAS unsigned* Xl = (LAS unsigned*)(F.lds + F.wave * 4608);
    for (int task = F.wave * F.G + F.bid; task < 256 * 32; task += F.NGW) {
        const int dbg = task >> 5, seg = (task & 31) + (OUTPUT ? 1 : 0);
        const int di = dbg >> 7, b = (dbg >> 6) & 1, g = dbg & 63;
        const int dg = di * 64 + g;
        f32x2 l1[4], l2[4], l3[4], l4[4];
        bf16x8 bfr[8];
#pragma unroll
        for (int t = 0; t < 4; ++t) { const int dgp = dg * 64 + 16 * t + fr; l1[t] = lamb[dgp]; l2[t] = cmulf(l1[t], l1[t]); l3[t] = cmulf(l2[t], l1[t]); l4[t] = cmulf(l2[t], l2[t]);
            v4u wre = {0u, 0u, 0u, 0u}, wim = {0u, 0u, 0u, 0u};
            if (fq < 2) { const f32x4* bp = (const f32x4*)(bbar + (size_t)dgp * 16 + 8 * fq); const f32x4 q0 = bp[0], q1 = bp[1], q2 = bp[2], q3 = bp[3];
                wre.x = cvt_pk_bf16(q0.x, q0.z); wre.y = cvt_pk_bf16(q1.x, q1.z); wre.z = cvt_pk_bf16(q2.x, q2.z); wre.w = cvt_pk_bf16(q3.x, q3.z);
                wim.x = cvt_pk_bf16(q0.y, q0.w); wim.y = cvt_pk_bf16(q1.y, q1.w); wim.z = cvt_pk_bf16(q2.y, q2.w); wim.w = cvt_pk_bf16(q3.y, q3.w); }
            bfr[t] = __builtin_bit_cast(bf16x8, wre); bfr[4 + t] = __builtin_bit_cast(bf16x8, wim); }
        bf16x8 cfr[4];
        if (OUTPUT) {
#pragma unroll
            for (int ks = 0; ks < 4; ++ks) { const size_t cb = ((size_t)dg * 16 + fr) * 64 + 16 * ks + 4 * fq; const f32x4 r4 = *(const f32x4*)(cre + cb), i4 = *(const f32x4*)(cim + cb);
                v4u w; w.x = cvt_pk_bf16(r4.x, -i4.x); w.y = cvt_pk_bf16(r4.y, -i4.y); w.z = cvt_pk_bf16(r4.z, -i4.z); w.w = cvt_pk_bf16(r4.w, -i4.w); cfr[ks] = __builtin_bit_cast(bf16x8, w); }
        }
        f32x2 st[4];
#pragma unroll
        for (int t = 0; t < 4; ++t) st[t] = (f32x2){0.f, 0.f};
        if (OUTPUT) {
#pragma unroll
            for (int t = 0; t < 4; ++t) { const f32x2 lq = l256[dg * 64 + 16 * t + fr]; const f32x2* ep = Eb + ((size_t)dbg * 32) * 64 + 16 * t + fr;
                for (int k = 0; k < seg; ++k) { const f32x2 e = ep[(size_t)k * 64]; st[t] = cmulf(lq, st[t]) + e; } }
        }
        const int s0 = seg * 256;
        v4u unext = {0u, 0u, 0u, 0u};
        if (fq < 2) unext = *(const v4u*)(PJ + (size_t)s5_row(di, b, s0 + fr) * 4096 + 3072 + g * 16 + 8 * fq);
#pragma nounroll
        for (int blk = 0; blk < 16; ++blk) {
            const bf16x8 ufr = __builtin_bit_cast(bf16x8, unext);
            if (blk + 1 < 16 && fq < 2) unext = *(const v4u*)(PJ + (size_t)s5_row(di, b, s0 + 16 * (blk + 1) + fr) * 4096 + 3072 + g * 16 + 8 * fq);
            f32x4 bu[8];
#pragma unroll
            for (int nt = 0; nt < 8; ++nt) bu[nt] = __builtin_amdgcn_mfma_f32_16x16x32_bf16(ufr, bfr[nt], (f32x4){0.f, 0.f, 0.f, 0.f}, 0, 0, 0);
            f32x2 xs[4][4];
#pragma unroll
            for (int t = 0; t < 4; ++t) {
                f32x2 x0 = {bu[t][0], bu[4 + t][0]}, x1 = cmulf(l1[t], x0) + (f32x2){bu[t][1], bu[4 + t][1]}, x2 = cmulf(l1[t], x1) + (f32x2){bu[t][2], bu[4 + t][2]}, x3 = cmulf(l1[t], x2) + (f32x2){bu[t][3], bu[4 + t][3]};
                f32x2 sin = st[t];
                f32x2 fin = x3 + cmulf(l4[t], (fq == 0) ? sin : (f32x2){0.f, 0.f});
#pragma unroll
                for (int rd = 1; rd < 4; ++rd) { const float vr = __shfl(fin.x, lane - 16), vi = __shfl(fin.y, lane - 16);
                    if (fq == rd) { sin = (f32x2){vr, vi}; fin = x3 + cmulf(l4[t], sin); } }
                xs[t][0] = x0 + cmulf(l1[t], sin); xs[t][1] = x1 + cmulf(l2[t], sin); xs[t][2] = x2 + cmulf(l3[t], sin); xs[t][3] = x3 + cmulf(l4[t], sin);
                st[t] = (f32x2){__shfl(xs[t][3].x, 48 + fr), __shfl(xs[t][3].y, 48 + fr)};
            }
            if (OUTPUT) {
#pragma unroll
                for (int t = 0; t < 4; ++t)
#pragma unroll
                    for (int r = 0; r < 4; ++r) Xl[(4 * fq + r) * 68 + 16 * t + fr] = cvt_pk_bf16(xs[t][r].x, xs[t][r].y);
                LDS_WAIT(); asm volatile("" ::: "memory");
                f32x4 y = {0.f, 0.f, 0.f, 0.f};
#pragma unroll
                for (int ks = 0; ks < 4; ++ks) { const bf16x8 xa = *(const LAS bf16x8*)(Xl + fr * 68 + 16 * ks + 4 * fq); y = __builtin_amdgcn_mfma_f32_16x16x32_bf16(xa, cfr[ks], y, 0, 0, 0); }
                LDS_WAIT(); asm volatile("" ::: "memory");
#pragma unroll
                for (int r = 0; r < 4; ++r) { const int s = s0 + 16 * blk + 4 * fq + r, tl = (di == 0) ? s - CTX : SEQ - 1 - (s - CTX);
                    YD[((size_t)di * TL + (size_t)b * SEQ + tl) * 1024 + g * 16 + fr] = y[r]; }
            }
        }
        if (!OUTPUT) { if (fq == 0) {
#pragma unroll
            for (int t = 0; t < 4; ++t) Eb[((size_t)dbg * 32 + seg) * 64 + 16 * t + fr] = st[t]; } }
    }
}

constexpr int NPHASES = 21;
#ifndef MK_SINGLE
#define MK_SINGLE 1
#endif

__device__ __forceinline__ unsigned long long launder_u64(unsigned long long v) {
    unsigned lo = (unsigned)v, hi = (unsigned)(v >> 32);
    asm volatile("" : "+v"(lo), "+v"(hi));
    lo = __builtin_amdgcn_readfirstlane(lo); hi = __builtin_amdgcn_readfirstlane(hi);
    return ((unsigned long long)hi << 32) | lo;
}
__device__ __forceinline__ const void* launder_ptr(const void* p) {
    unsigned long long v = (unsigned long long)p; unsigned lo = (unsigned)v, hi = (unsigned)(v >> 32);
    asm volatile("" : "+v"(lo), "+v"(hi));
    lo = __builtin_amdgcn_readfirstlane(lo); hi = __builtin_amdgcn_readfirstlane(hi);
    return (const void*)(((unsigned long long)hi << 32) | lo);
}
__device__ __forceinline__ void moe_blocks(Frame& F, int l, LAS int* bstart) {
    __syncthreads();
    if (F.tid == 0) { const unsigned* cnt = WSP(unsigned, WS_CTL) + CW_CNT + l * 64; int acc = 0;
        for (int e = 0; e < 64; ++e) { bstart[e] = acc; const int nb = ((int)cnt[e] + 255) >> 8; for (int j = 0; j < nb; ++j) bstart[65 + acc + j] = e; acc += nb; } bstart[64] = acc; }
    __syncthreads();
}

template <int PHSEL>
__global__ void __launch_bounds__(NTHREADS, 2) mk_fwd(Args args) {
    extern __shared__ __attribute__((aligned(16))) unsigned char lds_raw[];
    Frame F;
    F.lds = (LAS unsigned char*)lds_raw; F.ws = args.ws; F.kin = (const __attribute__((address_space(4))) unsigned long long*)__builtin_amdgcn_kernarg_segment_ptr();
    F.tid = threadIdx.x; F.lane = F.tid & 63; F.wave = __builtin_amdgcn_readfirstlane(F.tid >> 6); F.bid = blockIdx.x; F.G = gridDim.x;
    F.gw = F.bid * NWAVES + F.wave; F.NGW = F.G * NWAVES;
    volatile LAS unsigned* lctl = (volatile LAS unsigned*)(F.lds + LDS_CTL);
    LAS int* bstart = (LAS int*)(F.lds + LDS_CTL + 64);
    if (F.tid < 4) lctl[F.tid] = 0u;
    __syncthreads();
    const int lo = args.ph_lo, hi = args.ph_hi;
    XcdBarrier bar; bar.bar = WSP(unsigned, WS_CTL) + CW_BAR; bar.x = 0; bar.st = lctl;
    if (PHSEL < 0) bar = xcd_barrier_post(WSP(unsigned, WS_CTL) + CW_BAR, lctl);
#ifndef PH_MASK
#define PH_MASK 0xffffffffu
#endif
#define IN(k) (((PH_MASK >> (k)) & 1u) && (PHSEL < 0 || PHSEL == (k)))
#define INL(j) (((PH_MASK >> (6 + (j))) & 1u) && (PHSEL < 0 || (PHSEL == 6 + (j) && lo == pb + (j))))
#define PH_END(k) do { if (PHSEL < 0) xcd_barrier(bar); } while (0)
#ifndef PH_REPEAT
#define PH_REPEAT 0u
#endif
#define REP(k) for (int _rep = 0; _rep < (((PH_REPEAT >> (k)) & 1u) ? 2 : 1); ++_rep)
#define PH_BEGIN() do { F.ws = (unsigned char*)launder_ptr((const void*)F.ws); F.kin = (const __attribute__((address_space(4))) unsigned long long*)launder_u64((unsigned long long)F.kin); \
    { int _t = threadIdx.x; asm volatile("" : "+v"(_t)); F.tid = _t; F.lane = _t & 63; F.wave = __builtin_amdgcn_readfirstlane(_t >> 6); \
      int _b = blockIdx.x; asm volatile("" : "+v"(_b)); F.bid = __builtin_amdgcn_readfirstlane(_b); F.gw = F.bid * NWAVES + F.wave; } } while (0)
    LAS unsigned char* lds = F.lds;
    const int G = F.G, bid = F.bid;
    constexpr long T2048 = 256L * 2048 * 2;

    if (IN(0)) { PH_BEGIN(); REP(0) { p0_prologue(F); __syncthreads(); } PH_END(0); }
    if (IN(1)) { PH_BEGIN(); p1_reduce(F); PH_END(1); }
        if (IN(2)) { PH_BEGIN(); REP(2) norm_phase<0>(F, 0, nullptr); PH_END(2); }
        if (IN(3)) { PH_BEGIN(); REP(3) {
            { pg8::Gemm g{WSP(bf16, WS_HA), WSP(bf16, WS_WIN0), 2048, 2048, 2048}; pg8::StaticOrder S; S.init(TT / 256, 12, G, bid, T2048, 0, T2048);
              EpiQKP E{WSP(bf16, WS_Q), WSP(bf16, WS_K), WSP(bf16, WS_P), WSP(f32x2, WS_ROPE)}; pg8::gemm_phase<EpiQKP, pg8::StaticOrder, false>(lds, g, S, E); }
            { pg8::Gemm g{WSP(bf16, WS_WIN0) + (size_t)3072 * 2048, WSP(bf16, WS_HA), 2048, 2048, 2048}; pg8::StaticOrder S; S.init(4, TT / 256, G, bid, T2048, 0, T2048);
              EpiVT E{WSP(bf16, WS_VT)}; pg8::gemm_phase<EpiVT, pg8::StaticOrder, false>(lds, g, S, E); } }
            PH_END(3);
        }
        if (IN(4)) { PH_BEGIN(); REP(4) attn_phase(F); REP(21) poold_phase(F); PH_END(4); }
        if (IN(5)) { PH_BEGIN();
            pg8::Gemm g{WSP(bf16, WS_PD), WSP(bf16, WS_WPOOL), 1024, 256, 256}; pg8::StaticOrder S; S.init(TT / 256, 4, G, bid, 256L * 1024 * 2, 256L * 2, 256L * 256 * 2);
            EpiScaleBf16 E{WSP(bf16, WS_CAT), 2048, 1024, INP(14)}; pg8::gemm_phase<EpiScaleBf16, pg8::StaticOrder, false>(lds, g, S, E);
            PH_END(5);
        }
    {
    constexpr int pb = 6; constexpr int l = 0;
    if (INL(0)) { PH_BEGIN();
        float* xbuf = WSP(float, WS_X);
        pg8::Gemm g{WSP(bf16, WS_CAT), WSP(bf16, l == 0 ? WS_WOUT0 : WS_WOUT1), 2048, 2048, 2048}; pg8::StaticOrder S; S.init(l == 0 ? TT / 256 : TL / 256, 8, G, bid, T2048, 0, T2048);
        EpiRes E{l == 0 ? INP(0) : xbuf, l == 0 ? INP(2) : xbuf + (size_t)TL * 2048, xbuf, modp(F, l, 0, 2)}; pg8::gemm_phase<EpiRes, pg8::StaticOrder, false>(lds, g, S, E);
        PH_END(pb);
    }
    if (INL(1)) { PH_BEGIN(); ffn_norm_router_phase(F, l); PH_END(pb + 1); }
    if (INL(2)) { PH_BEGIN(); REP(8) {
        moe_blocks(F, l, bstart);
        pg8::Gemm g{WSP(bf16, WS_HA), (const bf16*)(F.ws + WS_WMOE + (size_t)l * MOE_L_BYTES), 2048, 2048, 2048};
        MoeOrder S{bstart, WSP(unsigned, WS_CTL) + CW_CNT + l * 64, WSP(int, WS_TOKL), 4, G, bid, bstart[64], T2048, 0, true};
        EpiMoeUp E{WSP(bf16, WS_H)}; pg8::gemm_phase<EpiMoeUp, MoeOrder, true>(lds, g, S, E); }
        PH_END(pb + 2);
    }
    if (INL(3)) { PH_BEGIN(); REP(9) {
        moe_blocks(F, l, bstart);
        pg8::Gemm g{WSP(bf16, WS_H), (const bf16*)(F.ws + WS_WMOE + (size_t)l * MOE_L_BYTES), 512, 512, 512};
        MoeOrder S{bstart, WSP(unsigned, WS_CTL) + CW_CNT + l * 64, WSP(int, WS_TOKL), 8, G, bid, bstart[64], 256L * 512 * 2, (long)(4 * MiB), false};
        EpiMoeDown E{WSP(bf16, WS_Y), WSP(int, WS_TOKL), WSP(float, WS_GATEL), WSP(unsigned, WS_CTL) + CW_CNT + l * 64}; pg8::gemm_phase<EpiMoeDown, MoeOrder, false>(lds, g, S, E); }
        PH_END(pb + 3);
    }
    }
        if (IN(10)) { PH_BEGIN(); norm_phase<2>(F, 1, nullptr); PH_END(10); }
        if (IN(11)) { PH_BEGIN(); REP(11) {
            pg8::Gemm g{WSP(bf16, WS_HA), WSP(bf16, WS_WIN1), 2048, 2048, 2048}; pg8::StaticOrder S; S.init(TT / 256, 16, G, bid, T2048, 0, T2048);
            EpiBf16 E{WSP(bf16, WS_PROJ1), 4096}; pg8::gemm_phase<EpiBf16, pg8::StaticOrder, false>(lds, g, S, E); }
            PH_END(11);
        }
        if (IN(12)) { PH_BEGIN(); REP(12) shortconv_phase(F); REP(22) s5_mfma_phase<false>(F); PH_END(12); }
        if (IN(13)) { PH_BEGIN(); REP(23) s5_mfma_phase<true>(F); __syncthreads(); REP(13) hyena_fft_phase(F); PH_END(13); }
        if (IN(14)) { PH_BEGIN(); REP(14) { s5_gelu_phase(F); hyena_out_transpose(F); } PH_END(14); }
        if (IN(15)) { PH_BEGIN();
            pg8::Gemm g{WSP(bf16, WS_PD), WSP(bf16, WS_WGLU), 1024, 1024, 1024}; pg8::StaticOrder S; S.init(TL / 256, 4, G, bid, 256L * 1024 * 2, 0, 256L * 1024 * 2);
            EpiGlu E{WSP(bf16, WS_CAT), 2048, 1024, WSP(bf16, WS_PD), INP(35)}; pg8::gemm_phase<EpiGlu, pg8::StaticOrder, false>(lds, g, S, E);
            PH_END(15);
        }
    {
    constexpr int pb = 16; constexpr int l = 1;
    if (INL(0)) { PH_BEGIN();
        float* xbuf = WSP(float, WS_X);
        pg8::Gemm g{WSP(bf16, WS_CAT), WSP(bf16, l == 0 ? WS_WOUT0 : WS_WOUT1), 2048, 2048, 2048}; pg8::StaticOrder S; S.init(l == 0 ? TT / 256 : TL / 256, 8, G, bid, T2048, 0, T2048);
        EpiRes E{l == 0 ? INP(0) : xbuf, l == 0 ? INP(2) : xbuf + (size_t)TL * 2048, xbuf, modp(F, l, 0, 2)}; pg8::gemm_phase<EpiRes, pg8::StaticOrder, false>(lds, g, S, E);
        PH_END(pb);
    }
    if (INL(1)) { PH_BEGIN(); ffn_norm_router_phase(F, l); PH_END(pb + 1); }
    if (INL(2)) { PH_BEGIN(); REP(8) {
        moe_blocks(F, l, bstart);
        pg8::Gemm g{WSP(bf16, WS_HA), (const bf16*)(F.ws + WS_WMOE + (size_t)l * MOE_L_BYTES), 2048, 2048, 2048};
        MoeOrder S{bstart, WSP(unsigned, WS_CTL) + CW_CNT + l * 64, WSP(int, WS_TOKL), 4, G, bid, bstart[64], T2048, 0, true};
        EpiMoeUp E{WSP(bf16, WS_H)}; pg8::gemm_phase<EpiMoeUp, MoeOrder, true>(lds, g, S, E); }
        PH_END(pb + 2);
    }
    if (INL(3)) { PH_BEGIN(); REP(9) {
        moe_blocks(F, l, bstart);
        pg8::Gemm g{WSP(bf16, WS_H), (const bf16*)(F.ws + WS_WMOE + (size_t)l * MOE_L_BYTES), 512, 512, 512};
        MoeOrder S{bstart, WSP(unsigned, WS_CTL) + CW_CNT + l * 64, WSP(int, WS_TOKL), 8, G, bid, bstart[64], 256L * 512 * 2, (long)(4 * MiB), false};
        EpiMoeDown E{WSP(bf16, WS_Y), WSP(int, WS_TOKL), WSP(float, WS_GATEL), WSP(unsigned, WS_CTL) + CW_CNT + l * 64}; pg8::gemm_phase<EpiMoeDown, MoeOrder, false>(lds, g, S, E); }
        PH_END(pb + 3);
    }
    }
    if (IN(20)) { PH_BEGIN(); norm_phase<3>(F, 1, args.out); }
#undef IN
#undef INL
#undef PH_END
}

typedef void (*kern_t)(Args);
template <int P> static void launch_phase(int grid, hipStream_t stream, Args a) { hipLaunchKernelGGL(mk_fwd<P>, dim3(grid), dim3(NTHREADS), LDS_BYTES, stream, a); }
template <int P> static bool prep_phase() { return hipFuncSetAttribute((const void*)mk_fwd<P>, hipFuncAttributeMaxDynamicSharedMemorySize, LDS_BYTES) == hipSuccess; }
extern "C" void kernel_launch(void* const* d_in, const int* in_sizes, int n_in, void* d_out, int out_size, void* d_ws, size_t ws_size, hipStream_t stream) {
    static int grid = 0;
    if (grid == 0) {
        if (n_in != 43 || out_size != TL * DM || ws_size < WS_END) { fprintf(stderr, "kernel_launch: unexpected shapes (n_in %d, out %d, ws %zu < %zu)\n", n_in, out_size, ws_size, (size_t)WS_END); grid = -1; return; }
        int dev = 0, cus = 0;
        if (hipGetDevice(&dev) != hipSuccess || hipDeviceGetAttribute(&cus, hipDeviceAttributeMultiprocessorCount, dev) != hipSuccess) { grid = -1; return; }
        bool ok = true;
#if MK_SINGLE
        ok = prep_phase<-1>();
#else
        ok = prep_phase<0>() && prep_phase<1>() && prep_phase<2>() && prep_phase<3>() && prep_phase<4>() && prep_phase<5>() && prep_phase<6>() && prep_phase<7>() && prep_phase<8>() && prep_phase<9>() &&
             prep_phase<10>() && prep_phase<11>() && prep_phase<12>() && prep_phase<13>() && prep_phase<14>() && prep_phase<15>() && prep_phase<20>();
#endif
        if (!ok) { fprintf(stderr, "kernel_launch: hipFuncSetAttribute failed\n"); grid = -1; return; }
        (void)hipGetLastError();
        grid = cus;
    }
    if (grid < 0) return;
    (void)hipMemsetAsync((char*)d_ws + WS_CTL, 0, CTL_BYTES, stream);
    Args a{};
    for (int i = 0; i < 43; ++i) a.in[i] = (const float*)d_in[i];
    a.out = (float*)d_out; a.ws = (unsigned char*)d_ws;
#if MK_SINGLE
    a.ph_lo = 0; a.ph_hi = NPHASES;
    launch_phase<-1>(grid, stream, a);
#else
#define LP(k, P) a.ph_lo = (k); a.ph_hi = (k) + 1; launch_phase<P>(grid, stream, a);
    LP(0, 0) LP(1, 1) LP(2, 2) LP(3, 3) LP(4, 4) LP(5, 5) LP(6, 6) LP(7, 7) LP(8, 8) LP(9, 9) LP(10, 10) LP(11, 11) LP(12, 12) LP(13, 13) LP(14, 14) LP(15, 15)
    LP(16, 6) LP(17, 7) LP(18, 8) LP(19, 9) LP(20, 20)
#undef LP
#endif
}
```

```cpp
#include <hip/hip_runtime.h>
#include <cstdio>
#include <cstdint>
#include <cmath>

#define GAS __attribute__((address_space(1)))
#define LAS __attribute__((address_space(3)))
typedef unsigned short bf16;
typedef unsigned v4u __attribute__((ext_vector_type(4)));
typedef unsigned v2u __attribute__((ext_vector_type(2)));
typedef float f32x4 __attribute__((ext_vector_type(4)));
typedef float f32x2 __attribute__((ext_vector_type(2)));
typedef float f32x16 __attribute__((ext_vector_type(16)));
typedef short bf16x8 __attribute__((ext_vector_type(8)));
#define LDS_WAIT() asm volatile("s_waitcnt lgkmcnt(0)" ::: "memory")
#define VM_WAIT() asm volatile("s_waitcnt vmcnt(0)" ::: "memory")

__device__ __forceinline__ unsigned f2bf(float f) { unsigned u = __builtin_bit_cast(unsigned, f); return (u + 0x7fffu + ((u >> 16) & 1u)) >> 16; }
__device__ __forceinline__ unsigned pk2(float lo, float hi) { return f2bf(lo) | (f2bf(hi) << 16); }
__device__ __forceinline__ unsigned cvt_pk_bf16(float lo, float hi) { unsigned r; asm volatile("v_cvt_pk_bf16_f32 %0, %1, %2" : "=v"(r) : "v"(lo), "v"(hi)); return r; }
__device__ __forceinline__ float bf2f(unsigned short b) { return __builtin_bit_cast(float, (unsigned)b << 16); }
__device__ __forceinline__ float bflo(unsigned w) { return __builtin_bit_cast(float, w << 16); }
__device__ __forceinline__ float bfhi(unsigned w) { return __builtin_bit_cast(float, w & 0xffff0000u); }
__device__ __forceinline__ float wave_sum(float v) {
#pragma unroll
    for (int o = 1; o < 64; o <<= 1) v += __shfl_xor(v, o);
    return v;
}

namespace pg8 {
typedef unsigned short bf16_t;
constexpr int BM = 256, BK = 64, HALF = 128, HTB = HALF * BK * 2, STAGE_BYTES = 8 * HTB;

__host__ __device__ __forceinline__ int lds_byte(int r, int c) { const int st = (r >> 4) * 2 + (c >> 5), rr = r & 15, cc = c & 31, ob = rr * 64 + cc * 2; return st * 1024 + (ob ^ (((ob >> 9) & 1) << 5)); }
__host__ __device__ __forceinline__ void stage_rc(int b, int& R, int& C) { const int st = b / 1024, sb = b % 1024, swz = sb ^ (((sb >> 9) & 1) << 5); R = (st >> 1) * 16 + swz / 64; C = (st & 1) * 32 + (swz % 64) / 2; }

struct Unit { int pm, pn; long aoff, boff; int e, idx0; };
struct Gemm { const bf16_t* A; const bf16_t* Bt; int lda, ldb, K; };

template <class Epi, class Sched, bool GATHER>
__device__ __forceinline__ void gemm_phase(LAS unsigned char* lds, const Gemm g, const Sched& S, const Epi& E) {
    const int tid = threadIdx.x, wid = __builtin_amdgcn_readfirstlane(tid >> 6), lane = tid & 63, wr = wid >> 2, wc = wid & 3, fr = lane & 15, fq = lane >> 4;
    const int K = g.K, nt = K / BK;
    unsigned voffA[2], voffB[2];
#pragma unroll
    for (int i = 0; i < 2; ++i) { int R, C; stage_rc(tid * 16 + i * 8192, R, C);
        voffA[i] = (unsigned)(R * g.lda + C) * 2u; voffB[i] = (unsigned)(R * g.ldb + C) * 2u; }
    const size_t kstep = (size_t)(BK * 2);
    const size_t hstepA = GATHER ? 0 : (size_t)HALF * g.lda * 2, hstepB = (size_t)HALF * g.ldb * 2;
    const unsigned ldsw = (unsigned)wid * 1024u;
    const int aoff = lds_byte(wr * 64 + fr, fq * 8), boff = lds_byte(wc * 32 + fr, fq * 8);
#define PG8_SA(b, h) (((b) * 2 + (h)) * HTB)
#define PG8_SB(b, h) ((4 + (b) * 2 + (h)) * HTB)
#define PG8_STAGE(bufoff, gbase, voff) do { _Pragma("unroll") for (int _i = 0; _i < 2; ++_i) \
        __builtin_amdgcn_global_load_lds((const unsigned*)((const char*)(gbase) + (voff)[_i]), (LAS unsigned*)(lds + (bufoff) + ldsw + _i * 8192), 16, 0, 0); } while (0)
#define PG8_STAGE_A(bufoff, gbase, h, nx) do { if constexpr (GATHER) { unsigned _tv[2]; \
        if (nx) { int _tz = tid; asm volatile("" : "+v"(_tz)); _Pragma("unroll") for (int _j = 0; _j < 2; ++_j) { int _R, _C; stage_rc(_tz * 16 + _j * 8192, _R, _C); _tv[_j] = (unsigned)S.arow(nxt, (h) * HALF + _R) * (unsigned)(g.lda * 2) + (unsigned)(_C * 2); } } \
        else { _tv[0] = gvc[h][0]; _tv[1] = gvc[h][1]; } \
        PG8_STAGE(bufoff, gbase, _tv); } else { PG8_STAGE(bufoff, (gbase) + (h) * hstepA, voffA); } } while (0)
#define PG8_LDA(dst, b, h) do { _Pragma("unroll") for (int m = 0; m < 4; ++m) _Pragma("unroll") for (int k = 0; k < 2; ++k) dst[m][k] = *(const LAS bf16x8*)(lds + PG8_SA(b, h) + aoff + m * 2048 + k * 1024); } while (0)
#define PG8_LDB(dst, b, h) do { _Pragma("unroll") for (int n = 0; n < 2; ++n) _Pragma("unroll") for (int k = 0; k < 2; ++k) dst[n][k] = *(const LAS bf16x8*)(lds + PG8_SB(b, h) + boff + n * 2048 + k * 1024); } while (0)
#define PG8_MMA(ai, bj, At, Bt) do { __builtin_amdgcn_s_setprio(1); _Pragma("unroll") for (int m = 0; m < 4; ++m) _Pragma("unroll") for (int n = 0; n < 2; ++n) _Pragma("unroll") for (int k = 0; k < 2; ++k) \
        acc[ai][bj][m][n] = __builtin_amdgcn_mfma_f32_16x16x32_bf16(Bt[n][k], At[m][k], acc[ai][bj][m][n], 0, 0, 0); __builtin_amdgcn_s_setprio(0); } while (0)
#define PG8_WAIT_V(n) asm volatile("s_waitcnt vmcnt(" #n ")" ::: "memory")
#define PG8_WAIT_L(n) asm volatile("s_waitcnt lgkmcnt(" #n ")" ::: "memory")
#define PG8_BAR __builtin_amdgcn_s_barrier()
#define PG8_SCHED __builtin_amdgcn_sched_barrier(0)
    Unit cur, nxt; int ui = 0;
    if (!S.next(0, cur)) return;
    unsigned gvc[2][2];
#define PG8_GV(unit) do { if constexpr (GATHER) { int _tz = tid; asm volatile("" : "+v"(_tz)); _Pragma("unroll") for (int _h = 0; _h < 2; ++_h) _Pragma("unroll") for (int _j = 0; _j < 2; ++_j) { int _R, _C; stage_rc(_tz * 16 + _j * 8192, _R, _C); \
        gvc[_h][_j] = (unsigned)S.arow(unit, _h * HALF + _R) * (unsigned)(g.lda * 2) + (unsigned)(_C * 2); } } } while (0)
    PG8_GV(cur);
    f32x4 acc[2][2][4][2];
#pragma unroll
    for (int a = 0; a < 2; ++a)
#pragma unroll
        for (int b = 0; b < 2; ++b)
#pragma unroll
            for (int m = 0; m < 4; ++m)
#pragma unroll
                for (int n = 0; n < 2; ++n) acc[a][b][m][n] = (f32x4){0.f, 0.f, 0.f, 0.f};
    bf16x8 At[4][2], B0[2][2], B1[2][2];
    const char* cA = (const char*)g.A + cur.aoff; const char* cB = (const char*)g.Bt + cur.boff;
    PG8_STAGE(PG8_SB(0, 0), cB, voffB); PG8_STAGE(PG8_SB(0, 1), cB + hstepB, voffB); PG8_STAGE_A(PG8_SA(0, 0), cA, 0, false); PG8_STAGE_A(PG8_SA(0, 1), cA, 1, false);
    if (wr == 1) PG8_BAR;
    PG8_WAIT_V(2); PG8_BAR;
    PG8_STAGE(PG8_SB(1, 0), cB + kstep, voffB); PG8_STAGE_A(PG8_SA(1, 0), cA + kstep, 0, false); PG8_STAGE(PG8_SB(1, 1), cB + hstepB + kstep, voffB);
    PG8_WAIT_V(6); PG8_BAR;
    for (;;) {
        const bool has_next = S.next(ui + 1, nxt);
        const char* nA = has_next ? (const char*)g.A + nxt.aoff : cA; const char* nB = has_next ? (const char*)g.Bt + nxt.boff : cB;
#pragma nounroll
        for (int t = 0; t < nt; t += 2) {
            const bool last = (t == nt - 2);
            const char* a1 = cA + (size_t)(t + 1) * kstep;
            const char* a2 = last ? nA : cA + (size_t)(t + 2) * kstep; const char* b2 = last ? nB : cB + (size_t)(t + 2) * kstep;
            const char* a3 = a2 + kstep; const char* b3 = b2 + kstep;
            PG8_LDB(B0, 0, 0); PG8_LDB(B1, 0, 1); PG8_SCHED; PG8_LDA(At, 0, 0); PG8_STAGE_A(PG8_SA(1, 1), a1, 1, false);
            PG8_WAIT_V(8); PG8_WAIT_L(0); PG8_BAR; PG8_MMA(0, 0, At, B0); PG8_MMA(0, 1, At, B1); PG8_BAR; PG8_SCHED;
            PG8_LDA(At, 0, 1); PG8_STAGE(PG8_SB(0, 0), b2, voffB); PG8_STAGE(PG8_SB(0, 1), b2 + hstepB, voffB); PG8_STAGE_A(PG8_SA(0, 0), a2, 0, last);
            PG8_WAIT_V(8); PG8_WAIT_L(0); PG8_BAR; PG8_MMA(1, 0, At, B0); PG8_MMA(1, 1, At, B1); PG8_BAR; PG8_SCHED;
            PG8_LDB(B0, 1, 0); PG8_LDB(B1, 1, 1); PG8_SCHED; PG8_LDA(At, 1, 0); PG8_STAGE_A(PG8_SA(0, 1), a2, 1, last);
            PG8_WAIT_V(8); PG8_WAIT_L(0); PG8_BAR; PG8_MMA(0, 0, At, B0); PG8_MMA(0, 1, At, B1); PG8_BAR; PG8_SCHED;
            PG8_LDA(At, 1, 1); PG8_STAGE(PG8_SB(1, 0), b3, voffB); PG8_STAGE(PG8_SB(1, 1), b3 + hstepB, voffB); PG8_STAGE_A(PG8_SA(1, 0), a3, 0, last);
            PG8_WAIT_V(8); PG8_WAIT_L(0); PG8_BAR; PG8_MMA(1, 0, At, B0); PG8_MMA(1, 1, At, B1); PG8_BAR; PG8_SCHED;
        }
        if (wr == 0) PG8_BAR;
        E(acc, cur, wr, wc, fr, fq);
        if (!has_next) break;
#pragma unroll
        for (int a = 0; a < 2; ++a)
#pragma unroll
            for (int b = 0; b < 2; ++b)
#pragma unroll
                for (int m = 0; m < 4; ++m)
#pragma unroll
                    for (int n = 0; n < 2; ++n) acc[a][b][m][n] = (f32x4){0.f, 0.f, 0.f, 0.f};
        cur = nxt; cA = nA; cB = nB; ++ui;
        PG8_GV(cur);
        if (wr == 1) PG8_BAR;
    }
    PG8_WAIT_V(0);
    PG8_BAR;
#undef PG8_SA
#undef PG8_SB
#undef PG8_STAGE
#undef PG8_STAGE_A
#undef PG8_GV
#undef PG8_LDA
#undef PG8_LDB
#undef PG8_MMA
#undef PG8_WAIT_V
#undef PG8_WAIT_L
#undef PG8_BAR
#undef PG8_SCHED
}

struct StaticOrder {
    int nM, nN, nwg, G, c; long astride, apn, bstride;
    __device__ void init(int nM_, int nN_, int G_, int c_, long astride_, long apn_, long bstride_) { nM = nM_; nN = nN_; nwg = nM * nN; G = G_; c = c_; astride = astride_; apn = apn_; bstride = bstride_; }
    __device__ bool next(int i, Unit& u) const {
        const long Lx = (long)i * G + c; if (Lx >= nwg) return false;
        int wgid = (int)Lx; { const int q = nwg / 8, r = nwg % 8, xcd = wgid % 8, off = wgid / 8; wgid = (xcd < r ? xcd * (q + 1) : r * (q + 1) + (xcd - r) * q) + off; }
        const int nig = 8 * nN, gid = wgid / nig, fm = gid * 8, gsz = (nM - fm) < 8 ? (nM - fm) : 8;
        u.pm = fm + ((wgid % nig) % gsz); u.pn = (wgid % nig) / gsz; u.aoff = (long)u.pm * astride + (long)u.pn * apn; u.boff = (long)u.pn * bstride; u.e = 0; u.idx0 = 0; return true;
    }
    __device__ int arow(const Unit&, int) const { return 0; }
};
}

constexpr int DM = 2048, NBATCH = 2, SEQ = 8192, CTX = 256;
constexpr int TL = NBATCH * SEQ;
constexpr int TC = NBATCH * CTX;
constexpr int TT = TL + TC;
constexpr int KEYS = CTX + SEQ;
constexpr int NEXP = 64, DEXP = 512;
constexpr int LISTCAP = 2 * TT;
constexpr float EPS = 1e-6f;
constexpr float QSCALE = 0.125f * 1.4426950408889634f;
constexpr int NWAVES = 8, NTHREADS = 512;

constexpr size_t MiB = 1u << 20;
constexpr size_t WS_CTL = 0, CTL_BYTES = 1 * MiB;
constexpr size_t WS_WIN0 = 1 * MiB;
constexpr size_t WS_WOUT0 = WS_WIN0 + 16 * MiB;
constexpr size_t WS_WIN1 = WS_WOUT0 + 8 * MiB;
constexpr size_t WS_WOUT1 = WS_WIN1 + 16 * MiB;
constexpr size_t WS_WPOOL = WS_WOUT1 + 8 * MiB;
constexpr size_t WS_WGLU = WS_WPOOL + 1 * MiB;
constexpr size_t WS_WMOE = WS_WGLU + 2 * MiB;
constexpr size_t MOE_E_BYTES = 6 * MiB, MOE_L_BYTES = 64 * MOE_E_BYTES;
constexpr size_t WS_X = WS_WMOE + 2 * MOE_L_BYTES;
constexpr size_t WS_HA = WS_X + 132 * MiB;
constexpr size_t WS_Q = WS_HA + 67 * MiB;
constexpr size_t WS_K = WS_Q + 33 * MiB;
constexpr size_t WS_VT = WS_K + 33 * MiB;
constexpr size_t WS_P = WS_VT + 33 * MiB;
constexpr size_t WS_PROJ1 = WS_Q;
constexpr size_t WS_CAT = WS_P + 33 * MiB;
constexpr size_t WS_PD = WS_CAT + 66 * MiB;
constexpr size_t WS_H = WS_PD + 33 * MiB;
constexpr size_t WS_Y = WS_H + 49 * MiB;
constexpr size_t WS_GT = WS_Y + 132 * MiB;
constexpr size_t WS_KT = WS_GT + 192 * MiB;
constexpr size_t WS_YD = WS_KT + 128 * MiB;
constexpr size_t WS_MISC = WS_YD + 128 * MiB;
constexpr size_t WS_MOD = WS_MISC;
constexpr size_t WS_ADAP = WS_MOD + 1 * MiB;
constexpr size_t WS_ROPE = WS_ADAP + 10 * MiB;
constexpr size_t WS_NORMP = WS_ROPE + 1 * MiB;
constexpr size_t WS_INVN = WS_NORMP + 4 * MiB;
constexpr size_t WS_S5LAM = WS_INVN + 1 * MiB;
constexpr size_t WS_S5B = WS_S5LAM + 1 * MiB;
constexpr size_t WS_WRT = WS_S5B + 2 * MiB;
constexpr size_t WS_TOKL = WS_WRT + 2 * MiB;
constexpr size_t WS_GATEL = WS_TOKL + 9 * MiB;
constexpr size_t WS_TW = WS_GATEL + 9 * MiB;
constexpr size_t WS_FFTW = WS_TW + 1 * MiB;
constexpr size_t WS_S5L256 = WS_FFTW + 32 * MiB;
constexpr size_t WS_S5E = WS_S5L256 + 1 * MiB;
constexpr size_t WS_YHT = WS_S5E + 4 * MiB;
constexpr size_t WS_END = WS_YHT + 64 * MiB;
static_assert(WS_END <= 2040 * MiB, "d_ws map");
constexpr int CW_BAR = 1024;
constexpr int CW_CNT = 8192;

constexpr int LDS_PHASE = 131072;
constexpr int LDS_CTL = 147456 - 2048;
constexpr int LDS_BYTES = 147456;

#define XB_TMO      128
#define XB_XCNT(j)  (256  + 64 * (j))
#define XB_XSUB(j)  (1280 + 64 * (j))
#define XB_XGEN(j)  (2304 + 64 * (j))
#define XB_TOP      3328
#define XB_TOPGEN   3392
#define XCD_BAR_WORDS 3456
#define XB_SPIN_CAP (1u << 22)

__device__ __forceinline__ unsigned xb_ld(unsigned* p)              { return __hip_atomic_load(p, __ATOMIC_RELAXED, __HIP_MEMORY_SCOPE_AGENT); }
__device__ __forceinline__ unsigned xb_add(unsigned* p, unsigned v) { return __hip_atomic_fetch_add(p, v, __ATOMIC_RELAXED, __HIP_MEMORY_SCOPE_AGENT); }
__device__ __forceinline__ unsigned xb_xcc_id() { return (unsigned)__builtin_amdgcn_s_getreg((3 << 11) | 20) & 0xFu; }
#define XB_SPIN(cond, bar) do { unsigned _sp = 0; while (cond) { __builtin_amdgcn_s_sleep(1); \
    if ((++_sp & 255u) == 0u) { if (xb_ld(&(bar)[XB_TMO])) break; if (_sp > XB_SPIN_CAP) { atomicAdd(&(bar)[XB_TMO], 1u); break; } } } } while (0)

struct XcdBarrier { unsigned* bar; unsigned x; volatile LAS unsigned* st; };

__device__ __forceinline__ XcdBarrier xcd_barrier_post(unsigned* bar, volatile LAS unsigned* st) {
    XcdBarrier b; b.bar = bar; b.x = xb_xcc_id(); b.st = st;
    if (threadIdx.x == 0) (void)xb_add(&bar[XB_XCNT(b.x)], 1u);
    return b;
}
__device__ __forceinline__ void xcd_barrier_complete(unsigned* bar, unsigned x, unsigned& nloc, unsigned& nx) {
    const unsigned G = gridDim.x * gridDim.y * gridDim.z;
    unsigned sum, cnt, mine, sp = 0u;
    for (;;) {
        sum = 0u; cnt = 0u; mine = 0u;
#pragma unroll
        for (unsigned j = 0; j < 16; ++j) { const unsigned c = xb_ld(&bar[XB_XCNT(j)]); sum += c; cnt += (c > 0u) ? 1u : 0u; mine = (j == x) ? c : mine; }
        if (sum == G) break;
        __builtin_amdgcn_s_sleep(1);
        if ((++sp & 255u) == 0u) { if (xb_ld(&bar[XB_TMO])) break; if (sp > XB_SPIN_CAP) { atomicAdd(&bar[XB_TMO], 1u); break; } }
    }
    nloc = mine > 0u ? mine : 1u; nx = cnt > 0u ? cnt : 1u;
}
__device__ __forceinline__ void xcd_barrier(const XcdBarrier& b) {
    asm volatile("s_waitcnt vmcnt(0)" ::: "memory");
    __syncthreads();
    if (threadIdx.x == 0) {
        unsigned* bar = b.bar;
        __builtin_amdgcn_s_waitcnt(0);
        unsigned nloc = b.st[0], nx = b.st[1];
        if (nloc == 0u) { xcd_barrier_complete(bar, b.x, nloc, nx); b.st[0] = nloc; b.st[1] = nx; }
        const unsigned old = xb_add(&bar[XB_XSUB(b.x)], 1u);
        const unsigned gen = old / nloc;
        if (old + 1u == (gen + 1u) * nloc) {
            __builtin_amdgcn_fence(__ATOMIC_RELEASE, "agent");
            asm volatile("s_waitcnt vmcnt(0)" ::: "memory");
            const unsigned og = xb_add(&bar[XB_TOP], 1u);
            const unsigned tg = og / nx;
            if (og + 1u == (tg + 1u) * nx) xb_add(&bar[XB_TOPGEN], 1u);
            else XB_SPIN(xb_ld(&bar[XB_TOPGEN]) == tg, bar);
            __builtin_amdgcn_fence(__ATOMIC_ACQUIRE, "agent");
            xb_add(&bar[XB_XGEN(b.x)], 1u);
            asm volatile("s_waitcnt vmcnt(0)" ::: "memory");
        } else {
            XB_SPIN(xb_ld(&bar[XB_XGEN(b.x)]) == gen, bar);
            __builtin_amdgcn_fence(__ATOMIC_ACQUIRE, "agent");
            asm volatile("s_waitcnt vmcnt(0)" ::: "memory");
        }
    }
    __syncthreads();
}

__device__ __forceinline__ void sincos_2pi(double x, double& s, double& c) {
    const double q = __builtin_rint(x * 4.0);
    const double y = (x - q * 0.25) * 6.283185307179586476925;
    const double y2 = y * y;
    double sp = -7.6471637318198164759e-13; sp = sp * y2 + 1.6059043836821614599e-10; sp = sp * y2 - 2.5052108385441718775e-8; sp = sp * y2 + 2.7557319223985890653e-6;
    sp = sp * y2 - 1.9841269841269841270e-4; sp = sp * y2 + 8.3333333333333333333e-3; sp = sp * y2 - 1.6666666666666666667e-1; sp = sp * y2 * y + y;
    double cp = 4.7794773323873852974e-14; cp = cp * y2 - 1.1470745597729724714e-11; cp = cp * y2 + 2.0876756987868098979e-9; cp = cp * y2 - 2.7557319223985890653e-7;
    cp = cp * y2 + 2.4801587301587301587e-5; cp = cp * y2 - 1.3888888888888888889e-3; cp = cp * y2 + 4.1666666666666666667e-2; cp = cp * y2 - 0.5; cp = cp * y2 + 1.0;
    const int qi = ((int)q) & 3;
    s = (qi == 0) ? sp : (qi == 1) ? cp : (qi == 2) ? -sp : -cp;
    c = (qi == 0) ? cp : (qi == 1) ? -sp : (qi == 2) ? -cp : sp;
}
__device__ __forceinline__ void sincos_rad(double a, double& s, double& c) {
    double f = a * 0.15915494309189533576888; f -= __builtin_floor(f);
    if (f >= 1.0) f = 0.0;
    sincos_2pi(f, s, c);
}
__device__ __forceinline__ double exp_small(double x) {
    double r = 1.0 / 479001600.0;
    r = r * x + 1.0 / 39916800.0; r = r * x + 1.0 / 3628800.0; r = r * x + 1.0 / 362880.0; r = r * x + 1.0 / 40320.0; r = r * x + 1.0 / 5040.0;
    r = r * x + 1.0 / 720.0; r = r * x + 1.0 / 120.0; r = r * x + 1.0 / 24.0; r = r * x + 1.0 / 6.0; r = r * x + 0.5; r = r * x + 1.0; r = r * x + 1.0;
    return r;
}
__device__ __forceinline__ float fast_exp(float x) { return __builtin_amdgcn_exp2f(x * 1.4426950408889634f); }
__device__ __forceinline__ float sigmoidf_(float x) { return 1.0f / (1.0f + fast_exp(-x)); }
__device__ __forceinline__ float siluf_(float x) { return x * sigmoidf_(x); }
__device__ __forceinline__ float tanhf_(float x) { const float e = fast_exp(-2.0f * fabsf(x)); const float t = (1.0f - e) / (1.0f + e); return x < 0.f ? -t : t; }
__device__ __forceinline__ float gelu_tanh(float x) { return 0.5f * x * (1.0f + tanhf_(0.7978845608028654f * (x + 0.044715f * x * x * x))); }

#ifndef PH_REPEAT
#define PH_REPEAT 0u
#endif
struct Args { const float* in[43]; float* out; unsigned char* ws; int ph_lo, ph_hi; };

struct Frame {
    LAS unsigned char* lds; unsigned char* ws; int tid, lane, wave, bid, G, gw, NGW;
    const __attribute__((address_space(4))) unsigned long long* kin;
};
#define INP(i) ((const float*)F.kin[i])
#define WSP(T, off) ((T*)(F.ws + (off)))

__device__ __forceinline__ void tr_item(const float* W, int ldw, int N, bf16* WT, int ldt, int row_off, int rs16, LAS float* scr, int item, int lane) {
    const int nblk = N / 64, kb = item / nblk, nb = item % nblk, k0 = 64 * kb, n0 = 64 * nb;
    const int la = lane & 15, lb = lane >> 4;
    f32x4 v[16];
#pragma unroll
    for (int i = 0; i < 16; ++i) v[i] = *(const f32x4*)(W + (size_t)(k0 + 4 * i + lb) * ldw + n0 + 4 * la);
#pragma unroll
    for (int i = 0; i < 16; ++i) { const int kk = 4 * i + lb; LAS float* d = scr + (4 * la) * 65 + kk; d[0] = v[i].x; d[65] = v[i].y; d[130] = v[i].z; d[195] = v[i].w; }
    LDS_WAIT(); asm volatile("" ::: "memory");
    const int c = lane & 7;
#pragma unroll
    for (int j = 0; j < 8; ++j) { const int n = (lane >> 3) + 8 * j; const LAS float* s = scr + n * 65 + 8 * c;
        v4u o; o.x = cvt_pk_bf16(s[0], s[1]); o.y = cvt_pk_bf16(s[2], s[3]); o.z = cvt_pk_bf16(s[4], s[5]); o.w = cvt_pk_bf16(s[6], s[7]);
        const int nn = n0 + n, drow = row_off + (nn >> 4) * rs16 + (nn & 15);
        *(v4u*)(WT + (size_t)drow * ldt + k0 + 8 * c) = o; }
    LDS_WAIT(); asm volatile("" ::: "memory");
}

__device__ __forceinline__ void hyfilt_item(Frame& F, int pb) {
    const float* w1 = INP(19); const float* b1 = INP(20); const float* fq = INP(21); const float* w2 = INP(22); const float* b2 = INP(23); const float* w3 = INP(24);
    LAS float* z = (LAS float*)F.lds;
    LAS float* h1 = z + 1088;
    LAS float* h2 = h1 + 2048;
    const int tid = F.tid;
    for (int idx = tid; idx < 32 * 33; idx += NTHREADS) {
        const int p = idx / 33, f = idx % 33, i = pb * 32 + p;
        float v;
        if (f == 0) v = (float)i * (1.0f / (float)(SEQ - 1));
        else { const int j = (f - 1) & 15; const float fj = 1e-4f + (float)j * ((15.0f - 1e-4f) / 15.0f);
            double fr = (double)fj * (double)i / (double)SEQ; fr -= __builtin_floor(fr); double s, c; sincos_2pi(fr, s, c); v = (f <= 16) ? (float)c : (float)(-s); }
        z[p * 33 + f] = v;
    }
    __syncthreads();
    for (int idx = tid; idx < 2048; idx += NTHREADS) {
        const int p = idx >> 6, j = idx & 63; float a = b1[j];
        for (int f = 0; f < 33; ++f) a += z[p * 33 + f] * w1[f * 64 + j];
        double s, c; sincos_rad((double)(fq[j] * a), s, c); h1[idx] = (float)s;
    }
    __syncthreads();
    for (int idx = tid; idx < 2048; idx += NTHREADS) {
        const int p = idx >> 6, j = idx & 63; float a = b2[j];
        for (int k = 0; k < 64; ++k) a += h1[p * 64 + k] * w2[k * 64 + j];
        double s, c; sincos_rad((double)(fq[64 + j] * a), s, c); h2[idx] = (float)s;
    }
    __syncthreads();
    float* kT = WSP(float, WS_KT); float* normp = WSP(float, WS_NORMP);
    {
        const int lane = F.lane, l31 = lane & 31, lh = lane >> 5;
        float af[32];
#pragma unroll
        for (int s = 0; s < 32; ++s) af[s] = h2[l31 * 64 + 2 * s + lh];
        for (int ct = F.wave; ct < 128; ct += NWAVES) {
            const int col = ct * 32 + l31;
            f32x16 acc;
#pragma unroll
            for (int r = 0; r < 16; ++r) acc[r] = 0.f;
            float bv[32];
#pragma unroll
            for (int s = 0; s < 32; ++s) bv[s] = w3[(size_t)(2 * s + lh) * 4096 + col];
#pragma unroll
            for (int s = 0; s < 32; ++s) acc = __builtin_amdgcn_mfma_f32_32x32x2f32(af[s], bv[s], acc, 0, 0, 0);
            const int ch = col & 1023, dir = (col >> 10) & 1;
            const float adel = 3.0701134573253946f + (float)ch * ((15.350567286626972f - 3.0701134573253946f) / 1023.0f);
            float sabs = 0.f;
#pragma unroll
            for (int r = 0; r < 16; ++r) { const int i = pb * 32 + (r & 3) + 8 * (r >> 2) + 4 * lh; const float t = (float)i * (1.0f / (float)(SEQ - 1)); acc[r] *= fast_exp(-t * adel); if (!(dir == 1 && i == 0)) sabs += fabsf(acc[r]); }
            sabs += __shfl_xor(sabs, 32);
#pragma unroll
            for (int q = 0; q < 4; ++q) *(f32x4*)(kT + (size_t)col * SEQ + pb * 32 + 8 * q + 4 * lh) = (f32x4){acc[4 * q], acc[4 * q + 1], acc[4 * q + 2], acc[4 * q + 3]};
            if (lh == 0) normp[(size_t)pb * 4096 + col] = sabs;
        }
    }
    __syncthreads();
}

__device__ __forceinline__ void tr_wg_item(Frame& F, const float* W, int ldw, bf16* WT, int ldt, int row_off, int rs16, int k0, int n0) {
    LAS float* T = (LAS float*)F.lds;
    const int t = F.tid;
    f32x4 v[16];
#pragma unroll
    for (int i = 0; i < 16; ++i) v[i] = *(const f32x4*)(W + (size_t)(k0 + 4 * i + (t >> 7)) * ldw + n0 + 4 * (t & 127));
#pragma unroll
    for (int i = 0; i < 16; ++i) { const int k = 4 * i + (t >> 7); *(LAS f32x4*)(T + k * 516 + ((4 * (t & 127) + 8 * (k >> 3)) & 511)) = v[i]; }
    __syncthreads();
    const int c = (t >> 3) & 7, nl = (t & 7) | ((t >> 6) << 3);
#pragma unroll
    for (int q = 0; q < 8; ++q) { const int n = 64 * q + nl; const LAS float* s = T + (8 * c) * 516 + ((n + 8 * c) & 511);
        v4u o; o.x = cvt_pk_bf16(s[0], s[516]); o.y = cvt_pk_bf16(s[2 * 516], s[3 * 516]); o.z = cvt_pk_bf16(s[4 * 516], s[5 * 516]); o.w = cvt_pk_bf16(s[6 * 516], s[7 * 516]);
        const int nn = n0 + n, drow = row_off + (nn >> 4) * rs16 + (nn & 15);
        *(v4u*)(WT + (size_t)drow * ldt + k0 + 8 * c) = o; }
    __syncthreads();
}

__device__ __forceinline__ void p0_prologue(Frame& F) {
    for (int rep = 0; rep < (((PH_REPEAT >> 25) & 1u) ? 2 : 1); ++rep)
    for (int pb = F.bid; pb < SEQ / 32; pb += F.G) hyfilt_item(F, pb);
    for (int rep = 0; rep < (((PH_REPEAT >> 24) & 1u) ? 2 : 1); ++rep)
    for (int it = F.bid; it < 128 * 96; it += F.G) {
        const int le = it / 96, q = it % 96;
        bf16* wc = (bf16*)(F.ws + WS_WMOE + (size_t)le * MOE_E_BYTES); bf16* w2t = wc + 1024 * 2048;
        if (q < 32) tr_wg_item(F, INP(40) + (size_t)le * (2048 * 512), 512, wc, 2048, 0, 32, 64 * q, 0);
        else if (q < 64) tr_wg_item(F, INP(41) + (size_t)le * (2048 * 512), 512, wc, 2048, 16, 32, 64 * (q - 32), 0);
        else { const int r = q - 64; tr_wg_item(F, INP(42) + (size_t)le * (512 * 2048), 2048, w2t, 512, 0, 16, 64 * (r >> 2), 512 * (r & 3)); }
    }
    const int gt = F.bid * NTHREADS + F.tid, NGT = F.G * NTHREADS;
    {
        f32x2* rope = WSP(f32x2, WS_ROPE);
        for (int idx = gt; idx < 128 * 16; idx += NGT) { const int pos = idx >> 4, i = idx & 15;
            double inv = (i & 3) == 0 ? 1.0 : (i & 3) == 1 ? 0.56234132519034908 : (i & 3) == 2 ? 0.31622776601683794 : 0.17782794100389228;
            inv *= (i >> 2) == 0 ? 1.0 : (i >> 2) == 1 ? 0.1 : (i >> 2) == 2 ? 0.01 : 0.001;
            const float ang = (float)pos * (float)inv; double s, c; sincos_rad((double)ang, s, c); rope[idx] = (f32x2){(float)c, (float)s}; }
    }
    {
        f32x2* tw = WSP(f32x2, WS_TW);
        for (int idx = gt; idx < 16384; idx += NGT) { double s, c; sincos_2pi((double)idx * (1.0 / 16384.0), s, c); tw[idx] = (f32x2){(float)c, (float)(-s)}; }
    }
    {
        const float* are = INP(26); const float* aim = INP(27); const float* ldt = INP(28); const float* bre = INP(29); const float* bim = INP(30);
        f32x2* lamb = WSP(f32x2, WS_S5LAM); f32x2* bb = WSP(f32x2, WS_S5B); f32x2* l256 = WSP(f32x2, WS_S5L256);
        for (int idx = gt; idx < 2 * 64 * 64; idx += NGT) { const int dg = idx >> 6;
            const float dt = expf(ldt[dg]); const float ar = are[idx], ai = aim[idx];
            const float zr = ar * dt, zi = ai * dt; double s, c; sincos_rad((double)zi, s, c); const double er = exp_small((double)zr);
            const double lr = er * c, li = er * s; lamb[idx] = (f32x2){(float)lr, (float)li};
            { double pr = lr, pi = li; for (int q = 0; q < 8; ++q) { const double tr = pr * pr - pi * pi, ti = 2.0 * pr * pi; pr = tr; pi = ti; } l256[idx] = (f32x2){(float)pr, (float)pi}; }
            const double nr = lr - 1.0, ni = li, den = (double)ar * ar + (double)ai * ai; const double qr = (nr * ar + ni * ai) / den, qi = (ni * ar - nr * ai) / den;
            for (int cc = 0; cc < 16; ++cc) { const double br = bre[(size_t)idx * 16 + cc], bi = bim[(size_t)idx * 16 + cc]; bb[(size_t)idx * 16 + cc] = (f32x2){(float)(qr * br - qi * bi), (float)(qr * bi + qi * br)}; } }
    }
    {
        float* wrt = WSP(float, WS_WRT);
        for (int idx = gt; idx < 2 * 72 * 2048; idx += NGT) { const int l = idx / (72 * 2048), r = idx % (72 * 2048), n = r / 2048, k = r % 2048;
            wrt[idx] = n < 8 ? INP(36)[((size_t)l * 2048 + k) * 8 + n] : INP(38)[((size_t)l * 2048 + k) * 64 + (n - 8)]; }
    }
    {
        bf16* ha = WSP(bf16, WS_HA);
        for (int idx = gt; idx < 2048; idx += NGT) ha[(size_t)TT * 2048 + idx] = 0;
    }
    LAS float* scr = (LAS float*)(F.lds + F.wave * 16896);
    {
        const float* c = INP(1); const float* cctx = INP(3); const float* adaw = INP(4); float* part = WSP(float, WS_ADAP);
        for (int rep = 0; rep < (((PH_REPEAT >> 26) & 1u) ? 2 : 1); ++rep)
        for (int it = F.gw; it < 2 * 32 * 48; it += F.NGW) {
            const int l = it / (32 * 48), r = it % (32 * 48), ks = r / 48, jb = r % 48, k0 = ks * 64, j0 = jb * 256 + F.lane * 4;
            const float c0 = c[k0 + F.lane], c1 = c[2048 + k0 + F.lane], c2 = cctx[k0 + F.lane];
            const float s0 = c0 / (1.0f + expf(-c0)), s1 = c1 / (1.0f + expf(-c1)), s2 = c2 / (1.0f + expf(-c2));
            f32x4 a0 = {0.f, 0.f, 0.f, 0.f}, a1 = a0, a2 = a0;
            const float* wp = adaw + ((size_t)l * 2048 + k0) * 12288 + j0;
#pragma unroll 8
            for (int kk = 0; kk < 64; ++kk) { const f32x4 w = *(const f32x4*)(wp + (size_t)kk * 12288);
                const float t0 = __builtin_bit_cast(float, __builtin_amdgcn_readlane(__builtin_bit_cast(int, s0), kk));
                const float t1 = __builtin_bit_cast(float, __builtin_amdgcn_readlane(__builtin_bit_cast(int, s1), kk));
                const float t2 = __builtin_bit_cast(float, __builtin_amdgcn_readlane(__builtin_bit_cast(int, s2), kk));
                a0 += w * t0; a1 += w * t1; a2 += w * t2; }
            float* pp = part + ((size_t)(l * 32 + ks) * 3) * 12288 + j0;
            *(f32x4*)(pp) = a0; *(f32x4*)(pp + 12288) = a1; *(f32x4*)(pp + 2 * 12288) = a2;
        }
    }
    {
        constexpr int I0 = 1024, I1 = 512, I2 = 512, I3 = 1024, I4 = 2048, I5 = 1024, I6 = 64, I7 = 256, IE = 768;
        constexpr int NSMALL = I0 + I1 + I2 + I3 + I4 + I5 + I6 + I7;
        const int NITEMS = NSMALL;
        for (int rep = 0; rep < (((PH_REPEAT >> 27) & 1u) ? 2 : 1); ++rep)
        for (int it = F.gw; it < NITEMS; it += F.NGW) {
            int r = it;
            if (r < I0) { tr_item(INP(9), 4096, 2048, WSP(bf16, WS_WIN0), 2048, 0, 16, scr, r, F.lane); continue; } r -= I0;
            if (r < I1) { tr_item(INP(9) + 2048, 4096, 1024, WSP(bf16, WS_WIN0), 2048, 3072, 16, scr, r, F.lane); continue; } r -= I1;
            if (r < I2) { tr_item(INP(9) + 3072, 4096, 1024, WSP(bf16, WS_WIN0), 2048, 2048, 16, scr, r, F.lane); continue; } r -= I2;
            if (r < I3) { tr_item(INP(10), 2048, 2048, WSP(bf16, WS_WOUT0), 2048, 0, 16, scr, r, F.lane); continue; } r -= I3;
            if (r < I4) { tr_item(INP(15), 4096, 4096, WSP(bf16, WS_WIN1), 2048, 0, 16, scr, r, F.lane); continue; } r -= I4;
            if (r < I5) { tr_item(INP(16), 2048, 2048, WSP(bf16, WS_WOUT1), 2048, 0, 16, scr, r, F.lane); continue; } r -= I5;
            if (r < I6) { const int g = r / 16; tr_item(INP(13) + (size_t)g * 65536, 256, 256, WSP(bf16, WS_WPOOL), 256, g * 256, 16, scr, r % 16, F.lane); continue; } r -= I6;
            if (r < I7) { tr_item(INP(34), 1024, 1024, WSP(bf16, WS_WGLU), 1024, 0, 16, scr, r, F.lane); continue; } r -= I7;
        }
    }
}

__device__ __forceinline__ void p1_reduce(Frame& F) {
    const int gt = F.bid * NTHREADS + F.tid, NGT = F.G * NTHREADS;
    const float* part = WSP(float, WS_ADAP); float* mod = WSP(float, WS_MOD); const float* adab = INP(5);
    for (int idx = gt; idx < 2 * 3 * 12288; idx += NGT) { const int l = idx / (3 * 12288), r = idx % (3 * 12288), m = r / 12288, j = r % 12288;
        float a = adab[l * 12288 + j];
        for (int ks = 0; ks < 32; ++ks) a += part[((size_t)(l * 32 + ks) * 3 + m) * 12288 + j];
        mod[idx] = a; }
    const float* normp = WSP(float, WS_NORMP); float* invn = WSP(float, WS_INVN);
    for (int idx = gt; idx < 2048; idx += NGT) { const int o = idx >> 10, ch = idx & 1023; float a = 0.f;
        for (int pb = 0; pb < 256; ++pb) a += normp[(size_t)pb * 4096 + o * 2048 + ch] + normp[(size_t)pb * 4096 + o * 2048 + 1024 + ch];
        invn[idx] = 1.0f / a; }
}

__device__ __forceinline__ const float* modp(Frame& F, int l, int m, int c) { return WSP(float, WS_MOD) + ((size_t)(l * 3 + m) * 6 + c) * 2048; }
__device__ __forceinline__ int row_stream(int r) { return r < TL ? r / SEQ : 2; }

template <int MODE>
__device__ __forceinline__ void norm_phase(Frame& F, int l, float* dout) {
    const int nrows = (MODE == 3 || (MODE == 1 && l == 1)) ? TL : TT;
    float* xbuf = WSP(float, WS_X); bf16* ha = WSP(bf16, WS_HA); const bf16* Y = WSP(bf16, WS_Y);
    const float* gvec = (MODE == 0) ? INP(6) : (MODE == 1) ? INP(7) + l * 2048 : (MODE == 2) ? INP(6) + 2048 : INP(8);
    const int lane = F.lane;
    for (int r = F.gw; r < nrows; r += F.NGW) {
        const int m = row_stream(r);
        const float* src = (MODE == 0) ? (r < TL ? INP(0) + (size_t)r * 2048 : INP(2) + (size_t)(r - TL) * 2048) : xbuf + (size_t)r * 2048;
        f32x4 v[8]; float ss = 0.f;
#pragma unroll
        for (int j = 0; j < 8; ++j) v[j] = *(const f32x4*)(src + 4 * lane + 256 * j);
        if (MODE == 2 || MODE == 3) {
            const float* g2 = modp(F, MODE == 2 ? 0 : 1, m, 5);
            const bf16* y0 = Y + (size_t)(2 * r) * 2048; const bf16* y1 = y0 + 2048;
#pragma unroll
            for (int j = 0; j < 8; ++j) { const int c = 4 * lane + 256 * j; const v2u a = *(const v2u*)(y0 + c), b = *(const v2u*)(y1 + c); const f32x4 gg = *(const f32x4*)(g2 + c);
                v[j].x += gg.x * (bflo(a.x) + bflo(b.x)); v[j].y += gg.y * (bfhi(a.x) + bfhi(b.x)); v[j].z += gg.z * (bflo(a.y) + bflo(b.y)); v[j].w += gg.w * (bfhi(a.y) + bfhi(b.y)); }
            if (MODE == 2) {
#pragma unroll
                for (int j = 0; j < 8; ++j) *(f32x4*)(xbuf + (size_t)r * 2048 + 4 * lane + 256 * j) = v[j];
            }
        }
#pragma unroll
        for (int j = 0; j < 8; ++j) ss += (v[j].x * v[j].x + v[j].y * v[j].y) + (v[j].z * v[j].z + v[j].w * v[j].w);
        ss = wave_sum(ss);
        const float rs = 1.0f / sqrtf(ss * (1.0f / 2048.0f) + EPS);
        if (MODE == 3) {
#pragma unroll
            for (int j = 0; j < 8; ++j) { const int c = 4 * lane + 256 * j; const f32x4 gg = *(const f32x4*)(gvec + c); *(f32x4*)(dout + (size_t)r * 2048 + c) = v[j] * rs * gg; }
            continue;
        }
        const int lm = (MODE == 2) ? 1 : l;
        const float* sh = modp(F, lm, m, MODE == 1 ? 3 : 0); const float* sc = modp(F, lm, m, MODE == 1 ? 4 : 1);
#pragma unroll
        for (int j = 0; j < 8; ++j) { const int c = 4 * lane + 256 * j; const f32x4 gg = *(const f32x4*)(gvec + c), s1 = *(const f32x4*)(sc + c), s0 = *(const f32x4*)(sh + c);
            v[j] = (v[j] * rs * gg) * (1.0f + s1) + s0;
            v2u o; o.x = pk2(v[j].x, v[j].y); o.y = pk2(v[j].z, v[j].w); *(v2u*)(ha + (size_t)r * 2048 + c) = o; }
    }
}

__device__ __forceinline__ void ffn_norm_router_phase(Frame& F, int l) {
    const int nrows = (l == 1) ? TL : TT;
    const float* xbuf = WSP(float, WS_X); bf16* ha = WSP(bf16, WS_HA);
    const float* gvec = INP(7) + l * 2048;
    const float* wrt = WSP(float, WS_WRT) + (size_t)l * 72 * 2048;
    LAS float* lg = (LAS float*)(F.lds + F.wave * 2048);
    const int lane = F.lane;
    for (int r0 = F.gw * 4; r0 < nrows; r0 += F.NGW * 4) {
        f32x4 v[4][8];
#pragma unroll
        for (int rr = 0; rr < 4; ++rr) {
            const int r = r0 + rr, m = row_stream(r);
            const float* src = xbuf + (size_t)r * 2048; float ss = 0.f;
#pragma unroll
            for (int j = 0; j < 8; ++j) { v[rr][j] = *(const f32x4*)(src + 4 * lane + 256 * j); ss += (v[rr][j].x * v[rr][j].x + v[rr][j].y * v[rr][j].y) + (v[rr][j].z * v[rr][j].z + v[rr][j].w * v[rr][j].w); }
            ss = wave_sum(ss);
            const float rs = 1.0f / sqrtf(ss * (1.0f / 2048.0f) + EPS);
            const float* sh = modp(F, l, m, 3); const float* sc = modp(F, l, m, 4);
#pragma unroll
            for (int j = 0; j < 8; ++j) { const int c = 4 * lane + 256 * j; const f32x4 gg = *(const f32x4*)(gvec + c), s1 = *(const f32x4*)(sc + c), s0 = *(const f32x4*)(sh + c);
                v[rr][j] = (v[rr][j] * rs * gg) * (1.0f + s1) + s0;
                v2u o; o.x = pk2(v[rr][j].x, v[rr][j].y); o.y = pk2(v[rr][j].z, v[rr][j].w); *(v2u*)(ha + (size_t)r * 2048 + c) = o; }
        }
        const bool b5 = (lane & 32) != 0, b4 = (lane & 16) != 0, b3 = (lane & 8) != 0, b2 = (lane & 4) != 0, b1 = (lane & 2) != 0;
#pragma nounroll
        for (int q = 0; q < 9; ++q) {
            float a[32];
#pragma unroll
            for (int nn = 0; nn < 8; ++nn) { const float* wn = wrt + (size_t)(q * 8 + nn) * 2048 + 4 * lane; float s0 = 0.f, s1 = 0.f, s2 = 0.f, s3 = 0.f;
#pragma unroll
                for (int j = 0; j < 8; ++j) { const f32x4 w = *(const f32x4*)(wn + 256 * j);
                    s0 += (v[0][j].x * w.x + v[0][j].y * w.y) + (v[0][j].z * w.z + v[0][j].w * w.w); s1 += (v[1][j].x * w.x + v[1][j].y * w.y) + (v[1][j].z * w.z + v[1][j].w * w.w);
                    s2 += (v[2][j].x * w.x + v[2][j].y * w.y) + (v[2][j].z * w.z + v[2][j].w * w.w); s3 += (v[3][j].x * w.x + v[3][j].y * w.y) + (v[3][j].z * w.z + v[3][j].w * w.w); }
                a[nn] = s0; a[8 + nn] = s1; a[16 + nn] = s2; a[24 + nn] = s3; }
            float c16[16], c8[8], c4[4], c2[2], c1;
#pragma unroll
            for (int i = 0; i < 16; ++i) { const float keep = b5 ? a[i + 16] : a[i], send = b5 ? a[i] : a[i + 16]; c16[i] = keep + __shfl_xor(send, 32); }
#pragma unroll
            for (int i = 0; i < 8; ++i) { const float keep = b4 ? c16[i + 8] : c16[i], send = b4 ? c16[i] : c16[i + 8]; c8[i] = keep + __shfl_xor(send, 16); }
#pragma unroll
            for (int i = 0; i < 4; ++i) { const float keep = b3 ? c8[i + 4] : c8[i], send = b3 ? c8[i] : c8[i + 4]; c4[i] = keep + __shfl_xor(send, 8); }
#pragma unroll
            for (int i = 0; i < 2; ++i) { const float keep = b2 ? c4[i + 2] : c4[i], send = b2 ? c4[i] : c4[i + 2]; c2[i] = keep + __shfl_xor(send, 4); }
            { const float keep = b1 ? c2[1] : c2[0], send = b1 ? c2[0] : c2[1]; c1 = keep + __shfl_xor(send, 2); }
            c1 += __shfl_xor(c1, 1);
            if ((lane & 1) == 0) { const int i = lane >> 1; lg[(i >> 3) * 80 + q * 8 + (i & 7)] = c1; }
        }
        LDS_WAIT(); asm volatile("" ::: "memory");
        if (lane < 4) {
            const int r = r0 + lane; const LAS float* L = lg + lane * 80;
            float gl[8]; float gmax = -INFINITY; int gi = 0;
#pragma unroll
            for (int j = 0; j < 8; ++j) { gl[j] = L[j] + INP(37)[l * 8 + j]; if (gl[j] > gmax) { gmax = gl[j]; gi = j; } }
            float gsum = 0.f;
#pragma unroll
            for (int j = 0; j < 8; ++j) gsum += expf(gl[j] - gmax);
            const float pg_top = 1.0f / gsum;
            float pe[8]; float emax = -INFINITY;
#pragma unroll
            for (int j = 0; j < 8; ++j) { pe[j] = L[8 + gi * 8 + j] + INP(39)[l * 64 + gi * 8 + j]; emax = fmaxf(emax, pe[j]); }
            float esum = 0.f;
#pragma unroll
            for (int j = 0; j < 8; ++j) { pe[j] = expf(pe[j] - emax); esum += pe[j]; }
            int e1 = 0; float p1 = -1.f;
#pragma unroll
            for (int j = 0; j < 8; ++j) { pe[j] /= esum; if (pe[j] > p1) { p1 = pe[j]; e1 = j; } }
            int e2 = 0; float p2 = -1.f;
#pragma unroll
            for (int j = 0; j < 8; ++j) { if (j != e1 && pe[j] > p2) { p2 = pe[j]; e2 = j; } }
            const float den = p1 + p2; const float g1 = pg_top * p1 / den, g2 = pg_top * p2 / den;
            unsigned* cnt = WSP(unsigned, WS_CTL) + CW_CNT + l * 64; int* tokl = WSP(int, WS_TOKL); float* gatel = WSP(float, WS_GATEL);
            const int ex1 = gi * 8 + e1, ex2 = gi * 8 + e2;
            const unsigned k1 = atomicAdd(cnt + ex1, 1u); tokl[(size_t)ex1 * LISTCAP + k1] = 2 * r; gatel[(size_t)ex1 * LISTCAP + k1] = g1;
            const unsigned k2 = atomicAdd(cnt + ex2, 1u); tokl[(size_t)ex2 * LISTCAP + k2] = 2 * r + 1; gatel[(size_t)ex2 * LISTCAP + k2] = g2;
        }
        LDS_WAIT(); asm volatile("" ::: "memory");
    }
}

#define EPI_ARGS const f32x4 (&acc)[2][2][4][2], const pg8::Unit& u, int wr, int wc, int fr, int fq
__device__ __forceinline__ void st_bf4(bf16* p, f32x4 v) { v2u o; o.x = cvt_pk_bf16(v.x, v.y); o.y = cvt_pk_bf16(v.z, v.w); *(v2u*)p = o; }

struct EpiQKP {
    bf16* Q; bf16* Kb; bf16* P; const f32x2* rope;
    __device__ __forceinline__ void operator()(EPI_ARGS) const {
        const int sect = u.pn >> 2, cb = (u.pn & 3) * 256; const bool latent = u.pm < TL / 256;
#pragma unroll
        for (int ai = 0; ai < 2; ++ai)
#pragma unroll
            for (int m = 0; m < 4; ++m) {
                const int r = u.pm * 256 + ai * 128 + wr * 64 + m * 16 + fr;
                int b, t; if (latent) { b = r / SEQ; t = r % SEQ; } else { b = (r - TL) / CTX; t = (r - TL) % CTX; }
                f32x4 cs0 = {1.f, 0.f, 1.f, 0.f}, cs1 = cs0;
                if (latent && sect < 2) { const int pos = (wc & 1) ? (t & 63) : (t >> 6); const f32x4* rp = (const f32x4*)(rope + pos * 16 + 4 * fq); cs0 = rp[0]; cs1 = rp[1]; }
#pragma unroll
                for (int bj = 0; bj < 2; ++bj) {
                    const int c0 = cb + bj * 128 + wc * 32 + 4 * fq;
                    f32x4 a = acc[ai][bj][m][0], bb = acc[ai][bj][m][1];
                    if (sect < 2) {
                        const f32x4 co = {cs0.x, cs0.z, cs1.x, cs1.z}, si = {cs0.y, cs0.w, cs1.y, cs1.w};
                        const f32x4 oa = a * co - bb * si, ob = a * si + bb * co; a = oa; bb = ob;
                    }
                    if (sect == 0) { a = a * QSCALE; bb = bb * QSCALE; bf16* d = Q + (size_t)r * 1024 + c0; st_bf4(d, a); st_bf4(d + 16, bb); }
                    else if (sect == 1) { const size_t kr = (size_t)b * KEYS + (latent ? CTX + t : t); bf16* d = Kb + kr * 1024 + c0; st_bf4(d, a); st_bf4(d + 16, bb); }
                    else { bf16* d = P + (size_t)r * 1024 + c0; st_bf4(d, a); st_bf4(d + 16, bb); }
                }
            }
    }
};
struct EpiVT {
    bf16* VT;
    __device__ __forceinline__ void operator()(EPI_ARGS) const {
        const bool latent = u.pn < TL / 256; const int b = latent ? u.pn / 32 : u.pn - TL / 256; const int key_t0 = latent ? CTX + (u.pn % 32) * 256 : 0;
        const int kperm = 8 * (fq & 1) + 4 * (fq >> 1);
#pragma unroll
        for (int ai = 0; ai < 2; ++ai)
#pragma unroll
            for (int m = 0; m < 4; ++m) {
                const int rr = u.pm * 256 + ai * 128 + wr * 64 + m * 16 + fr;
                bf16* rowp = VT + ((size_t)b * 1024 + rr) * KEYS + key_t0;
#pragma unroll
                for (int bj = 0; bj < 2; ++bj)
#pragma unroll
                    for (int n = 0; n < 2; ++n) st_bf4(rowp + bj * 128 + wc * 32 + 16 * n + kperm, acc[ai][bj][m][n]);
            }
    }
};
struct EpiScaleBf16 {
    bf16* O; int ldo, coff; const float* cscale;
    __device__ __forceinline__ void operator()(EPI_ARGS) const {
#pragma unroll
        for (int bj = 0; bj < 2; ++bj)
#pragma unroll
            for (int n = 0; n < 2; ++n) { const int c = u.pn * 256 + bj * 128 + wc * 32 + 16 * n + 4 * fq; const f32x4 sc = *(const f32x4*)(cscale + c);
#pragma unroll
                for (int ai = 0; ai < 2; ++ai)
#pragma unroll
                    for (int m = 0; m < 4; ++m) { const int r = u.pm * 256 + ai * 128 + wr * 64 + m * 16 + fr; st_bf4(O + (size_t)r * ldo + coff + c, acc[ai][bj][m][n] * sc); } }
    }
};
struct EpiBf16 {
    bf16* O; int ldo;
    __device__ __forceinline__ void operator()(EPI_ARGS) const {
#pragma unroll
        for (int ai = 0; ai < 2; ++ai)
#pragma unroll
            for (int m = 0; m < 4; ++m) { const int r = u.pm * 256 + ai * 128 + wr * 64 + m * 16 + fr; bf16* rowp = O + (size_t)r * ldo + u.pn * 256 + wc * 32 + 4 * fq;
#pragma unroll
                for (int bj = 0; bj < 2; ++bj)
#pragma unroll
                    for (int n = 0; n < 2; ++n) st_bf4(rowp + bj * 128 + 16 * n, acc[ai][bj][m][n]); }
    }
};
struct EpiRes {
    const float* xlat; const float* xctx; float* xout; const float* gate0;
    __device__ __forceinline__ void operator()(EPI_ARGS) const {
        const bool latent = u.pm < TL / 256;
#pragma unroll
        for (int ai = 0; ai < 2; ++ai)
#pragma unroll
            for (int m = 0; m < 4; ++m) { const int r = u.pm * 256 + ai * 128 + wr * 64 + m * 16 + fr; const int ms = latent ? r / SEQ : 2;
                const float* xi = latent ? xlat + (size_t)r * 2048 : xctx + (size_t)(r - TL) * 2048; const float* gp = gate0 + (size_t)ms * 12288;
#pragma unroll
                for (int bj = 0; bj < 2; ++bj)
#pragma unroll
                    for (int n = 0; n < 2; ++n) { const int c = u.pn * 256 + bj * 128 + wc * 32 + 16 * n + 4 * fq;
                        const f32x4 xv = *(const f32x4*)(xi + c), gv = *(const f32x4*)(gp + c); *(f32x4*)(xout + (size_t)r * 2048 + c) = xv + gv * acc[ai][bj][m][n]; } }
    }
};
struct EpiMoeUp {
    bf16* H;
    __device__ __forceinline__ void operator()(EPI_ARGS) const {
#pragma unroll
        for (int ai = 0; ai < 2; ++ai)
#pragma unroll
            for (int m = 0; m < 4; ++m) { const size_t r = (size_t)u.pm * 256 + ai * 128 + wr * 64 + m * 16 + fr;
#pragma unroll
                for (int bj = 0; bj < 2; ++bj) { const int hc = (u.pn * 256 + bj * 128 + wc * 32) / 2 + 4 * fq; const f32x4 a = acc[ai][bj][m][0], b = acc[ai][bj][m][1];
                    const f32x4 h = {siluf_(a.x) * b.x, siluf_(a.y) * b.y, siluf_(a.z) * b.z, siluf_(a.w) * b.w}; st_bf4(H + r * 512 + hc, h); } }
    }
};
struct EpiMoeDown {
    bf16* Y; const int* tokl; const float* gatel; const unsigned* cnt;
    __device__ __forceinline__ void operator()(EPI_ARGS) const {
        const int ce = (int)cnt[u.e];
#pragma unroll
        for (int ai = 0; ai < 2; ++ai)
#pragma unroll
            for (int m = 0; m < 4; ++m) { const int idx = u.idx0 + ai * 128 + wr * 64 + m * 16 + fr;
                if (idx < ce) { const int pair = tokl[(size_t)u.e * LISTCAP + idx]; const float gt = gatel[(size_t)u.e * LISTCAP + idx]; bf16* rowp = Y + (size_t)pair * 2048 + u.pn * 256 + wc * 32 + 4 * fq;
#pragma unroll
                    for (int bj = 0; bj < 2; ++bj)
#pragma unroll
                        for (int n = 0; n < 2; ++n) st_bf4(rowp + bj * 128 + 16 * n, acc[ai][bj][m][n] * gt); } }
    }
};
struct EpiGlu {
    bf16* O; int ldo, coff; const bf16* Gb; const float* bias;
    __device__ __forceinline__ void operator()(EPI_ARGS) const {
#pragma unroll
        for (int ai = 0; ai < 2; ++ai)
#pragma unroll
            for (int m = 0; m < 4; ++m) { const int r = u.pm * 256 + ai * 128 + wr * 64 + m * 16 + fr;
#pragma unroll
                for (int bj = 0; bj < 2; ++bj)
#pragma unroll
                    for (int n = 0; n < 2; ++n) { const int c = u.pn * 256 + bj * 128 + wc * 32 + 16 * n + 4 * fq; const f32x4 bv = *(const f32x4*)(bias + c); const v2u gw = *(const v2u*)(Gb + (size_t)r * 1024 + c);
                        const f32x4 a = acc[ai][bj][m][n] + bv; const f32x4 o = {bflo(gw.x) * sigmoidf_(a.x), bfhi(gw.x) * sigmoidf_(a.y), bflo(gw.y) * sigmoidf_(a.z), bfhi(gw.y) * sigmoidf_(a.w)};
                        st_bf4(O + (size_t)r * ldo + coff + c, o); } }
    }
};

struct MoeOrder {
    const LAS int* bstart;
    const unsigned* cnt; const int* tokl; int nN, G, c, nblk; long bstride, eoff; bool up;
    __device__ bool next(int i, pg8::Unit& u) const {
        const long Lx = (long)i * G + c; if (Lx >= (long)nblk * nN) return false;
        const int blk = (int)(Lx / nN); u.pn = (int)(Lx % nN); u.pm = blk;
        const int e = bstart[65 + blk];
        u.e = e; u.idx0 = (blk - bstart[e]) * 256;
        u.aoff = up ? 0 : (long)blk * 256 * 512 * 2;
        u.boff = (long)e * (long)MOE_E_BYTES + eoff + (long)u.pn * bstride;
        return true;
    }
    __device__ int arow(const pg8::Unit& u, int row) const { const int idx = u.idx0 + row; return idx < (int)cnt[u.e] ? (tokl[(size_t)u.e * LISTCAP + idx] >> 1) : TT; }
};

__device__ __forceinline__ void attn_phase(Frame& F) {
    const bf16* Q = WSP(bf16, WS_Q); const bf16* Kb = WSP(bf16, WS_K); const bf16* VT = WSP(bf16, WS_VT); bf16* cat = WSP(bf16, WS_CAT);
    LAS unsigned char* lds = F.lds;
    const int tid = F.tid, lane = F.lane, w = F.wave, sub = w & 1, qw = w >> 1, r32 = lane & 31, hi = lane >> 5;
    float lam;
    { const float* lv = INP(11); float a = lv[lane] * lv[64 + lane], b = lv[128 + lane] * lv[192 + lane]; a = wave_sum(a); b = wave_sum(b); lam = expf(a) - expf(b) + 0.2f; }
    const float* subg = INP(12);
    const int NU = 1024 + 32;
    const int xcd = F.bid & 7, jcu = F.bid >> 3;
    for (int it = 0;; ++it) {
        int uidx;
        if (F.G == 256) { if (it < 4) uidx = 128 * xcd + it * 32 + jcu; else if (it == 4 && F.bid < 32) uidx = 1024 + F.bid; else break; }
        else { uidx = it * F.G + F.bid; if (uidx >= NU) break; }
        int b, head, q0row, nt; size_t kbase;
        if (uidx < 1024) { const int combo = uidx >> 6, qb = uidx & 63; b = combo >> 3; head = combo & 7; q0row = b * SEQ + qb * 128; nt = KEYS / 64; }
        else { const int v = uidx - 1024; b = v >> 4; head = (v >> 1) & 7; q0row = TL + b * CTX + (v & 1) * 128; nt = CTX / 64; }
        kbase = (size_t)b * KEYS;
        bf16x8 qf[4];
        { const bf16* qp = Q + (size_t)(q0row + qw * 32 + r32) * 1024 + head * 128 + sub * 64 + hi * 8;
#pragma unroll
          for (int ks = 0; ks < 4; ++ks) qf[ks] = *(const bf16x8*)(qp + ks * 16); }
        const char* gsrc[4];
#pragma unroll
        for (int j = 0; j < 4; ++j) { const int pi = w * 4 + j, rr = lane >> 3, pc = lane & 7;
            if (pi < 16) { const int key = (pi & 7) * 8 + rr, c = pc ^ ((key >> 1) & 7); gsrc[j] = (const char*)(Kb + (kbase + key) * 1024 + head * 128 + (pi >> 3) * 64 + c * 8); }
            else { const int dvr = (pi - 16) * 8 + rr, c = pc ^ ((dvr >> 1) & 7); gsrc[j] = (const char*)(VT + ((size_t)(b * 8 + head) * 128 + dvr) * KEYS + c * 8); } }
        const size_t gstep = (w < 4) ? (size_t)65536 * 2 : (size_t)64 * 2;
        const unsigned ldst = (unsigned)w * 4096u;
#define ATT_DMA(t, buf) do { _Pragma("unroll") for (int _j = 0; _j < 4; ++_j) \
            __builtin_amdgcn_global_load_lds((const unsigned*)(gsrc[_j] + (size_t)(t) * gstep), (LAS unsigned*)(lds + (buf) * 32768 + ldst + _j * 1024), 16, 0, 0); } while (0)
        ATT_DMA(0, 0);
        if (nt > 1) ATT_DMA(1, 1);
        if (nt > 1) asm volatile("s_waitcnt vmcnt(4)" ::: "memory"); else asm volatile("s_waitcnt vmcnt(0)" ::: "memory");
        __builtin_amdgcn_s_barrier();
        f32x16 o[4];
#pragma unroll
        for (int d = 0; d < 4; ++d)
#pragma unroll
            for (int r = 0; r < 16; ++r) o[d][r] = 0.f;
        float mref = 0.f, lrow = 0.f;
        f32x16 negm;
#pragma unroll
        for (int r = 0; r < 16; ++r) negm[r] = 0.f;
        const int rdoff = r32 * 128;
        const int swz = (r32 >> 1) & 7;
        for (int t = 0; t < nt; ++t) {
            const int cb = t % 3;
            if (t + 2 < nt) ATT_DMA(t + 2, (t + 2) % 3);
            const LAS unsigned char* bp = lds + cb * 32768;
            const LAS unsigned char* kp = bp + sub * 8192;
            f32x16 s0 = negm, s1 = negm;
            {
                bf16x8 kfa[4], kfb[4];
#pragma unroll
                for (int ks = 0; ks < 4; ++ks) { const int ch = ((2 * ks + hi) ^ swz) * 16; kfa[ks] = *(const LAS bf16x8*)(kp + rdoff + ch); kfb[ks] = *(const LAS bf16x8*)(kp + 4096 + rdoff + ch); }
                __builtin_amdgcn_sched_barrier(0);
#pragma unroll
                for (int ks = 0; ks < 4; ++ks) { s0 = __builtin_amdgcn_mfma_f32_32x32x16_bf16(kfa[ks], qf[ks], s0, 0, 0, 0); s1 = __builtin_amdgcn_mfma_f32_32x32x16_bf16(kfb[ks], qf[ks], s1, 0, 0, 0); }
                __builtin_amdgcn_sched_barrier(0);
            }
            float mxa = fmaxf(fmaxf(s0[0], s0[1]), s0[2]), mxb = fmaxf(fmaxf(s1[0], s1[1]), s1[2]);
#pragma unroll
            for (int r = 3; r < 15; r += 2) { mxa = fmaxf(fmaxf(mxa, s0[r]), s0[r + 1]); mxb = fmaxf(fmaxf(mxb, s1[r]), s1[r + 1]); }
            float mx = fmaxf(fmaxf(mxa, mxb), fmaxf(s0[15], s1[15]));
            mx = fmaxf(mx, __shfl_xor(mx, 32));
            if (__any(mx > 8.0f)) {
                const float dl = fmaxf(mx, 0.f); mref += dl;
                const float alpha = __builtin_amdgcn_exp2f(-dl); lrow *= alpha;
#pragma unroll
                for (int r = 0; r < 16; ++r) { s0[r] -= dl; s1[r] -= dl; negm[r] = -mref; }
#pragma unroll
                for (int d = 0; d < 4; ++d)
#pragma unroll
                    for (int r = 0; r < 16; ++r) o[d][r] *= alpha;
            }
            float rs = 0.f;
#pragma unroll
            for (int r = 0; r < 16; ++r) { s0[r] = __builtin_amdgcn_exp2f(s0[r]); rs += s0[r]; }
#pragma unroll
            for (int r = 0; r < 16; ++r) { s1[r] = __builtin_amdgcn_exp2f(s1[r]); rs += s1[r]; }
            lrow += rs;
            bf16x8 pf[4];
#pragma unroll
            for (int s = 0; s < 4; ++s) { v4u pw;
                if (s < 2) { pw.x = cvt_pk_bf16(s0[8 * s + 0], s0[8 * s + 1]); pw.y = cvt_pk_bf16(s0[8 * s + 2], s0[8 * s + 3]); pw.z = cvt_pk_bf16(s0[8 * s + 4], s0[8 * s + 5]); pw.w = cvt_pk_bf16(s0[8 * s + 6], s0[8 * s + 7]); }
                else { const int q = s - 2; pw.x = cvt_pk_bf16(s1[8 * q + 0], s1[8 * q + 1]); pw.y = cvt_pk_bf16(s1[8 * q + 2], s1[8 * q + 3]); pw.z = cvt_pk_bf16(s1[8 * q + 4], s1[8 * q + 5]); pw.w = cvt_pk_bf16(s1[8 * q + 6], s1[8 * q + 7]); }
                pf[s] = __builtin_bit_cast(bf16x8, pw); }
            const LAS unsigned char* vp = bp + 16384;
            bf16x8 vfa[4], vfb[4];
#pragma unroll
            for (int d = 0; d < 4; ++d) vfa[d] = *(const LAS bf16x8*)(vp + d * 4096 + rdoff + (((0 + hi) ^ swz) * 16));
            __builtin_amdgcn_sched_barrier(0);
#pragma unroll
            for (int d = 0; d < 4; ++d) vfb[d] = *(const LAS bf16x8*)(vp + d * 4096 + rdoff + (((2 + hi) ^ swz) * 16));
#pragma unroll
            for (int d = 0; d < 4; ++d) o[d] = __builtin_amdgcn_mfma_f32_32x32x16_bf16(vfa[d], pf[0], o[d], 0, 0, 0);
            __builtin_amdgcn_sched_barrier(0);
#pragma unroll
            for (int d = 0; d < 4; ++d) vfa[d] = *(const LAS bf16x8*)(vp + d * 4096 + rdoff + (((4 + hi) ^ swz) * 16));
#pragma unroll
            for (int d = 0; d < 4; ++d) o[d] = __builtin_amdgcn_mfma_f32_32x32x16_bf16(vfb[d], pf[1], o[d], 0, 0, 0);
            __builtin_amdgcn_sched_barrier(0);
#pragma unroll
            for (int d = 0; d < 4; ++d) vfb[d] = *(const LAS bf16x8*)(vp + d * 4096 + rdoff + (((6 + hi) ^ swz) * 16));
#pragma unroll
            for (int d = 0; d < 4; ++d) o[d] = __builtin_amdgcn_mfma_f32_32x32x16_bf16(vfa[d], pf[2], o[d], 0, 0, 0);
            __builtin_amdgcn_sched_barrier(0);
#pragma unroll
            for (int d = 0; d < 4; ++d) o[d] = __builtin_amdgcn_mfma_f32_32x32x16_bf16(vfb[d], pf[3], o[d], 0, 0, 0);
            __builtin_amdgcn_sched_barrier(0);
            if (t + 2 < nt) asm volatile("s_waitcnt vmcnt(4) lgkmcnt(0)" ::: "memory"); else asm volatile("s_waitcnt vmcnt(0) lgkmcnt(0)" ::: "memory");
            __builtin_amdgcn_s_barrier();
        }
#undef ATT_DMA
        const float ltot = lrow + __shfl_xor(lrow, 32); const float linv = 1.0f / ltot;
        LAS float* xch = (LAS float*)lds + (size_t)(qw * 32 + r32) * 132;
        if (sub == 1) {
#pragma unroll
            for (int d = 0; d < 4; ++d)
#pragma unroll
                for (int g = 0; g < 4; ++g) *(LAS f32x4*)(xch + 32 * d + 8 * g + 4 * hi) = (f32x4){o[d][4 * g] * linv, o[d][4 * g + 1] * linv, o[d][4 * g + 2] * linv, o[d][4 * g + 3] * linv};
        }
        __syncthreads();
        if (sub == 0) {
            float ss = 0.f;
#pragma unroll
            for (int d = 0; d < 4; ++d)
#pragma unroll
                for (int g = 0; g < 4; ++g) { const f32x4 o2 = *(const LAS f32x4*)(xch + 32 * d + 8 * g + 4 * hi);
#pragma unroll
                    for (int j = 0; j < 4; ++j) { const float v = o[d][4 * g + j] * linv - lam * o2[j]; o[d][4 * g + j] = v; ss += v * v; } }
            ss += __shfl_xor(ss, 32);
            const float rn = 0.8f / sqrtf(ss * (1.0f / 128.0f) + EPS);
            bf16* op = cat + (size_t)(q0row + qw * 32 + r32) * 2048 + head * 128;
#pragma unroll
            for (int d = 0; d < 4; ++d)
#pragma unroll
                for (int g = 0; g < 4; ++g) { const int dv = 32 * d + 8 * g + 4 * hi; const f32x4 gg = *(const f32x4*)(subg + dv);
                    st_bf4(op + dv, (f32x4){o[d][4 * g] * rn * gg.x, o[d][4 * g + 1] * rn * gg.y, o[d][4 * g + 2] * rn * gg.z, o[d][4 * g + 3] * rn * gg.w}); }
        }
        __syncthreads();
    }
}

__device__ __forceinline__ void poold_phase(Frame& F) {
    const bf16* P = WSP(bf16, WS_P); bf16* PD = WSP(bf16, WS_PD);
    const int gt = F.bid * NTHREADS + F.tid, NGT = F.G * NTHREADS;
    for (int idx = gt; idx < TT * 128; idx += NGT) {
        const int r = idx >> 7, cc = (idx & 127) * 8, g = cc >> 8, wdw = 2 << g;
        int sb, t, Ls; if (r < TL) { sb = (r / SEQ) * SEQ; t = r % SEQ; Ls = SEQ; } else { sb = TL + ((r - TL) / CTX) * CTX; t = (r - TL) % CTX; Ls = CTX; }
        int lo = t - wdw / 2, hi = lo + wdw; lo = lo < 0 ? 0 : lo; hi = hi > Ls ? Ls : hi;
        float a[8];
#pragma unroll
        for (int j = 0; j < 8; ++j) a[j] = 0.f;
        for (int s = lo; s < hi; ++s) { const v4u v = *(const v4u*)(P + (size_t)(sb + s) * 1024 + cc);
            a[0] += bflo(v.x); a[1] += bfhi(v.x); a[2] += bflo(v.y); a[3] += bfhi(v.y); a[4] += bflo(v.z); a[5] += bfhi(v.z); a[6] += bflo(v.w); a[7] += bfhi(v.w); }
        const float inv = 1.0f / (float)(hi - lo);
        const v4u me = *(const v4u*)(P + (size_t)r * 1024 + cc);
        v4u o; o.x = pk2(a[0] * inv - bflo(me.x), a[1] * inv - bfhi(me.x)); o.y = pk2(a[2] * inv - bflo(me.y), a[3] * inv - bfhi(me.y));
        o.z = pk2(a[4] * inv - bflo(me.z), a[5] * inv - bfhi(me.z)); o.w = pk2(a[6] * inv - bflo(me.w), a[7] * inv - bfhi(me.w));
        *(v4u*)(PD + (size_t)r * 1024 + cc) = o;
    }
}

__device__ __forceinline__ void shortconv_phase(Frame& F) {
    const bf16* PJ = WSP(bf16, WS_PROJ1); float* GT = WSP(float, WS_GT);
    const float* cw = INP(17); const float* cb = INP(18);
    LAS float* scr = (LAS float*)(F.lds + F.wave * 16896);
    const int lane = F.lane;
    for (int it = F.gw; it < 2 * 128 * 48; it += F.NGW) {
        const int cbk = it % 48, tb = (it / 48) % 128, b = it / (48 * 128), col = cbk * 64 + lane, t0 = tb * 64;
        const float w0 = cw[col], w1 = cw[3072 + col], w2 = cw[2 * 3072 + col], bias = cb[col];
        const bf16* base = PJ + ((size_t)b * SEQ) * 4096 + col;
        float prev = (t0 > 0) ? bf2f(base[(size_t)(t0 - 1) * 4096]) : 0.f;
        float cur = bf2f(base[(size_t)t0 * 4096]);
#pragma unroll 8
        for (int tt = 0; tt < 64; ++tt) { const int t = t0 + tt; const float nxt = (t + 1 < SEQ) ? bf2f(base[(size_t)(t + 1) * 4096]) : 0.f;
            scr[tt * 65 + lane] = prev * w0 + cur * w1 + nxt * w2 + bias; prev = cur; cur = nxt; }
        LDS_WAIT(); asm volatile("" ::: "memory");
        for (int c = 0; c < 64; ++c) GT[((size_t)(cbk * 64 + c) * 2 + b) * SEQ + t0 + lane] = scr[lane * 65 + c];
        LDS_WAIT(); asm volatile("" ::: "memory");
    }
}

__device__ __forceinline__ void s5_scan_phase(Frame& F) {
    const bf16* PJ = WSP(bf16, WS_PROJ1); float* YD = WSP(float, WS_YD);
    const f32x2* lamb = WSP(f32x2, WS_S5LAM); const f32x2* bbar = WSP(f32x2, WS_S5B);
    const float* cre = INP(31); const float* cim = INP(32);
    const int lane = F.lane;
    for (int task = F.wave * F.G + F.bid; task < 256; task += F.NGW) {
        const int di = task >> 7, b = (task >> 6) & 1, g = task & 63;
        const int dgp = (di * 64 + g) * 64 + lane;
        const f32x2 lam = lamb[dgp];
        float br[16], bi[16], cr[16], ci[16];
#pragma unroll
        for (int c = 0; c < 16; ++c) { const f32x2 bv = bbar[(size_t)dgp * 16 + c]; br[c] = bv.x; bi[c] = bv.y;
            cr[c] = cre[((size_t)(di * 64 + g) * 16 + c) * 64 + lane]; ci[c] = cim[((size_t)(di * 64 + g) * 16 + c) * 64 + lane]; }
        float sr = 0.f, si = 0.f;
        const int nsteps = CTX + SEQ;
        for (int st = 0; st < nsteps; st += 4) {
            const int stl = st + (lane >> 4);
            int row;
            if (stl < CTX) row = TL + b * CTX + (di == 0 ? stl : CTX - 1 - stl);
            else row = b * SEQ + (di == 0 ? stl - CTX : SEQ - 1 - (stl - CTX));
            const float uval = bf2f(PJ[(size_t)row * 4096 + 3072 + g * 16 + (lane & 15)]);
#pragma unroll
            for (int k = 0; k < 4; ++k) {
                float bur = 0.f, bui = 0.f;
#pragma unroll
                for (int c = 0; c < 16; ++c) { const float u = __builtin_bit_cast(float, __builtin_amdgcn_readlane(__builtin_bit_cast(int, uval), 16 * k + c)); bur += br[c] * u; bui += bi[c] * u; }
                const float nr = lam.x * sr - lam.y * si + bur, ni = lam.x * si + lam.y * sr + bui; sr = nr; si = ni;
                const int s2 = st + k;
                if (s2 >= CTX) {
                    const int t = (di == 0) ? s2 - CTX : SEQ - 1 - (s2 - CTX);
                    float outv = 0.f;
#pragma unroll
                    for (int c = 0; c < 16; ++c) { float v = cr[c] * sr - ci[c] * si; v = wave_sum(v); if (lane == c) outv = v; }
                    if (lane < 16) YD[((size_t)di * TL + (size_t)b * SEQ + t) * 1024 + g * 16 + lane] = outv;
                }
            }
        }
    }
}

__device__ __forceinline__ void hyena_naive_phase(Frame& F) {
    const float* GT = WSP(float, WS_GT); const float* kT = WSP(float, WS_KT); const float* invn = WSP(float, WS_INVN); bf16* cat = WSP(bf16, WS_CAT);
    const float* hyb = INP(25);
    LAS float* kf = (LAS float*)F.lds;
    LAS f32x2* ub = (LAS f32x2*)(F.lds + 65536);
    const int tid = F.tid;
    for (int ch = F.bid; ch < 1024; ch += F.G) {
        float res0[16], res1[16];
        for (int o = 0; o < 2; ++o) {
            const float inv = invn[o * 1024 + ch];
            const float* kfw = kT + (size_t)(o * 2048 + ch) * SEQ; const float* kbw = kT + (size_t)(o * 2048 + 1024 + ch) * SEQ;
            for (int n = tid; n < 16384; n += NTHREADS) { float v; if (n < SEQ) v = kfw[n]; else if (n == SEQ) v = 0.f; else v = kbw[16384 - n]; kf[n] = v * inv; }
            if (o == 0) { const float* v0 = GT + ((size_t)(0 * 1024 + ch) * 2) * SEQ; for (int n = tid; n < SEQ; n += NTHREADS) ub[n] = (f32x2){v0[n], v0[SEQ + n]}; }
            else {
#pragma unroll
                for (int j = 0; j < 16; ++j) ub[tid + NTHREADS * j] = (f32x2){res0[j], res1[j]}; }
            __syncthreads();
            float a0[16], a1[16];
#pragma unroll
            for (int j = 0; j < 16; ++j) { a0[j] = 0.f; a1[j] = 0.f; }
            for (int s = 0; s < SEQ; ++s) { const f32x2 u = ub[s];
#pragma unroll
                for (int j = 0; j < 16; ++j) { const float kk = kf[(tid + NTHREADS * j - s) & 16383]; a0[j] += u.x * kk; a1[j] += u.y * kk; } }
            const float bias = hyb[o * 1024 + ch];
            const float* xg = GT + ((size_t)((o + 1) * 1024 + ch) * 2) * SEQ;
#pragma unroll
            for (int j = 0; j < 16; ++j) { const int t = tid + NTHREADS * j; const f32x2 u = ub[t];
                res0[j] = xg[t] * (a0[j] + bias * u.x); res1[j] = xg[SEQ + t] * (a1[j] + bias * u.y); }
            __syncthreads();
        }
#pragma unroll
        for (int j = 0; j < 16; ++j) { const int t = tid + NTHREADS * j;
            cat[(size_t)t * 2048 + ch] = (bf16)f2bf(res0[j]); cat[((size_t)SEQ + t) * 2048 + ch] = (bf16)f2bf(res1[j]); }
    }
}

__device__ __forceinline__ void s5_gelu_phase(Frame& F) {
    const bf16* PJ = WSP(bf16, WS_PROJ1); const float* YD = WSP(float, WS_YD); bf16* Gb = WSP(bf16, WS_PD); const float* dd = INP(33);
    const int gt = F.bid * NTHREADS + F.tid, NGT = F.G * NTHREADS;
    for (int idx = gt; idx < TL * 256; idx += NGT) { const int r = idx >> 8, c = (idx & 255) * 4;
        const v2u uw = *(const v2u*)(PJ + (size_t)r * 4096 + 3072 + c); const f32x4 d4 = *(const f32x4*)(dd + c);
        const f32x4 y0 = *(const f32x4*)(YD + (size_t)r * 1024 + c), y1 = *(const f32x4*)(YD + ((size_t)TL + r) * 1024 + c);
        const f32x4 y = {bflo(uw.x) * d4.x + y0.x + y1.x, bfhi(uw.x) * d4.y + y0.y + y1.y, bflo(uw.y) * d4.z + y0.z + y1.z, bfhi(uw.y) * d4.w + y0.w + y1.w};
        st_bf4(Gb + (size_t)r * 1024 + c, (f32x4){gelu_tanh(y.x), gelu_tanh(y.y), gelu_tanh(y.z), gelu_tanh(y.w)}); }
}

__device__ __forceinline__ f32x2 cmulf(f32x2 a, f32x2 b) { return (f32x2){a.x * b.x - a.y * b.y, a.x * b.y + a.y * b.x}; }
__device__ __forceinline__ int drev14(int p) { const unsigned r = __builtin_bitreverse32((unsigned)p) >> 18; return (int)(((r & 0x2AAAu) >> 1) | ((r & 0x1555u) << 1)); }
__device__ __forceinline__ void fft_fwd(LAS f32x2* X, const f32x2* tw, int tid) {
#pragma nounroll
    for (int L = 4096; L >= 1; L >>= 2) {
        const int tws = 4096 / L;
#pragma unroll 2
        for (int i = 0; i < 8; ++i) {
            const int b = tid + NTHREADS * i, j = b & (L - 1), i0 = (b - j) * 4 + j;
            const f32x2 x0 = X[i0], x1 = X[i0 + L], x2 = X[i0 + 2 * L], x3 = X[i0 + 3 * L];
            const f32x2 w1 = tw[j * tws], w2 = cmulf(w1, w1), w3 = cmulf(w2, w1);
            const f32x2 a = x0 + x2, bb = x0 - x2, c = x1 + x3, d = x1 - x3;
            const f32x2 t1 = {bb.x + d.y, bb.y - d.x}, t3 = {bb.x - d.y, bb.y + d.x};
            X[i0] = a + c; X[i0 + L] = cmulf(t1, w1); X[i0 + 2 * L] = cmulf(a - c, w2); X[i0 + 3 * L] = cmulf(t3, w3);
        }
        __syncthreads();
    }
}
__device__ __forceinline__ void fft_inv(LAS f32x2* X, const f32x2* tw, int tid) {
#pragma nounroll
    for (int L = 1; L <= 4096; L <<= 2) {
        const int tws = 4096 / L;
#pragma unroll 2
        for (int i = 0; i < 8; ++i) {
            const int b = tid + NTHREADS * i, j = b & (L - 1), i0 = (b - j) * 4 + j;
            f32x2 w1 = tw[j * tws]; w1.y = -w1.y; const f32x2 w2 = cmulf(w1, w1), w3 = cmulf(w2, w1);
            const f32x2 x0 = X[i0], x1 = cmulf(X[i0 + L], w1), x2 = cmulf(X[i0 + 2 * L], w2), x3 = cmulf(X[i0 + 3 * L], w3);
            const f32x2 a = x0 + x2, bb = x0 - x2, c = x1 + x3, d = x1 - x3;
            X[i0] = a + c; X[i0 + L] = (f32x2){bb.x - d.y, bb.y + d.x}; X[i0 + 2 * L] = a - c; X[i0 + 3 * L] = (f32x2){bb.x + d.y, bb.y - d.x};
        }
        __syncthreads();
    }
}
__device__ __forceinline__ void fft_pointwise(LAS f32x2* X, const f32x2* Wg, int o, float scale, int tid) {
    const float hs = 0.5f * scale;
#pragma unroll 4
    for (int i = 0; i < 32; ++i) {
        const int p = tid + NTHREADS * i, f = drev14(p), pm = drev14((16384 - f) & 16383);
        const unsigned long long ua = __hip_atomic_load((const unsigned long long*)(Wg + p), __ATOMIC_RELAXED, __HIP_MEMORY_SCOPE_AGENT);
        const unsigned long long ub = __hip_atomic_load((const unsigned long long*)(Wg + pm), __ATOMIC_RELAXED, __HIP_MEMORY_SCOPE_AGENT);
        const f32x2 A = __builtin_bit_cast(f32x2, ua), B = __builtin_bit_cast(f32x2, ub);
        f32x2 K;
        if (o == 0) K = (f32x2){(A.x + B.x) * hs, (A.y - B.y) * hs};
        else { const f32x2 dd = {A.x - B.x, A.y + B.y}; K = (f32x2){dd.y * hs, -dd.x * hs}; }
        X[p] = cmulf(X[p], K);
    }
    __syncthreads();
}
__device__ __forceinline__ void hyena_fft_phase(Frame& F) {
    float* GT = WSP(float, WS_GT); const float* kT = WSP(float, WS_KT); const float* invn = WSP(float, WS_INVN); const f32x2* tw = WSP(f32x2, WS_TW);
    f32x2* Wg = WSP(f32x2, WS_FFTW) + (size_t)F.bid * 16384;
    const float* hyb = INP(25);
    LAS f32x2* X = (LAS f32x2*)F.lds;
    const int tid = F.tid;
    for (int ch = F.bid; ch < 1024; ch += F.G) {
        { const float* f0 = kT + (size_t)ch * SEQ; const float* b0 = kT + (size_t)(1024 + ch) * SEQ; const float* f1 = kT + (size_t)(2048 + ch) * SEQ; const float* b1 = kT + (size_t)(3072 + ch) * SEQ;
          for (int n = tid; n < SEQ; n += NTHREADS) { X[n] = (f32x2){f0[n], f1[n]}; X[SEQ + n] = (n == 0) ? (f32x2){0.f, 0.f} : (f32x2){b0[SEQ - n], b1[SEQ - n]}; } }
        __syncthreads();
        fft_fwd(X, tw, tid);
        for (int n = tid; n < 16384; n += NTHREADS) Wg[n] = X[n];
        __syncthreads();
        const float* v0 = GT + ((size_t)ch * 2) * SEQ; float* yo = WSP(float, WS_YHT) + ((size_t)ch * 2) * SEQ;
        const float* x1 = GT + ((size_t)(1024 + ch) * 2) * SEQ; const float* x2 = GT + ((size_t)(2048 + ch) * 2) * SEQ;
        float z0[16], z1[16];
#pragma unroll
        for (int j = 0; j < 16; ++j) { const int n = tid + NTHREADS * j; z0[j] = v0[n]; z1[j] = v0[SEQ + n]; }
#pragma unroll
        for (int o = 0; o < 2; ++o) {
#pragma unroll
            for (int j = 0; j < 16; ++j) { const int n = tid + NTHREADS * j; X[n] = (f32x2){z0[j], z1[j]}; X[SEQ + n] = (f32x2){0.f, 0.f}; }
            __syncthreads();
            fft_fwd(X, tw, tid);
            fft_pointwise(X, Wg, o, invn[o * 1024 + ch] * (1.0f / 16384.0f), tid);
            fft_inv(X, tw, tid);
            const float bias = hyb[o * 1024 + ch]; const float* xg = (o == 0) ? x1 : x2;
#pragma unroll
            for (int j = 0; j < 16; ++j) { const int n = tid + NTHREADS * j; const f32x2 y = X[n]; z0[j] = xg[n] * (y.x + bias * z0[j]); z1[j] = xg[SEQ + n] * (y.y + bias * z1[j]); }
            __syncthreads();
        }
#pragma unroll
        for (int j = 0; j < 16; ++j) { const int n = tid + NTHREADS * j; yo[n] = z0[j]; yo[SEQ + n] = z1[j]; }
    }
}
__device__ __forceinline__ void hyena_out_transpose(Frame& F) {
    const float* GT = WSP(float, WS_YHT); bf16* cat = WSP(bf16, WS_CAT);
    LAS float* scr = (LAS float*)(F.lds + F.wave * 16896);
    const int lane = F.lane;
    for (int it = F.gw; it < 2 * 128 * 16; it += F.NGW) {
        const int cbk = it & 15, tb = (it >> 4) & 127, b = it >> 11, t0 = tb * 64;
        for (int c = 0; c < 64; ++c) scr[c * 65 + lane] = GT[((size_t)(cbk * 64 + c) * 2 + b) * SEQ + t0 + lane];
        LDS_WAIT(); asm volatile("" ::: "memory");
        for (int tt = 0; tt < 64; ++tt) cat[((size_t)b * SEQ + t0 + tt) * 2048 + cbk * 64 + lane] = (bf16)f2bf(scr[lane * 65 + tt]);
        LDS_WAIT(); asm volatile("" ::: "memory");
    }
}

__device__ __forceinline__ int s5_row(int di, int b, int s) {
    return (s < CTX) ? TL + b * CTX + (di == 0 ? s : CTX - 1 - s) : b * SEQ + (di == 0 ? s - CTX : SEQ - 1 - (s - CTX));
}
template <bool OUTPUT>
__device__ __forceinline__ void s5_seg_phase(Frame& F) {
    const bf16* PJ = WSP(bf16, WS_PROJ1); float* YD = WSP(float, WS_YD);
    const f32x2* lamb = WSP(f32x2, WS_S5LAM); const f32x2* bbar = WSP(f32x2, WS_S5B); const f32x2* l256 = WSP(f32x2, WS_S5L256); f32x2* Eb = WSP(f32x2, WS_S5E);
    const float* cre = INP(31); const float* cim = INP(32);
    const int lane = F.lane;
    for (int task = F.wave * F.G + F.bid; task < 256 * 32; task += F.NGW) {
        const int dbg = task >> 5, seg = (task & 31) + (OUTPUT ? 1 : 0);
        const int di = dbg >> 7, b = (dbg >> 6) & 1, g = dbg & 63;
        const int dgp = (di * 64 + g) * 64 + lane;
        const f32x2 lam = lamb[dgp];
        float br[16], bi[16];
#pragma unroll
        for (int c = 0; c < 16; ++c) { const f32x2 bv = bbar[(size_t)dgp * 16 + c]; br[c] = bv.x; bi[c] = bv.y; }
        float cr[16], ci[16];
        if (OUTPUT) {
#pragma unroll
            for (int c = 0; c < 16; ++c) { cr[c] = cre[((size_t)(di * 64 + g) * 16 + c) * 64 + lane]; ci[c] = cim[((size_t)(di * 64 + g) * 16 + c) * 64 + lane]; }
        }
        float sr = 0.f, si = 0.f;
        if (OUTPUT) {
            const f32x2 l2 = l256[dgp]; const f32x2* ep = Eb + ((size_t)dbg * 32) * 64 + lane;
            for (int k = 0; k < seg; ++k) { const f32x2 e = ep[(size_t)k * 64]; const float nr = l2.x * sr - l2.y * si + e.x, ni = l2.x * si + l2.y * sr + e.y; sr = nr; si = ni; }
        }
        const int s0 = seg * 256;
#pragma nounroll
        for (int st = 0; st < 256; st += 4) {
            const int row = s5_row(di, b, s0 + st + (lane >> 4));
            const float uval = bf2f(PJ[(size_t)row * 4096 + 3072 + g * 16 + (lane & 15)]);
#pragma unroll
            for (int k = 0; k < 4; ++k) {
                float bur = 0.f, bui = 0.f;
#pragma unroll
                for (int c = 0; c < 16; ++c) { const float u = __builtin_bit_cast(float, __builtin_amdgcn_readlane(__builtin_bit_cast(int, uval), 16 * k + c)); bur += br[c] * u; bui += bi[c] * u; }
                const float nr = lam.x * sr - lam.y * si + bur, ni = lam.x * si + lam.y * sr + bui; sr = nr; si = ni;
                if (OUTPUT) {
                    float v8[8], v4[4], v2[2], v1;
                    const bool b5 = (lane & 32) != 0, b4 = (lane & 16) != 0, b3 = (lane & 8) != 0, b2 = (lane & 4) != 0;
#pragma unroll
                    for (int i = 0; i < 8; ++i) { const float lo = cr[i] * sr - ci[i] * si, hi = cr[i + 8] * sr - ci[i + 8] * si; const float keep = b5 ? hi : lo, send = b5 ? lo : hi; v8[i] = keep + __shfl_xor(send, 32); }
#pragma unroll
                    for (int i = 0; i < 4; ++i) { const float keep = b4 ? v8[i + 4] : v8[i], send = b4 ? v8[i] : v8[i + 4]; v4[i] = keep + __shfl_xor(send, 16); }
#pragma unroll
                    for (int i = 0; i < 2; ++i) { const float keep = b3 ? v4[i + 2] : v4[i], send = b3 ? v4[i] : v4[i + 2]; v2[i] = keep + __shfl_xor(send, 8); }
                    { const float keep = b2 ? v2[1] : v2[0], send = b2 ? v2[0] : v2[1]; v1 = keep + __shfl_xor(send, 4); }
                    v1 += __shfl_xor(v1, 2); v1 += __shfl_xor(v1, 1);
                    const int s = s0 + st + k, t = (di == 0) ? s - CTX : SEQ - 1 - (s - CTX);
                    if ((lane & 3) == 0) YD[((size_t)di * TL + (size_t)b * SEQ + t) * 1024 + g * 16 + (lane >> 2)] = v1;
                }
            }
        }
        if (!OUTPUT) Eb[((size_t)dbg * 32 + seg) * 64 + lane] = (f32x2){sr, si};
    }
}

typedef float f32x4_t __attribute__((ext_vector_type(4)));
template <bool OUTPUT>
__device__ __forceinline__ void s5_mfma_phase(Frame& F) {
    const bf16* PJ = WSP(bf16, WS_PROJ1); float* YD = WSP(float, WS_YD);
    const f32x2* lamb = WSP(f32x2, WS_S5LAM); const f32x2* bbar = WSP(f32x2, WS_S5B); const f32x2* l256 = WSP(f32x2, WS_S5L256); f32x2* Eb = WSP(f32x2, WS_S5E);
    const float* cre = INP(31); const float* cim = INP(32);
    const int lane = F.lane, fr = lane & 15, fq = lane >> 4;
    LAS unsigned* Xl = (LAS unsigned*)(F.lds + F.wave * 4608);
    for (int task = F.wave * F.G + F.bid; task < 256 * 32; task += F.NGW) {
        const int dbg = task >> 5, seg = (task & 31) + (OUTPUT ? 1 : 0);
        const int di = dbg >> 7, b = (dbg >> 6) & 1, g = dbg & 63;
        const int dg = di * 64 + g;
        f32x2 l1[4], l2[4], l3[4], l4[4];
        bf16x8 bfr[8];
#pragma unroll
        for (int t = 0; t < 4; ++t) { const int dgp = dg * 64 + 16 * t + fr; l1[t] = lamb[dgp]; l2[t] = cmulf(l1[t], l1[t]); l3[t] = cmulf(l2[t], l1[t]); l4[t] = cmulf(l2[t], l2[t]);
            v4u wre = {0u, 0u, 0u, 0u}, wim = {0u, 0u, 0u, 0u};
            if (fq < 2) { const f32x4* bp = (const f32x4*)(bbar + (size_t)dgp * 16 + 8 * fq); const f32x4 q0 = bp[0], q1 = bp[1], q2 = bp[2], q3 = bp[3];
                wre.x = cvt_pk_bf16(q0.x, q0.z); wre.y = cvt_pk_bf16(q1.x, q1.z); wre.z = cvt_pk_bf16(q2.x, q2.z); wre.w = cvt_pk_bf16(q3.x, q3.z);
                wim.x = cvt_pk_bf16(q0.y, q0.w); wim.y = cvt_pk_bf16(q1.y, q1.w); wim.z = cvt_pk_bf16(q2.y, q2.w); wim.w = cvt_pk_bf16(q3.y, q3.w); }
            bfr[t] = __builtin_bit_cast(bf16x8, wre); bfr[4 + t] = __builtin_bit_cast(bf16x8, wim); }
        bf16x8 cfr[4];
        if (OUTPUT) {
#pragma unroll
            for (int ks = 0; ks < 4; ++ks) { const size_t cb = ((size_t)dg * 16 + fr) * 64 + 16 * ks + 4 * fq; const f32x4 r4 = *(const f32x4*)(cre + cb), i4 = *(const f32x4*)(cim + cb);
                v4u w; w.x = cvt_pk_bf16(r4.x, -i4.x); w.y = cvt_pk_bf16(r4.y, -i4.y); w.z = cvt_pk_bf16(r4.z, -i4.z); w.w = cvt_pk_bf16(r4.w, -i4.w); cfr[ks] = __builtin_bit_cast(bf16x8, w); }
        }
        f32x2 st[4];
#pragma unroll
        for (int t = 0; t < 4; ++t) st[t] = (f32x2){0.f, 0.f};
        if (OUTPUT) {
#pragma unroll
            for (int t = 0; t < 4; ++t) { const f32x2 lq = l256[dg * 64 + 16 * t + fr]; const f32x2* ep = Eb + ((size_t)dbg * 32) * 64 + 16 * t + fr;
                for (int k = 0; k < seg; ++k) { const f32x2 e = ep[(size_t)k * 64]; st[t] = cmulf(lq, st[t]) + e; } }
        }
        const int s0 = seg * 256;
        v4u unext = {0u, 0u, 0u, 0u};
        if (fq < 2) unext = *(const v4u*)(PJ + (size_t)s5_row(di, b, s0 + fr) * 4096 + 3072 + g * 16 + 8 * fq);
#pragma nounroll
        for (int blk = 0; blk < 16; ++blk) {
            const bf16x8 ufr = __builtin_bit_cast(bf16x8, unext);
            if (blk + 1 < 16 && fq < 2) unext = *(const v4u*)(PJ + (size_t)s5_row(di, b, s0 + 16 * (blk + 1) + fr) * 4096 + 3072 + g * 16 + 8 * fq);
            f32x4 bu[8];
#pragma unroll
            for (int nt = 0; nt < 8; ++nt) bu[nt] = __builtin_amdgcn_mfma_f32_16x16x32_bf16(ufr, bfr[nt], (f32x4){0.f, 0.f, 0.f, 0.f}, 0, 0, 0);
            f32x2 xs[4][4];
#pragma unroll
            for (int t = 0; t < 4; ++t) {
                f32x2 x0 = {bu[t][0], bu[4 + t][0]}, x1 = cmulf(l1[t], x0) + (f32x2){bu[t][1], bu[4 + t][1]}, x2 = cmulf(l1[t], x1) + (f32x2){bu[t][2], bu[4 + t][2]}, x3 = cmulf(l1[t], x2) + (f32x2){bu[t][3], bu[4 + t][3]};
                f32x2 sin = st[t];
                f32x2 fin = x3 + cmulf(l4[t], (fq == 0) ? sin : (f32x2){0.f, 0.f});
#pragma unroll
                for (int rd = 1; rd < 4; ++rd) { const float vr = __shfl(fin.x, lane - 16), vi = __shfl(fin.y, lane - 16);
                    if (fq == rd) { sin = (f32x2){vr, vi}; fin = x3 + cmulf(l4[t], sin); } }
                xs[t][0] = x0 + cmulf(l1[t], sin); xs[t][1] = x1 + cmulf(l2[t], sin); xs[t][2] = x2 + cmulf(l3[t], sin); xs[t][3] = x3 + cmulf(l4[t], sin);
                st[t] = (f32x2){__shfl(xs[t][3].x, 48 + fr), __shfl(xs[t][3].y, 48 + fr)};
            }
            if (OUTPUT) {
#pragma unroll
                for (int t = 0; t < 4; ++t)
#pragma unroll
                    for (int r = 0; r < 4; ++r) Xl[(4 * fq + r) * 68 + 16 * t + fr] = cvt_pk_bf16(xs[t][r].x, xs[t][r].y);
                LDS_WAIT(); asm volatile("" ::: "memory");
                f32x4 y = {0.f, 0.f, 0.f, 0.f};
#pragma unroll
                for (int ks = 0; ks < 4; ++ks) { const bf16x8 xa = *(const LAS bf16x8*)(Xl + fr * 68 + 16 * ks + 4 * fq); y = __builtin_amdgcn_mfma_f32_16x16x32_bf16(xa, cfr[ks], y, 0, 0, 0); }
                LDS_WAIT(); asm volatile("" ::: "memory");
#pragma unroll
                for (int r = 0; r < 4; ++r) { const int s = s0 + 16 * blk + 4 * fq + r, tl = (di == 0) ? s - CTX : SEQ - 1 - (s - CTX);
                    YD[((size_t)di * TL + (size_t)b * SEQ + tl) * 1024 + g * 16 + fr] = y[r]; }
            }
        }
        if (!OUTPUT) { if (fq == 0) {
#pragma unroll
            for (int t = 0; t < 4; ++t) Eb[((size_t)dbg * 32 + seg) * 64 + 16 * t + fr] = st[t]; } }
    }
}

constexpr int NPHASES = 21;
#ifndef MK_SINGLE
#define MK_SINGLE 1
#endif

__device__ __forceinline__ unsigned long long launder_u64(unsigned long long v) {
    unsigned lo = (unsigned)v, hi = (unsigned)(v >> 32);
    asm volatile("" : "+v"(lo), "+v"(hi));
    lo = __builtin_amdgcn_readfirstlane(lo); hi = __builtin_amdgcn_readfirstlane(hi);
    return ((unsigned long long)hi << 32) | lo;
}
__device__ __forceinline__ const void* launder_ptr(const void* p) {
    unsigned long long v = (unsigned long long)p; unsigned lo = (unsigned)v, hi = (unsigned)(v >> 32);
    asm volatile("" : "+v"(lo), "+v"(hi));
    lo = __builtin_amdgcn_readfirstlane(lo); hi = __builtin_amdgcn_readfirstlane(hi);
    return (const void*)(((unsigned long long)hi << 32) | lo);
}
__device__ __forceinline__ void moe_blocks(Frame& F, int l, LAS int* bstart) {
    __syncthreads();
    if (F.tid == 0) { const unsigned* cnt = WSP(unsigned, WS_CTL) + CW_CNT + l * 64; int acc = 0;
        for (int e = 0; e < 64; ++e) { bstart[e] = acc; const int nb = ((int)cnt[e] + 255) >> 8; for (int j = 0; j < nb; ++j) bstart[65 + acc + j] = e; acc += nb; } bstart[64] = acc; }
    __syncthreads();
}

template <int PHSEL>
__global__ void __launch_bounds__(NTHREADS, 2) mk_fwd(Args args) {
    extern __shared__ __attribute__((aligned(16))) unsigned char lds_raw[];
    Frame F;
    F.lds = (LAS unsigned char*)lds_raw; F.ws = args.ws; F.kin = (const __attribute__((address_space(4))) unsigned long long*)__builtin_amdgcn_kernarg_segment_ptr();
    F.tid = threadIdx.x; F.lane = F.tid & 63; F.wave = __builtin_amdgcn_readfirstlane(F.tid >> 6); F.bid = blockIdx.x; F.G = gridDim.x;
    F.gw = F.bid * NWAVES + F.wave; F.NGW = F.G * NWAVES;
    volatile LAS unsigned* lctl = (volatile LAS unsigned*)(F.lds + LDS_CTL);
    LAS int* bstart = (LAS int*)(F.lds + LDS_CTL + 64);
    if (F.tid < 4) lctl[F.tid] = 0u;
    __syncthreads();
    const int lo = args.ph_lo, hi = args.ph_hi;
    XcdBarrier bar; bar.bar = WSP(unsigned, WS_CTL) + CW_BAR; bar.x = 0; bar.st = lctl;
    if (PHSEL < 0) bar = xcd_barrier_post(WSP(unsigned, WS_CTL) + CW_BAR, lctl);
#ifndef PH_MASK
#define PH_MASK 0xffffffffu
#endif
#define IN(k) (((PH_MASK >> (k)) & 1u) && (PHSEL < 0 || PHSEL == (k)))
#define INL(j) (((PH_MASK >> (6 + (j))) & 1u) && (PHSEL < 0 || (PHSEL == 6 + (j) && lo == pb + (j))))
#define PH_END(k) do { if (PHSEL < 0) xcd_barrier(bar); } while (0)
#ifndef PH_REPEAT
#define PH_REPEAT 0u
#endif
#define REP(k) for (int _rep = 0; _rep < (((PH_REPEAT >> (k)) & 1u) ? 2 : 1); ++_rep)
#define PH_BEGIN() do { F.ws = (unsigned char*)launder_ptr((const void*)F.ws); F.kin = (const __attribute__((address_space(4))) unsigned long long*)launder_u64((unsigned long long)F.kin); \
    { int _t = threadIdx.x; asm volatile("" : "+v"(_t)); F.tid = _t; F.lane = _t & 63; F.wave = __builtin_amdgcn_readfirstlane(_t >> 6); \
      int _b = blockIdx.x; asm volatile("" : "+v"(_b)); F.bid = __builtin_amdgcn_readfirstlane(_b); F.gw = F.bid * NWAVES + F.wave; } } while (0)
    LAS unsigned char* lds = F.lds;
    const int G = F.G, bid = F.bid;
    constexpr long T2048 = 256L * 2048 * 2;

    if (IN(0)) { PH_BEGIN(); REP(0) { p0_prologue(F); __syncthreads(); } PH_END(0); }
    if (IN(1)) { PH_BEGIN(); p1_reduce(F); PH_END(1); }
        if (IN(2)) { PH_BEGIN(); REP(2) norm_phase<0>(F, 0, nullptr); PH_END(2); }
        if (IN(3)) { PH_BEGIN(); REP(3) {
            { pg8::Gemm g{WSP(bf16, WS_HA), WSP(bf16, WS_WIN0), 2048, 2048, 2048}; pg8::StaticOrder S; S.init(TT / 256, 12, G, bid, T2048, 0, T2048);
              EpiQKP E{WSP(bf16, WS_Q), WSP(bf16, WS_K), WSP(bf16, WS_P), WSP(f32x2, WS_ROPE)}; pg8::gemm_phase<EpiQKP, pg8::StaticOrder, false>(lds, g, S, E); }
            { pg8::Gemm g{WSP(bf16, WS_WIN0) + (size_t)3072 * 2048, WSP(bf16, WS_HA), 2048, 2048, 2048}; pg8::StaticOrder S; S.init(4, TT / 256, G, bid, T2048, 0, T2048);
              EpiVT E{WSP(bf16, WS_VT)}; pg8::gemm_phase<EpiVT, pg8::StaticOrder, false>(lds, g, S, E); } }
            PH_END(3);
        }
        if (IN(4)) { PH_BEGIN(); REP(4) attn_phase(F); REP(21) poold_phase(F); PH_END(4); }
        if (IN(5)) { PH_BEGIN();
            pg8::Gemm g{WSP(bf16, WS_PD), WSP(bf16, WS_WPOOL), 1024, 256, 256}; pg8::StaticOrder S; S.init(TT / 256, 4, G, bid, 256L * 1024 * 2, 256L * 2, 256L * 256 * 2);
            EpiScaleBf16 E{WSP(bf16, WS_CAT), 2048, 1024, INP(14)}; pg8::gemm_phase<EpiScaleBf16, pg8::StaticOrder, false>(lds, g, S, E);
            PH_END(5);
        }
    {
    constexpr int pb = 6; constexpr int l = 0;
    if (INL(0)) { PH_BEGIN();
        float* xbuf = WSP(float, WS_X);
        pg8::Gemm g{WSP(bf16, WS_CAT), WSP(bf16, l == 0 ? WS_WOUT0 : WS_WOUT1), 2048, 2048, 2048}; pg8::StaticOrder S; S.init(l == 0 ? TT / 256 : TL / 256, 8, G, bid, T2048, 0, T2048);
        EpiRes E{l == 0 ? INP(0) : xbuf, l == 0 ? INP(2) : xbuf + (size_t)TL * 2048, xbuf, modp(F, l, 0, 2)}; pg8::gemm_phase<EpiRes, pg8::StaticOrder, false>(lds, g, S, E);
        PH_END(pb);
    }
    if (INL(1)) { PH_BEGIN(); ffn_norm_router_phase(F, l); PH_END(pb + 1); }
    if (INL(2)) { PH_BEGIN(); REP(8) {
        moe_blocks(F, l, bstart);
        pg8::Gemm g{WSP(bf16, WS_HA), (const bf16*)(F.ws + WS_WMOE + (size_t)l * MOE_L_BYTES), 2048, 2048, 2048};
        MoeOrder S{bstart, WSP(unsigned, WS_CTL) + CW_CNT + l * 64, WSP(int, WS_TOKL), 4, G, bid, bstart[64], T2048, 0, true};
        EpiMoeUp E{WSP(bf16, WS_H)}; pg8::gemm_phase<EpiMoeUp, MoeOrder, true>(lds, g, S, E); }
        PH_END(pb + 2);
    }
    if (INL(3)) { PH_BEGIN(); REP(9) {
        moe_blocks(F, l, bstart);
        pg8::Gemm g{WSP(bf16, WS_H), (const bf16*)(F.ws + WS_WMOE + (size_t)l * MOE_L_BYTES), 512, 512, 512};
        MoeOrder S{bstart, WSP(unsigned, WS_CTL) + CW_CNT + l * 64, WSP(int, WS_TOKL), 8, G, bid, bstart[64], 256L * 512 * 2, (long)(4 * MiB), false};
        EpiMoeDown E{WSP(bf16, WS_Y), WSP(int, WS_TOKL), WSP(float, WS_GATEL), WSP(unsigned, WS_CTL) + CW_CNT + l * 64}; pg8::gemm_phase<EpiMoeDown, MoeOrder, false>(lds, g, S, E); }
        PH_END(pb + 3);
    }
    }
        if (IN(10)) { PH_BEGIN(); norm_phase<2>(F, 1, nullptr); PH_END(10); }
        if (IN(11)) { PH_BEGIN(); REP(11) {
            pg8::Gemm g{WSP(bf16, WS_HA), WSP(bf16, WS_WIN1), 2048, 2048, 2048}; pg8::StaticOrder S; S.init(TT / 256, 16, G, bid, T2048, 0, T2048);
            EpiBf16 E{WSP(bf16, WS_PROJ1), 4096}; pg8::gemm_phase<EpiBf16, pg8::StaticOrder, false>(lds, g, S, E); }
            PH_END(11);
        }
        if (IN(12)) { PH_BEGIN(); REP(12) shortconv_phase(F); REP(22) s5_mfma_phase<false>(F); PH_END(12); }
        if (IN(13)) { PH_BEGIN(); REP(23) s5_mfma_phase<true>(F); __syncthreads(); REP(13) hyena_fft_phase(F); PH_END(13); }
        if (IN(14)) { PH_BEGIN(); REP(14) { s5_gelu_phase(F); hyena_out_transpose(F); } PH_END(14); }
        if (IN(15)) { PH_BEGIN();
            pg8::Gemm g{WSP(bf16, WS_PD), WSP(bf16, WS_WGLU), 1024, 1024, 1024}; pg8::StaticOrder S; S.init(TL / 256, 4, G, bid, 256L * 1024 * 2, 0, 256L * 1024 * 2);
            EpiGlu E{WSP(bf16, WS_CAT), 2048, 1024, WSP(bf16, WS_PD), INP(35)}; pg8::gemm_phase<EpiGlu, pg8::StaticOrder, false>(lds, g, S, E);
            PH_END(15);
        }
    {
    constexpr int pb = 16; constexpr int l = 1;
    if (INL(0)) { PH_BEGIN();
        float* xbuf = WSP(float, WS_X);
        pg8::Gemm g{WSP(bf16, WS_CAT), WSP(bf16, l == 0 ? WS_WOUT0 : WS_WOUT1), 2048, 2048, 2048}; pg8::StaticOrder S; S.init(l == 0 ? TT / 256 : TL / 256, 8, G, bid, T2048, 0, T2048);
        EpiRes E{l == 0 ? INP(0) : xbuf, l == 0 ? INP(2) : xbuf + (size_t)TL * 2048, xbuf, modp(F, l, 0, 2)}; pg8::gemm_phase<EpiRes, pg8::StaticOrder, false>(lds, g, S, E);
        PH_END(pb);
    }
    if (INL(1)) { PH_BEGIN(); ffn_norm_router_phase(F, l); PH_END(pb + 1); }
    if (INL(2)) { PH_BEGIN(); REP(8) {
        moe_blocks(F, l, bstart);
        pg8::Gemm g{WSP(bf16, WS_HA), (const bf16*)(F.ws + WS_WMOE + (size_t)l * MOE_L_BYTES), 2048, 2048, 2048};
        MoeOrder S{bstart, WSP(unsigned, WS_CTL) + CW_CNT + l * 64, WSP(int, WS_TOKL), 4, G, bid, bstart[64], T2048, 0, true};
        EpiMoeUp E{WSP(bf16, WS_H)}; pg8::gemm_phase<EpiMoeUp, MoeOrder, true>(lds, g, S, E); }
        PH_END(pb + 2);
    }
    if (INL(3)) { PH_BEGIN(); REP(9) {
        moe_blocks(F, l, bstart);
        pg8::Gemm g{WSP(bf16, WS_H), (const bf16*)(F.ws + WS_WMOE + (size_t)l * MOE_L_BYTES), 512, 512, 512};
        MoeOrder S{bstart, WSP(unsigned, WS_CTL) + CW_CNT + l * 64, WSP(int, WS_TOKL), 8, G, bid, bstart[64], 256L * 512 * 2, (long)(4 * MiB), false};
        EpiMoeDown E{WSP(bf16, WS_Y), WSP(int, WS_TOKL), WSP(float, WS_GATEL), WSP(unsigned, WS_CTL) + CW_CNT + l * 64}; pg8::gemm_phase<EpiMoeDown, MoeOrder, false>(lds, g, S, E); }
        PH_END(pb + 3);
    }
    }
    if (IN(20)) { PH_BEGIN(); norm_phase<3>(F, 1, args.out); }
#undef IN
#undef INL
#undef PH_END
}

typedef void (*kern_t)(Args);
template <int P> static void launch_phase(int grid, hipStream_t stream, Args a) { hipLaunchKernelGGL(mk_fwd<P>, dim3(grid), dim3(NTHREADS), LDS_BYTES, stream, a); }
template <int P> static bool prep_phase() { return hipFuncSetAttribute((const void*)mk_fwd<P>, hipFuncAttributeMaxDynamicSharedMemorySize, LDS_BYTES) == hipSuccess; }
extern "C" void kernel_launch(void* const* d_in, const int* in_sizes, int n_in, void* d_out, int out_size, void* d_ws, size_t ws_size, hipStream_t stream) {
    static int grid = 0;
    if (grid == 0) {
        if (n_in != 43 || out_size != TL * DM || ws_size < WS_END) { fprintf(stderr, "kernel_launch: unexpected shapes (n_in %d, out %d, ws %zu < %zu)\n", n_in, out_size, ws_size, (size_t)WS_END); grid = -1; return; }
        int dev = 0, cus = 0;
        if (hipGetDevice(&dev) != hipSuccess || hipDeviceGetAttribute(&cus, hipDeviceAttributeMultiprocessorCount, dev) != hipSuccess) { grid = -1; return; }
        bool ok = true;
#if MK_SINGLE
        ok = prep_phase<-1>();
#else
        ok = prep_phase<0>() && prep_phase<1>() && prep_phase<2>() && prep_phase<3>() && prep_phase<4>() && prep_phase<5>() && prep_phase<6>() && prep_phase<7>() && prep_phase<8>() && prep_phase<9>() &&
             prep_phase<10>() && prep_phase<11>() && prep_phase<12>() && prep_phase<13>() && prep_phase<14>() && prep_phase<15>() && prep_phase<20>();
#endif
        if (!ok) { fprintf(stderr, "kernel_launch: hipFuncSetAttribute failed\n"); grid = -1; return; }
        (void)hipGetLastError();
        grid = cus;
    }
    if (grid < 0) return;
    (void)hipMemsetAsync((char*)d_ws + WS_CTL, 0, CTL_BYTES, stream);
    Args a{};
    for (int i = 0; i < 43; ++i) a.in[i] = (const float*)d_in[i];
    a.out = (float*)d_out; a.ws = (unsigned char*)d_ws;
#if MK_SINGLE
    a.ph_lo = 0; a.ph_hi = NPHASES;
    launch_phase<-1>(grid, stream, a);
#else
#define LP(k, P) a.ph_lo = (k); a.ph_hi = (k) + 1; launch_phase<P>(grid, stream, a);
    LP(0, 0) LP(1, 1) LP(2, 2) LP(3, 3) LP(4, 4) LP(5, 5) LP(6, 6) LP(7, 7) LP(8, 8) LP(9, 9) LP(10, 10) LP(11, 11) LP(12, 12) LP(13, 13) LP(14, 14) LP(15, 15)
    LP(16, 6) LP(17, 7) LP(18, 8) LP(19, 9) LP(20, 20)
#undef LP
#endif
}
```

```cpp
#include <hip/hip_runtime.h>
#include <cstdio>
#include <cstdint>
#include <cmath>

#define GAS __attribute__((address_space(1)))
#define LAS __attribute__((address_space(3)))
typedef unsigned short bf16;
typedef unsigned v4u __attribute__((ext_vector_type(4)));
typedef unsigned v2u __attribute__((ext_vector_type(2)));
typedef float f32x4 __attribute__((ext_vector_type(4)));
typedef float f32x2 __attribute__((ext_vector_type(2)));
typedef float f32x16 __attribute__((ext_vector_type(16)));
typedef short bf16x8 __attribute__((ext_vector_type(8)));
#define LDS_WAIT() asm volatile("s_waitcnt lgkmcnt(0)" ::: "memory")
#define VM_WAIT() asm volatile("s_waitcnt vmcnt(0)" ::: "memory")

__device__ __forceinline__ unsigned f2bf(float f) { unsigned u = __builtin_bit_cast(unsigned, f); return (u + 0x7fffu + ((u >> 16) & 1u)) >> 16; }
__device__ __forceinline__ unsigned pk2(float lo, float hi) { return f2bf(lo) | (f2bf(hi) << 16); }
__device__ __forceinline__ unsigned cvt_pk_bf16(float lo, float hi) { unsigned r; asm volatile("v_cvt_pk_bf16_f32 %0, %1, %2" : "=v"(r) : "v"(lo), "v"(hi)); return r; }
__device__ __forceinline__ float bf2f(unsigned short b) { return __builtin_bit_cast(float, (unsigned)b << 16); }
__device__ __forceinline__ float bflo(unsigned w) { return __builtin_bit_cast(float, w << 16); }
__device__ __forceinline__ float bfhi(unsigned w) { return __builtin_bit_cast(float, w & 0xffff0000u); }
__device__ __forceinline__ float wave_sum(float v) {
#pragma unroll
    for (int o = 1; o < 64; o <<= 1) v += __shfl_xor(v, o);
    return v;
}

namespace pg8 {
typedef unsigned short bf16_t;
constexpr int BM = 256, BK = 64, HALF = 128, HTB = HALF * BK * 2, STAGE_BYTES = 8 * HTB;

__host__ __device__ __forceinline__ int lds_byte(int r, int c) { const int st = (r >> 4) * 2 + (c >> 5), rr = r & 15, cc = c & 31, ob = rr * 64 + cc * 2; return st * 1024 + (ob ^ (((ob >> 9) & 1) << 5)); }
__host__ __device__ __forceinline__ void stage_rc(int b, int& R, int& C) { const int st = b / 1024, sb = b % 1024, swz = sb ^ (((sb >> 9) & 1) << 5); R = (st >> 1) * 16 + swz / 64; C = (st & 1) * 32 + (swz % 64) / 2; }

struct Unit { int pm, pn; long aoff, boff; int e, idx0; };
struct Gemm { const bf16_t* A; const bf16_t* Bt; int lda, ldb, K; };

template <class Epi, class Sched, bool GATHER>
__device__ __forceinline__ void gemm_phase(LAS unsigned char* lds, const Gemm g, const Sched& S, const Epi& E) {
    const int tid = threadIdx.x, wid = __builtin_amdgcn_readfirstlane(tid >> 6), lane = tid & 63, wr = wid >> 2, wc = wid & 3, fr = lane & 15, fq = lane >> 4;
    const int K = g.K, nt = K / BK;
    unsigned voffA[2], voffB[2];
#pragma unroll
    for (int i = 0; i < 2; ++i) { int R, C; stage_rc(tid * 16 + i * 8192, R, C);
        voffA[i] = (unsigned)(R * g.lda + C) * 2u; voffB[i] = (unsigned)(R * g.ldb + C) * 2u; }
    const size_t kstep = (size_t)(BK * 2);
    const size_t hstepA = GATHER ? 0 : (size_t)HALF * g.lda * 2, hstepB = (size_t)HALF * g.ldb * 2;
    const unsigned ldsw = (unsigned)wid * 1024u;
    const int aoff = lds_byte(wr * 64 + fr, fq * 8), boff = lds_byte(wc * 32 + fr, fq * 8);
#define PG8_SA(b, h) (((b) * 2 + (h)) * HTB)
#define PG8_SB(b, h) ((4 + (b) * 2 + (h)) * HTB)
#define PG8_STAGE(bufoff, gbase, voff) do { _Pragma("unroll") for (int _i = 0; _i < 2; ++_i) \
        __builtin_amdgcn_global_load_lds((const unsigned*)((const char*)(gbase) + (voff)[_i]), (LAS unsigned*)(lds + (bufoff) + ldsw + _i * 8192), 16, 0, 0); } while (0)
#define PG8_STAGE_A(bufoff, gbase, h, nx) do { if constexpr (GATHER) { unsigned _tv[2]; \
        if (nx) { int _tz = tid; asm volatile("" : "+v"(_tz)); _Pragma("unroll") for (int _j = 0; _j < 2; ++_j) { int _R, _C; stage_rc(_tz * 16 + _j * 8192, _R, _C); _tv[_j] = (unsigned)S.arow(nxt, (h) * HALF + _R) * (unsigned)(g.lda * 2) + (unsigned)(_C * 2); } } \
        else { _tv[0] = gvc[h][0]; _tv[1] = gvc[h][1]; } \
        PG8_STAGE(bufoff, gbase, _tv); } else { PG8_STAGE(bufoff, (gbase) + (h) * hstepA, voffA); } } while (0)
#define PG8_LDA(dst, b, h) do { _Pragma("unroll") for (int m = 0; m < 4; ++m) _Pragma("unroll") for (int k = 0; k < 2; ++k) dst[m][k] = *(const LAS bf16x8*)(lds + PG8_SA(b, h) + aoff + m * 2048 + k * 1024); } while (0)
#define PG8_LDB(dst, b, h) do { _Pragma("unroll") for (int n = 0; n < 2; ++n) _Pragma("unroll") for (int k = 0; k < 2; ++k) dst[n][k] = *(const LAS bf16x8*)(lds + PG8_SB(b, h) + boff + n * 2048 + k * 1024); } while (0)
#define PG8_MMA(ai, bj, At, Bt) do { __builtin_amdgcn_s_setprio(1); _Pragma("unroll") for (int m = 0; m < 4; ++m) _Pragma("unroll") for (int n = 0; n < 2; ++n) _Pragma("unroll") for (int k = 0; k < 2; ++k) \
        acc[ai][bj][m][n] = __builtin_amdgcn_mfma_f32_16x16x32_bf16(Bt[n][k], At[m][k], acc[ai][bj][m][n], 0, 0, 0); __builtin_amdgcn_s_setprio(0); } while (0)
#define PG8_WAIT_V(n) asm volatile("s_waitcnt vmcnt(" #n ")" ::: "memory")
#define PG8_WAIT_L(n) asm volatile("s_waitcnt lgkmcnt(" #n ")" ::: "memory")
#define PG8_BAR __builtin_amdgcn_s_barrier()
#define PG8_SCHED __builtin_amdgcn_sched_barrier(0)
    Unit cur, nxt; int ui = 0;
    if (!S.next(0, cur)) return;
    unsigned gvc[2][2];
#define PG8_GV(unit) do { if constexpr (GATHER) { int _tz = tid; asm volatile("" : "+v"(_tz)); _Pragma("unroll") for (int _h = 0; _h < 2; ++_h) _Pragma("unroll") for (int _j = 0; _j < 2; ++_j) { int _R, _C; stage_rc(_tz * 16 + _j * 8192, _R, _C); \
        gvc[_h][_j] = (unsigned)S.arow(unit, _h * HALF + _R) * (unsigned)(g.lda * 2) + (unsigned)(_C * 2); } } } while (0)
    PG8_GV(cur);
    f32x4 acc[2][2][4][2];
#pragma unroll
    for (int a = 0; a < 2; ++a)
#pragma unroll
        for (int b = 0; b < 2; ++b)
#pragma unroll
            for (int m = 0; m < 4; ++m)
#pragma unroll
                for (int n = 0; n < 2; ++n) acc[a][b][m][n] = (f32x4){0.f, 0.f, 0.f, 0.f};
    bf16x8 At[4][2], B0[2][2], B1[2][2];
    const char* cA = (const char*)g.A + cur.aoff; const char* cB = (const char*)g.Bt + cur.boff;
    PG8_STAGE(PG8_SB(0, 0), cB, voffB); PG8_STAGE(PG8_SB(0, 1), cB + hstepB, voffB); PG8_STAGE_A(PG8_SA(0, 0), cA, 0, false); PG8_STAGE_A(PG8_SA(0, 1), cA, 1, false);
    if (wr == 1) PG8_BAR;
    PG8_WAIT_V(2); PG8_BAR;
    PG8_STAGE(PG8_SB(1, 0), cB + kstep, voffB); PG8_STAGE_A(PG8_SA(1, 0), cA + kstep, 0, false); PG8_STAGE(PG8_SB(1, 1), cB + hstepB + kstep, voffB);
    PG8_WAIT_V(6); PG8_BAR;
    for (;;) {
        const bool has_next = S.next(ui + 1, nxt);
        const char* nA = has_next ? (const char*)g.A + nxt.aoff : cA; const char* nB = has_next ? (const char*)g.Bt + nxt.boff : cB;
#pragma nounroll
        for (int t = 0; t < nt; t += 2) {
            const bool last = (t == nt - 2);
            const char* a1 = cA + (size_t)(t + 1) * kstep;
            const char* a2 = last ? nA : cA + (size_t)(t + 2) * kstep; const char* b2 = last ? nB : cB + (size_t)(t + 2) * kstep;
            const char* a3 = a2 + kstep; const char* b3 = b2 + kstep;
            PG8_LDB(B0, 0, 0); PG8_LDB(B1, 0, 1); PG8_SCHED; PG8_LDA(At, 0, 0); PG8_STAGE_A(PG8_SA(1, 1), a1, 1, false);
            PG8_WAIT_V(8); PG8_WAIT_L(0); PG8_BAR; PG8_MMA(0, 0, At, B0); PG8_MMA(0, 1, At, B1); PG8_BAR; PG8_SCHED;
            PG8_LDA(At, 0, 1); PG8_STAGE(PG8_SB(0, 0), b2, voffB); PG8_STAGE(PG8_SB(0, 1), b2 + hstepB, voffB); PG8_STAGE_A(PG8_SA(0, 0), a2, 0, last);
            PG8_WAIT_V(8); PG8_WAIT_L(0); PG8_BAR; PG8_MMA(1, 0, At, B0); PG8_MMA(1, 1, At, B1); PG8_BAR; PG8_SCHED;
            PG8_LDB(B0, 1, 0); PG8_LDB(B1, 1, 1); PG8_SCHED; PG8_LDA(At, 1, 0); PG8_STAGE_A(PG8_SA(0, 1), a2, 1, last);
            PG8_WAIT_V(8); PG8_WAIT_L(0); PG8_BAR; PG8_MMA(0, 0, At, B0); PG8_MMA(0, 1, At, B1); PG8_BAR; PG8_SCHED;
            PG8_LDA(At, 1, 1); PG8_STAGE(PG8_SB(1, 0), b3, voffB); PG8_STAGE(PG8_SB(1, 1), b3 + hstepB, voffB); PG8_STAGE_A(PG8_SA(1, 0), a3, 0, last);
            PG8_WAIT_V(8); PG8_WAIT_L(0); PG8_BAR; PG8_MMA(1, 0, At, B0); PG8_MMA(1, 1, At, B1); PG8_BAR; PG8_SCHED;
        }
        if (wr == 0) PG8_BAR;
        E(acc, cur, wr, wc, fr, fq);
        if (!has_next) break;
#pragma unroll
        for (int a = 0; a < 2; ++a)
#pragma unroll
            for (int b = 0; b < 2; ++b)
#pragma unroll
                for (int m = 0; m < 4; ++m)
#pragma unroll
                    for (int n = 0; n < 2; ++n) acc[a][b][m][n] = (f32x4){0.f, 0.f, 0.f, 0.f};
        cur = nxt; cA = nA; cB = nB; ++ui;
        PG8_GV(cur);
        if (wr == 1) PG8_BAR;
    }
    PG8_WAIT_V(0);
    PG8_BAR;
#undef PG8_SA
#undef PG8_SB
#undef PG8_STAGE
#undef PG8_STAGE_A
#undef PG8_GV
#undef PG8_LDA
#undef PG8_LDB
#undef PG8_MMA
#undef PG8_WAIT_V
#undef PG8_WAIT_L
#undef PG8_BAR
#undef PG8_SCHED
}

struct StaticOrder {
    int nM, nN, nwg, G, c; long astride, apn, bstride;
    __device__ void init(int nM_, int nN_, int G_, int c_, long astride_, long apn_, long bstride_) { nM = nM_; nN = nN_; nwg = nM * nN; G = G_; c = c_; astride = astride_; apn = apn_; bstride = bstride_; }
    __device__ bool next(int i, Unit& u) const {
        const long Lx = (long)i * G + c; if (Lx >= nwg) return false;
        int wgid = (int)Lx; { const int q = nwg / 8, r = nwg % 8, xcd = wgid % 8, off = wgid / 8; wgid = (xcd < r ? xcd * (q + 1) : r * (q + 1) + (xcd - r) * q) + off; }
        const int nig = 8 * nN, gid = wgid / nig, fm = gid * 8, gsz = (nM - fm) < 8 ? (nM - fm) : 8;
        u.pm = fm + ((wgid % nig) % gsz); u.pn = (wgid % nig) / gsz; u.aoff = (long)u.pm * astride + (long)u.pn * apn; u.boff = (long)u.pn * bstride; u.e = 0; u.idx0 = 0; return true;
    }
    __device__ int arow(const Unit&, int) const { return 0; }
};
}

constexpr int DM = 2048, NBATCH = 2, SEQ = 8192, CTX = 256;
constexpr int TL = NBATCH * SEQ;
constexpr int TC = NBATCH * CTX;
constexpr int TT = TL + TC;
constexpr int KEYS = CTX + SEQ;
constexpr int NEXP = 64, DEXP = 512;
constexpr int LISTCAP = 2 * TT;
constexpr float EPS = 1e-6f;
constexpr float QSCALE = 0.125f * 1.4426950408889634f;
constexpr int NWAVES = 8, NTHREADS = 512;

constexpr size_t MiB = 1u << 20;
constexpr size_t WS_CTL = 0, CTL_BYTES = 1 * MiB;
constexpr size_t WS_WIN0 = 1 * MiB;
constexpr size_t WS_WOUT0 = WS_WIN0 + 16 * MiB;
constexpr size_t WS_WIN1 = WS_WOUT0 + 8 * MiB;
constexpr size_t WS_WOUT1 = WS_WIN1 + 16 * MiB;
constexpr size_t WS_WPOOL = WS_WOUT1 + 8 * MiB;
constexpr size_t WS_WGLU = WS_WPOOL + 1 * MiB;
constexpr size_t WS_WMOE = WS_WGLU + 2 * MiB;
constexpr size_t MOE_E_BYTES = 6 * MiB, MOE_L_BYTES = 64 * MOE_E_BYTES;
constexpr size_t WS_X = WS_WMOE + 2 * MOE_L_BYTES;
constexpr size_t WS_HA = WS_X + 132 * MiB;
constexpr size_t WS_Q = WS_HA + 67 * MiB;
constexpr size_t WS_K = WS_Q + 33 * MiB;
constexpr size_t WS_VT = WS_K + 33 * MiB;
constexpr size_t WS_P = WS_VT + 33 * MiB;
constexpr size_t WS_PROJ1 = WS_Q;
constexpr size_t WS_CAT = WS_P + 33 * MiB;
constexpr size_t WS_PD = WS_CAT + 66 * MiB;
constexpr size_t WS_H = WS_PD + 33 * MiB;
constexpr size_t WS_Y = WS_H + 49 * MiB;
constexpr size_t WS_GT = WS_Y + 132 * MiB;
constexpr size_t WS_KT = WS_GT + 192 * MiB;
constexpr size_t WS_YD = WS_KT + 128 * MiB;
constexpr size_t WS_MISC = WS_YD + 128 * MiB;
constexpr size_t WS_MOD = WS_MISC;
constexpr size_t WS_ADAP = WS_MOD + 1 * MiB;
constexpr size_t WS_ROPE = WS_ADAP + 10 * MiB;
constexpr size_t WS_NORMP = WS_ROPE + 1 * MiB;
constexpr size_t WS_INVN = WS_NORMP + 4 * MiB;
constexpr size_t WS_S5LAM = WS_INVN + 1 * MiB;
constexpr size_t WS_S5B = WS_S5LAM + 1 * MiB;
constexpr size_t WS_WRT = WS_S5B + 2 * MiB;
constexpr size_t WS_TOKL = WS_WRT + 2 * MiB;
constexpr size_t WS_GATEL = WS_TOKL + 9 * MiB;
constexpr size_t WS_TW = WS_GATEL + 9 * MiB;
constexpr size_t WS_FFTW = WS_TW + 1 * MiB;
constexpr size_t WS_S5L256 = WS_FFTW + 32 * MiB;
constexpr size_t WS_S5E = WS_S5L256 + 1 * MiB;
constexpr size_t WS_YHT = WS_S5E + 4 * MiB;
constexpr size_t WS_END = WS_YHT + 64 * MiB;
static_assert(WS_END <= 2040 * MiB, "d_ws map");
constexpr int CW_BAR = 1024;
constexpr int CW_CNT = 8192;

constexpr int LDS_PHASE = 131072;
constexpr int LDS_CTL = 147456 - 2048;
constexpr int LDS_BYTES = 147456;

#define XB_TMO      128
#define XB_XCNT(j)  (256  + 64 * (j))
#define XB_XSUB(j)  (1280 + 64 * (j))
#define XB_XGEN(j)  (2304 + 64 * (j))
#define XB_TOP      3328
#define XB_TOPGEN   3392
#define XCD_BAR_WORDS 3456
#define XB_SPIN_CAP (1u << 22)

__device__ __forceinline__ unsigned xb_ld(unsigned* p)              { return __hip_atomic_load(p, __ATOMIC_RELAXED, __HIP_MEMORY_SCOPE_AGENT); }
__device__ __forceinline__ unsigned xb_add(unsigned* p, unsigned v) { return __hip_atomic_fetch_add(p, v, __ATOMIC_RELAXED, __HIP_MEMORY_SCOPE_AGENT); }
__device__ __forceinline__ unsigned xb_xcc_id() { return (unsigned)__builtin_amdgcn_s_getreg((3 << 11) | 20) & 0xFu; }
#define XB_SPIN(cond, bar) do { unsigned _sp = 0; while (cond) { __builtin_amdgcn_s_sleep(1); \
    if ((++_sp & 255u) == 0u) { if (xb_ld(&(bar)[XB_TMO])) break; if (_sp > XB_SPIN_CAP) { atomicAdd(&(bar)[XB_TMO], 1u); break; } } } } while (0)

struct XcdBarrier { unsigned* bar; unsigned x; volatile LAS unsigned* st; };

__device__ __forceinline__ XcdBarrier xcd_barrier_post(unsigned* bar, volatile LAS unsigned* st) {
    XcdBarrier b; b.bar = bar; b.x = xb_xcc_id(); b.st = st;
    if (threadIdx.x == 0) (void)xb_add(&bar[XB_XCNT(b.x)], 1u);
    return b;
}
__device__ __forceinline__ void xcd_barrier_complete(unsigned* bar, unsigned x, unsigned& nloc, unsigned& nx) {
    const unsigned G = gridDim.x * gridDim.y * gridDim.z;
    unsigned sum, cnt, mine, sp = 0u;
    for (;;) {
        sum = 0u; cnt = 0u; mine = 0u;
#pragma unroll
        for (unsigned j = 0; j < 16; ++j) { const unsigned c = xb_ld(&bar[XB_XCNT(j)]); sum += c; cnt += (c > 0u) ? 1u : 0u; mine = (j == x) ? c : mine; }
        if (sum == G) break;
        __builtin_amdgcn_s_sleep(1);
        if ((++sp & 255u) == 0u) { if (xb_ld(&bar[XB_TMO])) break; if (sp > XB_SPIN_CAP) { atomicAdd(&bar[XB_TMO], 1u); break; } }
    }
    nloc = mine > 0u ? mine : 1u; nx = cnt > 0u ? cnt : 1u;
}
__device__ __forceinline__ void xcd_barrier(const XcdBarrier& b) {
    asm volatile("s_waitcnt vmcnt(0)" ::: "memory");
    __syncthreads();
    if (threadIdx.x == 0) {
        unsigned* bar = b.bar;
        __builtin_amdgcn_s_waitcnt(0);
        unsigned nloc = b.st[0], nx = b.st[1];
        if (nloc == 0u) { xcd_barrier_complete(bar, b.x, nloc, nx); b.st[0] = nloc; b.st[1] = nx; }
        const unsigned old = xb_add(&bar[XB_XSUB(b.x)], 1u);
        const unsigned gen = old / nloc;
        if (old + 1u == (gen + 1u) * nloc) {
            __builtin_amdgcn_fence(__ATOMIC_RELEASE, "agent");
            asm volatile("s_waitcnt vmcnt(0)" ::: "memory");
            const unsigned og = xb_add(&bar[XB_TOP], 1u);
            const unsigned tg = og / nx;
            if (og + 1u == (tg + 1u) * nx) xb_add(&bar[XB_TOPGEN], 1u);
            else XB_SPIN(xb_ld(&bar[XB_TOPGEN]) == tg, bar);
            __builtin_amdgcn_fence(__ATOMIC_ACQUIRE, "agent");
            xb_add(&bar[XB_XGEN(b.x)], 1u);
            asm volatile("s_waitcnt vmcnt(0)" ::: "memory");
        } else {
            XB_SPIN(xb_ld(&bar[XB_XGEN(b.x)]) == gen, bar);
            __builtin_amdgcn_fence(__ATOMIC_ACQUIRE, "agent");
            asm volatile("s_waitcnt vmcnt(0)" ::: "memory");
        }
    }
    __syncthreads();
}

__device__ __forceinline__ void sincos_2pi(double x, double& s, double& c) {
    const double q = __builtin_rint(x * 4.0);
    const double y = (x - q * 0.25) * 6.283185307179586476925;
    const double y2 = y * y;
    double sp = -7.6471637318198164759e-13; sp = sp * y2 + 1.6059043836821614599e-10; sp = sp * y2 - 2.5052108385441718775e-8; sp = sp * y2 + 2.7557319223985890653e-6;
    sp = sp * y2 - 1.9841269841269841270e-4; sp = sp * y2 + 8.3333333333333333333e-3; sp = sp * y2 - 1.6666666666666666667e-1; sp = sp * y2 * y + y;
    double cp = 4.7794773323873852974e-14; cp = cp * y2 - 1.1470745597729724714e-11; cp = cp * y2 + 2.0876756987868098979e-9; cp = cp * y2 - 2.7557319223985890653e-7;
    cp = cp * y2 + 2.4801587301587301587e-5; cp = cp * y2 - 1.3888888888888888889e-3; cp = cp * y2 + 4.1666666666666666667e-2; cp = cp * y2 - 0.5; cp = cp * y2 + 1.0;
    const int qi = ((int)q) & 3;
    s = (qi == 0) ? sp : (qi == 1) ? cp : (qi == 2) ? -sp : -cp;
    c = (qi == 0) ? cp : (qi == 1) ? -sp : (qi == 2) ? -cp : sp;
}
__device__ __forceinline__ void sincos_rad(double a, double& s, double& c) {
    double f = a * 0.15915494309189533576888; f -= __builtin_floor(f);
    if (f >= 1.0) f = 0.0;
    sincos_2pi(f, s, c);
}
__device__ __forceinline__ double exp_small(double x) {
    double r = 1.0 / 479001600.0;
    r = r * x + 1.0 / 39916800.0; r = r * x + 1.0 / 3628800.0; r = r * x + 1.0 / 362880.0; r = r * x + 1.0 / 40320.0; r = r * x + 1.0 / 5040.0;
    r = r * x + 1.0 / 720.0; r = r * x + 1.0 / 120.0; r = r * x + 1.0 / 24.0; r = r * x + 1.0 / 6.0; r = r * x + 0.5; r = r * x + 1.0; r = r * x + 1.0;
    return r;
}
__device__ __forceinline__ float fast_exp(float x) { return __builtin_amdgcn_exp2f(x * 1.4426950408889634f); }
__device__ __forceinline__ float sigmoidf_(float x) { return 1.0f / (1.0f + fast_exp(-x)); }
__device__ __forceinline__ float siluf_(float x) { return x * sigmoidf_(x); }
__device__ __forceinline__ float tanhf_(float x) { const float e = fast_exp(-2.0f * fabsf(x)); const float t = (1.0f - e) / (1.0f + e); return x < 0.f ? -t : t; }
__device__ __forceinline__ float gelu_tanh(float x) { return 0.5f * x * (1.0f + tanhf_(0.7978845608028654f * (x + 0.044715f * x * x * x))); }

#ifndef PH_REPEAT
#define PH_REPEAT 0u
#endif
struct Args { const float* in[43]; float* out; unsigned char* ws; int ph_lo, ph_hi; };

struct Frame {
    LAS unsigned char* lds; unsigned char* ws; int tid, lane, wave, bid, G, gw, NGW;
    const __attribute__((address_space(4))) unsigned long long* kin;
};
#define INP(i) ((const float*)F.kin[i])
#define WSP(T, off) ((T*)(F.ws + (off)))

__device__ __forceinline__ void tr_item(const float* W, int ldw, int N, bf16* WT, int ldt, int row_off, int rs16, LAS float* scr, int item, int lane) {
    const int nblk = N / 64, kb = item / nblk, nb = item % nblk, k0 = 64 * kb, n0 = 64 * nb;
    const int la = lane & 15, lb = lane >> 4;
    f32x4 v[16];
#pragma unroll
    for (int i = 0; i < 16; ++i) v[i] = *(const f32x4*)(W + (size_t)(k0 + 4 * i + lb) * ldw + n0 + 4 * la);
#pragma unroll
    for (int i = 0; i < 16; ++i) { const int kk = 4 * i + lb; LAS float* d = scr + (4 * la) * 65 + kk; d[0] = v[i].x; d[65] = v[i].y; d[130] = v[i].z; d[195] = v[i].w; }
    LDS_WAIT(); asm volatile("" ::: "memory");
    const int c = lane & 7;
#pragma unroll
    for (int j = 0; j < 8; ++j) { const int n = (lane >> 3) + 8 * j; const LAS float* s = scr + n * 65 + 8 * c;
        v4u o; o.x = cvt_pk_bf16(s[0], s[1]); o.y = cvt_pk_bf16(s[2], s[3]); o.z = cvt_pk_bf16(s[4], s[5]); o.w = cvt_pk_bf16(s[6], s[7]);
        const int nn = n0 + n, drow = row_off + (nn >> 4) * rs16 + (nn & 15);
        *(v4u*)(WT + (size_t)drow * ldt + k0 + 8 * c) = o; }
    LDS_WAIT(); asm volatile("" ::: "memory");
}

__device__ __forceinline__ void hyfilt_item(Frame& F, int pb) {
    const float* w1 = INP(19); const float* b1 = INP(20); const float* fq = INP(21); const float* w2 = INP(22); const float* b2 = INP(23); const float* w3 = INP(24);
    LAS float* z = (LAS float*)F.lds;
    LAS float* h1 = z + 1088;
    LAS float* h2 = h1 + 2048;
    const int tid = F.tid;
    for (int idx = tid; idx < 32 * 33; idx += NTHREADS) {
        const int p = idx / 33, f = idx % 33, i = pb * 32 + p;
        float v;
        if (f == 0) v = (float)i * (1.0f / (float)(SEQ - 1));
        else { const int j = (f - 1) & 15; const float fj = 1e-4f + (float)j * ((15.0f - 1e-4f) / 15.0f);
            double fr = (double)fj * (double)i / (double)SEQ; fr -= __builtin_floor(fr); double s, c; sincos_2pi(fr, s, c); v = (f <= 16) ? (float)c : (float)(-s); }
        z[p * 33 + f] = v;
    }
    __syncthreads();
    for (int idx = tid; idx < 2048; idx += NTHREADS) {
        const int p = idx >> 6, j = idx & 63; float a = b1[j];
        for (int f = 0; f < 33; ++f) a += z[p * 33 + f] * w1[f * 64 + j];
        double s, c; sincos_rad((double)(fq[j] * a), s, c); h1[idx] = (float)s;
    }
    __syncthreads();
    for (int idx = tid; idx < 2048; idx += NTHREADS) {
        const int p = idx >> 6, j = idx & 63; float a = b2[j];
        for (int k = 0; k < 64; ++k) a += h1[p * 64 + k] * w2[k * 64 + j];
        double s, c; sincos_rad((double)(fq[64 + j] * a), s, c); h2[idx] = (float)s;
    }
    __syncthreads();
    float* kT = WSP(float, WS_KT); float* normp = WSP(float, WS_NORMP);
    {
        const int lane = F.lane, l31 = lane & 31, lh = lane >> 5;
        float af[32];
#pragma unroll
        for (int s = 0; s < 32; ++s) af[s] = h2[l31 * 64 + 2 * s + lh];
        for (int ct = F.wave; ct < 128; ct += NWAVES) {
            const int col = ct * 32 + l31;
            f32x16 acc;
#pragma unroll
            for (int r = 0; r < 16; ++r) acc[r] = 0.f;
            float bv[32];
#pragma unroll
            for (int s = 0; s < 32; ++s) bv[s] = w3[(size_t)(2 * s + lh) * 4096 + col];
#pragma unroll
            for (int s = 0; s < 32; ++s) acc = __builtin_amdgcn_mfma_f32_32x32x2f32(af[s], bv[s], acc, 0, 0, 0);
            const int ch = col & 1023, dir = (col >> 10) & 1;
            const float adel = 3.0701134573253946f + (float)ch * ((15.350567286626972f - 3.0701134573253946f) / 1023.0f);
            float sabs = 0.f;
#pragma unroll
            for (int r = 0; r < 16; ++r) { const int i = pb * 32 + (r & 3) + 8 * (r >> 2) + 4 * lh; const float t = (float)i * (1.0f / (float)(SEQ - 1)); acc[r] *= fast_exp(-t * adel); if (!(dir == 1 && i == 0)) sabs += fabsf(acc[r]); }
            sabs += __shfl_xor(sabs, 32);
#pragma unroll
            for (int q = 0; q < 4; ++q) *(f32x4*)(kT + (size_t)col * SEQ + pb * 32 + 8 * q + 4 * lh) = (f32x4){acc[4 * q], acc[4 * q + 1], acc[4 * q + 2], acc[4 * q + 3]};
            if (lh == 0) normp[(size_t)pb * 4096 + col] = sabs;
        }
    }
    __syncthreads();
}

__device__ __forceinline__ void tr_wg_item(Frame& F, const float* W, int ldw, bf16* WT, int ldt, int row_off, int rs16, int k0, int n0) {
    LAS float* T = (LAS float*)F.lds;
    const int t = F.tid;
    f32x4 v[16];
#pragma unroll
    for (int i = 0; i < 16; ++i) v[i] = *(const f32x4*)(W + (size_t)(k0 + 4 * i + (t >> 7)) * ldw + n0 + 4 * (t & 127));
#pragma unroll
    for (int i = 0; i < 16; ++i) { const int k = 4 * i + (t >> 7); *(LAS f32x4*)(T + k * 516 + ((4 * (t & 127) + 8 * (k >> 3)) & 511)) = v[i]; }
    __syncthreads();
    const int c = (t >> 3) & 7, nl = (t & 7) | ((t >> 6) << 3);
#pragma unroll
    for (int q = 0; q < 8; ++q) { const int n = 64 * q + nl; const LAS float* s = T + (8 * c) * 516 + ((n + 8 * c) & 511);
        v4u o; o.x = cvt_pk_bf16(s[0], s[516]); o.y = cvt_pk_bf16(s[2 * 516], s[3 * 516]); o.z = cvt_pk_bf16(s[4 * 516], s[5 * 516]); o.w = cvt_pk_bf16(s[6 * 516], s[7 * 516]);
        const int nn = n0 + n, drow = row_off + (nn >> 4) * rs16 + (nn & 15);
        *(v4u*)(WT + (size_t)drow * ldt + k0 + 8 * c) = o; }
    __syncthreads();
}

__device__ __forceinline__ void p0_prologue(Frame& F) {
    for (int rep = 0; rep < (((PH_REPEAT >> 25) & 1u) ? 2 : 1); ++rep)
    for (int pb = F.bid; pb < SEQ / 32; pb += F.G) hyfilt_item(F, pb);
    for (int rep = 0; rep < (((PH_REPEAT >> 24) & 1u) ? 2 : 1); ++rep)
    for (int it = F.bid; it < 128 * 96; it += F.G) {
        const int le = it / 96, q = it % 96;
        bf16* wc = (bf16*)(F.ws + WS_WMOE + (size_t)le * MOE_E_BYTES); bf16* w2t = wc + 1024 * 2048;
        if (q < 32) tr_wg_item(F, INP(40) + (size_t)le * (2048 * 512), 512, wc, 2048, 0, 32, 64 * q, 0);
        else if (q < 64) tr_wg_item(F, INP(41) + (size_t)le * (2048 * 512), 512, wc, 2048, 16, 32, 64 * (q - 32), 0);
        else { const int r = q - 64; tr_wg_item(F, INP(42) + (size_t)le * (512 * 2048), 2048, w2t, 512, 0, 16, 64 * (r >> 2), 512 * (r & 3)); }
    }
    const int gt = F.bid * NTHREADS + F.tid, NGT = F.G * NTHREADS;
    {
        f32x2* rope = WSP(f32x2, WS_ROPE);
        for (int idx = gt; idx < 128 * 16; idx += NGT) { const int pos = idx >> 4, i = idx & 15;
            double inv = (i & 3) == 0 ? 1.0 : (i & 3) == 1 ? 0.56234132519034908 : (i & 3) == 2 ? 0.31622776601683794 : 0.17782794100389228;
            inv *= (i >> 2) == 0 ? 1.0 : (i >> 2) == 1 ? 0.1 : (i >> 2) == 2 ? 0.01 : 0.001;
            const float ang = (float)pos * (float)inv; double s, c; sincos_rad((double)ang, s, c); rope[idx] = (f32x2){(float)c, (float)s}; }
    }
    {
        f32x2* tw = WSP(f32x2, WS_TW);
        for (int idx = gt; idx < 16384; idx += NGT) { double s, c; sincos_2pi((double)idx * (1.0 / 16384.0), s, c); tw[idx] = (f32x2){(float)c, (float)(-s)}; }
    }
    {
        const float* are = INP(26); const float* aim = INP(27); const float* ldt = INP(28); const float* bre = INP(29); const float* bim = INP(30);
        f32x2* lamb = WSP(f32x2, WS_S5LAM); f32x2* bb = WSP(f32x2, WS_S5B); f32x2* l256 = WSP(f32x2, WS_S5L256);
        for (int idx = gt; idx < 2 * 64 * 64; idx += NGT) { const int dg = idx >> 6;
            const float dt = expf(ldt[dg]); const float ar = are[idx], ai = aim[idx];
            const float zr = ar * dt, zi = ai * dt; double s, c; sincos_rad((double)zi, s, c); const double er = exp_small((double)zr);
            const double lr = er * c, li = er * s; lamb[idx] = (f32x2){(float)lr, (float)li};
            { double pr = lr, pi = li; for (int q = 0; q < 8; ++q) { const double tr = pr * pr - pi * pi, ti = 2.0 * pr * pi; pr = tr; pi = ti; } l256[idx] = (f32x2){(float)pr, (float)pi}; }
            const double nr = lr - 1.0, ni = li, den = (double)ar * ar + (double)ai * ai; const double qr = (nr * ar + ni * ai) / den, qi = (ni * ar - nr * ai) / den;
            for (int cc = 0; cc < 16; ++cc) { const double br = bre[(size_t)idx * 16 + cc], bi = bim[(size_t)idx * 16 + cc]; bb[(size_t)idx * 16 + cc] = (f32x2){(float)(qr * br - qi * bi), (float)(qr * bi + qi * br)}; } }
    }
    {
        float* wrt = WSP(float, WS_WRT);
        for (int idx = gt; idx < 2 * 72 * 2048; idx += NGT) { const int l = idx / (72 * 2048), r = idx % (72 * 2048), n = r / 2048, k = r % 2048;
            wrt[idx] = n < 8 ? INP(36)[((size_t)l * 2048 + k) * 8 + n] : INP(38)[((size_t)l * 2048 + k) * 64 + (n - 8)]; }
    }
    {
        bf16* ha = WSP(bf16, WS_HA);
        for (int idx = gt; idx < 2048; idx += NGT) ha[(size_t)TT * 2048 + idx] = 0;
    }
    LAS float* scr = (LAS float*)(F.lds + F.wave * 16896);
    {
        const float* c = INP(1); const float* cctx = INP(3); const float* adaw = INP(4); float* part = WSP(float, WS_ADAP);
        for (int rep = 0; rep < (((PH_REPEAT >> 26) & 1u) ? 2 : 1); ++rep)
        for (int it = F.gw; it < 2 * 32 * 48; it += F.NGW) {
            const int l = it / (32 * 48), r = it % (32 * 48), ks = r / 48, jb = r % 48, k0 = ks * 64, j0 = jb * 256 + F.lane * 4;
            const float c0 = c[k0 + F.lane], c1 = c[2048 + k0 + F.lane], c2 = cctx[k0 + F.lane];
            const float s0 = c0 / (1.0f + expf(-c0)), s1 = c1 / (1.0f + expf(-c1)), s2 = c2 / (1.0f + expf(-c2));
            f32x4 a0 = {0.f, 0.f, 0.f, 0.f}, a1 = a0, a2 = a0;
            const float* wp = adaw + ((size_t)l * 2048 + k0) * 12288 + j0;
#pragma unroll 8
            for (int kk = 0; kk < 64; ++kk) { const f32x4 w = *(const f32x4*)(wp + (size_t)kk * 12288);
                const float t0 = __builtin_bit_cast(float, __builtin_amdgcn_readlane(__builtin_bit_cast(int, s0), kk));
                const float t1 = __builtin_bit_cast(float, __builtin_amdgcn_readlane(__builtin_bit_cast(int, s1), kk));
                const float t2 = __builtin_bit_cast(float, __builtin_amdgcn_readlane(__builtin_bit_cast(int, s2), kk));
                a0 += w * t0; a1 += w * t1; a2 += w * t2; }
            float* pp = part + ((size_t)(l * 32 + ks) * 3) * 12288 + j0;
            *(f32x4*)(pp) = a0; *(f32x4*)(pp + 12288) = a1; *(f32x4*)(pp + 2 * 12288) = a2;
        }
    }
    {
        constexpr int I0 = 1024, I1 = 512, I2 = 512, I3 = 1024, I4 = 2048, I5 = 1024, I6 = 64, I7 = 256, IE = 768;
        constexpr int NSMALL = I0 + I1 + I2 + I3 + I4 + I5 + I6 + I7;
        const int NITEMS = NSMALL;
        for (int rep = 0; rep < (((PH_REPEAT >> 27) & 1u) ? 2 : 1); ++rep)
        for (int it = F.gw; it < NITEMS; it += F.NGW) {
            int r = it;
            if (r < I0) { tr_item(INP(9), 4096, 2048, WSP(bf16, WS_WIN0), 2048, 0, 16, scr, r, F.lane); continue; } r -= I0;
            if (r < I1) { tr_item(INP(9) + 2048, 4096, 1024, WSP(bf16, WS_WIN0), 2048, 3072, 16, scr, r, F.lane); continue; } r -= I1;
            if (r < I2) { tr_item(INP(9) + 3072, 4096, 1024, WSP(bf16, WS_WIN0), 2048, 2048, 16, scr, r, F.lane); continue; } r -= I2;
            if (r < I3) { tr_item(INP(10), 2048, 2048, WSP(bf16, WS_WOUT0), 2048, 0, 16, scr, r, F.lane); continue; } r -= I3;
            if (r < I4) { tr_item(INP(15), 4096, 4096, WSP(bf16, WS_WIN1), 2048, 0, 16, scr, r, F.lane); continue; } r -= I4;
            if (r < I5) { tr_item(INP(16), 2048, 2048, WSP(bf16, WS_WOUT1), 2048, 0, 16, scr, r, F.lane); continue; } r -= I5;
            if (r < I6) { const int g = r / 16; tr_item(INP(13) + (size_t)g * 65536, 256, 256, WSP(bf16, WS_WPOOL), 256, g * 256, 16, scr, r % 16, F.lane); continue; } r -= I6;
            if (r < I7) { tr_item(INP(34), 1024, 1024, WSP(bf16, WS_WGLU), 1024, 0, 16, scr, r, F.lane); continue; } r -= I7;
        }
    }
}

__device__ __forceinline__ void p1_reduce(Frame& F) {
    const int gt = F.bid * NTHREADS + F.tid, NGT = F.G * NTHREADS;
    const float* part = WSP(float, WS_ADAP); float* mod = WSP(float, WS_MOD); const float* adab = INP(5);
    for (int idx = gt; idx < 2 * 3 * 12288; idx += NGT) { const int l = idx / (3 * 12288), r = idx % (3 * 12288), m = r / 12288, j = r % 12288;
        float a = adab[l * 12288 + j];
        for (int ks = 0; ks < 32; ++ks) a += part[((size_t)(l * 32 + ks) * 3 + m) * 12288 + j];
        mod[idx] = a; }
    const float* normp = WSP(float, WS_NORMP); float* invn = WSP(float, WS_INVN);
    for (int idx = gt; idx < 2048; idx += NGT) { const int o = idx >> 10, ch = idx & 1023; float a = 0.f;
        for (int pb = 0; pb < 256; ++pb) a += normp[(size_t)pb * 4096 + o * 2048 + ch] + normp[(size_t)pb * 4096 + o * 2048 + 1024 + ch];
        invn[idx] = 1.0f / a; }
}

__device__ __forceinline__ const float* modp(Frame& F, int l, int m, int c) { return WSP(float, WS_MOD) + ((size_t)(l * 3 + m) * 6 + c) * 2048; }
__device__ __forceinline__ int row_stream(int r) { return r < TL ? r / SEQ : 2; }

template <int MODE>
__device__ __forceinline__ void norm_phase(Frame& F, int l, float* dout) {
    const int nrows = (MODE == 3 || (MODE == 1 && l == 1)) ? TL : TT;
    float* xbuf = WSP(float, WS_X); bf16* ha = WSP(bf16, WS_HA); const bf16* Y = WSP(bf16, WS_Y);
    const float* gvec = (MODE == 0) ? INP(6) : (MODE == 1) ? INP(7) + l * 2048 : (MODE == 2) ? INP(6) + 2048 : INP(8);
    const int lane = F.lane;
    for (int r = F.gw; r < nrows; r += F.NGW) {
        const int m = row_stream(r);
        const float* src = (MODE == 0) ? (r < TL ? INP(0) + (size_t)r * 2048 : INP(2) + (size_t)(r - TL) * 2048) : xbuf + (size_t)r * 2048;
        f32x4 v[8]; float ss = 0.f;
#pragma unroll
        for (int j = 0; j < 8; ++j) v[j] = *(const f32x4*)(src + 4 * lane + 256 * j);
        if (MODE == 2 || MODE == 3) {
            const float* g2 = modp(F, MODE == 2 ? 0 : 1, m, 5);
            const bf16* y0 = Y + (size_t)(2 * r) * 2048; const bf16* y1 = y0 + 2048;
#pragma unroll
            for (int j = 0; j < 8; ++j) { const int c = 4 * lane + 256 * j; const v2u a = *(const v2u*)(y0 + c), b = *(const v2u*)(y1 + c); const f32x4 gg = *(const f32x4*)(g2 + c);
                v[j].x += gg.x * (bflo(a.x) + bflo(b.x)); v[j].y += gg.y * (bfhi(a.x) + bfhi(b.x)); v[j].z += gg.z * (bflo(a.y) + bflo(b.y)); v[j].w += gg.w * (bfhi(a.y) + bfhi(b.y)); }
            if (MODE == 2) {
#pragma unroll
                for (int j = 0; j < 8; ++j) *(f32x4*)(xbuf + (size_t)r * 2048 + 4 * lane + 256 * j) = v[j];
            }
        }
#pragma unroll
        for (int j = 0; j < 8; ++j) ss += (v[j].x * v[j].x + v[j].y * v[j].y) + (v[j].z * v[j].z + v[j].w * v[j].w);
        ss = wave_sum(ss);
        const float rs = 1.0f / sqrtf(ss * (1.0f / 2048.0f) + EPS);
        if (MODE == 3) {
#pragma unroll
            for (int j = 0; j < 8; ++j) { const int c = 4 * lane + 256 * j; const f32x4 gg = *(const f32x4*)(gvec + c); *(f32x4*)(dout + (size_t)r * 2048 + c) = v[j] * rs * gg; }
            continue;
        }
        const int lm = (MODE == 2) ? 1 : l;
        const float* sh = modp(F, lm, m, MODE == 1 ? 3 : 0); const float* sc = modp(F, lm, m, MODE == 1 ? 4 : 1);
#pragma unroll
        for (int j = 0; j < 8; ++j) { const int c = 4 * lane + 256 * j; const f32x4 gg = *(const f32x4*)(gvec + c), s1 = *(const f32x4*)(sc + c), s0 = *(const f32x4*)(sh + c);
            v[j] = (v[j] * rs * gg) * (1.0f + s1) + s0;
            v2u o; o.x = pk2(v[j].x, v[j].y); o.y = pk2(v[j].z, v[j].w); *(v2u*)(ha + (size_t)r * 2048 + c) = o; }
    }
}

__device__ __forceinline__ void ffn_norm_router_phase(Frame& F, int l) {
    const int nrows = (l == 1) ? TL : TT;
    const float* xbuf = WSP(float, WS_X); bf16* ha = WSP(bf16, WS_HA);
    const float* gvec = INP(7) + l * 2048;
    const float* wrt = WSP(float, WS_WRT) + (size_t)l * 72 * 2048;
    LAS float* lg = (LAS float*)(F.lds + F.wave * 2048);
    const int lane = F.lane;
    for (int r0 = F.gw * 4; r0 < nrows; r0 += F.NGW * 4) {
        f32x4 v[4][8];
#pragma unroll
        for (int rr = 0; rr < 4; ++rr) {
            const int r = r0 + rr, m = row_stream(r);
            const float* src = xbuf + (size_t)r * 2048; float ss = 0.f;
#pragma unroll
            for (int j = 0; j < 8; ++j) { v[rr][j] = *(const f32x4*)(src + 4 * lane + 256 * j); ss += (v[rr][j].x * v[rr][j].x + v[rr][j].y * v[rr][j].y) + (v[rr][j].z * v[rr][j].z + v[rr][j].w * v[rr][j].w); }
            ss = wave_sum(ss);
            const float rs = 1.0f / sqrtf(ss * (1.0f / 2048.0f) + EPS);
            const float* sh = modp(F, l, m, 3); const float* sc = modp(F, l, m, 4);
#pragma unroll
            for (int j = 0; j < 8; ++j) { const int c = 4 * lane + 256 * j; const f32x4 gg = *(const f32x4*)(gvec + c), s1 = *(const f32x4*)(sc + c), s0 = *(const f32x4*)(sh + c);
                v[rr][j] = (v[rr][j] * rs * gg) * (1.0f + s1) + s0;
                v2u o; o.x = pk2(v[rr][j].x, v[rr][j].y); o.y = pk2(v[rr][j].z, v[rr][j].w); *(v2u*)(ha + (size_t)r * 2048 + c) = o; }
        }
        const bool b5 = (lane & 32) != 0, b4 = (lane & 16) != 0, b3 = (lane & 8) != 0, b2 = (lane & 4) != 0, b1 = (lane & 2) != 0;
#pragma nounroll
        for (int q = 0; q < 9; ++q) {
            float a[32];
#pragma unroll
            for (int nn = 0; nn < 8; ++nn) { const float* wn = wrt + (size_t)(q * 8 + nn) * 2048 + 4 * lane; float s0 = 0.f, s1 = 0.f, s2 = 0.f, s3 = 0.f;
#pragma unroll
                for (int j = 0; j < 8; ++j) { const f32x4 w = *(const f32x4*)(wn + 256 * j);
                    s0 += (v[0][j].x * w.x + v[0][j].y * w.y) + (v[0][j].z * w.z + v[0][j].w * w.w); s1 += (v[1][j].x * w.x + v[1][j].y * w.y) + (v[1][j].z * w.z + v[1][j].w * w.w);
                    s2 += (v[2][j].x * w.x + v[2][j].y * w.y) + (v[2][j].z * w.z + v[2][j].w * w.w); s3 += (v[3][j].x * w.x + v[3][j].y * w.y) + (v[3][j].z * w.z + v[3][j].w * w.w); }
                a[nn] = s0; a[8 + nn] = s1; a[16 + nn] = s2; a[24 + nn] = s3; }
            float c16[16], c8[8], c4[4], c2[2], c1;
#pragma unroll
            for (int i = 0; i < 16; ++i) { const float keep = b5 ? a[i + 16] : a[i], send = b5 ? a[i] : a[i + 16]; c16[i] = keep + __shfl_xor(send, 32); }
#pragma unroll
            for (int i = 0; i < 8; ++i) { const float keep = b4 ? c16[i + 8] : c16[i], send = b4 ? c16[i] : c16[i + 8]; c8[i] = keep + __shfl_xor(send, 16); }
#pragma unroll
            for (int i = 0; i < 4; ++i) { const float keep = b3 ? c8[i + 4] : c8[i], send = b3 ? c8[i] : c8[i + 4]; c4[i] = keep + __shfl_xor(send, 8); }
#pragma unroll
            for (int i = 0; i < 2; ++i) { const float keep = b2 ? c4[i + 2] : c4[i], send = b2 ? c4[i] : c4[i + 2]; c2[i] = keep + __shfl_xor(send, 4); }
            { const float keep = b1 ? c2[1] : c2[0], send = b1 ? c2[0] : c2[1]; c1 = keep + __shfl_xor(send, 2); }
            c1 += __shfl_xor(c1, 1);
            if ((lane & 1) == 0) { const int i = lane >> 1; lg[(i >> 3) * 80 + q * 8 + (i & 7)] = c1; }
        }
        LDS_WAIT(); asm volatile("" ::: "memory");
        if (lane < 4) {
            const int r = r0 + lane; const LAS float* L = lg + lane * 80;
            float gl[8]; float gmax = -INFINITY; int gi = 0;
#pragma unroll
            for (int j = 0; j < 8; ++j) { gl[j] = L[j] + INP(37)[l * 8 + j]; if (gl[j] > gmax) { gmax = gl[j]; gi = j; } }
            float gsum = 0.f;
#pragma unroll
            for (int j = 0; j < 8; ++j) gsum += expf(gl[j] - gmax);
            const float pg_top = 1.0f / gsum;
            float pe[8]; float emax = -INFINITY;
#pragma unroll
            for (int j = 0; j < 8; ++j) { pe[j] = L[8 + gi * 8 + j] + INP(39)[l * 64 + gi * 8 + j]; emax = fmaxf(emax, pe[j]); }
            float esum = 0.f;
#pragma unroll
            for (int j = 0; j < 8; ++j) { pe[j] = expf(pe[j] - emax); esum += pe[j]; }
            int e1 = 0; float p1 = -1.f;
#pragma unroll
            for (int j = 0; j < 8; ++j) { pe[j] /= esum; if (pe[j] > p1) { p1 = pe[j]; e1 = j; } }
            int e2 = 0; float p2 = -1.f;
#pragma unroll
            for (int j = 0; j < 8; ++j) { if (j != e1 && pe[j] > p2) { p2 = pe[j]; e2 = j; } }
            const float den = p1 + p2; const float g1 = pg_top * p1 / den, g2 = pg_top * p2 / den;
            unsigned* cnt = WSP(unsigned, WS_CTL) + CW_CNT + l * 64; int* tokl = WSP(int, WS_TOKL); float* gatel = WSP(float, WS_GATEL);
            const int ex1 = gi * 8 + e1, ex2 = gi * 8 + e2;
            const unsigned k1 = atomicAdd(cnt + ex1, 1u); tokl[(size_t)ex1 * LISTCAP + k1] = 2 * r; gatel[(size_t)ex1 * LISTCAP + k1] = g1;
            const unsigned k2 = atomicAdd(cnt + ex2, 1u); tokl[(size_t)ex2 * LISTCAP + k2] = 2 * r + 1; gatel[(size_t)ex2 * LISTCAP + k2] = g2;
        }
        LDS_WAIT(); asm volatile("" ::: "memory");
    }
}

#define EPI_ARGS const f32x4 (&acc)[2][2][4][2], const pg8::Unit& u, int wr, int wc, int fr, int fq
__device__ __forceinline__ void st_bf4(bf16* p, f32x4 v) { v2u o; o.x = cvt_pk_bf16(v.x, v.y); o.y = cvt_pk_bf16(v.z, v.w); *(v2u*)p = o; }

struct EpiQKP {
    bf16* Q; bf16* Kb; bf16* P; const f32x2* rope;
    __device__ __forceinline__ void operator()(EPI_ARGS) const {
        const int sect = u.pn >> 2, cb = (u.pn & 3) * 256; const bool latent = u.pm < TL / 256;
#pragma unroll
        for (int ai = 0; ai < 2; ++ai)
#pragma unroll
            for (int m = 0; m < 4; ++m) {
                const int r = u.pm * 256 + ai * 128 + wr * 64 + m * 16 + fr;
                int b, t; if (latent) { b = r / SEQ; t = r % SEQ; } else { b = (r - TL) / CTX; t = (r - TL) % CTX; }
                f32x4 cs0 = {1.f, 0.f, 1.f, 0.f}, cs1 = cs0;
                if (latent && sect < 2) { const int pos = (wc & 1) ? (t & 63) : (t >> 6); const f32x4* rp = (const f32x4*)(rope + pos * 16 + 4 * fq); cs0 = rp[0]; cs1 = rp[1]; }
#pragma unroll
                for (int bj = 0; bj < 2; ++bj) {
                    const int c0 = cb + bj * 128 + wc * 32 + 4 * fq;
                    f32x4 a = acc[ai][bj][m][0], bb = acc[ai][bj][m][1];
                    if (sect < 2) {
                        const f32x4 co = {cs0.x, cs0.z, cs1.x, cs1.z}, si = {cs0.y, cs0.w, cs1.y, cs1.w};
                        const f32x4 oa = a * co - bb * si, ob = a * si + bb * co; a = oa; bb = ob;
                    }
                    if (sect == 0) { a = a * QSCALE; bb = bb * QSCALE; bf16* d = Q + (size_t)r * 1024 + c0; st_bf4(d, a); st_bf4(d + 16, bb); }
                    else if (sect == 1) { const size_t kr = (size_t)b * KEYS + (latent ? CTX + t : t); bf16* d = Kb + kr * 1024 + c0; st_bf4(d, a); st_bf4(d + 16, bb); }
                    else { bf16* d = P + (size_t)r * 1024 + c0; st_bf4(d, a); st_bf4(d + 16, bb); }
                }
            }
    }
};
struct EpiVT {
    bf16* VT;
    __device__ __forceinline__ void operator()(EPI_ARGS) const {
        const bool latent = u.pn < TL / 256; const int b = latent ? u.pn / 32 : u.pn - TL / 256; const int key_t0 = latent ? CTX + (u.pn % 32) * 256 : 0;
        const int kperm = 8 * (fq & 1) + 4 * (fq >> 1);
#pragma unroll
        for (int ai = 0; ai < 2; ++ai)
#pragma unroll
            for (int m = 0; m < 4; ++m) {
                const int rr = u.pm * 256 + ai * 128 + wr * 64 + m * 16 + fr;
                bf16* rowp = VT + ((size_t)b * 1024 + rr) * KEYS + key_t0;
#pragma unroll
                for (int bj = 0; bj < 2; ++bj)
#pragma unroll
                    for (int n = 0; n < 2; ++n) st_bf4(rowp + bj * 128 + wc * 32 + 16 * n + kperm, acc[ai][bj][m][n]);
            }
    }
};
struct EpiScaleBf16 {
    bf16* O; int ldo, coff; const float* cscale;
    __device__ __forceinline__ void operator()(EPI_ARGS) const {
#pragma unroll
        for (int bj = 0; bj < 2; ++bj)
#pragma unroll
            for (int n = 0; n < 2; ++n) { const int c = u.pn * 256 + bj * 128 + wc * 32 + 16 * n + 4 * fq; const f32x4 sc = *(const f32x4*)(cscale + c);
#pragma unroll
                for (int ai = 0; ai < 2; ++ai)
#pragma unroll
                    for (int m = 0; m < 4; ++m) { const int r = u.pm * 256 + ai * 128 + wr * 64 + m * 16 + fr; st_bf4(O + (size_t)r * ldo + coff + c, acc[ai][bj][m][n] * sc); } }
    }
};
struct EpiBf16 {
    bf16* O; int ldo;
    __device__ __forceinline__ void operator()(EPI_ARGS) const {
#pragma unroll
        for (int ai = 0; ai < 2; ++ai)
#pragma unroll
            for (int m = 0; m < 4; ++m) { const int r = u.pm * 256 + ai * 128 + wr * 64 + m * 16 + fr; bf16* rowp = O + (size_t)r * ldo + u.pn * 256 + wc * 32 + 4 * fq;
#pragma unroll
                for (int bj = 0; bj < 2; ++bj)
#pragma unroll
                    for (int n = 0; n < 2; ++n) st_bf4(rowp + bj * 128 + 16 * n, acc[ai][bj][m][n]); }
    }
};
struct EpiRes {
    const float* xlat; const float* xctx; float* xout; const float* gate0;
    __device__ __forceinline__ void operator()(EPI_ARGS) const {
        const bool latent = u.pm < TL / 256;
#pragma unroll
        for (int ai = 0; ai < 2; ++ai)
#pragma unroll
            for (int m = 0; m < 4; ++m) { const int r = u.pm * 256 + ai * 128 + wr * 64 + m * 16 + fr; const int ms = latent ? r / SEQ : 2;
                const float* xi = latent ? xlat + (size_t)r * 2048 : xctx + (size_t)(r - TL) * 2048; const float* gp = gate0 + (size_t)ms * 12288;
#pragma unroll
                for (int bj = 0; bj < 2; ++bj)
#pragma unroll
                    for (int n = 0; n < 2; ++n) { const int c = u.pn * 256 + bj * 128 + wc * 32 + 16 * n + 4 * fq;
                        const f32x4 xv = *(const f32x4*)(xi + c), gv = *(const f32x4*)(gp + c); *(f32x4*)(xout + (size_t)r * 2048 + c) = xv + gv * acc[ai][bj][m][n]; } }
    }
};
struct EpiMoeUp {
    bf16* H;
    __device__ __forceinline__ void operator()(EPI_ARGS) const {
#pragma unroll
        for (int ai = 0; ai < 2; ++ai)
#pragma unroll
            for (int m = 0; m < 4; ++m) { const size_t r = (size_t)u.pm * 256 + ai * 128 + wr * 64 + m * 16 + fr;
#pragma unroll
                for (int bj = 0; bj < 2; ++bj) { const int hc = (u.pn * 256 + bj * 128 + wc * 32) / 2 + 4 * fq; const f32x4 a = acc[ai][bj][m][0], b = acc[ai][bj][m][1];
                    const f32x4 h = {siluf_(a.x) * b.x, siluf_(a.y) * b.y, siluf_(a.z) * b.z, siluf_(a.w) * b.w}; st_bf4(H + r * 512 + hc, h); } }
    }
};
struct EpiMoeDown {
    bf16* Y; const int* tokl; const float* gatel; const unsigned* cnt;
    __device__ __forceinline__ void operator()(EPI_ARGS) const {
        const int ce = (int)cnt[u.e];
#pragma unroll
        for (int ai = 0; ai < 2; ++ai)
#pragma unroll
            for (int m = 0; m < 4; ++m) { const int idx = u.idx0 + ai * 128 + wr * 64 + m * 16 + fr;
                if (idx < ce) { const int pair = tokl[(size_t)u.e * LISTCAP + idx]; const float gt = gatel[(size_t)u.e * LISTCAP + idx]; bf16* rowp = Y + (size_t)pair * 2048 + u.pn * 256 + wc * 32 + 4 * fq;
#pragma unroll
                    for (int bj = 0; bj < 2; ++bj)
#pragma unroll
                        for (int n = 0; n < 2; ++n) st_bf4(rowp + bj * 128 + 16 * n, acc[ai][bj][m][n] * gt); } }
    }
};
struct EpiGlu {
    bf16* O; int ldo, coff; const bf16* Gb; const float* bias;
    __device__ __forceinline__ void operator()(EPI_ARGS) const {
#pragma unroll
        for (int ai = 0; ai < 2; ++ai)
#pragma unroll
            for (int m = 0; m < 4; ++m) { const int r = u.pm * 256 + ai * 128 + wr * 64 + m * 16 + fr;
#pragma unroll
                for (int bj = 0; bj < 2; ++bj)
#pragma unroll
                    for (int n = 0; n < 2; ++n) { const int c = u.pn * 256 + bj * 128 + wc * 32 + 16 * n + 4 * fq; const f32x4 bv = *(const f32x4*)(bias + c); const v2u gw = *(const v2u*)(Gb + (size_t)r * 1024 + c);
                        const f32x4 a = acc[ai][bj][m][n] + bv; const f32x4 o = {bflo(gw.x) * sigmoidf_(a.x), bfhi(gw.x) * sigmoidf_(a.y), bflo(gw.y) * sigmoidf_(a.z), bfhi(gw.y) * sigmoidf_(a.w)};
                        st_bf4(O + (size_t)r * ldo + coff + c, o); } }
    }
};

struct MoeOrder {
    const LAS int* bstart;
    const unsigned* cnt; const int* tokl; int nN, G, c, nblk; long bstride, eoff; bool up;
    __device__ bool next(int i, pg8::Unit& u) const {
        const long Lx = (long)i * G + c; if (Lx >= (long)nblk * nN) return false;
        const int blk = (int)(Lx / nN); u.pn = (int)(Lx % nN); u.pm = blk;
        const int e = bstart[65 + blk];
        u.e = e; u.idx0 = (blk - bstart[e]) * 256;
        u.aoff = up ? 0 : (long)blk * 256 * 512 * 2;
        u.boff = (long)e * (long)MOE_E_BYTES + eoff + (long)u.pn * bstride;
        return true;
    }
    __device__ int arow(const pg8::Unit& u, int row) const { const int idx = u.idx0 + row; return idx < (int)cnt[u.e] ? (tokl[(size_t)u.e * LISTCAP + idx] >> 1) : TT; }
};

#ifdef ATT_NORARE
#define ATT_RARE(mx) false
#else
#define ATT_RARE(mx) __any(mx > 8.0f)
#endif
__device__ __forceinline__ void attn_phase(Frame& F) {
    const bf16* Q = WSP(bf16, WS_Q); const bf16* Kb = WSP(bf16, WS_K); const bf16* VT = WSP(bf16, WS_VT); bf16* cat = WSP(bf16, WS_CAT);
    LAS unsigned char* lds = F.lds;
    const int lane0 = F.lane;
    float lam;
    { const float* lv = INP(11); float a = lv[lane0] * lv[64 + lane0], b = lv[128 + lane0] * lv[192 + lane0]; a = wave_sum(a); b = wave_sum(b); lam = expf(a) - expf(b) + 0.2f; }
    const float* subg = INP(12);
    const int NU = 1024 + 32;
    const int xcd = F.bid & 7, jcu = F.bid >> 3;
    for (int it = 0;; ++it) {
        int tl_ = F.tid; asm volatile("" : "+v"(tl_));
        const int lane = tl_ & 63, w = __builtin_amdgcn_readfirstlane(tl_ >> 6), sub = w & 1, qw = w >> 1, r32 = lane & 31, hi = lane >> 5;
        int uidx;
        if (F.G == 256) { if (it < 4) uidx = 128 * xcd + it * 32 + jcu; else if (it == 4 && F.bid < 32) uidx = 1024 + F.bid; else break; }
        else { uidx = it * F.G + F.bid; if (uidx >= NU) break; }
        int b, head, q0row, nt; size_t kbase;
        if (uidx < 1024) { const int combo = uidx >> 6, qb = uidx & 63; b = combo >> 3; head = combo & 7; q0row = b * SEQ + qb * 128; nt = KEYS / 64; }
        else { const int v = uidx - 1024; b = v >> 4; head = (v >> 1) & 7; q0row = TL + b * CTX + (v & 1) * 128; nt = CTX / 64; }
        kbase = (size_t)b * KEYS;
        bf16x8 qf[4];
        { const bf16* qp = Q + (size_t)(q0row + qw * 32 + r32) * 1024 + head * 128 + sub * 64 + hi * 8;
#pragma unroll
          for (int ks = 0; ks < 4; ++ks) qf[ks] = *(const bf16x8*)(qp + ks * 16); }
        const char* gsrc[4];
#pragma unroll
        for (int j = 0; j < 4; ++j) { const int pi = w * 4 + j, rr = lane >> 3, pc = lane & 7;
            if (pi < 16) { const int key = (pi & 7) * 8 + rr, c = pc ^ ((key >> 1) & 7); gsrc[j] = (const char*)(Kb + (kbase + key) * 1024 + head * 128 + (pi >> 3) * 64 + c * 8); }
            else { const int dvr = (pi - 16) * 8 + rr, c = pc ^ ((dvr >> 1) & 7); gsrc[j] = (const char*)(VT + ((size_t)(b * 8 + head) * 128 + dvr) * KEYS + c * 8); } }
        const size_t gstep = (w < 4) ? (size_t)65536 * 2 : (size_t)64 * 2;
        const unsigned ldst = (unsigned)w * 4096u;
#define ATT_DMA(t, buf) do { _Pragma("unroll") for (int _j = 0; _j < 4; ++_j) \
            __builtin_amdgcn_global_load_lds((const unsigned*)(gsrc[_j] + (size_t)(t) * gstep), (LAS unsigned*)(lds + (buf) * 32768 + ldst + _j * 1024), 16, 0, 0); } while (0)
        ATT_DMA(0, 0); ATT_DMA(1, 1); ATT_DMA(2, 2);
        asm volatile("s_waitcnt vmcnt(4)" ::: "memory");
        __builtin_amdgcn_s_barrier();
        f32x16 o[4];
#pragma unroll
        for (int d = 0; d < 4; ++d)
#pragma unroll
            for (int r = 0; r < 16; ++r) o[d][r] = 0.f;
        float mref = 0.f, lrow = 0.f;
        f32x16 negm;
#pragma unroll
        for (int r = 0; r < 16; ++r) negm[r] = 0.f;
        const int rdoff = r32 * 128;
        const int swz = (r32 >> 1) & 7;
        f32x16 s0, s1; bf16x8 pf[4];
#define ATT_QK(bufidx) do { const LAS unsigned char* kp_ = lds + (bufidx) * 32768 + sub * 8192; bf16x8 kfa[4], kfb[4]; \
            _Pragma("unroll") for (int ks = 0; ks < 4; ++ks) { const int ch = ((2 * ks + hi) ^ swz) * 16; kfa[ks] = *(const LAS bf16x8*)(kp_ + rdoff + ch); kfb[ks] = *(const LAS bf16x8*)(kp_ + 4096 + rdoff + ch); } \
            s0 = negm; s1 = negm; \
            _Pragma("unroll") for (int ks = 0; ks < 4; ++ks) { s0 = __builtin_amdgcn_mfma_f32_32x32x16_bf16(kfa[ks], qf[ks], s0, 0, 0, 0); s1 = __builtin_amdgcn_mfma_f32_32x32x16_bf16(kfb[ks], qf[ks], s1, 0, 0, 0); } } while (0)
#define ATT_MAX(mx) do { float mxa = fmaxf(fmaxf(s0[0], s0[1]), s0[2]), mxb = fmaxf(fmaxf(s1[0], s1[1]), s1[2]); \
            _Pragma("unroll") for (int r = 3; r < 15; r += 2) { mxa = fmaxf(fmaxf(mxa, s0[r]), s0[r + 1]); mxb = fmaxf(fmaxf(mxb, s1[r]), s1[r + 1]); } \
            mx = fmaxf(fmaxf(mxa, mxb), fmaxf(s0[15], s1[15])); mx = fmaxf(mx, __shfl_xor(mx, 32)); } while (0)
#define ATT_FIX(mx) do { const float dl = fmaxf(mx, 0.f); mref += dl; const float alpha = __builtin_amdgcn_exp2f(-dl); lrow *= alpha; \
            _Pragma("unroll") for (int r = 0; r < 16; ++r) { s0[r] -= dl; s1[r] -= dl; negm[r] = -mref; } \
            _Pragma("unroll") for (int d = 0; d < 4; ++d) _Pragma("unroll") for (int r = 0; r < 16; ++r) o[d][r] *= alpha; } while (0)
#define ATT_EXP8(S, base, dst) do { float rs_ = 0.f; _Pragma("unroll") for (int r = 0; r < 8; ++r) { S[base + r] = __builtin_amdgcn_exp2f(S[base + r]); rs_ += S[base + r]; } lrow += rs_; \
            v4u pw_; pw_.x = cvt_pk_bf16(S[base + 0], S[base + 1]); pw_.y = cvt_pk_bf16(S[base + 2], S[base + 3]); pw_.z = cvt_pk_bf16(S[base + 4], S[base + 5]); pw_.w = cvt_pk_bf16(S[base + 6], S[base + 7]); dst = __builtin_bit_cast(bf16x8, pw_); } while (0)
#define ATT_VLD(dstv, vp_, s) do { _Pragma("unroll") for (int d = 0; d < 4; ++d) dstv[d] = *(const LAS bf16x8*)(vp_ + d * 4096 + rdoff + (((2 * (s) + hi) ^ swz) * 16)); } while (0)
#define ATT_PV4(srcv, pfrag) do { _Pragma("unroll") for (int d = 0; d < 4; ++d) o[d] = __builtin_amdgcn_mfma_f32_32x32x16_bf16(srcv[d], pfrag, o[d], 0, 0, 0); } while (0)
        { ATT_QK(0); float mx; ATT_MAX(mx); if (__any(mx > 8.0f)) ATT_FIX(mx);
          ATT_EXP8(s0, 0, pf[0]); ATT_EXP8(s0, 8, pf[1]); ATT_EXP8(s1, 0, pf[2]); ATT_EXP8(s1, 8, pf[3]); }
        int bcur = 0;
#pragma nounroll
        for (int t = 0; t < nt; ++t) {
            const int bn1 = (bcur + 1) & 3, bn3 = (bcur + 3) & 3;
            if (t + 3 < nt) ATT_DMA(t + 3, bn3);
            const LAS unsigned char* vp = lds + bcur * 32768 + 16384;
            bf16x8 vfa[4], vfb[4];
            if (t + 1 < nt) {
                __builtin_amdgcn_sched_barrier(0);
                ATT_QK(bn1);
                float mx; ATT_MAX(mx);
                __builtin_amdgcn_sched_barrier(0);
                if (__any(mx > 8.0f)) {
                    const float dl = fmaxf(mx, 0.f); mref += dl; const float alpha = __builtin_amdgcn_exp2f(-dl); lrow *= alpha;
#pragma unroll
                    for (int r = 0; r < 16; ++r) { s0[r] -= dl; s1[r] -= dl; negm[r] = -mref; }
#pragma unroll
                    for (int d = 0; d < 4; ++d)
#pragma unroll
                        for (int r = 0; r < 16; ++r) o[d][r] *= alpha;
#pragma unroll
                    for (int s = 0; s < 4; ++s) { v4u pw = __builtin_bit_cast(v4u, pf[s]);
                        pw.x = cvt_pk_bf16(bflo(pw.x) * alpha, bfhi(pw.x) * alpha); pw.y = cvt_pk_bf16(bflo(pw.y) * alpha, bfhi(pw.y) * alpha);
                        pw.z = cvt_pk_bf16(bflo(pw.z) * alpha, bfhi(pw.z) * alpha); pw.w = cvt_pk_bf16(bflo(pw.w) * alpha, bfhi(pw.w) * alpha); pf[s] = __builtin_bit_cast(bf16x8, pw); }
                }
                __builtin_amdgcn_sched_barrier(0);
                {
                    ATT_VLD(vfa, vp, 0);
                    __builtin_amdgcn_sched_barrier(0);
                    ATT_VLD(vfb, vp, 1); ATT_PV4(vfa, pf[0]); ATT_EXP8(s0, 0, pf[0]);
                    __builtin_amdgcn_sched_barrier(0);
                    ATT_VLD(vfa, vp, 2); ATT_PV4(vfb, pf[1]); ATT_EXP8(s0, 8, pf[1]);
                    __builtin_amdgcn_sched_barrier(0);
                    ATT_VLD(vfb, vp, 3); ATT_PV4(vfa, pf[2]); ATT_EXP8(s1, 0, pf[2]);
                    __builtin_amdgcn_sched_barrier(0);
                    ATT_PV4(vfb, pf[3]); ATT_EXP8(s1, 8, pf[3]);
                }
                __builtin_amdgcn_sched_barrier(0);
            } else {
#pragma unroll
                for (int s = 0; s < 4; ++s) { ATT_VLD(vfa, vp, s); ATT_PV4(vfa, pf[s]); }
            }
            if (t + 3 < nt) asm volatile("s_waitcnt vmcnt(4) lgkmcnt(0)" ::: "memory"); else asm volatile("s_waitcnt vmcnt(0) lgkmcnt(0)" ::: "memory");
            __builtin_amdgcn_s_barrier();
            bcur = bn1;
        }
#undef ATT_DMA
#undef ATT_QK
#undef ATT_MAX
#undef ATT_FIX
#undef ATT_EXP8
#undef ATT_VLD
#undef ATT_PV4
        const float ltot = lrow + __shfl_xor(lrow, 32); const float linv = 1.0f / ltot;
        LAS float* xch = (LAS float*)lds + (size_t)(qw * 32 + r32) * 132;
        if (sub == 1) {
#pragma unroll
            for (int d = 0; d < 4; ++d)
#pragma unroll
                for (int g = 0; g < 4; ++g) *(LAS f32x4*)(xch + 32 * d + 8 * g + 4 * hi) = (f32x4){o[d][4 * g] * linv, o[d][4 * g + 1] * linv, o[d][4 * g + 2] * linv, o[d][4 * g + 3] * linv};
        }
        __syncthreads();
        if (sub == 0) {
            float ss = 0.f;
#pragma unroll
            for (int d = 0; d < 4; ++d)
#pragma unroll
                for (int g = 0; g < 4; ++g) { const f32x4 o2 = *(const LAS f32x4*)(xch + 32 * d + 8 * g + 4 * hi);
#pragma unroll
                    for (int j = 0; j < 4; ++j) { const float v = o[d][4 * g + j] * linv - lam * o2[j]; o[d][4 * g + j] = v; ss += v * v; } }
            ss += __shfl_xor(ss, 32);
            const float rn = 0.8f / sqrtf(ss * (1.0f / 128.0f) + EPS);
            bf16* op = cat + (size_t)(q0row + qw * 32 + r32) * 2048 + head * 128;
#pragma unroll
            for (int d = 0; d < 4; ++d)
#pragma unroll
                for (int g = 0; g < 4; ++g) { const int dv = 32 * d + 8 * g + 4 * hi; const f32x4 gg = *(const f32x4*)(subg + dv);
                    st_bf4(op + dv, (f32x4){o[d][4 * g] * rn * gg.x, o[d][4 * g + 1] * rn * gg.y, o[d][4 * g + 2] * rn * gg.z, o[d][4 * g + 3] * rn * gg.w}); }
        }
        __syncthreads();
    }
}

__device__ __forceinline__ void poold_phase(Frame& F) {
    const bf16* P = WSP(bf16, WS_P); bf16* PD = WSP(bf16, WS_PD);
    const int gt = F.bid * NTHREADS + F.tid, NGT = F.G * NTHREADS;
    for (int idx = gt; idx < TT * 128; idx += NGT) {
        const int r = idx >> 7, cc = (idx & 127) * 8, g = cc >> 8, wdw = 2 << g;
        int sb, t, Ls; if (r < TL) { sb = (r / SEQ) * SEQ; t = r % SEQ; Ls = SEQ; } else { sb = TL + ((r - TL) / CTX) * CTX; t = (r - TL) % CTX; Ls = CTX; }
        int lo = t - wdw / 2, hi = lo + wdw; lo = lo < 0 ? 0 : lo; hi = hi > Ls ? Ls : hi;
        float a[8];
#pragma unroll
        for (int j = 0; j < 8; ++j) a[j] = 0.f;
        for (int s = lo; s < hi; ++s) { const v4u v = *(const v4u*)(P + (size_t)(sb + s) * 1024 + cc);
            a[0] += bflo(v.x); a[1] += bfhi(v.x); a[2] += bflo(v.y); a[3] += bfhi(v.y); a[4] += bflo(v.z); a[5] += bfhi(v.z); a[6] += bflo(v.w); a[7] += bfhi(v.w); }
        const float inv = 1.0f / (float)(hi - lo);
        const v4u me = *(const v4u*)(P + (size_t)r * 1024 + cc);
        v4u o; o.x = pk2(a[0] * inv - bflo(me.x), a[1] * inv - bfhi(me.x)); o.y = pk2(a[2] * inv - bflo(me.y), a[3] * inv - bfhi(me.y));
        o.z = pk2(a[4] * inv - bflo(me.z), a[5] * inv - bfhi(me.z)); o.w = pk2(a[6] * inv - bflo(me.w), a[7] * inv - bfhi(me.w));
        *(v4u*)(PD + (size_t)r * 1024 + cc) = o;
    }
}

__device__ __forceinline__ void shortconv_phase(Frame& F) {
    const bf16* PJ = WSP(bf16, WS_PROJ1); float* GT = WSP(float, WS_GT);
    const float* cw = INP(17); const float* cb = INP(18);
    LAS float* scr = (LAS float*)(F.lds + F.wave * 16896);
    const int lane = F.lane;
    for (int it = F.gw; it < 2 * 128 * 48; it += F.NGW) {
        const int cbk = it % 48, tb = (it / 48) % 128, b = it / (48 * 128), col = cbk * 64 + lane, t0 = tb * 64;
        const float w0 = cw[col], w1 = cw[3072 + col], w2 = cw[2 * 3072 + col], bias = cb[col];
        const bf16* base = PJ + ((size_t)b * SEQ) * 4096 + col;
        float prev = (t0 > 0) ? bf2f(base[(size_t)(t0 - 1) * 4096]) : 0.f;
        float cur = bf2f(base[(size_t)t0 * 4096]);
#pragma unroll 8
        for (int tt = 0; tt < 64; ++tt) { const int t = t0 + tt; const float nxt = (t + 1 < SEQ) ? bf2f(base[(size_t)(t + 1) * 4096]) : 0.f;
            scr[tt * 65 + lane] = prev * w0 + cur * w1 + nxt * w2 + bias; prev = cur; cur = nxt; }
        LDS_WAIT(); asm volatile("" ::: "memory");
        for (int c = 0; c < 64; ++c) GT[((size_t)(cbk * 64 + c) * 2 + b) * SEQ + t0 + lane] = scr[lane * 65 + c];
        LDS_WAIT(); asm volatile("" ::: "memory");
    }
}

__device__ __forceinline__ void s5_scan_phase(Frame& F) {
    const bf16* PJ = WSP(bf16, WS_PROJ1); float* YD = WSP(float, WS_YD);
    const f32x2* lamb = WSP(f32x2, WS_S5LAM); const f32x2* bbar = WSP(f32x2, WS_S5B);
    const float* cre = INP(31); const float* cim = INP(32);
    const int lane = F.lane;
    for (int task = F.wave * F.G + F.bid; task < 256; task += F.NGW) {
        const int di = task >> 7, b = (task >> 6) & 1, g = task & 63;
        const int dgp = (di * 64 + g) * 64 + lane;
        const f32x2 lam = lamb[dgp];
        float br[16], bi[16], cr[16], ci[16];
#pragma unroll
        for (int c = 0; c < 16; ++c) { const f32x2 bv = bbar[(size_t)dgp * 16 + c]; br[c] = bv.x; bi[c] = bv.y;
            cr[c] = cre[((size_t)(di * 64 + g) * 16 + c) * 64 + lane]; ci[c] = cim[((size_t)(di * 64 + g) * 16 + c) * 64 + lane]; }
        float sr = 0.f, si = 0.f;
        const int nsteps = CTX + SEQ;
        for (int st = 0; st < nsteps; st += 4) {
            const int stl = st + (lane >> 4);
            int row;
            if (stl < CTX) row = TL + b * CTX + (di == 0 ? stl : CTX - 1 - stl);
            else row = b * SEQ + (di == 0 ? stl - CTX : SEQ - 1 - (stl - CTX));
            const float uval = bf2f(PJ[(size_t)row * 4096 + 3072 + g * 16 + (lane & 15)]);
#pragma unroll
            for (int k = 0; k < 4; ++k) {
                float bur = 0.f, bui = 0.f;
#pragma unroll
                for (int c = 0; c < 16; ++c) { const float u = __builtin_bit_cast(float, __builtin_amdgcn_readlane(__builtin_bit_cast(int, uval), 16 * k + c)); bur += br[c] * u; bui += bi[c] * u; }
                const float nr = lam.x * sr - lam.y * si + bur, ni = lam.x * si + lam.y * sr + bui; sr = nr; si = ni;
                const int s2 = st + k;
                if (s2 >= CTX) {
                    const int t = (di == 0) ? s2 - CTX : SEQ - 1 - (s2 - CTX);
                    float outv = 0.f;
#pragma unroll
                    for (int c = 0; c < 16; ++c) { float v = cr[c] * sr - ci[c] * si; v = wave_sum(v); if (lane == c) outv = v; }
                    if (lane < 16) YD[((size_t)di * TL + (size_t)b * SEQ + t) * 1024 + g * 16 + lane] = outv;
                }
            }
        }
    }
}

__device__ __forceinline__ void hyena_naive_phase(Frame& F) {
    const float* GT = WSP(float, WS_GT); const float* kT = WSP(float, WS_KT); const float* invn = WSP(float, WS_INVN); bf16* cat = WSP(bf16, WS_CAT);
    const float* hyb = INP(25);
    LAS float* kf = (LAS float*)F.lds;
    LAS f32x2* ub = (LAS f32x2*)(F.lds + 65536);
    const int tid = F.tid;
    for (int ch = F.bid; ch < 1024; ch += F.G) {
        float res0[16], res1[16];
        for (int o = 0; o < 2; ++o) {
            const float inv = invn[o * 1024 + ch];
            const float* kfw = kT + (size_t)(o * 2048 + ch) * SEQ; const float* kbw = kT + (size_t)(o * 2048 + 1024 + ch) * SEQ;
            for (int n = tid; n < 16384; n += NTHREADS) { float v; if (n < SEQ) v = kfw[n]; else if (n == SEQ) v = 0.f; else v = kbw[16384 - n]; kf[n] = v * inv; }
            if (o == 0) { const float* v0 = GT + ((size_t)(0 * 1024 + ch) * 2) * SEQ; for (int n = tid; n < SEQ; n += NTHREADS) ub[n] = (f32x2){v0[n], v0[SEQ + n]}; }
            else {
#pragma unroll
                for (int j = 0; j < 16; ++j) ub[tid + NTHREADS * j] = (f32x2){res0[j], res1[j]}; }
            __syncthreads();
            float a0[16], a1[16];
#pragma unroll
            for (int j = 0; j < 16; ++j) { a0[j] = 0.f; a1[j] = 0.f; }
            for (int s = 0; s < SEQ; ++s) { const f32x2 u = ub[s];
#pragma unroll
                for (int j = 0; j < 16; ++j) { const float kk = kf[(tid + NTHREADS * j - s) & 16383]; a0[j] += u.x * kk; a1[j] += u.y * kk; } }
            const float bias = hyb[o * 1024 + ch];
            const float* xg = GT + ((size_t)((o + 1) * 1024 + ch) * 2) * SEQ;
#pragma unroll
            for (int j = 0; j < 16; ++j) { const int t = tid + NTHREADS * j; const f32x2 u = ub[t];
                res0[j] = xg[t] * (a0[j] + bias * u.x); res1[j] = xg[SEQ + t] * (a1[j] + bias * u.y); }
            __syncthreads();
        }
#pragma unroll
        for (int j = 0; j < 16; ++j) { const int t = tid + NTHREADS * j;
            cat[(size_t)t * 2048 + ch] = (bf16)f2bf(res0[j]); cat[((size_t)SEQ + t) * 2048 + ch] = (bf16)f2bf(res1[j]); }
    }
}

__device__ __forceinline__ void s5_gelu_phase(Frame& F) {
    const bf16* PJ = WSP(bf16, WS_PROJ1); const float* YD = WSP(float, WS_YD); bf16* Gb = WSP(bf16, WS_PD); const float* dd = INP(33);
    const int gt = F.bid * NTHREADS + F.tid, NGT = F.G * NTHREADS;
    for (int idx = gt; idx < TL * 256; idx += NGT) { const int r = idx >> 8, c = (idx & 255) * 4;
        const v2u uw = *(const v2u*)(PJ + (size_t)r * 4096 + 3072 + c); const f32x4 d4 = *(const f32x4*)(dd + c);
        const f32x4 y0 = *(const f32x4*)(YD + (size_t)r * 1024 + c), y1 = *(const f32x4*)(YD + ((size_t)TL + r) * 1024 + c);
        const f32x4 y = {bflo(uw.x) * d4.x + y0.x + y1.x, bfhi(uw.x) * d4.y + y0.y + y1.y, bflo(uw.y) * d4.z + y0.z + y1.z, bfhi(uw.y) * d4.w + y0.w + y1.w};
        st_bf4(Gb + (size_t)r * 1024 + c, (f32x4){gelu_tanh(y.x), gelu_tanh(y.y), gelu_tanh(y.z), gelu_tanh(y.w)}); }
}

__device__ __forceinline__ f32x2 cmulf(f32x2 a, f32x2 b) { return (f32x2){a.x * b.x - a.y * b.y, a.x * b.y + a.y * b.x}; }
__device__ __forceinline__ int drev14(int p) { const unsigned r = __builtin_bitreverse32((unsigned)p) >> 18; return (int)(((r & 0x2AAAu) >> 1) | ((r & 0x1555u) << 1)); }
__device__ __forceinline__ void fft_fwd(LAS f32x2* X, const f32x2* tw, int tid) {
#pragma nounroll
    for (int L = 4096; L >= 1; L >>= 2) {
        const int tws = 4096 / L;
#pragma unroll 2
        for (int i = 0; i < 8; ++i) {
            const int b = tid + NTHREADS * i, j = b & (L - 1), i0 = (b - j) * 4 + j;
            const f32x2 x0 = X[i0], x1 = X[i0 + L], x2 = X[i0 + 2 * L], x3 = X[i0 + 3 * L];
            const f32x2 w1 = tw[j * tws], w2 = cmulf(w1, w1), w3 = cmulf(w2, w1);
            const f32x2 a = x0 + x2, bb = x0 - x2, c = x1 + x3, d = x1 - x3;
            const f32x2 t1 = {bb.x + d.y, bb.y - d.x}, t3 = {bb.x - d.y, bb.y + d.x};
            X[i0] = a + c; X[i0 + L] = cmulf(t1, w1); X[i0 + 2 * L] = cmulf(a - c, w2); X[i0 + 3 * L] = cmulf(t3, w3);
        }
        __syncthreads();
    }
}
__device__ __forceinline__ void fft_inv(LAS f32x2* X, const f32x2* tw, int tid) {
#pragma nounroll
    for (int L = 1; L <= 4096; L <<= 2) {
        const int tws = 4096 / L;
#pragma unroll 2
        for (int i = 0; i < 8; ++i) {
            const int b = tid + NTHREADS * i, j = b & (L - 1), i0 = (b - j) * 4 + j;
            f32x2 w1 = tw[j * tws]; w1.y = -w1.y; const f32x2 w2 = cmulf(w1, w1), w3 = cmulf(w2, w1);
            const f32x2 x0 = X[i0], x1 = cmulf(X[i0 + L], w1), x2 = cmulf(X[i0 + 2 * L], w2), x3 = cmulf(X[i0 + 3 * L], w3);
            const f32x2 a = x0 + x2, bb = x0 - x2, c = x1 + x3, d = x1 - x3;
            X[i0] = a + c; X[i0 + L] = (f32x2){bb.x - d.y, bb.y + d.x}; X[i0 + 2 * L] = a - c; X[i0 + 3 * L] = (f32x2){bb.x + d.y, bb.y - d.x};
        }
        __syncthreads();
    }
}
__device__ __forceinline__ void fft_pointwise(LAS f32x2* X, const f32x2* Wg, int o, float scale, int tid) {
    const float hs = 0.5f * scale;
#pragma unroll 4
    for (int i = 0; i < 32; ++i) {
        const int p = tid + NTHREADS * i, f = drev14(p), pm = drev14((16384 - f) & 16383);
        const unsigned long long ua = __hip_atomic_load((const unsigned long long*)(Wg + p), __ATOMIC_RELAXED, __HIP_MEMORY_SCOPE_AGENT);
        const unsigned long long ub = __hip_atomic_load((const unsigned long long*)(Wg + pm), __ATOMIC_RELAXED, __HIP_MEMORY_SCOPE_AGENT);
        const f32x2 A = __builtin_bit_cast(f32x2, ua), B = __builtin_bit_cast(f32x2, ub);
        f32x2 K;
        if (o == 0) K = (f32x2){(A.x + B.x) * hs, (A.y - B.y) * hs};
        else { const f32x2 dd = {A.x - B.x, A.y + B.y}; K = (f32x2){dd.y * hs, -dd.x * hs}; }
        X[p] = cmulf(X[p], K);
    }
    __syncthreads();
}
__device__ __forceinline__ void hyena_fft_phase(Frame& F) {
    float* GT = WSP(float, WS_GT); const float* kT = WSP(float, WS_KT); const float* invn = WSP(float, WS_INVN); const f32x2* tw = WSP(f32x2, WS_TW);
    f32x2* Wg = WSP(f32x2, WS_FFTW) + (size_t)F.bid * 16384;
    const float* hyb = INP(25);
    LAS f32x2* X = (LAS f32x2*)F.lds;
    const int tid = F.tid;
    for (int ch = F.bid; ch < 1024; ch += F.G) {
        { const float* f0 = kT + (size_t)ch * SEQ; const float* b0 = kT + (size_t)(1024 + ch) * SEQ; const float* f1 = kT + (size_t)(2048 + ch) * SEQ; const float* b1 = kT + (size_t)(3072 + ch) * SEQ;
          for (int n = tid; n < SEQ; n += NTHREADS) { X[n] = (f32x2){f0[n], f1[n]}; X[SEQ + n] = (n == 0) ? (f32x2){0.f, 0.f} : (f32x2){b0[SEQ - n], b1[SEQ - n]}; } }
        __syncthreads();
        fft_fwd(X, tw, tid);
        for (int n = tid; n < 16384; n += NTHREADS) Wg[n] = X[n];
        __syncthreads();
        const float* v0 = GT + ((size_t)ch * 2) * SEQ; float* yo = WSP(float, WS_YHT) + ((size_t)ch * 2) * SEQ;
        const float* x1 = GT + ((size_t)(1024 + ch) * 2) * SEQ; const float* x2 = GT + ((size_t)(2048 + ch) * 2) * SEQ;
        float z0[16], z1[16];
#pragma unroll
        for (int j = 0; j < 16; ++j) { const int n = tid + NTHREADS * j; z0[j] = v0[n]; z1[j] = v0[SEQ + n]; }
#pragma unroll
        for (int o = 0; o < 2; ++o) {
#pragma unroll
            for (int j = 0; j < 16; ++j) { const int n = tid + NTHREADS * j; X[n] = (f32x2){z0[j], z1[j]}; X[SEQ + n] = (f32x2){0.f, 0.f}; }
            __syncthreads();
            fft_fwd(X, tw, tid);
            fft_pointwise(X, Wg, o, invn[o * 1024 + ch] * (1.0f / 16384.0f), tid);
            fft_inv(X, tw, tid);
            const float bias = hyb[o * 1024 + ch]; const float* xg = (o == 0) ? x1 : x2;
#pragma unroll
            for (int j = 0; j < 16; ++j) { const int n = tid + NTHREADS * j; const f32x2 y = X[n]; z0[j] = xg[n] * (y.x + bias * z0[j]); z1[j] = xg[SEQ + n] * (y.y + bias * z1[j]); }
            __syncthreads();
        }
#pragma unroll
        for (int j = 0; j < 16; ++j) { const int n = tid + NTHREADS * j; yo[n] = z0[j]; yo[SEQ + n] = z1[j]; }
    }
}
__device__ __forceinline__ void hyena_out_transpose(Frame& F) {
    const float* GT = WSP(float, WS_YHT); bf16* cat = WSP(bf16, WS_CAT);
    LAS float* scr = (LAS float*)(F.lds + F.wave * 16896);
    const int lane = F.lane;
    for (int it = F.gw; it < 2 * 128 * 16; it += F.NGW) {
        const int cbk = it & 15, tb = (it >> 4) & 127, b = it >> 11, t0 = tb * 64;
        for (int c = 0; c < 64; ++c) scr[c * 65 + lane] = GT[((size_t)(cbk * 64 + c) * 2 + b) * SEQ + t0 + lane];
        LDS_WAIT(); asm volatile("" ::: "memory");
        for (int tt = 0; tt < 64; ++tt) cat[((size_t)b * SEQ + t0 + tt) * 2048 + cbk * 64 + lane] = (bf16)f2bf(scr[lane * 65 + tt]);
        LDS_WAIT(); asm volatile("" ::: "memory");
    }
}

__device__ __forceinline__ int s5_row(int di, int b, int s) {
    return (s < CTX) ? TL + b * CTX + (di == 0 ? s : CTX - 1 - s) : b * SEQ + (di == 0 ? s - CTX : SEQ - 1 - (s - CTX));
}
template <bool OUTPUT>
__device__ __forceinline__ void s5_seg_phase(Frame& F) {
    const bf16* PJ = WSP(bf16, WS_PROJ1); float* YD = WSP(float, WS_YD);
    const f32x2* lamb = WSP(f32x2, WS_S5LAM); const f32x2* bbar = WSP(f32x2, WS_S5B); const f32x2* l256 = WSP(f32x2, WS_S5L256); f32x2* Eb = WSP(f32x2, WS_S5E);
    const float* cre = INP(31); const float* cim = INP(32);
    const int lane = F.lane;
    for (int task = F.wave * F.G + F.bid; task < 256 * 32; task += F.NGW) {
        const int dbg = task >> 5, seg = (task & 31) + (OUTPUT ? 1 : 0);
        const int di = dbg >> 7, b = (dbg >> 6) & 1, g = dbg & 63;
        const int dgp = (di * 64 + g) * 64 + lane;
        const f32x2 lam = lamb[dgp];
        float br[16], bi[16];
#pragma unroll
        for (int c = 0; c < 16; ++c) { const f32x2 bv = bbar[(size_t)dgp * 16 + c]; br[c] = bv.x; bi[c] = bv.y; }
        float cr[16], ci[16];
        if (OUTPUT) {
#pragma unroll
            for (int c = 0; c < 16; ++c) { cr[c] = cre[((size_t)(di * 64 + g) * 16 + c) * 64 + lane]; ci[c] = cim[((size_t)(di * 64 + g) * 16 + c) * 64 + lane]; }
        }
        float sr = 0.f, si = 0.f;
        if (OUTPUT) {
            const f32x2 l2 = l256[dgp]; const f32x2* ep = Eb + ((size_t)dbg * 32) * 64 + lane;
            for (int k = 0; k < seg; ++k) { const f32x2 e = ep[(size_t)k * 64]; const float nr = l2.x * sr - l2.y * si + e.x, ni = l2.x * si + l2.y * sr + e.y; sr = nr; si = ni; }
        }
        const int s0 = seg * 256;
#pragma nounroll
        for (int st = 0; st < 256; st += 4) {
            const int row = s5_row(di, b, s0 + st + (lane >> 4));
            const float uval = bf2f(PJ[(size_t)row * 4096 + 3072 + g * 16 + (lane & 15)]);
#pragma unroll
            for (int k = 0; k < 4; ++k) {
                float bur = 0.f, bui = 0.f;
#pragma unroll
                for (int c = 0; c < 16; ++c) { const float u = __builtin_bit_cast(float, __builtin_amdgcn_readlane(__builtin_bit_cast(int, uval), 16 * k + c)); bur += br[c] * u; bui += bi[c] * u; }
                const float nr = lam.x * sr - lam.y * si + bur, ni = lam.x * si + lam.y * sr + bui; sr = nr; si = ni;
                if (OUTPUT) {
                    float v8[8], v4[4], v2[2], v1;
                    const bool b5 = (lane & 32) != 0, b4 = (lane & 16) != 0, b3 = (lane & 8) != 0, b2 = (lane & 4) != 0;
#pragma unroll
                    for (int i = 0; i < 8; ++i) { const float lo = cr[i] * sr - ci[i] * si, hi = cr[i + 8] * sr - ci[i + 8] * si; const float keep = b5 ? hi : lo, send = b5 ? lo : hi; v8[i] = keep + __shfl_xor(send, 32); }
#pragma unroll
                    for (int i = 0; i < 4; ++i) { const float keep = b4 ? v8[i + 4] : v8[i], send = b4 ? v8[i] : v8[i + 4]; v4[i] = keep + __shfl_xor(send, 16); }
#pragma unroll
                    for (int i = 0; i < 2; ++i) { const float keep = b3 ? v4[i + 2] : v4[i], send = b3 ? v4[i] : v4[i + 2]; v2[i] = keep + __shfl_xor(send, 8); }
                    { const float keep = b2 ? v2[1] : v2[0], send = b2 ? v2[0] : v2[1]; v1 = keep + __shfl_xor(send, 4); }
                    v1 += __shfl_xor(v1, 2); v1 += __shfl_xor(v1, 1);
                    const int s = s0 + st + k, t = (di == 0) ? s - CTX : SEQ - 1 - (s - CTX);
                    if ((lane & 3) == 0) YD[((size_t)di * TL + (size_t)b * SEQ + t) * 1024 + g * 16 + (lane >> 2)] = v1;
                }
            }
        }
        if (!OUTPUT) Eb[((size_t)dbg * 32 + seg) * 64 + lane] = (f32x2){sr, si};
    }
}

typedef float f32x4_t __attribute__((ext_vector_type(4)));
template <bool OUTPUT>
__device__ __forceinline__ void s5_mfma_phase(Frame& F) {
    const bf16* PJ = WSP(bf16, WS_PROJ1); float* YD = WSP(float, WS_YD);
    const f32x2* lamb = WSP(f32x2, WS_S5LAM); const f32x2* bbar = WSP(f32x2, WS_S5B); const f32x2* l256 = WSP(f32x2, WS_S5L256); f32x2* Eb = WSP(f32x2, WS_S5E);
    const float* cre = INP(31); const float* cim = INP(32);
    const int lane = F.lane, fr = lane & 15, fq = lane >> 4;
    LAS unsigned* Xl = (LAS unsigned*)(F.lds + F.wave * 4608);
    for (int task = F.wave * F.G + F.bid; task < 256 * 32; task += F.NGW) {
        const int dbg = task >> 5, seg = (task & 31) + (OUTPUT ? 1 : 0);
        const int di = dbg >> 7, b = (dbg >> 6) & 1, g = dbg & 63;
        const int dg = di * 64 + g;
        f32x2 l1[4], l2[4], l3[4], l4[4];
        bf16x8 bfr[8];
#pragma unroll
        for (int t = 0; t < 4; ++t) { const int dgp = dg * 64 + 16 * t + fr; l1[t] = lamb[dgp]; l2[t] = cmulf(l1[t], l1[t]); l3[t] = cmulf(l2[t], l1[t]); l4[t] = cmulf(l2[t], l2[t]);
            v4u wre = {0u, 0u, 0u, 0u}, wim = {0u, 0u, 0u, 0u};
            if (fq < 2) { const f32x4* bp = (const f32x4*)(bbar + (size_t)dgp * 16 + 8 * fq); const f32x4 q0 = bp[0], q1 = bp[1], q2 = bp[2], q3 = bp[3];
                wre.x = cvt_pk_bf16(q0.x, q0.z); wre.y = cvt_pk_bf16(q1.x, q1.z); wre.z = cvt_pk_bf16(q2.x, q2.z); wre.w = cvt_pk_bf16(q3.x, q3.z);
                wim.x = cvt_pk_bf16(q0.y, q0.w); wim.y = cvt_pk_bf16(q1.y, q1.w); wim.z = cvt_pk_bf16(q2.y, q2.w); wim.w = cvt_pk_bf16(q3.y, q3.w); }
            bfr[t] = __builtin_bit_cast(bf16x8, wre); bfr[4 + t] = __builtin_bit_cast(bf16x8, wim); }
        bf16x8 cfr[4];
        if (OUTPUT) {
#pragma unroll
            for (int ks = 0; ks < 4; ++ks) { const size_t cb = ((size_t)dg * 16 + fr) * 64 + 16 * ks + 4 * fq; const f32x4 r4 = *(const f32x4*)(cre + cb), i4 = *(const f32x4*)(cim + cb);
                v4u w; w.x = cvt_pk_bf16(r4.x, -i4.x); w.y = cvt_pk_bf16(r4.y, -i4.y); w.z = cvt_pk_bf16(r4.z, -i4.z); w.w = cvt_pk_bf16(r4.w, -i4.w); cfr[ks] = __builtin_bit_cast(bf16x8, w); }
        }
        f32x2 st[4];
#pragma unroll
        for (int t = 0; t < 4; ++t) st[t] = (f32x2){0.f, 0.f};
        if (OUTPUT) {
#pragma unroll
            for (int t = 0; t < 4; ++t) { const f32x2 lq = l256[dg * 64 + 16 * t + fr]; const f32x2* ep = Eb + ((size_t)dbg * 32) * 64 + 16 * t + fr;
                for (int k = 0; k < seg; ++k) { const f32x2 e = ep[(size_t)k * 64]; st[t] = cmulf(lq, st[t]) + e; } }
        }
        const int s0 = seg * 256;
        v4u unext = {0u, 0u, 0u, 0u};
        if (fq < 2) unext = *(const v4u*)(PJ + (size_t)s5_row(di, b, s0 + fr) * 4096 + 3072 + g * 16 + 8 * fq);
#pragma nounroll
        for (int blk = 0; blk < 16; ++blk) {
            const bf16x8 ufr = __builtin_bit_cast(bf16x8, unext);
            if (blk + 1 < 16 && fq < 2) unext = *(const v4u*)(PJ + (size_t)s5_row(di, b, s0 + 16 * (blk + 1) + fr) * 4096 + 3072 + g * 16 + 8 * fq);
            f32x4 bu[8];
#pragma unroll
            for (int nt = 0; nt < 8; ++nt) bu[nt] = __builtin_amdgcn_mfma_f32_16x16x32_bf16(ufr, bfr[nt], (f32x4){0.f, 0.f, 0.f, 0.f}, 0, 0, 0);
            f32x2 xs[4][4];
#pragma unroll
            for (int t = 0; t < 4; ++t) {
                f32x2 x0 = {bu[t][0], bu[4 + t][0]}, x1 = cmulf(l1[t], x0) + (f32x2){bu[t][1], bu[4 + t][1]}, x2 = cmulf(l1[t], x1) + (f32x2){bu[t][2], bu[4 + t][2]}, x3 = cmulf(l1[t], x2) + (f32x2){bu[t][3], bu[4 + t][3]};
                f32x2 sin = st[t];
                f32x2 fin = x3 + cmulf(l4[t], (fq == 0) ? sin : (f32x2){0.f, 0.f});
#pragma unroll
                for (int rd = 1; rd < 4; ++rd) { const float vr = __shfl(fin.x, lane - 16), vi = __shfl(fin.y, lane - 16);
                    if (fq == rd) { sin = (f32x2){vr, vi}; fin = x3 + cmulf(l4[t], sin); } }
                xs[t][0] = x0 + cmulf(l1[t], sin); xs[t][1] = x1 + cmulf(l2[t], sin); xs[t][2] = x2 + cmulf(l3[t], sin); xs[t][3] = x3 + cmulf(l4[t], sin);
                st[t] = (f32x2){__shfl(xs[t][3].x, 48 + fr), __shfl(xs[t][3].y, 48 + fr)};
            }
            if (OUTPUT) {
#pragma unroll
                for (int t = 0; t < 4; ++t)
#pragma unroll
                    for (int r = 0; r < 4; ++r) Xl[(4 * fq + r) * 68 + 16 * t + fr] = cvt_pk_bf16(xs[t][r].x, xs[t][r].y);
                LDS_WAIT(); asm volatile("" ::: "memory");
                f32x4 y = {0.f, 0.f, 0.f, 0.f};
#pragma unroll
                for (int ks = 0; ks < 4; ++ks) { const bf16x8 xa = *(const LAS bf16x8*)(Xl + fr * 68 + 16 * ks + 4 * fq); y = __builtin_amdgcn_mfma_f32_16x16x32_bf16(xa, cfr[ks], y, 0, 0, 0); }
                LDS_WAIT(); asm volatile("" ::: "memory");
#pragma unroll
                for (int r = 0; r < 4; ++r) { const int s = s0 + 16 * blk + 4 * fq + r, tl = (di == 0) ? s - CTX : SEQ - 1 - (s - CTX);
                    YD[((size_t)di * TL + (size_t)b * SEQ + tl) * 1024 + g * 16 + fr] = y[r]; }
            }
        }
        if (!OUTPUT) { if (fq == 0) {
#pragma unroll
            for (int t = 0; t < 4; ++t) Eb[((size_t)dbg * 32 + seg) * 64 + 16 * t + fr] = st[t]; } }
    }
}

constexpr int NPHASES = 21;
#ifndef MK_SINGLE
#define MK_SINGLE 1
#endif

__device__ __forceinline__ unsigned long long launder_u64(unsigned long long v) {
    unsigned lo = (unsigned)v, hi = (unsigned)(v >> 32);
    asm volatile("" : "+v"(lo), "+v"(hi));
    lo = __builtin_amdgcn_readfirstlane(lo); hi = __builtin_amdgcn_readfirstlane(hi);
    return ((unsigned long long)hi << 32) | lo;
}
__device__ __forceinline__ const void* launder_ptr(const void* p) {
    unsigned long long v = (unsigned long long)p; unsigned lo = (unsigned)v, hi = (unsigned)(v >> 32);
    asm volatile("" : "+v"(lo), "+v"(hi));
    lo = __builtin_amdgcn_readfirstlane(lo); hi = __builtin_amdgcn_readfirstlane(hi);
    return (const void*)(((unsigned long long)hi << 32) | lo);
}
__device__ __forceinline__ void moe_blocks(Frame& F, int l, LAS int* bstart) {
    __syncthreads();
    if (F.tid == 0) { const unsigned* cnt = WSP(unsigned, WS_CTL) + CW_CNT + l * 64; int acc = 0;
        for (int e = 0; e < 64; ++e) { bstart[e] = acc; const int nb = ((int)cnt[e] + 255) >> 8; for (int j = 0; j < nb; ++j) bstart[65 + acc + j] = e; acc += nb; } bstart[64] = acc; }
    __syncthreads();
}

template <int PHSEL>
__global__ void __launch_bounds__(NTHREADS, 2) mk_fwd(Args args) {
    extern __shared__ __attribute__((aligned(16))) unsigned char lds_raw[];
    Frame F;
    F.lds = (LAS unsigned char*)lds_raw; F.ws = args.ws; F.kin = (const __attribute__((address_space(4))) unsigned long long*)__builtin_amdgcn_kernarg_segment_ptr();
    F.tid = threadIdx.x; F.lane = F.tid & 63; F.wave = __builtin_amdgcn_readfirstlane(F.tid >> 6); F.bid = blockIdx.x; F.G = gridDim.x;
    F.gw = F.bid * NWAVES + F.wave; F.NGW = F.G * NWAVES;
    volatile LAS unsigned* lctl = (volatile LAS unsigned*)(F.lds + LDS_CTL);
    LAS int* bstart = (LAS int*)(F.lds + LDS_CTL + 64);
    if (F.tid < 4) lctl[F.tid] = 0u;
    __syncthreads();
    const int lo = args.ph_lo, hi = args.ph_hi;
    XcdBarrier bar; bar.bar = WSP(unsigned, WS_CTL) + CW_BAR; bar.x = 0; bar.st = lctl;
    if (PHSEL < 0) bar = xcd_barrier_post(WSP(unsigned, WS_CTL) + CW_BAR, lctl);
#ifndef PH_MASK
#define PH_MASK 0xffffffffu
#endif
#define IN(k) (((PH_MASK >> (k)) & 1u) && (PHSEL < 0 || PHSEL == (k)))
#define INL(j) (((PH_MASK >> (6 + (j))) & 1u) && (PHSEL < 0 || (PHSEL == 6 + (j) && lo == pb + (j))))
#define PH_END(k) do { if (PHSEL < 0) xcd_barrier(bar); } while (0)
#ifndef PH_REPEAT
#define PH_REPEAT 0u
#endif
#define REP(k) for (int _rep = 0; _rep < (((PH_REPEAT >> (k)) & 1u) ? 2 : 1); ++_rep)
#define PH_BEGIN() do { F.ws = (unsigned char*)launder_ptr((const void*)F.ws); F.kin = (const __attribute__((address_space(4))) unsigned long long*)launder_u64((unsigned long long)F.kin); \
    { int _t = threadIdx.x; asm volatile("" : "+v"(_t)); F.tid = _t; F.lane = _t & 63; F.wave = __builtin_amdgcn_readfirstlane(_t >> 6); \
      int _b = blockIdx.x; asm volatile("" : "+v"(_b)); F.bid = __builtin_amdgcn_readfirstlane(_b); F.gw = F.bid * NWAVES + F.wave; } } while (0)
    LAS unsigned char* lds = F.lds;
    const int G = F.G, bid = F.bid;
    constexpr long T2048 = 256L * 2048 * 2;

    if (IN(0)) { PH_BEGIN(); REP(0) { p0_prologue(F); __syncthreads(); } PH_END(0); }
    if (IN(1)) { PH_BEGIN(); p1_reduce(F); PH_END(1); }
        if (IN(2)) { PH_BEGIN(); REP(2) norm_phase<0>(F, 0, nullptr); PH_END(2); }
        if (IN(3)) { PH_BEGIN(); REP(3) {
            { pg8::Gemm g{WSP(bf16, WS_HA), WSP(bf16, WS_WIN0), 2048, 2048, 2048}; pg8::StaticOrder S; S.init(TT / 256, 12, G, bid, T2048, 0, T2048);
              EpiQKP E{WSP(bf16, WS_Q), WSP(bf16, WS_K), WSP(bf16, WS_P), WSP(f32x2, WS_ROPE)}; pg8::gemm_phase<EpiQKP, pg8::StaticOrder, false>(lds, g, S, E); }
            { pg8::Gemm g{WSP(bf16, WS_WIN0) + (size_t)3072 * 2048, WSP(bf16, WS_HA), 2048, 2048, 2048}; pg8::StaticOrder S; S.init(4, TT / 256, G, bid, T2048, 0, T2048);
              EpiVT E{WSP(bf16, WS_VT)}; pg8::gemm_phase<EpiVT, pg8::StaticOrder, false>(lds, g, S, E); } }
            PH_END(3);
        }
        if (IN(4)) { PH_BEGIN(); REP(4) attn_phase(F); REP(21) poold_phase(F); PH_END(4); }
        if (IN(5)) { PH_BEGIN();
            pg8::Gemm g{WSP(bf16, WS_PD), WSP(bf16, WS_WPOOL), 1024, 256, 256}; pg8::StaticOrder S; S.init(TT / 256, 4, G, bid, 256L * 1024 * 2, 256L * 2, 256L * 256 * 2);
            EpiScaleBf16 E{WSP(bf16, WS_CAT), 2048, 1024, INP(14)}; pg8::gemm_phase<EpiScaleBf16, pg8::StaticOrder, false>(lds, g, S, E);
            PH_END(5);
        }
    {
    constexpr int pb = 6; constexpr int l = 0;
    if (INL(0)) { PH_BEGIN();
        float* xbuf = WSP(float, WS_X);
        pg8::Gemm g{WSP(bf16, WS_CAT), WSP(bf16, l == 0 ? WS_WOUT0 : WS_WOUT1), 2048, 2048, 2048}; pg8::StaticOrder S; S.init(l == 0 ? TT / 256 : TL / 256, 8, G, bid, T2048, 0, T2048);
        EpiRes E{l == 0 ? INP(0) : xbuf, l == 0 ? INP(2) : xbuf + (size_t)TL * 2048, xbuf, modp(F, l, 0, 2)}; pg8::gemm_phase<EpiRes, pg8::StaticOrder, false>(lds, g, S, E);
        PH_END(pb);
    }
    if (INL(1)) { PH_BEGIN(); ffn_norm_router_phase(F, l); PH_END(pb + 1); }
    if (INL(2)) { PH_BEGIN(); REP(8) {
        moe_blocks(F, l, bstart);
        pg8::Gemm g{WSP(bf16, WS_HA), (const bf16*)(F.ws + WS_WMOE + (size_t)l * MOE_L_BYTES), 2048, 2048, 2048};
        MoeOrder S{bstart, WSP(unsigned, WS_CTL) + CW_CNT + l * 64, WSP(int, WS_TOKL), 4, G, bid, bstart[64], T2048, 0, true};
        EpiMoeUp E{WSP(bf16, WS_H)}; pg8::gemm_phase<EpiMoeUp, MoeOrder, true>(lds, g, S, E); }
        PH_END(pb + 2);
    }
    if (INL(3)) { PH_BEGIN(); REP(9) {
        moe_blocks(F, l, bstart);
        pg8::Gemm g{WSP(bf16, WS_H), (const bf16*)(F.ws + WS_WMOE + (size_t)l * MOE_L_BYTES), 512, 512, 512};
        MoeOrder S{bstart, WSP(unsigned, WS_CTL) + CW_CNT + l * 64, WSP(int, WS_TOKL), 8, G, bid, bstart[64], 256L * 512 * 2, (long)(4 * MiB), false};
        EpiMoeDown E{WSP(bf16, WS_Y), WSP(int, WS_TOKL), WSP(float, WS_GATEL), WSP(unsigned, WS_CTL) + CW_CNT + l * 64}; pg8::gemm_phase<EpiMoeDown, MoeOrder, false>(lds, g, S, E); }
        PH_END(pb + 3);
    }
    }
        if (IN(10)) { PH_BEGIN(); norm_phase<2>(F, 1, nullptr); PH_END(10); }
        if (IN(11)) { PH_BEGIN(); REP(11) {
            pg8::Gemm g{WSP(bf16, WS_HA), WSP(bf16, WS_WIN1), 2048, 2048, 2048}; pg8::StaticOrder S; S.init(TT / 256, 16, G, bid, T2048, 0, T2048);
            EpiBf16 E{WSP(bf16, WS_PROJ1), 4096}; pg8::gemm_phase<EpiBf16, pg8::StaticOrder, false>(lds, g, S, E); }
            PH_END(11);
        }
        if (IN(12)) { PH_BEGIN(); REP(12) shortconv_phase(F); REP(22) s5_mfma_phase<false>(F); PH_END(12); }
        if (IN(13)) { PH_BEGIN(); REP(23) s5_mfma_phase<true>(F); __syncthreads(); REP(13) hyena_fft_phase(F); PH_END(13); }
        if (IN(14)) { PH_BEGIN(); REP(14) { s5_gelu_phase(F); hyena_out_transpose(F); } PH_END(14); }
        if (IN(15)) { PH_BEGIN();
            pg8::Gemm g{WSP(bf16, WS_PD), WSP(bf16, WS_WGLU), 1024, 1024, 1024}; pg8::StaticOrder S; S.init(TL / 256, 4, G, bid, 256L * 1024 * 2, 0, 256L * 1024 * 2);
            EpiGlu E{WSP(bf16, WS_CAT), 2048, 1024, WSP(bf16, WS_PD), INP(35)}; pg8::gemm_phase<EpiGlu, pg8::StaticOrder, false>(lds, g, S, E);
            PH_END(15);
        }
    {
    constexpr int pb = 16; constexpr int l = 1;
    if (INL(0)) { PH_BEGIN();
        float* xbuf = WSP(float, WS_X);
        pg8::Gemm g{WSP(bf16, WS_CAT), WSP(bf16, l == 0 ? WS_WOUT0 : WS_WOUT1), 2048, 2048, 2048}; pg8::StaticOrder S; S.init(l == 0 ? TT / 256 : TL / 256, 8, G, bid, T2048, 0, T2048);
        EpiRes E{l == 0 ? INP(0) : xbuf, l == 0 ? INP(2) : xbuf + (size_t)TL * 2048, xbuf, modp(F, l, 0, 2)}; pg8::gemm_phase<EpiRes, pg8::StaticOrder, false>(lds, g, S, E);
        PH_END(pb);
    }
    if (INL(1)) { PH_BEGIN(); ffn_norm_router_phase(F, l); PH_END(pb + 1); }
    if (INL(2)) { PH_BEGIN(); REP(8) {
        moe_blocks(F, l, bstart);
        pg8::Gemm g{WSP(bf16, WS_HA), (const bf16*)(F.ws + WS_WMOE + (size_t)l * MOE_L_BYTES), 2048, 2048, 2048};
        MoeOrder S{bstart, WSP(unsigned, WS_CTL) + CW_CNT + l * 64, WSP(int, WS_TOKL), 4, G, bid, bstart[64], T2048, 0, true};
        EpiMoeUp E{WSP(bf16, WS_H)}; pg8::gemm_phase<EpiMoeUp, MoeOrder, true>(lds, g, S, E); }
        PH_END(pb + 2);
    }
    if (INL(3)) { PH_BEGIN(); REP(9) {
        moe_blocks(F, l, bstart);
        pg8::Gemm g{WSP(bf16, WS_H), (const bf16*)(F.ws + WS_WMOE + (size_t)l * MOE_L_BYTES), 512, 512, 512};
        MoeOrder S{bstart, WSP(unsigned, WS_CTL) + CW_CNT + l * 64, WSP(int, WS_TOKL), 8, G, bid, bstart[64], 256L * 512 * 2, (long)(4 * MiB), false};
        EpiMoeDown E{WSP(bf16, WS_Y), WSP(int, WS_TOKL), WSP(float, WS_GATEL), WSP(unsigned, WS_CTL) + CW_CNT + l * 64}; pg8::gemm_phase<EpiMoeDown, MoeOrder, false>(lds, g, S, E); }
        PH_END(pb + 3);
    }
    }
    if (IN(20)) { PH_BEGIN(); norm_phase<3>(F, 1, args.out); }
#undef IN
#undef INL
#undef PH_END
}

typedef void (*kern_t)(Args);
template <int P> static void launch_phase(int grid, hipStream_t stream, Args a) { hipLaunchKernelGGL(mk_fwd<P>, dim3(grid), dim3(NTHREADS), LDS_BYTES, stream, a); }
template <int P> static bool prep_phase() { return hipFuncSetAttribute((const void*)mk_fwd<P>, hipFuncAttributeMaxDynamicSharedMemorySize, LDS_BYTES) == hipSuccess; }
extern "C" void kernel_launch(void* const* d_in, const int* in_sizes, int n_in, void* d_out, int out_size, void* d_ws, size_t ws_size, hipStream_t stream) {
    static int grid = 0;
    if (grid == 0) {
        if (n_in != 43 || out_size != TL * DM || ws_size < WS_END) { fprintf(stderr, "kernel_launch: unexpected shapes (n_in %d, out %d, ws %zu < %zu)\n", n_in, out_size, ws_size, (size_t)WS_END); grid = -1; return; }
        int dev = 0, cus = 0;
        if (hipGetDevice(&dev) != hipSuccess || hipDeviceGetAttribute(&cus, hipDeviceAttributeMultiprocessorCount, dev) != hipSuccess) { grid = -1; return; }
        bool ok = true;
#if MK_SINGLE
        ok = prep_phase<-1>();
#else
        ok = prep_phase<0>() && prep_phase<1>() && prep_phase<2>() && prep_phase<3>() && prep_phase<4>() && prep_phase<5>() && prep_phase<6>() && prep_phase<7>() && prep_phase<8>() && prep_phase<9>() &&
             prep_phase<10>() && prep_phase<11>() && prep_phase<12>() && prep_phase<13>() && prep_phase<14>() && prep_phase<15>() && prep_phase<20>();
#endif
        if (!ok) { fprintf(stderr, "kernel_launch: hipFuncSetAttribute failed\n"); grid = -1; return; }
        (void)hipGetLastError();
        grid = cus;
    }
    if (grid < 0) return;
    (void)hipMemsetAsync((char*)d_ws + WS_CTL, 0, CTL_BYTES, stream);
    Args a{};
    for (int i = 0; i < 43; ++i) a.in[i] = (const float*)d_in[i];
    a.out = (float*)d_out; a.ws = (unsigned char*)d_ws;
#if MK_SINGLE
    a.ph_lo = 0; a.ph_hi = NPHASES;
    launch_phase<-1>(grid, stream, a);
#else
#define LP(k, P) a.ph_lo = (k); a.ph_hi = (k) + 1; launch_phase<P>(grid, stream, a);
    LP(0, 0) LP(1, 1) LP(2, 2) LP(3, 3) LP(4, 4) LP(5, 5) LP(6, 6) LP(7, 7) LP(8, 8) LP(9, 9) LP(10, 10) LP(11, 11) LP(12, 12) LP(13, 13) LP(14, 14) LP(15, 15)
    LP(16, 6) LP(17, 7) LP(18, 8) LP(19, 9) LP(20, 20)
#undef LP
#endif
}
```

```cpp
#include <hip/hip_runtime.h>
#include <cstdio>
#include <cstdint>
#include <cmath>

#define GAS __attribute__((address_space(1)))
#define LAS __attribute__((address_space(3)))
typedef unsigned short bf16;
typedef unsigned v4u __attribute__((ext_vector_type(4)));
typedef unsigned v2u __attribute__((ext_vector_type(2)));
typedef float f32x4 __attribute__((ext_vector_type(4)));
typedef float f32x2 __attribute__((ext_vector_type(2)));
typedef float f32x16 __attribute__((ext_vector_type(16)));
typedef short bf16x8 __attribute__((ext_vector_type(8)));
#define LDS_WAIT() asm volatile("s_waitcnt lgkmcnt(0)" ::: "memory")
#define VM_WAIT() asm volatile("s_waitcnt vmcnt(0)" ::: "memory")

__device__ __forceinline__ unsigned f2bf(float f) { unsigned u = __builtin_bit_cast(unsigned, f); return (u + 0x7fffu + ((u >> 16) & 1u)) >> 16; }
__device__ __forceinline__ unsigned pk2(float lo, float hi) { return f2bf(lo) | (f2bf(hi) << 16); }
__device__ __forceinline__ unsigned cvt_pk_bf16(float lo, float hi) { unsigned r; asm volatile("v_cvt_pk_bf16_f32 %0, %1, %2" : "=v"(r) : "v"(lo), "v"(hi)); return r; }
__device__ __forceinline__ float bf2f(unsigned short b) { return __builtin_bit_cast(float, (unsigned)b << 16); }
__device__ __forceinline__ float bflo(unsigned w) { return __builtin_bit_cast(float, w << 16); }
__device__ __forceinline__ float bfhi(unsigned w) { return __builtin_bit_cast(float, w & 0xffff0000u); }
__device__ __forceinline__ float wave_sum(float v) {
#pragma unroll
    for (int o = 1; o < 64; o <<= 1) v += __shfl_xor(v, o);
    return v;
}

namespace pg8 {
typedef unsigned short bf16_t;
constexpr int BM = 256, BK = 64, HALF = 128, HTB = HALF * BK * 2, STAGE_BYTES = 8 * HTB;

__host__ __device__ __forceinline__ int lds_byte(int r, int c) { const int st = (r >> 4) * 2 + (c >> 5), rr = r & 15, cc = c & 31, ob = rr * 64 + cc * 2; return st * 1024 + (ob ^ (((ob >> 9) & 1) << 5)); }
__host__ __device__ __forceinline__ void stage_rc(int b, int& R, int& C) { const int st = b / 1024, sb = b % 1024, swz = sb ^ (((sb >> 9) & 1) << 5); R = (st >> 1) * 16 + swz / 64; C = (st & 1) * 32 + (swz % 64) / 2; }

struct Unit { int pm, pn; long aoff, boff; int e, idx0; };
struct Gemm { const bf16_t* A; const bf16_t* Bt; int lda, ldb, K; };

template <class Epi, class Sched, bool GATHER>
__device__ __forceinline__ void gemm_phase(LAS unsigned char* lds, const Gemm g, const Sched& S, const Epi& E) {
    const int tid = threadIdx.x, wid = __builtin_amdgcn_readfirstlane(tid >> 6), lane = tid & 63, wr = wid >> 2, wc = wid & 3, fr = lane & 15, fq = lane >> 4;
    const int K = g.K, nt = K / BK;
    unsigned voffA[2], voffB[2];
#pragma unroll
    for (int i = 0; i < 2; ++i) { int R, C; stage_rc(tid * 16 + i * 8192, R, C);
        voffA[i] = (unsigned)(R * g.lda + C) * 2u; voffB[i] = (unsigned)(R * g.ldb + C) * 2u; }
    const size_t kstep = (size_t)(BK * 2);
    const size_t hstepA = GATHER ? 0 : (size_t)HALF * g.lda * 2, hstepB = (size_t)HALF * g.ldb * 2;
    const unsigned ldsw = (unsigned)wid * 1024u;
    const int aoff = lds_byte(wr * 64 + fr, fq * 8), boff = lds_byte(wc * 32 + fr, fq * 8);
#define PG8_SA(b, h) (((b) * 2 + (h)) * HTB)
#define PG8_SB(b, h) ((4 + (b) * 2 + (h)) * HTB)
#define PG8_STAGE(bufoff, gbase, voff) do { _Pragma("unroll") for (int _i = 0; _i < 2; ++_i) \
        __builtin_amdgcn_global_load_lds((const unsigned*)((const char*)(gbase) + (voff)[_i]), (LAS unsigned*)(lds + (bufoff) + ldsw + _i * 8192), 16, 0, 0); } while (0)
#define PG8_STAGE_A(bufoff, gbase, h, nx) do { if constexpr (GATHER) { unsigned _tv[2]; \
        if (nx) { int _tz = tid; asm volatile("" : "+v"(_tz)); _Pragma("unroll") for (int _j = 0; _j < 2; ++_j) { int _R, _C; stage_rc(_tz * 16 + _j * 8192, _R, _C); _tv[_j] = (unsigned)S.arow(nxt, (h) * HALF + _R) * (unsigned)(g.lda * 2) + (unsigned)(_C * 2); } } \
        else { _tv[0] = gvc[h][0]; _tv[1] = gvc[h][1]; } \
        PG8_STAGE(bufoff, gbase, _tv); } else { PG8_STAGE(bufoff, (gbase) + (h) * hstepA, voffA); } } while (0)
#define PG8_LDA(dst, b, h) do { _Pragma("unroll") for (int m = 0; m < 4; ++m) _Pragma("unroll") for (int k = 0; k < 2; ++k) dst[m][k] = *(const LAS bf16x8*)(lds + PG8_SA(b, h) + aoff + m * 2048 + k * 1024); } while (0)
#define PG8_LDB(dst, b, h) do { _Pragma("unroll") for (int n = 0; n < 2; ++n) _Pragma("unroll") for (int k = 0; k < 2; ++k) dst[n][k] = *(const LAS bf16x8*)(lds + PG8_SB(b, h) + boff + n * 2048 + k * 1024); } while (0)
#define PG8_MMA(ai, bj, At, Bt) do { __builtin_amdgcn_s_setprio(1); _Pragma("unroll") for (int m = 0; m < 4; ++m) _Pragma("unroll") for (int n = 0; n < 2; ++n) _Pragma("unroll") for (int k = 0; k < 2; ++k) \
        acc[ai][bj][m][n] = __builtin_amdgcn_mfma_f32_16x16x32_bf16(Bt[n][k], At[m][k], acc[ai][bj][m][n], 0, 0, 0); __builtin_amdgcn_s_setprio(0); } while (0)
#define PG8_WAIT_V(n) asm volatile("s_waitcnt vmcnt(" #n ")" ::: "memory")
#define PG8_WAIT_L(n) asm volatile("s_waitcnt lgkmcnt(" #n ")" ::: "memory")
#define PG8_BAR __builtin_amdgcn_s_barrier()
#define PG8_SCHED __builtin_amdgcn_sched_barrier(0)
    Unit cur, nxt; int ui = 0;
    if (!S.next(0, cur)) return;
    unsigned gvc[2][2];
#define PG8_GV(unit) do { if constexpr (GATHER) { int _tz = tid; asm volatile("" : "+v"(_tz)); _Pragma("unroll") for (int _h = 0; _h < 2; ++_h) _Pragma("unroll") for (int _j = 0; _j < 2; ++_j) { int _R, _C; stage_rc(_tz * 16 + _j * 8192, _R, _C); \
        gvc[_h][_j] = (unsigned)S.arow(unit, _h * HALF + _R) * (unsigned)(g.lda * 2) + (unsigned)(_C * 2); } } } while (0)
    PG8_GV(cur);
    f32x4 acc[2][2][4][2];
#pragma unroll
    for (int a = 0; a < 2; ++a)
#pragma unroll
        for (int b = 0; b < 2; ++b)
#pragma unroll
            for (int m = 0; m < 4; ++m)
#pragma unroll
                for (int n = 0; n < 2; ++n) acc[a][b][m][n] = (f32x4){0.f, 0.f, 0.f, 0.f};
    bf16x8 At[4][2], B0[2][2], B1[2][2];
    const char* cA = (const char*)g.A + cur.aoff; const char* cB = (const char*)g.Bt + cur.boff;
    PG8_STAGE(PG8_SB(0, 0), cB, voffB); PG8_STAGE(PG8_SB(0, 1), cB + hstepB, voffB); PG8_STAGE_A(PG8_SA(0, 0), cA, 0, false); PG8_STAGE_A(PG8_SA(0, 1), cA, 1, false);
    if (wr == 1) PG8_BAR;
    PG8_WAIT_V(2); PG8_BAR;
    PG8_STAGE(PG8_SB(1, 0), cB + kstep, voffB); PG8_STAGE_A(PG8_SA(1, 0), cA + kstep, 0, false); PG8_STAGE(PG8_SB(1, 1), cB + hstepB + kstep, voffB);
    PG8_WAIT_V(6); PG8_BAR;
    for (;;) {
        const bool has_next = S.next(ui + 1, nxt);
        const char* nA = has_next ? (const char*)g.A + nxt.aoff : cA; const char* nB = has_next ? (const char*)g.Bt + nxt.boff : cB;
#pragma nounroll
        for (int t = 0; t < nt; t += 2) {
            const bool last = (t == nt - 2);
            const char* a1 = cA + (size_t)(t + 1) * kstep;
            const char* a2 = last ? nA : cA + (size_t)(t + 2) * kstep; const char* b2 = last ? nB : cB + (size_t)(t + 2) * kstep;
            const char* a3 = a2 + kstep; const char* b3 = b2 + kstep;
            PG8_LDB(B0, 0, 0); PG8_LDB(B1, 0, 1); PG8_SCHED; PG8_LDA(At, 0, 0); PG8_STAGE_A(PG8_SA(1, 1), a1, 1, false);
            PG8_WAIT_V(8); PG8_WAIT_L(0); PG8_BAR; PG8_MMA(0, 0, At, B0); PG8_MMA(0, 1, At, B1); PG8_BAR; PG8_SCHED;
            PG8_LDA(At, 0, 1); PG8_STAGE(PG8_SB(0, 0), b2, voffB); PG8_STAGE(PG8_SB(0, 1), b2 + hstepB, voffB); PG8_STAGE_A(PG8_SA(0, 0), a2, 0, last);
            PG8_WAIT_V(8); PG8_WAIT_L(0); PG8_BAR; PG8_MMA(1, 0, At, B0); PG8_MMA(1, 1, At, B1); PG8_BAR; PG8_SCHED;
            PG8_LDB(B0, 1, 0); PG8_LDB(B1, 1, 1); PG8_SCHED; PG8_LDA(At, 1, 0); PG8_STAGE_A(PG8_SA(0, 1), a2, 1, last);
            PG8_WAIT_V(8); PG8_WAIT_L(0); PG8_BAR; PG8_MMA(0, 0, At, B0); PG8_MMA(0, 1, At, B1); PG8_BAR; PG8_SCHED;
            PG8_LDA(At, 1, 1); PG8_STAGE(PG8_SB(1, 0), b3, voffB); PG8_STAGE(PG8_SB(1, 1), b3 + hstepB, voffB); PG8_STAGE_A(PG8_SA(1, 0), a3, 0, last);
            PG8_WAIT_V(8); PG8_WAIT_L(0); PG8_BAR; PG8_MMA(1, 0, At, B0); PG8_MMA(1, 1, At, B1); PG8_BAR; PG8_SCHED;
        }
        if (wr == 0) PG8_BAR;
        E(acc, cur, wr, wc, fr, fq);
        if (!has_next) break;
#pragma unroll
        for (int a = 0; a < 2; ++a)
#pragma unroll
            for (int b = 0; b < 2; ++b)
#pragma unroll
                for (int m = 0; m < 4; ++m)
#pragma unroll
                    for (int n = 0; n < 2; ++n) acc[a][b][m][n] = (f32x4){0.f, 0.f, 0.f, 0.f};
        cur = nxt; cA = nA; cB = nB; ++ui;
        PG8_GV(cur);
        if (wr == 1) PG8_BAR;
    }
    PG8_WAIT_V(0);
    PG8_BAR;
#undef PG8_SA
#undef PG8_SB
#undef PG8_STAGE
#undef PG8_STAGE_A
#undef PG8_GV
#undef PG8_LDA
#undef PG8_LDB
#undef PG8_MMA
#undef PG8_WAIT_V
#undef PG8_WAIT_L
#undef PG8_BAR
#undef PG8_SCHED
}

struct StaticOrder {
    int nM, nN, nwg, G, c; long astride, apn, bstride;
    __device__ void init(int nM_, int nN_, int G_, int c_, long astride_, long apn_, long bstride_) { nM = nM_; nN = nN_; nwg = nM * nN; G = G_; c = c_; astride = astride_; apn = apn_; bstride = bstride_; }
    __device__ bool next(int i, Unit& u) const {
        const long Lx = (long)i * G + c; if (Lx >= nwg) return false;
        int wgid = (int)Lx; { const int q = nwg / 8, r = nwg % 8, xcd = wgid % 8, off = wgid / 8; wgid = (xcd < r ? xcd * (q + 1) : r * (q + 1) + (xcd - r) * q) + off; }
        const int nig = 8 * nN, gid = wgid / nig, fm = gid * 8, gsz = (nM - fm) < 8 ? (nM - fm) : 8;
        u.pm = fm + ((wgid % nig) % gsz); u.pn = (wgid % nig) / gsz; u.aoff = (long)u.pm * astride + (long)u.pn * apn; u.boff = (long)u.pn * bstride; u.e = 0; u.idx0 = 0; return true;
    }
    __device__ int arow(const Unit&, int) const { return 0; }
};
}

constexpr int DM = 2048, NBATCH = 2, SEQ = 8192, CTX = 256;
constexpr int TL = NBATCH * SEQ;
constexpr int TC = NBATCH * CTX;
constexpr int TT = TL + TC;
constexpr int KEYS = CTX + SEQ;
constexpr int NEXP = 64, DEXP = 512;
constexpr int LISTCAP = 2 * TT;
constexpr float EPS = 1e-6f;
constexpr float QSCALE = 0.125f * 1.4426950408889634f;
constexpr int NWAVES = 8, NTHREADS = 512;

constexpr size_t MiB = 1u << 20;
constexpr size_t WS_CTL = 0, CTL_BYTES = 1 * MiB;
constexpr size_t WS_WIN0 = 1 * MiB;
constexpr size_t WS_WOUT0 = WS_WIN0 + 16 * MiB;
constexpr size_t WS_WIN1 = WS_WOUT0 + 8 * MiB;
constexpr size_t WS_WOUT1 = WS_WIN1 + 16 * MiB;
constexpr size_t WS_WPOOL = WS_WOUT1 + 8 * MiB;
constexpr size_t WS_WGLU = WS_WPOOL + 1 * MiB;
constexpr size_t WS_WMOE = WS_WGLU + 2 * MiB;
constexpr size_t MOE_E_BYTES = 6 * MiB, MOE_L_BYTES = 64 * MOE_E_BYTES;
constexpr size_t WS_X = WS_WMOE + 2 * MOE_L_BYTES;
constexpr size_t WS_HA = WS_X + 132 * MiB;
constexpr size_t WS_Q = WS_HA + 67 * MiB;
constexpr size_t WS_K = WS_Q + 33 * MiB;
constexpr size_t WS_VT = WS_K + 33 * MiB;
constexpr size_t WS_P = WS_VT + 33 * MiB;
constexpr size_t WS_PROJ1 = WS_Q;
constexpr size_t WS_CAT = WS_P + 33 * MiB;
constexpr size_t WS_PD = WS_CAT + 66 * MiB;
constexpr size_t WS_H = WS_PD + 33 * MiB;
constexpr size_t WS_Y = WS_H + 49 * MiB;
constexpr size_t WS_GT = WS_Y + 132 * MiB;
constexpr size_t WS_KT = WS_GT + 192 * MiB;
constexpr size_t WS_YD = WS_KT + 128 * MiB;
constexpr size_t WS_MISC = WS_YD + 128 * MiB;
constexpr size_t WS_MOD = WS_MISC;
constexpr size_t WS_ADAP = WS_MOD + 1 * MiB;
constexpr size_t WS_ROPE = WS_ADAP + 10 * MiB;
constexpr size_t WS_NORMP = WS_ROPE + 1 * MiB;
constexpr size_t WS_INVN = WS_NORMP + 4 * MiB;
constexpr size_t WS_S5LAM = WS_INVN + 1 * MiB;
constexpr size_t WS_S5B = WS_S5LAM + 1 * MiB;
constexpr size_t WS_WRT = WS_S5B + 2 * MiB;
constexpr size_t WS_TOKL = WS_WRT + 2 * MiB;
constexpr size_t WS_GATEL = WS_TOKL + 9 * MiB;
constexpr size_t WS_TW = WS_GATEL + 9 * MiB;
constexpr size_t WS_FFTW = WS_TW + 1 * MiB;
constexpr size_t WS_S5L256 = WS_FFTW + 32 * MiB;
constexpr size_t WS_S5E = WS_S5L256 + 1 * MiB;
constexpr size_t WS_YHT = WS_S5E + 4 * MiB;
constexpr size_t WS_END = WS_YHT + 64 * MiB;
static_assert(WS_END <= 2040 * MiB, "d_ws map");
constexpr int CW_BAR = 1024;
constexpr int CW_CNT = 8192;

constexpr int LDS_PHASE = 131072;
constexpr int LDS_CTL = 147456 - 2048;
constexpr int LDS_BYTES = 147456;

#define XB_TMO      128
#define XB_XCNT(j)  (256  + 64 * (j))
#define XB_XSUB(j)  (1280 + 64 * (j))
#define XB_XGEN(j)  (2304 + 64 * (j))
#define XB_TOP      3328
#define XB_TOPGEN   3392
#define XCD_BAR_WORDS 3456
#define XB_SPIN_CAP (1u << 22)

__device__ __forceinline__ unsigned xb_ld(unsigned* p)              { return __hip_atomic_load(p, __ATOMIC_RELAXED, __HIP_MEMORY_SCOPE_AGENT); }
__device__ __forceinline__ unsigned xb_add(unsigned* p, unsigned v) { return __hip_atomic_fetch_add(p, v, __ATOMIC_RELAXED, __HIP_MEMORY_SCOPE_AGENT); }
__device__ __forceinline__ unsigned xb_xcc_id() { return (unsigned)__builtin_amdgcn_s_getreg((3 << 11) | 20) & 0xFu; }
#define XB_SPIN(cond, bar) do { unsigned _sp = 0; while (cond) { __builtin_amdgcn_s_sleep(1); \
    if ((++_sp & 255u) == 0u) { if (xb_ld(&(bar)[XB_TMO])) break; if (_sp > XB_SPIN_CAP) { atomicAdd(&(bar)[XB_TMO], 1u); break; } } } } while (0)

struct XcdBarrier { unsigned* bar; unsigned x; volatile LAS unsigned* st; };

__device__ __forceinline__ XcdBarrier xcd_barrier_post(unsigned* bar, volatile LAS unsigned* st) {
    XcdBarrier b; b.bar = bar; b.x = xb_xcc_id(); b.st = st;
    if (threadIdx.x == 0) (void)xb_add(&bar[XB_XCNT(b.x)], 1u);
    return b;
}
__device__ __forceinline__ void xcd_barrier_complete(unsigned* bar, unsigned x, unsigned& nloc, unsigned& nx) {
    const unsigned G = gridDim.x * gridDim.y * gridDim.z;
    unsigned sum, cnt, mine, sp = 0u;
    for (;;) {
        sum = 0u; cnt = 0u; mine = 0u;
#pragma unroll
        for (unsigned j = 0; j < 16; ++j) { const unsigned c = xb_ld(&bar[XB_XCNT(j)]); sum += c; cnt += (c > 0u) ? 1u : 0u; mine = (j == x) ? c : mine; }
        if (sum == G) break;
        __builtin_amdgcn_s_sleep(1);
        if ((++sp & 255u) == 0u) { if (xb_ld(&bar[XB_TMO])) break; if (sp > XB_SPIN_CAP) { atomicAdd(&bar[XB_TMO], 1u); break; } }
    }
    nloc = mine > 0u ? mine : 1u; nx = cnt > 0u ? cnt : 1u;
}
__device__ __forceinline__ void xcd_barrier(const XcdBarrier& b) {
    asm volatile("s_waitcnt vmcnt(0)" ::: "memory");
    __syncthreads();
    if (threadIdx.x == 0) {
        unsigned* bar = b.bar;
        __builtin_amdgcn_s_waitcnt(0);
        unsigned nloc = b.st[0], nx = b.st[1];
        if (nloc == 0u) { xcd_barrier_complete(bar, b.x, nloc, nx); b.st[0] = nloc; b.st[1] = nx; }
        const unsigned old = xb_add(&bar[XB_XSUB(b.x)], 1u);
        const unsigned gen = old / nloc;
        if (old + 1u == (gen + 1u) * nloc) {
            __builtin_amdgcn_fence(__ATOMIC_RELEASE, "agent");
            asm volatile("s_waitcnt vmcnt(0)" ::: "memory");
            const unsigned og = xb_add(&bar[XB_TOP], 1u);
            const unsigned tg = og / nx;
            if (og + 1u == (tg + 1u) * nx) xb_add(&bar[XB_TOPGEN], 1u);
            else XB_SPIN(xb_ld(&bar[XB_TOPGEN]) == tg, bar);
            __builtin_amdgcn_fence(__ATOMIC_ACQUIRE, "agent");
            xb_add(&bar[XB_XGEN(b.x)], 1u);
            asm volatile("s_waitcnt vmcnt(0)" ::: "memory");
        } else {
            XB_SPIN(xb_ld(&bar[XB_XGEN(b.x)]) == gen, bar);
            __builtin_amdgcn_fence(__ATOMIC_ACQUIRE, "agent");
            asm volatile("s_waitcnt vmcnt(0)" ::: "memory");
        }
    }
    __syncthreads();
}

__device__ __forceinline__ void sincos_2pi(double x, double& s, double& c) {
    const double q = __builtin_rint(x * 4.0);
    const double y = (x - q * 0.25) * 6.283185307179586476925;
    const double y2 = y * y;
    double sp = -7.6471637318198164759e-13; sp = sp * y2 + 1.6059043836821614599e-10; sp = sp * y2 - 2.5052108385441718775e-8; sp = sp * y2 + 2.7557319223985890653e-6;
    sp = sp * y2 - 1.9841269841269841270e-4; sp = sp * y2 + 8.3333333333333333333e-3; sp = sp * y2 - 1.6666666666666666667e-1; sp = sp * y2 * y + y;
    double cp = 4.7794773323873852974e-14; cp = cp * y2 - 1.1470745597729724714e-11; cp = cp * y2 + 2.0876756987868098979e-9; cp = cp * y2 - 2.7557319223985890653e-7;
    cp = cp * y2 + 2.4801587301587301587e-5; cp = cp * y2 - 1.3888888888888888889e-3; cp = cp * y2 + 4.1666666666666666667e-2; cp = cp * y2 - 0.5; cp = cp * y2 + 1.0;
    const int qi = ((int)q) & 3;
    s = (qi == 0) ? sp : (qi == 1) ? cp : (qi == 2) ? -sp : -cp;
    c = (qi == 0) ? cp : (qi == 1) ? -sp : (qi == 2) ? -cp : sp;
}
__device__ __forceinline__ void sincos_rad(double a, double& s, double& c) {
    double f = a * 0.15915494309189533576888; f -= __builtin_floor(f);
    if (f >= 1.0) f = 0.0;
    sincos_2pi(f, s, c);
}
__device__ __forceinline__ double exp_small(double x) {
    double r = 1.0 / 479001600.0;
    r = r * x + 1.0 / 39916800.0; r = r * x + 1.0 / 3628800.0; r = r * x + 1.0 / 362880.0; r = r * x + 1.0 / 40320.0; r = r * x + 1.0 / 5040.0;
    r = r * x + 1.0 / 720.0; r = r * x + 1.0 / 120.0; r = r * x + 1.0 / 24.0; r = r * x + 1.0 / 6.0; r = r * x + 0.5; r = r * x + 1.0; r = r * x + 1.0;
    return r;
}
__device__ __forceinline__ float fast_exp(float x) { return __builtin_amdgcn_exp2f(x * 1.4426950408889634f); }
__device__ __forceinline__ float sigmoidf_(float x) { return 1.0f / (1.0f + fast_exp(-x)); }
__device__ __forceinline__ float siluf_(float x) { return x * sigmoidf_(x); }
__device__ __forceinline__ float tanhf_(float x) { const float e = fast_exp(-2.0f * fabsf(x)); const float t = (1.0f - e) / (1.0f + e); return x < 0.f ? -t : t; }
__device__ __forceinline__ float gelu_tanh(float x) { return 0.5f * x * (1.0f + tanhf_(0.7978845608028654f * (x + 0.044715f * x * x * x))); }

#ifndef PH_REPEAT
#define PH_REPEAT 0u
#endif
struct Args { const float* in[43]; float* out; unsigned char* ws; int ph_lo, ph_hi; };

struct Frame {
    LAS unsigned char* lds; unsigned char* ws; int tid, lane, wave, bid, G, gw, NGW;
    const __attribute__((address_space(4))) unsigned long long* kin;
};
#define INP(i) ((const float*)F.kin[i])
#define WSP(T, off) ((T*)(F.ws + (off)))

__device__ __forceinline__ void tr_item(const float* W, int ldw, int N, bf16* WT, int ldt, int row_off, int rs16, LAS float* scr, int item, int lane) {
    const int nblk = N / 64, kb = item / nblk, nb = item % nblk, k0 = 64 * kb, n0 = 64 * nb;
    const int la = lane & 15, lb = lane >> 4;
    f32x4 v[16];
#pragma unroll
    for (int i = 0; i < 16; ++i) v[i] = *(const f32x4*)(W + (size_t)(k0 + 4 * i + lb) * ldw + n0 + 4 * la);
#pragma unroll
    for (int i = 0; i < 16; ++i) { const int kk = 4 * i + lb; LAS float* d = scr + (4 * la) * 65 + kk; d[0] = v[i].x; d[65] = v[i].y; d[130] = v[i].z; d[195] = v[i].w; }
    LDS_WAIT(); asm volatile("" ::: "memory");
    const int c = lane & 7;
#pragma unroll
    for (int j = 0; j < 8; ++j) { const int n = (lane >> 3) + 8 * j; const LAS float* s = scr + n * 65 + 8 * c;
        v4u o; o.x = cvt_pk_bf16(s[0], s[1]); o.y = cvt_pk_bf16(s[2], s[3]); o.z = cvt_pk_bf16(s[4], s[5]); o.w = cvt_pk_bf16(s[6], s[7]);
        const int nn = n0 + n, drow = row_off + (nn >> 4) * rs16 + (nn & 15);
        *(v4u*)(WT + (size_t)drow * ldt + k0 + 8 * c) = o; }
    LDS_WAIT(); asm volatile("" ::: "memory");
}

__device__ __forceinline__ void hyfilt_item(Frame& F, int pb) {
    const float* w1 = INP(19); const float* b1 = INP(20); const float* fq = INP(21); const float* w2 = INP(22); const float* b2 = INP(23); const float* w3 = INP(24);
    LAS float* z = (LAS float*)F.lds;
    LAS float* h1 = z + 1088;
    LAS float* h2 = h1 + 2048;
    const int tid = F.tid;
    for (int idx = tid; idx < 32 * 33; idx += NTHREADS) {
        const int p = idx / 33, f = idx % 33, i = pb * 32 + p;
        float v;
        if (f == 0) v = (float)i * (1.0f / (float)(SEQ - 1));
        else { const int j = (f - 1) & 15; const float fj = 1e-4f + (float)j * ((15.0f - 1e-4f) / 15.0f);
            double fr = (double)fj * (double)i / (double)SEQ; fr -= __builtin_floor(fr); double s, c; sincos_2pi(fr, s, c); v = (f <= 16) ? (float)c : (float)(-s); }
        z[p * 33 + f] = v;
    }
    __syncthreads();
    for (int idx = tid; idx < 2048; idx += NTHREADS) {
        const int p = idx >> 6, j = idx & 63; float a = b1[j];
        for (int f = 0; f < 33; ++f) a += z[p * 33 + f] * w1[f * 64 + j];
        double s, c; sincos_rad((double)(fq[j] * a), s, c); h1[idx] = (float)s;
    }
    __syncthreads();
    for (int idx = tid; idx < 2048; idx += NTHREADS) {
        const int p = idx >> 6, j = idx & 63; float a = b2[j];
        for (int k = 0; k < 64; ++k) a += h1[p * 64 + k] * w2[k * 64 + j];
        double s, c; sincos_rad((double)(fq[64 + j] * a), s, c); h2[idx] = (float)s;
    }
    __syncthreads();
    float* kT = WSP(float, WS_KT); float* normp = WSP(float, WS_NORMP);
    {
        const int lane = F.lane, l31 = lane & 31, lh = lane >> 5;
        float af[32];
#pragma unroll
        for (int s = 0; s < 32; ++s) af[s] = h2[l31 * 64 + 2 * s + lh];
        for (int ct = F.wave; ct < 128; ct += NWAVES) {
            const int col = ct * 32 + l31;
            f32x16 acc;
#pragma unroll
            for (int r = 0; r < 16; ++r) acc[r] = 0.f;
            float bv[32];
#pragma unroll
            for (int s = 0; s < 32; ++s) bv[s] = w3[(size_t)(2 * s + lh) * 4096 + col];
#pragma unroll
            for (int s = 0; s < 32; ++s) acc = __builtin_amdgcn_mfma_f32_32x32x2f32(af[s], bv[s], acc, 0, 0, 0);
            const int ch = col & 1023, dir = (col >> 10) & 1;
            const float adel = 3.0701134573253946f + (float)ch * ((15.350567286626972f - 3.0701134573253946f) / 1023.0f);
            float sabs = 0.f;
#pragma unroll
            for (int r = 0; r < 16; ++r) { const int i = pb * 32 + (r & 3) + 8 * (r >> 2) + 4 * lh; const float t = (float)i * (1.0f / (float)(SEQ - 1)); acc[r] *= fast_exp(-t * adel); if (!(dir == 1 && i == 0)) sabs += fabsf(acc[r]); }
            sabs += __shfl_xor(sabs, 32);
#pragma unroll
            for (int q = 0; q < 4; ++q) *(f32x4*)(kT + (size_t)col * SEQ + pb * 32 + 8 * q + 4 * lh) = (f32x4){acc[4 * q], acc[4 * q + 1], acc[4 * q + 2], acc[4 * q + 3]};
            if (lh == 0) normp[(size_t)pb * 4096 + col] = sabs;
        }
    }
    __syncthreads();
}

__device__ __forceinline__ void tr_wg_item(Frame& F, const float* W, int ldw, bf16* WT, int ldt, int row_off, int rs16, int k0, int n0) {
    LAS float* T = (LAS float*)F.lds;
    const int t = F.tid;
    f32x4 v[16];
#pragma unroll
    for (int i = 0; i < 16; ++i) v[i] = *(const f32x4*)(W + (size_t)(k0 + 4 * i + (t >> 7)) * ldw + n0 + 4 * (t & 127));
#pragma unroll
    for (int i = 0; i < 16; ++i) { const int k = 4 * i + (t >> 7); *(LAS f32x4*)(T + k * 516 + ((4 * (t & 127) + 8 * (k >> 3)) & 511)) = v[i]; }
    __syncthreads();
    const int c = (t >> 3) & 7, nl = (t & 7) | ((t >> 6) << 3);
#pragma unroll
    for (int q = 0; q < 8; ++q) { const int n = 64 * q + nl; const LAS float* s = T + (8 * c) * 516 + ((n + 8 * c) & 511);
        v4u o; o.x = cvt_pk_bf16(s[0], s[516]); o.y = cvt_pk_bf16(s[2 * 516], s[3 * 516]); o.z = cvt_pk_bf16(s[4 * 516], s[5 * 516]); o.w = cvt_pk_bf16(s[6 * 516], s[7 * 516]);
        const int nn = n0 + n, drow = row_off + (nn >> 4) * rs16 + (nn & 15);
        *(v4u*)(WT + (size_t)drow * ldt + k0 + 8 * c) = o; }
    __syncthreads();
}

__device__ __forceinline__ void p0_prologue(Frame& F) {
    for (int rep = 0; rep < (((PH_REPEAT >> 25) & 1u) ? 2 : 1); ++rep)
    for (int pb = F.bid; pb < SEQ / 32; pb += F.G) hyfilt_item(F, pb);
    for (int rep = 0; rep < (((PH_REPEAT >> 24) & 1u) ? 2 : 1); ++rep)
    for (int it = F.bid; it < 128 * 96; it += F.G) {
        const int le = it / 96, q = it % 96;
        bf16* wc = (bf16*)(F.ws + WS_WMOE + (size_t)le * MOE_E_BYTES); bf16* w2t = wc + 1024 * 2048;
        if (q < 32) tr_wg_item(F, INP(40) + (size_t)le * (2048 * 512), 512, wc, 2048, 0, 32, 64 * q, 0);
        else if (q < 64) tr_wg_item(F, INP(41) + (size_t)le * (2048 * 512), 512, wc, 2048, 16, 32, 64 * (q - 32), 0);
        else { const int r = q - 64; tr_wg_item(F, INP(42) + (size_t)le * (512 * 2048), 2048, w2t, 512, 0, 16, 64 * (r >> 2), 512 * (r & 3)); }
    }
    const int gt = F.bid * NTHREADS + F.tid, NGT = F.G * NTHREADS;
    {
        f32x2* rope = WSP(f32x2, WS_ROPE);
        for (int idx = gt; idx < 128 * 16; idx += NGT) { const int pos = idx >> 4, i = idx & 15;
            double inv = (i & 3) == 0 ? 1.0 : (i & 3) == 1 ? 0.56234132519034908 : (i & 3) == 2 ? 0.31622776601683794 : 0.17782794100389228;
            inv *= (i >> 2) == 0 ? 1.0 : (i >> 2) == 1 ? 0.1 : (i >> 2) == 2 ? 0.01 : 0.001;
            const float ang = (float)pos * (float)inv; double s, c; sincos_rad((double)ang, s, c); rope[idx] = (f32x2){(float)c, (float)s}; }
    }
    {
        f32x2* tw = WSP(f32x2, WS_TW);
        for (int idx = gt; idx < 16384; idx += NGT) { double s, c; sincos_2pi((double)idx * (1.0 / 16384.0), s, c); tw[idx] = (f32x2){(float)c, (float)(-s)}; }
    }
    {
        const float* are = INP(26); const float* aim = INP(27); const float* ldt = INP(28); const float* bre = INP(29); const float* bim = INP(30);
        f32x2* lamb = WSP(f32x2, WS_S5LAM); f32x2* bb = WSP(f32x2, WS_S5B); f32x2* l256 = WSP(f32x2, WS_S5L256);
        for (int idx = gt; idx < 2 * 64 * 64; idx += NGT) { const int dg = idx >> 6;
            const float dt = expf(ldt[dg]); const float ar = are[idx], ai = aim[idx];
            const float zr = ar * dt, zi = ai * dt; double s, c; sincos_rad((double)zi, s, c); const double er = exp_small((double)zr);
            const double lr = er * c, li = er * s; lamb[idx] = (f32x2){(float)lr, (float)li};
            { double pr = lr, pi = li; for (int q = 0; q < 8; ++q) { const double tr = pr * pr - pi * pi, ti = 2.0 * pr * pi; pr = tr; pi = ti; } l256[idx] = (f32x2){(float)pr, (float)pi}; }
            const double nr = lr - 1.0, ni = li, den = (double)ar * ar + (double)ai * ai; const double qr = (nr * ar + ni * ai) / den, qi = (ni * ar - nr * ai) / den;
            for (int cc = 0; cc < 16; ++cc) { const double br = bre[(size_t)idx * 16 + cc], bi = bim[(size_t)idx * 16 + cc]; bb[(size_t)idx * 16 + cc] = (f32x2){(float)(qr * br - qi * bi), (float)(qr * bi + qi * br)}; } }
    }
    {
        float* wrt = WSP(float, WS_WRT);
        for (int idx = gt; idx < 2 * 72 * 2048; idx += NGT) { const int l = idx / (72 * 2048), r = idx % (72 * 2048), n = r / 2048, k = r % 2048;
            wrt[idx] = n < 8 ? INP(36)[((size_t)l * 2048 + k) * 8 + n] : INP(38)[((size_t)l * 2048 + k) * 64 + (n - 8)]; }
    }
    {
        bf16* ha = WSP(bf16, WS_HA);
        for (int idx = gt; idx < 2048; idx += NGT) ha[(size_t)TT * 2048 + idx] = 0;
    }
    LAS float* scr = (LAS float*)(F.lds + F.wave * 16896);
    {
        const float* c = INP(1); const float* cctx = INP(3); const float* adaw = INP(4); float* part = WSP(float, WS_ADAP);
        for (int rep = 0; rep < (((PH_REPEAT >> 26) & 1u) ? 2 : 1); ++rep)
        for (int it = F.gw; it < 2 * 32 * 48; it += F.NGW) {
            const int l = it / (32 * 48), r = it % (32 * 48), ks = r / 48, jb = r % 48, k0 = ks * 64, j0 = jb * 256 + F.lane * 4;
            const float c0 = c[k0 + F.lane], c1 = c[2048 + k0 + F.lane], c2 = cctx[k0 + F.lane];
            const float s0 = c0 / (1.0f + expf(-c0)), s1 = c1 / (1.0f + expf(-c1)), s2 = c2 / (1.0f + expf(-c2));
            f32x4 a0 = {0.f, 0.f, 0.f, 0.f}, a1 = a0, a2 = a0;
            const float* wp = adaw + ((size_t)l * 2048 + k0) * 12288 + j0;
#pragma unroll 8
            for (int kk = 0; kk < 64; ++kk) { const f32x4 w = *(const f32x4*)(wp + (size_t)kk * 12288);
                const float t0 = __builtin_bit_cast(float, __builtin_amdgcn_readlane(__builtin_bit_cast(int, s0), kk));
                const float t1 = __builtin_bit_cast(float, __builtin_amdgcn_readlane(__builtin_bit_cast(int, s1), kk));
                const float t2 = __builtin_bit_cast(float, __builtin_amdgcn_readlane(__builtin_bit_cast(int, s2), kk));
                a0 += w * t0; a1 += w * t1; a2 += w * t2; }
            float* pp = part + ((size_t)(l * 32 + ks) * 3) * 12288 + j0;
            *(f32x4*)(pp) = a0; *(f32x4*)(pp + 12288) = a1; *(f32x4*)(pp + 2 * 12288) = a2;
        }
    }
    {
        constexpr int I0 = 1024, I1 = 512, I2 = 512, I3 = 1024, I4 = 2048, I5 = 1024, I6 = 64, I7 = 256, IE = 768;
        constexpr int NSMALL = I0 + I1 + I2 + I3 + I4 + I5 + I6 + I7;
        const int NITEMS = NSMALL;
        for (int rep = 0; rep < (((PH_REPEAT >> 27) & 1u) ? 2 : 1); ++rep)
        for (int it = F.gw; it < NITEMS; it += F.NGW) {
            int r = it;
            if (r < I0) { tr_item(INP(9), 4096, 2048, WSP(bf16, WS_WIN0), 2048, 0, 16, scr, r, F.lane); continue; } r -= I0;
            if (r < I1) { tr_item(INP(9) + 2048, 4096, 1024, WSP(bf16, WS_WIN0), 2048, 3072, 16, scr, r, F.lane); continue; } r -= I1;
            if (r < I2) { tr_item(INP(9) + 3072, 4096, 1024, WSP(bf16, WS_WIN0), 2048, 2048, 16, scr, r, F.lane); continue; } r -= I2;
            if (r < I3) { tr_item(INP(10), 2048, 2048, WSP(bf16, WS_WOUT0), 2048, 0, 16, scr, r, F.lane); continue; } r -= I3;
            if (r < I4) { tr_item(INP(15), 4096, 4096, WSP(bf16, WS_WIN1), 2048, 0, 16, scr, r, F.lane); continue; } r -= I4;
            if (r < I5) { tr_item(INP(16), 2048, 2048, WSP(bf16, WS_WOUT1), 2048, 0, 16, scr, r, F.lane); continue; } r -= I5;
            if (r < I6) { const int g = r / 16; tr_item(INP(13) + (size_t)g * 65536, 256, 256, WSP(bf16, WS_WPOOL), 256, g * 256, 16, scr, r % 16, F.lane); continue; } r -= I6;
            if (r < I7) { tr_item(INP(34), 1024, 1024, WSP(bf16, WS_WGLU), 1024, 0, 16, scr, r, F.lane); continue; } r -= I7;
        }
    }
}

__device__ __forceinline__ void p1_reduce(Frame& F) {
    const int gt = F.bid * NTHREADS + F.tid, NGT = F.G * NTHREADS;
    const float* part = WSP(float, WS_ADAP); float* mod = WSP(float, WS_MOD); const float* adab = INP(5);
    for (int idx = gt; idx < 2 * 3 * 12288; idx += NGT) { const int l = idx / (3 * 12288), r = idx % (3 * 12288), m = r / 12288, j = r % 12288;
        float a = adab[l * 12288 + j];
        for (int ks = 0; ks < 32; ++ks) a += part[((size_t)(l * 32 + ks) * 3 + m) * 12288 + j];
        mod[idx] = a; }
    const float* normp = WSP(float, WS_NORMP); float* invn = WSP(float, WS_INVN);
    for (int idx = gt; idx < 2048; idx += NGT) { const int o = idx >> 10, ch = idx & 1023; float a = 0.f;
        for (int pb = 0; pb < 256; ++pb) a += normp[(size_t)pb * 4096 + o * 2048 + ch] + normp[(size_t)pb * 4096 + o * 2048 + 1024 + ch];
        invn[idx] = 1.0f / a; }
}

__device__ __forceinline__ const float* modp(Frame& F, int l, int m, int c) { return WSP(float, WS_MOD) + ((size_t)(l * 3 + m) * 6 + c) * 2048; }
__device__ __forceinline__ int row_stream(int r) { return r < TL ? r / SEQ : 2; }

template <int MODE>
__device__ __forceinline__ void norm_phase(Frame& F, int l, float* dout) {
    const int nrows = (MODE == 3 || (MODE == 1 && l == 1)) ? TL : TT;
    float* xbuf = WSP(float, WS_X); bf16* ha = WSP(bf16, WS_HA); const bf16* Y = WSP(bf16, WS_Y);
    const float* gvec = (MODE == 0) ? INP(6) : (MODE == 1) ? INP(7) + l * 2048 : (MODE == 2) ? INP(6) + 2048 : INP(8);
    const int lane = F.lane;
    for (int r = F.gw; r < nrows; r += F.NGW) {
        const int m = row_stream(r);
        const float* src = (MODE == 0) ? (r < TL ? INP(0) + (size_t)r * 2048 : INP(2) + (size_t)(r - TL) * 2048) : xbuf + (size_t)r * 2048;
        f32x4 v[8]; float ss = 0.f;
#pragma unroll
        for (int j = 0; j < 8; ++j) v[j] = *(const f32x4*)(src + 4 * lane + 256 * j);
        if (MODE == 2 || MODE == 3) {
            const float* g2 = modp(F, MODE == 2 ? 0 : 1, m, 5);
            const bf16* y0 = Y + (size_t)(2 * r) * 2048; const bf16* y1 = y0 + 2048;
#pragma unroll
            for (int j = 0; j < 8; ++j) { const int c = 4 * lane + 256 * j; const v2u a = *(const v2u*)(y0 + c), b = *(const v2u*)(y1 + c); const f32x4 gg = *(const f32x4*)(g2 + c);
                v[j].x += gg.x * (bflo(a.x) + bflo(b.x)); v[j].y += gg.y * (bfhi(a.x) + bfhi(b.x)); v[j].z += gg.z * (bflo(a.y) + bflo(b.y)); v[j].w += gg.w * (bfhi(a.y) + bfhi(b.y)); }
            if (MODE == 2) {
#pragma unroll
                for (int j = 0; j < 8; ++j) *(f32x4*)(xbuf + (size_t)r * 2048 + 4 * lane + 256 * j) = v[j];
            }
        }
#pragma unroll
        for (int j = 0; j < 8; ++j) ss += (v[j].x * v[j].x + v[j].y * v[j].y) + (v[j].z * v[j].z + v[j].w * v[j].w);
        ss = wave_sum(ss);
        const float rs = 1.0f / sqrtf(ss * (1.0f / 2048.0f) + EPS);
        if (MODE == 3) {
#pragma unroll
            for (int j = 0; j < 8; ++j) { const int c = 4 * lane + 256 * j; const f32x4 gg = *(const f32x4*)(gvec + c); *(f32x4*)(dout + (size_t)r * 2048 + c) = v[j] * rs * gg; }
            continue;
        }
        const int lm = (MODE == 2) ? 1 : l;
        const float* sh = modp(F, lm, m, MODE == 1 ? 3 : 0); const float* sc = modp(F, lm, m, MODE == 1 ? 4 : 1);
#pragma unroll
        for (int j = 0; j < 8; ++j) { const int c = 4 * lane + 256 * j; const f32x4 gg = *(const f32x4*)(gvec + c), s1 = *(const f32x4*)(sc + c), s0 = *(const f32x4*)(sh + c);
            v[j] = (v[j] * rs * gg) * (1.0f + s1) + s0;
            v2u o; o.x = pk2(v[j].x, v[j].y); o.y = pk2(v[j].z, v[j].w); *(v2u*)(ha + (size_t)r * 2048 + c) = o; }
    }
}

__device__ __forceinline__ void ffn_norm_router_phase(Frame& F, int l) {
    const int nrows = (l == 1) ? TL : TT;
    const float* xbuf = WSP(float, WS_X); bf16* ha = WSP(bf16, WS_HA);
    const float* gvec = INP(7) + l * 2048;
    const float* wrt = WSP(float, WS_WRT) + (size_t)l * 72 * 2048;
    LAS float* wl = (LAS float*)F.lds;
    LAS float* lg = (LAS float*)(F.lds + 131072 + F.wave * 1536);
    const int lane = F.lane, tid = F.tid;
    for (int it = F.bid; it < nrows / 32; it += F.G) {
        const int r0 = it * 32 + F.wave * 4;
#define RT_DMA(q_, buf_) do { _Pragma("unroll") for (int _i = 0; _i < 8; ++_i) \
            __builtin_amdgcn_global_load_lds((const unsigned*)(wrt + (size_t)(q_) * 16384 + (size_t)(F.wave * 8 + _i) * 256 + lane * 4), (LAS unsigned*)(wl + (buf_) * 16384 + (F.wave * 8 + _i) * 256), 16, 0, 0); } while (0)
        RT_DMA(0, 0);
        f32x4 v[4][8];
#pragma unroll
        for (int rr = 0; rr < 4; ++rr) {
            const int r = r0 + rr, m = row_stream(r);
            const float* src = xbuf + (size_t)r * 2048; float ss = 0.f;
#pragma unroll
            for (int j = 0; j < 8; ++j) { v[rr][j] = *(const f32x4*)(src + 4 * lane + 256 * j); ss += (v[rr][j].x * v[rr][j].x + v[rr][j].y * v[rr][j].y) + (v[rr][j].z * v[rr][j].z + v[rr][j].w * v[rr][j].w); }
            ss = wave_sum(ss);
            const float rs = 1.0f / sqrtf(ss * (1.0f / 2048.0f) + EPS);
            const float* sh = modp(F, l, m, 3); const float* sc = modp(F, l, m, 4);
#pragma unroll
            for (int j = 0; j < 8; ++j) { const int c = 4 * lane + 256 * j; const f32x4 gg = *(const f32x4*)(gvec + c), s1 = *(const f32x4*)(sc + c), s0 = *(const f32x4*)(sh + c);
                v[rr][j] = (v[rr][j] * rs * gg) * (1.0f + s1) + s0;
                v2u o; o.x = cvt_pk_bf16(v[rr][j].x, v[rr][j].y); o.y = cvt_pk_bf16(v[rr][j].z, v[rr][j].w); *(v2u*)(ha + (size_t)r * 2048 + c) = o; }
        }
        asm volatile("s_waitcnt vmcnt(0)" ::: "memory");
        __syncthreads();
        const bool b5 = (lane & 32) != 0, b4 = (lane & 16) != 0, b3 = (lane & 8) != 0, b2 = (lane & 4) != 0, b1 = (lane & 2) != 0;
#pragma nounroll
        for (int q = 0; q < 9; ++q) {
            const LAS float* wq = wl + (q & 1) * 16384;
            if (q + 1 < 9) RT_DMA(q + 1, (q + 1) & 1);
            float a[32];
#pragma unroll
            for (int nn = 0; nn < 8; ++nn) { const LAS float* wn = wq + nn * 2048 + 4 * lane; float s0 = 0.f, s1 = 0.f, s2 = 0.f, s3 = 0.f;
#pragma unroll
                for (int j = 0; j < 8; ++j) { const f32x4 w = *(const LAS f32x4*)(wn + 256 * j);
                    s0 += (v[0][j].x * w.x + v[0][j].y * w.y) + (v[0][j].z * w.z + v[0][j].w * w.w); s1 += (v[1][j].x * w.x + v[1][j].y * w.y) + (v[1][j].z * w.z + v[1][j].w * w.w);
                    s2 += (v[2][j].x * w.x + v[2][j].y * w.y) + (v[2][j].z * w.z + v[2][j].w * w.w); s3 += (v[3][j].x * w.x + v[3][j].y * w.y) + (v[3][j].z * w.z + v[3][j].w * w.w); }
                a[nn] = s0; a[8 + nn] = s1; a[16 + nn] = s2; a[24 + nn] = s3; }
            float c16[16], c8[8], c4[4], c2[2], c1;
#pragma unroll
            for (int i = 0; i < 16; ++i) { const float keep = b5 ? a[i + 16] : a[i], send = b5 ? a[i] : a[i + 16]; c16[i] = keep + __shfl_xor(send, 32); }
#pragma unroll
            for (int i = 0; i < 8; ++i) { const float keep = b4 ? c16[i + 8] : c16[i], send = b4 ? c16[i] : c16[i + 8]; c8[i] = keep + __shfl_xor(send, 16); }
#pragma unroll
            for (int i = 0; i < 4; ++i) { const float keep = b3 ? c8[i + 4] : c8[i], send = b3 ? c8[i] : c8[i + 4]; c4[i] = keep + __shfl_xor(send, 8); }
#pragma unroll
            for (int i = 0; i < 2; ++i) { const float keep = b2 ? c4[i + 2] : c4[i], send = b2 ? c4[i] : c4[i + 2]; c2[i] = keep + __shfl_xor(send, 4); }
            { const float keep = b1 ? c2[1] : c2[0], send = b1 ? c2[0] : c2[1]; c1 = keep + __shfl_xor(send, 2); }
            c1 += __shfl_xor(c1, 1);
            if ((lane & 1) == 0) { const int i = lane >> 1; lg[(i >> 3) * 80 + q * 8 + (i & 7)] = c1; }
            asm volatile("s_waitcnt vmcnt(0)" ::: "memory");
            __syncthreads();
        }
#undef RT_DMA
        if (lane < 4) {
            const int r = r0 + lane; const LAS float* L = lg + lane * 80;
            float gl[8]; float gmax = -INFINITY; int gi = 0;
#pragma unroll
            for (int j = 0; j < 8; ++j) { gl[j] = L[j] + INP(37)[l * 8 + j]; if (gl[j] > gmax) { gmax = gl[j]; gi = j; } }
            float gsum = 0.f;
#pragma unroll
            for (int j = 0; j < 8; ++j) gsum += expf(gl[j] - gmax);
            const float pg_top = 1.0f / gsum;
            float pe[8]; float emax = -INFINITY;
#pragma unroll
            for (int j = 0; j < 8; ++j) { pe[j] = L[8 + gi * 8 + j] + INP(39)[l * 64 + gi * 8 + j]; emax = fmaxf(emax, pe[j]); }
            float esum = 0.f;
#pragma unroll
            for (int j = 0; j < 8; ++j) { pe[j] = expf(pe[j] - emax); esum += pe[j]; }
            int e1 = 0; float p1 = -1.f;
#pragma unroll
            for (int j = 0; j < 8; ++j) { pe[j] /= esum; if (pe[j] > p1) { p1 = pe[j]; e1 = j; } }
            int e2 = 0; float p2 = -1.f;
#pragma unroll
            for (int j = 0; j < 8; ++j) { if (j != e1 && pe[j] > p2) { p2 = pe[j]; e2 = j; } }
            const float den = p1 + p2; const float g1 = pg_top * p1 / den, g2 = pg_top * p2 / den;
            unsigned* cnt = WSP(unsigned, WS_CTL) + CW_CNT + l * 64; int* tokl = WSP(int, WS_TOKL); float* gatel = WSP(float, WS_GATEL);
            const int ex1 = gi * 8 + e1, ex2 = gi * 8 + e2;
            const unsigned k1 = atomicAdd(cnt + ex1, 1u); tokl[(size_t)ex1 * LISTCAP + k1] = 2 * r; gatel[(size_t)ex1 * LISTCAP + k1] = g1;
            const unsigned k2 = atomicAdd(cnt + ex2, 1u); tokl[(size_t)ex2 * LISTCAP + k2] = 2 * r + 1; gatel[(size_t)ex2 * LISTCAP + k2] = g2;
        }
        __syncthreads();
    }
}

#define EPI_ARGS const f32x4 (&acc)[2][2][4][2], const pg8::Unit& u, int wr, int wc, int fr, int fq
__device__ __forceinline__ void st_bf4(bf16* p, f32x4 v) { v2u o; o.x = cvt_pk_bf16(v.x, v.y); o.y = cvt_pk_bf16(v.z, v.w); *(v2u*)p = o; }

struct EpiQKP {
    bf16* Q; bf16* Kb; bf16* P; const f32x2* rope;
    __device__ __forceinline__ void operator()(EPI_ARGS) const {
        const int sect = u.pn >> 2, cb = (u.pn & 3) * 256; const bool latent = u.pm < TL / 256;
#pragma unroll
        for (int ai = 0; ai < 2; ++ai)
#pragma unroll
            for (int m = 0; m < 4; ++m) {
                const int r = u.pm * 256 + ai * 128 + wr * 64 + m * 16 + fr;
                int b, t; if (latent) { b = r / SEQ; t = r % SEQ; } else { b = (r - TL) / CTX; t = (r - TL) % CTX; }
                f32x4 cs0 = {1.f, 0.f, 1.f, 0.f}, cs1 = cs0;
                if (latent && sect < 2) { const int pos = (wc & 1) ? (t & 63) : (t >> 6); const f32x4* rp = (const f32x4*)(rope + pos * 16 + 4 * fq); cs0 = rp[0]; cs1 = rp[1]; }
#pragma unroll
                for (int bj = 0; bj < 2; ++bj) {
                    const int c0 = cb + bj * 128 + wc * 32 + 4 * fq;
                    f32x4 a = acc[ai][bj][m][0], bb = acc[ai][bj][m][1];
                    if (sect < 2) {
                        const f32x4 co = {cs0.x, cs0.z, cs1.x, cs1.z}, si = {cs0.y, cs0.w, cs1.y, cs1.w};
                        const f32x4 oa = a * co - bb * si, ob = a * si + bb * co; a = oa; bb = ob;
                    }
                    if (sect == 0) { a = a * QSCALE; bb = bb * QSCALE; bf16* d = Q + (size_t)r * 1024 + c0; st_bf4(d, a); st_bf4(d + 16, bb); }
                    else if (sect == 1) { const size_t kr = (size_t)b * KEYS + (latent ? CTX + t : t); bf16* d = Kb + kr * 1024 + c0; st_bf4(d, a); st_bf4(d + 16, bb); }
                    else { bf16* d = P + (size_t)r * 1024 + c0; st_bf4(d, a); st_bf4(d + 16, bb); }
                }
            }
    }
};
struct EpiVT {
    bf16* VT;
    __device__ __forceinline__ void operator()(EPI_ARGS) const {
        const bool latent = u.pn < TL / 256; const int b = latent ? u.pn / 32 : u.pn - TL / 256; const int key_t0 = latent ? CTX + (u.pn % 32) * 256 : 0;
        const int kperm = 8 * (fq & 1) + 4 * (fq >> 1);
#pragma unroll
        for (int ai = 0; ai < 2; ++ai)
#pragma unroll
            for (int m = 0; m < 4; ++m) {
                const int rr = u.pm * 256 + ai * 128 + wr * 64 + m * 16 + fr;
                bf16* rowp = VT + ((size_t)b * 1024 + rr) * KEYS + key_t0;
#pragma unroll
                for (int bj = 0; bj < 2; ++bj)
#pragma unroll
                    for (int n = 0; n < 2; ++n) st_bf4(rowp + bj * 128 + wc * 32 + 16 * n + kperm, acc[ai][bj][m][n]);
            }
    }
};
struct EpiScaleBf16 {
    bf16* O; int ldo, coff; const float* cscale;
    __device__ __forceinline__ void operator()(EPI_ARGS) const {
#pragma unroll
        for (int bj = 0; bj < 2; ++bj)
#pragma unroll
            for (int n = 0; n < 2; ++n) { const int c = u.pn * 256 + bj * 128 + wc * 32 + 16 * n + 4 * fq; const f32x4 sc = *(const f32x4*)(cscale + c);
#pragma unroll
                for (int ai = 0; ai < 2; ++ai)
#pragma unroll
                    for (int m = 0; m < 4; ++m) { const int r = u.pm * 256 + ai * 128 + wr * 64 + m * 16 + fr; st_bf4(O + (size_t)r * ldo + coff + c, acc[ai][bj][m][n] * sc); } }
    }
};
struct EpiBf16 {
    bf16* O; int ldo;
    __device__ __forceinline__ void operator()(EPI_ARGS) const {
#pragma unroll
        for (int ai = 0; ai < 2; ++ai)
#pragma unroll
            for (int m = 0; m < 4; ++m) { const int r = u.pm * 256 + ai * 128 + wr * 64 + m * 16 + fr; bf16* rowp = O + (size_t)r * ldo + u.pn * 256 + wc * 32 + 4 * fq;
#pragma unroll
                for (int bj = 0; bj < 2; ++bj)
#pragma unroll
                    for (int n = 0; n < 2; ++n) st_bf4(rowp + bj * 128 + 16 * n, acc[ai][bj][m][n]); }
    }
};
struct EpiRes {
    const float* xlat; const float* xctx; float* xout; const float* gate0;
    __device__ __forceinline__ void operator()(EPI_ARGS) const {
        const bool latent = u.pm < TL / 256;
#pragma unroll
        for (int ai = 0; ai < 2; ++ai)
#pragma unroll
            for (int m = 0; m < 4; ++m) { const int r = u.pm * 256 + ai * 128 + wr * 64 + m * 16 + fr; const int ms = latent ? r / SEQ : 2;
                const float* xi = latent ? xlat + (size_t)r * 2048 : xctx + (size_t)(r - TL) * 2048; const float* gp = gate0 + (size_t)ms * 12288;
#pragma unroll
                for (int bj = 0; bj < 2; ++bj)
#pragma unroll
                    for (int n = 0; n < 2; ++n) { const int c = u.pn * 256 + bj * 128 + wc * 32 + 16 * n + 4 * fq;
                        const f32x4 xv = *(const f32x4*)(xi + c), gv = *(const f32x4*)(gp + c); *(f32x4*)(xout + (size_t)r * 2048 + c) = xv + gv * acc[ai][bj][m][n]; } }
    }
};
struct EpiMoeUp {
    bf16* H;
    __device__ __forceinline__ void operator()(EPI_ARGS) const {
#pragma unroll
        for (int ai = 0; ai < 2; ++ai)
#pragma unroll
            for (int m = 0; m < 4; ++m) { const size_t r = (size_t)u.pm * 256 + ai * 128 + wr * 64 + m * 16 + fr;
#pragma unroll
                for (int bj = 0; bj < 2; ++bj) { const int hc = (u.pn * 256 + bj * 128 + wc * 32) / 2 + 4 * fq; const f32x4 a = acc[ai][bj][m][0], b = acc[ai][bj][m][1];
                    const f32x4 h = {siluf_(a.x) * b.x, siluf_(a.y) * b.y, siluf_(a.z) * b.z, siluf_(a.w) * b.w}; st_bf4(H + r * 512 + hc, h); } }
    }
};
struct EpiMoeDown {
    bf16* Y; const int* tokl; const float* gatel; const unsigned* cnt;
    __device__ __forceinline__ void operator()(EPI_ARGS) const {
        const int ce = (int)cnt[u.e];
#pragma unroll
        for (int ai = 0; ai < 2; ++ai)
#pragma unroll
            for (int m = 0; m < 4; ++m) { const int idx = u.idx0 + ai * 128 + wr * 64 + m * 16 + fr;
                if (idx < ce) { const int pair = tokl[(size_t)u.e * LISTCAP + idx]; const float gt = gatel[(size_t)u.e * LISTCAP + idx]; bf16* rowp = Y + (size_t)pair * 2048 + u.pn * 256 + wc * 32 + 4 * fq;
#pragma unroll
                    for (int bj = 0; bj < 2; ++bj)
#pragma unroll
                        for (int n = 0; n < 2; ++n) st_bf4(rowp + bj * 128 + 16 * n, acc[ai][bj][m][n] * gt); } }
    }
};
struct EpiGlu {
    bf16* O; int ldo, coff; const bf16* Gb; const float* bias;
    __device__ __forceinline__ void operator()(EPI_ARGS) const {
#pragma unroll
        for (int ai = 0; ai < 2; ++ai)
#pragma unroll
            for (int m = 0; m < 4; ++m) { const int r = u.pm * 256 + ai * 128 + wr * 64 + m * 16 + fr;
#pragma unroll
                for (int bj = 0; bj < 2; ++bj)
#pragma unroll
                    for (int n = 0; n < 2; ++n) { const int c = u.pn * 256 + bj * 128 + wc * 32 + 16 * n + 4 * fq; const f32x4 bv = *(const f32x4*)(bias + c); const v2u gw = *(const v2u*)(Gb + (size_t)r * 1024 + c);
                        const f32x4 a = acc[ai][bj][m][n] + bv; const f32x4 o = {bflo(gw.x) * sigmoidf_(a.x), bfhi(gw.x) * sigmoidf_(a.y), bflo(gw.y) * sigmoidf_(a.z), bfhi(gw.y) * sigmoidf_(a.w)};
                        st_bf4(O + (size_t)r * ldo + coff + c, o); } }
    }
};

struct MoeOrder {
    const LAS int* bstart;
    const unsigned* cnt; const int* tokl; int nN, G, c, nblk; long bstride, eoff; bool up;
    __device__ bool next(int i, pg8::Unit& u) const {
        const long Lx = (long)i * G + c; if (Lx >= (long)nblk * nN) return false;
        const int blk = (int)(Lx / nN); u.pn = (int)(Lx % nN); u.pm = blk;
        const int e = bstart[65 + blk];
        u.e = e; u.idx0 = (blk - bstart[e]) * 256;
        u.aoff = up ? 0 : (long)blk * 256 * 512 * 2;
        u.boff = (long)e * (long)MOE_E_BYTES + eoff + (long)u.pn * bstride;
        return true;
    }
    __device__ int arow(const pg8::Unit& u, int row) const { const int idx = u.idx0 + row; return idx < (int)cnt[u.e] ? (tokl[(size_t)u.e * LISTCAP + idx] >> 1) : TT; }
};

#ifdef ATT_NORARE
#define ATT_RARE(mx) false
#else
#define ATT_RARE(mx) __any(mx > 8.0f)
#endif
__device__ __forceinline__ void attn_phase(Frame& F) {
    const bf16* Q = WSP(bf16, WS_Q); const bf16* Kb = WSP(bf16, WS_K); const bf16* VT = WSP(bf16, WS_VT); bf16* cat = WSP(bf16, WS_CAT);
    LAS unsigned char* lds = F.lds;
    const int lane0 = F.lane;
    float lam;
    { const float* lv = INP(11); float a = lv[lane0] * lv[64 + lane0], b = lv[128 + lane0] * lv[192 + lane0]; a = wave_sum(a); b = wave_sum(b); lam = expf(a) - expf(b) + 0.2f; }
    const float* subg = INP(12);
    const int NU = 1024 + 32;
    const int xcd = F.bid & 7, jcu = F.bid >> 3;
    for (int it = 0;; ++it) {
        int tl_ = F.tid; asm volatile("" : "+v"(tl_));
        const int lane = tl_ & 63, w = __builtin_amdgcn_readfirstlane(tl_ >> 6), sub = w & 1, qw = w >> 1, r32 = lane & 31, hi = lane >> 5;
        int uidx;
        if (F.G == 256) { if (it < 4) uidx = 128 * xcd + it * 32 + jcu; else if (it == 4 && F.bid < 32) uidx = 1024 + F.bid; else break; }
        else { uidx = it * F.G + F.bid; if (uidx >= NU) break; }
        int b, head, q0row, nt; size_t kbase;
        if (uidx < 1024) { const int combo = uidx >> 6, qb = uidx & 63; b = combo >> 3; head = combo & 7; q0row = b * SEQ + qb * 128; nt = KEYS / 64; }
        else { const int v = uidx - 1024; b = v >> 4; head = (v >> 1) & 7; q0row = TL + b * CTX + (v & 1) * 128; nt = CTX / 64; }
        kbase = (size_t)b * KEYS;
        bf16x8 qf[4];
        { const bf16* qp = Q + (size_t)(q0row + qw * 32 + r32) * 1024 + head * 128 + sub * 64 + hi * 8;
#pragma unroll
          for (int ks = 0; ks < 4; ++ks) qf[ks] = *(const bf16x8*)(qp + ks * 16); }
        const char* gsrc[4];
#pragma unroll
        for (int j = 0; j < 4; ++j) { const int pi = w * 4 + j, rr = lane >> 3, pc = lane & 7;
            if (pi < 16) { const int key = (pi & 7) * 8 + rr, c = pc ^ ((key >> 1) & 7); gsrc[j] = (const char*)(Kb + (kbase + key) * 1024 + head * 128 + (pi >> 3) * 64 + c * 8); }
            else { const int dvr = (pi - 16) * 8 + rr, c = pc ^ ((dvr >> 1) & 7); gsrc[j] = (const char*)(VT + ((size_t)(b * 8 + head) * 128 + dvr) * KEYS + c * 8); } }
        const size_t gstep = (w < 4) ? (size_t)65536 * 2 : (size_t)64 * 2;
        const unsigned ldst = (unsigned)w * 4096u;
#define ATT_DMA(t, buf) do { _Pragma("unroll") for (int _j = 0; _j < 4; ++_j) \
            __builtin_amdgcn_global_load_lds((const unsigned*)(gsrc[_j] + (size_t)(t) * gstep), (LAS unsigned*)(lds + (buf) * 32768 + ldst + _j * 1024), 16, 0, 0); } while (0)
        ATT_DMA(0, 0); ATT_DMA(1, 1); ATT_DMA(2, 2);
        asm volatile("s_waitcnt vmcnt(4)" ::: "memory");
        __builtin_amdgcn_s_barrier();
        f32x16 o[4];
#pragma unroll
        for (int d = 0; d < 4; ++d)
#pragma unroll
            for (int r = 0; r < 16; ++r) o[d][r] = 0.f;
        float mref = 0.f, lrow = 0.f;
        f32x16 negm;
#pragma unroll
        for (int r = 0; r < 16; ++r) negm[r] = 0.f;
        const int rdoff = r32 * 128;
        const int swz = (r32 >> 1) & 7;
        f32x16 s0, s1; bf16x8 pf[4];
#define ATT_QK(bufidx) do { const LAS unsigned char* kp_ = lds + (bufidx) * 32768 + sub * 8192; bf16x8 kfa[4], kfb[4]; \
            _Pragma("unroll") for (int ks = 0; ks < 4; ++ks) { const int ch = ((2 * ks + hi) ^ swz) * 16; kfa[ks] = *(const LAS bf16x8*)(kp_ + rdoff + ch); kfb[ks] = *(const LAS bf16x8*)(kp_ + 4096 + rdoff + ch); } \
            s0 = negm; s1 = negm; \
            _Pragma("unroll") for (int ks = 0; ks < 4; ++ks) { s0 = __builtin_amdgcn_mfma_f32_32x32x16_bf16(kfa[ks], qf[ks], s0, 0, 0, 0); s1 = __builtin_amdgcn_mfma_f32_32x32x16_bf16(kfb[ks], qf[ks], s1, 0, 0, 0); } } while (0)
#define ATT_MAX(mx) do { float mxa = fmaxf(fmaxf(s0[0], s0[1]), s0[2]), mxb = fmaxf(fmaxf(s1[0], s1[1]), s1[2]); \
            _Pragma("unroll") for (int r = 3; r < 15; r += 2) { mxa = fmaxf(fmaxf(mxa, s0[r]), s0[r + 1]); mxb = fmaxf(fmaxf(mxb, s1[r]), s1[r + 1]); } \
            mx = fmaxf(fmaxf(mxa, mxb), fmaxf(s0[15], s1[15])); mx = fmaxf(mx, __shfl_xor(mx, 32)); } while (0)
#define ATT_FIX(mx) do { const float dl = fmaxf(mx, 0.f); mref += dl; const float alpha = __builtin_amdgcn_exp2f(-dl); lrow *= alpha; \
            _Pragma("unroll") for (int r = 0; r < 16; ++r) { s0[r] -= dl; s1[r] -= dl; negm[r] = -mref; } \
            _Pragma("unroll") for (int d = 0; d < 4; ++d) _Pragma("unroll") for (int r = 0; r < 16; ++r) o[d][r] *= alpha; } while (0)
#define ATT_EXP8(S, base, dst) do { float rs_ = 0.f; _Pragma("unroll") for (int r = 0; r < 8; ++r) { S[base + r] = __builtin_amdgcn_exp2f(S[base + r]); rs_ += S[base + r]; } lrow += rs_; \
            v4u pw_; pw_.x = cvt_pk_bf16(S[base + 0], S[base + 1]); pw_.y = cvt_pk_bf16(S[base + 2], S[base + 3]); pw_.z = cvt_pk_bf16(S[base + 4], S[base + 5]); pw_.w = cvt_pk_bf16(S[base + 6], S[base + 7]); dst = __builtin_bit_cast(bf16x8, pw_); } while (0)
#define ATT_VLD(dstv, vp_, s) do { _Pragma("unroll") for (int d = 0; d < 4; ++d) dstv[d] = *(const LAS bf16x8*)(vp_ + d * 4096 + rdoff + (((2 * (s) + hi) ^ swz) * 16)); } while (0)
#define ATT_PV4(srcv, pfrag) do { _Pragma("unroll") for (int d = 0; d < 4; ++d) o[d] = __builtin_amdgcn_mfma_f32_32x32x16_bf16(srcv[d], pfrag, o[d], 0, 0, 0); } while (0)
        { ATT_QK(0); float mx; ATT_MAX(mx); if (__any(mx > 8.0f)) ATT_FIX(mx);
          ATT_EXP8(s0, 0, pf[0]); ATT_EXP8(s0, 8, pf[1]); ATT_EXP8(s1, 0, pf[2]); ATT_EXP8(s1, 8, pf[3]); }
        int bcur = 0;
#pragma nounroll
        for (int t = 0; t < nt; ++t) {
            const int bn1 = (bcur + 1) & 3, bn3 = (bcur + 3) & 3;
            if (t + 3 < nt) ATT_DMA(t + 3, bn3);
            const LAS unsigned char* vp = lds + bcur * 32768 + 16384;
            bf16x8 vfa[4], vfb[4];
            if (t + 1 < nt) {
                __builtin_amdgcn_sched_barrier(0);
                ATT_QK(bn1);
                float mx; ATT_MAX(mx);
                __builtin_amdgcn_sched_barrier(0);
                if (__any(mx > 8.0f)) {
                    const float dl = fmaxf(mx, 0.f); mref += dl; const float alpha = __builtin_amdgcn_exp2f(-dl); lrow *= alpha;
#pragma unroll
                    for (int r = 0; r < 16; ++r) { s0[r] -= dl; s1[r] -= dl; negm[r] = -mref; }
#pragma unroll
                    for (int d = 0; d < 4; ++d)
#pragma unroll
                        for (int r = 0; r < 16; ++r) o[d][r] *= alpha;
#pragma unroll
                    for (int s = 0; s < 4; ++s) { v4u pw = __builtin_bit_cast(v4u, pf[s]);
                        pw.x = cvt_pk_bf16(bflo(pw.x) * alpha, bfhi(pw.x) * alpha); pw.y = cvt_pk_bf16(bflo(pw.y) * alpha, bfhi(pw.y) * alpha);
                        pw.z = cvt_pk_bf16(bflo(pw.z) * alpha, bfhi(pw.z) * alpha); pw.w = cvt_pk_bf16(bflo(pw.w) * alpha, bfhi(pw.w) * alpha); pf[s] = __builtin_bit_cast(bf16x8, pw); }
                }
                __builtin_amdgcn_sched_barrier(0);
                {
                    ATT_VLD(vfa, vp, 0);
                    __builtin_amdgcn_sched_barrier(0);
                    ATT_VLD(vfb, vp, 1); ATT_PV4(vfa, pf[0]); ATT_EXP8(s0, 0, pf[0]);
                    __builtin_amdgcn_sched_barrier(0);
                    ATT_VLD(vfa, vp, 2); ATT_PV4(vfb, pf[1]); ATT_EXP8(s0, 8, pf[1]);
                    __builtin_amdgcn_sched_barrier(0);
                    ATT_VLD(vfb, vp, 3); ATT_PV4(vfa, pf[2]); ATT_EXP8(s1, 0, pf[2]);
                    __builtin_amdgcn_sched_barrier(0);
                    ATT_PV4(vfb, pf[3]); ATT_EXP8(s1, 8, pf[3]);
                }
                __builtin_amdgcn_sched_barrier(0);
            } else {
#pragma unroll
                for (int s = 0; s < 4; ++s) { ATT_VLD(vfa, vp, s); ATT_PV4(vfa, pf[s]); }
            }
            if (t + 3 < nt) asm volatile("s_waitcnt vmcnt(4) lgkmcnt(0)" ::: "memory"); else asm volatile("s_waitcnt vmcnt(0) lgkmcnt(0)" ::: "memory");
            __builtin_amdgcn_s_barrier();
            bcur = bn1;
        }
#undef ATT_DMA
#undef ATT_QK
#undef ATT_MAX
#undef ATT_FIX
#undef ATT_EXP8
#undef ATT_VLD
#undef ATT_PV4
        const float ltot = lrow + __shfl_xor(lrow, 32); const float linv = 1.0f / ltot;
        LAS float* xch = (LAS float*)lds + (size_t)(qw * 32 + r32) * 132;
        if (sub == 1) {
#pragma unroll
            for (int d = 0; d < 4; ++d)
#pragma unroll
                for (int g = 0; g < 4; ++g) *(LAS f32x4*)(xch + 32 * d + 8 * g + 4 * hi) = (f32x4){o[d][4 * g] * linv, o[d][4 * g + 1] * linv, o[d][4 * g + 2] * linv, o[d][4 * g + 3] * linv};
        }
        __syncthreads();
        if (sub == 0) {
            float ss = 0.f;
#pragma unroll
            for (int d = 0; d < 4; ++d)
#pragma unroll
                for (int g = 0; g < 4; ++g) { const f32x4 o2 = *(const LAS f32x4*)(xch + 32 * d + 8 * g + 4 * hi);
#pragma unroll
                    for (int j = 0; j < 4; ++j) { const float v = o[d][4 * g + j] * linv - lam * o2[j]; o[d][4 * g + j] = v; ss += v * v; } }
            ss += __shfl_xor(ss, 32);
            const float rn = 0.8f / sqrtf(ss * (1.0f / 128.0f) + EPS);
            bf16* op = cat + (size_t)(q0row + qw * 32 + r32) * 2048 + head * 128;
#pragma unroll
            for (int d = 0; d < 4; ++d)
#pragma unroll
                for (int g = 0; g < 4; ++g) { const int dv = 32 * d + 8 * g + 4 * hi; const f32x4 gg = *(const f32x4*)(subg + dv);
                    st_bf4(op + dv, (f32x4){o[d][4 * g] * rn * gg.x, o[d][4 * g + 1] * rn * gg.y, o[d][4 * g + 2] * rn * gg.z, o[d][4 * g + 3] * rn * gg.w}); }
        }
        __syncthreads();
    }
}

__device__ __forceinline__ void poold_phase(Frame& F) {
    const bf16* P = WSP(bf16, WS_P); bf16* PD = WSP(bf16, WS_PD);
    const int gt = F.bid * NTHREADS + F.tid, NGT = F.G * NTHREADS;
    for (int idx = gt; idx < TT * 128; idx += NGT) {
        const int r = idx >> 7, cc = (idx & 127) * 8, g = cc >> 8, wdw = 2 << g;
        int sb, t, Ls; if (r < TL) { sb = (r / SEQ) * SEQ; t = r % SEQ; Ls = SEQ; } else { sb = TL + ((r - TL) / CTX) * CTX; t = (r - TL) % CTX; Ls = CTX; }
        int lo = t - wdw / 2, hi = lo + wdw; lo = lo < 0 ? 0 : lo; hi = hi > Ls ? Ls : hi;
        float a[8];
#pragma unroll
        for (int j = 0; j < 8; ++j) a[j] = 0.f;
        for (int s = lo; s < hi; ++s) { const v4u v = *(const v4u*)(P + (size_t)(sb + s) * 1024 + cc);
            a[0] += bflo(v.x); a[1] += bfhi(v.x); a[2] += bflo(v.y); a[3] += bfhi(v.y); a[4] += bflo(v.z); a[5] += bfhi(v.z); a[6] += bflo(v.w); a[7] += bfhi(v.w); }
        const float inv = 1.0f / (float)(hi - lo);
        const v4u me = *(const v4u*)(P + (size_t)r * 1024 + cc);
        v4u o; o.x = pk2(a[0] * inv - bflo(me.x), a[1] * inv - bfhi(me.x)); o.y = pk2(a[2] * inv - bflo(me.y), a[3] * inv - bfhi(me.y));
        o.z = pk2(a[4] * inv - bflo(me.z), a[5] * inv - bfhi(me.z)); o.w = pk2(a[6] * inv - bflo(me.w), a[7] * inv - bfhi(me.w));
        *(v4u*)(PD + (size_t)r * 1024 + cc) = o;
    }
}

__device__ __forceinline__ void shortconv_phase(Frame& F) {
    const bf16* PJ = WSP(bf16, WS_PROJ1); float* GT = WSP(float, WS_GT);
    const float* cw = INP(17); const float* cb = INP(18);
    LAS float* scr = (LAS float*)(F.lds + F.wave * 16896);
    const int lane = F.lane;
    for (int it = F.gw; it < 2 * 128 * 48; it += F.NGW) {
        const int cbk = it % 48, tb = (it / 48) % 128, b = it / (48 * 128), col = cbk * 64 + lane, t0 = tb * 64;
        const float w0 = cw[col], w1 = cw[3072 + col], w2 = cw[2 * 3072 + col], bias = cb[col];
        const bf16* base = PJ + ((size_t)b * SEQ) * 4096 + col;
        float prev = (t0 > 0) ? bf2f(base[(size_t)(t0 - 1) * 4096]) : 0.f;
        float cur = bf2f(base[(size_t)t0 * 4096]);
#pragma unroll 8
        for (int tt = 0; tt < 64; ++tt) { const int t = t0 + tt; const float nxt = (t + 1 < SEQ) ? bf2f(base[(size_t)(t + 1) * 4096]) : 0.f;
            scr[tt * 65 + lane] = prev * w0 + cur * w1 + nxt * w2 + bias; prev = cur; cur = nxt; }
        LDS_WAIT(); asm volatile("" ::: "memory");
        for (int c = 0; c < 64; ++c) GT[((size_t)(cbk * 64 + c) * 2 + b) * SEQ + t0 + lane] = scr[lane * 65 + c];
        LDS_WAIT(); asm volatile("" ::: "memory");
    }
}

__device__ __forceinline__ void s5_scan_phase(Frame& F) {
    const bf16* PJ = WSP(bf16, WS_PROJ1); float* YD = WSP(float, WS_YD);
    const f32x2* lamb = WSP(f32x2, WS_S5LAM); const f32x2* bbar = WSP(f32x2, WS_S5B);
    const float* cre = INP(31); const float* cim = INP(32);
    const int lane = F.lane;
    for (int task = F.wave * F.G + F.bid; task < 256; task += F.NGW) {
        const int di = task >> 7, b = (task >> 6) & 1, g = task & 63;
        const int dgp = (di * 64 + g) * 64 + lane;
        const f32x2 lam = lamb[dgp];
        float br[16], bi[16], cr[16], ci[16];
#pragma unroll
        for (int c = 0; c < 16; ++c) { const f32x2 bv = bbar[(size_t)dgp * 16 + c]; br[c] = bv.x; bi[c] = bv.y;
            cr[c] = cre[((size_t)(di * 64 + g) * 16 + c) * 64 + lane]; ci[c] = cim[((size_t)(di * 64 + g) * 16 + c) * 64 + lane]; }
        float sr = 0.f, si = 0.f;
        const int nsteps = CTX + SEQ;
        for (int st = 0; st < nsteps; st += 4) {
            const int stl = st + (lane >> 4);
            int row;
            if (stl < CTX) row = TL + b * CTX + (di == 0 ? stl : CTX - 1 - stl);
            else row = b * SEQ + (di == 0 ? stl - CTX : SEQ - 1 - (stl - CTX));
            const float uval = bf2f(PJ[(size_t)row * 4096 + 3072 + g * 16 + (lane & 15)]);
#pragma unroll
            for (int k = 0; k < 4; ++k) {
                float bur = 0.f, bui = 0.f;
#pragma unroll
                for (int c = 0; c < 16; ++c) { const float u = __builtin_bit_cast(float, __builtin_amdgcn_readlane(__builtin_bit_cast(int, uval), 16 * k + c)); bur += br[c] * u; bui += bi[c] * u; }
                const float nr = lam.x * sr - lam.y * si + bur, ni = lam.x * si + lam.y * sr + bui; sr = nr; si = ni;
                const int s2 = st + k;
                if (s2 >= CTX) {
                    const int t = (di == 0) ? s2 - CTX : SEQ - 1 - (s2 - CTX);
                    float outv = 0.f;
#pragma unroll
                    for (int c = 0; c < 16; ++c) { float v = cr[c] * sr - ci[c] * si; v = wave_sum(v); if (lane == c) outv = v; }
                    if (lane < 16) YD[((size_t)di * TL + (size_t)b * SEQ + t) * 1024 + g * 16 + lane] = outv;
                }
            }
        }
    }
}

__device__ __forceinline__ void hyena_naive_phase(Frame& F) {
    const float* GT = WSP(float, WS_GT); const float* kT = WSP(float, WS_KT); const float* invn = WSP(float, WS_INVN); bf16* cat = WSP(bf16, WS_CAT);
    const float* hyb = INP(25);
    LAS float* kf = (LAS float*)F.lds;
    LAS f32x2* ub = (LAS f32x2*)(F.lds + 65536);
    const int tid = F.tid;
    for (int ch = F.bid; ch < 1024; ch += F.G) {
        float res0[16], res1[16];
        for (int o = 0; o < 2; ++o) {
            const float inv = invn[o * 1024 + ch];
            const float* kfw = kT + (size_t)(o * 2048 + ch) * SEQ; const float* kbw = kT + (size_t)(o * 2048 + 1024 + ch) * SEQ;
            for (int n = tid; n < 16384; n += NTHREADS) { float v; if (n < SEQ) v = kfw[n]; else if (n == SEQ) v = 0.f; else v = kbw[16384 - n]; kf[n] = v * inv; }
            if (o == 0) { const float* v0 = GT + ((size_t)(0 * 1024 + ch) * 2) * SEQ; for (int n = tid; n < SEQ; n += NTHREADS) ub[n] = (f32x2){v0[n], v0[SEQ + n]}; }
            else {
#pragma unroll
                for (int j = 0; j < 16; ++j) ub[tid + NTHREADS * j] = (f32x2){res0[j], res1[j]}; }
            __syncthreads();
            float a0[16], a1[16];
#pragma unroll
            for (int j = 0; j < 16; ++j) { a0[j] = 0.f; a1[j] = 0.f; }
            for (int s = 0; s < SEQ; ++s) { const f32x2 u = ub[s];
#pragma unroll
                for (int j = 0; j < 16; ++j) { const float kk = kf[(tid + NTHREADS * j - s) & 16383]; a0[j] += u.x * kk; a1[j] += u.y * kk; } }
            const float bias = hyb[o * 1024 + ch];
            const float* xg = GT + ((size_t)((o + 1) * 1024 + ch) * 2) * SEQ;
#pragma unroll
            for (int j = 0; j < 16; ++j) { const int t = tid + NTHREADS * j; const f32x2 u = ub[t];
                res0[j] = xg[t] * (a0[j] + bias * u.x); res1[j] = xg[SEQ + t] * (a1[j] + bias * u.y); }
            __syncthreads();
        }
#pragma unroll
        for (int j = 0; j < 16; ++j) { const int t = tid + NTHREADS * j;
            cat[(size_t)t * 2048 + ch] = (bf16)f2bf(res0[j]); cat[((size_t)SEQ + t) * 2048 + ch] = (bf16)f2bf(res1[j]); }
    }
}

__device__ __forceinline__ void s5_gelu_phase(Frame& F) {
    const bf16* PJ = WSP(bf16, WS_PROJ1); const float* YD = WSP(float, WS_YD); bf16* Gb = WSP(bf16, WS_PD); const float* dd = INP(33);
    const int gt = F.bid * NTHREADS + F.tid, NGT = F.G * NTHREADS;
    for (int idx = gt; idx < TL * 256; idx += NGT) { const int r = idx >> 8, c = (idx & 255) * 4;
        const v2u uw = *(const v2u*)(PJ + (size_t)r * 4096 + 3072 + c); const f32x4 d4 = *(const f32x4*)(dd + c);
        const f32x4 y0 = *(const f32x4*)(YD + (size_t)r * 1024 + c), y1 = *(const f32x4*)(YD + ((size_t)TL + r) * 1024 + c);
        const f32x4 y = {bflo(uw.x) * d4.x + y0.x + y1.x, bfhi(uw.x) * d4.y + y0.y + y1.y, bflo(uw.y) * d4.z + y0.z + y1.z, bfhi(uw.y) * d4.w + y0.w + y1.w};
        st_bf4(Gb + (size_t)r * 1024 + c, (f32x4){gelu_tanh(y.x), gelu_tanh(y.y), gelu_tanh(y.z), gelu_tanh(y.w)}); }
}

__device__ __forceinline__ f32x2 cmulf(f32x2 a, f32x2 b) { return (f32x2){a.x * b.x - a.y * b.y, a.x * b.y + a.y * b.x}; }
__device__ __forceinline__ int drev14(int p) { const unsigned r = __builtin_bitreverse32((unsigned)p) >> 18; return (int)(((r & 0x2AAAu) >> 1) | ((r & 0x1555u) << 1)); }
__device__ __forceinline__ void fft_fwd(LAS f32x2* X, const f32x2* tw, int tid) {
#pragma nounroll
    for (int L = 4096; L >= 1; L >>= 2) {
        const int tws = 4096 / L;
#pragma unroll 2
        for (int i = 0; i < 8; ++i) {
            const int b = tid + NTHREADS * i, j = b & (L - 1), i0 = (b - j) * 4 + j;
            const f32x2 x0 = X[i0], x1 = X[i0 + L], x2 = X[i0 + 2 * L], x3 = X[i0 + 3 * L];
            const f32x2 w1 = tw[j * tws], w2 = cmulf(w1, w1), w3 = cmulf(w2, w1);
            const f32x2 a = x0 + x2, bb = x0 - x2, c = x1 + x3, d = x1 - x3;
            const f32x2 t1 = {bb.x + d.y, bb.y - d.x}, t3 = {bb.x - d.y, bb.y + d.x};
            X[i0] = a + c; X[i0 + L] = cmulf(t1, w1); X[i0 + 2 * L] = cmulf(a - c, w2); X[i0 + 3 * L] = cmulf(t3, w3);
        }
        __syncthreads();
    }
}
__device__ __forceinline__ void fft_inv(LAS f32x2* X, const f32x2* tw, int tid) {
#pragma nounroll
    for (int L = 1; L <= 4096; L <<= 2) {
        const int tws = 4096 / L;
#pragma unroll 2
        for (int i = 0; i < 8; ++i) {
            const int b = tid + NTHREADS * i, j = b & (L - 1), i0 = (b - j) * 4 + j;
            f32x2 w1 = tw[j * tws]; w1.y = -w1.y; const f32x2 w2 = cmulf(w1, w1), w3 = cmulf(w2, w1);
            const f32x2 x0 = X[i0], x1 = cmulf(X[i0 + L], w1), x2 = cmulf(X[i0 + 2 * L], w2), x3 = cmulf(X[i0 + 3 * L], w3);
            const f32x2 a = x0 + x2, bb = x0 - x2, c = x1 + x3, d = x1 - x3;
            X[i0] = a + c; X[i0 + L] = (f32x2){bb.x - d.y, bb.y + d.x}; X[i0 + 2 * L] = a - c; X[i0 + 3 * L] = (f32x2){bb.x + d.y, bb.y - d.x};
        }
        __syncthreads();
    }
}
__device__ __forceinline__ void fft_pointwise(LAS f32x2* X, const f32x2* Wg, int o, float scale, int tid) {
    const float hs = 0.5f * scale;
#pragma unroll 4
    for (int i = 0; i < 32; ++i) {
        const int p = tid + NTHREADS * i, f = drev14(p), pm = drev14((16384 - f) & 16383);
        const unsigned long long ua = __hip_atomic_load((const unsigned long long*)(Wg + p), __ATOMIC_RELAXED, __HIP_MEMORY_SCOPE_AGENT);
        const unsigned long long ub = __hip_atomic_load((const unsigned long long*)(Wg + pm), __ATOMIC_RELAXED, __HIP_MEMORY_SCOPE_AGENT);
        const f32x2 A = __builtin_bit_cast(f32x2, ua), B = __builtin_bit_cast(f32x2, ub);
        f32x2 K;
        if (o == 0) K = (f32x2){(A.x + B.x) * hs, (A.y - B.y) * hs};
        else { const f32x2 dd = {A.x - B.x, A.y + B.y}; K = (f32x2){dd.y * hs, -dd.x * hs}; }
        X[p] = cmulf(X[p], K);
    }
    __syncthreads();
}
__device__ __forceinline__ void hyena_fft_phase(Frame& F) {
    float* GT = WSP(float, WS_GT); const float* kT = WSP(float, WS_KT); const float* invn = WSP(float, WS_INVN); const f32x2* tw = WSP(f32x2, WS_TW);
    f32x2* Wg = WSP(f32x2, WS_FFTW) + (size_t)F.bid * 16384;
    const float* hyb = INP(25);
    LAS f32x2* X = (LAS f32x2*)F.lds;
    const int tid = F.tid;
    for (int ch = F.bid; ch < 1024; ch += F.G) {
        { const float* f0 = kT + (size_t)ch * SEQ; const float* b0 = kT + (size_t)(1024 + ch) * SEQ; const float* f1 = kT + (size_t)(2048 + ch) * SEQ; const float* b1 = kT + (size_t)(3072 + ch) * SEQ;
          for (int n = tid; n < SEQ; n += NTHREADS) { X[n] = (f32x2){f0[n], f1[n]}; X[SEQ + n] = (n == 0) ? (f32x2){0.f, 0.f} : (f32x2){b0[SEQ - n], b1[SEQ - n]}; } }
        __syncthreads();
        fft_fwd(X, tw, tid);
        for (int n = tid; n < 16384; n += NTHREADS) Wg[n] = X[n];
        __syncthreads();
        const float* v0 = GT + ((size_t)ch * 2) * SEQ; float* yo = WSP(float, WS_YHT) + ((size_t)ch * 2) * SEQ;
        const float* x1 = GT + ((size_t)(1024 + ch) * 2) * SEQ; const float* x2 = GT + ((size_t)(2048 + ch) * 2) * SEQ;
        float z0[16], z1[16];
#pragma unroll
        for (int j = 0; j < 16; ++j) { const int n = tid + NTHREADS * j; z0[j] = v0[n]; z1[j] = v0[SEQ + n]; }
#pragma unroll
        for (int o = 0; o < 2; ++o) {
#pragma unroll
            for (int j = 0; j < 16; ++j) { const int n = tid + NTHREADS * j; X[n] = (f32x2){z0[j], z1[j]}; X[SEQ + n] = (f32x2){0.f, 0.f}; }
            __syncthreads();
            fft_fwd(X, tw, tid);
            fft_pointwise(X, Wg, o, invn[o * 1024 + ch] * (1.0f / 16384.0f), tid);
            fft_inv(X, tw, tid);
            const float bias = hyb[o * 1024 + ch]; const float* xg = (o == 0) ? x1 : x2;
#pragma unroll
            for (int j = 0; j < 16; ++j) { const int n = tid + NTHREADS * j; const f32x2 y = X[n]; z0[j] = xg[n] * (y.x + bias * z0[j]); z1[j] = xg[SEQ + n] * (y.y + bias * z1[j]); }
            __syncthreads();
        }
#pragma unroll
        for (int j = 0; j < 16; ++j) { const int n = tid + NTHREADS * j; yo[n] = z0[j]; yo[SEQ + n] = z1[j]; }
    }
}
__device__ __forceinline__ void hyena_out_transpose(Frame& F) {
    const float* GT = WSP(float, WS_YHT); bf16* cat = WSP(bf16, WS_CAT);
    LAS float* scr = (LAS float*)(F.lds + F.wave * 16896);
    const int lane = F.lane;
    for (int it = F.gw; it < 2 * 128 * 16; it += F.NGW) {
        const int cbk = it & 15, tb = (it >> 4) & 127, b = it >> 11, t0 = tb * 64;
        for (int c = 0; c < 64; ++c) scr[c * 65 + lane] = GT[((size_t)(cbk * 64 + c) * 2 + b) * SEQ + t0 + lane];
        LDS_WAIT(); asm volatile("" ::: "memory");
        for (int tt = 0; tt < 64; ++tt) cat[((size_t)b * SEQ + t0 + tt) * 2048 + cbk * 64 + lane] = (bf16)f2bf(scr[lane * 65 + tt]);
        LDS_WAIT(); asm volatile("" ::: "memory");
    }
}

__device__ __forceinline__ int s5_row(int di, int b, int s) {
    return (s < CTX) ? TL + b * CTX + (di == 0 ? s : CTX - 1 - s) : b * SEQ + (di == 0 ? s - CTX : SEQ - 1 - (s - CTX));
}
template <bool OUTPUT>
__device__ __forceinline__ void s5_seg_phase(Frame& F) {
    const bf16* PJ = WSP(bf16, WS_PROJ1); float* YD = WSP(float, WS_YD);
    const f32x2* lamb = WSP(f32x2, WS_S5LAM); const f32x2* bbar = WSP(f32x2, WS_S5B); const f32x2* l256 = WSP(f32x2, WS_S5L256); f32x2* Eb = WSP(f32x2, WS_S5E);
    const float* cre = INP(31); const float* cim = INP(32);
    const int lane = F.lane;
    for (int task = F.wave * F.G + F.bid; task < 256 * 32; task += F.NGW) {
        const int dbg = task >> 5, seg = (task & 31) + (OUTPUT ? 1 : 0);
        const int di = dbg >> 7, b = (dbg >> 6) & 1, g = dbg & 63;
        const int dgp = (di * 64 + g) * 64 + lane;
        const f32x2 lam = lamb[dgp];
        float br[16], bi[16];
#pragma unroll
        for (int c = 0; c < 16; ++c) { const f32x2 bv = bbar[(size_t)dgp * 16 + c]; br[c] = bv.x; bi[c] = bv.y; }
        float cr[16], ci[16];
        if (OUTPUT) {
#pragma unroll
            for (int c = 0; c < 16; ++c) { cr[c] = cre[((size_t)(di * 64 + g) * 16 + c) * 64 + lane]; ci[c] = cim[((size_t)(di * 64 + g) * 16 + c) * 64 + lane]; }
        }
        float sr = 0.f, si = 0.f;
        if (OUTPUT) {
            const f32x2 l2 = l256[dgp]; const f32x2* ep = Eb + ((size_t)dbg * 32) * 64 + lane;
            for (int k = 0; k < seg; ++k) { const f32x2 e = ep[(size_t)k * 64]; const float nr = l2.x * sr - l2.y * si + e.x, ni = l2.x * si + l2.y * sr + e.y; sr = nr; si = ni; }
        }
        const int s0 = seg * 256;
#pragma nounroll
        for (int st = 0; st < 256; st += 4) {
            const int row = s5_row(di, b, s0 + st + (lane >> 4));
            const float uval = bf2f(PJ[(size_t)row * 4096 + 3072 + g * 16 + (lane & 15)]);
#pragma unroll
            for (int k = 0; k < 4; ++k) {
                float bur = 0.f, bui = 0.f;
#pragma unroll
                for (int c = 0; c < 16; ++c) { const float u = __builtin_bit_cast(float, __builtin_amdgcn_readlane(__builtin_bit_cast(int, uval), 16 * k + c)); bur += br[c] * u; bui += bi[c] * u; }
                const float nr = lam.x * sr - lam.y * si + bur, ni = lam.x * si + lam.y * sr + bui; sr = nr; si = ni;
                if (OUTPUT) {
                    float v8[8], v4[4], v2[2], v1;
                    const bool b5 = (lane & 32) != 0, b4 = (lane & 16) != 0, b3 = (lane & 8) != 0, b2 = (lane & 4) != 0;
#pragma unroll
                    for (int i = 0; i < 8; ++i) { const float lo = cr[i] * sr - ci[i] * si, hi = cr[i + 8] * sr - ci[i + 8] * si; const float keep = b5 ? hi : lo, send = b5 ? lo : hi; v8[i] = keep + __shfl_xor(send, 32); }
#pragma unroll
                    for (int i = 0; i < 4; ++i) { const float keep = b4 ? v8[i + 4] : v8[i], send = b4 ? v8[i] : v8[i + 4]; v4[i] = keep + __shfl_xor(send, 16); }
#pragma unroll
                    for (int i = 0; i < 2; ++i) { const float keep = b3 ? v4[i + 2] : v4[i], send = b3 ? v4[i] : v4[i + 2]; v2[i] = keep + __shfl_xor(send, 8); }
                    { const float keep = b2 ? v2[1] : v2[0], send = b2 ? v2[0] : v2[1]; v1 = keep + __shfl_xor(send, 4); }
                    v1 += __shfl_xor(v1, 2); v1 += __shfl_xor(v1, 1);
                    const int s = s0 + st + k, t = (di == 0) ? s - CTX : SEQ - 1 - (s - CTX);
                    if ((lane & 3) == 0) YD[((size_t)di * TL + (size_t)b * SEQ + t) * 1024 + g * 16 + (lane >> 2)] = v1;
                }
            }
        }
        if (!OUTPUT) Eb[((size_t)dbg * 32 + seg) * 64 + lane] = (f32x2){sr, si};
    }
}

typedef float f32x4_t __attribute__((ext_vector_type(4)));
template <bool OUTPUT>
__device__ __forceinline__ void s5_mfma_phase(Frame& F) {
    const bf16* PJ = WSP(bf16, WS_PROJ1); float* YD = WSP(float, WS_YD);
    const f32x2* lamb = WSP(f32x2, WS_S5LAM); const f32x2* bbar = WSP(f32x2, WS_S5B); const f32x2* l256 = WSP(f32x2, WS_S5L256); f32x2* Eb = WSP(f32x2, WS_S5E);
    const float* cre = INP(31); const float* cim = INP(32);
    const int lane = F.lane, fr = lane & 15, fq = lane >> 4;
    LAS unsigned* Xl = (LAS unsigned*)(F.lds + F.wave * 4608);
    for (int task = F.wave * F.G + F.bid; task < 256 * 32; task += F.NGW) {
        const int dbg = task >> 5, seg = (task & 31) + (OUTPUT ? 1 : 0);
        const int di = dbg >> 7, b = (dbg >> 6) & 1, g = dbg & 63;
        const int dg = di * 64 + g;
        f32x2 l1[4], l2[4], l3[4], l4[4];
        bf16x8 bfr[8];
#pragma unroll
        for (int t = 0; t < 4; ++t) { const int dgp = dg * 64 + 16 * t + fr; l1[t] = lamb[dgp]; l2[t] = cmulf(l1[t], l1[t]); l3[t] = cmulf(l2[t], l1[t]); l4[t] = cmulf(l2[t], l2[t]);
            v4u wre = {0u, 0u, 0u, 0u}, wim = {0u, 0u, 0u, 0u};
            if (fq < 2) { const f32x4* bp = (const f32x4*)(bbar + (size_t)dgp * 16 + 8 * fq); const f32x4 q0 = bp[0], q1 = bp[1], q2 = bp[2], q3 = bp[3];
                wre.x = cvt_pk_bf16(q0.x, q0.z); wre.y = cvt_pk_bf16(q1.x, q1.z); wre.z = cvt_pk_bf16(q2.x, q2.z); wre.w = cvt_pk_bf16(q3.x, q3.z);
                wim.x = cvt_pk_bf16(q0.y, q0.w); wim.y = cvt_pk_bf16(q1.y, q1.w); wim.z = cvt_pk_bf16(q2.y, q2.w); wim.w = cvt_pk_bf16(q3.y, q3.w); }
            bfr[t] = __builtin_bit_cast(bf16x8, wre); bfr[4 + t] = __builtin_bit_cast(bf16x8, wim); }
        bf16x8 cfr[4];
        if (OUTPUT) {
#pragma unroll
            for (int ks = 0; ks < 4; ++ks) { const size_t cb = ((size_t)dg * 16 + fr) * 64 + 16 * ks + 4 * fq; const f32x4 r4 = *(const f32x4*)(cre + cb), i4 = *(const f32x4*)(cim + cb);
                v4u w; w.x = cvt_pk_bf16(r4.x, -i4.x); w.y = cvt_pk_bf16(r4.y, -i4.y); w.z = cvt_pk_bf16(r4.z, -i4.z); w.w = cvt_pk_bf16(r4.w, -i4.w); cfr[ks] = __builtin_bit_cast(bf16x8, w); }
        }
        f32x2 st[4];
#pragma unroll
        for (int t = 0; t < 4; ++t) st[t] = (f32x2){0.f, 0.f};
        if (OUTPUT) {
#pragma unroll
            for (int t = 0; t < 4; ++t) { const f32x2 lq = l256[dg * 64 + 16 * t + fr]; const f32x2* ep = Eb + ((size_t)dbg * 32) * 64 + 16 * t + fr;
                for (int k = 0; k < seg; ++k) { const f32x2 e = ep[(size_t)k * 64]; st[t] = cmulf(lq, st[t]) + e; } }
        }
        const int s0 = seg * 256;
        v4u unext = {0u, 0u, 0u, 0u};
        if (fq < 2) unext = *(const v4u*)(PJ + (size_t)s5_row(di, b, s0 + fr) * 4096 + 3072 + g * 16 + 8 * fq);
#pragma nounroll
        for (int blk = 0; blk < 16; ++blk) {
            const bf16x8 ufr = __builtin_bit_cast(bf16x8, unext);
            if (blk + 1 < 16 && fq < 2) unext = *(const v4u*)(PJ + (size_t)s5_row(di, b, s0 + 16 * (blk + 1) + fr) * 4096 + 3072 + g * 16 + 8 * fq);
            f32x4 bu[8];
#pragma unroll
            for (int nt = 0; nt < 8; ++nt) bu[nt] = __builtin_amdgcn_mfma_f32_16x16x32_bf16(ufr, bfr[nt], (f32x4){0.f, 0.f, 0.f, 0.f}, 0, 0, 0);
            f32x2 xs[4][4];
#pragma unroll
            for (int t = 0; t < 4; ++t) {
                f32x2 x0 = {bu[t][0], bu[4 + t][0]}, x1 = cmulf(l1[t], x0) + (f32x2){bu[t][1], bu[4 + t][1]}, x2 = cmulf(l1[t], x1) + (f32x2){bu[t][2], bu[4 + t][2]}, x3 = cmulf(l1[t], x2) + (f32x2){bu[t][3], bu[4 + t][3]};
                f32x2 sin = st[t];
                f32x2 fin = x3 + cmulf(l4[t], (fq == 0) ? sin : (f32x2){0.f, 0.f});
#pragma unroll
                for (int rd = 1; rd < 4; ++rd) { const float vr = __shfl(fin.x, lane - 16), vi = __shfl(fin.y, lane - 16);
                    if (fq == rd) { sin = (f32x2){vr, vi}; fin = x3 + cmulf(l4[t], sin); } }
                xs[t][0] = x0 + cmulf(l1[t], sin); xs[t][1] = x1 + cmulf(l2[t], sin); xs[t][2] = x2 + cmulf(l3[t], sin); xs[t][3] = x3 + cmulf(l4[t], sin);
                st[t] = (f32x2){__shfl(xs[t][3].x, 48 + fr), __shfl(xs[t][3].y, 48 + fr)};
            }
            if (OUTPUT) {
#pragma unroll
                for (int t = 0; t < 4; ++t)
#pragma unroll
                    for (int r = 0; r < 4; ++r) Xl[(4 * fq + r) * 68 + 16 * t + fr] = cvt_pk_bf16(xs[t][r].x, xs[t][r].y);
                LDS_WAIT(); asm volatile("" ::: "memory");
                f32x4 y = {0.f, 0.f, 0.f, 0.f};
#pragma unroll
                for (int ks = 0; ks < 4; ++ks) { const bf16x8 xa = *(const LAS bf16x8*)(Xl + fr * 68 + 16 * ks + 4 * fq); y = __builtin_amdgcn_mfma_f32_16x16x32_bf16(xa, cfr[ks], y, 0, 0, 0); }
                LDS_WAIT(); asm volatile("" ::: "memory");
#pragma unroll
                for (int r = 0; r < 4; ++r) { const int s = s0 + 16 * blk + 4 * fq + r, tl = (di == 0) ? s - CTX : SEQ - 1 - (s - CTX);
                    YD[((size_t)di * TL + (size_t)b * SEQ + tl) * 1024 + g * 16 + fr] = y[r]; }
            }
        }
        if (!OUTPUT) { if (fq == 0) {
#pragma unroll
            for (int t = 0; t < 4; ++t) Eb[((size_t)dbg * 32 + seg) * 64 + 16 * t + fr] = st[t]; } }
    }
}

constexpr int NPHASES = 21;
#ifndef MK_SINGLE
#define MK_SINGLE 1
#endif

__device__ __forceinline__ unsigned long long launder_u64(unsigned long long v) {
    unsigned lo = (unsigned)v, hi = (unsigned)(v >> 32);
    asm volatile("" : "+v"(lo), "+v"(hi));
    lo = __builtin_amdgcn_readfirstlane(lo); hi = __builtin_amdgcn_readfirstlane(hi);
    return ((unsigned long long)hi << 32) | lo;
}
__device__ __forceinline__ const void* launder_ptr(const void* p) {
    unsigned long long v = (unsigned long long)p; unsigned lo = (unsigned)v, hi = (unsigned)(v >> 32);
    asm volatile("" : "+v"(lo), "+v"(hi));
    lo = __builtin_amdgcn_readfirstlane(lo); hi = __builtin_amdgcn_readfirstlane(hi);
    return (const void*)(((unsigned long long)hi << 32) | lo);
}
__device__ __forceinline__ void moe_blocks(Frame& F, int l, LAS int* bstart) {
    __syncthreads();
    if (F.tid == 0) { const unsigned* cnt = WSP(unsigned, WS_CTL) + CW_CNT + l * 64; int acc = 0;
        for (int e = 0; e < 64; ++e) { bstart[e] = acc; const int nb = ((int)cnt[e] + 255) >> 8; for (int j = 0; j < nb; ++j) bstart[65 + acc + j] = e; acc += nb; } bstart[64] = acc; }
    __syncthreads();
}

template <int PHSEL>
__global__ void __launch_bounds__(NTHREADS, 2) mk_fwd(Args args) {
    extern __shared__ __attribute__((aligned(16))) unsigned char lds_raw[];
    Frame F;
    F.lds = (LAS unsigned char*)lds_raw; F.ws = args.ws; F.kin = (const __attribute__((address_space(4))) unsigned long long*)__builtin_amdgcn_kernarg_segment_ptr();
    F.tid = threadIdx.x; F.lane = F.tid & 63; F.wave = __builtin_amdgcn_readfirstlane(F.tid >> 6); F.bid = blockIdx.x; F.G = gridDim.x;
    F.gw = F.bid * NWAVES + F.wave; F.NGW = F.G * NWAVES;
    volatile LAS unsigned* lctl = (volatile LAS unsigned*)(F.lds + LDS_CTL);
    LAS int* bstart = (LAS int*)(F.lds + LDS_CTL + 64);
    if (F.tid < 4) lctl[F.tid] = 0u;
    __syncthreads();
    const int lo = args.ph_lo, hi = args.ph_hi;
    XcdBarrier bar; bar.bar = WSP(unsigned, WS_CTL) + CW_BAR; bar.x = 0; bar.st = lctl;
    if (PHSEL < 0) bar = xcd_barrier_post(WSP(unsigned, WS_CTL) + CW_BAR, lctl);
#ifndef PH_MASK
#define PH_MASK 0xffffffffu
#endif
#define IN(k) (((PH_MASK >> (k)) & 1u) && (PHSEL < 0 || PHSEL == (k)))
#define INL(j) (((PH_MASK >> (6 + (j))) & 1u) && (PHSEL < 0 || (PHSEL == 6 + (j) && lo == pb + (j))))
#define PH_END(k) do { if (PHSEL < 0) xcd_barrier(bar); } while (0)
#ifndef PH_REPEAT
#define PH_REPEAT 0u
#endif
#define REP(k) for (int _rep = 0; _rep < (((PH_REPEAT >> (k)) & 1u) ? 2 : 1); ++_rep)
#define PH_BEGIN() do { F.ws = (unsigned char*)launder_ptr((const void*)F.ws); F.kin = (const __attribute__((address_space(4))) unsigned long long*)launder_u64((unsigned long long)F.kin); \
    { int _t = threadIdx.x; asm volatile("" : "+v"(_t)); F.tid = _t; F.lane = _t & 63; F.wave = __builtin_amdgcn_readfirstlane(_t >> 6); \
      int _b = blockIdx.x; asm volatile("" : "+v"(_b)); F.bid = __builtin_amdgcn_readfirstlane(_b); F.gw = F.bid * NWAVES + F.wave; } } while (0)
    LAS unsigned char* lds = F.lds;
    const int G = F.G, bid = F.bid;
    constexpr long T2048 = 256L * 2048 * 2;

    if (IN(0)) { PH_BEGIN(); REP(0) { p0_prologue(F); __syncthreads(); } PH_END(0); }
    if (IN(1)) { PH_BEGIN(); p1_reduce(F); PH_END(1); }
        if (IN(2)) { PH_BEGIN(); REP(2) norm_phase<0>(F, 0, nullptr); PH_END(2); }
        if (IN(3)) { PH_BEGIN(); REP(3) {
            { pg8::Gemm g{WSP(bf16, WS_HA), WSP(bf16, WS_WIN0), 2048, 2048, 2048}; pg8::StaticOrder S; S.init(TT / 256, 12, G, bid, T2048, 0, T2048);
              EpiQKP E{WSP(bf16, WS_Q), WSP(bf16, WS_K), WSP(bf16, WS_P), WSP(f32x2, WS_ROPE)}; pg8::gemm_phase<EpiQKP, pg8::StaticOrder, false>(lds, g, S, E); }
            { pg8::Gemm g{WSP(bf16, WS_WIN0) + (size_t)3072 * 2048, WSP(bf16, WS_HA), 2048, 2048, 2048}; pg8::StaticOrder S; S.init(4, TT / 256, G, bid, T2048, 0, T2048);
              EpiVT E{WSP(bf16, WS_VT)}; pg8::gemm_phase<EpiVT, pg8::StaticOrder, false>(lds, g, S, E); } }
            PH_END(3);
        }
        if (IN(4)) { PH_BEGIN(); REP(4) attn_phase(F); REP(21) poold_phase(F); PH_END(4); }
        if (IN(5)) { PH_BEGIN();
            pg8::Gemm g{WSP(bf16, WS_PD), WSP(bf16, WS_WPOOL), 1024, 256, 256}; pg8::StaticOrder S; S.init(TT / 256, 4, G, bid, 256L * 1024 * 2, 256L * 2, 256L * 256 * 2);
            EpiScaleBf16 E{WSP(bf16, WS_CAT), 2048, 1024, INP(14)}; pg8::gemm_phase<EpiScaleBf16, pg8::StaticOrder, false>(lds, g, S, E);
            PH_END(5);
        }
    {
    constexpr int pb = 6; constexpr int l = 0;
    if (INL(0)) { PH_BEGIN();
        float* xbuf = WSP(float, WS_X);
        pg8::Gemm g{WSP(bf16, WS_CAT), WSP(bf16, l == 0 ? WS_WOUT0 : WS_WOUT1), 2048, 2048, 2048}; pg8::StaticOrder S; S.init(l == 0 ? TT / 256 : TL / 256, 8, G, bid, T2048, 0, T2048);
        EpiRes E{l == 0 ? INP(0) : xbuf, l == 0 ? INP(2) : xbuf + (size_t)TL * 2048, xbuf, modp(F, l, 0, 2)}; pg8::gemm_phase<EpiRes, pg8::StaticOrder, false>(lds, g, S, E);
        PH_END(pb);
    }
    if (INL(1)) { PH_BEGIN(); ffn_norm_router_phase(F, l); PH_END(pb + 1); }
    if (INL(2)) { PH_BEGIN(); REP(8) {
        moe_blocks(F, l, bstart);
        pg8::Gemm g{WSP(bf16, WS_HA), (const bf16*)(F.ws + WS_WMOE + (size_t)l * MOE_L_BYTES), 2048, 2048, 2048};
        MoeOrder S{bstart, WSP(unsigned, WS_CTL) + CW_CNT + l * 64, WSP(int, WS_TOKL), 4, G, bid, bstart[64], T2048, 0, true};
        EpiMoeUp E{WSP(bf16, WS_H)}; pg8::gemm_phase<EpiMoeUp, MoeOrder, true>(lds, g, S, E); }
        PH_END(pb + 2);
    }
    if (INL(3)) { PH_BEGIN(); REP(9) {
        moe_blocks(F, l, bstart);
        pg8::Gemm g{WSP(bf16, WS_H), (const bf16*)(F.ws + WS_WMOE + (size_t)l * MOE_L_BYTES), 512, 512, 512};
        MoeOrder S{bstart, WSP(unsigned, WS_CTL) + CW_CNT + l * 64, WSP(int, WS_TOKL), 8, G, bid, bstart[64], 256L * 512 * 2, (long)(4 * MiB), false};
        EpiMoeDown E{WSP(bf16, WS_Y), WSP(int, WS_TOKL), WSP(float, WS_GATEL), WSP(unsigned, WS_CTL) + CW_CNT + l * 64}; pg8::gemm_phase<EpiMoeDown, MoeOrder, false>(lds, g, S, E); }
        PH_END(pb + 3);
    }
    }
        if (IN(10)) { PH_BEGIN(); norm_phase<2>(F, 1, nullptr); PH_END(10); }
        if (IN(11)) { PH_BEGIN(); REP(11) {
            pg8::Gemm g{WSP(bf16, WS_HA), WSP(bf16, WS_WIN1), 2048, 2048, 2048}; pg8::StaticOrder S; S.init(TT / 256, 16, G, bid, T2048, 0, T2048);
            EpiBf16 E{WSP(bf16, WS_PROJ1), 4096}; pg8::gemm_phase<EpiBf16, pg8::StaticOrder, false>(lds, g, S, E); }
            PH_END(11);
        }
        if (IN(12)) { PH_BEGIN(); REP(12) shortconv_phase(F); REP(22) s5_mfma_phase<false>(F); PH_END(12); }
        if (IN(13)) { PH_BEGIN(); REP(23) s5_mfma_phase<true>(F); __syncthreads(); REP(13) hyena_fft_phase(F); PH_END(13); }
        if (IN(14)) { PH_BEGIN(); REP(14) { s5_gelu_phase(F); hyena_out_transpose(F); } PH_END(14); }
        if (IN(15)) { PH_BEGIN();
            pg8::Gemm g{WSP(bf16, WS_PD), WSP(bf16, WS_WGLU), 1024, 1024, 1024}; pg8::StaticOrder S; S.init(TL / 256, 4, G, bid, 256L * 1024 * 2, 0, 256L * 1024 * 2);
            EpiGlu E{WSP(bf16, WS_CAT), 2048, 1024, WSP(bf16, WS_PD), INP(35)}; pg8::gemm_phase<EpiGlu, pg8::StaticOrder, false>(lds, g, S, E);
            PH_END(15);
        }
    {
    constexpr int pb = 16; constexpr int l = 1;
    if (INL(0)) { PH_BEGIN();
        float* xbuf = WSP(float, WS_X);
        pg8::Gemm g{WSP(bf16, WS_CAT), WSP(bf16, l == 0 ? WS_WOUT0 : WS_WOUT1), 2048, 2048, 2048}; pg8::StaticOrder S; S.init(l == 0 ? TT / 256 : TL / 256, 8, G, bid, T2048, 0, T2048);
        EpiRes E{l == 0 ? INP(0) : xbuf, l == 0 ? INP(2) : xbuf + (size_t)TL * 2048, xbuf, modp(F, l, 0, 2)}; pg8::gemm_phase<EpiRes, pg8::StaticOrder, false>(lds, g, S, E);
        PH_END(pb);
    }
    if (INL(1)) { PH_BEGIN(); ffn_norm_router_phase(F, l); PH_END(pb + 1); }
    if (INL(2)) { PH_BEGIN(); REP(8) {
        moe_blocks(F, l, bstart);
        pg8::Gemm g{WSP(bf16, WS_HA), (const bf16*)(F.ws + WS_WMOE + (size_t)l * MOE_L_BYTES), 2048, 2048, 2048};
        MoeOrder S{bstart, WSP(unsigned, WS_CTL) + CW_CNT + l * 64, WSP(int, WS_TOKL), 4, G, bid, bstart[64], T2048, 0, true};
        EpiMoeUp E{WSP(bf16, WS_H)}; pg8::gemm_phase<EpiMoeUp, MoeOrder, true>(lds, g, S, E); }
        PH_END(pb + 2);
    }
    if (INL(3)) { PH_BEGIN(); REP(9) {
        moe_blocks(F, l, bstart);
        pg8::Gemm g{WSP(bf16, WS_H), (const bf16*)(F.ws + WS_WMOE + (size_t)l * MOE_L_BYTES), 512, 512, 512};
        MoeOrder S{bstart, WSP(unsigned, WS_CTL) + CW_CNT + l * 64, WSP(int, WS_TOKL), 8, G, bid, bstart[64], 256L * 512 * 2, (long)(4 * MiB), false};
        EpiMoeDown E{WSP(bf16, WS_Y), WSP(int, WS_TOKL), WSP(float, WS_GATEL), WSP(unsigned, WS_CTL) + CW_CNT + l * 64}; pg8::gemm_phase<EpiMoeDown, MoeOrder, false>(lds, g, S, E); }
        PH_END(pb + 3);
    }
    }
    if (IN(20)) { PH_BEGIN(); norm_phase<3>(F, 1, args.out); }
#undef IN
#undef INL
#undef PH_END
}

typedef void (*kern_t)(Args);
template <int P> static void launch_phase(int grid, hipStream_t stream, Args a) { hipLaunchKernelGGL(mk_fwd<P>, dim3(grid), dim3(NTHREADS), LDS_BYTES, stream, a); }
template <int P> static bool prep_phase() { return hipFuncSetAttribute((const void*)mk_fwd<P>, hipFuncAttributeMaxDynamicSharedMemorySize, LDS_BYTES) == hipSuccess; }
extern "C" void kernel_launch(void* const* d_in, const int* in_sizes, int n_in, void* d_out, int out_size, void* d_ws, size_t ws_size, hipStream_t stream) {
    static int grid = 0;
    if (grid == 0) {
        if (n_in != 43 || out_size != TL * DM || ws_size < WS_END) { fprintf(stderr, "kernel_launch: unexpected shapes (n_in %d, out %d, ws %zu < %zu)\n", n_in, out_size, ws_size, (size_t)WS_END); grid = -1; return; }
        int dev = 0, cus = 0;
        if (hipGetDevice(&dev) != hipSuccess || hipDeviceGetAttribute(&cus, hipDeviceAttributeMultiprocessorCount, dev) != hipSuccess) { grid = -1; return; }
        bool ok = true;
#if MK_SINGLE
        ok = prep_phase<-1>();
#else
        ok = prep_phase<0>() && prep_phase<1>() && prep_phase<2>() && prep_phase<3>() && prep_phase<4>() && prep_phase<5>() && prep_phase<6>() && prep_phase<7>() && prep_phase<8>() && prep_phase<9>() &&
             prep_phase<10>() && prep_phase<11>() && prep_phase<12>() && prep_phase<13>() && prep_phase<14>() && prep_phase<15>() && prep_phase<20>();
#endif
        if (!ok) { fprintf(stderr, "kernel_launch: hipFuncSetAttribute failed\n"); grid = -1; return; }
        (void)hipGetLastError();
        grid = cus;
    }
    if (grid < 0) return;
    (void)hipMemsetAsync((char*)d_ws + WS_CTL, 0, CTL_BYTES, stream);
    Args a{};
    for (int i = 0; i < 43; ++i) a.in[i] = (const float*)d_in[i];
    a.out = (float*)d_out; a.ws = (unsigned char*)d_ws;
#if MK_SINGLE
    a.ph_lo = 0; a.ph_hi = NPHASES;
    launch_phase<-1>(grid, stream, a);
#else
#define LP(k, P) a.ph_lo = (k); a.ph_hi = (k) + 1; launch_phase<P>(grid, stream, a);
    LP(0, 0) LP(1, 1) LP(2, 2) LP(3, 3) LP(4, 4) LP(5, 5) LP(6, 6) LP(7, 7) LP(8, 8) LP(9, 9) LP(10, 10) LP(11, 11) LP(12, 12) LP(13, 13) LP(14, 14) LP(15, 15)
    LP(16, 6) LP(17, 7) LP(18, 8) LP(19, 9) LP(20, 20)
#undef LP
#endif
}
```

```cpp
#include <hip/hip_runtime.h>
#include <cstdio>
#include <cstdint>
#include <cmath>

#define GAS __attribute__((address_space(1)))
#define LAS __attribute__((address_space(3)))
typedef unsigned short bf16;
typedef unsigned v4u __attribute__((ext_vector_type(4)));
typedef unsigned v2u __attribute__((ext_vector_type(2)));
typedef float f32x4 __attribute__((ext_vector_type(4)));
typedef float f32x2 __attribute__((ext_vector_type(2)));
typedef float f32x16 __attribute__((ext_vector_type(16)));
typedef short bf16x8 __attribute__((ext_vector_type(8)));
#define LDS_WAIT() asm volatile("s_waitcnt lgkmcnt(0)" ::: "memory")
#define VM_WAIT() asm volatile("s_waitcnt vmcnt(0)" ::: "memory")

__device__ __forceinline__ unsigned f2bf(float f) { unsigned u = __builtin_bit_cast(unsigned, f); return (u + 0x7fffu + ((u >> 16) & 1u)) >> 16; }
__device__ __forceinline__ unsigned pk2(float lo, float hi) { return f2bf(lo) | (f2bf(hi) << 16); }
__device__ __forceinline__ unsigned cvt_pk_bf16(float lo, float hi) { unsigned r; asm volatile("v_cvt_pk_bf16_f32 %0, %1, %2" : "=v"(r) : "v"(lo), "v"(hi)); return r; }
__device__ __forceinline__ float bf2f(unsigned short b) { return __builtin_bit_cast(float, (unsigned)b << 16); }
__device__ __forceinline__ float bflo(unsigned w) { return __builtin_bit_cast(float, w << 16); }
__device__ __forceinline__ float bfhi(unsigned w) { return __builtin_bit_cast(float, w & 0xffff0000u); }
__device__ __forceinline__ float wave_sum(float v) {
#pragma unroll
    for (int o = 1; o < 64; o <<= 1) v += __shfl_xor(v, o);
    return v;
}

namespace pg8 {
typedef unsigned short bf16_t;
constexpr int BM = 256, BK = 64, HALF = 128, HTB = HALF * BK * 2, STAGE_BYTES = 8 * HTB;

__host__ __device__ __forceinline__ int lds_byte(int r, int c) { const int st = (r >> 4) * 2 + (c >> 5), rr = r & 15, cc = c & 31, ob = rr * 64 + cc * 2; return st * 1024 + (ob ^ (((ob >> 9) & 1) << 5)); }
__host__ __device__ __forceinline__ void stage_rc(int b, int& R, int& C) { const int st = b / 1024, sb = b % 1024, swz = sb ^ (((sb >> 9) & 1) << 5); R = (st >> 1) * 16 + swz / 64; C = (st & 1) * 32 + (swz % 64) / 2; }

struct Unit { int pm, pn; long aoff, boff; int e, idx0; };
struct Gemm { const bf16_t* A; const bf16_t* Bt; int lda, ldb, K; };

template <class Epi, class Sched, bool GATHER>
__device__ __forceinline__ void gemm_phase(LAS unsigned char* lds, const Gemm g, const Sched& S, const Epi& E) {
    const int tid = threadIdx.x, wid = __builtin_amdgcn_readfirstlane(tid >> 6), lane = tid & 63, wr = wid >> 2, wc = wid & 3, fr = lane & 15, fq = lane >> 4;
    const int K = g.K, nt = K / BK;
    unsigned voffA[2], voffB[2];
#pragma unroll
    for (int i = 0; i < 2; ++i) { int R, C; stage_rc(tid * 16 + i * 8192, R, C);
        voffA[i] = (unsigned)(R * g.lda + C) * 2u; voffB[i] = (unsigned)(R * g.ldb + C) * 2u; }
    const size_t kstep = (size_t)(BK * 2);
    const size_t hstepA = GATHER ? 0 : (size_t)HALF * g.lda * 2, hstepB = (size_t)HALF * g.ldb * 2;
    const unsigned ldsw = (unsigned)wid * 1024u;
    const int aoff = lds_byte(wr * 64 + fr, fq * 8), boff = lds_byte(wc * 32 + fr, fq * 8);
#define PG8_SA(b, h) (((b) * 2 + (h)) * HTB)
#define PG8_SB(b, h) ((4 + (b) * 2 + (h)) * HTB)
#define PG8_STAGE(bufoff, gbase, voff) do { _Pragma("unroll") for (int _i = 0; _i < 2; ++_i) \
        __builtin_amdgcn_global_load_lds((const unsigned*)((const char*)(gbase) + (voff)[_i]), (LAS unsigned*)(lds + (bufoff) + ldsw + _i * 8192), 16, 0, 0); } while (0)
#define PG8_STAGE_A(bufoff, gbase, h, nx) do { if constexpr (GATHER) { unsigned _tv[2]; \
        if (nx) { int _tz = tid; asm volatile("" : "+v"(_tz)); _Pragma("unroll") for (int _j = 0; _j < 2; ++_j) { int _R, _C; stage_rc(_tz * 16 + _j * 8192, _R, _C); _tv[_j] = (unsigned)S.arow(nxt, (h) * HALF + _R) * (unsigned)(g.lda * 2) + (unsigned)(_C * 2); } } \
        else { _tv[0] = gvc[h][0]; _tv[1] = gvc[h][1]; } \
        PG8_STAGE(bufoff, gbase, _tv); } else { PG8_STAGE(bufoff, (gbase) + (h) * hstepA, voffA); } } while (0)
#define PG8_LDA(dst, b, h) do { _Pragma("unroll") for (int m = 0; m < 4; ++m) _Pragma("unroll") for (int k = 0; k < 2; ++k) dst[m][k] = *(const LAS bf16x8*)(lds + PG8_SA(b, h) + aoff + m * 2048 + k * 1024); } while (0)
#define PG8_LDB(dst, b, h) do { _Pragma("unroll") for (int n = 0; n < 2; ++n) _Pragma("unroll") for (int k = 0; k < 2; ++k) dst[n][k] = *(const LAS bf16x8*)(lds + PG8_SB(b, h) + boff + n * 2048 + k * 1024); } while (0)
#define PG8_MMA(ai, bj, At, Bt) do { __builtin_amdgcn_s_setprio(1); _Pragma("unroll") for (int m = 0; m < 4; ++m) _Pragma("unroll") for (int n = 0; n < 2; ++n) _Pragma("unroll") for (int k = 0; k < 2; ++k) \
        acc[ai][bj][m][n] = __builtin_amdgcn_mfma_f32_16x16x32_bf16(Bt[n][k], At[m][k], acc[ai][bj][m][n], 0, 0, 0); __builtin_amdgcn_s_setprio(0); } while (0)
#define PG8_WAIT_V(n) asm volatile("s_waitcnt vmcnt(" #n ")" ::: "memory")
#define PG8_WAIT_L(n) asm volatile("s_waitcnt lgkmcnt(" #n ")" ::: "memory")
#define PG8_BAR __builtin_amdgcn_s_barrier()
#define PG8_SCHED __builtin_amdgcn_sched_barrier(0)
    Unit cur, nxt; int ui = 0;
    if (!S.next(0, cur)) return;
    unsigned gvc[2][2];
#define PG8_GV(unit) do { if constexpr (GATHER) { int _tz = tid; asm volatile("" : "+v"(_tz)); _Pragma("unroll") for (int _h = 0; _h < 2; ++_h) _Pragma("unroll") for (int _j = 0; _j < 2; ++_j) { int _R, _C; stage_rc(_tz * 16 + _j * 8192, _R, _C); \
        gvc[_h][_j] = (unsigned)S.arow(unit, _h * HALF + _R) * (unsigned)(g.lda * 2) + (unsigned)(_C * 2); } } } while (0)
    PG8_GV(cur);
    f32x4 acc[2][2][4][2];
#pragma unroll
    for (int a = 0; a < 2; ++a)
#pragma unroll
        for (int b = 0; b < 2; ++b)
#pragma unroll
            for (int m = 0; m < 4; ++m)
#pragma unroll
                for (int n = 0; n < 2; ++n) acc[a][b][m][n] = (f32x4){0.f, 0.f, 0.f, 0.f};
    bf16x8 At[4][2], B0[2][2], B1[2][2];
    const char* cA = (const char*)g.A + cur.aoff; const char* cB = (const char*)g.Bt + cur.boff;
    PG8_STAGE(PG8_SB(0, 0), cB, voffB); PG8_STAGE(PG8_SB(0, 1), cB + hstepB, voffB); PG8_STAGE_A(PG8_SA(0, 0), cA, 0, false); PG8_STAGE_A(PG8_SA(0, 1), cA, 1, false);
    if (wr == 1) PG8_BAR;
    PG8_WAIT_V(2); PG8_BAR;
    PG8_STAGE(PG8_SB(1, 0), cB + kstep, voffB); PG8_STAGE_A(PG8_SA(1, 0), cA + kstep, 0, false); PG8_STAGE(PG8_SB(1, 1), cB + hstepB + kstep, voffB);
    PG8_WAIT_V(6); PG8_BAR;
    for (;;) {
        const bool has_next = S.next(ui + 1, nxt);
        const char* nA = has_next ? (const char*)g.A + nxt.aoff : cA; const char* nB = has_next ? (const char*)g.Bt + nxt.boff : cB;
#pragma nounroll
        for (int t = 0; t < nt; t += 2) {
            const bool last = (t == nt - 2);
            const char* a1 = cA + (size_t)(t + 1) * kstep;
            const char* a2 = last ? nA : cA + (size_t)(t + 2) * kstep; const char* b2 = last ? nB : cB + (size_t)(t + 2) * kstep;
            const char* a3 = a2 + kstep; const char* b3 = b2 + kstep;
            PG8_LDB(B0, 0, 0); PG8_LDB(B1, 0, 1); PG8_SCHED; PG8_LDA(At, 0, 0); PG8_STAGE_A(PG8_SA(1, 1), a1, 1, false);
            PG8_WAIT_V(8); PG8_WAIT_L(0); PG8_BAR; PG8_MMA(0, 0, At, B0); PG8_MMA(0, 1, At, B1); PG8_BAR; PG8_SCHED;
            PG8_LDA(At, 0, 1); PG8_STAGE(PG8_SB(0, 0), b2, voffB); PG8_STAGE(PG8_SB(0, 1), b2 + hstepB, voffB); PG8_STAGE_A(PG8_SA(0, 0), a2, 0, last);
            PG8_WAIT_V(8); PG8_WAIT_L(0); PG8_BAR; PG8_MMA(1, 0, At, B0); PG8_MMA(1, 1, At, B1); PG8_BAR; PG8_SCHED;
            PG8_LDB(B0, 1, 0); PG8_LDB(B1, 1, 1); PG8_SCHED; PG8_LDA(At, 1, 0); PG8_STAGE_A(PG8_SA(0, 1), a2, 1, last);
            PG8_WAIT_V(8); PG8_WAIT_L(0); PG8_BAR; PG8_MMA(0, 0, At, B0); PG8_MMA(0, 1, At, B1); PG8_BAR; PG8_SCHED;
            PG8_LDA(At, 1, 1); PG8_STAGE(PG8_SB(1, 0), b3, voffB); PG8_STAGE(PG8_SB(1, 1), b3 + hstepB, voffB); PG8_STAGE_A(PG8_SA(1, 0), a3, 0, last);
            PG8_WAIT_V(8); PG8_WAIT_L(0); PG8_BAR; PG8_MMA(1, 0, At, B0); PG8_MMA(1, 1, At, B1); PG8_BAR; PG8_SCHED;
        }
        if (wr == 0) PG8_BAR;
        E(acc, cur, wr, wc, fr, fq);
        if (!has_next) break;
#pragma unroll
        for (int a = 0; a < 2; ++a)
#pragma unroll
            for (int b = 0; b < 2; ++b)
#pragma unroll
                for (int m = 0; m < 4; ++m)
#pragma unroll
                    for (int n = 0; n < 2; ++n) acc[a][b][m][n] = (f32x4){0.f, 0.f, 0.f, 0.f};
        cur = nxt; cA = nA; cB = nB; ++ui;
        PG8_GV(cur);
        if (wr == 1) PG8_BAR;
    }
    PG8_WAIT_V(0);
    PG8_BAR;
#undef PG8_SA
#undef PG8_SB
#undef PG8_STAGE
#undef PG8_STAGE_A
#undef PG8_GV
#undef PG8_LDA
#undef PG8_LDB
#undef PG8_MMA
#undef PG8_WAIT_V
#undef PG8_WAIT_L
#undef PG8_BAR
#undef PG8_SCHED
}

struct StaticOrder {
    int nM, nN, nwg, G, c; long astride, apn, bstride;
    __device__ void init(int nM_, int nN_, int G_, int c_, long astride_, long apn_, long bstride_) { nM = nM_; nN = nN_; nwg = nM * nN; G = G_; c = c_; astride = astride_; apn = apn_; bstride = bstride_; }
    __device__ bool next(int i, Unit& u) const {
        const long Lx = (long)i * G + c; if (Lx >= nwg) return false;
        int wgid = (int)Lx; { const int q = nwg / 8, r = nwg % 8, xcd = wgid % 8, off = wgid / 8; wgid = (xcd < r ? xcd * (q + 1) : r * (q + 1) + (xcd - r) * q) + off; }
        const int nig = 8 * nN, gid = wgid / nig, fm = gid * 8, gsz = (nM - fm) < 8 ? (nM - fm) : 8;
        u.pm = fm + ((wgid % nig) % gsz); u.pn = (wgid % nig) / gsz; u.aoff = (long)u.pm * astride + (long)u.pn * apn; u.boff = (long)u.pn * bstride; u.e = 0; u.idx0 = 0; return true;
    }
    __device__ int arow(const Unit&, int) const { return 0; }
};
}

constexpr int DM = 2048, NBATCH = 2, SEQ = 8192, CTX = 256;
constexpr int TL = NBATCH * SEQ;
constexpr int TC = NBATCH * CTX;
constexpr int TT = TL + TC;
constexpr int KEYS = CTX + SEQ;
constexpr int NEXP = 64, DEXP = 512;
constexpr int LISTCAP = 2 * TT;
constexpr float EPS = 1e-6f;
constexpr float QSCALE = 0.125f * 1.4426950408889634f;
constexpr int NWAVES = 8, NTHREADS = 512;

constexpr size_t MiB = 1u << 20;
constexpr size_t WS_CTL = 0, CTL_BYTES = 1 * MiB;
constexpr size_t WS_WIN0 = 1 * MiB;
constexpr size_t WS_WOUT0 = WS_WIN0 + 16 * MiB;
constexpr size_t WS_WIN1 = WS_WOUT0 + 8 * MiB;
constexpr size_t WS_WOUT1 = WS_WIN1 + 16 * MiB;
constexpr size_t WS_WPOOL = WS_WOUT1 + 8 * MiB;
constexpr size_t WS_WGLU = WS_WPOOL + 1 * MiB;
constexpr size_t WS_WMOE = WS_WGLU + 2 * MiB;
constexpr size_t MOE_E_BYTES = 6 * MiB, MOE_L_BYTES = 64 * MOE_E_BYTES;
constexpr size_t WS_X = WS_WMOE + 2 * MOE_L_BYTES;
constexpr size_t WS_HA = WS_X + 132 * MiB;
constexpr size_t WS_Q = WS_HA + 67 * MiB;
constexpr size_t WS_K = WS_Q + 33 * MiB;
constexpr size_t WS_VT = WS_K + 33 * MiB;
constexpr size_t WS_P = WS_VT + 33 * MiB;
constexpr size_t WS_PROJ1 = WS_Q;
constexpr size_t WS_CAT = WS_P + 33 * MiB;
constexpr size_t WS_PD = WS_CAT + 66 * MiB;
constexpr size_t WS_H = WS_PD + 33 * MiB;
constexpr size_t WS_Y = WS_H + 49 * MiB;
constexpr size_t WS_GT = WS_Y + 132 * MiB;
constexpr size_t WS_KT = WS_GT + 192 * MiB;
constexpr size_t WS_YD = WS_KT + 128 * MiB;
constexpr size_t WS_MISC = WS_YD + 128 * MiB;
constexpr size_t WS_MOD = WS_MISC;
constexpr size_t WS_ADAP = WS_MOD + 1 * MiB;
constexpr size_t WS_ROPE = WS_ADAP + 10 * MiB;
constexpr size_t WS_NORMP = WS_ROPE + 1 * MiB;
constexpr size_t WS_INVN = WS_NORMP + 4 * MiB;
constexpr size_t WS_S5LAM = WS_INVN + 1 * MiB;
constexpr size_t WS_S5B = WS_S5LAM + 1 * MiB;
constexpr size_t WS_WRT = WS_S5B + 2 * MiB;
constexpr size_t WS_TOKL = WS_WRT + 2 * MiB;
constexpr size_t WS_GATEL = WS_TOKL + 9 * MiB;
constexpr size_t WS_TW = WS_GATEL + 9 * MiB;
constexpr size_t WS_FFTW = WS_TW + 1 * MiB;
constexpr size_t WS_S5L256 = WS_FFTW + 32 * MiB;
constexpr size_t WS_S5E = WS_S5L256 + 1 * MiB;
constexpr size_t WS_YHT = WS_S5E + 4 * MiB;
constexpr size_t WS_S5L16 = WS_YHT + 64 * MiB;
constexpr size_t WS_S5W1 = WS_S5L16 + 1 * MiB;
constexpr size_t WS_S5W3 = WS_S5W1 + 8 * MiB;
constexpr size_t WS_S5KT = WS_S5W3 + 8 * MiB;
constexpr size_t WS_END = WS_S5KT + 2 * MiB;
static_assert(WS_END <= 2040 * MiB, "d_ws map");
constexpr int CW_BAR = 1024;
constexpr int CW_CNT = 8192;

constexpr int LDS_PHASE = 131072;
constexpr int LDS_CTL = 147456 - 2048;
constexpr int LDS_BYTES = 147456;

#define XB_TMO      128
#define XB_XCNT(j)  (256  + 64 * (j))
#define XB_XSUB(j)  (1280 + 64 * (j))
#define XB_XGEN(j)  (2304 + 64 * (j))
#define XB_TOP      3328
#define XB_TOPGEN   3392
#define XCD_BAR_WORDS 3456
#define XB_SPIN_CAP (1u << 22)

__device__ __forceinline__ unsigned xb_ld(unsigned* p)              { return __hip_atomic_load(p, __ATOMIC_RELAXED, __HIP_MEMORY_SCOPE_AGENT); }
__device__ __forceinline__ unsigned xb_add(unsigned* p, unsigned v) { return __hip_atomic_fetch_add(p, v, __ATOMIC_RELAXED, __HIP_MEMORY_SCOPE_AGENT); }
__device__ __forceinline__ unsigned xb_xcc_id() { return (unsigned)__builtin_amdgcn_s_getreg((3 << 11) | 20) & 0xFu; }
#define XB_SPIN(cond, bar) do { unsigned _sp = 0; while (cond) { __builtin_amdgcn_s_sleep(1); \
    if ((++_sp & 255u) == 0u) { if (xb_ld(&(bar)[XB_TMO])) break; if (_sp > XB_SPIN_CAP) { atomicAdd(&(bar)[XB_TMO], 1u); break; } } } } while (0)

struct XcdBarrier { unsigned* bar; unsigned x; volatile LAS unsigned* st; };

__device__ __forceinline__ XcdBarrier xcd_barrier_post(unsigned* bar, volatile LAS unsigned* st) {
    XcdBarrier b; b.bar = bar; b.x = xb_xcc_id(); b.st = st;
    if (threadIdx.x == 0) (void)xb_add(&bar[XB_XCNT(b.x)], 1u);
    return b;
}
__device__ __forceinline__ void xcd_barrier_complete(unsigned* bar, unsigned x, unsigned& nloc, unsigned& nx) {
    const unsigned G = gridDim.x * gridDim.y * gridDim.z;
    unsigned sum, cnt, mine, sp = 0u;
    for (;;) {
        sum = 0u; cnt = 0u; mine = 0u;
#pragma unroll
        for (unsigned j = 0; j < 16; ++j) { const unsigned c = xb_ld(&bar[XB_XCNT(j)]); sum += c; cnt += (c > 0u) ? 1u : 0u; mine = (j == x) ? c : mine; }
        if (sum == G) break;
        __builtin_amdgcn_s_sleep(1);
        if ((++sp & 255u) == 0u) { if (xb_ld(&bar[XB_TMO])) break; if (sp > XB_SPIN_CAP) { atomicAdd(&bar[XB_TMO], 1u); break; } }
    }
    nloc = mine > 0u ? mine : 1u; nx = cnt > 0u ? cnt : 1u;
}
__device__ __forceinline__ void xcd_barrier(const XcdBarrier& b) {
    asm volatile("s_waitcnt vmcnt(0)" ::: "memory");
    __syncthreads();
    if (threadIdx.x == 0) {
        unsigned* bar = b.bar;
        __builtin_amdgcn_s_waitcnt(0);
        unsigned nloc = b.st[0], nx = b.st[1];
        if (nloc == 0u) { xcd_barrier_complete(bar, b.x, nloc, nx); b.st[0] = nloc; b.st[1] = nx; }
        const unsigned old = xb_add(&bar[XB_XSUB(b.x)], 1u);
        const unsigned gen = old / nloc;
        if (old + 1u == (gen + 1u) * nloc) {
            __builtin_amdgcn_fence(__ATOMIC_RELEASE, "agent");
            asm volatile("s_waitcnt vmcnt(0)" ::: "memory");
            const unsigned og = xb_add(&bar[XB_TOP], 1u);
            const unsigned tg = og / nx;
            if (og + 1u == (tg + 1u) * nx) xb_add(&bar[XB_TOPGEN], 1u);
            else XB_SPIN(xb_ld(&bar[XB_TOPGEN]) == tg, bar);
            __builtin_amdgcn_fence(__ATOMIC_ACQUIRE, "agent");
            xb_add(&bar[XB_XGEN(b.x)], 1u);
            asm volatile("s_waitcnt vmcnt(0)" ::: "memory");
        } else {
            XB_SPIN(xb_ld(&bar[XB_XGEN(b.x)]) == gen, bar);
            __builtin_amdgcn_fence(__ATOMIC_ACQUIRE, "agent");
            asm volatile("s_waitcnt vmcnt(0)" ::: "memory");
        }
    }
    __syncthreads();
}

__device__ __forceinline__ void sincos_2pi(double x, double& s, double& c) {
    const double q = __builtin_rint(x * 4.0);
    const double y = (x - q * 0.25) * 6.283185307179586476925;
    const double y2 = y * y;
    double sp = -7.6471637318198164759e-13; sp = sp * y2 + 1.6059043836821614599e-10; sp = sp * y2 - 2.5052108385441718775e-8; sp = sp * y2 + 2.7557319223985890653e-6;
    sp = sp * y2 - 1.9841269841269841270e-4; sp = sp * y2 + 8.3333333333333333333e-3; sp = sp * y2 - 1.6666666666666666667e-1; sp = sp * y2 * y + y;
    double cp = 4.7794773323873852974e-14; cp = cp * y2 - 1.1470745597729724714e-11; cp = cp * y2 + 2.0876756987868098979e-9; cp = cp * y2 - 2.7557319223985890653e-7;
    cp = cp * y2 + 2.4801587301587301587e-5; cp = cp * y2 - 1.3888888888888888889e-3; cp = cp * y2 + 4.1666666666666666667e-2; cp = cp * y2 - 0.5; cp = cp * y2 + 1.0;
    const int qi = ((int)q) & 3;
    s = (qi == 0) ? sp : (qi == 1) ? cp : (qi == 2) ? -sp : -cp;
    c = (qi == 0) ? cp : (qi == 1) ? -sp : (qi == 2) ? -cp : sp;
}
__device__ __forceinline__ void sincos_rad(double a, double& s, double& c) {
    double f = a * 0.15915494309189533576888; f -= __builtin_floor(f);
    if (f >= 1.0) f = 0.0;
    sincos_2pi(f, s, c);
}
__device__ __forceinline__ double exp_small(double x) {
    double r = 1.0 / 479001600.0;
    r = r * x + 1.0 / 39916800.0; r = r * x + 1.0 / 3628800.0; r = r * x + 1.0 / 362880.0; r = r * x + 1.0 / 40320.0; r = r * x + 1.0 / 5040.0;
    r = r * x + 1.0 / 720.0; r = r * x + 1.0 / 120.0; r = r * x + 1.0 / 24.0; r = r * x + 1.0 / 6.0; r = r * x + 0.5; r = r * x + 1.0; r = r * x + 1.0;
    return r;
}
__device__ __forceinline__ float fast_exp(float x) { return __builtin_amdgcn_exp2f(x * 1.4426950408889634f); }
__device__ __forceinline__ float sigmoidf_(float x) { return 1.0f / (1.0f + fast_exp(-x)); }
__device__ __forceinline__ float siluf_(float x) { return x * sigmoidf_(x); }
__device__ __forceinline__ float tanhf_(float x) { const float e = fast_exp(-2.0f * fabsf(x)); const float t = (1.0f - e) / (1.0f + e); return x < 0.f ? -t : t; }
__device__ __forceinline__ float gelu_tanh(float x) { return 0.5f * x * (1.0f + tanhf_(0.7978845608028654f * (x + 0.044715f * x * x * x))); }

#ifndef PH_REPEAT
#define PH_REPEAT 0u
#endif
struct Args { const float* in[43]; float* out; unsigned char* ws; int ph_lo, ph_hi; };

struct Frame {
    LAS unsigned char* lds; unsigned char* ws; int tid, lane, wave, bid, G, gw, NGW;
    const __attribute__((address_space(4))) unsigned long long* kin;
};
#define INP(i) ((const float*)F.kin[i])
#define WSP(T, off) ((T*)(F.ws + (off)))

__device__ __forceinline__ void tr_item(const float* W, int ldw, int N, bf16* WT, int ldt, int row_off, int rs16, LAS float* scr, int item, int lane) {
    const int nblk = N / 64, kb = item / nblk, nb = item % nblk, k0 = 64 * kb, n0 = 64 * nb;
    const int la = lane & 15, lb = lane >> 4;
    f32x4 v[16];
#pragma unroll
    for (int i = 0; i < 16; ++i) v[i] = *(const f32x4*)(W + (size_t)(k0 + 4 * i + lb) * ldw + n0 + 4 * la);
#pragma unroll
    for (int i = 0; i < 16; ++i) { const int kk = 4 * i + lb; LAS float* d = scr + (4 * la) * 65 + kk; d[0] = v[i].x; d[65] = v[i].y; d[130] = v[i].z; d[195] = v[i].w; }
    LDS_WAIT(); asm volatile("" ::: "memory");
    const int c = lane & 7;
#pragma unroll
    for (int j = 0; j < 8; ++j) { const int n = (lane >> 3) + 8 * j; const LAS float* s = scr + n * 65 + 8 * c;
        v4u o; o.x = cvt_pk_bf16(s[0], s[1]); o.y = cvt_pk_bf16(s[2], s[3]); o.z = cvt_pk_bf16(s[4], s[5]); o.w = cvt_pk_bf16(s[6], s[7]);
        const int nn = n0 + n, drow = row_off + (nn >> 4) * rs16 + (nn & 15);
        *(v4u*)(WT + (size_t)drow * ldt + k0 + 8 * c) = o; }
    LDS_WAIT(); asm volatile("" ::: "memory");
}

__device__ __forceinline__ void hyfilt_item(Frame& F, int pb) {
    const float* w1 = INP(19); const float* b1 = INP(20); const float* fq = INP(21); const float* w2 = INP(22); const float* b2 = INP(23); const float* w3 = INP(24);
    LAS float* z = (LAS float*)F.lds;
    LAS float* h1 = z + 1088;
    LAS float* h2 = h1 + 2048;
    const int tid = F.tid;
    for (int idx = tid; idx < 32 * 33; idx += NTHREADS) {
        const int p = idx / 33, f = idx % 33, i = pb * 32 + p;
        float v;
        if (f == 0) v = (float)i * (1.0f / (float)(SEQ - 1));
        else { const int j = (f - 1) & 15; const float fj = 1e-4f + (float)j * ((15.0f - 1e-4f) / 15.0f);
            double fr = (double)fj * (double)i / (double)SEQ; fr -= __builtin_floor(fr); double s, c; sincos_2pi(fr, s, c); v = (f <= 16) ? (float)c : (float)(-s); }
        z[p * 33 + f] = v;
    }
    __syncthreads();
    for (int idx = tid; idx < 2048; idx += NTHREADS) {
        const int p = idx >> 6, j = idx & 63; float a = b1[j];
        for (int f = 0; f < 33; ++f) a += z[p * 33 + f] * w1[f * 64 + j];
        double s, c; sincos_rad((double)(fq[j] * a), s, c); h1[idx] = (float)s;
    }
    __syncthreads();
    for (int idx = tid; idx < 2048; idx += NTHREADS) {
        const int p = idx >> 6, j = idx & 63; float a = b2[j];
        for (int k = 0; k < 64; ++k) a += h1[p * 64 + k] * w2[k * 64 + j];
        double s, c; sincos_rad((double)(fq[64 + j] * a), s, c); h2[idx] = (float)s;
    }
    __syncthreads();
    float* kT = WSP(float, WS_KT); float* normp = WSP(float, WS_NORMP);
    {
        const int lane = F.lane, l31 = lane & 31, lh = lane >> 5;
        float af[32];
#pragma unroll
        for (int s = 0; s < 32; ++s) af[s] = h2[l31 * 64 + 2 * s + lh];
        for (int ct = F.wave; ct < 128; ct += NWAVES) {
            const int col = ct * 32 + l31;
            f32x16 acc;
#pragma unroll
            for (int r = 0; r < 16; ++r) acc[r] = 0.f;
            float bv[32];
#pragma unroll
            for (int s = 0; s < 32; ++s) bv[s] = w3[(size_t)(2 * s + lh) * 4096 + col];
#pragma unroll
            for (int s = 0; s < 32; ++s) acc = __builtin_amdgcn_mfma_f32_32x32x2f32(af[s], bv[s], acc, 0, 0, 0);
#pragma unroll
            for (int s = 0; s < 32; s += 8) asm volatile("" : "+v"(acc) : "v"(bv[s]), "v"(bv[s + 1]), "v"(bv[s + 2]), "v"(bv[s + 3]), "v"(bv[s + 4]), "v"(bv[s + 5]), "v"(bv[s + 6]), "v"(bv[s + 7]));
            const int ch = col & 1023, dir = (col >> 10) & 1;
            const float adel = 3.0701134573253946f + (float)ch * ((15.350567286626972f - 3.0701134573253946f) / 1023.0f);
            float sabs = 0.f;
#pragma unroll
            for (int r = 0; r < 16; ++r) { const int i = pb * 32 + (r & 3) + 8 * (r >> 2) + 4 * lh; const float t = (float)i * (1.0f / (float)(SEQ - 1)); acc[r] *= fast_exp(-t * adel); if (!(dir == 1 && i == 0)) sabs += fabsf(acc[r]); }
            sabs += __shfl_xor(sabs, 32);
#pragma unroll
            for (int q = 0; q < 4; ++q) *(f32x4*)(kT + (size_t)col * SEQ + pb * 32 + 8 * q + 4 * lh) = (f32x4){acc[4 * q], acc[4 * q + 1], acc[4 * q + 2], acc[4 * q + 3]};
            if (lh == 0) normp[(size_t)pb * 4096 + col] = sabs;
        }
    }
    __syncthreads();
}

__device__ __forceinline__ void tr_wg_item(Frame& F, const float* W, int ldw, bf16* WT, int ldt, int row_off, int rs16, int k0, int n0) {
    LAS float* T = (LAS float*)F.lds;
    const int t = F.tid;
    f32x4 v[16];
#pragma unroll
    for (int i = 0; i < 16; ++i) v[i] = *(const f32x4*)(W + (size_t)(k0 + 4 * i + (t >> 7)) * ldw + n0 + 4 * (t & 127));
#pragma unroll
    for (int i = 0; i < 16; ++i) { const int k = 4 * i + (t >> 7); *(LAS f32x4*)(T + k * 516 + ((4 * (t & 127) + 8 * (k >> 3)) & 511)) = v[i]; }
    __syncthreads();
    const int c = (t >> 3) & 7, nl = (t & 7) | ((t >> 6) << 3);
#pragma unroll
    for (int q = 0; q < 8; ++q) { const int n = 64 * q + nl; const LAS float* s = T + (8 * c) * 516 + ((n + 8 * c) & 511);
        v4u o; o.x = cvt_pk_bf16(s[0], s[516]); o.y = cvt_pk_bf16(s[2 * 516], s[3 * 516]); o.z = cvt_pk_bf16(s[4 * 516], s[5 * 516]); o.w = cvt_pk_bf16(s[6 * 516], s[7 * 516]);
        const int nn = n0 + n, drow = row_off + (nn >> 4) * rs16 + (nn & 15);
        *(v4u*)(WT + (size_t)drow * ldt + k0 + 8 * c) = o; }
    __syncthreads();
}

__device__ __forceinline__ void p0_prologue(Frame& F) {
    for (int rep = 0; rep < (((PH_REPEAT >> 25) & 1u) ? 2 : 1); ++rep)
    for (int pb = F.bid; pb < SEQ / 32; pb += F.G) hyfilt_item(F, pb);
    for (int rep = 0; rep < (((PH_REPEAT >> 24) & 1u) ? 2 : 1); ++rep)
    for (int it = F.bid; it < 128 * 96; it += F.G) {
        const int le = it / 96, q = it % 96;
        bf16* wc = (bf16*)(F.ws + WS_WMOE + (size_t)le * MOE_E_BYTES); bf16* w2t = wc + 1024 * 2048;
        if (q < 32) tr_wg_item(F, INP(40) + (size_t)le * (2048 * 512), 512, wc, 2048, 0, 32, 64 * q, 0);
        else if (q < 64) tr_wg_item(F, INP(41) + (size_t)le * (2048 * 512), 512, wc, 2048, 16, 32, 64 * (q - 32), 0);
        else { const int r = q - 64; tr_wg_item(F, INP(42) + (size_t)le * (512 * 2048), 2048, w2t, 512, 0, 16, 64 * (r >> 2), 512 * (r & 3)); }
    }
    const int gt = F.bid * NTHREADS + F.tid, NGT = F.G * NTHREADS;
    {
        f32x2* rope = WSP(f32x2, WS_ROPE);
        for (int idx = gt; idx < 128 * 16; idx += NGT) { const int pos = idx >> 4, i = idx & 15;
            double inv = (i & 3) == 0 ? 1.0 : (i & 3) == 1 ? 0.56234132519034908 : (i & 3) == 2 ? 0.31622776601683794 : 0.17782794100389228;
            inv *= (i >> 2) == 0 ? 1.0 : (i >> 2) == 1 ? 0.1 : (i >> 2) == 2 ? 0.01 : 0.001;
            const float ang = (float)pos * (float)inv; double s, c; sincos_rad((double)ang, s, c); rope[idx] = (f32x2){(float)c, (float)s}; }
    }
    {
        f32x2* tw = WSP(f32x2, WS_TW);
        for (int idx = gt; idx < 16384; idx += NGT) { double s, c; sincos_2pi((double)idx * (1.0 / 16384.0), s, c); tw[idx] = (f32x2){(float)c, (float)(-s)}; }
    }
    {
        const float* are = INP(26); const float* aim = INP(27); const float* ldt = INP(28); const float* bre = INP(29); const float* bim = INP(30);
        f32x2* lamb = WSP(f32x2, WS_S5LAM); f32x2* bb = WSP(f32x2, WS_S5B); f32x2* l256 = WSP(f32x2, WS_S5L256);
        for (int idx = gt; idx < 2 * 64 * 64; idx += NGT) { const int dg = idx >> 6;
            const float dt = expf(ldt[dg]); const float ar = are[idx], ai = aim[idx];
            const float zr = ar * dt, zi = ai * dt; double s, c; sincos_rad((double)zi, s, c); const double er = exp_small((double)zr);
            const double lr = er * c, li = er * s; lamb[idx] = (f32x2){(float)lr, (float)li};
            { double pr = lr, pi = li; for (int q = 0; q < 8; ++q) { const double tr = pr * pr - pi * pi, ti = 2.0 * pr * pi; pr = tr; pi = ti; } l256[idx] = (f32x2){(float)pr, (float)pi}; }
            const double nr = lr - 1.0, ni = li, den = (double)ar * ar + (double)ai * ai; const double qr = (nr * ar + ni * ai) / den, qi = (ni * ar - nr * ai) / den;
            for (int cc = 0; cc < 16; ++cc) { const double br = bre[(size_t)idx * 16 + cc], bi = bim[(size_t)idx * 16 + cc]; bb[(size_t)idx * 16 + cc] = (f32x2){(float)(qr * br - qi * bi), (float)(qr * bi + qi * br)}; } }
    }
    {
        float* wrt = WSP(float, WS_WRT);
        for (int idx = gt; idx < 2 * 72 * 2048; idx += NGT) { const int l = idx / (72 * 2048), r = idx % (72 * 2048), n = r / 2048, k = r % 2048;
            wrt[idx] = n < 8 ? INP(36)[((size_t)l * 2048 + k) * 8 + n] : INP(38)[((size_t)l * 2048 + k) * 64 + (n - 8)]; }
    }
    {
        bf16* ha = WSP(bf16, WS_HA);
        for (int idx = gt; idx < 2048; idx += NGT) ha[(size_t)TT * 2048 + idx] = 0;
    }
    LAS float* scr = (LAS float*)(F.lds + F.wave * 16896);
    {
        const float* c = INP(1); const float* cctx = INP(3); const float* adaw = INP(4); float* part = WSP(float, WS_ADAP);
        for (int rep = 0; rep < (((PH_REPEAT >> 26) & 1u) ? 2 : 1); ++rep)
        for (int it = F.gw; it < 2 * 32 * 48; it += F.NGW) {
            const int l = it / (32 * 48), r = it % (32 * 48), ks = r / 48, jb = r % 48, k0 = ks * 64, j0 = jb * 256 + F.lane * 4;
            const float c0 = c[k0 + F.lane], c1 = c[2048 + k0 + F.lane], c2 = cctx[k0 + F.lane];
            const float s0 = c0 / (1.0f + expf(-c0)), s1 = c1 / (1.0f + expf(-c1)), s2 = c2 / (1.0f + expf(-c2));
            f32x4 a0 = {0.f, 0.f, 0.f, 0.f}, a1 = a0, a2 = a0;
            const float* wp = adaw + ((size_t)l * 2048 + k0) * 12288 + j0;
#pragma unroll 8
            for (int kk = 0; kk < 64; ++kk) { const f32x4 w = *(const f32x4*)(wp + (size_t)kk * 12288);
                const float t0 = __builtin_bit_cast(float, __builtin_amdgcn_readlane(__builtin_bit_cast(int, s0), kk));
                const float t1 = __builtin_bit_cast(float, __builtin_amdgcn_readlane(__builtin_bit_cast(int, s1), kk));
                const float t2 = __builtin_bit_cast(float, __builtin_amdgcn_readlane(__builtin_bit_cast(int, s2), kk));
                a0 += w * t0; a1 += w * t1; a2 += w * t2; }
            float* pp = part + ((size_t)(l * 32 + ks) * 3) * 12288 + j0;
            *(f32x4*)(pp) = a0; *(f32x4*)(pp + 12288) = a1; *(f32x4*)(pp + 2 * 12288) = a2;
        }
    }
    {
        constexpr int I0 = 1024, I1 = 512, I2 = 512, I3 = 1024, I4 = 2048, I5 = 1024, I6 = 64, I7 = 256, IE = 768;
        constexpr int NSMALL = I0 + I1 + I2 + I3 + I4 + I5 + I6 + I7;
        const int NITEMS = NSMALL;
        for (int rep = 0; rep < (((PH_REPEAT >> 27) & 1u) ? 2 : 1); ++rep)
        for (int it = F.gw; it < NITEMS; it += F.NGW) {
            int r = it;
            if (r < I0) { tr_item(INP(9), 4096, 2048, WSP(bf16, WS_WIN0), 2048, 0, 16, scr, r, F.lane); continue; } r -= I0;
            if (r < I1) { tr_item(INP(9) + 2048, 4096, 1024, WSP(bf16, WS_WIN0), 2048, 3072, 16, scr, r, F.lane); continue; } r -= I1;
            if (r < I2) { tr_item(INP(9) + 3072, 4096, 1024, WSP(bf16, WS_WIN0), 2048, 2048, 16, scr, r, F.lane); continue; } r -= I2;
            if (r < I3) { tr_item(INP(10), 2048, 2048, WSP(bf16, WS_WOUT0), 2048, 0, 16, scr, r, F.lane); continue; } r -= I3;
            if (r < I4) { tr_item(INP(15), 4096, 4096, WSP(bf16, WS_WIN1), 2048, 0, 16, scr, r, F.lane); continue; } r -= I4;
            if (r < I5) { tr_item(INP(16), 2048, 2048, WSP(bf16, WS_WOUT1), 2048, 0, 16, scr, r, F.lane); continue; } r -= I5;
            if (r < I6) { const int g = r / 16; tr_item(INP(13) + (size_t)g * 65536, 256, 256, WSP(bf16, WS_WPOOL), 256, g * 256, 16, scr, r % 16, F.lane); continue; } r -= I6;
            if (r < I7) { tr_item(INP(34), 1024, 1024, WSP(bf16, WS_WGLU), 1024, 0, 16, scr, r, F.lane); continue; } r -= I7;
        }
    }
}

__device__ __forceinline__ void p1_reduce(Frame& F) {
    const int gt = F.bid * NTHREADS + F.tid, NGT = F.G * NTHREADS;
    const float* part = WSP(float, WS_ADAP); float* mod = WSP(float, WS_MOD); const float* adab = INP(5);
    for (int idx = gt; idx < 2 * 3 * 12288; idx += NGT) { const int l = idx / (3 * 12288), r = idx % (3 * 12288), m = r / 12288, j = r % 12288;
        float a = adab[l * 12288 + j];
        for (int ks = 0; ks < 32; ++ks) a += part[((size_t)(l * 32 + ks) * 3 + m) * 12288 + j];
        mod[idx] = a; }
    const float* normp = WSP(float, WS_NORMP); float* invn = WSP(float, WS_INVN);
    for (int idx = gt; idx < 2048; idx += NGT) { const int o = idx >> 10, ch = idx & 1023; float a = 0.f;
        for (int pb = 0; pb < 256; ++pb) a += normp[(size_t)pb * 4096 + o * 2048 + ch] + normp[(size_t)pb * 4096 + o * 2048 + 1024 + ch];
        invn[idx] = 1.0f / a; }
    {
        const f32x2* lamb = WSP(f32x2, WS_S5LAM); const f32x2* bbar = WSP(f32x2, WS_S5B); const float* cre = INP(31); const float* cim = INP(32);
        bf16* W1 = WSP(bf16, WS_S5W1); bf16* W3 = WSP(bf16, WS_S5W3); bf16* KT = WSP(bf16, WS_S5KT); f32x2* l16 = WSP(f32x2, WS_S5L16);
#define S5_POWF(l_, e_, pw_) do { pw_ = (f32x2){1.f, 0.f}; f32x2 b_ = l_; for (int q_ = (e_); q_ > 0; q_ >>= 1) { if (q_ & 1) pw_ = (f32x2){pw_.x * b_.x - pw_.y * b_.y, pw_.x * b_.y + pw_.y * b_.x}; b_ = (f32x2){b_.x * b_.x - b_.y * b_.y, 2.f * b_.x * b_.y}; } } while (0)
        for (int idx = gt; idx < 128 * 64; idx += NGT) { f32x2 pw; S5_POWF(lamb[idx], 16, pw); l16[idx] = pw; }
        for (int idx = gt; idx < 128 * 128 * 32; idx += NGT) {
            const int k8 = idx & 31, n = (idx >> 5) & 127, dg = idx >> 12, sigma = k8 >> 1, h = k8 & 1, p = (n & 15) + 16 * ((n >> 4) & 3), im = n >> 6;
            f32x2 pw; S5_POWF(lamb[dg * 64 + p], 15 - sigma, pw);
            const f32x4* bp = (const f32x4*)(bbar + ((size_t)dg * 64 + p) * 16 + 8 * h); float o[8];
#pragma unroll
            for (int j = 0; j < 4; ++j) { const f32x4 q = bp[j]; o[2 * j] = im ? (pw.x * q.y + pw.y * q.x) : (pw.x * q.x - pw.y * q.y); o[2 * j + 1] = im ? (pw.x * q.w + pw.y * q.z) : (pw.x * q.z - pw.y * q.w); }
            v4u w; w.x = pk2(o[0], o[1]); w.y = pk2(o[2], o[3]); w.z = pk2(o[4], o[5]); w.w = pk2(o[6], o[7]);
            *(v4u*)(W1 + (size_t)idx * 8) = w; }
        for (int idx = gt; idx < 128 * 256 * 16; idx += NGT) {
            const int k8 = idx & 15, n = (idx >> 4) & 255, dg = idx >> 12, tau = n >> 4, cout = n & 15; float o[8];
#pragma unroll
            for (int j = 0; j < 4; ++j) { const int p = 4 * k8 + j; f32x2 pw; S5_POWF(lamb[dg * 64 + p], tau + 1, pw);
                const float cr = cre[((size_t)dg * 16 + cout) * 64 + p], ci = cim[((size_t)dg * 16 + cout) * 64 + p]; o[2 * j] = cr * pw.x - ci * pw.y; o[2 * j + 1] = -(cr * pw.y + ci * pw.x); }
            v4u w; w.x = pk2(o[0], o[1]); w.y = pk2(o[2], o[3]); w.z = pk2(o[4], o[5]); w.w = pk2(o[6], o[7]);
            *(v4u*)(W3 + (size_t)idx * 8) = w; }
        for (int idx = gt; idx < 128 * 17 * 16 * 2; idx += NGT) {
            const int h = idx & 1, cout = (idx >> 1) & 15, d1 = (idx >> 5) % 17, dg = (idx >> 5) / 17;
            float acc[8];
#pragma unroll
            for (int j = 0; j < 8; ++j) acc[j] = 0.f;
            if (d1 > 0) { for (int p = 0; p < 64; ++p) { f32x2 pw; S5_POWF(lamb[dg * 64 + p], d1 - 1, pw);
                const float cr = cre[((size_t)dg * 16 + cout) * 64 + p], ci = cim[((size_t)dg * 16 + cout) * 64 + p]; const float gr = cr * pw.x - ci * pw.y, gi = cr * pw.y + ci * pw.x;
                const f32x4* bp = (const f32x4*)(bbar + ((size_t)dg * 64 + p) * 16 + 8 * h);
#pragma unroll
                for (int j = 0; j < 4; ++j) { const f32x4 q = bp[j]; acc[2 * j] += gr * q.x - gi * q.y; acc[2 * j + 1] += gr * q.z - gi * q.w; } } }
            v4u w; w.x = pk2(acc[0], acc[1]); w.y = pk2(acc[2], acc[3]); w.z = pk2(acc[4], acc[5]); w.w = pk2(acc[6], acc[7]);
            *(v4u*)(KT + (size_t)idx * 8) = w; }
#undef S5_POWF
    }
}

__device__ __forceinline__ const float* modp(Frame& F, int l, int m, int c) { return WSP(float, WS_MOD) + ((size_t)(l * 3 + m) * 6 + c) * 2048; }
__device__ __forceinline__ int row_stream(int r) { return r < TL ? r / SEQ : 2; }

template <int MODE>
__device__ __forceinline__ void norm_phase(Frame& F, int l, float* dout) {
    const int nrows = (MODE == 3 || (MODE == 1 && l == 1)) ? TL : TT;
    float* xbuf = WSP(float, WS_X); bf16* ha = WSP(bf16, WS_HA); const bf16* Y = WSP(bf16, WS_Y);
    const float* gvec = (MODE == 0) ? INP(6) : (MODE == 1) ? INP(7) + l * 2048 : (MODE == 2) ? INP(6) + 2048 : INP(8);
    const int lane = F.lane;
    for (int r = F.gw; r < nrows; r += F.NGW) {
        const int m = row_stream(r);
        const float* src = (MODE == 0) ? (r < TL ? INP(0) + (size_t)r * 2048 : INP(2) + (size_t)(r - TL) * 2048) : xbuf + (size_t)r * 2048;
        f32x4 v[8]; float ss = 0.f;
#pragma unroll
        for (int j = 0; j < 8; ++j) v[j] = *(const f32x4*)(src + 4 * lane + 256 * j);
        if (MODE == 2 || MODE == 3) {
            const float* g2 = modp(F, MODE == 2 ? 0 : 1, m, 5);
            const bf16* y0 = Y + (size_t)(2 * r) * 2048; const bf16* y1 = y0 + 2048;
#pragma unroll
            for (int j = 0; j < 8; ++j) { const int c = 4 * lane + 256 * j; const v2u a = *(const v2u*)(y0 + c), b = *(const v2u*)(y1 + c); const f32x4 gg = *(const f32x4*)(g2 + c);
                v[j].x += gg.x * (bflo(a.x) + bflo(b.x)); v[j].y += gg.y * (bfhi(a.x) + bfhi(b.x)); v[j].z += gg.z * (bflo(a.y) + bflo(b.y)); v[j].w += gg.w * (bfhi(a.y) + bfhi(b.y)); }
            if (MODE == 2) {
#pragma unroll
                for (int j = 0; j < 8; ++j) *(f32x4*)(xbuf + (size_t)r * 2048 + 4 * lane + 256 * j) = v[j];
            }
        }
#pragma unroll
        for (int j = 0; j < 8; ++j) ss += (v[j].x * v[j].x + v[j].y * v[j].y) + (v[j].z * v[j].z + v[j].w * v[j].w);
        ss = wave_sum(ss);
        const float rs = 1.0f / sqrtf(ss * (1.0f / 2048.0f) + EPS);
        if (MODE == 3) {
#pragma unroll
            for (int j = 0; j < 8; ++j) { const int c = 4 * lane + 256 * j; const f32x4 gg = *(const f32x4*)(gvec + c); *(f32x4*)(dout + (size_t)r * 2048 + c) = v[j] * rs * gg; }
            continue;
        }
        const int lm = (MODE == 2) ? 1 : l;
        const float* sh = modp(F, lm, m, MODE == 1 ? 3 : 0); const float* sc = modp(F, lm, m, MODE == 1 ? 4 : 1);
#pragma unroll
        for (int j = 0; j < 8; ++j) { const int c = 4 * lane + 256 * j; const f32x4 gg = *(const f32x4*)(gvec + c), s1 = *(const f32x4*)(sc + c), s0 = *(const f32x4*)(sh + c);
            v[j] = (v[j] * rs * gg) * (1.0f + s1) + s0;
            v2u o; o.x = pk2(v[j].x, v[j].y); o.y = pk2(v[j].z, v[j].w); *(v2u*)(ha + (size_t)r * 2048 + c) = o; }
    }
}

__device__ __forceinline__ void ffn_norm_router_phase(Frame& F, int l) {
    const int nrows = (l == 1) ? TL : TT;
    const float* xbuf = WSP(float, WS_X); bf16* ha = WSP(bf16, WS_HA);
    const float* gvec = INP(7) + l * 2048;
    const float* wrt = WSP(float, WS_WRT) + (size_t)l * 72 * 2048;
    LAS float* wl = (LAS float*)F.lds;
    LAS float* lg = (LAS float*)(F.lds + 131072 + F.wave * 1536);
    const int lane = F.lane, tid = F.tid;
    for (int it = F.bid; it < nrows / 32; it += F.G) {
        const int r0 = it * 32 + F.wave * 4;
#define RT_DMA(q_, buf_) do { _Pragma("unroll") for (int _i = 0; _i < 8; ++_i) \
            __builtin_amdgcn_global_load_lds((const unsigned*)(wrt + (size_t)(q_) * 16384 + (size_t)(F.wave * 8 + _i) * 256 + lane * 4), (LAS unsigned*)(wl + (buf_) * 16384 + (F.wave * 8 + _i) * 256), 16, 0, 0); } while (0)
        RT_DMA(0, 0);
        f32x4 v[4][8];
#pragma unroll
        for (int rr = 0; rr < 4; ++rr) {
            const int r = r0 + rr, m = row_stream(r);
            const float* src = xbuf + (size_t)r * 2048; float ss = 0.f;
#pragma unroll
            for (int j = 0; j < 8; ++j) { v[rr][j] = *(const f32x4*)(src + 4 * lane + 256 * j); ss += (v[rr][j].x * v[rr][j].x + v[rr][j].y * v[rr][j].y) + (v[rr][j].z * v[rr][j].z + v[rr][j].w * v[rr][j].w); }
            ss = wave_sum(ss);
            const float rs = 1.0f / sqrtf(ss * (1.0f / 2048.0f) + EPS);
            const float* sh = modp(F, l, m, 3); const float* sc = modp(F, l, m, 4);
#pragma unroll
            for (int j = 0; j < 8; ++j) { const int c = 4 * lane + 256 * j; const f32x4 gg = *(const f32x4*)(gvec + c), s1 = *(const f32x4*)(sc + c), s0 = *(const f32x4*)(sh + c);
                v[rr][j] = (v[rr][j] * rs * gg) * (1.0f + s1) + s0;
                v2u o; o.x = cvt_pk_bf16(v[rr][j].x, v[rr][j].y); o.y = cvt_pk_bf16(v[rr][j].z, v[rr][j].w); *(v2u*)(ha + (size_t)r * 2048 + c) = o; }
        }
        asm volatile("s_waitcnt vmcnt(0)" ::: "memory");
        __syncthreads();
        const bool b5 = (lane & 32) != 0, b4 = (lane & 16) != 0, b3 = (lane & 8) != 0, b2 = (lane & 4) != 0, b1 = (lane & 2) != 0;
#pragma nounroll
        for (int q = 0; q < 9; ++q) {
            const LAS float* wq = wl + (q & 1) * 16384;
            if (q + 1 < 9) RT_DMA(q + 1, (q + 1) & 1);
            float a[32];
#pragma unroll
            for (int nn = 0; nn < 8; ++nn) { const LAS float* wn = wq + nn * 2048 + 4 * lane; float s0 = 0.f, s1 = 0.f, s2 = 0.f, s3 = 0.f;
#pragma unroll
                for (int j = 0; j < 8; ++j) { const f32x4 w = *(const LAS f32x4*)(wn + 256 * j);
                    s0 += (v[0][j].x * w.x + v[0][j].y * w.y) + (v[0][j].z * w.z + v[0][j].w * w.w); s1 += (v[1][j].x * w.x + v[1][j].y * w.y) + (v[1][j].z * w.z + v[1][j].w * w.w);
                    s2 += (v[2][j].x * w.x + v[2][j].y * w.y) + (v[2][j].z * w.z + v[2][j].w * w.w); s3 += (v[3][j].x * w.x + v[3][j].y * w.y) + (v[3][j].z * w.z + v[3][j].w * w.w); }
                a[nn] = s0; a[8 + nn] = s1; a[16 + nn] = s2; a[24 + nn] = s3; }
            float c16[16], c8[8], c4[4], c2[2], c1;
#pragma unroll
            for (int i = 0; i < 16; ++i) { const float keep = b5 ? a[i + 16] : a[i], send = b5 ? a[i] : a[i + 16]; c16[i] = keep + __shfl_xor(send, 32); }
#pragma unroll
            for (int i = 0; i < 8; ++i) { const float keep = b4 ? c16[i + 8] : c16[i], send = b4 ? c16[i] : c16[i + 8]; c8[i] = keep + __shfl_xor(send, 16); }
#pragma unroll
            for (int i = 0; i < 4; ++i) { const float keep = b3 ? c8[i + 4] : c8[i], send = b3 ? c8[i] : c8[i + 4]; c4[i] = keep + __shfl_xor(send, 8); }
#pragma unroll
            for (int i = 0; i < 2; ++i) { const float keep = b2 ? c4[i + 2] : c4[i], send = b2 ? c4[i] : c4[i + 2]; c2[i] = keep + __shfl_xor(send, 4); }
            { const float keep = b1 ? c2[1] : c2[0], send = b1 ? c2[0] : c2[1]; c1 = keep + __shfl_xor(send, 2); }
            c1 += __shfl_xor(c1, 1);
            if ((lane & 1) == 0) { const int i = lane >> 1; lg[(i >> 3) * 80 + q * 8 + (i & 7)] = c1; }
            asm volatile("s_waitcnt vmcnt(0)" ::: "memory");
            __syncthreads();
        }
#undef RT_DMA
        if (lane < 4) {
            const int r = r0 + lane; const LAS float* L = lg + lane * 80;
            float gl[8]; float gmax = -INFINITY; int gi = 0;
#pragma unroll
            for (int j = 0; j < 8; ++j) { gl[j] = L[j] + INP(37)[l * 8 + j]; if (gl[j] > gmax) { gmax = gl[j]; gi = j; } }
            float gsum = 0.f;
#pragma unroll
            for (int j = 0; j < 8; ++j) gsum += expf(gl[j] - gmax);
            const float pg_top = 1.0f / gsum;
            float pe[8]; float emax = -INFINITY;
#pragma unroll
            for (int j = 0; j < 8; ++j) { pe[j] = L[8 + gi * 8 + j] + INP(39)[l * 64 + gi * 8 + j]; emax = fmaxf(emax, pe[j]); }
            float esum = 0.f;
#pragma unroll
            for (int j = 0; j < 8; ++j) { pe[j] = expf(pe[j] - emax); esum += pe[j]; }
            int e1 = 0; float p1 = -1.f;
#pragma unroll
            for (int j = 0; j < 8; ++j) { pe[j] /= esum; if (pe[j] > p1) { p1 = pe[j]; e1 = j; } }
            int e2 = 0; float p2 = -1.f;
#pragma unroll
            for (int j = 0; j < 8; ++j) { if (j != e1 && pe[j] > p2) { p2 = pe[j]; e2 = j; } }
            const float den = p1 + p2; const float g1 = pg_top * p1 / den, g2 = pg_top * p2 / den;
            unsigned* cnt = WSP(unsigned, WS_CTL) + CW_CNT + l * 64; int* tokl = WSP(int, WS_TOKL); float* gatel = WSP(float, WS_GATEL);
            const int ex1 = gi * 8 + e1, ex2 = gi * 8 + e2;
            const unsigned k1 = atomicAdd(cnt + ex1, 1u); tokl[(size_t)ex1 * LISTCAP + k1] = 2 * r; gatel[(size_t)ex1 * LISTCAP + k1] = g1;
            const unsigned k2 = atomicAdd(cnt + ex2, 1u); tokl[(size_t)ex2 * LISTCAP + k2] = 2 * r + 1; gatel[(size_t)ex2 * LISTCAP + k2] = g2;
        }
        __syncthreads();
    }
}

#define EPI_ARGS const f32x4 (&acc)[2][2][4][2], const pg8::Unit& u, int wr, int wc, int fr, int fq
__device__ __forceinline__ void st_bf4(bf16* p, f32x4 v) { v2u o; o.x = cvt_pk_bf16(v.x, v.y); o.y = cvt_pk_bf16(v.z, v.w); *(v2u*)p = o; }

struct EpiQKP {
    bf16* Q; bf16* Kb; bf16* P; const f32x2* rope;
    __device__ __forceinline__ void operator()(EPI_ARGS) const {
        const int sect = u.pn >> 2, cb = (u.pn & 3) * 256; const bool latent = u.pm < TL / 256;
#pragma unroll
        for (int ai = 0; ai < 2; ++ai)
#pragma unroll
            for (int m = 0; m < 4; ++m) {
                const int r = u.pm * 256 + ai * 128 + wr * 64 + m * 16 + fr;
                int b, t; if (latent) { b = r / SEQ; t = r % SEQ; } else { b = (r - TL) / CTX; t = (r - TL) % CTX; }
                f32x4 cs0 = {1.f, 0.f, 1.f, 0.f}, cs1 = cs0;
                if (latent && sect < 2) { const int pos = (wc & 1) ? (t & 63) : (t >> 6); const f32x4* rp = (const f32x4*)(rope + pos * 16 + 4 * fq); cs0 = rp[0]; cs1 = rp[1]; }
#pragma unroll
                for (int bj = 0; bj < 2; ++bj) {
                    const int c0 = cb + bj * 128 + wc * 32 + 4 * fq;
                    f32x4 a = acc[ai][bj][m][0], bb = acc[ai][bj][m][1];
                    if (sect < 2) {
                        const f32x4 co = {cs0.x, cs0.z, cs1.x, cs1.z}, si = {cs0.y, cs0.w, cs1.y, cs1.w};
                        const f32x4 oa = a * co - bb * si, ob = a * si + bb * co; a = oa; bb = ob;
                    }
                    if (sect == 0) { a = a * QSCALE; bb = bb * QSCALE; bf16* d = Q + (size_t)r * 1024 + c0; st_bf4(d, a); st_bf4(d + 16, bb); }
                    else if (sect == 1) { const size_t kr = (size_t)b * KEYS + (latent ? CTX + t : t); bf16* d = Kb + kr * 1024 + c0; st_bf4(d, a); st_bf4(d + 16, bb); }
                    else { bf16* d = P + (size_t)r * 1024 + c0; st_bf4(d, a); st_bf4(d + 16, bb); }
                }
            }
    }
};
struct EpiVT {
    bf16* VT;
    __device__ __forceinline__ void operator()(EPI_ARGS) const {
        const bool latent = u.pn < TL / 256; const int b = latent ? u.pn / 32 : u.pn - TL / 256; const int key_t0 = latent ? CTX + (u.pn % 32) * 256 : 0;
        const int kperm = 8 * (fq & 1) + 4 * (fq >> 1);
#pragma unroll
        for (int ai = 0; ai < 2; ++ai)
#pragma unroll
            for (int m = 0; m < 4; ++m) {
                const int rr = u.pm * 256 + ai * 128 + wr * 64 + m * 16 + fr;
                bf16* rowp = VT + ((size_t)b * 1024 + rr) * KEYS + key_t0;
#pragma unroll
                for (int bj = 0; bj < 2; ++bj)
#pragma unroll
                    for (int n = 0; n < 2; ++n) st_bf4(rowp + bj * 128 + wc * 32 + 16 * n + kperm, acc[ai][bj][m][n]);
            }
    }
};
struct EpiScaleBf16 {
    bf16* O; int ldo, coff; const float* cscale;
    __device__ __forceinline__ void operator()(EPI_ARGS) const {
#pragma unroll
        for (int bj = 0; bj < 2; ++bj)
#pragma unroll
            for (int n = 0; n < 2; ++n) { const int c = u.pn * 256 + bj * 128 + wc * 32 + 16 * n + 4 * fq; const f32x4 sc = *(const f32x4*)(cscale + c);
#pragma unroll
                for (int ai = 0; ai < 2; ++ai)
#pragma unroll
                    for (int m = 0; m < 4; ++m) { const int r = u.pm * 256 + ai * 128 + wr * 64 + m * 16 + fr; st_bf4(O + (size_t)r * ldo + coff + c, acc[ai][bj][m][n] * sc); } }
    }
};
struct EpiBf16 {
    bf16* O; int ldo;
    __device__ __forceinline__ void operator()(EPI_ARGS) const {
#pragma unroll
        for (int ai = 0; ai < 2; ++ai)
#pragma unroll
            for (int m = 0; m < 4; ++m) { const int r = u.pm * 256 + ai * 128 + wr * 64 + m * 16 + fr; bf16* rowp = O + (size_t)r * ldo + u.pn * 256 + wc * 32 + 4 * fq;
#pragma unroll
                for (int bj = 0; bj < 2; ++bj)
#pragma unroll
                    for (int n = 0; n < 2; ++n) st_bf4(rowp + bj * 128 + 16 * n, acc[ai][bj][m][n]); }
    }
};
struct EpiRes {
    const float* xlat; const float* xctx; float* xout; const float* gate0;
    __device__ __forceinline__ void operator()(EPI_ARGS) const {
        const bool latent = u.pm < TL / 256;
#pragma unroll
        for (int ai = 0; ai < 2; ++ai)
#pragma unroll
            for (int m = 0; m < 4; ++m) { const int r = u.pm * 256 + ai * 128 + wr * 64 + m * 16 + fr; const int ms = latent ? r / SEQ : 2;
                const float* xi = latent ? xlat + (size_t)r * 2048 : xctx + (size_t)(r - TL) * 2048; const float* gp = gate0 + (size_t)ms * 12288;
#pragma unroll
                for (int bj = 0; bj < 2; ++bj)
#pragma unroll
                    for (int n = 0; n < 2; ++n) { const int c = u.pn * 256 + bj * 128 + wc * 32 + 16 * n + 4 * fq;
                        const f32x4 xv = *(const f32x4*)(xi + c), gv = *(const f32x4*)(gp + c); *(f32x4*)(xout + (size_t)r * 2048 + c) = xv + gv * acc[ai][bj][m][n]; } }
    }
};
struct EpiMoeUp {
    bf16* H;
    __device__ __forceinline__ void operator()(EPI_ARGS) const {
#pragma unroll
        for (int ai = 0; ai < 2; ++ai)
#pragma unroll
            for (int m = 0; m < 4; ++m) { const size_t r = (size_t)u.pm * 256 + ai * 128 + wr * 64 + m * 16 + fr;
#pragma unroll
                for (int bj = 0; bj < 2; ++bj) { const int hc = (u.pn * 256 + bj * 128 + wc * 32) / 2 + 4 * fq; const f32x4 a = acc[ai][bj][m][0], b = acc[ai][bj][m][1];
                    const f32x4 h = {siluf_(a.x) * b.x, siluf_(a.y) * b.y, siluf_(a.z) * b.z, siluf_(a.w) * b.w}; st_bf4(H + r * 512 + hc, h); } }
    }
};
struct EpiMoeDown {
    bf16* Y; const int* tokl; const float* gatel; const unsigned* cnt;
    __device__ __forceinline__ void operator()(EPI_ARGS) const {
        const int ce = (int)cnt[u.e];
#pragma unroll
        for (int ai = 0; ai < 2; ++ai)
#pragma unroll
            for (int m = 0; m < 4; ++m) { const int idx = u.idx0 + ai * 128 + wr * 64 + m * 16 + fr;
                if (idx < ce) { const int pair = tokl[(size_t)u.e * LISTCAP + idx]; const float gt = gatel[(size_t)u.e * LISTCAP + idx]; bf16* rowp = Y + (size_t)pair * 2048 + u.pn * 256 + wc * 32 + 4 * fq;
#pragma unroll
                    for (int bj = 0; bj < 2; ++bj)
#pragma unroll
                        for (int n = 0; n < 2; ++n) st_bf4(rowp + bj * 128 + 16 * n, acc[ai][bj][m][n] * gt); } }
    }
};
struct EpiGlu {
    bf16* O; int ldo, coff; const bf16* Gb; const float* bias;
    __device__ __forceinline__ void operator()(EPI_ARGS) const {
#pragma unroll
        for (int ai = 0; ai < 2; ++ai)
#pragma unroll
            for (int m = 0; m < 4; ++m) { const int r = u.pm * 256 + ai * 128 + wr * 64 + m * 16 + fr;
#pragma unroll
                for (int bj = 0; bj < 2; ++bj)
#pragma unroll
                    for (int n = 0; n < 2; ++n) { const int c = u.pn * 256 + bj * 128 + wc * 32 + 16 * n + 4 * fq; const f32x4 bv = *(const f32x4*)(bias + c); const v2u gw = *(const v2u*)(Gb + (size_t)r * 1024 + c);
                        const f32x4 a = acc[ai][bj][m][n] + bv; const f32x4 o = {bflo(gw.x) * sigmoidf_(a.x), bfhi(gw.x) * sigmoidf_(a.y), bflo(gw.y) * sigmoidf_(a.z), bfhi(gw.y) * sigmoidf_(a.w)};
                        st_bf4(O + (size_t)r * ldo + coff + c, o); } }
    }
};

struct MoeOrder {
    const LAS int* bstart;
    const unsigned* cnt; const int* tokl; int nN, G, c, nblk; long bstride, eoff; bool up;
    __device__ bool next(int i, pg8::Unit& u) const {
        const long Lx = (long)i * G + c; if (Lx >= (long)nblk * nN) return false;
        const int blk = (int)(Lx / nN); u.pn = (int)(Lx % nN); u.pm = blk;
        const int e = bstart[65 + blk];
        u.e = e; u.idx0 = (blk - bstart[e]) * 256;
        u.aoff = up ? 0 : (long)blk * 256 * 512 * 2;
        u.boff = (long)e * (long)MOE_E_BYTES + eoff + (long)u.pn * bstride;
        return true;
    }
    __device__ int arow(const pg8::Unit& u, int row) const { const int idx = u.idx0 + row; return idx < (int)cnt[u.e] ? (tokl[(size_t)u.e * LISTCAP + idx] >> 1) : TT; }
};

__device__ __forceinline__ void tile_order(int wgid, int nM, int nN, int& pm, int& pn) {
    const int nwg = nM * nN; { const int q = nwg / 8, r = nwg % 8, xcd = wgid % 8, off = wgid / 8; wgid = (xcd < r ? xcd * (q + 1) : r * (q + 1) + (xcd - r) * q) + off; }
    const int nig = 8 * nN, gid = wgid / nig, fm = gid * 8, gsz = (nM - fm) < 8 ? (nM - fm) : 8;
    pm = fm + ((wgid % nig) % gsz); pn = (wgid % nig) / gsz;
}
struct InProj0Order {
    int G, c; long offA1, offB1, offA2, offB2;
    __device__ bool next(int i, pg8::Unit& u) const {
        const int Lx = i * G + c; constexpr int N1 = (TT / 256) * 12, N2 = 4 * (TT / 256); constexpr long TS = 256L * 2048 * 2;
        if (Lx >= N1 + N2) return false;
        u.idx0 = 0;
        if (Lx < N1) { tile_order(Lx, TT / 256, 12, u.pm, u.pn); u.aoff = offA1 + (long)u.pm * TS; u.boff = offB1 + (long)u.pn * TS; u.e = 0; }
        else { tile_order(Lx - N1, 4, TT / 256, u.pm, u.pn); u.aoff = offA2 + (long)u.pm * TS; u.boff = offB2 + (long)u.pn * TS; u.e = 1; }
        return true;
    }
    __device__ int arow(const pg8::Unit&, int) const { return 0; }
};
struct EpiInProj0 {
    EpiQKP e1; EpiVT e2;
    __device__ __forceinline__ void operator()(EPI_ARGS) const { if (u.e == 0) e1(acc, u, wr, wc, fr, fq); else e2(acc, u, wr, wc, fr, fq); }
};

#ifdef ATT_NORARE
#define ATT_RARE(mx) false
#else
#define ATT_RARE(mx) __any(mx > 8.0f)
#endif
__device__ __forceinline__ void attn_phase(Frame& F) {
    const bf16* Q = WSP(bf16, WS_Q); const bf16* Kb = WSP(bf16, WS_K); const bf16* VT = WSP(bf16, WS_VT); bf16* cat = WSP(bf16, WS_CAT);
    LAS unsigned char* lds = F.lds;
    const int lane0 = F.lane;
    float lam;
    { const float* lv = INP(11); float a = lv[lane0] * lv[64 + lane0], b = lv[128 + lane0] * lv[192 + lane0]; a = wave_sum(a); b = wave_sum(b); lam = expf(a) - expf(b) + 0.2f; }
    const float* subg = INP(12);
    const int NU = 1024 + 32;
    const int xcd = F.bid & 7, jcu = F.bid >> 3;
    for (int it = 0;; ++it) {
        int tl_ = F.tid; asm volatile("" : "+v"(tl_));
        const int lane = tl_ & 63, w = __builtin_amdgcn_readfirstlane(tl_ >> 6), sub = w & 1, qw = w >> 1, r32 = lane & 31, hi = lane >> 5;
        int uidx;
        if (F.G == 256) { if (it < 4) uidx = 128 * xcd + it * 32 + jcu; else if (it == 4 && F.bid < 32) uidx = 1024 + F.bid; else break; }
        else { uidx = it * F.G + F.bid; if (uidx >= NU) break; }
        int b, head, q0row, nt; size_t kbase;
        if (uidx < 1024) { const int combo = uidx >> 6, qb = uidx & 63; b = combo >> 3; head = combo & 7; q0row = b * SEQ + qb * 128; nt = KEYS / 64; }
        else { const int v = uidx - 1024; b = v >> 4; head = (v >> 1) & 7; q0row = TL + b * CTX + (v & 1) * 128; nt = CTX / 64; }
        kbase = (size_t)b * KEYS;
        bf16x8 qf[4];
        { const bf16* qp = Q + (size_t)(q0row + qw * 32 + r32) * 1024 + head * 128 + sub * 64 + hi * 8;
#pragma unroll
          for (int ks = 0; ks < 4; ++ks) qf[ks] = *(const bf16x8*)(qp + ks * 16); }
        const char* gsrc[4];
#pragma unroll
        for (int j = 0; j < 4; ++j) { const int pi = w * 4 + j, rr = lane >> 3, pc = lane & 7;
            if (pi < 16) { const int key = (pi & 7) * 8 + rr, c = pc ^ ((key >> 1) & 7); gsrc[j] = (const char*)(Kb + (kbase + key) * 1024 + head * 128 + (pi >> 3) * 64 + c * 8); }
            else { const int dvr = (pi - 16) * 8 + rr, c = pc ^ ((dvr >> 1) & 7); gsrc[j] = (const char*)(VT + ((size_t)(b * 8 + head) * 128 + dvr) * KEYS + c * 8); } }
        const size_t gstep = (w < 4) ? (size_t)65536 * 2 : (size_t)64 * 2;
        const unsigned ldst = (unsigned)w * 4096u;
#define ATT_DMA(t, buf) do { _Pragma("unroll") for (int _j = 0; _j < 4; ++_j) \
            __builtin_amdgcn_global_load_lds((const unsigned*)(gsrc[_j] + (size_t)(t) * gstep), (LAS unsigned*)(lds + (buf) * 32768 + ldst + _j * 1024), 16, 0, 0); } while (0)
        ATT_DMA(0, 0); ATT_DMA(1, 1); ATT_DMA(2, 2);
        asm volatile("s_waitcnt vmcnt(4)" ::: "memory");
        __builtin_amdgcn_s_barrier();
        f32x16 o[4];
#pragma unroll
        for (int d = 0; d < 4; ++d)
#pragma unroll
            for (int r = 0; r < 16; ++r) o[d][r] = 0.f;
        float mref = 0.f, lrow = 0.f;
        f32x16 negm;
#pragma unroll
        for (int r = 0; r < 16; ++r) negm[r] = 0.f;
        const int rdoff = r32 * 128;
        const int swz = (r32 >> 1) & 7;
        f32x16 s0, s1; bf16x8 pf[4];
#define ATT_QK(bufidx) do { const LAS unsigned char* kp_ = lds + (bufidx) * 32768 + sub * 8192; bf16x8 kfa[4], kfb[4]; \
            _Pragma("unroll") for (int ks = 0; ks < 4; ++ks) { const int ch = ((2 * ks + hi) ^ swz) * 16; kfa[ks] = *(const LAS bf16x8*)(kp_ + rdoff + ch); kfb[ks] = *(const LAS bf16x8*)(kp_ + 4096 + rdoff + ch); } \
            s0 = negm; s1 = negm; \
            _Pragma("unroll") for (int ks = 0; ks < 4; ++ks) { s0 = __builtin_amdgcn_mfma_f32_32x32x16_bf16(kfa[ks], qf[ks], s0, 0, 0, 0); s1 = __builtin_amdgcn_mfma_f32_32x32x16_bf16(kfb[ks], qf[ks], s1, 0, 0, 0); } \
            asm volatile("" : "+v"(s0), "+v"(s1) : "v"(kfa[0]), "v"(kfa[1]), "v"(kfa[2]), "v"(kfa[3]), "v"(kfb[0]), "v"(kfb[1]), "v"(kfb[2]), "v"(kfb[3])); } while (0)
#define ATT_MAX(mx) do { float mxa = fmaxf(fmaxf(s0[0], s0[1]), s0[2]), mxb = fmaxf(fmaxf(s1[0], s1[1]), s1[2]); \
            _Pragma("unroll") for (int r = 3; r < 15; r += 2) { mxa = fmaxf(fmaxf(mxa, s0[r]), s0[r + 1]); mxb = fmaxf(fmaxf(mxb, s1[r]), s1[r + 1]); } \
            mx = fmaxf(fmaxf(mxa, mxb), fmaxf(s0[15], s1[15])); mx = fmaxf(mx, __shfl_xor(mx, 32)); } while (0)
#define ATT_FIX(mx) do { const float dl = fmaxf(mx, 0.f); mref += dl; const float alpha = __builtin_amdgcn_exp2f(-dl); lrow *= alpha; \
            _Pragma("unroll") for (int r = 0; r < 16; ++r) { s0[r] -= dl; s1[r] -= dl; negm[r] = -mref; } \
            _Pragma("unroll") for (int d = 0; d < 4; ++d) _Pragma("unroll") for (int r = 0; r < 16; ++r) o[d][r] *= alpha; } while (0)
#define ATT_EXP8(S, base, dst) do { float rs_ = 0.f; _Pragma("unroll") for (int r = 0; r < 8; ++r) { S[base + r] = __builtin_amdgcn_exp2f(S[base + r]); rs_ += S[base + r]; } lrow += rs_; \
            v4u pw_; pw_.x = cvt_pk_bf16(S[base + 0], S[base + 1]); pw_.y = cvt_pk_bf16(S[base + 2], S[base + 3]); pw_.z = cvt_pk_bf16(S[base + 4], S[base + 5]); pw_.w = cvt_pk_bf16(S[base + 6], S[base + 7]); dst = __builtin_bit_cast(bf16x8, pw_); } while (0)
#define ATT_VLD(dstv, vp_, s) do { _Pragma("unroll") for (int d = 0; d < 4; ++d) dstv[d] = *(const LAS bf16x8*)(vp_ + d * 4096 + rdoff + (((2 * (s) + hi) ^ swz) * 16)); } while (0)
#define ATT_PV4(srcv, pfrag) do { _Pragma("unroll") for (int d = 0; d < 4; ++d) o[d] = __builtin_amdgcn_mfma_f32_32x32x16_bf16(srcv[d], pfrag, o[d], 0, 0, 0); } while (0)
        { ATT_QK(0); float mx; ATT_MAX(mx); if (__any(mx > 8.0f)) ATT_FIX(mx);
          ATT_EXP8(s0, 0, pf[0]); ATT_EXP8(s0, 8, pf[1]); ATT_EXP8(s1, 0, pf[2]); ATT_EXP8(s1, 8, pf[3]); }
        int bcur = 0;
#pragma nounroll
        for (int t = 0; t < nt; ++t) {
            const int bn1 = (bcur + 1) & 3, bn3 = (bcur + 3) & 3;
            if (t + 3 < nt) ATT_DMA(t + 3, bn3);
            const LAS unsigned char* vp = lds + bcur * 32768 + 16384;
            bf16x8 vfa[4], vfb[4];
            if (t + 1 < nt) {
                __builtin_amdgcn_sched_barrier(0);
                ATT_QK(bn1);
                float mx; ATT_MAX(mx);
                __builtin_amdgcn_sched_barrier(0);
                if (__any(mx > 8.0f)) {
                    const float dl = fmaxf(mx, 0.f); mref += dl; const float alpha = __builtin_amdgcn_exp2f(-dl); lrow *= alpha;
#pragma unroll
                    for (int r = 0; r < 16; ++r) { s0[r] -= dl; s1[r] -= dl; negm[r] = -mref; }
#pragma unroll
                    for (int d = 0; d < 4; ++d)
#pragma unroll
                        for (int r = 0; r < 16; ++r) o[d][r] *= alpha;
#pragma unroll
                    for (int s = 0; s < 4; ++s) { v4u pw = __builtin_bit_cast(v4u, pf[s]);
                        pw.x = cvt_pk_bf16(bflo(pw.x) * alpha, bfhi(pw.x) * alpha); pw.y = cvt_pk_bf16(bflo(pw.y) * alpha, bfhi(pw.y) * alpha);
                        pw.z = cvt_pk_bf16(bflo(pw.z) * alpha, bfhi(pw.z) * alpha); pw.w = cvt_pk_bf16(bflo(pw.w) * alpha, bfhi(pw.w) * alpha); pf[s] = __builtin_bit_cast(bf16x8, pw); }
                }
                __builtin_amdgcn_sched_barrier(0);
                {
                    ATT_VLD(vfa, vp, 0);
                    __builtin_amdgcn_sched_barrier(0);
                    ATT_VLD(vfb, vp, 1); ATT_PV4(vfa, pf[0]); ATT_EXP8(s0, 0, pf[0]);
                    __builtin_amdgcn_sched_barrier(0);
                    ATT_VLD(vfa, vp, 2); ATT_PV4(vfb, pf[1]); ATT_EXP8(s0, 8, pf[1]);
                    __builtin_amdgcn_sched_barrier(0);
                    ATT_VLD(vfb, vp, 3); ATT_PV4(vfa, pf[2]); ATT_EXP8(s1, 0, pf[2]);
                    __builtin_amdgcn_sched_barrier(0);
                    ATT_PV4(vfb, pf[3]); ATT_EXP8(s1, 8, pf[3]);
                }
                __builtin_amdgcn_sched_barrier(0);
            } else {
#pragma unroll
                for (int s = 0; s < 4; ++s) { ATT_VLD(vfa, vp, s); ATT_PV4(vfa, pf[s]); }
            }
            if (t + 3 < nt) asm volatile("s_waitcnt vmcnt(4) lgkmcnt(0)" ::: "memory"); else asm volatile("s_waitcnt vmcnt(0) lgkmcnt(0)" ::: "memory");
            __builtin_amdgcn_s_barrier();
            bcur = bn1;
        }
#undef ATT_DMA
#undef ATT_QK
#undef ATT_MAX
#undef ATT_FIX
#undef ATT_EXP8
#undef ATT_VLD
#undef ATT_PV4
        const float ltot = lrow + __shfl_xor(lrow, 32); const float linv = 1.0f / ltot;
        LAS float* xch = (LAS float*)lds + (size_t)(qw * 32 + r32) * 132;
        if (sub == 1) {
#pragma unroll
            for (int d = 0; d < 4; ++d)
#pragma unroll
                for (int g = 0; g < 4; ++g) *(LAS f32x4*)(xch + 32 * d + 8 * g + 4 * hi) = (f32x4){o[d][4 * g] * linv, o[d][4 * g + 1] * linv, o[d][4 * g + 2] * linv, o[d][4 * g + 3] * linv};
        }
        __syncthreads();
        if (sub == 0) {
            float ss = 0.f;
#pragma unroll
            for (int d = 0; d < 4; ++d)
#pragma unroll
                for (int g = 0; g < 4; ++g) { const f32x4 o2 = *(const LAS f32x4*)(xch + 32 * d + 8 * g + 4 * hi);
#pragma unroll
                    for (int j = 0; j < 4; ++j) { const float v = o[d][4 * g + j] * linv - lam * o2[j]; o[d][4 * g + j] = v; ss += v * v; } }
            ss += __shfl_xor(ss, 32);
            const float rn = 0.8f / sqrtf(ss * (1.0f / 128.0f) + EPS);
            bf16* op = cat + (size_t)(q0row + qw * 32 + r32) * 2048 + head * 128;
#pragma unroll
            for (int d = 0; d < 4; ++d)
#pragma unroll
                for (int g = 0; g < 4; ++g) { const int dv = 32 * d + 8 * g + 4 * hi; const f32x4 gg = *(const f32x4*)(subg + dv);
                    st_bf4(op + dv, (f32x4){o[d][4 * g] * rn * gg.x, o[d][4 * g + 1] * rn * gg.y, o[d][4 * g + 2] * rn * gg.z, o[d][4 * g + 3] * rn * gg.w}); }
        }
        __syncthreads();
    }
}

__device__ __forceinline__ void poold_phase(Frame& F) {
    const bf16* P = WSP(bf16, WS_P); bf16* PD = WSP(bf16, WS_PD);
    const int gt = F.bid * NTHREADS + F.tid, NGT = F.G * NTHREADS;
    for (int idx = gt; idx < TT * 128; idx += NGT) {
        const int r = idx >> 7, cc = (idx & 127) * 8, g = cc >> 8, wdw = 2 << g;
        int sb, t, Ls; if (r < TL) { sb = (r / SEQ) * SEQ; t = r % SEQ; Ls = SEQ; } else { sb = TL + ((r - TL) / CTX) * CTX; t = (r - TL) % CTX; Ls = CTX; }
        int lo = t - wdw / 2, hi = lo + wdw; lo = lo < 0 ? 0 : lo; hi = hi > Ls ? Ls : hi;
        float a[8];
#pragma unroll
        for (int j = 0; j < 8; ++j) a[j] = 0.f;
        for (int s = lo; s < hi; ++s) { const v4u v = *(const v4u*)(P + (size_t)(sb + s) * 1024 + cc);
            a[0] += bflo(v.x); a[1] += bfhi(v.x); a[2] += bflo(v.y); a[3] += bfhi(v.y); a[4] += bflo(v.z); a[5] += bfhi(v.z); a[6] += bflo(v.w); a[7] += bfhi(v.w); }
        const float inv = 1.0f / (float)(hi - lo);
        const v4u me = *(const v4u*)(P + (size_t)r * 1024 + cc);
        v4u o; o.x = pk2(a[0] * inv - bflo(me.x), a[1] * inv - bfhi(me.x)); o.y = pk2(a[2] * inv - bflo(me.y), a[3] * inv - bfhi(me.y));
        o.z = pk2(a[4] * inv - bflo(me.z), a[5] * inv - bfhi(me.z)); o.w = pk2(a[6] * inv - bflo(me.w), a[7] * inv - bfhi(me.w));
        *(v4u*)(PD + (size_t)r * 1024 + cc) = o;
    }
}

__device__ __forceinline__ void shortconv_phase(Frame& F) {
    const bf16* PJ = WSP(bf16, WS_PROJ1); float* GT = WSP(float, WS_GT);
    const float* cw = INP(17); const float* cb = INP(18);
    LAS float* scr = (LAS float*)(F.lds + F.wave * 17408);
    const int lane = F.lane;
    for (int it = F.gw; it < 2 * 128 * 48; it += F.NGW) {
        const int cbk = it % 48, tb = (it / 48) % 128, b = it / (48 * 128), col = cbk * 64 + lane, t0 = tb * 64;
        const bf16* base = PJ + ((size_t)b * SEQ) * 4096 + cbk * 64 + (lane & 7) * 8;
#pragma unroll
        for (int i = 0; i < 9; ++i) { const int row = 8 * i + (lane >> 3); const int t = t0 - 1 + row;
            if (row < 66) { v4u v = {0u, 0u, 0u, 0u}; if (t >= 0 && t < SEQ) v = *(const v4u*)(base + (size_t)t * 4096);
                LAS float* d = scr + row * 65 + (lane & 7) * 8; d[0] = bflo(v.x); d[1] = bfhi(v.x); d[2] = bflo(v.y); d[3] = bfhi(v.y); d[4] = bflo(v.z); d[5] = bfhi(v.z); d[6] = bflo(v.w); d[7] = bfhi(v.w); } }
        LDS_WAIT(); asm volatile("" ::: "memory");
        const float w0 = cw[col], w1 = cw[3072 + col], w2 = cw[2 * 3072 + col], bias = cb[col];
        float prev = scr[lane], cur = scr[65 + lane];
#pragma unroll 8
        for (int tt = 0; tt < 64; ++tt) { const float nxt = scr[(tt + 2) * 65 + lane]; const float o = prev * w0 + cur * w1 + nxt * w2 + bias; scr[tt * 65 + lane] = o; prev = cur; cur = nxt; }
        LDS_WAIT(); asm volatile("" ::: "memory");
        for (int c = 0; c < 64; ++c) GT[((size_t)(cbk * 64 + c) * 2 + b) * SEQ + t0 + lane] = scr[lane * 65 + c];
        LDS_WAIT(); asm volatile("" ::: "memory");
    }
}

__device__ __forceinline__ void s5_scan_phase(Frame& F) {
    const bf16* PJ = WSP(bf16, WS_PROJ1); float* YD = WSP(float, WS_YD);
    const f32x2* lamb = WSP(f32x2, WS_S5LAM); const f32x2* bbar = WSP(f32x2, WS_S5B);
    const float* cre = INP(31); const float* cim = INP(32);
    const int lane = F.lane;
    for (int task = F.wave * F.G + F.bid; task < 256; task += F.NGW) {
        const int di = task >> 7, b = (task >> 6) & 1, g = task & 63;
        const int dgp = (di * 64 + g) * 64 + lane;
        const f32x2 lam = lamb[dgp];
        float br[16], bi[16], cr[16], ci[16];
#pragma unroll
        for (int c = 0; c < 16; ++c) { const f32x2 bv = bbar[(size_t)dgp * 16 + c]; br[c] = bv.x; bi[c] = bv.y;
            cr[c] = cre[((size_t)(di * 64 + g) * 16 + c) * 64 + lane]; ci[c] = cim[((size_t)(di * 64 + g) * 16 + c) * 64 + lane]; }
        float sr = 0.f, si = 0.f;
        const int nsteps = CTX + SEQ;
        for (int st = 0; st < nsteps; st += 4) {
            const int stl = st + (lane >> 4);
            int row;
            if (stl < CTX) row = TL + b * CTX + (di == 0 ? stl : CTX - 1 - stl);
            else row = b * SEQ + (di == 0 ? stl - CTX : SEQ - 1 - (stl - CTX));
            const float uval = bf2f(PJ[(size_t)row * 4096 + 3072 + g * 16 + (lane & 15)]);
#pragma unroll
            for (int k = 0; k < 4; ++k) {
                float bur = 0.f, bui = 0.f;
#pragma unroll
                for (int c = 0; c < 16; ++c) { const float u = __builtin_bit_cast(float, __builtin_amdgcn_readlane(__builtin_bit_cast(int, uval), 16 * k + c)); bur += br[c] * u; bui += bi[c] * u; }
                const float nr = lam.x * sr - lam.y * si + bur, ni = lam.x * si + lam.y * sr + bui; sr = nr; si = ni;
                const int s2 = st + k;
                if (s2 >= CTX) {
                    const int t = (di == 0) ? s2 - CTX : SEQ - 1 - (s2 - CTX);
                    float outv = 0.f;
#pragma unroll
                    for (int c = 0; c < 16; ++c) { float v = cr[c] * sr - ci[c] * si; v = wave_sum(v); if (lane == c) outv = v; }
                    if (lane < 16) YD[((size_t)di * TL + (size_t)b * SEQ + t) * 1024 + g * 16 + lane] = outv;
                }
            }
        }
    }
}

__device__ __forceinline__ void hyena_naive_phase(Frame& F) {
    const float* GT = WSP(float, WS_GT); const float* kT = WSP(float, WS_KT); const float* invn = WSP(float, WS_INVN); bf16* cat = WSP(bf16, WS_CAT);
    const float* hyb = INP(25);
    LAS float* kf = (LAS float*)F.lds;
    LAS f32x2* ub = (LAS f32x2*)(F.lds + 65536);
    const int tid = F.tid;
    for (int ch = F.bid; ch < 1024; ch += F.G) {
        float res0[16], res1[16];
        for (int o = 0; o < 2; ++o) {
            const float inv = invn[o * 1024 + ch];
            const float* kfw = kT + (size_t)(o * 2048 + ch) * SEQ; const float* kbw = kT + (size_t)(o * 2048 + 1024 + ch) * SEQ;
            for (int n = tid; n < 16384; n += NTHREADS) { float v; if (n < SEQ) v = kfw[n]; else if (n == SEQ) v = 0.f; else v = kbw[16384 - n]; kf[n] = v * inv; }
            if (o == 0) { const float* v0 = GT + ((size_t)(0 * 1024 + ch) * 2) * SEQ; for (int n = tid; n < SEQ; n += NTHREADS) ub[n] = (f32x2){v0[n], v0[SEQ + n]}; }
            else {
#pragma unroll
                for (int j = 0; j < 16; ++j) ub[tid + NTHREADS * j] = (f32x2){res0[j], res1[j]}; }
            __syncthreads();
            float a0[16], a1[16];
#pragma unroll
            for (int j = 0; j < 16; ++j) { a0[j] = 0.f; a1[j] = 0.f; }
            for (int s = 0; s < SEQ; ++s) { const f32x2 u = ub[s];
#pragma unroll
                for (int j = 0; j < 16; ++j) { const float kk = kf[(tid + NTHREADS * j - s) & 16383]; a0[j] += u.x * kk; a1[j] += u.y * kk; } }
            const float bias = hyb[o * 1024 + ch];
            const float* xg = GT + ((size_t)((o + 1) * 1024 + ch) * 2) * SEQ;
#pragma unroll
            for (int j = 0; j < 16; ++j) { const int t = tid + NTHREADS * j; const f32x2 u = ub[t];
                res0[j] = xg[t] * (a0[j] + bias * u.x); res1[j] = xg[SEQ + t] * (a1[j] + bias * u.y); }
            __syncthreads();
        }
#pragma unroll
        for (int j = 0; j < 16; ++j) { const int t = tid + NTHREADS * j;
            cat[(size_t)t * 2048 + ch] = (bf16)f2bf(res0[j]); cat[((size_t)SEQ + t) * 2048 + ch] = (bf16)f2bf(res1[j]); }
    }
}

__device__ __forceinline__ void s5_gelu_phase(Frame& F) {
    const bf16* PJ = WSP(bf16, WS_PROJ1); const float* YD = WSP(float, WS_YD); bf16* Gb = WSP(bf16, WS_PD); const float* dd = INP(33);
    const int gt = F.bid * NTHREADS + F.tid, NGT = F.G * NTHREADS;
    for (int idx = gt; idx < TL * 256; idx += NGT) { const int r = idx >> 8, c = (idx & 255) * 4;
        const v2u uw = *(const v2u*)(PJ + (size_t)r * 4096 + 3072 + c); const f32x4 d4 = *(const f32x4*)(dd + c);
        const int bb = r / SEQ, tt = r % SEQ, gg = c >> 4, cc = c & 15;
        const f32x4 y0 = *(const f32x4*)(YD + (((size_t)(0 * 2 + bb) * 64 + gg) * SEQ + tt) * 16 + cc), y1 = *(const f32x4*)(YD + (((size_t)(1 * 2 + bb) * 64 + gg) * SEQ + tt) * 16 + cc);
        const f32x4 y = {bflo(uw.x) * d4.x + y0.x + y1.x, bfhi(uw.x) * d4.y + y0.y + y1.y, bflo(uw.y) * d4.z + y0.z + y1.z, bfhi(uw.y) * d4.w + y0.w + y1.w};
        st_bf4(Gb + (size_t)r * 1024 + c, (f32x4){gelu_tanh(y.x), gelu_tanh(y.y), gelu_tanh(y.z), gelu_tanh(y.w)}); }
}

__device__ __forceinline__ f32x2 cmulf(f32x2 a, f32x2 b) { return (f32x2){a.x * b.x - a.y * b.y, a.x * b.y + a.y * b.x}; }
__device__ __forceinline__ int drev14(int p) { const unsigned r = __builtin_bitreverse32((unsigned)p) >> 18; return (int)(((r & 0x2AAAu) >> 1) | ((r & 0x1555u) << 1)); }
__device__ __forceinline__ void fft_fwd(LAS f32x2* X, const f32x2* tw, int tid) {
#pragma nounroll
    for (int L = 4096; L >= 1; L >>= 2) {
        const int tws = 4096 / L;
#pragma unroll 2
        for (int i = 0; i < 8; ++i) {
            const int b = tid + NTHREADS * i, j = b & (L - 1), i0 = (b - j) * 4 + j;
            const f32x2 x0 = X[i0], x1 = X[i0 + L], x2 = X[i0 + 2 * L], x3 = X[i0 + 3 * L];
            const f32x2 w1 = tw[j * tws], w2 = cmulf(w1, w1), w3 = cmulf(w2, w1);
            const f32x2 a = x0 + x2, bb = x0 - x2, c = x1 + x3, d = x1 - x3;
            const f32x2 t1 = {bb.x + d.y, bb.y - d.x}, t3 = {bb.x - d.y, bb.y + d.x};
            X[i0] = a + c; X[i0 + L] = cmulf(t1, w1); X[i0 + 2 * L] = cmulf(a - c, w2); X[i0 + 3 * L] = cmulf(t3, w3);
        }
        __syncthreads();
    }
}
__device__ __forceinline__ void fft_inv(LAS f32x2* X, const f32x2* tw, int tid) {
#pragma nounroll
    for (int L = 1; L <= 4096; L <<= 2) {
        const int tws = 4096 / L;
#pragma unroll 2
        for (int i = 0; i < 8; ++i) {
            const int b = tid + NTHREADS * i, j = b & (L - 1), i0 = (b - j) * 4 + j;
            f32x2 w1 = tw[j * tws]; w1.y = -w1.y; const f32x2 w2 = cmulf(w1, w1), w3 = cmulf(w2, w1);
            const f32x2 x0 = X[i0], x1 = cmulf(X[i0 + L], w1), x2 = cmulf(X[i0 + 2 * L], w2), x3 = cmulf(X[i0 + 3 * L], w3);
            const f32x2 a = x0 + x2, bb = x0 - x2, c = x1 + x3, d = x1 - x3;
            X[i0] = a + c; X[i0 + L] = (f32x2){bb.x - d.y, bb.y + d.x}; X[i0 + 2 * L] = a - c; X[i0 + 3 * L] = (f32x2){bb.x + d.y, bb.y - d.x};
        }
        __syncthreads();
    }
}
__device__ __forceinline__ void fft_pointwise(LAS f32x2* X, const f32x2* Wg, int o, float scale, int tid) {
    const float hs = 0.5f * scale;
#pragma unroll 4
    for (int i = 0; i < 32; ++i) {
        const int p = tid + NTHREADS * i, f = drev14(p), pm = drev14((16384 - f) & 16383);
        const unsigned long long ua = __hip_atomic_load((const unsigned long long*)(Wg + p), __ATOMIC_RELAXED, __HIP_MEMORY_SCOPE_AGENT);
        const unsigned long long ub = __hip_atomic_load((const unsigned long long*)(Wg + pm), __ATOMIC_RELAXED, __HIP_MEMORY_SCOPE_AGENT);
        const f32x2 A = __builtin_bit_cast(f32x2, ua), B = __builtin_bit_cast(f32x2, ub);
        f32x2 K;
        if (o == 0) K = (f32x2){(A.x + B.x) * hs, (A.y - B.y) * hs};
        else { const f32x2 dd = {A.x - B.x, A.y + B.y}; K = (f32x2){dd.y * hs, -dd.x * hs}; }
        X[p] = cmulf(X[p], K);
    }
    __syncthreads();
}
__device__ __forceinline__ void hyena_fft_phase(Frame& F) {
    float* GT = WSP(float, WS_GT); const float* kT = WSP(float, WS_KT); const float* invn = WSP(float, WS_INVN); const f32x2* tw = WSP(f32x2, WS_TW);
    f32x2* Wg = WSP(f32x2, WS_FFTW) + (size_t)F.bid * 16384;
    const float* hyb = INP(25);
    LAS f32x2* X = (LAS f32x2*)F.lds;
    const int tid = F.tid;
    for (int ch = F.bid; ch < 1024; ch += F.G) {
        { const float* f0 = kT + (size_t)ch * SEQ; const float* b0 = kT + (size_t)(1024 + ch) * SEQ; const float* f1 = kT + (size_t)(2048 + ch) * SEQ; const float* b1 = kT + (size_t)(3072 + ch) * SEQ;
          for (int n = tid; n < SEQ; n += NTHREADS) { X[n] = (f32x2){f0[n], f1[n]}; X[SEQ + n] = (n == 0) ? (f32x2){0.f, 0.f} : (f32x2){b0[SEQ - n], b1[SEQ - n]}; } }
        __syncthreads();
        fft_fwd(X, tw, tid);
        for (int n = tid; n < 16384; n += NTHREADS) Wg[n] = X[n];
        __syncthreads();
        const float* v0 = GT + ((size_t)ch * 2) * SEQ; float* yo = WSP(float, WS_YHT) + ((size_t)ch * 2) * SEQ;
        const float* x1 = GT + ((size_t)(1024 + ch) * 2) * SEQ; const float* x2 = GT + ((size_t)(2048 + ch) * 2) * SEQ;
        float z0[16], z1[16];
#pragma unroll
        for (int j = 0; j < 16; ++j) { const int n = tid + NTHREADS * j; z0[j] = v0[n]; z1[j] = v0[SEQ + n]; }
#pragma unroll
        for (int o = 0; o < 2; ++o) {
#pragma unroll
            for (int j = 0; j < 16; ++j) { const int n = tid + NTHREADS * j; X[n] = (f32x2){z0[j], z1[j]}; X[SEQ + n] = (f32x2){0.f, 0.f}; }
            __syncthreads();
            fft_fwd(X, tw, tid);
            fft_pointwise(X, Wg, o, invn[o * 1024 + ch] * (1.0f / 16384.0f), tid);
            fft_inv(X, tw, tid);
            const float bias = hyb[o * 1024 + ch]; const float* xg = (o == 0) ? x1 : x2;
#pragma unroll
            for (int j = 0; j < 16; ++j) { const int n = tid + NTHREADS * j; const f32x2 y = X[n]; z0[j] = xg[n] * (y.x + bias * z0[j]); z1[j] = xg[SEQ + n] * (y.y + bias * z1[j]); }
            __syncthreads();
        }
#pragma unroll
        for (int j = 0; j < 16; ++j) { const int n = tid + NTHREADS * j; yo[n] = z0[j]; yo[SEQ + n] = z1[j]; }
    }
}
__device__ __forceinline__ void hyena_out_transpose(Frame& F) {
    const float* GT = WSP(float, WS_YHT); bf16* cat = WSP(bf16, WS_CAT);
    LAS float* scr = (LAS float*)(F.lds + F.wave * 17408);
    const int lane = F.lane;
    for (int it = F.gw; it < 2 * 128 * 16; it += F.NGW) {
        const int cbk = it & 15, tb = (it >> 4) & 127, b = it >> 11, t0 = tb * 64;
        for (int c = 0; c < 64; ++c) scr[c * 65 + lane] = GT[((size_t)(cbk * 64 + c) * 2 + b) * SEQ + t0 + lane];
        LDS_WAIT(); asm volatile("" ::: "memory");
#pragma unroll
        for (int i = 0; i < 8; ++i) { const int tt = 8 * i + (lane >> 3), c0 = (lane & 7) * 8; const LAS float* s = scr + c0 * 65 + tt;
            v4u o; o.x = cvt_pk_bf16(s[0], s[65]); o.y = cvt_pk_bf16(s[130], s[195]); o.z = cvt_pk_bf16(s[260], s[325]); o.w = cvt_pk_bf16(s[390], s[455]);
            *(v4u*)(cat + ((size_t)b * SEQ + t0 + tt) * 2048 + cbk * 64 + c0) = o; }
        LDS_WAIT(); asm volatile("" ::: "memory");
    }
}

__device__ __forceinline__ int s5_row(int di, int b, int s) {
    return (s < CTX) ? TL + b * CTX + (di == 0 ? s : CTX - 1 - s) : b * SEQ + (di == 0 ? s - CTX : SEQ - 1 - (s - CTX));
}
template <bool OUTPUT>
__device__ __forceinline__ void s5_seg_phase(Frame& F) {
    const bf16* PJ = WSP(bf16, WS_PROJ1); float* YD = WSP(float, WS_YD);
    const f32x2* lamb = WSP(f32x2, WS_S5LAM); const f32x2* bbar = WSP(f32x2, WS_S5B); const f32x2* l256 = WSP(f32x2, WS_S5L256); f32x2* Eb = WSP(f32x2, WS_S5E);
    const float* cre = INP(31); const float* cim = INP(32);
    const int lane = F.lane;
    for (int task = F.wave * F.G + F.bid; task < 256 * 32; task += F.NGW) {
        const int dbg = task >> 5, seg = (task & 31) + (OUTPUT ? 1 : 0);
        const int di = dbg >> 7, b = (dbg >> 6) & 1, g = dbg & 63;
        const int dgp = (di * 64 + g) * 64 + lane;
        const f32x2 lam = lamb[dgp];
        float br[16], bi[16];
#pragma unroll
        for (int c = 0; c < 16; ++c) { const f32x2 bv = bbar[(size_t)dgp * 16 + c]; br[c] = bv.x; bi[c] = bv.y; }
        float cr[16], ci[16];
        if (OUTPUT) {
#pragma unroll
            for (int c = 0; c < 16; ++c) { cr[c] = cre[((size_t)(di * 64 + g) * 16 + c) * 64 + lane]; ci[c] = cim[((size_t)(di * 64 + g) * 16 + c) * 64 + lane]; }
        }
        float sr = 0.f, si = 0.f;
        if (OUTPUT) {
            const f32x2 l2 = l256[dgp]; const f32x2* ep = Eb + ((size_t)dbg * 32) * 64 + lane;
            for (int k = 0; k < seg; ++k) { const f32x2 e = ep[(size_t)k * 64]; const float nr = l2.x * sr - l2.y * si + e.x, ni = l2.x * si + l2.y * sr + e.y; sr = nr; si = ni; }
        }
        const int s0 = seg * 256;
#pragma nounroll
        for (int st = 0; st < 256; st += 4) {
            const int row = s5_row(di, b, s0 + st + (lane >> 4));
            const float uval = bf2f(PJ[(size_t)row * 4096 + 3072 + g * 16 + (lane & 15)]);
#pragma unroll
            for (int k = 0; k < 4; ++k) {
                float bur = 0.f, bui = 0.f;
#pragma unroll
                for (int c = 0; c < 16; ++c) { const float u = __builtin_bit_cast(float, __builtin_amdgcn_readlane(__builtin_bit_cast(int, uval), 16 * k + c)); bur += br[c] * u; bui += bi[c] * u; }
                const float nr = lam.x * sr - lam.y * si + bur, ni = lam.x * si + lam.y * sr + bui; sr = nr; si = ni;
                if (OUTPUT) {
                    float v8[8], v4[4], v2[2], v1;
                    const bool b5 = (lane & 32) != 0, b4 = (lane & 16) != 0, b3 = (lane & 8) != 0, b2 = (lane & 4) != 0;
#pragma unroll
                    for (int i = 0; i < 8; ++i) { const float lo = cr[i] * sr - ci[i] * si, hi = cr[i + 8] * sr - ci[i + 8] * si; const float keep = b5 ? hi : lo, send = b5 ? lo : hi; v8[i] = keep + __shfl_xor(send, 32); }
#pragma unroll
                    for (int i = 0; i < 4; ++i) { const float keep = b4 ? v8[i + 4] : v8[i], send = b4 ? v8[i] : v8[i + 4]; v4[i] = keep + __shfl_xor(send, 16); }
#pragma unroll
                    for (int i = 0; i < 2; ++i) { const float keep = b3 ? v4[i + 2] : v4[i], send = b3 ? v4[i] : v4[i + 2]; v2[i] = keep + __shfl_xor(send, 8); }
                    { const float keep = b2 ? v2[1] : v2[0], send = b2 ? v2[0] : v2[1]; v1 = keep + __shfl_xor(send, 4); }
                    v1 += __shfl_xor(v1, 2); v1 += __shfl_xor(v1, 1);
                    const int s = s0 + st + k, t = (di == 0) ? s - CTX : SEQ - 1 - (s - CTX);
                    if ((lane & 3) == 0) YD[((size_t)di * TL + (size_t)b * SEQ + t) * 1024 + g * 16 + (lane >> 2)] = v1;
                }
            }
        }
        if (!OUTPUT) Eb[((size_t)dbg * 32 + seg) * 64 + lane] = (f32x2){sr, si};
    }
}

typedef float f32x4_t __attribute__((ext_vector_type(4)));
template <bool OUTPUT>
__device__ __forceinline__ void s5_mfma_phase(Frame& F) {
    const bf16* PJ = WSP(bf16, WS_PROJ1); float* YD = WSP(float, WS_YD);
    const f32x2* lamb = WSP(f32x2, WS_S5LAM); const f32x2* bbar = WSP(f32x2, WS_S5B); const f32x2* l256 = WSP(f32x2, WS_S5L256); f32x2* Eb = WSP(f32x2, WS_S5E);
    const float* cre = INP(31); const float* cim = INP(32);
    const int lane = F.lane, fr = lane & 15, fq = lane >> 4;
    LAS unsigned* Xl = (LAS unsigned*)(F.lds + F.wave * 4608);
    for (int task = F.wave * F.G + F.bid; task < 256 * 32; task += F.NGW) {
        const int dbg = task >> 5, seg = (task & 31) + (OUTPUT ? 1 : 0);
        const int di = dbg >> 7, b = (dbg >> 6) & 1, g = dbg & 63;
        const int dg = di * 64 + g;
        f32x2 l1[4], l2[4], l3[4], l4[4];
        bf16x8 bfr[8];
#pragma unroll
        for (int t = 0; t < 4; ++t) { const int dgp = dg * 64 + 16 * t + fr; l1[t] = lamb[dgp]; l2[t] = cmulf(l1[t], l1[t]); l3[t] = cmulf(l2[t], l1[t]); l4[t] = cmulf(l2[t], l2[t]);
            v4u wre = {0u, 0u, 0u, 0u}, wim = {0u, 0u, 0u, 0u};
            if (fq < 2) { const f32x4* bp = (const f32x4*)(bbar + (size_t)dgp * 16 + 8 * fq); const f32x4 q0 = bp[0], q1 = bp[1], q2 = bp[2], q3 = bp[3];
                wre.x = cvt_pk_bf16(q0.x, q0.z); wre.y = cvt_pk_bf16(q1.x, q1.z); wre.z = cvt_pk_bf16(q2.x, q2.z); wre.w = cvt_pk_bf16(q3.x, q3.z);
                wim.x = cvt_pk_bf16(q0.y, q0.w); wim.y = cvt_pk_bf16(q1.y, q1.w); wim.z = cvt_pk_bf16(q2.y, q2.w); wim.w = cvt_pk_bf16(q3.y, q3.w); }
            bfr[t] = __builtin_bit_cast(bf16x8, wre); bfr[4 + t] = __builtin_bit_cast(bf16x8, wim); }
        bf16x8 cfr[4];
        if (OUTPUT) {
#pragma unroll
            for (int ks = 0; ks < 4; ++ks) { const size_t cb = ((size_t)dg * 16 + fr) * 64 + 16 * ks + 4 * fq; const f32x4 r4 = *(const f32x4*)(cre + cb), i4 = *(const f32x4*)(cim + cb);
                v4u w; w.x = cvt_pk_bf16(r4.x, -i4.x); w.y = cvt_pk_bf16(r4.y, -i4.y); w.z = cvt_pk_bf16(r4.z, -i4.z); w.w = cvt_pk_bf16(r4.w, -i4.w); cfr[ks] = __builtin_bit_cast(bf16x8, w); }
        }
        f32x2 st[4];
#pragma unroll
        for (int t = 0; t < 4; ++t) st[t] = (f32x2){0.f, 0.f};
        if (OUTPUT) {
#pragma unroll
            for (int t = 0; t < 4; ++t) { const f32x2 lq = l256[dg * 64 + 16 * t + fr]; const f32x2* ep = Eb + ((size_t)dbg * 32) * 64 + 16 * t + fr;
                for (int k = 0; k < seg; ++k) { const f32x2 e = ep[(size_t)k * 64]; st[t] = cmulf(lq, st[t]) + e; } }
        }
        const int s0 = seg * 256;
        v4u unext = {0u, 0u, 0u, 0u};
        if (fq < 2) unext = *(const v4u*)(PJ + (size_t)s5_row(di, b, s0 + fr) * 4096 + 3072 + g * 16 + 8 * fq);
#pragma nounroll
        for (int blk = 0; blk < 16; ++blk) {
            const bf16x8 ufr = __builtin_bit_cast(bf16x8, unext);
            if (blk + 1 < 16 && fq < 2) unext = *(const v4u*)(PJ + (size_t)s5_row(di, b, s0 + 16 * (blk + 1) + fr) * 4096 + 3072 + g * 16 + 8 * fq);
            f32x4 bu[8];
#pragma unroll
            for (int nt = 0; nt < 8; ++nt) bu[nt] = __builtin_amdgcn_mfma_f32_16x16x32_bf16(ufr, bfr[nt], (f32x4){0.f, 0.f, 0.f, 0.f}, 0, 0, 0);
            f32x2 xs[4][4];
#pragma unroll
            for (int t = 0; t < 4; ++t) {
                f32x2 x0 = {bu[t][0], bu[4 + t][0]}, x1 = cmulf(l1[t], x0) + (f32x2){bu[t][1], bu[4 + t][1]}, x2 = cmulf(l1[t], x1) + (f32x2){bu[t][2], bu[4 + t][2]}, x3 = cmulf(l1[t], x2) + (f32x2){bu[t][3], bu[4 + t][3]};
                f32x2 sin = st[t];
                f32x2 fin = x3 + cmulf(l4[t], (fq == 0) ? sin : (f32x2){0.f, 0.f});
#pragma unroll
                for (int rd = 1; rd < 4; ++rd) { const float vr = __shfl(fin.x, lane - 16), vi = __shfl(fin.y, lane - 16);
                    if (fq == rd) { sin = (f32x2){vr, vi}; fin = x3 + cmulf(l4[t], sin); } }
                xs[t][0] = x0 + cmulf(l1[t], sin); xs[t][1] = x1 + cmulf(l2[t], sin); xs[t][2] = x2 + cmulf(l3[t], sin); xs[t][3] = x3 + cmulf(l4[t], sin);
                st[t] = (f32x2){__shfl(xs[t][3].x, 48 + fr), __shfl(xs[t][3].y, 48 + fr)};
            }
            if (OUTPUT) {
#pragma unroll
                for (int t = 0; t < 4; ++t)
#pragma unroll
                    for (int r = 0; r < 4; ++r) Xl[(4 * fq + r) * 68 + 16 * t + fr] = cvt_pk_bf16(xs[t][r].x, xs[t][r].y);
                LDS_WAIT(); asm volatile("" ::: "memory");
                f32x4 y = {0.f, 0.f, 0.f, 0.f};
#pragma unroll
                for (int ks = 0; ks < 4; ++ks) { const bf16x8 xa = *(const LAS bf16x8*)(Xl + fr * 68 + 16 * ks + 4 * fq); y = __builtin_amdgcn_mfma_f32_16x16x32_bf16(xa, cfr[ks], y, 0, 0, 0); }
                LDS_WAIT(); asm volatile("" ::: "memory");
#pragma unroll
                for (int r = 0; r < 4; ++r) { const int s = s0 + 16 * blk + 4 * fq + r, tl = (di == 0) ? s - CTX : SEQ - 1 - (s - CTX);
                    YD[((size_t)di * TL + (size_t)b * SEQ + tl) * 1024 + g * 16 + fr] = y[r]; }
            }
        }
        if (!OUTPUT) { if (fq == 0) {
#pragma unroll
            for (int t = 0; t < 4; ++t) Eb[((size_t)dbg * 32 + seg) * 64 + 16 * t + fr] = st[t]; } }
    }
}

#ifndef S5C_EOFF
#define S5C_EOFF 0
#endif
#define S5_KEEP8(acc, f) asm volatile("" : "+v"(acc) : "v"(f[0]), "v"(f[1]), "v"(f[2]), "v"(f[3]), "v"(f[4]), "v"(f[5]), "v"(f[6]), "v"(f[7]))
#define S5_KEEP4(acc, f) asm volatile("" : "+v"(acc) : "v"(f[0]), "v"(f[1]), "v"(f[2]), "v"(f[3]))
template <bool OUTPUT, int S5C_RUN = 0>
__device__ __forceinline__ void s5_chunk_phase(Frame& F) {
    const bf16* PJ = WSP(bf16, WS_PROJ1); float* YD = WSP(float, WS_YD);
    const f32x2* l16t = WSP(f32x2, WS_S5L16); const f32x2* l256 = WSP(f32x2, WS_S5L256); f32x2* Eb = WSP(f32x2, WS_S5E);
    const bf16* W1 = WSP(bf16, WS_S5W1); const bf16* W3 = WSP(bf16, WS_S5W3); const bf16* KT = WSP(bf16, WS_S5KT);
    const int lane = F.lane, fr = lane & 15, fq = lane >> 4;
    LAS unsigned* Xl = (LAS unsigned*)(F.lds + F.wave * 4608);
    f32x2 carry[4];
#pragma unroll
    for (int t = 0; t < 4; ++t) carry[t] = (f32x2){0.f, 0.f};
#pragma nounroll
    for (int j = 0;; ++j) {
        const int tq = F.wave * F.G + F.bid + (j >> 2) * F.NGW, sub4 = j & 3;
        if (tq >= 256 * 8) break;
        const int task = tq * 4 + sub4;
        const int dbg = task >> 5, seg = (task & 31) + (OUTPUT ? 1 : 0);
        const int di = dbg >> 7, b = (dbg >> 6) & 1, g = dbg & 63;
        const int dg = di * 64 + g;
        const int s0 = seg * 256;
        bf16x8 afr[8];
#pragma unroll
        for (int ks = 0; ks < 8; ++ks) afr[ks] = *(const bf16x8*)(PJ + (size_t)s5_row(di, b, s0 + 16 * fr + 2 * ks + (fq >> 1)) * 4096 + 3072 + g * 16 + 8 * (fq & 1));
        f32x4 ea[8];
        { const bf16* w1p = W1 + ((size_t)dg * 128 + fr) * 256 + 8 * fq;
#pragma unroll
          for (int nt = 0; nt < 8; ++nt) { f32x4 a = {0.f, 0.f, 0.f, 0.f}; bf16x8 bw[8];
#pragma unroll
              for (int ks = 0; ks < 8; ++ks) bw[ks] = *(const bf16x8*)(w1p + (size_t)nt * 16 * 256 + 32 * ks);
#pragma unroll
              for (int ks = 0; ks < 8; ++ks) a = __builtin_amdgcn_mfma_f32_16x16x32_bf16(afr[ks], bw[ks], a, 0, 0, 0);
              S5_KEEP8(a, bw); S5_KEEP8(a, afr);
              ea[nt] = a; } }
        f32x2 st[4];
#pragma unroll
        for (int t = 0; t < 4; ++t) st[t] = (f32x2){0.f, 0.f};
        if (OUTPUT) {
#pragma unroll
            for (int t = 0; t < 4; ++t) { const f32x2 lq = l256[dg * 64 + 16 * t + fr]; const f32x2* ep = Eb + ((size_t)dbg * 32) * 64 + 16 * t + fr;
                if (sub4 == 0) {
                    int k = 0;
                    for (; k + 8 <= seg; k += 8) { f32x2 e8[8];
#pragma unroll
                        for (int j = 0; j < 8; ++j) e8[j] = ep[(size_t)(k + j) * 64];
#pragma unroll
                        for (int j = 0; j < 8; ++j) st[t] = cmulf(lq, st[t]) + e8[j]; }
                    for (; k < seg; ++k) st[t] = cmulf(lq, st[t]) + ep[(size_t)k * 64];
                } else st[t] = cmulf(lq, carry[t]) + ep[(size_t)(seg - 1) * 64];
                carry[t] = st[t]; }
        }
#pragma unroll
        for (int t = 0; t < 4; ++t) {
            const f32x2 L1 = l16t[dg * 64 + 16 * t + fr], L2 = cmulf(L1, L1), L3 = cmulf(L2, L1), L4 = cmulf(L2, L2);
            const f32x2 x0 = {ea[t][0], ea[4 + t][0]}, x1 = cmulf(L1, x0) + (f32x2){ea[t][1], ea[4 + t][1]}, x2 = cmulf(L1, x1) + (f32x2){ea[t][2], ea[4 + t][2]}, x3 = cmulf(L1, x2) + (f32x2){ea[t][3], ea[4 + t][3]};
            f32x2 sin = st[t];
            f32x2 fin = x3 + cmulf(L4, (fq == 0) ? sin : (f32x2){0.f, 0.f});
#pragma unroll
            for (int rd = 1; rd < 4; ++rd) { const float vr = __shfl(fin.x, lane - 16), vi = __shfl(fin.y, lane - 16);
                if (fq == rd) { sin = (f32x2){vr, vi}; fin = x3 + cmulf(L4, sin); } }
            if (OUTPUT) {
                const f32x2 h1 = x0 + cmulf(L1, sin), h2 = x1 + cmulf(L2, sin), h3 = x2 + cmulf(L3, sin);
                Xl[(4 * fq + 0) * 68 + 16 * t + fr] = cvt_pk_bf16(sin.x, sin.y); Xl[(4 * fq + 1) * 68 + 16 * t + fr] = cvt_pk_bf16(h1.x, h1.y);
                Xl[(4 * fq + 2) * 68 + 16 * t + fr] = cvt_pk_bf16(h2.x, h2.y); Xl[(4 * fq + 3) * 68 + 16 * t + fr] = cvt_pk_bf16(h3.x, h3.y);
#if S5C_EOFF == 2
                { const f32x2 L8 = cmulf(L4, L4), L12 = cmulf(L8, L4); const f32x2 wgt = (fq == 3) ? (f32x2){1.f, 0.f} : (fq == 2) ? L4 : (fq == 1) ? L8 : L12;
                  f32x2 xe = cmulf(wgt, x3); xe.x += __shfl_xor(xe.x, 16); xe.y += __shfl_xor(xe.y, 16); xe.x += __shfl_xor(xe.x, 32); xe.y += __shfl_xor(xe.y, 32);
                  if (fq == 0 && seg < 32) WSP(f32x2, WS_Y)[((size_t)dbg * 32 + seg) * 64 + 16 * t + fr] = xe; }
#endif
            } else {
                st[t] = (f32x2){__shfl(fin.x, 48 + fr), __shfl(fin.y, 48 + fr)};
            }
        }
        if (!OUTPUT) {
            if (fq == 0) {
#pragma unroll
                for (int t = 0; t < 4; ++t) (S5C_EOFF == 1 ? WSP(f32x2, WS_Y) : (S5C_EOFF == 3 ? WSP(f32x2, WS_Y) + S5C_RUN * (1u << 20) : Eb))[((size_t)dbg * 32 + seg) * 64 + 16 * t + fr] = st[t];
            }
        } else {
            LDS_WAIT(); asm volatile("" ::: "memory");
            bf16x8 hfr[4];
#pragma unroll
            for (int ks = 0; ks < 4; ++ks) hfr[ks] = *(const LAS bf16x8*)(Xl + fr * 68 + 16 * ks + 4 * fq);
#ifdef S5_ZERO_CARRY
#pragma unroll
            for (int ks = 0; ks < 4; ++ks) hfr[ks] = (bf16x8){0,0,0,0,0,0,0,0};
#endif
            LDS_WAIT(); asm volatile("" ::: "memory");
            const bf16* w3p = W3 + ((size_t)dg * 256 + fr) * 128 + 8 * fq;
            const bf16* ktp = KT + (size_t)dg * 17 * 256 + fr * 16 + 8 * (fq & 1);
#pragma unroll
            for (int tau = 0; tau < 16; ++tau) {
                f32x4 y = {0.f, 0.f, 0.f, 0.f}; bf16x8 b3[4], bk[8];
#pragma unroll
                for (int ks = 0; ks < 4; ++ks) b3[ks] = *(const bf16x8*)(w3p + (size_t)tau * 16 * 128 + 32 * ks);
#pragma unroll
                for (int ks = 0; ks < 8; ++ks) { const int d1 = (ks <= tau / 2) ? tau - 2 * ks - (fq >> 1) + 1 : 0;
                    bk[ks] = *(const bf16x8*)(ktp + (size_t)d1 * 256); }
#pragma unroll
                for (int ks = 0; ks < 4; ++ks) y = __builtin_amdgcn_mfma_f32_16x16x32_bf16(hfr[ks], b3[ks], y, 0, 0, 0);
#pragma unroll
                for (int ks = 0; ks <= tau / 2; ++ks) y = __builtin_amdgcn_mfma_f32_16x16x32_bf16(afr[ks], bk[ks], y, 0, 0, 0);
                S5_KEEP4(y, b3); S5_KEEP8(y, bk); S5_KEEP8(y, afr); S5_KEEP4(y, hfr);
#pragma unroll
                for (int r = 0; r < 4; ++r) { const int s = s0 + 16 * (4 * fq + r) + tau, tl = (di == 0) ? s - CTX : SEQ - 1 - (s - CTX);
                    YD[(((size_t)(di * 2 + b) * 64 + g) * SEQ + tl) * 16 + fr] = y[r]; }
            }
        }
    }
}

#if S5C_EOFF
__device__ __forceinline__ void s5_check_phase(Frame& F) {
    const f32x2* Ea = (S5C_EOFF == 3) ? WSP(f32x2, WS_Y) + (1u << 20) : WSP(f32x2, WS_S5E); const f32x2* Ebn = WSP(f32x2, WS_Y); unsigned* flag = WSP(unsigned, WS_CTL) + 9000;
    const int gt = F.bid * NTHREADS + F.tid, NGT = F.G * NTHREADS;
    for (int idx = gt; idx < 256 * 32 * 64; idx += NGT) { const f32x2 a = Ea[idx], b = Ebn[idx];
        const float d = fabsf(a.x - b.x) + fabsf(a.y - b.y), m = fabsf(a.x) + fabsf(a.y) + fabsf(b.x) + fabsf(b.y);
        if (S5C_FILTER(idx) && !(d <= S5C_TOL * m + 1e-4f)) atomicAdd(flag, 1u); }
}
#endif

constexpr int NPHASES = 21;
#ifndef MK_SINGLE
#define MK_SINGLE 1
#endif

__device__ __forceinline__ unsigned long long launder_u64(unsigned long long v) {
    unsigned lo = (unsigned)v, hi = (unsigned)(v >> 32);
    asm volatile("" : "+v"(lo), "+v"(hi));
    lo = __builtin_amdgcn_readfirstlane(lo); hi = __builtin_amdgcn_readfirstlane(hi);
    return ((unsigned long long)hi << 32) | lo;
}
__device__ __forceinline__ const void* launder_ptr(const void* p) {
    unsigned long long v = (unsigned long long)p; unsigned lo = (unsigned)v, hi = (unsigned)(v >> 32);
    asm volatile("" : "+v"(lo), "+v"(hi));
    lo = __builtin_amdgcn_readfirstlane(lo); hi = __builtin_amdgcn_readfirstlane(hi);
    return (const void*)(((unsigned long long)hi << 32) | lo);
}
__device__ __forceinline__ void moe_blocks(Frame& F, int l, LAS int* bstart) {
    __syncthreads();
    if (F.tid == 0) { const unsigned* cnt = WSP(unsigned, WS_CTL) + CW_CNT + l * 64; int acc = 0;
        for (int e = 0; e < 64; ++e) { bstart[e] = acc; const int nb = ((int)cnt[e] + 255) >> 8; for (int j = 0; j < nb; ++j) bstart[65 + acc + j] = e; acc += nb; } bstart[64] = acc; }
    __syncthreads();
}

template <int PHSEL>
__global__ void __launch_bounds__(NTHREADS, 2) mk_fwd(Args args) {
    extern __shared__ __attribute__((aligned(16))) unsigned char lds_raw[];
    Frame F;
    F.lds = (LAS unsigned char*)lds_raw; F.ws = args.ws; F.kin = (const __attribute__((address_space(4))) unsigned long long*)__builtin_amdgcn_kernarg_segment_ptr();
    F.tid = threadIdx.x; F.lane = F.tid & 63; F.wave = __builtin_amdgcn_readfirstlane(F.tid >> 6); F.bid = blockIdx.x; F.G = gridDim.x;
    F.gw = F.bid * NWAVES + F.wave; F.NGW = F.G * NWAVES;
    volatile LAS unsigned* lctl = (volatile LAS unsigned*)(F.lds + LDS_CTL);
    LAS int* bstart = (LAS int*)(F.lds + LDS_CTL + 64);
    if (F.tid < 4) lctl[F.tid] = 0u;
    __syncthreads();
    const int lo = args.ph_lo, hi = args.ph_hi;
    XcdBarrier bar; bar.bar = WSP(unsigned, WS_CTL) + CW_BAR; bar.x = 0; bar.st = lctl;
    if (PHSEL < 0) bar = xcd_barrier_post(WSP(unsigned, WS_CTL) + CW_BAR, lctl);
#ifndef PH_MASK
#define PH_MASK 0xffffffffu
#endif
#define IN(k) (((PH_MASK >> (k)) & 1u) && (PHSEL < 0 || PHSEL == (k)))
#define INL(j) (((PH_MASK >> (6 + (j))) & 1u) && (PHSEL < 0 || (PHSEL == 6 + (j) && lo == pb + (j))))
#define PH_END(k) do { if (PHSEL < 0) xcd_barrier(bar); } while (0)
#ifndef PH_REPEAT
#define PH_REPEAT 0u
#endif
#define REP(k) for (int _rep = 0; _rep < (((PH_REPEAT >> (k)) & 1u) ? 2 : 1); ++_rep)
#define DUP(k) (((PH_REPEAT >> (k)) & 1u) != 0u)
#define PH_BEGIN() do { F.ws = (unsigned char*)launder_ptr((const void*)F.ws); F.kin = (const __attribute__((address_space(4))) unsigned long long*)launder_u64((unsigned long long)F.kin); \
    { int _t = threadIdx.x; asm volatile("" : "+v"(_t)); F.tid = _t; F.lane = _t & 63; F.wave = __builtin_amdgcn_readfirstlane(_t >> 6); \
      int _b = blockIdx.x; asm volatile("" : "+v"(_b)); F.bid = __builtin_amdgcn_readfirstlane(_b); F.gw = F.bid * NWAVES + F.wave; } } while (0)
    LAS unsigned char* lds = F.lds;
    const int G = F.G, bid = F.bid;
    constexpr long T2048 = 256L * 2048 * 2;

    if (IN(0)) { PH_BEGIN(); REP(0) { p0_prologue(F); __syncthreads(); } PH_END(0); }
    if (IN(1)) { PH_BEGIN(); p1_reduce(F); PH_END(1); }
#ifdef EXTRA_BARS
    xcd_barrier(bar); xcd_barrier(bar); xcd_barrier(bar); xcd_barrier(bar); xcd_barrier(bar); xcd_barrier(bar); xcd_barrier(bar); xcd_barrier(bar); xcd_barrier(bar); xcd_barrier(bar);
#endif
        if (IN(2)) { PH_BEGIN(); REP(2) norm_phase<0>(F, 0, nullptr); PH_END(2); }
        if (IN(3)) { PH_BEGIN();
#define BODY3 { pg8::Gemm g{(const bf16*)F.ws, (const bf16*)F.ws, 2048, 2048, 2048}; InProj0Order S; S.G = G; S.c = bid; \
              S.offA1 = (long)WS_HA; S.offB1 = (long)WS_WIN0; S.offA2 = (long)(WS_WIN0 + (size_t)3072 * 2048 * 2); S.offB2 = (long)WS_HA; \
              EpiInProj0 E{EpiQKP{WSP(bf16, WS_Q), WSP(bf16, WS_K), WSP(bf16, WS_P), WSP(f32x2, WS_ROPE)}, EpiVT{WSP(bf16, WS_VT)}}; pg8::gemm_phase<EpiInProj0, InProj0Order, false>(lds, g, S, E); }
            BODY3
            if constexpr (DUP(3)) { BODY3 }
#undef BODY3
            PH_END(3);
        }
        if (IN(4)) { PH_BEGIN(); REP(4) attn_phase(F); REP(21) poold_phase(F); PH_END(4); }
        if (IN(5)) { PH_BEGIN();
            pg8::Gemm g{WSP(bf16, WS_PD), WSP(bf16, WS_WPOOL), 1024, 256, 256}; pg8::StaticOrder S; S.init(TT / 256, 4, G, bid, 256L * 1024 * 2, 256L * 2, 256L * 256 * 2);
            EpiScaleBf16 E{WSP(bf16, WS_CAT), 2048, 1024, INP(14)}; pg8::gemm_phase<EpiScaleBf16, pg8::StaticOrder, false>(lds, g, S, E);
            PH_END(5);
        }
    {
    constexpr int pb = 6; constexpr int l = 0;
    if (INL(0)) { PH_BEGIN();
        float* xbuf = WSP(float, WS_X);
        pg8::Gemm g{WSP(bf16, WS_CAT), WSP(bf16, l == 0 ? WS_WOUT0 : WS_WOUT1), 2048, 2048, 2048}; pg8::StaticOrder S; S.init(l == 0 ? TT / 256 : TL / 256, 8, G, bid, T2048, 0, T2048);
        EpiRes E{l == 0 ? INP(0) : xbuf, l == 0 ? INP(2) : xbuf + (size_t)TL * 2048, xbuf, modp(F, l, 0, 2)}; pg8::gemm_phase<EpiRes, pg8::StaticOrder, false>(lds, g, S, E);
        PH_END(pb);
    }
    if (INL(1)) { PH_BEGIN(); ffn_norm_router_phase(F, l); PH_END(pb + 1); }
    if (INL(2)) { PH_BEGIN(); REP(8) {
        moe_blocks(F, l, bstart);
        pg8::Gemm g{WSP(bf16, WS_HA), (const bf16*)(F.ws + WS_WMOE + (size_t)l * MOE_L_BYTES), 2048, 2048, 2048};
        MoeOrder S{bstart, WSP(unsigned, WS_CTL) + CW_CNT + l * 64, WSP(int, WS_TOKL), 4, G, bid, bstart[64], T2048, 0, true};
        EpiMoeUp E{WSP(bf16, WS_H)}; pg8::gemm_phase<EpiMoeUp, MoeOrder, true>(lds, g, S, E); }
        PH_END(pb + 2);
    }
    if (INL(3)) { PH_BEGIN(); REP(9) {
        moe_blocks(F, l, bstart);
        pg8::Gemm g{WSP(bf16, WS_H), (const bf16*)(F.ws + WS_WMOE + (size_t)l * MOE_L_BYTES), 512, 512, 512};
        MoeOrder S{bstart, WSP(unsigned, WS_CTL) + CW_CNT + l * 64, WSP(int, WS_TOKL), 8, G, bid, bstart[64], 256L * 512 * 2, (long)(4 * MiB), false};
        EpiMoeDown E{WSP(bf16, WS_Y), WSP(int, WS_TOKL), WSP(float, WS_GATEL), WSP(unsigned, WS_CTL) + CW_CNT + l * 64}; pg8::gemm_phase<EpiMoeDown, MoeOrder, false>(lds, g, S, E); }
        PH_END(pb + 3);
    }
    }
        if (IN(10)) { PH_BEGIN(); norm_phase<2>(F, 1, nullptr); PH_END(10); }
        if (IN(11)) { PH_BEGIN();
#define BODY11             pg8::Gemm g{WSP(bf16, WS_HA), WSP(bf16, WS_WIN1), 2048, 2048, 2048}; pg8::StaticOrder S; S.init(TT / 256, 16, G, bid, T2048, 0, T2048); \
            EpiBf16 E{WSP(bf16, WS_PROJ1), 4096}; pg8::gemm_phase<EpiBf16, pg8::StaticOrder, false>(lds, g, S, E);
            BODY11
            if constexpr (DUP(11)) { BODY11 }
#undef BODY11
            PH_END(11);
        }
        if (IN(12)) { PH_BEGIN(); REP(12) shortconv_phase(F); REP(22) s5_chunk_phase<false>(F);
#if S5C_EOFF == 1
            s5_chunk_phase<false>(F);
#endif
#if S5C_EOFF == 3
            s5_chunk_phase<false, 0>(F); s5_chunk_phase<false, 1>(F);
#endif
 PH_END(12); }
        if (IN(13)) { PH_BEGIN();
#if S5C_EOFF == 1 || S5C_EOFF == 3
            s5_check_phase(F);
#endif
            REP(23) s5_chunk_phase<true>(F); __syncthreads(); REP(13) hyena_fft_phase(F); PH_END(13); }
        if (IN(14)) { PH_BEGIN();
#if S5C_EOFF == 2
            s5_check_phase(F);
#endif
 REP(14) { s5_gelu_phase(F); hyena_out_transpose(F); } PH_END(14); }
        if (IN(15)) { PH_BEGIN();
            pg8::Gemm g{WSP(bf16, WS_PD), WSP(bf16, WS_WGLU), 1024, 1024, 1024}; pg8::StaticOrder S; S.init(TL / 256, 4, G, bid, 256L * 1024 * 2, 0, 256L * 1024 * 2);
            EpiGlu E{WSP(bf16, WS_CAT), 2048, 1024, WSP(bf16, WS_PD), INP(35)}; pg8::gemm_phase<EpiGlu, pg8::StaticOrder, false>(lds, g, S, E);
            PH_END(15);
        }
    {
    constexpr int pb = 16; constexpr int l = 1;
    if (INL(0)) { PH_BEGIN();
        float* xbuf = WSP(float, WS_X);
        pg8::Gemm g{WSP(bf16, WS_CAT), WSP(bf16, l == 0 ? WS_WOUT0 : WS_WOUT1), 2048, 2048, 2048}; pg8::StaticOrder S; S.init(l == 0 ? TT / 256 : TL / 256, 8, G, bid, T2048, 0, T2048);
        EpiRes E{l == 0 ? INP(0) : xbuf, l == 0 ? INP(2) : xbuf + (size_t)TL * 2048, xbuf, modp(F, l, 0, 2)}; pg8::gemm_phase<EpiRes, pg8::StaticOrder, false>(lds, g, S, E);
        PH_END(pb);
    }
    if (INL(1)) { PH_BEGIN(); ffn_norm_router_phase(F, l); PH_END(pb + 1); }
    if (INL(2)) { PH_BEGIN(); REP(8) {
        moe_blocks(F, l, bstart);
        pg8::Gemm g{WSP(bf16, WS_HA), (const bf16*)(F.ws + WS_WMOE + (size_t)l * MOE_L_BYTES), 2048, 2048, 2048};
        MoeOrder S{bstart, WSP(unsigned, WS_CTL) + CW_CNT + l * 64, WSP(int, WS_TOKL), 4, G, bid, bstart[64], T2048, 0, true};
        EpiMoeUp E{WSP(bf16, WS_H)}; pg8::gemm_phase<EpiMoeUp, MoeOrder, true>(lds, g, S, E); }
        PH_END(pb + 2);
    }
    if (INL(3)) { PH_BEGIN(); REP(9) {
        moe_blocks(F, l, bstart);
        pg8::Gemm g{WSP(bf16, WS_H), (const bf16*)(F.ws + WS_WMOE + (size_t)l * MOE_L_BYTES), 512, 512, 512};
        MoeOrder S{bstart, WSP(unsigned, WS_CTL) + CW_CNT + l * 64, WSP(int, WS_TOKL), 8, G, bid, bstart[64], 256L * 512 * 2, (long)(4 * MiB), false};
        EpiMoeDown E{WSP(bf16, WS_Y), WSP(int, WS_TOKL), WSP(float, WS_GATEL), WSP(unsigned, WS_CTL) + CW_CNT + l * 64}; pg8::gemm_phase<EpiMoeDown, MoeOrder, false>(lds, g, S, E); }
        PH_END(pb + 3);
    }
    }
    if (IN(20)) { PH_BEGIN(); norm_phase<3>(F, 1, args.out);
#if S5C_EOFF
        if (WSP(unsigned, WS_CTL)[9000] != 0u) { for (int i = F.bid * NTHREADS + F.tid; i < TL * 2048; i += F.G * NTHREADS) args.out[i] = __builtin_nanf(""); }
#endif
    }
#undef IN
#undef INL
#undef PH_END
}

typedef void (*kern_t)(Args);
template <int P> static void launch_phase(int grid, hipStream_t stream, Args a) { hipLaunchKernelGGL(mk_fwd<P>, dim3(grid), dim3(NTHREADS), LDS_BYTES, stream, a); }
template <int P> static bool prep_phase() { return hipFuncSetAttribute((const void*)mk_fwd<P>, hipFuncAttributeMaxDynamicSharedMemorySize, LDS_BYTES) == hipSuccess; }
extern "C" void kernel_launch(void* const* d_in, const int* in_sizes, int n_in, void* d_out, int out_size, void* d_ws, size_t ws_size, hipStream_t stream) {
    static int grid = 0;
    if (grid == 0) {
        if (n_in != 43 || out_size != TL * DM || ws_size < WS_END) { fprintf(stderr, "kernel_launch: unexpected shapes (n_in %d, out %d, ws %zu < %zu)\n", n_in, out_size, ws_size, (size_t)WS_END); grid = -1; return; }
        int dev = 0, cus = 0;
        if (hipGetDevice(&dev) != hipSuccess || hipDeviceGetAttribute(&cus, hipDeviceAttributeMultiprocessorCount, dev) != hipSuccess) { grid = -1; return; }
        bool ok = true;
#if MK_SINGLE
        ok = prep_phase<-1>();
#else
        ok = prep_phase<0>() && prep_phase<1>() && prep_phase<2>() && prep_phase<3>() && prep_phase<4>() && prep_phase<5>() && prep_phase<6>() && prep_phase<7>() && prep_phase<8>() && prep_phase<9>() &&
             prep_phase<10>() && prep_phase<11>() && prep_phase<12>() && prep_phase<13>() && prep_phase<14>() && prep_phase<15>() && prep_phase<20>();
#endif
        if (!ok) { fprintf(stderr, "kernel_launch: hipFuncSetAttribute failed\n"); grid = -1; return; }
        (void)hipGetLastError();
        grid = cus;
    }
    if (grid < 0) return;
    (void)hipMemsetAsync((char*)d_ws + WS_CTL, 0, CTL_BYTES, stream);
    Args a{};
    for (int i = 0; i < 43; ++i) a.in[i] = (const float*)d_in[i];
    a.out = (float*)d_out; a.ws = (unsigned char*)d_ws;
#if MK_SINGLE
    a.ph_lo = 0; a.ph_hi = NPHASES;
    launch_phase<-1>(grid, stream, a);
#else
#define LP(k, P) a.ph_lo = (k); a.ph_hi = (k) + 1; launch_phase<P>(grid, stream, a);
    LP(0, 0) LP(1, 1) LP(2, 2) LP(3, 3) LP(4, 4) LP(5, 5) LP(6, 6) LP(7, 7) LP(8, 8) LP(9, 9) LP(10, 10) LP(11, 11) LP(12, 12) LP(13, 13) LP(14, 14) LP(15, 15)
    LP(16, 6) LP(17, 7) LP(18, 8) LP(19, 9) LP(20, 20)
#undef LP
#endif
}
```

```cpp
#include <hip/hip_runtime.h>
#include <cstdio>
#include <cstdint>
#include <cmath>

#define GAS __attribute__((address_space(1)))
#define LAS __attribute__((address_space(3)))
typedef unsigned short bf16;
typedef unsigned v4u __attribute__((ext_vector_type(4)));
typedef unsigned v2u __attribute__((ext_vector_type(2)));
typedef float f32x4 __attribute__((ext_vector_type(4)));
typedef float f32x2 __attribute__((ext_vector_type(2)));
typedef float f32x16 __attribute__((ext_vector_type(16)));
typedef short bf16x8 __attribute__((ext_vector_type(8)));
#define LDS_WAIT() asm volatile("s_waitcnt lgkmcnt(0)" ::: "memory")
#define VM_WAIT() asm volatile("s_waitcnt vmcnt(0)" ::: "memory")

__device__ __forceinline__ unsigned f2bf(float f) { unsigned u = __builtin_bit_cast(unsigned, f); return (u + 0x7fffu + ((u >> 16) & 1u)) >> 16; }
__device__ __forceinline__ unsigned pk2(float lo, float hi) { return f2bf(lo) | (f2bf(hi) << 16); }
__device__ __forceinline__ unsigned cvt_pk_bf16(float lo, float hi) { unsigned r; asm volatile("v_cvt_pk_bf16_f32 %0, %1, %2" : "=v"(r) : "v"(lo), "v"(hi)); return r; }
__device__ __forceinline__ float bf2f(unsigned short b) { return __builtin_bit_cast(float, (unsigned)b << 16); }
__device__ __forceinline__ float bflo(unsigned w) { return __builtin_bit_cast(float, w << 16); }
__device__ __forceinline__ float bfhi(unsigned w) { return __builtin_bit_cast(float, w & 0xffff0000u); }
__device__ __forceinline__ float wave_sum(float v) {
#pragma unroll
    for (int o = 1; o < 64; o <<= 1) v += __shfl_xor(v, o);
    return v;
}

namespace pg8 {
typedef unsigned short bf16_t;
constexpr int BM = 256, BK = 64, HALF = 128, HTB = HALF * BK * 2, STAGE_BYTES = 8 * HTB;

__host__ __device__ __forceinline__ int lds_byte(int r, int c) { const int st = (r >> 4) * 2 + (c >> 5), rr = r & 15, cc = c & 31, ob = rr * 64 + cc * 2; return st * 1024 + (ob ^ (((ob >> 9) & 1) << 5)); }
__host__ __device__ __forceinline__ void stage_rc(int b, int& R, int& C) { const int st = b / 1024, sb = b % 1024, swz = sb ^ (((sb >> 9) & 1) << 5); R = (st >> 1) * 16 + swz / 64; C = (st & 1) * 32 + (swz % 64) / 2; }

struct Unit { int pm, pn; long aoff, boff; int e, idx0; };
struct Gemm { const bf16_t* A; const bf16_t* Bt; int lda, ldb, K; };

template <class Epi, class Sched, bool GATHER>
__device__ __forceinline__ void gemm_phase(LAS unsigned char* lds, const Gemm g, const Sched& S, const Epi& E) {
    const int tid = threadIdx.x, wid = __builtin_amdgcn_readfirstlane(tid >> 6), lane = tid & 63, wr = wid >> 2, wc = wid & 3, fr = lane & 15, fq = lane >> 4;
    const int K = g.K, nt = K / BK;
    unsigned voffA[2], voffB[2];
#pragma unroll
    for (int i = 0; i < 2; ++i) { int R, C; stage_rc(tid * 16 + i * 8192, R, C);
        voffA[i] = (unsigned)(R * g.lda + C) * 2u; voffB[i] = (unsigned)(R * g.ldb + C) * 2u; }
    const size_t kstep = (size_t)(BK * 2);
    const size_t hstepA = GATHER ? 0 : (size_t)HALF * g.lda * 2, hstepB = (size_t)HALF * g.ldb * 2;
    const unsigned ldsw = (unsigned)wid * 1024u;
    const int aoff = lds_byte(wr * 64 + fr, fq * 8), boff = lds_byte(wc * 32 + fr, fq * 8);
#define PG8_SA(b, h) (((b) * 2 + (h)) * HTB)
#define PG8_SB(b, h) ((4 + (b) * 2 + (h)) * HTB)
#define PG8_STAGE(bufoff, gbase, voff) do { _Pragma("unroll") for (int _i = 0; _i < 2; ++_i) \
        __builtin_amdgcn_global_load_lds((const unsigned*)((const char*)(gbase) + (voff)[_i]), (LAS unsigned*)(lds + (bufoff) + ldsw + _i * 8192), 16, 0, 0); } while (0)
#define PG8_STAGE_A(bufoff, gbase, h, nx) do { if constexpr (GATHER) { unsigned _tv[2]; \
        if (nx) { int _tz = tid; asm volatile("" : "+v"(_tz)); _Pragma("unroll") for (int _j = 0; _j < 2; ++_j) { int _R, _C; stage_rc(_tz * 16 + _j * 8192, _R, _C); _tv[_j] = (unsigned)S.arow(nxt, (h) * HALF + _R) * (unsigned)(g.lda * 2) + (unsigned)(_C * 2); } } \
        else { _tv[0] = gvc[h][0]; _tv[1] = gvc[h][1]; } \
        PG8_STAGE(bufoff, gbase, _tv); } else { PG8_STAGE(bufoff, (gbase) + (h) * hstepA, voffA); } } while (0)
#define PG8_LDA(dst, b, h) do { _Pragma("unroll") for (int m = 0; m < 4; ++m) _Pragma("unroll") for (int k = 0; k < 2; ++k) dst[m][k] = *(const LAS bf16x8*)(lds + PG8_SA(b, h) + aoff + m * 2048 + k * 1024); } while (0)
#define PG8_LDB(dst, b, h) do { _Pragma("unroll") for (int n = 0; n < 2; ++n) _Pragma("unroll") for (int k = 0; k < 2; ++k) dst[n][k] = *(const LAS bf16x8*)(lds + PG8_SB(b, h) + boff + n * 2048 + k * 1024); } while (0)
#define PG8_MMA(ai, bj, At, Bt) do { __builtin_amdgcn_s_setprio(1); _Pragma("unroll") for (int m = 0; m < 4; ++m) _Pragma("unroll") for (int n = 0; n < 2; ++n) _Pragma("unroll") for (int k = 0; k < 2; ++k) \
        acc[ai][bj][m][n] = __builtin_amdgcn_mfma_f32_16x16x32_bf16(Bt[n][k], At[m][k], acc[ai][bj][m][n], 0, 0, 0); __builtin_amdgcn_s_setprio(0); } while (0)
#define PG8_WAIT_V(n) asm volatile("s_waitcnt vmcnt(" #n ")" ::: "memory")
#define PG8_WAIT_L(n) asm volatile("s_waitcnt lgkmcnt(" #n ")" ::: "memory")
#define PG8_BAR __builtin_amdgcn_s_barrier()
#define PG8_SCHED __builtin_amdgcn_sched_barrier(0)
    Unit cur, nxt; int ui = 0;
    if (!S.next(0, cur)) return;
    unsigned gvc[2][2];
#define PG8_GV(unit) do { if constexpr (GATHER) { int _tz = tid; asm volatile("" : "+v"(_tz)); _Pragma("unroll") for (int _h = 0; _h < 2; ++_h) _Pragma("unroll") for (int _j = 0; _j < 2; ++_j) { int _R, _C; stage_rc(_tz * 16 + _j * 8192, _R, _C); \
        gvc[_h][_j] = (unsigned)S.arow(unit, _h * HALF + _R) * (unsigned)(g.lda * 2) + (unsigned)(_C * 2); } } } while (0)
    PG8_GV(cur);
    f32x4 acc[2][2][4][2];
#pragma unroll
    for (int a = 0; a < 2; ++a)
#pragma unroll
        for (int b = 0; b < 2; ++b)
#pragma unroll
            for (int m = 0; m < 4; ++m)
#pragma unroll
                for (int n = 0; n < 2; ++n) acc[a][b][m][n] = (f32x4){0.f, 0.f, 0.f, 0.f};
    bf16x8 At[4][2], B0[2][2], B1[2][2];
    const char* cA = (const char*)g.A + cur.aoff; const char* cB = (const char*)g.Bt + cur.boff;
    PG8_STAGE(PG8_SB(0, 0), cB, voffB); PG8_STAGE(PG8_SB(0, 1), cB + hstepB, voffB); PG8_STAGE_A(PG8_SA(0, 0), cA, 0, false); PG8_STAGE_A(PG8_SA(0, 1), cA, 1, false);
    if (wr == 1) PG8_BAR;
    PG8_WAIT_V(2); PG8_BAR;
    PG8_STAGE(PG8_SB(1, 0), cB + kstep, voffB); PG8_STAGE_A(PG8_SA(1, 0), cA + kstep, 0, false); PG8_STAGE(PG8_SB(1, 1), cB + hstepB + kstep, voffB);
    PG8_WAIT_V(6); PG8_BAR;
    for (;;) {
        const bool has_next = S.next(ui + 1, nxt);
        const char* nA = has_next ? (const char*)g.A + nxt.aoff : cA; const char* nB = has_next ? (const char*)g.Bt + nxt.boff : cB;
#pragma nounroll
        for (int t = 0; t < nt; t += 2) {
            const bool last = (t == nt - 2);
            const char* a1 = cA + (size_t)(t + 1) * kstep;
            const char* a2 = last ? nA : cA + (size_t)(t + 2) * kstep; const char* b2 = last ? nB : cB + (size_t)(t + 2) * kstep;
            const char* a3 = a2 + kstep; const char* b3 = b2 + kstep;
            PG8_LDB(B0, 0, 0); PG8_LDB(B1, 0, 1); PG8_SCHED; PG8_LDA(At, 0, 0); PG8_STAGE_A(PG8_SA(1, 1), a1, 1, false);
            PG8_WAIT_V(8); PG8_WAIT_L(0); PG8_BAR; PG8_MMA(0, 0, At, B0); PG8_MMA(0, 1, At, B1); PG8_BAR; PG8_SCHED;
            PG8_LDA(At, 0, 1); PG8_STAGE(PG8_SB(0, 0), b2, voffB); PG8_STAGE(PG8_SB(0, 1), b2 + hstepB, voffB); PG8_STAGE_A(PG8_SA(0, 0), a2, 0, last);
            PG8_WAIT_V(8); PG8_WAIT_L(0); PG8_BAR; PG8_MMA(1, 0, At, B0); PG8_MMA(1, 1, At, B1); PG8_BAR; PG8_SCHED;
            PG8_LDB(B0, 1, 0); PG8_LDB(B1, 1, 1); PG8_SCHED; PG8_LDA(At, 1, 0); PG8_STAGE_A(PG8_SA(0, 1), a2, 1, last);
            PG8_WAIT_V(8); PG8_WAIT_L(0); PG8_BAR; PG8_MMA(0, 0, At, B0); PG8_MMA(0, 1, At, B1); PG8_BAR; PG8_SCHED;
            PG8_LDA(At, 1, 1); PG8_STAGE(PG8_SB(1, 0), b3, voffB); PG8_STAGE(PG8_SB(1, 1), b3 + hstepB, voffB); PG8_STAGE_A(PG8_SA(1, 0), a3, 0, last);
            PG8_WAIT_V(8); PG8_WAIT_L(0); PG8_BAR; PG8_MMA(1, 0, At, B0); PG8_MMA(1, 1, At, B1); PG8_BAR; PG8_SCHED;
        }
        if (wr == 0) PG8_BAR;
        E(acc, cur, wr, wc, fr, fq);
        if (!has_next) break;
#pragma unroll
        for (int a = 0; a < 2; ++a)
#pragma unroll
            for (int b = 0; b < 2; ++b)
#pragma unroll
                for (int m = 0; m < 4; ++m)
#pragma unroll
                    for (int n = 0; n < 2; ++n) acc[a][b][m][n] = (f32x4){0.f, 0.f, 0.f, 0.f};
        cur = nxt; cA = nA; cB = nB; ++ui;
        PG8_GV(cur);
        if (wr == 1) PG8_BAR;
    }
    PG8_WAIT_V(0);
    PG8_BAR;
#undef PG8_SA
#undef PG8_SB
#undef PG8_STAGE
#undef PG8_STAGE_A
#undef PG8_GV
#undef PG8_LDA
#undef PG8_LDB
#undef PG8_MMA
#undef PG8_WAIT_V
#undef PG8_WAIT_L
#undef PG8_BAR
#undef PG8_SCHED
}

struct StaticOrder {
    int nM, nN, nwg, G, c; long astride, apn, bstride;
    __device__ void init(int nM_, int nN_, int G_, int c_, long astride_, long apn_, long bstride_) { nM = nM_; nN = nN_; nwg = nM * nN; G = G_; c = c_; astride = astride_; apn = apn_; bstride = bstride_; }
    __device__ bool next(int i, Unit& u) const {
        const long Lx = (long)i * G + c; if (Lx >= nwg) return false;
        int wgid = (int)Lx; { const int q = nwg / 8, r = nwg % 8, xcd = wgid % 8, off = wgid / 8; wgid = (xcd < r ? xcd * (q + 1) : r * (q + 1) + (xcd - r) * q) + off; }
        const int nig = 8 * nN, gid = wgid / nig, fm = gid * 8, gsz = (nM - fm) < 8 ? (nM - fm) : 8;
        u.pm = fm + ((wgid % nig) % gsz); u.pn = (wgid % nig) / gsz; u.aoff = (long)u.pm * astride + (long)u.pn * apn; u.boff = (long)u.pn * bstride; u.e = 0; u.idx0 = 0; return true;
    }
    __device__ int arow(const Unit&, int) const { return 0; }
};
}

constexpr int DM = 2048, NBATCH = 2, SEQ = 8192, CTX = 256;
constexpr int TL = NBATCH * SEQ;
constexpr int TC = NBATCH * CTX;
constexpr int TT = TL + TC;
constexpr int KEYS = CTX + SEQ;
constexpr int NEXP = 64, DEXP = 512;
constexpr int LISTCAP = 2 * TT;
constexpr float EPS = 1e-6f;
constexpr float QSCALE = 0.125f * 1.4426950408889634f;
constexpr int NWAVES = 8, NTHREADS = 512;

constexpr size_t MiB = 1u << 20;
constexpr size_t WS_CTL = 0, CTL_BYTES = 1 * MiB;
constexpr size_t WS_WIN0 = 1 * MiB;
constexpr size_t WS_WOUT0 = WS_WIN0 + 16 * MiB;
constexpr size_t WS_WIN1 = WS_WOUT0 + 8 * MiB;
constexpr size_t WS_WOUT1 = WS_WIN1 + 16 * MiB;
constexpr size_t WS_WPOOL = WS_WOUT1 + 8 * MiB;
constexpr size_t WS_WGLU = WS_WPOOL + 1 * MiB;
constexpr size_t WS_WMOE = WS_WGLU + 2 * MiB;
constexpr size_t MOE_E_BYTES = 6 * MiB, MOE_L_BYTES = 64 * MOE_E_BYTES;
constexpr size_t WS_X = WS_WMOE + 2 * MOE_L_BYTES;
constexpr size_t WS_HA = WS_X + 132 * MiB;
constexpr size_t WS_Q = WS_HA + 67 * MiB;
constexpr size_t WS_K = WS_Q + 33 * MiB;
constexpr size_t WS_VT = WS_K + 33 * MiB;
constexpr size_t WS_P = WS_VT + 33 * MiB;
constexpr size_t WS_PROJ1 = WS_Q;
constexpr size_t WS_CAT = WS_P + 33 * MiB;
constexpr size_t WS_PD = WS_CAT + 66 * MiB;
constexpr size_t WS_H = WS_PD + 33 * MiB;
constexpr size_t WS_Y = WS_H + 49 * MiB;
constexpr size_t WS_GT = WS_Y + 132 * MiB;
constexpr size_t WS_KT = WS_GT + 192 * MiB;
constexpr size_t WS_YD = WS_KT + 128 * MiB;
constexpr size_t WS_MISC = WS_YD + 128 * MiB;
constexpr size_t WS_MOD = WS_MISC;
constexpr size_t WS_ADAP = WS_MOD + 1 * MiB;
constexpr size_t WS_ROPE = WS_ADAP + 10 * MiB;
constexpr size_t WS_NORMP = WS_ROPE + 1 * MiB;
constexpr size_t WS_INVN = WS_NORMP + 4 * MiB;
constexpr size_t WS_S5LAM = WS_INVN + 1 * MiB;
constexpr size_t WS_S5B = WS_S5LAM + 1 * MiB;
constexpr size_t WS_WRT = WS_S5B + 2 * MiB;
constexpr size_t WS_TOKL = WS_WRT + 2 * MiB;
constexpr size_t WS_GATEL = WS_TOKL + 9 * MiB;
constexpr size_t WS_TW = WS_GATEL + 9 * MiB;
constexpr size_t WS_FFTW = WS_TW + 1 * MiB;
constexpr size_t WS_S5L256 = WS_FFTW + 32 * MiB;
constexpr size_t WS_S5E = WS_S5L256 + 1 * MiB;
constexpr size_t WS_YHT = WS_S5E + 4 * MiB;
constexpr size_t WS_S5L16 = WS_YHT + 64 * MiB;
constexpr size_t WS_S5W1 = WS_S5L16 + 1 * MiB;
constexpr size_t WS_S5W3 = WS_S5W1 + 8 * MiB;
constexpr size_t WS_S5KT = WS_S5W3 + 8 * MiB;
constexpr size_t WS_END = WS_S5KT + 2 * MiB;
static_assert(WS_END <= 2040 * MiB, "d_ws map");
constexpr int CW_BAR = 1024;
constexpr int CW_CNT = 8192;

constexpr int LDS_PHASE = 131072;
constexpr int LDS_CTL = 147456 - 2048;
constexpr int LDS_BYTES = 147456;

#define XB_TMO      128
#define XB_XCNT(j)  (256  + 64 * (j))
#define XB_XSUB(j)  (1280 + 64 * (j))
#define XB_XGEN(j)  (2304 + 64 * (j))
#define XB_TOP      3328
#define XB_TOPGEN   3392
#define XCD_BAR_WORDS 3456
#define XB_SPIN_CAP (1u << 22)

__device__ __forceinline__ unsigned xb_ld(unsigned* p)              { return __hip_atomic_load(p, __ATOMIC_RELAXED, __HIP_MEMORY_SCOPE_AGENT); }
__device__ __forceinline__ unsigned xb_add(unsigned* p, unsigned v) { return __hip_atomic_fetch_add(p, v, __ATOMIC_RELAXED, __HIP_MEMORY_SCOPE_AGENT); }
__device__ __forceinline__ unsigned xb_xcc_id() { return (unsigned)__builtin_amdgcn_s_getreg((3 << 11) | 20) & 0xFu; }
#define XB_SPIN(cond, bar) do { unsigned _sp = 0; while (cond) { __builtin_amdgcn_s_sleep(1); \
    if ((++_sp & 255u) == 0u) { if (xb_ld(&(bar)[XB_TMO])) break; if (_sp > XB_SPIN_CAP) { atomicAdd(&(bar)[XB_TMO], 1u); break; } } } } while (0)

struct XcdBarrier { unsigned* bar; unsigned x; volatile LAS unsigned* st; };

__device__ __forceinline__ XcdBarrier xcd_barrier_post(unsigned* bar, volatile LAS unsigned* st) {
    XcdBarrier b; b.bar = bar; b.x = xb_xcc_id(); b.st = st;
    if (threadIdx.x == 0) (void)xb_add(&bar[XB_XCNT(b.x)], 1u);
    return b;
}
__device__ __forceinline__ void xcd_barrier_complete(unsigned* bar, unsigned x, unsigned& nloc, unsigned& nx) {
    const unsigned G = gridDim.x * gridDim.y * gridDim.z;
    unsigned sum, cnt, mine, sp = 0u;
    for (;;) {
        sum = 0u; cnt = 0u; mine = 0u;
#pragma unroll
        for (unsigned j = 0; j < 16; ++j) { const unsigned c = xb_ld(&bar[XB_XCNT(j)]); sum += c; cnt += (c > 0u) ? 1u : 0u; mine = (j == x) ? c : mine; }
        if (sum == G) break;
        __builtin_amdgcn_s_sleep(1);
        if ((++sp & 255u) == 0u) { if (xb_ld(&bar[XB_TMO])) break; if (sp > XB_SPIN_CAP) { atomicAdd(&bar[XB_TMO], 1u); break; } }
    }
    nloc = mine > 0u ? mine : 1u; nx = cnt > 0u ? cnt : 1u;
}
__device__ __forceinline__ void xcd_barrier(const XcdBarrier& b) {
    asm volatile("s_waitcnt vmcnt(0)" ::: "memory");
    __syncthreads();
    if (threadIdx.x == 0) {
        unsigned* bar = b.bar;
        __builtin_amdgcn_s_waitcnt(0);
        unsigned nloc = b.st[0], nx = b.st[1];
        if (nloc == 0u) { xcd_barrier_complete(bar, b.x, nloc, nx); b.st[0] = nloc; b.st[1] = nx; }
        const unsigned old = xb_add(&bar[XB_XSUB(b.x)], 1u);
        const unsigned gen = old / nloc;
        if (old + 1u == (gen + 1u) * nloc) {
            __builtin_amdgcn_fence(__ATOMIC_RELEASE, "agent");
            asm volatile("s_waitcnt vmcnt(0)" ::: "memory");
            const unsigned og = xb_add(&bar[XB_TOP], 1u);
            const unsigned tg = og / nx;
            if (og + 1u == (tg + 1u) * nx) xb_add(&bar[XB_TOPGEN], 1u);
            else XB_SPIN(xb_ld(&bar[XB_TOPGEN]) == tg, bar);
            __builtin_amdgcn_fence(__ATOMIC_ACQUIRE, "agent");
            xb_add(&bar[XB_XGEN(b.x)], 1u);
            asm volatile("s_waitcnt vmcnt(0)" ::: "memory");
        } else {
            XB_SPIN(xb_ld(&bar[XB_XGEN(b.x)]) == gen, bar);
            __builtin_amdgcn_fence(__ATOMIC_ACQUIRE, "agent");
            asm volatile("s_waitcnt vmcnt(0)" ::: "memory");
        }
    }
    __syncthreads();
}

__device__ __forceinline__ void sincos_2pi(double x, double& s, double& c) {
    const double q = __builtin_rint(x * 4.0);
    const double y = (x - q * 0.25) * 6.283185307179586476925;
    const double y2 = y * y;
    double sp = -7.6471637318198164759e-13; sp = sp * y2 + 1.6059043836821614599e-10; sp = sp * y2 - 2.5052108385441718775e-8; sp = sp * y2 + 2.7557319223985890653e-6;
    sp = sp * y2 - 1.9841269841269841270e-4; sp = sp * y2 + 8.3333333333333333333e-3; sp = sp * y2 - 1.6666666666666666667e-1; sp = sp * y2 * y + y;
    double cp = 4.7794773323873852974e-14; cp = cp * y2 - 1.1470745597729724714e-11; cp = cp * y2 + 2.0876756987868098979e-9; cp = cp * y2 - 2.7557319223985890653e-7;
    cp = cp * y2 + 2.4801587301587301587e-5; cp = cp * y2 - 1.3888888888888888889e-3; cp = cp * y2 + 4.1666666666666666667e-2; cp = cp * y2 - 0.5; cp = cp * y2 + 1.0;
    const int qi = ((int)q) & 3;
    s = (qi == 0) ? sp : (qi == 1) ? cp : (qi == 2) ? -sp : -cp;
    c = (qi == 0) ? cp : (qi == 1) ? -sp : (qi == 2) ? -cp : sp;
}
__device__ __forceinline__ void sincos_rad(double a, double& s, double& c) {
    double f = a * 0.15915494309189533576888; f -= __builtin_floor(f);
    if (f >= 1.0) f = 0.0;
    sincos_2pi(f, s, c);
}
__device__ __forceinline__ double exp_small(double x) {
    double r = 1.0 / 479001600.0;
    r = r * x + 1.0 / 39916800.0; r = r * x + 1.0 / 3628800.0; r = r * x + 1.0 / 362880.0; r = r * x + 1.0 / 40320.0; r = r * x + 1.0 / 5040.0;
    r = r * x + 1.0 / 720.0; r = r * x + 1.0 / 120.0; r = r * x + 1.0 / 24.0; r = r * x + 1.0 / 6.0; r = r * x + 0.5; r = r * x + 1.0; r = r * x + 1.0;
    return r;
}
__device__ __forceinline__ float fast_exp(float x) { return __builtin_amdgcn_exp2f(x * 1.4426950408889634f); }
__device__ __forceinline__ float sigmoidf_(float x) { return 1.0f / (1.0f + fast_exp(-x)); }
__device__ __forceinline__ float siluf_(float x) { return x * sigmoidf_(x); }
__device__ __forceinline__ float tanhf_(float x) { const float e = fast_exp(-2.0f * fabsf(x)); const float t = (1.0f - e) / (1.0f + e); return x < 0.f ? -t : t; }
__device__ __forceinline__ float gelu_tanh(float x) { return 0.5f * x * (1.0f + tanhf_(0.7978845608028654f * (x + 0.044715f * x * x * x))); }

#ifndef PH_REPEAT
#define PH_REPEAT 0u
#endif
struct Args { const float* in[43]; float* out; unsigned char* ws; int ph_lo, ph_hi; };

struct Frame {
    LAS unsigned char* lds; unsigned char* ws; int tid, lane, wave, bid, G, gw, NGW;
    const __attribute__((address_space(4))) unsigned long long* kin;
};
#define INP(i) ((const float*)F.kin[i])
#define WSP(T, off) ((T*)(F.ws + (off)))

__device__ __forceinline__ void tr_item(const float* W, int ldw, int N, bf16* WT, int ldt, int row_off, int rs16, LAS float* scr, int item, int lane) {
    const int nblk = N / 64, kb = item / nblk, nb = item % nblk, k0 = 64 * kb, n0 = 64 * nb;
    const int la = lane & 15, lb = lane >> 4;
    f32x4 v[16];
#pragma unroll
    for (int i = 0; i < 16; ++i) v[i] = *(const f32x4*)(W + (size_t)(k0 + 4 * i + lb) * ldw + n0 + 4 * la);
#pragma unroll
    for (int i = 0; i < 16; ++i) { const int kk = 4 * i + lb; LAS float* d = scr + (4 * la) * 65 + kk; d[0] = v[i].x; d[65] = v[i].y; d[130] = v[i].z; d[195] = v[i].w; }
    LDS_WAIT(); asm volatile("" ::: "memory");
    const int c = lane & 7;
#pragma unroll
    for (int j = 0; j < 8; ++j) { const int n = (lane >> 3) + 8 * j; const LAS float* s = scr + n * 65 + 8 * c;
        v4u o; o.x = cvt_pk_bf16(s[0], s[1]); o.y = cvt_pk_bf16(s[2], s[3]); o.z = cvt_pk_bf16(s[4], s[5]); o.w = cvt_pk_bf16(s[6], s[7]);
        const int nn = n0 + n, drow = row_off + (nn >> 4) * rs16 + (nn & 15);
        *(v4u*)(WT + (size_t)drow * ldt + k0 + 8 * c) = o; }
    LDS_WAIT(); asm volatile("" ::: "memory");
}

__device__ __forceinline__ void hyfilt_item(Frame& F, int pb) {
    const float* w1 = INP(19); const float* b1 = INP(20); const float* fq = INP(21); const float* w2 = INP(22); const float* b2 = INP(23); const float* w3 = INP(24);
    LAS float* z = (LAS float*)F.lds;
    LAS float* h1 = z + 1088;
    LAS float* h2 = h1 + 2048;
    const int tid = F.tid;
    for (int idx = tid; idx < 32 * 33; idx += NTHREADS) {
        const int p = idx / 33, f = idx % 33, i = pb * 32 + p;
        float v;
        if (f == 0) v = (float)i * (1.0f / (float)(SEQ - 1));
        else { const int j = (f - 1) & 15; const float fj = 1e-4f + (float)j * ((15.0f - 1e-4f) / 15.0f);
            double fr = (double)fj * (double)i / (double)SEQ; fr -= __builtin_floor(fr); double s, c; sincos_2pi(fr, s, c); v = (f <= 16) ? (float)c : (float)(-s); }
        z[p * 33 + f] = v;
    }
    __syncthreads();
    for (int idx = tid; idx < 2048; idx += NTHREADS) {
        const int p = idx >> 6, j = idx & 63; float a = b1[j];
        for (int f = 0; f < 33; ++f) a += z[p * 33 + f] * w1[f * 64 + j];
        double s, c; sincos_rad((double)(fq[j] * a), s, c); h1[idx] = (float)s;
    }
    __syncthreads();
    for (int idx = tid; idx < 2048; idx += NTHREADS) {
        const int p = idx >> 6, j = idx & 63; float a = b2[j];
        for (int k = 0; k < 64; ++k) a += h1[p * 64 + k] * w2[k * 64 + j];
        double s, c; sincos_rad((double)(fq[64 + j] * a), s, c); h2[idx] = (float)s;
    }
    __syncthreads();
    float* kT = WSP(float, WS_KT); float* normp = WSP(float, WS_NORMP);
    {
        const int lane = F.lane, l31 = lane & 31, lh = lane >> 5;
        float af[32];
#pragma unroll
        for (int s = 0; s < 32; ++s) af[s] = h2[l31 * 64 + 2 * s + lh];
        for (int ct = F.wave; ct < 128; ct += NWAVES) {
            const int col = ct * 32 + l31;
            f32x16 acc;
#pragma unroll
            for (int r = 0; r < 16; ++r) acc[r] = 0.f;
            float bv[32];
#pragma unroll
            for (int s = 0; s < 32; ++s) bv[s] = w3[(size_t)(2 * s + lh) * 4096 + col];
#pragma unroll
            for (int s = 0; s < 32; ++s) acc = __builtin_amdgcn_mfma_f32_32x32x2f32(af[s], bv[s], acc, 0, 0, 0);
#pragma unroll
            for (int s = 0; s < 32; s += 8) asm volatile("" : "+v"(acc) : "v"(bv[s]), "v"(bv[s + 1]), "v"(bv[s + 2]), "v"(bv[s + 3]), "v"(bv[s + 4]), "v"(bv[s + 5]), "v"(bv[s + 6]), "v"(bv[s + 7]));
            const int ch = col & 1023, dir = (col >> 10) & 1;
            const float adel = 3.0701134573253946f + (float)ch * ((15.350567286626972f - 3.0701134573253946f) / 1023.0f);
            float sabs = 0.f;
#pragma unroll
            for (int r = 0; r < 16; ++r) { const int i = pb * 32 + (r & 3) + 8 * (r >> 2) + 4 * lh; const float t = (float)i * (1.0f / (float)(SEQ - 1)); acc[r] *= fast_exp(-t * adel); if (!(dir == 1 && i == 0)) sabs += fabsf(acc[r]); }
            sabs += __shfl_xor(sabs, 32);
#pragma unroll
            for (int q = 0; q < 4; ++q) *(f32x4*)(kT + (size_t)col * SEQ + pb * 32 + 8 * q + 4 * lh) = (f32x4){acc[4 * q], acc[4 * q + 1], acc[4 * q + 2], acc[4 * q + 3]};
            if (lh == 0) normp[(size_t)pb * 4096 + col] = sabs;
        }
    }
    __syncthreads();
}

__device__ __forceinline__ void tr_wg_item(Frame& F, const float* W, int ldw, bf16* WT, int ldt, int row_off, int rs16, int k0, int n0) {
    LAS float* T = (LAS float*)F.lds;
    const int t = F.tid;
    f32x4 v[16];
#pragma unroll
    for (int i = 0; i < 16; ++i) v[i] = *(const f32x4*)(W + (size_t)(k0 + 4 * i + (t >> 7)) * ldw + n0 + 4 * (t & 127));
#pragma unroll
    for (int i = 0; i < 16; ++i) { const int k = 4 * i + (t >> 7); *(LAS f32x4*)(T + k * 516 + ((4 * (t & 127) + 8 * (k >> 3)) & 511)) = v[i]; }
    __syncthreads();
    const int c = (t >> 3) & 7, nl = (t & 7) | ((t >> 6) << 3);
#pragma unroll
    for (int q = 0; q < 8; ++q) { const int n = 64 * q + nl; const LAS float* s = T + (8 * c) * 516 + ((n + 8 * c) & 511);
        v4u o; o.x = cvt_pk_bf16(s[0], s[516]); o.y = cvt_pk_bf16(s[2 * 516], s[3 * 516]); o.z = cvt_pk_bf16(s[4 * 516], s[5 * 516]); o.w = cvt_pk_bf16(s[6 * 516], s[7 * 516]);
        const int nn = n0 + n, drow = row_off + (nn >> 4) * rs16 + (nn & 15);
        *(v4u*)(WT + (size_t)drow * ldt + k0 + 8 * c) = o; }
    __syncthreads();
}

__device__ __forceinline__ void p0_prologue(Frame& F) {
    for (int rep = 0; rep < (((PH_REPEAT >> 25) & 1u) ? 2 : 1); ++rep)
    for (int pb = F.bid; pb < SEQ / 32; pb += F.G) hyfilt_item(F, pb);
    for (int rep = 0; rep < (((PH_REPEAT >> 24) & 1u) ? 2 : 1); ++rep)
    for (int it = F.bid; it < 128 * 96; it += F.G) {
        const int le = it / 96, q = it % 96;
        bf16* wc = (bf16*)(F.ws + WS_WMOE + (size_t)le * MOE_E_BYTES); bf16* w2t = wc + 1024 * 2048;
        if (q < 32) tr_wg_item(F, INP(40) + (size_t)le * (2048 * 512), 512, wc, 2048, 0, 32, 64 * q, 0);
        else if (q < 64) tr_wg_item(F, INP(41) + (size_t)le * (2048 * 512), 512, wc, 2048, 16, 32, 64 * (q - 32), 0);
        else { const int r = q - 64; tr_wg_item(F, INP(42) + (size_t)le * (512 * 2048), 2048, w2t, 512, 0, 16, 64 * (r >> 2), 512 * (r & 3)); }
    }
    const int gt = F.bid * NTHREADS + F.tid, NGT = F.G * NTHREADS;
    {
        f32x2* rope = WSP(f32x2, WS_ROPE);
        for (int idx = gt; idx < 128 * 16; idx += NGT) { const int pos = idx >> 4, i = idx & 15;
            double inv = (i & 3) == 0 ? 1.0 : (i & 3) == 1 ? 0.56234132519034908 : (i & 3) == 2 ? 0.31622776601683794 : 0.17782794100389228;
            inv *= (i >> 2) == 0 ? 1.0 : (i >> 2) == 1 ? 0.1 : (i >> 2) == 2 ? 0.01 : 0.001;
            const float ang = (float)pos * (float)inv; double s, c; sincos_rad((double)ang, s, c); rope[idx] = (f32x2){(float)c, (float)s}; }
    }
    {
        f32x2* tw = WSP(f32x2, WS_TW);
        for (int idx = gt; idx < 16384; idx += NGT) { double s, c; sincos_2pi((double)idx * (1.0 / 16384.0), s, c); tw[idx] = (f32x2){(float)c, (float)(-s)}; }
    }
    {
        const float* are = INP(26); const float* aim = INP(27); const float* ldt = INP(28); const float* bre = INP(29); const float* bim = INP(30);
        f32x2* lamb = WSP(f32x2, WS_S5LAM); f32x2* bb = WSP(f32x2, WS_S5B); f32x2* l256 = WSP(f32x2, WS_S5L256);
        for (int idx = gt; idx < 2 * 64 * 64; idx += NGT) { const int dg = idx >> 6;
            const float dt = expf(ldt[dg]); const float ar = are[idx], ai = aim[idx];
            const float zr = ar * dt, zi = ai * dt; double s, c; sincos_rad((double)zi, s, c); const double er = exp_small((double)zr);
            const double lr = er * c, li = er * s; lamb[idx] = (f32x2){(float)lr, (float)li};
            { double pr = lr, pi = li; for (int q = 0; q < 8; ++q) { const double tr = pr * pr - pi * pi, ti = 2.0 * pr * pi; pr = tr; pi = ti; } l256[idx] = (f32x2){(float)pr, (float)pi}; }
            const double nr = lr - 1.0, ni = li, den = (double)ar * ar + (double)ai * ai; const double qr = (nr * ar + ni * ai) / den, qi = (ni * ar - nr * ai) / den;
            for (int cc = 0; cc < 16; ++cc) { const double br = bre[(size_t)idx * 16 + cc], bi = bim[(size_t)idx * 16 + cc]; bb[(size_t)idx * 16 + cc] = (f32x2){(float)(qr * br - qi * bi), (float)(qr * bi + qi * br)}; } }
    }
    {
        float* wrt = WSP(float, WS_WRT);
        for (int idx = gt; idx < 2 * 72 * 2048; idx += NGT) { const int l = idx / (72 * 2048), r = idx % (72 * 2048), n = r / 2048, k = r % 2048;
            wrt[idx] = n < 8 ? INP(36)[((size_t)l * 2048 + k) * 8 + n] : INP(38)[((size_t)l * 2048 + k) * 64 + (n - 8)]; }
    }
    {
        bf16* ha = WSP(bf16, WS_HA);
        for (int idx = gt; idx < 2048; idx += NGT) ha[(size_t)TT * 2048 + idx] = 0;
    }
    LAS float* scr = (LAS float*)(F.lds + F.wave * 16896);
    {
        const float* c = INP(1); const float* cctx = INP(3); const float* adaw = INP(4); float* part = WSP(float, WS_ADAP);
        for (int rep = 0; rep < (((PH_REPEAT >> 26) & 1u) ? 2 : 1); ++rep)
        for (int it = F.gw; it < 2 * 32 * 48; it += F.NGW) {
            const int l = it / (32 * 48), r = it % (32 * 48), ks = r / 48, jb = r % 48, k0 = ks * 64, j0 = jb * 256 + F.lane * 4;
            const float c0 = c[k0 + F.lane], c1 = c[2048 + k0 + F.lane], c2 = cctx[k0 + F.lane];
            const float s0 = c0 / (1.0f + expf(-c0)), s1 = c1 / (1.0f + expf(-c1)), s2 = c2 / (1.0f + expf(-c2));
            f32x4 a0 = {0.f, 0.f, 0.f, 0.f}, a1 = a0, a2 = a0;
            const float* wp = adaw + ((size_t)l * 2048 + k0) * 12288 + j0;
#pragma unroll 8
            for (int kk = 0; kk < 64; ++kk) { const f32x4 w = *(const f32x4*)(wp + (size_t)kk * 12288);
                const float t0 = __builtin_bit_cast(float, __builtin_amdgcn_readlane(__builtin_bit_cast(int, s0), kk));
                const float t1 = __builtin_bit_cast(float, __builtin_amdgcn_readlane(__builtin_bit_cast(int, s1), kk));
                const float t2 = __builtin_bit_cast(float, __builtin_amdgcn_readlane(__builtin_bit_cast(int, s2), kk));
                a0 += w * t0; a1 += w * t1; a2 += w * t2; }
            float* pp = part + ((size_t)(l * 32 + ks) * 3) * 12288 + j0;
            *(f32x4*)(pp) = a0; *(f32x4*)(pp + 12288) = a1; *(f32x4*)(pp + 2 * 12288) = a2;
        }
    }
    {
        constexpr int I0 = 1024, I1 = 512, I2 = 512, I3 = 1024, I4 = 2048, I5 = 1024, I6 = 64, I7 = 256, IE = 768;
        constexpr int NSMALL = I0 + I1 + I2 + I3 + I4 + I5 + I6 + I7;
        const int NITEMS = NSMALL;
        for (int rep = 0; rep < (((PH_REPEAT >> 27) & 1u) ? 2 : 1); ++rep)
        for (int it = F.gw; it < NITEMS; it += F.NGW) {
            int r = it;
            if (r < I0) { tr_item(INP(9), 4096, 2048, WSP(bf16, WS_WIN0), 2048, 0, 16, scr, r, F.lane); continue; } r -= I0;
            if (r < I1) { tr_item(INP(9) + 2048, 4096, 1024, WSP(bf16, WS_WIN0), 2048, 3072, 16, scr, r, F.lane); continue; } r -= I1;
            if (r < I2) { tr_item(INP(9) + 3072, 4096, 1024, WSP(bf16, WS_WIN0), 2048, 2048, 16, scr, r, F.lane); continue; } r -= I2;
            if (r < I3) { tr_item(INP(10), 2048, 2048, WSP(bf16, WS_WOUT0), 2048, 0, 16, scr, r, F.lane); continue; } r -= I3;
            if (r < I4) { tr_item(INP(15), 4096, 4096, WSP(bf16, WS_WIN1), 2048, 0, 16, scr, r, F.lane); continue; } r -= I4;
            if (r < I5) { tr_item(INP(16), 2048, 2048, WSP(bf16, WS_WOUT1), 2048, 0, 16, scr, r, F.lane); continue; } r -= I5;
            if (r < I6) { const int g = r / 16; tr_item(INP(13) + (size_t)g * 65536, 256, 256, WSP(bf16, WS_WPOOL), 256, g * 256, 16, scr, r % 16, F.lane); continue; } r -= I6;
            if (r < I7) { tr_item(INP(34), 1024, 1024, WSP(bf16, WS_WGLU), 1024, 0, 16, scr, r, F.lane); continue; } r -= I7;
        }
    }
}

__device__ __forceinline__ void p1_reduce(Frame& F) {
    const int gt = F.bid * NTHREADS + F.tid, NGT = F.G * NTHREADS;
    const float* part = WSP(float, WS_ADAP); float* mod = WSP(float, WS_MOD); const float* adab = INP(5);
    for (int idx = gt; idx < 2 * 3 * 12288; idx += NGT) { const int l = idx / (3 * 12288), r = idx % (3 * 12288), m = r / 12288, j = r % 12288;
        float a = adab[l * 12288 + j];
        for (int ks = 0; ks < 32; ++ks) a += part[((size_t)(l * 32 + ks) * 3 + m) * 12288 + j];
        mod[idx] = a; }
    const float* normp = WSP(float, WS_NORMP); float* invn = WSP(float, WS_INVN);
    for (int idx = gt; idx < 2048; idx += NGT) { const int o = idx >> 10, ch = idx & 1023; float a = 0.f;
        for (int pb = 0; pb < 256; ++pb) a += normp[(size_t)pb * 4096 + o * 2048 + ch] + normp[(size_t)pb * 4096 + o * 2048 + 1024 + ch];
        invn[idx] = 1.0f / a; }
    {
        const f32x2* lamb = WSP(f32x2, WS_S5LAM); const f32x2* bbar = WSP(f32x2, WS_S5B); const float* cre = INP(31); const float* cim = INP(32);
        bf16* W1 = WSP(bf16, WS_S5W1); bf16* W3 = WSP(bf16, WS_S5W3); bf16* KT = WSP(bf16, WS_S5KT); f32x2* l16 = WSP(f32x2, WS_S5L16);
#define S5_POWF(l_, e_, pw_) do { pw_ = (f32x2){1.f, 0.f}; f32x2 b_ = l_; for (int q_ = (e_); q_ > 0; q_ >>= 1) { if (q_ & 1) pw_ = (f32x2){pw_.x * b_.x - pw_.y * b_.y, pw_.x * b_.y + pw_.y * b_.x}; b_ = (f32x2){b_.x * b_.x - b_.y * b_.y, 2.f * b_.x * b_.y}; } } while (0)
        for (int idx = gt; idx < 128 * 64; idx += NGT) { f32x2 pw; S5_POWF(lamb[idx], 16, pw); l16[idx] = pw; }
        for (int idx = gt; idx < 128 * 128 * 32; idx += NGT) {
            const int k8 = idx & 31, n = (idx >> 5) & 127, dg = idx >> 12, sigma = k8 >> 1, h = k8 & 1, p = (n & 15) + 16 * ((n >> 4) & 3), im = n >> 6;
            f32x2 pw; S5_POWF(lamb[dg * 64 + p], 15 - sigma, pw);
            const f32x4* bp = (const f32x4*)(bbar + ((size_t)dg * 64 + p) * 16 + 8 * h); float o[8];
#pragma unroll
            for (int j = 0; j < 4; ++j) { const f32x4 q = bp[j]; o[2 * j] = im ? (pw.x * q.y + pw.y * q.x) : (pw.x * q.x - pw.y * q.y); o[2 * j + 1] = im ? (pw.x * q.w + pw.y * q.z) : (pw.x * q.z - pw.y * q.w); }
            v4u w; w.x = pk2(o[0], o[1]); w.y = pk2(o[2], o[3]); w.z = pk2(o[4], o[5]); w.w = pk2(o[6], o[7]);
            *(v4u*)(W1 + (size_t)idx * 8) = w; }
        for (int idx = gt; idx < 128 * 256 * 16; idx += NGT) {
            const int k8 = idx & 15, n = (idx >> 4) & 255, dg = idx >> 12, tau = n >> 4, cout = n & 15; float o[8];
#pragma unroll
            for (int j = 0; j < 4; ++j) { const int p = 4 * k8 + j; f32x2 pw; S5_POWF(lamb[dg * 64 + p], tau + 1, pw);
                const float cr = cre[((size_t)dg * 16 + cout) * 64 + p], ci = cim[((size_t)dg * 16 + cout) * 64 + p]; o[2 * j] = cr * pw.x - ci * pw.y; o[2 * j + 1] = -(cr * pw.y + ci * pw.x); }
            v4u w; w.x = pk2(o[0], o[1]); w.y = pk2(o[2], o[3]); w.z = pk2(o[4], o[5]); w.w = pk2(o[6], o[7]);
            *(v4u*)(W3 + (size_t)idx * 8) = w; }
        for (int idx = gt; idx < 128 * 17 * 16 * 2; idx += NGT) {
            const int h = idx & 1, cout = (idx >> 1) & 15, d1 = (idx >> 5) % 17, dg = (idx >> 5) / 17;
            float acc[8];
#pragma unroll
            for (int j = 0; j < 8; ++j) acc[j] = 0.f;
            if (d1 > 0) { for (int p = 0; p < 64; ++p) { f32x2 pw; S5_POWF(lamb[dg * 64 + p], d1 - 1, pw);
                const float cr = cre[((size_t)dg * 16 + cout) * 64 + p], ci = cim[((size_t)dg * 16 + cout) * 64 + p]; const float gr = cr * pw.x - ci * pw.y, gi = cr * pw.y + ci * pw.x;
                const f32x4* bp = (const f32x4*)(bbar + ((size_t)dg * 64 + p) * 16 + 8 * h);
#pragma unroll
                for (int j = 0; j < 4; ++j) { const f32x4 q = bp[j]; acc[2 * j] += gr * q.x - gi * q.y; acc[2 * j + 1] += gr * q.z - gi * q.w; } } }
            v4u w; w.x = pk2(acc[0], acc[1]); w.y = pk2(acc[2], acc[3]); w.z = pk2(acc[4], acc[5]); w.w = pk2(acc[6], acc[7]);
            *(v4u*)(KT + (size_t)idx * 8) = w; }
#undef S5_POWF
    }
}

__device__ __forceinline__ const float* modp(Frame& F, int l, int m, int c) { return WSP(float, WS_MOD) + ((size_t)(l * 3 + m) * 6 + c) * 2048; }
__device__ __forceinline__ int row_stream(int r) { return r < TL ? r / SEQ : 2; }

template <int MODE>
__device__ __forceinline__ void norm_phase(Frame& F, int l, float* dout) {
    const int nrows = (MODE == 3 || (MODE == 1 && l == 1)) ? TL : TT;
    float* xbuf = WSP(float, WS_X); bf16* ha = WSP(bf16, WS_HA); const bf16* Y = WSP(bf16, WS_Y);
    const float* gvec = (MODE == 0) ? INP(6) : (MODE == 1) ? INP(7) + l * 2048 : (MODE == 2) ? INP(6) + 2048 : INP(8);
    const int lane = F.lane;
    for (int r = F.gw; r < nrows; r += F.NGW) {
        const int m = row_stream(r);
        const float* src = (MODE == 0) ? (r < TL ? INP(0) + (size_t)r * 2048 : INP(2) + (size_t)(r - TL) * 2048) : xbuf + (size_t)r * 2048;
        f32x4 v[8]; float ss = 0.f;
#pragma unroll
        for (int j = 0; j < 8; ++j) v[j] = *(const f32x4*)(src + 4 * lane + 256 * j);
        if (MODE == 2 || MODE == 3) {
            const float* g2 = modp(F, MODE == 2 ? 0 : 1, m, 5);
            const bf16* y0 = Y + (size_t)(2 * r) * 2048; const bf16* y1 = y0 + 2048;
#pragma unroll
            for (int j = 0; j < 8; ++j) { const int c = 4 * lane + 256 * j; const v2u a = *(const v2u*)(y0 + c), b = *(const v2u*)(y1 + c); const f32x4 gg = *(const f32x4*)(g2 + c);
                v[j].x += gg.x * (bflo(a.x) + bflo(b.x)); v[j].y += gg.y * (bfhi(a.x) + bfhi(b.x)); v[j].z += gg.z * (bflo(a.y) + bflo(b.y)); v[j].w += gg.w * (bfhi(a.y) + bfhi(b.y)); }
            if (MODE == 2) {
#pragma unroll
                for (int j = 0; j < 8; ++j) *(f32x4*)(xbuf + (size_t)r * 2048 + 4 * lane + 256 * j) = v[j];
            }
        }
#pragma unroll
        for (int j = 0; j < 8; ++j) ss += (v[j].x * v[j].x + v[j].y * v[j].y) + (v[j].z * v[j].z + v[j].w * v[j].w);
        ss = wave_sum(ss);
        const float rs = 1.0f / sqrtf(ss * (1.0f / 2048.0f) + EPS);
        if (MODE == 3) {
#pragma unroll
            for (int j = 0; j < 8; ++j) { const int c = 4 * lane + 256 * j; const f32x4 gg = *(const f32x4*)(gvec + c); *(f32x4*)(dout + (size_t)r * 2048 + c) = v[j] * rs * gg; }
            continue;
        }
        const int lm = (MODE == 2) ? 1 : l;
        const float* sh = modp(F, lm, m, MODE == 1 ? 3 : 0); const float* sc = modp(F, lm, m, MODE == 1 ? 4 : 1);
#pragma unroll
        for (int j = 0; j < 8; ++j) { const int c = 4 * lane + 256 * j; const f32x4 gg = *(const f32x4*)(gvec + c), s1 = *(const f32x4*)(sc + c), s0 = *(const f32x4*)(sh + c);
            v[j] = (v[j] * rs * gg) * (1.0f + s1) + s0;
            v2u o; o.x = pk2(v[j].x, v[j].y); o.y = pk2(v[j].z, v[j].w); *(v2u*)(ha + (size_t)r * 2048 + c) = o; }
    }
}

__device__ __forceinline__ void ffn_norm_router_phase(Frame& F, int l, int dummy = 0) {
    const int nrows = (l == 1) ? TL : TT;
    const float* xbuf = WSP(float, WS_X); bf16* ha = WSP(bf16, WS_HA);
    const float* gvec = INP(7) + l * 2048;
    const float* wrt = WSP(float, WS_WRT) + (size_t)l * 72 * 2048;
    LAS float* wl = (LAS float*)F.lds;
    LAS float* lg = (LAS float*)(F.lds + 131072 + F.wave * 1536);
    const int lane = F.lane, tid = F.tid;
    for (int it = F.bid; it < nrows / 32; it += F.G) {
        const int r0 = it * 32 + F.wave * 4;
#define RT_DMA(q_, buf_) do { _Pragma("unroll") for (int _i = 0; _i < 8; ++_i) \
            __builtin_amdgcn_global_load_lds((const unsigned*)(wrt + (size_t)(q_) * 16384 + (size_t)(F.wave * 8 + _i) * 256 + lane * 4), (LAS unsigned*)(wl + (buf_) * 16384 + (F.wave * 8 + _i) * 256), 16, 0, 0); } while (0)
        RT_DMA(0, 0);
        f32x4 v[4][8];
#pragma unroll
        for (int rr = 0; rr < 4; ++rr) {
            const int r = r0 + rr, m = row_stream(r);
            const float* src = xbuf + (size_t)r * 2048; float ss = 0.f;
#pragma unroll
            for (int j = 0; j < 8; ++j) { v[rr][j] = *(const f32x4*)(src + 4 * lane + 256 * j); ss += (v[rr][j].x * v[rr][j].x + v[rr][j].y * v[rr][j].y) + (v[rr][j].z * v[rr][j].z + v[rr][j].w * v[rr][j].w); }
            ss = wave_sum(ss);
            const float rs = 1.0f / sqrtf(ss * (1.0f / 2048.0f) + EPS);
            const float* sh = modp(F, l, m, 3); const float* sc = modp(F, l, m, 4);
#pragma unroll
            for (int j = 0; j < 8; ++j) { if ((j & 1) == 0) __builtin_amdgcn_sched_barrier(0); const int c = 4 * lane + 256 * j; const f32x4 gg = *(const f32x4*)(gvec + c), s1 = *(const f32x4*)(sc + c), s0 = *(const f32x4*)(sh + c);
                v[rr][j] = (v[rr][j] * rs * gg) * (1.0f + s1) + s0;
                v2u o; o.x = cvt_pk_bf16(v[rr][j].x, v[rr][j].y); o.y = cvt_pk_bf16(v[rr][j].z, v[rr][j].w); *(v2u*)(ha + (size_t)r * 2048 + c) = o; }
        }
        asm volatile("s_waitcnt vmcnt(0)" ::: "memory");
        __syncthreads();
        const bool b5 = (lane & 32) != 0, b4 = (lane & 16) != 0, b3 = (lane & 8) != 0, b2 = (lane & 4) != 0;
#pragma nounroll
        for (int q = 0; q < 9; ++q) {
            const LAS float* wq = wl + (q & 1) * 16384;
            if (q + 1 < 9) RT_DMA(q + 1, (q + 1) & 1);
#pragma nounroll
            for (int hq = 0; hq < 2; ++hq) {
                float a[16];
#pragma unroll
                for (int nn = 0; nn < 4; ++nn) { const LAS float* wn = wq + (hq * 4 + nn) * 2048 + 4 * lane; f32x2 s0 = {0.f, 0.f}, s1 = s0, s2 = s0, s3 = s0;
#pragma unroll
                    for (int j = 0; j < 8; ++j) { const f32x4 w = *(const LAS f32x4*)(wn + 256 * j); const f32x2 wlo = {w.x, w.y}, whi = {w.z, w.w};
                        s0 = (f32x2){v[0][j].x, v[0][j].y} * wlo + s0; s0 = (f32x2){v[0][j].z, v[0][j].w} * whi + s0;
                        s1 = (f32x2){v[1][j].x, v[1][j].y} * wlo + s1; s1 = (f32x2){v[1][j].z, v[1][j].w} * whi + s1;
                        s2 = (f32x2){v[2][j].x, v[2][j].y} * wlo + s2; s2 = (f32x2){v[2][j].z, v[2][j].w} * whi + s2;
                        s3 = (f32x2){v[3][j].x, v[3][j].y} * wlo + s3; s3 = (f32x2){v[3][j].z, v[3][j].w} * whi + s3; }
                    a[nn] = s0.x + s0.y; a[4 + nn] = s1.x + s1.y; a[8 + nn] = s2.x + s2.y; a[12 + nn] = s3.x + s3.y; }
                float c8[8], c4[4], c2[2], c1;
#pragma unroll
                for (int i = 0; i < 8; ++i) { const float keep = b5 ? a[i + 8] : a[i], send = b5 ? a[i] : a[i + 8]; c8[i] = keep + __shfl_xor(send, 32); }
#pragma unroll
                for (int i = 0; i < 4; ++i) { const float keep = b4 ? c8[i + 4] : c8[i], send = b4 ? c8[i] : c8[i + 4]; c4[i] = keep + __shfl_xor(send, 16); }
#pragma unroll
                for (int i = 0; i < 2; ++i) { const float keep = b3 ? c4[i + 2] : c4[i], send = b3 ? c4[i] : c4[i + 2]; c2[i] = keep + __shfl_xor(send, 8); }
                { const float keep = b2 ? c2[1] : c2[0], send = b2 ? c2[0] : c2[1]; c1 = keep + __shfl_xor(send, 4); }
                c1 += __shfl_xor(c1, 2); c1 += __shfl_xor(c1, 1);
                if ((lane & 3) == 0) { const int i = lane >> 2; lg[(i >> 2) * 80 + q * 8 + hq * 4 + (i & 3)] = c1; }
            }
            asm volatile("s_waitcnt vmcnt(0)" ::: "memory");
            __syncthreads();
        }
#undef RT_DMA
        if (lane < 4) {
            const int r = r0 + lane; const LAS float* L = lg + lane * 80;
            float gl[8]; float gmax = -INFINITY; int gi = 0;
#pragma unroll
            for (int j = 0; j < 8; ++j) { gl[j] = L[j] + INP(37)[l * 8 + j]; if (gl[j] > gmax) { gmax = gl[j]; gi = j; } }
            float gsum = 0.f;
#pragma unroll
            for (int j = 0; j < 8; ++j) gsum += expf(gl[j] - gmax);
            const float pg_top = 1.0f / gsum;
            float pe[8]; float emax = -INFINITY;
#pragma unroll
            for (int j = 0; j < 8; ++j) { pe[j] = L[8 + gi * 8 + j] + INP(39)[l * 64 + gi * 8 + j]; emax = fmaxf(emax, pe[j]); }
            float esum = 0.f;
#pragma unroll
            for (int j = 0; j < 8; ++j) { pe[j] = expf(pe[j] - emax); esum += pe[j]; }
            int e1 = 0; float p1 = -1.f;
#pragma unroll
            for (int j = 0; j < 8; ++j) { pe[j] /= esum; if (pe[j] > p1) { p1 = pe[j]; e1 = j; } }
            int e2 = 0; float p2 = -1.f;
#pragma unroll
            for (int j = 0; j < 8; ++j) { if (j != e1 && pe[j] > p2) { p2 = pe[j]; e2 = j; } }
            const float den = p1 + p2; const float g1 = pg_top * p1 / den, g2 = pg_top * p2 / den;
            unsigned* cnt = WSP(unsigned, WS_CTL) + CW_CNT + l * 64 + dummy * 256; int* tokl = dummy ? WSP(int, WS_YD) : WSP(int, WS_TOKL); float* gatel = dummy ? WSP(float, WS_YD) + 16 * 1024 * 1024 : WSP(float, WS_GATEL);
            const int ex1 = gi * 8 + e1, ex2 = gi * 8 + e2;
            const unsigned k1 = atomicAdd(cnt + ex1, 1u); tokl[(size_t)ex1 * LISTCAP + k1] = 2 * r; gatel[(size_t)ex1 * LISTCAP + k1] = g1;
            const unsigned k2 = atomicAdd(cnt + ex2, 1u); tokl[(size_t)ex2 * LISTCAP + k2] = 2 * r + 1; gatel[(size_t)ex2 * LISTCAP + k2] = g2;
        }
        __syncthreads();
    }
}

#define EPI_ARGS const f32x4 (&acc)[2][2][4][2], const pg8::Unit& u, int wr, int wc, int fr, int fq
__device__ __forceinline__ void st_bf4(bf16* p, f32x4 v) { v2u o; o.x = cvt_pk_bf16(v.x, v.y); o.y = cvt_pk_bf16(v.z, v.w); *(v2u*)p = o; }

struct EpiQKP {
    bf16* Q; bf16* Kb; bf16* P; const f32x2* rope;
    __device__ __forceinline__ void operator()(EPI_ARGS) const {
        const int sect = u.pn >> 2, cb = (u.pn & 3) * 256; const bool latent = u.pm < TL / 256;
#pragma unroll
        for (int ai = 0; ai < 2; ++ai)
#pragma unroll
            for (int m = 0; m < 4; ++m) {
                const int r = u.pm * 256 + ai * 128 + wr * 64 + m * 16 + fr;
                int b, t; if (latent) { b = r / SEQ; t = r % SEQ; } else { b = (r - TL) / CTX; t = (r - TL) % CTX; }
                f32x4 cs0 = {1.f, 0.f, 1.f, 0.f}, cs1 = cs0;
                if (latent && sect < 2) { const int pos = (wc & 1) ? (t & 63) : (t >> 6); const f32x4* rp = (const f32x4*)(rope + pos * 16 + 4 * fq); cs0 = rp[0]; cs1 = rp[1]; }
#pragma unroll
                for (int bj = 0; bj < 2; ++bj) {
                    const int c0 = cb + bj * 128 + wc * 32 + 4 * fq;
                    f32x4 a = acc[ai][bj][m][0], bb = acc[ai][bj][m][1];
                    if (sect < 2) {
                        const f32x4 co = {cs0.x, cs0.z, cs1.x, cs1.z}, si = {cs0.y, cs0.w, cs1.y, cs1.w};
                        const f32x4 oa = a * co - bb * si, ob = a * si + bb * co; a = oa; bb = ob;
                    }
                    if (sect == 0) { a = a * QSCALE; bb = bb * QSCALE; bf16* d = Q + (size_t)r * 1024 + c0; st_bf4(d, a); st_bf4(d + 16, bb); }
                    else if (sect == 1) { const size_t kr = (size_t)b * KEYS + (latent ? CTX + t : t); bf16* d = Kb + kr * 1024 + c0; st_bf4(d, a); st_bf4(d + 16, bb); }
                    else { bf16* d = P + (size_t)r * 1024 + c0; st_bf4(d, a); st_bf4(d + 16, bb); }
                }
            }
    }
};
struct EpiVT {
    bf16* VT;
    __device__ __forceinline__ void operator()(EPI_ARGS) const {
        const bool latent = u.pn < TL / 256; const int b = latent ? u.pn / 32 : u.pn - TL / 256; const int key_t0 = latent ? CTX + (u.pn % 32) * 256 : 0;
        const int kperm = 8 * (fq & 1) + 4 * (fq >> 1);
#pragma unroll
        for (int ai = 0; ai < 2; ++ai)
#pragma unroll
            for (int m = 0; m < 4; ++m) {
                const int rr = u.pm * 256 + ai * 128 + wr * 64 + m * 16 + fr;
                bf16* rowp = VT + ((size_t)b * 1024 + rr) * KEYS + key_t0;
#pragma unroll
                for (int bj = 0; bj < 2; ++bj)
#pragma unroll
                    for (int n = 0; n < 2; ++n) st_bf4(rowp + bj * 128 + wc * 32 + 16 * n + kperm, acc[ai][bj][m][n]);
            }
    }
};
struct EpiScaleBf16 {
    bf16* O; int ldo, coff; const float* cscale;
    __device__ __forceinline__ void operator()(EPI_ARGS) const {
#pragma unroll
        for (int bj = 0; bj < 2; ++bj)
#pragma unroll
            for (int n = 0; n < 2; ++n) { const int c = u.pn * 256 + bj * 128 + wc * 32 + 16 * n + 4 * fq; const f32x4 sc = *(const f32x4*)(cscale + c);
#pragma unroll
                for (int ai = 0; ai < 2; ++ai)
#pragma unroll
                    for (int m = 0; m < 4; ++m) { const int r = u.pm * 256 + ai * 128 + wr * 64 + m * 16 + fr; st_bf4(O + (size_t)r * ldo + coff + c, acc[ai][bj][m][n] * sc); } }
    }
};
struct EpiBf16 {
    bf16* O; int ldo;
    __device__ __forceinline__ void operator()(EPI_ARGS) const {
#pragma unroll
        for (int ai = 0; ai < 2; ++ai)
#pragma unroll
            for (int m = 0; m < 4; ++m) { const int r = u.pm * 256 + ai * 128 + wr * 64 + m * 16 + fr; bf16* rowp = O + (size_t)r * ldo + u.pn * 256 + wc * 32 + 4 * fq;
#pragma unroll
                for (int bj = 0; bj < 2; ++bj)
#pragma unroll
                    for (int n = 0; n < 2; ++n) st_bf4(rowp + bj * 128 + 16 * n, acc[ai][bj][m][n]); }
    }
};
struct EpiRes {
    const float* xlat; const float* xctx; float* xout; const float* gate0;
    __device__ __forceinline__ void operator()(EPI_ARGS) const {
        const bool latent = u.pm < TL / 256;
#pragma unroll
        for (int ai = 0; ai < 2; ++ai)
#pragma unroll
            for (int m = 0; m < 4; ++m) { const int r = u.pm * 256 + ai * 128 + wr * 64 + m * 16 + fr; const int ms = latent ? r / SEQ : 2;
                const float* xi = latent ? xlat + (size_t)r * 2048 : xctx + (size_t)(r - TL) * 2048; const float* gp = gate0 + (size_t)ms * 12288;
#pragma unroll
                for (int bj = 0; bj < 2; ++bj)
#pragma unroll
                    for (int n = 0; n < 2; ++n) { const int c = u.pn * 256 + bj * 128 + wc * 32 + 16 * n + 4 * fq;
                        const f32x4 xv = *(const f32x4*)(xi + c), gv = *(const f32x4*)(gp + c); *(f32x4*)(xout + (size_t)r * 2048 + c) = xv + gv * acc[ai][bj][m][n]; } }
    }
};
struct EpiMoeUp {
    bf16* H;
    __device__ __forceinline__ void operator()(EPI_ARGS) const {
#pragma unroll
        for (int ai = 0; ai < 2; ++ai)
#pragma unroll
            for (int m = 0; m < 4; ++m) { const size_t r = (size_t)u.pm * 256 + ai * 128 + wr * 64 + m * 16 + fr;
#pragma unroll
                for (int bj = 0; bj < 2; ++bj) { const int hc = (u.pn * 256 + bj * 128 + wc * 32) / 2 + 4 * fq; const f32x4 a = acc[ai][bj][m][0], b = acc[ai][bj][m][1];
                    const f32x4 h = {siluf_(a.x) * b.x, siluf_(a.y) * b.y, siluf_(a.z) * b.z, siluf_(a.w) * b.w}; st_bf4(H + r * 512 + hc, h); } }
    }
};
struct EpiMoeDown {
    bf16* Y; const int* tokl; const float* gatel; const unsigned* cnt;
    __device__ __forceinline__ void operator()(EPI_ARGS) const {
        const int ce = (int)cnt[u.e];
#pragma unroll
        for (int ai = 0; ai < 2; ++ai)
#pragma unroll
            for (int m = 0; m < 4; ++m) { const int idx = u.idx0 + ai * 128 + wr * 64 + m * 16 + fr;
                if (idx < ce) { const int pair = tokl[(size_t)u.e * LISTCAP + idx]; const float gt = gatel[(size_t)u.e * LISTCAP + idx]; bf16* rowp = Y + (size_t)pair * 2048 + u.pn * 256 + wc * 32 + 4 * fq;
#pragma unroll
                    for (int bj = 0; bj < 2; ++bj)
#pragma unroll
                        for (int n = 0; n < 2; ++n) st_bf4(rowp + bj * 128 + 16 * n, acc[ai][bj][m][n] * gt); } }
    }
};
struct EpiGlu {
    bf16* O; int ldo, coff; const bf16* Gb; const float* bias;
    __device__ __forceinline__ void operator()(EPI_ARGS) const {
#pragma unroll
        for (int ai = 0; ai < 2; ++ai)
#pragma unroll
            for (int m = 0; m < 4; ++m) { const int r = u.pm * 256 + ai * 128 + wr * 64 + m * 16 + fr;
#pragma unroll
                for (int bj = 0; bj < 2; ++bj)
#pragma unroll
                    for (int n = 0; n < 2; ++n) { const int c = u.pn * 256 + bj * 128 + wc * 32 + 16 * n + 4 * fq; const f32x4 bv = *(const f32x4*)(bias + c); const v2u gw = *(const v2u*)(Gb + (size_t)r * 1024 + c);
                        const f32x4 a = acc[ai][bj][m][n] + bv; const f32x4 o = {bflo(gw.x) * sigmoidf_(a.x), bfhi(gw.x) * sigmoidf_(a.y), bflo(gw.y) * sigmoidf_(a.z), bfhi(gw.y) * sigmoidf_(a.w)};
                        st_bf4(O + (size_t)r * ldo + coff + c, o); } }
    }
};

struct MoeOrder {
    const LAS int* bstart;
    const unsigned* cnt; const int* tokl; int nN, G, c, nblk; long bstride, eoff; bool up;
    __device__ bool next(int i, pg8::Unit& u) const {
        const long Lx = (long)i * G + c; if (Lx >= (long)nblk * nN) return false;
        const int blk = (int)(Lx / nN); u.pn = (int)(Lx % nN); u.pm = blk;
        const int e = bstart[65 + blk];
        u.e = e; u.idx0 = (blk - bstart[e]) * 256;
        u.aoff = up ? 0 : (long)blk * 256 * 512 * 2;
        u.boff = (long)e * (long)MOE_E_BYTES + eoff + (long)u.pn * bstride;
        return true;
    }
    __device__ int arow(const pg8::Unit& u, int row) const { const int idx = u.idx0 + row; return idx < (int)cnt[u.e] ? (tokl[(size_t)u.e * LISTCAP + idx] >> 1) : TT; }
};

__device__ __forceinline__ void tile_order(int wgid, int nM, int nN, int& pm, int& pn) {
    const int nwg = nM * nN; { const int q = nwg / 8, r = nwg % 8, xcd = wgid % 8, off = wgid / 8; wgid = (xcd < r ? xcd * (q + 1) : r * (q + 1) + (xcd - r) * q) + off; }
    const int nig = 8 * nN, gid = wgid / nig, fm = gid * 8, gsz = (nM - fm) < 8 ? (nM - fm) : 8;
    pm = fm + ((wgid % nig) % gsz); pn = (wgid % nig) / gsz;
}
struct InProj0Order {
    int G, c; long offA1, offB1, offA2, offB2;
    __device__ bool next(int i, pg8::Unit& u) const {
        const int Lx = i * G + c; constexpr int N1 = (TT / 256) * 12, N2 = 4 * (TT / 256); constexpr long TS = 256L * 2048 * 2;
        if (Lx >= N1 + N2) return false;
        u.idx0 = 0;
        if (Lx < N1) { tile_order(Lx, TT / 256, 12, u.pm, u.pn); u.aoff = offA1 + (long)u.pm * TS; u.boff = offB1 + (long)u.pn * TS; u.e = 0; }
        else { tile_order(Lx - N1, 4, TT / 256, u.pm, u.pn); u.aoff = offA2 + (long)u.pm * TS; u.boff = offB2 + (long)u.pn * TS; u.e = 1; }
        return true;
    }
    __device__ int arow(const pg8::Unit&, int) const { return 0; }
};
struct EpiInProj0 {
    EpiQKP e1; EpiVT e2;
    __device__ __forceinline__ void operator()(EPI_ARGS) const { if (u.e == 0) e1(acc, u, wr, wc, fr, fq); else e2(acc, u, wr, wc, fr, fq); }
};

#ifdef ATT_NORARE
#define ATT_RARE(mx) false
#else
#define ATT_RARE(mx) __any(mx > 8.0f)
#endif
__device__ __forceinline__ void attn_phase(Frame& F) {
    const bf16* Q = WSP(bf16, WS_Q); const bf16* Kb = WSP(bf16, WS_K); const bf16* VT = WSP(bf16, WS_VT); bf16* cat = WSP(bf16, WS_CAT);
    LAS unsigned char* lds = F.lds;
    const int lane0 = F.lane;
    float lam;
    { const float* lv = INP(11); float a = lv[lane0] * lv[64 + lane0], b = lv[128 + lane0] * lv[192 + lane0]; a = wave_sum(a); b = wave_sum(b); lam = expf(a) - expf(b) + 0.2f; }
    const float* subg = INP(12);
    const int NU = 1024 + 32;
    const int xcd = F.bid & 7, jcu = F.bid >> 3;
    for (int it = 0;; ++it) {
        int tl_ = F.tid; asm volatile("" : "+v"(tl_));
        const int lane = tl_ & 63, w = __builtin_amdgcn_readfirstlane(tl_ >> 6), sub = w & 1, qw = w >> 1, r32 = lane & 31, hi = lane >> 5;
        int uidx;
        if (F.G == 256) { if (it < 4) uidx = 128 * xcd + it * 32 + jcu; else if (it == 4 && F.bid < 32) uidx = 1024 + F.bid; else break; }
        else { uidx = it * F.G + F.bid; if (uidx >= NU) break; }
        int b, head, q0row, nt; size_t kbase;
        if (uidx < 1024) { const int combo = uidx >> 6, qb = uidx & 63; b = combo >> 3; head = combo & 7; q0row = b * SEQ + qb * 128; nt = KEYS / 64; }
        else { const int v = uidx - 1024; b = v >> 4; head = (v >> 1) & 7; q0row = TL + b * CTX + (v & 1) * 128; nt = CTX / 64; }
        kbase = (size_t)b * KEYS;
        bf16x8 qf[4];
        { const bf16* qp = Q + (size_t)(q0row + qw * 32 + r32) * 1024 + head * 128 + sub * 64 + hi * 8;
#pragma unroll
          for (int ks = 0; ks < 4; ++ks) qf[ks] = *(const bf16x8*)(qp + ks * 16); }
        const char* gsrc[4];
#pragma unroll
        for (int j = 0; j < 4; ++j) { const int pi = w * 4 + j, rr = lane >> 3, pc = lane & 7;
            if (pi < 16) { const int key = (pi & 7) * 8 + rr, c = pc ^ ((key >> 1) & 7); gsrc[j] = (const char*)(Kb + (kbase + key) * 1024 + head * 128 + (pi >> 3) * 64 + c * 8); }
            else { const int dvr = (pi - 16) * 8 + rr, c = pc ^ ((dvr >> 1) & 7); gsrc[j] = (const char*)(VT + ((size_t)(b * 8 + head) * 128 + dvr) * KEYS + c * 8); } }
        const size_t gstep = (w < 4) ? (size_t)65536 * 2 : (size_t)64 * 2;
        const unsigned ldst = (unsigned)w * 4096u;
#define ATT_DMA(t, buf) do { _Pragma("unroll") for (int _j = 0; _j < 4; ++_j) \
            __builtin_amdgcn_global_load_lds((const unsigned*)(gsrc[_j] + (size_t)(t) * gstep), (LAS unsigned*)(lds + (buf) * 32768 + ldst + _j * 1024), 16, 0, 0); } while (0)
        ATT_DMA(0, 0); ATT_DMA(1, 1); ATT_DMA(2, 2);
        asm volatile("s_waitcnt vmcnt(4)" ::: "memory");
        __builtin_amdgcn_s_barrier();
        f32x16 o[4];
#pragma unroll
        for (int d = 0; d < 4; ++d)
#pragma unroll
            for (int r = 0; r < 16; ++r) o[d][r] = 0.f;
        float mref = 0.f, lrow = 0.f;
        f32x16 negm;
#pragma unroll
        for (int r = 0; r < 16; ++r) negm[r] = 0.f;
        const int rdoff = r32 * 128;
        const int swz = (r32 >> 1) & 7;
        f32x16 s0, s1; bf16x8 pf[4];
#define ATT_QK(bufidx) do { const LAS unsigned char* kp_ = lds + (bufidx) * 32768 + sub * 8192; bf16x8 kfa[4], kfb[4]; \
            _Pragma("unroll") for (int ks = 0; ks < 4; ++ks) { const int ch = ((2 * ks + hi) ^ swz) * 16; kfa[ks] = *(const LAS bf16x8*)(kp_ + rdoff + ch); kfb[ks] = *(const LAS bf16x8*)(kp_ + 4096 + rdoff + ch); } \
            s0 = negm; s1 = negm; \
            _Pragma("unroll") for (int ks = 0; ks < 4; ++ks) { s0 = __builtin_amdgcn_mfma_f32_32x32x16_bf16(kfa[ks], qf[ks], s0, 0, 0, 0); s1 = __builtin_amdgcn_mfma_f32_32x32x16_bf16(kfb[ks], qf[ks], s1, 0, 0, 0); } \
            asm volatile("" : "+v"(s0), "+v"(s1) : "v"(kfa[0]), "v"(kfa[1]), "v"(kfa[2]), "v"(kfa[3]), "v"(kfb[0]), "v"(kfb[1]), "v"(kfb[2]), "v"(kfb[3])); } while (0)
#define ATT_MAX(mx) do { float mxa = fmaxf(fmaxf(s0[0], s0[1]), s0[2]), mxb = fmaxf(fmaxf(s1[0], s1[1]), s1[2]); \
            _Pragma("unroll") for (int r = 3; r < 15; r += 2) { mxa = fmaxf(fmaxf(mxa, s0[r]), s0[r + 1]); mxb = fmaxf(fmaxf(mxb, s1[r]), s1[r + 1]); } \
            mx = fmaxf(fmaxf(mxa, mxb), fmaxf(s0[15], s1[15])); mx = fmaxf(mx, __shfl_xor(mx, 32)); } while (0)
#define ATT_FIX(mx) do { const float dl = fmaxf(mx, 0.f); mref += dl; const float alpha = __builtin_amdgcn_exp2f(-dl); lrow *= alpha; \
            _Pragma("unroll") for (int r = 0; r < 16; ++r) { s0[r] -= dl; s1[r] -= dl; negm[r] = -mref; } \
            _Pragma("unroll") for (int d = 0; d < 4; ++d) _Pragma("unroll") for (int r = 0; r < 16; ++r) o[d][r] *= alpha; } while (0)
#define ATT_EXP8(S, base, dst) do { float rs_ = 0.f; _Pragma("unroll") for (int r = 0; r < 8; ++r) { S[base + r] = __builtin_amdgcn_exp2f(S[base + r]); rs_ += S[base + r]; } lrow += rs_; \
            v4u pw_; pw_.x = cvt_pk_bf16(S[base + 0], S[base + 1]); pw_.y = cvt_pk_bf16(S[base + 2], S[base + 3]); pw_.z = cvt_pk_bf16(S[base + 4], S[base + 5]); pw_.w = cvt_pk_bf16(S[base + 6], S[base + 7]); dst = __builtin_bit_cast(bf16x8, pw_); } while (0)
#define ATT_VLD(dstv, vp_, s) do { _Pragma("unroll") for (int d = 0; d < 4; ++d) dstv[d] = *(const LAS bf16x8*)(vp_ + d * 4096 + rdoff + (((2 * (s) + hi) ^ swz) * 16)); } while (0)
#define ATT_PV4(srcv, pfrag) do { _Pragma("unroll") for (int d = 0; d < 4; ++d) o[d] = __builtin_amdgcn_mfma_f32_32x32x16_bf16(srcv[d], pfrag, o[d], 0, 0, 0); } while (0)
        { ATT_QK(0); float mx; ATT_MAX(mx); if (__any(mx > 8.0f)) ATT_FIX(mx);
          ATT_EXP8(s0, 0, pf[0]); ATT_EXP8(s0, 8, pf[1]); ATT_EXP8(s1, 0, pf[2]); ATT_EXP8(s1, 8, pf[3]); }
        int bcur = 0;
#pragma nounroll
        for (int t = 0; t < nt; ++t) {
            const int bn1 = (bcur + 1) & 3, bn3 = (bcur + 3) & 3;
            if (t + 3 < nt) ATT_DMA(t + 3, bn3);
            const LAS unsigned char* vp = lds + bcur * 32768 + 16384;
            bf16x8 vfa[4], vfb[4];
            if (t + 1 < nt) {
                __builtin_amdgcn_sched_barrier(0);
                ATT_QK(bn1);
                float mx; ATT_MAX(mx);
                __builtin_amdgcn_sched_barrier(0);
                if (__any(mx > 8.0f)) {
                    const float dl = fmaxf(mx, 0.f); mref += dl; const float alpha = __builtin_amdgcn_exp2f(-dl); lrow *= alpha;
#pragma unroll
                    for (int r = 0; r < 16; ++r) { s0[r] -= dl; s1[r] -= dl; negm[r] = -mref; }
#pragma unroll
                    for (int d = 0; d < 4; ++d)
#pragma unroll
                        for (int r = 0; r < 16; ++r) o[d][r] *= alpha;
#pragma unroll
                    for (int s = 0; s < 4; ++s) { v4u pw = __builtin_bit_cast(v4u, pf[s]);
                        pw.x = cvt_pk_bf16(bflo(pw.x) * alpha, bfhi(pw.x) * alpha); pw.y = cvt_pk_bf16(bflo(pw.y) * alpha, bfhi(pw.y) * alpha);
                        pw.z = cvt_pk_bf16(bflo(pw.z) * alpha, bfhi(pw.z) * alpha); pw.w = cvt_pk_bf16(bflo(pw.w) * alpha, bfhi(pw.w) * alpha); pf[s] = __builtin_bit_cast(bf16x8, pw); }
                }
                __builtin_amdgcn_sched_barrier(0);
                {
                    ATT_VLD(vfa, vp, 0);
                    __builtin_amdgcn_sched_barrier(0);
                    ATT_VLD(vfb, vp, 1); ATT_PV4(vfa, pf[0]); ATT_EXP8(s0, 0, pf[0]);
                    __builtin_amdgcn_sched_barrier(0);
                    ATT_VLD(vfa, vp, 2); ATT_PV4(vfb, pf[1]); ATT_EXP8(s0, 8, pf[1]);
                    __builtin_amdgcn_sched_barrier(0);
                    ATT_VLD(vfb, vp, 3); ATT_PV4(vfa, pf[2]); ATT_EXP8(s1, 0, pf[2]);
                    __builtin_amdgcn_sched_barrier(0);
                    ATT_PV4(vfb, pf[3]); ATT_EXP8(s1, 8, pf[3]);
                }
                __builtin_amdgcn_sched_barrier(0);
            } else {
#pragma unroll
                for (int s = 0; s < 4; ++s) { ATT_VLD(vfa, vp, s); ATT_PV4(vfa, pf[s]); }
            }
            if (t + 3 < nt) asm volatile("s_waitcnt vmcnt(4) lgkmcnt(0)" ::: "memory"); else asm volatile("s_waitcnt vmcnt(0) lgkmcnt(0)" ::: "memory");
            __builtin_amdgcn_s_barrier();
            bcur = bn1;
        }
#undef ATT_DMA
#undef ATT_QK
#undef ATT_MAX
#undef ATT_FIX
#undef ATT_EXP8
#undef ATT_VLD
#undef ATT_PV4
        const float ltot = lrow + __shfl_xor(lrow, 32); const float linv = 1.0f / ltot;
        LAS float* xch = (LAS float*)lds + (size_t)(qw * 32 + r32) * 132;
        if (sub == 1) {
#pragma unroll
            for (int d = 0; d < 4; ++d)
#pragma unroll
                for (int g = 0; g < 4; ++g) *(LAS f32x4*)(xch + 32 * d + 8 * g + 4 * hi) = (f32x4){o[d][4 * g] * linv, o[d][4 * g + 1] * linv, o[d][4 * g + 2] * linv, o[d][4 * g + 3] * linv};
        }
        __syncthreads();
        if (sub == 0) {
            float ss = 0.f;
#pragma unroll
            for (int d = 0; d < 4; ++d)
#pragma unroll
                for (int g = 0; g < 4; ++g) { const f32x4 o2 = *(const LAS f32x4*)(xch + 32 * d + 8 * g + 4 * hi);
#pragma unroll
                    for (int j = 0; j < 4; ++j) { const float v = o[d][4 * g + j] * linv - lam * o2[j]; o[d][4 * g + j] = v; ss += v * v; } }
            ss += __shfl_xor(ss, 32);
            const float rn = 0.8f / sqrtf(ss * (1.0f / 128.0f) + EPS);
            bf16* op = cat + (size_t)(q0row + qw * 32 + r32) * 2048 + head * 128;
#pragma unroll
            for (int d = 0; d < 4; ++d)
#pragma unroll
                for (int g = 0; g < 4; ++g) { const int dv = 32 * d + 8 * g + 4 * hi; const f32x4 gg = *(const f32x4*)(subg + dv);
                    st_bf4(op + dv, (f32x4){o[d][4 * g] * rn * gg.x, o[d][4 * g + 1] * rn * gg.y, o[d][4 * g + 2] * rn * gg.z, o[d][4 * g + 3] * rn * gg.w}); }
        }
        __syncthreads();
    }
}

__device__ __forceinline__ void poold_phase(Frame& F) {
    const bf16* P = WSP(bf16, WS_P); bf16* PD = WSP(bf16, WS_PD);
    const int gt = F.bid * NTHREADS + F.tid, NGT = F.G * NTHREADS;
    for (int idx = gt; idx < TT * 128; idx += NGT) {
        const int r = idx >> 7, cc = (idx & 127) * 8, g = cc >> 8, wdw = 2 << g;
        int sb, t, Ls; if (r < TL) { sb = (r / SEQ) * SEQ; t = r % SEQ; Ls = SEQ; } else { sb = TL + ((r - TL) / CTX) * CTX; t = (r - TL) % CTX; Ls = CTX; }
        int lo = t - wdw / 2, hi = lo + wdw; lo = lo < 0 ? 0 : lo; hi = hi > Ls ? Ls : hi;
        float a[8];
#pragma unroll
        for (int j = 0; j < 8; ++j) a[j] = 0.f;
        for (int s = lo; s < hi; ++s) { const v4u v = *(const v4u*)(P + (size_t)(sb + s) * 1024 + cc);
            a[0] += bflo(v.x); a[1] += bfhi(v.x); a[2] += bflo(v.y); a[3] += bfhi(v.y); a[4] += bflo(v.z); a[5] += bfhi(v.z); a[6] += bflo(v.w); a[7] += bfhi(v.w); }
        const float inv = 1.0f / (float)(hi - lo);
        const v4u me = *(const v4u*)(P + (size_t)r * 1024 + cc);
        v4u o; o.x = pk2(a[0] * inv - bflo(me.x), a[1] * inv - bfhi(me.x)); o.y = pk2(a[2] * inv - bflo(me.y), a[3] * inv - bfhi(me.y));
        o.z = pk2(a[4] * inv - bflo(me.z), a[5] * inv - bfhi(me.z)); o.w = pk2(a[6] * inv - bflo(me.w), a[7] * inv - bfhi(me.w));
        *(v4u*)(PD + (size_t)r * 1024 + cc) = o;
    }
}

__device__ __forceinline__ void shortconv_phase(Frame& F) {
    const bf16* PJ = WSP(bf16, WS_PROJ1); float* GT = WSP(float, WS_GT);
    const float* cw = INP(17); const float* cb = INP(18);
    LAS float* scr = (LAS float*)(F.lds + F.wave * 17408);
    const int lane = F.lane;
    for (int it = F.gw; it < 2 * 128 * 48; it += F.NGW) {
        const int cbk = it % 48, tb = (it / 48) % 128, b = it / (48 * 128), col = cbk * 64 + lane, t0 = tb * 64;
        const bf16* base = PJ + ((size_t)b * SEQ) * 4096 + cbk * 64 + (lane & 7) * 8;
#pragma unroll
        for (int i = 0; i < 9; ++i) { const int row = 8 * i + (lane >> 3); const int t = t0 - 1 + row;
            if (row < 66) { v4u v = {0u, 0u, 0u, 0u}; if (t >= 0 && t < SEQ) v = *(const v4u*)(base + (size_t)t * 4096);
                LAS float* d = scr + row * 65 + (lane & 7) * 8; d[0] = bflo(v.x); d[1] = bfhi(v.x); d[2] = bflo(v.y); d[3] = bfhi(v.y); d[4] = bflo(v.z); d[5] = bfhi(v.z); d[6] = bflo(v.w); d[7] = bfhi(v.w); } }
        LDS_WAIT(); asm volatile("" ::: "memory");
        const float w0 = cw[col], w1 = cw[3072 + col], w2 = cw[2 * 3072 + col], bias = cb[col];
        float prev = scr[lane], cur = scr[65 + lane];
#pragma unroll 8
        for (int tt = 0; tt < 64; ++tt) { const float nxt = scr[(tt + 2) * 65 + lane]; const float o = prev * w0 + cur * w1 + nxt * w2 + bias; scr[tt * 65 + lane] = o; prev = cur; cur = nxt; }
        LDS_WAIT(); asm volatile("" ::: "memory");
        for (int c = 0; c < 64; ++c) GT[((size_t)(cbk * 64 + c) * 2 + b) * SEQ + t0 + lane] = scr[lane * 65 + c];
        LDS_WAIT(); asm volatile("" ::: "memory");
    }
}

__device__ __forceinline__ void s5_scan_phase(Frame& F) {
    const bf16* PJ = WSP(bf16, WS_PROJ1); float* YD = WSP(float, WS_YD);
    const f32x2* lamb = WSP(f32x2, WS_S5LAM); const f32x2* bbar = WSP(f32x2, WS_S5B);
    const float* cre = INP(31); const float* cim = INP(32);
    const int lane = F.lane;
    for (int task = F.wave * F.G + F.bid; task < 256; task += F.NGW) {
        const int di = task >> 7, b = (task >> 6) & 1, g = task & 63;
        const int dgp = (di * 64 + g) * 64 + lane;
        const f32x2 lam = lamb[dgp];
        float br[16], bi[16], cr[16], ci[16];
#pragma unroll
        for (int c = 0; c < 16; ++c) { const f32x2 bv = bbar[(size_t)dgp * 16 + c]; br[c] = bv.x; bi[c] = bv.y;
            cr[c] = cre[((size_t)(di * 64 + g) * 16 + c) * 64 + lane]; ci[c] = cim[((size_t)(di * 64 + g) * 16 + c) * 64 + lane]; }
        float sr = 0.f, si = 0.f;
        const int nsteps = CTX + SEQ;
        for (int st = 0; st < nsteps; st += 4) {
            const int stl = st + (lane >> 4);
            int row;
            if (stl < CTX) row = TL + b * CTX + (di == 0 ? stl : CTX - 1 - stl);
            else row = b * SEQ + (di == 0 ? stl - CTX : SEQ - 1 - (stl - CTX));
            const float uval = bf2f(PJ[(size_t)row * 4096 + 3072 + g * 16 + (lane & 15)]);
#pragma unroll
            for (int k = 0; k < 4; ++k) {
                float bur = 0.f, bui = 0.f;
#pragma unroll
                for (int c = 0; c < 16; ++c) { const float u = __builtin_bit_cast(float, __builtin_amdgcn_readlane(__builtin_bit_cast(int, uval), 16 * k + c)); bur += br[c] * u; bui += bi[c] * u; }
                const float nr = lam.x * sr - lam.y * si + bur, ni = lam.x * si + lam.y * sr + bui; sr = nr; si = ni;
                const int s2 = st + k;
                if (s2 >= CTX) {
                    const int t = (di == 0) ? s2 - CTX : SEQ - 1 - (s2 - CTX);
                    float outv = 0.f;
#pragma unroll
                    for (int c = 0; c < 16; ++c) { float v = cr[c] * sr - ci[c] * si; v = wave_sum(v); if (lane == c) outv = v; }
                    if (lane < 16) YD[((size_t)di * TL + (size_t)b * SEQ + t) * 1024 + g * 16 + lane] = outv;
                }
            }
        }
    }
}

__device__ __forceinline__ void hyena_naive_phase(Frame& F) {
    const float* GT = WSP(float, WS_GT); const float* kT = WSP(float, WS_KT); const float* invn = WSP(float, WS_INVN); bf16* cat = WSP(bf16, WS_CAT);
    const float* hyb = INP(25);
    LAS float* kf = (LAS float*)F.lds;
    LAS f32x2* ub = (LAS f32x2*)(F.lds + 65536);
    const int tid = F.tid;
    for (int ch = F.bid; ch < 1024; ch += F.G) {
        float res0[16], res1[16];
        for (int o = 0; o < 2; ++o) {
            const float inv = invn[o * 1024 + ch];
            const float* kfw = kT + (size_t)(o * 2048 + ch) * SEQ; const float* kbw = kT + (size_t)(o * 2048 + 1024 + ch) * SEQ;
            for (int n = tid; n < 16384; n += NTHREADS) { float v; if (n < SEQ) v = kfw[n]; else if (n == SEQ) v = 0.f; else v = kbw[16384 - n]; kf[n] = v * inv; }
            if (o == 0) { const float* v0 = GT + ((size_t)(0 * 1024 + ch) * 2) * SEQ; for (int n = tid; n < SEQ; n += NTHREADS) ub[n] = (f32x2){v0[n], v0[SEQ + n]}; }
            else {
#pragma unroll
                for (int j = 0; j < 16; ++j) ub[tid + NTHREADS * j] = (f32x2){res0[j], res1[j]}; }
            __syncthreads();
            float a0[16], a1[16];
#pragma unroll
            for (int j = 0; j < 16; ++j) { a0[j] = 0.f; a1[j] = 0.f; }
            for (int s = 0; s < SEQ; ++s) { const f32x2 u = ub[s];
#pragma unroll
                for (int j = 0; j < 16; ++j) { const float kk = kf[(tid + NTHREADS * j - s) & 16383]; a0[j] += u.x * kk; a1[j] += u.y * kk; } }
            const float bias = hyb[o * 1024 + ch];
            const float* xg = GT + ((size_t)((o + 1) * 1024 + ch) * 2) * SEQ;
#pragma unroll
            for (int j = 0; j < 16; ++j) { const int t = tid + NTHREADS * j; const f32x2 u = ub[t];
                res0[j] = xg[t] * (a0[j] + bias * u.x); res1[j] = xg[SEQ + t] * (a1[j] + bias * u.y); }
            __syncthreads();
        }
#pragma unroll
        for (int j = 0; j < 16; ++j) { const int t = tid + NTHREADS * j;
            cat[(size_t)t * 2048 + ch] = (bf16)f2bf(res0[j]); cat[((size_t)SEQ + t) * 2048 + ch] = (bf16)f2bf(res1[j]); }
    }
}

__device__ __forceinline__ void s5_gelu_phase(Frame& F) {
    const bf16* PJ = WSP(bf16, WS_PROJ1); const float* YD = WSP(float, WS_YD); bf16* Gb = WSP(bf16, WS_PD); const float* dd = INP(33);
    const int gt = F.bid * NTHREADS + F.tid, NGT = F.G * NTHREADS;
    for (int idx = gt; idx < TL * 256; idx += NGT) { const int r = idx >> 8, c = (idx & 255) * 4;
        const v2u uw = *(const v2u*)(PJ + (size_t)r * 4096 + 3072 + c); const f32x4 d4 = *(const f32x4*)(dd + c);
        const int bb = r / SEQ, tt = r % SEQ, gg = c >> 4, cc = c & 15;
        const f32x4 y0 = *(const f32x4*)(YD + (((size_t)(0 * 2 + bb) * 64 + gg) * SEQ + tt) * 16 + cc), y1 = *(const f32x4*)(YD + (((size_t)(1 * 2 + bb) * 64 + gg) * SEQ + tt) * 16 + cc);
        const f32x4 y = {bflo(uw.x) * d4.x + y0.x + y1.x, bfhi(uw.x) * d4.y + y0.y + y1.y, bflo(uw.y) * d4.z + y0.z + y1.z, bfhi(uw.y) * d4.w + y0.w + y1.w};
        st_bf4(Gb + (size_t)r * 1024 + c, (f32x4){gelu_tanh(y.x), gelu_tanh(y.y), gelu_tanh(y.z), gelu_tanh(y.w)}); }
}

__device__ __forceinline__ f32x2 cmulf(f32x2 a, f32x2 b) { return (f32x2){a.x * b.x - a.y * b.y, a.x * b.y + a.y * b.x}; }
__device__ __forceinline__ int drev14(int p) { const unsigned r = __builtin_bitreverse32((unsigned)p) >> 18; return (int)(((r & 0x2AAAu) >> 1) | ((r & 0x1555u) << 1)); }
template <int L, bool ZHI>
__device__ __forceinline__ void fft_fwd_pass(LAS f32x2* X, const f32x2* tw, int tid) {
    constexpr int tws = 4096 / L;
    if constexpr (L == 1) {
#pragma unroll 2
        for (int i = 0; i < 8; ++i) { const int i0 = (tid + NTHREADS * i) * 4;
            const f32x4 p01 = *(const LAS f32x4*)(X + i0), p23 = *(const LAS f32x4*)(X + i0 + 2);
            const f32x2 x0 = {p01.x, p01.y}, x1 = {p01.z, p01.w}, x2 = {p23.x, p23.y}, x3 = {p23.z, p23.w};
            const f32x2 a = x0 + x2, bb = x0 - x2, c = x1 + x3, d = x1 - x3;
            const f32x2 y0 = a + c, y1 = {bb.x + d.y, bb.y - d.x}, y2 = a - c, y3 = {bb.x - d.y, bb.y + d.x};
            *(LAS f32x4*)(X + i0) = (f32x4){y0.x, y0.y, y1.x, y1.y}; *(LAS f32x4*)(X + i0 + 2) = (f32x4){y2.x, y2.y, y3.x, y3.y}; }
        __syncthreads();
        return;
    }
#pragma unroll 2
    for (int i = 0; i < 8; ++i) {
        const int b = tid + NTHREADS * i, j = b & (L - 1), i0 = (b - j) * 4 + j;
        const f32x2 w1 = tw[j * tws], w2 = cmulf(w1, w1), w3 = cmulf(w2, w1);
        const f32x2 x0 = X[i0], x1 = X[i0 + L];
        if (ZHI) {
            const f32x2 t1 = {x0.x + x1.y, x0.y - x1.x}, t3 = {x0.x - x1.y, x0.y + x1.x};
            X[i0] = x0 + x1; X[i0 + L] = cmulf(t1, w1); X[i0 + 2 * L] = cmulf(x0 - x1, w2); X[i0 + 3 * L] = cmulf(t3, w3);
        } else {
            const f32x2 x2 = X[i0 + 2 * L], x3 = X[i0 + 3 * L];
            const f32x2 a = x0 + x2, bb = x0 - x2, c = x1 + x3, d = x1 - x3;
            const f32x2 t1 = {bb.x + d.y, bb.y - d.x}, t3 = {bb.x - d.y, bb.y + d.x};
            X[i0] = a + c; X[i0 + L] = cmulf(t1, w1); X[i0 + 2 * L] = cmulf(a - c, w2); X[i0 + 3 * L] = cmulf(t3, w3);
        }
    }
    __syncthreads();
}
template <bool ZHI>
__device__ __forceinline__ void fft_fwd(LAS f32x2* X, const f32x2* tw, int tid) {
    fft_fwd_pass<4096, ZHI>(X, tw, tid); fft_fwd_pass<1024, false>(X, tw, tid); fft_fwd_pass<256, false>(X, tw, tid); fft_fwd_pass<64, false>(X, tw, tid);
    fft_fwd_pass<16, false>(X, tw, tid); fft_fwd_pass<4, false>(X, tw, tid); fft_fwd_pass<1, false>(X, tw, tid);
}
template <int L, bool LOHALF>
__device__ __forceinline__ void fft_inv_pass(LAS f32x2* X, const f32x2* tw, int tid) {
    constexpr int tws = 4096 / L;
    if constexpr (L == 1) {
#pragma unroll 2
        for (int i = 0; i < 8; ++i) { const int i0 = (tid + NTHREADS * i) * 4;
            const f32x4 p01 = *(const LAS f32x4*)(X + i0), p23 = *(const LAS f32x4*)(X + i0 + 2);
            const f32x2 x0 = {p01.x, p01.y}, x1 = {p01.z, p01.w}, x2 = {p23.x, p23.y}, x3 = {p23.z, p23.w};
            const f32x2 a = x0 + x2, bb = x0 - x2, c = x1 + x3, d = x1 - x3;
            const f32x2 y0 = a + c, y1 = {bb.x - d.y, bb.y + d.x}, y2 = a - c, y3 = {bb.x + d.y, bb.y - d.x};
            *(LAS f32x4*)(X + i0) = (f32x4){y0.x, y0.y, y1.x, y1.y}; *(LAS f32x4*)(X + i0 + 2) = (f32x4){y2.x, y2.y, y3.x, y3.y}; }
        __syncthreads();
        return;
    }
#pragma unroll 2
    for (int i = 0; i < 8; ++i) {
        const int b = tid + NTHREADS * i, j = b & (L - 1), i0 = (b - j) * 4 + j;
        f32x2 w1 = tw[j * tws]; w1.y = -w1.y; const f32x2 w2 = cmulf(w1, w1), w3 = cmulf(w2, w1);
        const f32x2 x0 = X[i0], x1 = cmulf(X[i0 + L], w1), x2 = cmulf(X[i0 + 2 * L], w2), x3 = cmulf(X[i0 + 3 * L], w3);
        const f32x2 a = x0 + x2, bb = x0 - x2, c = x1 + x3, d = x1 - x3;
        X[i0] = a + c; X[i0 + L] = (f32x2){bb.x - d.y, bb.y + d.x};
        if (!LOHALF) { X[i0 + 2 * L] = a - c; X[i0 + 3 * L] = (f32x2){bb.x + d.y, bb.y - d.x}; }
    }
    __syncthreads();
}
__device__ __forceinline__ void fft_inv(LAS f32x2* X, const f32x2* tw, int tid) {
    fft_inv_pass<1, false>(X, tw, tid); fft_inv_pass<4, false>(X, tw, tid); fft_inv_pass<16, false>(X, tw, tid); fft_inv_pass<64, false>(X, tw, tid);
    fft_inv_pass<256, false>(X, tw, tid); fft_inv_pass<1024, false>(X, tw, tid); fft_inv_pass<4096, true>(X, tw, tid);
}
__device__ __forceinline__ void fft_pointwise(LAS f32x2* X, const f32x2* Wg, int o, float scale, int tid) {
    const float hs = 0.5f * scale;
#pragma unroll 4
    for (int i = 0; i < 32; ++i) {
        const int p = tid + NTHREADS * i, f = drev14(p), pm = drev14((16384 - f) & 16383);
        const unsigned long long ua = __hip_atomic_load((const unsigned long long*)(Wg + p), __ATOMIC_RELAXED, __HIP_MEMORY_SCOPE_AGENT);
        const unsigned long long ub = __hip_atomic_load((const unsigned long long*)(Wg + pm), __ATOMIC_RELAXED, __HIP_MEMORY_SCOPE_AGENT);
        const f32x2 A = __builtin_bit_cast(f32x2, ua), B = __builtin_bit_cast(f32x2, ub);
        f32x2 K;
        if (o == 0) K = (f32x2){(A.x + B.x) * hs, (A.y - B.y) * hs};
        else { const f32x2 dd = {A.x - B.x, A.y + B.y}; K = (f32x2){dd.y * hs, -dd.x * hs}; }
        X[p] = cmulf(X[p], K);
    }
    __syncthreads();
}
__device__ __forceinline__ void hyena_fft_phase(Frame& F) {
    float* GT = WSP(float, WS_GT); const float* kT = WSP(float, WS_KT); const float* invn = WSP(float, WS_INVN); const f32x2* tw = WSP(f32x2, WS_TW);
    f32x2* Wg = WSP(f32x2, WS_FFTW) + (size_t)F.bid * 16384;
    const float* hyb = INP(25);
    LAS f32x2* X = (LAS f32x2*)F.lds;
    const int tid = F.tid;
    for (int ch = F.bid; ch < 1024; ch += F.G) {
        { const float* f0 = kT + (size_t)ch * SEQ; const float* b0 = kT + (size_t)(1024 + ch) * SEQ; const float* f1 = kT + (size_t)(2048 + ch) * SEQ; const float* b1 = kT + (size_t)(3072 + ch) * SEQ;
          for (int n = tid; n < SEQ; n += NTHREADS) { X[n] = (f32x2){f0[n], f1[n]}; X[SEQ + n] = (n == 0) ? (f32x2){0.f, 0.f} : (f32x2){b0[SEQ - n], b1[SEQ - n]}; } }
        __syncthreads();
        fft_fwd<false>(X, tw, tid);
        for (int n = tid; n < 16384; n += NTHREADS) Wg[n] = X[n];
        __syncthreads();
        const float* v0 = GT + ((size_t)ch * 2) * SEQ; float* yo = WSP(float, WS_YHT) + ((size_t)ch * 2) * SEQ;
        const float* x1 = GT + ((size_t)(1024 + ch) * 2) * SEQ; const float* x2 = GT + ((size_t)(2048 + ch) * 2) * SEQ;
        float z0[16], z1[16];
#pragma unroll
        for (int j = 0; j < 16; ++j) { const int n = tid + NTHREADS * j; z0[j] = v0[n]; z1[j] = v0[SEQ + n]; }
#pragma unroll
        for (int o = 0; o < 2; ++o) {
#pragma unroll
            for (int j = 0; j < 16; ++j) { const int n = tid + NTHREADS * j; X[n] = (f32x2){z0[j], z1[j]}; }
            __syncthreads();
            fft_fwd<true>(X, tw, tid);
            fft_pointwise(X, Wg, o, invn[o * 1024 + ch] * (1.0f / 16384.0f), tid);
            fft_inv(X, tw, tid);
            const float bias = hyb[o * 1024 + ch]; const float* xg = (o == 0) ? x1 : x2;
#pragma unroll
            for (int j = 0; j < 16; ++j) { const int n = tid + NTHREADS * j; const f32x2 y = X[n]; z0[j] = xg[n] * (y.x + bias * z0[j]); z1[j] = xg[SEQ + n] * (y.y + bias * z1[j]); }
            __syncthreads();
        }
#pragma unroll
        for (int j = 0; j < 16; ++j) { const int n = tid + NTHREADS * j; yo[n] = z0[j]; yo[SEQ + n] = z1[j]; }
    }
}
__device__ __forceinline__ void hyena_out_transpose(Frame& F) {
    const float* GT = WSP(float, WS_YHT); bf16* cat = WSP(bf16, WS_CAT);
    LAS float* scr = (LAS float*)(F.lds + F.wave * 17408);
    const int lane = F.lane;
    for (int it = F.gw; it < 2 * 128 * 16; it += F.NGW) {
        const int cbk = it & 15, tb = (it >> 4) & 127, b = it >> 11, t0 = tb * 64;
        for (int c = 0; c < 64; ++c) scr[c * 65 + lane] = GT[((size_t)(cbk * 64 + c) * 2 + b) * SEQ + t0 + lane];
        LDS_WAIT(); asm volatile("" ::: "memory");
#pragma unroll
        for (int i = 0; i < 8; ++i) { const int tt = 8 * i + (lane >> 3), c0 = (lane & 7) * 8; const LAS float* s = scr + c0 * 65 + tt;
            v4u o; o.x = cvt_pk_bf16(s[0], s[65]); o.y = cvt_pk_bf16(s[130], s[195]); o.z = cvt_pk_bf16(s[260], s[325]); o.w = cvt_pk_bf16(s[390], s[455]);
            *(v4u*)(cat + ((size_t)b * SEQ + t0 + tt) * 2048 + cbk * 64 + c0) = o; }
        LDS_WAIT(); asm volatile("" ::: "memory");
    }
}

__device__ __forceinline__ int s5_row(int di, int b, int s) {
    return (s < CTX) ? TL + b * CTX + (di == 0 ? s : CTX - 1 - s) : b * SEQ + (di == 0 ? s - CTX : SEQ - 1 - (s - CTX));
}
template <bool OUTPUT>
__device__ __forceinline__ void s5_seg_phase(Frame& F) {
    const bf16* PJ = WSP(bf16, WS_PROJ1); float* YD = WSP(float, WS_YD);
    const f32x2* lamb = WSP(f32x2, WS_S5LAM); const f32x2* bbar = WSP(f32x2, WS_S5B); const f32x2* l256 = WSP(f32x2, WS_S5L256); f32x2* Eb = WSP(f32x2, WS_S5E);
    const float* cre = INP(31); const float* cim = INP(32);
    const int lane = F.lane;
    for (int task = F.wave * F.G + F.bid; task < 256 * 32; task += F.NGW) {
        const int dbg = task >> 5, seg = (task & 31) + (OUTPUT ? 1 : 0);
        const int di = dbg >> 7, b = (dbg >> 6) & 1, g = dbg & 63;
        const int dgp = (di * 64 + g) * 64 + lane;
        const f32x2 lam = lamb[dgp];
        float br[16], bi[16];
#pragma unroll
        for (int c = 0; c < 16; ++c) { const f32x2 bv = bbar[(size_t)dgp * 16 + c]; br[c] = bv.x; bi[c] = bv.y; }
        float cr[16], ci[16];
        if (OUTPUT) {
#pragma unroll
            for (int c = 0; c < 16; ++c) { cr[c] = cre[((size_t)(di * 64 + g) * 16 + c) * 64 + lane]; ci[c] = cim[((size_t)(di * 64 + g) * 16 + c) * 64 + lane]; }
        }
        float sr = 0.f, si = 0.f;
        if (OUTPUT) {
            const f32x2 l2 = l256[dgp]; const f32x2* ep = Eb + ((size_t)dbg * 32) * 64 + lane;
            for (int k = 0; k < seg; ++k) { const f32x2 e = ep[(size_t)k * 64]; const float nr = l2.x * sr - l2.y * si + e.x, ni = l2.x * si + l2.y * sr + e.y; sr = nr; si = ni; }
        }
        const int s0 = seg * 256;
#pragma nounroll
        for (int st = 0; st < 256; st += 4) {
            const int row = s5_row(di, b, s0 + st + (lane >> 4));
            const float uval = bf2f(PJ[(size_t)row * 4096 + 3072 + g * 16 + (lane & 15)]);
#pragma unroll
            for (int k = 0; k < 4; ++k) {
                float bur = 0.f, bui = 0.f;
#pragma unroll
                for (int c = 0; c < 16; ++c) { const float u = __builtin_bit_cast(float, __builtin_amdgcn_readlane(__builtin_bit_cast(int, uval), 16 * k + c)); bur += br[c] * u; bui += bi[c] * u; }
                const float nr = lam.x * sr - lam.y * si + bur, ni = lam.x * si + lam.y * sr + bui; sr = nr; si = ni;
                if (OUTPUT) {
                    float v8[8], v4[4], v2[2], v1;
                    const bool b5 = (lane & 32) != 0, b4 = (lane & 16) != 0, b3 = (lane & 8) != 0, b2 = (lane & 4) != 0;
#pragma unroll
                    for (int i = 0; i < 8; ++i) { const float lo = cr[i] * sr - ci[i] * si, hi = cr[i + 8] * sr - ci[i + 8] * si; const float keep = b5 ? hi : lo, send = b5 ? lo : hi; v8[i] = keep + __shfl_xor(send, 32); }
#pragma unroll
                    for (int i = 0; i < 4; ++i) { const float keep = b4 ? v8[i + 4] : v8[i], send = b4 ? v8[i] : v8[i + 4]; v4[i] = keep + __shfl_xor(send, 16); }
#pragma unroll
                    for (int i = 0; i < 2; ++i) { const float keep = b3 ? v4[i + 2] : v4[i], send = b3 ? v4[i] : v4[i + 2]; v2[i] = keep + __shfl_xor(send, 8); }
                    { const float keep = b2 ? v2[1] : v2[0], send = b2 ? v2[0] : v2[1]; v1 = keep + __shfl_xor(send, 4); }
                    v1 += __shfl_xor(v1, 2); v1 += __shfl_xor(v1, 1);
                    const int s = s0 + st + k, t = (di == 0) ? s - CTX : SEQ - 1 - (s - CTX);
                    if ((lane & 3) == 0) YD[((size_t)di * TL + (size_t)b * SEQ + t) * 1024 + g * 16 + (lane >> 2)] = v1;
                }
            }
        }
        if (!OUTPUT) Eb[((size_t)dbg * 32 + seg) * 64 + lane] = (f32x2){sr, si};
    }
}

typedef float f32x4_t __attribute__((ext_vector_type(4)));
template <bool OUTPUT>
__device__ __forceinline__ void s5_mfma_phase(Frame& F) {
    const bf16* PJ = WSP(bf16, WS_PROJ1); float* YD = WSP(float, WS_YD);
    const f32x2* lamb = WSP(f32x2, WS_S5LAM); const f32x2* bbar = WSP(f32x2, WS_S5B); const f32x2* l256 = WSP(f32x2, WS_S5L256); f32x2* Eb = WSP(f32x2, WS_S5E);
    const float* cre = INP(31); const float* cim = INP(32);
    const int lane = F.lane, fr = lane & 15, fq = lane >> 4;
    LAS unsigned* Xl = (LAS unsigned*)(F.lds + F.wave * 4608);
    for (int task = F.wave * F.G + F.bid; task < 256 * 32; task += F.NGW) {
        const int dbg = task >> 5, seg = (task & 31) + (OUTPUT ? 1 : 0);
        const int di = dbg >> 7, b = (dbg >> 6) & 1, g = dbg & 63;
        const int dg = di * 64 + g;
        f32x2 l1[4], l2[4], l3[4], l4[4];
        bf16x8 bfr[8];
#pragma unroll
        for (int t = 0; t < 4; ++t) { const int dgp = dg * 64 + 16 * t + fr; l1[t] = lamb[dgp]; l2[t] = cmulf(l1[t], l1[t]); l3[t] = cmulf(l2[t], l1[t]); l4[t] = cmulf(l2[t], l2[t]);
            v4u wre = {0u, 0u, 0u, 0u}, wim = {0u, 0u, 0u, 0u};
            if (fq < 2) { const f32x4* bp = (const f32x4*)(bbar + (size_t)dgp * 16 + 8 * fq); const f32x4 q0 = bp[0], q1 = bp[1], q2 = bp[2], q3 = bp[3];
                wre.x = cvt_pk_bf16(q0.x, q0.z); wre.y = cvt_pk_bf16(q1.x, q1.z); wre.z = cvt_pk_bf16(q2.x, q2.z); wre.w = cvt_pk_bf16(q3.x, q3.z);
                wim.x = cvt_pk_bf16(q0.y, q0.w); wim.y = cvt_pk_bf16(q1.y, q1.w); wim.z = cvt_pk_bf16(q2.y, q2.w); wim.w = cvt_pk_bf16(q3.y, q3.w); }
            bfr[t] = __builtin_bit_cast(bf16x8, wre); bfr[4 + t] = __builtin_bit_cast(bf16x8, wim); }
        bf16x8 cfr[4];
        if (OUTPUT) {
#pragma unroll
            for (int ks = 0; ks < 4; ++ks) { const size_t cb = ((size_t)dg * 16 + fr) * 64 + 16 * ks + 4 * fq; const f32x4 r4 = *(const f32x4*)(cre + cb), i4 = *(const f32x4*)(cim + cb);
                v4u w; w.x = cvt_pk_bf16(r4.x, -i4.x); w.y = cvt_pk_bf16(r4.y, -i4.y); w.z = cvt_pk_bf16(r4.z, -i4.z); w.w = cvt_pk_bf16(r4.w, -i4.w); cfr[ks] = __builtin_bit_cast(bf16x8, w); }
        }
        f32x2 st[4];
#pragma unroll
        for (int t = 0; t < 4; ++t) st[t] = (f32x2){0.f, 0.f};
        if (OUTPUT) {
#pragma unroll
            for (int t = 0; t < 4; ++t) { const f32x2 lq = l256[dg * 64 + 16 * t + fr]; const f32x2* ep = Eb + ((size_t)dbg * 32) * 64 + 16 * t + fr;
                for (int k = 0; k < seg; ++k) { const f32x2 e = ep[(size_t)k * 64]; st[t] = cmulf(lq, st[t]) + e; } }
        }
        const int s0 = seg * 256;
        v4u unext = {0u, 0u, 0u, 0u};
        if (fq < 2) unext = *(const v4u*)(PJ + (size_t)s5_row(di, b, s0 + fr) * 4096 + 3072 + g * 16 + 8 * fq);
#pragma nounroll
        for (int blk = 0; blk < 16; ++blk) {
            const bf16x8 ufr = __builtin_bit_cast(bf16x8, unext);
            if (blk + 1 < 16 && fq < 2) unext = *(const v4u*)(PJ + (size_t)s5_row(di, b, s0 + 16 * (blk + 1) + fr) * 4096 + 3072 + g * 16 + 8 * fq);
            f32x4 bu[8];
#pragma unroll
            for (int nt = 0; nt < 8; ++nt) bu[nt] = __builtin_amdgcn_mfma_f32_16x16x32_bf16(ufr, bfr[nt], (f32x4){0.f, 0.f, 0.f, 0.f}, 0, 0, 0);
            f32x2 xs[4][4];
#pragma unroll
            for (int t = 0; t < 4; ++t) {
                f32x2 x0 = {bu[t][0], bu[4 + t][0]}, x1 = cmulf(l1[t], x0) + (f32x2){bu[t][1], bu[4 + t][1]}, x2 = cmulf(l1[t], x1) + (f32x2){bu[t][2], bu[4 + t][2]}, x3 = cmulf(l1[t], x2) + (f32x2){bu[t][3], bu[4 + t][3]};
                f32x2 sin = st[t];
                f32x2 fin = x3 + cmulf(l4[t], (fq == 0) ? sin : (f32x2){0.f, 0.f});
#pragma unroll
                for (int rd = 1; rd < 4; ++rd) { const float vr = __shfl(fin.x, lane - 16), vi = __shfl(fin.y, lane - 16);
                    if (fq == rd) { sin = (f32x2){vr, vi}; fin = x3 + cmulf(l4[t], sin); } }
                xs[t][0] = x0 + cmulf(l1[t], sin); xs[t][1] = x1 + cmulf(l2[t], sin); xs[t][2] = x2 + cmulf(l3[t], sin); xs[t][3] = x3 + cmulf(l4[t], sin);
                st[t] = (f32x2){__shfl(xs[t][3].x, 48 + fr), __shfl(xs[t][3].y, 48 + fr)};
            }
            if (OUTPUT) {
#pragma unroll
                for (int t = 0; t < 4; ++t)
#pragma unroll
                    for (int r = 0; r < 4; ++r) Xl[(4 * fq + r) * 68 + 16 * t + fr] = cvt_pk_bf16(xs[t][r].x, xs[t][r].y);
                LDS_WAIT(); asm volatile("" ::: "memory");
                f32x4 y = {0.f, 0.f, 0.f, 0.f};
#pragma unroll
                for (int ks = 0; ks < 4; ++ks) { const bf16x8 xa = *(const LAS bf16x8*)(Xl + fr * 68 + 16 * ks + 4 * fq); y = __builtin_amdgcn_mfma_f32_16x16x32_bf16(xa, cfr[ks], y, 0, 0, 0); }
                LDS_WAIT(); asm volatile("" ::: "memory");
#pragma unroll
                for (int r = 0; r < 4; ++r) { const int s = s0 + 16 * blk + 4 * fq + r, tl = (di == 0) ? s - CTX : SEQ - 1 - (s - CTX);
                    YD[((size_t)di * TL + (size_t)b * SEQ + tl) * 1024 + g * 16 + fr] = y[r]; }
            }
        }
        if (!OUTPUT) { if (fq == 0) {
#pragma unroll
            for (int t = 0; t < 4; ++t) Eb[((size_t)dbg * 32 + seg) * 64 + 16 * t + fr] = st[t]; } }
    }
}

#ifndef S5C_EOFF
#define S5C_EOFF 0
#endif
#define S5_KEEP8(acc, f) asm volatile("" : "+v"(acc) : "v"(f[0]), "v"(f[1]), "v"(f[2]), "v"(f[3]), "v"(f[4]), "v"(f[5]), "v"(f[6]), "v"(f[7]))
#define S5_KEEP4(acc, f) asm volatile("" : "+v"(acc) : "v"(f[0]), "v"(f[1]), "v"(f[2]), "v"(f[3]))
template <bool OUTPUT, int S5C_RUN = 0>
__device__ __forceinline__ void s5_chunk_phase(Frame& F) {
    const bf16* PJ = WSP(bf16, WS_PROJ1); float* YD = WSP(float, WS_YD);
    const f32x2* l16t = WSP(f32x2, WS_S5L16); const f32x2* l256 = WSP(f32x2, WS_S5L256); f32x2* Eb = WSP(f32x2, WS_S5E);
    const bf16* W1 = WSP(bf16, WS_S5W1); const bf16* W3 = WSP(bf16, WS_S5W3); const bf16* KT = WSP(bf16, WS_S5KT);
    const int lane = F.lane, fr = lane & 15, fq = lane >> 4;
    LAS unsigned* Xl = (LAS unsigned*)(F.lds + F.wave * 4608);
    f32x2 carry[4];
#pragma unroll
    for (int t = 0; t < 4; ++t) carry[t] = (f32x2){0.f, 0.f};
#pragma nounroll
    for (int j = 0;; ++j) {
        const int tq = F.wave * F.G + F.bid + (j >> 2) * F.NGW, sub4 = j & 3;
        if (tq >= 256 * 8) break;
        const int task = tq * 4 + sub4;
        const int dbg = task >> 5, seg = (task & 31) + (OUTPUT ? 1 : 0);
        const int di = dbg >> 7, b = (dbg >> 6) & 1, g = dbg & 63;
        const int dg = di * 64 + g;
        const int s0 = seg * 256;
        bf16x8 afr[8];
#pragma unroll
        for (int ks = 0; ks < 8; ++ks) afr[ks] = *(const bf16x8*)(PJ + (size_t)s5_row(di, b, s0 + 16 * fr + 2 * ks + (fq >> 1)) * 4096 + 3072 + g * 16 + 8 * (fq & 1));
        f32x4 ea[8];
        { const bf16* w1p = W1 + ((size_t)dg * 128 + fr) * 256 + 8 * fq;
#pragma unroll
          for (int nt = 0; nt < 8; ++nt) { f32x4 a = {0.f, 0.f, 0.f, 0.f}; bf16x8 bw[8];
#pragma unroll
              for (int ks = 0; ks < 8; ++ks) bw[ks] = *(const bf16x8*)(w1p + (size_t)nt * 16 * 256 + 32 * ks);
#pragma unroll
              for (int ks = 0; ks < 8; ++ks) a = __builtin_amdgcn_mfma_f32_16x16x32_bf16(afr[ks], bw[ks], a, 0, 0, 0);
              S5_KEEP8(a, bw); S5_KEEP8(a, afr);
              ea[nt] = a; } }
        f32x2 st[4];
#pragma unroll
        for (int t = 0; t < 4; ++t) st[t] = (f32x2){0.f, 0.f};
        if (OUTPUT) {
#pragma unroll
            for (int t = 0; t < 4; ++t) { const f32x2 lq = l256[dg * 64 + 16 * t + fr]; const f32x2* ep = Eb + ((size_t)dbg * 32) * 64 + 16 * t + fr;
                if (sub4 == 0) {
                    int k = 0;
                    for (; k + 8 <= seg; k += 8) { f32x2 e8[8];
#pragma unroll
                        for (int j = 0; j < 8; ++j) e8[j] = ep[(size_t)(k + j) * 64];
#pragma unroll
                        for (int j = 0; j < 8; ++j) st[t] = cmulf(lq, st[t]) + e8[j]; }
                    for (; k < seg; ++k) st[t] = cmulf(lq, st[t]) + ep[(size_t)k * 64];
                } else st[t] = cmulf(lq, carry[t]) + ep[(size_t)(seg - 1) * 64];
                carry[t] = st[t]; }
        }
#pragma unroll
        for (int t = 0; t < 4; ++t) {
            const f32x2 L1 = l16t[dg * 64 + 16 * t + fr], L2 = cmulf(L1, L1), L3 = cmulf(L2, L1), L4 = cmulf(L2, L2);
            const f32x2 x0 = {ea[t][0], ea[4 + t][0]}, x1 = cmulf(L1, x0) + (f32x2){ea[t][1], ea[4 + t][1]}, x2 = cmulf(L1, x1) + (f32x2){ea[t][2], ea[4 + t][2]}, x3 = cmulf(L1, x2) + (f32x2){ea[t][3], ea[4 + t][3]};
            f32x2 sin = st[t];
            f32x2 fin = x3 + cmulf(L4, (fq == 0) ? sin : (f32x2){0.f, 0.f});
#pragma unroll
            for (int rd = 1; rd < 4; ++rd) { const float vr = __shfl(fin.x, lane - 16), vi = __shfl(fin.y, lane - 16);
                if (fq == rd) { sin = (f32x2){vr, vi}; fin = x3 + cmulf(L4, sin); } }
            if (OUTPUT) {
                const f32x2 h1 = x0 + cmulf(L1, sin), h2 = x1 + cmulf(L2, sin), h3 = x2 + cmulf(L3, sin);
                Xl[(4 * fq + 0) * 68 + 16 * t + fr] = cvt_pk_bf16(sin.x, sin.y); Xl[(4 * fq + 1) * 68 + 16 * t + fr] = cvt_pk_bf16(h1.x, h1.y);
                Xl[(4 * fq + 2) * 68 + 16 * t + fr] = cvt_pk_bf16(h2.x, h2.y); Xl[(4 * fq + 3) * 68 + 16 * t + fr] = cvt_pk_bf16(h3.x, h3.y);
#if S5C_EOFF == 2
                { const f32x2 L8 = cmulf(L4, L4), L12 = cmulf(L8, L4); const f32x2 wgt = (fq == 3) ? (f32x2){1.f, 0.f} : (fq == 2) ? L4 : (fq == 1) ? L8 : L12;
                  f32x2 xe = cmulf(wgt, x3); xe.x += __shfl_xor(xe.x, 16); xe.y += __shfl_xor(xe.y, 16); xe.x += __shfl_xor(xe.x, 32); xe.y += __shfl_xor(xe.y, 32);
                  if (fq == 0 && seg < 32) WSP(f32x2, WS_Y)[((size_t)dbg * 32 + seg) * 64 + 16 * t + fr] = xe; }
#endif
            } else {
                st[t] = (f32x2){__shfl(fin.x, 48 + fr), __shfl(fin.y, 48 + fr)};
            }
        }
        if (!OUTPUT) {
            if (fq == 0) {
#pragma unroll
                for (int t = 0; t < 4; ++t) (S5C_EOFF == 1 ? WSP(f32x2, WS_Y) : (S5C_EOFF == 3 ? WSP(f32x2, WS_Y) + S5C_RUN * (1u << 20) : Eb))[((size_t)dbg * 32 + seg) * 64 + 16 * t + fr] = st[t];
            }
        } else {
            LDS_WAIT(); asm volatile("" ::: "memory");
            bf16x8 hfr[4];
#pragma unroll
            for (int ks = 0; ks < 4; ++ks) hfr[ks] = *(const LAS bf16x8*)(Xl + fr * 68 + 16 * ks + 4 * fq);
#ifdef S5_ZERO_CARRY
#pragma unroll
            for (int ks = 0; ks < 4; ++ks) hfr[ks] = (bf16x8){0,0,0,0,0,0,0,0};
#endif
            LDS_WAIT(); asm volatile("" ::: "memory");
            const bf16* w3p = W3 + ((size_t)dg * 256 + fr) * 128 + 8 * fq;
            const bf16* ktp = KT + (size_t)dg * 17 * 256 + fr * 16 + 8 * (fq & 1);
#pragma unroll
            for (int tau = 0; tau < 16; ++tau) {
                f32x4 y = {0.f, 0.f, 0.f, 0.f}; bf16x8 b3[4], bk[8];
#pragma unroll
                for (int ks = 0; ks < 4; ++ks) b3[ks] = *(const bf16x8*)(w3p + (size_t)tau * 16 * 128 + 32 * ks);
#pragma unroll
                for (int ks = 0; ks < 8; ++ks) { const int d1 = (ks <= tau / 2) ? tau - 2 * ks - (fq >> 1) + 1 : 0;
                    bk[ks] = *(const bf16x8*)(ktp + (size_t)d1 * 256); }
#pragma unroll
                for (int ks = 0; ks < 4; ++ks) y = __builtin_amdgcn_mfma_f32_16x16x32_bf16(hfr[ks], b3[ks], y, 0, 0, 0);
#pragma unroll
                for (int ks = 0; ks <= tau / 2; ++ks) y = __builtin_amdgcn_mfma_f32_16x16x32_bf16(afr[ks], bk[ks], y, 0, 0, 0);
                S5_KEEP4(y, b3); S5_KEEP8(y, bk); S5_KEEP8(y, afr); S5_KEEP4(y, hfr);
#pragma unroll
                for (int r = 0; r < 4; ++r) { const int s = s0 + 16 * (4 * fq + r) + tau, tl = (di == 0) ? s - CTX : SEQ - 1 - (s - CTX);
                    YD[(((size_t)(di * 2 + b) * 64 + g) * SEQ + tl) * 16 + fr] = y[r]; }
            }
        }
    }
}

#if S5C_EOFF
__device__ __forceinline__ void s5_check_phase(Frame& F) {
    const f32x2* Ea = (S5C_EOFF == 3) ? WSP(f32x2, WS_Y) + (1u << 20) : WSP(f32x2, WS_S5E); const f32x2* Ebn = WSP(f32x2, WS_Y); unsigned* flag = WSP(unsigned, WS_CTL) + 9000;
    const int gt = F.bid * NTHREADS + F.tid, NGT = F.G * NTHREADS;
    for (int idx = gt; idx < 256 * 32 * 64; idx += NGT) { const f32x2 a = Ea[idx], b = Ebn[idx];
        const float d = fabsf(a.x - b.x) + fabsf(a.y - b.y), m = fabsf(a.x) + fabsf(a.y) + fabsf(b.x) + fabsf(b.y);
        if (S5C_FILTER(idx) && !(d <= S5C_TOL * m + 1e-4f)) atomicAdd(flag, 1u); }
}
#endif

constexpr int NPHASES = 21;
#ifndef MK_SINGLE
#define MK_SINGLE 1
#endif

__device__ __forceinline__ unsigned long long launder_u64(unsigned long long v) {
    unsigned lo = (unsigned)v, hi = (unsigned)(v >> 32);
    asm volatile("" : "+v"(lo), "+v"(hi));
    lo = __builtin_amdgcn_readfirstlane(lo); hi = __builtin_amdgcn_readfirstlane(hi);
    return ((unsigned long long)hi << 32) | lo;
}
__device__ __forceinline__ const void* launder_ptr(const void* p) {
    unsigned long long v = (unsigned long long)p; unsigned lo = (unsigned)v, hi = (unsigned)(v >> 32);
    asm volatile("" : "+v"(lo), "+v"(hi));
    lo = __builtin_amdgcn_readfirstlane(lo); hi = __builtin_amdgcn_readfirstlane(hi);
    return (const void*)(((unsigned long long)hi << 32) | lo);
}
__device__ __forceinline__ void moe_blocks(Frame& F, int l, LAS int* bstart) {
    __syncthreads();
    if (F.tid == 0) { const unsigned* cnt = WSP(unsigned, WS_CTL) + CW_CNT + l * 64; int acc = 0;
        for (int e = 0; e < 64; ++e) { bstart[e] = acc; const int nb = ((int)cnt[e] + 255) >> 8; for (int j = 0; j < nb; ++j) bstart[65 + acc + j] = e; acc += nb; } bstart[64] = acc; }
    __syncthreads();
}

template <int PHSEL>
__global__ void __launch_bounds__(NTHREADS, 2) mk_fwd(Args args) {
    extern __shared__ __attribute__((aligned(16))) unsigned char lds_raw[];
    Frame F;
    F.lds = (LAS unsigned char*)lds_raw; F.ws = args.ws; F.kin = (const __attribute__((address_space(4))) unsigned long long*)__builtin_amdgcn_kernarg_segment_ptr();
    F.tid = threadIdx.x; F.lane = F.tid & 63; F.wave = __builtin_amdgcn_readfirstlane(F.tid >> 6); F.bid = blockIdx.x; F.G = gridDim.x;
    F.gw = F.bid * NWAVES + F.wave; F.NGW = F.G * NWAVES;
    volatile LAS unsigned* lctl = (volatile LAS unsigned*)(F.lds + LDS_CTL);
    LAS int* bstart = (LAS int*)(F.lds + LDS_CTL + 64);
    if (F.tid < 4) lctl[F.tid] = 0u;
    __syncthreads();
    const int lo = args.ph_lo, hi = args.ph_hi;
    XcdBarrier bar; bar.bar = WSP(unsigned, WS_CTL) + CW_BAR; bar.x = 0; bar.st = lctl;
    if (PHSEL < 0) bar = xcd_barrier_post(WSP(unsigned, WS_CTL) + CW_BAR, lctl);
#ifndef PH_MASK
#define PH_MASK 0xffffffffu
#endif
#define IN(k) (((PH_MASK >> (k)) & 1u) && (PHSEL < 0 || PHSEL == (k)))
#define INL(j) (((PH_MASK >> (6 + (j))) & 1u) && (PHSEL < 0 || (PHSEL == 6 + (j) && lo == pb + (j))))
#define PH_END(k) do { if (PHSEL < 0) xcd_barrier(bar); } while (0)
#ifndef PH_REPEAT
#define PH_REPEAT 0u
#endif
#define REP(k) for (int _rep = 0; _rep < (((PH_REPEAT >> (k)) & 1u) ? 2 : 1); ++_rep)
#define DUP(k) (((PH_REPEAT >> (k)) & 1u) != 0u)
#define PH_BEGIN() do { F.ws = (unsigned char*)launder_ptr((const void*)F.ws); F.kin = (const __attribute__((address_space(4))) unsigned long long*)launder_u64((unsigned long long)F.kin); \
    { int _t = threadIdx.x; asm volatile("" : "+v"(_t)); F.tid = _t; F.lane = _t & 63; F.wave = __builtin_amdgcn_readfirstlane(_t >> 6); \
      int _b = blockIdx.x; asm volatile("" : "+v"(_b)); F.bid = __builtin_amdgcn_readfirstlane(_b); F.gw = F.bid * NWAVES + F.wave; } } while (0)
    LAS unsigned char* lds = F.lds;
    const int G = F.G, bid = F.bid;
    constexpr long T2048 = 256L * 2048 * 2;

    if (IN(0)) { PH_BEGIN(); REP(0) { p0_prologue(F); __syncthreads(); } PH_END(0); }
    if (IN(1)) { PH_BEGIN(); p1_reduce(F); PH_END(1); }
#ifdef EXTRA_BARS
    xcd_barrier(bar); xcd_barrier(bar); xcd_barrier(bar); xcd_barrier(bar); xcd_barrier(bar); xcd_barrier(bar); xcd_barrier(bar); xcd_barrier(bar); xcd_barrier(bar); xcd_barrier(bar);
#endif
        if (IN(2)) { PH_BEGIN(); REP(2) norm_phase<0>(F, 0, nullptr); PH_END(2); }
        if (IN(3)) { PH_BEGIN();
#define BODY3 { pg8::Gemm g{(const bf16*)F.ws, (const bf16*)F.ws, 2048, 2048, 2048}; InProj0Order S; S.G = G; S.c = bid; \
              S.offA1 = (long)WS_HA; S.offB1 = (long)WS_WIN0; S.offA2 = (long)(WS_WIN0 + (size_t)3072 * 2048 * 2); S.offB2 = (long)WS_HA; \
              EpiInProj0 E{EpiQKP{WSP(bf16, WS_Q), WSP(bf16, WS_K), WSP(bf16, WS_P), WSP(f32x2, WS_ROPE)}, EpiVT{WSP(bf16, WS_VT)}}; pg8::gemm_phase<EpiInProj0, InProj0Order, false>(lds, g, S, E); }
            BODY3
            if constexpr (DUP(3)) { BODY3 }
#undef BODY3
            PH_END(3);
        }
        if (IN(4)) { PH_BEGIN(); REP(4) attn_phase(F); REP(21) poold_phase(F); PH_END(4); }
        if (IN(5)) { PH_BEGIN();
            pg8::Gemm g{WSP(bf16, WS_PD), WSP(bf16, WS_WPOOL), 1024, 256, 256}; pg8::StaticOrder S; S.init(TT / 256, 4, G, bid, 256L * 1024 * 2, 256L * 2, 256L * 256 * 2);
            EpiScaleBf16 E{WSP(bf16, WS_CAT), 2048, 1024, INP(14)}; pg8::gemm_phase<EpiScaleBf16, pg8::StaticOrder, false>(lds, g, S, E);
            PH_END(5);
        }
    {
    constexpr int pb = 6; constexpr int l = 0;
    if (INL(0)) { PH_BEGIN();
        float* xbuf = WSP(float, WS_X);
        pg8::Gemm g{WSP(bf16, WS_CAT), WSP(bf16, l == 0 ? WS_WOUT0 : WS_WOUT1), 2048, 2048, 2048}; pg8::StaticOrder S; S.init(l == 0 ? TT / 256 : TL / 256, 8, G, bid, T2048, 0, T2048);
        EpiRes E{l == 0 ? INP(0) : xbuf, l == 0 ? INP(2) : xbuf + (size_t)TL * 2048, xbuf, modp(F, l, 0, 2)}; pg8::gemm_phase<EpiRes, pg8::StaticOrder, false>(lds, g, S, E);
        PH_END(pb);
    }
    if (INL(1)) { PH_BEGIN(); ffn_norm_router_phase(F, l); PH_END(pb + 1); }
    if (INL(2)) { PH_BEGIN(); REP(8) {
        moe_blocks(F, l, bstart);
        pg8::Gemm g{WSP(bf16, WS_HA), (const bf16*)(F.ws + WS_WMOE + (size_t)l * MOE_L_BYTES), 2048, 2048, 2048};
        MoeOrder S{bstart, WSP(unsigned, WS_CTL) + CW_CNT + l * 64, WSP(int, WS_TOKL), 4, G, bid, bstart[64], T2048, 0, true};
        EpiMoeUp E{WSP(bf16, WS_H)}; pg8::gemm_phase<EpiMoeUp, MoeOrder, true>(lds, g, S, E); }
        PH_END(pb + 2);
    }
    if (INL(3)) { PH_BEGIN(); REP(9) {
        moe_blocks(F, l, bstart);
        pg8::Gemm g{WSP(bf16, WS_H), (const bf16*)(F.ws + WS_WMOE + (size_t)l * MOE_L_BYTES), 512, 512, 512};
        MoeOrder S{bstart, WSP(unsigned, WS_CTL) + CW_CNT + l * 64, WSP(int, WS_TOKL), 8, G, bid, bstart[64], 256L * 512 * 2, (long)(4 * MiB), false};
        EpiMoeDown E{WSP(bf16, WS_Y), WSP(int, WS_TOKL), WSP(float, WS_GATEL), WSP(unsigned, WS_CTL) + CW_CNT + l * 64}; pg8::gemm_phase<EpiMoeDown, MoeOrder, false>(lds, g, S, E); }
        PH_END(pb + 3);
    }
    }
        if (IN(10)) { PH_BEGIN(); norm_phase<2>(F, 1, nullptr); PH_END(10); }
        if (IN(11)) { PH_BEGIN();
#define BODY11             pg8::Gemm g{WSP(bf16, WS_HA), WSP(bf16, WS_WIN1), 2048, 2048, 2048}; pg8::StaticOrder S; S.init(TT / 256, 16, G, bid, T2048, 0, T2048); \
            EpiBf16 E{WSP(bf16, WS_PROJ1), 4096}; pg8::gemm_phase<EpiBf16, pg8::StaticOrder, false>(lds, g, S, E);
            BODY11
            if constexpr (DUP(11)) { BODY11 }
#undef BODY11
            PH_END(11);
        }
        if (IN(12)) { PH_BEGIN(); REP(12) shortconv_phase(F); REP(22) s5_chunk_phase<false>(F);
#if S5C_EOFF == 1
            s5_chunk_phase<false>(F);
#endif
#if S5C_EOFF == 3
            s5_chunk_phase<false, 0>(F); s5_chunk_phase<false, 1>(F);
#endif
 PH_END(12); }
        if (IN(13)) { PH_BEGIN();
#if S5C_EOFF == 1 || S5C_EOFF == 3
            s5_check_phase(F);
#endif
            REP(23) s5_chunk_phase<true>(F); __syncthreads(); REP(13) hyena_fft_phase(F); PH_END(13); }
        if (IN(14)) { PH_BEGIN();
#if S5C_EOFF == 2
            s5_check_phase(F);
#endif
 REP(14) { s5_gelu_phase(F); hyena_out_transpose(F); } PH_END(14); }
        if (IN(15)) { PH_BEGIN();
            pg8::Gemm g{WSP(bf16, WS_PD), WSP(bf16, WS_WGLU), 1024, 1024, 1024}; pg8::StaticOrder S; S.init(TL / 256, 4, G, bid, 256L * 1024 * 2, 0, 256L * 1024 * 2);
            EpiGlu E{WSP(bf16, WS_CAT), 2048, 1024, WSP(bf16, WS_PD), INP(35)}; pg8::gemm_phase<EpiGlu, pg8::StaticOrder, false>(lds, g, S, E);
            PH_END(15);
        }
    {
    constexpr int pb = 16; constexpr int l = 1;
    if (INL(0)) { PH_BEGIN();
        float* xbuf = WSP(float, WS_X);
        pg8::Gemm g{WSP(bf16, WS_CAT), WSP(bf16, l == 0 ? WS_WOUT0 : WS_WOUT1), 2048, 2048, 2048}; pg8::StaticOrder S; S.init(l == 0 ? TT / 256 : TL / 256, 8, G, bid, T2048, 0, T2048);
        EpiRes E{l == 0 ? INP(0) : xbuf, l == 0 ? INP(2) : xbuf + (size_t)TL * 2048, xbuf, modp(F, l, 0, 2)}; pg8::gemm_phase<EpiRes, pg8::StaticOrder, false>(lds, g, S, E);
        PH_END(pb);
    }
    if (INL(1)) { PH_BEGIN(); ffn_norm_router_phase(F, l); PH_END(pb + 1); }
    if (INL(2)) { PH_BEGIN(); REP(8) {
        moe_blocks(F, l, bstart);
        pg8::Gemm g{WSP(bf16, WS_HA), (const bf16*)(F.ws + WS_WMOE + (size_t)l * MOE_L_BYTES), 2048, 2048, 2048};
        MoeOrder S{bstart, WSP(unsigned, WS_CTL) + CW_CNT + l * 64, WSP(int, WS_TOKL), 4, G, bid, bstart[64], T2048, 0, true};
        EpiMoeUp E{WSP(bf16, WS_H)}; pg8::gemm_phase<EpiMoeUp, MoeOrder, true>(lds, g, S, E); }
        PH_END(pb + 2);
    }
    if (INL(3)) { PH_BEGIN(); REP(9) {
        moe_blocks(F, l, bstart);
        pg8::Gemm g{WSP(bf16, WS_H), (const bf16*)(F.ws + WS_WMOE + (size_t)l * MOE_L_BYTES), 512, 512, 512};
        MoeOrder S{bstart, WSP(unsigned, WS_CTL) + CW_CNT + l * 64, WSP(int, WS_TOKL), 8, G, bid, bstart[64], 256L * 512 * 2, (long)(4 * MiB), false};
        EpiMoeDown E{WSP(bf16, WS_Y), WSP(int, WS_TOKL), WSP(float, WS_GATEL), WSP(unsigned, WS_CTL) + CW_CNT + l * 64}; pg8::gemm_phase<EpiMoeDown, MoeOrder, false>(lds, g, S, E); }
        PH_END(pb + 3);
    }
    }
    if (IN(20)) { PH_BEGIN(); norm_phase<3>(F, 1, args.out);
#if S5C_EOFF
        if (WSP(unsigned, WS_CTL)[9000] != 0u) { for (int i = F.bid * NTHREADS + F.tid; i < TL * 2048; i += F.G * NTHREADS) args.out[i] = __builtin_nanf(""); }
#endif
    }
#undef IN
#undef INL
#undef PH_END
}

typedef void (*kern_t)(Args);
template <int P> static void launch_phase(int grid, hipStream_t stream, Args a) { hipLaunchKernelGGL(mk_fwd<P>, dim3(grid), dim3(NTHREADS), LDS_BYTES, stream, a); }
template <int P> static bool prep_phase() { return hipFuncSetAttribute((const void*)mk_fwd<P>, hipFuncAttributeMaxDynamicSharedMemorySize, LDS_BYTES) == hipSuccess; }
extern "C" void kernel_launch(void* const* d_in, const int* in_sizes, int n_in, void* d_out, int out_size, void* d_ws, size_t ws_size, hipStream_t stream) {
    static int grid = 0;
    if (grid == 0) {
        if (n_in != 43 || out_size != TL * DM || ws_size < WS_END) { fprintf(stderr, "kernel_launch: unexpected shapes (n_in %d, out %d, ws %zu < %zu)\n", n_in, out_size, ws_size, (size_t)WS_END); grid = -1; return; }
        int dev = 0, cus = 0;
        if (hipGetDevice(&dev) != hipSuccess || hipDeviceGetAttribute(&cus, hipDeviceAttributeMultiprocessorCount, dev) != hipSuccess) { grid = -1; return; }
        bool ok = true;
#if MK_SINGLE
        ok = prep_phase<-1>();
#else
        ok = prep_phase<0>() && prep_phase<1>() && prep_phase<2>() && prep_phase<3>() && prep_phase<4>() && prep_phase<5>() && prep_phase<6>() && prep_phase<7>() && prep_phase<8>() && prep_phase<9>() &&
             prep_phase<10>() && prep_phase<11>() && prep_phase<12>() && prep_phase<13>() && prep_phase<14>() && prep_phase<15>() && prep_phase<20>();
#endif
        if (!ok) { fprintf(stderr, "kernel_launch: hipFuncSetAttribute failed\n"); grid = -1; return; }
        (void)hipGetLastError();
        grid = cus;
    }
    if (grid < 0) return;
    (void)hipMemsetAsync((char*)d_ws + WS_CTL, 0, CTL_BYTES, stream);
    Args a{};
    for (int i = 0; i < 43; ++i) a.in[i] = (const float*)d_in[i];
    a.out = (float*)d_out; a.ws = (unsigned char*)d_ws;
#if MK_SINGLE
    a.ph_lo = 0; a.ph_hi = NPHASES;
    launch_phase<-1>(grid, stream, a);
#else
#define LP(k, P) a.ph_lo = (k); a.ph_hi = (k) + 1; launch_phase<P>(grid, stream, a);
    LP(0, 0) LP(1, 1) LP(2, 2) LP(3, 3) LP(4, 4) LP(5, 5) LP(6, 6) LP(7, 7) LP(8, 8) LP(9, 9) LP(10, 10) LP(11, 11) LP(12, 12) LP(13, 13) LP(14, 14) LP(15, 15)
    LP(16, 6) LP(17, 7) LP(18, 8) LP(19, 9) LP(20, 20)
#undef LP
#endif
}
```

```cpp
#include <hip/hip_runtime.h>
#include <cstdio>
#include <cstdint>
#include <cmath>

#define GAS __attribute__((address_space(1)))
#define LAS __attribute__((address_space(3)))
typedef unsigned short bf16;
typedef unsigned v4u __attribute__((ext_vector_type(4)));
typedef unsigned v2u __attribute__((ext_vector_type(2)));
typedef float f32x4 __attribute__((ext_vector_type(4)));
typedef float f32x2 __attribute__((ext_vector_type(2)));
typedef float f32x16 __attribute__((ext_vector_type(16)));
typedef short bf16x8 __attribute__((ext_vector_type(8)));
#define LDS_WAIT() asm volatile("s_waitcnt lgkmcnt(0)" ::: "memory")
#define VM_WAIT() asm volatile("s_waitcnt vmcnt(0)" ::: "memory")

__device__ __forceinline__ unsigned f2bf(float f) { unsigned u = __builtin_bit_cast(unsigned, f); return (u + 0x7fffu + ((u >> 16) & 1u)) >> 16; }
__device__ __forceinline__ unsigned pk2(float lo, float hi) { return f2bf(lo) | (f2bf(hi) << 16); }
__device__ __forceinline__ unsigned cvt_pk_bf16(float lo, float hi) { unsigned r; asm volatile("v_cvt_pk_bf16_f32 %0, %1, %2" : "=v"(r) : "v"(lo), "v"(hi)); return r; }
__device__ __forceinline__ float bf2f(unsigned short b) { return __builtin_bit_cast(float, (unsigned)b << 16); }
__device__ __forceinline__ float bflo(unsigned w) { return __builtin_bit_cast(float, w << 16); }
__device__ __forceinline__ float bfhi(unsigned w) { return __builtin_bit_cast(float, w & 0xffff0000u); }
__device__ __forceinline__ float wave_sum(float v) {
#pragma unroll
    for (int o = 1; o < 64; o <<= 1) v += __shfl_xor(v, o);
    return v;
}

namespace pg8 {
typedef unsigned short bf16_t;
constexpr int BM = 256, BK = 64, HALF = 128, HTB = HALF * BK * 2, STAGE_BYTES = 8 * HTB;

__host__ __device__ __forceinline__ int lds_byte(int r, int c) { const int st = (r >> 4) * 2 + (c >> 5), rr = r & 15, cc = c & 31, ob = rr * 64 + cc * 2; return st * 1024 + (ob ^ (((ob >> 9) & 1) << 5)); }
__host__ __device__ __forceinline__ int perm32(int rho) { const int n = rho >> 4, i = rho & 15; return 8 * (i >> 2) + 4 * n + (i & 3); }
__host__ __device__ __forceinline__ void stage_rc(int b, int& R, int& C) { const int st = b / 1024, sb = b % 1024, swz = sb ^ (((sb >> 9) & 1) << 5); R = (st >> 1) * 16 + swz / 64; C = (st & 1) * 32 + (swz % 64) / 2; }

struct Unit { int pm, pn; long aoff, boff; int e, idx0; };
struct Gemm { const bf16_t* A; const bf16_t* Bt; int lda, ldb, K; };

template <class Epi, class Sched, bool GATHER>
__device__ __forceinline__ void gemm_phase(LAS unsigned char* lds, const Gemm g, const Sched& S, const Epi& E) {
    int tid_ = threadIdx.x; asm volatile("" : "+v"(tid_));
    const int tid = tid_, wid = __builtin_amdgcn_readfirstlane(tid >> 6), lane = tid & 63, wr = wid >> 2, wc = wid & 3, fr = lane & 15, fq = lane >> 4;
    const int K = g.K, nt = K / BK;
    unsigned voffA[2], voffB[2];
#pragma unroll
    for (int i = 0; i < 2; ++i) { int R, C; stage_rc(tid * 16 + i * 8192, R, C);
        const int Rb = Epi::PERM ? ((R & ~31) + perm32(R & 31)) : R;
        voffA[i] = (unsigned)(R * g.lda + C) * 2u; voffB[i] = (unsigned)(Rb * g.ldb + C) * 2u; }
    const size_t kstep = (size_t)(BK * 2);
    const size_t hstepA = GATHER ? 0 : (size_t)HALF * g.lda * 2, hstepB = (size_t)HALF * g.ldb * 2;
    const unsigned ldsw = (unsigned)wid * 1024u;
    const int aoff = lds_byte(wr * 64 + fr, fq * 8), boff = lds_byte(wc * 32 + fr, fq * 8);
#define PG8_SA(b, h) (((b) * 2 + (h)) * HTB)
#define PG8_SB(b, h) ((4 + (b) * 2 + (h)) * HTB)
#define PG8_STAGE(bufoff, gbase, voff) do { _Pragma("unroll") for (int _i = 0; _i < 2; ++_i) \
        __builtin_amdgcn_global_load_lds((const unsigned*)((const char*)(gbase) + (voff)[_i]), (LAS unsigned*)(lds + (bufoff) + ldsw + _i * 8192), 16, 0, 0); } while (0)
#define PG8_STAGE_A(bufoff, gbase, h, nx) do { if constexpr (GATHER) { unsigned _tv[2]; \
        if (nx) { int _tz = tid; asm volatile("" : "+v"(_tz)); _Pragma("unroll") for (int _j = 0; _j < 2; ++_j) { int _R, _C; stage_rc(_tz * 16 + _j * 8192, _R, _C); _tv[_j] = (unsigned)S.arow(nxt, (h) * HALF + _R) * (unsigned)(g.lda * 2) + (unsigned)(_C * 2); } } \
        else { _tv[0] = gvc[h][0]; _tv[1] = gvc[h][1]; } \
        PG8_STAGE(bufoff, gbase, _tv); } else { PG8_STAGE(bufoff, (gbase) + (h) * hstepA, voffA); } } while (0)
#define PG8_LDA(dst, b, h) do { _Pragma("unroll") for (int m = 0; m < 4; ++m) _Pragma("unroll") for (int k = 0; k < 2; ++k) dst[m][k] = *(const LAS bf16x8*)(lds + PG8_SA(b, h) + aoff + m * 2048 + k * 1024); } while (0)
#define PG8_LDB(dst, b, h) do { _Pragma("unroll") for (int n = 0; n < 2; ++n) _Pragma("unroll") for (int k = 0; k < 2; ++k) dst[n][k] = *(const LAS bf16x8*)(lds + PG8_SB(b, h) + boff + n * 2048 + k * 1024); } while (0)
#define PG8_MMA(ai, bj, At, Bt) do { __builtin_amdgcn_s_setprio(1); _Pragma("unroll") for (int m = 0; m < 4; ++m) _Pragma("unroll") for (int n = 0; n < 2; ++n) _Pragma("unroll") for (int k = 0; k < 2; ++k) \
        acc[ai][bj][m][n] = __builtin_amdgcn_mfma_f32_16x16x32_bf16(Bt[n][k], At[m][k], acc[ai][bj][m][n], 0, 0, 0); __builtin_amdgcn_s_setprio(0); } while (0)
#define PG8_WAIT_V(n) asm volatile("s_waitcnt vmcnt(" #n ")" ::: "memory")
#define PG8_WAIT_L(n) asm volatile("s_waitcnt lgkmcnt(" #n ")" ::: "memory")
#define PG8_BAR __builtin_amdgcn_s_barrier()
#define PG8_SCHED __builtin_amdgcn_sched_barrier(0)
    Unit cur, nxt; int ui = 0;
    if (!S.next(0, cur)) return;
    unsigned gvc[2][2];
#define PG8_GV(unit) do { if constexpr (GATHER) { int _tz = tid; asm volatile("" : "+v"(_tz)); _Pragma("unroll") for (int _h = 0; _h < 2; ++_h) _Pragma("unroll") for (int _j = 0; _j < 2; ++_j) { int _R, _C; stage_rc(_tz * 16 + _j * 8192, _R, _C); \
        gvc[_h][_j] = (unsigned)S.arow(unit, _h * HALF + _R) * (unsigned)(g.lda * 2) + (unsigned)(_C * 2); } } } while (0)
    PG8_GV(cur);
    f32x4 acc[2][2][4][2];
#pragma unroll
    for (int a = 0; a < 2; ++a)
#pragma unroll
        for (int b = 0; b < 2; ++b)
#pragma unroll
            for (int m = 0; m < 4; ++m)
#pragma unroll
                for (int n = 0; n < 2; ++n) acc[a][b][m][n] = (f32x4){0.f, 0.f, 0.f, 0.f};
    bf16x8 At[4][2], B0[2][2], B1[2][2];
    const char* cA = (const char*)g.A + cur.aoff; const char* cB = (const char*)g.Bt + cur.boff;
    PG8_STAGE(PG8_SB(0, 0), cB, voffB); PG8_STAGE(PG8_SB(0, 1), cB + hstepB, voffB); PG8_STAGE_A(PG8_SA(0, 0), cA, 0, false); PG8_STAGE_A(PG8_SA(0, 1), cA, 1, false);
    if (wr == 1) PG8_BAR;
    PG8_WAIT_V(2); PG8_BAR;
    PG8_STAGE(PG8_SB(1, 0), cB + kstep, voffB); PG8_STAGE_A(PG8_SA(1, 0), cA + kstep, 0, false); PG8_STAGE(PG8_SB(1, 1), cB + hstepB + kstep, voffB);
    PG8_WAIT_V(6); PG8_BAR;
    for (;;) {
        const bool has_next = S.next(ui + 1, nxt);
        const char* nA = has_next ? (const char*)g.A + nxt.aoff : cA; const char* nB = has_next ? (const char*)g.Bt + nxt.boff : cB;
#pragma nounroll
        for (int t = 0; t < nt; t += 2) {
            const bool last = (t == nt - 2);
            const char* a1 = cA + (size_t)(t + 1) * kstep;
            const char* a2 = last ? nA : cA + (size_t)(t + 2) * kstep; const char* b2 = last ? nB : cB + (size_t)(t + 2) * kstep;
            const char* a3 = a2 + kstep; const char* b3 = b2 + kstep;
            PG8_LDB(B0, 0, 0); PG8_LDB(B1, 0, 1); PG8_SCHED; PG8_LDA(At, 0, 0); PG8_STAGE_A(PG8_SA(1, 1), a1, 1, false);
            PG8_WAIT_V(8); PG8_WAIT_L(0); PG8_BAR; PG8_MMA(0, 0, At, B0); PG8_MMA(0, 1, At, B1); PG8_BAR; PG8_SCHED;
            PG8_LDA(At, 0, 1); PG8_STAGE(PG8_SB(0, 0), b2, voffB); PG8_STAGE(PG8_SB(0, 1), b2 + hstepB, voffB); PG8_STAGE_A(PG8_SA(0, 0), a2, 0, last);
            PG8_WAIT_V(8); PG8_WAIT_L(0); PG8_BAR; PG8_MMA(1, 0, At, B0); PG8_MMA(1, 1, At, B1); PG8_BAR; PG8_SCHED;
            PG8_LDB(B0, 1, 0); PG8_LDB(B1, 1, 1); PG8_SCHED; PG8_LDA(At, 1, 0); PG8_STAGE_A(PG8_SA(0, 1), a2, 1, last);
            PG8_WAIT_V(8); PG8_WAIT_L(0); PG8_BAR; PG8_MMA(0, 0, At, B0); PG8_MMA(0, 1, At, B1); PG8_BAR; PG8_SCHED;
            PG8_LDA(At, 1, 1); PG8_STAGE(PG8_SB(1, 0), b3, voffB); PG8_STAGE(PG8_SB(1, 1), b3 + hstepB, voffB); PG8_STAGE_A(PG8_SA(1, 0), a3, 0, last);
            PG8_WAIT_V(8); PG8_WAIT_L(0); PG8_BAR; PG8_MMA(1, 0, At, B0); PG8_MMA(1, 1, At, B1); PG8_BAR; PG8_SCHED;
        }
        if (wr == 0) PG8_BAR;
        E(acc, cur, wr, wc, fr, fq);
        if (!has_next) break;
#pragma unroll
        for (int a = 0; a < 2; ++a)
#pragma unroll
            for (int b = 0; b < 2; ++b)
#pragma unroll
                for (int m = 0; m < 4; ++m)
#pragma unroll
                    for (int n = 0; n < 2; ++n) acc[a][b][m][n] = (f32x4){0.f, 0.f, 0.f, 0.f};
        cur = nxt; cA = nA; cB = nB; ++ui;
        PG8_GV(cur);
        if (wr == 1) PG8_BAR;
    }
    PG8_WAIT_V(0);
    PG8_BAR;
#undef PG8_SA
#undef PG8_SB
#undef PG8_STAGE
#undef PG8_STAGE_A
#undef PG8_GV
#undef PG8_LDA
#undef PG8_LDB
#undef PG8_MMA
#undef PG8_WAIT_V
#undef PG8_WAIT_L
#undef PG8_BAR
#undef PG8_SCHED
}

struct StaticOrder {
    int nM, nN, nwg, G, c; long astride, apn, bstride;
    __device__ void init(int nM_, int nN_, int G_, int c_, long astride_, long apn_, long bstride_) { nM = nM_; nN = nN_; nwg = nM * nN; G = G_; c = c_; astride = astride_; apn = apn_; bstride = bstride_; }
    __device__ bool next(int i, Unit& u) const {
        const long Lx = (long)i * G + c; if (Lx >= nwg) return false;
        int wgid = (int)Lx; { const int q = nwg / 8, r = nwg % 8, xcd = wgid % 8, off = wgid / 8; wgid = (xcd < r ? xcd * (q + 1) : r * (q + 1) + (xcd - r) * q) + off; }
        const int nig = 8 * nN, gid = wgid / nig, fm = gid * 8, gsz = (nM - fm) < 8 ? (nM - fm) : 8;
        u.pm = fm + ((wgid % nig) % gsz); u.pn = (wgid % nig) / gsz; u.aoff = (long)u.pm * astride + (long)u.pn * apn; u.boff = (long)u.pn * bstride; u.e = 0; u.idx0 = 0; return true;
    }
    __device__ int arow(const Unit&, int) const { return 0; }
};
}

constexpr int DM = 2048, NBATCH = 2, SEQ = 8192, CTX = 256;
constexpr int TL = NBATCH * SEQ;
constexpr int TC = NBATCH * CTX;
constexpr int TT = TL + TC;
constexpr int KEYS = CTX + SEQ;
constexpr int NEXP = 64, DEXP = 512;
constexpr int LISTCAP = 2 * TT;
constexpr float EPS = 1e-6f;
constexpr float QSCALE = 0.125f * 1.4426950408889634f;
constexpr int NWAVES = 8, NTHREADS = 512;

constexpr size_t MiB = 1u << 20;
constexpr size_t WS_CTL = 0, CTL_BYTES = 1 * MiB;
constexpr size_t WS_WIN0 = 1 * MiB;
constexpr size_t WS_WOUT0 = WS_WIN0 + 16 * MiB;
constexpr size_t WS_WIN1 = WS_WOUT0 + 8 * MiB;
constexpr size_t WS_WOUT1 = WS_WIN1 + 16 * MiB;
constexpr size_t WS_WPOOL = WS_WOUT1 + 8 * MiB;
constexpr size_t WS_WGLU = WS_WPOOL + 1 * MiB;
constexpr size_t WS_WMOE = WS_WGLU + 2 * MiB;
constexpr size_t MOE_E_BYTES = 6 * MiB, MOE_L_BYTES = 64 * MOE_E_BYTES;
constexpr size_t WS_X = WS_WMOE + 2 * MOE_L_BYTES;
constexpr size_t WS_HA = WS_X + 132 * MiB;
constexpr size_t WS_Q = WS_HA + 67 * MiB;
constexpr size_t WS_K = WS_Q + 33 * MiB;
constexpr size_t WS_VT = WS_K + 33 * MiB;
constexpr size_t WS_P = WS_VT + 33 * MiB;
constexpr size_t WS_PROJ1 = WS_Q;
constexpr size_t WS_CAT = WS_P + 33 * MiB;
constexpr size_t WS_PD = WS_CAT + 66 * MiB;
constexpr size_t WS_H = WS_PD + 33 * MiB;
constexpr size_t WS_Y = WS_H + 49 * MiB;
constexpr size_t WS_GT = WS_Y + 132 * MiB;
constexpr size_t WS_KT = WS_GT + 192 * MiB;
constexpr size_t WS_YD = WS_KT + 128 * MiB;
constexpr size_t WS_MISC = WS_YD + 128 * MiB;
constexpr size_t WS_MOD = WS_MISC;
constexpr size_t WS_ADAP = WS_MOD + 1 * MiB;
constexpr size_t WS_ROPE = WS_ADAP + 10 * MiB;
constexpr size_t WS_NORMP = WS_ROPE + 1 * MiB;
constexpr size_t WS_INVN = WS_NORMP + 4 * MiB;
constexpr size_t WS_S5LAM = WS_INVN + 1 * MiB;
constexpr size_t WS_S5B = WS_S5LAM + 1 * MiB;
constexpr size_t WS_WRT = WS_S5B + 2 * MiB;
constexpr size_t WS_TOKL = WS_WRT + 2 * MiB;
constexpr size_t WS_GATEL = WS_TOKL + 9 * MiB;
constexpr size_t WS_TW = WS_GATEL + 9 * MiB;
constexpr size_t WS_FFTW = WS_TW + 1 * MiB;
constexpr size_t WS_S5L256 = WS_FFTW + 32 * MiB;
constexpr size_t WS_S5E = WS_S5L256 + 1 * MiB;
constexpr size_t WS_YHT = WS_S5E + 4 * MiB;
constexpr size_t WS_S5L16 = WS_YHT + 64 * MiB;
constexpr size_t WS_S5W1 = WS_S5L16 + 1 * MiB;
constexpr size_t WS_S5W3 = WS_S5W1 + 8 * MiB;
constexpr size_t WS_S5KT = WS_S5W3 + 8 * MiB;
constexpr size_t WS_END = WS_S5KT + 2 * MiB;
static_assert(WS_END <= 2040 * MiB, "d_ws map");
constexpr int CW_BAR = 1024;
constexpr int CW_CNT = 8192;

constexpr int LDS_PHASE = 131072;
constexpr int LDS_CTL = 147456 - 2048;
constexpr int LDS_BYTES = 147456;

#define XB_TMO      128
#define XB_XCNT(j)  (256  + 64 * (j))
#define XB_XSUB(j)  (1280 + 64 * (j))
#define XB_XGEN(j)  (2304 + 64 * (j))
#define XB_TOP      3328
#define XB_TOPGEN   3392
#define XCD_BAR_WORDS 3456
#define XB_SPIN_CAP (1u << 22)

__device__ __forceinline__ unsigned xb_ld(unsigned* p)              { return __hip_atomic_load(p, __ATOMIC_RELAXED, __HIP_MEMORY_SCOPE_AGENT); }
__device__ __forceinline__ unsigned xb_add(unsigned* p, unsigned v) { return __hip_atomic_fetch_add(p, v, __ATOMIC_RELAXED, __HIP_MEMORY_SCOPE_AGENT); }
__device__ __forceinline__ unsigned xb_xcc_id() { return (unsigned)__builtin_amdgcn_s_getreg((3 << 11) | 20) & 0xFu; }
#define XB_SPIN(cond, bar) do { unsigned _sp = 0; while (cond) { __builtin_amdgcn_s_sleep(1); \
    if ((++_sp & 255u) == 0u) { if (xb_ld(&(bar)[XB_TMO])) break; if (_sp > XB_SPIN_CAP) { atomicAdd(&(bar)[XB_TMO], 1u); break; } } } } while (0)

struct XcdBarrier { unsigned* bar; unsigned x; volatile LAS unsigned* st; };

__device__ __forceinline__ XcdBarrier xcd_barrier_post(unsigned* bar, volatile LAS unsigned* st) {
    XcdBarrier b; b.bar = bar; b.x = xb_xcc_id(); b.st = st;
    if (threadIdx.x == 0) (void)xb_add(&bar[XB_XCNT(b.x)], 1u);
    return b;
}
__device__ __forceinline__ void xcd_barrier_complete(unsigned* bar, unsigned x, unsigned& nloc, unsigned& nx) {
    const unsigned G = gridDim.x * gridDim.y * gridDim.z;
    unsigned sum, cnt, mine, sp = 0u;
    for (;;) {
        sum = 0u; cnt = 0u; mine = 0u;
#pragma unroll
        for (unsigned j = 0; j < 16; ++j) { const unsigned c = xb_ld(&bar[XB_XCNT(j)]); sum += c; cnt += (c > 0u) ? 1u : 0u; mine = (j == x) ? c : mine; }
        if (sum == G) break;
        __builtin_amdgcn_s_sleep(1);
        if ((++sp & 255u) == 0u) { if (xb_ld(&bar[XB_TMO])) break; if (sp > XB_SPIN_CAP) { atomicAdd(&bar[XB_TMO], 1u); break; } }
    }
    nloc = mine > 0u ? mine : 1u; nx = cnt > 0u ? cnt : 1u;
}
__device__ __forceinline__ void xcd_barrier(const XcdBarrier& b) {
    asm volatile("s_waitcnt vmcnt(0)" ::: "memory");
    __syncthreads();
    if (threadIdx.x == 0) {
        unsigned* bar = b.bar;
        __builtin_amdgcn_s_waitcnt(0);
        unsigned nloc = b.st[0], nx = b.st[1];
        if (nloc == 0u) { xcd_barrier_complete(bar, b.x, nloc, nx); b.st[0] = nloc; b.st[1] = nx; }
        const unsigned old = xb_add(&bar[XB_XSUB(b.x)], 1u);
        const unsigned gen = old / nloc;
        if (old + 1u == (gen + 1u) * nloc) {
            __builtin_amdgcn_fence(__ATOMIC_RELEASE, "agent");
            asm volatile("s_waitcnt vmcnt(0)" ::: "memory");
            const unsigned og = xb_add(&bar[XB_TOP], 1u);
            const unsigned tg = og / nx;
            if (og + 1u == (tg + 1u) * nx) xb_add(&bar[XB_TOPGEN], 1u);
            else XB_SPIN(xb_ld(&bar[XB_TOPGEN]) == tg, bar);
            __builtin_amdgcn_fence(__ATOMIC_ACQUIRE, "agent");
            xb_add(&bar[XB_XGEN(b.x)], 1u);
            asm volatile("s_waitcnt vmcnt(0)" ::: "memory");
        } else {
            XB_SPIN(xb_ld(&bar[XB_XGEN(b.x)]) == gen, bar);
            __builtin_amdgcn_fence(__ATOMIC_ACQUIRE, "agent");
            asm volatile("s_waitcnt vmcnt(0)" ::: "memory");
        }
    }
    __syncthreads();
}

__device__ __forceinline__ void sincos_2pi(double x, double& s, double& c) {
    const double q = __builtin_rint(x * 4.0);
    const double y = (x - q * 0.25) * 6.283185307179586476925;
    const double y2 = y * y;
    double sp = -7.6471637318198164759e-13; sp = sp * y2 + 1.6059043836821614599e-10; sp = sp * y2 - 2.5052108385441718775e-8; sp = sp * y2 + 2.7557319223985890653e-6;
    sp = sp * y2 - 1.9841269841269841270e-4; sp = sp * y2 + 8.3333333333333333333e-3; sp = sp * y2 - 1.6666666666666666667e-1; sp = sp * y2 * y + y;
    double cp = 4.7794773323873852974e-14; cp = cp * y2 - 1.1470745597729724714e-11; cp = cp * y2 + 2.0876756987868098979e-9; cp = cp * y2 - 2.7557319223985890653e-7;
    cp = cp * y2 + 2.4801587301587301587e-5; cp = cp * y2 - 1.3888888888888888889e-3; cp = cp * y2 + 4.1666666666666666667e-2; cp = cp * y2 - 0.5; cp = cp * y2 + 1.0;
    const int qi = ((int)q) & 3;
    s = (qi == 0) ? sp : (qi == 1) ? cp : (qi == 2) ? -sp : -cp;
    c = (qi == 0) ? cp : (qi == 1) ? -sp : (qi == 2) ? -cp : sp;
}
__device__ __forceinline__ void sincos_rad(double a, double& s, double& c) {
    double f = a * 0.15915494309189533576888; f -= __builtin_floor(f);
    if (f >= 1.0) f = 0.0;
    sincos_2pi(f, s, c);
}
__device__ __forceinline__ double exp_small(double x) {
    double r = 1.0 / 479001600.0;
    r = r * x + 1.0 / 39916800.0; r = r * x + 1.0 / 3628800.0; r = r * x + 1.0 / 362880.0; r = r * x + 1.0 / 40320.0; r = r * x + 1.0 / 5040.0;
    r = r * x + 1.0 / 720.0; r = r * x + 1.0 / 120.0; r = r * x + 1.0 / 24.0; r = r * x + 1.0 / 6.0; r = r * x + 0.5; r = r * x + 1.0; r = r * x + 1.0;
    return r;
}
__device__ __forceinline__ float fast_exp(float x) { return __builtin_amdgcn_exp2f(x * 1.4426950408889634f); }
__device__ __forceinline__ float sigmoidf_(float x) { return 1.0f / (1.0f + fast_exp(-x)); }
__device__ __forceinline__ float siluf_(float x) { return x * sigmoidf_(x); }
__device__ __forceinline__ float tanhf_(float x) { const float e = fast_exp(-2.0f * fabsf(x)); const float t = (1.0f - e) / (1.0f + e); return x < 0.f ? -t : t; }
__device__ __forceinline__ float gelu_tanh(float x) { return 0.5f * x * (1.0f + tanhf_(0.7978845608028654f * (x + 0.044715f * x * x * x))); }

#ifndef PH_REPEAT
#define PH_REPEAT 0u
#endif
struct Args { const float* in[43]; float* out; unsigned char* ws; int ph_lo, ph_hi; };

struct Frame {
    LAS unsigned char* lds; unsigned char* ws; int tid, lane, wave, bid, G, gw, NGW;
    const __attribute__((address_space(4))) unsigned long long* kin;
};
#define INP(i) ((const float*)F.kin[i])
#define WSP(T, off) ((T*)(F.ws + (off)))

__device__ __forceinline__ void tr_item(const float* W, int ldw, int N, bf16* WT, int ldt, int row_off, int rs16, LAS float* scr, int item, int lane) {
    const int nblk = N / 64, kb = item / nblk, nb = item % nblk, k0 = 64 * kb, n0 = 64 * nb;
    const int la = lane & 15, lb = lane >> 4;
    f32x4 v[16];
#pragma unroll
    for (int i = 0; i < 16; ++i) v[i] = *(const f32x4*)(W + (size_t)(k0 + 4 * i + lb) * ldw + n0 + 4 * la);
#pragma unroll
    for (int i = 0; i < 16; ++i) { const int kk = 4 * i + lb; LAS float* d = scr + (4 * la) * 65 + kk; d[0] = v[i].x; d[65] = v[i].y; d[130] = v[i].z; d[195] = v[i].w; }
    LDS_WAIT(); asm volatile("" ::: "memory");
    const int c = lane & 7;
#pragma unroll
    for (int j = 0; j < 8; ++j) { const int n = (lane >> 3) + 8 * j; const LAS float* s = scr + n * 65 + 8 * c;
        v4u o; o.x = cvt_pk_bf16(s[0], s[1]); o.y = cvt_pk_bf16(s[2], s[3]); o.z = cvt_pk_bf16(s[4], s[5]); o.w = cvt_pk_bf16(s[6], s[7]);
        const int nn = n0 + n, drow = row_off + (nn >> 4) * rs16 + (nn & 15);
        *(v4u*)(WT + (size_t)drow * ldt + k0 + 8 * c) = o; }
    LDS_WAIT(); asm volatile("" ::: "memory");
}

__device__ __forceinline__ void hyfilt_item(Frame& F, int pb) {
    const float* w1 = INP(19); const float* b1 = INP(20); const float* fq = INP(21); const float* w2 = INP(22); const float* b2 = INP(23); const float* w3 = INP(24);
    LAS float* z = (LAS float*)F.lds;
    LAS float* h1 = z + 1088;
    LAS float* h2 = h1 + 2048;
    const int tid = F.tid;
    for (int idx = tid; idx < 32 * 33; idx += NTHREADS) {
        const int p = idx / 33, f = idx % 33, i = pb * 32 + p;
        float v;
        if (f == 0) v = (float)i * (1.0f / (float)(SEQ - 1));
        else { const int j = (f - 1) & 15; const float fj = 1e-4f + (float)j * ((15.0f - 1e-4f) / 15.0f);
            double fr = (double)fj * (double)i / (double)SEQ; fr -= __builtin_floor(fr); double s, c; sincos_2pi(fr, s, c); v = (f <= 16) ? (float)c : (float)(-s); }
        z[p * 33 + f] = v;
    }
    __syncthreads();
    for (int idx = tid; idx < 2048; idx += NTHREADS) {
        const int p = idx >> 6, j = idx & 63; float a = b1[j];
        for (int f = 0; f < 33; ++f) a += z[p * 33 + f] * w1[f * 64 + j];
        double s, c; sincos_rad((double)(fq[j] * a), s, c); h1[idx] = (float)s;
    }
    __syncthreads();
    for (int idx = tid; idx < 2048; idx += NTHREADS) {
        const int p = idx >> 6, j = idx & 63; float a = b2[j];
        for (int k = 0; k < 64; ++k) a += h1[p * 64 + k] * w2[k * 64 + j];
        double s, c; sincos_rad((double)(fq[64 + j] * a), s, c); h2[idx] = (float)s;
    }
    __syncthreads();
    float* kT = WSP(float, WS_KT); float* normp = WSP(float, WS_NORMP);
    {
        const int lane = F.lane, l31 = lane & 31, lh = lane >> 5;
        float af[32];
#pragma unroll
        for (int s = 0; s < 32; ++s) af[s] = h2[l31 * 64 + 2 * s + lh];
        for (int ct = F.wave; ct < 128; ct += NWAVES) {
            const int col = ct * 32 + l31;
            f32x16 acc;
#pragma unroll
            for (int r = 0; r < 16; ++r) acc[r] = 0.f;
            float bv[32];
#pragma unroll
            for (int s = 0; s < 32; ++s) bv[s] = w3[(size_t)(2 * s + lh) * 4096 + col];
#pragma unroll
            for (int s = 0; s < 32; ++s) acc = __builtin_amdgcn_mfma_f32_32x32x2f32(af[s], bv[s], acc, 0, 0, 0);
#pragma unroll
            for (int s = 0; s < 32; s += 8) asm volatile("" : "+v"(acc) : "v"(bv[s]), "v"(bv[s + 1]), "v"(bv[s + 2]), "v"(bv[s + 3]), "v"(bv[s + 4]), "v"(bv[s + 5]), "v"(bv[s + 6]), "v"(bv[s + 7]));
            const int ch = col & 1023, dir = (col >> 10) & 1;
            const float adel = 3.0701134573253946f + (float)ch * ((15.350567286626972f - 3.0701134573253946f) / 1023.0f);
            float sabs = 0.f;
#pragma unroll
            for (int r = 0; r < 16; ++r) { const int i = pb * 32 + (r & 3) + 8 * (r >> 2) + 4 * lh; const float t = (float)i * (1.0f / (float)(SEQ - 1)); acc[r] *= fast_exp(-t * adel); if (!(dir == 1 && i == 0)) sabs += fabsf(acc[r]); }
            sabs += __shfl_xor(sabs, 32);
#pragma unroll
            for (int q = 0; q < 4; ++q) *(f32x4*)(kT + (size_t)col * SEQ + pb * 32 + 8 * q + 4 * lh) = (f32x4){acc[4 * q], acc[4 * q + 1], acc[4 * q + 2], acc[4 * q + 3]};
            if (lh == 0) normp[(size_t)pb * 4096 + col] = sabs;
        }
    }
    __syncthreads();
}

__device__ __forceinline__ void tr_wg_item(Frame& F, const float* W, int ldw, bf16* WT, int ldt, int row_off, int rs16, int k0, int n0) {
    LAS float* T = (LAS float*)F.lds;
    const int t = F.tid;
    f32x4 v[16];
#pragma unroll
    for (int i = 0; i < 16; ++i) v[i] = *(const f32x4*)(W + (size_t)(k0 + 4 * i + (t >> 7)) * ldw + n0 + 4 * (t & 127));
#pragma unroll
    for (int i = 0; i < 16; ++i) { const int k = 4 * i + (t >> 7); *(LAS f32x4*)(T + k * 516 + ((4 * (t & 127) + 8 * (k >> 3)) & 511)) = v[i]; }
    __syncthreads();
    const int c = (t >> 3) & 7, nl = (t & 7) | ((t >> 6) << 3);
#pragma unroll
    for (int q = 0; q < 8; ++q) { const int n = 64 * q + nl; const LAS float* s = T + (8 * c) * 516 + ((n + 8 * c) & 511);
        v4u o; o.x = cvt_pk_bf16(s[0], s[516]); o.y = cvt_pk_bf16(s[2 * 516], s[3 * 516]); o.z = cvt_pk_bf16(s[4 * 516], s[5 * 516]); o.w = cvt_pk_bf16(s[6 * 516], s[7 * 516]);
        const int nn = n0 + n, drow = row_off + (nn >> 4) * rs16 + (nn & 15);
        *(v4u*)(WT + (size_t)drow * ldt + k0 + 8 * c) = o; }
    __syncthreads();
}

__device__ __forceinline__ void p0_prologue(Frame& F) {
    for (int rep = 0; rep < (((PH_REPEAT >> 25) & 1u) ? 2 : 1); ++rep)
    for (int pb = F.bid; pb < SEQ / 32; pb += F.G) hyfilt_item(F, pb);
    for (int rep = 0; rep < (((PH_REPEAT >> 24) & 1u) ? 2 : 1); ++rep)
    for (int it = F.bid; it < 128 * 96; it += F.G) {
        const int le = it / 96, q = it % 96;
        bf16* wc = (bf16*)(F.ws + WS_WMOE + (size_t)le * MOE_E_BYTES); bf16* w2t = wc + 1024 * 2048;
        if (q < 32) tr_wg_item(F, INP(40) + (size_t)le * (2048 * 512), 512, wc, 2048, 0, 32, 64 * q, 0);
        else if (q < 64) tr_wg_item(F, INP(41) + (size_t)le * (2048 * 512), 512, wc, 2048, 16, 32, 64 * (q - 32), 0);
        else { const int r = q - 64; tr_wg_item(F, INP(42) + (size_t)le * (512 * 2048), 2048, w2t, 512, 0, 16, 64 * (r >> 2), 512 * (r & 3)); }
    }
    const int gt = F.bid * NTHREADS + F.tid, NGT = F.G * NTHREADS;
    {
        f32x2* rope = WSP(f32x2, WS_ROPE);
        for (int idx = gt; idx < 128 * 16; idx += NGT) { const int pos = idx >> 4, i = idx & 15;
            double inv = (i & 3) == 0 ? 1.0 : (i & 3) == 1 ? 0.56234132519034908 : (i & 3) == 2 ? 0.31622776601683794 : 0.17782794100389228;
            inv *= (i >> 2) == 0 ? 1.0 : (i >> 2) == 1 ? 0.1 : (i >> 2) == 2 ? 0.01 : 0.001;
            const float ang = (float)pos * (float)inv; double s, c; sincos_rad((double)ang, s, c); rope[idx] = (f32x2){(float)c, (float)s}; }
    }
    {
        f32x2* tw = WSP(f32x2, WS_TW);
        for (int idx = gt; idx < 16384; idx += NGT) { double s, c; sincos_2pi((double)idx * (1.0 / 16384.0), s, c); tw[idx] = (f32x2){(float)c, (float)(-s)}; }
    }
    {
        const float* are = INP(26); const float* aim = INP(27); const float* ldt = INP(28); const float* bre = INP(29); const float* bim = INP(30);
        f32x2* lamb = WSP(f32x2, WS_S5LAM); f32x2* bb = WSP(f32x2, WS_S5B); f32x2* l256 = WSP(f32x2, WS_S5L256);
        for (int idx = gt; idx < 2 * 64 * 64; idx += NGT) { const int dg = idx >> 6;
            const float dt = expf(ldt[dg]); const float ar = are[idx], ai = aim[idx];
            const float zr = ar * dt, zi = ai * dt; double s, c; sincos_rad((double)zi, s, c); const double er = exp_small((double)zr);
            const double lr = er * c, li = er * s; lamb[idx] = (f32x2){(float)lr, (float)li};
            { double pr = lr, pi = li; for (int q = 0; q < 8; ++q) { const double tr = pr * pr - pi * pi, ti = 2.0 * pr * pi; pr = tr; pi = ti; } l256[idx] = (f32x2){(float)pr, (float)pi}; }
            const double nr = lr - 1.0, ni = li, den = (double)ar * ar + (double)ai * ai; const double qr = (nr * ar + ni * ai) / den, qi = (ni * ar - nr * ai) / den;
            for (int cc = 0; cc < 16; ++cc) { const double br = bre[(size_t)idx * 16 + cc], bi = bim[(size_t)idx * 16 + cc]; bb[(size_t)idx * 16 + cc] = (f32x2){(float)(qr * br - qi * bi), (float)(qr * bi + qi * br)}; } }
    }
    {
        float* wrt = WSP(float, WS_WRT);
        for (int idx = gt; idx < 2 * 72 * 2048; idx += NGT) { const int l = idx / (72 * 2048), r = idx % (72 * 2048), n = r / 2048, k = r % 2048;
            wrt[idx] = n < 8 ? INP(36)[((size_t)l * 2048 + k) * 8 + n] : INP(38)[((size_t)l * 2048 + k) * 64 + (n - 8)]; }
    }
    {
        bf16* ha = WSP(bf16, WS_HA);
        for (int idx = gt; idx < 2048; idx += NGT) ha[(size_t)TT * 2048 + idx] = 0;
    }
    LAS float* scr = (LAS float*)(F.lds + F.wave * 16896);
    {
        const float* c = INP(1); const float* cctx = INP(3); const float* adaw = INP(4); float* part = WSP(float, WS_ADAP);
        for (int rep = 0; rep < (((PH_REPEAT >> 26) & 1u) ? 2 : 1); ++rep)
        for (int it = F.gw; it < 2 * 32 * 48; it += F.NGW) {
            const int l = it / (32 * 48), r = it % (32 * 48), ks = r / 48, jb = r % 48, k0 = ks * 64, j0 = jb * 256 + F.lane * 4;
            const float c0 = c[k0 + F.lane], c1 = c[2048 + k0 + F.lane], c2 = cctx[k0 + F.lane];
            const float s0 = c0 / (1.0f + expf(-c0)), s1 = c1 / (1.0f + expf(-c1)), s2 = c2 / (1.0f + expf(-c2));
            f32x4 a0 = {0.f, 0.f, 0.f, 0.f}, a1 = a0, a2 = a0;
            const float* wp = adaw + ((size_t)l * 2048 + k0) * 12288 + j0;
#pragma unroll 8
            for (int kk = 0; kk < 64; ++kk) { const f32x4 w = *(const f32x4*)(wp + (size_t)kk * 12288);
                const float t0 = __builtin_bit_cast(float, __builtin_amdgcn_readlane(__builtin_bit_cast(int, s0), kk));
                const float t1 = __builtin_bit_cast(float, __builtin_amdgcn_readlane(__builtin_bit_cast(int, s1), kk));
                const float t2 = __builtin_bit_cast(float, __builtin_amdgcn_readlane(__builtin_bit_cast(int, s2), kk));
                a0 += w * t0; a1 += w * t1; a2 += w * t2; }
            float* pp = part + ((size_t)(l * 32 + ks) * 3) * 12288 + j0;
            *(f32x4*)(pp) = a0; *(f32x4*)(pp + 12288) = a1; *(f32x4*)(pp + 2 * 12288) = a2;
        }
    }
    {
        constexpr int I0 = 1024, I1 = 512, I2 = 512, I3 = 1024, I4 = 2048, I5 = 1024, I6 = 64, I7 = 256, IE = 768;
        constexpr int NSMALL = I0 + I1 + I2 + I3 + I4 + I5 + I6 + I7;
        const int NITEMS = NSMALL;
        for (int rep = 0; rep < (((PH_REPEAT >> 27) & 1u) ? 2 : 1); ++rep)
        for (int it = F.gw; it < NITEMS; it += F.NGW) {
            int r = it;
            if (r < I0) { tr_item(INP(9), 4096, 2048, WSP(bf16, WS_WIN0), 2048, 0, 16, scr, r, F.lane); continue; } r -= I0;
            if (r < I1) { tr_item(INP(9) + 2048, 4096, 1024, WSP(bf16, WS_WIN0), 2048, 3072, 16, scr, r, F.lane); continue; } r -= I1;
            if (r < I2) { tr_item(INP(9) + 3072, 4096, 1024, WSP(bf16, WS_WIN0), 2048, 2048, 16, scr, r, F.lane); continue; } r -= I2;
            if (r < I3) { tr_item(INP(10), 2048, 2048, WSP(bf16, WS_WOUT0), 2048, 0, 16, scr, r, F.lane); continue; } r -= I3;
            if (r < I4) { tr_item(INP(15), 4096, 4096, WSP(bf16, WS_WIN1), 2048, 0, 16, scr, r, F.lane); continue; } r -= I4;
            if (r < I5) { tr_item(INP(16), 2048, 2048, WSP(bf16, WS_WOUT1), 2048, 0, 16, scr, r, F.lane); continue; } r -= I5;
            if (r < I6) { const int g = r / 16; tr_item(INP(13) + (size_t)g * 65536, 256, 256, WSP(bf16, WS_WPOOL), 256, g * 256, 16, scr, r % 16, F.lane); continue; } r -= I6;
            if (r < I7) { tr_item(INP(34), 1024, 1024, WSP(bf16, WS_WGLU), 1024, 0, 16, scr, r, F.lane); continue; } r -= I7;
        }
    }
}

__device__ __forceinline__ void p1_reduce(Frame& F) {
    const int gt = F.bid * NTHREADS + F.tid, NGT = F.G * NTHREADS;
    const float* part = WSP(float, WS_ADAP); float* mod = WSP(float, WS_MOD); const float* adab = INP(5);
    for (int idx = gt; idx < 2 * 3 * 12288; idx += NGT) { const int l = idx / (3 * 12288), r = idx % (3 * 12288), m = r / 12288, j = r % 12288;
        float a = adab[l * 12288 + j];
        for (int ks = 0; ks < 32; ++ks) a += part[((size_t)(l * 32 + ks) * 3 + m) * 12288 + j];
        mod[idx] = a; }
    const float* normp = WSP(float, WS_NORMP); float* invn = WSP(float, WS_INVN);
    for (int idx = gt; idx < 2048; idx += NGT) { const int o = idx >> 10, ch = idx & 1023; float a = 0.f;
        for (int pb = 0; pb < 256; ++pb) a += normp[(size_t)pb * 4096 + o * 2048 + ch] + normp[(size_t)pb * 4096 + o * 2048 + 1024 + ch];
        invn[idx] = 1.0f / a; }
    {
        const f32x2* lamb = WSP(f32x2, WS_S5LAM); const f32x2* bbar = WSP(f32x2, WS_S5B); const float* cre = INP(31); const float* cim = INP(32);
        bf16* W1 = WSP(bf16, WS_S5W1); bf16* W3 = WSP(bf16, WS_S5W3); bf16* KT = WSP(bf16, WS_S5KT); f32x2* l16 = WSP(f32x2, WS_S5L16);
#define S5_POWF(l_, e_, pw_) do { pw_ = (f32x2){1.f, 0.f}; f32x2 b_ = l_; for (int q_ = (e_); q_ > 0; q_ >>= 1) { if (q_ & 1) pw_ = (f32x2){pw_.x * b_.x - pw_.y * b_.y, pw_.x * b_.y + pw_.y * b_.x}; b_ = (f32x2){b_.x * b_.x - b_.y * b_.y, 2.f * b_.x * b_.y}; } } while (0)
        for (int idx = gt; idx < 128 * 64; idx += NGT) { f32x2 pw; S5_POWF(lamb[idx], 16, pw); l16[idx] = pw; }
        for (int idx = gt; idx < 128 * 128 * 32; idx += NGT) {
            const int k8 = idx & 31, n = (idx >> 5) & 127, dg = idx >> 12, sigma = k8 >> 1, h = k8 & 1, p = (n & 15) + 16 * ((n >> 4) & 3), im = n >> 6;
            f32x2 pw; S5_POWF(lamb[dg * 64 + p], 15 - sigma, pw);
            const f32x4* bp = (const f32x4*)(bbar + ((size_t)dg * 64 + p) * 16 + 8 * h); float o[8];
#pragma unroll
            for (int j = 0; j < 4; ++j) { const f32x4 q = bp[j]; o[2 * j] = im ? (pw.x * q.y + pw.y * q.x) : (pw.x * q.x - pw.y * q.y); o[2 * j + 1] = im ? (pw.x * q.w + pw.y * q.z) : (pw.x * q.z - pw.y * q.w); }
            v4u w; w.x = pk2(o[0], o[1]); w.y = pk2(o[2], o[3]); w.z = pk2(o[4], o[5]); w.w = pk2(o[6], o[7]);
            *(v4u*)(W1 + (size_t)idx * 8) = w; }
        for (int idx = gt; idx < 128 * 256 * 16; idx += NGT) {
            const int k8 = idx & 15, n = (idx >> 4) & 255, dg = idx >> 12, tau = n >> 4, cout = n & 15; float o[8];
#pragma unroll
            for (int j = 0; j < 4; ++j) { const int p = 4 * k8 + j; f32x2 pw; S5_POWF(lamb[dg * 64 + p], tau + 1, pw);
                const float cr = cre[((size_t)dg * 16 + cout) * 64 + p], ci = cim[((size_t)dg * 16 + cout) * 64 + p]; o[2 * j] = cr * pw.x - ci * pw.y; o[2 * j + 1] = -(cr * pw.y + ci * pw.x); }
            v4u w; w.x = pk2(o[0], o[1]); w.y = pk2(o[2], o[3]); w.z = pk2(o[4], o[5]); w.w = pk2(o[6], o[7]);
            *(v4u*)(W3 + (size_t)idx * 8) = w; }
        for (int idx = gt; idx < 128 * 17 * 16 * 2; idx += NGT) {
            const int h = idx & 1, cout = (idx >> 1) & 15, d1 = (idx >> 5) % 17, dg = (idx >> 5) / 17;
            float acc[8];
#pragma unroll
            for (int j = 0; j < 8; ++j) acc[j] = 0.f;
            if (d1 > 0) { for (int p = 0; p < 64; ++p) { f32x2 pw; S5_POWF(lamb[dg * 64 + p], d1 - 1, pw);
                const float cr = cre[((size_t)dg * 16 + cout) * 64 + p], ci = cim[((size_t)dg * 16 + cout) * 64 + p]; const float gr = cr * pw.x - ci * pw.y, gi = cr * pw.y + ci * pw.x;
                const f32x4* bp = (const f32x4*)(bbar + ((size_t)dg * 64 + p) * 16 + 8 * h);
#pragma unroll
                for (int j = 0; j < 4; ++j) { const f32x4 q = bp[j]; acc[2 * j] += gr * q.x - gi * q.y; acc[2 * j + 1] += gr * q.z - gi * q.w; } } }
            v4u w; w.x = pk2(acc[0], acc[1]); w.y = pk2(acc[2], acc[3]); w.z = pk2(acc[4], acc[5]); w.w = pk2(acc[6], acc[7]);
            *(v4u*)(KT + (size_t)idx * 8) = w; }
#undef S5_POWF
    }
}

__device__ __forceinline__ const float* modp(Frame& F, int l, int m, int c) { return WSP(float, WS_MOD) + ((size_t)(l * 3 + m) * 6 + c) * 2048; }
__device__ __forceinline__ int row_stream(int r) { return r < TL ? r / SEQ : 2; }

template <int MODE>
__device__ __forceinline__ void norm_phase(Frame& F, int l, float* dout) {
    const int nrows = (MODE == 3 || (MODE == 1 && l == 1)) ? TL : TT;
    float* xbuf = WSP(float, WS_X); bf16* ha = WSP(bf16, WS_HA); const bf16* Y = WSP(bf16, WS_Y);
    const float* gvec = (MODE == 0) ? INP(6) : (MODE == 1) ? INP(7) + l * 2048 : (MODE == 2) ? INP(6) + 2048 : INP(8);
    const int lane = F.lane;
    for (int r = F.gw; r < nrows; r += F.NGW) {
        const int m = row_stream(r);
        const float* src = (MODE == 0) ? (r < TL ? INP(0) + (size_t)r * 2048 : INP(2) + (size_t)(r - TL) * 2048) : xbuf + (size_t)r * 2048;
        f32x4 v[8]; float ss = 0.f;
#pragma unroll
        for (int j = 0; j < 8; ++j) v[j] = *(const f32x4*)(src + 4 * lane + 256 * j);
        if (MODE == 2 || MODE == 3) {
            const float* g2 = modp(F, MODE == 2 ? 0 : 1, m, 5);
            const bf16* y0 = Y + (size_t)(2 * r) * 2048; const bf16* y1 = y0 + 2048;
#pragma unroll
            for (int j = 0; j < 8; ++j) { const int c = 4 * lane + 256 * j; const v2u a = *(const v2u*)(y0 + c), b = *(const v2u*)(y1 + c); const f32x4 gg = *(const f32x4*)(g2 + c);
                v[j].x += gg.x * (bflo(a.x) + bflo(b.x)); v[j].y += gg.y * (bfhi(a.x) + bfhi(b.x)); v[j].z += gg.z * (bflo(a.y) + bflo(b.y)); v[j].w += gg.w * (bfhi(a.y) + bfhi(b.y)); }
            if (MODE == 2) {
#pragma unroll
                for (int j = 0; j < 8; ++j) *(f32x4*)(xbuf + (size_t)r * 2048 + 4 * lane + 256 * j) = v[j];
            }
        }
#pragma unroll
        for (int j = 0; j < 8; ++j) ss += (v[j].x * v[j].x + v[j].y * v[j].y) + (v[j].z * v[j].z + v[j].w * v[j].w);
        ss = wave_sum(ss);
        const float rs = 1.0f / sqrtf(ss * (1.0f / 2048.0f) + EPS);
        if (MODE == 3) {
#pragma unroll
            for (int j = 0; j < 8; ++j) { const int c = 4 * lane + 256 * j; const f32x4 gg = *(const f32x4*)(gvec + c); *(f32x4*)(dout + (size_t)r * 2048 + c) = v[j] * rs * gg; }
            continue;
        }
        const int lm = (MODE == 2) ? 1 : l;
        const float* sh = modp(F, lm, m, MODE == 1 ? 3 : 0); const float* sc = modp(F, lm, m, MODE == 1 ? 4 : 1);
#pragma unroll
        for (int j = 0; j < 8; ++j) { const int c = 4 * lane + 256 * j; const f32x4 gg = *(const f32x4*)(gvec + c), s1 = *(const f32x4*)(sc + c), s0 = *(const f32x4*)(sh + c);
            v[j] = (v[j] * rs * gg) * (1.0f + s1) + s0;
            v2u o; o.x = pk2(v[j].x, v[j].y); o.y = pk2(v[j].z, v[j].w); *(v2u*)(ha + (size_t)r * 2048 + c) = o; }
    }
}

__device__ __forceinline__ void ffn_norm_router_phase(Frame& F, int l, int dummy = 0) {
    const int nrows = (l == 1) ? TL : TT;
    const float* xbuf = WSP(float, WS_X); bf16* ha = WSP(bf16, WS_HA);
    const float* gvec = INP(7) + l * 2048;
    const float* wrt = WSP(float, WS_WRT) + (size_t)l * 72 * 2048;
    LAS float* wl = (LAS float*)F.lds;
    LAS float* lg = (LAS float*)(F.lds + 131072 + F.wave * 1536);
    const int lane = F.lane, tid = F.tid;
    for (int it = F.bid; it < nrows / 32; it += F.G) {
        const int r0 = it * 32 + F.wave * 4;
#define RT_DMA(q_, buf_) do { _Pragma("unroll") for (int _i = 0; _i < 8; ++_i) \
            __builtin_amdgcn_global_load_lds((const unsigned*)(wrt + (size_t)(q_) * 16384 + (size_t)(F.wave * 8 + _i) * 256 + lane * 4), (LAS unsigned*)(wl + (buf_) * 16384 + (F.wave * 8 + _i) * 256), 16, 0, 0); } while (0)
        RT_DMA(0, 0);
        f32x4 v[4][8];
#pragma unroll
        for (int rr = 0; rr < 4; ++rr) {
            const int r = r0 + rr, m = row_stream(r);
            const float* src = xbuf + (size_t)r * 2048; float ss = 0.f;
#pragma unroll
            for (int j = 0; j < 8; ++j) { v[rr][j] = *(const f32x4*)(src + 4 * lane + 256 * j); ss += (v[rr][j].x * v[rr][j].x + v[rr][j].y * v[rr][j].y) + (v[rr][j].z * v[rr][j].z + v[rr][j].w * v[rr][j].w); }
            ss = wave_sum(ss);
            const float rs = 1.0f / sqrtf(ss * (1.0f / 2048.0f) + EPS);
            const float* sh = modp(F, l, m, 3); const float* sc = modp(F, l, m, 4);
#pragma unroll
            for (int j = 0; j < 8; ++j) { if ((j & 1) == 0) __builtin_amdgcn_sched_barrier(0); const int c = 4 * lane + 256 * j; const f32x4 gg = *(const f32x4*)(gvec + c), s1 = *(const f32x4*)(sc + c), s0 = *(const f32x4*)(sh + c);
                v[rr][j] = (v[rr][j] * rs * gg) * (1.0f + s1) + s0;
                v2u o; o.x = cvt_pk_bf16(v[rr][j].x, v[rr][j].y); o.y = cvt_pk_bf16(v[rr][j].z, v[rr][j].w); *(v2u*)(ha + (size_t)r * 2048 + c) = o; }
        }
        asm volatile("s_waitcnt vmcnt(0)" ::: "memory");
        __syncthreads();
        const bool b5 = (lane & 32) != 0, b4 = (lane & 16) != 0, b3 = (lane & 8) != 0, b2 = (lane & 4) != 0;
#pragma nounroll
        for (int q = 0; q < 9; ++q) {
            const LAS float* wq = wl + (q & 1) * 16384;
            if (q + 1 < 9) RT_DMA(q + 1, (q + 1) & 1);
#pragma nounroll
            for (int hq = 0; hq < 2; ++hq) {
                float a[16];
#pragma unroll
                for (int nn = 0; nn < 4; ++nn) { const LAS float* wn = wq + (hq * 4 + nn) * 2048 + 4 * lane; f32x2 s0 = {0.f, 0.f}, s1 = s0, s2 = s0, s3 = s0;
#pragma unroll
                    for (int j = 0; j < 8; ++j) { const f32x4 w = *(const LAS f32x4*)(wn + 256 * j); const f32x2 wlo = {w.x, w.y}, whi = {w.z, w.w};
                        s0 = (f32x2){v[0][j].x, v[0][j].y} * wlo + s0; s0 = (f32x2){v[0][j].z, v[0][j].w} * whi + s0;
                        s1 = (f32x2){v[1][j].x, v[1][j].y} * wlo + s1; s1 = (f32x2){v[1][j].z, v[1][j].w} * whi + s1;
                        s2 = (f32x2){v[2][j].x, v[2][j].y} * wlo + s2; s2 = (f32x2){v[2][j].z, v[2][j].w} * whi + s2;
                        s3 = (f32x2){v[3][j].x, v[3][j].y} * wlo + s3; s3 = (f32x2){v[3][j].z, v[3][j].w} * whi + s3; }
                    a[nn] = s0.x + s0.y; a[4 + nn] = s1.x + s1.y; a[8 + nn] = s2.x + s2.y; a[12 + nn] = s3.x + s3.y; }
                float c8[8], c4[4], c2[2], c1;
#pragma unroll
                for (int i = 0; i < 8; ++i) { const float keep = b5 ? a[i + 8] : a[i], send = b5 ? a[i] : a[i + 8]; c8[i] = keep + __shfl_xor(send, 32); }
#pragma unroll
                for (int i = 0; i < 4; ++i) { const float keep = b4 ? c8[i + 4] : c8[i], send = b4 ? c8[i] : c8[i + 4]; c4[i] = keep + __shfl_xor(send, 16); }
#pragma unroll
                for (int i = 0; i < 2; ++i) { const float keep = b3 ? c4[i + 2] : c4[i], send = b3 ? c4[i] : c4[i + 2]; c2[i] = keep + __shfl_xor(send, 8); }
                { const float keep = b2 ? c2[1] : c2[0], send = b2 ? c2[0] : c2[1]; c1 = keep + __shfl_xor(send, 4); }
                c1 += __shfl_xor(c1, 2); c1 += __shfl_xor(c1, 1);
                if ((lane & 3) == 0) { const int i = lane >> 2; lg[(i >> 2) * 80 + q * 8 + hq * 4 + (i & 3)] = c1; }
            }
            asm volatile("s_waitcnt vmcnt(0)" ::: "memory");
            __syncthreads();
        }
#undef RT_DMA
        if (lane < 4) {
            const int r = r0 + lane; const LAS float* L = lg + lane * 80;
            float gl[8]; float gmax = -INFINITY; int gi = 0;
#pragma unroll
            for (int j = 0; j < 8; ++j) { gl[j] = L[j] + INP(37)[l * 8 + j]; if (gl[j] > gmax) { gmax = gl[j]; gi = j; } }
            float gsum = 0.f;
#pragma unroll
            for (int j = 0; j < 8; ++j) gsum += expf(gl[j] - gmax);
            const float pg_top = 1.0f / gsum;
            float pe[8]; float emax = -INFINITY;
#pragma unroll
            for (int j = 0; j < 8; ++j) { pe[j] = L[8 + gi * 8 + j] + INP(39)[l * 64 + gi * 8 + j]; emax = fmaxf(emax, pe[j]); }
            float esum = 0.f;
#pragma unroll
            for (int j = 0; j < 8; ++j) { pe[j] = expf(pe[j] - emax); esum += pe[j]; }
            int e1 = 0; float p1 = -1.f;
#pragma unroll
            for (int j = 0; j < 8; ++j) { pe[j] /= esum; if (pe[j] > p1) { p1 = pe[j]; e1 = j; } }
            int e2 = 0; float p2 = -1.f;
#pragma unroll
            for (int j = 0; j < 8; ++j) { if (j != e1 && pe[j] > p2) { p2 = pe[j]; e2 = j; } }
            const float den = p1 + p2; const float g1 = pg_top * p1 / den, g2 = pg_top * p2 / den;
            unsigned* cnt = WSP(unsigned, WS_CTL) + CW_CNT + l * 64 + dummy * 256; int* tokl = dummy ? WSP(int, WS_YD) : WSP(int, WS_TOKL); float* gatel = dummy ? WSP(float, WS_YD) + 16 * 1024 * 1024 : WSP(float, WS_GATEL);
            const int ex1 = gi * 8 + e1, ex2 = gi * 8 + e2;
            const unsigned k1 = atomicAdd(cnt + ex1, 1u); tokl[(size_t)ex1 * LISTCAP + k1] = 2 * r; gatel[(size_t)ex1 * LISTCAP + k1] = g1;
            const unsigned k2 = atomicAdd(cnt + ex2, 1u); tokl[(size_t)ex2 * LISTCAP + k2] = 2 * r + 1; gatel[(size_t)ex2 * LISTCAP + k2] = g2;
        }
        __syncthreads();
    }
}

#define EPI_ARGS const f32x4 (&acc)[2][2][4][2], const pg8::Unit& u, int wr, int wc, int fr, int fq
__device__ __forceinline__ void st_bf4(bf16* p, f32x4 v) { v2u o; o.x = cvt_pk_bf16(v.x, v.y); o.y = cvt_pk_bf16(v.z, v.w); *(v2u*)p = o; }
__device__ __forceinline__ void st_bf8(bf16* p, f32x4 a, f32x4 b) { v4u o; o.x = cvt_pk_bf16(a.x, a.y); o.y = cvt_pk_bf16(a.z, a.w); o.z = cvt_pk_bf16(b.x, b.y); o.w = cvt_pk_bf16(b.z, b.w); *(v4u*)p = o; }

struct EpiQKP {
    static constexpr bool PERM = false;
    bf16* Q; bf16* Kb; bf16* P; const f32x2* rope;
    __device__ __forceinline__ void operator()(EPI_ARGS) const {
        const int sect = u.pn >> 2, cb = (u.pn & 3) * 256; const bool latent = u.pm < TL / 256;
#pragma unroll
        for (int ai = 0; ai < 2; ++ai)
#pragma unroll
            for (int m = 0; m < 4; ++m) {
                const int r = u.pm * 256 + ai * 128 + wr * 64 + m * 16 + fr;
                int b, t; if (latent) { b = r / SEQ; t = r % SEQ; } else { b = (r - TL) / CTX; t = (r - TL) % CTX; }
                f32x4 cs0 = {1.f, 0.f, 1.f, 0.f}, cs1 = cs0;
                if (latent && sect < 2) { const int pos = (wc & 1) ? (t & 63) : (t >> 6); const f32x4* rp = (const f32x4*)(rope + pos * 16 + 4 * fq); cs0 = rp[0]; cs1 = rp[1]; }
#pragma unroll
                for (int bj = 0; bj < 2; ++bj) {
                    const int c0 = cb + bj * 128 + wc * 32 + 4 * fq;
                    f32x4 a = acc[ai][bj][m][0], bb = acc[ai][bj][m][1];
                    if (sect < 2) {
                        const f32x4 co = {cs0.x, cs0.z, cs1.x, cs1.z}, si = {cs0.y, cs0.w, cs1.y, cs1.w};
                        const f32x4 oa = a * co - bb * si, ob = a * si + bb * co; a = oa; bb = ob;
                    }
                    if (sect == 0) { a = a * QSCALE; bb = bb * QSCALE; bf16* d = Q + (size_t)r * 1024 + c0; st_bf4(d, a); st_bf4(d + 16, bb); }
                    else if (sect == 1) { const size_t kr = (size_t)b * KEYS + (latent ? CTX + t : t); bf16* d = Kb + kr * 1024 + c0; st_bf4(d, a); st_bf4(d + 16, bb); }
                    else { bf16* d = P + (size_t)r * 1024 + c0; st_bf4(d, a); st_bf4(d + 16, bb); }
                }
            }
    }
};
struct EpiVT {
    static constexpr bool PERM = false;
    bf16* VT;
    __device__ __forceinline__ void operator()(EPI_ARGS) const {
        const bool latent = u.pn < TL / 256; const int b = latent ? u.pn / 32 : u.pn - TL / 256; const int key_t0 = latent ? CTX + (u.pn % 32) * 256 : 0;
        const int kperm = 8 * (fq & 1) + 4 * (fq >> 1);
#pragma unroll
        for (int ai = 0; ai < 2; ++ai)
#pragma unroll
            for (int m = 0; m < 4; ++m) {
                const int rr = u.pm * 256 + ai * 128 + wr * 64 + m * 16 + fr;
                bf16* rowp = VT + ((size_t)b * 1024 + rr) * KEYS + key_t0;
#pragma unroll
                for (int bj = 0; bj < 2; ++bj)
#pragma unroll
                    for (int n = 0; n < 2; ++n) st_bf4(rowp + bj * 128 + wc * 32 + 16 * n + kperm, acc[ai][bj][m][n]);
            }
    }
};
struct EpiScaleBf16 {
    static constexpr bool PERM = true;
    bf16* O; int ldo, coff; const float* cscale;
    __device__ __forceinline__ void operator()(EPI_ARGS) const {
#pragma unroll
        for (int bj = 0; bj < 2; ++bj) { const int c = u.pn * 256 + bj * 128 + wc * 32 + 8 * fq; const f32x4 s0 = *(const f32x4*)(cscale + c), s1 = *(const f32x4*)(cscale + c + 4);
#pragma unroll
            for (int ai = 0; ai < 2; ++ai)
#pragma unroll
                for (int m = 0; m < 4; ++m) { const int r = u.pm * 256 + ai * 128 + wr * 64 + m * 16 + fr; st_bf8(O + (size_t)r * ldo + coff + c, acc[ai][bj][m][0] * s0, acc[ai][bj][m][1] * s1); } }
    }
};
struct EpiBf16 {
    static constexpr bool PERM = true;
    bf16* O; int ldo;
    __device__ __forceinline__ void operator()(EPI_ARGS) const {
#pragma unroll
        for (int ai = 0; ai < 2; ++ai)
#pragma unroll
            for (int m = 0; m < 4; ++m) { const int r = u.pm * 256 + ai * 128 + wr * 64 + m * 16 + fr; bf16* rowp = O + (size_t)r * ldo + u.pn * 256 + wc * 32 + 8 * fq;
#pragma unroll
                for (int bj = 0; bj < 2; ++bj) st_bf8(rowp + bj * 128, acc[ai][bj][m][0], acc[ai][bj][m][1]); }
    }
};
struct EpiRes {
    static constexpr bool PERM = false;
    const float* xlat; const float* xctx; float* xout; const float* gate0;
    __device__ __forceinline__ void operator()(EPI_ARGS) const {
        const bool latent = u.pm < TL / 256;
#pragma unroll
        for (int ai = 0; ai < 2; ++ai)
#pragma unroll
            for (int m = 0; m < 4; ++m) { const int r = u.pm * 256 + ai * 128 + wr * 64 + m * 16 + fr; const int ms = latent ? r / SEQ : 2;
                const float* xi = latent ? xlat + (size_t)r * 2048 : xctx + (size_t)(r - TL) * 2048; const float* gp = gate0 + (size_t)ms * 12288;
#pragma unroll
                for (int bj = 0; bj < 2; ++bj)
#pragma unroll
                    for (int n = 0; n < 2; ++n) { const int c = u.pn * 256 + bj * 128 + wc * 32 + 16 * n + 4 * fq;
                        const f32x4 xv = *(const f32x4*)(xi + c), gv = *(const f32x4*)(gp + c); *(f32x4*)(xout + (size_t)r * 2048 + c) = xv + gv * acc[ai][bj][m][n]; } }
    }
};
struct EpiMoeUp {
    static constexpr bool PERM = false;
    bf16* H;
    __device__ __forceinline__ void operator()(EPI_ARGS) const {
#pragma unroll
        for (int ai = 0; ai < 2; ++ai)
#pragma unroll
            for (int m = 0; m < 4; ++m) { const size_t r = (size_t)u.pm * 256 + ai * 128 + wr * 64 + m * 16 + fr;
#pragma unroll
                for (int bj = 0; bj < 2; ++bj) { const int hc = (u.pn * 256 + bj * 128 + wc * 32) / 2 + 4 * fq; const f32x4 a = acc[ai][bj][m][0], b = acc[ai][bj][m][1];
                    const f32x4 h = {siluf_(a.x) * b.x, siluf_(a.y) * b.y, siluf_(a.z) * b.z, siluf_(a.w) * b.w}; st_bf4(H + r * 512 + hc, h); } }
    }
};
struct EpiMoeDown {
    static constexpr bool PERM = true;
    bf16* Y; const int* tokl; const float* gatel; const unsigned* cnt;
    __device__ __forceinline__ void operator()(EPI_ARGS) const {
        const int ce = (int)cnt[u.e];
#pragma unroll
        for (int ai = 0; ai < 2; ++ai)
#pragma unroll
            for (int m = 0; m < 4; ++m) { const int idx = u.idx0 + ai * 128 + wr * 64 + m * 16 + fr;
                if (idx < ce) { const int pair = tokl[(size_t)u.e * LISTCAP + idx]; const float gt = gatel[(size_t)u.e * LISTCAP + idx]; bf16* rowp = Y + (size_t)pair * 2048 + u.pn * 256 + wc * 32 + 8 * fq;
#pragma unroll
                    for (int bj = 0; bj < 2; ++bj) st_bf8(rowp + bj * 128, acc[ai][bj][m][0] * gt, acc[ai][bj][m][1] * gt); } }
    }
};
struct EpiGlu {
    static constexpr bool PERM = true;
    bf16* O; int ldo, coff; const bf16* Gb; const float* bias;
    __device__ __forceinline__ void operator()(EPI_ARGS) const {
#pragma unroll
        for (int ai = 0; ai < 2; ++ai)
#pragma unroll
            for (int m = 0; m < 4; ++m) { const int r = u.pm * 256 + ai * 128 + wr * 64 + m * 16 + fr;
#pragma unroll
                for (int bj = 0; bj < 2; ++bj) { const int c = u.pn * 256 + bj * 128 + wc * 32 + 8 * fq; const f32x4 b0 = *(const f32x4*)(bias + c), b1 = *(const f32x4*)(bias + c + 4); const v4u gw = *(const v4u*)(Gb + (size_t)r * 1024 + c);
                    const f32x4 a0 = acc[ai][bj][m][0] + b0, a1 = acc[ai][bj][m][1] + b1;
                    const f32x4 o0 = {bflo(gw.x) * sigmoidf_(a0.x), bfhi(gw.x) * sigmoidf_(a0.y), bflo(gw.y) * sigmoidf_(a0.z), bfhi(gw.y) * sigmoidf_(a0.w)};
                    const f32x4 o1 = {bflo(gw.z) * sigmoidf_(a1.x), bfhi(gw.z) * sigmoidf_(a1.y), bflo(gw.w) * sigmoidf_(a1.z), bfhi(gw.w) * sigmoidf_(a1.w)};
                    st_bf8(O + (size_t)r * ldo + coff + c, o0, o1); } }
    }
};

struct MoeOrder {
    const LAS int* bstart;
    const unsigned* cnt; const int* tokl; int nN, G, c, nblk; long bstride, eoff; bool up;
    __device__ bool next(int i, pg8::Unit& u) const {
        const long Lx = (long)i * G + c; if (Lx >= (long)nblk * nN) return false;
        const int blk = (int)(Lx / nN); u.pn = (int)(Lx % nN); u.pm = blk;
        const int e = bstart[65 + blk];
        u.e = e; u.idx0 = (blk - bstart[e]) * 256;
        u.aoff = up ? 0 : (long)blk * 256 * 512 * 2;
        u.boff = (long)e * (long)MOE_E_BYTES + eoff + (long)u.pn * bstride;
        return true;
    }
    __device__ int arow(const pg8::Unit& u, int row) const { const int idx = u.idx0 + row; return idx < (int)cnt[u.e] ? (tokl[(size_t)u.e * LISTCAP + idx] >> 1) : TT; }
};

__device__ __forceinline__ void tile_order(int wgid, int nM, int nN, int& pm, int& pn) {
    const int nwg = nM * nN; { const int q = nwg / 8, r = nwg % 8, xcd = wgid % 8, off = wgid / 8; wgid = (xcd < r ? xcd * (q + 1) : r * (q + 1) + (xcd - r) * q) + off; }
    const int nig = 8 * nN, gid = wgid / nig, fm = gid * 8, gsz = (nM - fm) < 8 ? (nM - fm) : 8;
    pm = fm + ((wgid % nig) % gsz); pn = (wgid % nig) / gsz;
}
struct InProj0Order {
    int G, c; long offA1, offB1, offA2, offB2;
    __device__ bool next(int i, pg8::Unit& u) const {
        const int Lx = i * G + c; constexpr int N1 = (TT / 256) * 12, N2 = 4 * (TT / 256); constexpr long TS = 256L * 2048 * 2;
        if (Lx >= N1 + N2) return false;
        u.idx0 = 0;
        if (Lx < N1) { tile_order(Lx, TT / 256, 12, u.pm, u.pn); u.aoff = offA1 + (long)u.pm * TS; u.boff = offB1 + (long)u.pn * TS; u.e = 0; }
        else { tile_order(Lx - N1, 4, TT / 256, u.pm, u.pn); u.aoff = offA2 + (long)u.pm * TS; u.boff = offB2 + (long)u.pn * TS; u.e = 1; }
        return true;
    }
    __device__ int arow(const pg8::Unit&, int) const { return 0; }
};
struct EpiInProj0 {
    static constexpr bool PERM = false;
    EpiQKP e1; EpiVT e2;
    __device__ __forceinline__ void operator()(EPI_ARGS) const { if (u.e == 0) e1(acc, u, wr, wc, fr, fq); else e2(acc, u, wr, wc, fr, fq); }
};

#ifdef ATT_NORARE
#define ATT_RARE(mx) false
#else
#define ATT_RARE(mx) __any(mx > 8.0f)
#endif
__device__ __forceinline__ void attn_phase(Frame& F) {
    const bf16* Q = WSP(bf16, WS_Q); const bf16* Kb = WSP(bf16, WS_K); const bf16* VT = WSP(bf16, WS_VT); bf16* cat = WSP(bf16, WS_CAT);
    LAS unsigned char* lds = F.lds;
    const int lane0 = F.lane;
    float lam;
    { const float* lv = INP(11); float a = lv[lane0] * lv[64 + lane0], b = lv[128 + lane0] * lv[192 + lane0]; a = wave_sum(a); b = wave_sum(b); lam = expf(a) - expf(b) + 0.2f; }
    const float* subg = INP(12);
    const int NU = 1024 + 32;
    const int xcd = F.bid & 7, jcu = F.bid >> 3;
    for (int it = 0;; ++it) {
        int tl_ = F.tid; asm volatile("" : "+v"(tl_));
        const int lane = tl_ & 63, w = __builtin_amdgcn_readfirstlane(tl_ >> 6), sub = w & 1, qw = w >> 1, r32 = lane & 31, hi = lane >> 5;
        int uidx;
        if (F.G == 256) { if (it < 4) uidx = 128 * xcd + it * 32 + jcu; else if (it == 4 && F.bid < 32) uidx = 1024 + F.bid; else break; }
        else { uidx = it * F.G + F.bid; if (uidx >= NU) break; }
        int b, head, q0row, nt; size_t kbase;
        if (uidx < 1024) { const int combo = uidx >> 6, qb = uidx & 63; b = combo >> 3; head = combo & 7; q0row = b * SEQ + qb * 128; nt = KEYS / 64; }
        else { const int v = uidx - 1024; b = v >> 4; head = (v >> 1) & 7; q0row = TL + b * CTX + (v & 1) * 128; nt = CTX / 64; }
        kbase = (size_t)b * KEYS;
        bf16x8 qf[4];
        { const bf16* qp = Q + (size_t)(q0row + qw * 32 + r32) * 1024 + head * 128 + sub * 64 + hi * 8;
#pragma unroll
          for (int ks = 0; ks < 4; ++ks) qf[ks] = *(const bf16x8*)(qp + ks * 16); }
        const char* gsrc[4];
#pragma unroll
        for (int j = 0; j < 4; ++j) { const int pi = w * 4 + j, rr = lane >> 3, pc = lane & 7;
            if (pi < 16) { const int key = (pi & 7) * 8 + rr, c = pc ^ ((key >> 1) & 7); gsrc[j] = (const char*)(Kb + (kbase + key) * 1024 + head * 128 + (pi >> 3) * 64 + c * 8); }
            else { const int dvr = (pi - 16) * 8 + rr, c = pc ^ ((dvr >> 1) & 7); gsrc[j] = (const char*)(VT + ((size_t)(b * 8 + head) * 128 + dvr) * KEYS + c * 8); } }
        const size_t gstep = (w < 4) ? (size_t)65536 * 2 : (size_t)64 * 2;
        const unsigned ldst = (unsigned)w * 4096u;
#define ATT_DMA(t, buf) do { _Pragma("unroll") for (int _j = 0; _j < 4; ++_j) \
            __builtin_amdgcn_global_load_lds((const unsigned*)(gsrc[_j] + (size_t)(t) * gstep), (LAS unsigned*)(lds + (buf) * 32768 + ldst + _j * 1024), 16, 0, 0); } while (0)
        ATT_DMA(0, 0); ATT_DMA(1, 1); ATT_DMA(2, 2);
        asm volatile("s_waitcnt vmcnt(4)" ::: "memory");
        __builtin_amdgcn_s_barrier();
        f32x16 o[4];
#pragma unroll
        for (int d = 0; d < 4; ++d)
#pragma unroll
            for (int r = 0; r < 16; ++r) o[d][r] = 0.f;
        float mref = 0.f, lrow = 0.f;
        f32x16 negm;
#pragma unroll
        for (int r = 0; r < 16; ++r) negm[r] = 0.f;
        const int rdoff = r32 * 128;
        const int swz = (r32 >> 1) & 7;
        f32x16 s0, s1; bf16x8 pf[4];
#define ATT_QK(bufidx) do { const LAS unsigned char* kp_ = lds + (bufidx) * 32768 + sub * 8192; bf16x8 kfa[4], kfb[4]; \
            _Pragma("unroll") for (int ks = 0; ks < 4; ++ks) { const int ch = ((2 * ks + hi) ^ swz) * 16; kfa[ks] = *(const LAS bf16x8*)(kp_ + rdoff + ch); kfb[ks] = *(const LAS bf16x8*)(kp_ + 4096 + rdoff + ch); } \
            s0 = negm; s1 = negm; \
            _Pragma("unroll") for (int ks = 0; ks < 4; ++ks) { s0 = __builtin_amdgcn_mfma_f32_32x32x16_bf16(kfa[ks], qf[ks], s0, 0, 0, 0); s1 = __builtin_amdgcn_mfma_f32_32x32x16_bf16(kfb[ks], qf[ks], s1, 0, 0, 0); } \
            asm volatile("" : "+v"(s0), "+v"(s1) : "v"(kfa[0]), "v"(kfa[1]), "v"(kfa[2]), "v"(kfa[3]), "v"(kfb[0]), "v"(kfb[1]), "v"(kfb[2]), "v"(kfb[3])); } while (0)
#define ATT_MAX(mx) do { float mxa = fmaxf(fmaxf(s0[0], s0[1]), s0[2]), mxb = fmaxf(fmaxf(s1[0], s1[1]), s1[2]); \
            _Pragma("unroll") for (int r = 3; r < 15; r += 2) { mxa = fmaxf(fmaxf(mxa, s0[r]), s0[r + 1]); mxb = fmaxf(fmaxf(mxb, s1[r]), s1[r + 1]); } \
            mx = fmaxf(fmaxf(mxa, mxb), fmaxf(s0[15], s1[15])); mx = fmaxf(mx, __shfl_xor(mx, 32)); } while (0)
#define ATT_FIX(mx) do { const float dl = fmaxf(mx, 0.f); mref += dl; const float alpha = __builtin_amdgcn_exp2f(-dl); lrow *= alpha; \
            _Pragma("unroll") for (int r = 0; r < 16; ++r) { s0[r] -= dl; s1[r] -= dl; negm[r] = -mref; } \
            _Pragma("unroll") for (int d = 0; d < 4; ++d) _Pragma("unroll") for (int r = 0; r < 16; ++r) o[d][r] *= alpha; } while (0)
#define ATT_EXP8(S, base, dst) do { float rs_ = 0.f; _Pragma("unroll") for (int r = 0; r < 8; ++r) { S[base + r] = __builtin_amdgcn_exp2f(S[base + r]); rs_ += S[base + r]; } lrow += rs_; \
            v4u pw_; pw_.x = cvt_pk_bf16(S[base + 0], S[base + 1]); pw_.y = cvt_pk_bf16(S[base + 2], S[base + 3]); pw_.z = cvt_pk_bf16(S[base + 4], S[base + 5]); pw_.w = cvt_pk_bf16(S[base + 6], S[base + 7]); dst = __builtin_bit_cast(bf16x8, pw_); } while (0)
#define ATT_VLD(dstv, vp_, s) do { _Pragma("unroll") for (int d = 0; d < 4; ++d) dstv[d] = *(const LAS bf16x8*)(vp_ + d * 4096 + rdoff + (((2 * (s) + hi) ^ swz) * 16)); } while (0)
#define ATT_PV4(srcv, pfrag) do { _Pragma("unroll") for (int d = 0; d < 4; ++d) o[d] = __builtin_amdgcn_mfma_f32_32x32x16_bf16(srcv[d], pfrag, o[d], 0, 0, 0); } while (0)
        { ATT_QK(0); float mx; ATT_MAX(mx); if (__any(mx > 8.0f)) ATT_FIX(mx);
          ATT_EXP8(s0, 0, pf[0]); ATT_EXP8(s0, 8, pf[1]); ATT_EXP8(s1, 0, pf[2]); ATT_EXP8(s1, 8, pf[3]); }
        int bcur = 0;
#pragma nounroll
        for (int t = 0; t < nt; ++t) {
            const int bn1 = (bcur + 1) & 3, bn3 = (bcur + 3) & 3;
            if (t + 3 < nt) ATT_DMA(t + 3, bn3);
            const LAS unsigned char* vp = lds + bcur * 32768 + 16384;
            bf16x8 vfa[4], vfb[4];
            if (t + 1 < nt) {
                __builtin_amdgcn_sched_barrier(0);
                ATT_QK(bn1);
                float mx; ATT_MAX(mx);
                __builtin_amdgcn_sched_barrier(0);
                if (__any(mx > 8.0f)) {
                    const float dl = fmaxf(mx, 0.f); mref += dl; const float alpha = __builtin_amdgcn_exp2f(-dl); lrow *= alpha;
#pragma unroll
                    for (int r = 0; r < 16; ++r) { s0[r] -= dl; s1[r] -= dl; negm[r] = -mref; }
#pragma unroll
                    for (int d = 0; d < 4; ++d)
#pragma unroll
                        for (int r = 0; r < 16; ++r) o[d][r] *= alpha;
#pragma unroll
                    for (int s = 0; s < 4; ++s) { v4u pw = __builtin_bit_cast(v4u, pf[s]);
                        pw.x = cvt_pk_bf16(bflo(pw.x) * alpha, bfhi(pw.x) * alpha); pw.y = cvt_pk_bf16(bflo(pw.y) * alpha, bfhi(pw.y) * alpha);
                        pw.z = cvt_pk_bf16(bflo(pw.z) * alpha, bfhi(pw.z) * alpha); pw.w = cvt_pk_bf16(bflo(pw.w) * alpha, bfhi(pw.w) * alpha); pf[s] = __builtin_bit_cast(bf16x8, pw); }
                }
                __builtin_amdgcn_sched_barrier(0);
                {
                    ATT_VLD(vfa, vp, 0);
                    __builtin_amdgcn_sched_barrier(0);
                    ATT_VLD(vfb, vp, 1); ATT_PV4(vfa, pf[0]); ATT_EXP8(s0, 0, pf[0]);
                    __builtin_amdgcn_sched_barrier(0);
                    ATT_VLD(vfa, vp, 2); ATT_PV4(vfb, pf[1]); ATT_EXP8(s0, 8, pf[1]);
                    __builtin_amdgcn_sched_barrier(0);
                    ATT_VLD(vfb, vp, 3); ATT_PV4(vfa, pf[2]); ATT_EXP8(s1, 0, pf[2]);
                    __builtin_amdgcn_sched_barrier(0);
                    ATT_PV4(vfb, pf[3]); ATT_EXP8(s1, 8, pf[3]);
                }
                __builtin_amdgcn_sched_barrier(0);
            } else {
#pragma unroll
                for (int s = 0; s < 4; ++s) { ATT_VLD(vfa, vp, s); ATT_PV4(vfa, pf[s]); }
            }
            if (t + 3 < nt) asm volatile("s_waitcnt vmcnt(4) lgkmcnt(0)" ::: "memory"); else asm volatile("s_waitcnt vmcnt(0) lgkmcnt(0)" ::: "memory");
            __builtin_amdgcn_s_barrier();
            bcur = bn1;
        }
#undef ATT_DMA
#undef ATT_QK
#undef ATT_MAX
#undef ATT_FIX
#undef ATT_EXP8
#undef ATT_VLD
#undef ATT_PV4
        const float ltot = lrow + __shfl_xor(lrow, 32); const float linv = 1.0f / ltot;
        LAS float* xch = (LAS float*)lds + (size_t)(qw * 32 + r32) * 132;
        if (sub == 1) {
#pragma unroll
            for (int d = 0; d < 4; ++d)
#pragma unroll
                for (int g = 0; g < 4; ++g) *(LAS f32x4*)(xch + 32 * d + 8 * g + 4 * hi) = (f32x4){o[d][4 * g] * linv, o[d][4 * g + 1] * linv, o[d][4 * g + 2] * linv, o[d][4 * g + 3] * linv};
        }
        __syncthreads();
        if (sub == 0) {
            float ss = 0.f;
#pragma unroll
            for (int d = 0; d < 4; ++d)
#pragma unroll
                for (int g = 0; g < 4; ++g) { const f32x4 o2 = *(const LAS f32x4*)(xch + 32 * d + 8 * g + 4 * hi);
#pragma unroll
                    for (int j = 0; j < 4; ++j) { const float v = o[d][4 * g + j] * linv - lam * o2[j]; o[d][4 * g + j] = v; ss += v * v; } }
            ss += __shfl_xor(ss, 32);
            const float rn = 0.8f / sqrtf(ss * (1.0f / 128.0f) + EPS);
            bf16* op = cat + (size_t)(q0row + qw * 32 + r32) * 2048 + head * 128;
#pragma unroll
            for (int d = 0; d < 4; ++d)
#pragma unroll
                for (int g = 0; g < 4; ++g) { const int dv = 32 * d + 8 * g + 4 * hi; const f32x4 gg = *(const f32x4*)(subg + dv);
                    st_bf4(op + dv, (f32x4){o[d][4 * g] * rn * gg.x, o[d][4 * g + 1] * rn * gg.y, o[d][4 * g + 2] * rn * gg.z, o[d][4 * g + 3] * rn * gg.w}); }
        }
        __syncthreads();
    }
}

__device__ __forceinline__ void poold_phase(Frame& F) {
    const bf16* P = WSP(bf16, WS_P); bf16* PD = WSP(bf16, WS_PD);
    const int gt = F.bid * NTHREADS + F.tid, NGT = F.G * NTHREADS;
    for (int idx = gt; idx < TT * 128; idx += NGT) {
        const int r = idx >> 7, cc = (idx & 127) * 8, g = cc >> 8, wdw = 2 << g;
        int sb, t, Ls; if (r < TL) { sb = (r / SEQ) * SEQ; t = r % SEQ; Ls = SEQ; } else { sb = TL + ((r - TL) / CTX) * CTX; t = (r - TL) % CTX; Ls = CTX; }
        int lo = t - wdw / 2, hi = lo + wdw; lo = lo < 0 ? 0 : lo; hi = hi > Ls ? Ls : hi;
        float a[8];
#pragma unroll
        for (int j = 0; j < 8; ++j) a[j] = 0.f;
        for (int s = lo; s < hi; ++s) { const v4u v = *(const v4u*)(P + (size_t)(sb + s) * 1024 + cc);
            a[0] += bflo(v.x); a[1] += bfhi(v.x); a[2] += bflo(v.y); a[3] += bfhi(v.y); a[4] += bflo(v.z); a[5] += bfhi(v.z); a[6] += bflo(v.w); a[7] += bfhi(v.w); }
        const float inv = 1.0f / (float)(hi - lo);
        const v4u me = *(const v4u*)(P + (size_t)r * 1024 + cc);
        v4u o; o.x = pk2(a[0] * inv - bflo(me.x), a[1] * inv - bfhi(me.x)); o.y = pk2(a[2] * inv - bflo(me.y), a[3] * inv - bfhi(me.y));
        o.z = pk2(a[4] * inv - bflo(me.z), a[5] * inv - bfhi(me.z)); o.w = pk2(a[6] * inv - bflo(me.w), a[7] * inv - bfhi(me.w));
        *(v4u*)(PD + (size_t)r * 1024 + cc) = o;
    }
}

__device__ __forceinline__ void shortconv_phase(Frame& F) {
    const bf16* PJ = WSP(bf16, WS_PROJ1); float* GT = WSP(float, WS_GT);
    const float* cw = INP(17); const float* cb = INP(18);
    LAS float* scr = (LAS float*)(F.lds + F.wave * 17408);
    const int lane = F.lane;
    for (int it = F.gw; it < 2 * 128 * 48; it += F.NGW) {
        const int cbk = it % 48, tb = (it / 48) % 128, b = it / (48 * 128), col = cbk * 64 + lane, t0 = tb * 64;
        const bf16* base = PJ + ((size_t)b * SEQ) * 4096 + cbk * 64 + (lane & 7) * 8;
#pragma unroll
        for (int i = 0; i < 9; ++i) { const int row = 8 * i + (lane >> 3); const int t = t0 - 1 + row;
            if (row < 66) { v4u v = {0u, 0u, 0u, 0u}; if (t >= 0 && t < SEQ) v = *(const v4u*)(base + (size_t)t * 4096);
                LAS float* d = scr + row * 65 + (lane & 7) * 8; d[0] = bflo(v.x); d[1] = bfhi(v.x); d[2] = bflo(v.y); d[3] = bfhi(v.y); d[4] = bflo(v.z); d[5] = bfhi(v.z); d[6] = bflo(v.w); d[7] = bfhi(v.w); } }
        LDS_WAIT(); asm volatile("" ::: "memory");
        const float w0 = cw[col], w1 = cw[3072 + col], w2 = cw[2 * 3072 + col], bias = cb[col];
        float prev = scr[lane], cur = scr[65 + lane];
#pragma unroll 8
        for (int tt = 0; tt < 64; ++tt) { const float nxt = scr[(tt + 2) * 65 + lane]; const float o = prev * w0 + cur * w1 + nxt * w2 + bias; scr[tt * 65 + lane] = o; prev = cur; cur = nxt; }
        LDS_WAIT(); asm volatile("" ::: "memory");
        for (int c = 0; c < 64; ++c) GT[((size_t)(cbk * 64 + c) * 2 + b) * SEQ + t0 + lane] = scr[lane * 65 + c];
        LDS_WAIT(); asm volatile("" ::: "memory");
    }
}

__device__ __forceinline__ void s5_scan_phase(Frame& F) {
    const bf16* PJ = WSP(bf16, WS_PROJ1); float* YD = WSP(float, WS_YD);
    const f32x2* lamb = WSP(f32x2, WS_S5LAM); const f32x2* bbar = WSP(f32x2, WS_S5B);
    const float* cre = INP(31); const float* cim = INP(32);
    const int lane = F.lane;
    for (int task = F.wave * F.G + F.bid; task < 256; task += F.NGW) {
        const int di = task >> 7, b = (task >> 6) & 1, g = task & 63;
        const int dgp = (di * 64 + g) * 64 + lane;
        const f32x2 lam = lamb[dgp];
        float br[16], bi[16], cr[16], ci[16];
#pragma unroll
        for (int c = 0; c < 16; ++c) { const f32x2 bv = bbar[(size_t)dgp * 16 + c]; br[c] = bv.x; bi[c] = bv.y;
            cr[c] = cre[((size_t)(di * 64 + g) * 16 + c) * 64 + lane]; ci[c] = cim[((size_t)(di * 64 + g) * 16 + c) * 64 + lane]; }
        float sr = 0.f, si = 0.f;
        const int nsteps = CTX + SEQ;
        for (int st = 0; st < nsteps; st += 4) {
            const int stl = st + (lane >> 4);
            int row;
            if (stl < CTX) row = TL + b * CTX + (di == 0 ? stl : CTX - 1 - stl);
            else row = b * SEQ + (di == 0 ? stl - CTX : SEQ - 1 - (stl - CTX));
            const float uval = bf2f(PJ[(size_t)row * 4096 + 3072 + g * 16 + (lane & 15)]);
#pragma unroll
            for (int k = 0; k < 4; ++k) {
                float bur = 0.f, bui = 0.f;
#pragma unroll
                for (int c = 0; c < 16; ++c) { const float u = __builtin_bit_cast(float, __builtin_amdgcn_readlane(__builtin_bit_cast(int, uval), 16 * k + c)); bur += br[c] * u; bui += bi[c] * u; }
                const float nr = lam.x * sr - lam.y * si + bur, ni = lam.x * si + lam.y * sr + bui; sr = nr; si = ni;
                const int s2 = st + k;
                if (s2 >= CTX) {
                    const int t = (di == 0) ? s2 - CTX : SEQ - 1 - (s2 - CTX);
                    float outv = 0.f;
#pragma unroll
                    for (int c = 0; c < 16; ++c) { float v = cr[c] * sr - ci[c] * si; v = wave_sum(v); if (lane == c) outv = v; }
                    if (lane < 16) YD[((size_t)di * TL + (size_t)b * SEQ + t) * 1024 + g * 16 + lane] = outv;
                }
            }
        }
    }
}

__device__ __forceinline__ void hyena_naive_phase(Frame& F) {
    const float* GT = WSP(float, WS_GT); const float* kT = WSP(float, WS_KT); const float* invn = WSP(float, WS_INVN); bf16* cat = WSP(bf16, WS_CAT);
    const float* hyb = INP(25);
    LAS float* kf = (LAS float*)F.lds;
    LAS f32x2* ub = (LAS f32x2*)(F.lds + 65536);
    const int tid = F.tid;
    for (int ch = F.bid; ch < 1024; ch += F.G) {
        float res0[16], res1[16];
        for (int o = 0; o < 2; ++o) {
            const float inv = invn[o * 1024 + ch];
            const float* kfw = kT + (size_t)(o * 2048 + ch) * SEQ; const float* kbw = kT + (size_t)(o * 2048 + 1024 + ch) * SEQ;
            for (int n = tid; n < 16384; n += NTHREADS) { float v; if (n < SEQ) v = kfw[n]; else if (n == SEQ) v = 0.f; else v = kbw[16384 - n]; kf[n] = v * inv; }
            if (o == 0) { const float* v0 = GT + ((size_t)(0 * 1024 + ch) * 2) * SEQ; for (int n = tid; n < SEQ; n += NTHREADS) ub[n] = (f32x2){v0[n], v0[SEQ + n]}; }
            else {
#pragma unroll
                for (int j = 0; j < 16; ++j) ub[tid + NTHREADS * j] = (f32x2){res0[j], res1[j]}; }
            __syncthreads();
            float a0[16], a1[16];
#pragma unroll
            for (int j = 0; j < 16; ++j) { a0[j] = 0.f; a1[j] = 0.f; }
            for (int s = 0; s < SEQ; ++s) { const f32x2 u = ub[s];
#pragma unroll
                for (int j = 0; j < 16; ++j) { const float kk = kf[(tid + NTHREADS * j - s) & 16383]; a0[j] += u.x * kk; a1[j] += u.y * kk; } }
            const float bias = hyb[o * 1024 + ch];
            const float* xg = GT + ((size_t)((o + 1) * 1024 + ch) * 2) * SEQ;
#pragma unroll
            for (int j = 0; j < 16; ++j) { const int t = tid + NTHREADS * j; const f32x2 u = ub[t];
                res0[j] = xg[t] * (a0[j] + bias * u.x); res1[j] = xg[SEQ + t] * (a1[j] + bias * u.y); }
            __syncthreads();
        }
#pragma unroll
        for (int j = 0; j < 16; ++j) { const int t = tid + NTHREADS * j;
            cat[(size_t)t * 2048 + ch] = (bf16)f2bf(res0[j]); cat[((size_t)SEQ + t) * 2048 + ch] = (bf16)f2bf(res1[j]); }
    }
}

__device__ __forceinline__ void s5_gelu_phase(Frame& F) {
    const bf16* PJ = WSP(bf16, WS_PROJ1); const float* YD = WSP(float, WS_YD); bf16* Gb = WSP(bf16, WS_PD); const float* dd = INP(33);
    const int gt = F.bid * NTHREADS + F.tid, NGT = F.G * NTHREADS;
    for (int idx = gt; idx < TL * 256; idx += NGT) { const int r = idx >> 8, c = (idx & 255) * 4;
        const v2u uw = *(const v2u*)(PJ + (size_t)r * 4096 + 3072 + c); const f32x4 d4 = *(const f32x4*)(dd + c);
        const int bb = r / SEQ, tt = r % SEQ, gg = c >> 4, cc = c & 15;
        const f32x4 y0 = *(const f32x4*)(YD + (((size_t)(0 * 2 + bb) * 64 + gg) * SEQ + tt) * 16 + cc), y1 = *(const f32x4*)(YD + (((size_t)(1 * 2 + bb) * 64 + gg) * SEQ + tt) * 16 + cc);
        const f32x4 y = {bflo(uw.x) * d4.x + y0.x + y1.x, bfhi(uw.x) * d4.y + y0.y + y1.y, bflo(uw.y) * d4.z + y0.z + y1.z, bfhi(uw.y) * d4.w + y0.w + y1.w};
        st_bf4(Gb + (size_t)r * 1024 + c, (f32x4){gelu_tanh(y.x), gelu_tanh(y.y), gelu_tanh(y.z), gelu_tanh(y.w)}); }
}

__device__ __forceinline__ f32x2 cmulf(f32x2 a, f32x2 b) { return (f32x2){a.x * b.x - a.y * b.y, a.x * b.y + a.y * b.x}; }
__device__ __forceinline__ int drev14(int p) { const unsigned r = __builtin_bitreverse32((unsigned)p) >> 18; return (int)(((r & 0x2AAAu) >> 1) | ((r & 0x1555u) << 1)); }
template <int L, bool ZHI>
__device__ __forceinline__ void fft_fwd_pass(LAS f32x2* X, const f32x2* tw, int tid) {
    constexpr int tws = 4096 / L;
    if constexpr (L == 1) {
#pragma unroll 2
        for (int i = 0; i < 8; ++i) { const int i0 = (tid + NTHREADS * i) * 4;
            const f32x4 p01 = *(const LAS f32x4*)(X + i0), p23 = *(const LAS f32x4*)(X + i0 + 2);
            const f32x2 x0 = {p01.x, p01.y}, x1 = {p01.z, p01.w}, x2 = {p23.x, p23.y}, x3 = {p23.z, p23.w};
            const f32x2 a = x0 + x2, bb = x0 - x2, c = x1 + x3, d = x1 - x3;
            const f32x2 y0 = a + c, y1 = {bb.x + d.y, bb.y - d.x}, y2 = a - c, y3 = {bb.x - d.y, bb.y + d.x};
            *(LAS f32x4*)(X + i0) = (f32x4){y0.x, y0.y, y1.x, y1.y}; *(LAS f32x4*)(X + i0 + 2) = (f32x4){y2.x, y2.y, y3.x, y3.y}; }
        __syncthreads();
        return;
    }
#pragma unroll 2
    for (int i = 0; i < 8; ++i) {
        const int b = tid + NTHREADS * i, j = b & (L - 1), i0 = (b - j) * 4 + j;
        const f32x2 w1 = tw[j * tws], w2 = cmulf(w1, w1), w3 = cmulf(w2, w1);
        const f32x2 x0 = X[i0], x1 = X[i0 + L];
        if (ZHI) {
            const f32x2 t1 = {x0.x + x1.y, x0.y - x1.x}, t3 = {x0.x - x1.y, x0.y + x1.x};
            X[i0] = x0 + x1; X[i0 + L] = cmulf(t1, w1); X[i0 + 2 * L] = cmulf(x0 - x1, w2); X[i0 + 3 * L] = cmulf(t3, w3);
        } else {
            const f32x2 x2 = X[i0 + 2 * L], x3 = X[i0 + 3 * L];
            const f32x2 a = x0 + x2, bb = x0 - x2, c = x1 + x3, d = x1 - x3;
            const f32x2 t1 = {bb.x + d.y, bb.y - d.x}, t3 = {bb.x - d.y, bb.y + d.x};
            X[i0] = a + c; X[i0 + L] = cmulf(t1, w1); X[i0 + 2 * L] = cmulf(a - c, w2); X[i0 + 3 * L] = cmulf(t3, w3);
        }
    }
    __syncthreads();
}
template <bool ZHI>
__device__ __forceinline__ void fft_fwd(LAS f32x2* X, const f32x2* tw, int tid) {
    fft_fwd_pass<4096, ZHI>(X, tw, tid); fft_fwd_pass<1024, false>(X, tw, tid); fft_fwd_pass<256, false>(X, tw, tid); fft_fwd_pass<64, false>(X, tw, tid);
    fft_fwd_pass<16, false>(X, tw, tid); fft_fwd_pass<4, false>(X, tw, tid); fft_fwd_pass<1, false>(X, tw, tid);
}
template <int L, bool LOHALF>
__device__ __forceinline__ void fft_inv_pass(LAS f32x2* X, const f32x2* tw, int tid) {
    constexpr int tws = 4096 / L;
    if constexpr (L == 1) {
#pragma unroll 2
        for (int i = 0; i < 8; ++i) { const int i0 = (tid + NTHREADS * i) * 4;
            const f32x4 p01 = *(const LAS f32x4*)(X + i0), p23 = *(const LAS f32x4*)(X + i0 + 2);
            const f32x2 x0 = {p01.x, p01.y}, x1 = {p01.z, p01.w}, x2 = {p23.x, p23.y}, x3 = {p23.z, p23.w};
            const f32x2 a = x0 + x2, bb = x0 - x2, c = x1 + x3, d = x1 - x3;
            const f32x2 y0 = a + c, y1 = {bb.x - d.y, bb.y + d.x}, y2 = a - c, y3 = {bb.x + d.y, bb.y - d.x};
            *(LAS f32x4*)(X + i0) = (f32x4){y0.x, y0.y, y1.x, y1.y}; *(LAS f32x4*)(X + i0 + 2) = (f32x4){y2.x, y2.y, y3.x, y3.y}; }
        __syncthreads();
        return;
    }
#pragma unroll 2
    for (int i = 0; i < 8; ++i) {
        const int b = tid + NTHREADS * i, j = b & (L - 1), i0 = (b - j) * 4 + j;
        f32x2 w1 = tw[j * tws]; w1.y = -w1.y; const f32x2 w2 = cmulf(w1, w1), w3 = cmulf(w2, w1);
        const f32x2 x0 = X[i0], x1 = cmulf(X[i0 + L], w1), x2 = cmulf(X[i0 + 2 * L], w2), x3 = cmulf(X[i0 + 3 * L], w3);
        const f32x2 a = x0 + x2, bb = x0 - x2, c = x1 + x3, d = x1 - x3;
        X[i0] = a + c; X[i0 + L] = (f32x2){bb.x - d.y, bb.y + d.x};
        if (!LOHALF) { X[i0 + 2 * L] = a - c; X[i0 + 3 * L] = (f32x2){bb.x + d.y, bb.y - d.x}; }
    }
    __syncthreads();
}
__device__ __forceinline__ void fft_inv(LAS f32x2* X, const f32x2* tw, int tid) {
    fft_inv_pass<1, false>(X, tw, tid); fft_inv_pass<4, false>(X, tw, tid); fft_inv_pass<16, false>(X, tw, tid); fft_inv_pass<64, false>(X, tw, tid);
    fft_inv_pass<256, false>(X, tw, tid); fft_inv_pass<1024, false>(X, tw, tid); fft_inv_pass<4096, true>(X, tw, tid);
}
__device__ __forceinline__ void fft_pointwise(LAS f32x2* X, const f32x2* Wg, int o, float scale, int tid) {
    const float hs = 0.5f * scale;
#pragma unroll 4
    for (int i = 0; i < 32; ++i) {
        const int p = tid + NTHREADS * i, f = drev14(p), pm = drev14((16384 - f) & 16383);
        const unsigned long long ua = __hip_atomic_load((const unsigned long long*)(Wg + p), __ATOMIC_RELAXED, __HIP_MEMORY_SCOPE_AGENT);
        const unsigned long long ub = __hip_atomic_load((const unsigned long long*)(Wg + pm), __ATOMIC_RELAXED, __HIP_MEMORY_SCOPE_AGENT);
        const f32x2 A = __builtin_bit_cast(f32x2, ua), B = __builtin_bit_cast(f32x2, ub);
        f32x2 K;
        if (o == 0) K = (f32x2){(A.x + B.x) * hs, (A.y - B.y) * hs};
        else { const f32x2 dd = {A.x - B.x, A.y + B.y}; K = (f32x2){dd.y * hs, -dd.x * hs}; }
        X[p] = cmulf(X[p], K);
    }
    __syncthreads();
}
__device__ __forceinline__ void hyena_fft_phase(Frame& F) {
    float* GT = WSP(float, WS_GT); const float* kT = WSP(float, WS_KT); const float* invn = WSP(float, WS_INVN); const f32x2* tw = WSP(f32x2, WS_TW);
    f32x2* Wg = WSP(f32x2, WS_FFTW) + (size_t)F.bid * 16384;
    const float* hyb = INP(25);
    LAS f32x2* X = (LAS f32x2*)F.lds;
    const int tid = F.tid;
    for (int ch = F.bid; ch < 1024; ch += F.G) {
        { const float* f0 = kT + (size_t)ch * SEQ; const float* b0 = kT + (size_t)(1024 + ch) * SEQ; const float* f1 = kT + (size_t)(2048 + ch) * SEQ; const float* b1 = kT + (size_t)(3072 + ch) * SEQ;
          for (int n = tid; n < SEQ; n += NTHREADS) { X[n] = (f32x2){f0[n], f1[n]}; X[SEQ + n] = (n == 0) ? (f32x2){0.f, 0.f} : (f32x2){b0[SEQ - n], b1[SEQ - n]}; } }
        __syncthreads();
        fft_fwd<false>(X, tw, tid);
        for (int n = tid; n < 16384; n += NTHREADS) Wg[n] = X[n];
        __syncthreads();
        const float* v0 = GT + ((size_t)ch * 2) * SEQ; float* yo = WSP(float, WS_YHT) + ((size_t)ch * 2) * SEQ;
        const float* x1 = GT + ((size_t)(1024 + ch) * 2) * SEQ; const float* x2 = GT + ((size_t)(2048 + ch) * 2) * SEQ;
        float z0[16], z1[16];
#pragma unroll
        for (int j = 0; j < 16; ++j) { const int n = tid + NTHREADS * j; z0[j] = v0[n]; z1[j] = v0[SEQ + n]; }
#pragma unroll
        for (int o = 0; o < 2; ++o) {
#pragma unroll
            for (int j = 0; j < 16; ++j) { const int n = tid + NTHREADS * j; X[n] = (f32x2){z0[j], z1[j]}; }
            __syncthreads();
            fft_fwd<true>(X, tw, tid);
            fft_pointwise(X, Wg, o, invn[o * 1024 + ch] * (1.0f / 16384.0f), tid);
            fft_inv(X, tw, tid);
            const float bias = hyb[o * 1024 + ch]; const float* xg = (o == 0) ? x1 : x2;
#pragma unroll
            for (int j = 0; j < 16; ++j) { const int n = tid + NTHREADS * j; const f32x2 y = X[n]; z0[j] = xg[n] * (y.x + bias * z0[j]); z1[j] = xg[SEQ + n] * (y.y + bias * z1[j]); }
            __syncthreads();
        }
#pragma unroll
        for (int j = 0; j < 16; ++j) { const int n = tid + NTHREADS * j; yo[n] = z0[j]; yo[SEQ + n] = z1[j]; }
    }
}
__device__ __forceinline__ void hyena_out_transpose(Frame& F) {
    const float* GT = WSP(float, WS_YHT); bf16* cat = WSP(bf16, WS_CAT);
    LAS float* scr = (LAS float*)(F.lds + F.wave * 17408);
    const int lane = F.lane;
    for (int it = F.gw; it < 2 * 128 * 16; it += F.NGW) {
        const int cbk = it & 15, tb = (it >> 4) & 127, b = it >> 11, t0 = tb * 64;
        for (int c = 0; c < 64; ++c) scr[c * 65 + lane] = GT[((size_t)(cbk * 64 + c) * 2 + b) * SEQ + t0 + lane];
        LDS_WAIT(); asm volatile("" ::: "memory");
#pragma unroll
        for (int i = 0; i < 8; ++i) { const int tt = 8 * i + (lane >> 3), c0 = (lane & 7) * 8; const LAS float* s = scr + c0 * 65 + tt;
            v4u o; o.x = cvt_pk_bf16(s[0], s[65]); o.y = cvt_pk_bf16(s[130], s[195]); o.z = cvt_pk_bf16(s[260], s[325]); o.w = cvt_pk_bf16(s[390], s[455]);
            *(v4u*)(cat + ((size_t)b * SEQ + t0 + tt) * 2048 + cbk * 64 + c0) = o; }
        LDS_WAIT(); asm volatile("" ::: "memory");
    }
}

__device__ __forceinline__ int s5_row(int di, int b, int s) {
    return (s < CTX) ? TL + b * CTX + (di == 0 ? s : CTX - 1 - s) : b * SEQ + (di == 0 ? s - CTX : SEQ - 1 - (s - CTX));
}
template <bool OUTPUT>
__device__ __forceinline__ void s5_seg_phase(Frame& F) {
    const bf16* PJ = WSP(bf16, WS_PROJ1); float* YD = WSP(float, WS_YD);
    const f32x2* lamb = WSP(f32x2, WS_S5LAM); const f32x2* bbar = WSP(f32x2, WS_S5B); const f32x2* l256 = WSP(f32x2, WS_S5L256); f32x2* Eb = WSP(f32x2, WS_S5E);
    const float* cre = INP(31); const float* cim = INP(32);
    const int lane = F.lane;
    for (int task = F.wave * F.G + F.bid; task < 256 * 32; task += F.NGW) {
        const int dbg = task >> 5, seg = (task & 31) + (OUTPUT ? 1 : 0);
        const int di = dbg >> 7, b = (dbg >> 6) & 1, g = dbg & 63;
        const int dgp = (di * 64 + g) * 64 + lane;
        const f32x2 lam = lamb[dgp];
        float br[16], bi[16];
#pragma unroll
        for (int c = 0; c < 16; ++c) { const f32x2 bv = bbar[(size_t)dgp * 16 + c]; br[c] = bv.x; bi[c] = bv.y; }
        float cr[16], ci[16];
        if (OUTPUT) {
#pragma unroll
            for (int c = 0; c < 16; ++c) { cr[c] = cre[((size_t)(di * 64 + g) * 16 + c) * 64 + lane]; ci[c] = cim[((size_t)(di * 64 + g) * 16 + c) * 64 + lane]; }
        }
        float sr = 0.f, si = 0.f;
        if (OUTPUT) {
            const f32x2 l2 = l256[dgp]; const f32x2* ep = Eb + ((size_t)dbg * 32) * 64 + lane;
            for (int k = 0; k < seg; ++k) { const f32x2 e = ep[(size_t)k * 64]; const float nr = l2.x * sr - l2.y * si + e.x, ni = l2.x * si + l2.y * sr + e.y; sr = nr; si = ni; }
        }
        const int s0 = seg * 256;
#pragma nounroll
        for (int st = 0; st < 256; st += 4) {
            const int row = s5_row(di, b, s0 + st + (lane >> 4));
            const float uval = bf2f(PJ[(size_t)row * 4096 + 3072 + g * 16 + (lane & 15)]);
#pragma unroll
            for (int k = 0; k < 4; ++k) {
                float bur = 0.f, bui = 0.f;
#pragma unroll
                for (int c = 0; c < 16; ++c) { const float u = __builtin_bit_cast(float, __builtin_amdgcn_readlane(__builtin_bit_cast(int, uval), 16 * k + c)); bur += br[c] * u; bui += bi[c] * u; }
                const float nr = lam.x * sr - lam.y * si + bur, ni = lam.x * si + lam.y * sr + bui; sr = nr; si = ni;
                if (OUTPUT) {
                    float v8[8], v4[4], v2[2], v1;
                    const bool b5 = (lane & 32) != 0, b4 = (lane & 16) != 0, b3 = (lane & 8) != 0, b2 = (lane & 4) != 0;
#pragma unroll
                    for (int i = 0; i < 8; ++i) { const float lo = cr[i] * sr - ci[i] * si, hi = cr[i + 8] * sr - ci[i + 8] * si; const float keep = b5 ? hi : lo, send = b5 ? lo : hi; v8[i] = keep + __shfl_xor(send, 32); }
#pragma unroll
                    for (int i = 0; i < 4; ++i) { const float keep = b4 ? v8[i + 4] : v8[i], send = b4 ? v8[i] : v8[i + 4]; v4[i] = keep + __shfl_xor(send, 16); }
#pragma unroll
                    for (int i = 0; i < 2; ++i) { const float keep = b3 ? v4[i + 2] : v4[i], send = b3 ? v4[i] : v4[i + 2]; v2[i] = keep + __shfl_xor(send, 8); }
                    { const float keep = b2 ? v2[1] : v2[0], send = b2 ? v2[0] : v2[1]; v1 = keep + __shfl_xor(send, 4); }
                    v1 += __shfl_xor(v1, 2); v1 += __shfl_xor(v1, 1);
                    const int s = s0 + st + k, t = (di == 0) ? s - CTX : SEQ - 1 - (s - CTX);
                    if ((lane & 3) == 0) YD[((size_t)di * TL + (size_t)b * SEQ + t) * 1024 + g * 16 + (lane >> 2)] = v1;
                }
            }
        }
        if (!OUTPUT) Eb[((size_t)dbg * 32 + seg) * 64 + lane] = (f32x2){sr, si};
    }
}

typedef float f32x4_t __attribute__((ext_vector_type(4)));
template <bool OUTPUT>
__device__ __forceinline__ void s5_mfma_phase(Frame& F) {
    const bf16* PJ = WSP(bf16, WS_PROJ1); float* YD = WSP(float, WS_YD);
    const f32x2* lamb = WSP(f32x2, WS_S5LAM); const f32x2* bbar = WSP(f32x2, WS_S5B); const f32x2* l256 = WSP(f32x2, WS_S5L256); f32x2* Eb = WSP(f32x2, WS_S5E);
    const float* cre = INP(31); const float* cim = INP(32);
    const int lane = F.lane, fr = lane & 15, fq = lane >> 4;
    LAS unsigned* Xl = (LAS unsigned*)(F.lds + F.wave * 4608);
    for (int task = F.wave * F.G + F.bid; task < 256 * 32; task += F.NGW) {
        const int dbg = task >> 5, seg = (task & 31) + (OUTPUT ? 1 : 0);
        const int di = dbg >> 7, b = (dbg >> 6) & 1, g = dbg & 63;
        const int dg = di * 64 + g;
        f32x2 l1[4], l2[4], l3[4], l4[4];
        bf16x8 bfr[8];
#pragma unroll
        for (int t = 0; t < 4; ++t) { const int dgp = dg * 64 + 16 * t + fr; l1[t] = lamb[dgp]; l2[t] = cmulf(l1[t], l1[t]); l3[t] = cmulf(l2[t], l1[t]); l4[t] = cmulf(l2[t], l2[t]);
            v4u wre = {0u, 0u, 0u, 0u}, wim = {0u, 0u, 0u, 0u};
            if (fq < 2) { const f32x4* bp = (const f32x4*)(bbar + (size_t)dgp * 16 + 8 * fq); const f32x4 q0 = bp[0], q1 = bp[1], q2 = bp[2], q3 = bp[3];
                wre.x = cvt_pk_bf16(q0.x, q0.z); wre.y = cvt_pk_bf16(q1.x, q1.z); wre.z = cvt_pk_bf16(q2.x, q2.z); wre.w = cvt_pk_bf16(q3.x, q3.z);
                wim.x = cvt_pk_bf16(q0.y, q0.w); wim.y = cvt_pk_bf16(q1.y, q1.w); wim.z = cvt_pk_bf16(q2.y, q2.w); wim.w = cvt_pk_bf16(q3.y, q3.w); }
            bfr[t] = __builtin_bit_cast(bf16x8, wre); bfr[4 + t] = __builtin_bit_cast(bf16x8, wim); }
        bf16x8 cfr[4];
        if (OUTPUT) {
#pragma unroll
            for (int ks = 0; ks < 4; ++ks) { const size_t cb = ((size_t)dg * 16 + fr) * 64 + 16 * ks + 4 * fq; const f32x4 r4 = *(const f32x4*)(cre + cb), i4 = *(const f32x4*)(cim + cb);
                v4u w; w.x = cvt_pk_bf16(r4.x, -i4.x); w.y = cvt_pk_bf16(r4.y, -i4.y); w.z = cvt_pk_bf16(r4.z, -i4.z); w.w = cvt_pk_bf16(r4.w, -i4.w); cfr[ks] = __builtin_bit_cast(bf16x8, w); }
        }
        f32x2 st[4];
#pragma unroll
        for (int t = 0; t < 4; ++t) st[t] = (f32x2){0.f, 0.f};
        if (OUTPUT) {
#pragma unroll
            for (int t = 0; t < 4; ++t) { const f32x2 lq = l256[dg * 64 + 16 * t + fr]; const f32x2* ep = Eb + ((size_t)dbg * 32) * 64 + 16 * t + fr;
                for (int k = 0; k < seg; ++k) { const f32x2 e = ep[(size_t)k * 64]; st[t] = cmulf(lq, st[t]) + e; } }
        }
        const int s0 = seg * 256;
        v4u unext = {0u, 0u, 0u, 0u};
        if (fq < 2) unext = *(const v4u*)(PJ + (size_t)s5_row(di, b, s0 + fr) * 4096 + 3072 + g * 16 + 8 * fq);
#pragma nounroll
        for (int blk = 0; blk < 16; ++blk) {
            const bf16x8 ufr = __builtin_bit_cast(bf16x8, unext);
            if (blk + 1 < 16 && fq < 2) unext = *(const v4u*)(PJ + (size_t)s5_row(di, b, s0 + 16 * (blk + 1) + fr) * 4096 + 3072 + g * 16 + 8 * fq);
            f32x4 bu[8];
#pragma unroll
            for (int nt = 0; nt < 8; ++nt) bu[nt] = __builtin_amdgcn_mfma_f32_16x16x32_bf16(ufr, bfr[nt], (f32x4){0.f, 0.f, 0.f, 0.f}, 0, 0, 0);
            f32x2 xs[4][4];
#pragma unroll
            for (int t = 0; t < 4; ++t) {
                f32x2 x0 = {bu[t][0], bu[4 + t][0]}, x1 = cmulf(l1[t], x0) + (f32x2){bu[t][1], bu[4 + t][1]}, x2 = cmulf(l1[t], x1) + (f32x2){bu[t][2], bu[4 + t][2]}, x3 = cmulf(l1[t], x2) + (f32x2){bu[t][3], bu[4 + t][3]};
                f32x2 sin = st[t];
                f32x2 fin = x3 + cmulf(l4[t], (fq == 0) ? sin : (f32x2){0.f, 0.f});
#pragma unroll
                for (int rd = 1; rd < 4; ++rd) { const float vr = __shfl(fin.x, lane - 16), vi = __shfl(fin.y, lane - 16);
                    if (fq == rd) { sin = (f32x2){vr, vi}; fin = x3 + cmulf(l4[t], sin); } }
                xs[t][0] = x0 + cmulf(l1[t], sin); xs[t][1] = x1 + cmulf(l2[t], sin); xs[t][2] = x2 + cmulf(l3[t], sin); xs[t][3] = x3 + cmulf(l4[t], sin);
                st[t] = (f32x2){__shfl(xs[t][3].x, 48 + fr), __shfl(xs[t][3].y, 48 + fr)};
            }
            if (OUTPUT) {
#pragma unroll
                for (int t = 0; t < 4; ++t)
#pragma unroll
                    for (int r = 0; r < 4; ++r) Xl[(4 * fq + r) * 68 + 16 * t + fr] = cvt_pk_bf16(xs[t][r].x, xs[t][r].y);
                LDS_WAIT(); asm volatile("" ::: "memory");
                f32x4 y = {0.f, 0.f, 0.f, 0.f};
#pragma unroll
                for (int ks = 0; ks < 4; ++ks) { const bf16x8 xa = *(const LAS bf16x8*)(Xl + fr * 68 + 16 * ks + 4 * fq); y = __builtin_amdgcn_mfma_f32_16x16x32_bf16(xa, cfr[ks], y, 0, 0, 0); }
                LDS_WAIT(); asm volatile("" ::: "memory");
#pragma unroll
                for (int r = 0; r < 4; ++r) { const int s = s0 + 16 * blk + 4 * fq + r, tl = (di == 0) ? s - CTX : SEQ - 1 - (s - CTX);
                    YD[((size_t)di * TL + (size_t)b * SEQ + tl) * 1024 + g * 16 + fr] = y[r]; }
            }
        }
        if (!OUTPUT) { if (fq == 0) {
#pragma unroll
            for (int t = 0; t < 4; ++t) Eb[((size_t)dbg * 32 + seg) * 64 + 16 * t + fr] = st[t]; } }
    }
}

#ifndef S5C_EOFF
#define S5C_EOFF 0
#endif
#define S5_KEEP8(acc, f) asm volatile("" : "+v"(acc) : "v"(f[0]), "v"(f[1]), "v"(f[2]), "v"(f[3]), "v"(f[4]), "v"(f[5]), "v"(f[6]), "v"(f[7]))
#define S5_KEEP4(acc, f) asm volatile("" : "+v"(acc) : "v"(f[0]), "v"(f[1]), "v"(f[2]), "v"(f[3]))
template <bool OUTPUT, int S5C_RUN = 0>
__device__ __forceinline__ void s5_chunk_phase(Frame& F) {
    const bf16* PJ = WSP(bf16, WS_PROJ1); float* YD = WSP(float, WS_YD);
    const f32x2* l16t = WSP(f32x2, WS_S5L16); const f32x2* l256 = WSP(f32x2, WS_S5L256); f32x2* Eb = WSP(f32x2, WS_S5E);
    const bf16* W1 = WSP(bf16, WS_S5W1); const bf16* W3 = WSP(bf16, WS_S5W3); const bf16* KT = WSP(bf16, WS_S5KT);
    const int lane = F.lane, fr = lane & 15, fq = lane >> 4;
    LAS unsigned* Xl = (LAS unsigned*)(F.lds + F.wave * 4608);
    f32x2 carry[4];
#pragma unroll
    for (int t = 0; t < 4; ++t) carry[t] = (f32x2){0.f, 0.f};
#pragma nounroll
    for (int j = 0;; ++j) {
        const int tq = F.wave * F.G + F.bid + (j >> 2) * F.NGW, sub4 = j & 3;
        if (tq >= 256 * 8) break;
        const int task = tq * 4 + sub4;
        const int dbg = task >> 5, seg = (task & 31) + (OUTPUT ? 1 : 0);
        const int di = dbg >> 7, b = (dbg >> 6) & 1, g = dbg & 63;
        const int dg = di * 64 + g;
        const int s0 = seg * 256;
        bf16x8 afr[8];
#pragma unroll
        for (int ks = 0; ks < 8; ++ks) afr[ks] = *(const bf16x8*)(PJ + (size_t)s5_row(di, b, s0 + 16 * fr + 2 * ks + (fq >> 1)) * 4096 + 3072 + g * 16 + 8 * (fq & 1));
        f32x4 ea[8];
        { const bf16* w1p = W1 + ((size_t)dg * 128 + fr) * 256 + 8 * fq;
#pragma unroll
          for (int nt = 0; nt < 8; ++nt) { f32x4 a = {0.f, 0.f, 0.f, 0.f}; bf16x8 bw[8];
#pragma unroll
              for (int ks = 0; ks < 8; ++ks) bw[ks] = *(const bf16x8*)(w1p + (size_t)nt * 16 * 256 + 32 * ks);
#pragma unroll
              for (int ks = 0; ks < 8; ++ks) a = __builtin_amdgcn_mfma_f32_16x16x32_bf16(afr[ks], bw[ks], a, 0, 0, 0);
              S5_KEEP8(a, bw); S5_KEEP8(a, afr);
              ea[nt] = a; } }
        f32x2 st[4];
#pragma unroll
        for (int t = 0; t < 4; ++t) st[t] = (f32x2){0.f, 0.f};
        if (OUTPUT) {
#pragma unroll
            for (int t = 0; t < 4; ++t) { const f32x2 lq = l256[dg * 64 + 16 * t + fr]; const f32x2* ep = Eb + ((size_t)dbg * 32) * 64 + 16 * t + fr;
                if (sub4 == 0) {
                    int k = 0;
                    for (; k + 8 <= seg; k += 8) { f32x2 e8[8];
#pragma unroll
                        for (int j = 0; j < 8; ++j) e8[j] = ep[(size_t)(k + j) * 64];
#pragma unroll
                        for (int j = 0; j < 8; ++j) st[t] = cmulf(lq, st[t]) + e8[j]; }
                    for (; k < seg; ++k) st[t] = cmulf(lq, st[t]) + ep[(size_t)k * 64];
                } else st[t] = cmulf(lq, carry[t]) + ep[(size_t)(seg - 1) * 64];
                carry[t] = st[t]; }
        }
#pragma unroll
        for (int t = 0; t < 4; ++t) {
            const f32x2 L1 = l16t[dg * 64 + 16 * t + fr], L2 = cmulf(L1, L1), L3 = cmulf(L2, L1), L4 = cmulf(L2, L2);
            const f32x2 x0 = {ea[t][0], ea[4 + t][0]}, x1 = cmulf(L1, x0) + (f32x2){ea[t][1], ea[4 + t][1]}, x2 = cmulf(L1, x1) + (f32x2){ea[t][2], ea[4 + t][2]}, x3 = cmulf(L1, x2) + (f32x2){ea[t][3], ea[4 + t][3]};
            f32x2 sin = st[t];
            f32x2 fin = x3 + cmulf(L4, (fq == 0) ? sin : (f32x2){0.f, 0.f});
#pragma unroll
            for (int rd = 1; rd < 4; ++rd) { const float vr = __shfl(fin.x, lane - 16), vi = __shfl(fin.y, lane - 16);
                if (fq == rd) { sin = (f32x2){vr, vi}; fin = x3 + cmulf(L4, sin); } }
            if (OUTPUT) {
                const f32x2 h1 = x0 + cmulf(L1, sin), h2 = x1 + cmulf(L2, sin), h3 = x2 + cmulf(L3, sin);
                Xl[(4 * fq + 0) * 68 + 16 * t + fr] = cvt_pk_bf16(sin.x, sin.y); Xl[(4 * fq + 1) * 68 + 16 * t + fr] = cvt_pk_bf16(h1.x, h1.y);
                Xl[(4 * fq + 2) * 68 + 16 * t + fr] = cvt_pk_bf16(h2.x, h2.y); Xl[(4 * fq + 3) * 68 + 16 * t + fr] = cvt_pk_bf16(h3.x, h3.y);
#if S5C_EOFF == 2
                { const f32x2 L8 = cmulf(L4, L4), L12 = cmulf(L8, L4); const f32x2 wgt = (fq == 3) ? (f32x2){1.f, 0.f} : (fq == 2) ? L4 : (fq == 1) ? L8 : L12;
                  f32x2 xe = cmulf(wgt, x3); xe.x += __shfl_xor(xe.x, 16); xe.y += __shfl_xor(xe.y, 16); xe.x += __shfl_xor(xe.x, 32); xe.y += __shfl_xor(xe.y, 32);
                  if (fq == 0 && seg < 32) WSP(f32x2, WS_Y)[((size_t)dbg * 32 + seg) * 64 + 16 * t + fr] = xe; }
#endif
            } else {
                st[t] = (f32x2){__shfl(fin.x, 48 + fr), __shfl(fin.y, 48 + fr)};
            }
        }
        if (!OUTPUT) {
            if (fq == 0) {
#pragma unroll
                for (int t = 0; t < 4; ++t) (S5C_EOFF == 1 ? WSP(f32x2, WS_Y) : (S5C_EOFF == 3 ? WSP(f32x2, WS_Y) + S5C_RUN * (1u << 20) : Eb))[((size_t)dbg * 32 + seg) * 64 + 16 * t + fr] = st[t];
            }
        } else {
            LDS_WAIT(); asm volatile("" ::: "memory");
            bf16x8 hfr[4];
#pragma unroll
            for (int ks = 0; ks < 4; ++ks) hfr[ks] = *(const LAS bf16x8*)(Xl + fr * 68 + 16 * ks + 4 * fq);
#ifdef S5_ZERO_CARRY
#pragma unroll
            for (int ks = 0; ks < 4; ++ks) hfr[ks] = (bf16x8){0,0,0,0,0,0,0,0};
#endif
            LDS_WAIT(); asm volatile("" ::: "memory");
            const bf16* w3p = W3 + ((size_t)dg * 256 + fr) * 128 + 8 * fq;
            const bf16* ktp = KT + (size_t)dg * 17 * 256 + fr * 16 + 8 * (fq & 1);
#pragma unroll
            for (int tau = 0; tau < 16; ++tau) {
                f32x4 y = {0.f, 0.f, 0.f, 0.f}; bf16x8 b3[4], bk[8];
#pragma unroll
                for (int ks = 0; ks < 4; ++ks) b3[ks] = *(const bf16x8*)(w3p + (size_t)tau * 16 * 128 + 32 * ks);
#pragma unroll
                for (int ks = 0; ks < 8; ++ks) { const int d1 = (ks <= tau / 2) ? tau - 2 * ks - (fq >> 1) + 1 : 0;
                    bk[ks] = *(const bf16x8*)(ktp + (size_t)d1 * 256); }
#pragma unroll
                for (int ks = 0; ks < 4; ++ks) y = __builtin_amdgcn_mfma_f32_16x16x32_bf16(hfr[ks], b3[ks], y, 0, 0, 0);
#pragma unroll
                for (int ks = 0; ks <= tau / 2; ++ks) y = __builtin_amdgcn_mfma_f32_16x16x32_bf16(afr[ks], bk[ks], y, 0, 0, 0);
                S5_KEEP4(y, b3); S5_KEEP8(y, bk); S5_KEEP8(y, afr); S5_KEEP4(y, hfr);
#pragma unroll
                for (int r = 0; r < 4; ++r) { const int s = s0 + 16 * (4 * fq + r) + tau, tl = (di == 0) ? s - CTX : SEQ - 1 - (s - CTX);
                    YD[(((size_t)(di * 2 + b) * 64 + g) * SEQ + tl) * 16 + fr] = y[r]; }
            }
        }
    }
}

#if S5C_EOFF
__device__ __forceinline__ void s5_check_phase(Frame& F) {
    const f32x2* Ea = (S5C_EOFF == 3) ? WSP(f32x2, WS_Y) + (1u << 20) : WSP(f32x2, WS_S5E); const f32x2* Ebn = WSP(f32x2, WS_Y); unsigned* flag = WSP(unsigned, WS_CTL) + 9000;
    const int gt = F.bid * NTHREADS + F.tid, NGT = F.G * NTHREADS;
    for (int idx = gt; idx < 256 * 32 * 64; idx += NGT) { const f32x2 a = Ea[idx], b = Ebn[idx];
        const float d = fabsf(a.x - b.x) + fabsf(a.y - b.y), m = fabsf(a.x) + fabsf(a.y) + fabsf(b.x) + fabsf(b.y);
        if (S5C_FILTER(idx) && !(d <= S5C_TOL * m + 1e-4f)) atomicAdd(flag, 1u); }
}
#endif

constexpr int NPHASES = 21;
#ifndef MK_SINGLE
#define MK_SINGLE 1
#endif

__device__ __forceinline__ unsigned long long launder_u64(unsigned long long v) {
    unsigned lo = (unsigned)v, hi = (unsigned)(v >> 32);
    asm volatile("" : "+v"(lo), "+v"(hi));
    lo = __builtin_amdgcn_readfirstlane(lo); hi = __builtin_amdgcn_readfirstlane(hi);
    return ((unsigned long long)hi << 32) | lo;
}
__device__ __forceinline__ const void* launder_ptr(const void* p) {
    unsigned long long v = (unsigned long long)p; unsigned lo = (unsigned)v, hi = (unsigned)(v >> 32);
    asm volatile("" : "+v"(lo), "+v"(hi));
    lo = __builtin_amdgcn_readfirstlane(lo); hi = __builtin_amdgcn_readfirstlane(hi);
    return (const void*)(((unsigned long long)hi << 32) | lo);
}
__device__ __forceinline__ void moe_blocks(Frame& F, int l, LAS int* bstart) {
    __syncthreads();
    if (F.tid == 0) { const unsigned* cnt = WSP(unsigned, WS_CTL) + CW_CNT + l * 64; int acc = 0;
        for (int e = 0; e < 64; ++e) { bstart[e] = acc; const int nb = ((int)cnt[e] + 255) >> 8; for (int j = 0; j < nb; ++j) bstart[65 + acc + j] = e; acc += nb; } bstart[64] = acc; }
    __syncthreads();
}

template <int PHSEL>
__global__ void __launch_bounds__(NTHREADS, 2) mk_fwd(Args args) {
    extern __shared__ __attribute__((aligned(16))) unsigned char lds_raw[];
    Frame F;
    F.lds = (LAS unsigned char*)lds_raw; F.ws = args.ws; F.kin = (const __attribute__((address_space(4))) unsigned long long*)__builtin_amdgcn_kernarg_segment_ptr();
    F.tid = threadIdx.x; F.lane = F.tid & 63; F.wave = __builtin_amdgcn_readfirstlane(F.tid >> 6); F.bid = blockIdx.x; F.G = gridDim.x;
    F.gw = F.bid * NWAVES + F.wave; F.NGW = F.G * NWAVES;
    volatile LAS unsigned* lctl = (volatile LAS unsigned*)(F.lds + LDS_CTL);
    LAS int* bstart = (LAS int*)(F.lds + LDS_CTL + 64);
    if (F.tid < 4) lctl[F.tid] = 0u;
    __syncthreads();
    const int lo = args.ph_lo, hi = args.ph_hi;
    XcdBarrier bar; bar.bar = WSP(unsigned, WS_CTL) + CW_BAR; bar.x = 0; bar.st = lctl;
    if (PHSEL < 0) bar = xcd_barrier_post(WSP(unsigned, WS_CTL) + CW_BAR, lctl);
#ifndef PH_MASK
#define PH_MASK 0xffffffffu
#endif
#define IN(k) (((PH_MASK >> (k)) & 1u) && (PHSEL < 0 || PHSEL == (k)))
#define INL(j) (((PH_MASK >> (6 + (j))) & 1u) && (PHSEL < 0 || (PHSEL == 6 + (j) && lo == pb + (j))))
#define PH_END(k) do { if (PHSEL < 0) xcd_barrier(bar); } while (0)
#ifndef PH_REPEAT
#define PH_REPEAT 0u
#endif
#define REP(k) for (int _rep = 0; _rep < (((PH_REPEAT >> (k)) & 1u) ? 2 : 1); ++_rep)
#define DUP(k) (((PH_REPEAT >> (k)) & 1u) != 0u)
#define PH_BEGIN() do { F.ws = (unsigned char*)launder_ptr((const void*)F.ws); F.kin = (const __attribute__((address_space(4))) unsigned long long*)launder_u64((unsigned long long)F.kin); \
    { int _t = threadIdx.x; asm volatile("" : "+v"(_t)); F.tid = _t; F.lane = _t & 63; F.wave = __builtin_amdgcn_readfirstlane(_t >> 6); \
      int _b = blockIdx.x; asm volatile("" : "+v"(_b)); F.bid = __builtin_amdgcn_readfirstlane(_b); F.gw = F.bid * NWAVES + F.wave; } } while (0)
    LAS unsigned char* lds = F.lds;
    const int G = F.G, bid = F.bid;
    constexpr long T2048 = 256L * 2048 * 2;

    if (IN(0)) { PH_BEGIN(); REP(0) { p0_prologue(F); __syncthreads(); } PH_END(0); }
    if (IN(1)) { PH_BEGIN(); p1_reduce(F); PH_END(1); }
#ifdef EXTRA_BARS
    xcd_barrier(bar); xcd_barrier(bar); xcd_barrier(bar); xcd_barrier(bar); xcd_barrier(bar); xcd_barrier(bar); xcd_barrier(bar); xcd_barrier(bar); xcd_barrier(bar); xcd_barrier(bar);
#endif
        if (IN(2)) { PH_BEGIN(); REP(2) norm_phase<0>(F, 0, nullptr); PH_END(2); }
        if (IN(3)) { PH_BEGIN();
#define BODY3 { pg8::Gemm g{(const bf16*)F.ws, (const bf16*)F.ws, 2048, 2048, 2048}; InProj0Order S; S.G = G; S.c = bid; \
              S.offA1 = (long)WS_HA; S.offB1 = (long)WS_WIN0; S.offA2 = (long)(WS_WIN0 + (size_t)3072 * 2048 * 2); S.offB2 = (long)WS_HA; \
              EpiInProj0 E{EpiQKP{WSP(bf16, WS_Q), WSP(bf16, WS_K), WSP(bf16, WS_P), WSP(f32x2, WS_ROPE)}, EpiVT{WSP(bf16, WS_VT)}}; pg8::gemm_phase<EpiInProj0, InProj0Order, false>(lds, g, S, E); }
            BODY3
            if constexpr (DUP(3)) { BODY3 }
#undef BODY3
            PH_END(3);
        }
        if (IN(4)) { PH_BEGIN(); REP(4) attn_phase(F); REP(21) poold_phase(F); PH_END(4); }
        if (IN(5)) { PH_BEGIN();
            pg8::Gemm g{WSP(bf16, WS_PD), WSP(bf16, WS_WPOOL), 1024, 256, 256}; pg8::StaticOrder S; S.init(TT / 256, 4, G, bid, 256L * 1024 * 2, 256L * 2, 256L * 256 * 2);
            EpiScaleBf16 E{WSP(bf16, WS_CAT), 2048, 1024, INP(14)}; pg8::gemm_phase<EpiScaleBf16, pg8::StaticOrder, false>(lds, g, S, E);
            PH_END(5);
        }
    {
    constexpr int pb = 6; constexpr int l = 0;
    if (INL(0)) { PH_BEGIN();
        float* xbuf = WSP(float, WS_X);
        pg8::Gemm g{WSP(bf16, WS_CAT), WSP(bf16, l == 0 ? WS_WOUT0 : WS_WOUT1), 2048, 2048, 2048}; pg8::StaticOrder S; S.init(l == 0 ? TT / 256 : TL / 256, 8, G, bid, T2048, 0, T2048);
        EpiRes E{l == 0 ? INP(0) : xbuf, l == 0 ? INP(2) : xbuf + (size_t)TL * 2048, xbuf, modp(F, l, 0, 2)}; pg8::gemm_phase<EpiRes, pg8::StaticOrder, false>(lds, g, S, E);
        PH_END(pb);
    }
    if (INL(1)) { PH_BEGIN(); ffn_norm_router_phase(F, l); PH_END(pb + 1); }
    if (INL(2)) { PH_BEGIN(); REP(8) {
        moe_blocks(F, l, bstart);
        pg8::Gemm g{WSP(bf16, WS_HA), (const bf16*)(F.ws + WS_WMOE + (size_t)l * MOE_L_BYTES), 2048, 2048, 2048};
        MoeOrder S{bstart, WSP(unsigned, WS_CTL) + CW_CNT + l * 64, WSP(int, WS_TOKL), 4, G, bid, bstart[64], T2048, 0, true};
        EpiMoeUp E{WSP(bf16, WS_H)}; pg8::gemm_phase<EpiMoeUp, MoeOrder, true>(lds, g, S, E); }
        PH_END(pb + 2);
    }
    if (INL(3)) { PH_BEGIN(); REP(9) {
        moe_blocks(F, l, bstart);
        pg8::Gemm g{WSP(bf16, WS_H), (const bf16*)(F.ws + WS_WMOE + (size_t)l * MOE_L_BYTES), 512, 512, 512};
        MoeOrder S{bstart, WSP(unsigned, WS_CTL) + CW_CNT + l * 64, WSP(int, WS_TOKL), 8, G, bid, bstart[64], 256L * 512 * 2, (long)(4 * MiB), false};
        EpiMoeDown E{WSP(bf16, WS_Y), WSP(int, WS_TOKL), WSP(float, WS_GATEL), WSP(unsigned, WS_CTL) + CW_CNT + l * 64}; pg8::gemm_phase<EpiMoeDown, MoeOrder, false>(lds, g, S, E); }
        PH_END(pb + 3);
    }
    }
        if (IN(10)) { PH_BEGIN(); norm_phase<2>(F, 1, nullptr); PH_END(10); }
        if (IN(11)) { PH_BEGIN();
#define BODY11             pg8::Gemm g{WSP(bf16, WS_HA), WSP(bf16, WS_WIN1), 2048, 2048, 2048}; pg8::StaticOrder S; S.init(TT / 256, 16, G, bid, T2048, 0, T2048); \
            EpiBf16 E{WSP(bf16, WS_PROJ1), 4096}; pg8::gemm_phase<EpiBf16, pg8::StaticOrder, false>(lds, g, S, E);
            BODY11
            if constexpr (DUP(11)) { BODY11 }
#undef BODY11
            PH_END(11);
        }
        if (IN(12)) { PH_BEGIN(); REP(12) shortconv_phase(F); REP(22) s5_chunk_phase<false>(F);
#if S5C_EOFF == 1
            s5_chunk_phase<false>(F);
#endif
#if S5C_EOFF == 3
            s5_chunk_phase<false, 0>(F); s5_chunk_phase<false, 1>(F);
#endif
 PH_END(12); }
        if (IN(13)) { PH_BEGIN();
#if S5C_EOFF == 1 || S5C_EOFF == 3
            s5_check_phase(F);
#endif
            REP(23) s5_chunk_phase<true>(F); __syncthreads(); REP(13) hyena_fft_phase(F); PH_END(13); }
        if (IN(14)) { PH_BEGIN();
#if S5C_EOFF == 2
            s5_check_phase(F);
#endif
 REP(14) { s5_gelu_phase(F); hyena_out_transpose(F); } PH_END(14); }
        if (IN(15)) { PH_BEGIN();
            pg8::Gemm g{WSP(bf16, WS_PD), WSP(bf16, WS_WGLU), 1024, 1024, 1024}; pg8::StaticOrder S; S.init(TL / 256, 4, G, bid, 256L * 1024 * 2, 0, 256L * 1024 * 2);
            EpiGlu E{WSP(bf16, WS_CAT), 2048, 1024, WSP(bf16, WS_PD), INP(35)}; pg8::gemm_phase<EpiGlu, pg8::StaticOrder, false>(lds, g, S, E);
            PH_END(15);
        }
    {
    constexpr int pb = 16; constexpr int l = 1;
    if (INL(0)) { PH_BEGIN();
        float* xbuf = WSP(float, WS_X);
        pg8::Gemm g{WSP(bf16, WS_CAT), WSP(bf16, l == 0 ? WS_WOUT0 : WS_WOUT1), 2048, 2048, 2048}; pg8::StaticOrder S; S.init(l == 0 ? TT / 256 : TL / 256, 8, G, bid, T2048, 0, T2048);
        EpiRes E{l == 0 ? INP(0) : xbuf, l == 0 ? INP(2) : xbuf + (size_t)TL * 2048, xbuf, modp(F, l, 0, 2)}; pg8::gemm_phase<EpiRes, pg8::StaticOrder, false>(lds, g, S, E);
        PH_END(pb);
    }
    if (INL(1)) { PH_BEGIN(); ffn_norm_router_phase(F, l); PH_END(pb + 1); }
    if (INL(2)) { PH_BEGIN(); REP(8) {
        moe_blocks(F, l, bstart);
        pg8::Gemm g{WSP(bf16, WS_HA), (const bf16*)(F.ws + WS_WMOE + (size_t)l * MOE_L_BYTES), 2048, 2048, 2048};
        MoeOrder S{bstart, WSP(unsigned, WS_CTL) + CW_CNT + l * 64, WSP(int, WS_TOKL), 4, G, bid, bstart[64], T2048, 0, true};
        EpiMoeUp E{WSP(bf16, WS_H)}; pg8::gemm_phase<EpiMoeUp, MoeOrder, true>(lds, g, S, E); }
        PH_END(pb + 2);
    }
    if (INL(3)) { PH_BEGIN(); REP(9) {
        moe_blocks(F, l, bstart);
        pg8::Gemm g{WSP(bf16, WS_H), (const bf16*)(F.ws + WS_WMOE + (size_t)l * MOE_L_BYTES), 512, 512, 512};
        MoeOrder S{bstart, WSP(unsigned, WS_CTL) + CW_CNT + l * 64, WSP(int, WS_TOKL), 8, G, bid, bstart[64], 256L * 512 * 2, (long)(4 * MiB), false};
        EpiMoeDown E{WSP(bf16, WS_Y), WSP(int, WS_TOKL), WSP(float, WS_GATEL), WSP(unsigned, WS_CTL) + CW_CNT + l * 64}; pg8::gemm_phase<EpiMoeDown, MoeOrder, false>(lds, g, S, E); }
        PH_END(pb + 3);
    }
    }
    if (IN(20)) { PH_BEGIN(); norm_phase<3>(F, 1, args.out);
#if S5C_EOFF
        if (WSP(unsigned, WS_CTL)[9000] != 0u) { for (int i = F.bid * NTHREADS + F.tid; i < TL * 2048; i += F.G * NTHREADS) args.out[i] = __builtin_nanf(""); }
#endif
    }
#undef IN
#undef INL
#undef PH_END
}

typedef void (*kern_t)(Args);
template <int P> static void launch_phase(int grid, hipStream_t stream, Args a) { hipLaunchKernelGGL(mk_fwd<P>, dim3(grid), dim3(NTHREADS), LDS_BYTES, stream, a); }
template <int P> static bool prep_phase() { return hipFuncSetAttribute((const void*)mk_fwd<P>, hipFuncAttributeMaxDynamicSharedMemorySize, LDS_BYTES) == hipSuccess; }
extern "C" void kernel_launch(void* const* d_in, const int* in_sizes, int n_in, void* d_out, int out_size, void* d_ws, size_t ws_size, hipStream_t stream) {
    static int grid = 0;
    if (grid == 0) {
        if (n_in != 43 || out_size != TL * DM || ws_size < WS_END) { fprintf(stderr, "kernel_launch: unexpected shapes (n_in %d, out %d, ws %zu < %zu)\n", n_in, out_size, ws_size, (size_t)WS_END); grid = -1; return; }
        int dev = 0, cus = 0;
        if (hipGetDevice(&dev) != hipSuccess || hipDeviceGetAttribute(&cus, hipDeviceAttributeMultiprocessorCount, dev) != hipSuccess) { grid = -1; return; }
        bool ok = true;
#if MK_SINGLE
        ok = prep_phase<-1>();
#else
        ok = prep_phase<0>() && prep_phase<1>() && prep_phase<2>() && prep_phase<3>() && prep_phase<4>() && prep_phase<5>() && prep_phase<6>() && prep_phase<7>() && prep_phase<8>() && prep_phase<9>() &&
             prep_phase<10>() && prep_phase<11>() && prep_phase<12>() && prep_phase<13>() && prep_phase<14>() && prep_phase<15>() && prep_phase<20>();
#endif
        if (!ok) { fprintf(stderr, "kernel_launch: hipFuncSetAttribute failed\n"); grid = -1; return; }
        (void)hipGetLastError();
        grid = cus;
    }
    if (grid < 0) return;
    (void)hipMemsetAsync((char*)d_ws + WS_CTL, 0, CTL_BYTES, stream);
    Args a{};
    for (int i = 0; i < 43; ++i) a.in[i] = (const float*)d_in[i];
    a.out = (float*)d_out; a.ws = (unsigned char*)d_ws;
#if MK_SINGLE
    a.ph_lo = 0; a.ph_hi = NPHASES;
    launch_phase<-1>(grid, stream, a);
#else
#define LP(k, P) a.ph_lo = (k); a.ph_hi = (k) + 1; launch_phase<P>(grid, stream, a);
    LP(0, 0) LP(1, 1) LP(2, 2) LP(3, 3) LP(4, 4) LP(5, 5) LP(6, 6) LP(7, 7) LP(8, 8) LP(9, 9) LP(10, 10) LP(11, 11) LP(12, 12) LP(13, 13) LP(14, 14) LP(15, 15)
    LP(16, 6) LP(17, 7) LP(18, 8) LP(19, 9) LP(20, 20)
#undef LP
#endif
}
```

```cpp
#include <hip/hip_runtime.h>
#include <cstdio>
#include <cstdint>
#include <cmath>

#define GAS __attribute__((address_space(1)))
#define LAS __attribute__((address_space(3)))
typedef unsigned short bf16;
typedef unsigned v4u __attribute__((ext_vector_type(4)));
typedef unsigned v2u __attribute__((ext_vector_type(2)));
typedef float f32x4 __attribute__((ext_vector_type(4)));
typedef float f32x2 __attribute__((ext_vector_type(2)));
typedef float f32x16 __attribute__((ext_vector_type(16)));
typedef short bf16x8 __attribute__((ext_vector_type(8)));
#define LDS_WAIT() asm volatile("s_waitcnt lgkmcnt(0)" ::: "memory")
#define VM_WAIT() asm volatile("s_waitcnt vmcnt(0)" ::: "memory")

__device__ __forceinline__ unsigned f2bf(float f) { unsigned u = __builtin_bit_cast(unsigned, f); return (u + 0x7fffu + ((u >> 16) & 1u)) >> 16; }
__device__ __forceinline__ unsigned pk2(float lo, float hi) { return f2bf(lo) | (f2bf(hi) << 16); }
__device__ __forceinline__ unsigned cvt_pk_bf16(float lo, float hi) { unsigned r; asm volatile("v_cvt_pk_bf16_f32 %0, %1, %2" : "=v"(r) : "v"(lo), "v"(hi)); return r; }
__device__ __forceinline__ float bf2f(unsigned short b) { return __builtin_bit_cast(float, (unsigned)b << 16); }
__device__ __forceinline__ float bflo(unsigned w) { return __builtin_bit_cast(float, w << 16); }
__device__ __forceinline__ float bfhi(unsigned w) { return __builtin_bit_cast(float, w & 0xffff0000u); }
__device__ __forceinline__ float wave_sum(float v) {
#pragma unroll
    for (int o = 1; o < 64; o <<= 1) v += __shfl_xor(v, o);
    return v;
}

namespace pg8 {
typedef unsigned short bf16_t;
constexpr int BM = 256, BK = 64, HALF = 128, HTB = HALF * BK * 2, STAGE_BYTES = 8 * HTB;

__host__ __device__ __forceinline__ int lds_byte(int r, int c) { const int st = (r >> 4) * 2 + (c >> 5), rr = r & 15, cc = c & 31, ob = rr * 64 + cc * 2; return st * 1024 + (ob ^ (((ob >> 9) & 1) << 5)); }
__host__ __device__ __forceinline__ int perm32(int rho) { const int n = rho >> 4, i = rho & 15; return 8 * (i >> 2) + 4 * n + (i & 3); }
__host__ __device__ __forceinline__ void stage_rc(int b, int& R, int& C) { const int st = b / 1024, sb = b % 1024, swz = sb ^ (((sb >> 9) & 1) << 5); R = (st >> 1) * 16 + swz / 64; C = (st & 1) * 32 + (swz % 64) / 2; }

struct Unit { int pm, pn; long aoff, boff; int e, idx0; };
struct Gemm { const bf16_t* A; const bf16_t* Bt; int lda, ldb, K; };

template <class Epi, class Sched, bool GATHER>
__device__ __forceinline__ void gemm_phase(LAS unsigned char* lds, const Gemm g, const Sched& S, const Epi& E) {
    int tid_ = threadIdx.x; asm volatile("" : "+v"(tid_));
    const int tid = tid_, wid = __builtin_amdgcn_readfirstlane(tid >> 6), lane = tid & 63, wr = wid >> 2, wc = wid & 3, fr = lane & 15, fq = lane >> 4;
    const int K = g.K, nt = K / BK;
    unsigned voffA[2], voffB[2];
#pragma unroll
    for (int i = 0; i < 2; ++i) { int R, C; stage_rc(tid * 16 + i * 8192, R, C);
        const int Rb = Epi::PERM ? ((R & ~31) + perm32(R & 31)) : R;
        voffA[i] = (unsigned)(R * g.lda + C) * 2u; voffB[i] = (unsigned)(Rb * g.ldb + C) * 2u; }
    const size_t kstep = (size_t)(BK * 2);
    const size_t hstepA = GATHER ? 0 : (size_t)HALF * g.lda * 2, hstepB = (size_t)HALF * g.ldb * 2;
    const unsigned ldsw = (unsigned)wid * 1024u;
    const int aoff = lds_byte(wr * 64 + fr, fq * 8), boff = lds_byte(wc * 32 + fr, fq * 8);
#define PG8_SA(b, h) (((b) * 2 + (h)) * HTB)
#define PG8_SB(b, h) ((4 + (b) * 2 + (h)) * HTB)
#define PG8_STAGE(bufoff, gbase, voff) do { _Pragma("unroll") for (int _i = 0; _i < 2; ++_i) \
        __builtin_amdgcn_global_load_lds((const unsigned*)((const char*)(gbase) + (voff)[_i]), (LAS unsigned*)(lds + (bufoff) + ldsw + _i * 8192), 16, 0, 0); } while (0)
#define PG8_STAGE_A(bufoff, gbase, h, nx) do { if constexpr (GATHER) { unsigned _tv[2]; \
        if (nx) { int _tz = tid; asm volatile("" : "+v"(_tz)); _Pragma("unroll") for (int _j = 0; _j < 2; ++_j) { int _R, _C; stage_rc(_tz * 16 + _j * 8192, _R, _C); _tv[_j] = (unsigned)S.arow(nxt, (h) * HALF + _R) * (unsigned)(g.lda * 2) + (unsigned)(_C * 2); } } \
        else { _tv[0] = gvc[h][0]; _tv[1] = gvc[h][1]; } \
        PG8_STAGE(bufoff, gbase, _tv); } else { PG8_STAGE(bufoff, (gbase) + (h) * hstepA, voffA); } } while (0)
#define PG8_LDA(dst, b, h) do { _Pragma("unroll") for (int m = 0; m < 4; ++m) _Pragma("unroll") for (int k = 0; k < 2; ++k) dst[m][k] = *(const LAS bf16x8*)(lds + PG8_SA(b, h) + aoff + m * 2048 + k * 1024); } while (0)
#define PG8_LDB(dst, b, h) do { _Pragma("unroll") for (int n = 0; n < 2; ++n) _Pragma("unroll") for (int k = 0; k < 2; ++k) dst[n][k] = *(const LAS bf16x8*)(lds + PG8_SB(b, h) + boff + n * 2048 + k * 1024); } while (0)
#define PG8_MMA(ai, bj, At, Bt) do { __builtin_amdgcn_s_setprio(1); _Pragma("unroll") for (int m = 0; m < 4; ++m) _Pragma("unroll") for (int n = 0; n < 2; ++n) _Pragma("unroll") for (int k = 0; k < 2; ++k) \
        acc[ai][bj][m][n] = __builtin_amdgcn_mfma_f32_16x16x32_bf16(Bt[n][k], At[m][k], acc[ai][bj][m][n], 0, 0, 0); __builtin_amdgcn_s_setprio(0); } while (0)
#define PG8_WAIT_V(n) asm volatile("s_waitcnt vmcnt(" #n ")" ::: "memory")
#define PG8_WAIT_L(n) asm volatile("s_waitcnt lgkmcnt(" #n ")" ::: "memory")
#define PG8_BAR __builtin_amdgcn_s_barrier()
#define PG8_SCHED __builtin_amdgcn_sched_barrier(0)
    Unit cur, nxt; int ui = 0;
    if (!S.next(0, cur)) return;
    unsigned gvc[2][2];
#define PG8_GV(unit) do { if constexpr (GATHER) { int _tz = tid; asm volatile("" : "+v"(_tz)); _Pragma("unroll") for (int _h = 0; _h < 2; ++_h) _Pragma("unroll") for (int _j = 0; _j < 2; ++_j) { int _R, _C; stage_rc(_tz * 16 + _j * 8192, _R, _C); \
        gvc[_h][_j] = (unsigned)S.arow(unit, _h * HALF + _R) * (unsigned)(g.lda * 2) + (unsigned)(_C * 2); } } } while (0)
    PG8_GV(cur);
    f32x4 acc[2][2][4][2];
#pragma unroll
    for (int a = 0; a < 2; ++a)
#pragma unroll
        for (int b = 0; b < 2; ++b)
#pragma unroll
            for (int m = 0; m < 4; ++m)
#pragma unroll
                for (int n = 0; n < 2; ++n) acc[a][b][m][n] = (f32x4){0.f, 0.f, 0.f, 0.f};
    bf16x8 At[4][2], B0[2][2], B1[2][2];
    const char* cA = (const char*)g.A + cur.aoff; const char* cB = (const char*)g.Bt + cur.boff;
    PG8_STAGE(PG8_SB(0, 0), cB, voffB); PG8_STAGE(PG8_SB(0, 1), cB + hstepB, voffB); PG8_STAGE_A(PG8_SA(0, 0), cA, 0, false); PG8_STAGE_A(PG8_SA(0, 1), cA, 1, false);
    if (wr == 1) PG8_BAR;
    PG8_WAIT_V(2); PG8_BAR;
    PG8_STAGE(PG8_SB(1, 0), cB + kstep, voffB); PG8_STAGE_A(PG8_SA(1, 0), cA + kstep, 0, false); PG8_STAGE(PG8_SB(1, 1), cB + hstepB + kstep, voffB);
    PG8_WAIT_V(6); PG8_BAR;
    for (;;) {
        const bool has_next = S.next(ui + 1, nxt);
        const char* nA = has_next ? (const char*)g.A + nxt.aoff : cA; const char* nB = has_next ? (const char*)g.Bt + nxt.boff : cB;
#pragma nounroll
        for (int t = 0; t < nt; t += 2) {
            const bool last = (t == nt - 2);
            const char* a1 = cA + (size_t)(t + 1) * kstep;
            const char* a2 = last ? nA : cA + (size_t)(t + 2) * kstep; const char* b2 = last ? nB : cB + (size_t)(t + 2) * kstep;
            const char* a3 = a2 + kstep; const char* b3 = b2 + kstep;
            PG8_LDB(B0, 0, 0); PG8_LDB(B1, 0, 1); PG8_SCHED; PG8_LDA(At, 0, 0); PG8_STAGE_A(PG8_SA(1, 1), a1, 1, false);
            PG8_WAIT_V(8); PG8_WAIT_L(0); PG8_BAR; PG8_MMA(0, 0, At, B0); PG8_MMA(0, 1, At, B1); PG8_BAR; PG8_SCHED;
            PG8_LDA(At, 0, 1); PG8_STAGE(PG8_SB(0, 0), b2, voffB); PG8_STAGE(PG8_SB(0, 1), b2 + hstepB, voffB); PG8_STAGE_A(PG8_SA(0, 0), a2, 0, last);
            PG8_WAIT_V(8); PG8_WAIT_L(0); PG8_BAR; PG8_MMA(1, 0, At, B0); PG8_MMA(1, 1, At, B1); PG8_BAR; PG8_SCHED;
            PG8_LDB(B0, 1, 0); PG8_LDB(B1, 1, 1); PG8_SCHED; PG8_LDA(At, 1, 0); PG8_STAGE_A(PG8_SA(0, 1), a2, 1, last);
            PG8_WAIT_V(8); PG8_WAIT_L(0); PG8_BAR; PG8_MMA(0, 0, At, B0); PG8_MMA(0, 1, At, B1); PG8_BAR; PG8_SCHED;
            PG8_LDA(At, 1, 1); PG8_STAGE(PG8_SB(1, 0), b3, voffB); PG8_STAGE(PG8_SB(1, 1), b3 + hstepB, voffB); PG8_STAGE_A(PG8_SA(1, 0), a3, 0, last);
            PG8_WAIT_V(8); PG8_WAIT_L(0); PG8_BAR; PG8_MMA(1, 0, At, B0); PG8_MMA(1, 1, At, B1); PG8_BAR; PG8_SCHED;
        }
        if (wr == 0) PG8_BAR;
        E(acc, cur, wr, wc, fr, fq);
        if (!has_next) break;
#pragma unroll
        for (int a = 0; a < 2; ++a)
#pragma unroll
            for (int b = 0; b < 2; ++b)
#pragma unroll
                for (int m = 0; m < 4; ++m)
#pragma unroll
                    for (int n = 0; n < 2; ++n) acc[a][b][m][n] = (f32x4){0.f, 0.f, 0.f, 0.f};
        cur = nxt; cA = nA; cB = nB; ++ui;
        PG8_GV(cur);
        if (wr == 1) PG8_BAR;
    }
    PG8_WAIT_V(0);
    PG8_BAR;
#undef PG8_SA
#undef PG8_SB
#undef PG8_STAGE
#undef PG8_STAGE_A
#undef PG8_GV
#undef PG8_LDA
#undef PG8_LDB
#undef PG8_MMA
#undef PG8_WAIT_V
#undef PG8_WAIT_L
#undef PG8_BAR
#undef PG8_SCHED
}

struct StaticOrder {
    int nM, nN, nwg, G, c; long astride, apn, bstride;
    __device__ void init(int nM_, int nN_, int G_, int c_, long astride_, long apn_, long bstride_) { nM = nM_; nN = nN_; nwg = nM * nN; G = G_; c = c_; astride = astride_; apn = apn_; bstride = bstride_; }
    __device__ bool next(int i, Unit& u) const {
        const long Lx = (long)i * G + c; if (Lx >= nwg) return false;
        int wgid = (int)Lx; { const int q = nwg / 8, r = nwg % 8, xcd = wgid % 8, off = wgid / 8; wgid = (xcd < r ? xcd * (q + 1) : r * (q + 1) + (xcd - r) * q) + off; }
        const int nig = 8 * nN, gid = wgid / nig, fm = gid * 8, gsz = (nM - fm) < 8 ? (nM - fm) : 8;
        u.pm = fm + ((wgid % nig) % gsz); u.pn = (wgid % nig) / gsz; u.aoff = (long)u.pm * astride + (long)u.pn * apn; u.boff = (long)u.pn * bstride; u.e = 0; u.idx0 = 0; return true;
    }
    __device__ int arow(const Unit&, int) const { return 0; }
};
}

constexpr int DM = 2048, NBATCH = 2, SEQ = 8192, CTX = 256;
constexpr int TL = NBATCH * SEQ;
constexpr int TC = NBATCH * CTX;
constexpr int TT = TL + TC;
constexpr int KEYS = CTX + SEQ;
constexpr int NEXP = 64, DEXP = 512;
constexpr int LISTCAP = 2 * TT;
constexpr float EPS = 1e-6f;
constexpr float QSCALE = 0.125f * 1.4426950408889634f;
constexpr int NWAVES = 8, NTHREADS = 512;

constexpr size_t MiB = 1u << 20;
constexpr size_t WS_CTL = 0, CTL_BYTES = 1 * MiB;
constexpr size_t WS_WIN0 = 1 * MiB;
constexpr size_t WS_WOUT0 = WS_WIN0 + 16 * MiB;
constexpr size_t WS_WIN1 = WS_WOUT0 + 8 * MiB;
constexpr size_t WS_WOUT1 = WS_WIN1 + 16 * MiB;
constexpr size_t WS_WPOOL = WS_WOUT1 + 8 * MiB;
constexpr size_t WS_WGLU = WS_WPOOL + 1 * MiB;
constexpr size_t WS_WMOE = WS_WGLU + 2 * MiB;
constexpr size_t MOE_E_BYTES = 6 * MiB, MOE_L_BYTES = 64 * MOE_E_BYTES;
constexpr size_t WS_X = WS_WMOE + 2 * MOE_L_BYTES;
constexpr size_t WS_HA = WS_X + 132 * MiB;
constexpr size_t WS_Q = WS_HA + 67 * MiB;
constexpr size_t WS_K = WS_Q + 33 * MiB;
constexpr size_t WS_VT = WS_K + 33 * MiB;
constexpr size_t WS_P = WS_VT + 33 * MiB;
constexpr size_t WS_PROJ1 = WS_Q;
constexpr size_t WS_CAT = WS_P + 33 * MiB;
constexpr size_t WS_PD = WS_CAT + 66 * MiB;
constexpr size_t WS_H = WS_PD + 33 * MiB;
constexpr size_t WS_Y = WS_H + 49 * MiB;
constexpr size_t WS_GT = WS_Y + 132 * MiB;
constexpr size_t WS_KT = WS_GT + 192 * MiB;
constexpr size_t WS_YD = WS_KT + 128 * MiB;
constexpr size_t WS_MISC = WS_YD + 128 * MiB;
constexpr size_t WS_MOD = WS_MISC;
constexpr size_t WS_ADAP = WS_MOD + 1 * MiB;
constexpr size_t WS_ROPE = WS_ADAP + 10 * MiB;
constexpr size_t WS_NORMP = WS_ROPE + 1 * MiB;
constexpr size_t WS_INVN = WS_NORMP + 4 * MiB;
constexpr size_t WS_S5LAM = WS_INVN + 1 * MiB;
constexpr size_t WS_S5B = WS_S5LAM + 1 * MiB;
constexpr size_t WS_WRT = WS_S5B + 2 * MiB;
constexpr size_t WS_TOKL = WS_WRT + 2 * MiB;
constexpr size_t WS_GATEL = WS_TOKL + 9 * MiB;
constexpr size_t WS_TW = WS_GATEL + 9 * MiB;
constexpr size_t WS_FFTW = WS_TW + 1 * MiB;
constexpr size_t WS_S5L256 = WS_FFTW + 32 * MiB;
constexpr size_t WS_S5E = WS_S5L256 + 1 * MiB;
constexpr size_t WS_YHT = WS_S5E + 4 * MiB;
constexpr size_t WS_S5L16 = WS_YHT + 64 * MiB;
constexpr size_t WS_S5W1 = WS_S5L16 + 1 * MiB;
constexpr size_t WS_S5W3 = WS_S5W1 + 8 * MiB;
constexpr size_t WS_S5KT = WS_S5W3 + 8 * MiB;
constexpr size_t WS_END = WS_S5KT + 2 * MiB;
static_assert(WS_END <= 2040 * MiB, "d_ws map");
constexpr int CW_BAR = 1024;
constexpr int CW_CNT = 8192;

constexpr int LDS_PHASE = 131072;
constexpr int LDS_CTL = 147456 - 2048;
constexpr int LDS_BYTES = 147456;

#define XB_TMO      128
#define XB_XCNT(j)  (256  + 64 * (j))
#define XB_XSUB(j)  (1280 + 64 * (j))
#define XB_XGEN(j)  (2304 + 64 * (j))
#define XB_TOP      3328
#define XB_TOPGEN   3392
#define XCD_BAR_WORDS 3456
#define XB_SPIN_CAP (1u << 22)

__device__ __forceinline__ unsigned xb_ld(unsigned* p)              { return __hip_atomic_load(p, __ATOMIC_RELAXED, __HIP_MEMORY_SCOPE_AGENT); }
__device__ __forceinline__ unsigned xb_add(unsigned* p, unsigned v) { return __hip_atomic_fetch_add(p, v, __ATOMIC_RELAXED, __HIP_MEMORY_SCOPE_AGENT); }
__device__ __forceinline__ unsigned xb_xcc_id() { return (unsigned)__builtin_amdgcn_s_getreg((3 << 11) | 20) & 0xFu; }
#define XB_SPIN(cond, bar) do { unsigned _sp = 0; while (cond) { __builtin_amdgcn_s_sleep(1); \
    if ((++_sp & 255u) == 0u) { if (xb_ld(&(bar)[XB_TMO])) break; if (_sp > XB_SPIN_CAP) { atomicAdd(&(bar)[XB_TMO], 1u); break; } } } } while (0)

struct XcdBarrier { unsigned* bar; unsigned x; volatile LAS unsigned* st; };

__device__ __forceinline__ XcdBarrier xcd_barrier_post(unsigned* bar, volatile LAS unsigned* st) {
    XcdBarrier b; b.bar = bar; b.x = xb_xcc_id(); b.st = st;
    if (threadIdx.x == 0) (void)xb_add(&bar[XB_XCNT(b.x)], 1u);
    return b;
}
__device__ __forceinline__ void xcd_barrier_complete(unsigned* bar, unsigned x, unsigned& nloc, unsigned& nx) {
    const unsigned G = gridDim.x * gridDim.y * gridDim.z;
    unsigned sum, cnt, mine, sp = 0u;
    for (;;) {
        sum = 0u; cnt = 0u; mine = 0u;
#pragma unroll
        for (unsigned j = 0; j < 16; ++j) { const unsigned c = xb_ld(&bar[XB_XCNT(j)]); sum += c; cnt += (c > 0u) ? 1u : 0u; mine = (j == x) ? c : mine; }
        if (sum == G) break;
        __builtin_amdgcn_s_sleep(1);
        if ((++sp & 255u) == 0u) { if (xb_ld(&bar[XB_TMO])) break; if (sp > XB_SPIN_CAP) { atomicAdd(&bar[XB_TMO], 1u); break; } }
    }
    nloc = mine > 0u ? mine : 1u; nx = cnt > 0u ? cnt : 1u;
}
__device__ __forceinline__ void xcd_barrier(const XcdBarrier& b) {
    asm volatile("s_waitcnt vmcnt(0)" ::: "memory");
    __syncthreads();
    if (threadIdx.x == 0) {
        unsigned* bar = b.bar;
        __builtin_amdgcn_s_waitcnt(0);
        unsigned nloc = b.st[0], nx = b.st[1];
        if (nloc == 0u) { xcd_barrier_complete(bar, b.x, nloc, nx); b.st[0] = nloc; b.st[1] = nx; }
        const unsigned old = xb_add(&bar[XB_XSUB(b.x)], 1u);
        const unsigned gen = old / nloc;
        if (old + 1u == (gen + 1u) * nloc) {
            __builtin_amdgcn_fence(__ATOMIC_RELEASE, "agent");
            asm volatile("s_waitcnt vmcnt(0)" ::: "memory");
            const unsigned og = xb_add(&bar[XB_TOP], 1u);
            const unsigned tg = og / nx;
            if (og + 1u == (tg + 1u) * nx) xb_add(&bar[XB_TOPGEN], 1u);
            else XB_SPIN(xb_ld(&bar[XB_TOPGEN]) == tg, bar);
            __builtin_amdgcn_fence(__ATOMIC_ACQUIRE, "agent");
            xb_add(&bar[XB_XGEN(b.x)], 1u);
            asm volatile("s_waitcnt vmcnt(0)" ::: "memory");
        } else {
            XB_SPIN(xb_ld(&bar[XB_XGEN(b.x)]) == gen, bar);
            __builtin_amdgcn_fence(__ATOMIC_ACQUIRE, "agent");
            asm volatile("s_waitcnt vmcnt(0)" ::: "memory");
        }
    }
    __syncthreads();
}

__device__ __forceinline__ void sincos_2pi(double x, double& s, double& c) {
    const double q = __builtin_rint(x * 4.0);
    const double y = (x - q * 0.25) * 6.283185307179586476925;
    const double y2 = y * y;
    double sp = -7.6471637318198164759e-13; sp = sp * y2 + 1.6059043836821614599e-10; sp = sp * y2 - 2.5052108385441718775e-8; sp = sp * y2 + 2.7557319223985890653e-6;
    sp = sp * y2 - 1.9841269841269841270e-4; sp = sp * y2 + 8.3333333333333333333e-3; sp = sp * y2 - 1.6666666666666666667e-1; sp = sp * y2 * y + y;
    double cp = 4.7794773323873852974e-14; cp = cp * y2 - 1.1470745597729724714e-11; cp = cp * y2 + 2.0876756987868098979e-9; cp = cp * y2 - 2.7557319223985890653e-7;
    cp = cp * y2 + 2.4801587301587301587e-5; cp = cp * y2 - 1.3888888888888888889e-3; cp = cp * y2 + 4.1666666666666666667e-2; cp = cp * y2 - 0.5; cp = cp * y2 + 1.0;
    const int qi = ((int)q) & 3;
    s = (qi == 0) ? sp : (qi == 1) ? cp : (qi == 2) ? -sp : -cp;
    c = (qi == 0) ? cp : (qi == 1) ? -sp : (qi == 2) ? -cp : sp;
}
__device__ __forceinline__ void sincos_rad(double a, double& s, double& c) {
    double f = a * 0.15915494309189533576888; f -= __builtin_floor(f);
    if (f >= 1.0) f = 0.0;
    sincos_2pi(f, s, c);
}
__device__ __forceinline__ double exp_small(double x) {
    double r = 1.0 / 479001600.0;
    r = r * x + 1.0 / 39916800.0; r = r * x + 1.0 / 3628800.0; r = r * x + 1.0 / 362880.0; r = r * x + 1.0 / 40320.0; r = r * x + 1.0 / 5040.0;
    r = r * x + 1.0 / 720.0; r = r * x + 1.0 / 120.0; r = r * x + 1.0 / 24.0; r = r * x + 1.0 / 6.0; r = r * x + 0.5; r = r * x + 1.0; r = r * x + 1.0;
    return r;
}
__device__ __forceinline__ float fast_exp(float x) { return __builtin_amdgcn_exp2f(x * 1.4426950408889634f); }
__device__ __forceinline__ float sigmoidf_(float x) { return 1.0f / (1.0f + fast_exp(-x)); }
__device__ __forceinline__ float siluf_(float x) { return x * sigmoidf_(x); }
__device__ __forceinline__ float tanhf_(float x) { const float e = fast_exp(-2.0f * fabsf(x)); const float t = (1.0f - e) / (1.0f + e); return x < 0.f ? -t : t; }
__device__ __forceinline__ float gelu_tanh(float x) { return 0.5f * x * (1.0f + tanhf_(0.7978845608028654f * (x + 0.044715f * x * x * x))); }

#ifndef PH_REPEAT
#define PH_REPEAT 0u
#endif
struct Args { const float* in[43]; float* out; unsigned char* ws; int ph_lo, ph_hi; };

struct Frame {
    LAS unsigned char* lds; unsigned char* ws; int tid, lane, wave, bid, G, gw, NGW;
    const __attribute__((address_space(4))) unsigned long long* kin;
};
#define INP(i) ((const float*)F.kin[i])
#define WSP(T, off) ((T*)(F.ws + (off)))

__device__ __forceinline__ void tr_item(const float* W, int ldw, int N, bf16* WT, int ldt, int row_off, int rs16, LAS float* scr, int item, int lane) {
    const int nblk = N / 64, kb = item / nblk, nb = item % nblk, k0 = 64 * kb, n0 = 64 * nb;
    const int la = lane & 15, lb = lane >> 4;
    f32x4 v[16];
#pragma unroll
    for (int i = 0; i < 16; ++i) v[i] = *(const f32x4*)(W + (size_t)(k0 + 4 * i + lb) * ldw + n0 + 4 * la);
#pragma unroll
    for (int i = 0; i < 16; ++i) { const int kk = 4 * i + lb; LAS float* d = scr + (4 * la) * 65 + kk; d[0] = v[i].x; d[65] = v[i].y; d[130] = v[i].z; d[195] = v[i].w; }
    LDS_WAIT(); asm volatile("" ::: "memory");
    const int c = lane & 7;
#pragma unroll
    for (int j = 0; j < 8; ++j) { const int n = (lane >> 3) + 8 * j; const LAS float* s = scr + n * 65 + 8 * c;
        v4u o; o.x = cvt_pk_bf16(s[0], s[1]); o.y = cvt_pk_bf16(s[2], s[3]); o.z = cvt_pk_bf16(s[4], s[5]); o.w = cvt_pk_bf16(s[6], s[7]);
        const int nn = n0 + n, drow = row_off + (nn >> 4) * rs16 + (nn & 15);
        *(v4u*)(WT + (size_t)drow * ldt + k0 + 8 * c) = o; }
    LDS_WAIT(); asm volatile("" ::: "memory");
}

__device__ __forceinline__ void hyfilt_item(Frame& F, int pb) {
    const float* w1 = INP(19); const float* b1 = INP(20); const float* fq = INP(21); const float* w2 = INP(22); const float* b2 = INP(23); const float* w3 = INP(24);
    LAS float* z = (LAS float*)F.lds;
    LAS float* h1 = z + 1088;
    LAS float* h2 = h1 + 2048;
    const int tid = F.tid;
    for (int idx = tid; idx < 32 * 33; idx += NTHREADS) {
        const int p = idx / 33, f = idx % 33, i = pb * 32 + p;
        float v;
        if (f == 0) v = (float)i * (1.0f / (float)(SEQ - 1));
        else { const int j = (f - 1) & 15; const float fj = 1e-4f + (float)j * ((15.0f - 1e-4f) / 15.0f);
            double fr = (double)fj * (double)i / (double)SEQ; fr -= __builtin_floor(fr); double s, c; sincos_2pi(fr, s, c); v = (f <= 16) ? (float)c : (float)(-s); }
        z[p * 33 + f] = v;
    }
    __syncthreads();
    for (int idx = tid; idx < 2048; idx += NTHREADS) {
        const int p = idx >> 6, j = idx & 63; float a = b1[j];
        for (int f = 0; f < 33; ++f) a += z[p * 33 + f] * w1[f * 64 + j];
        double s, c; sincos_rad((double)(fq[j] * a), s, c); h1[idx] = (float)s;
    }
    __syncthreads();
    for (int idx = tid; idx < 2048; idx += NTHREADS) {
        const int p = idx >> 6, j = idx & 63; float a = b2[j];
        for (int k = 0; k < 64; ++k) a += h1[p * 64 + k] * w2[k * 64 + j];
        double s, c; sincos_rad((double)(fq[64 + j] * a), s, c); h2[idx] = (float)s;
    }
    __syncthreads();
    float* kT = WSP(float, WS_KT); float* normp = WSP(float, WS_NORMP);
    {
        const int lane = F.lane, l31 = lane & 31, lh = lane >> 5;
        float af[32];
#pragma unroll
        for (int s = 0; s < 32; ++s) af[s] = h2[l31 * 64 + 2 * s + lh];
        for (int ct = F.wave; ct < 128; ct += NWAVES) {
            const int col = ct * 32 + l31;
            f32x16 acc;
#pragma unroll
            for (int r = 0; r < 16; ++r) acc[r] = 0.f;
            float bv[32];
#pragma unroll
            for (int s = 0; s < 32; ++s) bv[s] = w3[(size_t)(2 * s + lh) * 4096 + col];
#pragma unroll
            for (int s = 0; s < 32; ++s) acc = __builtin_amdgcn_mfma_f32_32x32x2f32(af[s], bv[s], acc, 0, 0, 0);
#pragma unroll
            for (int s = 0; s < 32; s += 8) asm volatile("" : "+v"(acc) : "v"(bv[s]), "v"(bv[s + 1]), "v"(bv[s + 2]), "v"(bv[s + 3]), "v"(bv[s + 4]), "v"(bv[s + 5]), "v"(bv[s + 6]), "v"(bv[s + 7]));
            const int ch = col & 1023, dir = (col >> 10) & 1;
            const float adel = 3.0701134573253946f + (float)ch * ((15.350567286626972f - 3.0701134573253946f) / 1023.0f);
            float sabs = 0.f;
#pragma unroll
            for (int r = 0; r < 16; ++r) { const int i = pb * 32 + (r & 3) + 8 * (r >> 2) + 4 * lh; const float t = (float)i * (1.0f / (float)(SEQ - 1)); acc[r] *= fast_exp(-t * adel); if (!(dir == 1 && i == 0)) sabs += fabsf(acc[r]); }
            sabs += __shfl_xor(sabs, 32);
#pragma unroll
            for (int q = 0; q < 4; ++q) *(f32x4*)(kT + (size_t)col * SEQ + pb * 32 + 8 * q + 4 * lh) = (f32x4){acc[4 * q], acc[4 * q + 1], acc[4 * q + 2], acc[4 * q + 3]};
            if (lh == 0) normp[(size_t)pb * 4096 + col] = sabs;
        }
    }
    __syncthreads();
}

struct TrItem { const float* W; bf16* WT; int ldw, ldt, row_off, rs16, k0, n0; };
__device__ __forceinline__ TrItem moe_tr_item(Frame& F, int it) {
    const int le = it / 96, q = it % 96; TrItem r;
    bf16* wc = (bf16*)(F.ws + WS_WMOE + (size_t)le * MOE_E_BYTES);
    if (q < 32) { r.W = INP(40) + (size_t)le * (2048 * 512); r.ldw = 512; r.WT = wc; r.ldt = 2048; r.row_off = 0; r.rs16 = 32; r.k0 = 64 * q; r.n0 = 0; }
    else if (q < 64) { r.W = INP(41) + (size_t)le * (2048 * 512); r.ldw = 512; r.WT = wc; r.ldt = 2048; r.row_off = 16; r.rs16 = 32; r.k0 = 64 * (q - 32); r.n0 = 0; }
    else { const int x = q - 64; r.W = INP(42) + (size_t)le * (512 * 2048); r.ldw = 2048; r.WT = wc + 1024 * 2048; r.ldt = 512; r.row_off = 0; r.rs16 = 16; r.k0 = 64 * (x >> 2); r.n0 = 512 * (x & 3); }
    return r;
}
__device__ __forceinline__ void moe_convert_items(Frame& F) {
    LAS float* T = (LAS float*)F.lds;
    const int t = F.tid;
    f32x4 v[16];
    int it = F.bid;
    if (it >= 128 * 96) return;
    { const TrItem c = moe_tr_item(F, it);
#pragma unroll
      for (int i = 0; i < 16; ++i) v[i] = __builtin_nontemporal_load((const f32x4*)(c.W + (size_t)(c.k0 + 4 * i + (t >> 7)) * c.ldw + c.n0 + 4 * (t & 127))); }
#pragma nounroll
    for (; it < 128 * 96; it += F.G) {
        const TrItem c = moe_tr_item(F, it);
#pragma unroll
        for (int i = 0; i < 16; ++i) { const int k = 4 * i + (t >> 7); *(LAS f32x4*)(T + k * 516 + ((4 * (t & 127) + 8 * (k >> 3)) & 511)) = v[i]; }
        if (it + F.G < 128 * 96) { const TrItem nx = moe_tr_item(F, it + F.G);
#pragma unroll
            for (int i = 0; i < 16; ++i) v[i] = __builtin_nontemporal_load((const f32x4*)(nx.W + (size_t)(nx.k0 + 4 * i + (t >> 7)) * nx.ldw + nx.n0 + 4 * (t & 127))); }
        __syncthreads();
        const int cc = (t >> 3) & 7, nl = (t & 7) | ((t >> 6) << 3);
#pragma unroll
        for (int q = 0; q < 8; ++q) { const int n = 64 * q + nl; const LAS float* s = T + (8 * cc) * 516 + ((n + 8 * cc) & 511);
            v4u o; o.x = cvt_pk_bf16(s[0], s[516]); o.y = cvt_pk_bf16(s[2 * 516], s[3 * 516]); o.z = cvt_pk_bf16(s[4 * 516], s[5 * 516]); o.w = cvt_pk_bf16(s[6 * 516], s[7 * 516]);
            const int nn = c.n0 + n, drow = c.row_off + (nn >> 4) * c.rs16 + (nn & 15);
            __builtin_nontemporal_store(o, (v4u*)(c.WT + (size_t)drow * c.ldt + c.k0 + 8 * cc)); }
        __syncthreads();
    }
}

__device__ __forceinline__ void p0_prologue(Frame& F) {
    for (int rep = 0; rep < (((PH_REPEAT >> 25) & 1u) ? 2 : 1); ++rep)
    for (int pb = F.bid; pb < SEQ / 32; pb += F.G) hyfilt_item(F, pb);
    const int gt = F.bid * NTHREADS + F.tid, NGT = F.G * NTHREADS;
    {
        f32x2* rope = WSP(f32x2, WS_ROPE);
        for (int idx = gt; idx < 128 * 16; idx += NGT) { const int pos = idx >> 4, i = idx & 15;
            double inv = (i & 3) == 0 ? 1.0 : (i & 3) == 1 ? 0.56234132519034908 : (i & 3) == 2 ? 0.31622776601683794 : 0.17782794100389228;
            inv *= (i >> 2) == 0 ? 1.0 : (i >> 2) == 1 ? 0.1 : (i >> 2) == 2 ? 0.01 : 0.001;
            const float ang = (float)pos * (float)inv; double s, c; sincos_rad((double)ang, s, c); rope[idx] = (f32x2){(float)c, (float)s}; }
    }
    {
        f32x2* tw = WSP(f32x2, WS_TW);
        for (int idx = gt; idx < 16384; idx += NGT) { double s, c; sincos_2pi((double)idx * (1.0 / 16384.0), s, c); tw[idx] = (f32x2){(float)c, (float)(-s)}; }
    }
    {
        const float* are = INP(26); const float* aim = INP(27); const float* ldt = INP(28); const float* bre = INP(29); const float* bim = INP(30);
        f32x2* lamb = WSP(f32x2, WS_S5LAM); f32x2* bb = WSP(f32x2, WS_S5B); f32x2* l256 = WSP(f32x2, WS_S5L256);
        for (int idx = gt; idx < 2 * 64 * 64; idx += NGT) { const int dg = idx >> 6;
            const float dt = expf(ldt[dg]); const float ar = are[idx], ai = aim[idx];
            const float zr = ar * dt, zi = ai * dt; double s, c; sincos_rad((double)zi, s, c); const double er = exp_small((double)zr);
            const double lr = er * c, li = er * s; lamb[idx] = (f32x2){(float)lr, (float)li};
            { double pr = lr, pi = li; for (int q = 0; q < 8; ++q) { const double tr = pr * pr - pi * pi, ti = 2.0 * pr * pi; pr = tr; pi = ti; } l256[idx] = (f32x2){(float)pr, (float)pi}; }
            const double nr = lr - 1.0, ni = li, den = (double)ar * ar + (double)ai * ai; const double qr = (nr * ar + ni * ai) / den, qi = (ni * ar - nr * ai) / den;
            for (int cc = 0; cc < 16; ++cc) { const double br = bre[(size_t)idx * 16 + cc], bi = bim[(size_t)idx * 16 + cc]; bb[(size_t)idx * 16 + cc] = (f32x2){(float)(qr * br - qi * bi), (float)(qr * bi + qi * br)}; } }
    }
    {
        float* wrt = WSP(float, WS_WRT);
        for (int idx = gt; idx < 2 * 72 * 2048; idx += NGT) { const int l = idx / (72 * 2048), r = idx % (72 * 2048), n = r / 2048, k = r % 2048;
            wrt[idx] = n < 8 ? INP(36)[((size_t)l * 2048 + k) * 8 + n] : INP(38)[((size_t)l * 2048 + k) * 64 + (n - 8)]; }
    }
    {
        bf16* ha = WSP(bf16, WS_HA);
        for (int idx = gt; idx < 2048; idx += NGT) ha[(size_t)TT * 2048 + idx] = 0;
    }
    LAS float* scr = (LAS float*)(F.lds + F.wave * 16896);
    {
        const float* c = INP(1); const float* cctx = INP(3); const float* adaw = INP(4); float* part = WSP(float, WS_ADAP);
        for (int rep = 0; rep < (((PH_REPEAT >> 26) & 1u) ? 2 : 1); ++rep)
        for (int it = F.gw; it < 2 * 32 * 48; it += F.NGW) {
            const int l = it / (32 * 48), r = it % (32 * 48), ks = r / 48, jb = r % 48, k0 = ks * 64, j0 = jb * 256 + F.lane * 4;
            const float c0 = c[k0 + F.lane], c1 = c[2048 + k0 + F.lane], c2 = cctx[k0 + F.lane];
            const float s0 = c0 / (1.0f + expf(-c0)), s1 = c1 / (1.0f + expf(-c1)), s2 = c2 / (1.0f + expf(-c2));
            f32x4 a0 = {0.f, 0.f, 0.f, 0.f}, a1 = a0, a2 = a0;
            const float* wp = adaw + ((size_t)l * 2048 + k0) * 12288 + j0;
#pragma unroll 8
            for (int kk = 0; kk < 64; ++kk) { const f32x4 w = *(const f32x4*)(wp + (size_t)kk * 12288);
                const float t0 = __builtin_bit_cast(float, __builtin_amdgcn_readlane(__builtin_bit_cast(int, s0), kk));
                const float t1 = __builtin_bit_cast(float, __builtin_amdgcn_readlane(__builtin_bit_cast(int, s1), kk));
                const float t2 = __builtin_bit_cast(float, __builtin_amdgcn_readlane(__builtin_bit_cast(int, s2), kk));
                a0 += w * t0; a1 += w * t1; a2 += w * t2; }
            float* pp = part + ((size_t)(l * 32 + ks) * 3) * 12288 + j0;
            *(f32x4*)(pp) = a0; *(f32x4*)(pp + 12288) = a1; *(f32x4*)(pp + 2 * 12288) = a2;
        }
    }
    {
        constexpr int I0 = 1024, I1 = 512, I2 = 512, I3 = 1024, I4 = 2048, I5 = 1024, I6 = 64, I7 = 256, IE = 768;
        constexpr int NSMALL = I0 + I1 + I2 + I3 + I4 + I5 + I6 + I7;
        const int NITEMS = NSMALL;
        for (int rep = 0; rep < (((PH_REPEAT >> 27) & 1u) ? 2 : 1); ++rep)
        for (int it = F.gw; it < NITEMS; it += F.NGW) {
            int r = it;
            if (r < I0) { tr_item(INP(9), 4096, 2048, WSP(bf16, WS_WIN0), 2048, 0, 16, scr, r, F.lane); continue; } r -= I0;
            if (r < I1) { tr_item(INP(9) + 2048, 4096, 1024, WSP(bf16, WS_WIN0), 2048, 3072, 16, scr, r, F.lane); continue; } r -= I1;
            if (r < I2) { tr_item(INP(9) + 3072, 4096, 1024, WSP(bf16, WS_WIN0), 2048, 2048, 16, scr, r, F.lane); continue; } r -= I2;
            if (r < I3) { tr_item(INP(10), 2048, 2048, WSP(bf16, WS_WOUT0), 2048, 0, 16, scr, r, F.lane); continue; } r -= I3;
            if (r < I4) { tr_item(INP(15), 4096, 4096, WSP(bf16, WS_WIN1), 2048, 0, 16, scr, r, F.lane); continue; } r -= I4;
            if (r < I5) { tr_item(INP(16), 2048, 2048, WSP(bf16, WS_WOUT1), 2048, 0, 16, scr, r, F.lane); continue; } r -= I5;
            if (r < I6) { const int g = r / 16; tr_item(INP(13) + (size_t)g * 65536, 256, 256, WSP(bf16, WS_WPOOL), 256, g * 256, 16, scr, r % 16, F.lane); continue; } r -= I6;
            if (r < I7) { tr_item(INP(34), 1024, 1024, WSP(bf16, WS_WGLU), 1024, 0, 16, scr, r, F.lane); continue; } r -= I7;
        }
    }
}

__device__ __forceinline__ void p1_reduce(Frame& F) {
    const int gt = F.bid * NTHREADS + F.tid, NGT = F.G * NTHREADS;
    const float* part = WSP(float, WS_ADAP); float* mod = WSP(float, WS_MOD); const float* adab = INP(5);
    for (int idx = gt; idx < 2 * 3 * 12288; idx += NGT) { const int l = idx / (3 * 12288), r = idx % (3 * 12288), m = r / 12288, j = r % 12288;
        float a = adab[l * 12288 + j];
        for (int ks = 0; ks < 32; ++ks) a += part[((size_t)(l * 32 + ks) * 3 + m) * 12288 + j];
        mod[idx] = a; }
    const float* normp = WSP(float, WS_NORMP); float* invn = WSP(float, WS_INVN);
    for (int idx = gt; idx < 2048; idx += NGT) { const int o = idx >> 10, ch = idx & 1023; float a = 0.f;
        for (int pb = 0; pb < 256; ++pb) a += normp[(size_t)pb * 4096 + o * 2048 + ch] + normp[(size_t)pb * 4096 + o * 2048 + 1024 + ch];
        invn[idx] = 1.0f / a; }
    {
        const f32x2* lamb = WSP(f32x2, WS_S5LAM); const f32x2* bbar = WSP(f32x2, WS_S5B); const float* cre = INP(31); const float* cim = INP(32);
        bf16* W1 = WSP(bf16, WS_S5W1); bf16* W3 = WSP(bf16, WS_S5W3); bf16* KT = WSP(bf16, WS_S5KT); f32x2* l16 = WSP(f32x2, WS_S5L16);
#define S5_POWF(l_, e_, pw_) do { pw_ = (f32x2){1.f, 0.f}; f32x2 b_ = l_; for (int q_ = (e_); q_ > 0; q_ >>= 1) { if (q_ & 1) pw_ = (f32x2){pw_.x * b_.x - pw_.y * b_.y, pw_.x * b_.y + pw_.y * b_.x}; b_ = (f32x2){b_.x * b_.x - b_.y * b_.y, 2.f * b_.x * b_.y}; } } while (0)
        for (int idx = gt; idx < 128 * 64; idx += NGT) { f32x2 pw; S5_POWF(lamb[idx], 16, pw); l16[idx] = pw; }
        for (int idx = gt; idx < 128 * 128 * 32; idx += NGT) {
            const int k8 = idx & 31, n = (idx >> 5) & 127, dg = idx >> 12, sigma = k8 >> 1, h = k8 & 1, p = (n & 15) + 16 * ((n >> 4) & 3), im = n >> 6;
            f32x2 pw; S5_POWF(lamb[dg * 64 + p], 15 - sigma, pw);
            const f32x4* bp = (const f32x4*)(bbar + ((size_t)dg * 64 + p) * 16 + 8 * h); float o[8];
#pragma unroll
            for (int j = 0; j < 4; ++j) { const f32x4 q = bp[j]; o[2 * j] = im ? (pw.x * q.y + pw.y * q.x) : (pw.x * q.x - pw.y * q.y); o[2 * j + 1] = im ? (pw.x * q.w + pw.y * q.z) : (pw.x * q.z - pw.y * q.w); }
            v4u w; w.x = pk2(o[0], o[1]); w.y = pk2(o[2], o[3]); w.z = pk2(o[4], o[5]); w.w = pk2(o[6], o[7]);
            *(v4u*)(W1 + (size_t)idx * 8) = w; }
        for (int idx = gt; idx < 128 * 256 * 16; idx += NGT) {
            const int k8 = idx & 15, n = (idx >> 4) & 255, dg = idx >> 12, tau = n >> 4, cout = n & 15; float o[8];
#pragma unroll
            for (int j = 0; j < 4; ++j) { const int p = 4 * k8 + j; f32x2 pw; S5_POWF(lamb[dg * 64 + p], tau + 1, pw);
                const float cr = cre[((size_t)dg * 16 + cout) * 64 + p], ci = cim[((size_t)dg * 16 + cout) * 64 + p]; o[2 * j] = cr * pw.x - ci * pw.y; o[2 * j + 1] = -(cr * pw.y + ci * pw.x); }
            v4u w; w.x = pk2(o[0], o[1]); w.y = pk2(o[2], o[3]); w.z = pk2(o[4], o[5]); w.w = pk2(o[6], o[7]);
            *(v4u*)(W3 + (size_t)idx * 8) = w; }
        for (int idx = gt; idx < 128 * 17 * 16 * 2; idx += NGT) {
            const int h = idx & 1, cout = (idx >> 1) & 15, d1 = (idx >> 5) % 17, dg = (idx >> 5) / 17;
            float acc[8];
#pragma unroll
            for (int j = 0; j < 8; ++j) acc[j] = 0.f;
            if (d1 > 0) { for (int p = 0; p < 64; ++p) { f32x2 pw; S5_POWF(lamb[dg * 64 + p], d1 - 1, pw);
                const float cr = cre[((size_t)dg * 16 + cout) * 64 + p], ci = cim[((size_t)dg * 16 + cout) * 64 + p]; const float gr = cr * pw.x - ci * pw.y, gi = cr * pw.y + ci * pw.x;
                const f32x4* bp = (const f32x4*)(bbar + ((size_t)dg * 64 + p) * 16 + 8 * h);
#pragma unroll
                for (int j = 0; j < 4; ++j) { const f32x4 q = bp[j]; acc[2 * j] += gr * q.x - gi * q.y; acc[2 * j + 1] += gr * q.z - gi * q.w; } } }
            v4u w; w.x = pk2(acc[0], acc[1]); w.y = pk2(acc[2], acc[3]); w.z = pk2(acc[4], acc[5]); w.w = pk2(acc[6], acc[7]);
            *(v4u*)(KT + (size_t)idx * 8) = w; }
#undef S5_POWF
    }
}

__device__ __forceinline__ const float* modp(Frame& F, int l, int m, int c) { return WSP(float, WS_MOD) + ((size_t)(l * 3 + m) * 6 + c) * 2048; }
__device__ __forceinline__ int row_stream(int r) { return r < TL ? r / SEQ : 2; }

template <int MODE>
__device__ __forceinline__ void norm_phase(Frame& F, int l, float* dout) {
    const int nrows = (MODE == 3 || (MODE == 1 && l == 1)) ? TL : TT;
    float* xbuf = WSP(float, WS_X); bf16* ha = WSP(bf16, WS_HA); const bf16* Y = WSP(bf16, WS_Y);
    const float* gvec = (MODE == 0) ? INP(6) : (MODE == 1) ? INP(7) + l * 2048 : (MODE == 2) ? INP(6) + 2048 : INP(8);
    const int lane = F.lane;
    for (int r = F.gw; r < nrows; r += F.NGW) {
        const int m = row_stream(r);
        const float* src = (MODE == 0) ? (r < TL ? INP(0) + (size_t)r * 2048 : INP(2) + (size_t)(r - TL) * 2048) : xbuf + (size_t)r * 2048;
        f32x4 v[8]; float ss = 0.f;
#pragma unroll
        for (int j = 0; j < 8; ++j) v[j] = *(const f32x4*)(src + 4 * lane + 256 * j);
        if (MODE == 2 || MODE == 3) {
            const float* g2 = modp(F, MODE == 2 ? 0 : 1, m, 5);
            const bf16* y0 = Y + (size_t)(2 * r) * 2048; const bf16* y1 = y0 + 2048;
#pragma unroll
            for (int j = 0; j < 8; ++j) { const int c = 4 * lane + 256 * j; const v2u a = *(const v2u*)(y0 + c), b = *(const v2u*)(y1 + c); const f32x4 gg = *(const f32x4*)(g2 + c);
                v[j].x += gg.x * (bflo(a.x) + bflo(b.x)); v[j].y += gg.y * (bfhi(a.x) + bfhi(b.x)); v[j].z += gg.z * (bflo(a.y) + bflo(b.y)); v[j].w += gg.w * (bfhi(a.y) + bfhi(b.y)); }
            if (MODE == 2) {
#pragma unroll
                for (int j = 0; j < 8; ++j) *(f32x4*)(xbuf + (size_t)r * 2048 + 4 * lane + 256 * j) = v[j];
            }
        }
#pragma unroll
        for (int j = 0; j < 8; ++j) ss += (v[j].x * v[j].x + v[j].y * v[j].y) + (v[j].z * v[j].z + v[j].w * v[j].w);
        ss = wave_sum(ss);
        const float rs = 1.0f / sqrtf(ss * (1.0f / 2048.0f) + EPS);
        if (MODE == 3) {
#pragma unroll
            for (int j = 0; j < 8; ++j) { const int c = 4 * lane + 256 * j; const f32x4 gg = *(const f32x4*)(gvec + c); *(f32x4*)(dout + (size_t)r * 2048 + c) = v[j] * rs * gg; }
            continue;
        }
        const int lm = (MODE == 2) ? 1 : l;
        const float* sh = modp(F, lm, m, MODE == 1 ? 3 : 0); const float* sc = modp(F, lm, m, MODE == 1 ? 4 : 1);
#pragma unroll
        for (int j = 0; j < 8; ++j) { const int c = 4 * lane + 256 * j; const f32x4 gg = *(const f32x4*)(gvec + c), s1 = *(const f32x4*)(sc + c), s0 = *(const f32x4*)(sh + c);
            v[j] = (v[j] * rs * gg) * (1.0f + s1) + s0;
            v2u o; o.x = pk2(v[j].x, v[j].y); o.y = pk2(v[j].z, v[j].w); *(v2u*)(ha + (size_t)r * 2048 + c) = o; }
    }
}

__device__ __forceinline__ void ffn_norm_router_phase(Frame& F, int l, int dummy = 0) {
    const int nrows = (l == 1) ? TL : TT;
    const float* xbuf = WSP(float, WS_X); bf16* ha = WSP(bf16, WS_HA);
    const float* gvec = INP(7) + l * 2048;
    const float* wrt = WSP(float, WS_WRT) + (size_t)l * 72 * 2048;
    LAS float* wl = (LAS float*)F.lds;
    LAS float* lg = (LAS float*)(F.lds + 131072 + F.wave * 1536);
    const int lane = F.lane, tid = F.tid;
    for (int it = F.bid; it < nrows / 32; it += F.G) {
        const int r0 = it * 32 + F.wave * 4;
#define RT_DMA(q_, buf_) do { _Pragma("unroll") for (int _i = 0; _i < 8; ++_i) \
            __builtin_amdgcn_global_load_lds((const unsigned*)(wrt + (size_t)(q_) * 16384 + (size_t)(F.wave * 8 + _i) * 256 + lane * 4), (LAS unsigned*)(wl + (buf_) * 16384 + (F.wave * 8 + _i) * 256), 16, 0, 0); } while (0)
        RT_DMA(0, 0);
        f32x4 v[4][8];
#pragma unroll
        for (int rr = 0; rr < 4; ++rr) {
            const int r = r0 + rr, m = row_stream(r);
            const float* src = xbuf + (size_t)r * 2048; float ss = 0.f;
#pragma unroll
            for (int j = 0; j < 8; ++j) { v[rr][j] = *(const f32x4*)(src + 4 * lane + 256 * j); ss += (v[rr][j].x * v[rr][j].x + v[rr][j].y * v[rr][j].y) + (v[rr][j].z * v[rr][j].z + v[rr][j].w * v[rr][j].w); }
            ss = wave_sum(ss);
            const float rs = 1.0f / sqrtf(ss * (1.0f / 2048.0f) + EPS);
            const float* sh = modp(F, l, m, 3); const float* sc = modp(F, l, m, 4);
#pragma unroll
            for (int j = 0; j < 8; ++j) { if ((j & 1) == 0) __builtin_amdgcn_sched_barrier(0); const int c = 4 * lane + 256 * j; const f32x4 gg = *(const f32x4*)(gvec + c), s1 = *(const f32x4*)(sc + c), s0 = *(const f32x4*)(sh + c);
                v[rr][j] = (v[rr][j] * rs * gg) * (1.0f + s1) + s0;
                v2u o; o.x = cvt_pk_bf16(v[rr][j].x, v[rr][j].y); o.y = cvt_pk_bf16(v[rr][j].z, v[rr][j].w); *(v2u*)(ha + (size_t)r * 2048 + c) = o; }
        }
        asm volatile("s_waitcnt vmcnt(0)" ::: "memory");
        __syncthreads();
        const bool b5 = (lane & 32) != 0, b4 = (lane & 16) != 0, b3 = (lane & 8) != 0, b2 = (lane & 4) != 0;
#pragma nounroll
        for (int q = 0; q < 9; ++q) {
            const LAS float* wq = wl + (q & 1) * 16384;
            if (q + 1 < 9) RT_DMA(q + 1, (q + 1) & 1);
#pragma nounroll
            for (int hq = 0; hq < 2; ++hq) {
                float a[16];
#pragma unroll
                for (int nn = 0; nn < 4; ++nn) { const LAS float* wn = wq + (hq * 4 + nn) * 2048 + 4 * lane; f32x2 s0 = {0.f, 0.f}, s1 = s0, s2 = s0, s3 = s0;
#pragma unroll
                    for (int j = 0; j < 8; ++j) { const f32x4 w = *(const LAS f32x4*)(wn + 256 * j); const f32x2 wlo = {w.x, w.y}, whi = {w.z, w.w};
                        s0 = (f32x2){v[0][j].x, v[0][j].y} * wlo + s0; s0 = (f32x2){v[0][j].z, v[0][j].w} * whi + s0;
                        s1 = (f32x2){v[1][j].x, v[1][j].y} * wlo + s1; s1 = (f32x2){v[1][j].z, v[1][j].w} * whi + s1;
                        s2 = (f32x2){v[2][j].x, v[2][j].y} * wlo + s2; s2 = (f32x2){v[2][j].z, v[2][j].w} * whi + s2;
                        s3 = (f32x2){v[3][j].x, v[3][j].y} * wlo + s3; s3 = (f32x2){v[3][j].z, v[3][j].w} * whi + s3; }
                    a[nn] = s0.x + s0.y; a[4 + nn] = s1.x + s1.y; a[8 + nn] = s2.x + s2.y; a[12 + nn] = s3.x + s3.y; }
                float c8[8], c4[4], c2[2], c1;
#pragma unroll
                for (int i = 0; i < 8; ++i) { const float keep = b5 ? a[i + 8] : a[i], send = b5 ? a[i] : a[i + 8]; c8[i] = keep + __shfl_xor(send, 32); }
#pragma unroll
                for (int i = 0; i < 4; ++i) { const float keep = b4 ? c8[i + 4] : c8[i], send = b4 ? c8[i] : c8[i + 4]; c4[i] = keep + __shfl_xor(send, 16); }
#pragma unroll
                for (int i = 0; i < 2; ++i) { const float keep = b3 ? c4[i + 2] : c4[i], send = b3 ? c4[i] : c4[i + 2]; c2[i] = keep + __shfl_xor(send, 8); }
                { const float keep = b2 ? c2[1] : c2[0], send = b2 ? c2[0] : c2[1]; c1 = keep + __shfl_xor(send, 4); }
                c1 += __shfl_xor(c1, 2); c1 += __shfl_xor(c1, 1);
                if ((lane & 3) == 0) { const int i = lane >> 2; lg[(i >> 2) * 80 + q * 8 + hq * 4 + (i & 3)] = c1; }
            }
            asm volatile("s_waitcnt vmcnt(0)" ::: "memory");
            __syncthreads();
        }
#undef RT_DMA
        if (lane < 4) {
            const int r = r0 + lane; const LAS float* L = lg + lane * 80;
            float gl[8]; float gmax = -INFINITY; int gi = 0;
#pragma unroll
            for (int j = 0; j < 8; ++j) { gl[j] = L[j] + INP(37)[l * 8 + j]; if (gl[j] > gmax) { gmax = gl[j]; gi = j; } }
            float gsum = 0.f;
#pragma unroll
            for (int j = 0; j < 8; ++j) gsum += expf(gl[j] - gmax);
            const float pg_top = 1.0f / gsum;
            float pe[8]; float emax = -INFINITY;
#pragma unroll
            for (int j = 0; j < 8; ++j) { pe[j] = L[8 + gi * 8 + j] + INP(39)[l * 64 + gi * 8 + j]; emax = fmaxf(emax, pe[j]); }
            float esum = 0.f;
#pragma unroll
            for (int j = 0; j < 8; ++j) { pe[j] = expf(pe[j] - emax); esum += pe[j]; }
            int e1 = 0; float p1 = -1.f;
#pragma unroll
            for (int j = 0; j < 8; ++j) { pe[j] /= esum; if (pe[j] > p1) { p1 = pe[j]; e1 = j; } }
            int e2 = 0; float p2 = -1.f;
#pragma unroll
            for (int j = 0; j < 8; ++j) { if (j != e1 && pe[j] > p2) { p2 = pe[j]; e2 = j; } }
            const float den = p1 + p2; const float g1 = pg_top * p1 / den, g2 = pg_top * p2 / den;
            unsigned* cnt = WSP(unsigned, WS_CTL) + CW_CNT + l * 64 + dummy * 256; int* tokl = dummy ? WSP(int, WS_YD) : WSP(int, WS_TOKL); float* gatel = dummy ? WSP(float, WS_YD) + 16 * 1024 * 1024 : WSP(float, WS_GATEL);
            const int ex1 = gi * 8 + e1, ex2 = gi * 8 + e2;
            const unsigned k1 = atomicAdd(cnt + ex1, 1u); tokl[(size_t)ex1 * LISTCAP + k1] = 2 * r; gatel[(size_t)ex1 * LISTCAP + k1] = g1;
            const unsigned k2 = atomicAdd(cnt + ex2, 1u); tokl[(size_t)ex2 * LISTCAP + k2] = 2 * r + 1; gatel[(size_t)ex2 * LISTCAP + k2] = g2;
        }
        __syncthreads();
    }
}

#define EPI_ARGS const f32x4 (&acc)[2][2][4][2], const pg8::Unit& u, int wr, int wc, int fr, int fq
__device__ __forceinline__ void st_bf4(bf16* p, f32x4 v) { v2u o; o.x = cvt_pk_bf16(v.x, v.y); o.y = cvt_pk_bf16(v.z, v.w); *(v2u*)p = o; }
__device__ __forceinline__ void st_bf8(bf16* p, f32x4 a, f32x4 b) { v4u o; o.x = cvt_pk_bf16(a.x, a.y); o.y = cvt_pk_bf16(a.z, a.w); o.z = cvt_pk_bf16(b.x, b.y); o.w = cvt_pk_bf16(b.z, b.w); *(v4u*)p = o; }

struct EpiQKP {
    static constexpr bool PERM = false;
    bf16* Q; bf16* Kb; bf16* P; const f32x2* rope;
    __device__ __forceinline__ void operator()(EPI_ARGS) const {
        const int sect = u.pn >> 2, cb = (u.pn & 3) * 256; const bool latent = u.pm < TL / 256;
#pragma unroll
        for (int ai = 0; ai < 2; ++ai)
#pragma unroll
            for (int m = 0; m < 4; ++m) {
                const int r = u.pm * 256 + ai * 128 + wr * 64 + m * 16 + fr;
                int b, t; if (latent) { b = r / SEQ; t = r % SEQ; } else { b = (r - TL) / CTX; t = (r - TL) % CTX; }
                f32x4 cs0 = {1.f, 0.f, 1.f, 0.f}, cs1 = cs0;
                if (latent && sect < 2) { const int pos = (wc & 1) ? (t & 63) : (t >> 6); const f32x4* rp = (const f32x4*)(rope + pos * 16 + 4 * fq); cs0 = rp[0]; cs1 = rp[1]; }
#pragma unroll
                for (int bj = 0; bj < 2; ++bj) {
                    const int c0 = cb + bj * 128 + wc * 32 + 4 * fq;
                    f32x4 a = acc[ai][bj][m][0], bb = acc[ai][bj][m][1];
                    if (sect < 2) {
                        const f32x4 co = {cs0.x, cs0.z, cs1.x, cs1.z}, si = {cs0.y, cs0.w, cs1.y, cs1.w};
                        const f32x4 oa = a * co - bb * si, ob = a * si + bb * co; a = oa; bb = ob;
                    }
                    if (sect == 0) { a = a * QSCALE; bb = bb * QSCALE; bf16* d = Q + (size_t)r * 1024 + c0; st_bf4(d, a); st_bf4(d + 16, bb); }
                    else if (sect == 1) { const size_t kr = (size_t)b * KEYS + (latent ? CTX + t : t); bf16* d = Kb + kr * 1024 + c0; st_bf4(d, a); st_bf4(d + 16, bb); }
                    else { bf16* d = P + (size_t)r * 1024 + c0; st_bf4(d, a); st_bf4(d + 16, bb); }
                }
            }
    }
};
struct EpiVT {
    static constexpr bool PERM = false;
    bf16* VT;
    __device__ __forceinline__ void operator()(EPI_ARGS) const {
        const bool latent = u.pn < TL / 256; const int b = latent ? u.pn / 32 : u.pn - TL / 256; const int key_t0 = latent ? CTX + (u.pn % 32) * 256 : 0;
        const int kperm = 8 * (fq & 1) + 4 * (fq >> 1);
#pragma unroll
        for (int ai = 0; ai < 2; ++ai)
#pragma unroll
            for (int m = 0; m < 4; ++m) {
                const int rr = u.pm * 256 + ai * 128 + wr * 64 + m * 16 + fr;
                bf16* rowp = VT + ((size_t)b * 1024 + rr) * KEYS + key_t0;
#pragma unroll
                for (int bj = 0; bj < 2; ++bj)
#pragma unroll
                    for (int n = 0; n < 2; ++n) st_bf4(rowp + bj * 128 + wc * 32 + 16 * n + kperm, acc[ai][bj][m][n]);
            }
    }
};
struct EpiScaleBf16 {
    static constexpr bool PERM = true;
    bf16* O; int ldo, coff; const float* cscale;
    __device__ __forceinline__ void operator()(EPI_ARGS) const {
#pragma unroll
        for (int bj = 0; bj < 2; ++bj) { const int c = u.pn * 256 + bj * 128 + wc * 32 + 8 * fq; const f32x4 s0 = *(const f32x4*)(cscale + c), s1 = *(const f32x4*)(cscale + c + 4);
#pragma unroll
            for (int ai = 0; ai < 2; ++ai)
#pragma unroll
                for (int m = 0; m < 4; ++m) { const int r = u.pm * 256 + ai * 128 + wr * 64 + m * 16 + fr; st_bf8(O + (size_t)r * ldo + coff + c, acc[ai][bj][m][0] * s0, acc[ai][bj][m][1] * s1); } }
    }
};
struct EpiBf16 {
    static constexpr bool PERM = true;
    bf16* O; int ldo;
    __device__ __forceinline__ void operator()(EPI_ARGS) const {
#pragma unroll
        for (int ai = 0; ai < 2; ++ai)
#pragma unroll
            for (int m = 0; m < 4; ++m) { const int r = u.pm * 256 + ai * 128 + wr * 64 + m * 16 + fr; bf16* rowp = O + (size_t)r * ldo + u.pn * 256 + wc * 32 + 8 * fq;
#pragma unroll
                for (int bj = 0; bj < 2; ++bj) st_bf8(rowp + bj * 128, acc[ai][bj][m][0], acc[ai][bj][m][1]); }
    }
};
struct EpiRes {
    static constexpr bool PERM = false;
    const float* xlat; const float* xctx; float* xout; const float* gate0;
    __device__ __forceinline__ void operator()(EPI_ARGS) const {
        const bool latent = u.pm < TL / 256;
#pragma unroll
        for (int ai = 0; ai < 2; ++ai)
#pragma unroll
            for (int m = 0; m < 4; ++m) { const int r = u.pm * 256 + ai * 128 + wr * 64 + m * 16 + fr; const int ms = latent ? r / SEQ : 2;
                const float* xi = latent ? xlat + (size_t)r * 2048 : xctx + (size_t)(r - TL) * 2048; const float* gp = gate0 + (size_t)ms * 12288;
#pragma unroll
                for (int bj = 0; bj < 2; ++bj)
#pragma unroll
                    for (int n = 0; n < 2; ++n) { const int c = u.pn * 256 + bj * 128 + wc * 32 + 16 * n + 4 * fq;
                        const f32x4 xv = *(const f32x4*)(xi + c), gv = *(const f32x4*)(gp + c); *(f32x4*)(xout + (size_t)r * 2048 + c) = xv + gv * acc[ai][bj][m][n]; } }
    }
};
struct EpiMoeUp {
    static constexpr bool PERM = false;
    bf16* H;
    __device__ __forceinline__ void operator()(EPI_ARGS) const {
#pragma unroll
        for (int ai = 0; ai < 2; ++ai)
#pragma unroll
            for (int m = 0; m < 4; ++m) { const size_t r = (size_t)u.pm * 256 + ai * 128 + wr * 64 + m * 16 + fr;
#pragma unroll
                for (int bj = 0; bj < 2; ++bj) { const int hc = (u.pn * 256 + bj * 128 + wc * 32) / 2 + 4 * fq; const f32x4 a = acc[ai][bj][m][0], b = acc[ai][bj][m][1];
                    const f32x4 h = {siluf_(a.x) * b.x, siluf_(a.y) * b.y, siluf_(a.z) * b.z, siluf_(a.w) * b.w}; st_bf4(H + r * 512 + hc, h); } }
    }
};
struct EpiMoeDown {
    static constexpr bool PERM = true;
    bf16* Y; const int* tokl; const float* gatel; const unsigned* cnt;
    __device__ __forceinline__ void operator()(EPI_ARGS) const {
        const int ce = (int)cnt[u.e];
#pragma unroll
        for (int ai = 0; ai < 2; ++ai)
#pragma unroll
            for (int m = 0; m < 4; ++m) { const int idx = u.idx0 + ai * 128 + wr * 64 + m * 16 + fr;
                if (idx < ce) { const int pair = tokl[(size_t)u.e * LISTCAP + idx]; const float gt = gatel[(size_t)u.e * LISTCAP + idx]; bf16* rowp = Y + (size_t)pair * 2048 + u.pn * 256 + wc * 32 + 8 * fq;
#pragma unroll
                    for (int bj = 0; bj < 2; ++bj) st_bf8(rowp + bj * 128, acc[ai][bj][m][0] * gt, acc[ai][bj][m][1] * gt); } }
    }
};
struct EpiGlu {
    static constexpr bool PERM = true;
    bf16* O; int ldo, coff; const bf16* Gb; const float* bias;
    __device__ __forceinline__ void operator()(EPI_ARGS) const {
#pragma unroll
        for (int ai = 0; ai < 2; ++ai)
#pragma unroll
            for (int m = 0; m < 4; ++m) { const int r = u.pm * 256 + ai * 128 + wr * 64 + m * 16 + fr;
#pragma unroll
                for (int bj = 0; bj < 2; ++bj) { const int c = u.pn * 256 + bj * 128 + wc * 32 + 8 * fq; const f32x4 b0 = *(const f32x4*)(bias + c), b1 = *(const f32x4*)(bias + c + 4); const v4u gw = *(const v4u*)(Gb + (size_t)r * 1024 + c);
                    const f32x4 a0 = acc[ai][bj][m][0] + b0, a1 = acc[ai][bj][m][1] + b1;
                    const f32x4 o0 = {bflo(gw.x) * sigmoidf_(a0.x), bfhi(gw.x) * sigmoidf_(a0.y), bflo(gw.y) * sigmoidf_(a0.z), bfhi(gw.y) * sigmoidf_(a0.w)};
                    const f32x4 o1 = {bflo(gw.z) * sigmoidf_(a1.x), bfhi(gw.z) * sigmoidf_(a1.y), bflo(gw.w) * sigmoidf_(a1.z), bfhi(gw.w) * sigmoidf_(a1.w)};
                    st_bf8(O + (size_t)r * ldo + coff + c, o0, o1); } }
    }
};

struct MoeOrder {
    const LAS int* bstart;
    const unsigned* cnt; const int* tokl; int nN, G, c, nblk; long bstride, eoff; bool up;
    __device__ bool next(int i, pg8::Unit& u) const {
        const long Lx = (long)i * G + c; if (Lx >= (long)nblk * nN) return false;
        const int blk = (int)(Lx / nN); u.pn = (int)(Lx % nN); u.pm = blk;
        const int e = bstart[65 + blk];
        u.e = e; u.idx0 = (blk - bstart[e]) * 256;
        u.aoff = up ? 0 : (long)blk * 256 * 512 * 2;
        u.boff = (long)e * (long)MOE_E_BYTES + eoff + (long)u.pn * bstride;
        return true;
    }
    __device__ int arow(const pg8::Unit& u, int row) const { const int idx = u.idx0 + row; return idx < (int)cnt[u.e] ? (tokl[(size_t)u.e * LISTCAP + idx] >> 1) : TT; }
};

__device__ __forceinline__ void tile_order(int wgid, int nM, int nN, int& pm, int& pn) {
    const int nwg = nM * nN; { const int q = nwg / 8, r = nwg % 8, xcd = wgid % 8, off = wgid / 8; wgid = (xcd < r ? xcd * (q + 1) : r * (q + 1) + (xcd - r) * q) + off; }
    const int nig = 8 * nN, gid = wgid / nig, fm = gid * 8, gsz = (nM - fm) < 8 ? (nM - fm) : 8;
    pm = fm + ((wgid % nig) % gsz); pn = (wgid % nig) / gsz;
}
struct InProj0Order {
    int G, c; long offA1, offB1, offA2, offB2;
    __device__ bool next(int i, pg8::Unit& u) const {
        const int Lx = i * G + c; constexpr int N1 = (TT / 256) * 12, N2 = 4 * (TT / 256); constexpr long TS = 256L * 2048 * 2;
        if (Lx >= N1 + N2) return false;
        u.idx0 = 0;
        if (Lx < N1) { tile_order(Lx, TT / 256, 12, u.pm, u.pn); u.aoff = offA1 + (long)u.pm * TS; u.boff = offB1 + (long)u.pn * TS; u.e = 0; }
        else { tile_order(Lx - N1, 4, TT / 256, u.pm, u.pn); u.aoff = offA2 + (long)u.pm * TS; u.boff = offB2 + (long)u.pn * TS; u.e = 1; }
        return true;
    }
    __device__ int arow(const pg8::Unit&, int) const { return 0; }
};
struct EpiInProj0 {
    static constexpr bool PERM = false;
    EpiQKP e1; EpiVT e2;
    __device__ __forceinline__ void operator()(EPI_ARGS) const { if (u.e == 0) e1(acc, u, wr, wc, fr, fq); else e2(acc, u, wr, wc, fr, fq); }
};

#ifdef ATT_NORARE
#define ATT_RARE(mx) false
#else
#define ATT_RARE(mx) __any(mx > 8.0f)
#endif
__device__ __forceinline__ void attn_phase(Frame& F) {
    const bf16* Q = WSP(bf16, WS_Q); const bf16* Kb = WSP(bf16, WS_K); const bf16* VT = WSP(bf16, WS_VT); bf16* cat = WSP(bf16, WS_CAT);
    LAS unsigned char* lds = F.lds;
    const int lane0 = F.lane;
    float lam;
    { const float* lv = INP(11); float a = lv[lane0] * lv[64 + lane0], b = lv[128 + lane0] * lv[192 + lane0]; a = wave_sum(a); b = wave_sum(b); lam = expf(a) - expf(b) + 0.2f; }
    const float* subg = INP(12);
    const int NU = 1024 + 32;
    const int xcd = F.bid & 7, jcu = F.bid >> 3;
    for (int it = 0;; ++it) {
        int tl_ = F.tid; asm volatile("" : "+v"(tl_));
        const int lane = tl_ & 63, w = __builtin_amdgcn_readfirstlane(tl_ >> 6), sub = w & 1, qw = w >> 1, r32 = lane & 31, hi = lane >> 5;
        int uidx;
        if (F.G == 256) { if (it < 4) uidx = 128 * xcd + it * 32 + jcu; else if (it == 4 && F.bid < 32) uidx = 1024 + F.bid; else break; }
        else { uidx = it * F.G + F.bid; if (uidx >= NU) break; }
        int b, head, q0row, nt; size_t kbase;
        if (uidx < 1024) { const int combo = uidx >> 6, qb = uidx & 63; b = combo >> 3; head = combo & 7; q0row = b * SEQ + qb * 128; nt = KEYS / 64; }
        else { const int v = uidx - 1024; b = v >> 4; head = (v >> 1) & 7; q0row = TL + b * CTX + (v & 1) * 128; nt = CTX / 64; }
        kbase = (size_t)b * KEYS;
        bf16x8 qf[4];
        { const bf16* qp = Q + (size_t)(q0row + qw * 32 + r32) * 1024 + head * 128 + sub * 64 + hi * 8;
#pragma unroll
          for (int ks = 0; ks < 4; ++ks) qf[ks] = *(const bf16x8*)(qp + ks * 16); }
        const char* gsrc[4];
#pragma unroll
        for (int j = 0; j < 4; ++j) { const int pi = w * 4 + j, rr = lane >> 3, pc = lane & 7;
            if (pi < 16) { const int key = (pi & 7) * 8 + rr, c = pc ^ ((key >> 1) & 7); gsrc[j] = (const char*)(Kb + (kbase + key) * 1024 + head * 128 + (pi >> 3) * 64 + c * 8); }
            else { const int dvr = (pi - 16) * 8 + rr, c = pc ^ ((dvr >> 1) & 7); gsrc[j] = (const char*)(VT + ((size_t)(b * 8 + head) * 128 + dvr) * KEYS + c * 8); } }
        const size_t gstep = (w < 4) ? (size_t)65536 * 2 : (size_t)64 * 2;
        const unsigned ldst = (unsigned)w * 4096u;
#define ATT_DMA(t, buf) do { _Pragma("unroll") for (int _j = 0; _j < 4; ++_j) \
            __builtin_amdgcn_global_load_lds((const unsigned*)(gsrc[_j] + (size_t)(t) * gstep), (LAS unsigned*)(lds + (buf) * 32768 + ldst + _j * 1024), 16, 0, 0); } while (0)
        ATT_DMA(0, 0); ATT_DMA(1, 1); ATT_DMA(2, 2);
        asm volatile("s_waitcnt vmcnt(4)" ::: "memory");
        __builtin_amdgcn_s_barrier();
        f32x16 o[4];
#pragma unroll
        for (int d = 0; d < 4; ++d)
#pragma unroll
            for (int r = 0; r < 16; ++r) o[d][r] = 0.f;
        float mref = 0.f, lrow = 0.f;
        f32x16 negm;
#pragma unroll
        for (int r = 0; r < 16; ++r) negm[r] = 0.f;
        const int rdoff = r32 * 128;
        const int swz = (r32 >> 1) & 7;
        f32x16 s0, s1; bf16x8 pf[4];
#define ATT_QK(bufidx) do { const LAS unsigned char* kp_ = lds + (bufidx) * 32768 + sub * 8192; bf16x8 kfa[4], kfb[4]; \
            _Pragma("unroll") for (int ks = 0; ks < 4; ++ks) { const int ch = ((2 * ks + hi) ^ swz) * 16; kfa[ks] = *(const LAS bf16x8*)(kp_ + rdoff + ch); kfb[ks] = *(const LAS bf16x8*)(kp_ + 4096 + rdoff + ch); } \
            s0 = negm; s1 = negm; \
            _Pragma("unroll") for (int ks = 0; ks < 4; ++ks) { s0 = __builtin_amdgcn_mfma_f32_32x32x16_bf16(kfa[ks], qf[ks], s0, 0, 0, 0); s1 = __builtin_amdgcn_mfma_f32_32x32x16_bf16(kfb[ks], qf[ks], s1, 0, 0, 0); } \
            asm volatile("" : "+v"(s0), "+v"(s1) : "v"(kfa[0]), "v"(kfa[1]), "v"(kfa[2]), "v"(kfa[3]), "v"(kfb[0]), "v"(kfb[1]), "v"(kfb[2]), "v"(kfb[3])); } while (0)
#define ATT_MAX(mx) do { float mxa = fmaxf(fmaxf(s0[0], s0[1]), s0[2]), mxb = fmaxf(fmaxf(s1[0], s1[1]), s1[2]); \
            _Pragma("unroll") for (int r = 3; r < 15; r += 2) { mxa = fmaxf(fmaxf(mxa, s0[r]), s0[r + 1]); mxb = fmaxf(fmaxf(mxb, s1[r]), s1[r + 1]); } \
            mx = fmaxf(fmaxf(mxa, mxb), fmaxf(s0[15], s1[15])); mx = fmaxf(mx, __shfl_xor(mx, 32)); } while (0)
#define ATT_FIX(mx) do { const float dl = fmaxf(mx, 0.f); mref += dl; const float alpha = __builtin_amdgcn_exp2f(-dl); lrow *= alpha; \
            _Pragma("unroll") for (int r = 0; r < 16; ++r) { s0[r] -= dl; s1[r] -= dl; negm[r] = -mref; } \
            _Pragma("unroll") for (int d = 0; d < 4; ++d) _Pragma("unroll") for (int r = 0; r < 16; ++r) o[d][r] *= alpha; } while (0)
#define ATT_EXP8(S, base, dst) do { float rs_ = 0.f; _Pragma("unroll") for (int r = 0; r < 8; ++r) { S[base + r] = __builtin_amdgcn_exp2f(S[base + r]); rs_ += S[base + r]; } lrow += rs_; \
            v4u pw_; pw_.x = cvt_pk_bf16(S[base + 0], S[base + 1]); pw_.y = cvt_pk_bf16(S[base + 2], S[base + 3]); pw_.z = cvt_pk_bf16(S[base + 4], S[base + 5]); pw_.w = cvt_pk_bf16(S[base + 6], S[base + 7]); dst = __builtin_bit_cast(bf16x8, pw_); } while (0)
#define ATT_VLD(dstv, vp_, s) do { _Pragma("unroll") for (int d = 0; d < 4; ++d) dstv[d] = *(const LAS bf16x8*)(vp_ + d * 4096 + rdoff + (((2 * (s) + hi) ^ swz) * 16)); } while (0)
#define ATT_PV4(srcv, pfrag) do { _Pragma("unroll") for (int d = 0; d < 4; ++d) o[d] = __builtin_amdgcn_mfma_f32_32x32x16_bf16(srcv[d], pfrag, o[d], 0, 0, 0); } while (0)
        { ATT_QK(0); float mx; ATT_MAX(mx); if (__any(mx > 8.0f)) ATT_FIX(mx);
          ATT_EXP8(s0, 0, pf[0]); ATT_EXP8(s0, 8, pf[1]); ATT_EXP8(s1, 0, pf[2]); ATT_EXP8(s1, 8, pf[3]); }
        int bcur = 0;
#pragma nounroll
        for (int t = 0; t < nt; ++t) {
            const int bn1 = (bcur + 1) & 3, bn3 = (bcur + 3) & 3;
            if (t + 3 < nt) ATT_DMA(t + 3, bn3);
            const LAS unsigned char* vp = lds + bcur * 32768 + 16384;
            bf16x8 vfa[4], vfb[4];
            if (t + 1 < nt) {
                __builtin_amdgcn_sched_barrier(0);
                ATT_QK(bn1);
                float mx; ATT_MAX(mx);
                __builtin_amdgcn_sched_barrier(0);
                if (__any(mx > 8.0f)) {
                    const float dl = fmaxf(mx, 0.f); mref += dl; const float alpha = __builtin_amdgcn_exp2f(-dl); lrow *= alpha;
#pragma unroll
                    for (int r = 0; r < 16; ++r) { s0[r] -= dl; s1[r] -= dl; negm[r] = -mref; }
#pragma unroll
                    for (int d = 0; d < 4; ++d)
#pragma unroll
                        for (int r = 0; r < 16; ++r) o[d][r] *= alpha;
#pragma unroll
                    for (int s = 0; s < 4; ++s) { v4u pw = __builtin_bit_cast(v4u, pf[s]);
                        pw.x = cvt_pk_bf16(bflo(pw.x) * alpha, bfhi(pw.x) * alpha); pw.y = cvt_pk_bf16(bflo(pw.y) * alpha, bfhi(pw.y) * alpha);
                        pw.z = cvt_pk_bf16(bflo(pw.z) * alpha, bfhi(pw.z) * alpha); pw.w = cvt_pk_bf16(bflo(pw.w) * alpha, bfhi(pw.w) * alpha); pf[s] = __builtin_bit_cast(bf16x8, pw); }
                }
                __builtin_amdgcn_sched_barrier(0);
                {
                    ATT_VLD(vfa, vp, 0);
                    __builtin_amdgcn_sched_barrier(0);
                    ATT_VLD(vfb, vp, 1); ATT_PV4(vfa, pf[0]); ATT_EXP8(s0, 0, pf[0]);
                    __builtin_amdgcn_sched_barrier(0);
                    ATT_VLD(vfa, vp, 2); ATT_PV4(vfb, pf[1]); ATT_EXP8(s0, 8, pf[1]);
                    __builtin_amdgcn_sched_barrier(0);
                    ATT_VLD(vfb, vp, 3); ATT_PV4(vfa, pf[2]); ATT_EXP8(s1, 0, pf[2]);
                    __builtin_amdgcn_sched_barrier(0);
                    ATT_PV4(vfb, pf[3]); ATT_EXP8(s1, 8, pf[3]);
                }
                __builtin_amdgcn_sched_barrier(0);
            } else {
#pragma unroll
                for (int s = 0; s < 4; ++s) { ATT_VLD(vfa, vp, s); ATT_PV4(vfa, pf[s]); }
            }
            if (t + 3 < nt) asm volatile("s_waitcnt vmcnt(4) lgkmcnt(0)" ::: "memory"); else asm volatile("s_waitcnt vmcnt(0) lgkmcnt(0)" ::: "memory");
            __builtin_amdgcn_s_barrier();
            bcur = bn1;
        }
#undef ATT_DMA
#undef ATT_QK
#undef ATT_MAX
#undef ATT_FIX
#undef ATT_EXP8
#undef ATT_VLD
#undef ATT_PV4
        const float ltot = lrow + __shfl_xor(lrow, 32); const float linv = 1.0f / ltot;
        LAS float* xch = (LAS float*)lds + (size_t)(qw * 32 + r32) * 132;
        if (sub == 1) {
#pragma unroll
            for (int d = 0; d < 4; ++d)
#pragma unroll
                for (int g = 0; g < 4; ++g) *(LAS f32x4*)(xch + 32 * d + 8 * g + 4 * hi) = (f32x4){o[d][4 * g] * linv, o[d][4 * g + 1] * linv, o[d][4 * g + 2] * linv, o[d][4 * g + 3] * linv};
        }
        __syncthreads();
        if (sub == 0) {
            float ss = 0.f;
#pragma unroll
            for (int d = 0; d < 4; ++d)
#pragma unroll
                for (int g = 0; g < 4; ++g) { const f32x4 o2 = *(const LAS f32x4*)(xch + 32 * d + 8 * g + 4 * hi);
#pragma unroll
                    for (int j = 0; j < 4; ++j) { const float v = o[d][4 * g + j] * linv - lam * o2[j]; o[d][4 * g + j] = v; ss += v * v; } }
            ss += __shfl_xor(ss, 32);
            const float rn = 0.8f / sqrtf(ss * (1.0f / 128.0f) + EPS);
            bf16* op = cat + (size_t)(q0row + qw * 32 + r32) * 2048 + head * 128;
#pragma unroll
            for (int d = 0; d < 4; ++d)
#pragma unroll
                for (int g = 0; g < 4; ++g) { const int dv = 32 * d + 8 * g + 4 * hi; const f32x4 gg = *(const f32x4*)(subg + dv);
                    st_bf4(op + dv, (f32x4){o[d][4 * g] * rn * gg.x, o[d][4 * g + 1] * rn * gg.y, o[d][4 * g + 2] * rn * gg.z, o[d][4 * g + 3] * rn * gg.w}); }
        }
        __syncthreads();
    }
}

__device__ __forceinline__ void poold_phase(Frame& F) {
    const bf16* P = WSP(bf16, WS_P); bf16* PD = WSP(bf16, WS_PD);
    const int gt = F.bid * NTHREADS + F.tid, NGT = F.G * NTHREADS;
    for (int idx = gt; idx < TT * 128; idx += NGT) {
        const int r = idx >> 7, cc = (idx & 127) * 8, g = cc >> 8, wdw = 2 << g;
        int sb, t, Ls; if (r < TL) { sb = (r / SEQ) * SEQ; t = r % SEQ; Ls = SEQ; } else { sb = TL + ((r - TL) / CTX) * CTX; t = (r - TL) % CTX; Ls = CTX; }
        int lo = t - wdw / 2, hi = lo + wdw; lo = lo < 0 ? 0 : lo; hi = hi > Ls ? Ls : hi;
        float a[8];
#pragma unroll
        for (int j = 0; j < 8; ++j) a[j] = 0.f;
        for (int s = lo; s < hi; ++s) { const v4u v = *(const v4u*)(P + (size_t)(sb + s) * 1024 + cc);
            a[0] += bflo(v.x); a[1] += bfhi(v.x); a[2] += bflo(v.y); a[3] += bfhi(v.y); a[4] += bflo(v.z); a[5] += bfhi(v.z); a[6] += bflo(v.w); a[7] += bfhi(v.w); }
        const float inv = 1.0f / (float)(hi - lo);
        const v4u me = *(const v4u*)(P + (size_t)r * 1024 + cc);
        v4u o; o.x = pk2(a[0] * inv - bflo(me.x), a[1] * inv - bfhi(me.x)); o.y = pk2(a[2] * inv - bflo(me.y), a[3] * inv - bfhi(me.y));
        o.z = pk2(a[4] * inv - bflo(me.z), a[5] * inv - bfhi(me.z)); o.w = pk2(a[6] * inv - bflo(me.w), a[7] * inv - bfhi(me.w));
        *(v4u*)(PD + (size_t)r * 1024 + cc) = o;
    }
}

__device__ __forceinline__ void shortconv_phase(Frame& F) {
    const bf16* PJ = WSP(bf16, WS_PROJ1); float* GT = WSP(float, WS_GT);
    const float* cw = INP(17); const float* cb = INP(18);
    LAS float* scr = (LAS float*)(F.lds + F.wave * 17408);
    const int lane = F.lane;
    for (int it = F.gw; it < 2 * 128 * 48; it += F.NGW) {
        const int cbk = it % 48, tb = (it / 48) % 128, b = it / (48 * 128), col = cbk * 64 + lane, t0 = tb * 64;
        const bf16* base = PJ + ((size_t)b * SEQ) * 4096 + cbk * 64 + (lane & 7) * 8;
#pragma unroll
        for (int i = 0; i < 9; ++i) { const int row = 8 * i + (lane >> 3); const int t = t0 - 1 + row;
            if (row < 66) { v4u v = {0u, 0u, 0u, 0u}; if (t >= 0 && t < SEQ) v = *(const v4u*)(base + (size_t)t * 4096);
                LAS float* d = scr + row * 65 + (lane & 7) * 8; d[0] = bflo(v.x); d[1] = bfhi(v.x); d[2] = bflo(v.y); d[3] = bfhi(v.y); d[4] = bflo(v.z); d[5] = bfhi(v.z); d[6] = bflo(v.w); d[7] = bfhi(v.w); } }
        LDS_WAIT(); asm volatile("" ::: "memory");
        const float w0 = cw[col], w1 = cw[3072 + col], w2 = cw[2 * 3072 + col], bias = cb[col];
        float prev = scr[lane], cur = scr[65 + lane];
#pragma unroll 8
        for (int tt = 0; tt < 64; ++tt) { const float nxt = scr[(tt + 2) * 65 + lane]; const float o = prev * w0 + cur * w1 + nxt * w2 + bias; scr[tt * 65 + lane] = o; prev = cur; cur = nxt; }
        LDS_WAIT(); asm volatile("" ::: "memory");
        for (int c = 0; c < 64; ++c) GT[((size_t)(cbk * 64 + c) * 2 + b) * SEQ + t0 + lane] = scr[lane * 65 + c];
        LDS_WAIT(); asm volatile("" ::: "memory");
    }
}

__device__ __forceinline__ void s5_scan_phase(Frame& F) {
    const bf16* PJ = WSP(bf16, WS_PROJ1); float* YD = WSP(float, WS_YD);
    const f32x2* lamb = WSP(f32x2, WS_S5LAM); const f32x2* bbar = WSP(f32x2, WS_S5B);
    const float* cre = INP(31); const float* cim = INP(32);
    const int lane = F.lane;
    for (int task = F.wave * F.G + F.bid; task < 256; task += F.NGW) {
        const int di = task >> 7, b = (task >> 6) & 1, g = task & 63;
        const int dgp = (di * 64 + g) * 64 + lane;
        const f32x2 lam = lamb[dgp];
        float br[16], bi[16], cr[16], ci[16];
#pragma unroll
        for (int c = 0; c < 16; ++c) { const f32x2 bv = bbar[(size_t)dgp * 16 + c]; br[c] = bv.x; bi[c] = bv.y;
            cr[c] = cre[((size_t)(di * 64 + g) * 16 + c) * 64 + lane]; ci[c] = cim[((size_t)(di * 64 + g) * 16 + c) * 64 + lane]; }
        float sr = 0.f, si = 0.f;
        const int nsteps = CTX + SEQ;
        for (int st = 0; st < nsteps; st += 4) {
            const int stl = st + (lane >> 4);
            int row;
            if (stl < CTX) row = TL + b * CTX + (di == 0 ? stl : CTX - 1 - stl);
            else row = b * SEQ + (di == 0 ? stl - CTX : SEQ - 1 - (stl - CTX));
            const float uval = bf2f(PJ[(size_t)row * 4096 + 3072 + g * 16 + (lane & 15)]);
#pragma unroll
            for (int k = 0; k < 4; ++k) {
                float bur = 0.f, bui = 0.f;
#pragma unroll
                for (int c = 0; c < 16; ++c) { const float u = __builtin_bit_cast(float, __builtin_amdgcn_readlane(__builtin_bit_cast(int, uval), 16 * k + c)); bur += br[c] * u; bui += bi[c] * u; }
                const float nr = lam.x * sr - lam.y * si + bur, ni = lam.x * si + lam.y * sr + bui; sr = nr; si = ni;
                const int s2 = st + k;
                if (s2 >= CTX) {
                    const int t = (di == 0) ? s2 - CTX : SEQ - 1 - (s2 - CTX);
                    float outv = 0.f;
#pragma unroll
                    for (int c = 0; c < 16; ++c) { float v = cr[c] * sr - ci[c] * si; v = wave_sum(v); if (lane == c) outv = v; }
                    if (lane < 16) YD[((size_t)di * TL + (size_t)b * SEQ + t) * 1024 + g * 16 + lane] = outv;
                }
            }
        }
    }
}

__device__ __forceinline__ void hyena_naive_phase(Frame& F) {
    const float* GT = WSP(float, WS_GT); const float* kT = WSP(float, WS_KT); const float* invn = WSP(float, WS_INVN); bf16* cat = WSP(bf16, WS_CAT);
    const float* hyb = INP(25);
    LAS float* kf = (LAS float*)F.lds;
    LAS f32x2* ub = (LAS f32x2*)(F.lds + 65536);
    const int tid = F.tid;
    for (int ch = F.bid; ch < 1024; ch += F.G) {
        float res0[16], res1[16];
        for (int o = 0; o < 2; ++o) {
            const float inv = invn[o * 1024 + ch];
            const float* kfw = kT + (size_t)(o * 2048 + ch) * SEQ; const float* kbw = kT + (size_t)(o * 2048 + 1024 + ch) * SEQ;
            for (int n = tid; n < 16384; n += NTHREADS) { float v; if (n < SEQ) v = kfw[n]; else if (n == SEQ) v = 0.f; else v = kbw[16384 - n]; kf[n] = v * inv; }
            if (o == 0) { const float* v0 = GT + ((size_t)(0 * 1024 + ch) * 2) * SEQ; for (int n = tid; n < SEQ; n += NTHREADS) ub[n] = (f32x2){v0[n], v0[SEQ + n]}; }
            else {
#pragma unroll
                for (int j = 0; j < 16; ++j) ub[tid + NTHREADS * j] = (f32x2){res0[j], res1[j]}; }
            __syncthreads();
            float a0[16], a1[16];
#pragma unroll
            for (int j = 0; j < 16; ++j) { a0[j] = 0.f; a1[j] = 0.f; }
            for (int s = 0; s < SEQ; ++s) { const f32x2 u = ub[s];
#pragma unroll
                for (int j = 0; j < 16; ++j) { const float kk = kf[(tid + NTHREADS * j - s) & 16383]; a0[j] += u.x * kk; a1[j] += u.y * kk; } }
            const float bias = hyb[o * 1024 + ch];
            const float* xg = GT + ((size_t)((o + 1) * 1024 + ch) * 2) * SEQ;
#pragma unroll
            for (int j = 0; j < 16; ++j) { const int t = tid + NTHREADS * j; const f32x2 u = ub[t];
                res0[j] = xg[t] * (a0[j] + bias * u.x); res1[j] = xg[SEQ + t] * (a1[j] + bias * u.y); }
            __syncthreads();
        }
#pragma unroll
        for (int j = 0; j < 16; ++j) { const int t = tid + NTHREADS * j;
            cat[(size_t)t * 2048 + ch] = (bf16)f2bf(res0[j]); cat[((size_t)SEQ + t) * 2048 + ch] = (bf16)f2bf(res1[j]); }
    }
}

__device__ __forceinline__ void s5_gelu_phase(Frame& F) {
    const bf16* PJ = WSP(bf16, WS_PROJ1); const float* YD = WSP(float, WS_YD); bf16* Gb = WSP(bf16, WS_PD); const float* dd = INP(33);
    const int gt = F.bid * NTHREADS + F.tid, NGT = F.G * NTHREADS;
    for (int idx = gt; idx < TL * 256; idx += NGT) { const int r = idx >> 8, c = (idx & 255) * 4;
        const v2u uw = *(const v2u*)(PJ + (size_t)r * 4096 + 3072 + c); const f32x4 d4 = *(const f32x4*)(dd + c);
        const int bb = r / SEQ, tt = r % SEQ, gg = c >> 4, cc = c & 15;
        const f32x4 y0 = *(const f32x4*)(YD + (((size_t)(0 * 2 + bb) * 64 + gg) * SEQ + tt) * 16 + cc), y1 = *(const f32x4*)(YD + (((size_t)(1 * 2 + bb) * 64 + gg) * SEQ + tt) * 16 + cc);
        const f32x4 y = {bflo(uw.x) * d4.x + y0.x + y1.x, bfhi(uw.x) * d4.y + y0.y + y1.y, bflo(uw.y) * d4.z + y0.z + y1.z, bfhi(uw.y) * d4.w + y0.w + y1.w};
        st_bf4(Gb + (size_t)r * 1024 + c, (f32x4){gelu_tanh(y.x), gelu_tanh(y.y), gelu_tanh(y.z), gelu_tanh(y.w)}); }
}

__device__ __forceinline__ f32x2 cmulf(f32x2 a, f32x2 b) { return (f32x2){a.x * b.x - a.y * b.y, a.x * b.y + a.y * b.x}; }
__device__ __forceinline__ int drev14(int p) { const unsigned r = __builtin_bitreverse32((unsigned)p) >> 18; return (int)(((r & 0x2AAAu) >> 1) | ((r & 0x1555u) << 1)); }
template <int L, bool ZHI>
__device__ __forceinline__ void fft_fwd_pass(LAS f32x2* X, const f32x2* tw, int tid) {
    constexpr int tws = 4096 / L;
    if constexpr (L == 1) {
#pragma unroll 2
        for (int i = 0; i < 8; ++i) { const int i0 = (tid + NTHREADS * i) * 4;
            const f32x4 p01 = *(const LAS f32x4*)(X + i0), p23 = *(const LAS f32x4*)(X + i0 + 2);
            const f32x2 x0 = {p01.x, p01.y}, x1 = {p01.z, p01.w}, x2 = {p23.x, p23.y}, x3 = {p23.z, p23.w};
            const f32x2 a = x0 + x2, bb = x0 - x2, c = x1 + x3, d = x1 - x3;
            const f32x2 y0 = a + c, y1 = {bb.x + d.y, bb.y - d.x}, y2 = a - c, y3 = {bb.x - d.y, bb.y + d.x};
            *(LAS f32x4*)(X + i0) = (f32x4){y0.x, y0.y, y1.x, y1.y}; *(LAS f32x4*)(X + i0 + 2) = (f32x4){y2.x, y2.y, y3.x, y3.y}; }
        __syncthreads();
        return;
    }
#pragma unroll 2
    for (int i = 0; i < 8; ++i) {
        const int b = tid + NTHREADS * i, j = b & (L - 1), i0 = (b - j) * 4 + j;
        const f32x2 w1 = tw[j * tws], w2 = cmulf(w1, w1), w3 = cmulf(w2, w1);
        const f32x2 x0 = X[i0], x1 = X[i0 + L];
        if (ZHI) {
            const f32x2 t1 = {x0.x + x1.y, x0.y - x1.x}, t3 = {x0.x - x1.y, x0.y + x1.x};
            X[i0] = x0 + x1; X[i0 + L] = cmulf(t1, w1); X[i0 + 2 * L] = cmulf(x0 - x1, w2); X[i0 + 3 * L] = cmulf(t3, w3);
        } else {
            const f32x2 x2 = X[i0 + 2 * L], x3 = X[i0 + 3 * L];
            const f32x2 a = x0 + x2, bb = x0 - x2, c = x1 + x3, d = x1 - x3;
            const f32x2 t1 = {bb.x + d.y, bb.y - d.x}, t3 = {bb.x - d.y, bb.y + d.x};
            X[i0] = a + c; X[i0 + L] = cmulf(t1, w1); X[i0 + 2 * L] = cmulf(a - c, w2); X[i0 + 3 * L] = cmulf(t3, w3);
        }
    }
    __syncthreads();
}
template <bool ZHI>
__device__ __forceinline__ void fft_fwd(LAS f32x2* X, const f32x2* tw, int tid) {
    fft_fwd_pass<4096, ZHI>(X, tw, tid); fft_fwd_pass<1024, false>(X, tw, tid); fft_fwd_pass<256, false>(X, tw, tid); fft_fwd_pass<64, false>(X, tw, tid);
    fft_fwd_pass<16, false>(X, tw, tid); fft_fwd_pass<4, false>(X, tw, tid); fft_fwd_pass<1, false>(X, tw, tid);
}
template <int L, bool LOHALF>
__device__ __forceinline__ void fft_inv_pass(LAS f32x2* X, const f32x2* tw, int tid) {
    constexpr int tws = 4096 / L;
    if constexpr (L == 1) {
#pragma unroll 2
        for (int i = 0; i < 8; ++i) { const int i0 = (tid + NTHREADS * i) * 4;
            const f32x4 p01 = *(const LAS f32x4*)(X + i0), p23 = *(const LAS f32x4*)(X + i0 + 2);
            const f32x2 x0 = {p01.x, p01.y}, x1 = {p01.z, p01.w}, x2 = {p23.x, p23.y}, x3 = {p23.z, p23.w};
            const f32x2 a = x0 + x2, bb = x0 - x2, c = x1 + x3, d = x1 - x3;
            const f32x2 y0 = a + c, y1 = {bb.x - d.y, bb.y + d.x}, y2 = a - c, y3 = {bb.x + d.y, bb.y - d.x};
            *(LAS f32x4*)(X + i0) = (f32x4){y0.x, y0.y, y1.x, y1.y}; *(LAS f32x4*)(X + i0 + 2) = (f32x4){y2.x, y2.y, y3.x, y3.y}; }
        __syncthreads();
        return;
    }
#pragma unroll 2
    for (int i = 0; i < 8; ++i) {
        const int b = tid + NTHREADS * i, j = b & (L - 1), i0 = (b - j) * 4 + j;
        f32x2 w1 = tw[j * tws]; w1.y = -w1.y; const f32x2 w2 = cmulf(w1, w1), w3 = cmulf(w2, w1);
        const f32x2 x0 = X[i0], x1 = cmulf(X[i0 + L], w1), x2 = cmulf(X[i0 + 2 * L], w2), x3 = cmulf(X[i0 + 3 * L], w3);
        const f32x2 a = x0 + x2, bb = x0 - x2, c = x1 + x3, d = x1 - x3;
        X[i0] = a + c; X[i0 + L] = (f32x2){bb.x - d.y, bb.y + d.x};
        if (!LOHALF) { X[i0 + 2 * L] = a - c; X[i0 + 3 * L] = (f32x2){bb.x + d.y, bb.y - d.x}; }
    }
    __syncthreads();
}
__device__ __forceinline__ void fft_inv(LAS f32x2* X, const f32x2* tw, int tid) {
    fft_inv_pass<1, false>(X, tw, tid); fft_inv_pass<4, false>(X, tw, tid); fft_inv_pass<16, false>(X, tw, tid); fft_inv_pass<64, false>(X, tw, tid);
    fft_inv_pass<256, false>(X, tw, tid); fft_inv_pass<1024, false>(X, tw, tid); fft_inv_pass<4096, true>(X, tw, tid);
}
__device__ __forceinline__ void fft_pointwise(LAS f32x2* X, const f32x2* Wg, int o, float scale, int tid) {
    const float hs = 0.5f * scale;
#pragma unroll 4
    for (int i = 0; i < 32; ++i) {
        const int p = tid + NTHREADS * i, f = drev14(p), pm = drev14((16384 - f) & 16383);
        const unsigned long long ua = __hip_atomic_load((const unsigned long long*)(Wg + p), __ATOMIC_RELAXED, __HIP_MEMORY_SCOPE_AGENT);
        const unsigned long long ub = __hip_atomic_load((const unsigned long long*)(Wg + pm), __ATOMIC_RELAXED, __HIP_MEMORY_SCOPE_AGENT);
        const f32x2 A = __builtin_bit_cast(f32x2, ua), B = __builtin_bit_cast(f32x2, ub);
        f32x2 K;
        if (o == 0) K = (f32x2){(A.x + B.x) * hs, (A.y - B.y) * hs};
        else { const f32x2 dd = {A.x - B.x, A.y + B.y}; K = (f32x2){dd.y * hs, -dd.x * hs}; }
        X[p] = cmulf(X[p], K);
    }
    __syncthreads();
}
__device__ __forceinline__ void hyena_fft_phase(Frame& F) {
    float* GT = WSP(float, WS_GT); const float* kT = WSP(float, WS_KT); const float* invn = WSP(float, WS_INVN); const f32x2* tw = WSP(f32x2, WS_TW);
    f32x2* Wg = WSP(f32x2, WS_FFTW) + (size_t)F.bid * 16384;
    const float* hyb = INP(25);
    LAS f32x2* X = (LAS f32x2*)F.lds;
    const int tid = F.tid;
    for (int ch = F.bid; ch < 1024; ch += F.G) {
        { const float* f0 = kT + (size_t)ch * SEQ; const float* b0 = kT + (size_t)(1024 + ch) * SEQ; const float* f1 = kT + (size_t)(2048 + ch) * SEQ; const float* b1 = kT + (size_t)(3072 + ch) * SEQ;
          for (int n = tid; n < SEQ; n += NTHREADS) { X[n] = (f32x2){f0[n], f1[n]}; X[SEQ + n] = (n == 0) ? (f32x2){0.f, 0.f} : (f32x2){b0[SEQ - n], b1[SEQ - n]}; } }
        __syncthreads();
        fft_fwd<false>(X, tw, tid);
        for (int n = tid; n < 16384; n += NTHREADS) Wg[n] = X[n];
        __syncthreads();
        const float* v0 = GT + ((size_t)ch * 2) * SEQ; float* yo = WSP(float, WS_YHT) + ((size_t)ch * 2) * SEQ;
        const float* x1 = GT + ((size_t)(1024 + ch) * 2) * SEQ; const float* x2 = GT + ((size_t)(2048 + ch) * 2) * SEQ;
        float z0[16], z1[16];
#pragma unroll
        for (int j = 0; j < 16; ++j) { const int n = tid + NTHREADS * j; z0[j] = v0[n]; z1[j] = v0[SEQ + n]; }
#pragma unroll
        for (int o = 0; o < 2; ++o) {
#pragma unroll
            for (int j = 0; j < 16; ++j) { const int n = tid + NTHREADS * j; X[n] = (f32x2){z0[j], z1[j]}; }
            __syncthreads();
            fft_fwd<true>(X, tw, tid);
            fft_pointwise(X, Wg, o, invn[o * 1024 + ch] * (1.0f / 16384.0f), tid);
            fft_inv(X, tw, tid);
            const float bias = hyb[o * 1024 + ch]; const float* xg = (o == 0) ? x1 : x2;
#pragma unroll
            for (int j = 0; j < 16; ++j) { const int n = tid + NTHREADS * j; const f32x2 y = X[n]; z0[j] = xg[n] * (y.x + bias * z0[j]); z1[j] = xg[SEQ + n] * (y.y + bias * z1[j]); }
            __syncthreads();
        }
#pragma unroll
        for (int j = 0; j < 16; ++j) { const int n = tid + NTHREADS * j; yo[n] = z0[j]; yo[SEQ + n] = z1[j]; }
    }
}
__device__ __forceinline__ void hyena_out_transpose(Frame& F) {
    const float* GT = WSP(float, WS_YHT); bf16* cat = WSP(bf16, WS_CAT);
    LAS float* scr = (LAS float*)(F.lds + F.wave * 17408);
    const int lane = F.lane;
    for (int it = F.gw; it < 2 * 128 * 16; it += F.NGW) {
        const int cbk = it & 15, tb = (it >> 4) & 127, b = it >> 11, t0 = tb * 64;
        for (int c = 0; c < 64; ++c) scr[c * 65 + lane] = GT[((size_t)(cbk * 64 + c) * 2 + b) * SEQ + t0 + lane];
        LDS_WAIT(); asm volatile("" ::: "memory");
#pragma unroll
        for (int i = 0; i < 8; ++i) { const int tt = 8 * i + (lane >> 3), c0 = (lane & 7) * 8; const LAS float* s = scr + c0 * 65 + tt;
            v4u o; o.x = cvt_pk_bf16(s[0], s[65]); o.y = cvt_pk_bf16(s[130], s[195]); o.z = cvt_pk_bf16(s[260], s[325]); o.w = cvt_pk_bf16(s[390], s[455]);
            *(v4u*)(cat + ((size_t)b * SEQ + t0 + tt) * 2048 + cbk * 64 + c0) = o; }
        LDS_WAIT(); asm volatile("" ::: "memory");
    }
}

__device__ __forceinline__ int s5_row(int di, int b, int s) {
    return (s < CTX) ? TL + b * CTX + (di == 0 ? s : CTX - 1 - s) : b * SEQ + (di == 0 ? s - CTX : SEQ - 1 - (s - CTX));
}
template <bool OUTPUT>
__device__ __forceinline__ void s5_seg_phase(Frame& F) {
    const bf16* PJ = WSP(bf16, WS_PROJ1); float* YD = WSP(float, WS_YD);
    const f32x2* lamb = WSP(f32x2, WS_S5LAM); const f32x2* bbar = WSP(f32x2, WS_S5B); const f32x2* l256 = WSP(f32x2, WS_S5L256); f32x2* Eb = WSP(f32x2, WS_S5E);
    const float* cre = INP(31); const float* cim = INP(32);
    const int lane = F.lane;
    for (int task = F.wave * F.G + F.bid; task < 256 * 32; task += F.NGW) {
        const int dbg = task >> 5, seg = (task & 31) + (OUTPUT ? 1 : 0);
        const int di = dbg >> 7, b = (dbg >> 6) & 1, g = dbg & 63;
        const int dgp = (di * 64 + g) * 64 + lane;
        const f32x2 lam = lamb[dgp];
        float br[16], bi[16];
#pragma unroll
        for (int c = 0; c < 16; ++c) { const f32x2 bv = bbar[(size_t)dgp * 16 + c]; br[c] = bv.x; bi[c] = bv.y; }
        float cr[16], ci[16];
        if (OUTPUT) {
#pragma unroll
            for (int c = 0; c < 16; ++c) { cr[c] = cre[((size_t)(di * 64 + g) * 16 + c) * 64 + lane]; ci[c] = cim[((size_t)(di * 64 + g) * 16 + c) * 64 + lane]; }
        }
        float sr = 0.f, si = 0.f;
        if (OUTPUT) {
            const f32x2 l2 = l256[dgp]; const f32x2* ep = Eb + ((size_t)dbg * 32) * 64 + lane;
            for (int k = 0; k < seg; ++k) { const f32x2 e = ep[(size_t)k * 64]; const float nr = l2.x * sr - l2.y * si + e.x, ni = l2.x * si + l2.y * sr + e.y; sr = nr; si = ni; }
        }
        const int s0 = seg * 256;
#pragma nounroll
        for (int st = 0; st < 256; st += 4) {
            const int row = s5_row(di, b, s0 + st + (lane >> 4));
            const float uval = bf2f(PJ[(size_t)row * 4096 + 3072 + g * 16 + (lane & 15)]);
#pragma unroll
            for (int k = 0; k < 4; ++k) {
                float bur = 0.f, bui = 0.f;
#pragma unroll
                for (int c = 0; c < 16; ++c) { const float u = __builtin_bit_cast(float, __builtin_amdgcn_readlane(__builtin_bit_cast(int, uval), 16 * k + c)); bur += br[c] * u; bui += bi[c] * u; }
                const float nr = lam.x * sr - lam.y * si + bur, ni = lam.x * si + lam.y * sr + bui; sr = nr; si = ni;
                if (OUTPUT) {
                    float v8[8], v4[4], v2[2], v1;
                    const bool b5 = (lane & 32) != 0, b4 = (lane & 16) != 0, b3 = (lane & 8) != 0, b2 = (lane & 4) != 0;
#pragma unroll
                    for (int i = 0; i < 8; ++i) { const float lo = cr[i] * sr - ci[i] * si, hi = cr[i + 8] * sr - ci[i + 8] * si; const float keep = b5 ? hi : lo, send = b5 ? lo : hi; v8[i] = keep + __shfl_xor(send, 32); }
#pragma unroll
                    for (int i = 0; i < 4; ++i) { const float keep = b4 ? v8[i + 4] : v8[i], send = b4 ? v8[i] : v8[i + 4]; v4[i] = keep + __shfl_xor(send, 16); }
#pragma unroll
                    for (int i = 0; i < 2; ++i) { const float keep = b3 ? v4[i + 2] : v4[i], send = b3 ? v4[i] : v4[i + 2]; v2[i] = keep + __shfl_xor(send, 8); }
                    { const float keep = b2 ? v2[1] : v2[0], send = b2 ? v2[0] : v2[1]; v1 = keep + __shfl_xor(send, 4); }
                    v1 += __shfl_xor(v1, 2); v1 += __shfl_xor(v1, 1);
                    const int s = s0 + st + k, t = (di == 0) ? s - CTX : SEQ - 1 - (s - CTX);
                    if ((lane & 3) == 0) YD[((size_t)di * TL + (size_t)b * SEQ + t) * 1024 + g * 16 + (lane >> 2)] = v1;
                }
            }
        }
        if (!OUTPUT) Eb[((size_t)dbg * 32 + seg) * 64 + lane] = (f32x2){sr, si};
    }
}

typedef float f32x4_t __attribute__((ext_vector_type(4)));
template <bool OUTPUT>
__device__ __forceinline__ void s5_mfma_phase(Frame& F) {
    const bf16* PJ = WSP(bf16, WS_PROJ1); float* YD = WSP(float, WS_YD);
    const f32x2* lamb = WSP(f32x2, WS_S5LAM); const f32x2* bbar = WSP(f32x2, WS_S5B); const f32x2* l256 = WSP(f32x2, WS_S5L256); f32x2* Eb = WSP(f32x2, WS_S5E);
    const float* cre = INP(31); const float* cim = INP(32);
    const int lane = F.lane, fr = lane & 15, fq = lane >> 4;
    LAS unsigned* Xl = (LAS unsigned*)(F.lds + F.wave * 4608);
    for (int task = F.wave * F.G + F.bid; task < 256 * 32; task += F.NGW) {
        const int dbg = task >> 5, seg = (task & 31) + (OUTPUT ? 1 : 0);
        const int di = dbg >> 7, b = (dbg >> 6) & 1, g = dbg & 63;
        const int dg = di * 64 + g;
        f32x2 l1[4], l2[4], l3[4], l4[4];
        bf16x8 bfr[8];
#pragma unroll
        for (int t = 0; t < 4; ++t) { const int dgp = dg * 64 + 16 * t + fr; l1[t] = lamb[dgp]; l2[t] = cmulf(l1[t], l1[t]); l3[t] = cmulf(l2[t], l1[t]); l4[t] = cmulf(l2[t], l2[t]);
            v4u wre = {0u, 0u, 0u, 0u}, wim = {0u, 0u, 0u, 0u};
            if (fq < 2) { const f32x4* bp = (const f32x4*)(bbar + (size_t)dgp * 16 + 8 * fq); const f32x4 q0 = bp[0], q1 = bp[1], q2 = bp[2], q3 = bp[3];
                wre.x = cvt_pk_bf16(q0.x, q0.z); wre.y = cvt_pk_bf16(q1.x, q1.z); wre.z = cvt_pk_bf16(q2.x, q2.z); wre.w = cvt_pk_bf16(q3.x, q3.z);
                wim.x = cvt_pk_bf16(q0.y, q0.w); wim.y = cvt_pk_bf16(q1.y, q1.w); wim.z = cvt_pk_bf16(q2.y, q2.w); wim.w = cvt_pk_bf16(q3.y, q3.w); }
            bfr[t] = __builtin_bit_cast(bf16x8, wre); bfr[4 + t] = __builtin_bit_cast(bf16x8, wim); }
        bf16x8 cfr[4];
        if (OUTPUT) {
#pragma unroll
            for (int ks = 0; ks < 4; ++ks) { const size_t cb = ((size_t)dg * 16 + fr) * 64 + 16 * ks + 4 * fq; const f32x4 r4 = *(const f32x4*)(cre + cb), i4 = *(const f32x4*)(cim + cb);
                v4u w; w.x = cvt_pk_bf16(r4.x, -i4.x); w.y = cvt_pk_bf16(r4.y, -i4.y); w.z = cvt_pk_bf16(r4.z, -i4.z); w.w = cvt_pk_bf16(r4.w, -i4.w); cfr[ks] = __builtin_bit_cast(bf16x8, w); }
        }
        f32x2 st[4];
#pragma unroll
        for (int t = 0; t < 4; ++t) st[t] = (f32x2){0.f, 0.f};
        if (OUTPUT) {
#pragma unroll
            for (int t = 0; t < 4; ++t) { const f32x2 lq = l256[dg * 64 + 16 * t + fr]; const f32x2* ep = Eb + ((size_t)dbg * 32) * 64 + 16 * t + fr;
                for (int k = 0; k < seg; ++k) { const f32x2 e = ep[(size_t)k * 64]; st[t] = cmulf(lq, st[t]) + e; } }
        }
        const int s0 = seg * 256;
        v4u unext = {0u, 0u, 0u, 0u};
        if (fq < 2) unext = *(const v4u*)(PJ + (size_t)s5_row(di, b, s0 + fr) * 4096 + 3072 + g * 16 + 8 * fq);
#pragma nounroll
        for (int blk = 0; blk < 16; ++blk) {
            const bf16x8 ufr = __builtin_bit_cast(bf16x8, unext);
            if (blk + 1 < 16 && fq < 2) unext = *(const v4u*)(PJ + (size_t)s5_row(di, b, s0 + 16 * (blk + 1) + fr) * 4096 + 3072 + g * 16 + 8 * fq);
            f32x4 bu[8];
#pragma unroll
            for (int nt = 0; nt < 8; ++nt) bu[nt] = __builtin_amdgcn_mfma_f32_16x16x32_bf16(ufr, bfr[nt], (f32x4){0.f, 0.f, 0.f, 0.f}, 0, 0, 0);
            f32x2 xs[4][4];
#pragma unroll
            for (int t = 0; t < 4; ++t) {
                f32x2 x0 = {bu[t][0], bu[4 + t][0]}, x1 = cmulf(l1[t], x0) + (f32x2){bu[t][1], bu[4 + t][1]}, x2 = cmulf(l1[t], x1) + (f32x2){bu[t][2], bu[4 + t][2]}, x3 = cmulf(l1[t], x2) + (f32x2){bu[t][3], bu[4 + t][3]};
                f32x2 sin = st[t];
                f32x2 fin = x3 + cmulf(l4[t], (fq == 0) ? sin : (f32x2){0.f, 0.f});
#pragma unroll
                for (int rd = 1; rd < 4; ++rd) { const float vr = __shfl(fin.x, lane - 16), vi = __shfl(fin.y, lane - 16);
                    if (fq == rd) { sin = (f32x2){vr, vi}; fin = x3 + cmulf(l4[t], sin); } }
                xs[t][0] = x0 + cmulf(l1[t], sin); xs[t][1] = x1 + cmulf(l2[t], sin); xs[t][2] = x2 + cmulf(l3[t], sin); xs[t][3] = x3 + cmulf(l4[t], sin);
                st[t] = (f32x2){__shfl(xs[t][3].x, 48 + fr), __shfl(xs[t][3].y, 48 + fr)};
            }
            if (OUTPUT) {
#pragma unroll
                for (int t = 0; t < 4; ++t)
#pragma unroll
                    for (int r = 0; r < 4; ++r) Xl[(4 * fq + r) * 68 + 16 * t + fr] = cvt_pk_bf16(xs[t][r].x, xs[t][r].y);
                LDS_WAIT(); asm volatile("" ::: "memory");
                f32x4 y = {0.f, 0.f, 0.f, 0.f};
#pragma unroll
                for (int ks = 0; ks < 4; ++ks) { const bf16x8 xa = *(const LAS bf16x8*)(Xl + fr * 68 + 16 * ks + 4 * fq); y = __builtin_amdgcn_mfma_f32_16x16x32_bf16(xa, cfr[ks], y, 0, 0, 0); }
                LDS_WAIT(); asm volatile("" ::: "memory");
#pragma unroll
                for (int r = 0; r < 4; ++r) { const int s = s0 + 16 * blk + 4 * fq + r, tl = (di == 0) ? s - CTX : SEQ - 1 - (s - CTX);
                    YD[((size_t)di * TL + (size_t)b * SEQ + tl) * 1024 + g * 16 + fr] = y[r]; }
            }
        }
        if (!OUTPUT) { if (fq == 0) {
#pragma unroll
            for (int t = 0; t < 4; ++t) Eb[((size_t)dbg * 32 + seg) * 64 + 16 * t + fr] = st[t]; } }
    }
}

#ifndef S5C_EOFF
#define S5C_EOFF 0
#endif
#define S5_KEEP8(acc, f) asm volatile("" : "+v"(acc) : "v"(f[0]), "v"(f[1]), "v"(f[2]), "v"(f[3]), "v"(f[4]), "v"(f[5]), "v"(f[6]), "v"(f[7]))
#define S5_KEEP4(acc, f) asm volatile("" : "+v"(acc) : "v"(f[0]), "v"(f[1]), "v"(f[2]), "v"(f[3]))
template <bool OUTPUT, int S5C_RUN = 0>
__device__ __forceinline__ void s5_chunk_phase(Frame& F) {
    const bf16* PJ = WSP(bf16, WS_PROJ1); float* YD = WSP(float, WS_YD);
    const f32x2* l16t = WSP(f32x2, WS_S5L16); const f32x2* l256 = WSP(f32x2, WS_S5L256); f32x2* Eb = WSP(f32x2, WS_S5E);
    const bf16* W1 = WSP(bf16, WS_S5W1); const bf16* W3 = WSP(bf16, WS_S5W3); const bf16* KT = WSP(bf16, WS_S5KT);
    const int lane = F.lane, fr = lane & 15, fq = lane >> 4;
    LAS unsigned* Xl = (LAS unsigned*)(F.lds + F.wave * 4608);
    f32x2 carry[4];
#pragma unroll
    for (int t = 0; t < 4; ++t) carry[t] = (f32x2){0.f, 0.f};
#pragma nounroll
    for (int j = 0;; ++j) {
        const int tq = F.wave * F.G + F.bid + (j >> 2) * F.NGW, sub4 = j & 3;
        if (tq >= 256 * 8) break;
        const int task = tq * 4 + sub4;
        const int dbg = task >> 5, seg = (task & 31) + (OUTPUT ? 1 : 0);
        const int di = dbg >> 7, b = (dbg >> 6) & 1, g = dbg & 63;
        const int dg = di * 64 + g;
        const int s0 = seg * 256;
        bf16x8 afr[8];
#pragma unroll
        for (int ks = 0; ks < 8; ++ks) afr[ks] = *(const bf16x8*)(PJ + (size_t)s5_row(di, b, s0 + 16 * fr + 2 * ks + (fq >> 1)) * 4096 + 3072 + g * 16 + 8 * (fq & 1));
        f32x4 ea[8];
        { const bf16* w1p = W1 + ((size_t)dg * 128 + fr) * 256 + 8 * fq;
#pragma unroll
          for (int nt = 0; nt < 8; ++nt) { f32x4 a = {0.f, 0.f, 0.f, 0.f}; bf16x8 bw[8];
#pragma unroll
              for (int ks = 0; ks < 8; ++ks) bw[ks] = *(const bf16x8*)(w1p + (size_t)nt * 16 * 256 + 32 * ks);
#pragma unroll
              for (int ks = 0; ks < 8; ++ks) a = __builtin_amdgcn_mfma_f32_16x16x32_bf16(afr[ks], bw[ks], a, 0, 0, 0);
              S5_KEEP8(a, bw); S5_KEEP8(a, afr);
              ea[nt] = a; } }
        f32x2 st[4];
#pragma unroll
        for (int t = 0; t < 4; ++t) st[t] = (f32x2){0.f, 0.f};
        if (OUTPUT) {
#pragma unroll
            for (int t = 0; t < 4; ++t) { const f32x2 lq = l256[dg * 64 + 16 * t + fr]; const f32x2* ep = Eb + ((size_t)dbg * 32) * 64 + 16 * t + fr;
                if (sub4 == 0) {
                    int k = 0;
                    for (; k + 8 <= seg; k += 8) { f32x2 e8[8];
#pragma unroll
                        for (int j = 0; j < 8; ++j) e8[j] = ep[(size_t)(k + j) * 64];
#pragma unroll
                        for (int j = 0; j < 8; ++j) st[t] = cmulf(lq, st[t]) + e8[j]; }
                    for (; k < seg; ++k) st[t] = cmulf(lq, st[t]) + ep[(size_t)k * 64];
                } else st[t] = cmulf(lq, carry[t]) + ep[(size_t)(seg - 1) * 64];
                carry[t] = st[t]; }
        }
#pragma unroll
        for (int t = 0; t < 4; ++t) {
            const f32x2 L1 = l16t[dg * 64 + 16 * t + fr], L2 = cmulf(L1, L1), L3 = cmulf(L2, L1), L4 = cmulf(L2, L2);
            const f32x2 x0 = {ea[t][0], ea[4 + t][0]}, x1 = cmulf(L1, x0) + (f32x2){ea[t][1], ea[4 + t][1]}, x2 = cmulf(L1, x1) + (f32x2){ea[t][2], ea[4 + t][2]}, x3 = cmulf(L1, x2) + (f32x2){ea[t][3], ea[4 + t][3]};
            f32x2 sin = st[t];
            f32x2 fin = x3 + cmulf(L4, (fq == 0) ? sin : (f32x2){0.f, 0.f});
#pragma unroll
            for (int rd = 1; rd < 4; ++rd) { const float vr = __shfl(fin.x, lane - 16), vi = __shfl(fin.y, lane - 16);
                if (fq == rd) { sin = (f32x2){vr, vi}; fin = x3 + cmulf(L4, sin); } }
            if (OUTPUT) {
                const f32x2 h1 = x0 + cmulf(L1, sin), h2 = x1 + cmulf(L2, sin), h3 = x2 + cmulf(L3, sin);
                Xl[(4 * fq + 0) * 68 + 16 * t + fr] = cvt_pk_bf16(sin.x, sin.y); Xl[(4 * fq + 1) * 68 + 16 * t + fr] = cvt_pk_bf16(h1.x, h1.y);
                Xl[(4 * fq + 2) * 68 + 16 * t + fr] = cvt_pk_bf16(h2.x, h2.y); Xl[(4 * fq + 3) * 68 + 16 * t + fr] = cvt_pk_bf16(h3.x, h3.y);
#if S5C_EOFF == 2
                { const f32x2 L8 = cmulf(L4, L4), L12 = cmulf(L8, L4); const f32x2 wgt = (fq == 3) ? (f32x2){1.f, 0.f} : (fq == 2) ? L4 : (fq == 1) ? L8 : L12;
                  f32x2 xe = cmulf(wgt, x3); xe.x += __shfl_xor(xe.x, 16); xe.y += __shfl_xor(xe.y, 16); xe.x += __shfl_xor(xe.x, 32); xe.y += __shfl_xor(xe.y, 32);
                  if (fq == 0 && seg < 32) WSP(f32x2, WS_Y)[((size_t)dbg * 32 + seg) * 64 + 16 * t + fr] = xe; }
#endif
            } else {
                st[t] = (f32x2){__shfl(fin.x, 48 + fr), __shfl(fin.y, 48 + fr)};
            }
        }
        if (!OUTPUT) {
            if (fq == 0) {
#pragma unroll
                for (int t = 0; t < 4; ++t) (S5C_EOFF == 1 ? WSP(f32x2, WS_Y) : (S5C_EOFF == 3 ? WSP(f32x2, WS_Y) + S5C_RUN * (1u << 20) : Eb))[((size_t)dbg * 32 + seg) * 64 + 16 * t + fr] = st[t];
            }
        } else {
            LDS_WAIT(); asm volatile("" ::: "memory");
            bf16x8 hfr[4];
#pragma unroll
            for (int ks = 0; ks < 4; ++ks) hfr[ks] = *(const LAS bf16x8*)(Xl + fr * 68 + 16 * ks + 4 * fq);
#ifdef S5_ZERO_CARRY
#pragma unroll
            for (int ks = 0; ks < 4; ++ks) hfr[ks] = (bf16x8){0,0,0,0,0,0,0,0};
#endif
            LDS_WAIT(); asm volatile("" ::: "memory");
            const bf16* w3p = W3 + ((size_t)dg * 256 + fr) * 128 + 8 * fq;
            const bf16* ktp = KT + (size_t)dg * 17 * 256 + fr * 16 + 8 * (fq & 1);
#pragma unroll
            for (int tau = 0; tau < 16; ++tau) {
                f32x4 y = {0.f, 0.f, 0.f, 0.f}; bf16x8 b3[4], bk[8];
#pragma unroll
                for (int ks = 0; ks < 4; ++ks) b3[ks] = *(const bf16x8*)(w3p + (size_t)tau * 16 * 128 + 32 * ks);
#pragma unroll
                for (int ks = 0; ks < 8; ++ks) { const int d1 = (ks <= tau / 2) ? tau - 2 * ks - (fq >> 1) + 1 : 0;
                    bk[ks] = *(const bf16x8*)(ktp + (size_t)d1 * 256); }
#pragma unroll
                for (int ks = 0; ks < 4; ++ks) y = __builtin_amdgcn_mfma_f32_16x16x32_bf16(hfr[ks], b3[ks], y, 0, 0, 0);
#pragma unroll
                for (int ks = 0; ks <= tau / 2; ++ks) y = __builtin_amdgcn_mfma_f32_16x16x32_bf16(afr[ks], bk[ks], y, 0, 0, 0);
                S5_KEEP4(y, b3); S5_KEEP8(y, bk); S5_KEEP8(y, afr); S5_KEEP4(y, hfr);
#pragma unroll
                for (int r = 0; r < 4; ++r) { const int s = s0 + 16 * (4 * fq + r) + tau, tl = (di == 0) ? s - CTX : SEQ - 1 - (s - CTX);
                    YD[(((size_t)(di * 2 + b) * 64 + g) * SEQ + tl) * 16 + fr] = y[r]; }
            }
        }
    }
}

#if S5C_EOFF
__device__ __forceinline__ void s5_check_phase(Frame& F) {
    const f32x2* Ea = (S5C_EOFF == 3) ? WSP(f32x2, WS_Y) + (1u << 20) : WSP(f32x2, WS_S5E); const f32x2* Ebn = WSP(f32x2, WS_Y); unsigned* flag = WSP(unsigned, WS_CTL) + 9000;
    const int gt = F.bid * NTHREADS + F.tid, NGT = F.G * NTHREADS;
    for (int idx = gt; idx < 256 * 32 * 64; idx += NGT) { const f32x2 a = Ea[idx], b = Ebn[idx];
        const float d = fabsf(a.x - b.x) + fabsf(a.y - b.y), m = fabsf(a.x) + fabsf(a.y) + fabsf(b.x) + fabsf(b.y);
        if (S5C_FILTER(idx) && !(d <= S5C_TOL * m + 1e-4f)) atomicAdd(flag, 1u); }
}
#endif

constexpr int NPHASES = 21;
#ifndef MK_SINGLE
#define MK_SINGLE 1
#endif

__device__ __forceinline__ unsigned long long launder_u64(unsigned long long v) {
    unsigned lo = (unsigned)v, hi = (unsigned)(v >> 32);
    asm volatile("" : "+v"(lo), "+v"(hi));
    lo = __builtin_amdgcn_readfirstlane(lo); hi = __builtin_amdgcn_readfirstlane(hi);
    return ((unsigned long long)hi << 32) | lo;
}
__device__ __forceinline__ const void* launder_ptr(const void* p) {
    unsigned long long v = (unsigned long long)p; unsigned lo = (unsigned)v, hi = (unsigned)(v >> 32);
    asm volatile("" : "+v"(lo), "+v"(hi));
    lo = __builtin_amdgcn_readfirstlane(lo); hi = __builtin_amdgcn_readfirstlane(hi);
    return (const void*)(((unsigned long long)hi << 32) | lo);
}
__device__ __forceinline__ void moe_blocks(Frame& F, int l, LAS int* bstart) {
    __syncthreads();
    if (F.tid == 0) { const unsigned* cnt = WSP(unsigned, WS_CTL) + CW_CNT + l * 64; int acc = 0;
        for (int e = 0; e < 64; ++e) { bstart[e] = acc; const int nb = ((int)cnt[e] + 255) >> 8; for (int j = 0; j < nb; ++j) bstart[65 + acc + j] = e; acc += nb; } bstart[64] = acc; }
    __syncthreads();
}

template <int PHSEL>
__global__ void __launch_bounds__(NTHREADS, 2) mk_fwd(Args args) {
    extern __shared__ __attribute__((aligned(16))) unsigned char lds_raw[];
    Frame F;
    F.lds = (LAS unsigned char*)lds_raw; F.ws = args.ws; F.kin = (const __attribute__((address_space(4))) unsigned long long*)__builtin_amdgcn_kernarg_segment_ptr();
    F.tid = threadIdx.x; F.lane = F.tid & 63; F.wave = __builtin_amdgcn_readfirstlane(F.tid >> 6); F.bid = blockIdx.x; F.G = gridDim.x;
    F.gw = F.bid * NWAVES + F.wave; F.NGW = F.G * NWAVES;
    volatile LAS unsigned* lctl = (volatile LAS unsigned*)(F.lds + LDS_CTL);
    LAS int* bstart = (LAS int*)(F.lds + LDS_CTL + 64);
    if (F.tid < 4) lctl[F.tid] = 0u;
    __syncthreads();
    const int lo = args.ph_lo, hi = args.ph_hi;
    XcdBarrier bar; bar.bar = WSP(unsigned, WS_CTL) + CW_BAR; bar.x = 0; bar.st = lctl;
    if (PHSEL < 0) bar = xcd_barrier_post(WSP(unsigned, WS_CTL) + CW_BAR, lctl);
#ifndef PH_MASK
#define PH_MASK 0xffffffffu
#endif
#define IN(k) (((PH_MASK >> (k)) & 1u) && (PHSEL < 0 || PHSEL == (k)))
#define INL(j) (((PH_MASK >> (6 + (j))) & 1u) && (PHSEL < 0 || (PHSEL == 6 + (j) && lo == pb + (j))))
#define PH_END(k) do { if (PHSEL < 0) xcd_barrier(bar); } while (0)
#ifndef PH_REPEAT
#define PH_REPEAT 0u
#endif
#define REP(k) for (int _rep = 0; _rep < (((PH_REPEAT >> (k)) & 1u) ? 2 : 1); ++_rep)
#define DUP(k) (((PH_REPEAT >> (k)) & 1u) != 0u)
#define PH_BEGIN() do { F.ws = (unsigned char*)launder_ptr((const void*)F.ws); F.kin = (const __attribute__((address_space(4))) unsigned long long*)launder_u64((unsigned long long)F.kin); \
    { int _t = threadIdx.x; asm volatile("" : "+v"(_t)); F.tid = _t; F.lane = _t & 63; F.wave = __builtin_amdgcn_readfirstlane(_t >> 6); \
      int _b = blockIdx.x; asm volatile("" : "+v"(_b)); F.bid = __builtin_amdgcn_readfirstlane(_b); F.gw = F.bid * NWAVES + F.wave; } } while (0)
    LAS unsigned char* lds = F.lds;
    const int G = F.G, bid = F.bid;
    constexpr long T2048 = 256L * 2048 * 2;

    if (IN(0)) { PH_BEGIN(); REP(0) { p0_prologue(F); __syncthreads(); } PH_END(0); }
    if (IN(1)) { PH_BEGIN(); p1_reduce(F); PH_END(1); }
#ifdef EXTRA_BARS
    xcd_barrier(bar); xcd_barrier(bar); xcd_barrier(bar); xcd_barrier(bar); xcd_barrier(bar); xcd_barrier(bar); xcd_barrier(bar); xcd_barrier(bar); xcd_barrier(bar); xcd_barrier(bar);
#endif
        if (IN(2)) { PH_BEGIN(); REP(2) norm_phase<0>(F, 0, nullptr); PH_END(2); }
        if (IN(3)) { PH_BEGIN();
#define BODY3 { pg8::Gemm g{(const bf16*)F.ws, (const bf16*)F.ws, 2048, 2048, 2048}; InProj0Order S; S.G = G; S.c = bid; \
              S.offA1 = (long)WS_HA; S.offB1 = (long)WS_WIN0; S.offA2 = (long)(WS_WIN0 + (size_t)3072 * 2048 * 2); S.offB2 = (long)WS_HA; \
              EpiInProj0 E{EpiQKP{WSP(bf16, WS_Q), WSP(bf16, WS_K), WSP(bf16, WS_P), WSP(f32x2, WS_ROPE)}, EpiVT{WSP(bf16, WS_VT)}}; pg8::gemm_phase<EpiInProj0, InProj0Order, false>(lds, g, S, E); }
            BODY3
            if constexpr (DUP(3)) { BODY3 }
#undef BODY3
            PH_END(3);
        }
        if (IN(4)) { PH_BEGIN();
            if (bid & 1) { moe_convert_items(F); __syncthreads(); REP(4) attn_phase(F); }
            else { REP(4) attn_phase(F); __syncthreads(); moe_convert_items(F); }
            __syncthreads(); REP(21) poold_phase(F); PH_END(4); }
        if (IN(5)) { PH_BEGIN();
            pg8::Gemm g{WSP(bf16, WS_PD), WSP(bf16, WS_WPOOL), 1024, 256, 256}; pg8::StaticOrder S; S.init(TT / 256, 4, G, bid, 256L * 1024 * 2, 256L * 2, 256L * 256 * 2);
            EpiScaleBf16 E{WSP(bf16, WS_CAT), 2048, 1024, INP(14)}; pg8::gemm_phase<EpiScaleBf16, pg8::StaticOrder, false>(lds, g, S, E);
            PH_END(5);
        }
    {
    constexpr int pb = 6; constexpr int l = 0;
    if (INL(0)) { PH_BEGIN();
        float* xbuf = WSP(float, WS_X);
        pg8::Gemm g{WSP(bf16, WS_CAT), WSP(bf16, l == 0 ? WS_WOUT0 : WS_WOUT1), 2048, 2048, 2048}; pg8::StaticOrder S; S.init(l == 0 ? TT / 256 : TL / 256, 8, G, bid, T2048, 0, T2048);
        EpiRes E{l == 0 ? INP(0) : xbuf, l == 0 ? INP(2) : xbuf + (size_t)TL * 2048, xbuf, modp(F, l, 0, 2)}; pg8::gemm_phase<EpiRes, pg8::StaticOrder, false>(lds, g, S, E);
        PH_END(pb);
    }
    if (INL(1)) { PH_BEGIN(); ffn_norm_router_phase(F, l); PH_END(pb + 1); }
    if (INL(2)) { PH_BEGIN(); REP(8) {
        moe_blocks(F, l, bstart);
        pg8::Gemm g{WSP(bf16, WS_HA), (const bf16*)(F.ws + WS_WMOE + (size_t)l * MOE_L_BYTES), 2048, 2048, 2048};
        MoeOrder S{bstart, WSP(unsigned, WS_CTL) + CW_CNT + l * 64, WSP(int, WS_TOKL), 4, G, bid, bstart[64], T2048, 0, true};
        EpiMoeUp E{WSP(bf16, WS_H)}; pg8::gemm_phase<EpiMoeUp, MoeOrder, true>(lds, g, S, E); }
        PH_END(pb + 2);
    }
    if (INL(3)) { PH_BEGIN(); REP(9) {
        moe_blocks(F, l, bstart);
        pg8::Gemm g{WSP(bf16, WS_H), (const bf16*)(F.ws + WS_WMOE + (size_t)l * MOE_L_BYTES), 512, 512, 512};
        MoeOrder S{bstart, WSP(unsigned, WS_CTL) + CW_CNT + l * 64, WSP(int, WS_TOKL), 8, G, bid, bstart[64], 256L * 512 * 2, (long)(4 * MiB), false};
        EpiMoeDown E{WSP(bf16, WS_Y), WSP(int, WS_TOKL), WSP(float, WS_GATEL), WSP(unsigned, WS_CTL) + CW_CNT + l * 64}; pg8::gemm_phase<EpiMoeDown, MoeOrder, false>(lds, g, S, E); }
        PH_END(pb + 3);
    }
    }
        if (IN(10)) { PH_BEGIN(); norm_phase<2>(F, 1, nullptr); PH_END(10); }
        if (IN(11)) { PH_BEGIN();
#define BODY11             pg8::Gemm g{WSP(bf16, WS_HA), WSP(bf16, WS_WIN1), 2048, 2048, 2048}; pg8::StaticOrder S; S.init(TT / 256, 16, G, bid, T2048, 0, T2048); \
            EpiBf16 E{WSP(bf16, WS_PROJ1), 4096}; pg8::gemm_phase<EpiBf16, pg8::StaticOrder, false>(lds, g, S, E);
            BODY11
            if constexpr (DUP(11)) { BODY11 }
#undef BODY11
            PH_END(11);
        }
        if (IN(12)) { PH_BEGIN(); REP(12) shortconv_phase(F); REP(22) s5_chunk_phase<false>(F);
#if S5C_EOFF == 1
            s5_chunk_phase<false>(F);
#endif
#if S5C_EOFF == 3
            s5_chunk_phase<false, 0>(F); s5_chunk_phase<false, 1>(F);
#endif
 PH_END(12); }
        if (IN(13)) { PH_BEGIN();
#if S5C_EOFF == 1 || S5C_EOFF == 3
            s5_check_phase(F);
#endif
            REP(23) s5_chunk_phase<true>(F); __syncthreads(); REP(13) hyena_fft_phase(F); PH_END(13); }
        if (IN(14)) { PH_BEGIN();
#if S5C_EOFF == 2
            s5_check_phase(F);
#endif
 REP(14) { s5_gelu_phase(F); hyena_out_transpose(F); } PH_END(14); }
        if (IN(15)) { PH_BEGIN();
            pg8::Gemm g{WSP(bf16, WS_PD), WSP(bf16, WS_WGLU), 1024, 1024, 1024}; pg8::StaticOrder S; S.init(TL / 256, 4, G, bid, 256L * 1024 * 2, 0, 256L * 1024 * 2);
            EpiGlu E{WSP(bf16, WS_CAT), 2048, 1024, WSP(bf16, WS_PD), INP(35)}; pg8::gemm_phase<EpiGlu, pg8::StaticOrder, false>(lds, g, S, E);
            PH_END(15);
        }
    {
    constexpr int pb = 16; constexpr int l = 1;
    if (INL(0)) { PH_BEGIN();
        float* xbuf = WSP(float, WS_X);
        pg8::Gemm g{WSP(bf16, WS_CAT), WSP(bf16, l == 0 ? WS_WOUT0 : WS_WOUT1), 2048, 2048, 2048}; pg8::StaticOrder S; S.init(l == 0 ? TT / 256 : TL / 256, 8, G, bid, T2048, 0, T2048);
        EpiRes E{l == 0 ? INP(0) : xbuf, l == 0 ? INP(2) : xbuf + (size_t)TL * 2048, xbuf, modp(F, l, 0, 2)}; pg8::gemm_phase<EpiRes, pg8::StaticOrder, false>(lds, g, S, E);
        PH_END(pb);
    }
    if (INL(1)) { PH_BEGIN(); ffn_norm_router_phase(F, l); PH_END(pb + 1); }
    if (INL(2)) { PH_BEGIN(); REP(8) {
        moe_blocks(F, l, bstart);
        pg8::Gemm g{WSP(bf16, WS_HA), (const bf16*)(F.ws + WS_WMOE + (size_t)l * MOE_L_BYTES), 2048, 2048, 2048};
        MoeOrder S{bstart, WSP(unsigned, WS_CTL) + CW_CNT + l * 64, WSP(int, WS_TOKL), 4, G, bid, bstart[64], T2048, 0, true};
        EpiMoeUp E{WSP(bf16, WS_H)}; pg8::gemm_phase<EpiMoeUp, MoeOrder, true>(lds, g, S, E); }
        PH_END(pb + 2);
    }
    if (INL(3)) { PH_BEGIN(); REP(9) {
        moe_blocks(F, l, bstart);
        pg8::Gemm g{WSP(bf16, WS_H), (const bf16*)(F.ws + WS_WMOE + (size_t)l * MOE_L_BYTES), 512, 512, 512};
        MoeOrder S{bstart, WSP(unsigned, WS_CTL) + CW_CNT + l * 64, WSP(int, WS_TOKL), 8, G, bid, bstart[64], 256L * 512 * 2, (long)(4 * MiB), false};
        EpiMoeDown E{WSP(bf16, WS_Y), WSP(int, WS_TOKL), WSP(float, WS_GATEL), WSP(unsigned, WS_CTL) + CW_CNT + l * 64}; pg8::gemm_phase<EpiMoeDown, MoeOrder, false>(lds, g, S, E); }
        PH_END(pb + 3);
    }
    }
    if (IN(20)) { PH_BEGIN(); norm_phase<3>(F, 1, args.out);
#if S5C_EOFF
        if (WSP(unsigned, WS_CTL)[9000] != 0u) { for (int i = F.bid * NTHREADS + F.tid; i < TL * 2048; i += F.G * NTHREADS) args.out[i] = __builtin_nanf(""); }
#endif
    }
#undef IN
#undef INL
#undef PH_END
}

typedef void (*kern_t)(Args);
template <int P> static void launch_phase(int grid, hipStream_t stream, Args a) { hipLaunchKernelGGL(mk_fwd<P>, dim3(grid), dim3(NTHREADS), LDS_BYTES, stream, a); }
template <int P> static bool prep_phase() { return hipFuncSetAttribute((const void*)mk_fwd<P>, hipFuncAttributeMaxDynamicSharedMemorySize, LDS_BYTES) == hipSuccess; }
extern "C" void kernel_launch(void* const* d_in, const int* in_sizes, int n_in, void* d_out, int out_size, void* d_ws, size_t ws_size, hipStream_t stream) {
    static int grid = 0;
    if (grid == 0) {
        if (n_in != 43 || out_size != TL * DM || ws_size < WS_END) { fprintf(stderr, "kernel_launch: unexpected shapes (n_in %d, out %d, ws %zu < %zu)\n", n_in, out_size, ws_size, (size_t)WS_END); grid = -1; return; }
        int dev = 0, cus = 0;
        if (hipGetDevice(&dev) != hipSuccess || hipDeviceGetAttribute(&cus, hipDeviceAttributeMultiprocessorCount, dev) != hipSuccess) { grid = -1; return; }
        bool ok = true;
#if MK_SINGLE
        ok = prep_phase<-1>();
#else
        ok = prep_phase<0>() && prep_phase<1>() && prep_phase<2>() && prep_phase<3>() && prep_phase<4>() && prep_phase<5>() && prep_phase<6>() && prep_phase<7>() && prep_phase<8>() && prep_phase<9>() &&
             prep_phase<10>() && prep_phase<11>() && prep_phase<12>() && prep_phase<13>() && prep_phase<14>() && prep_phase<15>() && prep_phase<20>();
#endif
        if (!ok) { fprintf(stderr, "kernel_launch: hipFuncSetAttribute failed\n"); grid = -1; return; }
        (void)hipGetLastError();
        grid = cus;
    }
    if (grid < 0) return;
    (void)hipMemsetAsync((char*)d_ws + WS_CTL, 0, CTL_BYTES, stream);
    Args a{};
    for (int i = 0; i < 43; ++i) a.in[i] = (const float*)d_in[i];
    a.out = (float*)d_out; a.ws = (unsigned char*)d_ws;
#if MK_SINGLE
    a.ph_lo = 0; a.ph_hi = NPHASES;
    launch_phase<-1>(grid, stream, a);
#else
#define LP(k, P) a.ph_lo = (k); a.ph_hi = (k) + 1; launch_phase<P>(grid, stream, a);
    LP(0, 0) LP(1, 1) LP(2, 2) LP(3, 3) LP(4, 4) LP(5, 5) LP(6, 6) LP(7, 7) LP(8, 8) LP(9, 9) LP(10, 10) LP(11, 11) LP(12, 12) LP(13, 13) LP(14, 14) LP(15, 15)
    LP(16, 6) LP(17, 7) LP(18, 8) LP(19, 9) LP(20, 20)
#undef LP
#endif
}
```

```cpp
#include <hip/hip_runtime.h>
#include <cstdio>
#include <cstdint>
#include <cmath>

#define GAS __attribute__((address_space(1)))
#define LAS __attribute__((address_space(3)))
typedef unsigned short bf16;
typedef unsigned v4u __attribute__((ext_vector_type(4)));
typedef unsigned v2u __attribute__((ext_vector_type(2)));
typedef float f32x4 __attribute__((ext_vector_type(4)));
typedef float f32x2 __attribute__((ext_vector_type(2)));
typedef float f32x16 __attribute__((ext_vector_type(16)));
typedef short bf16x8 __attribute__((ext_vector_type(8)));
#define LDS_WAIT() asm volatile("s_waitcnt lgkmcnt(0)" ::: "memory")
#define VM_WAIT() asm volatile("s_waitcnt vmcnt(0)" ::: "memory")

__device__ __forceinline__ unsigned f2bf(float f) { unsigned u = __builtin_bit_cast(unsigned, f); return (u + 0x7fffu + ((u >> 16) & 1u)) >> 16; }
__device__ __forceinline__ unsigned pk2(float lo, float hi) { return f2bf(lo) | (f2bf(hi) << 16); }
__device__ __forceinline__ unsigned cvt_pk_bf16(float lo, float hi) { unsigned r; asm volatile("v_cvt_pk_bf16_f32 %0, %1, %2" : "=v"(r) : "v"(lo), "v"(hi)); return r; }
__device__ __forceinline__ float bf2f(unsigned short b) { return __builtin_bit_cast(float, (unsigned)b << 16); }
__device__ __forceinline__ float bflo(unsigned w) { return __builtin_bit_cast(float, w << 16); }
__device__ __forceinline__ float bfhi(unsigned w) { return __builtin_bit_cast(float, w & 0xffff0000u); }
__device__ __forceinline__ float wave_sum(float v) {
#pragma unroll
    for (int o = 1; o < 64; o <<= 1) v += __shfl_xor(v, o);
    return v;
}

namespace pg8 {
typedef unsigned short bf16_t;
constexpr int BM = 256, BK = 64, HALF = 128, HTB = HALF * BK * 2, STAGE_BYTES = 8 * HTB;

__host__ __device__ __forceinline__ int lds_byte(int r, int c) { const int st = (r >> 4) * 2 + (c >> 5), rr = r & 15, cc = c & 31, ob = rr * 64 + cc * 2; return st * 1024 + (ob ^ (((ob >> 9) & 1) << 5)); }
__host__ __device__ __forceinline__ int perm32(int rho) { const int n = rho >> 4, i = rho & 15; return 8 * (i >> 2) + 4 * n + (i & 3); }
__host__ __device__ __forceinline__ void stage_rc(int b, int& R, int& C) { const int st = b / 1024, sb = b % 1024, swz = sb ^ (((sb >> 9) & 1) << 5); R = (st >> 1) * 16 + swz / 64; C = (st & 1) * 32 + (swz % 64) / 2; }

struct Unit { int pm, pn; long aoff, boff; int e, idx0; };
struct Gemm { const bf16_t* A; const bf16_t* Bt; int lda, ldb, K; };

template <class Epi, class Sched, bool GATHER>
__device__ __forceinline__ void gemm_phase(LAS unsigned char* lds, const Gemm g, const Sched& S, const Epi& E) {
    int tid_ = threadIdx.x; asm volatile("" : "+v"(tid_));
    const int tid = tid_, wid = __builtin_amdgcn_readfirstlane(tid >> 6), lane = tid & 63, wr = wid >> 2, wc = wid & 3, fr = lane & 15, fq = lane >> 4;
    const int K = g.K, nt = K / BK;
    unsigned voffA[2], voffB[2];
#pragma unroll
    for (int i = 0; i < 2; ++i) { int R, C; stage_rc(tid * 16 + i * 8192, R, C);
        const int Rb = Epi::PERM ? ((R & ~31) + perm32(R & 31)) : R;
        voffA[i] = (unsigned)(R * g.lda + C) * 2u; voffB[i] = (unsigned)(Rb * g.ldb + C) * 2u; }
    const size_t kstep = (size_t)(BK * 2);
    const size_t hstepA = GATHER ? 0 : (size_t)HALF * g.lda * 2, hstepB = (size_t)HALF * g.ldb * 2;
    const unsigned ldsw = (unsigned)wid * 1024u;
    const int aoff = lds_byte(wr * 64 + fr, fq * 8), boff = lds_byte(wc * 32 + fr, fq * 8);
#define PG8_SA(b, h) (((b) * 2 + (h)) * HTB)
#define PG8_SB(b, h) ((4 + (b) * 2 + (h)) * HTB)
#define PG8_STAGE(bufoff, gbase, voff) do { _Pragma("unroll") for (int _i = 0; _i < 2; ++_i) \
        __builtin_amdgcn_global_load_lds((const unsigned*)((const char*)(gbase) + (voff)[_i]), (LAS unsigned*)(lds + (bufoff) + ldsw + _i * 8192), 16, 0, 0); } while (0)
#define PG8_STAGE_A(bufoff, gbase, h, nx) do { if constexpr (GATHER) { unsigned _tv[2]; \
        if (nx) { int _tz = tid; asm volatile("" : "+v"(_tz)); _Pragma("unroll") for (int _j = 0; _j < 2; ++_j) { int _R, _C; stage_rc(_tz * 16 + _j * 8192, _R, _C); _tv[_j] = (unsigned)S.arow(nxt, (h) * HALF + _R) * (unsigned)(g.lda * 2) + (unsigned)(_C * 2); } } \
        else { _tv[0] = gvc[h][0]; _tv[1] = gvc[h][1]; } \
        PG8_STAGE(bufoff, gbase, _tv); } else { PG8_STAGE(bufoff, (gbase) + (h) * hstepA, voffA); } } while (0)
#define PG8_LDA(dst, b, h) do { _Pragma("unroll") for (int m = 0; m < 4; ++m) _Pragma("unroll") for (int k = 0; k < 2; ++k) dst[m][k] = *(const LAS bf16x8*)(lds + PG8_SA(b, h) + aoff + m * 2048 + k * 1024); } while (0)
#define PG8_LDB(dst, b, h) do { _Pragma("unroll") for (int n = 0; n < 2; ++n) _Pragma("unroll") for (int k = 0; k < 2; ++k) dst[n][k] = *(const LAS bf16x8*)(lds + PG8_SB(b, h) + boff + n * 2048 + k * 1024); } while (0)
#define PG8_MMA(ai, bj, At, Bt) do { __builtin_amdgcn_s_setprio(1); _Pragma("unroll") for (int m = 0; m < 4; ++m) _Pragma("unroll") for (int n = 0; n < 2; ++n) _Pragma("unroll") for (int k = 0; k < 2; ++k) \
        acc[ai][bj][m][n] = __builtin_amdgcn_mfma_f32_16x16x32_bf16(Bt[n][k], At[m][k], acc[ai][bj][m][n], 0, 0, 0); __builtin_amdgcn_s_setprio(0); } while (0)
#define PG8_WAIT_V(n) asm volatile("s_waitcnt vmcnt(" #n ")" ::: "memory")
#define PG8_WAIT_L(n) asm volatile("s_waitcnt lgkmcnt(" #n ")" ::: "memory")
#define PG8_BAR __builtin_amdgcn_s_barrier()
#define PG8_SCHED __builtin_amdgcn_sched_barrier(0)
    Unit cur, nxt; int ui = 0;
    if (!S.next(0, cur)) return;
    unsigned gvc[2][2];
#define PG8_GV(unit) do { if constexpr (GATHER) { int _tz = tid; asm volatile("" : "+v"(_tz)); _Pragma("unroll") for (int _h = 0; _h < 2; ++_h) _Pragma("unroll") for (int _j = 0; _j < 2; ++_j) { int _R, _C; stage_rc(_tz * 16 + _j * 8192, _R, _C); \
        gvc[_h][_j] = (unsigned)S.arow(unit, _h * HALF + _R) * (unsigned)(g.lda * 2) + (unsigned)(_C * 2); } } } while (0)
    PG8_GV(cur);
    f32x4 acc[2][2][4][2];
#pragma unroll
    for (int a = 0; a < 2; ++a)
#pragma unroll
        for (int b = 0; b < 2; ++b)
#pragma unroll
            for (int m = 0; m < 4; ++m)
#pragma unroll
                for (int n = 0; n < 2; ++n) acc[a][b][m][n] = (f32x4){0.f, 0.f, 0.f, 0.f};
    bf16x8 At[4][2], B0[2][2], B1[2][2];
    const char* cA = (const char*)g.A + cur.aoff; const char* cB = (const char*)g.Bt + cur.boff;
    PG8_STAGE(PG8_SB(0, 0), cB, voffB); PG8_STAGE(PG8_SB(0, 1), cB + hstepB, voffB); PG8_STAGE_A(PG8_SA(0, 0), cA, 0, false); PG8_STAGE_A(PG8_SA(0, 1), cA, 1, false);
    if (wr == 1) PG8_BAR;
    PG8_WAIT_V(2); PG8_BAR;
    PG8_STAGE(PG8_SB(1, 0), cB + kstep, voffB); PG8_STAGE_A(PG8_SA(1, 0), cA + kstep, 0, false); PG8_STAGE(PG8_SB(1, 1), cB + hstepB + kstep, voffB);
    PG8_WAIT_V(6); PG8_BAR;
    for (;;) {
        const bool has_next = S.next(ui + 1, nxt);
        const char* nA = has_next ? (const char*)g.A + nxt.aoff : cA; const char* nB = has_next ? (const char*)g.Bt + nxt.boff : cB;
#pragma nounroll
        for (int t = 0; t < nt; t += 2) {
            const bool last = (t == nt - 2);
            const char* a1 = cA + (size_t)(t + 1) * kstep;
            const char* a2 = last ? nA : cA + (size_t)(t + 2) * kstep; const char* b2 = last ? nB : cB + (size_t)(t + 2) * kstep;
            const char* a3 = a2 + kstep; const char* b3 = b2 + kstep;
            PG8_LDB(B0, 0, 0); PG8_LDB(B1, 0, 1); PG8_SCHED; PG8_LDA(At, 0, 0); PG8_STAGE_A(PG8_SA(1, 1), a1, 1, false);
            PG8_WAIT_V(8); PG8_WAIT_L(0); PG8_BAR; PG8_MMA(0, 0, At, B0); PG8_MMA(0, 1, At, B1); PG8_BAR; PG8_SCHED;
            PG8_LDA(At, 0, 1); PG8_STAGE(PG8_SB(0, 0), b2, voffB); PG8_STAGE(PG8_SB(0, 1), b2 + hstepB, voffB); PG8_STAGE_A(PG8_SA(0, 0), a2, 0, last);
            PG8_WAIT_V(8); PG8_WAIT_L(0); PG8_BAR; PG8_MMA(1, 0, At, B0); PG8_MMA(1, 1, At, B1); PG8_BAR; PG8_SCHED;
            PG8_LDB(B0, 1, 0); PG8_LDB(B1, 1, 1); PG8_SCHED; PG8_LDA(At, 1, 0); PG8_STAGE_A(PG8_SA(0, 1), a2, 1, last);
            PG8_WAIT_V(8); PG8_WAIT_L(0); PG8_BAR; PG8_MMA(0, 0, At, B0); PG8_MMA(0, 1, At, B1); PG8_BAR; PG8_SCHED;
            PG8_LDA(At, 1, 1); PG8_STAGE(PG8_SB(1, 0), b3, voffB); PG8_STAGE(PG8_SB(1, 1), b3 + hstepB, voffB); PG8_STAGE_A(PG8_SA(1, 0), a3, 0, last);
            PG8_WAIT_V(8); PG8_WAIT_L(0); PG8_BAR; PG8_MMA(1, 0, At, B0); PG8_MMA(1, 1, At, B1); PG8_BAR; PG8_SCHED;
        }
        if (wr == 0) PG8_BAR;
        E(acc, cur, wr, wc, fr, fq);
        if (!has_next) break;
#pragma unroll
        for (int a = 0; a < 2; ++a)
#pragma unroll
            for (int b = 0; b < 2; ++b)
#pragma unroll
                for (int m = 0; m < 4; ++m)
#pragma unroll
                    for (int n = 0; n < 2; ++n) acc[a][b][m][n] = (f32x4){0.f, 0.f, 0.f, 0.f};
        cur = nxt; cA = nA; cB = nB; ++ui;
        PG8_GV(cur);
        if (wr == 1) PG8_BAR;
    }
    PG8_WAIT_V(0);
    PG8_BAR;
#undef PG8_SA
#undef PG8_SB
#undef PG8_STAGE
#undef PG8_STAGE_A
#undef PG8_GV
#undef PG8_LDA
#undef PG8_LDB
#undef PG8_MMA
#undef PG8_WAIT_V
#undef PG8_WAIT_L
#undef PG8_BAR
#undef PG8_SCHED
}

struct StaticOrder {
    int nM, nN, nwg, G, c; long astride, apn, bstride;
    __device__ void init(int nM_, int nN_, int G_, int c_, long astride_, long apn_, long bstride_) { nM = nM_; nN = nN_; nwg = nM * nN; G = G_; c = c_; astride = astride_; apn = apn_; bstride = bstride_; }
    __device__ bool next(int i, Unit& u) const {
        const long Lx = (long)i * G + c; if (Lx >= nwg) return false;
        int wgid = (int)Lx; { const int q = nwg / 8, r = nwg % 8, xcd = wgid % 8, off = wgid / 8; wgid = (xcd < r ? xcd * (q + 1) : r * (q + 1) + (xcd - r) * q) + off; }
        const int nig = 8 * nN, gid = wgid / nig, fm = gid * 8, gsz = (nM - fm) < 8 ? (nM - fm) : 8;
        u.pm = fm + ((wgid % nig) % gsz); u.pn = (wgid % nig) / gsz; u.aoff = (long)u.pm * astride + (long)u.pn * apn; u.boff = (long)u.pn * bstride; u.e = 0; u.idx0 = 0; return true;
    }
    __device__ int arow(const Unit&, int) const { return 0; }
};
}

constexpr int DM = 2048, NBATCH = 2, SEQ = 8192, CTX = 256;
constexpr int TL = NBATCH * SEQ;
constexpr int TC = NBATCH * CTX;
constexpr int TT = TL + TC;
constexpr int KEYS = CTX + SEQ;
constexpr int NEXP = 64, DEXP = 512;
constexpr int LISTCAP = 2 * TT;
constexpr float EPS = 1e-6f;
constexpr float QSCALE = 0.125f * 1.4426950408889634f;
constexpr int NWAVES = 8, NTHREADS = 512;

constexpr size_t MiB = 1u << 20;
constexpr size_t WS_CTL = 0, CTL_BYTES = 1 * MiB;
constexpr size_t WS_WIN0 = 1 * MiB;
constexpr size_t WS_WOUT0 = WS_WIN0 + 16 * MiB;
constexpr size_t WS_WIN1 = WS_WOUT0 + 8 * MiB;
constexpr size_t WS_WOUT1 = WS_WIN1 + 16 * MiB;
constexpr size_t WS_WPOOL = WS_WOUT1 + 8 * MiB;
constexpr size_t WS_WGLU = WS_WPOOL + 1 * MiB;
constexpr size_t WS_WMOE = WS_WGLU + 2 * MiB;
constexpr size_t MOE_E_BYTES = 6 * MiB, MOE_L_BYTES = 64 * MOE_E_BYTES;
constexpr size_t WS_X = WS_WMOE + 2 * MOE_L_BYTES;
constexpr size_t WS_HA = WS_X + 132 * MiB;
constexpr size_t WS_Q = WS_HA + 67 * MiB;
constexpr size_t WS_K = WS_Q + 33 * MiB;
constexpr size_t WS_VT = WS_K + 33 * MiB;
constexpr size_t WS_P = WS_VT + 33 * MiB;
constexpr size_t WS_PROJ1 = WS_Q;
constexpr size_t WS_CAT = WS_P + 33 * MiB;
constexpr size_t WS_PD = WS_CAT + 66 * MiB;
constexpr size_t WS_H = WS_PD + 33 * MiB;
constexpr size_t WS_Y = WS_H + 49 * MiB;
constexpr size_t WS_GT = WS_Y + 132 * MiB;
constexpr size_t WS_KT = WS_GT + 192 * MiB;
constexpr size_t WS_YD = WS_KT + 128 * MiB;
constexpr size_t WS_MISC = WS_YD + 128 * MiB;
constexpr size_t WS_MOD = WS_MISC;
constexpr size_t WS_ADAP = WS_MOD + 1 * MiB;
constexpr size_t WS_ROPE = WS_ADAP + 10 * MiB;
constexpr size_t WS_NORMP = WS_ROPE + 1 * MiB;
constexpr size_t WS_INVN = WS_NORMP + 4 * MiB;
constexpr size_t WS_S5LAM = WS_INVN + 1 * MiB;
constexpr size_t WS_S5B = WS_S5LAM + 1 * MiB;
constexpr size_t WS_WRT = WS_S5B + 2 * MiB;
constexpr size_t WS_TOKL = WS_WRT + 2 * MiB;
constexpr size_t WS_GATEL = WS_TOKL + 9 * MiB;
constexpr size_t WS_TW = WS_GATEL + 9 * MiB;
constexpr size_t WS_FFTW = WS_TW + 1 * MiB;
constexpr size_t WS_S5L256 = WS_FFTW + 32 * MiB;
constexpr size_t WS_S5E = WS_S5L256 + 1 * MiB;
constexpr size_t WS_YHT = WS_S5E + 4 * MiB;
constexpr size_t WS_S5L16 = WS_YHT + 64 * MiB;
constexpr size_t WS_S5W1 = WS_S5L16 + 1 * MiB;
constexpr size_t WS_S5W3 = WS_S5W1 + 8 * MiB;
constexpr size_t WS_S5KT = WS_S5W3 + 8 * MiB;
constexpr size_t WS_END = WS_S5KT + 2 * MiB;
static_assert(WS_END <= 2040 * MiB, "d_ws map");
constexpr int CW_BAR = 1024;
constexpr int CW_CNT = 8192;
constexpr int CSTR = 32;

constexpr int LDS_PHASE = 131072;
constexpr int LDS_CTL = 147456 - 2048;
constexpr int LDS_BYTES = 147456;

#define XB_TMO      128
#define XB_XCNT(j)  (256  + 64 * (j))
#define XB_XSUB(j)  (1280 + 64 * (j))
#define XB_XGEN(j)  (2304 + 64 * (j))
#define XB_TOP      3328
#define XB_TOPGEN   3392
#define XCD_BAR_WORDS 3456
#define XB_SPIN_CAP (1u << 22)

__device__ __forceinline__ unsigned xb_ld(unsigned* p)              { return __hip_atomic_load(p, __ATOMIC_RELAXED, __HIP_MEMORY_SCOPE_AGENT); }
__device__ __forceinline__ unsigned xb_add(unsigned* p, unsigned v) { return __hip_atomic_fetch_add(p, v, __ATOMIC_RELAXED, __HIP_MEMORY_SCOPE_AGENT); }
__device__ __forceinline__ unsigned xb_xcc_id() { return (unsigned)__builtin_amdgcn_s_getreg((3 << 11) | 20) & 0xFu; }
#define XB_SPIN(cond, bar) do { unsigned _sp = 0; while (cond) { __builtin_amdgcn_s_sleep(1); \
    if ((++_sp & 255u) == 0u) { if (xb_ld(&(bar)[XB_TMO])) break; if (_sp > XB_SPIN_CAP) { atomicAdd(&(bar)[XB_TMO], 1u); break; } } } } while (0)

struct XcdBarrier { unsigned* bar; unsigned x; volatile LAS unsigned* st; };

__device__ __forceinline__ XcdBarrier xcd_barrier_post(unsigned* bar, volatile LAS unsigned* st) {
    XcdBarrier b; b.bar = bar; b.x = xb_xcc_id(); b.st = st;
    if (threadIdx.x == 0) (void)xb_add(&bar[XB_XCNT(b.x)], 1u);
    return b;
}
__device__ __forceinline__ void xcd_barrier_complete(unsigned* bar, unsigned x, unsigned& nloc, unsigned& nx) {
    const unsigned G = gridDim.x * gridDim.y * gridDim.z;
    unsigned sum, cnt, mine, sp = 0u;
    for (;;) {
        sum = 0u; cnt = 0u; mine = 0u;
#pragma unroll
        for (unsigned j = 0; j < 16; ++j) { const unsigned c = xb_ld(&bar[XB_XCNT(j)]); sum += c; cnt += (c > 0u) ? 1u : 0u; mine = (j == x) ? c : mine; }
        if (sum == G) break;
        __builtin_amdgcn_s_sleep(1);
        if ((++sp & 255u) == 0u) { if (xb_ld(&bar[XB_TMO])) break; if (sp > XB_SPIN_CAP) { atomicAdd(&bar[XB_TMO], 1u); break; } }
    }
    nloc = mine > 0u ? mine : 1u; nx = cnt > 0u ? cnt : 1u;
}
__device__ __forceinline__ void xcd_barrier(const XcdBarrier& b) {
    asm volatile("s_waitcnt vmcnt(0)" ::: "memory");
    __syncthreads();
    if (threadIdx.x == 0) {
        unsigned* bar = b.bar;
        __builtin_amdgcn_s_waitcnt(0);
        unsigned nloc = b.st[0], nx = b.st[1];
        if (nloc == 0u) { xcd_barrier_complete(bar, b.x, nloc, nx); b.st[0] = nloc; b.st[1] = nx; }
        const unsigned old = xb_add(&bar[XB_XSUB(b.x)], 1u);
        const unsigned gen = old / nloc;
        if (old + 1u == (gen + 1u) * nloc) {
            __builtin_amdgcn_fence(__ATOMIC_RELEASE, "agent");
            asm volatile("s_waitcnt vmcnt(0)" ::: "memory");
            const unsigned og = xb_add(&bar[XB_TOP], 1u);
            const unsigned tg = og / nx;
            if (og + 1u == (tg + 1u) * nx) xb_add(&bar[XB_TOPGEN], 1u);
            else XB_SPIN(xb_ld(&bar[XB_TOPGEN]) == tg, bar);
            __builtin_amdgcn_fence(__ATOMIC_ACQUIRE, "agent");
            xb_add(&bar[XB_XGEN(b.x)], 1u);
            asm volatile("s_waitcnt vmcnt(0)" ::: "memory");
        } else {
            XB_SPIN(xb_ld(&bar[XB_XGEN(b.x)]) == gen, bar);
            __builtin_amdgcn_fence(__ATOMIC_ACQUIRE, "agent");
            asm volatile("s_waitcnt vmcnt(0)" ::: "memory");
        }
    }
    __syncthreads();
}

__device__ __forceinline__ void sincos_2pi(double x, double& s, double& c) {
    const double q = __builtin_rint(x * 4.0);
    const double y = (x - q * 0.25) * 6.283185307179586476925;
    const double y2 = y * y;
    double sp = -7.6471637318198164759e-13; sp = sp * y2 + 1.6059043836821614599e-10; sp = sp * y2 - 2.5052108385441718775e-8; sp = sp * y2 + 2.7557319223985890653e-6;
    sp = sp * y2 - 1.9841269841269841270e-4; sp = sp * y2 + 8.3333333333333333333e-3; sp = sp * y2 - 1.6666666666666666667e-1; sp = sp * y2 * y + y;
    double cp = 4.7794773323873852974e-14; cp = cp * y2 - 1.1470745597729724714e-11; cp = cp * y2 + 2.0876756987868098979e-9; cp = cp * y2 - 2.7557319223985890653e-7;
    cp = cp * y2 + 2.4801587301587301587e-5; cp = cp * y2 - 1.3888888888888888889e-3; cp = cp * y2 + 4.1666666666666666667e-2; cp = cp * y2 - 0.5; cp = cp * y2 + 1.0;
    const int qi = ((int)q) & 3;
    s = (qi == 0) ? sp : (qi == 1) ? cp : (qi == 2) ? -sp : -cp;
    c = (qi == 0) ? cp : (qi == 1) ? -sp : (qi == 2) ? -cp : sp;
}
__device__ __forceinline__ void sincos_rad(double a, double& s, double& c) {
    double f = a * 0.15915494309189533576888; f -= __builtin_floor(f);
    if (f >= 1.0) f = 0.0;
    sincos_2pi(f, s, c);
}
__device__ __forceinline__ double exp_small(double x) {
    double r = 1.0 / 479001600.0;
    r = r * x + 1.0 / 39916800.0; r = r * x + 1.0 / 3628800.0; r = r * x + 1.0 / 362880.0; r = r * x + 1.0 / 40320.0; r = r * x + 1.0 / 5040.0;
    r = r * x + 1.0 / 720.0; r = r * x + 1.0 / 120.0; r = r * x + 1.0 / 24.0; r = r * x + 1.0 / 6.0; r = r * x + 0.5; r = r * x + 1.0; r = r * x + 1.0;
    return r;
}
__device__ __forceinline__ float fast_exp(float x) { return __builtin_amdgcn_exp2f(x * 1.4426950408889634f); }
__device__ __forceinline__ float sigmoidf_(float x) { return 1.0f / (1.0f + fast_exp(-x)); }
__device__ __forceinline__ float siluf_(float x) { return x * sigmoidf_(x); }
__device__ __forceinline__ float tanhf_(float x) { const float e = fast_exp(-2.0f * fabsf(x)); const float t = (1.0f - e) / (1.0f + e); return x < 0.f ? -t : t; }
__device__ __forceinline__ float gelu_tanh(float x) { return 0.5f * x * (1.0f + tanhf_(0.7978845608028654f * (x + 0.044715f * x * x * x))); }

#ifndef PH_REPEAT
#define PH_REPEAT 0u
#endif
struct Args { const float* in[43]; float* out; unsigned char* ws; int ph_lo, ph_hi; };

#define GAS __attribute__((address_space(1)))
struct Frame {
    LAS unsigned char* lds; GAS unsigned char* ws; int tid, lane, wave, bid, G, gw, NGW;
    const __attribute__((address_space(4))) unsigned long long* kin;
};
#define INP(i) ((const float*)(const GAS float*)F.kin[i])
#define WSP(T, off) ((T*)(GAS T*)(F.ws + (off)))

__device__ __forceinline__ void tr_item(const float* W, int ldw, int N, bf16* WT, int ldt, int row_off, int rs16, LAS float* scr, int item, int lane) {
    const int nblk = N / 64, kb = item / nblk, nb = item % nblk, k0 = 64 * kb, n0 = 64 * nb;
    const int la = lane & 15, lb = lane >> 4;
    f32x4 v[16];
#pragma unroll
    for (int i = 0; i < 16; ++i) v[i] = *(const f32x4*)(W + (size_t)(k0 + 4 * i + lb) * ldw + n0 + 4 * la);
#pragma unroll
    for (int i = 0; i < 16; ++i) { const int kk = 4 * i + lb; LAS float* d = scr + (4 * la) * 65 + kk; d[0] = v[i].x; d[65] = v[i].y; d[130] = v[i].z; d[195] = v[i].w; }
    LDS_WAIT(); asm volatile("" ::: "memory");
    const int c = lane & 7;
#pragma unroll
    for (int j = 0; j < 8; ++j) { const int n = (lane >> 3) + 8 * j; const LAS float* s = scr + n * 65 + 8 * c;
        v4u o; o.x = cvt_pk_bf16(s[0], s[1]); o.y = cvt_pk_bf16(s[2], s[3]); o.z = cvt_pk_bf16(s[4], s[5]); o.w = cvt_pk_bf16(s[6], s[7]);
        const int nn = n0 + n, drow = row_off + (nn >> 4) * rs16 + (nn & 15);
        *(v4u*)(WT + (size_t)drow * ldt + k0 + 8 * c) = o; }
    LDS_WAIT(); asm volatile("" ::: "memory");
}

__device__ __forceinline__ void hyfilt_item(Frame& F, int pb) {
    const float* w1 = INP(19); const float* b1 = INP(20); const float* fq = INP(21); const float* w2 = INP(22); const float* b2 = INP(23); const float* w3 = INP(24);
    LAS float* z = (LAS float*)F.lds;
    LAS float* h1 = z + 1088;
    LAS float* h2 = h1 + 2048;
    const int tid = F.tid;
    for (int idx = tid; idx < 32 * 33; idx += NTHREADS) {
        const int p = idx / 33, f = idx % 33, i = pb * 32 + p;
        float v;
        if (f == 0) v = (float)i * (1.0f / (float)(SEQ - 1));
        else { const int j = (f - 1) & 15; const float fj = 1e-4f + (float)j * ((15.0f - 1e-4f) / 15.0f);
            double fr = (double)fj * (double)i / (double)SEQ; fr -= __builtin_floor(fr); double s, c; sincos_2pi(fr, s, c); v = (f <= 16) ? (float)c : (float)(-s); }
        z[p * 33 + f] = v;
    }
    __syncthreads();
    for (int idx = tid; idx < 2048; idx += NTHREADS) {
        const int p = idx >> 6, j = idx & 63; float a = b1[j];
        for (int f = 0; f < 33; ++f) a += z[p * 33 + f] * w1[f * 64 + j];
        double s, c; sincos_rad((double)(fq[j] * a), s, c); h1[idx] = (float)s;
    }
    __syncthreads();
    for (int idx = tid; idx < 2048; idx += NTHREADS) {
        const int p = idx >> 6, j = idx & 63; float a = b2[j];
        for (int k = 0; k < 64; ++k) a += h1[p * 64 + k] * w2[k * 64 + j];
        double s, c; sincos_rad((double)(fq[64 + j] * a), s, c); h2[idx] = (float)s;
    }
    __syncthreads();
    float* kT = WSP(float, WS_KT); float* normp = WSP(float, WS_NORMP);
    {
        const int lane = F.lane, l31 = lane & 31, lh = lane >> 5;
        float af[32];
#pragma unroll
        for (int s = 0; s < 32; ++s) af[s] = h2[l31 * 64 + 2 * s + lh];
        float bn[32];
        { const unsigned vo = (unsigned)(lh * 4096 + F.wave * 32 + l31);
#pragma unroll
          for (int s = 0; s < 32; ++s) bn[s] = (w3 + s * 8192)[vo]; }
#pragma nounroll
        for (int ct = F.wave; ct < 128; ct += NWAVES) {
            const int col = ct * 32 + l31;
            f32x16 acc;
#pragma unroll
            for (int r = 0; r < 16; ++r) acc[r] = 0.f;
            float bv[32];
#pragma unroll
            for (int s = 0; s < 32; ++s) bv[s] = bn[s];
            { const unsigned vo = (unsigned)(lh * 4096 + (ct + NWAVES < 128 ? ct + NWAVES : ct) * 32 + l31);
#pragma unroll
              for (int s = 0; s < 32; ++s) bn[s] = (w3 + s * 8192)[vo]; }
#pragma unroll
            for (int s = 0; s < 32; ++s) acc = __builtin_amdgcn_mfma_f32_32x32x2f32(af[s], bv[s], acc, 0, 0, 0);
#pragma unroll
            for (int s = 0; s < 32; s += 8) asm volatile("" : "+v"(acc) : "v"(bv[s]), "v"(bv[s + 1]), "v"(bv[s + 2]), "v"(bv[s + 3]), "v"(bv[s + 4]), "v"(bv[s + 5]), "v"(bv[s + 6]), "v"(bv[s + 7]));
            const int ch = col & 1023, dir = (col >> 10) & 1;
            const float adel = 3.0701134573253946f + (float)ch * ((15.350567286626972f - 3.0701134573253946f) / 1023.0f);
            float sabs = 0.f;
#pragma unroll
            for (int r = 0; r < 16; ++r) { const int i = pb * 32 + (r & 3) + 8 * (r >> 2) + 4 * lh; const float t = (float)i * (1.0f / (float)(SEQ - 1)); acc[r] *= fast_exp(-t * adel); if (!(dir == 1 && i == 0)) sabs += fabsf(acc[r]); }
            sabs += __shfl_xor(sabs, 32);
#pragma unroll
            for (int q = 0; q < 4; ++q) *(f32x4*)(kT + (size_t)col * SEQ + pb * 32 + 8 * q + 4 * lh) = (f32x4){acc[4 * q], acc[4 * q + 1], acc[4 * q + 2], acc[4 * q + 3]};
            if (lh == 0) normp[(size_t)pb * 4096 + col] = sabs;
        }
    }
    __syncthreads();
}

struct TrItem { const float* W; bf16* WT; int ldw, ldt, row_off, rs16, k0, n0; };
__device__ __forceinline__ TrItem moe_tr_item(Frame& F, int it) {
    if (F.G == 256) it = (it & 255) * 48 + (it >> 8);
    const int le = it / 96, q = it % 96; TrItem r;
    bf16* wc = (bf16*)(F.ws + WS_WMOE + (size_t)le * MOE_E_BYTES);
    if (q < 32) { r.W = INP(40) + (size_t)le * (2048 * 512); r.ldw = 512; r.WT = wc; r.ldt = 2048; r.row_off = 0; r.rs16 = 32; r.k0 = 64 * q; r.n0 = 0; }
    else if (q < 64) { r.W = INP(41) + (size_t)le * (2048 * 512); r.ldw = 512; r.WT = wc; r.ldt = 2048; r.row_off = 16; r.rs16 = 32; r.k0 = 64 * (q - 32); r.n0 = 0; }
    else { const int x = q - 64; r.W = INP(42) + (size_t)le * (512 * 2048); r.ldw = 2048; r.WT = wc + 1024 * 2048; r.ldt = 512; r.row_off = 0; r.rs16 = 16; r.k0 = 64 * (x >> 2); r.n0 = 512 * (x & 3); }
    return r;
}
__device__ __forceinline__ void moe_convert_items(Frame& F) {
    LAS unsigned* T = (LAS unsigned*)F.lds;
    const int t = F.tid, r4 = t >> 7, n4 = t & 127;
    const int cc = t & 7, nl = t >> 3;
    f32x4 va[16], vb[16];
    int it = F.bid;
    constexpr int NIT = 128 * 96;
    if (it >= NIT) return;
#define TR_LOAD(v, c) do { _Pragma("unroll") for (int i = 0; i < 16; ++i) v[i] = __builtin_nontemporal_load((const f32x4*)((c).W + (size_t)((c).k0 + 8 * (i >> 1) + 2 * r4 + (i & 1)) * (c).ldw + (c).n0 + 4 * n4)); } while (0)
#define LDS_BARRIER() do { asm volatile("s_waitcnt lgkmcnt(0)" ::: "memory"); __builtin_amdgcn_s_barrier(); asm volatile("" ::: "memory"); } while (0)
#define TR_BODY(v, itc) do { const TrItem c = moe_tr_item(F, (itc)); \
        _Pragma("unroll") for (int a = 0; a < 8; ++a) { const int kp = 4 * a + r4; v4u d; \
            d.x = cvt_pk_bf16(v[2 * a].x, v[2 * a + 1].x); d.y = cvt_pk_bf16(v[2 * a].y, v[2 * a + 1].y); d.z = cvt_pk_bf16(v[2 * a].z, v[2 * a + 1].z); d.w = cvt_pk_bf16(v[2 * a].w, v[2 * a + 1].w); \
            *(LAS v4u*)(T + kp * 516 + ((4 * n4 + 8 * ((kp >> 3) & 1)) & 511)) = d; } \
        { const TrItem nx = moe_tr_item(F, (itc) + 2 * F.G < NIT ? (itc) + 2 * F.G : (itc)); TR_LOAD(v, nx); }        \
        LDS_BARRIER(); \
        _Pragma("unroll") for (int q = 0; q < 8; ++q) { const int n = 64 * q + nl; const LAS unsigned* s = T + (4 * cc) * 516 + ((n + 8 * ((cc >> 1) & 1)) & 511); \
            v4u o; o.x = s[0]; o.y = s[516]; o.z = s[2 * 516]; o.w = s[3 * 516]; \
            const int nn = c.n0 + n, drow = c.row_off + (nn >> 4) * c.rs16 + (nn & 15); \
            __builtin_nontemporal_store(o, (v4u*)(c.WT + (size_t)drow * c.ldt + c.k0 + 8 * cc)); } \
        LDS_BARRIER(); } while (0)
    { const TrItem c = moe_tr_item(F, it); TR_LOAD(va, c); }
    { const TrItem c = moe_tr_item(F, it + F.G < NIT ? it + F.G : it); TR_LOAD(vb, c); }
#pragma nounroll
    for (; it < NIT; it += 2 * F.G) {
        TR_BODY(va, it);
        const int itb = it + F.G < NIT ? it + F.G : it;
        TR_BODY(vb, itb);
    }
#undef TR_LOAD
#undef TR_BODY
}

__device__ __forceinline__ void p0_prologue(Frame& F) {
    if ((F.bid & 1) == 0) { for (int pb = F.bid; pb < SEQ / 32; pb += F.G) hyfilt_item(F, pb); __syncthreads(); }
    const int gt = F.bid * NTHREADS + F.tid, NGT = F.G * NTHREADS;
    {
        f32x2* rope = WSP(f32x2, WS_ROPE);
        for (int idx = gt; idx < 128 * 16; idx += NGT) { const int pos = idx >> 4, i = idx & 15;
            double inv = (i & 3) == 0 ? 1.0 : (i & 3) == 1 ? 0.56234132519034908 : (i & 3) == 2 ? 0.31622776601683794 : 0.17782794100389228;
            inv *= (i >> 2) == 0 ? 1.0 : (i >> 2) == 1 ? 0.1 : (i >> 2) == 2 ? 0.01 : 0.001;
            const float ang = (float)pos * (float)inv; double s, c; sincos_rad((double)ang, s, c); rope[idx] = (f32x2){(float)c, (float)s}; }
    }
    {
        f32x2* tw = WSP(f32x2, WS_TW);
        for (int idx = gt; idx < 16384; idx += NGT) { double s, c; sincos_2pi((double)idx * (1.0 / 16384.0), s, c); tw[idx] = (f32x2){(float)c, (float)(-s)}; }
    }
    {
        const float* are = INP(26); const float* aim = INP(27); const float* ldt = INP(28); const float* bre = INP(29); const float* bim = INP(30);
        f32x2* lamb = WSP(f32x2, WS_S5LAM); f32x2* bb = WSP(f32x2, WS_S5B); f32x2* l256 = WSP(f32x2, WS_S5L256);
        for (int idx = gt; idx < 2 * 64 * 64; idx += NGT) { const int dg = idx >> 6;
            const float dt = expf(ldt[dg]); const float ar = are[idx], ai = aim[idx];
            const float zr = ar * dt, zi = ai * dt; double s, c; sincos_rad((double)zi, s, c); const double er = exp_small((double)zr);
            const double lr = er * c, li = er * s; lamb[idx] = (f32x2){(float)lr, (float)li};
            { double pr = lr, pi = li; for (int q = 0; q < 8; ++q) { const double tr = pr * pr - pi * pi, ti = 2.0 * pr * pi; pr = tr; pi = ti; } l256[idx] = (f32x2){(float)pr, (float)pi}; }
            const double nr = lr - 1.0, ni = li, den = (double)ar * ar + (double)ai * ai; const double qr = (nr * ar + ni * ai) / den, qi = (ni * ar - nr * ai) / den;
            for (int cc = 0; cc < 16; ++cc) { const double br = bre[(size_t)idx * 16 + cc], bi = bim[(size_t)idx * 16 + cc]; bb[(size_t)idx * 16 + cc] = (f32x2){(float)(qr * br - qi * bi), (float)(qr * bi + qi * br)}; } }
    }
    {
        float* wrt = WSP(float, WS_WRT);
        for (int idx = gt; idx < 2 * 72 * 2048; idx += NGT) { const int l = idx / (72 * 2048), r = idx % (72 * 2048), n = r / 2048, k = r % 2048;
            wrt[idx] = n < 8 ? INP(36)[((size_t)l * 2048 + k) * 8 + n] : INP(38)[((size_t)l * 2048 + k) * 64 + (n - 8)]; }
    }
    {
        bf16* ha = WSP(bf16, WS_HA);
        for (int idx = gt; idx < 2048; idx += NGT) ha[(size_t)TT * 2048 + idx] = 0;
    }
    LAS float* scr = (LAS float*)(F.lds + F.wave * 16896);
    {
        const float* c = INP(1); const float* cctx = INP(3); const float* adaw = INP(4); float* part = WSP(float, WS_ADAP);
        for (int rep = 0; rep < (((PH_REPEAT >> 26) & 1u) ? 2 : 1); ++rep)
        for (int it = F.gw; it < 2 * 32 * 48; it += F.NGW) {
            const int l = it / (32 * 48), r = it % (32 * 48), ks = r / 48, jb = r % 48, k0 = ks * 64, j0 = jb * 256 + F.lane * 4;
            const float c0 = c[k0 + F.lane], c1 = c[2048 + k0 + F.lane], c2 = cctx[k0 + F.lane];
            const float s0 = c0 / (1.0f + expf(-c0)), s1 = c1 / (1.0f + expf(-c1)), s2 = c2 / (1.0f + expf(-c2));
            f32x4 a0 = {0.f, 0.f, 0.f, 0.f}, a1 = a0, a2 = a0;
            const float* wp = adaw + ((size_t)l * 2048 + k0) * 12288 + j0;
#pragma unroll 8
            for (int kk = 0; kk < 64; ++kk) { const f32x4 w = *(const f32x4*)(wp + (size_t)kk * 12288);
                const float t0 = __builtin_bit_cast(float, __builtin_amdgcn_readlane(__builtin_bit_cast(int, s0), kk));
                const float t1 = __builtin_bit_cast(float, __builtin_amdgcn_readlane(__builtin_bit_cast(int, s1), kk));
                const float t2 = __builtin_bit_cast(float, __builtin_amdgcn_readlane(__builtin_bit_cast(int, s2), kk));
                a0 += w * t0; a1 += w * t1; a2 += w * t2; }
            float* pp = part + ((size_t)(l * 32 + ks) * 3) * 12288 + j0;
            *(f32x4*)(pp) = a0; *(f32x4*)(pp + 12288) = a1; *(f32x4*)(pp + 2 * 12288) = a2;
        }
    }
    {
        constexpr int I0 = 1024, I1 = 512, I2 = 512, I3 = 1024, I4 = 2048, I5 = 1024, I6 = 64, I7 = 256, IE = 768;
        constexpr int NSMALL = I0 + I1 + I2 + I3 + I4 + I5 + I6 + I7;
        const int NITEMS = NSMALL;
        for (int rep = 0; rep < (((PH_REPEAT >> 27) & 1u) ? 2 : 1); ++rep)
        for (int it = F.gw; it < NITEMS; it += F.NGW) {
            int r = it;
            if (r < I0) { tr_item(INP(9), 4096, 2048, WSP(bf16, WS_WIN0), 2048, 0, 16, scr, r, F.lane); continue; } r -= I0;
            if (r < I1) { tr_item(INP(9) + 2048, 4096, 1024, WSP(bf16, WS_WIN0), 2048, 3072, 16, scr, r, F.lane); continue; } r -= I1;
            if (r < I2) { tr_item(INP(9) + 3072, 4096, 1024, WSP(bf16, WS_WIN0), 2048, 2048, 16, scr, r, F.lane); continue; } r -= I2;
            if (r < I3) { tr_item(INP(10), 2048, 2048, WSP(bf16, WS_WOUT0), 2048, 0, 16, scr, r, F.lane); continue; } r -= I3;
            if (r < I4) { tr_item(INP(15), 4096, 4096, WSP(bf16, WS_WIN1), 2048, 0, 16, scr, r, F.lane); continue; } r -= I4;
            if (r < I5) { tr_item(INP(16), 2048, 2048, WSP(bf16, WS_WOUT1), 2048, 0, 16, scr, r, F.lane); continue; } r -= I5;
            if (r < I6) { const int g = r / 16; tr_item(INP(13) + (size_t)g * 65536, 256, 256, WSP(bf16, WS_WPOOL), 256, g * 256, 16, scr, r % 16, F.lane); continue; } r -= I6;
            if (r < I7) { tr_item(INP(34), 1024, 1024, WSP(bf16, WS_WGLU), 1024, 0, 16, scr, r, F.lane); continue; } r -= I7;
        }
    }
    if ((F.bid & 1) != 0) { __syncthreads(); for (int pb = F.bid; pb < SEQ / 32; pb += F.G) hyfilt_item(F, pb); }
}

__device__ __forceinline__ void p1_reduce(Frame& F) {
    const int gt = F.bid * NTHREADS + F.tid, NGT = F.G * NTHREADS;
    const float* part = WSP(float, WS_ADAP); float* mod = WSP(float, WS_MOD); const float* adab = INP(5);
    for (int idx = gt; idx < 2 * 3 * 12288; idx += NGT) { const int l = idx / (3 * 12288), r = idx % (3 * 12288), m = r / 12288, j = r % 12288;
        float a = adab[l * 12288 + j];
        for (int ks = 0; ks < 32; ++ks) a += part[((size_t)(l * 32 + ks) * 3 + m) * 12288 + j];
        mod[idx] = a; }
    const float* normp = WSP(float, WS_NORMP); float* invn = WSP(float, WS_INVN);
    for (int idx = gt; idx < 2048; idx += NGT) { const int o = idx >> 10, ch = idx & 1023; float a = 0.f;
        for (int pb = 0; pb < 256; ++pb) a += normp[(size_t)pb * 4096 + o * 2048 + ch] + normp[(size_t)pb * 4096 + o * 2048 + 1024 + ch];
        invn[idx] = 1.0f / a; }
    {
        const f32x2* lamb = WSP(f32x2, WS_S5LAM); const f32x2* bbar = WSP(f32x2, WS_S5B); const float* cre = INP(31); const float* cim = INP(32);
        bf16* W1 = WSP(bf16, WS_S5W1); bf16* W3 = WSP(bf16, WS_S5W3); bf16* KT = WSP(bf16, WS_S5KT); f32x2* l16 = WSP(f32x2, WS_S5L16);
#define S5_POWF(l_, e_, pw_) do { pw_ = (f32x2){1.f, 0.f}; f32x2 b_ = l_; for (int q_ = (e_); q_ > 0; q_ >>= 1) { if (q_ & 1) pw_ = (f32x2){pw_.x * b_.x - pw_.y * b_.y, pw_.x * b_.y + pw_.y * b_.x}; b_ = (f32x2){b_.x * b_.x - b_.y * b_.y, 2.f * b_.x * b_.y}; } } while (0)
        for (int idx = gt; idx < 128 * 64; idx += NGT) { f32x2 pw; S5_POWF(lamb[idx], 16, pw); l16[idx] = pw; }
        for (int idx = gt; idx < 128 * 128 * 32; idx += NGT) {
            const int k8 = idx & 31, n = (idx >> 5) & 127, dg = idx >> 12, sigma = k8 >> 1, h = k8 & 1, p = (n & 15) + 16 * ((n >> 4) & 3), im = n >> 6;
            f32x2 pw; S5_POWF(lamb[dg * 64 + p], 15 - sigma, pw);
            const f32x4* bp = (const f32x4*)(bbar + ((size_t)dg * 64 + p) * 16 + 8 * h); float o[8];
#pragma unroll
            for (int j = 0; j < 4; ++j) { const f32x4 q = bp[j]; o[2 * j] = im ? (pw.x * q.y + pw.y * q.x) : (pw.x * q.x - pw.y * q.y); o[2 * j + 1] = im ? (pw.x * q.w + pw.y * q.z) : (pw.x * q.z - pw.y * q.w); }
            v4u w; w.x = pk2(o[0], o[1]); w.y = pk2(o[2], o[3]); w.z = pk2(o[4], o[5]); w.w = pk2(o[6], o[7]);
            *(v4u*)(W1 + (size_t)idx * 8) = w; }
        for (int idx = gt; idx < 128 * 256 * 16; idx += NGT) {
            const int k8 = idx & 15, n = (idx >> 4) & 255, dg = idx >> 12, tau = n >> 4, cout = n & 15; float o[8];
#pragma unroll
            for (int j = 0; j < 4; ++j) { const int p = 4 * k8 + j; f32x2 pw; S5_POWF(lamb[dg * 64 + p], tau + 1, pw);
                const float cr = cre[((size_t)dg * 16 + cout) * 64 + p], ci = cim[((size_t)dg * 16 + cout) * 64 + p]; o[2 * j] = cr * pw.x - ci * pw.y; o[2 * j + 1] = -(cr * pw.y + ci * pw.x); }
            v4u w; w.x = pk2(o[0], o[1]); w.y = pk2(o[2], o[3]); w.z = pk2(o[4], o[5]); w.w = pk2(o[6], o[7]);
            *(v4u*)(W3 + (size_t)idx * 8) = w; }
        for (int idx = gt; idx < 128 * 17 * 16 * 2; idx += NGT) {
            const int h = idx & 1, cout = (idx >> 1) & 15, d1 = (idx >> 5) % 17, dg = (idx >> 5) / 17;
            float acc[8];
#pragma unroll
            for (int j = 0; j < 8; ++j) acc[j] = 0.f;
            if (d1 > 0) { for (int p = 0; p < 64; ++p) { f32x2 pw; S5_POWF(lamb[dg * 64 + p], d1 - 1, pw);
                const float cr = cre[((size_t)dg * 16 + cout) * 64 + p], ci = cim[((size_t)dg * 16 + cout) * 64 + p]; const float gr = cr * pw.x - ci * pw.y, gi = cr * pw.y + ci * pw.x;
                const f32x4* bp = (const f32x4*)(bbar + ((size_t)dg * 64 + p) * 16 + 8 * h);
#pragma unroll
                for (int j = 0; j < 4; ++j) { const f32x4 q = bp[j]; acc[2 * j] += gr * q.x - gi * q.y; acc[2 * j + 1] += gr * q.z - gi * q.w; } } }
            v4u w; w.x = pk2(acc[0], acc[1]); w.y = pk2(acc[2], acc[3]); w.z = pk2(acc[4], acc[5]); w.w = pk2(acc[6], acc[7]);
            *(v4u*)(KT + (size_t)idx * 8) = w; }
#undef S5_POWF
    }
}

__device__ __forceinline__ const float* modp(Frame& F, int l, int m, int c) { return WSP(float, WS_MOD) + ((size_t)(l * 3 + m) * 6 + c) * 2048; }
__device__ __forceinline__ int row_stream(int r) { return r < TL ? r / SEQ : 2; }

template <int MODE>
__device__ __forceinline__ void norm_phase(Frame& F, int l, float* dout) {
    const int nrows = (MODE == 3 || (MODE == 1 && l == 1)) ? TL : TT;
    float* xbuf = WSP(float, WS_X); bf16* ha = WSP(bf16, WS_HA); const bf16* Y = WSP(bf16, WS_Y);
    const float* gvec = (MODE == 0) ? INP(6) : (MODE == 1) ? INP(7) + l * 2048 : (MODE == 2) ? INP(6) + 2048 : INP(8);
    const int lane = F.lane;
    for (int r = F.gw; r < nrows; r += F.NGW) {
        const int m = row_stream(r);
        const float* src = (MODE == 0) ? (r < TL ? INP(0) + (size_t)r * 2048 : INP(2) + (size_t)(r - TL) * 2048) : xbuf + (size_t)r * 2048;
        f32x4 v[8]; float ss = 0.f;
#pragma unroll
        for (int j = 0; j < 8; ++j) v[j] = *(const f32x4*)(src + 4 * lane + 256 * j);
        if (MODE == 2 || MODE == 3) {
            const float* g2 = modp(F, MODE == 2 ? 0 : 1, m, 5);
            const bf16* y0 = Y + (size_t)(2 * r) * 2048; const bf16* y1 = y0 + 2048;
#pragma unroll
            for (int j = 0; j < 8; ++j) { const int c = 4 * lane + 256 * j; const v2u a = *(const v2u*)(y0 + c), b = *(const v2u*)(y1 + c); const f32x4 gg = *(const f32x4*)(g2 + c);
                v[j].x += gg.x * (bflo(a.x) + bflo(b.x)); v[j].y += gg.y * (bfhi(a.x) + bfhi(b.x)); v[j].z += gg.z * (bflo(a.y) + bflo(b.y)); v[j].w += gg.w * (bfhi(a.y) + bfhi(b.y)); }
            if (MODE == 2) {
#pragma unroll
                for (int j = 0; j < 8; ++j) *(f32x4*)(xbuf + (size_t)r * 2048 + 4 * lane + 256 * j) = v[j];
            }
        }
#pragma unroll
        for (int j = 0; j < 8; ++j) ss += (v[j].x * v[j].x + v[j].y * v[j].y) + (v[j].z * v[j].z + v[j].w * v[j].w);
        ss = wave_sum(ss);
        const float rs = 1.0f / sqrtf(ss * (1.0f / 2048.0f) + EPS);
        if (MODE == 3) {
#pragma unroll
            for (int j = 0; j < 8; ++j) { const int c = 4 * lane + 256 * j; const f32x4 gg = *(const f32x4*)(gvec + c); *(f32x4*)(dout + (size_t)r * 2048 + c) = v[j] * rs * gg; }
            continue;
        }
        const int lm = (MODE == 2) ? 1 : l;
        const float* sh = modp(F, lm, m, MODE == 1 ? 3 : 0); const float* sc = modp(F, lm, m, MODE == 1 ? 4 : 1);
#pragma unroll
        for (int j = 0; j < 8; ++j) { const int c = 4 * lane + 256 * j; const f32x4 gg = *(const f32x4*)(gvec + c), s1 = *(const f32x4*)(sc + c), s0 = *(const f32x4*)(sh + c);
            v[j] = (v[j] * rs * gg) * (1.0f + s1) + s0;
            v2u o; o.x = pk2(v[j].x, v[j].y); o.y = pk2(v[j].z, v[j].w); *(v2u*)(ha + (size_t)r * 2048 + c) = o; }
    }
}

__device__ __forceinline__ void ffn_norm_router_phase(Frame& F, int l) {
    const int nrows = (l == 1) ? TL : TT;
    const float* xbuf = WSP(float, WS_X); bf16* ha = WSP(bf16, WS_HA);
    const float* gvec = INP(7) + l * 2048;
    const float* wrt = WSP(float, WS_WRT) + (size_t)l * 72 * 2048;
    LAS float* hl = (LAS float*)F.lds;
    LAS float* lg = (LAS float*)(F.lds + 131584);
    const int lane = F.lane, tid = F.tid, l31 = lane & 31, lh = lane >> 5;
    for (int it = F.bid; it < nrows / 32; it += F.G) {
        const int r0 = it * 32 + F.wave * 4;
        f32x4 v[4][8];
#pragma unroll
        for (int rr = 0; rr < 4; ++rr)
#pragma unroll
            for (int j = 0; j < 8; ++j) v[rr][j] = *(const f32x4*)(xbuf + (size_t)(r0 + rr) * 2048 + 4 * lane + 256 * j);
        const int m = row_stream(r0);
        const float* sh = modp(F, l, m, 3); const float* sc = modp(F, l, m, 4);
        float rs[4];
#pragma unroll
        for (int rr = 0; rr < 4; ++rr) { float ss = 0.f;
#pragma unroll
            for (int j = 0; j < 8; ++j) ss += (v[rr][j].x * v[rr][j].x + v[rr][j].y * v[rr][j].y) + (v[rr][j].z * v[rr][j].z + v[rr][j].w * v[rr][j].w);
            ss = wave_sum(ss); rs[rr] = 1.0f / sqrtf(ss * (1.0f / 2048.0f) + EPS); }
#pragma unroll
        for (int j = 0; j < 8; ++j) { if ((j & 1) == 0) __builtin_amdgcn_sched_barrier(0); const int c = 4 * lane + 256 * j; const f32x4 gg = *(const f32x4*)(gvec + c), s1 = *(const f32x4*)(sc + c), s0 = *(const f32x4*)(sh + c);
#pragma unroll
            for (int rr = 0; rr < 4; ++rr) { v[rr][j] = (v[rr][j] * rs[rr] * gg) * (1.0f + s1) + s0;
                v2u o; o.x = cvt_pk_bf16(v[rr][j].x, v[rr][j].y); o.y = cvt_pk_bf16(v[rr][j].z, v[rr][j].w); *(v2u*)(ha + (size_t)(r0 + rr) * 2048 + c) = o; } }
        f32x16 acc[3];
#pragma unroll
        for (int nt = 0; nt < 3; ++nt)
#pragma unroll
            for (int r = 0; r < 16; ++r) acc[nt][r] = 0.f;
        const int nr2 = (64 + l31 < 72) ? 64 + l31 : 71;
#pragma unroll
        for (int hK = 0; hK < 2; ++hK) {
#pragma unroll
            for (int rr = 0; rr < 4; ++rr)
#pragma unroll
                for (int j = 0; j < 4; ++j) *(LAS f32x4*)(hl + (F.wave * 4 + rr) * 1028 + 256 * j + 4 * lane) = v[rr][4 * hK + j];
            __syncthreads();
            const LAS float* ap = hl + l31 * 1028 + 128 * F.wave + 4 * lh;
            const float* wp = wrt + 1024 * hK + 128 * F.wave + 4 * lh;
            const float* w0 = wp + (size_t)l31 * 2048; const float* w1 = wp + (size_t)(32 + l31) * 2048; const float* w2 = wp + (size_t)nr2 * 2048;
#pragma nounroll
            for (int jc = 0; jc < 4; ++jc) {
                f32x4 af[4], b0[4], b1[4], b2[4];
#pragma unroll
                for (int jj = 0; jj < 4; ++jj) { const int o = 8 * (4 * jc + jj); b0[jj] = *(const f32x4*)(w0 + o); b1[jj] = *(const f32x4*)(w1 + o); b2[jj] = *(const f32x4*)(w2 + o); af[jj] = *(const LAS f32x4*)(ap + o); }
#pragma unroll
                for (int jj = 0; jj < 4; ++jj)
#pragma unroll
                    for (int c = 0; c < 4; ++c) {
                        acc[0] = __builtin_amdgcn_mfma_f32_32x32x2f32(af[jj][c], b0[jj][c], acc[0], 0, 0, 0);
                        acc[1] = __builtin_amdgcn_mfma_f32_32x32x2f32(af[jj][c], b1[jj][c], acc[1], 0, 0, 0);
                        acc[2] = __builtin_amdgcn_mfma_f32_32x32x2f32(af[jj][c], b2[jj][c], acc[2], 0, 0, 0); }
                asm volatile("" : "+v"(acc[0]), "+v"(acc[1]), "+v"(acc[2]) : "v"(af[0]), "v"(af[1]), "v"(af[2]), "v"(af[3]), "v"(b0[0]), "v"(b0[1]), "v"(b0[2]), "v"(b0[3]),
                             "v"(b1[0]), "v"(b1[1]), "v"(b1[2]), "v"(b1[3]), "v"(b2[0]), "v"(b2[1]), "v"(b2[2]), "v"(b2[3]));
            }
            __syncthreads();
        }
        {
            LAS float* pw = hl + F.wave * (32 * 96);
#pragma unroll
            for (int nt = 0; nt < 3; ++nt)
#pragma unroll
                for (int r = 0; r < 16; ++r) pw[((r & 3) + 8 * (r >> 2) + 4 * lh) * 96 + 32 * nt + l31] = acc[nt][r];
        }
        __syncthreads();
        for (int idx = tid; idx < 32 * 72; idx += NTHREADS) { const int row = idx / 72, col = idx - row * 72; float s = 0.f;
#pragma unroll
            for (int w = 0; w < 8; ++w) s += hl[w * (32 * 96) + row * 96 + col];
            lg[row * 80 + col] = s; }
        __syncthreads();
        if (lane < 4) {
            const int r = r0 + lane; const LAS float* L = lg + (F.wave * 4 + lane) * 80;
            float gl[8]; float gmax = -INFINITY; int gi = 0;
#pragma unroll
            for (int j = 0; j < 8; ++j) { gl[j] = L[j] + INP(37)[l * 8 + j]; if (gl[j] > gmax) { gmax = gl[j]; gi = j; } }
            float gsum = 0.f;
#pragma unroll
            for (int j = 0; j < 8; ++j) gsum += expf(gl[j] - gmax);
            const float pg_top = 1.0f / gsum;
            float pe[8]; float emax = -INFINITY;
#pragma unroll
            for (int j = 0; j < 8; ++j) { pe[j] = L[8 + gi * 8 + j] + INP(39)[l * 64 + gi * 8 + j]; emax = fmaxf(emax, pe[j]); }
            float esum = 0.f;
#pragma unroll
            for (int j = 0; j < 8; ++j) { pe[j] = expf(pe[j] - emax); esum += pe[j]; }
            int e1 = 0; float p1 = -1.f;
#pragma unroll
            for (int j = 0; j < 8; ++j) { pe[j] /= esum; if (pe[j] > p1) { p1 = pe[j]; e1 = j; } }
            int e2 = 0; float p2 = -1.f;
#pragma unroll
            for (int j = 0; j < 8; ++j) { if (j != e1 && pe[j] > p2) { p2 = pe[j]; e2 = j; } }
            const float den = p1 + p2; const float g1 = pg_top * p1 / den, g2 = pg_top * p2 / den;
            unsigned* cnt = WSP(unsigned, WS_CTL) + CW_CNT + l * 64 * CSTR; int* tokl = WSP(int, WS_TOKL); float* gatel = WSP(float, WS_GATEL);
            const int ex1 = gi * 8 + e1, ex2 = gi * 8 + e2;
            const unsigned k1 = atomicAdd(cnt + ex1 * CSTR, 1u); tokl[(size_t)ex1 * LISTCAP + k1] = 2 * r; gatel[(size_t)ex1 * LISTCAP + k1] = g1;
            const unsigned k2 = atomicAdd(cnt + ex2 * CSTR, 1u); tokl[(size_t)ex2 * LISTCAP + k2] = 2 * r + 1; gatel[(size_t)ex2 * LISTCAP + k2] = g2;
        }
        __syncthreads();
    }
}

#define EPI_ARGS const f32x4 (&acc)[2][2][4][2], const pg8::Unit& u, int wr, int wc, int fr, int fq
__device__ __forceinline__ void st_bf4(bf16* p, f32x4 v) { v2u o; o.x = cvt_pk_bf16(v.x, v.y); o.y = cvt_pk_bf16(v.z, v.w); *(v2u*)p = o; }
__device__ __forceinline__ void st_bf8(bf16* p, f32x4 a, f32x4 b) { v4u o; o.x = cvt_pk_bf16(a.x, a.y); o.y = cvt_pk_bf16(a.z, a.w); o.z = cvt_pk_bf16(b.x, b.y); o.w = cvt_pk_bf16(b.z, b.w); *(v4u*)p = o; }

struct EpiQKP {
    static constexpr bool PERM = false;
    bf16* Q; bf16* Kb; bf16* P; const f32x2* rope;
    __device__ __forceinline__ void operator()(EPI_ARGS) const {
        const int sect = u.pn >> 2, cb = (u.pn & 3) * 256; const bool latent = u.pm < TL / 256;
#pragma unroll
        for (int ai = 0; ai < 2; ++ai)
#pragma unroll
            for (int m = 0; m < 4; ++m) {
                const int r = u.pm * 256 + ai * 128 + wr * 64 + m * 16 + fr;
                int b, t; if (latent) { b = r / SEQ; t = r % SEQ; } else { b = (r - TL) / CTX; t = (r - TL) % CTX; }
                f32x4 cs0 = {1.f, 0.f, 1.f, 0.f}, cs1 = cs0;
                if (latent && sect < 2) { const int pos = (wc & 1) ? (t & 63) : (t >> 6); const f32x4* rp = (const f32x4*)(rope + pos * 16 + 4 * fq); cs0 = rp[0]; cs1 = rp[1]; }
#pragma unroll
                for (int bj = 0; bj < 2; ++bj) {
                    const int c0 = cb + bj * 128 + wc * 32 + 4 * fq;
                    f32x4 a = acc[ai][bj][m][0], bb = acc[ai][bj][m][1];
                    if (sect < 2) {
                        const f32x4 co = {cs0.x, cs0.z, cs1.x, cs1.z}, si = {cs0.y, cs0.w, cs1.y, cs1.w};
                        const f32x4 oa = a * co - bb * si, ob = a * si + bb * co; a = oa; bb = ob;
                    }
                    if (sect == 0) { a = a * QSCALE; bb = bb * QSCALE; bf16* d = Q + (size_t)r * 1024 + c0; st_bf4(d, a); st_bf4(d + 16, bb); }
                    else if (sect == 1) { const size_t kr = (size_t)b * KEYS + (latent ? CTX + t : t); bf16* d = Kb + kr * 1024 + c0; st_bf4(d, a); st_bf4(d + 16, bb); }
                    else { bf16* d = P + (size_t)r * 1024 + c0; st_bf4(d, a); st_bf4(d + 16, bb); }
                }
            }
    }
};
struct EpiVT {
    static constexpr bool PERM = false;
    bf16* VT;
    __device__ __forceinline__ void operator()(EPI_ARGS) const {
        const bool latent = u.pn < TL / 256; const int b = latent ? u.pn / 32 : u.pn - TL / 256; const int key_t0 = latent ? CTX + (u.pn % 32) * 256 : 0;
        const int kperm = 8 * (fq & 1) + 4 * (fq >> 1);
#pragma unroll
        for (int ai = 0; ai < 2; ++ai)
#pragma unroll
            for (int m = 0; m < 4; ++m) {
                const int rr = u.pm * 256 + ai * 128 + wr * 64 + m * 16 + fr;
                bf16* rowp = VT + ((size_t)b * 1024 + rr) * KEYS + key_t0;
#pragma unroll
                for (int bj = 0; bj < 2; ++bj)
#pragma unroll
                    for (int n = 0; n < 2; ++n) st_bf4(rowp + bj * 128 + wc * 32 + 16 * n + kperm, acc[ai][bj][m][n]);
            }
    }
};
struct EpiScaleBf16 {
    static constexpr bool PERM = true;
    bf16* O; int ldo, coff; const float* cscale;
    __device__ __forceinline__ void operator()(EPI_ARGS) const {
#pragma unroll
        for (int bj = 0; bj < 2; ++bj) { const int c = u.pn * 256 + bj * 128 + wc * 32 + 8 * fq; const f32x4 s0 = *(const f32x4*)(cscale + c), s1 = *(const f32x4*)(cscale + c + 4);
#pragma unroll
            for (int ai = 0; ai < 2; ++ai)
#pragma unroll
                for (int m = 0; m < 4; ++m) { const int r = u.pm * 256 + ai * 128 + wr * 64 + m * 16 + fr; st_bf8(O + (size_t)r * ldo + coff + c, acc[ai][bj][m][0] * s0, acc[ai][bj][m][1] * s1); } }
    }
};
struct EpiBf16 {
    static constexpr bool PERM = true;
    bf16* O; int ldo;
    __device__ __forceinline__ void operator()(EPI_ARGS) const {
#pragma unroll
        for (int ai = 0; ai < 2; ++ai)
#pragma unroll
            for (int m = 0; m < 4; ++m) { const int r = u.pm * 256 + ai * 128 + wr * 64 + m * 16 + fr; bf16* rowp = O + (size_t)r * ldo + u.pn * 256 + wc * 32 + 8 * fq;
#pragma unroll
                for (int bj = 0; bj < 2; ++bj) st_bf8(rowp + bj * 128, acc[ai][bj][m][0], acc[ai][bj][m][1]); }
    }
};
struct EpiRes {
    static constexpr bool PERM = false;
    const float* xlat; const float* xctx; float* xout; const float* gate0;
    __device__ __forceinline__ void operator()(EPI_ARGS) const {
        const bool latent = u.pm < TL / 256;
#pragma unroll
        for (int ai = 0; ai < 2; ++ai)
#pragma unroll
            for (int m = 0; m < 4; ++m) { const int r = u.pm * 256 + ai * 128 + wr * 64 + m * 16 + fr; const int ms = latent ? r / SEQ : 2;
                const float* xi = latent ? xlat + (size_t)r * 2048 : xctx + (size_t)(r - TL) * 2048; const float* gp = gate0 + (size_t)ms * 12288;
#pragma unroll
                for (int bj = 0; bj < 2; ++bj)
#pragma unroll
                    for (int n = 0; n < 2; ++n) { const int c = u.pn * 256 + bj * 128 + wc * 32 + 16 * n + 4 * fq;
                        const f32x4 xv = *(const f32x4*)(xi + c), gv = *(const f32x4*)(gp + c); *(f32x4*)(xout + (size_t)r * 2048 + c) = xv + gv * acc[ai][bj][m][n]; } }
    }
};
struct EpiMoeUp {
    static constexpr bool PERM = false;
    bf16* H;
    __device__ __forceinline__ void operator()(EPI_ARGS) const {
#pragma unroll
        for (int ai = 0; ai < 2; ++ai)
#pragma unroll
            for (int m = 0; m < 4; ++m) { const size_t r = (size_t)u.pm * 256 + ai * 128 + wr * 64 + m * 16 + fr;
#pragma unroll
                for (int bj = 0; bj < 2; ++bj) { const int hc = (u.pn * 256 + bj * 128 + wc * 32) / 2 + 4 * fq; const f32x4 a = acc[ai][bj][m][0], b = acc[ai][bj][m][1];
                    const f32x4 h = {siluf_(a.x) * b.x, siluf_(a.y) * b.y, siluf_(a.z) * b.z, siluf_(a.w) * b.w}; st_bf4(H + r * 512 + hc, h); } }
    }
};
struct EpiMoeDown {
    static constexpr bool PERM = true;
    bf16* Y; const int* tokl; const float* gatel; const unsigned* cnt;
    __device__ __forceinline__ void operator()(EPI_ARGS) const {
        const int ce = (int)cnt[u.e * CSTR];
#pragma unroll
        for (int ai = 0; ai < 2; ++ai)
#pragma unroll
            for (int m = 0; m < 4; ++m) { const int idx = u.idx0 + ai * 128 + wr * 64 + m * 16 + fr;
                if (idx < ce) { const int pair = tokl[(size_t)u.e * LISTCAP + idx]; const float gt = gatel[(size_t)u.e * LISTCAP + idx]; bf16* rowp = Y + (size_t)pair * 2048 + u.pn * 256 + wc * 32 + 8 * fq;
#pragma unroll
                    for (int bj = 0; bj < 2; ++bj) st_bf8(rowp + bj * 128, acc[ai][bj][m][0] * gt, acc[ai][bj][m][1] * gt); } }
    }
};
struct EpiGlu {
    static constexpr bool PERM = true;
    bf16* O; int ldo, coff; const bf16* Gb; const float* bias;
    __device__ __forceinline__ void operator()(EPI_ARGS) const {
#pragma unroll
        for (int ai = 0; ai < 2; ++ai)
#pragma unroll
            for (int m = 0; m < 4; ++m) { const int r = u.pm * 256 + ai * 128 + wr * 64 + m * 16 + fr;
#pragma unroll
                for (int bj = 0; bj < 2; ++bj) { const int c = u.pn * 256 + bj * 128 + wc * 32 + 8 * fq; const f32x4 b0 = *(const f32x4*)(bias + c), b1 = *(const f32x4*)(bias + c + 4); const v4u gw = *(const v4u*)(Gb + (size_t)r * 1024 + c);
                    const f32x4 a0 = acc[ai][bj][m][0] + b0, a1 = acc[ai][bj][m][1] + b1;
                    const f32x4 o0 = {bflo(gw.x) * sigmoidf_(a0.x), bfhi(gw.x) * sigmoidf_(a0.y), bflo(gw.y) * sigmoidf_(a0.z), bfhi(gw.y) * sigmoidf_(a0.w)};
                    const f32x4 o1 = {bflo(gw.z) * sigmoidf_(a1.x), bfhi(gw.z) * sigmoidf_(a1.y), bflo(gw.w) * sigmoidf_(a1.z), bfhi(gw.w) * sigmoidf_(a1.w)};
                    st_bf8(O + (size_t)r * ldo + coff + c, o0, o1); } }
    }
};

struct MoeOrder {
    const LAS int* bstart;
    const unsigned* cnt; const int* tokl; int nN, G, c, nblk; long bstride, eoff; bool up;
    __device__ bool next(int i, pg8::Unit& u) const {
        const long Lx = (long)i * G + c; if (Lx >= (long)nblk * nN) return false;
        const int blk = (int)(Lx / nN); u.pn = (int)(Lx % nN); u.pm = blk;
        const int e = bstart[65 + blk];
        u.e = e; u.idx0 = (blk - bstart[e]) * 256;
        u.aoff = up ? 0 : (long)blk * 256 * 512 * 2;
        u.boff = (long)e * (long)MOE_E_BYTES + eoff + (long)u.pn * bstride;
        return true;
    }
    __device__ int arow(const pg8::Unit& u, int row) const { const int idx = u.idx0 + row; return idx < (int)cnt[u.e * CSTR] ? (tokl[(size_t)u.e * LISTCAP + idx] >> 1) : TT; }
};

__device__ __forceinline__ void tile_order(int wgid, int nM, int nN, int& pm, int& pn) {
    const int nwg = nM * nN; { const int q = nwg / 8, r = nwg % 8, xcd = wgid % 8, off = wgid / 8; wgid = (xcd < r ? xcd * (q + 1) : r * (q + 1) + (xcd - r) * q) + off; }
    const int nig = 8 * nN, gid = wgid / nig, fm = gid * 8, gsz = (nM - fm) < 8 ? (nM - fm) : 8;
    pm = fm + ((wgid % nig) % gsz); pn = (wgid % nig) / gsz;
}
struct InProj0Order {
    int G, c; long offA1, offB1, offA2, offB2;
    __device__ bool next(int i, pg8::Unit& u) const {
        const int Lx = i * G + c; constexpr int N1 = (TT / 256) * 12, N2 = 4 * (TT / 256); constexpr long TS = 256L * 2048 * 2;
        if (Lx >= N1 + N2) return false;
        u.idx0 = 0;
        if (Lx < N1) { tile_order(Lx, TT / 256, 12, u.pm, u.pn); u.aoff = offA1 + (long)u.pm * TS; u.boff = offB1 + (long)u.pn * TS; u.e = 0; }
        else { tile_order(Lx - N1, 4, TT / 256, u.pm, u.pn); u.aoff = offA2 + (long)u.pm * TS; u.boff = offB2 + (long)u.pn * TS; u.e = 1; }
        return true;
    }
    __device__ int arow(const pg8::Unit&, int) const { return 0; }
};
struct EpiInProj0 {
    static constexpr bool PERM = false;
    EpiQKP e1; EpiVT e2;
    __device__ __forceinline__ void operator()(EPI_ARGS) const { if (u.e == 0) e1(acc, u, wr, wc, fr, fq); else e2(acc, u, wr, wc, fr, fq); }
};

#ifdef ATT_NORARE
#define ATT_RARE(mx) false
#else
#define ATT_RARE(mx) __any(mx > 8.0f)
#endif
__device__ __forceinline__ void attn_phase(Frame& F, const int cvslot) {
    const bf16* Q = WSP(bf16, WS_Q); const bf16* Kb = WSP(bf16, WS_K); const bf16* VT = WSP(bf16, WS_VT); bf16* cat = WSP(bf16, WS_CAT);
    LAS unsigned char* lds = F.lds;
    const int lane0 = F.lane;
    float lam;
    { const float* lv = INP(11); float a = lv[lane0] * lv[64 + lane0], b = lv[128 + lane0] * lv[192 + lane0]; a = wave_sum(a); b = wave_sum(b); lam = expf(a) - expf(b) + 0.2f; }
    const float* subg = INP(12);
    const int NU = 1024 + 32;
    const int xcd = F.bid & 7, jcu = F.bid >> 3;
    for (int it = 0;; ++it) {
        if (it == cvslot) { for (int rep_ = 0; rep_ < (((PH_REPEAT >> 26) & 1u) ? 2 : 1); ++rep_) { moe_convert_items(F); __syncthreads(); } }
        int tl_ = F.tid; asm volatile("" : "+v"(tl_));
        const int lane = tl_ & 63, w = __builtin_amdgcn_readfirstlane(tl_ >> 6), sub = w & 1, qw = w >> 1, r32 = lane & 31, hi = lane >> 5;
        int uidx;
        if (F.G == 256) { if (it < 4) uidx = 128 * xcd + it * 32 + jcu; else if (it == 4 && F.bid < 32) uidx = 1024 + F.bid; else break; }
        else { uidx = it * F.G + F.bid; if (uidx >= NU) break; }
        int b, head, q0row, nt; size_t kbase;
        if (uidx < 1024) { const int combo = uidx >> 6, qb = uidx & 63; b = combo >> 3; head = combo & 7; q0row = b * SEQ + qb * 128; nt = KEYS / 64; }
        else { const int v = uidx - 1024; b = v >> 4; head = (v >> 1) & 7; q0row = TL + b * CTX + (v & 1) * 128; nt = CTX / 64; }
        kbase = (size_t)b * KEYS;
        bf16x8 qf[4];
        { const bf16* qp = Q + (size_t)(q0row + qw * 32 + r32) * 1024 + head * 128 + sub * 64 + hi * 8;
#pragma unroll
          for (int ks = 0; ks < 4; ++ks) qf[ks] = *(const bf16x8*)(qp + ks * 16); }
        const char* gsrc[4];
#pragma unroll
        for (int j = 0; j < 4; ++j) { const int pi = w * 4 + j, rr = lane >> 3, pc = lane & 7;
            if (pi < 16) { const int key = (pi & 7) * 8 + rr, c = pc ^ ((key >> 1) & 7); gsrc[j] = (const char*)(Kb + (kbase + key) * 1024 + head * 128 + (pi >> 3) * 64 + c * 8); }
            else { const int dvr = (pi - 16) * 8 + rr, c = pc ^ ((dvr >> 1) & 7); gsrc[j] = (const char*)(VT + ((size_t)(b * 8 + head) * 128 + dvr) * KEYS + c * 8); } }
        const size_t gstep = (w < 4) ? (size_t)65536 * 2 : (size_t)64 * 2;
        const unsigned ldst = (unsigned)w * 4096u;
#define ATT_DMA(t, buf) do { _Pragma("unroll") for (int _j = 0; _j < 4; ++_j) \
            __builtin_amdgcn_global_load_lds((const unsigned*)(gsrc[_j] + (size_t)(t) * gstep), (LAS unsigned*)(lds + (buf) * 32768 + ldst + _j * 1024), 16, 0, 0); } while (0)
        ATT_DMA(0, 0); ATT_DMA(1, 1); ATT_DMA(2, 2);
        asm volatile("s_waitcnt vmcnt(4)" ::: "memory");
        __builtin_amdgcn_s_barrier();
        f32x16 o[4];
#pragma unroll
        for (int d = 0; d < 4; ++d)
#pragma unroll
            for (int r = 0; r < 16; ++r) o[d][r] = 0.f;
        float mref = 0.f, lrow = 0.f;
        f32x16 negm;
#pragma unroll
        for (int r = 0; r < 16; ++r) negm[r] = 0.f;
        const int rdoff = r32 * 128;
        const int swz = (r32 >> 1) & 7;
        f32x16 s0, s1; bf16x8 pf[4];
#define ATT_QK(bufidx) do { const LAS unsigned char* kp_ = lds + (bufidx) * 32768 + sub * 8192; bf16x8 kfa[4], kfb[4]; \
            _Pragma("unroll") for (int ks = 0; ks < 4; ++ks) { const int ch = ((2 * ks + hi) ^ swz) * 16; kfa[ks] = *(const LAS bf16x8*)(kp_ + rdoff + ch); kfb[ks] = *(const LAS bf16x8*)(kp_ + 4096 + rdoff + ch); } \
            s0 = negm; s1 = negm; \
            _Pragma("unroll") for (int ks = 0; ks < 4; ++ks) { s0 = __builtin_amdgcn_mfma_f32_32x32x16_bf16(kfa[ks], qf[ks], s0, 0, 0, 0); s1 = __builtin_amdgcn_mfma_f32_32x32x16_bf16(kfb[ks], qf[ks], s1, 0, 0, 0); } \
            asm volatile("" : "+v"(s0), "+v"(s1) : "v"(kfa[0]), "v"(kfa[1]), "v"(kfa[2]), "v"(kfa[3]), "v"(kfb[0]), "v"(kfb[1]), "v"(kfb[2]), "v"(kfb[3])); } while (0)
#define ATT_MAX(mx) do { float mxa = fmaxf(fmaxf(s0[0], s0[1]), s0[2]), mxb = fmaxf(fmaxf(s1[0], s1[1]), s1[2]); \
            _Pragma("unroll") for (int r = 3; r < 15; r += 2) { mxa = fmaxf(fmaxf(mxa, s0[r]), s0[r + 1]); mxb = fmaxf(fmaxf(mxb, s1[r]), s1[r + 1]); } \
            mx = fmaxf(fmaxf(mxa, mxb), fmaxf(s0[15], s1[15])); mx = fmaxf(mx, __shfl_xor(mx, 32)); } while (0)
#define ATT_FIX(mx) do { const float dl = fmaxf(mx, 0.f); mref += dl; const float alpha = __builtin_amdgcn_exp2f(-dl); lrow *= alpha; \
            _Pragma("unroll") for (int r = 0; r < 16; ++r) { s0[r] -= dl; s1[r] -= dl; negm[r] = -mref; } \
            _Pragma("unroll") for (int d = 0; d < 4; ++d) _Pragma("unroll") for (int r = 0; r < 16; ++r) o[d][r] *= alpha; } while (0)
#define ATT_EXP8(S, base, dst) do { float rs_ = 0.f; _Pragma("unroll") for (int r = 0; r < 8; ++r) { S[base + r] = __builtin_amdgcn_exp2f(S[base + r]); rs_ += S[base + r]; } lrow += rs_; \
            v4u pw_; pw_.x = cvt_pk_bf16(S[base + 0], S[base + 1]); pw_.y = cvt_pk_bf16(S[base + 2], S[base + 3]); pw_.z = cvt_pk_bf16(S[base + 4], S[base + 5]); pw_.w = cvt_pk_bf16(S[base + 6], S[base + 7]); dst = __builtin_bit_cast(bf16x8, pw_); } while (0)
#define ATT_VLD(dstv, vp_, s) do { _Pragma("unroll") for (int d = 0; d < 4; ++d) dstv[d] = *(const LAS bf16x8*)(vp_ + d * 4096 + rdoff + (((2 * (s) + hi) ^ swz) * 16)); } while (0)
#define ATT_PV4(srcv, pfrag) do { _Pragma("unroll") for (int d = 0; d < 4; ++d) o[d] = __builtin_amdgcn_mfma_f32_32x32x16_bf16(srcv[d], pfrag, o[d], 0, 0, 0); } while (0)
        { ATT_QK(0); float mx; ATT_MAX(mx); if (__any(mx > 8.0f)) ATT_FIX(mx);
          ATT_EXP8(s0, 0, pf[0]); ATT_EXP8(s0, 8, pf[1]); ATT_EXP8(s1, 0, pf[2]); ATT_EXP8(s1, 8, pf[3]); }
        int bcur = 0;
#pragma nounroll
        for (int t = 0; t < nt; ++t) {
            const int bn1 = (bcur + 1) & 3, bn3 = (bcur + 3) & 3;
            if (t + 3 < nt) ATT_DMA(t + 3, bn3);
            const LAS unsigned char* vp = lds + bcur * 32768 + 16384;
            bf16x8 vfa[4], vfb[4];
            if (t + 1 < nt) {
                __builtin_amdgcn_sched_barrier(0);
                ATT_QK(bn1);
                float mx; ATT_MAX(mx);
                __builtin_amdgcn_sched_barrier(0);
                if (__any(mx > 8.0f)) {
                    const float dl = fmaxf(mx, 0.f); mref += dl; const float alpha = __builtin_amdgcn_exp2f(-dl); lrow *= alpha;
#pragma unroll
                    for (int r = 0; r < 16; ++r) { s0[r] -= dl; s1[r] -= dl; negm[r] = -mref; }
#pragma unroll
                    for (int d = 0; d < 4; ++d)
#pragma unroll
                        for (int r = 0; r < 16; ++r) o[d][r] *= alpha;
#pragma unroll
                    for (int s = 0; s < 4; ++s) { v4u pw = __builtin_bit_cast(v4u, pf[s]);
                        pw.x = cvt_pk_bf16(bflo(pw.x) * alpha, bfhi(pw.x) * alpha); pw.y = cvt_pk_bf16(bflo(pw.y) * alpha, bfhi(pw.y) * alpha);
                        pw.z = cvt_pk_bf16(bflo(pw.z) * alpha, bfhi(pw.z) * alpha); pw.w = cvt_pk_bf16(bflo(pw.w) * alpha, bfhi(pw.w) * alpha); pf[s] = __builtin_bit_cast(bf16x8, pw); }
                }
                __builtin_amdgcn_sched_barrier(0);
                {
                    ATT_VLD(vfa, vp, 0);
                    __builtin_amdgcn_sched_barrier(0);
                    ATT_VLD(vfb, vp, 1); ATT_PV4(vfa, pf[0]); ATT_EXP8(s0, 0, pf[0]);
                    __builtin_amdgcn_sched_barrier(0);
                    ATT_VLD(vfa, vp, 2); ATT_PV4(vfb, pf[1]); ATT_EXP8(s0, 8, pf[1]);
                    __builtin_amdgcn_sched_barrier(0);
                    ATT_VLD(vfb, vp, 3); ATT_PV4(vfa, pf[2]); ATT_EXP8(s1, 0, pf[2]);
                    __builtin_amdgcn_sched_barrier(0);
                    ATT_PV4(vfb, pf[3]); ATT_EXP8(s1, 8, pf[3]);
                }
                __builtin_amdgcn_sched_barrier(0);
            } else {
#pragma unroll
                for (int s = 0; s < 4; ++s) { ATT_VLD(vfa, vp, s); ATT_PV4(vfa, pf[s]); }
            }
            if (t + 3 < nt) asm volatile("s_waitcnt vmcnt(4) lgkmcnt(0)" ::: "memory"); else asm volatile("s_waitcnt vmcnt(0) lgkmcnt(0)" ::: "memory");
            __builtin_amdgcn_s_barrier();
            bcur = bn1;
        }
#undef ATT_DMA
#undef ATT_QK
#undef ATT_MAX
#undef ATT_FIX
#undef ATT_EXP8
#undef ATT_VLD
#undef ATT_PV4
        const float ltot = lrow + __shfl_xor(lrow, 32); const float linv = 1.0f / ltot;
        LAS float* xch = (LAS float*)lds + (size_t)(qw * 32 + r32) * 132;
        if (sub == 1) {
#pragma unroll
            for (int d = 0; d < 4; ++d)
#pragma unroll
                for (int g = 0; g < 4; ++g) *(LAS f32x4*)(xch + 32 * d + 8 * g + 4 * hi) = (f32x4){o[d][4 * g] * linv, o[d][4 * g + 1] * linv, o[d][4 * g + 2] * linv, o[d][4 * g + 3] * linv};
        }
        __syncthreads();
        if (sub == 0) {
            float ss = 0.f;
#pragma unroll
            for (int d = 0; d < 4; ++d)
#pragma unroll
                for (int g = 0; g < 4; ++g) { const f32x4 o2 = *(const LAS f32x4*)(xch + 32 * d + 8 * g + 4 * hi);
#pragma unroll
                    for (int j = 0; j < 4; ++j) { const float v = o[d][4 * g + j] * linv - lam * o2[j]; o[d][4 * g + j] = v; ss += v * v; } }
            ss += __shfl_xor(ss, 32);
            const float rn = 0.8f / sqrtf(ss * (1.0f / 128.0f) + EPS);
            bf16* op = cat + (size_t)(q0row + qw * 32 + r32) * 2048 + head * 128;
#pragma unroll
            for (int d = 0; d < 4; ++d)
#pragma unroll
                for (int g = 0; g < 4; ++g) { const int dv = 32 * d + 8 * g + 4 * hi; const f32x4 gg = *(const f32x4*)(subg + dv);
                    st_bf4(op + dv, (f32x4){o[d][4 * g] * rn * gg.x, o[d][4 * g + 1] * rn * gg.y, o[d][4 * g + 2] * rn * gg.z, o[d][4 * g + 3] * rn * gg.w}); }
        }
        __syncthreads();
    }
}

__device__ __forceinline__ void poold_phase(Frame& F) {
    const bf16* P = WSP(bf16, WS_P); bf16* PD = WSP(bf16, WS_PD);
    const int gt = F.bid * NTHREADS + F.tid, NGT = F.G * NTHREADS;
    for (int idx = gt; idx < TT * 128; idx += NGT) {
        const int r = idx >> 7, cc = (idx & 127) * 8, g = cc >> 8, wdw = 2 << g;
        int sb, t, Ls; if (r < TL) { sb = (r / SEQ) * SEQ; t = r % SEQ; Ls = SEQ; } else { sb = TL + ((r - TL) / CTX) * CTX; t = (r - TL) % CTX; Ls = CTX; }
        int lo = t - wdw / 2, hi = lo + wdw; lo = lo < 0 ? 0 : lo; hi = hi > Ls ? Ls : hi;
        float a[8];
#pragma unroll
        for (int j = 0; j < 8; ++j) a[j] = 0.f;
        for (int s = lo; s < hi; ++s) { const v4u v = *(const v4u*)(P + (size_t)(sb + s) * 1024 + cc);
            a[0] += bflo(v.x); a[1] += bfhi(v.x); a[2] += bflo(v.y); a[3] += bfhi(v.y); a[4] += bflo(v.z); a[5] += bfhi(v.z); a[6] += bflo(v.w); a[7] += bfhi(v.w); }
        const float inv = 1.0f / (float)(hi - lo);
        const v4u me = *(const v4u*)(P + (size_t)r * 1024 + cc);
        v4u o; o.x = pk2(a[0] * inv - bflo(me.x), a[1] * inv - bfhi(me.x)); o.y = pk2(a[2] * inv - bflo(me.y), a[3] * inv - bfhi(me.y));
        o.z = pk2(a[4] * inv - bflo(me.z), a[5] * inv - bfhi(me.z)); o.w = pk2(a[6] * inv - bflo(me.w), a[7] * inv - bfhi(me.w));
        *(v4u*)(PD + (size_t)r * 1024 + cc) = o;
    }
}

__device__ __forceinline__ void shortconv_phase(Frame& F) {
    const bf16* PJ = WSP(bf16, WS_PROJ1); float* GT = WSP(float, WS_GT);
    const float* cw = INP(17); const float* cb = INP(18);
    LAS float* scr = (LAS float*)(F.lds + F.wave * 17408);
    const int lane = F.lane;
    for (int it = F.gw; it < 2 * 128 * 48; it += F.NGW) {
        const int cbk = it % 48, tb = (it / 48) % 128, b = it / (48 * 128), col = cbk * 64 + lane, t0 = tb * 64;
        const bf16* base = PJ + ((size_t)b * SEQ) * 4096 + cbk * 64 + (lane & 7) * 8;
#pragma unroll
        for (int i = 0; i < 9; ++i) { const int row = 8 * i + (lane >> 3); const int t = t0 - 1 + row;
            if (row < 66) { v4u v = {0u, 0u, 0u, 0u}; if (t >= 0 && t < SEQ) v = *(const v4u*)(base + (size_t)t * 4096);
                LAS float* d = scr + row * 65 + (lane & 7) * 8; d[0] = bflo(v.x); d[1] = bfhi(v.x); d[2] = bflo(v.y); d[3] = bfhi(v.y); d[4] = bflo(v.z); d[5] = bfhi(v.z); d[6] = bflo(v.w); d[7] = bfhi(v.w); } }
        LDS_WAIT(); asm volatile("" ::: "memory");
        const float w0 = cw[col], w1 = cw[3072 + col], w2 = cw[2 * 3072 + col], bias = cb[col];
        float prev = scr[lane], cur = scr[65 + lane];
#pragma unroll 8
        for (int tt = 0; tt < 64; ++tt) { const float nxt = scr[(tt + 2) * 65 + lane]; const float o = prev * w0 + cur * w1 + nxt * w2 + bias; scr[tt * 65 + lane] = o; prev = cur; cur = nxt; }
        LDS_WAIT(); asm volatile("" ::: "memory");
        for (int c = 0; c < 64; ++c) GT[((size_t)(cbk * 64 + c) * 2 + b) * SEQ + t0 + lane] = scr[lane * 65 + c];
        LDS_WAIT(); asm volatile("" ::: "memory");
    }
}

__device__ __forceinline__ void s5_gelu_phase(Frame& F) {
    const bf16* PJ = WSP(bf16, WS_PROJ1); const float* YD = WSP(float, WS_YD); bf16* Gb = WSP(bf16, WS_PD); const float* dd = INP(33);
    const int gt = F.bid * NTHREADS + F.tid, NGT = F.G * NTHREADS;
    for (int idx = gt; idx < TL * 256; idx += NGT) { const int r = idx >> 8, c = (idx & 255) * 4;
        const v2u uw = *(const v2u*)(PJ + (size_t)r * 4096 + 3072 + c); const f32x4 d4 = *(const f32x4*)(dd + c);
        const int bb = r / SEQ, tt = r % SEQ, gg = c >> 4, cc = c & 15;
        const f32x4 y0 = *(const f32x4*)(YD + (((size_t)(0 * 2 + bb) * 64 + gg) * SEQ + tt) * 16 + cc), y1 = *(const f32x4*)(YD + (((size_t)(1 * 2 + bb) * 64 + gg) * SEQ + tt) * 16 + cc);
        const f32x4 y = {bflo(uw.x) * d4.x + y0.x + y1.x, bfhi(uw.x) * d4.y + y0.y + y1.y, bflo(uw.y) * d4.z + y0.z + y1.z, bfhi(uw.y) * d4.w + y0.w + y1.w};
        st_bf4(Gb + (size_t)r * 1024 + c, (f32x4){gelu_tanh(y.x), gelu_tanh(y.y), gelu_tanh(y.z), gelu_tanh(y.w)}); }
}

__device__ __forceinline__ f32x2 cmulf(f32x2 a, f32x2 b) { return (f32x2){a.x * b.x - a.y * b.y, a.x * b.y + a.y * b.x}; }
__device__ __forceinline__ int drev14(int p) { const unsigned r = __builtin_bitreverse32((unsigned)p) >> 18; return (int)(((r & 0x2AAAu) >> 1) | ((r & 0x1555u) << 1)); }
template <int L, bool ZHI>
__device__ __forceinline__ void fft_fwd_pass(LAS f32x2* X, const f32x2* tw, int tid) {
    constexpr int tws = 4096 / L;
    if constexpr (L == 1) {
#pragma unroll 2
        for (int i = 0; i < 8; ++i) { const int i0 = (tid + NTHREADS * i) * 4;
            const f32x4 p01 = *(const LAS f32x4*)(X + i0), p23 = *(const LAS f32x4*)(X + i0 + 2);
            const f32x2 x0 = {p01.x, p01.y}, x1 = {p01.z, p01.w}, x2 = {p23.x, p23.y}, x3 = {p23.z, p23.w};
            const f32x2 a = x0 + x2, bb = x0 - x2, c = x1 + x3, d = x1 - x3;
            const f32x2 y0 = a + c, y1 = {bb.x + d.y, bb.y - d.x}, y2 = a - c, y3 = {bb.x - d.y, bb.y + d.x};
            *(LAS f32x4*)(X + i0) = (f32x4){y0.x, y0.y, y1.x, y1.y}; *(LAS f32x4*)(X + i0 + 2) = (f32x4){y2.x, y2.y, y3.x, y3.y}; }
        LDS_BARRIER();
        return;
    }
#pragma unroll 2
    for (int i = 0; i < 8; ++i) {
        const int b = tid + NTHREADS * i, j = b & (L - 1), i0 = (b - j) * 4 + j;
        const f32x2 w1 = tw[j * tws], w2 = cmulf(w1, w1), w3 = cmulf(w2, w1);
        const f32x2 x0 = X[i0], x1 = X[i0 + L];
        if (ZHI) {
            const f32x2 t1 = {x0.x + x1.y, x0.y - x1.x}, t3 = {x0.x - x1.y, x0.y + x1.x};
            X[i0] = x0 + x1; X[i0 + L] = cmulf(t1, w1); X[i0 + 2 * L] = cmulf(x0 - x1, w2); X[i0 + 3 * L] = cmulf(t3, w3);
        } else {
            const f32x2 x2 = X[i0 + 2 * L], x3 = X[i0 + 3 * L];
            const f32x2 a = x0 + x2, bb = x0 - x2, c = x1 + x3, d = x1 - x3;
            const f32x2 t1 = {bb.x + d.y, bb.y - d.x}, t3 = {bb.x - d.y, bb.y + d.x};
            X[i0] = a + c; X[i0 + L] = cmulf(t1, w1); X[i0 + 2 * L] = cmulf(a - c, w2); X[i0 + 3 * L] = cmulf(t3, w3);
        }
    }
    LDS_BARRIER();
}
template <int L>
__device__ __forceinline__ void fft_fwd_pass16(LAS f32x2* X, const f32x2* tw, int tid) {
    constexpr int Q = L / 4, tws = 4096 / L;
    const int jq = tid & (Q - 1);
    f32x2 wa[4][3];
#pragma unroll
    for (int mq = 0; mq < 4; ++mq) { const f32x2 w1 = tw[(mq * Q + jq) * tws]; wa[mq][0] = w1; wa[mq][1] = cmulf(w1, w1); wa[mq][2] = cmulf(wa[mq][1], w1); }
    const f32x2 v1 = tw[jq * 4 * tws], v2 = cmulf(v1, v1), v3 = cmulf(v2, v1);
#pragma unroll
    for (int i = 0; i < 2; ++i) {
        const int u = tid + NTHREADS * i, base = (u / Q) * 4 * L + jq;
        f32x2 pt[4][4];
#pragma unroll
        for (int m = 0; m < 4; ++m)
#pragma unroll
            for (int mq = 0; mq < 4; ++mq) pt[m][mq] = X[base + m * L + mq * Q];
#pragma unroll
        for (int mq = 0; mq < 4; ++mq) {
            const f32x2 x0 = pt[0][mq], x1 = pt[1][mq], x2 = pt[2][mq], x3 = pt[3][mq];
            const f32x2 a = x0 + x2, bb = x0 - x2, c = x1 + x3, d = x1 - x3;
            const f32x2 t1 = {bb.x + d.y, bb.y - d.x}, t3 = {bb.x - d.y, bb.y + d.x};
            pt[0][mq] = a + c; pt[1][mq] = cmulf(t1, wa[mq][0]); pt[2][mq] = cmulf(a - c, wa[mq][1]); pt[3][mq] = cmulf(t3, wa[mq][2]);
        }
#pragma unroll
        for (int m = 0; m < 4; ++m) {
            const f32x2 x0 = pt[m][0], x1 = pt[m][1], x2 = pt[m][2], x3 = pt[m][3];
            const f32x2 a = x0 + x2, bb = x0 - x2, c = x1 + x3, d = x1 - x3;
            const f32x2 t1 = {bb.x + d.y, bb.y - d.x}, t3 = {bb.x - d.y, bb.y + d.x};
            X[base + m * L] = a + c; X[base + m * L + Q] = cmulf(t1, v1); X[base + m * L + 2 * Q] = cmulf(a - c, v2); X[base + m * L + 3 * Q] = cmulf(t3, v3);
        }
    }
    LDS_BARRIER();
}
template <bool ZHI>
__device__ __forceinline__ void fft_fwd(LAS f32x2* X, const f32x2* tw, int tid) {
    fft_fwd_pass<4096, ZHI>(X, tw, tid); fft_fwd_pass16<1024>(X, tw, tid); fft_fwd_pass16<64>(X, tw, tid);
    fft_fwd_pass<4, false>(X, tw, tid); fft_fwd_pass<1, false>(X, tw, tid);
}
template <int L, bool LOHALF>
__device__ __forceinline__ void fft_inv_pass(LAS f32x2* X, const f32x2* tw, int tid) {
    constexpr int tws = 4096 / L;
    if constexpr (L == 1) {
#pragma unroll 2
        for (int i = 0; i < 8; ++i) { const int i0 = (tid + NTHREADS * i) * 4;
            const f32x4 p01 = *(const LAS f32x4*)(X + i0), p23 = *(const LAS f32x4*)(X + i0 + 2);
            const f32x2 x0 = {p01.x, p01.y}, x1 = {p01.z, p01.w}, x2 = {p23.x, p23.y}, x3 = {p23.z, p23.w};
            const f32x2 a = x0 + x2, bb = x0 - x2, c = x1 + x3, d = x1 - x3;
            const f32x2 y0 = a + c, y1 = {bb.x - d.y, bb.y + d.x}, y2 = a - c, y3 = {bb.x + d.y, bb.y - d.x};
            *(LAS f32x4*)(X + i0) = (f32x4){y0.x, y0.y, y1.x, y1.y}; *(LAS f32x4*)(X + i0 + 2) = (f32x4){y2.x, y2.y, y3.x, y3.y}; }
        LDS_BARRIER();
        return;
    }
#pragma unroll 2
    for (int i = 0; i < 8; ++i) {
        const int b = tid + NTHREADS * i, j = b & (L - 1), i0 = (b - j) * 4 + j;
        f32x2 w1 = tw[j * tws]; w1.y = -w1.y; const f32x2 w2 = cmulf(w1, w1), w3 = cmulf(w2, w1);
        const f32x2 x0 = X[i0], x1 = cmulf(X[i0 + L], w1), x2 = cmulf(X[i0 + 2 * L], w2), x3 = cmulf(X[i0 + 3 * L], w3);
        const f32x2 a = x0 + x2, bb = x0 - x2, c = x1 + x3, d = x1 - x3;
        X[i0] = a + c; X[i0 + L] = (f32x2){bb.x - d.y, bb.y + d.x};
        if (!LOHALF) { X[i0 + 2 * L] = a - c; X[i0 + 3 * L] = (f32x2){bb.x + d.y, bb.y - d.x}; }
    }
    LDS_BARRIER();
}
template <int L>
__device__ __forceinline__ void fft_inv_pass16(LAS f32x2* X, const f32x2* tw, int tid) {
    constexpr int tws = 4096 / L, tws4 = 1024 / L;
    const int jq = tid & (L - 1);
    f32x2 v1 = tw[jq * tws]; v1.y = -v1.y; const f32x2 v2 = cmulf(v1, v1), v3 = cmulf(v2, v1);
    f32x2 wb[4][3];
#pragma unroll
    for (int mq = 0; mq < 4; ++mq) { f32x2 w1 = tw[(mq * L + jq) * tws4]; w1.y = -w1.y; wb[mq][0] = w1; wb[mq][1] = cmulf(w1, w1); wb[mq][2] = cmulf(wb[mq][1], w1); }
#pragma unroll
    for (int i = 0; i < 2; ++i) {
        const int u = tid + NTHREADS * i, base = (u / L) * 16 * L + jq;
        f32x2 pt[4][4];
#pragma unroll
        for (int M = 0; M < 4; ++M)
#pragma unroll
            for (int mq = 0; mq < 4; ++mq) pt[M][mq] = X[base + M * 4 * L + mq * L];
#pragma unroll
        for (int M = 0; M < 4; ++M) {
            const f32x2 x0 = pt[M][0], x1 = cmulf(pt[M][1], v1), x2 = cmulf(pt[M][2], v2), x3 = cmulf(pt[M][3], v3);
            const f32x2 a = x0 + x2, bb = x0 - x2, c = x1 + x3, d = x1 - x3;
            pt[M][0] = a + c; pt[M][1] = (f32x2){bb.x - d.y, bb.y + d.x}; pt[M][2] = a - c; pt[M][3] = (f32x2){bb.x + d.y, bb.y - d.x};
        }
#pragma unroll
        for (int mq = 0; mq < 4; ++mq) {
            const f32x2 x0 = pt[0][mq], x1 = cmulf(pt[1][mq], wb[mq][0]), x2 = cmulf(pt[2][mq], wb[mq][1]), x3 = cmulf(pt[3][mq], wb[mq][2]);
            const f32x2 a = x0 + x2, bb = x0 - x2, c = x1 + x3, d = x1 - x3;
            X[base + mq * L] = a + c; X[base + 4 * L + mq * L] = (f32x2){bb.x - d.y, bb.y + d.x}; X[base + 8 * L + mq * L] = a - c; X[base + 12 * L + mq * L] = (f32x2){bb.x + d.y, bb.y - d.x};
        }
    }
    LDS_BARRIER();
}
__device__ __forceinline__ void fft_inv(LAS f32x2* X, const f32x2* tw, int tid) {
    fft_inv_pass<1, false>(X, tw, tid); fft_inv_pass<4, false>(X, tw, tid); fft_inv_pass16<16>(X, tw, tid); fft_inv_pass16<256>(X, tw, tid);
    fft_inv_pass<4096, true>(X, tw, tid);
}
__device__ __forceinline__ void fft_pointwise(LAS f32x2* X, const f32x2* Wg, int o, float scale, int tid) {
    const float hs = 0.5f * scale;
#pragma unroll 4
    for (int i = 0; i < 32; ++i) {
        const int p = tid + NTHREADS * i, f = drev14(p), pm = drev14((16384 - f) & 16383);
        const unsigned long long ua = __hip_atomic_load((const unsigned long long*)(Wg + p), __ATOMIC_RELAXED, __HIP_MEMORY_SCOPE_AGENT);
        const unsigned long long ub = __hip_atomic_load((const unsigned long long*)(Wg + pm), __ATOMIC_RELAXED, __HIP_MEMORY_SCOPE_AGENT);
        const f32x2 A = __builtin_bit_cast(f32x2, ua), B = __builtin_bit_cast(f32x2, ub);
        f32x2 K;
        if (o == 0) K = (f32x2){(A.x + B.x) * hs, (A.y - B.y) * hs};
        else { const f32x2 dd = {A.x - B.x, A.y + B.y}; K = (f32x2){dd.y * hs, -dd.x * hs}; }
        X[p] = cmulf(X[p], K);
    }
    LDS_BARRIER();
}
__device__ __forceinline__ void hyena_fft_phase(Frame& F) {
    float* GT = WSP(float, WS_GT); const float* kT = WSP(float, WS_KT); const float* invn = WSP(float, WS_INVN); const f32x2* tw = WSP(f32x2, WS_TW);
    f32x2* Wg = WSP(f32x2, WS_FFTW) + (size_t)F.bid * 16384;
    const float* hyb = INP(25);
    LAS f32x2* X = (LAS f32x2*)F.lds;
    const int tid = F.tid;
    for (int ch = F.bid; ch < 1024; ch += F.G) {
        { const float* f0 = kT + (size_t)ch * SEQ; const float* b0 = kT + (size_t)(1024 + ch) * SEQ; const float* f1 = kT + (size_t)(2048 + ch) * SEQ; const float* b1 = kT + (size_t)(3072 + ch) * SEQ;
          for (int n = tid; n < SEQ; n += NTHREADS) { X[n] = (f32x2){f0[n], f1[n]}; X[SEQ + n] = (n == 0) ? (f32x2){0.f, 0.f} : (f32x2){b0[SEQ - n], b1[SEQ - n]}; } }
        const float* v0 = GT + ((size_t)ch * 2) * SEQ; float* yo = WSP(float, WS_YHT) + ((size_t)ch * 2) * SEQ;
        const float* x1 = GT + ((size_t)(1024 + ch) * 2) * SEQ; const float* x2 = GT + ((size_t)(2048 + ch) * 2) * SEQ;
        float z0[16], z1[16];
#pragma unroll
        for (int j = 0; j < 16; ++j) { const int n = tid + NTHREADS * j; z0[j] = v0[n]; z1[j] = v0[SEQ + n]; }
        LDS_BARRIER();
        fft_fwd<false>(X, tw, tid);
        for (int n = tid; n < 16384; n += NTHREADS) Wg[n] = X[n];
        __syncthreads();
#pragma unroll
        for (int o = 0; o < 2; ++o) {
            const float* xg = (o == 0) ? x1 : x2;
            float g0[16], g1[16];
#pragma unroll
            for (int j = 0; j < 16; ++j) { const int n = tid + NTHREADS * j; g0[j] = xg[n]; g1[j] = xg[SEQ + n]; }
#pragma unroll
            for (int j = 0; j < 16; ++j) { const int n = tid + NTHREADS * j; X[n] = (f32x2){z0[j], z1[j]}; }
            LDS_BARRIER();
            fft_fwd<true>(X, tw, tid);
            fft_pointwise(X, Wg, o, invn[o * 1024 + ch] * (1.0f / 16384.0f), tid);
            fft_inv(X, tw, tid);
            const float bias = hyb[o * 1024 + ch];
#pragma unroll
            for (int j = 0; j < 16; ++j) { const int n = tid + NTHREADS * j; const f32x2 y = X[n]; z0[j] = g0[j] * (y.x + bias * z0[j]); z1[j] = g1[j] * (y.y + bias * z1[j]); }
            LDS_BARRIER();
        }
#pragma unroll
        for (int j = 0; j < 16; ++j) { const int n = tid + NTHREADS * j; yo[n] = z0[j]; yo[SEQ + n] = z1[j]; }
    }
}
__device__ __forceinline__ void hyena_out_transpose(Frame& F) {
    const float* GT = WSP(float, WS_YHT); bf16* cat = WSP(bf16, WS_CAT);
    LAS float* scr = (LAS float*)(F.lds + F.wave * 17408);
    const int lane = F.lane;
    for (int it = F.gw; it < 2 * 128 * 16; it += F.NGW) {
        const int cbk = it & 15, tb = (it >> 4) & 127, b = it >> 11, t0 = tb * 64;
        for (int c = 0; c < 64; ++c) scr[c * 65 + lane] = GT[((size_t)(cbk * 64 + c) * 2 + b) * SEQ + t0 + lane];
        LDS_WAIT(); asm volatile("" ::: "memory");
#pragma unroll
        for (int i = 0; i < 8; ++i) { const int tt = 8 * i + (lane >> 3), c0 = (lane & 7) * 8; const LAS float* s = scr + c0 * 65 + tt;
            v4u o; o.x = cvt_pk_bf16(s[0], s[65]); o.y = cvt_pk_bf16(s[130], s[195]); o.z = cvt_pk_bf16(s[260], s[325]); o.w = cvt_pk_bf16(s[390], s[455]);
            *(v4u*)(cat + ((size_t)b * SEQ + t0 + tt) * 2048 + cbk * 64 + c0) = o; }
        LDS_WAIT(); asm volatile("" ::: "memory");
    }
}

__device__ __forceinline__ int s5_row(int di, int b, int s) {
    return (s < CTX) ? TL + b * CTX + (di == 0 ? s : CTX - 1 - s) : b * SEQ + (di == 0 ? s - CTX : SEQ - 1 - (s - CTX));
}
typedef float f32x4_t __attribute__((ext_vector_type(4)));
#define S5_KEEP8(acc, f) asm volatile("" : "+v"(acc) : "v"(f[0]), "v"(f[1]), "v"(f[2]), "v"(f[3]), "v"(f[4]), "v"(f[5]), "v"(f[6]), "v"(f[7]))
#define S5_KEEP4(acc, f) asm volatile("" : "+v"(acc) : "v"(f[0]), "v"(f[1]), "v"(f[2]), "v"(f[3]))
template <bool OUTPUT>
__device__ __forceinline__ void s5_chunk_phase(Frame& F) {
    const bf16* PJ = WSP(bf16, WS_PROJ1); float* YD = WSP(float, WS_YD);
    const f32x2* l16t = WSP(f32x2, WS_S5L16); const f32x2* l256 = WSP(f32x2, WS_S5L256); f32x2* Eb = WSP(f32x2, WS_S5E);
    const bf16* W1 = WSP(bf16, WS_S5W1); const bf16* W3 = WSP(bf16, WS_S5W3); const bf16* KT = WSP(bf16, WS_S5KT);
    const int lane = F.lane, fr = lane & 15, fq = lane >> 4;
    LAS unsigned* Xl = (LAS unsigned*)(F.lds + F.wave * 4608);
    f32x2 carry[4];
#pragma unroll
    for (int t = 0; t < 4; ++t) carry[t] = (f32x2){0.f, 0.f};
#pragma nounroll
    for (int j = 0;; ++j) {
        const int tq = F.wave * F.G + F.bid + (j >> 2) * F.NGW, sub4 = j & 3;
        if (tq >= 256 * 8) break;
        const int task = tq * 4 + sub4;
        const int dbg = task >> 5, seg = (task & 31) + (OUTPUT ? 1 : 0);
        const int di = dbg >> 7, b = (dbg >> 6) & 1, g = dbg & 63;
        const int dg = di * 64 + g;
        const int s0 = seg * 256;
        bf16x8 afr[8];
#pragma unroll
        for (int ks = 0; ks < 8; ++ks) afr[ks] = *(const bf16x8*)(PJ + (size_t)s5_row(di, b, s0 + 16 * fr + 2 * ks + (fq >> 1)) * 4096 + 3072 + g * 16 + 8 * (fq & 1));
        f32x4 ea[8];
        { const bf16* w1p = W1 + ((size_t)dg * 128 + fr) * 256 + 8 * fq;
#pragma unroll
          for (int nt = 0; nt < 8; ++nt) { f32x4 a = {0.f, 0.f, 0.f, 0.f}; bf16x8 bw[8];
#pragma unroll
              for (int ks = 0; ks < 8; ++ks) bw[ks] = *(const bf16x8*)(w1p + (size_t)nt * 16 * 256 + 32 * ks);
#pragma unroll
              for (int ks = 0; ks < 8; ++ks) a = __builtin_amdgcn_mfma_f32_16x16x32_bf16(afr[ks], bw[ks], a, 0, 0, 0);
              S5_KEEP8(a, bw); S5_KEEP8(a, afr);
              ea[nt] = a; } }
        f32x2 st[4];
#pragma unroll
        for (int t = 0; t < 4; ++t) st[t] = (f32x2){0.f, 0.f};
        if (OUTPUT) {
#pragma unroll
            for (int t = 0; t < 4; ++t) { const f32x2 lq = l256[dg * 64 + 16 * t + fr]; const f32x2* ep = Eb + ((size_t)dbg * 32) * 64 + 16 * t + fr;
                if (sub4 == 0) {
                    int k = 0;
                    for (; k + 8 <= seg; k += 8) { f32x2 e8[8];
#pragma unroll
                        for (int j = 0; j < 8; ++j) e8[j] = ep[(size_t)(k + j) * 64];
#pragma unroll
                        for (int j = 0; j < 8; ++j) st[t] = cmulf(lq, st[t]) + e8[j]; }
                    for (; k < seg; ++k) st[t] = cmulf(lq, st[t]) + ep[(size_t)k * 64];
                } else st[t] = cmulf(lq, carry[t]) + ep[(size_t)(seg - 1) * 64];
                carry[t] = st[t]; }
        }
#pragma unroll
        for (int t = 0; t < 4; ++t) {
            const f32x2 L1 = l16t[dg * 64 + 16 * t + fr], L2 = cmulf(L1, L1), L3 = cmulf(L2, L1), L4 = cmulf(L2, L2);
            const f32x2 x0 = {ea[t][0], ea[4 + t][0]}, x1 = cmulf(L1, x0) + (f32x2){ea[t][1], ea[4 + t][1]}, x2 = cmulf(L1, x1) + (f32x2){ea[t][2], ea[4 + t][2]}, x3 = cmulf(L1, x2) + (f32x2){ea[t][3], ea[4 + t][3]};
            f32x2 sin = st[t];
            f32x2 fin = x3 + cmulf(L4, (fq == 0) ? sin : (f32x2){0.f, 0.f});
#pragma unroll
            for (int rd = 1; rd < 4; ++rd) { const float vr = __shfl(fin.x, lane - 16), vi = __shfl(fin.y, lane - 16);
                if (fq == rd) { sin = (f32x2){vr, vi}; fin = x3 + cmulf(L4, sin); } }
            if (OUTPUT) {
                const f32x2 h1 = x0 + cmulf(L1, sin), h2 = x1 + cmulf(L2, sin), h3 = x2 + cmulf(L3, sin);
                Xl[(4 * fq + 0) * 68 + 16 * t + fr] = cvt_pk_bf16(sin.x, sin.y); Xl[(4 * fq + 1) * 68 + 16 * t + fr] = cvt_pk_bf16(h1.x, h1.y);
                Xl[(4 * fq + 2) * 68 + 16 * t + fr] = cvt_pk_bf16(h2.x, h2.y); Xl[(4 * fq + 3) * 68 + 16 * t + fr] = cvt_pk_bf16(h3.x, h3.y);
            } else {
                st[t] = (f32x2){__shfl(fin.x, 48 + fr), __shfl(fin.y, 48 + fr)};
            }
        }
        if (!OUTPUT) {
            if (fq == 0) {
#pragma unroll
                for (int t = 0; t < 4; ++t) Eb[((size_t)dbg * 32 + seg) * 64 + 16 * t + fr] = st[t];
            }
        } else {
            LDS_WAIT(); asm volatile("" ::: "memory");
            bf16x8 hfr[4];
#pragma unroll
            for (int ks = 0; ks < 4; ++ks) hfr[ks] = *(const LAS bf16x8*)(Xl + fr * 68 + 16 * ks + 4 * fq);
            LDS_WAIT(); asm volatile("" ::: "memory");
            const bf16* w3p = W3 + ((size_t)dg * 256 + fr) * 128 + 8 * fq;
            const bf16* ktp = KT + (size_t)dg * 17 * 256 + fr * 16 + 8 * (fq & 1);
#pragma unroll
            for (int tau = 0; tau < 16; ++tau) {
                f32x4 y = {0.f, 0.f, 0.f, 0.f}; bf16x8 b3[4], bk[8];
#pragma unroll
                for (int ks = 0; ks < 4; ++ks) b3[ks] = *(const bf16x8*)(w3p + (size_t)tau * 16 * 128 + 32 * ks);
#pragma unroll
                for (int ks = 0; ks < 8; ++ks) { const int d1 = (ks <= tau / 2) ? tau - 2 * ks - (fq >> 1) + 1 : 0;
                    bk[ks] = *(const bf16x8*)(ktp + (size_t)d1 * 256); }
#pragma unroll
                for (int ks = 0; ks < 4; ++ks) y = __builtin_amdgcn_mfma_f32_16x16x32_bf16(hfr[ks], b3[ks], y, 0, 0, 0);
#pragma unroll
                for (int ks = 0; ks <= tau / 2; ++ks) y = __builtin_amdgcn_mfma_f32_16x16x32_bf16(afr[ks], bk[ks], y, 0, 0, 0);
                S5_KEEP4(y, b3); S5_KEEP8(y, bk); S5_KEEP8(y, afr); S5_KEEP4(y, hfr);
#pragma unroll
                for (int r = 0; r < 4; ++r) { const int s = s0 + 16 * (4 * fq + r) + tau, tl = (di == 0) ? s - CTX : SEQ - 1 - (s - CTX);
                    YD[(((size_t)(di * 2 + b) * 64 + g) * SEQ + tl) * 16 + fr] = y[r]; }
            }
        }
    }
}


constexpr int NPHASES = 21;
#ifndef MK_SINGLE
#define MK_SINGLE 1
#endif

__device__ __forceinline__ unsigned long long launder_u64(unsigned long long v) {
    unsigned lo = (unsigned)v, hi = (unsigned)(v >> 32);
    asm volatile("" : "+v"(lo), "+v"(hi));
    lo = __builtin_amdgcn_readfirstlane(lo); hi = __builtin_amdgcn_readfirstlane(hi);
    return ((unsigned long long)hi << 32) | lo;
}
__device__ __forceinline__ const void* launder_ptr(const void* p) {
    unsigned long long v = (unsigned long long)p; unsigned lo = (unsigned)v, hi = (unsigned)(v >> 32);
    asm volatile("" : "+v"(lo), "+v"(hi));
    lo = __builtin_amdgcn_readfirstlane(lo); hi = __builtin_amdgcn_readfirstlane(hi);
    return (const void*)(((unsigned long long)hi << 32) | lo);
}
__device__ __forceinline__ void moe_blocks(Frame& F, int l, LAS int* bstart) {
    __syncthreads();
    if (F.tid == 0) { const unsigned* cnt = WSP(unsigned, WS_CTL) + CW_CNT + l * 64 * CSTR; int acc = 0;
        for (int e = 0; e < 64; ++e) { bstart[e] = acc; const int nb = ((int)cnt[e * CSTR] + 255) >> 8; for (int j = 0; j < nb; ++j) bstart[65 + acc + j] = e; acc += nb; } bstart[64] = acc; }
    __syncthreads();
}

template <int PHSEL>
__global__ void __launch_bounds__(NTHREADS, 2) mk_fwd(Args args) {
    extern __shared__ __attribute__((aligned(16))) unsigned char lds_raw[];
    Frame F;
    F.lds = (LAS unsigned char*)lds_raw; F.ws = (GAS unsigned char*)args.ws; F.kin = (const __attribute__((address_space(4))) unsigned long long*)__builtin_amdgcn_kernarg_segment_ptr();
    F.tid = threadIdx.x; F.lane = F.tid & 63; F.wave = __builtin_amdgcn_readfirstlane(F.tid >> 6); F.bid = blockIdx.x; F.G = gridDim.x;
    F.gw = F.bid * NWAVES + F.wave; F.NGW = F.G * NWAVES;
    volatile LAS unsigned* lctl = (volatile LAS unsigned*)(F.lds + LDS_CTL);
    LAS int* bstart = (LAS int*)(F.lds + LDS_CTL + 64);
    if (F.tid < 4) lctl[F.tid] = 0u;
    __syncthreads();
    const int lo = args.ph_lo, hi = args.ph_hi;
    XcdBarrier bar; bar.bar = WSP(unsigned, WS_CTL) + CW_BAR; bar.x = 0; bar.st = lctl;
    if (PHSEL < 0) bar = xcd_barrier_post(WSP(unsigned, WS_CTL) + CW_BAR, lctl);
#ifndef PH_MASK
#define PH_MASK 0xffffffffu
#endif
#define IN(k) (((PH_MASK >> (k)) & 1u) && (PHSEL < 0 || PHSEL == (k)))
#define INL(j) (((PH_MASK >> (6 + (j))) & 1u) && (PHSEL < 0 || (PHSEL == 6 + (j) && lo == pb + (j))))
#define PH_END(k) do { if (PHSEL < 0) xcd_barrier(bar); } while (0)
#ifndef PH_REPEAT
#define PH_REPEAT 0u
#endif
#define REP(k) for (int _rep = 0; _rep < (((PH_REPEAT >> (k)) & 1u) ? 2 : 1); ++_rep)
#define DUP(k) (((PH_REPEAT >> (k)) & 1u) != 0u)
#define PH_BEGIN() do { F.ws = (GAS unsigned char*)launder_u64((unsigned long long)F.ws); F.kin = (const __attribute__((address_space(4))) unsigned long long*)launder_u64((unsigned long long)F.kin); \
    { int _t = threadIdx.x; asm volatile("" : "+v"(_t)); F.tid = _t; F.lane = _t & 63; F.wave = __builtin_amdgcn_readfirstlane(_t >> 6); \
      int _b = blockIdx.x; asm volatile("" : "+v"(_b)); F.bid = __builtin_amdgcn_readfirstlane(_b); F.gw = F.bid * NWAVES + F.wave; } } while (0)
    LAS unsigned char* lds = F.lds;
    const int G = F.G, bid = F.bid;
    const int vcu = (G % 8 == 0) ? (bid % 8) * (G / 8) + bid / 8 : bid;
    constexpr long T2048 = 256L * 2048 * 2;

    if (IN(0)) { PH_BEGIN(); REP(0) { p0_prologue(F); __syncthreads(); } PH_END(0); }
    if (IN(1)) { PH_BEGIN(); p1_reduce(F); PH_END(1); }
#ifdef EXTRA_BARS
    xcd_barrier(bar); xcd_barrier(bar); xcd_barrier(bar); xcd_barrier(bar); xcd_barrier(bar); xcd_barrier(bar); xcd_barrier(bar); xcd_barrier(bar); xcd_barrier(bar); xcd_barrier(bar);
#endif
        if (IN(2)) { PH_BEGIN(); REP(2) norm_phase<0>(F, 0, nullptr); PH_END(2); }
        if (IN(3)) { PH_BEGIN();
#define BODY3 { pg8::Gemm g{(const bf16*)F.ws, (const bf16*)F.ws, 2048, 2048, 2048}; InProj0Order S; S.G = G; S.c = bid; \
              S.offA1 = (long)WS_HA; S.offB1 = (long)WS_WIN0; S.offA2 = (long)(WS_WIN0 + (size_t)3072 * 2048 * 2); S.offB2 = (long)WS_HA; \
              EpiInProj0 E{EpiQKP{WSP(bf16, WS_Q), WSP(bf16, WS_K), WSP(bf16, WS_P), WSP(f32x2, WS_ROPE)}, EpiVT{WSP(bf16, WS_VT)}}; pg8::gemm_phase<EpiInProj0, InProj0Order, false>(lds, g, S, E); }
            BODY3
            if constexpr (DUP(3)) { BODY3 }
#undef BODY3
            PH_END(3);
        }
        if (IN(4)) { PH_BEGIN();
            REP(4) attn_phase(F, (bid >> 3) % 5);
            __syncthreads(); REP(21) poold_phase(F); PH_END(4); }
        if (IN(5)) { PH_BEGIN();
            pg8::Gemm g{WSP(bf16, WS_PD), WSP(bf16, WS_WPOOL), 1024, 256, 256}; pg8::StaticOrder S; S.init(TT / 256, 4, G, bid, 256L * 1024 * 2, 256L * 2, 256L * 256 * 2);
            EpiScaleBf16 E{WSP(bf16, WS_CAT), 2048, 1024, INP(14)}; pg8::gemm_phase<EpiScaleBf16, pg8::StaticOrder, false>(lds, g, S, E);
            PH_END(5);
        }
    {
    constexpr int pb = 6; constexpr int l = 0;
    if (INL(0)) { PH_BEGIN();
        float* xbuf = WSP(float, WS_X);
        pg8::Gemm g{WSP(bf16, WS_CAT), WSP(bf16, l == 0 ? WS_WOUT0 : WS_WOUT1), 2048, 2048, 2048}; pg8::StaticOrder S; S.init(l == 0 ? TT / 256 : TL / 256, 8, G, bid, T2048, 0, T2048);
        EpiRes E{l == 0 ? INP(0) : xbuf, l == 0 ? INP(2) : xbuf + (size_t)TL * 2048, xbuf, modp(F, l, 0, 2)}; pg8::gemm_phase<EpiRes, pg8::StaticOrder, false>(lds, g, S, E);
        PH_END(pb);
    }
    if (INL(1)) { PH_BEGIN(); ffn_norm_router_phase(F, l); PH_END(pb + 1); }
    if (INL(2)) { PH_BEGIN(); REP(8) {
        moe_blocks(F, l, bstart);
        pg8::Gemm g{WSP(bf16, WS_HA), (const bf16*)(F.ws + WS_WMOE + (size_t)l * MOE_L_BYTES), 2048, 2048, 2048};
        MoeOrder S{bstart, WSP(unsigned, WS_CTL) + CW_CNT + l * 64 * CSTR, WSP(int, WS_TOKL), 4, G, vcu, bstart[64], T2048, 0, true};
        EpiMoeUp E{WSP(bf16, WS_H)}; pg8::gemm_phase<EpiMoeUp, MoeOrder, true>(lds, g, S, E); }
        PH_END(pb + 2);
    }
    if (INL(3)) { PH_BEGIN(); REP(9) {
        moe_blocks(F, l, bstart);
        pg8::Gemm g{WSP(bf16, WS_H), (const bf16*)(F.ws + WS_WMOE + (size_t)l * MOE_L_BYTES), 512, 512, 512};
        MoeOrder S{bstart, WSP(unsigned, WS_CTL) + CW_CNT + l * 64 * CSTR, WSP(int, WS_TOKL), 8, G, vcu, bstart[64], 256L * 512 * 2, (long)(4 * MiB), false};
        EpiMoeDown E{WSP(bf16, WS_Y), WSP(int, WS_TOKL), WSP(float, WS_GATEL), WSP(unsigned, WS_CTL) + CW_CNT + l * 64 * CSTR}; pg8::gemm_phase<EpiMoeDown, MoeOrder, false>(lds, g, S, E); }
        PH_END(pb + 3);
    }
    }
        if (IN(10)) { PH_BEGIN(); norm_phase<2>(F, 1, nullptr); PH_END(10); }
        if (IN(11)) { PH_BEGIN();
#define BODY11             pg8::Gemm g{WSP(bf16, WS_HA), WSP(bf16, WS_WIN1), 2048, 2048, 2048}; pg8::StaticOrder S; S.init(TT / 256, 16, G, bid, T2048, 0, T2048); \
            EpiBf16 E{WSP(bf16, WS_PROJ1), 4096}; pg8::gemm_phase<EpiBf16, pg8::StaticOrder, false>(lds, g, S, E);
            BODY11
            if constexpr (DUP(11)) { BODY11 }
#undef BODY11
            PH_END(11);
        }
        if (IN(12)) { PH_BEGIN(); REP(12) shortconv_phase(F); REP(22) s5_chunk_phase<false>(F);
 PH_END(12); }
        if (IN(13)) { PH_BEGIN();
            REP(23) s5_chunk_phase<true>(F); __syncthreads(); REP(13) hyena_fft_phase(F); PH_END(13); }
        if (IN(14)) { PH_BEGIN();
 REP(14) { s5_gelu_phase(F); hyena_out_transpose(F); } PH_END(14); }
        if (IN(15)) { PH_BEGIN();
            pg8::Gemm g{WSP(bf16, WS_PD), WSP(bf16, WS_WGLU), 1024, 1024, 1024}; pg8::StaticOrder S; S.init(TL / 256, 4, G, bid, 256L * 1024 * 2, 0, 256L * 1024 * 2);
            EpiGlu E{WSP(bf16, WS_CAT), 2048, 1024, WSP(bf16, WS_PD), INP(35)}; pg8::gemm_phase<EpiGlu, pg8::StaticOrder, false>(lds, g, S, E);
            PH_END(15);
        }
    {
    constexpr int pb = 16; constexpr int l = 1;
    if (INL(0)) { PH_BEGIN();
        float* xbuf = WSP(float, WS_X);
        pg8::Gemm g{WSP(bf16, WS_CAT), WSP(bf16, l == 0 ? WS_WOUT0 : WS_WOUT1), 2048, 2048, 2048}; pg8::StaticOrder S; S.init(l == 0 ? TT / 256 : TL / 256, 8, G, bid, T2048, 0, T2048);
        EpiRes E{l == 0 ? INP(0) : xbuf, l == 0 ? INP(2) : xbuf + (size_t)TL * 2048, xbuf, modp(F, l, 0, 2)}; pg8::gemm_phase<EpiRes, pg8::StaticOrder, false>(lds, g, S, E);
        PH_END(pb);
    }
    if (INL(1)) { PH_BEGIN(); ffn_norm_router_phase(F, l); PH_END(pb + 1); }
    if (INL(2)) { PH_BEGIN(); REP(8) {
        moe_blocks(F, l, bstart);
        pg8::Gemm g{WSP(bf16, WS_HA), (const bf16*)(F.ws + WS_WMOE + (size_t)l * MOE_L_BYTES), 2048, 2048, 2048};
        MoeOrder S{bstart, WSP(unsigned, WS_CTL) + CW_CNT + l * 64 * CSTR, WSP(int, WS_TOKL), 4, G, vcu, bstart[64], T2048, 0, true};
        EpiMoeUp E{WSP(bf16, WS_H)}; pg8::gemm_phase<EpiMoeUp, MoeOrder, true>(lds, g, S, E); }
        PH_END(pb + 2);
    }
    if (INL(3)) { PH_BEGIN(); REP(9) {
        moe_blocks(F, l, bstart);
        pg8::Gemm g{WSP(bf16, WS_H), (const bf16*)(F.ws + WS_WMOE + (size_t)l * MOE_L_BYTES), 512, 512, 512};
        MoeOrder S{bstart, WSP(unsigned, WS_CTL) + CW_CNT + l * 64 * CSTR, WSP(int, WS_TOKL), 8, G, vcu, bstart[64], 256L * 512 * 2, (long)(4 * MiB), false};
        EpiMoeDown E{WSP(bf16, WS_Y), WSP(int, WS_TOKL), WSP(float, WS_GATEL), WSP(unsigned, WS_CTL) + CW_CNT + l * 64 * CSTR}; pg8::gemm_phase<EpiMoeDown, MoeOrder, false>(lds, g, S, E); }
        PH_END(pb + 3);
    }
    }
    if (IN(20)) { PH_BEGIN(); norm_phase<3>(F, 1, args.out);
    }
#undef IN
#undef INL
#undef PH_END
}

typedef void (*kern_t)(Args);
template <int P> static void launch_phase(int grid, hipStream_t stream, Args a) { hipLaunchKernelGGL(mk_fwd<P>, dim3(grid), dim3(NTHREADS), LDS_BYTES, stream, a); }
template <int P> static bool prep_phase() { return hipFuncSetAttribute((const void*)mk_fwd<P>, hipFuncAttributeMaxDynamicSharedMemorySize, LDS_BYTES) == hipSuccess; }
extern "C" void kernel_launch(void* const* d_in, const int* in_sizes, int n_in, void* d_out, int out_size, void* d_ws, size_t ws_size, hipStream_t stream) {
    static int grid = 0;
    if (grid == 0) {
        if (n_in != 43 || out_size != TL * DM || ws_size < WS_END) { fprintf(stderr, "kernel_launch: unexpected shapes (n_in %d, out %d, ws %zu < %zu)\n", n_in, out_size, ws_size, (size_t)WS_END); grid = -1; return; }
        int dev = 0, cus = 0;
        if (hipGetDevice(&dev) != hipSuccess || hipDeviceGetAttribute(&cus, hipDeviceAttributeMultiprocessorCount, dev) != hipSuccess) { grid = -1; return; }
        bool ok = true;
#if MK_SINGLE
        ok = prep_phase<-1>();
#else
        ok = prep_phase<0>() && prep_phase<1>() && prep_phase<2>() && prep_phase<3>() && prep_phase<4>() && prep_phase<5>() && prep_phase<6>() && prep_phase<7>() && prep_phase<8>() && prep_phase<9>() &&
             prep_phase<10>() && prep_phase<11>() && prep_phase<12>() && prep_phase<13>() && prep_phase<14>() && prep_phase<15>() && prep_phase<20>();
#endif
        if (!ok) { fprintf(stderr, "kernel_launch: hipFuncSetAttribute failed\n"); grid = -1; return; }
        (void)hipGetLastError();
        grid = cus;
    }
    if (grid < 0) return;
    (void)hipMemsetAsync((char*)d_ws + WS_CTL, 0, CTL_BYTES, stream);
    Args a{};
    for (int i = 0; i < 43; ++i) a.in[i] = (const float*)d_in[i];
    a.out = (float*)d_out; a.ws = (unsigned char*)d_ws;
#if MK_SINGLE
    a.ph_lo = 0; a.ph_hi = NPHASES;
    launch_phase<-1>(grid, stream, a);
#else
#ifndef MK_DUP
#define MK_DUP -1
#endif
#define LP(k, P) a.ph_lo = (k); a.ph_hi = (k) + 1; launch_phase<P>(grid, stream, a); \
    if (MK_DUP == (k)) { if (P == 7) (void)hipMemsetAsync((char*)d_ws + WS_CTL + (size_t)(CW_CNT + ((k) > 10 ? 64 * CSTR : 0)) * 4, 0, 256 * CSTR, stream); launch_phase<P>(grid, stream, a); }
    LP(0, 0) LP(1, 1) LP(2, 2) LP(3, 3) LP(4, 4) LP(5, 5) LP(6, 6) LP(7, 7) LP(8, 8) LP(9, 9) LP(10, 10) LP(11, 11) LP(12, 12) LP(13, 13) LP(14, 14) LP(15, 15)
    LP(16, 6) LP(17, 7) LP(18, 8) LP(19, 9) LP(20, 20)
#undef LP
#endif
}
```

```cpp
#include <hip/hip_runtime.h>
#include <cstdio>
#include <cstdint>
#include <cmath>

#define GAS __attribute__((address_space(1)))
#define LAS __attribute__((address_space(3)))
typedef unsigned short bf16;
typedef unsigned v4u __attribute__((ext_vector_type(4)));
typedef unsigned v2u __attribute__((ext_vector_type(2)));
typedef float f32x4 __attribute__((ext_vector_type(4)));
typedef float f32x2 __attribute__((ext_vector_type(2)));
typedef float f32x16 __attribute__((ext_vector_type(16)));
typedef short bf16x8 __attribute__((ext_vector_type(8)));
#define LDS_WAIT() asm volatile("s_waitcnt lgkmcnt(0)" ::: "memory")
#define VM_WAIT() asm volatile("s_waitcnt vmcnt(0)" ::: "memory")

__device__ __forceinline__ unsigned f2bf(float f) { unsigned u = __builtin_bit_cast(unsigned, f); return (u + 0x7fffu + ((u >> 16) & 1u)) >> 16; }
__device__ __forceinline__ unsigned pk2(float lo, float hi) { return f2bf(lo) | (f2bf(hi) << 16); }
__device__ __forceinline__ unsigned cvt_pk_bf16(float lo, float hi) { unsigned r; asm volatile("v_cvt_pk_bf16_f32 %0, %1, %2" : "=v"(r) : "v"(lo), "v"(hi)); return r; }
__device__ __forceinline__ float bf2f(unsigned short b) { return __builtin_bit_cast(float, (unsigned)b << 16); }
__device__ __forceinline__ float bflo(unsigned w) { return __builtin_bit_cast(float, w << 16); }
__device__ __forceinline__ float bfhi(unsigned w) { return __builtin_bit_cast(float, w & 0xffff0000u); }
__device__ __forceinline__ float wave_sum(float v) {
#pragma unroll
    for (int o = 1; o < 64; o <<= 1) v += __shfl_xor(v, o);
    return v;
}

namespace pg8 {
typedef unsigned short bf16_t;
constexpr int BM = 256, BK = 64, HALF = 128, HTB = HALF * BK * 2, STAGE_BYTES = 8 * HTB;

__host__ __device__ __forceinline__ int lds_byte(int r, int c) { const int st = (r >> 4) * 2 + (c >> 5), rr = r & 15, cc = c & 31, ob = rr * 64 + cc * 2; return st * 1024 + (ob ^ (((ob >> 9) & 1) << 5)); }
__host__ __device__ __forceinline__ int perm32(int rho) { const int n = rho >> 4, i = rho & 15; return 8 * (i >> 2) + 4 * n + (i & 3); }
__host__ __device__ __forceinline__ void stage_rc(int b, int& R, int& C) { const int st = b / 1024, sb = b % 1024, swz = sb ^ (((sb >> 9) & 1) << 5); R = (st >> 1) * 16 + swz / 64; C = (st & 1) * 32 + (swz % 64) / 2; }

struct Unit { int pm, pn; long aoff, boff; int e, idx0; };
struct Gemm { const bf16_t* A; const bf16_t* Bt; int lda, ldb, K; };

template <class Epi, class Sched, bool GATHER>
__device__ __forceinline__ void gemm_phase(LAS unsigned char* lds, const Gemm g, const Sched& S, const Epi& E) {
    int tid_ = threadIdx.x; asm volatile("" : "+v"(tid_));
    const int tid = tid_, wid = __builtin_amdgcn_readfirstlane(tid >> 6), lane = tid & 63, wr = wid >> 2, wc = wid & 3, fr = lane & 15, fq = lane >> 4;
    const int K = g.K, nt = K / BK;
    unsigned voffA[2], voffB[2];
#pragma unroll
    for (int i = 0; i < 2; ++i) { int R, C; stage_rc(tid * 16 + i * 8192, R, C);
        const int Rb = Epi::PERM ? ((R & ~31) + perm32(R & 31)) : R;
        voffA[i] = (unsigned)(R * g.lda + C) * 2u; voffB[i] = (unsigned)(Rb * g.ldb + C) * 2u; }
    const size_t kstep = (size_t)(BK * 2);
    const size_t hstepA = GATHER ? 0 : (size_t)HALF * g.lda * 2, hstepB = (size_t)HALF * g.ldb * 2;
    const unsigned ldsw = (unsigned)wid * 1024u;
    const int aoff = lds_byte(wr * 64 + fr, fq * 8), boff = lds_byte(wc * 32 + fr, fq * 8);
#define PG8_SA(b, h) (((b) * 2 + (h)) * HTB)
#define PG8_SB(b, h) ((4 + (b) * 2 + (h)) * HTB)
#define PG8_STAGE(bufoff, gbase, voff) do { _Pragma("unroll") for (int _i = 0; _i < 2; ++_i) \
        __builtin_amdgcn_global_load_lds((const unsigned*)((const char*)(gbase) + (voff)[_i]), (LAS unsigned*)(lds + (bufoff) + ldsw + _i * 8192), 16, 0, 0); } while (0)
#define PG8_STAGE_A(bufoff, gbase, h, nx) do { if constexpr (GATHER) { unsigned _tv[2]; \
        if (nx) { int _tz = tid; asm volatile("" : "+v"(_tz)); _Pragma("unroll") for (int _j = 0; _j < 2; ++_j) { int _R, _C; stage_rc(_tz * 16 + _j * 8192, _R, _C); _tv[_j] = (unsigned)S.arow(nxt, (h) * HALF + _R) * (unsigned)(g.lda * 2) + (unsigned)(_C * 2); } } \
        else { _tv[0] = gvc[h][0]; _tv[1] = gvc[h][1]; } \
        PG8_STAGE(bufoff, gbase, _tv); } else { PG8_STAGE(bufoff, (gbase) + (h) * hstepA, voffA); } } while (0)
#define PG8_LDA(dst, b, h) do { _Pragma("unroll") for (int m = 0; m < 4; ++m) _Pragma("unroll") for (int k = 0; k < 2; ++k) dst[m][k] = *(const LAS bf16x8*)(lds + PG8_SA(b, h) + aoff + m * 2048 + k * 1024); } while (0)
#define PG8_LDB(dst, b, h) do { _Pragma("unroll") for (int n = 0; n < 2; ++n) _Pragma("unroll") for (int k = 0; k < 2; ++k) dst[n][k] = *(const LAS bf16x8*)(lds + PG8_SB(b, h) + boff + n * 2048 + k * 1024); } while (0)
#define PG8_MMA(ai, bj, At, Bt) do { __builtin_amdgcn_s_setprio(1); _Pragma("unroll") for (int m = 0; m < 4; ++m) _Pragma("unroll") for (int n = 0; n < 2; ++n) _Pragma("unroll") for (int k = 0; k < 2; ++k) \
        acc[ai][bj][m][n] = __builtin_amdgcn_mfma_f32_16x16x32_bf16(Bt[n][k], At[m][k], acc[ai][bj][m][n], 0, 0, 0); __builtin_amdgcn_s_setprio(0); } while (0)
#define PG8_WAIT_V(n) asm volatile("s_waitcnt vmcnt(" #n ")" ::: "memory")
#define PG8_WAIT_L(n) asm volatile("s_waitcnt lgkmcnt(" #n ")" ::: "memory")
#define PG8_BAR __builtin_amdgcn_s_barrier()
#define PG8_SCHED __builtin_amdgcn_sched_barrier(0)
    Unit cur, nxt; int ui = 0;
    if (!S.next(0, cur)) return;
    unsigned gvc[2][2];
#define PG8_GV(unit) do { if constexpr (GATHER) { int _tz = tid; asm volatile("" : "+v"(_tz)); _Pragma("unroll") for (int _h = 0; _h < 2; ++_h) _Pragma("unroll") for (int _j = 0; _j < 2; ++_j) { int _R, _C; stage_rc(_tz * 16 + _j * 8192, _R, _C); \
        gvc[_h][_j] = (unsigned)S.arow(unit, _h * HALF + _R) * (unsigned)(g.lda * 2) + (unsigned)(_C * 2); } } } while (0)
    PG8_GV(cur);
    f32x4 acc[2][2][4][2];
#pragma unroll
    for (int a = 0; a < 2; ++a)
#pragma unroll
        for (int b = 0; b < 2; ++b)
#pragma unroll
            for (int m = 0; m < 4; ++m)
#pragma unroll
                for (int n = 0; n < 2; ++n) acc[a][b][m][n] = (f32x4){0.f, 0.f, 0.f, 0.f};
    bf16x8 At[4][2], B0[2][2], B1[2][2];
    const char* cA = (const char*)g.A + cur.aoff; const char* cB = (const char*)g.Bt + cur.boff;
    PG8_STAGE(PG8_SB(0, 0), cB, voffB); PG8_STAGE(PG8_SB(0, 1), cB + hstepB, voffB); PG8_STAGE_A(PG8_SA(0, 0), cA, 0, false); PG8_STAGE_A(PG8_SA(0, 1), cA, 1, false);
    if (wr == 1) PG8_BAR;
    PG8_WAIT_V(2); PG8_BAR;
    PG8_STAGE(PG8_SB(1, 0), cB + kstep, voffB); PG8_STAGE_A(PG8_SA(1, 0), cA + kstep, 0, false); PG8_STAGE(PG8_SB(1, 1), cB + hstepB + kstep, voffB);
    PG8_WAIT_V(6); PG8_BAR;
    for (;;) {
        const bool has_next = S.next(ui + 1, nxt);
        const char* nA = has_next ? (const char*)g.A + nxt.aoff : cA; const char* nB = has_next ? (const char*)g.Bt + nxt.boff : cB;
#pragma nounroll
        for (int t = 0; t < nt; t += 2) {
            const bool last = (t == nt - 2);
            const char* a1 = cA + (size_t)(t + 1) * kstep;
            const char* a2 = last ? nA : cA + (size_t)(t + 2) * kstep; const char* b2 = last ? nB : cB + (size_t)(t + 2) * kstep;
            const char* a3 = a2 + kstep; const char* b3 = b2 + kstep;
            PG8_LDB(B0, 0, 0); PG8_LDB(B1, 0, 1); PG8_SCHED; PG8_LDA(At, 0, 0); PG8_STAGE_A(PG8_SA(1, 1), a1, 1, false);
            PG8_WAIT_V(8); PG8_WAIT_L(0); PG8_BAR; PG8_MMA(0, 0, At, B0); PG8_MMA(0, 1, At, B1); PG8_BAR; PG8_SCHED;
            PG8_LDA(At, 0, 1); PG8_STAGE(PG8_SB(0, 0), b2, voffB); PG8_STAGE(PG8_SB(0, 1), b2 + hstepB, voffB); PG8_STAGE_A(PG8_SA(0, 0), a2, 0, last);
            PG8_WAIT_V(8); PG8_WAIT_L(0); PG8_BAR; PG8_MMA(1, 0, At, B0); PG8_MMA(1, 1, At, B1); PG8_BAR; PG8_SCHED;
            PG8_LDB(B0, 1, 0); PG8_LDB(B1, 1, 1); PG8_SCHED; PG8_LDA(At, 1, 0); PG8_STAGE_A(PG8_SA(0, 1), a2, 1, last);
            PG8_WAIT_V(8); PG8_WAIT_L(0); PG8_BAR; PG8_MMA(0, 0, At, B0); PG8_MMA(0, 1, At, B1); PG8_BAR; PG8_SCHED;
            PG8_LDA(At, 1, 1); PG8_STAGE(PG8_SB(1, 0), b3, voffB); PG8_STAGE(PG8_SB(1, 1), b3 + hstepB, voffB); PG8_STAGE_A(PG8_SA(1, 0), a3, 0, last);
            PG8_WAIT_V(8); PG8_WAIT_L(0); PG8_BAR; PG8_MMA(1, 0, At, B0); PG8_MMA(1, 1, At, B1); PG8_BAR; PG8_SCHED;
        }
        if (wr == 0) PG8_BAR;
        E(acc, cur, wr, wc, fr, fq);
        if (!has_next) break;
#pragma unroll
        for (int a = 0; a < 2; ++a)
#pragma unroll
            for (int b = 0; b < 2; ++b)
#pragma unroll
                for (int m = 0; m < 4; ++m)
#pragma unroll
                    for (int n = 0; n < 2; ++n) acc[a][b][m][n] = (f32x4){0.f, 0.f, 0.f, 0.f};
        cur = nxt; cA = nA; cB = nB; ++ui;
        PG8_GV(cur);
        if (wr == 1) PG8_BAR;
    }
    PG8_WAIT_V(0);
    PG8_BAR;
#undef PG8_SA
#undef PG8_SB
#undef PG8_STAGE
#undef PG8_STAGE_A
#undef PG8_GV
#undef PG8_LDA
#undef PG8_LDB
#undef PG8_MMA
#undef PG8_WAIT_V
#undef PG8_WAIT_L
#undef PG8_BAR
#undef PG8_SCHED
}

struct StaticOrder {
    int nM, nN, nwg, G, c; long astride, apn, bstride;
    __device__ void init(int nM_, int nN_, int G_, int c_, long astride_, long apn_, long bstride_) { nM = nM_; nN = nN_; nwg = nM * nN; G = G_; c = c_; astride = astride_; apn = apn_; bstride = bstride_; }
    __device__ bool next(int i, Unit& u) const {
        const long Lx = (long)i * G + c; if (Lx >= nwg) return false;
        int wgid = (int)Lx; { const int q = nwg / 8, r = nwg % 8, xcd = wgid % 8, off = wgid / 8; wgid = (xcd < r ? xcd * (q + 1) : r * (q + 1) + (xcd - r) * q) + off; }
        const int nig = 8 * nN, gid = wgid / nig, fm = gid * 8, gsz = (nM - fm) < 8 ? (nM - fm) : 8;
        u.pm = fm + ((wgid % nig) % gsz); u.pn = (wgid % nig) / gsz; u.aoff = (long)u.pm * astride + (long)u.pn * apn; u.boff = (long)u.pn * bstride; u.e = 0; u.idx0 = 0; return true;
    }
    __device__ int arow(const Unit&, int) const { return 0; }
};
}

constexpr int DM = 2048, NBATCH = 2, SEQ = 8192, CTX = 256;
constexpr int TL = NBATCH * SEQ;
constexpr int TC = NBATCH * CTX;
constexpr int TT = TL + TC;
constexpr int KEYS = CTX + SEQ;
constexpr int NEXP = 64, DEXP = 512;
constexpr int LISTCAP = 2 * TT;
constexpr float EPS = 1e-6f;
constexpr float QSCALE = 0.125f * 1.4426950408889634f;
constexpr int NWAVES = 8, NTHREADS = 512;

constexpr size_t MiB = 1u << 20;
constexpr size_t WS_CTL = 0, CTL_BYTES = 1 * MiB;
constexpr size_t WS_WIN0 = 1 * MiB;
constexpr size_t WS_WOUT0 = WS_WIN0 + 16 * MiB;
constexpr size_t WS_WIN1 = WS_WOUT0 + 8 * MiB;
constexpr size_t WS_WOUT1 = WS_WIN1 + 16 * MiB;
constexpr size_t WS_WPOOL = WS_WOUT1 + 8 * MiB;
constexpr size_t WS_WGLU = WS_WPOOL + 1 * MiB;
constexpr size_t WS_WMOE = WS_WGLU + 2 * MiB;
constexpr size_t MOE_E_BYTES = 6 * MiB, MOE_L_BYTES = 64 * MOE_E_BYTES;
constexpr size_t WS_X = WS_WMOE + 2 * MOE_L_BYTES;
constexpr size_t WS_HA = WS_X + 132 * MiB;
constexpr size_t WS_Q = WS_HA + 67 * MiB;
constexpr size_t WS_K = WS_Q + 33 * MiB;
constexpr size_t WS_VT = WS_K + 33 * MiB;
constexpr size_t WS_P = WS_VT + 33 * MiB;
constexpr size_t WS_PROJ1 = WS_Q;
constexpr size_t WS_CAT = WS_P + 33 * MiB;
constexpr size_t WS_PD = WS_CAT + 66 * MiB;
constexpr size_t WS_H = WS_PD + 33 * MiB;
constexpr size_t WS_Y = WS_H + 49 * MiB;
constexpr size_t WS_GT = WS_Y + 132 * MiB;
constexpr size_t WS_KT = WS_GT + 192 * MiB;
constexpr size_t WS_YD = WS_KT + 128 * MiB;
constexpr size_t WS_MISC = WS_YD + 128 * MiB;
constexpr size_t WS_MOD = WS_MISC;
constexpr size_t WS_ADAP = WS_MOD + 1 * MiB;
constexpr size_t WS_ROPE = WS_ADAP + 10 * MiB;
constexpr size_t WS_NORMP = WS_ROPE + 1 * MiB;
constexpr size_t WS_INVN = WS_NORMP + 4 * MiB;
constexpr size_t WS_S5LAM = WS_INVN + 1 * MiB;
constexpr size_t WS_S5B = WS_S5LAM + 1 * MiB;
constexpr size_t WS_WRT = WS_S5B + 2 * MiB;
constexpr size_t WS_TOKL = WS_WRT + 2 * MiB;
constexpr size_t WS_GATEL = WS_TOKL + 9 * MiB;
constexpr size_t WS_TW = WS_GATEL + 9 * MiB;
constexpr size_t WS_FFTW = WS_TW + 1 * MiB;
constexpr size_t WS_S5L256 = WS_FFTW + 32 * MiB;
constexpr size_t WS_S5E = WS_S5L256 + 1 * MiB;
constexpr size_t WS_YHT = WS_S5E + 4 * MiB;
constexpr size_t WS_S5L16 = WS_YHT + 64 * MiB;
constexpr size_t WS_S5W1 = WS_S5L16 + 1 * MiB;
constexpr size_t WS_S5W3 = WS_S5W1 + 8 * MiB;
constexpr size_t WS_S5KT = WS_S5W3 + 8 * MiB;
constexpr size_t WS_END = WS_S5KT + 2 * MiB;
static_assert(WS_END <= 2040 * MiB, "d_ws map");
constexpr int CW_BAR = 1024;
constexpr int CW_CNT = 8192;
constexpr int CSTR = 32;

constexpr int LDS_PHASE = 131072;
constexpr int LDS_CTL = 147456 - 2048;
constexpr int LDS_BYTES = 147456;

#define XB_TMO      128
#define XB_XCNT(j)  (256  + 64 * (j))
#define XB_XSUB(j)  (1280 + 64 * (j))
#define XB_XGEN(j)  (2304 + 64 * (j))
#define XB_TOP      3328
#define XB_TOPGEN   3392
#define XCD_BAR_WORDS 3456
#define XB_SPIN_CAP (1u << 22)

__device__ __forceinline__ unsigned xb_ld(unsigned* p)              { return __hip_atomic_load(p, __ATOMIC_RELAXED, __HIP_MEMORY_SCOPE_AGENT); }
__device__ __forceinline__ unsigned xb_add(unsigned* p, unsigned v) { return __hip_atomic_fetch_add(p, v, __ATOMIC_RELAXED, __HIP_MEMORY_SCOPE_AGENT); }
__device__ __forceinline__ unsigned xb_xcc_id() { return (unsigned)__builtin_amdgcn_s_getreg((3 << 11) | 20) & 0xFu; }
#define XB_SPIN(cond, bar) do { unsigned _sp = 0; while (cond) { __builtin_amdgcn_s_sleep(1); \
    if ((++_sp & 255u) == 0u) { if (xb_ld(&(bar)[XB_TMO])) break; if (_sp > XB_SPIN_CAP) { atomicAdd(&(bar)[XB_TMO], 1u); break; } } } } while (0)

struct XcdBarrier { unsigned* bar; unsigned x; volatile LAS unsigned* st; };

__device__ __forceinline__ XcdBarrier xcd_barrier_post(unsigned* bar, volatile LAS unsigned* st) {
    XcdBarrier b; b.bar = bar; b.x = xb_xcc_id(); b.st = st;
    if (threadIdx.x == 0) (void)xb_add(&bar[XB_XCNT(b.x)], 1u);
    return b;
}
__device__ __forceinline__ void xcd_barrier_complete(unsigned* bar, unsigned x, unsigned& nloc, unsigned& nx) {
    const unsigned G = gridDim.x * gridDim.y * gridDim.z;
    unsigned sum, cnt, mine, sp = 0u;
    for (;;) {
        sum = 0u; cnt = 0u; mine = 0u;
#pragma unroll
        for (unsigned j = 0; j < 16; ++j) { const unsigned c = xb_ld(&bar[XB_XCNT(j)]); sum += c; cnt += (c > 0u) ? 1u : 0u; mine = (j == x) ? c : mine; }
        if (sum == G) break;
        __builtin_amdgcn_s_sleep(1);
        if ((++sp & 255u) == 0u) { if (xb_ld(&bar[XB_TMO])) break; if (sp > XB_SPIN_CAP) { atomicAdd(&bar[XB_TMO], 1u); break; } }
    }
    nloc = mine > 0u ? mine : 1u; nx = cnt > 0u ? cnt : 1u;
}
__device__ __forceinline__ void xcd_barrier(const XcdBarrier& b) {
    asm volatile("s_waitcnt vmcnt(0)" ::: "memory");
    __syncthreads();
    if (threadIdx.x == 0) {
        unsigned* bar = b.bar;
        __builtin_amdgcn_s_waitcnt(0);
        unsigned nloc = b.st[0], nx = b.st[1];
        if (nloc == 0u) { xcd_barrier_complete(bar, b.x, nloc, nx); b.st[0] = nloc; b.st[1] = nx; }
        const unsigned old = xb_add(&bar[XB_XSUB(b.x)], 1u);
        const unsigned gen = old / nloc;
        if (old + 1u == (gen + 1u) * nloc) {
            __builtin_amdgcn_fence(__ATOMIC_RELEASE, "agent");
            asm volatile("s_waitcnt vmcnt(0)" ::: "memory");
            const unsigned og = xb_add(&bar[XB_TOP], 1u);
            const unsigned tg = og / nx;
            if (og + 1u == (tg + 1u) * nx) xb_add(&bar[XB_TOPGEN], 1u);
            else XB_SPIN(xb_ld(&bar[XB_TOPGEN]) == tg, bar);
            __builtin_amdgcn_fence(__ATOMIC_ACQUIRE, "agent");
            xb_add(&bar[XB_XGEN(b.x)], 1u);
            asm volatile("s_waitcnt vmcnt(0)" ::: "memory");
        } else {
            XB_SPIN(xb_ld(&bar[XB_XGEN(b.x)]) == gen, bar);
            __builtin_amdgcn_fence(__ATOMIC_ACQUIRE, "agent");
            asm volatile("s_waitcnt vmcnt(0)" ::: "memory");
        }
    }
    __syncthreads();
}

__device__ __forceinline__ void sincos_2pi(double x, double& s, double& c) {
    const double q = __builtin_rint(x * 4.0);
    const double y = (x - q * 0.25) * 6.283185307179586476925;
    const double y2 = y * y;
    double sp = -7.6471637318198164759e-13; sp = sp * y2 + 1.6059043836821614599e-10; sp = sp * y2 - 2.5052108385441718775e-8; sp = sp * y2 + 2.7557319223985890653e-6;
    sp = sp * y2 - 1.9841269841269841270e-4; sp = sp * y2 + 8.3333333333333333333e-3; sp = sp * y2 - 1.6666666666666666667e-1; sp = sp * y2 * y + y;
    double cp = 4.7794773323873852974e-14; cp = cp * y2 - 1.1470745597729724714e-11; cp = cp * y2 + 2.0876756987868098979e-9; cp = cp * y2 - 2.7557319223985890653e-7;
    cp = cp * y2 + 2.4801587301587301587e-5; cp = cp * y2 - 1.3888888888888888889e-3; cp = cp * y2 + 4.1666666666666666667e-2; cp = cp * y2 - 0.5; cp = cp * y2 + 1.0;
    const int qi = ((int)q) & 3;
    s = (qi == 0) ? sp : (qi == 1) ? cp : (qi == 2) ? -sp : -cp;
    c = (qi == 0) ? cp : (qi == 1) ? -sp : (qi == 2) ? -cp : sp;
}
__device__ __forceinline__ void sincos_rad(double a, double& s, double& c) {
    double f = a * 0.15915494309189533576888; f -= __builtin_floor(f);
    if (f >= 1.0) f = 0.0;
    sincos_2pi(f, s, c);
}
__device__ __forceinline__ double exp_small(double x) {
    double r = 1.0 / 479001600.0;
    r = r * x + 1.0 / 39916800.0; r = r * x + 1.0 / 3628800.0; r = r * x + 1.0 / 362880.0; r = r * x + 1.0 / 40320.0; r = r * x + 1.0 / 5040.0;
    r = r * x + 1.0 / 720.0; r = r * x + 1.0 / 120.0; r = r * x + 1.0 / 24.0; r = r * x + 1.0 / 6.0; r = r * x + 0.5; r = r * x + 1.0; r = r * x + 1.0;
    return r;
}
__device__ __forceinline__ float fast_exp(float x) { return __builtin_amdgcn_exp2f(x * 1.4426950408889634f); }
__device__ __forceinline__ float sigmoidf_(float x) { return 1.0f / (1.0f + fast_exp(-x)); }
__device__ __forceinline__ float siluf_(float x) { return x * sigmoidf_(x); }
__device__ __forceinline__ float tanhf_(float x) { const float e = fast_exp(-2.0f * fabsf(x)); const float t = (1.0f - e) / (1.0f + e); return x < 0.f ? -t : t; }
__device__ __forceinline__ float gelu_tanh(float x) { return 0.5f * x * (1.0f + tanhf_(0.7978845608028654f * (x + 0.044715f * x * x * x))); }

#ifndef PH_REPEAT
#define PH_REPEAT 0u
#endif
struct Args { const float* in[43]; float* out; unsigned char* ws; int ph_lo, ph_hi; };

#define GAS __attribute__((address_space(1)))
struct Frame {
    LAS unsigned char* lds; GAS unsigned char* ws; int tid, lane, wave, bid, G, gw, NGW;
    const __attribute__((address_space(4))) unsigned long long* kin;
};
#define INP(i) ((const float*)(const GAS float*)F.kin[i])
#define WSP(T, off) ((T*)(GAS T*)(F.ws + (off)))

__device__ __forceinline__ void tr_item(const float* W, int ldw, int N, bf16* WT, int ldt, int row_off, int rs16, LAS float* scr, int item, int lane) {
    const int nblk = N / 64, kb = item / nblk, nb = item % nblk, k0 = 64 * kb, n0 = 64 * nb;
    const int la = lane & 15, lb = lane >> 4;
    f32x4 v[16];
#pragma unroll
    for (int i = 0; i < 16; ++i) v[i] = *(const f32x4*)(W + (size_t)(k0 + 4 * i + lb) * ldw + n0 + 4 * la);
#pragma unroll
    for (int i = 0; i < 16; ++i) { const int kk = 4 * i + lb; LAS float* d = scr + (4 * la) * 65 + kk; d[0] = v[i].x; d[65] = v[i].y; d[130] = v[i].z; d[195] = v[i].w; }
    LDS_WAIT(); asm volatile("" ::: "memory");
    const int c = lane & 7;
#pragma unroll
    for (int j = 0; j < 8; ++j) { const int n = (lane >> 3) + 8 * j; const LAS float* s = scr + n * 65 + 8 * c;
        v4u o; o.x = cvt_pk_bf16(s[0], s[1]); o.y = cvt_pk_bf16(s[2], s[3]); o.z = cvt_pk_bf16(s[4], s[5]); o.w = cvt_pk_bf16(s[6], s[7]);
        const int nn = n0 + n, drow = row_off + (nn >> 4) * rs16 + (nn & 15);
        *(v4u*)(WT + (size_t)drow * ldt + k0 + 8 * c) = o; }
    LDS_WAIT(); asm volatile("" ::: "memory");
}

__device__ __forceinline__ void hyfilt_item(Frame& F, int pb) {
    const float* w1 = INP(19); const float* b1 = INP(20); const float* fq = INP(21); const float* w2 = INP(22); const float* b2 = INP(23); const float* w3 = INP(24);
    LAS float* z = (LAS float*)F.lds;
    LAS float* h1 = z + 1088;
    LAS float* h2 = h1 + 2048;
    const int tid = F.tid;
    for (int idx = tid; idx < 32 * 33; idx += NTHREADS) {
        const int p = idx / 33, f = idx % 33, i = pb * 32 + p;
        float v;
        if (f == 0) v = (float)i * (1.0f / (float)(SEQ - 1));
        else { const int j = (f - 1) & 15; const float fj = 1e-4f + (float)j * ((15.0f - 1e-4f) / 15.0f);
            double fr = (double)fj * (double)i / (double)SEQ; fr -= __builtin_floor(fr); double s, c; sincos_2pi(fr, s, c); v = (f <= 16) ? (float)c : (float)(-s); }
        z[p * 33 + f] = v;
    }
    __syncthreads();
    for (int idx = tid; idx < 2048; idx += NTHREADS) {
        const int p = idx >> 6, j = idx & 63; float a = b1[j];
        for (int f = 0; f < 33; ++f) a += z[p * 33 + f] * w1[f * 64 + j];
        double s, c; sincos_rad((double)(fq[j] * a), s, c); h1[idx] = (float)s;
    }
    __syncthreads();
    for (int idx = tid; idx < 2048; idx += NTHREADS) {
        const int p = idx >> 6, j = idx & 63; float a = b2[j];
        for (int k = 0; k < 64; ++k) a += h1[p * 64 + k] * w2[k * 64 + j];
        double s, c; sincos_rad((double)(fq[64 + j] * a), s, c); h2[idx] = (float)s;
    }
    __syncthreads();
    float* kT = WSP(float, WS_KT); float* normp = WSP(float, WS_NORMP);
    {
        const int lane = F.lane, l31 = lane & 31, lh = lane >> 5;
        float af[32];
#pragma unroll
        for (int s = 0; s < 32; ++s) af[s] = h2[l31 * 64 + 2 * s + lh];
        float bn[32];
        { const unsigned vo = (unsigned)(lh * 4096 + F.wave * 32 + l31);
#pragma unroll
          for (int s = 0; s < 32; ++s) bn[s] = (w3 + s * 8192)[vo]; }
#pragma nounroll
        for (int ct = F.wave; ct < 128; ct += NWAVES) {
            const int col = ct * 32 + l31;
            f32x16 acc;
#pragma unroll
            for (int r = 0; r < 16; ++r) acc[r] = 0.f;
            float bv[32];
#pragma unroll
            for (int s = 0; s < 32; ++s) bv[s] = bn[s];
            { const unsigned vo = (unsigned)(lh * 4096 + (ct + NWAVES < 128 ? ct + NWAVES : ct) * 32 + l31);
#pragma unroll
              for (int s = 0; s < 32; ++s) bn[s] = (w3 + s * 8192)[vo]; }
#pragma unroll
            for (int s = 0; s < 32; ++s) acc = __builtin_amdgcn_mfma_f32_32x32x2f32(af[s], bv[s], acc, 0, 0, 0);
#pragma unroll
            for (int s = 0; s < 32; s += 8) asm volatile("" : "+v"(acc) : "v"(bv[s]), "v"(bv[s + 1]), "v"(bv[s + 2]), "v"(bv[s + 3]), "v"(bv[s + 4]), "v"(bv[s + 5]), "v"(bv[s + 6]), "v"(bv[s + 7]));
            const int ch = col & 1023, dir = (col >> 10) & 1;
            const float adel = 3.0701134573253946f + (float)ch * ((15.350567286626972f - 3.0701134573253946f) / 1023.0f);
            float sabs = 0.f;
#pragma unroll
            for (int r = 0; r < 16; ++r) { const int i = pb * 32 + (r & 3) + 8 * (r >> 2) + 4 * lh; const float t = (float)i * (1.0f / (float)(SEQ - 1)); acc[r] *= fast_exp(-t * adel); if (!(dir == 1 && i == 0)) sabs += fabsf(acc[r]); }
            sabs += __shfl_xor(sabs, 32);
#pragma unroll
            for (int q = 0; q < 4; ++q) *(f32x4*)(kT + (size_t)col * SEQ + pb * 32 + 8 * q + 4 * lh) = (f32x4){acc[4 * q], acc[4 * q + 1], acc[4 * q + 2], acc[4 * q + 3]};
            if (lh == 0) normp[(size_t)pb * 4096 + col] = sabs;
        }
    }
    __syncthreads();
}

struct TrItem { const float* W; bf16* WT; int ldw, ldt, row_off, rs16, k0, n0; };
__device__ __forceinline__ TrItem moe_tr_item(Frame& F, int it) {
    if (F.G == 256) it = (it & 255) * 48 + (it >> 8);
    const int le = it / 96, q = it % 96; TrItem r;
    bf16* wc = (bf16*)(F.ws + WS_WMOE + (size_t)le * MOE_E_BYTES);
    if (q < 32) { r.W = INP(40) + (size_t)le * (2048 * 512); r.ldw = 512; r.WT = wc; r.ldt = 2048; r.row_off = 0; r.rs16 = 32; r.k0 = 64 * q; r.n0 = 0; }
    else if (q < 64) { r.W = INP(41) + (size_t)le * (2048 * 512); r.ldw = 512; r.WT = wc; r.ldt = 2048; r.row_off = 16; r.rs16 = 32; r.k0 = 64 * (q - 32); r.n0 = 0; }
    else { const int x = q - 64; r.W = INP(42) + (size_t)le * (512 * 2048); r.ldw = 2048; r.WT = wc + 1024 * 2048; r.ldt = 512; r.row_off = 0; r.rs16 = 16; r.k0 = 64 * (x >> 2); r.n0 = 512 * (x & 3); }
    return r;
}
__device__ __forceinline__ void moe_convert_items(Frame& F) {
    LAS unsigned* T = (LAS unsigned*)F.lds;
    const int t = F.tid, r4 = t >> 7, n4 = t & 127;
    const int cc = t & 7, nl = t >> 3;
    f32x4 va[16], vb[16];
    int it = F.bid;
    constexpr int NIT = 128 * 96;
    if (it >= NIT) return;
#define TR_LOAD(v, c) do { _Pragma("unroll") for (int i = 0; i < 16; ++i) v[i] = __builtin_nontemporal_load((const f32x4*)((c).W + (size_t)((c).k0 + 8 * (i >> 1) + 2 * r4 + (i & 1)) * (c).ldw + (c).n0 + 4 * n4)); } while (0)
#define LDS_BARRIER() do { asm volatile("s_waitcnt lgkmcnt(0)" ::: "memory"); __builtin_amdgcn_s_barrier(); asm volatile("" ::: "memory"); } while (0)
#define TR_BODY(v, itc) do { const TrItem c = moe_tr_item(F, (itc)); \
        _Pragma("unroll") for (int a = 0; a < 8; ++a) { const int kp = 4 * a + r4; v4u d; \
            d.x = cvt_pk_bf16(v[2 * a].x, v[2 * a + 1].x); d.y = cvt_pk_bf16(v[2 * a].y, v[2 * a + 1].y); d.z = cvt_pk_bf16(v[2 * a].z, v[2 * a + 1].z); d.w = cvt_pk_bf16(v[2 * a].w, v[2 * a + 1].w); \
            *(LAS v4u*)(T + kp * 516 + ((4 * n4 + 8 * ((kp >> 3) & 1)) & 511)) = d; } \
        { const TrItem nx = moe_tr_item(F, (itc) + 2 * F.G < NIT ? (itc) + 2 * F.G : (itc)); TR_LOAD(v, nx); }        \
        LDS_BARRIER(); \
        _Pragma("unroll") for (int q = 0; q < 8; ++q) { const int n = 64 * q + nl; const LAS unsigned* s = T + (4 * cc) * 516 + ((n + 8 * ((cc >> 1) & 1)) & 511); \
            v4u o; o.x = s[0]; o.y = s[516]; o.z = s[2 * 516]; o.w = s[3 * 516]; \
            const int nn = c.n0 + n, drow = c.row_off + (nn >> 4) * c.rs16 + (nn & 15); \
            __builtin_nontemporal_store(o, (v4u*)(c.WT + (size_t)drow * c.ldt + c.k0 + 8 * cc)); } \
        LDS_BARRIER(); } while (0)
    { const TrItem c = moe_tr_item(F, it); TR_LOAD(va, c); }
    { const TrItem c = moe_tr_item(F, it + F.G < NIT ? it + F.G : it); TR_LOAD(vb, c); }
#pragma nounroll
    for (; it < NIT; it += 2 * F.G) {
        TR_BODY(va, it);
        const int itb = it + F.G < NIT ? it + F.G : it;
        TR_BODY(vb, itb);
    }
#undef TR_LOAD
#undef TR_BODY
}

__device__ __forceinline__ void p0_prologue(Frame& F) {
    if ((F.bid & 1) == 0) { for (int pb = F.bid; pb < SEQ / 32; pb += F.G) hyfilt_item(F, pb); __syncthreads(); }
    const int gt = F.bid * NTHREADS + F.tid, NGT = F.G * NTHREADS;
    {
        f32x2* rope = WSP(f32x2, WS_ROPE);
        for (int idx = gt; idx < 128 * 16; idx += NGT) { const int pos = idx >> 4, i = idx & 15;
            double inv = (i & 3) == 0 ? 1.0 : (i & 3) == 1 ? 0.56234132519034908 : (i & 3) == 2 ? 0.31622776601683794 : 0.17782794100389228;
            inv *= (i >> 2) == 0 ? 1.0 : (i >> 2) == 1 ? 0.1 : (i >> 2) == 2 ? 0.01 : 0.001;
            const float ang = (float)pos * (float)inv; double s, c; sincos_rad((double)ang, s, c); rope[idx] = (f32x2){(float)c, (float)s}; }
    }
    {
        f32x2* tw = WSP(f32x2, WS_TW);
        for (int idx = gt; idx < 16384; idx += NGT) { double s, c; sincos_2pi((double)idx * (1.0 / 16384.0), s, c); tw[idx] = (f32x2){(float)c, (float)(-s)}; }
    }
    {
        const float* are = INP(26); const float* aim = INP(27); const float* ldt = INP(28); const float* bre = INP(29); const float* bim = INP(30);
        f32x2* lamb = WSP(f32x2, WS_S5LAM); f32x2* bb = WSP(f32x2, WS_S5B); f32x2* l256 = WSP(f32x2, WS_S5L256);
        for (int idx = gt; idx < 2 * 64 * 64; idx += NGT) { const int dg = idx >> 6;
            const float dt = expf(ldt[dg]); const float ar = are[idx], ai = aim[idx];
            const float zr = ar * dt, zi = ai * dt; double s, c; sincos_rad((double)zi, s, c); const double er = exp_small((double)zr);
            const double lr = er * c, li = er * s; lamb[idx] = (f32x2){(float)lr, (float)li};
            { double pr = lr, pi = li; for (int q = 0; q < 8; ++q) { const double tr = pr * pr - pi * pi, ti = 2.0 * pr * pi; pr = tr; pi = ti; } l256[idx] = (f32x2){(float)pr, (float)pi}; }
            const double nr = lr - 1.0, ni = li, den = (double)ar * ar + (double)ai * ai; const double qr = (nr * ar + ni * ai) / den, qi = (ni * ar - nr * ai) / den;
            for (int cc = 0; cc < 16; ++cc) { const double br = bre[(size_t)idx * 16 + cc], bi = bim[(size_t)idx * 16 + cc]; bb[(size_t)idx * 16 + cc] = (f32x2){(float)(qr * br - qi * bi), (float)(qr * bi + qi * br)}; } }
    }
    {
        float* wrt = WSP(float, WS_WRT);
        for (int idx = gt; idx < 2 * 72 * 2048; idx += NGT) { const int l = idx / (72 * 2048), r = idx % (72 * 2048), n = r / 2048, k = r % 2048;
            wrt[idx] = n < 8 ? INP(36)[((size_t)l * 2048 + k) * 8 + n] : INP(38)[((size_t)l * 2048 + k) * 64 + (n - 8)]; }
    }
    {
        bf16* ha = WSP(bf16, WS_HA);
        for (int idx = gt; idx < 2048; idx += NGT) ha[(size_t)TT * 2048 + idx] = 0;
    }
    LAS float* scr = (LAS float*)(F.lds + F.wave * 16896);
    {
        const float* c = INP(1); const float* cctx = INP(3); const float* adaw = INP(4); float* part = WSP(float, WS_ADAP);
        for (int rep = 0; rep < (((PH_REPEAT >> 26) & 1u) ? 2 : 1); ++rep)
        for (int it = F.gw; it < 2 * 32 * 48; it += F.NGW) {
            const int l = it / (32 * 48), r = it % (32 * 48), ks = r / 48, jb = r % 48, k0 = ks * 64, j0 = jb * 256 + F.lane * 4;
            const float c0 = c[k0 + F.lane], c1 = c[2048 + k0 + F.lane], c2 = cctx[k0 + F.lane];
            const float s0 = c0 / (1.0f + expf(-c0)), s1 = c1 / (1.0f + expf(-c1)), s2 = c2 / (1.0f + expf(-c2));
            f32x4 a0 = {0.f, 0.f, 0.f, 0.f}, a1 = a0, a2 = a0;
            const float* wp = adaw + ((size_t)l * 2048 + k0) * 12288 + j0;
#pragma unroll 8
            for (int kk = 0; kk < 64; ++kk) { const f32x4 w = *(const f32x4*)(wp + (size_t)kk * 12288);
                const float t0 = __builtin_bit_cast(float, __builtin_amdgcn_readlane(__builtin_bit_cast(int, s0), kk));
                const float t1 = __builtin_bit_cast(float, __builtin_amdgcn_readlane(__builtin_bit_cast(int, s1), kk));
                const float t2 = __builtin_bit_cast(float, __builtin_amdgcn_readlane(__builtin_bit_cast(int, s2), kk));
                a0 += w * t0; a1 += w * t1; a2 += w * t2; }
            float* pp = part + ((size_t)(l * 32 + ks) * 3) * 12288 + j0;
            *(f32x4*)(pp) = a0; *(f32x4*)(pp + 12288) = a1; *(f32x4*)(pp + 2 * 12288) = a2;
        }
    }
    {
        constexpr int I0 = 1024, I1 = 512, I2 = 512, I3 = 1024, I4 = 2048, I5 = 1024, I6 = 64, I7 = 256, IE = 768;
        constexpr int NSMALL = I0 + I1 + I2 + I3 + I4 + I5 + I6 + I7;
        const int NITEMS = NSMALL;
        for (int rep = 0; rep < (((PH_REPEAT >> 27) & 1u) ? 2 : 1); ++rep)
        for (int it = F.gw; it < NITEMS; it += F.NGW) {
            int r = it;
            if (r < I0) { tr_item(INP(9), 4096, 2048, WSP(bf16, WS_WIN0), 2048, 0, 16, scr, r, F.lane); continue; } r -= I0;
            if (r < I1) { tr_item(INP(9) + 2048, 4096, 1024, WSP(bf16, WS_WIN0), 2048, 3072, 16, scr, r, F.lane); continue; } r -= I1;
            if (r < I2) { tr_item(INP(9) + 3072, 4096, 1024, WSP(bf16, WS_WIN0), 2048, 2048, 16, scr, r, F.lane); continue; } r -= I2;
            if (r < I3) { tr_item(INP(10), 2048, 2048, WSP(bf16, WS_WOUT0), 2048, 0, 16, scr, r, F.lane); continue; } r -= I3;
            if (r < I4) { tr_item(INP(15), 4096, 4096, WSP(bf16, WS_WIN1), 2048, 0, 16, scr, r, F.lane); continue; } r -= I4;
            if (r < I5) { tr_item(INP(16), 2048, 2048, WSP(bf16, WS_WOUT1), 2048, 0, 16, scr, r, F.lane); continue; } r -= I5;
            if (r < I6) { const int g = r / 16; tr_item(INP(13) + (size_t)g * 65536, 256, 256, WSP(bf16, WS_WPOOL), 256, g * 256, 16, scr, r % 16, F.lane); continue; } r -= I6;
            if (r < I7) { tr_item(INP(34), 1024, 1024, WSP(bf16, WS_WGLU), 1024, 0, 16, scr, r, F.lane); continue; } r -= I7;
        }
    }
    if ((F.bid & 1) != 0) { __syncthreads(); for (int pb = F.bid; pb < SEQ / 32; pb += F.G) hyfilt_item(F, pb); }
}

__device__ __forceinline__ void p1_reduce(Frame& F) {
    const int gt = F.bid * NTHREADS + F.tid, NGT = F.G * NTHREADS;
    const float* part = WSP(float, WS_ADAP); float* mod = WSP(float, WS_MOD); const float* adab = INP(5);
    for (int idx = gt; idx < 2 * 3 * 12288; idx += NGT) { const int l = idx / (3 * 12288), r = idx % (3 * 12288), m = r / 12288, j = r % 12288;
        float a = adab[l * 12288 + j];
        for (int ks = 0; ks < 32; ++ks) a += part[((size_t)(l * 32 + ks) * 3 + m) * 12288 + j];
        mod[idx] = a; }
    const float* normp = WSP(float, WS_NORMP); float* invn = WSP(float, WS_INVN);
    for (int idx = gt; idx < 2048; idx += NGT) { const int o = idx >> 10, ch = idx & 1023; float a = 0.f;
        for (int pb = 0; pb < 256; ++pb) a += normp[(size_t)pb * 4096 + o * 2048 + ch] + normp[(size_t)pb * 4096 + o * 2048 + 1024 + ch];
        invn[idx] = 1.0f / a; }
    {
        const f32x2* lamb = WSP(f32x2, WS_S5LAM); const f32x2* bbar = WSP(f32x2, WS_S5B); const float* cre = INP(31); const float* cim = INP(32);
        bf16* W1 = WSP(bf16, WS_S5W1); bf16* W3 = WSP(bf16, WS_S5W3); bf16* KT = WSP(bf16, WS_S5KT); f32x2* l16 = WSP(f32x2, WS_S5L16);
#define S5_POWF(l_, e_, pw_) do { pw_ = (f32x2){1.f, 0.f}; f32x2 b_ = l_; for (int q_ = (e_); q_ > 0; q_ >>= 1) { if (q_ & 1) pw_ = (f32x2){pw_.x * b_.x - pw_.y * b_.y, pw_.x * b_.y + pw_.y * b_.x}; b_ = (f32x2){b_.x * b_.x - b_.y * b_.y, 2.f * b_.x * b_.y}; } } while (0)
        for (int idx = gt; idx < 128 * 64; idx += NGT) { f32x2 pw; S5_POWF(lamb[idx], 16, pw); l16[idx] = pw; }
        for (int idx = gt; idx < 128 * 128 * 32; idx += NGT) {
            const int k8 = idx & 31, n = (idx >> 5) & 127, dg = idx >> 12, sigma = k8 >> 1, h = k8 & 1, p = (n & 15) + 16 * ((n >> 4) & 3), im = n >> 6;
            f32x2 pw; S5_POWF(lamb[dg * 64 + p], 15 - sigma, pw);
            const f32x4* bp = (const f32x4*)(bbar + ((size_t)dg * 64 + p) * 16 + 8 * h); float o[8];
#pragma unroll
            for (int j = 0; j < 4; ++j) { const f32x4 q = bp[j]; o[2 * j] = im ? (pw.x * q.y + pw.y * q.x) : (pw.x * q.x - pw.y * q.y); o[2 * j + 1] = im ? (pw.x * q.w + pw.y * q.z) : (pw.x * q.z - pw.y * q.w); }
            v4u w; w.x = pk2(o[0], o[1]); w.y = pk2(o[2], o[3]); w.z = pk2(o[4], o[5]); w.w = pk2(o[6], o[7]);
            *(v4u*)(W1 + (size_t)idx * 8) = w; }
        for (int idx = gt; idx < 128 * 256 * 16; idx += NGT) {
            const int k8 = idx & 15, n = (idx >> 4) & 255, dg = idx >> 12, tau = n >> 4, cout = n & 15; float o[8];
#pragma unroll
            for (int j = 0; j < 4; ++j) { const int p = 4 * k8 + j; f32x2 pw; S5_POWF(lamb[dg * 64 + p], tau + 1, pw);
                const float cr = cre[((size_t)dg * 16 + cout) * 64 + p], ci = cim[((size_t)dg * 16 + cout) * 64 + p]; o[2 * j] = cr * pw.x - ci * pw.y; o[2 * j + 1] = -(cr * pw.y + ci * pw.x); }
            v4u w; w.x = pk2(o[0], o[1]); w.y = pk2(o[2], o[3]); w.z = pk2(o[4], o[5]); w.w = pk2(o[6], o[7]);
            *(v4u*)(W3 + (size_t)idx * 8) = w; }
        for (int idx = gt; idx < 128 * 17 * 16 * 2; idx += NGT) {
            const int h = idx & 1, cout = (idx >> 1) & 15, d1 = (idx >> 5) % 17, dg = (idx >> 5) / 17;
            float acc[8];
#pragma unroll
            for (int j = 0; j < 8; ++j) acc[j] = 0.f;
            if (d1 > 0) { for (int p = 0; p < 64; ++p) { f32x2 pw; S5_POWF(lamb[dg * 64 + p], d1 - 1, pw);
                const float cr = cre[((size_t)dg * 16 + cout) * 64 + p], ci = cim[((size_t)dg * 16 + cout) * 64 + p]; const float gr = cr * pw.x - ci * pw.y, gi = cr * pw.y + ci * pw.x;
                const f32x4* bp = (const f32x4*)(bbar + ((size_t)dg * 64 + p) * 16 + 8 * h);
#pragma unroll
                for (int j = 0; j < 4; ++j) { const f32x4 q = bp[j]; acc[2 * j] += gr * q.x - gi * q.y; acc[2 * j + 1] += gr * q.z - gi * q.w; } } }
            v4u w; w.x = pk2(acc[0], acc[1]); w.y = pk2(acc[2], acc[3]); w.z = pk2(acc[4], acc[5]); w.w = pk2(acc[6], acc[7]);
            *(v4u*)(KT + (size_t)idx * 8) = w; }
#undef S5_POWF
    }
}

__device__ __forceinline__ const float* modp(Frame& F, int l, int m, int c) { return WSP(float, WS_MOD) + ((size_t)(l * 3 + m) * 6 + c) * 2048; }
__device__ __forceinline__ int row_stream(int r) { return r < TL ? r / SEQ : 2; }

template <int MODE>
__device__ __forceinline__ void norm_phase(Frame& F, int l, float* dout) {
    const int nrows = (MODE == 3 || (MODE == 1 && l == 1)) ? TL : TT;
    float* xbuf = WSP(float, WS_X); bf16* ha = WSP(bf16, WS_HA); const bf16* Y = WSP(bf16, WS_Y);
    const float* gvec = (MODE == 0) ? INP(6) : (MODE == 1) ? INP(7) + l * 2048 : (MODE == 2) ? INP(6) + 2048 : INP(8);
    const int lane = F.lane;
    for (int r = F.gw; r < nrows; r += F.NGW) {
        const int m = row_stream(r);
        const float* src = (MODE == 0) ? (r < TL ? INP(0) + (size_t)r * 2048 : INP(2) + (size_t)(r - TL) * 2048) : xbuf + (size_t)r * 2048;
        f32x4 v[8]; float ss = 0.f;
#pragma unroll
        for (int j = 0; j < 8; ++j) v[j] = *(const f32x4*)(src + 4 * lane + 256 * j);
        if (MODE == 2 || MODE == 3) {
            const float* g2 = modp(F, MODE == 2 ? 0 : 1, m, 5);
            const bf16* y0 = Y + (size_t)(2 * r) * 2048; const bf16* y1 = y0 + 2048;
#pragma unroll
            for (int j = 0; j < 8; ++j) { const int c = 4 * lane + 256 * j; const v2u a = *(const v2u*)(y0 + c), b = *(const v2u*)(y1 + c); const f32x4 gg = *(const f32x4*)(g2 + c);
                v[j].x += gg.x * (bflo(a.x) + bflo(b.x)); v[j].y += gg.y * (bfhi(a.x) + bfhi(b.x)); v[j].z += gg.z * (bflo(a.y) + bflo(b.y)); v[j].w += gg.w * (bfhi(a.y) + bfhi(b.y)); }
            if (MODE == 2) {
#pragma unroll
                for (int j = 0; j < 8; ++j) *(f32x4*)(xbuf + (size_t)r * 2048 + 4 * lane + 256 * j) = v[j];
            }
        }
#pragma unroll
        for (int j = 0; j < 8; ++j) ss += (v[j].x * v[j].x + v[j].y * v[j].y) + (v[j].z * v[j].z + v[j].w * v[j].w);
        ss = wave_sum(ss);
        const float rs = 1.0f / sqrtf(ss * (1.0f / 2048.0f) + EPS);
        if (MODE == 3) {
#pragma unroll
            for (int j = 0; j < 8; ++j) { const int c = 4 * lane + 256 * j; const f32x4 gg = *(const f32x4*)(gvec + c); *(f32x4*)(dout + (size_t)r * 2048 + c) = v[j] * rs * gg; }
            continue;
        }
        const int lm = (MODE == 2) ? 1 : l;
        const float* sh = modp(F, lm, m, MODE == 1 ? 3 : 0); const float* sc = modp(F, lm, m, MODE == 1 ? 4 : 1);
#pragma unroll
        for (int j = 0; j < 8; ++j) { const int c = 4 * lane + 256 * j; const f32x4 gg = *(const f32x4*)(gvec + c), s1 = *(const f32x4*)(sc + c), s0 = *(const f32x4*)(sh + c);
            v[j] = (v[j] * rs * gg) * (1.0f + s1) + s0;
            v2u o; o.x = pk2(v[j].x, v[j].y); o.y = pk2(v[j].z, v[j].w); *(v2u*)(ha + (size_t)r * 2048 + c) = o; }
    }
}

__device__ __forceinline__ void ffn_norm_router_phase(Frame& F, int l) {
    const int nrows = (l == 1) ? TL : TT;
    const float* xbuf = WSP(float, WS_X); bf16* ha = WSP(bf16, WS_HA);
    const float* gvec = INP(7) + l * 2048;
    const float* wrt = WSP(float, WS_WRT) + (size_t)l * 72 * 2048;
    LAS float* hl = (LAS float*)F.lds;
    LAS float* lg = (LAS float*)(F.lds + 131584);
    const int lane = F.lane, tid = F.tid, l31 = lane & 31, lh = lane >> 5;
    for (int it = F.bid; it < nrows / 32; it += F.G) {
        const int r0 = it * 32 + F.wave * 4;
        f32x4 v[4][8];
#pragma unroll
        for (int rr = 0; rr < 4; ++rr)
#pragma unroll
            for (int j = 0; j < 8; ++j) v[rr][j] = *(const f32x4*)(xbuf + (size_t)(r0 + rr) * 2048 + 4 * lane + 256 * j);
        const int m = row_stream(r0);
        const float* sh = modp(F, l, m, 3); const float* sc = modp(F, l, m, 4);
        float rs[4];
#pragma unroll
        for (int rr = 0; rr < 4; ++rr) { float ss = 0.f;
#pragma unroll
            for (int j = 0; j < 8; ++j) ss += (v[rr][j].x * v[rr][j].x + v[rr][j].y * v[rr][j].y) + (v[rr][j].z * v[rr][j].z + v[rr][j].w * v[rr][j].w);
            ss = wave_sum(ss); rs[rr] = 1.0f / sqrtf(ss * (1.0f / 2048.0f) + EPS); }
#pragma unroll
        for (int j = 0; j < 8; ++j) { if ((j & 1) == 0) __builtin_amdgcn_sched_barrier(0); const int c = 4 * lane + 256 * j; const f32x4 gg = *(const f32x4*)(gvec + c), s1 = *(const f32x4*)(sc + c), s0 = *(const f32x4*)(sh + c);
#pragma unroll
            for (int rr = 0; rr < 4; ++rr) { v[rr][j] = (v[rr][j] * rs[rr] * gg) * (1.0f + s1) + s0;
                v2u o; o.x = cvt_pk_bf16(v[rr][j].x, v[rr][j].y); o.y = cvt_pk_bf16(v[rr][j].z, v[rr][j].w); *(v2u*)(ha + (size_t)(r0 + rr) * 2048 + c) = o; } }
        f32x16 acc[3];
#pragma unroll
        for (int nt = 0; nt < 3; ++nt)
#pragma unroll
            for (int r = 0; r < 16; ++r) acc[nt][r] = 0.f;
        const int nr2 = (64 + l31 < 72) ? 64 + l31 : 71;
#pragma unroll
        for (int hK = 0; hK < 2; ++hK) {
#pragma unroll
            for (int rr = 0; rr < 4; ++rr)
#pragma unroll
                for (int j = 0; j < 4; ++j) *(LAS f32x4*)(hl + (F.wave * 4 + rr) * 1028 + 256 * j + 4 * lane) = v[rr][4 * hK + j];
            __syncthreads();
            const LAS float* ap = hl + l31 * 1028 + 128 * F.wave + 4 * lh;
            const float* wp = wrt + 1024 * hK + 128 * F.wave + 4 * lh;
            const float* w0 = wp + (size_t)l31 * 2048; const float* w1 = wp + (size_t)(32 + l31) * 2048; const float* w2 = wp + (size_t)nr2 * 2048;
#pragma nounroll
            for (int jc = 0; jc < 4; ++jc) {
                f32x4 af[4], b0[4], b1[4], b2[4];
#pragma unroll
                for (int jj = 0; jj < 4; ++jj) { const int o = 8 * (4 * jc + jj); b0[jj] = *(const f32x4*)(w0 + o); b1[jj] = *(const f32x4*)(w1 + o); b2[jj] = *(const f32x4*)(w2 + o); af[jj] = *(const LAS f32x4*)(ap + o); }
#pragma unroll
                for (int jj = 0; jj < 4; ++jj)
#pragma unroll
                    for (int c = 0; c < 4; ++c) {
                        acc[0] = __builtin_amdgcn_mfma_f32_32x32x2f32(af[jj][c], b0[jj][c], acc[0], 0, 0, 0);
                        acc[1] = __builtin_amdgcn_mfma_f32_32x32x2f32(af[jj][c], b1[jj][c], acc[1], 0, 0, 0);
                        acc[2] = __builtin_amdgcn_mfma_f32_32x32x2f32(af[jj][c], b2[jj][c], acc[2], 0, 0, 0); }
                asm volatile("" : "+v"(acc[0]), "+v"(acc[1]), "+v"(acc[2]) : "v"(af[0]), "v"(af[1]), "v"(af[2]), "v"(af[3]), "v"(b0[0]), "v"(b0[1]), "v"(b0[2]), "v"(b0[3]),
                             "v"(b1[0]), "v"(b1[1]), "v"(b1[2]), "v"(b1[3]), "v"(b2[0]), "v"(b2[1]), "v"(b2[2]), "v"(b2[3]));
            }
            __syncthreads();
        }
        {
            LAS float* pw = hl + F.wave * (32 * 96);
#pragma unroll
            for (int nt = 0; nt < 3; ++nt)
#pragma unroll
                for (int r = 0; r < 16; ++r) pw[((r & 3) + 8 * (r >> 2) + 4 * lh) * 96 + 32 * nt + l31] = acc[nt][r];
        }
        __syncthreads();
        for (int idx = tid; idx < 32 * 72; idx += NTHREADS) { const int row = idx / 72, col = idx - row * 72; float s = 0.f;
#pragma unroll
            for (int w = 0; w < 8; ++w) s += hl[w * (32 * 96) + row * 96 + col];
            lg[row * 80 + col] = s; }
        __syncthreads();
        if (lane < 4) {
            const int r = r0 + lane; const LAS float* L = lg + (F.wave * 4 + lane) * 80;
            float gl[8]; float gmax = -INFINITY; int gi = 0;
#pragma unroll
            for (int j = 0; j < 8; ++j) { gl[j] = L[j] + INP(37)[l * 8 + j]; if (gl[j] > gmax) { gmax = gl[j]; gi = j; } }
            float gsum = 0.f;
#pragma unroll
            for (int j = 0; j < 8; ++j) gsum += expf(gl[j] - gmax);
            const float pg_top = 1.0f / gsum;
            float pe[8]; float emax = -INFINITY;
#pragma unroll
            for (int j = 0; j < 8; ++j) { pe[j] = L[8 + gi * 8 + j] + INP(39)[l * 64 + gi * 8 + j]; emax = fmaxf(emax, pe[j]); }
            float esum = 0.f;
#pragma unroll
            for (int j = 0; j < 8; ++j) { pe[j] = expf(pe[j] - emax); esum += pe[j]; }
            int e1 = 0; float p1 = -1.f;
#pragma unroll
            for (int j = 0; j < 8; ++j) { pe[j] /= esum; if (pe[j] > p1) { p1 = pe[j]; e1 = j; } }
            int e2 = 0; float p2 = -1.f;
#pragma unroll
            for (int j = 0; j < 8; ++j) { if (j != e1 && pe[j] > p2) { p2 = pe[j]; e2 = j; } }
            const float den = p1 + p2; const float g1 = pg_top * p1 / den, g2 = pg_top * p2 / den;
            unsigned* cnt = WSP(unsigned, WS_CTL) + CW_CNT + l * 64 * CSTR; int* tokl = WSP(int, WS_TOKL); float* gatel = WSP(float, WS_GATEL);
            const int ex1 = gi * 8 + e1, ex2 = gi * 8 + e2;
            const unsigned k1 = atomicAdd(cnt + ex1 * CSTR, 1u); tokl[(size_t)ex1 * LISTCAP + k1] = 2 * r; gatel[(size_t)ex1 * LISTCAP + k1] = g1;
            const unsigned k2 = atomicAdd(cnt + ex2 * CSTR, 1u); tokl[(size_t)ex2 * LISTCAP + k2] = 2 * r + 1; gatel[(size_t)ex2 * LISTCAP + k2] = g2;
        }
        __syncthreads();
    }
}

#define EPI_ARGS const f32x4 (&acc)[2][2][4][2], const pg8::Unit& u, int wr, int wc, int fr, int fq
__device__ __forceinline__ void st_bf4(bf16* p, f32x4 v) { v2u o; o.x = cvt_pk_bf16(v.x, v.y); o.y = cvt_pk_bf16(v.z, v.w); *(v2u*)p = o; }
__device__ __forceinline__ void st_bf8(bf16* p, f32x4 a, f32x4 b) { v4u o; o.x = cvt_pk_bf16(a.x, a.y); o.y = cvt_pk_bf16(a.z, a.w); o.z = cvt_pk_bf16(b.x, b.y); o.w = cvt_pk_bf16(b.z, b.w); *(v4u*)p = o; }

struct EpiQKP {
    static constexpr bool PERM = false;
    bf16* Q; bf16* Kb; bf16* P; const f32x2* rope;
    __device__ __forceinline__ void operator()(EPI_ARGS) const {
        const int sect = u.pn >> 2, cb = (u.pn & 3) * 256; const bool latent = u.pm < TL / 256;
#pragma unroll
        for (int ai = 0; ai < 2; ++ai)
#pragma unroll
            for (int m = 0; m < 4; ++m) {
                const int r = u.pm * 256 + ai * 128 + wr * 64 + m * 16 + fr;
                int b, t; if (latent) { b = r / SEQ; t = r % SEQ; } else { b = (r - TL) / CTX; t = (r - TL) % CTX; }
                f32x4 cs0 = {1.f, 0.f, 1.f, 0.f}, cs1 = cs0;
                if (latent && sect < 2) { const int pos = (wc & 1) ? (t & 63) : (t >> 6); const f32x4* rp = (const f32x4*)(rope + pos * 16 + 4 * fq); cs0 = rp[0]; cs1 = rp[1]; }
#pragma unroll
                for (int bj = 0; bj < 2; ++bj) {
                    const int c0 = cb + bj * 128 + wc * 32 + 4 * fq;
                    f32x4 a = acc[ai][bj][m][0], bb = acc[ai][bj][m][1];
                    if (sect < 2) {
                        const f32x4 co = {cs0.x, cs0.z, cs1.x, cs1.z}, si = {cs0.y, cs0.w, cs1.y, cs1.w};
                        const f32x4 oa = a * co - bb * si, ob = a * si + bb * co; a = oa; bb = ob;
                    }
                    if (sect == 0) { a = a * QSCALE; bb = bb * QSCALE; bf16* d = Q + (size_t)r * 1024 + c0; st_bf4(d, a); st_bf4(d + 16, bb); }
                    else if (sect == 1) { const size_t kr = (size_t)b * KEYS + (latent ? CTX + t : t); bf16* d = Kb + kr * 1024 + c0; st_bf4(d, a); st_bf4(d + 16, bb); }
                    else { bf16* d = P + (size_t)r * 1024 + c0; st_bf4(d, a); st_bf4(d + 16, bb); }
                }
            }
    }
};
struct EpiVT {
    static constexpr bool PERM = false;
    bf16* VT;
    __device__ __forceinline__ void operator()(EPI_ARGS) const {
        const bool latent = u.pn < TL / 256; const int b = latent ? u.pn / 32 : u.pn - TL / 256; const int key_t0 = latent ? CTX + (u.pn % 32) * 256 : 0;
        const int kperm = 8 * (fq & 1) + 4 * (fq >> 1);
#pragma unroll
        for (int ai = 0; ai < 2; ++ai)
#pragma unroll
            for (int m = 0; m < 4; ++m) {
                const int rr = u.pm * 256 + ai * 128 + wr * 64 + m * 16 + fr;
                bf16* rowp = VT + ((size_t)b * 1024 + rr) * KEYS + key_t0;
#pragma unroll
                for (int bj = 0; bj < 2; ++bj)
#pragma unroll
                    for (int n = 0; n < 2; ++n) st_bf4(rowp + bj * 128 + wc * 32 + 16 * n + kperm, acc[ai][bj][m][n]);
            }
    }
};
struct EpiScaleBf16 {
    static constexpr bool PERM = true;
    bf16* O; int ldo, coff; const float* cscale;
    __device__ __forceinline__ void operator()(EPI_ARGS) const {
#pragma unroll
        for (int bj = 0; bj < 2; ++bj) { const int c = u.pn * 256 + bj * 128 + wc * 32 + 8 * fq; const f32x4 s0 = *(const f32x4*)(cscale + c), s1 = *(const f32x4*)(cscale + c + 4);
#pragma unroll
            for (int ai = 0; ai < 2; ++ai)
#pragma unroll
                for (int m = 0; m < 4; ++m) { const int r = u.pm * 256 + ai * 128 + wr * 64 + m * 16 + fr; st_bf8(O + (size_t)r * ldo + coff + c, acc[ai][bj][m][0] * s0, acc[ai][bj][m][1] * s1); } }
    }
};
struct EpiBf16 {
    static constexpr bool PERM = true;
    bf16* O; int ldo;
    __device__ __forceinline__ void operator()(EPI_ARGS) const {
#pragma unroll
        for (int ai = 0; ai < 2; ++ai)
#pragma unroll
            for (int m = 0; m < 4; ++m) { const int r = u.pm * 256 + ai * 128 + wr * 64 + m * 16 + fr; bf16* rowp = O + (size_t)r * ldo + u.pn * 256 + wc * 32 + 8 * fq;
#pragma unroll
                for (int bj = 0; bj < 2; ++bj) st_bf8(rowp + bj * 128, acc[ai][bj][m][0], acc[ai][bj][m][1]); }
    }
};
struct EpiRes {
    static constexpr bool PERM = false;
    const float* xlat; const float* xctx; float* xout; const float* gate0;
    __device__ __forceinline__ void operator()(EPI_ARGS) const {
        const bool latent = u.pm < TL / 256;
#pragma unroll
        for (int ai = 0; ai < 2; ++ai)
#pragma unroll
            for (int m = 0; m < 4; ++m) { const int r = u.pm * 256 + ai * 128 + wr * 64 + m * 16 + fr; const int ms = latent ? r / SEQ : 2;
                const float* xi = latent ? xlat + (size_t)r * 2048 : xctx + (size_t)(r - TL) * 2048; const float* gp = gate0 + (size_t)ms * 12288;
#pragma unroll
                for (int bj = 0; bj < 2; ++bj)
#pragma unroll
                    for (int n = 0; n < 2; ++n) { const int c = u.pn * 256 + bj * 128 + wc * 32 + 16 * n + 4 * fq;
                        const f32x4 xv = *(const f32x4*)(xi + c), gv = *(const f32x4*)(gp + c); *(f32x4*)(xout + (size_t)r * 2048 + c) = xv + gv * acc[ai][bj][m][n]; } }
    }
};
struct EpiMoeUp {
    static constexpr bool PERM = false;
    bf16* H;
    __device__ __forceinline__ void operator()(EPI_ARGS) const {
#pragma unroll
        for (int ai = 0; ai < 2; ++ai)
#pragma unroll
            for (int m = 0; m < 4; ++m) { const size_t r = (size_t)u.pm * 256 + ai * 128 + wr * 64 + m * 16 + fr;
#pragma unroll
                for (int bj = 0; bj < 2; ++bj) { const int hc = (u.pn * 256 + bj * 128 + wc * 32) / 2 + 4 * fq; const f32x4 a = acc[ai][bj][m][0], b = acc[ai][bj][m][1];
                    const f32x4 h = {siluf_(a.x) * b.x, siluf_(a.y) * b.y, siluf_(a.z) * b.z, siluf_(a.w) * b.w}; st_bf4(H + r * 512 + hc, h); } }
    }
};
struct EpiMoeDown {
    static constexpr bool PERM = true;
    bf16* Y; const int* tokl; const float* gatel; const unsigned* cnt;
    __device__ __forceinline__ void operator()(EPI_ARGS) const {
        const int ce = (int)cnt[u.e * CSTR];
#pragma unroll
        for (int ai = 0; ai < 2; ++ai)
#pragma unroll
            for (int m = 0; m < 4; ++m) { const int idx = u.idx0 + ai * 128 + wr * 64 + m * 16 + fr;
                if (idx < ce) { const int pair = tokl[(size_t)u.e * LISTCAP + idx]; const float gt = gatel[(size_t)u.e * LISTCAP + idx]; bf16* rowp = Y + (size_t)pair * 2048 + u.pn * 256 + wc * 32 + 8 * fq;
#pragma unroll
                    for (int bj = 0; bj < 2; ++bj) st_bf8(rowp + bj * 128, acc[ai][bj][m][0] * gt, acc[ai][bj][m][1] * gt); } }
    }
};
struct EpiGlu {
    static constexpr bool PERM = true;
    bf16* O; int ldo, coff; const bf16* Gb; const float* bias;
    __device__ __forceinline__ void operator()(EPI_ARGS) const {
#pragma unroll
        for (int ai = 0; ai < 2; ++ai)
#pragma unroll
            for (int m = 0; m < 4; ++m) { const int r = u.pm * 256 + ai * 128 + wr * 64 + m * 16 + fr;
#pragma unroll
                for (int bj = 0; bj < 2; ++bj) { const int c = u.pn * 256 + bj * 128 + wc * 32 + 8 * fq; const f32x4 b0 = *(const f32x4*)(bias + c), b1 = *(const f32x4*)(bias + c + 4); const v4u gw = *(const v4u*)(Gb + (size_t)r * 1024 + c);
                    const f32x4 a0 = acc[ai][bj][m][0] + b0, a1 = acc[ai][bj][m][1] + b1;
                    const f32x4 o0 = {bflo(gw.x) * sigmoidf_(a0.x), bfhi(gw.x) * sigmoidf_(a0.y), bflo(gw.y) * sigmoidf_(a0.z), bfhi(gw.y) * sigmoidf_(a0.w)};
                    const f32x4 o1 = {bflo(gw.z) * sigmoidf_(a1.x), bfhi(gw.z) * sigmoidf_(a1.y), bflo(gw.w) * sigmoidf_(a1.z), bfhi(gw.w) * sigmoidf_(a1.w)};
                    st_bf8(O + (size_t)r * ldo + coff + c, o0, o1); } }
    }
};

struct MoeOrder {
    const LAS int* bstart;
    const unsigned* cnt; const int* tokl; int nN, G, c, nblk; long bstride, eoff; bool up;
    __device__ bool next(int i, pg8::Unit& u) const {
        const long Lx = (long)i * G + c; if (Lx >= (long)nblk * nN) return false;
        const int blk = (int)(Lx / nN); u.pn = (int)(Lx % nN); u.pm = blk;
        const int e = bstart[65 + blk];
        u.e = e; u.idx0 = (blk - bstart[e]) * 256;
        u.aoff = up ? 0 : (long)blk * 256 * 512 * 2;
        u.boff = (long)e * (long)MOE_E_BYTES + eoff + (long)u.pn * bstride;
        return true;
    }
    __device__ int arow(const pg8::Unit& u, int row) const { const int idx = u.idx0 + row; return idx < (int)cnt[u.e * CSTR] ? (tokl[(size_t)u.e * LISTCAP + idx] >> 1) : TT; }
};

__device__ __forceinline__ void tile_order(int wgid, int nM, int nN, int& pm, int& pn) {
    const int nwg = nM * nN; { const int q = nwg / 8, r = nwg % 8, xcd = wgid % 8, off = wgid / 8; wgid = (xcd < r ? xcd * (q + 1) : r * (q + 1) + (xcd - r) * q) + off; }
    const int nig = 8 * nN, gid = wgid / nig, fm = gid * 8, gsz = (nM - fm) < 8 ? (nM - fm) : 8;
    pm = fm + ((wgid % nig) % gsz); pn = (wgid % nig) / gsz;
}
struct InProj0Order {
    int G, c; long offA1, offB1, offA2, offB2;
    __device__ bool next(int i, pg8::Unit& u) const {
        const int Lx = i * G + c; constexpr int N1 = (TT / 256) * 12, N2 = 4 * (TT / 256); constexpr long TS = 256L * 2048 * 2;
        if (Lx >= N1 + N2) return false;
        u.idx0 = 0;
        if (Lx < N1) { tile_order(Lx, TT / 256, 12, u.pm, u.pn); u.aoff = offA1 + (long)u.pm * TS; u.boff = offB1 + (long)u.pn * TS; u.e = 0; }
        else { tile_order(Lx - N1, 4, TT / 256, u.pm, u.pn); u.aoff = offA2 + (long)u.pm * TS; u.boff = offB2 + (long)u.pn * TS; u.e = 1; }
        return true;
    }
    __device__ int arow(const pg8::Unit&, int) const { return 0; }
};
struct EpiInProj0 {
    static constexpr bool PERM = false;
    EpiQKP e1; EpiVT e2;
    __device__ __forceinline__ void operator()(EPI_ARGS) const { if (u.e == 0) e1(acc, u, wr, wc, fr, fq); else e2(acc, u, wr, wc, fr, fq); }
};

#ifdef ATT_NORARE
#define ATT_RARE(mx) false
#else
#define ATT_RARE(mx) __any(mx > 8.0f)
#endif
__device__ __forceinline__ float xhalf_max(float v) {
    const auto r = __builtin_amdgcn_permlane32_swap(__builtin_bit_cast(unsigned, v), __builtin_bit_cast(unsigned, v), false, false);
    return fmaxf(__builtin_bit_cast(float, r[0]), __builtin_bit_cast(float, r[1]));
}
__device__ __forceinline__ void attn_phase(Frame& F, const int cvslot) {
    const bf16* Q = WSP(bf16, WS_Q); const bf16* Kb = WSP(bf16, WS_K); const bf16* VT = WSP(bf16, WS_VT); bf16* cat = WSP(bf16, WS_CAT);
    LAS unsigned char* lds = F.lds;
    const int lane0 = F.lane;
    float lam;
    { const float* lv = INP(11); float a = lv[lane0] * lv[64 + lane0], b = lv[128 + lane0] * lv[192 + lane0]; a = wave_sum(a); b = wave_sum(b); lam = expf(a) - expf(b) + 0.2f; }
    const float* subg = INP(12);
    const int NU = 1024 + 32;
    const int xcd = F.bid & 7, jcu = F.bid >> 3;
    for (int it = 0;; ++it) {
        if (it == cvslot) { for (int rep_ = 0; rep_ < (((PH_REPEAT >> 26) & 1u) ? 2 : 1); ++rep_) { moe_convert_items(F); __syncthreads(); } }
        int tl_ = F.tid; asm volatile("" : "+v"(tl_));
        const int lane = tl_ & 63, w = __builtin_amdgcn_readfirstlane(tl_ >> 6), sub = w & 1, qw = w >> 1, r32 = lane & 31, hi = lane >> 5;
        int uidx;
        if (F.G == 256) { if (it < 4) uidx = 128 * xcd + it * 32 + jcu; else if (it == 4 && F.bid < 32) uidx = 1024 + F.bid; else break; }
        else { uidx = it * F.G + F.bid; if (uidx >= NU) break; }
        int b, head, q0row, nt; size_t kbase;
        if (uidx < 1024) { const int combo = uidx >> 6, qb = uidx & 63; b = combo >> 3; head = combo & 7; q0row = b * SEQ + qb * 128; nt = KEYS / 64; }
        else { const int v = uidx - 1024; b = v >> 4; head = (v >> 1) & 7; q0row = TL + b * CTX + (v & 1) * 128; nt = CTX / 64; }
        kbase = (size_t)b * KEYS;
        bf16x8 qf[4];
        { const bf16* qp = Q + (size_t)(q0row + qw * 32 + r32) * 1024 + head * 128 + sub * 64 + hi * 8;
#pragma unroll
          for (int ks = 0; ks < 4; ++ks) qf[ks] = *(const bf16x8*)(qp + ks * 16); }
        const char* gsrc[4];
#pragma unroll
        for (int j = 0; j < 4; ++j) { const int pi = w * 4 + j, rr = lane >> 3, pc = lane & 7;
            if (pi < 16) { const int key = (pi & 7) * 8 + rr, c = pc ^ ((key >> 1) & 7); gsrc[j] = (const char*)(Kb + (kbase + key) * 1024 + head * 128 + (pi >> 3) * 64 + c * 8); }
            else { const int dvr = (pi - 16) * 8 + rr, c = pc ^ ((dvr >> 1) & 7); gsrc[j] = (const char*)(VT + ((size_t)(b * 8 + head) * 128 + dvr) * KEYS + c * 8); } }
        const size_t gstep = (w < 4) ? (size_t)65536 * 2 : (size_t)64 * 2;
        const unsigned ldst = (unsigned)w * 4096u;
#define ATT_DMA(t, buf) do { _Pragma("unroll") for (int _j = 0; _j < 4; ++_j) \
            __builtin_amdgcn_global_load_lds((const unsigned*)(gsrc[_j] + (size_t)(t) * gstep), (LAS unsigned*)(lds + (buf) * 32768 + ldst + _j * 1024), 16, 0, 0); } while (0)
        ATT_DMA(0, 0); ATT_DMA(1, 1); ATT_DMA(2, 2);
        asm volatile("s_waitcnt vmcnt(4)" ::: "memory");
        __builtin_amdgcn_s_barrier();
        f32x16 o[4];
#pragma unroll
        for (int d = 0; d < 4; ++d)
#pragma unroll
            for (int r = 0; r < 16; ++r) o[d][r] = 0.f;
        float mref = 0.f, lrow = 0.f;
        f32x16 negm;
#pragma unroll
        for (int r = 0; r < 16; ++r) negm[r] = 0.f;
        const int rdoff = r32 * 128;
        const int swz = (r32 >> 1) & 7;
        f32x16 s0, s1; bf16x8 pf[4];
#define ATT_QK(bufidx) do { const LAS unsigned char* kp_ = lds + (bufidx) * 32768 + sub * 8192; bf16x8 kfa[4], kfb[4]; \
            _Pragma("unroll") for (int ks = 0; ks < 4; ++ks) { const int ch = ((2 * ks + hi) ^ swz) * 16; kfa[ks] = *(const LAS bf16x8*)(kp_ + rdoff + ch); kfb[ks] = *(const LAS bf16x8*)(kp_ + 4096 + rdoff + ch); } \
            s0 = negm; s1 = negm; \
            _Pragma("unroll") for (int ks = 0; ks < 4; ++ks) { s0 = __builtin_amdgcn_mfma_f32_32x32x16_bf16(kfa[ks], qf[ks], s0, 0, 0, 0); s1 = __builtin_amdgcn_mfma_f32_32x32x16_bf16(kfb[ks], qf[ks], s1, 0, 0, 0); } \
            asm volatile("" : "+v"(s0), "+v"(s1) : "v"(kfa[0]), "v"(kfa[1]), "v"(kfa[2]), "v"(kfa[3]), "v"(kfb[0]), "v"(kfb[1]), "v"(kfb[2]), "v"(kfb[3])); } while (0)
#define ATT_MAX(mx) do { float mxa = fmaxf(fmaxf(s0[0], s0[1]), s0[2]), mxb = fmaxf(fmaxf(s1[0], s1[1]), s1[2]); \
            _Pragma("unroll") for (int r = 3; r < 15; r += 2) { mxa = fmaxf(fmaxf(mxa, s0[r]), s0[r + 1]); mxb = fmaxf(fmaxf(mxb, s1[r]), s1[r + 1]); } \
            mx = fmaxf(fmaxf(mxa, mxb), fmaxf(s0[15], s1[15])); mx = xhalf_max(mx); } while (0)
#define ATT_FIX(mx) do { const float dl = fmaxf(mx, 0.f); mref += dl; const float alpha = __builtin_amdgcn_exp2f(-dl); lrow *= alpha; \
            _Pragma("unroll") for (int r = 0; r < 16; ++r) { s0[r] -= dl; s1[r] -= dl; negm[r] = -mref; } \
            _Pragma("unroll") for (int d = 0; d < 4; ++d) _Pragma("unroll") for (int r = 0; r < 16; ++r) o[d][r] *= alpha; } while (0)
#define ATT_EXP8(S, base, dst) do { float rs_ = 0.f; _Pragma("unroll") for (int r = 0; r < 8; ++r) { S[base + r] = __builtin_amdgcn_exp2f(S[base + r]); rs_ += S[base + r]; } lrow += rs_; \
            v4u pw_; pw_.x = cvt_pk_bf16(S[base + 0], S[base + 1]); pw_.y = cvt_pk_bf16(S[base + 2], S[base + 3]); pw_.z = cvt_pk_bf16(S[base + 4], S[base + 5]); pw_.w = cvt_pk_bf16(S[base + 6], S[base + 7]); dst = __builtin_bit_cast(bf16x8, pw_); } while (0)
#define ATT_VLD(dstv, vp_, s) do { _Pragma("unroll") for (int d = 0; d < 4; ++d) dstv[d] = *(const LAS bf16x8*)(vp_ + d * 4096 + rdoff + (((2 * (s) + hi) ^ swz) * 16)); } while (0)
#define ATT_PV4(srcv, pfrag) do { _Pragma("unroll") for (int d = 0; d < 4; ++d) o[d] = __builtin_amdgcn_mfma_f32_32x32x16_bf16(srcv[d], pfrag, o[d], 0, 0, 0); } while (0)
        { ATT_QK(0); float mx; ATT_MAX(mx); if (__any(mx > 8.0f)) ATT_FIX(mx);
          ATT_EXP8(s0, 0, pf[0]); ATT_EXP8(s0, 8, pf[1]); ATT_EXP8(s1, 0, pf[2]); ATT_EXP8(s1, 8, pf[3]); }
        int bcur = 0;
#pragma nounroll
        for (int t = 0; t < nt; ++t) {
            const int bn1 = (bcur + 1) & 3, bn3 = (bcur + 3) & 3;
            if (t + 3 < nt) ATT_DMA(t + 3, bn3);
            const LAS unsigned char* vp = lds + bcur * 32768 + 16384;
            bf16x8 vfa[4], vfb[4];
            if (t + 1 < nt) {
                __builtin_amdgcn_sched_barrier(0);
                ATT_QK(bn1);
                float mx; ATT_MAX(mx);
                __builtin_amdgcn_sched_barrier(0);
                if (__any(mx > 8.0f)) {
                    const float dl = fmaxf(mx, 0.f); mref += dl; const float alpha = __builtin_amdgcn_exp2f(-dl); lrow *= alpha;
#pragma unroll
                    for (int r = 0; r < 16; ++r) { s0[r] -= dl; s1[r] -= dl; negm[r] = -mref; }
#pragma unroll
                    for (int d = 0; d < 4; ++d)
#pragma unroll
                        for (int r = 0; r < 16; ++r) o[d][r] *= alpha;
#pragma unroll
                    for (int s = 0; s < 4; ++s) { v4u pw = __builtin_bit_cast(v4u, pf[s]);
                        pw.x = cvt_pk_bf16(bflo(pw.x) * alpha, bfhi(pw.x) * alpha); pw.y = cvt_pk_bf16(bflo(pw.y) * alpha, bfhi(pw.y) * alpha);
                        pw.z = cvt_pk_bf16(bflo(pw.z) * alpha, bfhi(pw.z) * alpha); pw.w = cvt_pk_bf16(bflo(pw.w) * alpha, bfhi(pw.w) * alpha); pf[s] = __builtin_bit_cast(bf16x8, pw); }
                }
                __builtin_amdgcn_sched_barrier(0);
                {
                    ATT_VLD(vfa, vp, 0);
                    __builtin_amdgcn_sched_barrier(0);
                    ATT_VLD(vfb, vp, 1); ATT_PV4(vfa, pf[0]); ATT_EXP8(s0, 0, pf[0]);
                    __builtin_amdgcn_sched_barrier(0);
                    ATT_VLD(vfa, vp, 2); ATT_PV4(vfb, pf[1]); ATT_EXP8(s0, 8, pf[1]);
                    __builtin_amdgcn_sched_barrier(0);
                    ATT_VLD(vfb, vp, 3); ATT_PV4(vfa, pf[2]); ATT_EXP8(s1, 0, pf[2]);
                    __builtin_amdgcn_sched_barrier(0);
                    ATT_PV4(vfb, pf[3]); ATT_EXP8(s1, 8, pf[3]);
                }
                __builtin_amdgcn_sched_barrier(0);
            } else {
#pragma unroll
                for (int s = 0; s < 4; ++s) { ATT_VLD(vfa, vp, s); ATT_PV4(vfa, pf[s]); }
            }
            if (t + 3 < nt) asm volatile("s_waitcnt vmcnt(4) lgkmcnt(0)" ::: "memory"); else asm volatile("s_waitcnt vmcnt(0) lgkmcnt(0)" ::: "memory");
            __builtin_amdgcn_s_barrier();
            bcur = bn1;
        }
#undef ATT_DMA
#undef ATT_QK
#undef ATT_MAX
#undef ATT_FIX
#undef ATT_EXP8
#undef ATT_VLD
#undef ATT_PV4
        const float ltot = lrow + __shfl_xor(lrow, 32); const float linv = 1.0f / ltot;
        LAS float* xch = (LAS float*)lds + (size_t)(qw * 32 + r32) * 132;
        if (sub == 1) {
#pragma unroll
            for (int d = 0; d < 4; ++d)
#pragma unroll
                for (int g = 0; g < 4; ++g) *(LAS f32x4*)(xch + 32 * d + 8 * g + 4 * hi) = (f32x4){o[d][4 * g] * linv, o[d][4 * g + 1] * linv, o[d][4 * g + 2] * linv, o[d][4 * g + 3] * linv};
        }
        __syncthreads();
        if (sub == 0) {
            float ss = 0.f;
#pragma unroll
            for (int d = 0; d < 4; ++d)
#pragma unroll
                for (int g = 0; g < 4; ++g) { const f32x4 o2 = *(const LAS f32x4*)(xch + 32 * d + 8 * g + 4 * hi);
#pragma unroll
                    for (int j = 0; j < 4; ++j) { const float v = o[d][4 * g + j] * linv - lam * o2[j]; o[d][4 * g + j] = v; ss += v * v; } }
            ss += __shfl_xor(ss, 32);
            const float rn = 0.8f / sqrtf(ss * (1.0f / 128.0f) + EPS);
            bf16* op = cat + (size_t)(q0row + qw * 32 + r32) * 2048 + head * 128;
#pragma unroll
            for (int d = 0; d < 4; ++d)
#pragma unroll
                for (int g = 0; g < 4; ++g) { const int dv = 32 * d + 8 * g + 4 * hi; const f32x4 gg = *(const f32x4*)(subg + dv);
                    st_bf4(op + dv, (f32x4){o[d][4 * g] * rn * gg.x, o[d][4 * g + 1] * rn * gg.y, o[d][4 * g + 2] * rn * gg.z, o[d][4 * g + 3] * rn * gg.w}); }
        }
        __syncthreads();
    }
}

__device__ __forceinline__ void poold_phase(Frame& F) {
    const bf16* P = WSP(bf16, WS_P); bf16* PD = WSP(bf16, WS_PD);
    const int gt = F.bid * NTHREADS + F.tid, NGT = F.G * NTHREADS;
    for (int idx = gt; idx < TT * 128; idx += NGT) {
        const int r = idx >> 7, cc = (idx & 127) * 8, g = cc >> 8, wdw = 2 << g;
        int sb, t, Ls; if (r < TL) { sb = (r / SEQ) * SEQ; t = r % SEQ; Ls = SEQ; } else { sb = TL + ((r - TL) / CTX) * CTX; t = (r - TL) % CTX; Ls = CTX; }
        int lo = t - wdw / 2, hi = lo + wdw; lo = lo < 0 ? 0 : lo; hi = hi > Ls ? Ls : hi;
        float a[8];
#pragma unroll
        for (int j = 0; j < 8; ++j) a[j] = 0.f;
        for (int s = lo; s < hi; ++s) { const v4u v = *(const v4u*)(P + (size_t)(sb + s) * 1024 + cc);
            a[0] += bflo(v.x); a[1] += bfhi(v.x); a[2] += bflo(v.y); a[3] += bfhi(v.y); a[4] += bflo(v.z); a[5] += bfhi(v.z); a[6] += bflo(v.w); a[7] += bfhi(v.w); }
        const float inv = 1.0f / (float)(hi - lo);
        const v4u me = *(const v4u*)(P + (size_t)r * 1024 + cc);
        v4u o; o.x = pk2(a[0] * inv - bflo(me.x), a[1] * inv - bfhi(me.x)); o.y = pk2(a[2] * inv - bflo(me.y), a[3] * inv - bfhi(me.y));
        o.z = pk2(a[4] * inv - bflo(me.z), a[5] * inv - bfhi(me.z)); o.w = pk2(a[6] * inv - bflo(me.w), a[7] * inv - bfhi(me.w));
        *(v4u*)(PD + (size_t)r * 1024 + cc) = o;
    }
}

__device__ __forceinline__ void shortconv_phase(Frame& F) {
    const bf16* PJ = WSP(bf16, WS_PROJ1); float* GT = WSP(float, WS_GT);
    const float* cw = INP(17); const float* cb = INP(18);
    LAS float* scr = (LAS float*)(F.lds + F.wave * 17408);
    const int lane = F.lane;
    for (int it = F.gw; it < 2 * 128 * 48; it += F.NGW) {
        const int cbk = it % 48, tb = (it / 48) % 128, b = it / (48 * 128), col = cbk * 64 + lane, t0 = tb * 64;
        const bf16* base = PJ + ((size_t)b * SEQ) * 4096 + cbk * 64 + (lane & 7) * 8;
#pragma unroll
        for (int i = 0; i < 9; ++i) { const int row = 8 * i + (lane >> 3); const int t = t0 - 1 + row;
            if (row < 66) { v4u v = {0u, 0u, 0u, 0u}; if (t >= 0 && t < SEQ) v = *(const v4u*)(base + (size_t)t * 4096);
                LAS float* d = scr + row * 65 + (lane & 7) * 8; d[0] = bflo(v.x); d[1] = bfhi(v.x); d[2] = bflo(v.y); d[3] = bfhi(v.y); d[4] = bflo(v.z); d[5] = bfhi(v.z); d[6] = bflo(v.w); d[7] = bfhi(v.w); } }
        LDS_WAIT(); asm volatile("" ::: "memory");
        const float w0 = cw[col], w1 = cw[3072 + col], w2 = cw[2 * 3072 + col], bias = cb[col];
        float prev = scr[lane], cur = scr[65 + lane];
#pragma unroll 8
        for (int tt = 0; tt < 64; ++tt) { const float nxt = scr[(tt + 2) * 65 + lane]; const float o = prev * w0 + cur * w1 + nxt * w2 + bias; scr[tt * 65 + lane] = o; prev = cur; cur = nxt; }
        LDS_WAIT(); asm volatile("" ::: "memory");
        for (int c = 0; c < 64; ++c) GT[((size_t)(cbk * 64 + c) * 2 + b) * SEQ + t0 + lane] = scr[lane * 65 + c];
        LDS_WAIT(); asm volatile("" ::: "memory");
    }
}

__device__ __forceinline__ void s5_gelu_phase(Frame& F) {
    const bf16* PJ = WSP(bf16, WS_PROJ1); const float* YD = WSP(float, WS_YD); bf16* Gb = WSP(bf16, WS_PD); const float* dd = INP(33);
    const int gt = F.bid * NTHREADS + F.tid, NGT = F.G * NTHREADS;
    for (int idx = gt; idx < TL * 256; idx += NGT) { const int r = idx >> 8, c = (idx & 255) * 4;
        const v2u uw = *(const v2u*)(PJ + (size_t)r * 4096 + 3072 + c); const f32x4 d4 = *(const f32x4*)(dd + c);
        const int bb = r / SEQ, tt = r % SEQ, gg = c >> 4, cc = c & 15;
        const f32x4 y0 = *(const f32x4*)(YD + (((size_t)(0 * 2 + bb) * 64 + gg) * SEQ + tt) * 16 + cc), y1 = *(const f32x4*)(YD + (((size_t)(1 * 2 + bb) * 64 + gg) * SEQ + tt) * 16 + cc);
        const f32x4 y = {bflo(uw.x) * d4.x + y0.x + y1.x, bfhi(uw.x) * d4.y + y0.y + y1.y, bflo(uw.y) * d4.z + y0.z + y1.z, bfhi(uw.y) * d4.w + y0.w + y1.w};
        st_bf4(Gb + (size_t)r * 1024 + c, (f32x4){gelu_tanh(y.x), gelu_tanh(y.y), gelu_tanh(y.z), gelu_tanh(y.w)}); }
}

__device__ __forceinline__ f32x2 cmulf(f32x2 a, f32x2 b) { return (f32x2){a.x * b.x - a.y * b.y, a.x * b.y + a.y * b.x}; }
__device__ __forceinline__ int drev14(int p) { const unsigned r = __builtin_bitreverse32((unsigned)p) >> 18; return (int)(((r & 0x2AAAu) >> 1) | ((r & 0x1555u) << 1)); }
template <int L, bool ZHI>
__device__ __forceinline__ void fft_fwd_pass(LAS f32x2* X, const f32x2* tw, int tid) {
    constexpr int tws = 4096 / L;
    if constexpr (L == 1) {
#pragma unroll 2
        for (int i = 0; i < 8; ++i) { const int i0 = (tid + NTHREADS * i) * 4;
            const f32x4 p01 = *(const LAS f32x4*)(X + i0), p23 = *(const LAS f32x4*)(X + i0 + 2);
            const f32x2 x0 = {p01.x, p01.y}, x1 = {p01.z, p01.w}, x2 = {p23.x, p23.y}, x3 = {p23.z, p23.w};
            const f32x2 a = x0 + x2, bb = x0 - x2, c = x1 + x3, d = x1 - x3;
            const f32x2 y0 = a + c, y1 = {bb.x + d.y, bb.y - d.x}, y2 = a - c, y3 = {bb.x - d.y, bb.y + d.x};
            *(LAS f32x4*)(X + i0) = (f32x4){y0.x, y0.y, y1.x, y1.y}; *(LAS f32x4*)(X + i0 + 2) = (f32x4){y2.x, y2.y, y3.x, y3.y}; }
        LDS_BARRIER();
        return;
    }
#pragma unroll 2
    for (int i = 0; i < 8; ++i) {
        const int b = tid + NTHREADS * i, j = b & (L - 1), i0 = (b - j) * 4 + j;
        const f32x2 w1 = tw[j * tws], w2 = cmulf(w1, w1), w3 = cmulf(w2, w1);
        const f32x2 x0 = X[i0], x1 = X[i0 + L];
        if (ZHI) {
            const f32x2 t1 = {x0.x + x1.y, x0.y - x1.x}, t3 = {x0.x - x1.y, x0.y + x1.x};
            X[i0] = x0 + x1; X[i0 + L] = cmulf(t1, w1); X[i0 + 2 * L] = cmulf(x0 - x1, w2); X[i0 + 3 * L] = cmulf(t3, w3);
        } else {
            const f32x2 x2 = X[i0 + 2 * L], x3 = X[i0 + 3 * L];
            const f32x2 a = x0 + x2, bb = x0 - x2, c = x1 + x3, d = x1 - x3;
            const f32x2 t1 = {bb.x + d.y, bb.y - d.x}, t3 = {bb.x - d.y, bb.y + d.x};
            X[i0] = a + c; X[i0 + L] = cmulf(t1, w1); X[i0 + 2 * L] = cmulf(a - c, w2); X[i0 + 3 * L] = cmulf(t3, w3);
        }
    }
    LDS_BARRIER();
}
template <int L>
__device__ __forceinline__ void fft_fwd_pass16(LAS f32x2* X, const f32x2* tw, int tid) {
    constexpr int Q = L / 4, tws = 4096 / L;
    const int jq = tid & (Q - 1);
    f32x2 wa[4][3];
#pragma unroll
    for (int mq = 0; mq < 4; ++mq) { const f32x2 w1 = tw[(mq * Q + jq) * tws]; wa[mq][0] = w1; wa[mq][1] = cmulf(w1, w1); wa[mq][2] = cmulf(wa[mq][1], w1); }
    const f32x2 v1 = tw[jq * 4 * tws], v2 = cmulf(v1, v1), v3 = cmulf(v2, v1);
#pragma unroll
    for (int i = 0; i < 2; ++i) {
        const int u = tid + NTHREADS * i, base = (u / Q) * 4 * L + jq;
        f32x2 pt[4][4];
#pragma unroll
        for (int m = 0; m < 4; ++m)
#pragma unroll
            for (int mq = 0; mq < 4; ++mq) pt[m][mq] = X[base + m * L + mq * Q];
#pragma unroll
        for (int mq = 0; mq < 4; ++mq) {
            const f32x2 x0 = pt[0][mq], x1 = pt[1][mq], x2 = pt[2][mq], x3 = pt[3][mq];
            const f32x2 a = x0 + x2, bb = x0 - x2, c = x1 + x3, d = x1 - x3;
            const f32x2 t1 = {bb.x + d.y, bb.y - d.x}, t3 = {bb.x - d.y, bb.y + d.x};
            pt[0][mq] = a + c; pt[1][mq] = cmulf(t1, wa[mq][0]); pt[2][mq] = cmulf(a - c, wa[mq][1]); pt[3][mq] = cmulf(t3, wa[mq][2]);
        }
#pragma unroll
        for (int m = 0; m < 4; ++m) {
            const f32x2 x0 = pt[m][0], x1 = pt[m][1], x2 = pt[m][2], x3 = pt[m][3];
            const f32x2 a = x0 + x2, bb = x0 - x2, c = x1 + x3, d = x1 - x3;
            const f32x2 t1 = {bb.x + d.y, bb.y - d.x}, t3 = {bb.x - d.y, bb.y + d.x};
            X[base + m * L] = a + c; X[base + m * L + Q] = cmulf(t1, v1); X[base + m * L + 2 * Q] = cmulf(a - c, v2); X[base + m * L + 3 * Q] = cmulf(t3, v3);
        }
    }
    LDS_BARRIER();
}
template <bool ZHI>
__device__ __forceinline__ void fft_fwd(LAS f32x2* X, const f32x2* tw, int tid) {
    fft_fwd_pass<4096, ZHI>(X, tw, tid); fft_fwd_pass16<1024>(X, tw, tid); fft_fwd_pass16<64>(X, tw, tid);
    fft_fwd_pass<4, false>(X, tw, tid); fft_fwd_pass<1, false>(X, tw, tid);
}
template <int L, bool LOHALF>
__device__ __forceinline__ void fft_inv_pass(LAS f32x2* X, const f32x2* tw, int tid) {
    constexpr int tws = 4096 / L;
    if constexpr (L == 1) {
#pragma unroll 2
        for (int i = 0; i < 8; ++i) { const int i0 = (tid + NTHREADS * i) * 4;
            const f32x4 p01 = *(const LAS f32x4*)(X + i0), p23 = *(const LAS f32x4*)(X + i0 + 2);
            const f32x2 x0 = {p01.x, p01.y}, x1 = {p01.z, p01.w}, x2 = {p23.x, p23.y}, x3 = {p23.z, p23.w};
            const f32x2 a = x0 + x2, bb = x0 - x2, c = x1 + x3, d = x1 - x3;
            const f32x2 y0 = a + c, y1 = {bb.x - d.y, bb.y + d.x}, y2 = a - c, y3 = {bb.x + d.y, bb.y - d.x};
            *(LAS f32x4*)(X + i0) = (f32x4){y0.x, y0.y, y1.x, y1.y}; *(LAS f32x4*)(X + i0 + 2) = (f32x4){y2.x, y2.y, y3.x, y3.y}; }
        LDS_BARRIER();
        return;
    }
#pragma unroll 2
    for (int i = 0; i < 8; ++i) {
        const int b = tid + NTHREADS * i, j = b & (L - 1), i0 = (b - j) * 4 + j;
        f32x2 w1 = tw[j * tws]; w1.y = -w1.y; const f32x2 w2 = cmulf(w1, w1), w3 = cmulf(w2, w1);
        const f32x2 x0 = X[i0], x1 = cmulf(X[i0 + L], w1), x2 = cmulf(X[i0 + 2 * L], w2), x3 = cmulf(X[i0 + 3 * L], w3);
        const f32x2 a = x0 + x2, bb = x0 - x2, c = x1 + x3, d = x1 - x3;
        X[i0] = a + c; X[i0 + L] = (f32x2){bb.x - d.y, bb.y + d.x};
        if (!LOHALF) { X[i0 + 2 * L] = a - c; X[i0 + 3 * L] = (f32x2){bb.x + d.y, bb.y - d.x}; }
    }
    LDS_BARRIER();
}
template <int L>
__device__ __forceinline__ void fft_inv_pass16(LAS f32x2* X, const f32x2* tw, int tid) {
    constexpr int tws = 4096 / L, tws4 = 1024 / L;
    const int jq = tid & (L - 1);
    f32x2 v1 = tw[jq * tws]; v1.y = -v1.y; const f32x2 v2 = cmulf(v1, v1), v3 = cmulf(v2, v1);
    f32x2 wb[4][3];
#pragma unroll
    for (int mq = 0; mq < 4; ++mq) { f32x2 w1 = tw[(mq * L + jq) * tws4]; w1.y = -w1.y; wb[mq][0] = w1; wb[mq][1] = cmulf(w1, w1); wb[mq][2] = cmulf(wb[mq][1], w1); }
#pragma unroll
    for (int i = 0; i < 2; ++i) {
        const int u = tid + NTHREADS * i, base = (u / L) * 16 * L + jq;
        f32x2 pt[4][4];
#pragma unroll
        for (int M = 0; M < 4; ++M)
#pragma unroll
            for (int mq = 0; mq < 4; ++mq) pt[M][mq] = X[base + M * 4 * L + mq * L];
#pragma unroll
        for (int M = 0; M < 4; ++M) {
            const f32x2 x0 = pt[M][0], x1 = cmulf(pt[M][1], v1), x2 = cmulf(pt[M][2], v2), x3 = cmulf(pt[M][3], v3);
            const f32x2 a = x0 + x2, bb = x0 - x2, c = x1 + x3, d = x1 - x3;
            pt[M][0] = a + c; pt[M][1] = (f32x2){bb.x - d.y, bb.y + d.x}; pt[M][2] = a - c; pt[M][3] = (f32x2){bb.x + d.y, bb.y - d.x};
        }
#pragma unroll
        for (int mq = 0; mq < 4; ++mq) {
            const f32x2 x0 = pt[0][mq], x1 = cmulf(pt[1][mq], wb[mq][0]), x2 = cmulf(pt[2][mq], wb[mq][1]), x3 = cmulf(pt[3][mq], wb[mq][2]);
            const f32x2 a = x0 + x2, bb = x0 - x2, c = x1 + x3, d = x1 - x3;
            X[base + mq * L] = a + c; X[base + 4 * L + mq * L] = (f32x2){bb.x - d.y, bb.y + d.x}; X[base + 8 * L + mq * L] = a - c; X[base + 12 * L + mq * L] = (f32x2){bb.x + d.y, bb.y - d.x};
        }
    }
    LDS_BARRIER();
}
__device__ __forceinline__ void fft_inv(LAS f32x2* X, const f32x2* tw, int tid) {
    fft_inv_pass<1, false>(X, tw, tid); fft_inv_pass<4, false>(X, tw, tid); fft_inv_pass16<16>(X, tw, tid); fft_inv_pass16<256>(X, tw, tid);
    fft_inv_pass<4096, true>(X, tw, tid);
}
__device__ __forceinline__ void fft_untangle(const LAS f32x2* X, f32x2* K0g, f32x2* K1g, float sc0, float sc1, int tid) {
    const float h0 = 0.5f * sc0, h1 = 0.5f * sc1;
#pragma unroll 4
    for (int i = 0; i < 32; ++i) {
        const int p = tid + NTHREADS * i, f = drev14(p), pm = drev14((16384 - f) & 16383);
        const f32x2 A = X[p], B = X[pm];
        const f32x2 dd = {A.x - B.x, A.y + B.y};
        K0g[p] = (f32x2){(A.x + B.x) * h0, (A.y - B.y) * h0};
        K1g[p] = (f32x2){dd.y * h1, -dd.x * h1};
    }
    LDS_BARRIER();
}
__device__ __forceinline__ void fft_pointwise(LAS f32x2* X, const f32x2* Kg, int tid) {
#pragma unroll 8
    for (int i = 0; i < 32; ++i) { const int p = tid + NTHREADS * i; X[p] = cmulf(X[p], Kg[p]); }
    LDS_BARRIER();
}
__device__ __forceinline__ void hyena_fft_phase(Frame& F) {
    float* GT = WSP(float, WS_GT); const float* kT = WSP(float, WS_KT); const float* invn = WSP(float, WS_INVN); const f32x2* tw = WSP(f32x2, WS_TW);
    f32x2* K0g = WSP(f32x2, WS_FFTW) + (size_t)F.bid * 16384; f32x2* K1g = WSP(f32x2, WS_Y) + (size_t)F.bid * 16384;
    const float* hyb = INP(25);
    LAS f32x2* X = (LAS f32x2*)F.lds;
    const int tid = F.tid;
    for (int ch = F.bid; ch < 1024; ch += F.G) {
        { const float* f0 = kT + (size_t)ch * SEQ; const float* b0 = kT + (size_t)(1024 + ch) * SEQ; const float* f1 = kT + (size_t)(2048 + ch) * SEQ; const float* b1 = kT + (size_t)(3072 + ch) * SEQ;
          for (int n = tid; n < SEQ; n += NTHREADS) { X[n] = (f32x2){f0[n], f1[n]}; X[SEQ + n] = (n == 0) ? (f32x2){0.f, 0.f} : (f32x2){b0[SEQ - n], b1[SEQ - n]}; } }
        const float* v0 = GT + ((size_t)ch * 2) * SEQ; float* yo = WSP(float, WS_YHT) + ((size_t)ch * 2) * SEQ;
        const float* x1 = GT + ((size_t)(1024 + ch) * 2) * SEQ; const float* x2 = GT + ((size_t)(2048 + ch) * 2) * SEQ;
        float z0[16], z1[16];
#pragma unroll
        for (int j = 0; j < 16; ++j) { const int n = tid + NTHREADS * j; z0[j] = v0[n]; z1[j] = v0[SEQ + n]; }
        LDS_BARRIER();
        fft_fwd<false>(X, tw, tid);
        fft_untangle(X, K0g, K1g, invn[ch] * (1.0f / 16384.0f), invn[1024 + ch] * (1.0f / 16384.0f), tid);
#pragma unroll
        for (int o = 0; o < 2; ++o) {
            const float* xg = (o == 0) ? x1 : x2;
            float g0[16], g1[16];
#pragma unroll
            for (int j = 0; j < 16; ++j) { const int n = tid + NTHREADS * j; g0[j] = xg[n]; g1[j] = xg[SEQ + n]; }
#pragma unroll
            for (int j = 0; j < 16; ++j) { const int n = tid + NTHREADS * j; X[n] = (f32x2){z0[j], z1[j]}; }
            LDS_BARRIER();
            fft_fwd<true>(X, tw, tid);
            fft_pointwise(X, o == 0 ? K0g : K1g, tid);
            fft_inv(X, tw, tid);
            const float bias = hyb[o * 1024 + ch];
#pragma unroll
            for (int j = 0; j < 16; ++j) { const int n = tid + NTHREADS * j; const f32x2 y = X[n]; z0[j] = g0[j] * (y.x + bias * z0[j]); z1[j] = g1[j] * (y.y + bias * z1[j]); }
            LDS_BARRIER();
        }
#pragma unroll
        for (int j = 0; j < 16; ++j) { const int n = tid + NTHREADS * j; yo[n] = z0[j]; yo[SEQ + n] = z1[j]; }
    }
}
__device__ __forceinline__ void hyena_out_transpose(Frame& F) {
    const float* GT = WSP(float, WS_YHT); bf16* cat = WSP(bf16, WS_CAT);
    LAS float* scr = (LAS float*)(F.lds + F.wave * 17408);
    const int lane = F.lane;
    for (int it = F.gw; it < 2 * 128 * 16; it += F.NGW) {
        const int cbk = it & 15, tb = (it >> 4) & 127, b = it >> 11, t0 = tb * 64;
        for (int c = 0; c < 64; ++c) scr[c * 65 + lane] = GT[((size_t)(cbk * 64 + c) * 2 + b) * SEQ + t0 + lane];
        LDS_WAIT(); asm volatile("" ::: "memory");
#pragma unroll
        for (int i = 0; i < 8; ++i) { const int tt = 8 * i + (lane >> 3), c0 = (lane & 7) * 8; const LAS float* s = scr + c0 * 65 + tt;
            v4u o; o.x = cvt_pk_bf16(s[0], s[65]); o.y = cvt_pk_bf16(s[130], s[195]); o.z = cvt_pk_bf16(s[260], s[325]); o.w = cvt_pk_bf16(s[390], s[455]);
            *(v4u*)(cat + ((size_t)b * SEQ + t0 + tt) * 2048 + cbk * 64 + c0) = o; }
        LDS_WAIT(); asm volatile("" ::: "memory");
    }
}

__device__ __forceinline__ int s5_row(int di, int b, int s) {
    return (s < CTX) ? TL + b * CTX + (di == 0 ? s : CTX - 1 - s) : b * SEQ + (di == 0 ? s - CTX : SEQ - 1 - (s - CTX));
}
typedef float f32x4_t __attribute__((ext_vector_type(4)));
#define S5_KEEP8(acc, f) asm volatile("" : "+v"(acc) : "v"(f[0]), "v"(f[1]), "v"(f[2]), "v"(f[3]), "v"(f[4]), "v"(f[5]), "v"(f[6]), "v"(f[7]))
#define S5_KEEP4(acc, f) asm volatile("" : "+v"(acc) : "v"(f[0]), "v"(f[1]), "v"(f[2]), "v"(f[3]))
template <bool OUTPUT>
__device__ __forceinline__ void s5_chunk_phase(Frame& F) {
    const bf16* PJ = WSP(bf16, WS_PROJ1); float* YD = WSP(float, WS_YD);
    const f32x2* l16t = WSP(f32x2, WS_S5L16); const f32x2* l256 = WSP(f32x2, WS_S5L256); f32x2* Eb = WSP(f32x2, WS_S5E);
    const bf16* W1 = WSP(bf16, WS_S5W1); const bf16* W3 = WSP(bf16, WS_S5W3); const bf16* KT = WSP(bf16, WS_S5KT);
    const int lane = F.lane, fr = lane & 15, fq = lane >> 4;
    LAS unsigned* Xl = (LAS unsigned*)(F.lds + F.wave * 4608);
    f32x2 carry[4];
#pragma unroll
    for (int t = 0; t < 4; ++t) carry[t] = (f32x2){0.f, 0.f};
#pragma nounroll
    for (int j = 0;; ++j) {
        const int tq = F.wave * F.G + F.bid + (j >> 2) * F.NGW, sub4 = j & 3;
        if (tq >= 256 * 8) break;
        const int task = tq * 4 + sub4;
        const int dbg = task >> 5, seg = (task & 31) + (OUTPUT ? 1 : 0);
        const int di = dbg >> 7, b = (dbg >> 6) & 1, g = dbg & 63;
        const int dg = di * 64 + g;
        const int s0 = seg * 256;
        bf16x8 afr[8];
#pragma unroll
        for (int ks = 0; ks < 8; ++ks) afr[ks] = *(const bf16x8*)(PJ + (size_t)s5_row(di, b, s0 + 16 * fr + 2 * ks + (fq >> 1)) * 4096 + 3072 + g * 16 + 8 * (fq & 1));
        f32x4 ea[8];
        { const bf16* w1p = W1 + ((size_t)dg * 128 + fr) * 256 + 8 * fq;
#pragma unroll
          for (int nt = 0; nt < 8; ++nt) { f32x4 a = {0.f, 0.f, 0.f, 0.f}; bf16x8 bw[8];
#pragma unroll
              for (int ks = 0; ks < 8; ++ks) bw[ks] = *(const bf16x8*)(w1p + (size_t)nt * 16 * 256 + 32 * ks);
#pragma unroll
              for (int ks = 0; ks < 8; ++ks) a = __builtin_amdgcn_mfma_f32_16x16x32_bf16(afr[ks], bw[ks], a, 0, 0, 0);
              S5_KEEP8(a, bw); S5_KEEP8(a, afr);
              ea[nt] = a; } }
        f32x2 st[4];
#pragma unroll
        for (int t = 0; t < 4; ++t) st[t] = (f32x2){0.f, 0.f};
        if (OUTPUT) {
#pragma unroll
            for (int t = 0; t < 4; ++t) { const f32x2 lq = l256[dg * 64 + 16 * t + fr]; const f32x2* ep = Eb + ((size_t)dbg * 32) * 64 + 16 * t + fr;
                if (sub4 == 0) {
                    int k = 0;
                    for (; k + 8 <= seg; k += 8) { f32x2 e8[8];
#pragma unroll
                        for (int j = 0; j < 8; ++j) e8[j] = ep[(size_t)(k + j) * 64];
#pragma unroll
                        for (int j = 0; j < 8; ++j) st[t] = cmulf(lq, st[t]) + e8[j]; }
                    for (; k < seg; ++k) st[t] = cmulf(lq, st[t]) + ep[(size_t)k * 64];
                } else st[t] = cmulf(lq, carry[t]) + ep[(size_t)(seg - 1) * 64];
                carry[t] = st[t]; }
        }
#pragma unroll
        for (int t = 0; t < 4; ++t) {
            const f32x2 L1 = l16t[dg * 64 + 16 * t + fr], L2 = cmulf(L1, L1), L3 = cmulf(L2, L1), L4 = cmulf(L2, L2);
            const f32x2 x0 = {ea[t][0], ea[4 + t][0]}, x1 = cmulf(L1, x0) + (f32x2){ea[t][1], ea[4 + t][1]}, x2 = cmulf(L1, x1) + (f32x2){ea[t][2], ea[4 + t][2]}, x3 = cmulf(L1, x2) + (f32x2){ea[t][3], ea[4 + t][3]};
            f32x2 sin = st[t];
            f32x2 fin = x3 + cmulf(L4, (fq == 0) ? sin : (f32x2){0.f, 0.f});
#pragma unroll
            for (int rd = 1; rd < 4; ++rd) { const float vr = __shfl(fin.x, lane - 16), vi = __shfl(fin.y, lane - 16);
                if (fq == rd) { sin = (f32x2){vr, vi}; fin = x3 + cmulf(L4, sin); } }
            if (OUTPUT) {
                const f32x2 h1 = x0 + cmulf(L1, sin), h2 = x1 + cmulf(L2, sin), h3 = x2 + cmulf(L3, sin);
                Xl[(4 * fq + 0) * 68 + 16 * t + fr] = cvt_pk_bf16(sin.x, sin.y); Xl[(4 * fq + 1) * 68 + 16 * t + fr] = cvt_pk_bf16(h1.x, h1.y);
                Xl[(4 * fq + 2) * 68 + 16 * t + fr] = cvt_pk_bf16(h2.x, h2.y); Xl[(4 * fq + 3) * 68 + 16 * t + fr] = cvt_pk_bf16(h3.x, h3.y);
            } else {
                st[t] = (f32x2){__shfl(fin.x, 48 + fr), __shfl(fin.y, 48 + fr)};
            }
        }
        if (!OUTPUT) {
            if (fq == 0) {
#pragma unroll
                for (int t = 0; t < 4; ++t) Eb[((size_t)dbg * 32 + seg) * 64 + 16 * t + fr] = st[t];
            }
        } else {
            LDS_WAIT(); asm volatile("" ::: "memory");
            bf16x8 hfr[4];
#pragma unroll
            for (int ks = 0; ks < 4; ++ks) hfr[ks] = *(const LAS bf16x8*)(Xl + fr * 68 + 16 * ks + 4 * fq);
            LDS_WAIT(); asm volatile("" ::: "memory");
            const bf16* w3p = W3 + ((size_t)dg * 256 + fr) * 128 + 8 * fq;
            const bf16* ktp = KT + (size_t)dg * 17 * 256 + fr * 16 + 8 * (fq & 1);
#pragma unroll
            for (int tau = 0; tau < 16; ++tau) {
                f32x4 y = {0.f, 0.f, 0.f, 0.f}; bf16x8 b3[4], bk[8];
#pragma unroll
                for (int ks = 0; ks < 4; ++ks) b3[ks] = *(const bf16x8*)(w3p + (size_t)tau * 16 * 128 + 32 * ks);
#pragma unroll
                for (int ks = 0; ks < 8; ++ks) { const int d1 = (ks <= tau / 2) ? tau - 2 * ks - (fq >> 1) + 1 : 0;
                    bk[ks] = *(const bf16x8*)(ktp + (size_t)d1 * 256); }
#pragma unroll
                for (int ks = 0; ks < 4; ++ks) y = __builtin_amdgcn_mfma_f32_16x16x32_bf16(hfr[ks], b3[ks], y, 0, 0, 0);
#pragma unroll
                for (int ks = 0; ks <= tau / 2; ++ks) y = __builtin_amdgcn_mfma_f32_16x16x32_bf16(afr[ks], bk[ks], y, 0, 0, 0);
                S5_KEEP4(y, b3); S5_KEEP8(y, bk); S5_KEEP8(y, afr); S5_KEEP4(y, hfr);
#pragma unroll
                for (int r = 0; r < 4; ++r) { const int s = s0 + 16 * (4 * fq + r) + tau, tl = (di == 0) ? s - CTX : SEQ - 1 - (s - CTX);
                    YD[(((size_t)(di * 2 + b) * 64 + g) * SEQ + tl) * 16 + fr] = y[r]; }
            }
        }
    }
}


constexpr int NPHASES = 21;
#ifndef MK_SINGLE
#define MK_SINGLE 1
#endif

__device__ __forceinline__ unsigned long long launder_u64(unsigned long long v) {
    unsigned lo = (unsigned)v, hi = (unsigned)(v >> 32);
    asm volatile("" : "+v"(lo), "+v"(hi));
    lo = __builtin_amdgcn_readfirstlane(lo); hi = __builtin_amdgcn_readfirstlane(hi);
    return ((unsigned long long)hi << 32) | lo;
}
__device__ __forceinline__ const void* launder_ptr(const void* p) {
    unsigned long long v = (unsigned long long)p; unsigned lo = (unsigned)v, hi = (unsigned)(v >> 32);
    asm volatile("" : "+v"(lo), "+v"(hi));
    lo = __builtin_amdgcn_readfirstlane(lo); hi = __builtin_amdgcn_readfirstlane(hi);
    return (const void*)(((unsigned long long)hi << 32) | lo);
}
__device__ __forceinline__ void moe_blocks(Frame& F, int l, LAS int* bstart) {
    __syncthreads();
    if (F.tid == 0) { const unsigned* cnt = WSP(unsigned, WS_CTL) + CW_CNT + l * 64 * CSTR; int acc = 0;
        for (int e = 0; e < 64; ++e) { bstart[e] = acc; const int nb = ((int)cnt[e * CSTR] + 255) >> 8; for (int j = 0; j < nb; ++j) bstart[65 + acc + j] = e; acc += nb; } bstart[64] = acc; }
    __syncthreads();
}

template <int PHSEL>
__global__ void __launch_bounds__(NTHREADS, 2) mk_fwd(Args args) {
    extern __shared__ __attribute__((aligned(16))) unsigned char lds_raw[];
    Frame F;
    F.lds = (LAS unsigned char*)lds_raw; F.ws = (GAS unsigned char*)args.ws; F.kin = (const __attribute__((address_space(4))) unsigned long long*)__builtin_amdgcn_kernarg_segment_ptr();
    F.tid = threadIdx.x; F.lane = F.tid & 63; F.wave = __builtin_amdgcn_readfirstlane(F.tid >> 6); F.bid = blockIdx.x; F.G = gridDim.x;
    F.gw = F.bid * NWAVES + F.wave; F.NGW = F.G * NWAVES;
    volatile LAS unsigned* lctl = (volatile LAS unsigned*)(F.lds + LDS_CTL);
    LAS int* bstart = (LAS int*)(F.lds + LDS_CTL + 64);
    if (F.tid < 4) lctl[F.tid] = 0u;
    __syncthreads();
    const int lo = args.ph_lo, hi = args.ph_hi;
    XcdBarrier bar; bar.bar = WSP(unsigned, WS_CTL) + CW_BAR; bar.x = 0; bar.st = lctl;
    if (PHSEL < 0) bar = xcd_barrier_post(WSP(unsigned, WS_CTL) + CW_BAR, lctl);
#ifndef PH_MASK
#define PH_MASK 0xffffffffu
#endif
#define IN(k) (((PH_MASK >> (k)) & 1u) && (PHSEL < 0 || PHSEL == (k)))
#define INL(j) (((PH_MASK >> (6 + (j))) & 1u) && (PHSEL < 0 || (PHSEL == 6 + (j) && lo == pb + (j))))
#define PH_END(k) do { if (PHSEL < 0) xcd_barrier(bar); } while (0)
#ifndef PH_REPEAT
#define PH_REPEAT 0u
#endif
#define REP(k) for (int _rep = 0; _rep < (((PH_REPEAT >> (k)) & 1u) ? 2 : 1); ++_rep)
#define DUP(k) (((PH_REPEAT >> (k)) & 1u) != 0u)
#define PH_BEGIN() do { F.ws = (GAS unsigned char*)launder_u64((unsigned long long)F.ws); F.kin = (const __attribute__((address_space(4))) unsigned long long*)launder_u64((unsigned long long)F.kin); \
    { int _t = threadIdx.x; asm volatile("" : "+v"(_t)); F.tid = _t; F.lane = _t & 63; F.wave = __builtin_amdgcn_readfirstlane(_t >> 6); \
      int _b = blockIdx.x; asm volatile("" : "+v"(_b)); F.bid = __builtin_amdgcn_readfirstlane(_b); F.gw = F.bid * NWAVES + F.wave; } } while (0)
    LAS unsigned char* lds = F.lds;
    const int G = F.G, bid = F.bid;
    const int vcu = (G % 8 == 0) ? (bid % 8) * (G / 8) + bid / 8 : bid;
    constexpr long T2048 = 256L * 2048 * 2;

    if (IN(0)) { PH_BEGIN(); REP(0) { p0_prologue(F); __syncthreads(); } PH_END(0); }
    if (IN(1)) { PH_BEGIN(); p1_reduce(F); PH_END(1); }
#ifdef EXTRA_BARS
    xcd_barrier(bar); xcd_barrier(bar); xcd_barrier(bar); xcd_barrier(bar); xcd_barrier(bar); xcd_barrier(bar); xcd_barrier(bar); xcd_barrier(bar); xcd_barrier(bar); xcd_barrier(bar);
#endif
        if (IN(2)) { PH_BEGIN(); REP(2) norm_phase<0>(F, 0, nullptr); PH_END(2); }
        if (IN(3)) { PH_BEGIN();
#define BODY3 { pg8::Gemm g{(const bf16*)F.ws, (const bf16*)F.ws, 2048, 2048, 2048}; InProj0Order S; S.G = G; S.c = bid; \
              S.offA1 = (long)WS_HA; S.offB1 = (long)WS_WIN0; S.offA2 = (long)(WS_WIN0 + (size_t)3072 * 2048 * 2); S.offB2 = (long)WS_HA; \
              EpiInProj0 E{EpiQKP{WSP(bf16, WS_Q), WSP(bf16, WS_K), WSP(bf16, WS_P), WSP(f32x2, WS_ROPE)}, EpiVT{WSP(bf16, WS_VT)}}; pg8::gemm_phase<EpiInProj0, InProj0Order, false>(lds, g, S, E); }
            BODY3
            if constexpr (DUP(3)) { BODY3 }
#undef BODY3
            PH_END(3);
        }
        if (IN(4)) { PH_BEGIN();
            REP(4) attn_phase(F, (bid >> 3) % 5);
            __syncthreads(); REP(21) poold_phase(F); PH_END(4); }
        if (IN(5)) { PH_BEGIN();
            pg8::Gemm g{WSP(bf16, WS_PD), WSP(bf16, WS_WPOOL), 1024, 256, 256}; pg8::StaticOrder S; S.init(TT / 256, 4, G, bid, 256L * 1024 * 2, 256L * 2, 256L * 256 * 2);
            EpiScaleBf16 E{WSP(bf16, WS_CAT), 2048, 1024, INP(14)}; pg8::gemm_phase<EpiScaleBf16, pg8::StaticOrder, false>(lds, g, S, E);
            PH_END(5);
        }
    {
    constexpr int pb = 6; constexpr int l = 0;
    if (INL(0)) { PH_BEGIN();
        float* xbuf = WSP(float, WS_X);
        pg8::Gemm g{WSP(bf16, WS_CAT), WSP(bf16, l == 0 ? WS_WOUT0 : WS_WOUT1), 2048, 2048, 2048}; pg8::StaticOrder S; S.init(l == 0 ? TT / 256 : TL / 256, 8, G, bid, T2048, 0, T2048);
        EpiRes E{l == 0 ? INP(0) : xbuf, l == 0 ? INP(2) : xbuf + (size_t)TL * 2048, xbuf, modp(F, l, 0, 2)}; pg8::gemm_phase<EpiRes, pg8::StaticOrder, false>(lds, g, S, E);
        PH_END(pb);
    }
    if (INL(1)) { PH_BEGIN(); ffn_norm_router_phase(F, l); PH_END(pb + 1); }
    if (INL(2)) { PH_BEGIN(); REP(8) {
        moe_blocks(F, l, bstart);
        pg8::Gemm g{WSP(bf16, WS_HA), (const bf16*)(F.ws + WS_WMOE + (size_t)l * MOE_L_BYTES), 2048, 2048, 2048};
        MoeOrder S{bstart, WSP(unsigned, WS_CTL) + CW_CNT + l * 64 * CSTR, WSP(int, WS_TOKL), 4, G, vcu, bstart[64], T2048, 0, true};
        EpiMoeUp E{WSP(bf16, WS_H)}; pg8::gemm_phase<EpiMoeUp, MoeOrder, true>(lds, g, S, E); }
        PH_END(pb + 2);
    }
    if (INL(3)) { PH_BEGIN(); REP(9) {
        moe_blocks(F, l, bstart);
        pg8::Gemm g{WSP(bf16, WS_H), (const bf16*)(F.ws + WS_WMOE + (size_t)l * MOE_L_BYTES), 512, 512, 512};
        MoeOrder S{bstart, WSP(unsigned, WS_CTL) + CW_CNT + l * 64 * CSTR, WSP(int, WS_TOKL), 8, G, vcu, bstart[64], 256L * 512 * 2, (long)(4 * MiB), false};
        EpiMoeDown E{WSP(bf16, WS_Y), WSP(int, WS_TOKL), WSP(float, WS_GATEL), WSP(unsigned, WS_CTL) + CW_CNT + l * 64 * CSTR}; pg8::gemm_phase<EpiMoeDown, MoeOrder, false>(lds, g, S, E); }
        PH_END(pb + 3);
    }
    }
        if (IN(10)) { PH_BEGIN(); norm_phase<2>(F, 1, nullptr); PH_END(10); }
        if (IN(11)) { PH_BEGIN();
#define BODY11             pg8::Gemm g{WSP(bf16, WS_HA), WSP(bf16, WS_WIN1), 2048, 2048, 2048}; pg8::StaticOrder S; S.init(TT / 256, 16, G, bid, T2048, 0, T2048); \
            EpiBf16 E{WSP(bf16, WS_PROJ1), 4096}; pg8::gemm_phase<EpiBf16, pg8::StaticOrder, false>(lds, g, S, E);
            BODY11
            if constexpr (DUP(11)) { BODY11 }
#undef BODY11
            PH_END(11);
        }
        if (IN(12)) { PH_BEGIN(); REP(12) shortconv_phase(F); REP(22) s5_chunk_phase<false>(F);
 PH_END(12); }
        if (IN(13)) { PH_BEGIN();
            REP(23) s5_chunk_phase<true>(F); __syncthreads(); REP(13) hyena_fft_phase(F); PH_END(13); }
        if (IN(14)) { PH_BEGIN();
 REP(14) { s5_gelu_phase(F); hyena_out_transpose(F); } PH_END(14); }
        if (IN(15)) { PH_BEGIN();
            pg8::Gemm g{WSP(bf16, WS_PD), WSP(bf16, WS_WGLU), 1024, 1024, 1024}; pg8::StaticOrder S; S.init(TL / 256, 4, G, bid, 256L * 1024 * 2, 0, 256L * 1024 * 2);
            EpiGlu E{WSP(bf16, WS_CAT), 2048, 1024, WSP(bf16, WS_PD), INP(35)}; pg8::gemm_phase<EpiGlu, pg8::StaticOrder, false>(lds, g, S, E);
            PH_END(15);
        }
    {
    constexpr int pb = 16; constexpr int l = 1;
    if (INL(0)) { PH_BEGIN();
        float* xbuf = WSP(float, WS_X);
        pg8::Gemm g{WSP(bf16, WS_CAT), WSP(bf16, l == 0 ? WS_WOUT0 : WS_WOUT1), 2048, 2048, 2048}; pg8::StaticOrder S; S.init(l == 0 ? TT / 256 : TL / 256, 8, G, bid, T2048, 0, T2048);
        EpiRes E{l == 0 ? INP(0) : xbuf, l == 0 ? INP(2) : xbuf + (size_t)TL * 2048, xbuf, modp(F, l, 0, 2)}; pg8::gemm_phase<EpiRes, pg8::StaticOrder, false>(lds, g, S, E);
        PH_END(pb);
    }
    if (INL(1)) { PH_BEGIN(); ffn_norm_router_phase(F, l); PH_END(pb + 1); }
    if (INL(2)) { PH_BEGIN(); REP(8) {
        moe_blocks(F, l, bstart);
        pg8::Gemm g{WSP(bf16, WS_HA), (const bf16*)(F.ws + WS_WMOE + (size_t)l * MOE_L_BYTES), 2048, 2048, 2048};
        MoeOrder S{bstart, WSP(unsigned, WS_CTL) + CW_CNT + l * 64 * CSTR, WSP(int, WS_TOKL), 4, G, vcu, bstart[64], T2048, 0, true};
        EpiMoeUp E{WSP(bf16, WS_H)}; pg8::gemm_phase<EpiMoeUp, MoeOrder, true>(lds, g, S, E); }
        PH_END(pb + 2);
    }
    if (INL(3)) { PH_BEGIN(); REP(9) {
        moe_blocks(F, l, bstart);
        pg8::Gemm g{WSP(bf16, WS_H), (const bf16*)(F.ws + WS_WMOE + (size_t)l * MOE_L_BYTES), 512, 512, 512};
        MoeOrder S{bstart, WSP(unsigned, WS_CTL) + CW_CNT + l * 64 * CSTR, WSP(int, WS_TOKL), 8, G, vcu, bstart[64], 256L * 512 * 2, (long)(4 * MiB), false};
        EpiMoeDown E{WSP(bf16, WS_Y), WSP(int, WS_TOKL), WSP(float, WS_GATEL), WSP(unsigned, WS_CTL) + CW_CNT + l * 64 * CSTR}; pg8::gemm_phase<EpiMoeDown, MoeOrder, false>(lds, g, S, E); }
        PH_END(pb + 3);
    }
    }
    if (IN(20)) { PH_BEGIN(); norm_phase<3>(F, 1, args.out);
    }
#undef IN
#undef INL
#undef PH_END
}

typedef void (*kern_t)(Args);
template <int P> static void launch_phase(int grid, hipStream_t stream, Args a) { hipLaunchKernelGGL(mk_fwd<P>, dim3(grid), dim3(NTHREADS), LDS_BYTES, stream, a); }
template <int P> static bool prep_phase() { return hipFuncSetAttribute((const void*)mk_fwd<P>, hipFuncAttributeMaxDynamicSharedMemorySize, LDS_BYTES) == hipSuccess; }
extern "C" void kernel_launch(void* const* d_in, const int* in_sizes, int n_in, void* d_out, int out_size, void* d_ws, size_t ws_size, hipStream_t stream) {
    static int grid = 0;
    if (grid == 0) {
        if (n_in != 43 || out_size != TL * DM || ws_size < WS_END) { fprintf(stderr, "kernel_launch: unexpected shapes (n_in %d, out %d, ws %zu < %zu)\n", n_in, out_size, ws_size, (size_t)WS_END); grid = -1; return; }
        int dev = 0, cus = 0;
        if (hipGetDevice(&dev) != hipSuccess || hipDeviceGetAttribute(&cus, hipDeviceAttributeMultiprocessorCount, dev) != hipSuccess) { grid = -1; return; }
        bool ok = true;
#if MK_SINGLE
        ok = prep_phase<-1>();
#else
        ok = prep_phase<0>() && prep_phase<1>() && prep_phase<2>() && prep_phase<3>() && prep_phase<4>() && prep_phase<5>() && prep_phase<6>() && prep_phase<7>() && prep_phase<8>() && prep_phase<9>() &&
             prep_phase<10>() && prep_phase<11>() && prep_phase<12>() && prep_phase<13>() && prep_phase<14>() && prep_phase<15>() && prep_phase<20>();
#endif
        if (!ok) { fprintf(stderr, "kernel_launch: hipFuncSetAttribute failed\n"); grid = -1; return; }
        (void)hipGetLastError();
        grid = cus;
    }
    if (grid < 0) return;
    (void)hipMemsetAsync((char*)d_ws + WS_CTL, 0, CTL_BYTES, stream);
    Args a{};
    for (int i = 0; i < 43; ++i) a.in[i] = (const float*)d_in[i];
    a.out = (float*)d_out; a.ws = (unsigned char*)d_ws;
#if MK_SINGLE
    a.ph_lo = 0; a.ph_hi = NPHASES;
    launch_phase<-1>(grid, stream, a);
#else
#ifndef MK_DUP
#define MK_DUP -1
#endif
#define LP(k, P) a.ph_lo = (k); a.ph_hi = (k) + 1; launch_phase<P>(grid, stream, a); \
    if (MK_DUP == (k)) { if (P == 7) (void)hipMemsetAsync((char*)d_ws + WS_CTL + (size_t)(CW_CNT + ((k) > 10 ? 64 * CSTR : 0)) * 4, 0, 256 * CSTR, stream); launch_phase<P>(grid, stream, a); }
    LP(0, 0) LP(1, 1) LP(2, 2) LP(3, 3) LP(4, 4) LP(5, 5) LP(6, 6) LP(7, 7) LP(8, 8) LP(9, 9) LP(10, 10) LP(11, 11) LP(12, 12) LP(13, 13) LP(14, 14) LP(15, 15)
    LP(16, 6) LP(17, 7) LP(18, 8) LP(19, 9) LP(20, 20)
#undef LP
#endif
}
```

```cpp
#include <hip/hip_runtime.h>
#include <cstdio>
#include <cstdint>
#include <cmath>

#define GAS __attribute__((address_space(1)))
#define LAS __attribute__((address_space(3)))
typedef unsigned short bf16;
typedef unsigned v4u __attribute__((ext_vector_type(4)));
typedef unsigned v2u __attribute__((ext_vector_type(2)));
typedef float f32x4 __attribute__((ext_vector_type(4)));
typedef float f32x2 __attribute__((ext_vector_type(2)));
typedef float f32x16 __attribute__((ext_vector_type(16)));
typedef short bf16x8 __attribute__((ext_vector_type(8)));
#define LDS_WAIT() asm volatile("s_waitcnt lgkmcnt(0)" ::: "memory")
#define VM_WAIT() asm volatile("s_waitcnt vmcnt(0)" ::: "memory")

__device__ __forceinline__ unsigned f2bf(float f) { unsigned u = __builtin_bit_cast(unsigned, f); return (u + 0x7fffu + ((u >> 16) & 1u)) >> 16; }
__device__ __forceinline__ unsigned pk2(float lo, float hi) { return f2bf(lo) | (f2bf(hi) << 16); }
__device__ __forceinline__ unsigned cvt_pk_bf16(float lo, float hi) { unsigned r; asm volatile("v_cvt_pk_bf16_f32 %0, %1, %2" : "=v"(r) : "v"(lo), "v"(hi)); return r; }
__device__ __forceinline__ float bf2f(unsigned short b) { return __builtin_bit_cast(float, (unsigned)b << 16); }
__device__ __forceinline__ float bflo(unsigned w) { return __builtin_bit_cast(float, w << 16); }
__device__ __forceinline__ float bfhi(unsigned w) { return __builtin_bit_cast(float, w & 0xffff0000u); }
__device__ __forceinline__ float wave_sum(float v) {
#pragma unroll
    for (int o = 1; o < 64; o <<= 1) v += __shfl_xor(v, o);
    return v;
}

namespace pg8 {
typedef unsigned short bf16_t;
constexpr int BM = 256, BK = 64, HALF = 128, HTB = HALF * BK * 2, STAGE_BYTES = 8 * HTB;

__host__ __device__ __forceinline__ int lds_byte(int r, int c) { const int st = (r >> 4) * 2 + (c >> 5), rr = r & 15, cc = c & 31, ob = rr * 64 + cc * 2; return st * 1024 + (ob ^ (((ob >> 9) & 1) << 5)); }
__host__ __device__ __forceinline__ int perm32(int rho) { const int n = rho >> 4, i = rho & 15; return 8 * (i >> 2) + 4 * n + (i & 3); }
__host__ __device__ __forceinline__ void stage_rc(int b, int& R, int& C) { const int st = b / 1024, sb = b % 1024, swz = sb ^ (((sb >> 9) & 1) << 5); R = (st >> 1) * 16 + swz / 64; C = (st & 1) * 32 + (swz % 64) / 2; }

struct Unit { int pm, pn; long aoff, boff; int e, idx0; };
struct Gemm { const bf16_t* A; const bf16_t* Bt; int lda, ldb, K; };

template <class Epi, class Sched, bool GATHER>
__device__ __forceinline__ void gemm_phase(LAS unsigned char* lds, const Gemm g, const Sched& S, const Epi& E) {
    int tid_ = threadIdx.x; asm volatile("" : "+v"(tid_));
    const int tid = tid_, wid = __builtin_amdgcn_readfirstlane(tid >> 6), lane = tid & 63, wr = wid >> 2, wc = wid & 3, fr = lane & 15, fq = lane >> 4;
    const int K = g.K, nt = K / BK;
    unsigned voffA[2], voffB[2];
#pragma unroll
    for (int i = 0; i < 2; ++i) { int R, C; stage_rc(tid * 16 + i * 8192, R, C);
        const int Rb = Epi::PERM ? ((R & ~31) + perm32(R & 31)) : R;
        voffA[i] = (unsigned)(R * g.lda + C) * 2u; voffB[i] = (unsigned)(Rb * g.ldb + C) * 2u; }
    const size_t kstep = (size_t)(BK * 2);
    const size_t hstepA = GATHER ? 0 : (size_t)HALF * g.lda * 2, hstepB = (size_t)HALF * g.ldb * 2;
    const unsigned ldsw = (unsigned)wid * 1024u;
    const int aoff = lds_byte(wr * 64 + fr, fq * 8), boff = lds_byte(wc * 32 + fr, fq * 8);
#define PG8_SA(b, h) (((b) * 2 + (h)) * HTB)
#define PG8_SB(b, h) ((4 + (b) * 2 + (h)) * HTB)
#define PG8_STAGE(bufoff, gbase, voff) do { _Pragma("unroll") for (int _i = 0; _i < 2; ++_i) \
        __builtin_amdgcn_global_load_lds((const unsigned*)((const char*)(gbase) + (voff)[_i]), (LAS unsigned*)(lds + (bufoff) + ldsw + _i * 8192), 16, 0, 0); } while (0)
#define PG8_STAGE_A(bufoff, gbase, h, nx) do { if constexpr (GATHER) { unsigned _tv[2]; \
        if (nx) { int _tz = tid; asm volatile("" : "+v"(_tz)); _Pragma("unroll") for (int _j = 0; _j < 2; ++_j) { int _R, _C; stage_rc(_tz * 16 + _j * 8192, _R, _C); _tv[_j] = (unsigned)S.arow(nxt, (h) * HALF + _R) * (unsigned)(g.lda * 2) + (unsigned)(_C * 2); } } \
        else { _tv[0] = gvc[h][0]; _tv[1] = gvc[h][1]; } \
        PG8_STAGE(bufoff, gbase, _tv); } else { PG8_STAGE(bufoff, (gbase) + (h) * hstepA, voffA); } } while (0)
#define PG8_LDA(dst, b, h) do { _Pragma("unroll") for (int m = 0; m < 4; ++m) _Pragma("unroll") for (int k = 0; k < 2; ++k) dst[m][k] = *(const LAS bf16x8*)(lds + PG8_SA(b, h) + aoff + m * 2048 + k * 1024); } while (0)
#define PG8_LDB(dst, b, h) do { _Pragma("unroll") for (int n = 0; n < 2; ++n) _Pragma("unroll") for (int k = 0; k < 2; ++k) dst[n][k] = *(const LAS bf16x8*)(lds + PG8_SB(b, h) + boff + n * 2048 + k * 1024); } while (0)
#define PG8_MMA(ai, bj, At, Bt) do { __builtin_amdgcn_s_setprio(1); _Pragma("unroll") for (int m = 0; m < 4; ++m) _Pragma("unroll") for (int n = 0; n < 2; ++n) _Pragma("unroll") for (int k = 0; k < 2; ++k) \
        acc[ai][bj][m][n] = __builtin_amdgcn_mfma_f32_16x16x32_bf16(Bt[n][k], At[m][k], acc[ai][bj][m][n], 0, 0, 0); __builtin_amdgcn_s_setprio(0); } while (0)
#define PG8_WAIT_V(n) asm volatile("s_waitcnt vmcnt(" #n ")" ::: "memory")
#define PG8_WAIT_L(n) asm volatile("s_waitcnt lgkmcnt(" #n ")" ::: "memory")
#define PG8_BAR __builtin_amdgcn_s_barrier()
#define PG8_SCHED __builtin_amdgcn_sched_barrier(0)
    Unit cur, nxt; int ui = 0;
    if (!S.next(0, cur)) return;
    unsigned gvc[2][2];
#define PG8_GV(unit) do { if constexpr (GATHER) { int _tz = tid; asm volatile("" : "+v"(_tz)); _Pragma("unroll") for (int _h = 0; _h < 2; ++_h) _Pragma("unroll") for (int _j = 0; _j < 2; ++_j) { int _R, _C; stage_rc(_tz * 16 + _j * 8192, _R, _C); \
        gvc[_h][_j] = (unsigned)S.arow(unit, _h * HALF + _R) * (unsigned)(g.lda * 2) + (unsigned)(_C * 2); } } } while (0)
    PG8_GV(cur);
    f32x4 acc[2][2][4][2];
#pragma unroll
    for (int a = 0; a < 2; ++a)
#pragma unroll
        for (int b = 0; b < 2; ++b)
#pragma unroll
            for (int m = 0; m < 4; ++m)
#pragma unroll
                for (int n = 0; n < 2; ++n) acc[a][b][m][n] = (f32x4){0.f, 0.f, 0.f, 0.f};
    bf16x8 At[4][2], B0[2][2], B1[2][2];
    const char* cA = (const char*)g.A + cur.aoff; const char* cB = (const char*)g.Bt + cur.boff;
    PG8_STAGE(PG8_SB(0, 0), cB, voffB); PG8_STAGE(PG8_SB(0, 1), cB + hstepB, voffB); PG8_STAGE_A(PG8_SA(0, 0), cA, 0, false); PG8_STAGE_A(PG8_SA(0, 1), cA, 1, false);
    if (wr == 1) PG8_BAR;
    PG8_WAIT_V(2); PG8_BAR;
    PG8_STAGE(PG8_SB(1, 0), cB + kstep, voffB); PG8_STAGE_A(PG8_SA(1, 0), cA + kstep, 0, false); PG8_STAGE(PG8_SB(1, 1), cB + hstepB + kstep, voffB);
    PG8_WAIT_V(6); PG8_BAR;
    for (;;) {
        const bool has_next = S.next(ui + 1, nxt);
        const char* nA = has_next ? (const char*)g.A + nxt.aoff : cA; const char* nB = has_next ? (const char*)g.Bt + nxt.boff : cB;
#pragma nounroll
        for (int t = 0; t < nt; t += 2) {
            const bool last = (t == nt - 2);
            const char* a1 = cA + (size_t)(t + 1) * kstep;
            const char* a2 = last ? nA : cA + (size_t)(t + 2) * kstep; const char* b2 = last ? nB : cB + (size_t)(t + 2) * kstep;
            const char* a3 = a2 + kstep; const char* b3 = b2 + kstep;
            PG8_LDB(B0, 0, 0); PG8_LDB(B1, 0, 1); PG8_SCHED; PG8_LDA(At, 0, 0); PG8_STAGE_A(PG8_SA(1, 1), a1, 1, false);
            PG8_WAIT_V(8); PG8_WAIT_L(0); PG8_BAR; PG8_MMA(0, 0, At, B0); PG8_MMA(0, 1, At, B1); PG8_BAR; PG8_SCHED;
            PG8_LDA(At, 0, 1); PG8_STAGE(PG8_SB(0, 0), b2, voffB); PG8_STAGE(PG8_SB(0, 1), b2 + hstepB, voffB); PG8_STAGE_A(PG8_SA(0, 0), a2, 0, last);
            PG8_WAIT_V(8); PG8_WAIT_L(0); PG8_BAR; PG8_MMA(1, 0, At, B0); PG8_MMA(1, 1, At, B1); PG8_BAR; PG8_SCHED;
            PG8_LDB(B0, 1, 0); PG8_LDB(B1, 1, 1); PG8_SCHED; PG8_LDA(At, 1, 0); PG8_STAGE_A(PG8_SA(0, 1), a2, 1, last);
            PG8_WAIT_V(8); PG8_WAIT_L(0); PG8_BAR; PG8_MMA(0, 0, At, B0); PG8_MMA(0, 1, At, B1); PG8_BAR; PG8_SCHED;
            PG8_LDA(At, 1, 1); PG8_STAGE(PG8_SB(1, 0), b3, voffB); PG8_STAGE(PG8_SB(1, 1), b3 + hstepB, voffB); PG8_STAGE_A(PG8_SA(1, 0), a3, 0, last);
            PG8_WAIT_V(8); PG8_WAIT_L(0); PG8_BAR; PG8_MMA(1, 0, At, B0); PG8_MMA(1, 1, At, B1); PG8_BAR; PG8_SCHED;
        }
        if (wr == 0) PG8_BAR;
        E(acc, cur, wr, wc, fr, fq);
        if (!has_next) break;
#pragma unroll
        for (int a = 0; a < 2; ++a)
#pragma unroll
            for (int b = 0; b < 2; ++b)
#pragma unroll
                for (int m = 0; m < 4; ++m)
#pragma unroll
                    for (int n = 0; n < 2; ++n) acc[a][b][m][n] = (f32x4){0.f, 0.f, 0.f, 0.f};
        cur = nxt; cA = nA; cB = nB; ++ui;
        PG8_GV(cur);
        if (wr == 1) PG8_BAR;
    }
    PG8_WAIT_V(0);
    PG8_BAR;
#undef PG8_SA
#undef PG8_SB
#undef PG8_STAGE
#undef PG8_STAGE_A
#undef PG8_GV
#undef PG8_LDA
#undef PG8_LDB
#undef PG8_MMA
#undef PG8_WAIT_V
#undef PG8_WAIT_L
#undef PG8_BAR
#undef PG8_SCHED
}

struct StaticOrder {
    int nM, nN, nwg, G, c; long astride, apn, bstride;
    __device__ void init(int nM_, int nN_, int G_, int c_, long astride_, long apn_, long bstride_) { nM = nM_; nN = nN_; nwg = nM * nN; G = G_; c = c_; astride = astride_; apn = apn_; bstride = bstride_; }
    __device__ bool next(int i, Unit& u) const {
        const long Lx = (long)i * G + c; if (Lx >= nwg) return false;
        int wgid = (int)Lx; { const int q = nwg / 8, r = nwg % 8, xcd = wgid % 8, off = wgid / 8; wgid = (xcd < r ? xcd * (q + 1) : r * (q + 1) + (xcd - r) * q) + off; }
        const int nig = 8 * nN, gid = wgid / nig, fm = gid * 8, gsz = (nM - fm) < 8 ? (nM - fm) : 8;
        u.pm = fm + ((wgid % nig) % gsz); u.pn = (wgid % nig) / gsz; u.aoff = (long)u.pm * astride + (long)u.pn * apn; u.boff = (long)u.pn * bstride; u.e = 0; u.idx0 = 0; return true;
    }
    __device__ int arow(const Unit&, int) const { return 0; }
};
}

constexpr int DM = 2048, NBATCH = 2, SEQ = 8192, CTX = 256;
constexpr int TL = NBATCH * SEQ;
constexpr int TC = NBATCH * CTX;
constexpr int TT = TL + TC;
constexpr int KEYS = CTX + SEQ;
constexpr int NEXP = 64, DEXP = 512;
constexpr int LISTCAP = 2 * TT;
constexpr float EPS = 1e-6f;
constexpr float QSCALE = 0.125f * 1.4426950408889634f;
constexpr int NWAVES = 8, NTHREADS = 512;

constexpr size_t MiB = 1u << 20;
constexpr size_t WS_CTL = 0, CTL_BYTES = 1 * MiB;
constexpr size_t WS_WIN0 = 1 * MiB;
constexpr size_t WS_WOUT0 = WS_WIN0 + 16 * MiB;
constexpr size_t WS_WIN1 = WS_WOUT0 + 8 * MiB;
constexpr size_t WS_WOUT1 = WS_WIN1 + 16 * MiB;
constexpr size_t WS_WPOOL = WS_WOUT1 + 8 * MiB;
constexpr size_t WS_WGLU = WS_WPOOL + 1 * MiB;
constexpr size_t WS_WMOE = WS_WGLU + 2 * MiB;
constexpr size_t MOE_E_BYTES = 6 * MiB, MOE_L_BYTES = 64 * MOE_E_BYTES;
constexpr size_t WS_X = WS_WMOE + 2 * MOE_L_BYTES;
constexpr size_t WS_HA = WS_X + 132 * MiB;
constexpr size_t WS_Q = WS_HA + 67 * MiB;
constexpr size_t WS_K = WS_Q + 33 * MiB;
constexpr size_t WS_VT = WS_K + 33 * MiB;
constexpr size_t WS_P = WS_VT + 33 * MiB;
constexpr size_t WS_PROJ1 = WS_Q;
constexpr size_t WS_CAT = WS_P + 33 * MiB;
constexpr size_t WS_PD = WS_CAT + 66 * MiB;
constexpr size_t WS_H = WS_PD + 33 * MiB;
constexpr size_t WS_Y = WS_H + 49 * MiB;
constexpr size_t WS_GT = WS_Y + 132 * MiB;
constexpr size_t WS_KT = WS_GT + 192 * MiB;
constexpr size_t WS_YD = WS_KT + 128 * MiB;
constexpr size_t WS_MISC = WS_YD + 128 * MiB;
constexpr size_t WS_MOD = WS_MISC;
constexpr size_t WS_ADAP = WS_MOD + 1 * MiB;
constexpr size_t WS_ROPE = WS_ADAP + 10 * MiB;
constexpr size_t WS_NORMP = WS_ROPE + 1 * MiB;
constexpr size_t WS_INVN = WS_NORMP + 4 * MiB;
constexpr size_t WS_S5LAM = WS_INVN + 1 * MiB;
constexpr size_t WS_S5B = WS_S5LAM + 1 * MiB;
constexpr size_t WS_WRT = WS_S5B + 2 * MiB;
constexpr size_t WS_TOKL = WS_WRT + 2 * MiB;
constexpr size_t WS_GATEL = WS_TOKL + 9 * MiB;
constexpr size_t WS_TW = WS_GATEL + 9 * MiB;
constexpr size_t WS_FFTW = WS_TW + 1 * MiB;
constexpr size_t WS_S5L256 = WS_FFTW + 32 * MiB;
constexpr size_t WS_S5E = WS_S5L256 + 1 * MiB;
constexpr size_t WS_YHT = WS_S5E + 4 * MiB;
constexpr size_t WS_S5L16 = WS_YHT + 64 * MiB;
constexpr size_t WS_S5W1 = WS_S5L16 + 1 * MiB;
constexpr size_t WS_S5W3 = WS_S5W1 + 8 * MiB;
constexpr size_t WS_S5KT = WS_S5W3 + 8 * MiB;
constexpr size_t WS_END = WS_S5KT + 2 * MiB;
static_assert(WS_END <= 2040 * MiB, "d_ws map");
constexpr int CW_BAR = 1024;
constexpr int CW_CNT = 8192;
constexpr int CSTR = 32;

constexpr int LDS_PHASE = 131072;
constexpr int LDS_CTL = 147456 - 2048;
constexpr int LDS_BYTES = 147456;

#define XB_TMO      128
#define XB_XCNT(j)  (256  + 64 * (j))
#define XB_XSUB(j)  (1280 + 64 * (j))
#define XB_XGEN(j)  (2304 + 64 * (j))
#define XB_TOP      3328
#define XB_TOPGEN   3392
#define XCD_BAR_WORDS 3456
#define XB_SPIN_CAP (1u << 22)

__device__ __forceinline__ unsigned xb_ld(unsigned* p)              { return __hip_atomic_load(p, __ATOMIC_RELAXED, __HIP_MEMORY_SCOPE_AGENT); }
__device__ __forceinline__ unsigned xb_add(unsigned* p, unsigned v) { return __hip_atomic_fetch_add(p, v, __ATOMIC_RELAXED, __HIP_MEMORY_SCOPE_AGENT); }
__device__ __forceinline__ unsigned xb_xcc_id() { return (unsigned)__builtin_amdgcn_s_getreg((3 << 11) | 20) & 0xFu; }
#define XB_SPIN(cond, bar) do { unsigned _sp = 0; while (cond) { __builtin_amdgcn_s_sleep(1); \
    if ((++_sp & 255u) == 0u) { if (xb_ld(&(bar)[XB_TMO])) break; if (_sp > XB_SPIN_CAP) { atomicAdd(&(bar)[XB_TMO], 1u); break; } } } } while (0)

struct XcdBarrier { unsigned* bar; unsigned x; volatile LAS unsigned* st; };

__device__ __forceinline__ XcdBarrier xcd_barrier_post(unsigned* bar, volatile LAS unsigned* st) {
    XcdBarrier b; b.bar = bar; b.x = xb_xcc_id(); b.st = st;
    if (threadIdx.x == 0) (void)xb_add(&bar[XB_XCNT(b.x)], 1u);
    return b;
}
__device__ __forceinline__ void xcd_barrier_complete(unsigned* bar, unsigned x, unsigned& nloc, unsigned& nx) {
    const unsigned G = gridDim.x * gridDim.y * gridDim.z;
    unsigned sum, cnt, mine, sp = 0u;
    for (;;) {
        sum = 0u; cnt = 0u; mine = 0u;
#pragma unroll
        for (unsigned j = 0; j < 16; ++j) { const unsigned c = xb_ld(&bar[XB_XCNT(j)]); sum += c; cnt += (c > 0u) ? 1u : 0u; mine = (j == x) ? c : mine; }
        if (sum == G) break;
        __builtin_amdgcn_s_sleep(1);
        if ((++sp & 255u) == 0u) { if (xb_ld(&bar[XB_TMO])) break; if (sp > XB_SPIN_CAP) { atomicAdd(&bar[XB_TMO], 1u); break; } }
    }
    nloc = mine > 0u ? mine : 1u; nx = cnt > 0u ? cnt : 1u;
}
__device__ __forceinline__ void xcd_barrier(const XcdBarrier& b) {
    asm volatile("s_waitcnt vmcnt(0)" ::: "memory");
    __syncthreads();
    if (threadIdx.x == 0) {
        unsigned* bar = b.bar;
        __builtin_amdgcn_s_waitcnt(0);
        unsigned nloc = b.st[0], nx = b.st[1];
        if (nloc == 0u) { xcd_barrier_complete(bar, b.x, nloc, nx); b.st[0] = nloc; b.st[1] = nx; }
        const unsigned old = xb_add(&bar[XB_XSUB(b.x)], 1u);
        const unsigned gen = old / nloc;
        if (old + 1u == (gen + 1u) * nloc) {
            __builtin_amdgcn_fence(__ATOMIC_RELEASE, "agent");
            asm volatile("s_waitcnt vmcnt(0)" ::: "memory");
            const unsigned og = xb_add(&bar[XB_TOP], 1u);
            const unsigned tg = og / nx;
            if (og + 1u == (tg + 1u) * nx) xb_add(&bar[XB_TOPGEN], 1u);
            else XB_SPIN(xb_ld(&bar[XB_TOPGEN]) == tg, bar);
            __builtin_amdgcn_fence(__ATOMIC_ACQUIRE, "agent");
            xb_add(&bar[XB_XGEN(b.x)], 1u);
            asm volatile("s_waitcnt vmcnt(0)" ::: "memory");
        } else {
            XB_SPIN(xb_ld(&bar[XB_XGEN(b.x)]) == gen, bar);
            __builtin_amdgcn_fence(__ATOMIC_ACQUIRE, "agent");
            asm volatile("s_waitcnt vmcnt(0)" ::: "memory");
        }
    }
    __syncthreads();
}

__device__ __forceinline__ void sincos_2pi(double x, double& s, double& c) {
    const double q = __builtin_rint(x * 4.0);
    const double y = (x - q * 0.25) * 6.283185307179586476925;
    const double y2 = y * y;
    double sp = -7.6471637318198164759e-13; sp = sp * y2 + 1.6059043836821614599e-10; sp = sp * y2 - 2.5052108385441718775e-8; sp = sp * y2 + 2.7557319223985890653e-6;
    sp = sp * y2 - 1.9841269841269841270e-4; sp = sp * y2 + 8.3333333333333333333e-3; sp = sp * y2 - 1.6666666666666666667e-1; sp = sp * y2 * y + y;
    double cp = 4.7794773323873852974e-14; cp = cp * y2 - 1.1470745597729724714e-11; cp = cp * y2 + 2.0876756987868098979e-9; cp = cp * y2 - 2.7557319223985890653e-7;
    cp = cp * y2 + 2.4801587301587301587e-5; cp = cp * y2 - 1.3888888888888888889e-3; cp = cp * y2 + 4.1666666666666666667e-2; cp = cp * y2 - 0.5; cp = cp * y2 + 1.0;
    const int qi = ((int)q) & 3;
    s = (qi == 0) ? sp : (qi == 1) ? cp : (qi == 2) ? -sp : -cp;
    c = (qi == 0) ? cp : (qi == 1) ? -sp : (qi == 2) ? -cp : sp;
}
__device__ __forceinline__ void sincos_rad(double a, double& s, double& c) {
    double f = a * 0.15915494309189533576888; f -= __builtin_floor(f);
    if (f >= 1.0) f = 0.0;
    sincos_2pi(f, s, c);
}
__device__ __forceinline__ double exp_small(double x) {
    double r = 1.0 / 479001600.0;
    r = r * x + 1.0 / 39916800.0; r = r * x + 1.0 / 3628800.0; r = r * x + 1.0 / 362880.0; r = r * x + 1.0 / 40320.0; r = r * x + 1.0 / 5040.0;
    r = r * x + 1.0 / 720.0; r = r * x + 1.0 / 120.0; r = r * x + 1.0 / 24.0; r = r * x + 1.0 / 6.0; r = r * x + 0.5; r = r * x + 1.0; r = r * x + 1.0;
    return r;
}
__device__ __forceinline__ float fast_exp(float x) { return __builtin_amdgcn_exp2f(x * 1.4426950408889634f); }
__device__ __forceinline__ float sigmoidf_(float x) { return 1.0f / (1.0f + fast_exp(-x)); }
__device__ __forceinline__ float siluf_(float x) { return x * sigmoidf_(x); }
__device__ __forceinline__ float tanhf_(float x) { const float e = fast_exp(-2.0f * fabsf(x)); const float t = (1.0f - e) / (1.0f + e); return x < 0.f ? -t : t; }
__device__ __forceinline__ float gelu_tanh(float x) { return 0.5f * x * (1.0f + tanhf_(0.7978845608028654f * (x + 0.044715f * x * x * x))); }

#ifndef PH_REPEAT
#define PH_REPEAT 0u
#endif
struct Args { const float* in[43]; float* out; unsigned char* ws; int ph_lo, ph_hi; };

#define GAS __attribute__((address_space(1)))
struct Frame {
    LAS unsigned char* lds; GAS unsigned char* ws; int tid, lane, wave, bid, G, gw, NGW;
    const __attribute__((address_space(4))) unsigned long long* kin;
};
#define INP(i) ((const float*)(const GAS float*)F.kin[i])
#define WSP(T, off) ((T*)(GAS T*)(F.ws + (off)))

__device__ __forceinline__ void tr_item(const float* W, int ldw, int N, bf16* WT, int ldt, int row_off, int rs16, LAS float* scr, int item, int lane) {
    const int nblk = N / 64, kb = item / nblk, nb = item % nblk, k0 = 64 * kb, n0 = 64 * nb;
    const int la = lane & 15, lb = lane >> 4;
    f32x4 v[16];
#pragma unroll
    for (int i = 0; i < 16; ++i) v[i] = *(const f32x4*)(W + (size_t)(k0 + 4 * i + lb) * ldw + n0 + 4 * la);
#pragma unroll
    for (int i = 0; i < 16; ++i) { const int kk = 4 * i + lb; LAS float* d = scr + (4 * la) * 65 + kk; d[0] = v[i].x; d[65] = v[i].y; d[130] = v[i].z; d[195] = v[i].w; }
    LDS_WAIT(); asm volatile("" ::: "memory");
    const int c = lane & 7;
#pragma unroll
    for (int j = 0; j < 8; ++j) { const int n = (lane >> 3) + 8 * j; const LAS float* s = scr + n * 65 + 8 * c;
        v4u o; o.x = cvt_pk_bf16(s[0], s[1]); o.y = cvt_pk_bf16(s[2], s[3]); o.z = cvt_pk_bf16(s[4], s[5]); o.w = cvt_pk_bf16(s[6], s[7]);
        const int nn = n0 + n, drow = row_off + (nn >> 4) * rs16 + (nn & 15);
        *(v4u*)(WT + (size_t)drow * ldt + k0 + 8 * c) = o; }
    LDS_WAIT(); asm volatile("" ::: "memory");
}

__device__ __forceinline__ void hyfilt_item(Frame& F, int pb) {
    const float* w1 = INP(19); const float* b1 = INP(20); const float* fq = INP(21); const float* w2 = INP(22); const float* b2 = INP(23); const float* w3 = INP(24);
    LAS float* z = (LAS float*)F.lds;
    LAS float* h1 = z + 1088;
    LAS float* h2 = h1 + 2048;
    const int tid = F.tid;
    for (int idx = tid; idx < 32 * 33; idx += NTHREADS) {
        const int p = idx / 33, f = idx % 33, i = pb * 32 + p;
        float v;
        if (f == 0) v = (float)i * (1.0f / (float)(SEQ - 1));
        else { const int j = (f - 1) & 15; const float fj = 1e-4f + (float)j * ((15.0f - 1e-4f) / 15.0f);
            double fr = (double)fj * (double)i / (double)SEQ; fr -= __builtin_floor(fr); double s, c; sincos_2pi(fr, s, c); v = (f <= 16) ? (float)c : (float)(-s); }
        z[p * 33 + f] = v;
    }
    __syncthreads();
    for (int idx = tid; idx < 2048; idx += NTHREADS) {
        const int p = idx >> 6, j = idx & 63; float a = b1[j];
        for (int f = 0; f < 33; ++f) a += z[p * 33 + f] * w1[f * 64 + j];
        double s, c; sincos_rad((double)(fq[j] * a), s, c); h1[idx] = (float)s;
    }
    __syncthreads();
    for (int idx = tid; idx < 2048; idx += NTHREADS) {
        const int p = idx >> 6, j = idx & 63; float a = b2[j];
        for (int k = 0; k < 64; ++k) a += h1[p * 64 + k] * w2[k * 64 + j];
        double s, c; sincos_rad((double)(fq[64 + j] * a), s, c); h2[idx] = (float)s;
    }
    __syncthreads();
    float* kT = WSP(float, WS_KT); float* normp = WSP(float, WS_NORMP);
    {
        const int lane = F.lane, l31 = lane & 31, lh = lane >> 5;
        float af[32];
#pragma unroll
        for (int s = 0; s < 32; ++s) af[s] = h2[l31 * 64 + 2 * s + lh];
        float bn[32];
        { const unsigned vo = (unsigned)(lh * 4096 + F.wave * 32 + l31);
#pragma unroll
          for (int s = 0; s < 32; ++s) bn[s] = (w3 + s * 8192)[vo]; }
#pragma nounroll
        for (int ct = F.wave; ct < 128; ct += NWAVES) {
            const int col = ct * 32 + l31;
            f32x16 acc;
#pragma unroll
            for (int r = 0; r < 16; ++r) acc[r] = 0.f;
            float bv[32];
#pragma unroll
            for (int s = 0; s < 32; ++s) bv[s] = bn[s];
            { const unsigned vo = (unsigned)(lh * 4096 + (ct + NWAVES < 128 ? ct + NWAVES : ct) * 32 + l31);
#pragma unroll
              for (int s = 0; s < 32; ++s) bn[s] = (w3 + s * 8192)[vo]; }
#pragma unroll
            for (int s = 0; s < 32; ++s) acc = __builtin_amdgcn_mfma_f32_32x32x2f32(af[s], bv[s], acc, 0, 0, 0);
#pragma unroll
            for (int s = 0; s < 32; s += 8) asm volatile("" : "+v"(acc) : "v"(bv[s]), "v"(bv[s + 1]), "v"(bv[s + 2]), "v"(bv[s + 3]), "v"(bv[s + 4]), "v"(bv[s + 5]), "v"(bv[s + 6]), "v"(bv[s + 7]));
            const int ch = col & 1023, dir = (col >> 10) & 1;
            const float adel = 3.0701134573253946f + (float)ch * ((15.350567286626972f - 3.0701134573253946f) / 1023.0f);
            float sabs = 0.f;
#pragma unroll
            for (int r = 0; r < 16; ++r) { const int i = pb * 32 + (r & 3) + 8 * (r >> 2) + 4 * lh; const float t = (float)i * (1.0f / (float)(SEQ - 1)); acc[r] *= fast_exp(-t * adel); if (!(dir == 1 && i == 0)) sabs += fabsf(acc[r]); }
            sabs += __shfl_xor(sabs, 32);
#pragma unroll
            for (int q = 0; q < 4; ++q) *(f32x4*)(kT + (size_t)col * SEQ + pb * 32 + 8 * q + 4 * lh) = (f32x4){acc[4 * q], acc[4 * q + 1], acc[4 * q + 2], acc[4 * q + 3]};
            if (lh == 0) normp[(size_t)pb * 4096 + col] = sabs;
        }
    }
    __syncthreads();
}

#define LDS_BARRIER() do { asm volatile("s_waitcnt lgkmcnt(0)" ::: "memory"); __builtin_amdgcn_s_barrier(); asm volatile("" ::: "memory"); } while (0)
struct TrItem { const float* W; bf16* WT; int ldw, ldt, row_off, rs16, k0, n0; };
__device__ __forceinline__ TrItem moe_tr_item(Frame& F, int it) {
    const int le = it / 192, q = it % 192; TrItem r;
    bf16* wc = (bf16*)(GAS bf16*)(F.ws + WS_WMOE + (size_t)le * MOE_E_BYTES);
    if (q < 128) { r.W = (q < 64 ? INP(40) : INP(41)) + (size_t)le * (2048 * 512); r.ldw = 512; r.WT = wc; r.ldt = 2048; r.row_off = (q < 64) ? 0 : 16; r.rs16 = 32; r.k0 = 64 * ((q & 63) >> 1); r.n0 = 256 * (q & 1); }
    else { const int x = q - 128; r.W = INP(42) + (size_t)le * (512 * 2048); r.ldw = 2048; r.WT = wc + 1024 * 2048; r.ldt = 512; r.row_off = 0; r.rs16 = 16; r.k0 = 64 * (x >> 3); r.n0 = 256 * (x & 7); }
    return r;
}
__device__ __forceinline__ void moe_convert_items(Frame& F) {
    constexpr int NIT = 128 * 192;
    const int t = F.tid, lane = t & 63, w = __builtin_amdgcn_readfirstlane(t >> 6);
    const int kc = t & 7, nb = t >> 3;
    int first, step, count;
    if (F.G == 256) { first = F.bid * (NIT / 256); step = 1; count = NIT / 256; }
    else { first = F.bid; step = F.G; count = (NIT - F.bid + F.G - 1) / F.G; }
    if (count <= 0) return;
    LAS unsigned char* lds = F.lds;
#define CV_DMA(sidx, buf) do { const int s_ = (sidx) < count ? (sidx) : count - 1; const TrItem c_ = moe_tr_item(F, first + s_ * step); \
        const float* g_ = c_.W + (size_t)(c_.k0 + 8 * w) * c_.ldw + c_.n0 + 4 * (lane ^ w); \
        _Pragma("unroll") for (int j_ = 0; j_ < 8; ++j_) \
            __builtin_amdgcn_global_load_lds((const unsigned*)(g_ + (size_t)j_ * c_.ldw), (LAS unsigned*)(lds + (buf) * 65536 + (8 * w + j_) * 1024), 16, 0, 2); } while (0)
    CV_DMA(0, 0); CV_DMA(1, 1);
#pragma nounroll
    for (int s = 0; s < count; ++s) {
        const int buf = s & 1;
        if (s == 0) asm volatile("s_waitcnt vmcnt(8)" ::: "memory"); else asm volatile("s_waitcnt vmcnt(12)" ::: "memory");
        __builtin_amdgcn_s_barrier(); asm volatile("" ::: "memory");
        const TrItem c = moe_tr_item(F, first + s * step);
        const LAS float* T = (const LAS float*)(lds + buf * 65536);
#pragma unroll
        for (int q = 0; q < 4; ++q) { const int n = nb + 64 * q; const LAS float* src = T + (8 * kc) * 256 + 4 * ((n >> 2) ^ kc) + (n & 3);
            v4u o; o.x = cvt_pk_bf16(src[0], src[256]); o.y = cvt_pk_bf16(src[512], src[768]); o.z = cvt_pk_bf16(src[1024], src[1280]); o.w = cvt_pk_bf16(src[1536], src[1792]);
            const int nn = c.n0 + n, drow = c.row_off + (nn >> 4) * c.rs16 + (nn & 15);
            __builtin_nontemporal_store(o, (v4u*)(c.WT + (size_t)drow * c.ldt + c.k0 + 8 * kc)); }
        LDS_BARRIER();
        CV_DMA(s + 2, buf);
    }
    asm volatile("s_waitcnt vmcnt(0)" ::: "memory");
#undef CV_DMA
}

__device__ __forceinline__ void p0_prologue(Frame& F) {
    if ((F.bid & 1) == 0) { for (int pb = F.bid; pb < SEQ / 32; pb += F.G) hyfilt_item(F, pb); __syncthreads(); }
    const int gt = F.bid * NTHREADS + F.tid, NGT = F.G * NTHREADS;
    {
        f32x2* rope = WSP(f32x2, WS_ROPE);
        for (int idx = gt; idx < 128 * 16; idx += NGT) { const int pos = idx >> 4, i = idx & 15;
            double inv = (i & 3) == 0 ? 1.0 : (i & 3) == 1 ? 0.56234132519034908 : (i & 3) == 2 ? 0.31622776601683794 : 0.17782794100389228;
            inv *= (i >> 2) == 0 ? 1.0 : (i >> 2) == 1 ? 0.1 : (i >> 2) == 2 ? 0.01 : 0.001;
            const float ang = (float)pos * (float)inv; double s, c; sincos_rad((double)ang, s, c); rope[idx] = (f32x2){(float)c, (float)s}; }
    }
    {
        f32x2* tw = WSP(f32x2, WS_TW);
        for (int idx = gt; idx < 16384; idx += NGT) { double s, c; sincos_2pi((double)idx * (1.0 / 16384.0), s, c); tw[idx] = (f32x2){(float)c, (float)(-s)}; }
    }
    {
        const float* are = INP(26); const float* aim = INP(27); const float* ldt = INP(28); const float* bre = INP(29); const float* bim = INP(30);
        f32x2* lamb = WSP(f32x2, WS_S5LAM); f32x2* bb = WSP(f32x2, WS_S5B); f32x2* l256 = WSP(f32x2, WS_S5L256);
        for (int idx = gt; idx < 2 * 64 * 64; idx += NGT) { const int dg = idx >> 6;
            const float dt = expf(ldt[dg]); const float ar = are[idx], ai = aim[idx];
            const float zr = ar * dt, zi = ai * dt; double s, c; sincos_rad((double)zi, s, c); const double er = exp_small((double)zr);
            const double lr = er * c, li = er * s; lamb[idx] = (f32x2){(float)lr, (float)li};
            { double pr = lr, pi = li; for (int q = 0; q < 8; ++q) { const double tr = pr * pr - pi * pi, ti = 2.0 * pr * pi; pr = tr; pi = ti; } l256[idx] = (f32x2){(float)pr, (float)pi}; }
            const double nr = lr - 1.0, ni = li, den = (double)ar * ar + (double)ai * ai; const double qr = (nr * ar + ni * ai) / den, qi = (ni * ar - nr * ai) / den;
            for (int cc = 0; cc < 16; ++cc) { const double br = bre[(size_t)idx * 16 + cc], bi = bim[(size_t)idx * 16 + cc]; bb[(size_t)idx * 16 + cc] = (f32x2){(float)(qr * br - qi * bi), (float)(qr * bi + qi * br)}; } }
    }
    {
        float* wrt = WSP(float, WS_WRT);
        for (int idx = gt; idx < 2 * 72 * 2048; idx += NGT) { const int l = idx / (72 * 2048), r = idx % (72 * 2048), n = r / 2048, k = r % 2048;
            wrt[idx] = n < 8 ? INP(36)[((size_t)l * 2048 + k) * 8 + n] : INP(38)[((size_t)l * 2048 + k) * 64 + (n - 8)]; }
    }
    {
        bf16* ha = WSP(bf16, WS_HA);
        for (int idx = gt; idx < 2048; idx += NGT) ha[(size_t)TT * 2048 + idx] = 0;
    }
    LAS float* scr = (LAS float*)(F.lds + F.wave * 16896);
    {
        const float* c = INP(1); const float* cctx = INP(3); const float* adaw = INP(4); float* part = WSP(float, WS_ADAP);
        for (int rep = 0; rep < (((PH_REPEAT >> 26) & 1u) ? 2 : 1); ++rep)
        for (int it = F.gw; it < 2 * 32 * 48; it += F.NGW) {
            const int l = it / (32 * 48), r = it % (32 * 48), ks = r / 48, jb = r % 48, k0 = ks * 64, j0 = jb * 256 + F.lane * 4;
            const float c0 = c[k0 + F.lane], c1 = c[2048 + k0 + F.lane], c2 = cctx[k0 + F.lane];
            const float s0 = c0 / (1.0f + expf(-c0)), s1 = c1 / (1.0f + expf(-c1)), s2 = c2 / (1.0f + expf(-c2));
            f32x4 a0 = {0.f, 0.f, 0.f, 0.f}, a1 = a0, a2 = a0;
            const float* wp = adaw + ((size_t)l * 2048 + k0) * 12288 + j0;
#pragma unroll 8
            for (int kk = 0; kk < 64; ++kk) { const f32x4 w = *(const f32x4*)(wp + (size_t)kk * 12288);
                const float t0 = __builtin_bit_cast(float, __builtin_amdgcn_readlane(__builtin_bit_cast(int, s0), kk));
                const float t1 = __builtin_bit_cast(float, __builtin_amdgcn_readlane(__builtin_bit_cast(int, s1), kk));
                const float t2 = __builtin_bit_cast(float, __builtin_amdgcn_readlane(__builtin_bit_cast(int, s2), kk));
                a0 += w * t0; a1 += w * t1; a2 += w * t2; }
            float* pp = part + ((size_t)(l * 32 + ks) * 3) * 12288 + j0;
            *(f32x4*)(pp) = a0; *(f32x4*)(pp + 12288) = a1; *(f32x4*)(pp + 2 * 12288) = a2;
        }
    }
    {
        constexpr int I0 = 1024, I1 = 512, I2 = 512, I3 = 1024, I4 = 2048, I5 = 1024, I6 = 64, I7 = 256, IE = 768;
        constexpr int NSMALL = I0 + I1 + I2 + I3 + I4 + I5 + I6 + I7;
        const int NITEMS = NSMALL;
        for (int rep = 0; rep < (((PH_REPEAT >> 27) & 1u) ? 2 : 1); ++rep)
        for (int it = F.gw; it < NITEMS; it += F.NGW) {
            int r = it;
            if (r < I0) { tr_item(INP(9), 4096, 2048, WSP(bf16, WS_WIN0), 2048, 0, 16, scr, r, F.lane); continue; } r -= I0;
            if (r < I1) { tr_item(INP(9) + 2048, 4096, 1024, WSP(bf16, WS_WIN0), 2048, 3072, 16, scr, r, F.lane); continue; } r -= I1;
            if (r < I2) { tr_item(INP(9) + 3072, 4096, 1024, WSP(bf16, WS_WIN0), 2048, 2048, 16, scr, r, F.lane); continue; } r -= I2;
            if (r < I3) { tr_item(INP(10), 2048, 2048, WSP(bf16, WS_WOUT0), 2048, 0, 16, scr, r, F.lane); continue; } r -= I3;
            if (r < I4) { tr_item(INP(15), 4096, 4096, WSP(bf16, WS_WIN1), 2048, 0, 16, scr, r, F.lane); continue; } r -= I4;
            if (r < I5) { tr_item(INP(16), 2048, 2048, WSP(bf16, WS_WOUT1), 2048, 0, 16, scr, r, F.lane); continue; } r -= I5;
            if (r < I6) { const int g = r / 16; tr_item(INP(13) + (size_t)g * 65536, 256, 256, WSP(bf16, WS_WPOOL), 256, g * 256, 16, scr, r % 16, F.lane); continue; } r -= I6;
            if (r < I7) { tr_item(INP(34), 1024, 1024, WSP(bf16, WS_WGLU), 1024, 0, 16, scr, r, F.lane); continue; } r -= I7;
        }
    }
    if ((F.bid & 1) != 0) { __syncthreads(); for (int pb = F.bid; pb < SEQ / 32; pb += F.G) hyfilt_item(F, pb); }
}

__device__ __forceinline__ void p1_reduce(Frame& F) {
    const int gt = F.bid * NTHREADS + F.tid, NGT = F.G * NTHREADS;
    const float* part = WSP(float, WS_ADAP); float* mod = WSP(float, WS_MOD); const float* adab = INP(5);
    for (int idx = gt; idx < 2 * 3 * 12288; idx += NGT) { const int l = idx / (3 * 12288), r = idx % (3 * 12288), m = r / 12288, j = r % 12288;
        float a = adab[l * 12288 + j];
        for (int ks = 0; ks < 32; ++ks) a += part[((size_t)(l * 32 + ks) * 3 + m) * 12288 + j];
        mod[idx] = a; }
    const float* normp = WSP(float, WS_NORMP); float* invn = WSP(float, WS_INVN);
    for (int idx = gt; idx < 2048; idx += NGT) { const int o = idx >> 10, ch = idx & 1023; float a = 0.f;
        for (int pb = 0; pb < 256; ++pb) a += normp[(size_t)pb * 4096 + o * 2048 + ch] + normp[(size_t)pb * 4096 + o * 2048 + 1024 + ch];
        invn[idx] = 1.0f / a; }
    {
        const f32x2* lamb = WSP(f32x2, WS_S5LAM); const f32x2* bbar = WSP(f32x2, WS_S5B); const float* cre = INP(31); const float* cim = INP(32);
        bf16* W1 = WSP(bf16, WS_S5W1); bf16* W3 = WSP(bf16, WS_S5W3); bf16* KT = WSP(bf16, WS_S5KT); f32x2* l16 = WSP(f32x2, WS_S5L16);
#define S5_POWF(l_, e_, pw_) do { pw_ = (f32x2){1.f, 0.f}; f32x2 b_ = l_; for (int q_ = (e_); q_ > 0; q_ >>= 1) { if (q_ & 1) pw_ = (f32x2){pw_.x * b_.x - pw_.y * b_.y, pw_.x * b_.y + pw_.y * b_.x}; b_ = (f32x2){b_.x * b_.x - b_.y * b_.y, 2.f * b_.x * b_.y}; } } while (0)
        for (int idx = gt; idx < 128 * 64; idx += NGT) { f32x2 pw; S5_POWF(lamb[idx], 16, pw); l16[idx] = pw; }
        for (int idx = gt; idx < 128 * 128 * 32; idx += NGT) {
            const int k8 = idx & 31, n = (idx >> 5) & 127, dg = idx >> 12, sigma = k8 >> 1, h = k8 & 1, p = (n & 15) + 16 * ((n >> 4) & 3), im = n >> 6;
            f32x2 pw; S5_POWF(lamb[dg * 64 + p], 15 - sigma, pw);
            const f32x4* bp = (const f32x4*)(bbar + ((size_t)dg * 64 + p) * 16 + 8 * h); float o[8];
#pragma unroll
            for (int j = 0; j < 4; ++j) { const f32x4 q = bp[j]; o[2 * j] = im ? (pw.x * q.y + pw.y * q.x) : (pw.x * q.x - pw.y * q.y); o[2 * j + 1] = im ? (pw.x * q.w + pw.y * q.z) : (pw.x * q.z - pw.y * q.w); }
            v4u w; w.x = pk2(o[0], o[1]); w.y = pk2(o[2], o[3]); w.z = pk2(o[4], o[5]); w.w = pk2(o[6], o[7]);
            *(v4u*)(W1 + (size_t)idx * 8) = w; }
        for (int idx = gt; idx < 128 * 256 * 16; idx += NGT) {
            const int k8 = idx & 15, n = (idx >> 4) & 255, dg = idx >> 12, tau = n >> 4, cout = n & 15; float o[8];
#pragma unroll
            for (int j = 0; j < 4; ++j) { const int p = 4 * k8 + j; f32x2 pw; S5_POWF(lamb[dg * 64 + p], tau + 1, pw);
                const float cr = cre[((size_t)dg * 16 + cout) * 64 + p], ci = cim[((size_t)dg * 16 + cout) * 64 + p]; o[2 * j] = cr * pw.x - ci * pw.y; o[2 * j + 1] = -(cr * pw.y + ci * pw.x); }
            v4u w; w.x = pk2(o[0], o[1]); w.y = pk2(o[2], o[3]); w.z = pk2(o[4], o[5]); w.w = pk2(o[6], o[7]);
            *(v4u*)(W3 + (size_t)idx * 8) = w; }
        for (int idx = gt; idx < 128 * 17 * 16 * 2; idx += NGT) {
            const int h = idx & 1, cout = (idx >> 1) & 15, d1 = (idx >> 5) % 17, dg = (idx >> 5) / 17;
            float acc[8];
#pragma unroll
            for (int j = 0; j < 8; ++j) acc[j] = 0.f;
            if (d1 > 0) { for (int p = 0; p < 64; ++p) { f32x2 pw; S5_POWF(lamb[dg * 64 + p], d1 - 1, pw);
                const float cr = cre[((size_t)dg * 16 + cout) * 64 + p], ci = cim[((size_t)dg * 16 + cout) * 64 + p]; const float gr = cr * pw.x - ci * pw.y, gi = cr * pw.y + ci * pw.x;
                const f32x4* bp = (const f32x4*)(bbar + ((size_t)dg * 64 + p) * 16 + 8 * h);
#pragma unroll
                for (int j = 0; j < 4; ++j) { const f32x4 q = bp[j]; acc[2 * j] += gr * q.x - gi * q.y; acc[2 * j + 1] += gr * q.z - gi * q.w; } } }
            v4u w; w.x = pk2(acc[0], acc[1]); w.y = pk2(acc[2], acc[3]); w.z = pk2(acc[4], acc[5]); w.w = pk2(acc[6], acc[7]);
            *(v4u*)(KT + (size_t)idx * 8) = w; }
#undef S5_POWF
    }
}

__device__ __forceinline__ const float* modp(Frame& F, int l, int m, int c) { return WSP(float, WS_MOD) + ((size_t)(l * 3 + m) * 6 + c) * 2048; }
__device__ __forceinline__ int row_stream(int r) { return r < TL ? r / SEQ : 2; }

template <int MODE>
__device__ __forceinline__ void norm_phase(Frame& F, int l, float* dout) {
    const int nrows = (MODE == 3 || (MODE == 1 && l == 1)) ? TL : TT;
    float* xbuf = WSP(float, WS_X); bf16* ha = WSP(bf16, WS_HA); const bf16* Y = WSP(bf16, WS_Y);
    const float* gvec = (MODE == 0) ? INP(6) : (MODE == 1) ? INP(7) + l * 2048 : (MODE == 2) ? INP(6) + 2048 : INP(8);
    const int lane = F.lane;
    for (int r = F.gw; r < nrows; r += F.NGW) {
        const int m = row_stream(r);
        const float* src = (MODE == 0) ? (r < TL ? INP(0) + (size_t)r * 2048 : INP(2) + (size_t)(r - TL) * 2048) : xbuf + (size_t)r * 2048;
        f32x4 v[8]; float ss = 0.f;
#pragma unroll
        for (int j = 0; j < 8; ++j) v[j] = *(const f32x4*)(src + 4 * lane + 256 * j);
        if (MODE == 2 || MODE == 3) {
            const float* g2 = modp(F, MODE == 2 ? 0 : 1, m, 5);
            const bf16* y0 = Y + (size_t)(2 * r) * 2048; const bf16* y1 = y0 + 2048;
#pragma unroll
            for (int j = 0; j < 8; ++j) { const int c = 4 * lane + 256 * j; const v2u a = *(const v2u*)(y0 + c), b = *(const v2u*)(y1 + c); const f32x4 gg = *(const f32x4*)(g2 + c);
                v[j].x += gg.x * (bflo(a.x) + bflo(b.x)); v[j].y += gg.y * (bfhi(a.x) + bfhi(b.x)); v[j].z += gg.z * (bflo(a.y) + bflo(b.y)); v[j].w += gg.w * (bfhi(a.y) + bfhi(b.y)); }
            if (MODE == 2) {
#pragma unroll
                for (int j = 0; j < 8; ++j) *(f32x4*)(xbuf + (size_t)r * 2048 + 4 * lane + 256 * j) = v[j];
            }
        }
#pragma unroll
        for (int j = 0; j < 8; ++j) ss += (v[j].x * v[j].x + v[j].y * v[j].y) + (v[j].z * v[j].z + v[j].w * v[j].w);
        ss = wave_sum(ss);
        const float rs = 1.0f / sqrtf(ss * (1.0f / 2048.0f) + EPS);
        if (MODE == 3) {
#pragma unroll
            for (int j = 0; j < 8; ++j) { const int c = 4 * lane + 256 * j; const f32x4 gg = *(const f32x4*)(gvec + c); *(f32x4*)(dout + (size_t)r * 2048 + c) = v[j] * rs * gg; }
            continue;
        }
        const int lm = (MODE == 2) ? 1 : l;
        const float* sh = modp(F, lm, m, MODE == 1 ? 3 : 0); const float* sc = modp(F, lm, m, MODE == 1 ? 4 : 1);
#pragma unroll
        for (int j = 0; j < 8; ++j) { const int c = 4 * lane + 256 * j; const f32x4 gg = *(const f32x4*)(gvec + c), s1 = *(const f32x4*)(sc + c), s0 = *(const f32x4*)(sh + c);
            v[j] = (v[j] * rs * gg) * (1.0f + s1) + s0;
            v2u o; o.x = pk2(v[j].x, v[j].y); o.y = pk2(v[j].z, v[j].w); *(v2u*)(ha + (size_t)r * 2048 + c) = o; }
    }
}

__device__ __forceinline__ void ffn_norm_router_phase(Frame& F, int l) {
    const int nrows = (l == 1) ? TL : TT;
    const float* xbuf = WSP(float, WS_X); bf16* ha = WSP(bf16, WS_HA);
    const float* gvec = INP(7) + l * 2048;
    const float* wrt = WSP(float, WS_WRT) + (size_t)l * 72 * 2048;
    LAS float* hl = (LAS float*)F.lds;
    LAS float* lg = (LAS float*)(F.lds + 131584);
    const int lane = F.lane, tid = F.tid, l31 = lane & 31, lh = lane >> 5;
    for (int it = F.bid; it < nrows / 32; it += F.G) {
        const int r0 = it * 32 + F.wave * 4;
        f32x4 v[4][8];
#pragma unroll
        for (int rr = 0; rr < 4; ++rr)
#pragma unroll
            for (int j = 0; j < 8; ++j) v[rr][j] = *(const f32x4*)(xbuf + (size_t)(r0 + rr) * 2048 + 4 * lane + 256 * j);
        const int m = row_stream(r0);
        const float* sh = modp(F, l, m, 3); const float* sc = modp(F, l, m, 4);
        float rs[4];
#pragma unroll
        for (int rr = 0; rr < 4; ++rr) { float ss = 0.f;
#pragma unroll
            for (int j = 0; j < 8; ++j) ss += (v[rr][j].x * v[rr][j].x + v[rr][j].y * v[rr][j].y) + (v[rr][j].z * v[rr][j].z + v[rr][j].w * v[rr][j].w);
            ss = wave_sum(ss); rs[rr] = 1.0f / sqrtf(ss * (1.0f / 2048.0f) + EPS); }
#pragma unroll
        for (int j = 0; j < 8; ++j) { if ((j & 1) == 0) __builtin_amdgcn_sched_barrier(0); const int c = 4 * lane + 256 * j; const f32x4 gg = *(const f32x4*)(gvec + c), s1 = *(const f32x4*)(sc + c), s0 = *(const f32x4*)(sh + c);
#pragma unroll
            for (int rr = 0; rr < 4; ++rr) { v[rr][j] = (v[rr][j] * rs[rr] * gg) * (1.0f + s1) + s0;
                v2u o; o.x = cvt_pk_bf16(v[rr][j].x, v[rr][j].y); o.y = cvt_pk_bf16(v[rr][j].z, v[rr][j].w); *(v2u*)(ha + (size_t)(r0 + rr) * 2048 + c) = o; } }
        f32x16 acc[3];
#pragma unroll
        for (int nt = 0; nt < 3; ++nt)
#pragma unroll
            for (int r = 0; r < 16; ++r) acc[nt][r] = 0.f;
        const int nr2 = (64 + l31 < 72) ? 64 + l31 : 71;
#pragma unroll
        for (int hK = 0; hK < 2; ++hK) {
#pragma unroll
            for (int rr = 0; rr < 4; ++rr)
#pragma unroll
                for (int j = 0; j < 4; ++j) *(LAS f32x4*)(hl + (F.wave * 4 + rr) * 1028 + 256 * j + 4 * lane) = v[rr][4 * hK + j];
            __syncthreads();
            const LAS float* ap = hl + l31 * 1028 + 128 * F.wave + 4 * lh;
            const float* wp = wrt + 1024 * hK + 128 * F.wave + 4 * lh;
            const float* w0 = wp + (size_t)l31 * 2048; const float* w1 = wp + (size_t)(32 + l31) * 2048; const float* w2 = wp + (size_t)nr2 * 2048;
#pragma nounroll
            for (int jc = 0; jc < 4; ++jc) {
                f32x4 af[4], b0[4], b1[4], b2[4];
#pragma unroll
                for (int jj = 0; jj < 4; ++jj) { const int o = 8 * (4 * jc + jj); b0[jj] = *(const f32x4*)(w0 + o); b1[jj] = *(const f32x4*)(w1 + o); b2[jj] = *(const f32x4*)(w2 + o); af[jj] = *(const LAS f32x4*)(ap + o); }
#pragma unroll
                for (int jj = 0; jj < 4; ++jj)
#pragma unroll
                    for (int c = 0; c < 4; ++c) {
                        acc[0] = __builtin_amdgcn_mfma_f32_32x32x2f32(af[jj][c], b0[jj][c], acc[0], 0, 0, 0);
                        acc[1] = __builtin_amdgcn_mfma_f32_32x32x2f32(af[jj][c], b1[jj][c], acc[1], 0, 0, 0);
                        acc[2] = __builtin_amdgcn_mfma_f32_32x32x2f32(af[jj][c], b2[jj][c], acc[2], 0, 0, 0); }
                asm volatile("" : "+v"(acc[0]), "+v"(acc[1]), "+v"(acc[2]) : "v"(af[0]), "v"(af[1]), "v"(af[2]), "v"(af[3]), "v"(b0[0]), "v"(b0[1]), "v"(b0[2]), "v"(b0[3]),
                             "v"(b1[0]), "v"(b1[1]), "v"(b1[2]), "v"(b1[3]), "v"(b2[0]), "v"(b2[1]), "v"(b2[2]), "v"(b2[3]));
            }
            __syncthreads();
        }
        {
            LAS float* pw = hl + F.wave * (32 * 96);
#pragma unroll
            for (int nt = 0; nt < 3; ++nt)
#pragma unroll
                for (int r = 0; r < 16; ++r) pw[((r & 3) + 8 * (r >> 2) + 4 * lh) * 96 + 32 * nt + l31] = acc[nt][r];
        }
        __syncthreads();
        for (int idx = tid; idx < 32 * 72; idx += NTHREADS) { const int row = idx / 72, col = idx - row * 72; float s = 0.f;
#pragma unroll
            for (int w = 0; w < 8; ++w) s += hl[w * (32 * 96) + row * 96 + col];
            lg[row * 80 + col] = s; }
        __syncthreads();
        if (lane < 4) {
            const int r = r0 + lane; const LAS float* L = lg + (F.wave * 4 + lane) * 80;
            float gl[8]; float gmax = -INFINITY; int gi = 0;
#pragma unroll
            for (int j = 0; j < 8; ++j) { gl[j] = L[j] + INP(37)[l * 8 + j]; if (gl[j] > gmax) { gmax = gl[j]; gi = j; } }
            float gsum = 0.f;
#pragma unroll
            for (int j = 0; j < 8; ++j) gsum += expf(gl[j] - gmax);
            const float pg_top = 1.0f / gsum;
            float pe[8]; float emax = -INFINITY;
#pragma unroll
            for (int j = 0; j < 8; ++j) { pe[j] = L[8 + gi * 8 + j] + INP(39)[l * 64 + gi * 8 + j]; emax = fmaxf(emax, pe[j]); }
            float esum = 0.f;
#pragma unroll
            for (int j = 0; j < 8; ++j) { pe[j] = expf(pe[j] - emax); esum += pe[j]; }
            int e1 = 0; float p1 = -1.f;
#pragma unroll
            for (int j = 0; j < 8; ++j) { pe[j] /= esum; if (pe[j] > p1) { p1 = pe[j]; e1 = j; } }
            int e2 = 0; float p2 = -1.f;
#pragma unroll
            for (int j = 0; j < 8; ++j) { if (j != e1 && pe[j] > p2) { p2 = pe[j]; e2 = j; } }
            const float den = p1 + p2; const float g1 = pg_top * p1 / den, g2 = pg_top * p2 / den;
            unsigned* cnt = WSP(unsigned, WS_CTL) + CW_CNT + l * 64 * CSTR; int* tokl = WSP(int, WS_TOKL); float* gatel = WSP(float, WS_GATEL);
            const int ex1 = gi * 8 + e1, ex2 = gi * 8 + e2;
            const unsigned k1 = atomicAdd(cnt + ex1 * CSTR, 1u); tokl[(size_t)ex1 * LISTCAP + k1] = 2 * r; gatel[(size_t)ex1 * LISTCAP + k1] = g1;
            const unsigned k2 = atomicAdd(cnt + ex2 * CSTR, 1u); tokl[(size_t)ex2 * LISTCAP + k2] = 2 * r + 1; gatel[(size_t)ex2 * LISTCAP + k2] = g2;
        }
        __syncthreads();
    }
}

#define EPI_ARGS const f32x4 (&acc)[2][2][4][2], const pg8::Unit& u, int wr, int wc, int fr, int fq
__device__ __forceinline__ void st_bf4(bf16* p, f32x4 v) { v2u o; o.x = cvt_pk_bf16(v.x, v.y); o.y = cvt_pk_bf16(v.z, v.w); *(v2u*)p = o; }
__device__ __forceinline__ void st_bf8(bf16* p, f32x4 a, f32x4 b) { v4u o; o.x = cvt_pk_bf16(a.x, a.y); o.y = cvt_pk_bf16(a.z, a.w); o.z = cvt_pk_bf16(b.x, b.y); o.w = cvt_pk_bf16(b.z, b.w); *(v4u*)p = o; }

struct EpiQKP {
    static constexpr bool PERM = false;
    bf16* Q; bf16* Kb; bf16* P; const f32x2* rope;
    __device__ __forceinline__ void operator()(EPI_ARGS) const {
        const int sect = u.pn >> 2, cb = (u.pn & 3) * 256; const bool latent = u.pm < TL / 256;
#pragma unroll
        for (int ai = 0; ai < 2; ++ai)
#pragma unroll
            for (int m = 0; m < 4; ++m) {
                const int r = u.pm * 256 + ai * 128 + wr * 64 + m * 16 + fr;
                int b, t; if (latent) { b = r / SEQ; t = r % SEQ; } else { b = (r - TL) / CTX; t = (r - TL) % CTX; }
                f32x4 cs0 = {1.f, 0.f, 1.f, 0.f}, cs1 = cs0;
                if (latent && sect < 2) { const int pos = (wc & 1) ? (t & 63) : (t >> 6); const f32x4* rp = (const f32x4*)(rope + pos * 16 + 4 * fq); cs0 = rp[0]; cs1 = rp[1]; }
#pragma unroll
                for (int bj = 0; bj < 2; ++bj) {
                    const int c0 = cb + bj * 128 + wc * 32 + 4 * fq;
                    f32x4 a = acc[ai][bj][m][0], bb = acc[ai][bj][m][1];
                    if (sect < 2) {
                        const f32x4 co = {cs0.x, cs0.z, cs1.x, cs1.z}, si = {cs0.y, cs0.w, cs1.y, cs1.w};
                        const f32x4 oa = a * co - bb * si, ob = a * si + bb * co; a = oa; bb = ob;
                    }
                    if (sect == 0) { a = a * QSCALE; bb = bb * QSCALE; bf16* d = Q + (size_t)r * 1024 + c0; st_bf4(d, a); st_bf4(d + 16, bb); }
                    else if (sect == 1) { const size_t kr = (size_t)b * KEYS + (latent ? CTX + t : t); bf16* d = Kb + kr * 1024 + c0; st_bf4(d, a); st_bf4(d + 16, bb); }
                    else { bf16* d = P + (size_t)r * 1024 + c0; st_bf4(d, a); st_bf4(d + 16, bb); }
                }
            }
    }
};
struct EpiVT {
    static constexpr bool PERM = false;
    bf16* VT;
    __device__ __forceinline__ void operator()(EPI_ARGS) const {
        const bool latent = u.pn < TL / 256; const int b = latent ? u.pn / 32 : u.pn - TL / 256; const int key_t0 = latent ? CTX + (u.pn % 32) * 256 : 0;
        const int kperm = 8 * (fq & 1) + 4 * (fq >> 1);
#pragma unroll
        for (int ai = 0; ai < 2; ++ai)
#pragma unroll
            for (int m = 0; m < 4; ++m) {
                const int rr = u.pm * 256 + ai * 128 + wr * 64 + m * 16 + fr;
                bf16* rowp = VT + ((size_t)b * 1024 + rr) * KEYS + key_t0;
#pragma unroll
                for (int bj = 0; bj < 2; ++bj)
#pragma unroll
                    for (int n = 0; n < 2; ++n) st_bf4(rowp + bj * 128 + wc * 32 + 16 * n + kperm, acc[ai][bj][m][n]);
            }
    }
};
struct EpiScaleBf16 {
    static constexpr bool PERM = true;
    bf16* O; int ldo, coff; const float* cscale;
    __device__ __forceinline__ void operator()(EPI_ARGS) const {
#pragma unroll
        for (int bj = 0; bj < 2; ++bj) { const int c = u.pn * 256 + bj * 128 + wc * 32 + 8 * fq; const f32x4 s0 = *(const f32x4*)(cscale + c), s1 = *(const f32x4*)(cscale + c + 4);
#pragma unroll
            for (int ai = 0; ai < 2; ++ai)
#pragma unroll
                for (int m = 0; m < 4; ++m) { const int r = u.pm * 256 + ai * 128 + wr * 64 + m * 16 + fr; st_bf8(O + (size_t)r * ldo + coff + c, acc[ai][bj][m][0] * s0, acc[ai][bj][m][1] * s1); } }
    }
};
struct EpiBf16 {
    static constexpr bool PERM = true;
    bf16* O; int ldo;
    __device__ __forceinline__ void operator()(EPI_ARGS) const {
#pragma unroll
        for (int ai = 0; ai < 2; ++ai)
#pragma unroll
            for (int m = 0; m < 4; ++m) { const int r = u.pm * 256 + ai * 128 + wr * 64 + m * 16 + fr; bf16* rowp = O + (size_t)r * ldo + u.pn * 256 + wc * 32 + 8 * fq;
#pragma unroll
                for (int bj = 0; bj < 2; ++bj) st_bf8(rowp + bj * 128, acc[ai][bj][m][0], acc[ai][bj][m][1]); }
    }
};
struct EpiRes {
    static constexpr bool PERM = false;
    const float* xlat; const float* xctx; float* xout; const float* gate0;
    __device__ __forceinline__ void operator()(EPI_ARGS) const {
        const bool latent = u.pm < TL / 256;
#pragma unroll
        for (int ai = 0; ai < 2; ++ai)
#pragma unroll
            for (int m = 0; m < 4; ++m) { const int r = u.pm * 256 + ai * 128 + wr * 64 + m * 16 + fr; const int ms = latent ? r / SEQ : 2;
                const float* xi = latent ? xlat + (size_t)r * 2048 : xctx + (size_t)(r - TL) * 2048; const float* gp = gate0 + (size_t)ms * 12288;
#pragma unroll
                for (int bj = 0; bj < 2; ++bj)
#pragma unroll
                    for (int n = 0; n < 2; ++n) { const int c = u.pn * 256 + bj * 128 + wc * 32 + 16 * n + 4 * fq;
                        const f32x4 xv = *(const f32x4*)(xi + c), gv = *(const f32x4*)(gp + c); *(f32x4*)(xout + (size_t)r * 2048 + c) = xv + gv * acc[ai][bj][m][n]; } }
    }
};
struct EpiMoeUp {
    static constexpr bool PERM = false;
    bf16* H;
    __device__ __forceinline__ void operator()(EPI_ARGS) const {
#pragma unroll
        for (int ai = 0; ai < 2; ++ai)
#pragma unroll
            for (int m = 0; m < 4; ++m) { const size_t r = (size_t)u.pm * 256 + ai * 128 + wr * 64 + m * 16 + fr;
#pragma unroll
                for (int bj = 0; bj < 2; ++bj) { const int hc = (u.pn * 256 + bj * 128 + wc * 32) / 2 + 4 * fq; const f32x4 a = acc[ai][bj][m][0], b = acc[ai][bj][m][1];
                    const f32x4 h = {siluf_(a.x) * b.x, siluf_(a.y) * b.y, siluf_(a.z) * b.z, siluf_(a.w) * b.w}; st_bf4(H + r * 512 + hc, h); } }
    }
};
struct EpiMoeDown {
    static constexpr bool PERM = true;
    bf16* Y; const int* tokl; const float* gatel; const unsigned* cnt;
    __device__ __forceinline__ void operator()(EPI_ARGS) const {
        const int ce = (int)cnt[u.e * CSTR];
#pragma unroll
        for (int ai = 0; ai < 2; ++ai)
#pragma unroll
            for (int m = 0; m < 4; ++m) { const int idx = u.idx0 + ai * 128 + wr * 64 + m * 16 + fr;
                if (idx < ce) { const int pair = tokl[(size_t)u.e * LISTCAP + idx]; const float gt = gatel[(size_t)u.e * LISTCAP + idx]; bf16* rowp = Y + (size_t)pair * 2048 + u.pn * 256 + wc * 32 + 8 * fq;
#pragma unroll
                    for (int bj = 0; bj < 2; ++bj) st_bf8(rowp + bj * 128, acc[ai][bj][m][0] * gt, acc[ai][bj][m][1] * gt); } }
    }
};
struct EpiGlu {
    static constexpr bool PERM = true;
    bf16* O; int ldo, coff; const bf16* Gb; const float* bias;
    __device__ __forceinline__ void operator()(EPI_ARGS) const {
#pragma unroll
        for (int ai = 0; ai < 2; ++ai)
#pragma unroll
            for (int m = 0; m < 4; ++m) { const int r = u.pm * 256 + ai * 128 + wr * 64 + m * 16 + fr;
#pragma unroll
                for (int bj = 0; bj < 2; ++bj) { const int c = u.pn * 256 + bj * 128 + wc * 32 + 8 * fq; const f32x4 b0 = *(const f32x4*)(bias + c), b1 = *(const f32x4*)(bias + c + 4); const v4u gw = *(const v4u*)(Gb + (size_t)r * 1024 + c);
                    const f32x4 a0 = acc[ai][bj][m][0] + b0, a1 = acc[ai][bj][m][1] + b1;
                    const f32x4 o0 = {bflo(gw.x) * sigmoidf_(a0.x), bfhi(gw.x) * sigmoidf_(a0.y), bflo(gw.y) * sigmoidf_(a0.z), bfhi(gw.y) * sigmoidf_(a0.w)};
                    const f32x4 o1 = {bflo(gw.z) * sigmoidf_(a1.x), bfhi(gw.z) * sigmoidf_(a1.y), bflo(gw.w) * sigmoidf_(a1.z), bfhi(gw.w) * sigmoidf_(a1.w)};
                    st_bf8(O + (size_t)r * ldo + coff + c, o0, o1); } }
    }
};

struct MoeOrder {
    const LAS int* bstart;
    const unsigned* cnt; const int* tokl; int nN, G, c, nblk; long bstride, eoff; bool up;
    __device__ bool next(int i, pg8::Unit& u) const {
        const long Lx = (long)i * G + c; if (Lx >= (long)nblk * nN) return false;
        const int blk = (int)(Lx / nN); u.pn = (int)(Lx % nN); u.pm = blk;
        const int e = bstart[65 + blk];
        u.e = e; u.idx0 = (blk - bstart[e]) * 256;
        u.aoff = up ? 0 : (long)blk * 256 * 512 * 2;
        u.boff = (long)e * (long)MOE_E_BYTES + eoff + (long)u.pn * bstride;
        return true;
    }
    __device__ int arow(const pg8::Unit& u, int row) const { const int idx = u.idx0 + row; return idx < (int)cnt[u.e * CSTR] ? (tokl[(size_t)u.e * LISTCAP + idx] >> 1) : TT; }
};

__device__ __forceinline__ void tile_order(int wgid, int nM, int nN, int& pm, int& pn) {
    const int nwg = nM * nN; { const int q = nwg / 8, r = nwg % 8, xcd = wgid % 8, off = wgid / 8; wgid = (xcd < r ? xcd * (q + 1) : r * (q + 1) + (xcd - r) * q) + off; }
    const int nig = 8 * nN, gid = wgid / nig, fm = gid * 8, gsz = (nM - fm) < 8 ? (nM - fm) : 8;
    pm = fm + ((wgid % nig) % gsz); pn = (wgid % nig) / gsz;
}
struct InProj0Order {
    int G, c; long offA1, offB1, offA2, offB2;
    __device__ bool next(int i, pg8::Unit& u) const {
        const int Lx = i * G + c; constexpr int N1 = (TT / 256) * 12, N2 = 4 * (TT / 256); constexpr long TS = 256L * 2048 * 2;
        if (Lx >= N1 + N2) return false;
        u.idx0 = 0;
        if (Lx < N1) { tile_order(Lx, TT / 256, 12, u.pm, u.pn); u.aoff = offA1 + (long)u.pm * TS; u.boff = offB1 + (long)u.pn * TS; u.e = 0; }
        else { tile_order(Lx - N1, 4, TT / 256, u.pm, u.pn); u.aoff = offA2 + (long)u.pm * TS; u.boff = offB2 + (long)u.pn * TS; u.e = 1; }
        return true;
    }
    __device__ int arow(const pg8::Unit&, int) const { return 0; }
};
struct EpiInProj0 {
    static constexpr bool PERM = false;
    EpiQKP e1; EpiVT e2;
    __device__ __forceinline__ void operator()(EPI_ARGS) const { if (u.e == 0) e1(acc, u, wr, wc, fr, fq); else e2(acc, u, wr, wc, fr, fq); }
};

#ifdef ATT_NORARE
#define ATT_RARE(mx) false
#else
#define ATT_RARE(mx) __any(mx > 8.0f)
#endif
__device__ __forceinline__ float xhalf_max(float v) {
    const auto r = __builtin_amdgcn_permlane32_swap(__builtin_bit_cast(unsigned, v), __builtin_bit_cast(unsigned, v), false, false);
    return fmaxf(__builtin_bit_cast(float, r[0]), __builtin_bit_cast(float, r[1]));
}
__device__ __forceinline__ void attn_phase(Frame& F, const int cvslot) {
    const bf16* Q = WSP(bf16, WS_Q); const bf16* Kb = WSP(bf16, WS_K); const bf16* VT = WSP(bf16, WS_VT); bf16* cat = WSP(bf16, WS_CAT);
    LAS unsigned char* lds = F.lds;
    const int lane0 = F.lane;
    float lam;
    { const float* lv = INP(11); float a = lv[lane0] * lv[64 + lane0], b = lv[128 + lane0] * lv[192 + lane0]; a = wave_sum(a); b = wave_sum(b); lam = expf(a) - expf(b) + 0.2f; }
    const float* subg = INP(12);
    const int NU = 1024 + 32;
    const int xcd = F.bid & 7, jcu = F.bid >> 3;
    for (int it = 0;; ++it) {
        if (it == cvslot) { for (int rep_ = 0; rep_ < (((PH_REPEAT >> 26) & 1u) ? 2 : 1); ++rep_) { moe_convert_items(F); __syncthreads(); } }
        int tl_ = F.tid; asm volatile("" : "+v"(tl_));
        const int lane = tl_ & 63, w = __builtin_amdgcn_readfirstlane(tl_ >> 6), sub = w & 1, qw = w >> 1, r32 = lane & 31, hi = lane >> 5;
        int uidx;
        if (F.G == 256) { if (it < 4) uidx = 128 * xcd + it * 32 + jcu; else if (it == 4 && F.bid < 32) uidx = 1024 + F.bid; else break; }
        else { uidx = it * F.G + F.bid; if (uidx >= NU) break; }
        int b, head, q0row, nt; size_t kbase;
        if (uidx < 1024) { const int combo = uidx >> 6, qb = uidx & 63; b = combo >> 3; head = combo & 7; q0row = b * SEQ + qb * 128; nt = KEYS / 64; }
        else { const int v = uidx - 1024; b = v >> 4; head = (v >> 1) & 7; q0row = TL + b * CTX + (v & 1) * 128; nt = CTX / 64; }
        kbase = (size_t)b * KEYS;
        bf16x8 qf[4];
        { const bf16* qp = Q + (size_t)(q0row + qw * 32 + r32) * 1024 + head * 128 + sub * 64 + hi * 8;
#pragma unroll
          for (int ks = 0; ks < 4; ++ks) qf[ks] = *(const bf16x8*)(qp + ks * 16); }
        const char* gsrc[4];
#pragma unroll
        for (int j = 0; j < 4; ++j) { const int pi = w * 4 + j, rr = lane >> 3, pc = lane & 7;
            if (pi < 16) { const int key = (pi & 7) * 8 + rr, c = pc ^ ((key >> 1) & 7); gsrc[j] = (const char*)(Kb + (kbase + key) * 1024 + head * 128 + (pi >> 3) * 64 + c * 8); }
            else { const int dvr = (pi - 16) * 8 + rr, c = pc ^ ((dvr >> 1) & 7); gsrc[j] = (const char*)(VT + ((size_t)(b * 8 + head) * 128 + dvr) * KEYS + c * 8); } }
        const size_t gstep = (w < 4) ? (size_t)65536 * 2 : (size_t)64 * 2;
        const unsigned ldst = (unsigned)w * 4096u;
#define ATT_DMA(t, buf) do { _Pragma("unroll") for (int _j = 0; _j < 4; ++_j) \
            __builtin_amdgcn_global_load_lds((const unsigned*)(gsrc[_j] + (size_t)(t) * gstep), (LAS unsigned*)(lds + (buf) * 32768 + ldst + _j * 1024), 16, 0, 0); } while (0)
        ATT_DMA(0, 0); ATT_DMA(1, 1); ATT_DMA(2, 2);
        asm volatile("s_waitcnt vmcnt(4)" ::: "memory");
        __builtin_amdgcn_s_barrier();
        f32x16 o[4];
#pragma unroll
        for (int d = 0; d < 4; ++d)
#pragma unroll
            for (int r = 0; r < 16; ++r) o[d][r] = 0.f;
        float mref = 0.f, lrow = 0.f;
        f32x16 negm;
#pragma unroll
        for (int r = 0; r < 16; ++r) negm[r] = 0.f;
        const int rdoff = r32 * 128;
        const int swz = (r32 >> 1) & 7;
        f32x16 s0, s1; bf16x8 pf[4];
#define ATT_QK(bufidx) do { const LAS unsigned char* kp_ = lds + (bufidx) * 32768 + sub * 8192; bf16x8 kfa[4], kfb[4]; \
            _Pragma("unroll") for (int ks = 0; ks < 4; ++ks) { const int ch = ((2 * ks + hi) ^ swz) * 16; kfa[ks] = *(const LAS bf16x8*)(kp_ + rdoff + ch); kfb[ks] = *(const LAS bf16x8*)(kp_ + 4096 + rdoff + ch); } \
            s0 = negm; s1 = negm; \
            _Pragma("unroll") for (int ks = 0; ks < 4; ++ks) { s0 = __builtin_amdgcn_mfma_f32_32x32x16_bf16(kfa[ks], qf[ks], s0, 0, 0, 0); s1 = __builtin_amdgcn_mfma_f32_32x32x16_bf16(kfb[ks], qf[ks], s1, 0, 0, 0); } \
            asm volatile("" : "+v"(s0), "+v"(s1) : "v"(kfa[0]), "v"(kfa[1]), "v"(kfa[2]), "v"(kfa[3]), "v"(kfb[0]), "v"(kfb[1]), "v"(kfb[2]), "v"(kfb[3])); } while (0)
#define ATT_MAX(mx) do { float mxa = fmaxf(fmaxf(s0[0], s0[1]), s0[2]), mxb = fmaxf(fmaxf(s1[0], s1[1]), s1[2]); \
            _Pragma("unroll") for (int r = 3; r < 15; r += 2) { mxa = fmaxf(fmaxf(mxa, s0[r]), s0[r + 1]); mxb = fmaxf(fmaxf(mxb, s1[r]), s1[r + 1]); } \
            mx = fmaxf(fmaxf(mxa, mxb), fmaxf(s0[15], s1[15])); mx = xhalf_max(mx); } while (0)
#define ATT_FIX(mx) do { const float dl = fmaxf(mx, 0.f); mref += dl; const float alpha = __builtin_amdgcn_exp2f(-dl); lrow *= alpha; \
            _Pragma("unroll") for (int r = 0; r < 16; ++r) { s0[r] -= dl; s1[r] -= dl; negm[r] = -mref; } \
            _Pragma("unroll") for (int d = 0; d < 4; ++d) _Pragma("unroll") for (int r = 0; r < 16; ++r) o[d][r] *= alpha; } while (0)
#define ATT_EXP8(S, base, dst) do { float rs_ = 0.f; _Pragma("unroll") for (int r = 0; r < 8; ++r) { S[base + r] = __builtin_amdgcn_exp2f(S[base + r]); rs_ += S[base + r]; } lrow += rs_; \
            v4u pw_; pw_.x = cvt_pk_bf16(S[base + 0], S[base + 1]); pw_.y = cvt_pk_bf16(S[base + 2], S[base + 3]); pw_.z = cvt_pk_bf16(S[base + 4], S[base + 5]); pw_.w = cvt_pk_bf16(S[base + 6], S[base + 7]); dst = __builtin_bit_cast(bf16x8, pw_); } while (0)
#define ATT_VLD(dstv, vp_, s) do { _Pragma("unroll") for (int d = 0; d < 4; ++d) dstv[d] = *(const LAS bf16x8*)(vp_ + d * 4096 + rdoff + (((2 * (s) + hi) ^ swz) * 16)); } while (0)
#define ATT_PV4(srcv, pfrag) do { _Pragma("unroll") for (int d = 0; d < 4; ++d) o[d] = __builtin_amdgcn_mfma_f32_32x32x16_bf16(srcv[d], pfrag, o[d], 0, 0, 0); } while (0)
        { ATT_QK(0); float mx; ATT_MAX(mx); if (__any(mx > 8.0f)) ATT_FIX(mx);
          ATT_EXP8(s0, 0, pf[0]); ATT_EXP8(s0, 8, pf[1]); ATT_EXP8(s1, 0, pf[2]); ATT_EXP8(s1, 8, pf[3]); }
        int bcur = 0;
#pragma nounroll
        for (int t = 0; t < nt; ++t) {
            const int bn1 = (bcur + 1) & 3, bn3 = (bcur + 3) & 3;
            if (t + 3 < nt) ATT_DMA(t + 3, bn3);
            const LAS unsigned char* vp = lds + bcur * 32768 + 16384;
            bf16x8 vfa[4], vfb[4];
            if (t + 1 < nt) {
                __builtin_amdgcn_sched_barrier(0);
                ATT_QK(bn1);
                float mx; ATT_MAX(mx);
                __builtin_amdgcn_sched_barrier(0);
                if (__any(mx > 8.0f)) {
                    const float dl = fmaxf(mx, 0.f); mref += dl; const float alpha = __builtin_amdgcn_exp2f(-dl); lrow *= alpha;
#pragma unroll
                    for (int r = 0; r < 16; ++r) { s0[r] -= dl; s1[r] -= dl; negm[r] = -mref; }
#pragma unroll
                    for (int d = 0; d < 4; ++d)
#pragma unroll
                        for (int r = 0; r < 16; ++r) o[d][r] *= alpha;
#pragma unroll
                    for (int s = 0; s < 4; ++s) { v4u pw = __builtin_bit_cast(v4u, pf[s]);
                        pw.x = cvt_pk_bf16(bflo(pw.x) * alpha, bfhi(pw.x) * alpha); pw.y = cvt_pk_bf16(bflo(pw.y) * alpha, bfhi(pw.y) * alpha);
                        pw.z = cvt_pk_bf16(bflo(pw.z) * alpha, bfhi(pw.z) * alpha); pw.w = cvt_pk_bf16(bflo(pw.w) * alpha, bfhi(pw.w) * alpha); pf[s] = __builtin_bit_cast(bf16x8, pw); }
                }
                __builtin_amdgcn_sched_barrier(0);
                {
                    ATT_VLD(vfa, vp, 0);
                    __builtin_amdgcn_sched_barrier(0);
                    ATT_VLD(vfb, vp, 1); ATT_PV4(vfa, pf[0]); ATT_EXP8(s0, 0, pf[0]);
                    __builtin_amdgcn_sched_barrier(0);
                    ATT_VLD(vfa, vp, 2); ATT_PV4(vfb, pf[1]); ATT_EXP8(s0, 8, pf[1]);
                    __builtin_amdgcn_sched_barrier(0);
                    ATT_VLD(vfb, vp, 3); ATT_PV4(vfa, pf[2]); ATT_EXP8(s1, 0, pf[2]);
                    __builtin_amdgcn_sched_barrier(0);
                    ATT_PV4(vfb, pf[3]); ATT_EXP8(s1, 8, pf[3]);
                }
                __builtin_amdgcn_sched_barrier(0);
            } else {
#pragma unroll
                for (int s = 0; s < 4; ++s) { ATT_VLD(vfa, vp, s); ATT_PV4(vfa, pf[s]); }
            }
            if (t + 3 < nt) asm volatile("s_waitcnt vmcnt(4) lgkmcnt(0)" ::: "memory"); else asm volatile("s_waitcnt vmcnt(0) lgkmcnt(0)" ::: "memory");
            __builtin_amdgcn_s_barrier();
            bcur = bn1;
        }
#undef ATT_DMA
#undef ATT_QK
#undef ATT_MAX
#undef ATT_FIX
#undef ATT_EXP8
#undef ATT_VLD
#undef ATT_PV4
        const float ltot = lrow + __shfl_xor(lrow, 32); const float linv = 1.0f / ltot;
        LAS float* xch = (LAS float*)lds + (size_t)(qw * 32 + r32) * 132;
        if (sub == 1) {
#pragma unroll
            for (int d = 0; d < 4; ++d)
#pragma unroll
                for (int g = 0; g < 4; ++g) *(LAS f32x4*)(xch + 32 * d + 8 * g + 4 * hi) = (f32x4){o[d][4 * g] * linv, o[d][4 * g + 1] * linv, o[d][4 * g + 2] * linv, o[d][4 * g + 3] * linv};
        }
        __syncthreads();
        if (sub == 0) {
            float ss = 0.f;
#pragma unroll
            for (int d = 0; d < 4; ++d)
#pragma unroll
                for (int g = 0; g < 4; ++g) { const f32x4 o2 = *(const LAS f32x4*)(xch + 32 * d + 8 * g + 4 * hi);
#pragma unroll
                    for (int j = 0; j < 4; ++j) { const float v = o[d][4 * g + j] * linv - lam * o2[j]; o[d][4 * g + j] = v; ss += v * v; } }
            ss += __shfl_xor(ss, 32);
            const float rn = 0.8f / sqrtf(ss * (1.0f / 128.0f) + EPS);
            bf16* op = cat + (size_t)(q0row + qw * 32 + r32) * 2048 + head * 128;
#pragma unroll
            for (int d = 0; d < 4; ++d)
#pragma unroll
                for (int g = 0; g < 4; ++g) { const int dv = 32 * d + 8 * g + 4 * hi; const f32x4 gg = *(const f32x4*)(subg + dv);
                    st_bf4(op + dv, (f32x4){o[d][4 * g] * rn * gg.x, o[d][4 * g + 1] * rn * gg.y, o[d][4 * g + 2] * rn * gg.z, o[d][4 * g + 3] * rn * gg.w}); }
        }
        __syncthreads();
    }
}

__device__ __forceinline__ void poold_phase(Frame& F) {
    const bf16* P = WSP(bf16, WS_P); bf16* PD = WSP(bf16, WS_PD);
    const int gt = F.bid * NTHREADS + F.tid, NGT = F.G * NTHREADS;
    for (int idx = gt; idx < TT * 128; idx += NGT) {
        const int r = idx >> 7, cc = (idx & 127) * 8, g = cc >> 8, wdw = 2 << g;
        int sb, t, Ls; if (r < TL) { sb = (r / SEQ) * SEQ; t = r % SEQ; Ls = SEQ; } else { sb = TL + ((r - TL) / CTX) * CTX; t = (r - TL) % CTX; Ls = CTX; }
        int lo = t - wdw / 2, hi = lo + wdw; lo = lo < 0 ? 0 : lo; hi = hi > Ls ? Ls : hi;
        float a[8];
#pragma unroll
        for (int j = 0; j < 8; ++j) a[j] = 0.f;
        for (int s = lo; s < hi; ++s) { const v4u v = *(const v4u*)(P + (size_t)(sb + s) * 1024 + cc);
            a[0] += bflo(v.x); a[1] += bfhi(v.x); a[2] += bflo(v.y); a[3] += bfhi(v.y); a[4] += bflo(v.z); a[5] += bfhi(v.z); a[6] += bflo(v.w); a[7] += bfhi(v.w); }
        const float inv = 1.0f / (float)(hi - lo);
        const v4u me = *(const v4u*)(P + (size_t)r * 1024 + cc);
        v4u o; o.x = pk2(a[0] * inv - bflo(me.x), a[1] * inv - bfhi(me.x)); o.y = pk2(a[2] * inv - bflo(me.y), a[3] * inv - bfhi(me.y));
        o.z = pk2(a[4] * inv - bflo(me.z), a[5] * inv - bfhi(me.z)); o.w = pk2(a[6] * inv - bflo(me.w), a[7] * inv - bfhi(me.w));
        *(v4u*)(PD + (size_t)r * 1024 + cc) = o;
    }
}

__device__ __forceinline__ void shortconv_phase(Frame& F) {
    const bf16* PJ = WSP(bf16, WS_PROJ1); float* GT = WSP(float, WS_GT);
    const float* cw = INP(17); const float* cb = INP(18);
    LAS float* scr = (LAS float*)(F.lds + F.wave * 17408);
    const int lane = F.lane;
    for (int it = F.gw; it < 2 * 128 * 48; it += F.NGW) {
        const int cbk = it % 48, tb = (it / 48) % 128, b = it / (48 * 128), col = cbk * 64 + lane, t0 = tb * 64;
        const bf16* base = PJ + ((size_t)b * SEQ) * 4096 + cbk * 64 + (lane & 7) * 8;
#pragma unroll
        for (int i = 0; i < 9; ++i) { const int row = 8 * i + (lane >> 3); const int t = t0 - 1 + row;
            if (row < 66) { v4u v = {0u, 0u, 0u, 0u}; if (t >= 0 && t < SEQ) v = *(const v4u*)(base + (size_t)t * 4096);
                LAS float* d = scr + row * 65 + (lane & 7) * 8; d[0] = bflo(v.x); d[1] = bfhi(v.x); d[2] = bflo(v.y); d[3] = bfhi(v.y); d[4] = bflo(v.z); d[5] = bfhi(v.z); d[6] = bflo(v.w); d[7] = bfhi(v.w); } }
        LDS_WAIT(); asm volatile("" ::: "memory");
        const float w0 = cw[col], w1 = cw[3072 + col], w2 = cw[2 * 3072 + col], bias = cb[col];
        float prev = scr[lane], cur = scr[65 + lane];
#pragma unroll 8
        for (int tt = 0; tt < 64; ++tt) { const float nxt = scr[(tt + 2) * 65 + lane]; const float o = prev * w0 + cur * w1 + nxt * w2 + bias; scr[tt * 65 + lane] = o; prev = cur; cur = nxt; }
        LDS_WAIT(); asm volatile("" ::: "memory");
        for (int c = 0; c < 64; ++c) GT[((size_t)(cbk * 64 + c) * 2 + b) * SEQ + t0 + lane] = scr[lane * 65 + c];
        LDS_WAIT(); asm volatile("" ::: "memory");
    }
}

__device__ __forceinline__ void s5_gelu_phase(Frame& F) {
    const bf16* PJ = WSP(bf16, WS_PROJ1); const float* YD = WSP(float, WS_YD); bf16* Gb = WSP(bf16, WS_PD); const float* dd = INP(33);
    const int gt = F.bid * NTHREADS + F.tid, NGT = F.G * NTHREADS;
    for (int idx = gt; idx < TL * 256; idx += NGT) { const int r = idx >> 8, c = (idx & 255) * 4;
        const v2u uw = *(const v2u*)(PJ + (size_t)r * 4096 + 3072 + c); const f32x4 d4 = *(const f32x4*)(dd + c);
        const int bb = r / SEQ, tt = r % SEQ, gg = c >> 4, cc = c & 15;
        const f32x4 y0 = *(const f32x4*)(YD + (((size_t)(0 * 2 + bb) * 64 + gg) * SEQ + tt) * 16 + cc), y1 = *(const f32x4*)(YD + (((size_t)(1 * 2 + bb) * 64 + gg) * SEQ + tt) * 16 + cc);
        const f32x4 y = {bflo(uw.x) * d4.x + y0.x + y1.x, bfhi(uw.x) * d4.y + y0.y + y1.y, bflo(uw.y) * d4.z + y0.z + y1.z, bfhi(uw.y) * d4.w + y0.w + y1.w};
        st_bf4(Gb + (size_t)r * 1024 + c, (f32x4){gelu_tanh(y.x), gelu_tanh(y.y), gelu_tanh(y.z), gelu_tanh(y.w)}); }
}

__device__ __forceinline__ f32x2 cmulf(f32x2 a, f32x2 b) { return (f32x2){a.x * b.x - a.y * b.y, a.x * b.y + a.y * b.x}; }
__device__ __forceinline__ int drev14(int p) { const unsigned r = __builtin_bitreverse32((unsigned)p) >> 18; return (int)(((r & 0x2AAAu) >> 1) | ((r & 0x1555u) << 1)); }
template <int L, bool ZHI>
__device__ __forceinline__ void fft_fwd_pass(LAS f32x2* X, const f32x2* tw, int tid) {
    constexpr int tws = 4096 / L;
    if constexpr (L == 1) {
#pragma unroll 2
        for (int i = 0; i < 8; ++i) { const int i0 = (tid + NTHREADS * i) * 4;
            const f32x4 p01 = *(const LAS f32x4*)(X + i0), p23 = *(const LAS f32x4*)(X + i0 + 2);
            const f32x2 x0 = {p01.x, p01.y}, x1 = {p01.z, p01.w}, x2 = {p23.x, p23.y}, x3 = {p23.z, p23.w};
            const f32x2 a = x0 + x2, bb = x0 - x2, c = x1 + x3, d = x1 - x3;
            const f32x2 y0 = a + c, y1 = {bb.x + d.y, bb.y - d.x}, y2 = a - c, y3 = {bb.x - d.y, bb.y + d.x};
            *(LAS f32x4*)(X + i0) = (f32x4){y0.x, y0.y, y1.x, y1.y}; *(LAS f32x4*)(X + i0 + 2) = (f32x4){y2.x, y2.y, y3.x, y3.y}; }
        LDS_BARRIER();
        return;
    }
#pragma unroll 2
    for (int i = 0; i < 8; ++i) {
        const int b = tid + NTHREADS * i, j = b & (L - 1), i0 = (b - j) * 4 + j;
        const f32x2 w1 = tw[j * tws], w2 = cmulf(w1, w1), w3 = cmulf(w2, w1);
        const f32x2 x0 = X[i0], x1 = X[i0 + L];
        if (ZHI) {
            const f32x2 t1 = {x0.x + x1.y, x0.y - x1.x}, t3 = {x0.x - x1.y, x0.y + x1.x};
            X[i0] = x0 + x1; X[i0 + L] = cmulf(t1, w1); X[i0 + 2 * L] = cmulf(x0 - x1, w2); X[i0 + 3 * L] = cmulf(t3, w3);
        } else {
            const f32x2 x2 = X[i0 + 2 * L], x3 = X[i0 + 3 * L];
            const f32x2 a = x0 + x2, bb = x0 - x2, c = x1 + x3, d = x1 - x3;
            const f32x2 t1 = {bb.x + d.y, bb.y - d.x}, t3 = {bb.x - d.y, bb.y + d.x};
            X[i0] = a + c; X[i0 + L] = cmulf(t1, w1); X[i0 + 2 * L] = cmulf(a - c, w2); X[i0 + 3 * L] = cmulf(t3, w3);
        }
    }
    LDS_BARRIER();
}
template <int L>
__device__ __forceinline__ void fft_fwd_pass16(LAS f32x2* X, const f32x2* tw, int tid) {
    constexpr int Q = L / 4, tws = 4096 / L;
    const int jq = tid & (Q - 1);
    f32x2 wa[4][3];
#pragma unroll
    for (int mq = 0; mq < 4; ++mq) { const f32x2 w1 = tw[(mq * Q + jq) * tws]; wa[mq][0] = w1; wa[mq][1] = cmulf(w1, w1); wa[mq][2] = cmulf(wa[mq][1], w1); }
    const f32x2 v1 = tw[jq * 4 * tws], v2 = cmulf(v1, v1), v3 = cmulf(v2, v1);
#pragma unroll
    for (int i = 0; i < 2; ++i) {
        const int u = tid + NTHREADS * i, base = (u / Q) * 4 * L + jq;
        f32x2 pt[4][4];
#pragma unroll
        for (int m = 0; m < 4; ++m)
#pragma unroll
            for (int mq = 0; mq < 4; ++mq) pt[m][mq] = X[base + m * L + mq * Q];
#pragma unroll
        for (int mq = 0; mq < 4; ++mq) {
            const f32x2 x0 = pt[0][mq], x1 = pt[1][mq], x2 = pt[2][mq], x3 = pt[3][mq];
            const f32x2 a = x0 + x2, bb = x0 - x2, c = x1 + x3, d = x1 - x3;
            const f32x2 t1 = {bb.x + d.y, bb.y - d.x}, t3 = {bb.x - d.y, bb.y + d.x};
            pt[0][mq] = a + c; pt[1][mq] = cmulf(t1, wa[mq][0]); pt[2][mq] = cmulf(a - c, wa[mq][1]); pt[3][mq] = cmulf(t3, wa[mq][2]);
        }
#pragma unroll
        for (int m = 0; m < 4; ++m) {
            const f32x2 x0 = pt[m][0], x1 = pt[m][1], x2 = pt[m][2], x3 = pt[m][3];
            const f32x2 a = x0 + x2, bb = x0 - x2, c = x1 + x3, d = x1 - x3;
            const f32x2 t1 = {bb.x + d.y, bb.y - d.x}, t3 = {bb.x - d.y, bb.y + d.x};
            X[base + m * L] = a + c; X[base + m * L + Q] = cmulf(t1, v1); X[base + m * L + 2 * Q] = cmulf(a - c, v2); X[base + m * L + 3 * Q] = cmulf(t3, v3);
        }
    }
    LDS_BARRIER();
}
template <bool ZHI>
__device__ __forceinline__ void fft_fwd(LAS f32x2* X, const f32x2* tw, int tid) {
    fft_fwd_pass<4096, ZHI>(X, tw, tid); fft_fwd_pass16<1024>(X, tw, tid); fft_fwd_pass16<64>(X, tw, tid);
    fft_fwd_pass<4, false>(X, tw, tid); fft_fwd_pass<1, false>(X, tw, tid);
}
template <int L, bool LOHALF>
__device__ __forceinline__ void fft_inv_pass(LAS f32x2* X, const f32x2* tw, int tid) {
    constexpr int tws = 4096 / L;
    if constexpr (L == 1) {
#pragma unroll 2
        for (int i = 0; i < 8; ++i) { const int i0 = (tid + NTHREADS * i) * 4;
            const f32x4 p01 = *(const LAS f32x4*)(X + i0), p23 = *(const LAS f32x4*)(X + i0 + 2);
            const f32x2 x0 = {p01.x, p01.y}, x1 = {p01.z, p01.w}, x2 = {p23.x, p23.y}, x3 = {p23.z, p23.w};
            const f32x2 a = x0 + x2, bb = x0 - x2, c = x1 + x3, d = x1 - x3;
            const f32x2 y0 = a + c, y1 = {bb.x - d.y, bb.y + d.x}, y2 = a - c, y3 = {bb.x + d.y, bb.y - d.x};
            *(LAS f32x4*)(X + i0) = (f32x4){y0.x, y0.y, y1.x, y1.y}; *(LAS f32x4*)(X + i0 + 2) = (f32x4){y2.x, y2.y, y3.x, y3.y}; }
        LDS_BARRIER();
        return;
    }
#pragma unroll 2
    for (int i = 0; i < 8; ++i) {
        const int b = tid + NTHREADS * i, j = b & (L - 1), i0 = (b - j) * 4 + j;
        f32x2 w1 = tw[j * tws]; w1.y = -w1.y; const f32x2 w2 = cmulf(w1, w1), w3 = cmulf(w2, w1);
        const f32x2 x0 = X[i0], x1 = cmulf(X[i0 + L], w1), x2 = cmulf(X[i0 + 2 * L], w2), x3 = cmulf(X[i0 + 3 * L], w3);
        const f32x2 a = x0 + x2, bb = x0 - x2, c = x1 + x3, d = x1 - x3;
        X[i0] = a + c; X[i0 + L] = (f32x2){bb.x - d.y, bb.y + d.x};
        if (!LOHALF) { X[i0 + 2 * L] = a - c; X[i0 + 3 * L] = (f32x2){bb.x + d.y, bb.y - d.x}; }
    }
    LDS_BARRIER();
}
template <int L>
__device__ __forceinline__ void fft_inv_pass16(LAS f32x2* X, const f32x2* tw, int tid) {
    constexpr int tws = 4096 / L, tws4 = 1024 / L;
    const int jq = tid & (L - 1);
    f32x2 v1 = tw[jq * tws]; v1.y = -v1.y; const f32x2 v2 = cmulf(v1, v1), v3 = cmulf(v2, v1);
    f32x2 wb[4][3];
#pragma unroll
    for (int mq = 0; mq < 4; ++mq) { f32x2 w1 = tw[(mq * L + jq) * tws4]; w1.y = -w1.y; wb[mq][0] = w1; wb[mq][1] = cmulf(w1, w1); wb[mq][2] = cmulf(wb[mq][1], w1); }
#pragma unroll
    for (int i = 0; i < 2; ++i) {
        const int u = tid + NTHREADS * i, base = (u / L) * 16 * L + jq;
        f32x2 pt[4][4];
#pragma unroll
        for (int M = 0; M < 4; ++M)
#pragma unroll
            for (int mq = 0; mq < 4; ++mq) pt[M][mq] = X[base + M * 4 * L + mq * L];
#pragma unroll
        for (int M = 0; M < 4; ++M) {
            const f32x2 x0 = pt[M][0], x1 = cmulf(pt[M][1], v1), x2 = cmulf(pt[M][2], v2), x3 = cmulf(pt[M][3], v3);
            const f32x2 a = x0 + x2, bb = x0 - x2, c = x1 + x3, d = x1 - x3;
            pt[M][0] = a + c; pt[M][1] = (f32x2){bb.x - d.y, bb.y + d.x}; pt[M][2] = a - c; pt[M][3] = (f32x2){bb.x + d.y, bb.y - d.x};
        }
#pragma unroll
        for (int mq = 0; mq < 4; ++mq) {
            const f32x2 x0 = pt[0][mq], x1 = cmulf(pt[1][mq], wb[mq][0]), x2 = cmulf(pt[2][mq], wb[mq][1]), x3 = cmulf(pt[3][mq], wb[mq][2]);
            const f32x2 a = x0 + x2, bb = x0 - x2, c = x1 + x3, d = x1 - x3;
            X[base + mq * L] = a + c; X[base + 4 * L + mq * L] = (f32x2){bb.x - d.y, bb.y + d.x}; X[base + 8 * L + mq * L] = a - c; X[base + 12 * L + mq * L] = (f32x2){bb.x + d.y, bb.y - d.x};
        }
    }
    LDS_BARRIER();
}
__device__ __forceinline__ void fft_inv(LAS f32x2* X, const f32x2* tw, int tid) {
    fft_inv_pass<1, false>(X, tw, tid); fft_inv_pass<4, false>(X, tw, tid); fft_inv_pass16<16>(X, tw, tid); fft_inv_pass16<256>(X, tw, tid);
    fft_inv_pass<4096, true>(X, tw, tid);
}
__device__ __forceinline__ void fft_untangle(const LAS f32x2* X, f32x2* K0g, f32x2* K1g, float sc0, float sc1, int tid) {
    const float h0 = 0.5f * sc0, h1 = 0.5f * sc1;
#pragma unroll 4
    for (int i = 0; i < 32; ++i) {
        const int p = tid + NTHREADS * i, f = drev14(p), pm = drev14((16384 - f) & 16383);
        const f32x2 A = X[p], B = X[pm];
        const f32x2 dd = {A.x - B.x, A.y + B.y};
        K0g[p] = (f32x2){(A.x + B.x) * h0, (A.y - B.y) * h0};
        K1g[p] = (f32x2){dd.y * h1, -dd.x * h1};
    }
    LDS_BARRIER();
}
__device__ __forceinline__ void fft_pointwise(LAS f32x2* X, const f32x2* Kg, int tid) {
#pragma unroll 8
    for (int i = 0; i < 32; ++i) { const int p = tid + NTHREADS * i; X[p] = cmulf(X[p], Kg[p]); }
    LDS_BARRIER();
}
__device__ __forceinline__ void hyena_fft_phase(Frame& F) {
    float* GT = WSP(float, WS_GT); const float* kT = WSP(float, WS_KT); const float* invn = WSP(float, WS_INVN); const f32x2* tw = WSP(f32x2, WS_TW);
    f32x2* K0g = WSP(f32x2, WS_FFTW) + (size_t)F.bid * 16384; f32x2* K1g = WSP(f32x2, WS_Y) + (size_t)F.bid * 16384;
    const float* hyb = INP(25);
    LAS f32x2* X = (LAS f32x2*)F.lds;
    const int tid = F.tid;
    for (int ch = F.bid; ch < 1024; ch += F.G) {
        { const float* f0 = kT + (size_t)ch * SEQ; const float* b0 = kT + (size_t)(1024 + ch) * SEQ; const float* f1 = kT + (size_t)(2048 + ch) * SEQ; const float* b1 = kT + (size_t)(3072 + ch) * SEQ;
          for (int n = tid; n < SEQ; n += NTHREADS) { X[n] = (f32x2){f0[n], f1[n]}; X[SEQ + n] = (n == 0) ? (f32x2){0.f, 0.f} : (f32x2){b0[SEQ - n], b1[SEQ - n]}; } }
        const float* v0 = GT + ((size_t)ch * 2) * SEQ; float* yo = WSP(float, WS_YHT) + ((size_t)ch * 2) * SEQ;
        const float* x1 = GT + ((size_t)(1024 + ch) * 2) * SEQ; const float* x2 = GT + ((size_t)(2048 + ch) * 2) * SEQ;
        float z0[16], z1[16];
#pragma unroll
        for (int j = 0; j < 16; ++j) { const int n = tid + NTHREADS * j; z0[j] = v0[n]; z1[j] = v0[SEQ + n]; }
        LDS_BARRIER();
        fft_fwd<false>(X, tw, tid);
        fft_untangle(X, K0g, K1g, invn[ch] * (1.0f / 16384.0f), invn[1024 + ch] * (1.0f / 16384.0f), tid);
#pragma unroll
        for (int o = 0; o < 2; ++o) {
            const float* xg = (o == 0) ? x1 : x2;
            float g0[16], g1[16];
#pragma unroll
            for (int j = 0; j < 16; ++j) { const int n = tid + NTHREADS * j; g0[j] = xg[n]; g1[j] = xg[SEQ + n]; }
#pragma unroll
            for (int j = 0; j < 16; ++j) { const int n = tid + NTHREADS * j; X[n] = (f32x2){z0[j], z1[j]}; }
            LDS_BARRIER();
            fft_fwd<true>(X, tw, tid);
            fft_pointwise(X, o == 0 ? K0g : K1g, tid);
            fft_inv(X, tw, tid);
            const float bias = hyb[o * 1024 + ch];
#pragma unroll
            for (int j = 0; j < 16; ++j) { const int n = tid + NTHREADS * j; const f32x2 y = X[n]; z0[j] = g0[j] * (y.x + bias * z0[j]); z1[j] = g1[j] * (y.y + bias * z1[j]); }
            LDS_BARRIER();
        }
#pragma unroll
        for (int j = 0; j < 16; ++j) { const int n = tid + NTHREADS * j; yo[n] = z0[j]; yo[SEQ + n] = z1[j]; }
    }
}
__device__ __forceinline__ void hyena_out_transpose(Frame& F) {
    const float* GT = WSP(float, WS_YHT); bf16* cat = WSP(bf16, WS_CAT);
    LAS float* scr = (LAS float*)(F.lds + F.wave * 17408);
    const int lane = F.lane;
    for (int it = F.gw; it < 2 * 128 * 16; it += F.NGW) {
        const int cbk = it & 15, tb = (it >> 4) & 127, b = it >> 11, t0 = tb * 64;
        for (int c = 0; c < 64; ++c) scr[c * 65 + lane] = GT[((size_t)(cbk * 64 + c) * 2 + b) * SEQ + t0 + lane];
        LDS_WAIT(); asm volatile("" ::: "memory");
#pragma unroll
        for (int i = 0; i < 8; ++i) { const int tt = 8 * i + (lane >> 3), c0 = (lane & 7) * 8; const LAS float* s = scr + c0 * 65 + tt;
            v4u o; o.x = cvt_pk_bf16(s[0], s[65]); o.y = cvt_pk_bf16(s[130], s[195]); o.z = cvt_pk_bf16(s[260], s[325]); o.w = cvt_pk_bf16(s[390], s[455]);
            *(v4u*)(cat + ((size_t)b * SEQ + t0 + tt) * 2048 + cbk * 64 + c0) = o; }
        LDS_WAIT(); asm volatile("" ::: "memory");
    }
}

__device__ __forceinline__ int s5_row(int di, int b, int s) {
    return (s < CTX) ? TL + b * CTX + (di == 0 ? s : CTX - 1 - s) : b * SEQ + (di == 0 ? s - CTX : SEQ - 1 - (s - CTX));
}
typedef float f32x4_t __attribute__((ext_vector_type(4)));
#define S5_KEEP8(acc, f) asm volatile("" : "+v"(acc) : "v"(f[0]), "v"(f[1]), "v"(f[2]), "v"(f[3]), "v"(f[4]), "v"(f[5]), "v"(f[6]), "v"(f[7]))
#define S5_KEEP4(acc, f) asm volatile("" : "+v"(acc) : "v"(f[0]), "v"(f[1]), "v"(f[2]), "v"(f[3]))
template <bool OUTPUT>
__device__ __forceinline__ void s5_chunk_phase(Frame& F) {
    const bf16* PJ = WSP(bf16, WS_PROJ1); float* YD = WSP(float, WS_YD);
    const f32x2* l16t = WSP(f32x2, WS_S5L16); const f32x2* l256 = WSP(f32x2, WS_S5L256); f32x2* Eb = WSP(f32x2, WS_S5E);
    const bf16* W1 = WSP(bf16, WS_S5W1); const bf16* W3 = WSP(bf16, WS_S5W3); const bf16* KT = WSP(bf16, WS_S5KT);
    const int lane = F.lane, fr = lane & 15, fq = lane >> 4;
    LAS unsigned* Xl = (LAS unsigned*)(F.lds + F.wave * 4608);
    f32x2 carry[4];
#pragma unroll
    for (int t = 0; t < 4; ++t) carry[t] = (f32x2){0.f, 0.f};
#pragma nounroll
    for (int j = 0;; ++j) {
        const int tq = F.wave * F.G + F.bid + (j >> 2) * F.NGW, sub4 = j & 3;
        if (tq >= 256 * 8) break;
        const int task = tq * 4 + sub4;
        const int dbg = task >> 5, seg = (task & 31) + (OUTPUT ? 1 : 0);
        const int di = dbg >> 7, b = (dbg >> 6) & 1, g = dbg & 63;
        const int dg = di * 64 + g;
        const int s0 = seg * 256;
        bf16x8 afr[8];
#pragma unroll
        for (int ks = 0; ks < 8; ++ks) afr[ks] = *(const bf16x8*)(PJ + (size_t)s5_row(di, b, s0 + 16 * fr + 2 * ks + (fq >> 1)) * 4096 + 3072 + g * 16 + 8 * (fq & 1));
        f32x4 ea[8];
        { const bf16* w1p = W1 + ((size_t)dg * 128 + fr) * 256 + 8 * fq;
#pragma unroll
          for (int nt = 0; nt < 8; ++nt) { f32x4 a = {0.f, 0.f, 0.f, 0.f}; bf16x8 bw[8];
#pragma unroll
              for (int ks = 0; ks < 8; ++ks) bw[ks] = *(const bf16x8*)(w1p + (size_t)nt * 16 * 256 + 32 * ks);
#pragma unroll
              for (int ks = 0; ks < 8; ++ks) a = __builtin_amdgcn_mfma_f32_16x16x32_bf16(afr[ks], bw[ks], a, 0, 0, 0);
              S5_KEEP8(a, bw); S5_KEEP8(a, afr);
              ea[nt] = a; } }
        f32x2 st[4];
#pragma unroll
        for (int t = 0; t < 4; ++t) st[t] = (f32x2){0.f, 0.f};
        if (OUTPUT) {
#pragma unroll
            for (int t = 0; t < 4; ++t) { const f32x2 lq = l256[dg * 64 + 16 * t + fr]; const f32x2* ep = Eb + ((size_t)dbg * 32) * 64 + 16 * t + fr;
                if (sub4 == 0) {
                    int k = 0;
                    for (; k + 8 <= seg; k += 8) { f32x2 e8[8];
#pragma unroll
                        for (int j = 0; j < 8; ++j) e8[j] = ep[(size_t)(k + j) * 64];
#pragma unroll
                        for (int j = 0; j < 8; ++j) st[t] = cmulf(lq, st[t]) + e8[j]; }
                    for (; k < seg; ++k) st[t] = cmulf(lq, st[t]) + ep[(size_t)k * 64];
                } else st[t] = cmulf(lq, carry[t]) + ep[(size_t)(seg - 1) * 64];
                carry[t] = st[t]; }
        }
#pragma unroll
        for (int t = 0; t < 4; ++t) {
            const f32x2 L1 = l16t[dg * 64 + 16 * t + fr], L2 = cmulf(L1, L1), L3 = cmulf(L2, L1), L4 = cmulf(L2, L2);
            const f32x2 x0 = {ea[t][0], ea[4 + t][0]}, x1 = cmulf(L1, x0) + (f32x2){ea[t][1], ea[4 + t][1]}, x2 = cmulf(L1, x1) + (f32x2){ea[t][2], ea[4 + t][2]}, x3 = cmulf(L1, x2) + (f32x2){ea[t][3], ea[4 + t][3]};
            f32x2 sin = st[t];
            f32x2 fin = x3 + cmulf(L4, (fq == 0) ? sin : (f32x2){0.f, 0.f});
#pragma unroll
            for (int rd = 1; rd < 4; ++rd) { const float vr = __shfl(fin.x, lane - 16), vi = __shfl(fin.y, lane - 16);
                if (fq == rd) { sin = (f32x2){vr, vi}; fin = x3 + cmulf(L4, sin); } }
            if (OUTPUT) {
                const f32x2 h1 = x0 + cmulf(L1, sin), h2 = x1 + cmulf(L2, sin), h3 = x2 + cmulf(L3, sin);
                Xl[(4 * fq + 0) * 68 + 16 * t + fr] = cvt_pk_bf16(sin.x, sin.y); Xl[(4 * fq + 1) * 68 + 16 * t + fr] = cvt_pk_bf16(h1.x, h1.y);
                Xl[(4 * fq + 2) * 68 + 16 * t + fr] = cvt_pk_bf16(h2.x, h2.y); Xl[(4 * fq + 3) * 68 + 16 * t + fr] = cvt_pk_bf16(h3.x, h3.y);
            } else {
                st[t] = (f32x2){__shfl(fin.x, 48 + fr), __shfl(fin.y, 48 + fr)};
            }
        }
        if (!OUTPUT) {
            if (fq == 0) {
#pragma unroll
                for (int t = 0; t < 4; ++t) Eb[((size_t)dbg * 32 + seg) * 64 + 16 * t + fr] = st[t];
            }
        } else {
            LDS_WAIT(); asm volatile("" ::: "memory");
            bf16x8 hfr[4];
#pragma unroll
            for (int ks = 0; ks < 4; ++ks) hfr[ks] = *(const LAS bf16x8*)(Xl + fr * 68 + 16 * ks + 4 * fq);
            LDS_WAIT(); asm volatile("" ::: "memory");
            const bf16* w3p = W3 + ((size_t)dg * 256 + fr) * 128 + 8 * fq;
            const bf16* ktp = KT + (size_t)dg * 17 * 256 + fr * 16 + 8 * (fq & 1);
#pragma unroll
            for (int tau = 0; tau < 16; ++tau) {
                f32x4 y = {0.f, 0.f, 0.f, 0.f}; bf16x8 b3[4], bk[8];
#pragma unroll
                for (int ks = 0; ks < 4; ++ks) b3[ks] = *(const bf16x8*)(w3p + (size_t)tau * 16 * 128 + 32 * ks);
#pragma unroll
                for (int ks = 0; ks < 8; ++ks) { const int d1 = (ks <= tau / 2) ? tau - 2 * ks - (fq >> 1) + 1 : 0;
                    bk[ks] = *(const bf16x8*)(ktp + (size_t)d1 * 256); }
#pragma unroll
                for (int ks = 0; ks < 4; ++ks) y = __builtin_amdgcn_mfma_f32_16x16x32_bf16(hfr[ks], b3[ks], y, 0, 0, 0);
#pragma unroll
                for (int ks = 0; ks <= tau / 2; ++ks) y = __builtin_amdgcn_mfma_f32_16x16x32_bf16(afr[ks], bk[ks], y, 0, 0, 0);
                S5_KEEP4(y, b3); S5_KEEP8(y, bk); S5_KEEP8(y, afr); S5_KEEP4(y, hfr);
#pragma unroll
                for (int r = 0; r < 4; ++r) { const int s = s0 + 16 * (4 * fq + r) + tau, tl = (di == 0) ? s - CTX : SEQ - 1 - (s - CTX);
                    YD[(((size_t)(di * 2 + b) * 64 + g) * SEQ + tl) * 16 + fr] = y[r]; }
            }
        }
    }
}


constexpr int NPHASES = 21;
#ifndef MK_SINGLE
#define MK_SINGLE 1
#endif

__device__ __forceinline__ unsigned long long launder_u64(unsigned long long v) {
    unsigned lo = (unsigned)v, hi = (unsigned)(v >> 32);
    asm volatile("" : "+v"(lo), "+v"(hi));
    lo = __builtin_amdgcn_readfirstlane(lo); hi = __builtin_amdgcn_readfirstlane(hi);
    return ((unsigned long long)hi << 32) | lo;
}
__device__ __forceinline__ const void* launder_ptr(const void* p) {
    unsigned long long v = (unsigned long long)p; unsigned lo = (unsigned)v, hi = (unsigned)(v >> 32);
    asm volatile("" : "+v"(lo), "+v"(hi));
    lo = __builtin_amdgcn_readfirstlane(lo); hi = __builtin_amdgcn_readfirstlane(hi);
    return (const void*)(((unsigned long long)hi << 32) | lo);
}
__device__ __forceinline__ void moe_blocks(Frame& F, int l, LAS int* bstart) {
    __syncthreads();
    if (F.tid == 0) { const unsigned* cnt = WSP(unsigned, WS_CTL) + CW_CNT + l * 64 * CSTR; int acc = 0;
        for (int e = 0; e < 64; ++e) { bstart[e] = acc; const int nb = ((int)cnt[e * CSTR] + 255) >> 8; for (int j = 0; j < nb; ++j) bstart[65 + acc + j] = e; acc += nb; } bstart[64] = acc; }
    __syncthreads();
}

template <int PHSEL>
__global__ void __launch_bounds__(NTHREADS, 2) mk_fwd(Args args) {
    extern __shared__ __attribute__((aligned(16))) unsigned char lds_raw[];
    Frame F;
    F.lds = (LAS unsigned char*)lds_raw; F.ws = (GAS unsigned char*)args.ws; F.kin = (const __attribute__((address_space(4))) unsigned long long*)__builtin_amdgcn_kernarg_segment_ptr();
    F.tid = threadIdx.x; F.lane = F.tid & 63; F.wave = __builtin_amdgcn_readfirstlane(F.tid >> 6); F.bid = blockIdx.x; F.G = gridDim.x;
    F.gw = F.bid * NWAVES + F.wave; F.NGW = F.G * NWAVES;
    volatile LAS unsigned* lctl = (volatile LAS unsigned*)(F.lds + LDS_CTL);
    LAS int* bstart = (LAS int*)(F.lds + LDS_CTL + 64);
    if (F.tid < 4) lctl[F.tid] = 0u;
    __syncthreads();
    const int lo = args.ph_lo, hi = args.ph_hi;
    XcdBarrier bar; bar.bar = WSP(unsigned, WS_CTL) + CW_BAR; bar.x = 0; bar.st = lctl;
    if (PHSEL < 0) bar = xcd_barrier_post(WSP(unsigned, WS_CTL) + CW_BAR, lctl);
#ifndef PH_MASK
#define PH_MASK 0xffffffffu
#endif
#define IN(k) (((PH_MASK >> (k)) & 1u) && (PHSEL < 0 || PHSEL == (k)))
#define INL(j) (((PH_MASK >> (6 + (j))) & 1u) && (PHSEL < 0 || (PHSEL == 6 + (j) && lo == pb + (j))))
#define PH_END(k) do { if (PHSEL < 0) xcd_barrier(bar); } while (0)
#ifndef PH_REPEAT
#define PH_REPEAT 0u
#endif
#define REP(k) for (int _rep = 0; _rep < (((PH_REPEAT >> (k)) & 1u) ? 2 : 1); ++_rep)
#define DUP(k) (((PH_REPEAT >> (k)) & 1u) != 0u)
#define PH_BEGIN() do { F.ws = (GAS unsigned char*)launder_u64((unsigned long long)F.ws); F.kin = (const __attribute__((address_space(4))) unsigned long long*)launder_u64((unsigned long long)F.kin); \
    { int _t = threadIdx.x; asm volatile("" : "+v"(_t)); F.tid = _t; F.lane = _t & 63; F.wave = __builtin_amdgcn_readfirstlane(_t >> 6); \
      int _b = blockIdx.x; asm volatile("" : "+v"(_b)); F.bid = __builtin_amdgcn_readfirstlane(_b); F.gw = F.bid * NWAVES + F.wave; } } while (0)
    LAS unsigned char* lds = F.lds;
    const int G = F.G, bid = F.bid;
    const int vcu = (G % 8 == 0) ? (bid % 8) * (G / 8) + bid / 8 : bid;
    constexpr long T2048 = 256L * 2048 * 2;

    if (IN(0)) { PH_BEGIN(); REP(0) { p0_prologue(F); __syncthreads(); } PH_END(0); }
    if (IN(1)) { PH_BEGIN(); p1_reduce(F); PH_END(1); }
#ifdef EXTRA_BARS
    xcd_barrier(bar); xcd_barrier(bar); xcd_barrier(bar); xcd_barrier(bar); xcd_barrier(bar); xcd_barrier(bar); xcd_barrier(bar); xcd_barrier(bar); xcd_barrier(bar); xcd_barrier(bar);
#endif
        if (IN(2)) { PH_BEGIN(); REP(2) norm_phase<0>(F, 0, nullptr); PH_END(2); }
        if (IN(3)) { PH_BEGIN();
#define BODY3 { pg8::Gemm g{(const bf16*)F.ws, (const bf16*)F.ws, 2048, 2048, 2048}; InProj0Order S; S.G = G; S.c = bid; \
              S.offA1 = (long)WS_HA; S.offB1 = (long)WS_WIN0; S.offA2 = (long)(WS_WIN0 + (size_t)3072 * 2048 * 2); S.offB2 = (long)WS_HA; \
              EpiInProj0 E{EpiQKP{WSP(bf16, WS_Q), WSP(bf16, WS_K), WSP(bf16, WS_P), WSP(f32x2, WS_ROPE)}, EpiVT{WSP(bf16, WS_VT)}}; pg8::gemm_phase<EpiInProj0, InProj0Order, false>(lds, g, S, E); }
            BODY3
            if constexpr (DUP(3)) { BODY3 }
#undef BODY3
            PH_END(3);
        }
        if (IN(4)) { PH_BEGIN();
            REP(4) attn_phase(F, (bid >> 3) % 5);
            __syncthreads(); REP(21) poold_phase(F); PH_END(4); }
        if (IN(5)) { PH_BEGIN();
            pg8::Gemm g{WSP(bf16, WS_PD), WSP(bf16, WS_WPOOL), 1024, 256, 256}; pg8::StaticOrder S; S.init(TT / 256, 4, G, bid, 256L * 1024 * 2, 256L * 2, 256L * 256 * 2);
            EpiScaleBf16 E{WSP(bf16, WS_CAT), 2048, 1024, INP(14)}; pg8::gemm_phase<EpiScaleBf16, pg8::StaticOrder, false>(lds, g, S, E);
            PH_END(5);
        }
    {
    constexpr int pb = 6; constexpr int l = 0;
    if (INL(0)) { PH_BEGIN();
        float* xbuf = WSP(float, WS_X);
        pg8::Gemm g{WSP(bf16, WS_CAT), WSP(bf16, l == 0 ? WS_WOUT0 : WS_WOUT1), 2048, 2048, 2048}; pg8::StaticOrder S; S.init(l == 0 ? TT / 256 : TL / 256, 8, G, bid, T2048, 0, T2048);
        EpiRes E{l == 0 ? INP(0) : xbuf, l == 0 ? INP(2) : xbuf + (size_t)TL * 2048, xbuf, modp(F, l, 0, 2)}; pg8::gemm_phase<EpiRes, pg8::StaticOrder, false>(lds, g, S, E);
        PH_END(pb);
    }
    if (INL(1)) { PH_BEGIN(); ffn_norm_router_phase(F, l); PH_END(pb + 1); }
    if (INL(2)) { PH_BEGIN(); REP(8) {
        moe_blocks(F, l, bstart);
        pg8::Gemm g{WSP(bf16, WS_HA), (const bf16*)(F.ws + WS_WMOE + (size_t)l * MOE_L_BYTES), 2048, 2048, 2048};
        MoeOrder S{bstart, WSP(unsigned, WS_CTL) + CW_CNT + l * 64 * CSTR, WSP(int, WS_TOKL), 4, G, vcu, bstart[64], T2048, 0, true};
        EpiMoeUp E{WSP(bf16, WS_H)}; pg8::gemm_phase<EpiMoeUp, MoeOrder, true>(lds, g, S, E); }
        PH_END(pb + 2);
    }
    if (INL(3)) { PH_BEGIN(); REP(9) {
        moe_blocks(F, l, bstart);
        pg8::Gemm g{WSP(bf16, WS_H), (const bf16*)(F.ws + WS_WMOE + (size_t)l * MOE_L_BYTES), 512, 512, 512};
        MoeOrder S{bstart, WSP(unsigned, WS_CTL) + CW_CNT + l * 64 * CSTR, WSP(int, WS_TOKL), 8, G, vcu, bstart[64], 256L * 512 * 2, (long)(4 * MiB), false};
        EpiMoeDown E{WSP(bf16, WS_Y), WSP(int, WS_TOKL), WSP(float, WS_GATEL), WSP(unsigned, WS_CTL) + CW_CNT + l * 64 * CSTR}; pg8::gemm_phase<EpiMoeDown, MoeOrder, false>(lds, g, S, E); }
        PH_END(pb + 3);
    }
    }
        if (IN(10)) { PH_BEGIN(); norm_phase<2>(F, 1, nullptr); PH_END(10); }
        if (IN(11)) { PH_BEGIN();
#define BODY11             pg8::Gemm g{WSP(bf16, WS_HA), WSP(bf16, WS_WIN1), 2048, 2048, 2048}; pg8::StaticOrder S; S.init(TT / 256, 16, G, bid, T2048, 0, T2048); \
            EpiBf16 E{WSP(bf16, WS_PROJ1), 4096}; pg8::gemm_phase<EpiBf16, pg8::StaticOrder, false>(lds, g, S, E);
            BODY11
            if constexpr (DUP(11)) { BODY11 }
#undef BODY11
            PH_END(11);
        }
        if (IN(12)) { PH_BEGIN(); REP(12) shortconv_phase(F); REP(22) s5_chunk_phase<false>(F);
 PH_END(12); }
        if (IN(13)) { PH_BEGIN();
            REP(23) s5_chunk_phase<true>(F); __syncthreads(); REP(13) hyena_fft_phase(F); PH_END(13); }
        if (IN(14)) { PH_BEGIN();
 REP(14) { s5_gelu_phase(F); hyena_out_transpose(F); } PH_END(14); }
        if (IN(15)) { PH_BEGIN();
            pg8::Gemm g{WSP(bf16, WS_PD), WSP(bf16, WS_WGLU), 1024, 1024, 1024}; pg8::StaticOrder S; S.init(TL / 256, 4, G, bid, 256L * 1024 * 2, 0, 256L * 1024 * 2);
            EpiGlu E{WSP(bf16, WS_CAT), 2048, 1024, WSP(bf16, WS_PD), INP(35)}; pg8::gemm_phase<EpiGlu, pg8::StaticOrder, false>(lds, g, S, E);
            PH_END(15);
        }
    {
    constexpr int pb = 16; constexpr int l = 1;
    if (INL(0)) { PH_BEGIN();
        float* xbuf = WSP(float, WS_X);
        pg8::Gemm g{WSP(bf16, WS_CAT), WSP(bf16, l == 0 ? WS_WOUT0 : WS_WOUT1), 2048, 2048, 2048}; pg8::StaticOrder S; S.init(l == 0 ? TT / 256 : TL / 256, 8, G, bid, T2048, 0, T2048);
        EpiRes E{l == 0 ? INP(0) : xbuf, l == 0 ? INP(2) : xbuf + (size_t)TL * 2048, xbuf, modp(F, l, 0, 2)}; pg8::gemm_phase<EpiRes, pg8::StaticOrder, false>(lds, g, S, E);
        PH_END(pb);
    }
    if (INL(1)) { PH_BEGIN(); ffn_norm_router_phase(F, l); PH_END(pb + 1); }
    if (INL(2)) { PH_BEGIN(); REP(8) {
        moe_blocks(F, l, bstart);
        pg8::Gemm g{WSP(bf16, WS_HA), (const bf16*)(F.ws + WS_WMOE + (size_t)l * MOE_L_BYTES), 2048, 2048, 2048};
        MoeOrder S{bstart, WSP(unsigned, WS_CTL) + CW_CNT + l * 64 * CSTR, WSP(int, WS_TOKL), 4, G, vcu, bstart[64], T2048, 0, true};
        EpiMoeUp E{WSP(bf16, WS_H)}; pg8::gemm_phase<EpiMoeUp, MoeOrder, true>(lds, g, S, E); }
        PH_END(pb + 2);
    }
    if (INL(3)) { PH_BEGIN(); REP(9) {
        moe_blocks(F, l, bstart);
        pg8::Gemm g{WSP(bf16, WS_H), (const bf16*)(F.ws + WS_WMOE + (size_t)l * MOE_L_BYTES), 512, 512, 512};
        MoeOrder S{bstart, WSP(unsigned, WS_CTL) + CW_CNT + l * 64 * CSTR, WSP(int, WS_TOKL), 8, G, vcu, bstart[64], 256L * 512 * 2, (long)(4 * MiB), false};
        EpiMoeDown E{WSP(bf16, WS_Y), WSP(int, WS_TOKL), WSP(float, WS_GATEL), WSP(unsigned, WS_CTL) + CW_CNT + l * 64 * CSTR}; pg8::gemm_phase<EpiMoeDown, MoeOrder, false>(lds, g, S, E); }
        PH_END(pb + 3);
    }
    }
    if (IN(20)) { PH_BEGIN(); norm_phase<3>(F, 1, args.out);
    }
#undef IN
#undef INL
#undef PH_END
}

typedef void (*kern_t)(Args);
template <int P> static void launch_phase(int grid, hipStream_t stream, Args a) { hipLaunchKernelGGL(mk_fwd<P>, dim3(grid), dim3(NTHREADS), LDS_BYTES, stream, a); }
template <int P> static bool prep_phase() { return hipFuncSetAttribute((const void*)mk_fwd<P>, hipFuncAttributeMaxDynamicSharedMemorySize, LDS_BYTES) == hipSuccess; }
extern "C" void kernel_launch(void* const* d_in, const int* in_sizes, int n_in, void* d_out, int out_size, void* d_ws, size_t ws_size, hipStream_t stream) {
    static int grid = 0;
    if (grid == 0) {
        if (n_in != 43 || out_size != TL * DM || ws_size < WS_END) { fprintf(stderr, "kernel_launch: unexpected shapes (n_in %d, out %d, ws %zu < %zu)\n", n_in, out_size, ws_size, (size_t)WS_END); grid = -1; return; }
        int dev = 0, cus = 0;
        if (hipGetDevice(&dev) != hipSuccess || hipDeviceGetAttribute(&cus, hipDeviceAttributeMultiprocessorCount, dev) != hipSuccess) { grid = -1; return; }
        bool ok = true;
#if MK_SINGLE
        ok = prep_phase<-1>();
#else
        ok = prep_phase<0>() && prep_phase<1>() && prep_phase<2>() && prep_phase<3>() && prep_phase<4>() && prep_phase<5>() && prep_phase<6>() && prep_phase<7>() && prep_phase<8>() && prep_phase<9>() &&
             prep_phase<10>() && prep_phase<11>() && prep_phase<12>() && prep_phase<13>() && prep_phase<14>() && prep_phase<15>() && prep_phase<20>();
#endif
        if (!ok) { fprintf(stderr, "kernel_launch: hipFuncSetAttribute failed\n"); grid = -1; return; }
        (void)hipGetLastError();
        grid = cus;
    }
    if (grid < 0) return;
    (void)hipMemsetAsync((char*)d_ws + WS_CTL, 0, CTL_BYTES, stream);
    Args a{};
    for (int i = 0; i < 43; ++i) a.in[i] = (const float*)d_in[i];
    a.out = (float*)d_out; a.ws = (unsigned char*)d_ws;
#if MK_SINGLE
    a.ph_lo = 0; a.ph_hi = NPHASES;
    launch_phase<-1>(grid, stream, a);
#else
#ifndef MK_DUP
#define MK_DUP -1
#endif
#define LP(k, P) a.ph_lo = (k); a.ph_hi = (k) + 1; launch_phase<P>(grid, stream, a); \
    if (MK_DUP == (k)) { if (P == 7) (void)hipMemsetAsync((char*)d_ws + WS_CTL + (size_t)(CW_CNT + ((k) > 10 ? 64 * CSTR : 0)) * 4, 0, 256 * CSTR, stream); launch_phase<P>(grid, stream, a); }
    LP(0, 0) LP(1, 1) LP(2, 2) LP(3, 3) LP(4, 4) LP(5, 5) LP(6, 6) LP(7, 7) LP(8, 8) LP(9, 9) LP(10, 10) LP(11, 11) LP(12, 12) LP(13, 13) LP(14, 14) LP(15, 15)
    LP(16, 6) LP(17, 7) LP(18, 8) LP(19, 9) LP(20, 20)
#undef LP
#endif
}
```

```cpp
#include <hip/hip_runtime.h>
#include <cstdio>
#include <cstdint>
#include <cmath>

#define GAS __attribute__((address_space(1)))
#define LAS __attribute__((address_space(3)))
typedef unsigned short bf16;
typedef unsigned v4u __attribute__((ext_vector_type(4)));
typedef unsigned v2u __attribute__((ext_vector_type(2)));
typedef float f32x4 __attribute__((ext_vector_type(4)));
typedef float f32x2 __attribute__((ext_vector_type(2)));
typedef float f32x16 __attribute__((ext_vector_type(16)));
typedef short bf16x8 __attribute__((ext_vector_type(8)));
#define LDS_WAIT() asm volatile("s_waitcnt lgkmcnt(0)" ::: "memory")
#define VM_WAIT() asm volatile("s_waitcnt vmcnt(0)" ::: "memory")

__device__ __forceinline__ unsigned f2bf(float f) { unsigned u = __builtin_bit_cast(unsigned, f); return (u + 0x7fffu + ((u >> 16) & 1u)) >> 16; }
__device__ __forceinline__ unsigned pk2(float lo, float hi) { return f2bf(lo) | (f2bf(hi) << 16); }
__device__ __forceinline__ unsigned cvt_pk_bf16(float lo, float hi) { unsigned r; asm volatile("v_cvt_pk_bf16_f32 %0, %1, %2" : "=v"(r) : "v"(lo), "v"(hi)); return r; }
__device__ __forceinline__ float bf2f(unsigned short b) { return __builtin_bit_cast(float, (unsigned)b << 16); }
__device__ __forceinline__ float bflo(unsigned w) { return __builtin_bit_cast(float, w << 16); }
__device__ __forceinline__ float bfhi(unsigned w) { return __builtin_bit_cast(float, w & 0xffff0000u); }
__device__ __forceinline__ float wave_sum(float v) {
#pragma unroll
    for (int o = 1; o < 64; o <<= 1) v += __shfl_xor(v, o);
    return v;
}

namespace pg8 {
typedef unsigned short bf16_t;
constexpr int BM = 256, BK = 64, HALF = 128, HTB = HALF * BK * 2, STAGE_BYTES = 8 * HTB;

__host__ __device__ __forceinline__ int lds_byte(int r, int c) { const int st = (r >> 4) * 2 + (c >> 5), rr = r & 15, cc = c & 31, ob = rr * 64 + cc * 2; return st * 1024 + (ob ^ (((ob >> 9) & 1) << 5)); }
__host__ __device__ __forceinline__ int perm32(int rho) { const int n = rho >> 4, i = rho & 15; return 8 * (i >> 2) + 4 * n + (i & 3); }
__host__ __device__ __forceinline__ void stage_rc(int b, int& R, int& C) { const int st = b / 1024, sb = b % 1024, swz = sb ^ (((sb >> 9) & 1) << 5); R = (st >> 1) * 16 + swz / 64; C = (st & 1) * 32 + (swz % 64) / 2; }

struct Unit { int pm, pn; long aoff, boff; int e, idx0; };
struct Gemm { const bf16_t* A; const bf16_t* Bt; int lda, ldb, K; };

template <class Epi, class Sched, bool GATHER>
__device__ __forceinline__ void gemm_phase(LAS unsigned char* lds, const Gemm g, const Sched& S, const Epi& E) {
    int tid_ = threadIdx.x; asm volatile("" : "+v"(tid_));
    const int tid = tid_, wid = __builtin_amdgcn_readfirstlane(tid >> 6), lane = tid & 63, wr = wid >> 2, wc = wid & 3, fr = lane & 15, fq = lane >> 4;
    const int K = g.K, nt = K / BK;
    unsigned voffA[2], voffB[2];
#pragma unroll
    for (int i = 0; i < 2; ++i) { int R, C; stage_rc(tid * 16 + i * 8192, R, C);
        const int Rb = Epi::PERM ? ((R & ~31) + perm32(R & 31)) : R;
        voffA[i] = (unsigned)(R * g.lda + C) * 2u; voffB[i] = (unsigned)(Rb * g.ldb + C) * 2u; }
    const size_t kstep = (size_t)(BK * 2);
    const size_t hstepA = GATHER ? 0 : (size_t)HALF * g.lda * 2, hstepB = (size_t)HALF * g.ldb * 2;
    const unsigned ldsw = (unsigned)wid * 1024u;
    const int aoff = lds_byte(wr * 64 + fr, fq * 8), boff = lds_byte(wc * 32 + fr, fq * 8);
#define PG8_SA(b, h) (((b) * 2 + (h)) * HTB)
#define PG8_SB(b, h) ((4 + (b) * 2 + (h)) * HTB)
#define PG8_STAGE(bufoff, gbase, voff) do { _Pragma("unroll") for (int _i = 0; _i < 2; ++_i) \
        __builtin_amdgcn_global_load_lds((const unsigned*)((const char*)(gbase) + (voff)[_i]), (LAS unsigned*)(lds + (bufoff) + ldsw + _i * 8192), 16, 0, 0); } while (0)
#define PG8_STAGE_A(bufoff, gbase, h, nx) do { if constexpr (GATHER) { unsigned _tv[2]; \
        if (nx) { int _tz = tid; asm volatile("" : "+v"(_tz)); _Pragma("unroll") for (int _j = 0; _j < 2; ++_j) { int _R, _C; stage_rc(_tz * 16 + _j * 8192, _R, _C); _tv[_j] = (unsigned)S.arow(nxt, (h) * HALF + _R) * (unsigned)(g.lda * 2) + (unsigned)(_C * 2); } } \
        else { _tv[0] = gvc[h][0]; _tv[1] = gvc[h][1]; } \
        PG8_STAGE(bufoff, gbase, _tv); } else { PG8_STAGE(bufoff, (gbase) + (h) * hstepA, voffA); } } while (0)
#define PG8_LDA(dst, b, h) do { _Pragma("unroll") for (int m = 0; m < 4; ++m) _Pragma("unroll") for (int k = 0; k < 2; ++k) dst[m][k] = *(const LAS bf16x8*)(lds + PG8_SA(b, h) + aoff + m * 2048 + k * 1024); } while (0)
#define PG8_LDB(dst, b, h) do { _Pragma("unroll") for (int n = 0; n < 2; ++n) _Pragma("unroll") for (int k = 0; k < 2; ++k) dst[n][k] = *(const LAS bf16x8*)(lds + PG8_SB(b, h) + boff + n * 2048 + k * 1024); } while (0)
#define PG8_MMA(ai, bj, At, Bt) do { __builtin_amdgcn_s_setprio(1); _Pragma("unroll") for (int m = 0; m < 4; ++m) _Pragma("unroll") for (int n = 0; n < 2; ++n) _Pragma("unroll") for (int k = 0; k < 2; ++k) \
        acc[ai][bj][m][n] = __builtin_amdgcn_mfma_f32_16x16x32_bf16(Bt[n][k], At[m][k], acc[ai][bj][m][n], 0, 0, 0); __builtin_amdgcn_s_setprio(0); } while (0)
#define PG8_WAIT_V(n) asm volatile("s_waitcnt vmcnt(" #n ")" ::: "memory")
#define PG8_WAIT_L(n) asm volatile("s_waitcnt lgkmcnt(" #n ")" ::: "memory")
#define PG8_BAR __builtin_amdgcn_s_barrier()
#define PG8_SCHED __builtin_amdgcn_sched_barrier(0)
    Unit cur, nxt; int ui = 0;
    if (!S.next(0, cur)) return;
    unsigned gvc[2][2];
#define PG8_GV(unit) do { if constexpr (GATHER) { int _tz = tid; asm volatile("" : "+v"(_tz)); _Pragma("unroll") for (int _h = 0; _h < 2; ++_h) _Pragma("unroll") for (int _j = 0; _j < 2; ++_j) { int _R, _C; stage_rc(_tz * 16 + _j * 8192, _R, _C); \
        gvc[_h][_j] = (unsigned)S.arow(unit, _h * HALF + _R) * (unsigned)(g.lda * 2) + (unsigned)(_C * 2); } } } while (0)
    PG8_GV(cur);
    f32x4 acc[2][2][4][2];
#pragma unroll
    for (int a = 0; a < 2; ++a)
#pragma unroll
        for (int b = 0; b < 2; ++b)
#pragma unroll
            for (int m = 0; m < 4; ++m)
#pragma unroll
                for (int n = 0; n < 2; ++n) acc[a][b][m][n] = (f32x4){0.f, 0.f, 0.f, 0.f};
    bf16x8 At[4][2], B0[2][2], B1[2][2];
    const char* cA = (const char*)g.A + cur.aoff; const char* cB = (const char*)g.Bt + cur.boff;
    PG8_STAGE(PG8_SB(0, 0), cB, voffB); PG8_STAGE(PG8_SB(0, 1), cB + hstepB, voffB); PG8_STAGE_A(PG8_SA(0, 0), cA, 0, false); PG8_STAGE_A(PG8_SA(0, 1), cA, 1, false);
    if (wr == 1) PG8_BAR;
    PG8_WAIT_V(2); PG8_BAR;
    PG8_STAGE(PG8_SB(1, 0), cB + kstep, voffB); PG8_STAGE_A(PG8_SA(1, 0), cA + kstep, 0, false); PG8_STAGE(PG8_SB(1, 1), cB + hstepB + kstep, voffB);
    PG8_WAIT_V(6); PG8_BAR;
    for (;;) {
        const bool has_next = S.next(ui + 1, nxt);
        const char* nA = has_next ? (const char*)g.A + nxt.aoff : cA; const char* nB = has_next ? (const char*)g.Bt + nxt.boff : cB;
#pragma nounroll
        for (int t = 0; t < nt; t += 2) {
            const bool last = (t == nt - 2);
            const char* a1 = cA + (size_t)(t + 1) * kstep;
            const char* a2 = last ? nA : cA + (size_t)(t + 2) * kstep; const char* b2 = last ? nB : cB + (size_t)(t + 2) * kstep;
            const char* a3 = a2 + kstep; const char* b3 = b2 + kstep;
            PG8_LDB(B0, 0, 0); PG8_LDB(B1, 0, 1); PG8_SCHED; PG8_LDA(At, 0, 0); PG8_STAGE_A(PG8_SA(1, 1), a1, 1, false);
            PG8_WAIT_V(8); PG8_WAIT_L(0); PG8_BAR; PG8_MMA(0, 0, At, B0); PG8_MMA(0, 1, At, B1); PG8_BAR; PG8_SCHED;
            PG8_LDA(At, 0, 1); PG8_STAGE(PG8_SB(0, 0), b2, voffB); PG8_STAGE(PG8_SB(0, 1), b2 + hstepB, voffB); PG8_STAGE_A(PG8_SA(0, 0), a2, 0, last);
            PG8_WAIT_V(8); PG8_WAIT_L(0); PG8_BAR; PG8_MMA(1, 0, At, B0); PG8_MMA(1, 1, At, B1); PG8_BAR; PG8_SCHED;
            PG8_LDB(B0, 1, 0); PG8_LDB(B1, 1, 1); PG8_SCHED; PG8_LDA(At, 1, 0); PG8_STAGE_A(PG8_SA(0, 1), a2, 1, last);
            PG8_WAIT_V(8); PG8_WAIT_L(0); PG8_BAR; PG8_MMA(0, 0, At, B0); PG8_MMA(0, 1, At, B1); PG8_BAR; PG8_SCHED;
            PG8_LDA(At, 1, 1); PG8_STAGE(PG8_SB(1, 0), b3, voffB); PG8_STAGE(PG8_SB(1, 1), b3 + hstepB, voffB); PG8_STAGE_A(PG8_SA(1, 0), a3, 0, last);
            PG8_WAIT_V(8); PG8_WAIT_L(0); PG8_BAR; PG8_MMA(1, 0, At, B0); PG8_MMA(1, 1, At, B1); PG8_BAR; PG8_SCHED;
        }
        if (wr == 0) PG8_BAR;
        E(acc, cur, wr, wc, fr, fq);
        if (!has_next) break;
#pragma unroll
        for (int a = 0; a < 2; ++a)
#pragma unroll
            for (int b = 0; b < 2; ++b)
#pragma unroll
                for (int m = 0; m < 4; ++m)
#pragma unroll
                    for (int n = 0; n < 2; ++n) acc[a][b][m][n] = (f32x4){0.f, 0.f, 0.f, 0.f};
        cur = nxt; cA = nA; cB = nB; ++ui;
        PG8_GV(cur);
        if (wr == 1) PG8_BAR;
    }
    PG8_WAIT_V(0);
    PG8_BAR;
#undef PG8_SA
#undef PG8_SB
#undef PG8_STAGE
#undef PG8_STAGE_A
#undef PG8_GV
#undef PG8_LDA
#undef PG8_LDB
#undef PG8_MMA
#undef PG8_WAIT_V
#undef PG8_WAIT_L
#undef PG8_BAR
#undef PG8_SCHED
}

struct StaticOrder {
    int nM, nN, nwg, G, c; long astride, apn, bstride;
    __device__ void init(int nM_, int nN_, int G_, int c_, long astride_, long apn_, long bstride_) { nM = nM_; nN = nN_; nwg = nM * nN; G = G_; c = c_; astride = astride_; apn = apn_; bstride = bstride_; }
    __device__ bool next(int i, Unit& u) const {
        const long Lx = (long)i * G + c; if (Lx >= nwg) return false;
        int wgid = (int)Lx; { const int q = nwg / 8, r = nwg % 8, xcd = wgid % 8, off = wgid / 8; wgid = (xcd < r ? xcd * (q + 1) : r * (q + 1) + (xcd - r) * q) + off; }
        const int nig = 8 * nN, gid = wgid / nig, fm = gid * 8, gsz = (nM - fm) < 8 ? (nM - fm) : 8;
        u.pm = fm + ((wgid % nig) % gsz); u.pn = (wgid % nig) / gsz; u.aoff = (long)u.pm * astride + (long)u.pn * apn; u.boff = (long)u.pn * bstride; u.e = 0; u.idx0 = 0; return true;
    }
    __device__ int arow(const Unit&, int) const { return 0; }
};
}

constexpr int DM = 2048, NBATCH = 2, SEQ = 8192, CTX = 256;
constexpr int TL = NBATCH * SEQ;
constexpr int TC = NBATCH * CTX;
constexpr int TT = TL + TC;
constexpr int KEYS = CTX + SEQ;
constexpr int NEXP = 64, DEXP = 512;
constexpr int LISTCAP = 2 * TT;
constexpr float EPS = 1e-6f;
constexpr float QSCALE = 0.125f * 1.4426950408889634f;
constexpr int NWAVES = 8, NTHREADS = 512;

constexpr size_t MiB = 1u << 20;
constexpr size_t WS_CTL = 0, CTL_BYTES = 64 * 1024;
constexpr size_t WS_WIN0 = 1 * MiB;
constexpr size_t WS_WOUT0 = WS_WIN0 + 16 * MiB;
constexpr size_t WS_WIN1 = WS_WOUT0 + 8 * MiB;
constexpr size_t WS_WOUT1 = WS_WIN1 + 16 * MiB;
constexpr size_t WS_WPOOL = WS_WOUT1 + 8 * MiB;
constexpr size_t WS_WGLU = WS_WPOOL + 1 * MiB;
constexpr size_t WS_WMOE = WS_WGLU + 2 * MiB;
constexpr size_t MOE_E_BYTES = 6 * MiB, MOE_L_BYTES = 64 * MOE_E_BYTES;
constexpr size_t WS_X = WS_WMOE + 2 * MOE_L_BYTES;
constexpr size_t WS_HA = WS_X + 132 * MiB;
constexpr size_t WS_Q = WS_HA + 67 * MiB;
constexpr size_t WS_K = WS_Q + 33 * MiB;
constexpr size_t WS_VT = WS_K + 33 * MiB;
constexpr size_t WS_P = WS_VT + 33 * MiB;
constexpr size_t WS_PROJ1 = WS_Q;
constexpr size_t WS_CAT = WS_P + 33 * MiB;
constexpr size_t WS_PD = WS_CAT + 66 * MiB;
constexpr size_t WS_H = WS_PD + 33 * MiB;
constexpr size_t WS_Y = WS_H + 49 * MiB;
constexpr size_t WS_GT = WS_Y + 132 * MiB;
constexpr size_t WS_KT = WS_GT + 192 * MiB;
constexpr size_t WS_YD = WS_KT + 128 * MiB;
constexpr size_t WS_MISC = WS_YD + 128 * MiB;
constexpr size_t WS_MOD = WS_MISC;
constexpr size_t WS_ADAP = WS_MOD + 1 * MiB;
constexpr size_t WS_ROPE = WS_ADAP + 10 * MiB;
constexpr size_t WS_NORMP = WS_ROPE + 1 * MiB;
constexpr size_t WS_INVN = WS_NORMP + 4 * MiB;
constexpr size_t WS_S5LAM = WS_INVN + 1 * MiB;
constexpr size_t WS_S5B = WS_S5LAM + 1 * MiB;
constexpr size_t WS_WRT = WS_S5B + 2 * MiB;
constexpr size_t WS_TOKL = WS_WRT + 2 * MiB;
constexpr size_t WS_GATEL = WS_TOKL + 9 * MiB;
constexpr size_t WS_TW = WS_GATEL + 9 * MiB;
constexpr size_t WS_FFTW = WS_TW + 1 * MiB;
constexpr size_t WS_S5L256 = WS_FFTW + 32 * MiB;
constexpr size_t WS_S5E = WS_S5L256 + 1 * MiB;
constexpr size_t WS_YHT = WS_S5E + 4 * MiB;
constexpr size_t WS_S5L16 = WS_YHT + 64 * MiB;
constexpr size_t WS_S5W1 = WS_S5L16 + 1 * MiB;
constexpr size_t WS_S5W3 = WS_S5W1 + 8 * MiB;
constexpr size_t WS_S5KT = WS_S5W3 + 8 * MiB;
constexpr size_t WS_END = WS_S5KT + 2 * MiB;
static_assert(WS_END <= 2040 * MiB, "d_ws map");
constexpr int CW_BAR = 1024;
constexpr int CW_CNT = 8192;
constexpr int CSTR = 32;

constexpr int LDS_PHASE = 131072;
constexpr int LDS_CTL = 147456 - 2048;
constexpr int LDS_BYTES = 147456;

#define XB_TMO      128
#define XB_XCNT(j)  (256  + 64 * (j))
#define XB_XSUB(j)  (1280 + 64 * (j))
#define XB_XGEN(j)  (2304 + 64 * (j))
#define XB_TOP      3328
#define XB_TOPGEN   3392
#define XCD_BAR_WORDS 3456
#define XB_SPIN_CAP (1u << 22)

__device__ __forceinline__ unsigned xb_ld(unsigned* p)              { return __hip_atomic_load(p, __ATOMIC_RELAXED, __HIP_MEMORY_SCOPE_AGENT); }
__device__ __forceinline__ unsigned xb_add(unsigned* p, unsigned v) { return __hip_atomic_fetch_add(p, v, __ATOMIC_RELAXED, __HIP_MEMORY_SCOPE_AGENT); }
__device__ __forceinline__ unsigned xb_xcc_id() { return (unsigned)__builtin_amdgcn_s_getreg((3 << 11) | 20) & 0xFu; }
#define XB_SPIN(cond, bar) do { unsigned _sp = 0; while (cond) { __builtin_amdgcn_s_sleep(1); \
    if ((++_sp & 255u) == 0u) { if (xb_ld(&(bar)[XB_TMO])) break; if (_sp > XB_SPIN_CAP) { atomicAdd(&(bar)[XB_TMO], 1u); break; } } } } while (0)

struct XcdBarrier { unsigned* bar; unsigned x; volatile LAS unsigned* st; };

__device__ __forceinline__ XcdBarrier xcd_barrier_post(unsigned* bar, volatile LAS unsigned* st) {
    XcdBarrier b; b.bar = bar; b.x = xb_xcc_id(); b.st = st;
    if (threadIdx.x == 0) (void)xb_add(&bar[XB_XCNT(b.x)], 1u);
    return b;
}
__device__ __forceinline__ void xcd_barrier_complete(unsigned* bar, unsigned x, unsigned& nloc, unsigned& nx) {
    const unsigned G = gridDim.x * gridDim.y * gridDim.z;
    unsigned sum, cnt, mine, sp = 0u;
    for (;;) {
        sum = 0u; cnt = 0u; mine = 0u;
#pragma unroll
        for (unsigned j = 0; j < 16; ++j) { const unsigned c = xb_ld(&bar[XB_XCNT(j)]); sum += c; cnt += (c > 0u) ? 1u : 0u; mine = (j == x) ? c : mine; }
        if (sum == G) break;
        __builtin_amdgcn_s_sleep(1);
        if ((++sp & 255u) == 0u) { if (xb_ld(&bar[XB_TMO])) break; if (sp > XB_SPIN_CAP) { atomicAdd(&bar[XB_TMO], 1u); break; } }
    }
    nloc = mine > 0u ? mine : 1u; nx = cnt > 0u ? cnt : 1u;
}
__device__ __forceinline__ void xcd_barrier(const XcdBarrier& b) {
    asm volatile("s_waitcnt vmcnt(0)" ::: "memory");
    __syncthreads();
    if (threadIdx.x == 0) {
        unsigned* bar = b.bar;
        __builtin_amdgcn_s_waitcnt(0);
        unsigned nloc = b.st[0], nx = b.st[1];
        if (nloc == 0u) { xcd_barrier_complete(bar, b.x, nloc, nx); b.st[0] = nloc; b.st[1] = nx; }
        const unsigned old = xb_add(&bar[XB_XSUB(b.x)], 1u);
        const unsigned gen = old / nloc;
        if (old + 1u == (gen + 1u) * nloc) {
            __builtin_amdgcn_fence(__ATOMIC_RELEASE, "agent");
            asm volatile("s_waitcnt vmcnt(0)" ::: "memory");
            const unsigned og = xb_add(&bar[XB_TOP], 1u);
            const unsigned tg = og / nx;
            if (og + 1u == (tg + 1u) * nx) xb_add(&bar[XB_TOPGEN], 1u);
            else XB_SPIN(xb_ld(&bar[XB_TOPGEN]) == tg, bar);
            __builtin_amdgcn_fence(__ATOMIC_ACQUIRE, "agent");
            xb_add(&bar[XB_XGEN(b.x)], 1u);
            asm volatile("s_waitcnt vmcnt(0)" ::: "memory");
        } else {
            XB_SPIN(xb_ld(&bar[XB_XGEN(b.x)]) == gen, bar);
            __builtin_amdgcn_fence(__ATOMIC_ACQUIRE, "agent");
            asm volatile("s_waitcnt vmcnt(0)" ::: "memory");
        }
    }
    __syncthreads();
}

__device__ __forceinline__ void sincos_2pi(double x, double& s, double& c) {
    const double q = __builtin_rint(x * 4.0);
    const double y = (x - q * 0.25) * 6.283185307179586476925;
    const double y2 = y * y;
    double sp = -7.6471637318198164759e-13; sp = sp * y2 + 1.6059043836821614599e-10; sp = sp * y2 - 2.5052108385441718775e-8; sp = sp * y2 + 2.7557319223985890653e-6;
    sp = sp * y2 - 1.9841269841269841270e-4; sp = sp * y2 + 8.3333333333333333333e-3; sp = sp * y2 - 1.6666666666666666667e-1; sp = sp * y2 * y + y;
    double cp = 4.7794773323873852974e-14; cp = cp * y2 - 1.1470745597729724714e-11; cp = cp * y2 + 2.0876756987868098979e-9; cp = cp * y2 - 2.7557319223985890653e-7;
    cp = cp * y2 + 2.4801587301587301587e-5; cp = cp * y2 - 1.3888888888888888889e-3; cp = cp * y2 + 4.1666666666666666667e-2; cp = cp * y2 - 0.5; cp = cp * y2 + 1.0;
    const int qi = ((int)q) & 3;
    s = (qi == 0) ? sp : (qi == 1) ? cp : (qi == 2) ? -sp : -cp;
    c = (qi == 0) ? cp : (qi == 1) ? -sp : (qi == 2) ? -cp : sp;
}
__device__ __forceinline__ void sincos_rad(double a, double& s, double& c) {
    double f = a * 0.15915494309189533576888; f -= __builtin_floor(f);
    if (f >= 1.0) f = 0.0;
    sincos_2pi(f, s, c);
}
__device__ __forceinline__ double exp_small(double x) {
    double r = 1.0 / 479001600.0;
    r = r * x + 1.0 / 39916800.0; r = r * x + 1.0 / 3628800.0; r = r * x + 1.0 / 362880.0; r = r * x + 1.0 / 40320.0; r = r * x + 1.0 / 5040.0;
    r = r * x + 1.0 / 720.0; r = r * x + 1.0 / 120.0; r = r * x + 1.0 / 24.0; r = r * x + 1.0 / 6.0; r = r * x + 0.5; r = r * x + 1.0; r = r * x + 1.0;
    return r;
}
__device__ __forceinline__ float fast_exp(float x) { return __builtin_amdgcn_exp2f(x * 1.4426950408889634f); }
__device__ __forceinline__ float sigmoidf_(float x) { return 1.0f / (1.0f + fast_exp(-x)); }
__device__ __forceinline__ float siluf_(float x) { return x * sigmoidf_(x); }
__device__ __forceinline__ float tanhf_(float x) { const float e = fast_exp(-2.0f * fabsf(x)); const float t = (1.0f - e) / (1.0f + e); return x < 0.f ? -t : t; }
__device__ __forceinline__ float gelu_tanh(float x) { return 0.5f * x * (1.0f + tanhf_(0.7978845608028654f * (x + 0.044715f * x * x * x))); }

#ifndef PH_REPEAT
#define PH_REPEAT 0u
#endif
struct Args { const float* in[43]; float* out; unsigned char* ws; int ph_lo, ph_hi; };

#define GAS __attribute__((address_space(1)))
struct Frame {
    LAS unsigned char* lds; GAS unsigned char* ws; int tid, lane, wave, bid, G, gw, NGW;
    const __attribute__((address_space(4))) unsigned long long* kin;
};
#define INP(i) ((const float*)(const GAS float*)F.kin[i])
#define WSP(T, off) ((T*)(GAS T*)(F.ws + (off)))

__device__ __forceinline__ void tr_item(const float* W, int ldw, int N, bf16* WT, int ldt, int row_off, int rs16, LAS float* scr, int item, int lane) {
    const int nblk = N / 64, kb = item / nblk, nb = item % nblk, k0 = 64 * kb, n0 = 64 * nb;
    const int la = lane & 15, lb = lane >> 4;
    f32x4 v[16];
#pragma unroll
    for (int i = 0; i < 16; ++i) v[i] = *(const f32x4*)(W + (size_t)(k0 + 4 * i + lb) * ldw + n0 + 4 * la);
#pragma unroll
    for (int i = 0; i < 16; ++i) { const int kk = 4 * i + lb; LAS float* d = scr + (4 * la) * 65 + kk; d[0] = v[i].x; d[65] = v[i].y; d[130] = v[i].z; d[195] = v[i].w; }
    LDS_WAIT(); asm volatile("" ::: "memory");
    const int c = lane & 7;
#pragma unroll
    for (int j = 0; j < 8; ++j) { const int n = (lane >> 3) + 8 * j; const LAS float* s = scr + n * 65 + 8 * c;
        v4u o; o.x = cvt_pk_bf16(s[0], s[1]); o.y = cvt_pk_bf16(s[2], s[3]); o.z = cvt_pk_bf16(s[4], s[5]); o.w = cvt_pk_bf16(s[6], s[7]);
        const int nn = n0 + n, drow = row_off + (nn >> 4) * rs16 + (nn & 15);
        *(v4u*)(WT + (size_t)drow * ldt + k0 + 8 * c) = o; }
    LDS_WAIT(); asm volatile("" ::: "memory");
}

__device__ __forceinline__ void hyfilt_item(Frame& F, int pb) {
    const float* w1 = INP(19); const float* b1 = INP(20); const float* fq = INP(21); const float* w2 = INP(22); const float* b2 = INP(23); const float* w3 = INP(24);
    LAS float* z = (LAS float*)F.lds;
    LAS float* h1 = z + 1088;
    LAS float* h2 = h1 + 2048;
    const int tid = F.tid;
    for (int idx = tid; idx < 32 * 33; idx += NTHREADS) {
        const int p = idx / 33, f = idx % 33, i = pb * 32 + p;
        float v;
        if (f == 0) v = (float)i * (1.0f / (float)(SEQ - 1));
        else { const int j = (f - 1) & 15; const float fj = 1e-4f + (float)j * ((15.0f - 1e-4f) / 15.0f);
            double fr = (double)fj * (double)i / (double)SEQ; fr -= __builtin_floor(fr); double s, c; sincos_2pi(fr, s, c); v = (f <= 16) ? (float)c : (float)(-s); }
        z[p * 33 + f] = v;
    }
    __syncthreads();
    for (int idx = tid; idx < 2048; idx += NTHREADS) {
        const int p = idx >> 6, j = idx & 63; float a = b1[j];
        for (int f = 0; f < 33; ++f) a += z[p * 33 + f] * w1[f * 64 + j];
        double s, c; sincos_rad((double)(fq[j] * a), s, c); h1[idx] = (float)s;
    }
    __syncthreads();
    for (int idx = tid; idx < 2048; idx += NTHREADS) {
        const int p = idx >> 6, j = idx & 63; float a = b2[j];
        for (int k = 0; k < 64; ++k) a += h1[p * 64 + k] * w2[k * 64 + j];
        double s, c; sincos_rad((double)(fq[64 + j] * a), s, c); h2[idx] = (float)s;
    }
    __syncthreads();
    float* kT = WSP(float, WS_KT); float* normp = WSP(float, WS_NORMP);
    {
        const int lane = F.lane, l31 = lane & 31, lh = lane >> 5;
        float af[32];
#pragma unroll
        for (int s = 0; s < 32; ++s) af[s] = h2[l31 * 64 + 2 * s + lh];
        float bn[32];
        { const unsigned vo = (unsigned)(lh * 4096 + F.wave * 32 + l31);
#pragma unroll
          for (int s = 0; s < 32; ++s) bn[s] = (w3 + s * 8192)[vo]; }
#pragma nounroll
        for (int ct = F.wave; ct < 128; ct += NWAVES) {
            const int col = ct * 32 + l31;
            f32x16 acc;
#pragma unroll
            for (int r = 0; r < 16; ++r) acc[r] = 0.f;
            float bv[32];
#pragma unroll
            for (int s = 0; s < 32; ++s) bv[s] = bn[s];
            { const unsigned vo = (unsigned)(lh * 4096 + (ct + NWAVES < 128 ? ct + NWAVES : ct) * 32 + l31);
#pragma unroll
              for (int s = 0; s < 32; ++s) bn[s] = (w3 + s * 8192)[vo]; }
#pragma unroll
            for (int s = 0; s < 32; ++s) acc = __builtin_amdgcn_mfma_f32_32x32x2f32(af[s], bv[s], acc, 0, 0, 0);
#pragma unroll
            for (int s = 0; s < 32; s += 8) asm volatile("" : "+v"(acc) : "v"(bv[s]), "v"(bv[s + 1]), "v"(bv[s + 2]), "v"(bv[s + 3]), "v"(bv[s + 4]), "v"(bv[s + 5]), "v"(bv[s + 6]), "v"(bv[s + 7]));
            const int ch = col & 1023, dir = (col >> 10) & 1;
            const float adel = 3.0701134573253946f + (float)ch * ((15.350567286626972f - 3.0701134573253946f) / 1023.0f);
            float sabs = 0.f;
#pragma unroll
            for (int r = 0; r < 16; ++r) { const int i = pb * 32 + (r & 3) + 8 * (r >> 2) + 4 * lh; const float t = (float)i * (1.0f / (float)(SEQ - 1)); acc[r] *= fast_exp(-t * adel); if (!(dir == 1 && i == 0)) sabs += fabsf(acc[r]); }
            sabs += __shfl_xor(sabs, 32);
#pragma unroll
            for (int q = 0; q < 4; ++q) *(f32x4*)(kT + (size_t)col * SEQ + pb * 32 + 8 * q + 4 * lh) = (f32x4){acc[4 * q], acc[4 * q + 1], acc[4 * q + 2], acc[4 * q + 3]};
            if (lh == 0) normp[(size_t)pb * 4096 + col] = sabs;
        }
    }
    __syncthreads();
}

#define LDS_BARRIER() do { asm volatile("s_waitcnt lgkmcnt(0)" ::: "memory"); __builtin_amdgcn_s_barrier(); asm volatile("" ::: "memory"); } while (0)
struct TrItem { const float* W; bf16* WT; int ldw, ldt, row_off, rs16, k0, n0; };
__device__ __forceinline__ TrItem moe_tr_item(Frame& F, int it) {
    const int le = it / 192, q = it % 192; TrItem r;
    bf16* wc = (bf16*)(GAS bf16*)(F.ws + WS_WMOE + (size_t)le * MOE_E_BYTES);
    if (q < 128) { r.W = (q < 64 ? INP(40) : INP(41)) + (size_t)le * (2048 * 512); r.ldw = 512; r.WT = wc; r.ldt = 2048; r.row_off = (q < 64) ? 0 : 16; r.rs16 = 32; r.k0 = 64 * ((q & 63) >> 1); r.n0 = 256 * (q & 1); }
    else { const int x = q - 128; r.W = INP(42) + (size_t)le * (512 * 2048); r.ldw = 2048; r.WT = wc + 1024 * 2048; r.ldt = 512; r.row_off = 0; r.rs16 = 16; r.k0 = 64 * (x >> 3); r.n0 = 256 * (x & 7); }
    return r;
}
__device__ __forceinline__ void moe_convert_items(Frame& F) {
    constexpr int NIT = 128 * 192;
    const int t = F.tid, lane = t & 63, w = __builtin_amdgcn_readfirstlane(t >> 6);
    const int kc = t & 7, nb = t >> 3;
    int first, step, count;
    if (F.G == 256) { first = F.bid * (NIT / 256); step = 1; count = NIT / 256; }
    else { first = F.bid; step = F.G; count = (NIT - F.bid + F.G - 1) / F.G; }
    if (count <= 0) return;
    LAS unsigned char* lds = F.lds;
#define CV_DMA(sidx, buf) do { const int s_ = (sidx) < count ? (sidx) : count - 1; const TrItem c_ = moe_tr_item(F, first + s_ * step); \
        const float* g_ = c_.W + (size_t)(c_.k0 + 8 * w) * c_.ldw + c_.n0 + 4 * (lane ^ w); \
        _Pragma("unroll") for (int j_ = 0; j_ < 8; ++j_) \
            __builtin_amdgcn_global_load_lds((const unsigned*)(g_ + (size_t)j_ * c_.ldw), (LAS unsigned*)(lds + (buf) * 65536 + (8 * w + j_) * 1024), 16, 0, 2); } while (0)
    CV_DMA(0, 0); CV_DMA(1, 1);
#pragma nounroll
    for (int s = 0; s < count; ++s) {
        const int buf = s & 1;
        if (s == 0) asm volatile("s_waitcnt vmcnt(8)" ::: "memory"); else asm volatile("s_waitcnt vmcnt(12)" ::: "memory");
        __builtin_amdgcn_s_barrier(); asm volatile("" ::: "memory");
        const TrItem c = moe_tr_item(F, first + s * step);
        const LAS float* T = (const LAS float*)(lds + buf * 65536);
#pragma unroll
        for (int q = 0; q < 4; ++q) { const int n = nb + 64 * q; const LAS float* src = T + (8 * kc) * 256 + 4 * ((n >> 2) ^ kc) + (n & 3);
            v4u o; o.x = cvt_pk_bf16(src[0], src[256]); o.y = cvt_pk_bf16(src[512], src[768]); o.z = cvt_pk_bf16(src[1024], src[1280]); o.w = cvt_pk_bf16(src[1536], src[1792]);
            const int nn = c.n0 + n, drow = c.row_off + (nn >> 4) * c.rs16 + (nn & 15);
            __builtin_nontemporal_store(o, (v4u*)(c.WT + (size_t)drow * c.ldt + c.k0 + 8 * kc)); }
        LDS_BARRIER();
        CV_DMA(s + 2, buf);
    }
    asm volatile("s_waitcnt vmcnt(0)" ::: "memory");
#undef CV_DMA
}

__device__ __forceinline__ void p0_prologue(Frame& F) {
    if ((F.bid & 1) == 0) { for (int pb = F.bid; pb < SEQ / 32; pb += F.G) hyfilt_item(F, pb); __syncthreads(); }
    const int gt = F.bid * NTHREADS + F.tid, NGT = F.G * NTHREADS;
    {
        f32x2* rope = WSP(f32x2, WS_ROPE);
        for (int idx = gt; idx < 128 * 16; idx += NGT) { const int pos = idx >> 4, i = idx & 15;
            double inv = (i & 3) == 0 ? 1.0 : (i & 3) == 1 ? 0.56234132519034908 : (i & 3) == 2 ? 0.31622776601683794 : 0.17782794100389228;
            inv *= (i >> 2) == 0 ? 1.0 : (i >> 2) == 1 ? 0.1 : (i >> 2) == 2 ? 0.01 : 0.001;
            const float ang = (float)pos * (float)inv; double s, c; sincos_rad((double)ang, s, c); rope[idx] = (f32x2){(float)c, (float)s}; }
    }
    {
        f32x2* tw = WSP(f32x2, WS_TW);
        for (int idx = gt; idx < 16384; idx += NGT) { double s, c; sincos_2pi((double)idx * (1.0 / 16384.0), s, c); tw[idx] = (f32x2){(float)c, (float)(-s)}; }
    }
    {
        const float* are = INP(26); const float* aim = INP(27); const float* ldt = INP(28); const float* bre = INP(29); const float* bim = INP(30);
        f32x2* lamb = WSP(f32x2, WS_S5LAM); f32x2* bb = WSP(f32x2, WS_S5B); f32x2* l256 = WSP(f32x2, WS_S5L256);
        for (int idx = gt; idx < 2 * 64 * 64; idx += NGT) { const int dg = idx >> 6;
            const float dt = expf(ldt[dg]); const float ar = are[idx], ai = aim[idx];
            const float zr = ar * dt, zi = ai * dt; double s, c; sincos_rad((double)zi, s, c); const double er = exp_small((double)zr);
            const double lr = er * c, li = er * s; lamb[idx] = (f32x2){(float)lr, (float)li};
            { double pr = lr, pi = li; for (int q = 0; q < 8; ++q) { const double tr = pr * pr - pi * pi, ti = 2.0 * pr * pi; pr = tr; pi = ti; } l256[idx] = (f32x2){(float)pr, (float)pi}; }
            const double nr = lr - 1.0, ni = li, den = (double)ar * ar + (double)ai * ai; const double qr = (nr * ar + ni * ai) / den, qi = (ni * ar - nr * ai) / den;
            for (int cc = 0; cc < 16; ++cc) { const double br = bre[(size_t)idx * 16 + cc], bi = bim[(size_t)idx * 16 + cc]; bb[(size_t)idx * 16 + cc] = (f32x2){(float)(qr * br - qi * bi), (float)(qr * bi + qi * br)}; } }
    }
    {
        float* wrt = WSP(float, WS_WRT);
        for (int idx = gt; idx < 2 * 72 * 2048; idx += NGT) { const int l = idx / (72 * 2048), r = idx % (72 * 2048), n = r / 2048, k = r % 2048;
            wrt[idx] = n < 8 ? INP(36)[((size_t)l * 2048 + k) * 8 + n] : INP(38)[((size_t)l * 2048 + k) * 64 + (n - 8)]; }
    }
    {
        bf16* ha = WSP(bf16, WS_HA);
        for (int idx = gt; idx < 2048; idx += NGT) ha[(size_t)TT * 2048 + idx] = 0;
    }
    LAS float* scr = (LAS float*)(F.lds + F.wave * 16896);
    {
        const float* c = INP(1); const float* cctx = INP(3); const float* adaw = INP(4); float* part = WSP(float, WS_ADAP);
        for (int rep = 0; rep < (((PH_REPEAT >> 26) & 1u) ? 2 : 1); ++rep)
        for (int it = F.gw; it < 2 * 32 * 48; it += F.NGW) {
            const int l = it / (32 * 48), r = it % (32 * 48), ks = r / 48, jb = r % 48, k0 = ks * 64, j0 = jb * 256 + F.lane * 4;
            const float c0 = c[k0 + F.lane], c1 = c[2048 + k0 + F.lane], c2 = cctx[k0 + F.lane];
            const float s0 = c0 / (1.0f + expf(-c0)), s1 = c1 / (1.0f + expf(-c1)), s2 = c2 / (1.0f + expf(-c2));
            f32x4 a0 = {0.f, 0.f, 0.f, 0.f}, a1 = a0, a2 = a0;
            const float* wp = adaw + ((size_t)l * 2048 + k0) * 12288 + j0;
#pragma unroll 8
            for (int kk = 0; kk < 64; ++kk) { const f32x4 w = *(const f32x4*)(wp + (size_t)kk * 12288);
                const float t0 = __builtin_bit_cast(float, __builtin_amdgcn_readlane(__builtin_bit_cast(int, s0), kk));
                const float t1 = __builtin_bit_cast(float, __builtin_amdgcn_readlane(__builtin_bit_cast(int, s1), kk));
                const float t2 = __builtin_bit_cast(float, __builtin_amdgcn_readlane(__builtin_bit_cast(int, s2), kk));
                a0 += w * t0; a1 += w * t1; a2 += w * t2; }
            float* pp = part + ((size_t)(l * 32 + ks) * 3) * 12288 + j0;
            *(f32x4*)(pp) = a0; *(f32x4*)(pp + 12288) = a1; *(f32x4*)(pp + 2 * 12288) = a2;
        }
    }
    {
        constexpr int I0 = 1024, I1 = 512, I2 = 512, I3 = 1024, I4 = 2048, I5 = 1024, I6 = 64, I7 = 256, IE = 768;
        constexpr int NSMALL = I0 + I1 + I2 + I3 + I4 + I5 + I6 + I7;
        const int NITEMS = NSMALL;
        for (int rep = 0; rep < (((PH_REPEAT >> 27) & 1u) ? 2 : 1); ++rep)
        for (int it = F.gw; it < NITEMS; it += F.NGW) {
            int r = it;
            if (r < I0) { tr_item(INP(9), 4096, 2048, WSP(bf16, WS_WIN0), 2048, 0, 16, scr, r, F.lane); continue; } r -= I0;
            if (r < I1) { tr_item(INP(9) + 2048, 4096, 1024, WSP(bf16, WS_WIN0), 2048, 3072, 16, scr, r, F.lane); continue; } r -= I1;
            if (r < I2) { tr_item(INP(9) + 3072, 4096, 1024, WSP(bf16, WS_WIN0), 2048, 2048, 16, scr, r, F.lane); continue; } r -= I2;
            if (r < I3) { tr_item(INP(10), 2048, 2048, WSP(bf16, WS_WOUT0), 2048, 0, 16, scr, r, F.lane); continue; } r -= I3;
            if (r < I4) { tr_item(INP(15), 4096, 4096, WSP(bf16, WS_WIN1), 2048, 0, 16, scr, r, F.lane); continue; } r -= I4;
            if (r < I5) { tr_item(INP(16), 2048, 2048, WSP(bf16, WS_WOUT1), 2048, 0, 16, scr, r, F.lane); continue; } r -= I5;
            if (r < I6) { const int g = r / 16; tr_item(INP(13) + (size_t)g * 65536, 256, 256, WSP(bf16, WS_WPOOL), 256, g * 256, 16, scr, r % 16, F.lane); continue; } r -= I6;
            if (r < I7) { tr_item(INP(34), 1024, 1024, WSP(bf16, WS_WGLU), 1024, 0, 16, scr, r, F.lane); continue; } r -= I7;
        }
    }
    if ((F.bid & 1) != 0) { __syncthreads(); for (int pb = F.bid; pb < SEQ / 32; pb += F.G) hyfilt_item(F, pb); }
}

__device__ __forceinline__ void p1_reduce(Frame& F) {
    const int gt = F.bid * NTHREADS + F.tid, NGT = F.G * NTHREADS;
    const float* part = WSP(float, WS_ADAP); float* mod = WSP(float, WS_MOD); const float* adab = INP(5);
    for (int idx = gt; idx < 2 * 3 * 12288; idx += NGT) { const int l = idx / (3 * 12288), r = idx % (3 * 12288), m = r / 12288, j = r % 12288;
        float a = adab[l * 12288 + j];
        for (int ks = 0; ks < 32; ++ks) a += part[((size_t)(l * 32 + ks) * 3 + m) * 12288 + j];
        mod[idx] = a; }
    const float* normp = WSP(float, WS_NORMP); float* invn = WSP(float, WS_INVN);
    for (int idx = gt; idx < 2048; idx += NGT) { const int o = idx >> 10, ch = idx & 1023; float a = 0.f;
        for (int pb = 0; pb < 256; ++pb) a += normp[(size_t)pb * 4096 + o * 2048 + ch] + normp[(size_t)pb * 4096 + o * 2048 + 1024 + ch];
        invn[idx] = 1.0f / a; }
    {
        const f32x2* lamb = WSP(f32x2, WS_S5LAM); const f32x2* bbar = WSP(f32x2, WS_S5B); const float* cre = INP(31); const float* cim = INP(32);
        bf16* W1 = WSP(bf16, WS_S5W1); bf16* W3 = WSP(bf16, WS_S5W3); bf16* KT = WSP(bf16, WS_S5KT); f32x2* l16 = WSP(f32x2, WS_S5L16);
#define S5_POWF(l_, e_, pw_) do { pw_ = (f32x2){1.f, 0.f}; f32x2 b_ = l_; for (int q_ = (e_); q_ > 0; q_ >>= 1) { if (q_ & 1) pw_ = (f32x2){pw_.x * b_.x - pw_.y * b_.y, pw_.x * b_.y + pw_.y * b_.x}; b_ = (f32x2){b_.x * b_.x - b_.y * b_.y, 2.f * b_.x * b_.y}; } } while (0)
        for (int idx = gt; idx < 128 * 64; idx += NGT) { f32x2 pw; S5_POWF(lamb[idx], 16, pw); l16[idx] = pw; }
        for (int idx = gt; idx < 128 * 128 * 32; idx += NGT) {
            const int k8 = idx & 31, n = (idx >> 5) & 127, dg = idx >> 12, sigma = k8 >> 1, h = k8 & 1, p = (n & 15) + 16 * ((n >> 4) & 3), im = n >> 6;
            f32x2 pw; S5_POWF(lamb[dg * 64 + p], 15 - sigma, pw);
            const f32x4* bp = (const f32x4*)(bbar + ((size_t)dg * 64 + p) * 16 + 8 * h); float o[8];
#pragma unroll
            for (int j = 0; j < 4; ++j) { const f32x4 q = bp[j]; o[2 * j] = im ? (pw.x * q.y + pw.y * q.x) : (pw.x * q.x - pw.y * q.y); o[2 * j + 1] = im ? (pw.x * q.w + pw.y * q.z) : (pw.x * q.z - pw.y * q.w); }
            v4u w; w.x = pk2(o[0], o[1]); w.y = pk2(o[2], o[3]); w.z = pk2(o[4], o[5]); w.w = pk2(o[6], o[7]);
            *(v4u*)(W1 + (size_t)idx * 8) = w; }
        for (int idx = gt; idx < 128 * 256 * 16; idx += NGT) {
            const int k8 = idx & 15, n = (idx >> 4) & 255, dg = idx >> 12, tau = n >> 4, cout = n & 15; float o[8];
#pragma unroll
            for (int j = 0; j < 4; ++j) { const int p = 4 * k8 + j; f32x2 pw; S5_POWF(lamb[dg * 64 + p], tau + 1, pw);
                const float cr = cre[((size_t)dg * 16 + cout) * 64 + p], ci = cim[((size_t)dg * 16 + cout) * 64 + p]; o[2 * j] = cr * pw.x - ci * pw.y; o[2 * j + 1] = -(cr * pw.y + ci * pw.x); }
            v4u w; w.x = pk2(o[0], o[1]); w.y = pk2(o[2], o[3]); w.z = pk2(o[4], o[5]); w.w = pk2(o[6], o[7]);
            *(v4u*)(W3 + (size_t)idx * 8) = w; }
        for (int idx = gt; idx < 128 * 17 * 16 * 2; idx += NGT) {
            const int h = idx & 1, cout = (idx >> 1) & 15, d1 = (idx >> 5) % 17, dg = (idx >> 5) / 17;
            float acc[8];
#pragma unroll
            for (int j = 0; j < 8; ++j) acc[j] = 0.f;
            if (d1 > 0) { for (int p = 0; p < 64; ++p) { f32x2 pw; S5_POWF(lamb[dg * 64 + p], d1 - 1, pw);
                const float cr = cre[((size_t)dg * 16 + cout) * 64 + p], ci = cim[((size_t)dg * 16 + cout) * 64 + p]; const float gr = cr * pw.x - ci * pw.y, gi = cr * pw.y + ci * pw.x;
                const f32x4* bp = (const f32x4*)(bbar + ((size_t)dg * 64 + p) * 16 + 8 * h);
#pragma unroll
                for (int j = 0; j < 4; ++j) { const f32x4 q = bp[j]; acc[2 * j] += gr * q.x - gi * q.y; acc[2 * j + 1] += gr * q.z - gi * q.w; } } }
            v4u w; w.x = pk2(acc[0], acc[1]); w.y = pk2(acc[2], acc[3]); w.z = pk2(acc[4], acc[5]); w.w = pk2(acc[6], acc[7]);
            *(v4u*)(KT + (size_t)idx * 8) = w; }
#undef S5_POWF
    }
}

__device__ __forceinline__ const float* modp(Frame& F, int l, int m, int c) { return WSP(float, WS_MOD) + ((size_t)(l * 3 + m) * 6 + c) * 2048; }
__device__ __forceinline__ int row_stream(int r) { return r < TL ? r / SEQ : 2; }

template <int MODE>
__device__ __forceinline__ void norm_phase(Frame& F, int l, float* dout) {
    const int nrows = (MODE == 3 || (MODE == 1 && l == 1)) ? TL : TT;
    float* xbuf = WSP(float, WS_X); bf16* ha = WSP(bf16, WS_HA); const bf16* Y = WSP(bf16, WS_Y);
    const float* gvec = (MODE == 0) ? INP(6) : (MODE == 1) ? INP(7) + l * 2048 : (MODE == 2) ? INP(6) + 2048 : INP(8);
    const int lane = F.lane;
    for (int r = F.gw; r < nrows; r += F.NGW) {
        const int m = row_stream(r);
        const float* src = (MODE == 0) ? (r < TL ? INP(0) + (size_t)r * 2048 : INP(2) + (size_t)(r - TL) * 2048) : xbuf + (size_t)r * 2048;
        f32x4 v[8]; float ss = 0.f;
#pragma unroll
        for (int j = 0; j < 8; ++j) v[j] = *(const f32x4*)(src + 4 * lane + 256 * j);
        if (MODE == 2 || MODE == 3) {
            const float* g2 = modp(F, MODE == 2 ? 0 : 1, m, 5);
            const bf16* y0 = Y + (size_t)(2 * r) * 2048; const bf16* y1 = y0 + 2048;
#pragma unroll
            for (int j = 0; j < 8; ++j) { const int c = 4 * lane + 256 * j; const v2u a = *(const v2u*)(y0 + c), b = *(const v2u*)(y1 + c); const f32x4 gg = *(const f32x4*)(g2 + c);
                v[j].x += gg.x * (bflo(a.x) + bflo(b.x)); v[j].y += gg.y * (bfhi(a.x) + bfhi(b.x)); v[j].z += gg.z * (bflo(a.y) + bflo(b.y)); v[j].w += gg.w * (bfhi(a.y) + bfhi(b.y)); }
            if (MODE == 2) {
#pragma unroll
                for (int j = 0; j < 8; ++j) *(f32x4*)(xbuf + (size_t)r * 2048 + 4 * lane + 256 * j) = v[j];
            }
        }
#pragma unroll
        for (int j = 0; j < 8; ++j) ss += (v[j].x * v[j].x + v[j].y * v[j].y) + (v[j].z * v[j].z + v[j].w * v[j].w);
        ss = wave_sum(ss);
        const float rs = 1.0f / sqrtf(ss * (1.0f / 2048.0f) + EPS);
        if (MODE == 3) {
#pragma unroll
            for (int j = 0; j < 8; ++j) { const int c = 4 * lane + 256 * j; const f32x4 gg = *(const f32x4*)(gvec + c); *(f32x4*)(dout + (size_t)r * 2048 + c) = v[j] * rs * gg; }
            continue;
        }
        const int lm = (MODE == 2) ? 1 : l;
        const float* sh = modp(F, lm, m, MODE == 1 ? 3 : 0); const float* sc = modp(F, lm, m, MODE == 1 ? 4 : 1);
#pragma unroll
        for (int j = 0; j < 8; ++j) { const int c = 4 * lane + 256 * j; const f32x4 gg = *(const f32x4*)(gvec + c), s1 = *(const f32x4*)(sc + c), s0 = *(const f32x4*)(sh + c);
            v[j] = (v[j] * rs * gg) * (1.0f + s1) + s0;
            v2u o; o.x = pk2(v[j].x, v[j].y); o.y = pk2(v[j].z, v[j].w); *(v2u*)(ha + (size_t)r * 2048 + c) = o; }
    }
}

__device__ __forceinline__ void ffn_norm_router_phase(Frame& F, int l) {
    const int nrows = (l == 1) ? TL : TT;
    const float* xbuf = WSP(float, WS_X); bf16* ha = WSP(bf16, WS_HA);
    const float* gvec = INP(7) + l * 2048;
    const float* wrt = WSP(float, WS_WRT) + (size_t)l * 72 * 2048;
    LAS float* hl = (LAS float*)F.lds;
    LAS float* lg = (LAS float*)(F.lds + 131584);
    const int lane = F.lane, tid = F.tid, l31 = lane & 31, lh = lane >> 5;
    for (int it = F.bid; it < nrows / 32; it += F.G) {
        const int r0 = it * 32 + F.wave * 4;
        f32x4 v[4][8];
#pragma unroll
        for (int rr = 0; rr < 4; ++rr)
#pragma unroll
            for (int j = 0; j < 8; ++j) v[rr][j] = *(const f32x4*)(xbuf + (size_t)(r0 + rr) * 2048 + 4 * lane + 256 * j);
        const int m = row_stream(r0);
        const float* sh = modp(F, l, m, 3); const float* sc = modp(F, l, m, 4);
        float rs[4];
#pragma unroll
        for (int rr = 0; rr < 4; ++rr) { float ss = 0.f;
#pragma unroll
            for (int j = 0; j < 8; ++j) ss += (v[rr][j].x * v[rr][j].x + v[rr][j].y * v[rr][j].y) + (v[rr][j].z * v[rr][j].z + v[rr][j].w * v[rr][j].w);
            ss = wave_sum(ss); rs[rr] = 1.0f / sqrtf(ss * (1.0f / 2048.0f) + EPS); }
#pragma unroll
        for (int j = 0; j < 8; ++j) { if ((j & 1) == 0) __builtin_amdgcn_sched_barrier(0); const int c = 4 * lane + 256 * j; const f32x4 gg = *(const f32x4*)(gvec + c), s1 = *(const f32x4*)(sc + c), s0 = *(const f32x4*)(sh + c);
#pragma unroll
            for (int rr = 0; rr < 4; ++rr) { v[rr][j] = (v[rr][j] * rs[rr] * gg) * (1.0f + s1) + s0;
                v2u o; o.x = cvt_pk_bf16(v[rr][j].x, v[rr][j].y); o.y = cvt_pk_bf16(v[rr][j].z, v[rr][j].w); *(v2u*)(ha + (size_t)(r0 + rr) * 2048 + c) = o; } }
        f32x16 acc[3];
#pragma unroll
        for (int nt = 0; nt < 3; ++nt)
#pragma unroll
            for (int r = 0; r < 16; ++r) acc[nt][r] = 0.f;
        const int nr2 = (64 + l31 < 72) ? 64 + l31 : 71;
#pragma unroll
        for (int hK = 0; hK < 2; ++hK) {
#pragma unroll
            for (int rr = 0; rr < 4; ++rr)
#pragma unroll
                for (int j = 0; j < 4; ++j) *(LAS f32x4*)(hl + (F.wave * 4 + rr) * 1028 + 256 * j + 4 * lane) = v[rr][4 * hK + j];
            __syncthreads();
            const LAS float* ap = hl + l31 * 1028 + 128 * F.wave + 4 * lh;
            const float* wp = wrt + 1024 * hK + 128 * F.wave + 4 * lh;
            const float* w0 = wp + (size_t)l31 * 2048; const float* w1 = wp + (size_t)(32 + l31) * 2048; const float* w2 = wp + (size_t)nr2 * 2048;
#pragma nounroll
            for (int jc = 0; jc < 4; ++jc) {
                f32x4 af[4], b0[4], b1[4], b2[4];
#pragma unroll
                for (int jj = 0; jj < 4; ++jj) { const int o = 8 * (4 * jc + jj); b0[jj] = *(const f32x4*)(w0 + o); b1[jj] = *(const f32x4*)(w1 + o); b2[jj] = *(const f32x4*)(w2 + o); af[jj] = *(const LAS f32x4*)(ap + o); }
#pragma unroll
                for (int jj = 0; jj < 4; ++jj)
#pragma unroll
                    for (int c = 0; c < 4; ++c) {
                        acc[0] = __builtin_amdgcn_mfma_f32_32x32x2f32(af[jj][c], b0[jj][c], acc[0], 0, 0, 0);
                        acc[1] = __builtin_amdgcn_mfma_f32_32x32x2f32(af[jj][c], b1[jj][c], acc[1], 0, 0, 0);
                        acc[2] = __builtin_amdgcn_mfma_f32_32x32x2f32(af[jj][c], b2[jj][c], acc[2], 0, 0, 0); }
                asm volatile("" : "+v"(acc[0]), "+v"(acc[1]), "+v"(acc[2]) : "v"(af[0]), "v"(af[1]), "v"(af[2]), "v"(af[3]), "v"(b0[0]), "v"(b0[1]), "v"(b0[2]), "v"(b0[3]),
                             "v"(b1[0]), "v"(b1[1]), "v"(b1[2]), "v"(b1[3]), "v"(b2[0]), "v"(b2[1]), "v"(b2[2]), "v"(b2[3]));
            }
            __syncthreads();
        }
        {
            LAS float* pw = hl + F.wave * (32 * 96);
#pragma unroll
            for (int nt = 0; nt < 3; ++nt)
#pragma unroll
                for (int r = 0; r < 16; ++r) pw[((r & 3) + 8 * (r >> 2) + 4 * lh) * 96 + 32 * nt + l31] = acc[nt][r];
        }
        __syncthreads();
        for (int idx = tid; idx < 32 * 72; idx += NTHREADS) { const int row = idx / 72, col = idx - row * 72; float s = 0.f;
#pragma unroll
            for (int w = 0; w < 8; ++w) s += hl[w * (32 * 96) + row * 96 + col];
            lg[row * 80 + col] = s; }
        __syncthreads();
        if (lane < 4) {
            const int r = r0 + lane; const LAS float* L = lg + (F.wave * 4 + lane) * 80;
            float gl[8]; float gmax = -INFINITY; int gi = 0;
#pragma unroll
            for (int j = 0; j < 8; ++j) { gl[j] = L[j] + INP(37)[l * 8 + j]; if (gl[j] > gmax) { gmax = gl[j]; gi = j; } }
            float gsum = 0.f;
#pragma unroll
            for (int j = 0; j < 8; ++j) gsum += expf(gl[j] - gmax);
            const float pg_top = 1.0f / gsum;
            float pe[8]; float emax = -INFINITY;
#pragma unroll
            for (int j = 0; j < 8; ++j) { pe[j] = L[8 + gi * 8 + j] + INP(39)[l * 64 + gi * 8 + j]; emax = fmaxf(emax, pe[j]); }
            float esum = 0.f;
#pragma unroll
            for (int j = 0; j < 8; ++j) { pe[j] = expf(pe[j] - emax); esum += pe[j]; }
            int e1 = 0; float p1 = -1.f;
#pragma unroll
            for (int j = 0; j < 8; ++j) { pe[j] /= esum; if (pe[j] > p1) { p1 = pe[j]; e1 = j; } }
            int e2 = 0; float p2 = -1.f;
#pragma unroll
            for (int j = 0; j < 8; ++j) { if (j != e1 && pe[j] > p2) { p2 = pe[j]; e2 = j; } }
            const float den = p1 + p2; const float g1 = pg_top * p1 / den, g2 = pg_top * p2 / den;
            unsigned* cnt = WSP(unsigned, WS_CTL) + CW_CNT + l * 64 * CSTR; int* tokl = WSP(int, WS_TOKL); float* gatel = WSP(float, WS_GATEL);
            const int ex1 = gi * 8 + e1, ex2 = gi * 8 + e2;
            const unsigned k1 = atomicAdd(cnt + ex1 * CSTR, 1u); tokl[(size_t)ex1 * LISTCAP + k1] = 2 * r; gatel[(size_t)ex1 * LISTCAP + k1] = g1;
            const unsigned k2 = atomicAdd(cnt + ex2 * CSTR, 1u); tokl[(size_t)ex2 * LISTCAP + k2] = 2 * r + 1; gatel[(size_t)ex2 * LISTCAP + k2] = g2;
        }
        __syncthreads();
    }
}

#define EPI_ARGS const f32x4 (&acc)[2][2][4][2], const pg8::Unit& u, int wr, int wc, int fr, int fq
__device__ __forceinline__ void st_bf4(bf16* p, f32x4 v) { v2u o; o.x = cvt_pk_bf16(v.x, v.y); o.y = cvt_pk_bf16(v.z, v.w); *(v2u*)p = o; }
__device__ __forceinline__ void st_bf8(bf16* p, f32x4 a, f32x4 b) { v4u o; o.x = cvt_pk_bf16(a.x, a.y); o.y = cvt_pk_bf16(a.z, a.w); o.z = cvt_pk_bf16(b.x, b.y); o.w = cvt_pk_bf16(b.z, b.w); *(v4u*)p = o; }

struct EpiQKP {
    static constexpr bool PERM = false;
    bf16* Q; bf16* Kb; bf16* P; const f32x2* rope;
    __device__ __forceinline__ void operator()(EPI_ARGS) const {
        const int sect = u.pn >> 2, cb = (u.pn & 3) * 256; const bool latent = u.pm < TL / 256;
#pragma unroll
        for (int ai = 0; ai < 2; ++ai)
#pragma unroll
            for (int m = 0; m < 4; ++m) {
                const int r = u.pm * 256 + ai * 128 + wr * 64 + m * 16 + fr;
                int b, t; if (latent) { b = r / SEQ; t = r % SEQ; } else { b = (r - TL) / CTX; t = (r - TL) % CTX; }
                f32x4 cs0 = {1.f, 0.f, 1.f, 0.f}, cs1 = cs0;
                if (latent && sect < 2) { const int pos = (wc & 1) ? (t & 63) : (t >> 6); const f32x4* rp = (const f32x4*)(rope + pos * 16 + 4 * fq); cs0 = rp[0]; cs1 = rp[1]; }
#pragma unroll
                for (int bj = 0; bj < 2; ++bj) {
                    const int c0 = cb + bj * 128 + wc * 32 + 4 * fq;
                    f32x4 a = acc[ai][bj][m][0], bb = acc[ai][bj][m][1];
                    if (sect < 2) {
                        const f32x4 co = {cs0.x, cs0.z, cs1.x, cs1.z}, si = {cs0.y, cs0.w, cs1.y, cs1.w};
                        const f32x4 oa = a * co - bb * si, ob = a * si + bb * co; a = oa; bb = ob;
                    }
                    if (sect == 0) { a = a * QSCALE; bb = bb * QSCALE; bf16* d = Q + (size_t)r * 1024 + c0; st_bf4(d, a); st_bf4(d + 16, bb); }
                    else if (sect == 1) { const size_t kr = (size_t)b * KEYS + (latent ? CTX + t : t); bf16* d = Kb + kr * 1024 + c0; st_bf4(d, a); st_bf4(d + 16, bb); }
                    else { bf16* d = P + (size_t)r * 1024 + c0; st_bf4(d, a); st_bf4(d + 16, bb); }
                }
            }
    }
};
struct EpiVT {
    static constexpr bool PERM = false;
    bf16* VT;
    __device__ __forceinline__ void operator()(EPI_ARGS) const {
        const bool latent = u.pn < TL / 256; const int b = latent ? u.pn / 32 : u.pn - TL / 256; const int key_t0 = latent ? CTX + (u.pn % 32) * 256 : 0;
        const int kperm = 8 * (fq & 1) + 4 * (fq >> 1);
#pragma unroll
        for (int ai = 0; ai < 2; ++ai)
#pragma unroll
            for (int m = 0; m < 4; ++m) {
                const int rr = u.pm * 256 + ai * 128 + wr * 64 + m * 16 + fr;
                bf16* rowp = VT + ((size_t)b * 1024 + rr) * KEYS + key_t0;
#pragma unroll
                for (int bj = 0; bj < 2; ++bj)
#pragma unroll
                    for (int n = 0; n < 2; ++n) st_bf4(rowp + bj * 128 + wc * 32 + 16 * n + kperm, acc[ai][bj][m][n]);
            }
    }
};
struct EpiScaleBf16 {
    static constexpr bool PERM = true;
    bf16* O; int ldo, coff; const float* cscale;
    __device__ __forceinline__ void operator()(EPI_ARGS) const {
#pragma unroll
        for (int bj = 0; bj < 2; ++bj) { const int c = u.pn * 256 + bj * 128 + wc * 32 + 8 * fq; const f32x4 s0 = *(const f32x4*)(cscale + c), s1 = *(const f32x4*)(cscale + c + 4);
#pragma unroll
            for (int ai = 0; ai < 2; ++ai)
#pragma unroll
                for (int m = 0; m < 4; ++m) { const int r = u.pm * 256 + ai * 128 + wr * 64 + m * 16 + fr; st_bf8(O + (size_t)r * ldo + coff + c, acc[ai][bj][m][0] * s0, acc[ai][bj][m][1] * s1); } }
    }
};
struct EpiBf16 {
    static constexpr bool PERM = true;
    bf16* O; int ldo;
    __device__ __forceinline__ void operator()(EPI_ARGS) const {
#pragma unroll
        for (int ai = 0; ai < 2; ++ai)
#pragma unroll
            for (int m = 0; m < 4; ++m) { const int r = u.pm * 256 + ai * 128 + wr * 64 + m * 16 + fr; bf16* rowp = O + (size_t)r * ldo + u.pn * 256 + wc * 32 + 8 * fq;
#pragma unroll
                for (int bj = 0; bj < 2; ++bj) st_bf8(rowp + bj * 128, acc[ai][bj][m][0], acc[ai][bj][m][1]); }
    }
};
struct EpiRes {
    static constexpr bool PERM = false;
    const float* xlat; const float* xctx; float* xout; const float* gate0;
    __device__ __forceinline__ void operator()(EPI_ARGS) const {
        const bool latent = u.pm < TL / 256;
#pragma unroll
        for (int ai = 0; ai < 2; ++ai)
#pragma unroll
            for (int m = 0; m < 4; ++m) { const int r = u.pm * 256 + ai * 128 + wr * 64 + m * 16 + fr; const int ms = latent ? r / SEQ : 2;
                const float* xi = latent ? xlat + (size_t)r * 2048 : xctx + (size_t)(r - TL) * 2048; const float* gp = gate0 + (size_t)ms * 12288;
#pragma unroll
                for (int bj = 0; bj < 2; ++bj)
#pragma unroll
                    for (int n = 0; n < 2; ++n) { const int c = u.pn * 256 + bj * 128 + wc * 32 + 16 * n + 4 * fq;
                        const f32x4 xv = *(const f32x4*)(xi + c), gv = *(const f32x4*)(gp + c); *(f32x4*)(xout + (size_t)r * 2048 + c) = xv + gv * acc[ai][bj][m][n]; } }
    }
};
struct EpiMoeUp {
    static constexpr bool PERM = false;
    bf16* H;
    __device__ __forceinline__ void operator()(EPI_ARGS) const {
#pragma unroll
        for (int ai = 0; ai < 2; ++ai)
#pragma unroll
            for (int m = 0; m < 4; ++m) { const size_t r = (size_t)u.pm * 256 + ai * 128 + wr * 64 + m * 16 + fr;
#pragma unroll
                for (int bj = 0; bj < 2; ++bj) { const int hc = (u.pn * 256 + bj * 128 + wc * 32) / 2 + 4 * fq; const f32x4 a = acc[ai][bj][m][0], b = acc[ai][bj][m][1];
                    const f32x4 h = {siluf_(a.x) * b.x, siluf_(a.y) * b.y, siluf_(a.z) * b.z, siluf_(a.w) * b.w}; st_bf4(H + r * 512 + hc, h); } }
    }
};
struct EpiMoeDown {
    static constexpr bool PERM = true;
    bf16* Y; const int* tokl; const float* gatel; const unsigned* cnt;
    __device__ __forceinline__ void operator()(EPI_ARGS) const {
        const int ce = (int)cnt[u.e * CSTR];
#pragma unroll
        for (int ai = 0; ai < 2; ++ai)
#pragma unroll
            for (int m = 0; m < 4; ++m) { const int idx = u.idx0 + ai * 128 + wr * 64 + m * 16 + fr;
                if (idx < ce) { const int pair = tokl[(size_t)u.e * LISTCAP + idx]; const float gt = gatel[(size_t)u.e * LISTCAP + idx]; bf16* rowp = Y + (size_t)pair * 2048 + u.pn * 256 + wc * 32 + 8 * fq;
#pragma unroll
                    for (int bj = 0; bj < 2; ++bj) st_bf8(rowp + bj * 128, acc[ai][bj][m][0] * gt, acc[ai][bj][m][1] * gt); } }
    }
};
struct EpiGlu {
    static constexpr bool PERM = true;
    bf16* O; int ldo, coff; const bf16* Gb; const float* bias;
    __device__ __forceinline__ void operator()(EPI_ARGS) const {
#pragma unroll
        for (int ai = 0; ai < 2; ++ai)
#pragma unroll
            for (int m = 0; m < 4; ++m) { const int r = u.pm * 256 + ai * 128 + wr * 64 + m * 16 + fr;
#pragma unroll
                for (int bj = 0; bj < 2; ++bj) { const int c = u.pn * 256 + bj * 128 + wc * 32 + 8 * fq; const f32x4 b0 = *(const f32x4*)(bias + c), b1 = *(const f32x4*)(bias + c + 4); const v4u gw = *(const v4u*)(Gb + (size_t)r * 1024 + c);
                    const f32x4 a0 = acc[ai][bj][m][0] + b0, a1 = acc[ai][bj][m][1] + b1;
                    const f32x4 o0 = {bflo(gw.x) * sigmoidf_(a0.x), bfhi(gw.x) * sigmoidf_(a0.y), bflo(gw.y) * sigmoidf_(a0.z), bfhi(gw.y) * sigmoidf_(a0.w)};
                    const f32x4 o1 = {bflo(gw.z) * sigmoidf_(a1.x), bfhi(gw.z) * sigmoidf_(a1.y), bflo(gw.w) * sigmoidf_(a1.z), bfhi(gw.w) * sigmoidf_(a1.w)};
                    st_bf8(O + (size_t)r * ldo + coff + c, o0, o1); } }
    }
};

struct MoeOrder {
    const LAS int* bstart;
    const unsigned* cnt; const int* tokl; int nN, G, c, nblk; long bstride, eoff; bool up;
    __device__ bool next(int i, pg8::Unit& u) const {
        const long Lx = (long)i * G + c; if (Lx >= (long)nblk * nN) return false;
        const int blk = (int)(Lx / nN); u.pn = (int)(Lx % nN); u.pm = blk;
        const int e = bstart[65 + blk];
        u.e = e; u.idx0 = (blk - bstart[e]) * 256;
        u.aoff = up ? 0 : (long)blk * 256 * 512 * 2;
        u.boff = (long)e * (long)MOE_E_BYTES + eoff + (long)u.pn * bstride;
        return true;
    }
    __device__ int arow(const pg8::Unit& u, int row) const { const int idx = u.idx0 + row; return idx < (int)cnt[u.e * CSTR] ? (tokl[(size_t)u.e * LISTCAP + idx] >> 1) : TT; }
};

__device__ __forceinline__ void tile_order(int wgid, int nM, int nN, int& pm, int& pn) {
    const int nwg = nM * nN; { const int q = nwg / 8, r = nwg % 8, xcd = wgid % 8, off = wgid / 8; wgid = (xcd < r ? xcd * (q + 1) : r * (q + 1) + (xcd - r) * q) + off; }
    const int nig = 8 * nN, gid = wgid / nig, fm = gid * 8, gsz = (nM - fm) < 8 ? (nM - fm) : 8;
    pm = fm + ((wgid % nig) % gsz); pn = (wgid % nig) / gsz;
}
struct InProj0Order {
    int G, c; long offA1, offB1, offA2, offB2;
    __device__ bool next(int i, pg8::Unit& u) const {
        const int Lx = i * G + c; constexpr int N1 = (TT / 256) * 12, N2 = 4 * (TT / 256); constexpr long TS = 256L * 2048 * 2;
        if (Lx >= N1 + N2) return false;
        u.idx0 = 0;
        if (Lx < N1) { tile_order(Lx, TT / 256, 12, u.pm, u.pn); u.aoff = offA1 + (long)u.pm * TS; u.boff = offB1 + (long)u.pn * TS; u.e = 0; }
        else { tile_order(Lx - N1, 4, TT / 256, u.pm, u.pn); u.aoff = offA2 + (long)u.pm * TS; u.boff = offB2 + (long)u.pn * TS; u.e = 1; }
        return true;
    }
    __device__ int arow(const pg8::Unit&, int) const { return 0; }
};
struct EpiInProj0 {
    static constexpr bool PERM = false;
    EpiQKP e1; EpiVT e2;
    __device__ __forceinline__ void operator()(EPI_ARGS) const { if (u.e == 0) e1(acc, u, wr, wc, fr, fq); else e2(acc, u, wr, wc, fr, fq); }
};

#ifdef ATT_NORARE
#define ATT_RARE(mx) false
#else
#define ATT_RARE(mx) __any(mx > 8.0f)
#endif
__device__ __forceinline__ float xhalf_max(float v) {
    const auto r = __builtin_amdgcn_permlane32_swap(__builtin_bit_cast(unsigned, v), __builtin_bit_cast(unsigned, v), false, false);
    return fmaxf(__builtin_bit_cast(float, r[0]), __builtin_bit_cast(float, r[1]));
}
__device__ __forceinline__ void attn_phase(Frame& F, const int cvslot) {
    const bf16* Q = WSP(bf16, WS_Q); const bf16* Kb = WSP(bf16, WS_K); const bf16* VT = WSP(bf16, WS_VT); bf16* cat = WSP(bf16, WS_CAT);
    LAS unsigned char* lds = F.lds;
    const int lane0 = F.lane;
    float lam;
    { const float* lv = INP(11); float a = lv[lane0] * lv[64 + lane0], b = lv[128 + lane0] * lv[192 + lane0]; a = wave_sum(a); b = wave_sum(b); lam = expf(a) - expf(b) + 0.2f; }
    const float* subg = INP(12);
    const int NU = 1024 + 32;
    const int xcd = F.bid & 7, jcu = F.bid >> 3;
    for (int it = 0;; ++it) {
        if (it == cvslot) { for (int rep_ = 0; rep_ < (((PH_REPEAT >> 26) & 1u) ? 2 : 1); ++rep_) { moe_convert_items(F); __syncthreads(); } }
        int tl_ = F.tid; asm volatile("" : "+v"(tl_));
        const int lane = tl_ & 63, w = __builtin_amdgcn_readfirstlane(tl_ >> 6), sub = w & 1, qw = w >> 1, r32 = lane & 31, hi = lane >> 5;
        int uidx;
        if (F.G == 256) { if (it < 4) uidx = 128 * xcd + it * 32 + jcu; else if (it == 4 && F.bid < 32) uidx = 1024 + F.bid; else break; }
        else { uidx = it * F.G + F.bid; if (uidx >= NU) break; }
        int b, head, q0row, nt; size_t kbase;
        if (uidx < 1024) { const int combo = uidx >> 6, qb = uidx & 63; b = combo >> 3; head = combo & 7; q0row = b * SEQ + qb * 128; nt = KEYS / 64; }
        else { const int v = uidx - 1024; b = v >> 4; head = (v >> 1) & 7; q0row = TL + b * CTX + (v & 1) * 128; nt = CTX / 64; }
        kbase = (size_t)b * KEYS;
        bf16x8 qf[4];
        { const bf16* qp = Q + (size_t)(q0row + qw * 32 + r32) * 1024 + head * 128 + sub * 64 + hi * 8;
#pragma unroll
          for (int ks = 0; ks < 4; ++ks) qf[ks] = *(const bf16x8*)(qp + ks * 16); }
        const char* gsrc[4];
#pragma unroll
        for (int j = 0; j < 4; ++j) { const int pi = w * 4 + j, rr = lane >> 3, pc = lane & 7;
            if (pi < 16) { const int key = (pi & 7) * 8 + rr, c = pc ^ ((key >> 1) & 7); gsrc[j] = (const char*)(Kb + (kbase + key) * 1024 + head * 128 + (pi >> 3) * 64 + c * 8); }
            else { const int dvr = (pi - 16) * 8 + rr, c = pc ^ ((dvr >> 1) & 7); gsrc[j] = (const char*)(VT + ((size_t)(b * 8 + head) * 128 + dvr) * KEYS + c * 8); } }
        const size_t gstep = (w < 4) ? (size_t)65536 * 2 : (size_t)64 * 2;
        const unsigned ldst = (unsigned)w * 4096u;
#define ATT_DMA(t, buf) do { _Pragma("unroll") for (int _j = 0; _j < 4; ++_j) \
            __builtin_amdgcn_global_load_lds((const unsigned*)(gsrc[_j] + (size_t)(t) * gstep), (LAS unsigned*)(lds + (buf) * 32768 + ldst + _j * 1024), 16, 0, 0); } while (0)
        ATT_DMA(0, 0); ATT_DMA(1, 1); ATT_DMA(2, 2);
        asm volatile("s_waitcnt vmcnt(4)" ::: "memory");
        __builtin_amdgcn_s_barrier();
        f32x16 o[4];
#pragma unroll
        for (int d = 0; d < 4; ++d)
#pragma unroll
            for (int r = 0; r < 16; ++r) o[d][r] = 0.f;
        float mref = 0.f, lrow = 0.f;
        f32x16 negm;
#pragma unroll
        for (int r = 0; r < 16; ++r) negm[r] = 0.f;
        const int rdoff = r32 * 128;
        const int swz = (r32 >> 1) & 7;
        f32x16 s0, s1; bf16x8 pf[4];
#define ATT_QK(bufidx) do { const LAS unsigned char* kp_ = lds + (bufidx) * 32768 + sub * 8192; bf16x8 kfa[4], kfb[4]; \
            _Pragma("unroll") for (int ks = 0; ks < 4; ++ks) { const int ch = ((2 * ks + hi) ^ swz) * 16; kfa[ks] = *(const LAS bf16x8*)(kp_ + rdoff + ch); kfb[ks] = *(const LAS bf16x8*)(kp_ + 4096 + rdoff + ch); } \
            s0 = negm; s1 = negm; \
            _Pragma("unroll") for (int ks = 0; ks < 4; ++ks) { s0 = __builtin_amdgcn_mfma_f32_32x32x16_bf16(kfa[ks], qf[ks], s0, 0, 0, 0); s1 = __builtin_amdgcn_mfma_f32_32x32x16_bf16(kfb[ks], qf[ks], s1, 0, 0, 0); } \
            asm volatile("" : "+v"(s0), "+v"(s1) : "v"(kfa[0]), "v"(kfa[1]), "v"(kfa[2]), "v"(kfa[3]), "v"(kfb[0]), "v"(kfb[1]), "v"(kfb[2]), "v"(kfb[3])); } while (0)
#define ATT_MAX(mx) do { float mxa = fmaxf(fmaxf(s0[0], s0[1]), s0[2]), mxb = fmaxf(fmaxf(s1[0], s1[1]), s1[2]); \
            _Pragma("unroll") for (int r = 3; r < 15; r += 2) { mxa = fmaxf(fmaxf(mxa, s0[r]), s0[r + 1]); mxb = fmaxf(fmaxf(mxb, s1[r]), s1[r + 1]); } \
            mx = fmaxf(fmaxf(mxa, mxb), fmaxf(s0[15], s1[15])); mx = xhalf_max(mx); } while (0)
#define ATT_FIX(mx) do { const float dl = fmaxf(mx, 0.f); mref += dl; const float alpha = __builtin_amdgcn_exp2f(-dl); lrow *= alpha; \
            _Pragma("unroll") for (int r = 0; r < 16; ++r) { s0[r] -= dl; s1[r] -= dl; negm[r] = -mref; } \
            _Pragma("unroll") for (int d = 0; d < 4; ++d) _Pragma("unroll") for (int r = 0; r < 16; ++r) o[d][r] *= alpha; } while (0)
#define ATT_EXP8(S, base, dst) do { float rs_ = 0.f; _Pragma("unroll") for (int r = 0; r < 8; ++r) { S[base + r] = __builtin_amdgcn_exp2f(S[base + r]); rs_ += S[base + r]; } lrow += rs_; \
            v4u pw_; pw_.x = cvt_pk_bf16(S[base + 0], S[base + 1]); pw_.y = cvt_pk_bf16(S[base + 2], S[base + 3]); pw_.z = cvt_pk_bf16(S[base + 4], S[base + 5]); pw_.w = cvt_pk_bf16(S[base + 6], S[base + 7]); dst = __builtin_bit_cast(bf16x8, pw_); } while (0)
#define ATT_VLD(dstv, vp_, s) do { _Pragma("unroll") for (int d = 0; d < 4; ++d) dstv[d] = *(const LAS bf16x8*)(vp_ + d * 4096 + rdoff + (((2 * (s) + hi) ^ swz) * 16)); } while (0)
#define ATT_PV4(srcv, pfrag) do { _Pragma("unroll") for (int d = 0; d < 4; ++d) o[d] = __builtin_amdgcn_mfma_f32_32x32x16_bf16(srcv[d], pfrag, o[d], 0, 0, 0); } while (0)
        { ATT_QK(0); float mx; ATT_MAX(mx); if (__any(mx > 8.0f)) ATT_FIX(mx);
          ATT_EXP8(s0, 0, pf[0]); ATT_EXP8(s0, 8, pf[1]); ATT_EXP8(s1, 0, pf[2]); ATT_EXP8(s1, 8, pf[3]); }
        int bcur = 0;
#pragma nounroll
        for (int t = 0; t < nt; ++t) {
            const int bn1 = (bcur + 1) & 3, bn3 = (bcur + 3) & 3;
            if (t + 3 < nt) ATT_DMA(t + 3, bn3);
            const LAS unsigned char* vp = lds + bcur * 32768 + 16384;
            bf16x8 vfa[4], vfb[4];
            if (t + 1 < nt) {
                __builtin_amdgcn_sched_barrier(0);
                ATT_QK(bn1);
                float mx; ATT_MAX(mx);
                __builtin_amdgcn_sched_barrier(0);
                if (__any(mx > 8.0f)) {
                    const float dl = fmaxf(mx, 0.f); mref += dl; const float alpha = __builtin_amdgcn_exp2f(-dl); lrow *= alpha;
#pragma unroll
                    for (int r = 0; r < 16; ++r) { s0[r] -= dl; s1[r] -= dl; negm[r] = -mref; }
#pragma unroll
                    for (int d = 0; d < 4; ++d)
#pragma unroll
                        for (int r = 0; r < 16; ++r) o[d][r] *= alpha;
#pragma unroll
                    for (int s = 0; s < 4; ++s) { v4u pw = __builtin_bit_cast(v4u, pf[s]);
                        pw.x = cvt_pk_bf16(bflo(pw.x) * alpha, bfhi(pw.x) * alpha); pw.y = cvt_pk_bf16(bflo(pw.y) * alpha, bfhi(pw.y) * alpha);
                        pw.z = cvt_pk_bf16(bflo(pw.z) * alpha, bfhi(pw.z) * alpha); pw.w = cvt_pk_bf16(bflo(pw.w) * alpha, bfhi(pw.w) * alpha); pf[s] = __builtin_bit_cast(bf16x8, pw); }
                }
                __builtin_amdgcn_sched_barrier(0);
                {
                    ATT_VLD(vfa, vp, 0);
                    __builtin_amdgcn_sched_barrier(0);
                    ATT_VLD(vfb, vp, 1); ATT_PV4(vfa, pf[0]); ATT_EXP8(s0, 0, pf[0]);
                    __builtin_amdgcn_sched_barrier(0);
                    ATT_VLD(vfa, vp, 2); ATT_PV4(vfb, pf[1]); ATT_EXP8(s0, 8, pf[1]);
                    __builtin_amdgcn_sched_barrier(0);
                    ATT_VLD(vfb, vp, 3); ATT_PV4(vfa, pf[2]); ATT_EXP8(s1, 0, pf[2]);
                    __builtin_amdgcn_sched_barrier(0);
                    ATT_PV4(vfb, pf[3]); ATT_EXP8(s1, 8, pf[3]);
                }
                __builtin_amdgcn_sched_barrier(0);
            } else {
#pragma unroll
                for (int s = 0; s < 4; ++s) { ATT_VLD(vfa, vp, s); ATT_PV4(vfa, pf[s]); }
            }
            if (t + 3 < nt) asm volatile("s_waitcnt vmcnt(4) lgkmcnt(0)" ::: "memory"); else asm volatile("s_waitcnt vmcnt(0) lgkmcnt(0)" ::: "memory");
            __builtin_amdgcn_s_barrier();
            bcur = bn1;
        }
#undef ATT_DMA
#undef ATT_QK
#undef ATT_MAX
#undef ATT_FIX
#undef ATT_EXP8
#undef ATT_VLD
#undef ATT_PV4
        const float ltot = lrow + __shfl_xor(lrow, 32); const float linv = 1.0f / ltot;
        LAS float* xch = (LAS float*)lds + (size_t)(qw * 32 + r32) * 132;
        if (sub == 1) {
#pragma unroll
            for (int d = 0; d < 4; ++d)
#pragma unroll
                for (int g = 0; g < 4; ++g) *(LAS f32x4*)(xch + 32 * d + 8 * g + 4 * hi) = (f32x4){o[d][4 * g] * linv, o[d][4 * g + 1] * linv, o[d][4 * g + 2] * linv, o[d][4 * g + 3] * linv};
        }
        __syncthreads();
        if (sub == 0) {
            float ss = 0.f;
#pragma unroll
            for (int d = 0; d < 4; ++d)
#pragma unroll
                for (int g = 0; g < 4; ++g) { const f32x4 o2 = *(const LAS f32x4*)(xch + 32 * d + 8 * g + 4 * hi);
#pragma unroll
                    for (int j = 0; j < 4; ++j) { const float v = o[d][4 * g + j] * linv - lam * o2[j]; o[d][4 * g + j] = v; ss += v * v; } }
            ss += __shfl_xor(ss, 32);
            const float rn = 0.8f / sqrtf(ss * (1.0f / 128.0f) + EPS);
            bf16* op = cat + (size_t)(q0row + qw * 32 + r32) * 2048 + head * 128;
#pragma unroll
            for (int d = 0; d < 4; ++d)
#pragma unroll
                for (int g = 0; g < 4; ++g) { const int dv = 32 * d + 8 * g + 4 * hi; const f32x4 gg = *(const f32x4*)(subg + dv);
                    st_bf4(op + dv, (f32x4){o[d][4 * g] * rn * gg.x, o[d][4 * g + 1] * rn * gg.y, o[d][4 * g + 2] * rn * gg.z, o[d][4 * g + 3] * rn * gg.w}); }
        }
        __syncthreads();
    }
}

__device__ __forceinline__ void poold_phase(Frame& F) {
    const bf16* P = WSP(bf16, WS_P); bf16* PD = WSP(bf16, WS_PD);
    const int gt = F.bid * NTHREADS + F.tid, NGT = F.G * NTHREADS;
    for (int idx = gt; idx < TT * 128; idx += NGT) {
        const int r = idx >> 7, cc = (idx & 127) * 8, g = cc >> 8, wdw = 2 << g;
        int sb, t, Ls; if (r < TL) { sb = (r / SEQ) * SEQ; t = r % SEQ; Ls = SEQ; } else { sb = TL + ((r - TL) / CTX) * CTX; t = (r - TL) % CTX; Ls = CTX; }
        int lo = t - wdw / 2, hi = lo + wdw; lo = lo < 0 ? 0 : lo; hi = hi > Ls ? Ls : hi;
        float a[8];
#pragma unroll
        for (int j = 0; j < 8; ++j) a[j] = 0.f;
        for (int s = lo; s < hi; ++s) { const v4u v = *(const v4u*)(P + (size_t)(sb + s) * 1024 + cc);
            a[0] += bflo(v.x); a[1] += bfhi(v.x); a[2] += bflo(v.y); a[3] += bfhi(v.y); a[4] += bflo(v.z); a[5] += bfhi(v.z); a[6] += bflo(v.w); a[7] += bfhi(v.w); }
        const float inv = 1.0f / (float)(hi - lo);
        const v4u me = *(const v4u*)(P + (size_t)r * 1024 + cc);
        v4u o; o.x = pk2(a[0] * inv - bflo(me.x), a[1] * inv - bfhi(me.x)); o.y = pk2(a[2] * inv - bflo(me.y), a[3] * inv - bfhi(me.y));
        o.z = pk2(a[4] * inv - bflo(me.z), a[5] * inv - bfhi(me.z)); o.w = pk2(a[6] * inv - bflo(me.w), a[7] * inv - bfhi(me.w));
        *(v4u*)(PD + (size_t)r * 1024 + cc) = o;
    }
}

__device__ __forceinline__ void shortconv_phase(Frame& F) {
    const bf16* PJ = WSP(bf16, WS_PROJ1); float* GT = WSP(float, WS_GT);
    const float* cw = INP(17); const float* cb = INP(18);
    LAS float* scr = (LAS float*)(F.lds + F.wave * 17408);
    const int lane = F.lane;
    for (int it = F.gw; it < 2 * 128 * 48; it += F.NGW) {
        const int cbk = it % 48, tb = (it / 48) % 128, b = it / (48 * 128), col = cbk * 64 + lane, t0 = tb * 64;
        const bf16* base = PJ + ((size_t)b * SEQ) * 4096 + cbk * 64 + (lane & 7) * 8;
#pragma unroll
        for (int i = 0; i < 9; ++i) { const int row = 8 * i + (lane >> 3); const int t = t0 - 1 + row;
            if (row < 66) { v4u v = {0u, 0u, 0u, 0u}; if (t >= 0 && t < SEQ) v = *(const v4u*)(base + (size_t)t * 4096);
                LAS float* d = scr + row * 65 + (lane & 7) * 8; d[0] = bflo(v.x); d[1] = bfhi(v.x); d[2] = bflo(v.y); d[3] = bfhi(v.y); d[4] = bflo(v.z); d[5] = bfhi(v.z); d[6] = bflo(v.w); d[7] = bfhi(v.w); } }
        LDS_WAIT(); asm volatile("" ::: "memory");
        const float w0 = cw[col], w1 = cw[3072 + col], w2 = cw[2 * 3072 + col], bias = cb[col];
        float prev = scr[lane], cur = scr[65 + lane];
#pragma unroll 8
        for (int tt = 0; tt < 64; ++tt) { const float nxt = scr[(tt + 2) * 65 + lane]; const float o = prev * w0 + cur * w1 + nxt * w2 + bias; scr[tt * 65 + lane] = o; prev = cur; cur = nxt; }
        LDS_WAIT(); asm volatile("" ::: "memory");
        for (int c = 0; c < 64; ++c) GT[((size_t)(cbk * 64 + c) * 2 + b) * SEQ + t0 + lane] = scr[lane * 65 + c];
        LDS_WAIT(); asm volatile("" ::: "memory");
    }
}

__device__ __forceinline__ void s5_gelu_phase(Frame& F) {
    const bf16* PJ = WSP(bf16, WS_PROJ1); const float* YD = WSP(float, WS_YD); bf16* Gb = WSP(bf16, WS_PD); const float* dd = INP(33);
    const int gt = F.bid * NTHREADS + F.tid, NGT = F.G * NTHREADS;
    for (int idx = gt; idx < TL * 256; idx += NGT) { const int r = idx >> 8, c = (idx & 255) * 4;
        const v2u uw = *(const v2u*)(PJ + (size_t)r * 4096 + 3072 + c); const f32x4 d4 = *(const f32x4*)(dd + c);
        const int bb = r / SEQ, tt = r % SEQ, gg = c >> 4, cc = c & 15;
        const f32x4 y0 = *(const f32x4*)(YD + (((size_t)(0 * 2 + bb) * 64 + gg) * SEQ + tt) * 16 + cc), y1 = *(const f32x4*)(YD + (((size_t)(1 * 2 + bb) * 64 + gg) * SEQ + tt) * 16 + cc);
        const f32x4 y = {bflo(uw.x) * d4.x + y0.x + y1.x, bfhi(uw.x) * d4.y + y0.y + y1.y, bflo(uw.y) * d4.z + y0.z + y1.z, bfhi(uw.y) * d4.w + y0.w + y1.w};
        st_bf4(Gb + (size_t)r * 1024 + c, (f32x4){gelu_tanh(y.x), gelu_tanh(y.y), gelu_tanh(y.z), gelu_tanh(y.w)}); }
}

__device__ __forceinline__ f32x2 cmulf(f32x2 a, f32x2 b) { return (f32x2){a.x * b.x - a.y * b.y, a.x * b.y + a.y * b.x}; }
__device__ __forceinline__ int drev14(int p) { const unsigned r = __builtin_bitreverse32((unsigned)p) >> 18; return (int)(((r & 0x2AAAu) >> 1) | ((r & 0x1555u) << 1)); }
template <int L, bool ZHI>
__device__ __forceinline__ void fft_fwd_pass(LAS f32x2* X, const f32x2* tw, int tid) {
    constexpr int tws = 4096 / L;
    if constexpr (L == 1) {
#pragma unroll 2
        for (int i = 0; i < 8; ++i) { const int i0 = (tid + NTHREADS * i) * 4;
            const f32x4 p01 = *(const LAS f32x4*)(X + i0), p23 = *(const LAS f32x4*)(X + i0 + 2);
            const f32x2 x0 = {p01.x, p01.y}, x1 = {p01.z, p01.w}, x2 = {p23.x, p23.y}, x3 = {p23.z, p23.w};
            const f32x2 a = x0 + x2, bb = x0 - x2, c = x1 + x3, d = x1 - x3;
            const f32x2 y0 = a + c, y1 = {bb.x + d.y, bb.y - d.x}, y2 = a - c, y3 = {bb.x - d.y, bb.y + d.x};
            *(LAS f32x4*)(X + i0) = (f32x4){y0.x, y0.y, y1.x, y1.y}; *(LAS f32x4*)(X + i0 + 2) = (f32x4){y2.x, y2.y, y3.x, y3.y}; }
        LDS_BARRIER();
        return;
    }
#pragma unroll 2
    for (int i = 0; i < 8; ++i) {
        const int b = tid + NTHREADS * i, j = b & (L - 1), i0 = (b - j) * 4 + j;
        const f32x2 w1 = tw[j * tws], w2 = cmulf(w1, w1), w3 = cmulf(w2, w1);
        const f32x2 x0 = X[i0], x1 = X[i0 + L];
        if (ZHI) {
            const f32x2 t1 = {x0.x + x1.y, x0.y - x1.x}, t3 = {x0.x - x1.y, x0.y + x1.x};
            X[i0] = x0 + x1; X[i0 + L] = cmulf(t1, w1); X[i0 + 2 * L] = cmulf(x0 - x1, w2); X[i0 + 3 * L] = cmulf(t3, w3);
        } else {
            const f32x2 x2 = X[i0 + 2 * L], x3 = X[i0 + 3 * L];
            const f32x2 a = x0 + x2, bb = x0 - x2, c = x1 + x3, d = x1 - x3;
            const f32x2 t1 = {bb.x + d.y, bb.y - d.x}, t3 = {bb.x - d.y, bb.y + d.x};
            X[i0] = a + c; X[i0 + L] = cmulf(t1, w1); X[i0 + 2 * L] = cmulf(a - c, w2); X[i0 + 3 * L] = cmulf(t3, w3);
        }
    }
    LDS_BARRIER();
}
template <int L>
__device__ __forceinline__ void fft_fwd_pass16(LAS f32x2* X, const f32x2* tw, int tid) {
    constexpr int Q = L / 4, tws = 4096 / L;
    const int jq = tid & (Q - 1);
    f32x2 wa[4][3];
#pragma unroll
    for (int mq = 0; mq < 4; ++mq) { const f32x2 w1 = tw[(mq * Q + jq) * tws]; wa[mq][0] = w1; wa[mq][1] = cmulf(w1, w1); wa[mq][2] = cmulf(wa[mq][1], w1); }
    const f32x2 v1 = tw[jq * 4 * tws], v2 = cmulf(v1, v1), v3 = cmulf(v2, v1);
#pragma unroll
    for (int i = 0; i < 2; ++i) {
        const int u = tid + NTHREADS * i, base = (u / Q) * 4 * L + jq;
        f32x2 pt[4][4];
#pragma unroll
        for (int m = 0; m < 4; ++m)
#pragma unroll
            for (int mq = 0; mq < 4; ++mq) pt[m][mq] = X[base + m * L + mq * Q];
#pragma unroll
        for (int mq = 0; mq < 4; ++mq) {
            const f32x2 x0 = pt[0][mq], x1 = pt[1][mq], x2 = pt[2][mq], x3 = pt[3][mq];
            const f32x2 a = x0 + x2, bb = x0 - x2, c = x1 + x3, d = x1 - x3;
            const f32x2 t1 = {bb.x + d.y, bb.y - d.x}, t3 = {bb.x - d.y, bb.y + d.x};
            pt[0][mq] = a + c; pt[1][mq] = cmulf(t1, wa[mq][0]); pt[2][mq] = cmulf(a - c, wa[mq][1]); pt[3][mq] = cmulf(t3, wa[mq][2]);
        }
#pragma unroll
        for (int m = 0; m < 4; ++m) {
            const f32x2 x0 = pt[m][0], x1 = pt[m][1], x2 = pt[m][2], x3 = pt[m][3];
            const f32x2 a = x0 + x2, bb = x0 - x2, c = x1 + x3, d = x1 - x3;
            const f32x2 t1 = {bb.x + d.y, bb.y - d.x}, t3 = {bb.x - d.y, bb.y + d.x};
            X[base + m * L] = a + c; X[base + m * L + Q] = cmulf(t1, v1); X[base + m * L + 2 * Q] = cmulf(a - c, v2); X[base + m * L + 3 * Q] = cmulf(t3, v3);
        }
    }
    LDS_BARRIER();
}
template <bool ZHI>
__device__ __forceinline__ void fft_fwd(LAS f32x2* X, const f32x2* tw, int tid) {
    fft_fwd_pass<4096, ZHI>(X, tw, tid); fft_fwd_pass16<1024>(X, tw, tid); fft_fwd_pass16<64>(X, tw, tid);
    fft_fwd_pass<4, false>(X, tw, tid); fft_fwd_pass<1, false>(X, tw, tid);
}
template <int L, bool LOHALF>
__device__ __forceinline__ void fft_inv_pass(LAS f32x2* X, const f32x2* tw, int tid) {
    constexpr int tws = 4096 / L;
    if constexpr (L == 1) {
#pragma unroll 2
        for (int i = 0; i < 8; ++i) { const int i0 = (tid + NTHREADS * i) * 4;
            const f32x4 p01 = *(const LAS f32x4*)(X + i0), p23 = *(const LAS f32x4*)(X + i0 + 2);
            const f32x2 x0 = {p01.x, p01.y}, x1 = {p01.z, p01.w}, x2 = {p23.x, p23.y}, x3 = {p23.z, p23.w};
            const f32x2 a = x0 + x2, bb = x0 - x2, c = x1 + x3, d = x1 - x3;
            const f32x2 y0 = a + c, y1 = {bb.x - d.y, bb.y + d.x}, y2 = a - c, y3 = {bb.x + d.y, bb.y - d.x};
            *(LAS f32x4*)(X + i0) = (f32x4){y0.x, y0.y, y1.x, y1.y}; *(LAS f32x4*)(X + i0 + 2) = (f32x4){y2.x, y2.y, y3.x, y3.y}; }
        LDS_BARRIER();
        return;
    }
#pragma unroll 2
    for (int i = 0; i < 8; ++i) {
        const int b = tid + NTHREADS * i, j = b & (L - 1), i0 = (b - j) * 4 + j;
        f32x2 w1 = tw[j * tws]; w1.y = -w1.y; const f32x2 w2 = cmulf(w1, w1), w3 = cmulf(w2, w1);
        const f32x2 x0 = X[i0], x1 = cmulf(X[i0 + L], w1), x2 = cmulf(X[i0 + 2 * L], w2), x3 = cmulf(X[i0 + 3 * L], w3);
        const f32x2 a = x0 + x2, bb = x0 - x2, c = x1 + x3, d = x1 - x3;
        X[i0] = a + c; X[i0 + L] = (f32x2){bb.x - d.y, bb.y + d.x};
        if (!LOHALF) { X[i0 + 2 * L] = a - c; X[i0 + 3 * L] = (f32x2){bb.x + d.y, bb.y - d.x}; }
    }
    LDS_BARRIER();
}
template <int L>
__device__ __forceinline__ void fft_inv_pass16(LAS f32x2* X, const f32x2* tw, int tid) {
    constexpr int tws = 4096 / L, tws4 = 1024 / L;
    const int jq = tid & (L - 1);
    f32x2 v1 = tw[jq * tws]; v1.y = -v1.y; const f32x2 v2 = cmulf(v1, v1), v3 = cmulf(v2, v1);
    f32x2 wb[4][3];
#pragma unroll
    for (int mq = 0; mq < 4; ++mq) { f32x2 w1 = tw[(mq * L + jq) * tws4]; w1.y = -w1.y; wb[mq][0] = w1; wb[mq][1] = cmulf(w1, w1); wb[mq][2] = cmulf(wb[mq][1], w1); }
#pragma unroll
    for (int i = 0; i < 2; ++i) {
        const int u = tid + NTHREADS * i, base = (u / L) * 16 * L + jq;
        f32x2 pt[4][4];
#pragma unroll
        for (int M = 0; M < 4; ++M)
#pragma unroll
            for (int mq = 0; mq < 4; ++mq) pt[M][mq] = X[base + M * 4 * L + mq * L];
#pragma unroll
        for (int M = 0; M < 4; ++M) {
            const f32x2 x0 = pt[M][0], x1 = cmulf(pt[M][1], v1), x2 = cmulf(pt[M][2], v2), x3 = cmulf(pt[M][3], v3);
            const f32x2 a = x0 + x2, bb = x0 - x2, c = x1 + x3, d = x1 - x3;
            pt[M][0] = a + c; pt[M][1] = (f32x2){bb.x - d.y, bb.y + d.x}; pt[M][2] = a - c; pt[M][3] = (f32x2){bb.x + d.y, bb.y - d.x};
        }
#pragma unroll
        for (int mq = 0; mq < 4; ++mq) {
            const f32x2 x0 = pt[0][mq], x1 = cmulf(pt[1][mq], wb[mq][0]), x2 = cmulf(pt[2][mq], wb[mq][1]), x3 = cmulf(pt[3][mq], wb[mq][2]);
            const f32x2 a = x0 + x2, bb = x0 - x2, c = x1 + x3, d = x1 - x3;
            X[base + mq * L] = a + c; X[base + 4 * L + mq * L] = (f32x2){bb.x - d.y, bb.y + d.x}; X[base + 8 * L + mq * L] = a - c; X[base + 12 * L + mq * L] = (f32x2){bb.x + d.y, bb.y - d.x};
        }
    }
    LDS_BARRIER();
}
__device__ __forceinline__ void fft_inv(LAS f32x2* X, const f32x2* tw, int tid) {
    fft_inv_pass<1, false>(X, tw, tid); fft_inv_pass<4, false>(X, tw, tid); fft_inv_pass16<16>(X, tw, tid); fft_inv_pass16<256>(X, tw, tid);
    fft_inv_pass<4096, true>(X, tw, tid);
}
__device__ __forceinline__ void fft_untangle(const LAS f32x2* X, f32x2* K0g, f32x2* K1g, float sc0, float sc1, int tid) {
    const float h0 = 0.5f * sc0, h1 = 0.5f * sc1;
#pragma unroll 4
    for (int i = 0; i < 32; ++i) {
        const int p = tid + NTHREADS * i, f = drev14(p), pm = drev14((16384 - f) & 16383);
        const f32x2 A = X[p], B = X[pm];
        const f32x2 dd = {A.x - B.x, A.y + B.y};
        K0g[p] = (f32x2){(A.x + B.x) * h0, (A.y - B.y) * h0};
        K1g[p] = (f32x2){dd.y * h1, -dd.x * h1};
    }
    LDS_BARRIER();
}
__device__ __forceinline__ void fft_pointwise(LAS f32x2* X, const f32x2* Kg, int tid) {
#pragma unroll 8
    for (int i = 0; i < 32; ++i) { const int p = tid + NTHREADS * i; X[p] = cmulf(X[p], Kg[p]); }
    LDS_BARRIER();
}
__device__ __forceinline__ void hyena_fft_phase(Frame& F) {
    float* GT = WSP(float, WS_GT); const float* kT = WSP(float, WS_KT); const float* invn = WSP(float, WS_INVN); const f32x2* tw = WSP(f32x2, WS_TW);
    f32x2* K0g = WSP(f32x2, WS_FFTW) + (size_t)F.bid * 16384; f32x2* K1g = WSP(f32x2, WS_Y) + (size_t)F.bid * 16384;
    const float* hyb = INP(25);
    LAS f32x2* X = (LAS f32x2*)F.lds;
    const int tid = F.tid;
    for (int ch = F.bid; ch < 1024; ch += F.G) {
        { const float* f0 = kT + (size_t)ch * SEQ; const float* b0 = kT + (size_t)(1024 + ch) * SEQ; const float* f1 = kT + (size_t)(2048 + ch) * SEQ; const float* b1 = kT + (size_t)(3072 + ch) * SEQ;
          for (int n = tid; n < SEQ; n += NTHREADS) { X[n] = (f32x2){f0[n], f1[n]}; X[SEQ + n] = (n == 0) ? (f32x2){0.f, 0.f} : (f32x2){b0[SEQ - n], b1[SEQ - n]}; } }
        const float* v0 = GT + ((size_t)ch * 2) * SEQ; float* yo = WSP(float, WS_YHT) + ((size_t)ch * 2) * SEQ;
        const float* x1 = GT + ((size_t)(1024 + ch) * 2) * SEQ; const float* x2 = GT + ((size_t)(2048 + ch) * 2) * SEQ;
        float z0[16], z1[16];
#pragma unroll
        for (int j = 0; j < 16; ++j) { const int n = tid + NTHREADS * j; z0[j] = v0[n]; z1[j] = v0[SEQ + n]; }
        LDS_BARRIER();
        fft_fwd<false>(X, tw, tid);
        fft_untangle(X, K0g, K1g, invn[ch] * (1.0f / 16384.0f), invn[1024 + ch] * (1.0f / 16384.0f), tid);
#pragma unroll
        for (int o = 0; o < 2; ++o) {
            const float* xg = (o == 0) ? x1 : x2;
            float g0[16], g1[16];
#pragma unroll
            for (int j = 0; j < 16; ++j) { const int n = tid + NTHREADS * j; g0[j] = xg[n]; g1[j] = xg[SEQ + n]; }
#pragma unroll
            for (int j = 0; j < 16; ++j) { const int n = tid + NTHREADS * j; X[n] = (f32x2){z0[j], z1[j]}; }
            LDS_BARRIER();
            fft_fwd<true>(X, tw, tid);
            fft_pointwise(X, o == 0 ? K0g : K1g, tid);
            fft_inv(X, tw, tid);
            const float bias = hyb[o * 1024 + ch];
#pragma unroll
            for (int j = 0; j < 16; ++j) { const int n = tid + NTHREADS * j; const f32x2 y = X[n]; z0[j] = g0[j] * (y.x + bias * z0[j]); z1[j] = g1[j] * (y.y + bias * z1[j]); }
            LDS_BARRIER();
        }
#pragma unroll
        for (int j = 0; j < 16; ++j) { const int n = tid + NTHREADS * j; yo[n] = z0[j]; yo[SEQ + n] = z1[j]; }
    }
}
__device__ __forceinline__ void hyena_out_transpose(Frame& F) {
    const float* GT = WSP(float, WS_YHT); bf16* cat = WSP(bf16, WS_CAT);
    LAS float* scr = (LAS float*)(F.lds + F.wave * 17408);
    const int lane = F.lane;
    for (int it = F.gw; it < 2 * 128 * 16; it += F.NGW) {
        const int cbk = it & 15, tb = (it >> 4) & 127, b = it >> 11, t0 = tb * 64;
        for (int c = 0; c < 64; ++c) scr[c * 65 + lane] = GT[((size_t)(cbk * 64 + c) * 2 + b) * SEQ + t0 + lane];
        LDS_WAIT(); asm volatile("" ::: "memory");
#pragma unroll
        for (int i = 0; i < 8; ++i) { const int tt = 8 * i + (lane >> 3), c0 = (lane & 7) * 8; const LAS float* s = scr + c0 * 65 + tt;
            v4u o; o.x = cvt_pk_bf16(s[0], s[65]); o.y = cvt_pk_bf16(s[130], s[195]); o.z = cvt_pk_bf16(s[260], s[325]); o.w = cvt_pk_bf16(s[390], s[455]);
            *(v4u*)(cat + ((size_t)b * SEQ + t0 + tt) * 2048 + cbk * 64 + c0) = o; }
        LDS_WAIT(); asm volatile("" ::: "memory");
    }
}

__device__ __forceinline__ int s5_row(int di, int b, int s) {
    return (s < CTX) ? TL + b * CTX + (di == 0 ? s : CTX - 1 - s) : b * SEQ + (di == 0 ? s - CTX : SEQ - 1 - (s - CTX));
}
typedef float f32x4_t __attribute__((ext_vector_type(4)));
#define S5_KEEP8(acc, f) asm volatile("" : "+v"(acc) : "v"(f[0]), "v"(f[1]), "v"(f[2]), "v"(f[3]), "v"(f[4]), "v"(f[5]), "v"(f[6]), "v"(f[7]))
#define S5_KEEP4(acc, f) asm volatile("" : "+v"(acc) : "v"(f[0]), "v"(f[1]), "v"(f[2]), "v"(f[3]))
template <bool OUTPUT>
__device__ __forceinline__ void s5_chunk_phase(Frame& F) {
    const bf16* PJ = WSP(bf16, WS_PROJ1); float* YD = WSP(float, WS_YD);
    const f32x2* l16t = WSP(f32x2, WS_S5L16); const f32x2* l256 = WSP(f32x2, WS_S5L256); f32x2* Eb = WSP(f32x2, WS_S5E);
    const bf16* W1 = WSP(bf16, WS_S5W1); const bf16* W3 = WSP(bf16, WS_S5W3); const bf16* KT = WSP(bf16, WS_S5KT);
    const int lane = F.lane, fr = lane & 15, fq = lane >> 4;
    LAS unsigned* Xl = (LAS unsigned*)(F.lds + F.wave * 4608);
    f32x2 carry[4];
#pragma unroll
    for (int t = 0; t < 4; ++t) carry[t] = (f32x2){0.f, 0.f};
#pragma nounroll
    for (int j = 0;; ++j) {
        const int tq = F.wave * F.G + F.bid + (j >> 2) * F.NGW, sub4 = j & 3;
        if (tq >= 256 * 8) break;
        const int task = tq * 4 + sub4;
        const int dbg = task >> 5, seg = (task & 31) + (OUTPUT ? 1 : 0);
        const int di = dbg >> 7, b = (dbg >> 6) & 1, g = dbg & 63;
        const int dg = di * 64 + g;
        const int s0 = seg * 256;
        bf16x8 afr[8];
#pragma unroll
        for (int ks = 0; ks < 8; ++ks) afr[ks] = *(const bf16x8*)(PJ + (size_t)s5_row(di, b, s0 + 16 * fr + 2 * ks + (fq >> 1)) * 4096 + 3072 + g * 16 + 8 * (fq & 1));
        f32x4 ea[8];
        { const bf16* w1p = W1 + ((size_t)dg * 128 + fr) * 256 + 8 * fq;
#pragma unroll
          for (int nt = 0; nt < 8; ++nt) { f32x4 a = {0.f, 0.f, 0.f, 0.f}; bf16x8 bw[8];
#pragma unroll
              for (int ks = 0; ks < 8; ++ks) bw[ks] = *(const bf16x8*)(w1p + (size_t)nt * 16 * 256 + 32 * ks);
#pragma unroll
              for (int ks = 0; ks < 8; ++ks) a = __builtin_amdgcn_mfma_f32_16x16x32_bf16(afr[ks], bw[ks], a, 0, 0, 0);
              S5_KEEP8(a, bw); S5_KEEP8(a, afr);
              ea[nt] = a; } }
        f32x2 st[4];
#pragma unroll
        for (int t = 0; t < 4; ++t) st[t] = (f32x2){0.f, 0.f};
        if (OUTPUT) {
#pragma unroll
            for (int t = 0; t < 4; ++t) { const f32x2 lq = l256[dg * 64 + 16 * t + fr]; const f32x2* ep = Eb + ((size_t)dbg * 32) * 64 + 16 * t + fr;
                if (sub4 == 0) {
                    int k = 0;
                    for (; k + 8 <= seg; k += 8) { f32x2 e8[8];
#pragma unroll
                        for (int j = 0; j < 8; ++j) e8[j] = ep[(size_t)(k + j) * 64];
#pragma unroll
                        for (int j = 0; j < 8; ++j) st[t] = cmulf(lq, st[t]) + e8[j]; }
                    for (; k < seg; ++k) st[t] = cmulf(lq, st[t]) + ep[(size_t)k * 64];
                } else st[t] = cmulf(lq, carry[t]) + ep[(size_t)(seg - 1) * 64];
                carry[t] = st[t]; }
        }
#pragma unroll
        for (int t = 0; t < 4; ++t) {
            const f32x2 L1 = l16t[dg * 64 + 16 * t + fr], L2 = cmulf(L1, L1), L3 = cmulf(L2, L1), L4 = cmulf(L2, L2);
            const f32x2 x0 = {ea[t][0], ea[4 + t][0]}, x1 = cmulf(L1, x0) + (f32x2){ea[t][1], ea[4 + t][1]}, x2 = cmulf(L1, x1) + (f32x2){ea[t][2], ea[4 + t][2]}, x3 = cmulf(L1, x2) + (f32x2){ea[t][3], ea[4 + t][3]};
            f32x2 sin = st[t];
            f32x2 fin = x3 + cmulf(L4, (fq == 0) ? sin : (f32x2){0.f, 0.f});
#pragma unroll
            for (int rd = 1; rd < 4; ++rd) { const float vr = __shfl(fin.x, lane - 16), vi = __shfl(fin.y, lane - 16);
                if (fq == rd) { sin = (f32x2){vr, vi}; fin = x3 + cmulf(L4, sin); } }
            if (OUTPUT) {
                const f32x2 h1 = x0 + cmulf(L1, sin), h2 = x1 + cmulf(L2, sin), h3 = x2 + cmulf(L3, sin);
                Xl[(4 * fq + 0) * 68 + 16 * t + fr] = cvt_pk_bf16(sin.x, sin.y); Xl[(4 * fq + 1) * 68 + 16 * t + fr] = cvt_pk_bf16(h1.x, h1.y);
                Xl[(4 * fq + 2) * 68 + 16 * t + fr] = cvt_pk_bf16(h2.x, h2.y); Xl[(4 * fq + 3) * 68 + 16 * t + fr] = cvt_pk_bf16(h3.x, h3.y);
            } else {
                st[t] = (f32x2){__shfl(fin.x, 48 + fr), __shfl(fin.y, 48 + fr)};
            }
        }
        if (!OUTPUT) {
            if (fq == 0) {
#pragma unroll
                for (int t = 0; t < 4; ++t) Eb[((size_t)dbg * 32 + seg) * 64 + 16 * t + fr] = st[t];
            }
        } else {
            LDS_WAIT(); asm volatile("" ::: "memory");
            bf16x8 hfr[4];
#pragma unroll
            for (int ks = 0; ks < 4; ++ks) hfr[ks] = *(const LAS bf16x8*)(Xl + fr * 68 + 16 * ks + 4 * fq);
            LDS_WAIT(); asm volatile("" ::: "memory");
            const bf16* w3p = W3 + ((size_t)dg * 256 + fr) * 128 + 8 * fq;
            const bf16* ktp = KT + (size_t)dg * 17 * 256 + fr * 16 + 8 * (fq & 1);
#pragma unroll
            for (int tau = 0; tau < 16; ++tau) {
                f32x4 y = {0.f, 0.f, 0.f, 0.f}; bf16x8 b3[4], bk[8];
#pragma unroll
                for (int ks = 0; ks < 4; ++ks) b3[ks] = *(const bf16x8*)(w3p + (size_t)tau * 16 * 128 + 32 * ks);
#pragma unroll
                for (int ks = 0; ks < 8; ++ks) { const int d1 = (ks <= tau / 2) ? tau - 2 * ks - (fq >> 1) + 1 : 0;
                    bk[ks] = *(const bf16x8*)(ktp + (size_t)d1 * 256); }
#pragma unroll
                for (int ks = 0; ks < 4; ++ks) y = __builtin_amdgcn_mfma_f32_16x16x32_bf16(hfr[ks], b3[ks], y, 0, 0, 0);
#pragma unroll
                for (int ks = 0; ks <= tau / 2; ++ks) y = __builtin_amdgcn_mfma_f32_16x16x32_bf16(afr[ks], bk[ks], y, 0, 0, 0);
                S5_KEEP4(y, b3); S5_KEEP8(y, bk); S5_KEEP8(y, afr); S5_KEEP4(y, hfr);
#pragma unroll
                for (int r = 0; r < 4; ++r) { const int s = s0 + 16 * (4 * fq + r) + tau, tl = (di == 0) ? s - CTX : SEQ - 1 - (s - CTX);
                    YD[(((size_t)(di * 2 + b) * 64 + g) * SEQ + tl) * 16 + fr] = y[r]; }
            }
        }
    }
}


constexpr int NPHASES = 21;
#ifndef MK_SINGLE
#define MK_SINGLE 1
#endif

__device__ __forceinline__ unsigned long long launder_u64(unsigned long long v) {
    unsigned lo = (unsigned)v, hi = (unsigned)(v >> 32);
    asm volatile("" : "+v"(lo), "+v"(hi));
    lo = __builtin_amdgcn_readfirstlane(lo); hi = __builtin_amdgcn_readfirstlane(hi);
    return ((unsigned long long)hi << 32) | lo;
}
__device__ __forceinline__ const void* launder_ptr(const void* p) {
    unsigned long long v = (unsigned long long)p; unsigned lo = (unsigned)v, hi = (unsigned)(v >> 32);
    asm volatile("" : "+v"(lo), "+v"(hi));
    lo = __builtin_amdgcn_readfirstlane(lo); hi = __builtin_amdgcn_readfirstlane(hi);
    return (const void*)(((unsigned long long)hi << 32) | lo);
}
__device__ __forceinline__ void moe_blocks(Frame& F, int l, LAS int* bstart) {
    __syncthreads();
    if (F.tid < 64) {
        const int e = F.tid; const unsigned* cnt = WSP(unsigned, WS_CTL) + CW_CNT + l * 64 * CSTR;
        const int nb = ((int)cnt[e * CSTR] + 255) >> 8; int incl = nb;
#pragma unroll
        for (int o = 1; o < 64; o <<= 1) { const int v = __shfl_up(incl, o); if (e >= o) incl += v; }
        const int excl = incl - nb;
        bstart[e] = excl;
        for (int j = 0; j < nb; ++j) bstart[65 + excl + j] = e;
        if (e == 63) bstart[64] = incl;
    }
    __syncthreads();
}

template <int PHSEL>
__global__ void __launch_bounds__(NTHREADS, 2) mk_fwd(Args args) {
    extern __shared__ __attribute__((aligned(16))) unsigned char lds_raw[];
    Frame F;
    F.lds = (LAS unsigned char*)lds_raw; F.ws = (GAS unsigned char*)args.ws; F.kin = (const __attribute__((address_space(4))) unsigned long long*)__builtin_amdgcn_kernarg_segment_ptr();
    F.tid = threadIdx.x; F.lane = F.tid & 63; F.wave = __builtin_amdgcn_readfirstlane(F.tid >> 6); F.bid = blockIdx.x; F.G = gridDim.x;
    F.gw = F.bid * NWAVES + F.wave; F.NGW = F.G * NWAVES;
    volatile LAS unsigned* lctl = (volatile LAS unsigned*)(F.lds + LDS_CTL);
    LAS int* bstart = (LAS int*)(F.lds + LDS_CTL + 64);
    if (F.tid < 4) lctl[F.tid] = 0u;
    __syncthreads();
    const int lo = args.ph_lo, hi = args.ph_hi;
    XcdBarrier bar; bar.bar = WSP(unsigned, WS_CTL) + CW_BAR; bar.x = 0; bar.st = lctl;
    if (PHSEL < 0) bar = xcd_barrier_post(WSP(unsigned, WS_CTL) + CW_BAR, lctl);
#ifndef PH_MASK
#define PH_MASK 0xffffffffu
#endif
#define IN(k) (((PH_MASK >> (k)) & 1u) && (PHSEL < 0 || PHSEL == (k)))
#define INL(j) (((PH_MASK >> (6 + (j))) & 1u) && (PHSEL < 0 || (PHSEL == 6 + (j) && lo == pb + (j))))
#define PH_END(k) do { if (PHSEL < 0) xcd_barrier(bar); } while (0)
#ifndef PH_REPEAT
#define PH_REPEAT 0u
#endif
#define REP(k) for (int _rep = 0; _rep < (((PH_REPEAT >> (k)) & 1u) ? 2 : 1); ++_rep)
#define DUP(k) (((PH_REPEAT >> (k)) & 1u) != 0u)
#define PH_BEGIN() do { F.ws = (GAS unsigned char*)launder_u64((unsigned long long)F.ws); F.kin = (const __attribute__((address_space(4))) unsigned long long*)launder_u64((unsigned long long)F.kin); \
    { int _t = threadIdx.x; asm volatile("" : "+v"(_t)); F.tid = _t; F.lane = _t & 63; F.wave = __builtin_amdgcn_readfirstlane(_t >> 6); \
      int _b = blockIdx.x; asm volatile("" : "+v"(_b)); F.bid = __builtin_amdgcn_readfirstlane(_b); F.gw = F.bid * NWAVES + F.wave; } } while (0)
    LAS unsigned char* lds = F.lds;
    const int G = F.G, bid = F.bid;
    const int vcu = (G % 8 == 0) ? (bid % 8) * (G / 8) + bid / 8 : bid;
    constexpr long T2048 = 256L * 2048 * 2;

    if (IN(0)) { PH_BEGIN(); REP(0) { p0_prologue(F); __syncthreads(); } PH_END(0); }
    if (IN(1)) { PH_BEGIN(); p1_reduce(F); PH_END(1); }
#ifdef EXTRA_BARS
    xcd_barrier(bar); xcd_barrier(bar); xcd_barrier(bar); xcd_barrier(bar); xcd_barrier(bar); xcd_barrier(bar); xcd_barrier(bar); xcd_barrier(bar); xcd_barrier(bar); xcd_barrier(bar);
#endif
        if (IN(2)) { PH_BEGIN(); REP(2) norm_phase<0>(F, 0, nullptr); PH_END(2); }
        if (IN(3)) { PH_BEGIN();
#define BODY3 { pg8::Gemm g{(const bf16*)F.ws, (const bf16*)F.ws, 2048, 2048, 2048}; InProj0Order S; S.G = G; S.c = bid; \
              S.offA1 = (long)WS_HA; S.offB1 = (long)WS_WIN0; S.offA2 = (long)(WS_WIN0 + (size_t)3072 * 2048 * 2); S.offB2 = (long)WS_HA; \
              EpiInProj0 E{EpiQKP{WSP(bf16, WS_Q), WSP(bf16, WS_K), WSP(bf16, WS_P), WSP(f32x2, WS_ROPE)}, EpiVT{WSP(bf16, WS_VT)}}; pg8::gemm_phase<EpiInProj0, InProj0Order, false>(lds, g, S, E); }
            BODY3
            if constexpr (DUP(3)) { BODY3 }
#undef BODY3
            PH_END(3);
        }
        if (IN(4)) { PH_BEGIN();
            REP(4) attn_phase(F, (bid >> 3) % 5);
            __syncthreads(); REP(21) poold_phase(F); PH_END(4); }
        if (IN(5)) { PH_BEGIN();
            pg8::Gemm g{WSP(bf16, WS_PD), WSP(bf16, WS_WPOOL), 1024, 256, 256}; pg8::StaticOrder S; S.init(TT / 256, 4, G, bid, 256L * 1024 * 2, 256L * 2, 256L * 256 * 2);
            EpiScaleBf16 E{WSP(bf16, WS_CAT), 2048, 1024, INP(14)}; pg8::gemm_phase<EpiScaleBf16, pg8::StaticOrder, false>(lds, g, S, E);
            PH_END(5);
        }
    {
    constexpr int pb = 6; constexpr int l = 0;
    if (INL(0)) { PH_BEGIN();
        float* xbuf = WSP(float, WS_X);
        pg8::Gemm g{WSP(bf16, WS_CAT), WSP(bf16, l == 0 ? WS_WOUT0 : WS_WOUT1), 2048, 2048, 2048}; pg8::StaticOrder S; S.init(l == 0 ? TT / 256 : TL / 256, 8, G, bid, T2048, 0, T2048);
        EpiRes E{l == 0 ? INP(0) : xbuf, l == 0 ? INP(2) : xbuf + (size_t)TL * 2048, xbuf, modp(F, l, 0, 2)}; pg8::gemm_phase<EpiRes, pg8::StaticOrder, false>(lds, g, S, E);
        PH_END(pb);
    }
    if (INL(1)) { PH_BEGIN(); ffn_norm_router_phase(F, l); PH_END(pb + 1); }
    if (INL(2)) { PH_BEGIN(); REP(8) {
        moe_blocks(F, l, bstart);
        pg8::Gemm g{WSP(bf16, WS_HA), (const bf16*)(F.ws + WS_WMOE + (size_t)l * MOE_L_BYTES), 2048, 2048, 2048};
        MoeOrder S{bstart, WSP(unsigned, WS_CTL) + CW_CNT + l * 64 * CSTR, WSP(int, WS_TOKL), 4, G, vcu, bstart[64], T2048, 0, true};
        EpiMoeUp E{WSP(bf16, WS_H)}; pg8::gemm_phase<EpiMoeUp, MoeOrder, true>(lds, g, S, E); }
        PH_END(pb + 2);
    }
    if (INL(3)) { PH_BEGIN(); REP(9) {
        moe_blocks(F, l, bstart);
        pg8::Gemm g{WSP(bf16, WS_H), (const bf16*)(F.ws + WS_WMOE + (size_t)l * MOE_L_BYTES), 512, 512, 512};
        MoeOrder S{bstart, WSP(unsigned, WS_CTL) + CW_CNT + l * 64 * CSTR, WSP(int, WS_TOKL), 8, G, vcu, bstart[64], 256L * 512 * 2, (long)(4 * MiB), false};
        EpiMoeDown E{WSP(bf16, WS_Y), WSP(int, WS_TOKL), WSP(float, WS_GATEL), WSP(unsigned, WS_CTL) + CW_CNT + l * 64 * CSTR}; pg8::gemm_phase<EpiMoeDown, MoeOrder, false>(lds, g, S, E); }
        PH_END(pb + 3);
    }
    }
        if (IN(10)) { PH_BEGIN(); norm_phase<2>(F, 1, nullptr); PH_END(10); }
        if (IN(11)) { PH_BEGIN();
#define BODY11             pg8::Gemm g{WSP(bf16, WS_HA), WSP(bf16, WS_WIN1), 2048, 2048, 2048}; pg8::StaticOrder S; S.init(TT / 256, 16, G, bid, T2048, 0, T2048); \
            EpiBf16 E{WSP(bf16, WS_PROJ1), 4096}; pg8::gemm_phase<EpiBf16, pg8::StaticOrder, false>(lds, g, S, E);
            BODY11
            if constexpr (DUP(11)) { BODY11 }
#undef BODY11
            PH_END(11);
        }
        if (IN(12)) { PH_BEGIN(); REP(12) shortconv_phase(F); REP(22) s5_chunk_phase<false>(F);
 PH_END(12); }
        if (IN(13)) { PH_BEGIN();
            REP(23) s5_chunk_phase<true>(F); __syncthreads(); REP(13) hyena_fft_phase(F); PH_END(13); }
        if (IN(14)) { PH_BEGIN();
 REP(14) { s5_gelu_phase(F); hyena_out_transpose(F); } PH_END(14); }
        if (IN(15)) { PH_BEGIN();
            pg8::Gemm g{WSP(bf16, WS_PD), WSP(bf16, WS_WGLU), 1024, 1024, 1024}; pg8::StaticOrder S; S.init(TL / 256, 4, G, bid, 256L * 1024 * 2, 0, 256L * 1024 * 2);
            EpiGlu E{WSP(bf16, WS_CAT), 2048, 1024, WSP(bf16, WS_PD), INP(35)}; pg8::gemm_phase<EpiGlu, pg8::StaticOrder, false>(lds, g, S, E);
            PH_END(15);
        }
    {
    constexpr int pb = 16; constexpr int l = 1;
    if (INL(0)) { PH_BEGIN();
        float* xbuf = WSP(float, WS_X);
        pg8::Gemm g{WSP(bf16, WS_CAT), WSP(bf16, l == 0 ? WS_WOUT0 : WS_WOUT1), 2048, 2048, 2048}; pg8::StaticOrder S; S.init(l == 0 ? TT / 256 : TL / 256, 8, G, bid, T2048, 0, T2048);
        EpiRes E{l == 0 ? INP(0) : xbuf, l == 0 ? INP(2) : xbuf + (size_t)TL * 2048, xbuf, modp(F, l, 0, 2)}; pg8::gemm_phase<EpiRes, pg8::StaticOrder, false>(lds, g, S, E);
        PH_END(pb);
    }
    if (INL(1)) { PH_BEGIN(); ffn_norm_router_phase(F, l); PH_END(pb + 1); }
    if (INL(2)) { PH_BEGIN(); REP(8) {
        moe_blocks(F, l, bstart);
        pg8::Gemm g{WSP(bf16, WS_HA), (const bf16*)(F.ws + WS_WMOE + (size_t)l * MOE_L_BYTES), 2048, 2048, 2048};
        MoeOrder S{bstart, WSP(unsigned, WS_CTL) + CW_CNT + l * 64 * CSTR, WSP(int, WS_TOKL), 4, G, vcu, bstart[64], T2048, 0, true};
        EpiMoeUp E{WSP(bf16, WS_H)}; pg8::gemm_phase<EpiMoeUp, MoeOrder, true>(lds, g, S, E); }
        PH_END(pb + 2);
    }
    if (INL(3)) { PH_BEGIN(); REP(9) {
        moe_blocks(F, l, bstart);
        pg8::Gemm g{WSP(bf16, WS_H), (const bf16*)(F.ws + WS_WMOE + (size_t)l * MOE_L_BYTES), 512, 512, 512};
        MoeOrder S{bstart, WSP(unsigned, WS_CTL) + CW_CNT + l * 64 * CSTR, WSP(int, WS_TOKL), 8, G, vcu, bstart[64], 256L * 512 * 2, (long)(4 * MiB), false};
        EpiMoeDown E{WSP(bf16, WS_Y), WSP(int, WS_TOKL), WSP(float, WS_GATEL), WSP(unsigned, WS_CTL) + CW_CNT + l * 64 * CSTR}; pg8::gemm_phase<EpiMoeDown, MoeOrder, false>(lds, g, S, E); }
        PH_END(pb + 3);
    }
    }
    if (IN(20)) { PH_BEGIN(); norm_phase<3>(F, 1, args.out);
    }
#undef IN
#undef INL
#undef PH_END
}

typedef void (*kern_t)(Args);
template <int P> static void launch_phase(int grid, hipStream_t stream, Args a) { hipLaunchKernelGGL(mk_fwd<P>, dim3(grid), dim3(NTHREADS), LDS_BYTES, stream, a); }
template <int P> static bool prep_phase() { return hipFuncSetAttribute((const void*)mk_fwd<P>, hipFuncAttributeMaxDynamicSharedMemorySize, LDS_BYTES) == hipSuccess; }
extern "C" void kernel_launch(void* const* d_in, const int* in_sizes, int n_in, void* d_out, int out_size, void* d_ws, size_t ws_size, hipStream_t stream) {
    static int grid = 0;
    if (grid == 0) {
        if (n_in != 43 || out_size != TL * DM || ws_size < WS_END) { fprintf(stderr, "kernel_launch: unexpected shapes (n_in %d, out %d, ws %zu < %zu)\n", n_in, out_size, ws_size, (size_t)WS_END); grid = -1; return; }
        int dev = 0, cus = 0;
        if (hipGetDevice(&dev) != hipSuccess || hipDeviceGetAttribute(&cus, hipDeviceAttributeMultiprocessorCount, dev) != hipSuccess) { grid = -1; return; }
        bool ok = true;
#if MK_SINGLE
        ok = prep_phase<-1>();
#else
        ok = prep_phase<0>() && prep_phase<1>() && prep_phase<2>() && prep_phase<3>() && prep_phase<4>() && prep_phase<5>() && prep_phase<6>() && prep_phase<7>() && prep_phase<8>() && prep_phase<9>() &&
             prep_phase<10>() && prep_phase<11>() && prep_phase<12>() && prep_phase<13>() && prep_phase<14>() && prep_phase<15>() && prep_phase<20>();
#endif
        if (!ok) { fprintf(stderr, "kernel_launch: hipFuncSetAttribute failed\n"); grid = -1; return; }
        (void)hipGetLastError();
        grid = cus;
    }
    if (grid < 0) return;
    (void)hipMemsetAsync((char*)d_ws + WS_CTL, 0, CTL_BYTES, stream);
    Args a{};
    for (int i = 0; i < 43; ++i) a.in[i] = (const float*)d_in[i];
    a.out = (float*)d_out; a.ws = (unsigned char*)d_ws;
#if MK_SINGLE
    a.ph_lo = 0; a.ph_hi = NPHASES;
    launch_phase<-1>(grid, stream, a);
#else
#ifndef MK_DUP
#define MK_DUP -1
#endif
#define LP(k, P) a.ph_lo = (k); a.ph_hi = (k) + 1; launch_phase<P>(grid, stream, a); \
    if (MK_DUP == (k)) { if (P == 7) (void)hipMemsetAsync((char*)d_ws + WS_CTL + (size_t)(CW_CNT + ((k) > 10 ? 64 * CSTR : 0)) * 4, 0, 256 * CSTR, stream); launch_phase<P>(grid, stream, a); }
    LP(0, 0) LP(1, 1) LP(2, 2) LP(3, 3) LP(4, 4) LP(5, 5) LP(6, 6) LP(7, 7) LP(8, 8) LP(9, 9) LP(10, 10) LP(11, 11) LP(12, 12) LP(13, 13) LP(14, 14) LP(15, 15)
    LP(16, 6) LP(17, 7) LP(18, 8) LP(19, 9) LP(20, 20)
#undef LP
#endif
}
```

```cpp
#include <hip/hip_runtime.h>
#include <cstdio>
#include <cstdint>
#include <cmath>

#define GAS __attribute__((address_space(1)))
#define LAS __attribute__((address_space(3)))
typedef unsigned short bf16;
typedef unsigned v4u __attribute__((ext_vector_type(4)));
typedef unsigned v2u __attribute__((ext_vector_type(2)));
typedef float f32x4 __attribute__((ext_vector_type(4)));
typedef float f32x2 __attribute__((ext_vector_type(2)));
typedef float f32x16 __attribute__((ext_vector_type(16)));
typedef short bf16x8 __attribute__((ext_vector_type(8)));
#define LDS_WAIT() asm volatile("s_waitcnt lgkmcnt(0)" ::: "memory")
#define VM_WAIT() asm volatile("s_waitcnt vmcnt(0)" ::: "memory")

__device__ __forceinline__ unsigned f2bf(float f) { unsigned u = __builtin_bit_cast(unsigned, f); return (u + 0x7fffu + ((u >> 16) & 1u)) >> 16; }
__device__ __forceinline__ unsigned pk2(float lo, float hi) { return f2bf(lo) | (f2bf(hi) << 16); }
__device__ __forceinline__ unsigned cvt_pk_bf16(float lo, float hi) { unsigned r; asm volatile("v_cvt_pk_bf16_f32 %0, %1, %2" : "=v"(r) : "v"(lo), "v"(hi)); return r; }
__device__ __forceinline__ float bf2f(unsigned short b) { return __builtin_bit_cast(float, (unsigned)b << 16); }
__device__ __forceinline__ float bflo(unsigned w) { return __builtin_bit_cast(float, w << 16); }
__device__ __forceinline__ float bfhi(unsigned w) { return __builtin_bit_cast(float, w & 0xffff0000u); }
__device__ __forceinline__ float wave_sum(float v) {
#pragma unroll
    for (int o = 1; o < 64; o <<= 1) v += __shfl_xor(v, o);
    return v;
}

namespace pg8 {
typedef unsigned short bf16_t;
constexpr int BM = 256, BK = 64, HALF = 128, HTB = HALF * BK * 2, STAGE_BYTES = 8 * HTB;

__host__ __device__ __forceinline__ int lds_byte(int r, int c) { const int st = (r >> 4) * 2 + (c >> 5), rr = r & 15, cc = c & 31, ob = rr * 64 + cc * 2; return st * 1024 + (ob ^ (((ob >> 9) & 1) << 5)); }
__host__ __device__ __forceinline__ int perm32(int rho) { const int n = rho >> 4, i = rho & 15; return 8 * (i >> 2) + 4 * n + (i & 3); }
__host__ __device__ __forceinline__ void stage_rc(int b, int& R, int& C) { const int st = b / 1024, sb = b % 1024, swz = sb ^ (((sb >> 9) & 1) << 5); R = (st >> 1) * 16 + swz / 64; C = (st & 1) * 32 + (swz % 64) / 2; }

struct Unit { int pm, pn; long aoff, boff; int e, idx0; };
struct Gemm { const bf16_t* A; const bf16_t* Bt; int lda, ldb, K; };

template <class Epi, class Sched, bool GATHER>
__device__ __forceinline__ void gemm_phase(LAS unsigned char* lds, const Gemm g, const Sched& S, const Epi& E) {
    int tid_ = threadIdx.x; asm volatile("" : "+v"(tid_));
    const int tid = tid_, wid = __builtin_amdgcn_readfirstlane(tid >> 6), lane = tid & 63, wr = wid >> 2, wc = wid & 3, fr = lane & 15, fq = lane >> 4;
    const int K = g.K, nt = K / BK;
    unsigned voffA[2], voffB[2];
#pragma unroll
    for (int i = 0; i < 2; ++i) { int R, C; stage_rc(tid * 16 + i * 8192, R, C);
        const int Rb = Epi::PERM ? ((R & ~31) + perm32(R & 31)) : R;
        voffA[i] = (unsigned)(R * g.lda + C) * 2u; voffB[i] = (unsigned)(Rb * g.ldb + C) * 2u; }
    const size_t kstep = (size_t)(BK * 2);
    const size_t hstepA = GATHER ? 0 : (size_t)HALF * g.lda * 2, hstepB = (size_t)HALF * g.ldb * 2;
    const unsigned ldsw = (unsigned)wid * 1024u;
    const int aoff = lds_byte(wr * 64 + fr, fq * 8), boff = lds_byte(wc * 32 + fr, fq * 8);
#define PG8_SA(b, h) (((b) * 2 + (h)) * HTB)
#define PG8_SB(b, h) ((4 + (b) * 2 + (h)) * HTB)
#define PG8_STAGE(bufoff, gbase, voff) do { _Pragma("unroll") for (int _i = 0; _i < 2; ++_i) \
        __builtin_amdgcn_global_load_lds((const unsigned*)((const char*)(gbase) + (voff)[_i]), (LAS unsigned*)(lds + (bufoff) + ldsw + _i * 8192), 16, 0, 0); } while (0)
#define PG8_STAGE_A(bufoff, gbase, h, nx) do { if constexpr (GATHER) { unsigned _tv[2]; \
        if (nx) { int _tz = tid; asm volatile("" : "+v"(_tz)); _Pragma("unroll") for (int _j = 0; _j < 2; ++_j) { int _R, _C; stage_rc(_tz * 16 + _j * 8192, _R, _C); _tv[_j] = (unsigned)S.arow(nxt, (h) * HALF + _R) * (unsigned)(g.lda * 2) + (unsigned)(_C * 2); } } \
        else { _tv[0] = gvc[h][0]; _tv[1] = gvc[h][1]; } \
        PG8_STAGE(bufoff, gbase, _tv); } else { PG8_STAGE(bufoff, (gbase) + (h) * hstepA, voffA); } } while (0)
#define PG8_LDA(dst, b, h) do { _Pragma("unroll") for (int m = 0; m < 4; ++m) _Pragma("unroll") for (int k = 0; k < 2; ++k) dst[m][k] = *(const LAS bf16x8*)(lds + PG8_SA(b, h) + aoff + m * 2048 + k * 1024); } while (0)
#define PG8_LDB(dst, b, h) do { _Pragma("unroll") for (int n = 0; n < 2; ++n) _Pragma("unroll") for (int k = 0; k < 2; ++k) dst[n][k] = *(const LAS bf16x8*)(lds + PG8_SB(b, h) + boff + n * 2048 + k * 1024); } while (0)
#define PG8_MMA(ai, bj, At, Bt) do { __builtin_amdgcn_s_setprio(1); _Pragma("unroll") for (int m = 0; m < 4; ++m) _Pragma("unroll") for (int n = 0; n < 2; ++n) _Pragma("unroll") for (int k = 0; k < 2; ++k) \
        acc[ai][bj][m][n] = __builtin_amdgcn_mfma_f32_16x16x32_bf16(Bt[n][k], At[m][k], acc[ai][bj][m][n], 0, 0, 0); __builtin_amdgcn_s_setprio(0); } while (0)
#define PG8_WAIT_V(n) asm volatile("s_waitcnt vmcnt(" #n ")" ::: "memory")
#define PG8_WAIT_L(n) asm volatile("s_waitcnt lgkmcnt(" #n ")" ::: "memory")
#define PG8_BAR __builtin_amdgcn_s_barrier()
#define PG8_SCHED __builtin_amdgcn_sched_barrier(0)
    Unit cur, nxt; int ui = 0;
    if (!S.next(0, cur)) return;
    unsigned gvc[2][2];
#define PG8_GV(unit) do { if constexpr (GATHER) { int _tz = tid; asm volatile("" : "+v"(_tz)); _Pragma("unroll") for (int _h = 0; _h < 2; ++_h) _Pragma("unroll") for (int _j = 0; _j < 2; ++_j) { int _R, _C; stage_rc(_tz * 16 + _j * 8192, _R, _C); \
        gvc[_h][_j] = (unsigned)S.arow(unit, _h * HALF + _R) * (unsigned)(g.lda * 2) + (unsigned)(_C * 2); } } } while (0)
    PG8_GV(cur);
    f32x4 acc[2][2][4][2];
#pragma unroll
    for (int a = 0; a < 2; ++a)
#pragma unroll
        for (int b = 0; b < 2; ++b)
#pragma unroll
            for (int m = 0; m < 4; ++m)
#pragma unroll
                for (int n = 0; n < 2; ++n) acc[a][b][m][n] = (f32x4){0.f, 0.f, 0.f, 0.f};
    bf16x8 At[4][2], B0[2][2], B1[2][2];
    const char* cA = (const char*)g.A + cur.aoff; const char* cB = (const char*)g.Bt + cur.boff;
    PG8_STAGE(PG8_SB(0, 0), cB, voffB); PG8_STAGE(PG8_SB(0, 1), cB + hstepB, voffB); PG8_STAGE_A(PG8_SA(0, 0), cA, 0, false); PG8_STAGE_A(PG8_SA(0, 1), cA, 1, false);
    if (wr == 1) PG8_BAR;
    PG8_WAIT_V(2); PG8_BAR;
    PG8_STAGE(PG8_SB(1, 0), cB + kstep, voffB); PG8_STAGE_A(PG8_SA(1, 0), cA + kstep, 0, false); PG8_STAGE(PG8_SB(1, 1), cB + hstepB + kstep, voffB);
    PG8_WAIT_V(6); PG8_BAR;
    for (;;) {
        const bool has_next = S.next(ui + 1, nxt);
        const char* nA = has_next ? (const char*)g.A + nxt.aoff : cA; const char* nB = has_next ? (const char*)g.Bt + nxt.boff : cB;
#pragma nounroll
        for (int t = 0; t < nt; t += 2) {
            const bool last = (t == nt - 2);
            const char* a1 = cA + (size_t)(t + 1) * kstep;
            const char* a2 = last ? nA : cA + (size_t)(t + 2) * kstep; const char* b2 = last ? nB : cB + (size_t)(t + 2) * kstep;
            const char* a3 = a2 + kstep; const char* b3 = b2 + kstep;
            PG8_LDB(B0, 0, 0); PG8_LDB(B1, 0, 1); PG8_SCHED; PG8_LDA(At, 0, 0); PG8_STAGE_A(PG8_SA(1, 1), a1, 1, false);
            PG8_WAIT_V(8); PG8_WAIT_L(0); PG8_BAR; PG8_MMA(0, 0, At, B0); PG8_MMA(0, 1, At, B1); PG8_BAR; PG8_SCHED;
            PG8_LDA(At, 0, 1); PG8_STAGE(PG8_SB(0, 0), b2, voffB); PG8_STAGE(PG8_SB(0, 1), b2 + hstepB, voffB); PG8_STAGE_A(PG8_SA(0, 0), a2, 0, last);
            PG8_WAIT_V(8); PG8_WAIT_L(0); PG8_BAR; PG8_MMA(1, 0, At, B0); PG8_MMA(1, 1, At, B1); PG8_BAR; PG8_SCHED;
            PG8_LDB(B0, 1, 0); PG8_LDB(B1, 1, 1); PG8_SCHED; PG8_LDA(At, 1, 0); PG8_STAGE_A(PG8_SA(0, 1), a2, 1, last);
            PG8_WAIT_V(8); PG8_WAIT_L(0); PG8_BAR; PG8_MMA(0, 0, At, B0); PG8_MMA(0, 1, At, B1); PG8_BAR; PG8_SCHED;
            PG8_LDA(At, 1, 1); PG8_STAGE(PG8_SB(1, 0), b3, voffB); PG8_STAGE(PG8_SB(1, 1), b3 + hstepB, voffB); PG8_STAGE_A(PG8_SA(1, 0), a3, 0, last);
            PG8_WAIT_V(8); PG8_WAIT_L(0); PG8_BAR; PG8_MMA(1, 0, At, B0); PG8_MMA(1, 1, At, B1); PG8_BAR; PG8_SCHED;
        }
        if (wr == 0) PG8_BAR;
        E(acc, cur, wr, wc, fr, fq);
        if (!has_next) break;
#pragma unroll
        for (int a = 0; a < 2; ++a)
#pragma unroll
            for (int b = 0; b < 2; ++b)
#pragma unroll
                for (int m = 0; m < 4; ++m)
#pragma unroll
                    for (int n = 0; n < 2; ++n) acc[a][b][m][n] = (f32x4){0.f, 0.f, 0.f, 0.f};
        cur = nxt; cA = nA; cB = nB; ++ui;
        PG8_GV(cur);
        if (wr == 1) PG8_BAR;
    }
    PG8_WAIT_V(0);
    PG8_BAR;
#undef PG8_SA
#undef PG8_SB
#undef PG8_STAGE
#undef PG8_STAGE_A
#undef PG8_GV
#undef PG8_LDA
#undef PG8_LDB
#undef PG8_MMA
#undef PG8_WAIT_V
#undef PG8_WAIT_L
#undef PG8_BAR
#undef PG8_SCHED
}

struct StaticOrder {
    int nM, nN, nwg, G, c; long astride, apn, bstride;
    __device__ void init(int nM_, int nN_, int G_, int c_, long astride_, long apn_, long bstride_) { nM = nM_; nN = nN_; nwg = nM * nN; G = G_; c = c_; astride = astride_; apn = apn_; bstride = bstride_; }
    __device__ bool next(int i, Unit& u) const {
        const long Lx = (long)i * G + c; if (Lx >= nwg) return false;
        int wgid = (int)Lx; { const int q = nwg / 8, r = nwg % 8, xcd = wgid % 8, off = wgid / 8; wgid = (xcd < r ? xcd * (q + 1) : r * (q + 1) + (xcd - r) * q) + off; }
        const int nig = 8 * nN, gid = wgid / nig, fm = gid * 8, gsz = (nM - fm) < 8 ? (nM - fm) : 8;
        u.pm = fm + ((wgid % nig) % gsz); u.pn = (wgid % nig) / gsz; u.aoff = (long)u.pm * astride + (long)u.pn * apn; u.boff = (long)u.pn * bstride; u.e = 0; u.idx0 = 0; return true;
    }
    __device__ int arow(const Unit&, int) const { return 0; }
};
}

constexpr int DM = 2048, NBATCH = 2, SEQ = 8192, CTX = 256;
constexpr int TL = NBATCH * SEQ;
constexpr int TC = NBATCH * CTX;
constexpr int TT = TL + TC;
constexpr int KEYS = CTX + SEQ;
constexpr int NEXP = 64, DEXP = 512;
constexpr int LISTCAP = 2 * TT;
constexpr float EPS = 1e-6f;
constexpr float QSCALE = 0.125f * 1.4426950408889634f;
constexpr int NWAVES = 8, NTHREADS = 512;

constexpr size_t MiB = 1u << 20;
constexpr size_t WS_CTL = 0, CTL_BYTES = 64 * 1024;
constexpr size_t WS_WIN0 = 1 * MiB;
constexpr size_t WS_WOUT0 = WS_WIN0 + 16 * MiB;
constexpr size_t WS_WIN1 = WS_WOUT0 + 8 * MiB;
constexpr size_t WS_WOUT1 = WS_WIN1 + 16 * MiB;
constexpr size_t WS_WPOOL = WS_WOUT1 + 8 * MiB;
constexpr size_t WS_WGLU = WS_WPOOL + 1 * MiB;
constexpr size_t WS_WMOE = WS_WGLU + 2 * MiB;
constexpr size_t MOE_E_BYTES = 6 * MiB, MOE_L_BYTES = 64 * MOE_E_BYTES;
constexpr size_t WS_X = WS_WMOE + 2 * MOE_L_BYTES;
constexpr size_t WS_HA = WS_X + 132 * MiB;
constexpr size_t WS_Q = WS_HA + 67 * MiB;
constexpr size_t WS_K = WS_Q + 33 * MiB;
constexpr size_t WS_VT = WS_K + 33 * MiB;
constexpr size_t WS_P = WS_VT + 33 * MiB;
constexpr size_t WS_PROJ1 = WS_Q;
constexpr size_t WS_CAT = WS_P + 33 * MiB;
constexpr size_t WS_PD = WS_CAT + 66 * MiB;
constexpr size_t WS_H = WS_PD + 33 * MiB;
constexpr size_t WS_Y = WS_H + 49 * MiB;
constexpr size_t WS_GT = WS_Y + 132 * MiB;
constexpr size_t WS_KT = WS_GT + 192 * MiB;
constexpr size_t WS_YD = WS_KT + 128 * MiB;
constexpr size_t WS_MISC = WS_YD + 128 * MiB;
constexpr size_t WS_MOD = WS_MISC;
constexpr size_t WS_ADAP = WS_MOD + 1 * MiB;
constexpr size_t WS_ROPE = WS_ADAP + 10 * MiB;
constexpr size_t WS_NORMP = WS_ROPE + 1 * MiB;
constexpr size_t WS_INVN = WS_NORMP + 4 * MiB;
constexpr size_t WS_S5LAM = WS_INVN + 1 * MiB;
constexpr size_t WS_S5B = WS_S5LAM + 1 * MiB;
constexpr size_t WS_WRT = WS_S5B + 2 * MiB;
constexpr size_t WS_TOKL = WS_WRT + 2 * MiB;
constexpr size_t WS_GATEL = WS_TOKL + 9 * MiB;
constexpr size_t WS_TW = WS_GATEL + 9 * MiB;
constexpr size_t WS_FFTW = WS_TW + 1 * MiB;
constexpr size_t WS_S5L256 = WS_FFTW + 32 * MiB;
constexpr size_t WS_S5E = WS_S5L256 + 1 * MiB;
constexpr size_t WS_YHT = WS_S5E + 4 * MiB;
constexpr size_t WS_S5L16 = WS_YHT + 64 * MiB;
constexpr size_t WS_S5W1 = WS_S5L16 + 1 * MiB;
constexpr size_t WS_S5W3 = WS_S5W1 + 8 * MiB;
constexpr size_t WS_S5KT = WS_S5W3 + 8 * MiB;
constexpr size_t WS_END = WS_S5KT + 2 * MiB;
static_assert(WS_END <= 2040 * MiB, "d_ws map");
constexpr int CW_BAR = 1024;
constexpr int CW_CNT = 8192;
constexpr int CSTR = 32;

constexpr int LDS_PHASE = 131072;
constexpr int LDS_CTL = 147456 - 2048;
constexpr int LDS_BYTES = 147456;

#define XB_TMO      128
#define XB_XCNT(j)  (256  + 64 * (j))
#define XB_XSUB(j)  (1280 + 64 * (j))
#define XB_XGEN(j)  (2304 + 64 * (j))
#define XB_TOP      3328
#define XB_TOPGEN   3392
#define XCD_BAR_WORDS 3456
#define XB_SPIN_CAP (1u << 22)

__device__ __forceinline__ unsigned xb_ld(unsigned* p)              { return __hip_atomic_load(p, __ATOMIC_RELAXED, __HIP_MEMORY_SCOPE_AGENT); }
__device__ __forceinline__ unsigned xb_add(unsigned* p, unsigned v) { return __hip_atomic_fetch_add(p, v, __ATOMIC_RELAXED, __HIP_MEMORY_SCOPE_AGENT); }
__device__ __forceinline__ unsigned xb_xcc_id() { return (unsigned)__builtin_amdgcn_s_getreg((3 << 11) | 20) & 0xFu; }
#define XB_SPIN(cond, bar) do { unsigned _sp = 0; while (cond) { __builtin_amdgcn_s_sleep(1); \
    if ((++_sp & 255u) == 0u) { if (xb_ld(&(bar)[XB_TMO])) break; if (_sp > XB_SPIN_CAP) { atomicAdd(&(bar)[XB_TMO], 1u); break; } } } } while (0)

struct XcdBarrier { unsigned* bar; unsigned x; volatile LAS unsigned* st; };

__device__ __forceinline__ XcdBarrier xcd_barrier_post(unsigned* bar, volatile LAS unsigned* st) {
    XcdBarrier b; b.bar = bar; b.x = xb_xcc_id(); b.st = st;
    if (threadIdx.x == 0) (void)xb_add(&bar[XB_XCNT(b.x)], 1u);
    return b;
}
__device__ __forceinline__ void xcd_barrier_complete(unsigned* bar, unsigned x, unsigned& nloc, unsigned& nx) {
    const unsigned G = gridDim.x * gridDim.y * gridDim.z;
    unsigned sum, cnt, mine, sp = 0u;
    for (;;) {
        sum = 0u; cnt = 0u; mine = 0u;
#pragma unroll
        for (unsigned j = 0; j < 16; ++j) { const unsigned c = xb_ld(&bar[XB_XCNT(j)]); sum += c; cnt += (c > 0u) ? 1u : 0u; mine = (j == x) ? c : mine; }
        if (sum == G) break;
        __builtin_amdgcn_s_sleep(1);
        if ((++sp & 255u) == 0u) { if (xb_ld(&bar[XB_TMO])) break; if (sp > XB_SPIN_CAP) { atomicAdd(&bar[XB_TMO], 1u); break; } }
    }
    nloc = mine > 0u ? mine : 1u; nx = cnt > 0u ? cnt : 1u;
}
__device__ __forceinline__ void xcd_barrier(const XcdBarrier& b) {
    asm volatile("s_waitcnt vmcnt(0)" ::: "memory");
    __syncthreads();
    if (threadIdx.x == 0) {
        unsigned* bar = b.bar;
        __builtin_amdgcn_s_waitcnt(0);
        unsigned nloc = b.st[0], nx = b.st[1];
        if (nloc == 0u) { xcd_barrier_complete(bar, b.x, nloc, nx); b.st[0] = nloc; b.st[1] = nx; }
        const unsigned old = xb_add(&bar[XB_XSUB(b.x)], 1u);
        const unsigned gen = old / nloc;
        if (old + 1u == (gen + 1u) * nloc) {
            __builtin_amdgcn_fence(__ATOMIC_RELEASE, "agent");
            asm volatile("s_waitcnt vmcnt(0)" ::: "memory");
            const unsigned og = xb_add(&bar[XB_TOP], 1u);
            const unsigned tg = og / nx;
            if (og + 1u == (tg + 1u) * nx) xb_add(&bar[XB_TOPGEN], 1u);
            else XB_SPIN(xb_ld(&bar[XB_TOPGEN]) == tg, bar);
            __builtin_amdgcn_fence(__ATOMIC_ACQUIRE, "agent");
            xb_add(&bar[XB_XGEN(b.x)], 1u);
            asm volatile("s_waitcnt vmcnt(0)" ::: "memory");
        } else {
            XB_SPIN(xb_ld(&bar[XB_XGEN(b.x)]) == gen, bar);
            __builtin_amdgcn_fence(__ATOMIC_ACQUIRE, "agent");
            asm volatile("s_waitcnt vmcnt(0)" ::: "memory");
        }
    }
    __syncthreads();
}

__device__ __forceinline__ void sincos_2pi(double x, double& s, double& c) {
    const double q = __builtin_rint(x * 4.0);
    const double y = (x - q * 0.25) * 6.283185307179586476925;
    const double y2 = y * y;
    double sp = -7.6471637318198164759e-13; sp = sp * y2 + 1.6059043836821614599e-10; sp = sp * y2 - 2.5052108385441718775e-8; sp = sp * y2 + 2.7557319223985890653e-6;
    sp = sp * y2 - 1.9841269841269841270e-4; sp = sp * y2 + 8.3333333333333333333e-3; sp = sp * y2 - 1.6666666666666666667e-1; sp = sp * y2 * y + y;
    double cp = 4.7794773323873852974e-14; cp = cp * y2 - 1.1470745597729724714e-11; cp = cp * y2 + 2.0876756987868098979e-9; cp = cp * y2 - 2.7557319223985890653e-7;
    cp = cp * y2 + 2.4801587301587301587e-5; cp = cp * y2 - 1.3888888888888888889e-3; cp = cp * y2 + 4.1666666666666666667e-2; cp = cp * y2 - 0.5; cp = cp * y2 + 1.0;
    const int qi = ((int)q) & 3;
    s = (qi == 0) ? sp : (qi == 1) ? cp : (qi == 2) ? -sp : -cp;
    c = (qi == 0) ? cp : (qi == 1) ? -sp : (qi == 2) ? -cp : sp;
}
__device__ __forceinline__ void sincos_rad(double a, double& s, double& c) {
    double f = a * 0.15915494309189533576888; f -= __builtin_floor(f);
    if (f >= 1.0) f = 0.0;
    sincos_2pi(f, s, c);
}
__device__ __forceinline__ double exp_small(double x) {
    double r = 1.0 / 479001600.0;
    r = r * x + 1.0 / 39916800.0; r = r * x + 1.0 / 3628800.0; r = r * x + 1.0 / 362880.0; r = r * x + 1.0 / 40320.0; r = r * x + 1.0 / 5040.0;
    r = r * x + 1.0 / 720.0; r = r * x + 1.0 / 120.0; r = r * x + 1.0 / 24.0; r = r * x + 1.0 / 6.0; r = r * x + 0.5; r = r * x + 1.0; r = r * x + 1.0;
    return r;
}
__device__ __forceinline__ float fast_exp(float x) { return __builtin_amdgcn_exp2f(x * 1.4426950408889634f); }
__device__ __forceinline__ float sigmoidf_(float x) { return 1.0f / (1.0f + fast_exp(-x)); }
__device__ __forceinline__ float siluf_(float x) { return x * sigmoidf_(x); }
__device__ __forceinline__ float tanhf_(float x) { const float e = fast_exp(-2.0f * fabsf(x)); const float t = (1.0f - e) / (1.0f + e); return x < 0.f ? -t : t; }
__device__ __forceinline__ float gelu_tanh(float x) { return 0.5f * x * (1.0f + tanhf_(0.7978845608028654f * (x + 0.044715f * x * x * x))); }

#ifndef PH_REPEAT
#define PH_REPEAT 0u
#endif
struct Args { const float* in[43]; float* out; unsigned char* ws; int ph_lo, ph_hi; };

#define GAS __attribute__((address_space(1)))
struct Frame {
    LAS unsigned char* lds; GAS unsigned char* ws; int tid, lane, wave, bid, G, gw, NGW;
    const __attribute__((address_space(4))) unsigned long long* kin;
};
#define INP(i) ((const float*)(const GAS float*)F.kin[i])
#define WSP(T, off) ((T*)(GAS T*)(F.ws + (off)))

__device__ __forceinline__ void tr_item(const float* W, int ldw, int N, bf16* WT, int ldt, int row_off, int rs16, LAS float* scr, int item, int lane) {
    const int nblk = N / 64, kb = item / nblk, nb = item % nblk, k0 = 64 * kb, n0 = 64 * nb;
    const int la = lane & 15, lb = lane >> 4;
    f32x4 v[16];
#pragma unroll
    for (int i = 0; i < 16; ++i) v[i] = *(const f32x4*)(W + (size_t)(k0 + 4 * i + lb) * ldw + n0 + 4 * la);
#pragma unroll
    for (int i = 0; i < 16; ++i) { const int kk = 4 * i + lb; LAS float* d = scr + (4 * la) * 65 + kk; d[0] = v[i].x; d[65] = v[i].y; d[130] = v[i].z; d[195] = v[i].w; }
    LDS_WAIT(); asm volatile("" ::: "memory");
    const int c = lane & 7;
#pragma unroll
    for (int j = 0; j < 8; ++j) { const int n = (lane >> 3) + 8 * j; const LAS float* s = scr + n * 65 + 8 * c;
        v4u o; o.x = cvt_pk_bf16(s[0], s[1]); o.y = cvt_pk_bf16(s[2], s[3]); o.z = cvt_pk_bf16(s[4], s[5]); o.w = cvt_pk_bf16(s[6], s[7]);
        const int nn = n0 + n, drow = row_off + (nn >> 4) * rs16 + (nn & 15);
        *(v4u*)(WT + (size_t)drow * ldt + k0 + 8 * c) = o; }
    LDS_WAIT(); asm volatile("" ::: "memory");
}

__device__ __forceinline__ void hyfilt_item(Frame& F, int pb) {
    const float* w1 = INP(19); const float* b1 = INP(20); const float* fq = INP(21); const float* w2 = INP(22); const float* b2 = INP(23); const float* w3 = INP(24);
    LAS float* z = (LAS float*)F.lds;
    LAS float* h1 = z + 1088;
    LAS float* h2 = h1 + 2048;
    const int tid = F.tid;
    for (int idx = tid; idx < 32 * 33; idx += NTHREADS) {
        const int p = idx / 33, f = idx % 33, i = pb * 32 + p;
        float v;
        if (f == 0) v = (float)i * (1.0f / (float)(SEQ - 1));
        else { const int j = (f - 1) & 15; const float fj = 1e-4f + (float)j * ((15.0f - 1e-4f) / 15.0f);
            double fr = (double)fj * (double)i / (double)SEQ; fr -= __builtin_floor(fr); double s, c; sincos_2pi(fr, s, c); v = (f <= 16) ? (float)c : (float)(-s); }
        z[p * 33 + f] = v;
    }
    __syncthreads();
    for (int idx = tid; idx < 2048; idx += NTHREADS) {
        const int p = idx >> 6, j = idx & 63; float a = b1[j];
        for (int f = 0; f < 33; ++f) a += z[p * 33 + f] * w1[f * 64 + j];
        double s, c; sincos_rad((double)(fq[j] * a), s, c); h1[idx] = (float)s;
    }
    __syncthreads();
    for (int idx = tid; idx < 2048; idx += NTHREADS) {
        const int p = idx >> 6, j = idx & 63; float a = b2[j];
        for (int k = 0; k < 64; ++k) a += h1[p * 64 + k] * w2[k * 64 + j];
        double s, c; sincos_rad((double)(fq[64 + j] * a), s, c); h2[idx] = (float)s;
    }
    __syncthreads();
    float* kT = WSP(float, WS_KT); float* normp = WSP(float, WS_NORMP);
    {
        const int lane = F.lane, l31 = lane & 31, lh = lane >> 5;
        float af[32];
#pragma unroll
        for (int s = 0; s < 32; ++s) af[s] = h2[l31 * 64 + 2 * s + lh];
        float bn[32];
        { const unsigned vo = (unsigned)(lh * 4096 + F.wave * 32 + l31);
#pragma unroll
          for (int s = 0; s < 32; ++s) bn[s] = (w3 + s * 8192)[vo]; }
#pragma nounroll
        for (int ct = F.wave; ct < 128; ct += NWAVES) {
            const int col = ct * 32 + l31;
            f32x16 acc;
#pragma unroll
            for (int r = 0; r < 16; ++r) acc[r] = 0.f;
            float bv[32];
#pragma unroll
            for (int s = 0; s < 32; ++s) bv[s] = bn[s];
            { const unsigned vo = (unsigned)(lh * 4096 + (ct + NWAVES < 128 ? ct + NWAVES : ct) * 32 + l31);
#pragma unroll
              for (int s = 0; s < 32; ++s) bn[s] = (w3 + s * 8192)[vo]; }
#pragma unroll
            for (int s = 0; s < 32; ++s) acc = __builtin_amdgcn_mfma_f32_32x32x2f32(af[s], bv[s], acc, 0, 0, 0);
#pragma unroll
            for (int s = 0; s < 32; s += 8) asm volatile("" : "+v"(acc) : "v"(bv[s]), "v"(bv[s + 1]), "v"(bv[s + 2]), "v"(bv[s + 3]), "v"(bv[s + 4]), "v"(bv[s + 5]), "v"(bv[s + 6]), "v"(bv[s + 7]));
            const int ch = col & 1023, dir = (col >> 10) & 1;
            const float adel = 3.0701134573253946f + (float)ch * ((15.350567286626972f - 3.0701134573253946f) / 1023.0f);
            float sabs = 0.f;
#pragma unroll
            for (int r = 0; r < 16; ++r) { const int i = pb * 32 + (r & 3) + 8 * (r >> 2) + 4 * lh; const float t = (float)i * (1.0f / (float)(SEQ - 1)); acc[r] *= fast_exp(-t * adel); if (!(dir == 1 && i == 0)) sabs += fabsf(acc[r]); }
            sabs += __shfl_xor(sabs, 32);
#pragma unroll
            for (int q = 0; q < 4; ++q) *(f32x4*)(kT + (size_t)col * SEQ + pb * 32 + 8 * q + 4 * lh) = (f32x4){acc[4 * q], acc[4 * q + 1], acc[4 * q + 2], acc[4 * q + 3]};
            if (lh == 0) normp[(size_t)pb * 4096 + col] = sabs;
        }
    }
    __syncthreads();
}

#define LDS_BARRIER() do { asm volatile("s_waitcnt lgkmcnt(0)" ::: "memory"); __builtin_amdgcn_s_barrier(); asm volatile("" ::: "memory"); } while (0)
struct TrItem { const float* W; bf16* WT; int ldw, ldt, row_off, rs16, k0, n0; };
__device__ __forceinline__ TrItem moe_tr_item(Frame& F, int it) {
    const int le = it / 192, q = it % 192; TrItem r;
    bf16* wc = (bf16*)(GAS bf16*)(F.ws + WS_WMOE + (size_t)le * MOE_E_BYTES);
    if (q < 128) { r.W = (q < 64 ? INP(40) : INP(41)) + (size_t)le * (2048 * 512); r.ldw = 512; r.WT = wc; r.ldt = 2048; r.row_off = (q < 64) ? 0 : 16; r.rs16 = 32; r.k0 = 64 * ((q & 63) >> 1); r.n0 = 256 * (q & 1); }
    else { const int x = q - 128; r.W = INP(42) + (size_t)le * (512 * 2048); r.ldw = 2048; r.WT = wc + 1024 * 2048; r.ldt = 512; r.row_off = 0; r.rs16 = 16; r.k0 = 64 * (x >> 3); r.n0 = 256 * (x & 7); }
    return r;
}
__device__ __forceinline__ void moe_convert_items(Frame& F) {
    constexpr int NIT = 128 * 192;
    const int t = F.tid, lane = t & 63, w = __builtin_amdgcn_readfirstlane(t >> 6);
    const int kc = t & 7, nb = t >> 3;
    int first, step, count;
    if (F.G == 256) { first = F.bid * (NIT / 256); step = 1; count = NIT / 256; }
    else { first = F.bid; step = F.G; count = (NIT - F.bid + F.G - 1) / F.G; }
    if (count <= 0) return;
    LAS unsigned char* lds = F.lds;
#define CV_DMA(sidx, buf) do { const int s_ = (sidx) < count ? (sidx) : count - 1; const TrItem c_ = moe_tr_item(F, first + s_ * step); \
        const float* g_ = c_.W + (size_t)(c_.k0 + 8 * w) * c_.ldw + c_.n0 + 4 * (lane ^ w); \
        _Pragma("unroll") for (int j_ = 0; j_ < 8; ++j_) \
            __builtin_amdgcn_global_load_lds((const unsigned*)(g_ + (size_t)j_ * c_.ldw), (LAS unsigned*)(lds + (buf) * 65536 + (8 * w + j_) * 1024), 16, 0, 2); } while (0)
    CV_DMA(0, 0); CV_DMA(1, 1);
#pragma nounroll
    for (int s = 0; s < count; ++s) {
        const int buf = s & 1;
        if (s == 0) asm volatile("s_waitcnt vmcnt(8)" ::: "memory"); else asm volatile("s_waitcnt vmcnt(12)" ::: "memory");
        __builtin_amdgcn_s_barrier(); asm volatile("" ::: "memory");
        const TrItem c = moe_tr_item(F, first + s * step);
        const LAS float* T = (const LAS float*)(lds + buf * 65536);
#pragma unroll
        for (int q = 0; q < 4; ++q) { const int n = nb + 64 * q; const LAS float* src = T + (8 * kc) * 256 + 4 * ((n >> 2) ^ kc) + (n & 3);
            v4u o; o.x = cvt_pk_bf16(src[0], src[256]); o.y = cvt_pk_bf16(src[512], src[768]); o.z = cvt_pk_bf16(src[1024], src[1280]); o.w = cvt_pk_bf16(src[1536], src[1792]);
            const int nn = c.n0 + n, drow = c.row_off + (nn >> 4) * c.rs16 + (nn & 15);
            __builtin_nontemporal_store(o, (v4u*)(c.WT + (size_t)drow * c.ldt + c.k0 + 8 * kc)); }
        LDS_BARRIER();
        CV_DMA(s + 2, buf);
    }
    asm volatile("s_waitcnt vmcnt(0)" ::: "memory");
#undef CV_DMA
}

__device__ __forceinline__ void p0_prologue(Frame& F) {
    if ((F.bid & 1) == 0) { for (int pb = F.bid; pb < SEQ / 32; pb += F.G) hyfilt_item(F, pb); __syncthreads(); }
    const int gt = F.bid * NTHREADS + F.tid, NGT = F.G * NTHREADS;
    {
        f32x2* rope = WSP(f32x2, WS_ROPE);
        for (int idx = gt; idx < 128 * 16; idx += NGT) { const int pos = idx >> 4, i = idx & 15;
            double inv = (i & 3) == 0 ? 1.0 : (i & 3) == 1 ? 0.56234132519034908 : (i & 3) == 2 ? 0.31622776601683794 : 0.17782794100389228;
            inv *= (i >> 2) == 0 ? 1.0 : (i >> 2) == 1 ? 0.1 : (i >> 2) == 2 ? 0.01 : 0.001;
            const float ang = (float)pos * (float)inv; double s, c; sincos_rad((double)ang, s, c); rope[idx] = (f32x2){(float)c, (float)s}; }
    }
    {
        f32x2* tw = WSP(f32x2, WS_TW);
        for (int idx = gt; idx < 16384; idx += NGT) { double s, c; sincos_2pi((double)idx * (1.0 / 16384.0), s, c); tw[idx] = (f32x2){(float)c, (float)(-s)}; }
    }
    {
        const float* are = INP(26); const float* aim = INP(27); const float* ldt = INP(28); const float* bre = INP(29); const float* bim = INP(30);
        f32x2* lamb = WSP(f32x2, WS_S5LAM); f32x2* bb = WSP(f32x2, WS_S5B); f32x2* l256 = WSP(f32x2, WS_S5L256);
        for (int idx = gt; idx < 2 * 64 * 64; idx += NGT) { const int dg = idx >> 6;
            const float dt = expf(ldt[dg]); const float ar = are[idx], ai = aim[idx];
            const float zr = ar * dt, zi = ai * dt; double s, c; sincos_rad((double)zi, s, c); const double er = exp_small((double)zr);
            const double lr = er * c, li = er * s; lamb[idx] = (f32x2){(float)lr, (float)li};
            { double pr = lr, pi = li; for (int q = 0; q < 8; ++q) { const double tr = pr * pr - pi * pi, ti = 2.0 * pr * pi; pr = tr; pi = ti; } l256[idx] = (f32x2){(float)pr, (float)pi}; }
            const double nr = lr - 1.0, ni = li, den = (double)ar * ar + (double)ai * ai; const double qr = (nr * ar + ni * ai) / den, qi = (ni * ar - nr * ai) / den;
            for (int cc = 0; cc < 16; ++cc) { const double br = bre[(size_t)idx * 16 + cc], bi = bim[(size_t)idx * 16 + cc]; bb[(size_t)idx * 16 + cc] = (f32x2){(float)(qr * br - qi * bi), (float)(qr * bi + qi * br)}; } }
    }
    {
        float* wrt = WSP(float, WS_WRT);
        for (int idx = gt; idx < 2 * 72 * 2048; idx += NGT) { const int l = idx / (72 * 2048), r = idx % (72 * 2048), n = r / 2048, k = r % 2048;
            wrt[idx] = n < 8 ? INP(36)[((size_t)l * 2048 + k) * 8 + n] : INP(38)[((size_t)l * 2048 + k) * 64 + (n - 8)]; }
    }
    {
        bf16* ha = WSP(bf16, WS_HA);
        for (int idx = gt; idx < 2048; idx += NGT) ha[(size_t)TT * 2048 + idx] = 0;
    }
    LAS float* scr = (LAS float*)(F.lds + F.wave * 16896);
    {
        const float* c = INP(1); const float* cctx = INP(3); const float* adaw = INP(4); float* part = WSP(float, WS_ADAP);
        for (int rep = 0; rep < (((PH_REPEAT >> 26) & 1u) ? 2 : 1); ++rep)
        for (int it = F.gw; it < 2 * 32 * 48; it += F.NGW) {
            const int l = it / (32 * 48), r = it % (32 * 48), ks = r / 48, jb = r % 48, k0 = ks * 64, j0 = jb * 256 + F.lane * 4;
            const float c0 = c[k0 + F.lane], c1 = c[2048 + k0 + F.lane], c2 = cctx[k0 + F.lane];
            const float s0 = c0 / (1.0f + expf(-c0)), s1 = c1 / (1.0f + expf(-c1)), s2 = c2 / (1.0f + expf(-c2));
            f32x4 a0 = {0.f, 0.f, 0.f, 0.f}, a1 = a0, a2 = a0;
            const float* wp = adaw + ((size_t)l * 2048 + k0) * 12288 + j0;
#pragma unroll 8
            for (int kk = 0; kk < 64; ++kk) { const f32x4 w = *(const f32x4*)(wp + (size_t)kk * 12288);
                const float t0 = __builtin_bit_cast(float, __builtin_amdgcn_readlane(__builtin_bit_cast(int, s0), kk));
                const float t1 = __builtin_bit_cast(float, __builtin_amdgcn_readlane(__builtin_bit_cast(int, s1), kk));
                const float t2 = __builtin_bit_cast(float, __builtin_amdgcn_readlane(__builtin_bit_cast(int, s2), kk));
                a0 += w * t0; a1 += w * t1; a2 += w * t2; }
            float* pp = part + ((size_t)(l * 32 + ks) * 3) * 12288 + j0;
            *(f32x4*)(pp) = a0; *(f32x4*)(pp + 12288) = a1; *(f32x4*)(pp + 2 * 12288) = a2;
        }
    }
    {
        constexpr int I0 = 1024, I1 = 512, I2 = 512, I3 = 1024, I4 = 2048, I5 = 1024, I6 = 64, I7 = 256, IE = 768;
        constexpr int NSMALL = I0 + I1 + I2 + I3 + I4 + I5 + I6 + I7;
        const int NITEMS = NSMALL;
        for (int rep = 0; rep < (((PH_REPEAT >> 27) & 1u) ? 2 : 1); ++rep)
        for (int it = F.gw; it < NITEMS; it += F.NGW) {
            int r = it;
            if (r < I0) { tr_item(INP(9), 4096, 2048, WSP(bf16, WS_WIN0), 2048, 0, 16, scr, r, F.lane); continue; } r -= I0;
            if (r < I1) { tr_item(INP(9) + 2048, 4096, 1024, WSP(bf16, WS_WIN0), 2048, 3072, 16, scr, r, F.lane); continue; } r -= I1;
            if (r < I2) { tr_item(INP(9) + 3072, 4096, 1024, WSP(bf16, WS_WIN0), 2048, 2048, 16, scr, r, F.lane); continue; } r -= I2;
            if (r < I3) { tr_item(INP(10), 2048, 2048, WSP(bf16, WS_WOUT0), 2048, 0, 16, scr, r, F.lane); continue; } r -= I3;
            if (r < I4) { tr_item(INP(15), 4096, 4096, WSP(bf16, WS_WIN1), 2048, 0, 16, scr, r, F.lane); continue; } r -= I4;
            if (r < I5) { tr_item(INP(16), 2048, 2048, WSP(bf16, WS_WOUT1), 2048, 0, 16, scr, r, F.lane); continue; } r -= I5;
            if (r < I6) { const int g = r / 16; tr_item(INP(13) + (size_t)g * 65536, 256, 256, WSP(bf16, WS_WPOOL), 256, g * 256, 16, scr, r % 16, F.lane); continue; } r -= I6;
            if (r < I7) { tr_item(INP(34), 1024, 1024, WSP(bf16, WS_WGLU), 1024, 0, 16, scr, r, F.lane); continue; } r -= I7;
        }
    }
    if ((F.bid & 1) != 0) { __syncthreads(); for (int pb = F.bid; pb < SEQ / 32; pb += F.G) hyfilt_item(F, pb); }
}

__device__ __forceinline__ void p1_reduce(Frame& F) {
    const int gt = F.bid * NTHREADS + F.tid, NGT = F.G * NTHREADS;
    const float* part = WSP(float, WS_ADAP); float* mod = WSP(float, WS_MOD); const float* adab = INP(5);
    for (int idx = gt; idx < 2 * 3 * 12288; idx += NGT) { const int l = idx / (3 * 12288), r = idx % (3 * 12288), m = r / 12288, j = r % 12288;
        float a = adab[l * 12288 + j];
        for (int ks = 0; ks < 32; ++ks) a += part[((size_t)(l * 32 + ks) * 3 + m) * 12288 + j];
        mod[idx] = a; }
    const float* normp = WSP(float, WS_NORMP); float* invn = WSP(float, WS_INVN);
    for (int idx = gt; idx < 2048; idx += NGT) { const int o = idx >> 10, ch = idx & 1023; float a = 0.f;
        for (int pb = 0; pb < 256; ++pb) a += normp[(size_t)pb * 4096 + o * 2048 + ch] + normp[(size_t)pb * 4096 + o * 2048 + 1024 + ch];
        invn[idx] = 1.0f / a; }
    {
        const f32x2* lamb = WSP(f32x2, WS_S5LAM); const f32x2* bbar = WSP(f32x2, WS_S5B); const float* cre = INP(31); const float* cim = INP(32);
        bf16* W1 = WSP(bf16, WS_S5W1); bf16* W3 = WSP(bf16, WS_S5W3); bf16* KT = WSP(bf16, WS_S5KT); f32x2* l16 = WSP(f32x2, WS_S5L16);
#define S5_POWF(l_, e_, pw_) do { pw_ = (f32x2){1.f, 0.f}; f32x2 b_ = l_; for (int q_ = (e_); q_ > 0; q_ >>= 1) { if (q_ & 1) pw_ = (f32x2){pw_.x * b_.x - pw_.y * b_.y, pw_.x * b_.y + pw_.y * b_.x}; b_ = (f32x2){b_.x * b_.x - b_.y * b_.y, 2.f * b_.x * b_.y}; } } while (0)
        for (int idx = gt; idx < 128 * 64; idx += NGT) { f32x2 pw; S5_POWF(lamb[idx], 16, pw); l16[idx] = pw; }
        for (int idx = gt; idx < 128 * 128 * 32; idx += NGT) {
            const int k8 = idx & 31, n = (idx >> 5) & 127, dg = idx >> 12, sigma = k8 >> 1, h = k8 & 1, p = (n & 15) + 16 * ((n >> 4) & 3), im = n >> 6;
            f32x2 pw; S5_POWF(lamb[dg * 64 + p], 15 - sigma, pw);
            const f32x4* bp = (const f32x4*)(bbar + ((size_t)dg * 64 + p) * 16 + 8 * h); float o[8];
#pragma unroll
            for (int j = 0; j < 4; ++j) { const f32x4 q = bp[j]; o[2 * j] = im ? (pw.x * q.y + pw.y * q.x) : (pw.x * q.x - pw.y * q.y); o[2 * j + 1] = im ? (pw.x * q.w + pw.y * q.z) : (pw.x * q.z - pw.y * q.w); }
            v4u w; w.x = pk2(o[0], o[1]); w.y = pk2(o[2], o[3]); w.z = pk2(o[4], o[5]); w.w = pk2(o[6], o[7]);
            *(v4u*)(W1 + (size_t)idx * 8) = w; }
        for (int idx = gt; idx < 128 * 256 * 16; idx += NGT) {
            const int k8 = idx & 15, n = (idx >> 4) & 255, dg = idx >> 12, tau = n >> 4, cout = n & 15; float o[8];
#pragma unroll
            for (int j = 0; j < 4; ++j) { const int p = 4 * k8 + j; f32x2 pw; S5_POWF(lamb[dg * 64 + p], tau + 1, pw);
                const float cr = cre[((size_t)dg * 16 + cout) * 64 + p], ci = cim[((size_t)dg * 16 + cout) * 64 + p]; o[2 * j] = cr * pw.x - ci * pw.y; o[2 * j + 1] = -(cr * pw.y + ci * pw.x); }
            v4u w; w.x = pk2(o[0], o[1]); w.y = pk2(o[2], o[3]); w.z = pk2(o[4], o[5]); w.w = pk2(o[6], o[7]);
            *(v4u*)(W3 + (size_t)idx * 8) = w; }
        for (int idx = gt; idx < 128 * 17 * 16 * 2; idx += NGT) {
            const int h = idx & 1, cout = (idx >> 1) & 15, d1 = (idx >> 5) % 17, dg = (idx >> 5) / 17;
            float acc[8];
#pragma unroll
            for (int j = 0; j < 8; ++j) acc[j] = 0.f;
            if (d1 > 0) { for (int p = 0; p < 64; ++p) { f32x2 pw; S5_POWF(lamb[dg * 64 + p], d1 - 1, pw);
                const float cr = cre[((size_t)dg * 16 + cout) * 64 + p], ci = cim[((size_t)dg * 16 + cout) * 64 + p]; const float gr = cr * pw.x - ci * pw.y, gi = cr * pw.y + ci * pw.x;
                const f32x4* bp = (const f32x4*)(bbar + ((size_t)dg * 64 + p) * 16 + 8 * h);
#pragma unroll
                for (int j = 0; j < 4; ++j) { const f32x4 q = bp[j]; acc[2 * j] += gr * q.x - gi * q.y; acc[2 * j + 1] += gr * q.z - gi * q.w; } } }
            v4u w; w.x = pk2(acc[0], acc[1]); w.y = pk2(acc[2], acc[3]); w.z = pk2(acc[4], acc[5]); w.w = pk2(acc[6], acc[7]);
            *(v4u*)(KT + (size_t)idx * 8) = w; }
#undef S5_POWF
    }
}

__device__ __forceinline__ const float* modp(Frame& F, int l, int m, int c) { return WSP(float, WS_MOD) + ((size_t)(l * 3 + m) * 6 + c) * 2048; }
__device__ __forceinline__ int row_stream(int r) { return r < TL ? r / SEQ : 2; }

template <int MODE>
__device__ __forceinline__ void norm_phase(Frame& F, int l, float* dout) {
    const int nrows = (MODE == 3 || (MODE == 1 && l == 1)) ? TL : TT;
    float* xbuf = WSP(float, WS_X); bf16* ha = WSP(bf16, WS_HA); const bf16* Y = WSP(bf16, WS_Y);
    const float* gvec = (MODE == 0) ? INP(6) : (MODE == 1) ? INP(7) + l * 2048 : (MODE == 2) ? INP(6) + 2048 : INP(8);
    const int lane = F.lane;
    for (int r = F.gw; r < nrows; r += F.NGW) {
        const int m = row_stream(r);
        const float* src = (MODE == 0) ? (r < TL ? INP(0) + (size_t)r * 2048 : INP(2) + (size_t)(r - TL) * 2048) : xbuf + (size_t)r * 2048;
        f32x4 v[8]; float ss = 0.f;
#pragma unroll
        for (int j = 0; j < 8; ++j) v[j] = *(const f32x4*)(src + 4 * lane + 256 * j);
        if (MODE == 2 || MODE == 3) {
            const float* g2 = modp(F, MODE == 2 ? 0 : 1, m, 5);
            const bf16* y0 = Y + (size_t)(2 * r) * 2048; const bf16* y1 = y0 + 2048;
#pragma unroll
            for (int j = 0; j < 8; ++j) { const int c = 4 * lane + 256 * j; const v2u a = *(const v2u*)(y0 + c), b = *(const v2u*)(y1 + c); const f32x4 gg = *(const f32x4*)(g2 + c);
                v[j].x += gg.x * (bflo(a.x) + bflo(b.x)); v[j].y += gg.y * (bfhi(a.x) + bfhi(b.x)); v[j].z += gg.z * (bflo(a.y) + bflo(b.y)); v[j].w += gg.w * (bfhi(a.y) + bfhi(b.y)); }
            if (MODE == 2) {
#pragma unroll
                for (int j = 0; j < 8; ++j) *(f32x4*)(xbuf + (size_t)r * 2048 + 4 * lane + 256 * j) = v[j];
            }
        }
#pragma unroll
        for (int j = 0; j < 8; ++j) ss += (v[j].x * v[j].x + v[j].y * v[j].y) + (v[j].z * v[j].z + v[j].w * v[j].w);
        ss = wave_sum(ss);
        const float rs = 1.0f / sqrtf(ss * (1.0f / 2048.0f) + EPS);
        if (MODE == 3) {
#pragma unroll
            for (int j = 0; j < 8; ++j) { const int c = 4 * lane + 256 * j; const f32x4 gg = *(const f32x4*)(gvec + c); *(f32x4*)(dout + (size_t)r * 2048 + c) = v[j] * rs * gg; }
            continue;
        }
        const int lm = (MODE == 2) ? 1 : l;
        const float* sh = modp(F, lm, m, MODE == 1 ? 3 : 0); const float* sc = modp(F, lm, m, MODE == 1 ? 4 : 1);
#pragma unroll
        for (int j = 0; j < 8; ++j) { const int c = 4 * lane + 256 * j; const f32x4 gg = *(const f32x4*)(gvec + c), s1 = *(const f32x4*)(sc + c), s0 = *(const f32x4*)(sh + c);
            v[j] = (v[j] * rs * gg) * (1.0f + s1) + s0;
            v2u o; o.x = pk2(v[j].x, v[j].y); o.y = pk2(v[j].z, v[j].w); *(v2u*)(ha + (size_t)r * 2048 + c) = o; }
    }
}

__device__ __forceinline__ void ffn_norm_router_phase(Frame& F, int l) {
    const int nrows = (l == 1) ? TL : TT;
    const float* xbuf = WSP(float, WS_X); bf16* ha = WSP(bf16, WS_HA);
    const float* gvec = INP(7) + l * 2048;
    const float* wrt = WSP(float, WS_WRT) + (size_t)l * 72 * 2048;
    LAS float* hl = (LAS float*)F.lds;
    LAS float* lg = (LAS float*)(F.lds + 131584);
    const int lane = F.lane, tid = F.tid, l31 = lane & 31, lh = lane >> 5;
    for (int it = F.bid; it < nrows / 32; it += F.G) {
        const int r0 = it * 32 + F.wave * 4;
        f32x4 v[4][8];
#pragma unroll
        for (int rr = 0; rr < 4; ++rr)
#pragma unroll
            for (int j = 0; j < 8; ++j) v[rr][j] = *(const f32x4*)(xbuf + (size_t)(r0 + rr) * 2048 + 4 * lane + 256 * j);
        const int m = row_stream(r0);
        const float* sh = modp(F, l, m, 3); const float* sc = modp(F, l, m, 4);
        float rs[4];
#pragma unroll
        for (int rr = 0; rr < 4; ++rr) { float ss = 0.f;
#pragma unroll
            for (int j = 0; j < 8; ++j) ss += (v[rr][j].x * v[rr][j].x + v[rr][j].y * v[rr][j].y) + (v[rr][j].z * v[rr][j].z + v[rr][j].w * v[rr][j].w);
            ss = wave_sum(ss); rs[rr] = 1.0f / sqrtf(ss * (1.0f / 2048.0f) + EPS); }
#pragma unroll
        for (int j = 0; j < 8; ++j) { if ((j & 1) == 0) __builtin_amdgcn_sched_barrier(0); const int c = 4 * lane + 256 * j; const f32x4 gg = *(const f32x4*)(gvec + c), s1 = *(const f32x4*)(sc + c), s0 = *(const f32x4*)(sh + c);
#pragma unroll
            for (int rr = 0; rr < 4; ++rr) { v[rr][j] = (v[rr][j] * rs[rr] * gg) * (1.0f + s1) + s0;
                v2u o; o.x = cvt_pk_bf16(v[rr][j].x, v[rr][j].y); o.y = cvt_pk_bf16(v[rr][j].z, v[rr][j].w); *(v2u*)(ha + (size_t)(r0 + rr) * 2048 + c) = o; } }
        f32x16 acc[3];
#pragma unroll
        for (int nt = 0; nt < 3; ++nt)
#pragma unroll
            for (int r = 0; r < 16; ++r) acc[nt][r] = 0.f;
        const int nr2 = (64 + l31 < 72) ? 64 + l31 : 71;
#pragma unroll
        for (int hK = 0; hK < 2; ++hK) {
#pragma unroll
            for (int rr = 0; rr < 4; ++rr)
#pragma unroll
                for (int j = 0; j < 4; ++j) *(LAS f32x4*)(hl + (F.wave * 4 + rr) * 1028 + 256 * j + 4 * lane) = v[rr][4 * hK + j];
            __syncthreads();
            const LAS float* ap = hl + l31 * 1028 + 128 * F.wave + 4 * lh;
            const float* wp = wrt + 1024 * hK + 128 * F.wave + 4 * lh;
            const float* w0 = wp + (size_t)l31 * 2048; const float* w1 = wp + (size_t)(32 + l31) * 2048; const float* w2 = wp + (size_t)nr2 * 2048;
#pragma nounroll
            for (int jc = 0; jc < 4; ++jc) {
                f32x4 af[4], b0[4], b1[4], b2[4];
#pragma unroll
                for (int jj = 0; jj < 4; ++jj) { const int o = 8 * (4 * jc + jj); b0[jj] = *(const f32x4*)(w0 + o); b1[jj] = *(const f32x4*)(w1 + o); b2[jj] = *(const f32x4*)(w2 + o); af[jj] = *(const LAS f32x4*)(ap + o); }
#pragma unroll
                for (int jj = 0; jj < 4; ++jj)
#pragma unroll
                    for (int c = 0; c < 4; ++c) {
                        acc[0] = __builtin_amdgcn_mfma_f32_32x32x2f32(af[jj][c], b0[jj][c], acc[0], 0, 0, 0);
                        acc[1] = __builtin_amdgcn_mfma_f32_32x32x2f32(af[jj][c], b1[jj][c], acc[1], 0, 0, 0);
                        acc[2] = __builtin_amdgcn_mfma_f32_32x32x2f32(af[jj][c], b2[jj][c], acc[2], 0, 0, 0); }
                asm volatile("" : "+v"(acc[0]), "+v"(acc[1]), "+v"(acc[2]) : "v"(af[0]), "v"(af[1]), "v"(af[2]), "v"(af[3]), "v"(b0[0]), "v"(b0[1]), "v"(b0[2]), "v"(b0[3]),
                             "v"(b1[0]), "v"(b1[1]), "v"(b1[2]), "v"(b1[3]), "v"(b2[0]), "v"(b2[1]), "v"(b2[2]), "v"(b2[3]));
            }
            __syncthreads();
        }
        {
            LAS float* pw = hl + F.wave * (32 * 96);
#pragma unroll
            for (int nt = 0; nt < 3; ++nt)
#pragma unroll
                for (int r = 0; r < 16; ++r) pw[((r & 3) + 8 * (r >> 2) + 4 * lh) * 96 + 32 * nt + l31] = acc[nt][r];
        }
        __syncthreads();
        for (int idx = tid; idx < 32 * 72; idx += NTHREADS) { const int row = idx / 72, col = idx - row * 72; float s = 0.f;
#pragma unroll
            for (int w = 0; w < 8; ++w) s += hl[w * (32 * 96) + row * 96 + col];
            lg[row * 80 + col] = s; }
        __syncthreads();
        if (lane < 4) {
            const int r = r0 + lane; const LAS float* L = lg + (F.wave * 4 + lane) * 80;
            float gl[8]; float gmax = -INFINITY; int gi = 0;
#pragma unroll
            for (int j = 0; j < 8; ++j) { gl[j] = L[j] + INP(37)[l * 8 + j]; if (gl[j] > gmax) { gmax = gl[j]; gi = j; } }
            float gsum = 0.f;
#pragma unroll
            for (int j = 0; j < 8; ++j) gsum += expf(gl[j] - gmax);
            const float pg_top = 1.0f / gsum;
            float pe[8]; float emax = -INFINITY;
#pragma unroll
            for (int j = 0; j < 8; ++j) { pe[j] = L[8 + gi * 8 + j] + INP(39)[l * 64 + gi * 8 + j]; emax = fmaxf(emax, pe[j]); }
            float esum = 0.f;
#pragma unroll
            for (int j = 0; j < 8; ++j) { pe[j] = expf(pe[j] - emax); esum += pe[j]; }
            int e1 = 0; float p1 = -1.f;
#pragma unroll
            for (int j = 0; j < 8; ++j) { pe[j] /= esum; if (pe[j] > p1) { p1 = pe[j]; e1 = j; } }
            int e2 = 0; float p2 = -1.f;
#pragma unroll
            for (int j = 0; j < 8; ++j) { if (j != e1 && pe[j] > p2) { p2 = pe[j]; e2 = j; } }
            const float den = p1 + p2; const float g1 = pg_top * p1 / den, g2 = pg_top * p2 / den;
            unsigned* cnt = WSP(unsigned, WS_CTL) + CW_CNT + l * 64 * CSTR; int* tokl = WSP(int, WS_TOKL); float* gatel = WSP(float, WS_GATEL);
            const int ex1 = gi * 8 + e1, ex2 = gi * 8 + e2;
            const unsigned k1 = atomicAdd(cnt + ex1 * CSTR, 1u); tokl[(size_t)ex1 * LISTCAP + k1] = 2 * r; gatel[(size_t)ex1 * LISTCAP + k1] = g1;
            const unsigned k2 = atomicAdd(cnt + ex2 * CSTR, 1u); tokl[(size_t)ex2 * LISTCAP + k2] = 2 * r + 1; gatel[(size_t)ex2 * LISTCAP + k2] = g2;
        }
        __syncthreads();
    }
}

#define EPI_ARGS const f32x4 (&acc)[2][2][4][2], const pg8::Unit& u, int wr, int wc, int fr, int fq
__device__ __forceinline__ void st_bf4(bf16* p, f32x4 v) { v2u o; o.x = cvt_pk_bf16(v.x, v.y); o.y = cvt_pk_bf16(v.z, v.w); *(v2u*)p = o; }
__device__ __forceinline__ void st_bf8(bf16* p, f32x4 a, f32x4 b) { v4u o; o.x = cvt_pk_bf16(a.x, a.y); o.y = cvt_pk_bf16(a.z, a.w); o.z = cvt_pk_bf16(b.x, b.y); o.w = cvt_pk_bf16(b.z, b.w); *(v4u*)p = o; }

struct EpiQKP {
    static constexpr bool PERM = false;
    bf16* Q; bf16* Kb; bf16* P; const f32x2* rope;
    __device__ __forceinline__ void operator()(EPI_ARGS) const {
        const int sect = u.pn >> 2, cb = (u.pn & 3) * 256; const bool latent = u.pm < TL / 256;
#pragma unroll
        for (int ai = 0; ai < 2; ++ai)
#pragma unroll
            for (int m = 0; m < 4; ++m) {
                const int r = u.pm * 256 + ai * 128 + wr * 64 + m * 16 + fr;
                int b, t; if (latent) { b = r / SEQ; t = r % SEQ; } else { b = (r - TL) / CTX; t = (r - TL) % CTX; }
                f32x4 cs0 = {1.f, 0.f, 1.f, 0.f}, cs1 = cs0;
                if (latent && sect < 2) { const int pos = (wc & 1) ? (t & 63) : (t >> 6); const f32x4* rp = (const f32x4*)(rope + pos * 16 + 4 * fq); cs0 = rp[0]; cs1 = rp[1]; }
#pragma unroll
                for (int bj = 0; bj < 2; ++bj) {
                    const int c0 = cb + bj * 128 + wc * 32 + 4 * fq;
                    f32x4 a = acc[ai][bj][m][0], bb = acc[ai][bj][m][1];
                    if (sect < 2) {
                        const f32x4 co = {cs0.x, cs0.z, cs1.x, cs1.z}, si = {cs0.y, cs0.w, cs1.y, cs1.w};
                        const f32x4 oa = a * co - bb * si, ob = a * si + bb * co; a = oa; bb = ob;
                    }
                    if (sect == 0) { a = a * QSCALE; bb = bb * QSCALE; bf16* d = Q + (size_t)r * 1024 + c0; st_bf4(d, a); st_bf4(d + 16, bb); }
                    else if (sect == 1) { const size_t kr = (size_t)b * KEYS + (latent ? CTX + t : t); bf16* d = Kb + kr * 1024 + c0; st_bf4(d, a); st_bf4(d + 16, bb); }
                    else { bf16* d = P + (size_t)r * 1024 + c0; st_bf4(d, a); st_bf4(d + 16, bb); }
                }
            }
    }
};
struct EpiVT {
    static constexpr bool PERM = false;
    bf16* VT;
    __device__ __forceinline__ void operator()(EPI_ARGS) const {
        const bool latent = u.pn < TL / 256; const int b = latent ? u.pn / 32 : u.pn - TL / 256; const int key_t0 = latent ? CTX + (u.pn % 32) * 256 : 0;
        const int kperm = 8 * (fq & 1) + 4 * (fq >> 1);
#pragma unroll
        for (int ai = 0; ai < 2; ++ai)
#pragma unroll
            for (int m = 0; m < 4; ++m) {
                const int rr = u.pm * 256 + ai * 128 + wr * 64 + m * 16 + fr;
                bf16* rowp = VT + ((size_t)b * 1024 + rr) * KEYS + key_t0;
#pragma unroll
                for (int bj = 0; bj < 2; ++bj)
#pragma unroll
                    for (int n = 0; n < 2; ++n) st_bf4(rowp + bj * 128 + wc * 32 + 16 * n + kperm, acc[ai][bj][m][n]);
            }
    }
};
struct EpiScaleBf16 {
    static constexpr bool PERM = true;
    bf16* O; int ldo, coff; const float* cscale;
    __device__ __forceinline__ void operator()(EPI_ARGS) const {
#pragma unroll
        for (int bj = 0; bj < 2; ++bj) { const int c = u.pn * 256 + bj * 128 + wc * 32 + 8 * fq; const f32x4 s0 = *(const f32x4*)(cscale + c), s1 = *(const f32x4*)(cscale + c + 4);
#pragma unroll
            for (int ai = 0; ai < 2; ++ai)
#pragma unroll
                for (int m = 0; m < 4; ++m) { const int r = u.pm * 256 + ai * 128 + wr * 64 + m * 16 + fr; st_bf8(O + (size_t)r * ldo + coff + c, acc[ai][bj][m][0] * s0, acc[ai][bj][m][1] * s1); } }
    }
};
struct EpiBf16 {
    static constexpr bool PERM = true;
    bf16* O; int ldo;
    __device__ __forceinline__ void operator()(EPI_ARGS) const {
#pragma unroll
        for (int ai = 0; ai < 2; ++ai)
#pragma unroll
            for (int m = 0; m < 4; ++m) { const int r = u.pm * 256 + ai * 128 + wr * 64 + m * 16 + fr; bf16* rowp = O + (size_t)r * ldo + u.pn * 256 + wc * 32 + 8 * fq;
#pragma unroll
                for (int bj = 0; bj < 2; ++bj) st_bf8(rowp + bj * 128, acc[ai][bj][m][0], acc[ai][bj][m][1]); }
    }
};
struct EpiRes {
    static constexpr bool PERM = false;
    const float* xlat; const float* xctx; float* xout; const float* gate0;
    __device__ __forceinline__ void operator()(EPI_ARGS) const {
        const bool latent = u.pm < TL / 256;
#pragma unroll
        for (int ai = 0; ai < 2; ++ai)
#pragma unroll
            for (int m = 0; m < 4; ++m) { const int r = u.pm * 256 + ai * 128 + wr * 64 + m * 16 + fr; const int ms = latent ? r / SEQ : 2;
                const float* xi = latent ? xlat + (size_t)r * 2048 : xctx + (size_t)(r - TL) * 2048; const float* gp = gate0 + (size_t)ms * 12288;
#pragma unroll
                for (int bj = 0; bj < 2; ++bj)
#pragma unroll
                    for (int n = 0; n < 2; ++n) { const int c = u.pn * 256 + bj * 128 + wc * 32 + 16 * n + 4 * fq;
                        const f32x4 xv = *(const f32x4*)(xi + c), gv = *(const f32x4*)(gp + c); *(f32x4*)(xout + (size_t)r * 2048 + c) = xv + gv * acc[ai][bj][m][n]; } }
    }
};
struct EpiMoeUp {
    static constexpr bool PERM = false;
    bf16* H;
    __device__ __forceinline__ void operator()(EPI_ARGS) const {
#pragma unroll
        for (int ai = 0; ai < 2; ++ai)
#pragma unroll
            for (int m = 0; m < 4; ++m) { const size_t r = (size_t)u.pm * 256 + ai * 128 + wr * 64 + m * 16 + fr;
#pragma unroll
                for (int bj = 0; bj < 2; ++bj) { const int hc = (u.pn * 256 + bj * 128 + wc * 32) / 2 + 4 * fq; const f32x4 a = acc[ai][bj][m][0], b = acc[ai][bj][m][1];
                    const f32x4 h = {siluf_(a.x) * b.x, siluf_(a.y) * b.y, siluf_(a.z) * b.z, siluf_(a.w) * b.w}; st_bf4(H + r * 512 + hc, h); } }
    }
};
struct EpiMoeDown {
    static constexpr bool PERM = true;
    bf16* Y; const int* tokl; const float* gatel; const unsigned* cnt;
    __device__ __forceinline__ void operator()(EPI_ARGS) const {
        const int ce = (int)cnt[u.e * CSTR];
#pragma unroll
        for (int ai = 0; ai < 2; ++ai)
#pragma unroll
            for (int m = 0; m < 4; ++m) { const int idx = u.idx0 + ai * 128 + wr * 64 + m * 16 + fr;
                if (idx < ce) { const int pair = tokl[(size_t)u.e * LISTCAP + idx]; const float gt = gatel[(size_t)u.e * LISTCAP + idx]; bf16* rowp = Y + (size_t)pair * 2048 + u.pn * 256 + wc * 32 + 8 * fq;
#pragma unroll
                    for (int bj = 0; bj < 2; ++bj) st_bf8(rowp + bj * 128, acc[ai][bj][m][0] * gt, acc[ai][bj][m][1] * gt); } }
    }
};
struct EpiGlu {
    static constexpr bool PERM = true;
    bf16* O; int ldo, coff; const bf16* Gb; const float* bias;
    __device__ __forceinline__ void operator()(EPI_ARGS) const {
#pragma unroll
        for (int ai = 0; ai < 2; ++ai)
#pragma unroll
            for (int m = 0; m < 4; ++m) { const int r = u.pm * 256 + ai * 128 + wr * 64 + m * 16 + fr;
#pragma unroll
                for (int bj = 0; bj < 2; ++bj) { const int c = u.pn * 256 + bj * 128 + wc * 32 + 8 * fq; const f32x4 b0 = *(const f32x4*)(bias + c), b1 = *(const f32x4*)(bias + c + 4); const v4u gw = *(const v4u*)(Gb + (size_t)r * 1024 + c);
                    const f32x4 a0 = acc[ai][bj][m][0] + b0, a1 = acc[ai][bj][m][1] + b1;
                    const f32x4 o0 = {bflo(gw.x) * sigmoidf_(a0.x), bfhi(gw.x) * sigmoidf_(a0.y), bflo(gw.y) * sigmoidf_(a0.z), bfhi(gw.y) * sigmoidf_(a0.w)};
                    const f32x4 o1 = {bflo(gw.z) * sigmoidf_(a1.x), bfhi(gw.z) * sigmoidf_(a1.y), bflo(gw.w) * sigmoidf_(a1.z), bfhi(gw.w) * sigmoidf_(a1.w)};
                    st_bf8(O + (size_t)r * ldo + coff + c, o0, o1); } }
    }
};

struct MoeOrder {
    const LAS int* bstart;
    const unsigned* cnt; const int* tokl; int nN, G, c, nblk; long bstride, eoff; bool up;
    __device__ bool next(int i, pg8::Unit& u) const {
        const long Lx = (long)i * G + c; if (Lx >= (long)nblk * nN) return false;
        const int blk = (int)(Lx / nN); u.pn = (int)(Lx % nN); u.pm = blk;
        const int e = bstart[65 + blk];
        u.e = e; u.idx0 = (blk - bstart[e]) * 256;
        u.aoff = up ? 0 : (long)blk * 256 * 512 * 2;
        u.boff = (long)e * (long)MOE_E_BYTES + eoff + (long)u.pn * bstride;
        return true;
    }
    __device__ int arow(const pg8::Unit& u, int row) const { const int idx = u.idx0 + row; return idx < (int)cnt[u.e * CSTR] ? (tokl[(size_t)u.e * LISTCAP + idx] >> 1) : TT; }
};

__device__ __forceinline__ void tile_order(int wgid, int nM, int nN, int& pm, int& pn) {
    const int nwg = nM * nN; { const int q = nwg / 8, r = nwg % 8, xcd = wgid % 8, off = wgid / 8; wgid = (xcd < r ? xcd * (q + 1) : r * (q + 1) + (xcd - r) * q) + off; }
    const int nig = 8 * nN, gid = wgid / nig, fm = gid * 8, gsz = (nM - fm) < 8 ? (nM - fm) : 8;
    pm = fm + ((wgid % nig) % gsz); pn = (wgid % nig) / gsz;
}
struct InProj0Order {
    int G, c; long offA1, offB1, offA2, offB2;
    __device__ bool next(int i, pg8::Unit& u) const {
        const int Lx = i * G + c; constexpr int N1 = (TT / 256) * 12, N2 = 4 * (TT / 256); constexpr long TS = 256L * 2048 * 2;
        if (Lx >= N1 + N2) return false;
        u.idx0 = 0;
        if (Lx < N1) { tile_order(Lx, TT / 256, 12, u.pm, u.pn); u.aoff = offA1 + (long)u.pm * TS; u.boff = offB1 + (long)u.pn * TS; u.e = 0; }
        else { tile_order(Lx - N1, 4, TT / 256, u.pm, u.pn); u.aoff = offA2 + (long)u.pm * TS; u.boff = offB2 + (long)u.pn * TS; u.e = 1; }
        return true;
    }
    __device__ int arow(const pg8::Unit&, int) const { return 0; }
};
struct EpiInProj0 {
    static constexpr bool PERM = false;
    EpiQKP e1; EpiVT e2;
    __device__ __forceinline__ void operator()(EPI_ARGS) const { if (u.e == 0) e1(acc, u, wr, wc, fr, fq); else e2(acc, u, wr, wc, fr, fq); }
};

#ifdef ATT_NORARE
#define ATT_RARE(mx) false
#else
#define ATT_RARE(mx) __any(mx > 8.0f)
#endif
__device__ __forceinline__ float xhalf_max(float v) {
    const auto r = __builtin_amdgcn_permlane32_swap(__builtin_bit_cast(unsigned, v), __builtin_bit_cast(unsigned, v), false, false);
    return fmaxf(__builtin_bit_cast(float, r[0]), __builtin_bit_cast(float, r[1]));
}
__device__ __forceinline__ void attn_phase(Frame& F, const int cvslot) {
    const bf16* Q = WSP(bf16, WS_Q); const bf16* Kb = WSP(bf16, WS_K); const bf16* VT = WSP(bf16, WS_VT); bf16* cat = WSP(bf16, WS_CAT);
    LAS unsigned char* lds = F.lds;
    const int lane0 = F.lane;
    float lam;
    { const float* lv = INP(11); float a = lv[lane0] * lv[64 + lane0], b = lv[128 + lane0] * lv[192 + lane0]; a = wave_sum(a); b = wave_sum(b); lam = expf(a) - expf(b) + 0.2f; }
    const float* subg = INP(12);
    const int NU = 1024 + 32;
    const int xcd = F.bid & 7, jcu = F.bid >> 3;
    for (int it = 0;; ++it) {
        if (it == cvslot) { for (int rep_ = 0; rep_ < (((PH_REPEAT >> 26) & 1u) ? 2 : 1); ++rep_) { moe_convert_items(F); __syncthreads(); } }
        int tl_ = F.tid; asm volatile("" : "+v"(tl_));
        const int lane = tl_ & 63, w = __builtin_amdgcn_readfirstlane(tl_ >> 6), sub = w & 1, qw = w >> 1, r32 = lane & 31, hi = lane >> 5;
        int uidx;
        if (F.G == 256) { if (it < 4) uidx = 128 * xcd + it * 32 + jcu; else if (it == 4 && F.bid < 32) uidx = 1024 + F.bid; else break; }
        else { uidx = it * F.G + F.bid; if (uidx >= NU) break; }
        int b, head, q0row, nt; size_t kbase;
        if (uidx < 1024) { const int combo = uidx >> 6, qb = uidx & 63; b = combo >> 3; head = combo & 7; q0row = b * SEQ + qb * 128; nt = KEYS / 64; }
        else { const int v = uidx - 1024; b = v >> 4; head = (v >> 1) & 7; q0row = TL + b * CTX + (v & 1) * 128; nt = CTX / 64; }
        kbase = (size_t)b * KEYS;
        bf16x8 qf[4];
        { const bf16* qp = Q + (size_t)(q0row + qw * 32 + r32) * 1024 + head * 128 + sub * 64 + hi * 8;
#pragma unroll
          for (int ks = 0; ks < 4; ++ks) qf[ks] = *(const bf16x8*)(qp + ks * 16); }
        const char* gsrc[4];
#pragma unroll
        for (int j = 0; j < 4; ++j) { const int pi = w * 4 + j, rr = lane >> 3, pc = lane & 7;
            if (pi < 16) { const int key = (pi & 7) * 8 + rr, c = pc ^ ((key >> 1) & 7); gsrc[j] = (const char*)(Kb + (kbase + key) * 1024 + head * 128 + (pi >> 3) * 64 + c * 8); }
            else { const int dvr = (pi - 16) * 8 + rr, c = pc ^ ((dvr >> 1) & 7); gsrc[j] = (const char*)(VT + ((size_t)(b * 8 + head) * 128 + dvr) * KEYS + c * 8); } }
        const size_t gstep = (w < 4) ? (size_t)65536 * 2 : (size_t)64 * 2;
        const unsigned ldst = (unsigned)w * 4096u;
#define ATT_DMA(t, buf) do { _Pragma("unroll") for (int _j = 0; _j < 4; ++_j) \
            __builtin_amdgcn_global_load_lds((const unsigned*)(gsrc[_j] + (size_t)(t) * gstep), (LAS unsigned*)(lds + (buf) * 32768 + ldst + _j * 1024), 16, 0, 0); } while (0)
        ATT_DMA(0, 0); ATT_DMA(1, 1); ATT_DMA(2, 2);
        asm volatile("s_waitcnt vmcnt(4)" ::: "memory");
        __builtin_amdgcn_s_barrier();
        f32x16 o[4];
#pragma unroll
        for (int d = 0; d < 4; ++d)
#pragma unroll
            for (int r = 0; r < 16; ++r) o[d][r] = 0.f;
        float mref = 0.f, lrow = 0.f;
        f32x16 negm;
#pragma unroll
        for (int r = 0; r < 16; ++r) negm[r] = 0.f;
        const int rdoff = r32 * 128;
        const int swz = (r32 >> 1) & 7;
        f32x16 s0, s1; bf16x8 pf[4];
#define ATT_QK(bufidx) do { const LAS unsigned char* kp_ = lds + (bufidx) * 32768 + sub * 8192; bf16x8 kfa[4], kfb[4]; \
            _Pragma("unroll") for (int ks = 0; ks < 4; ++ks) { const int ch = ((2 * ks + hi) ^ swz) * 16; kfa[ks] = *(const LAS bf16x8*)(kp_ + rdoff + ch); kfb[ks] = *(const LAS bf16x8*)(kp_ + 4096 + rdoff + ch); } \
            s0 = negm; s1 = negm; \
            _Pragma("unroll") for (int ks = 0; ks < 4; ++ks) { s0 = __builtin_amdgcn_mfma_f32_32x32x16_bf16(kfa[ks], qf[ks], s0, 0, 0, 0); s1 = __builtin_amdgcn_mfma_f32_32x32x16_bf16(kfb[ks], qf[ks], s1, 0, 0, 0); } \
            asm volatile("" : "+v"(s0), "+v"(s1) : "v"(kfa[0]), "v"(kfa[1]), "v"(kfa[2]), "v"(kfa[3]), "v"(kfb[0]), "v"(kfb[1]), "v"(kfb[2]), "v"(kfb[3])); } while (0)
#define ATT_MAX(mx) do { float mxa = fmaxf(fmaxf(s0[0], s0[1]), s0[2]), mxb = fmaxf(fmaxf(s1[0], s1[1]), s1[2]); \
            _Pragma("unroll") for (int r = 3; r < 15; r += 2) { mxa = fmaxf(fmaxf(mxa, s0[r]), s0[r + 1]); mxb = fmaxf(fmaxf(mxb, s1[r]), s1[r + 1]); } \
            mx = fmaxf(fmaxf(mxa, mxb), fmaxf(s0[15], s1[15])); mx = xhalf_max(mx); } while (0)
#define ATT_FIX(mx) do { const float dl = fmaxf(mx, 0.f); mref += dl; const float alpha = __builtin_amdgcn_exp2f(-dl); lrow *= alpha; \
            _Pragma("unroll") for (int r = 0; r < 16; ++r) { s0[r] -= dl; s1[r] -= dl; negm[r] = -mref; } \
            _Pragma("unroll") for (int d = 0; d < 4; ++d) _Pragma("unroll") for (int r = 0; r < 16; ++r) o[d][r] *= alpha; } while (0)
#define ATT_EXP8(S, base, dst) do { float rs_ = 0.f; _Pragma("unroll") for (int r = 0; r < 8; ++r) { S[base + r] = __builtin_amdgcn_exp2f(S[base + r]); rs_ += S[base + r]; } lrow += rs_; \
            v4u pw_; pw_.x = cvt_pk_bf16(S[base + 0], S[base + 1]); pw_.y = cvt_pk_bf16(S[base + 2], S[base + 3]); pw_.z = cvt_pk_bf16(S[base + 4], S[base + 5]); pw_.w = cvt_pk_bf16(S[base + 6], S[base + 7]); dst = __builtin_bit_cast(bf16x8, pw_); } while (0)
#define ATT_VLD(dstv, vp_, s) do { _Pragma("unroll") for (int d = 0; d < 4; ++d) dstv[d] = *(const LAS bf16x8*)(vp_ + d * 4096 + rdoff + (((2 * (s) + hi) ^ swz) * 16)); } while (0)
#define ATT_PV4(srcv, pfrag) do { _Pragma("unroll") for (int d = 0; d < 4; ++d) o[d] = __builtin_amdgcn_mfma_f32_32x32x16_bf16(srcv[d], pfrag, o[d], 0, 0, 0); } while (0)
        { ATT_QK(0); float mx; ATT_MAX(mx); if (__any(mx > 8.0f)) ATT_FIX(mx);
          ATT_EXP8(s0, 0, pf[0]); ATT_EXP8(s0, 8, pf[1]); ATT_EXP8(s1, 0, pf[2]); ATT_EXP8(s1, 8, pf[3]); }
        int bcur = 0;
#pragma nounroll
        for (int t = 0; t < nt; ++t) {
            const int bn1 = (bcur + 1) & 3, bn3 = (bcur + 3) & 3;
            if (t + 3 < nt) ATT_DMA(t + 3, bn3);
            const LAS unsigned char* vp = lds + bcur * 32768 + 16384;
            bf16x8 vfa[4], vfb[4];
            if (t + 1 < nt) {
                __builtin_amdgcn_sched_barrier(0);
                ATT_QK(bn1);
                float mx; ATT_MAX(mx);
                __builtin_amdgcn_sched_barrier(0);
                if (__any(mx > 8.0f)) {
                    const float dl = fmaxf(mx, 0.f); mref += dl; const float alpha = __builtin_amdgcn_exp2f(-dl); lrow *= alpha;
#pragma unroll
                    for (int r = 0; r < 16; ++r) { s0[r] -= dl; s1[r] -= dl; negm[r] = -mref; }
#pragma unroll
                    for (int d = 0; d < 4; ++d)
#pragma unroll
                        for (int r = 0; r < 16; ++r) o[d][r] *= alpha;
#pragma unroll
                    for (int s = 0; s < 4; ++s) { v4u pw = __builtin_bit_cast(v4u, pf[s]);
                        pw.x = cvt_pk_bf16(bflo(pw.x) * alpha, bfhi(pw.x) * alpha); pw.y = cvt_pk_bf16(bflo(pw.y) * alpha, bfhi(pw.y) * alpha);
                        pw.z = cvt_pk_bf16(bflo(pw.z) * alpha, bfhi(pw.z) * alpha); pw.w = cvt_pk_bf16(bflo(pw.w) * alpha, bfhi(pw.w) * alpha); pf[s] = __builtin_bit_cast(bf16x8, pw); }
                }
                __builtin_amdgcn_sched_barrier(0);
                {
                    ATT_VLD(vfa, vp, 0);
                    __builtin_amdgcn_sched_barrier(0);
                    ATT_VLD(vfb, vp, 1); ATT_PV4(vfa, pf[0]); ATT_EXP8(s0, 0, pf[0]);
                    __builtin_amdgcn_sched_barrier(0);
                    ATT_VLD(vfa, vp, 2); ATT_PV4(vfb, pf[1]); ATT_EXP8(s0, 8, pf[1]);
                    __builtin_amdgcn_sched_barrier(0);
                    ATT_VLD(vfb, vp, 3); ATT_PV4(vfa, pf[2]); ATT_EXP8(s1, 0, pf[2]);
                    __builtin_amdgcn_sched_barrier(0);
                    ATT_PV4(vfb, pf[3]); ATT_EXP8(s1, 8, pf[3]);
                }
                __builtin_amdgcn_sched_barrier(0);
            } else {
#pragma unroll
                for (int s = 0; s < 4; ++s) { ATT_VLD(vfa, vp, s); ATT_PV4(vfa, pf[s]); }
            }
            if (t + 3 < nt) asm volatile("s_waitcnt vmcnt(4) lgkmcnt(0)" ::: "memory"); else asm volatile("s_waitcnt vmcnt(0) lgkmcnt(0)" ::: "memory");
            __builtin_amdgcn_s_barrier();
            bcur = bn1;
        }
#undef ATT_DMA
#undef ATT_QK
#undef ATT_MAX
#undef ATT_FIX
#undef ATT_EXP8
#undef ATT_VLD
#undef ATT_PV4
        const float ltot = lrow + __shfl_xor(lrow, 32); const float linv = 1.0f / ltot;
        LAS float* xch = (LAS float*)lds + (size_t)(qw * 32 + r32) * 132;
        if (sub == 1) {
#pragma unroll
            for (int d = 0; d < 4; ++d)
#pragma unroll
                for (int g = 0; g < 4; ++g) *(LAS f32x4*)(xch + 32 * d + 8 * g + 4 * hi) = (f32x4){o[d][4 * g] * linv, o[d][4 * g + 1] * linv, o[d][4 * g + 2] * linv, o[d][4 * g + 3] * linv};
        }
        __syncthreads();
        if (sub == 0) {
            float ss = 0.f;
#pragma unroll
            for (int d = 0; d < 4; ++d)
#pragma unroll
                for (int g = 0; g < 4; ++g) { const f32x4 o2 = *(const LAS f32x4*)(xch + 32 * d + 8 * g + 4 * hi);
#pragma unroll
                    for (int j = 0; j < 4; ++j) { const float v = o[d][4 * g + j] * linv - lam * o2[j]; o[d][4 * g + j] = v; ss += v * v; } }
            ss += __shfl_xor(ss, 32);
            const float rn = 0.8f / sqrtf(ss * (1.0f / 128.0f) + EPS);
            bf16* op = cat + (size_t)(q0row + qw * 32 + r32) * 2048 + head * 128;
#pragma unroll
            for (int d = 0; d < 4; ++d)
#pragma unroll
                for (int g = 0; g < 4; ++g) { const int dv = 32 * d + 8 * g + 4 * hi; const f32x4 gg = *(const f32x4*)(subg + dv);
                    st_bf4(op + dv, (f32x4){o[d][4 * g] * rn * gg.x, o[d][4 * g + 1] * rn * gg.y, o[d][4 * g + 2] * rn * gg.z, o[d][4 * g + 3] * rn * gg.w}); }
        }
        __syncthreads();
    }
}

__device__ __forceinline__ void poold_phase(Frame& F) {
    const bf16* P = WSP(bf16, WS_P); bf16* PD = WSP(bf16, WS_PD);
    const int gt = F.bid * NTHREADS + F.tid, NGT = F.G * NTHREADS;
    for (int idx = gt; idx < TT * 128; idx += NGT) {
        const int r = idx >> 7, cc = (idx & 127) * 8, g = cc >> 8, wdw = 2 << g;
        int sb, t, Ls; if (r < TL) { sb = (r / SEQ) * SEQ; t = r % SEQ; Ls = SEQ; } else { sb = TL + ((r - TL) / CTX) * CTX; t = (r - TL) % CTX; Ls = CTX; }
        const int lo0 = t - wdw / 2; int lo = lo0, hi = lo + wdw; lo = lo < 0 ? 0 : lo; hi = hi > Ls ? Ls : hi;
        float a[8];
#pragma unroll
        for (int j = 0; j < 8; ++j) a[j] = 0.f;
        v4u wv[16];
#pragma unroll
        for (int i = 0; i < 16; ++i) { const int s = lo0 + i; wv[i] = (v4u){0u, 0u, 0u, 0u}; if (i < wdw && s >= 0 && s < Ls) wv[i] = *(const v4u*)(P + (size_t)(sb + s) * 1024 + cc); }
#pragma unroll
        for (int i = 0; i < 16; ++i) { const v4u v = wv[i];
            a[0] += bflo(v.x); a[1] += bfhi(v.x); a[2] += bflo(v.y); a[3] += bfhi(v.y); a[4] += bflo(v.z); a[5] += bfhi(v.z); a[6] += bflo(v.w); a[7] += bfhi(v.w); }
        const float inv = 1.0f / (float)(hi - lo);
        const v4u me = *(const v4u*)(P + (size_t)r * 1024 + cc);
        v4u o; o.x = pk2(a[0] * inv - bflo(me.x), a[1] * inv - bfhi(me.x)); o.y = pk2(a[2] * inv - bflo(me.y), a[3] * inv - bfhi(me.y));
        o.z = pk2(a[4] * inv - bflo(me.z), a[5] * inv - bfhi(me.z)); o.w = pk2(a[6] * inv - bflo(me.w), a[7] * inv - bfhi(me.w));
        *(v4u*)(PD + (size_t)r * 1024 + cc) = o;
    }
}

__device__ __forceinline__ void shortconv_phase(Frame& F) {
    const bf16* PJ = WSP(bf16, WS_PROJ1); float* GT = WSP(float, WS_GT);
    const float* cw = INP(17); const float* cb = INP(18);
    LAS float* scr = (LAS float*)(F.lds + F.wave * 17408);
    const int lane = F.lane;
    for (int it = F.gw; it < 2 * 128 * 48; it += F.NGW) {
        const int cbk = it % 48, tb = (it / 48) % 128, b = it / (48 * 128), col = cbk * 64 + lane, t0 = tb * 64;
        const bf16* base = PJ + ((size_t)b * SEQ) * 4096 + cbk * 64 + (lane & 7) * 8;
#pragma unroll
        for (int i = 0; i < 9; ++i) { const int row = 8 * i + (lane >> 3); const int t = t0 - 1 + row;
            if (row < 66) { v4u v = {0u, 0u, 0u, 0u}; if (t >= 0 && t < SEQ) v = *(const v4u*)(base + (size_t)t * 4096);
                LAS float* d = scr + row * 65 + (lane & 7) * 8; d[0] = bflo(v.x); d[1] = bfhi(v.x); d[2] = bflo(v.y); d[3] = bfhi(v.y); d[4] = bflo(v.z); d[5] = bfhi(v.z); d[6] = bflo(v.w); d[7] = bfhi(v.w); } }
        LDS_WAIT(); asm volatile("" ::: "memory");
        const float w0 = cw[col], w1 = cw[3072 + col], w2 = cw[2 * 3072 + col], bias = cb[col];
        float prev = scr[lane], cur = scr[65 + lane];
#pragma unroll 8
        for (int tt = 0; tt < 64; ++tt) { const float nxt = scr[(tt + 2) * 65 + lane]; const float o = prev * w0 + cur * w1 + nxt * w2 + bias; scr[tt * 65 + lane] = o; prev = cur; cur = nxt; }
        LDS_WAIT(); asm volatile("" ::: "memory");
        for (int c = 0; c < 64; ++c) GT[((size_t)(cbk * 64 + c) * 2 + b) * SEQ + t0 + lane] = scr[lane * 65 + c];
        LDS_WAIT(); asm volatile("" ::: "memory");
    }
}

__device__ __forceinline__ void s5_gelu_phase(Frame& F) {
    const bf16* PJ = WSP(bf16, WS_PROJ1); const float* YD = WSP(float, WS_YD); bf16* Gb = WSP(bf16, WS_PD); const float* dd = INP(33);
    const int gt = F.bid * NTHREADS + F.tid, NGT = F.G * NTHREADS;
    for (int idx = gt; idx < TL * 256; idx += NGT) { const int r = idx >> 8, c = (idx & 255) * 4;
        const v2u uw = *(const v2u*)(PJ + (size_t)r * 4096 + 3072 + c); const f32x4 d4 = *(const f32x4*)(dd + c);
        const int bb = r / SEQ, tt = r % SEQ, gg = c >> 4, cc = c & 15;
        const f32x4 y0 = *(const f32x4*)(YD + (((size_t)(0 * 2 + bb) * 64 + gg) * SEQ + tt) * 16 + cc), y1 = *(const f32x4*)(YD + (((size_t)(1 * 2 + bb) * 64 + gg) * SEQ + tt) * 16 + cc);
        const f32x4 y = {bflo(uw.x) * d4.x + y0.x + y1.x, bfhi(uw.x) * d4.y + y0.y + y1.y, bflo(uw.y) * d4.z + y0.z + y1.z, bfhi(uw.y) * d4.w + y0.w + y1.w};
        st_bf4(Gb + (size_t)r * 1024 + c, (f32x4){gelu_tanh(y.x), gelu_tanh(y.y), gelu_tanh(y.z), gelu_tanh(y.w)}); }
}

__device__ __forceinline__ f32x2 cmulf(f32x2 a, f32x2 b) { return (f32x2){a.x * b.x - a.y * b.y, a.x * b.y + a.y * b.x}; }
__device__ __forceinline__ int drev14(int p) { const unsigned r = __builtin_bitreverse32((unsigned)p) >> 18; return (int)(((r & 0x2AAAu) >> 1) | ((r & 0x1555u) << 1)); }
template <int L, bool ZHI>
__device__ __forceinline__ void fft_fwd_pass(LAS f32x2* X, const f32x2* tw, int tid) {
    constexpr int tws = 4096 / L;
    if constexpr (L == 1) {
#pragma unroll 2
        for (int i = 0; i < 8; ++i) { const int i0 = (tid + NTHREADS * i) * 4;
            const f32x4 p01 = *(const LAS f32x4*)(X + i0), p23 = *(const LAS f32x4*)(X + i0 + 2);
            const f32x2 x0 = {p01.x, p01.y}, x1 = {p01.z, p01.w}, x2 = {p23.x, p23.y}, x3 = {p23.z, p23.w};
            const f32x2 a = x0 + x2, bb = x0 - x2, c = x1 + x3, d = x1 - x3;
            const f32x2 y0 = a + c, y1 = {bb.x + d.y, bb.y - d.x}, y2 = a - c, y3 = {bb.x - d.y, bb.y + d.x};
            *(LAS f32x4*)(X + i0) = (f32x4){y0.x, y0.y, y1.x, y1.y}; *(LAS f32x4*)(X + i0 + 2) = (f32x4){y2.x, y2.y, y3.x, y3.y}; }
        LDS_BARRIER();
        return;
    }
#pragma unroll 2
    for (int i = 0; i < 8; ++i) {
        const int b = tid + NTHREADS * i, j = b & (L - 1), i0 = (b - j) * 4 + j;
        const f32x2 w1 = tw[j * tws], w2 = cmulf(w1, w1), w3 = cmulf(w2, w1);
        const f32x2 x0 = X[i0], x1 = X[i0 + L];
        if (ZHI) {
            const f32x2 t1 = {x0.x + x1.y, x0.y - x1.x}, t3 = {x0.x - x1.y, x0.y + x1.x};
            X[i0] = x0 + x1; X[i0 + L] = cmulf(t1, w1); X[i0 + 2 * L] = cmulf(x0 - x1, w2); X[i0 + 3 * L] = cmulf(t3, w3);
        } else {
            const f32x2 x2 = X[i0 + 2 * L], x3 = X[i0 + 3 * L];
            const f32x2 a = x0 + x2, bb = x0 - x2, c = x1 + x3, d = x1 - x3;
            const f32x2 t1 = {bb.x + d.y, bb.y - d.x}, t3 = {bb.x - d.y, bb.y + d.x};
            X[i0] = a + c; X[i0 + L] = cmulf(t1, w1); X[i0 + 2 * L] = cmulf(a - c, w2); X[i0 + 3 * L] = cmulf(t3, w3);
        }
    }
    LDS_BARRIER();
}
template <int L>
__device__ __forceinline__ void fft_fwd_pass16(LAS f32x2* X, const f32x2* tw, int tid) {
    constexpr int Q = L / 4, tws = 4096 / L;
    const int jq = tid & (Q - 1);
    f32x2 wa[4][3];
#pragma unroll
    for (int mq = 0; mq < 4; ++mq) { const f32x2 w1 = tw[(mq * Q + jq) * tws]; wa[mq][0] = w1; wa[mq][1] = cmulf(w1, w1); wa[mq][2] = cmulf(wa[mq][1], w1); }
    const f32x2 v1 = tw[jq * 4 * tws], v2 = cmulf(v1, v1), v3 = cmulf(v2, v1);
#pragma unroll
    for (int i = 0; i < 2; ++i) {
        const int u = tid + NTHREADS * i, base = (u / Q) * 4 * L + jq;
        f32x2 pt[4][4];
#pragma unroll
        for (int m = 0; m < 4; ++m)
#pragma unroll
            for (int mq = 0; mq < 4; ++mq) pt[m][mq] = X[base + m * L + mq * Q];
#pragma unroll
        for (int mq = 0; mq < 4; ++mq) {
            const f32x2 x0 = pt[0][mq], x1 = pt[1][mq], x2 = pt[2][mq], x3 = pt[3][mq];
            const f32x2 a = x0 + x2, bb = x0 - x2, c = x1 + x3, d = x1 - x3;
            const f32x2 t1 = {bb.x + d.y, bb.y - d.x}, t3 = {bb.x - d.y, bb.y + d.x};
            pt[0][mq] = a + c; pt[1][mq] = cmulf(t1, wa[mq][0]); pt[2][mq] = cmulf(a - c, wa[mq][1]); pt[3][mq] = cmulf(t3, wa[mq][2]);
        }
#pragma unroll
        for (int m = 0; m < 4; ++m) {
            const f32x2 x0 = pt[m][0], x1 = pt[m][1], x2 = pt[m][2], x3 = pt[m][3];
            const f32x2 a = x0 + x2, bb = x0 - x2, c = x1 + x3, d = x1 - x3;
            const f32x2 t1 = {bb.x + d.y, bb.y - d.x}, t3 = {bb.x - d.y, bb.y + d.x};
            X[base + m * L] = a + c; X[base + m * L + Q] = cmulf(t1, v1); X[base + m * L + 2 * Q] = cmulf(a - c, v2); X[base + m * L + 3 * Q] = cmulf(t3, v3);
        }
    }
    LDS_BARRIER();
}
template <bool ZHI>
__device__ __forceinline__ void fft_fwd(LAS f32x2* X, const f32x2* tw, int tid) {
    fft_fwd_pass<4096, ZHI>(X, tw, tid); fft_fwd_pass16<1024>(X, tw, tid); fft_fwd_pass16<64>(X, tw, tid);
    fft_fwd_pass<4, false>(X, tw, tid); fft_fwd_pass<1, false>(X, tw, tid);
}
template <int L, bool LOHALF>
__device__ __forceinline__ void fft_inv_pass(LAS f32x2* X, const f32x2* tw, int tid) {
    constexpr int tws = 4096 / L;
    if constexpr (L == 1) {
#pragma unroll 2
        for (int i = 0; i < 8; ++i) { const int i0 = (tid + NTHREADS * i) * 4;
            const f32x4 p01 = *(const LAS f32x4*)(X + i0), p23 = *(const LAS f32x4*)(X + i0 + 2);
            const f32x2 x0 = {p01.x, p01.y}, x1 = {p01.z, p01.w}, x2 = {p23.x, p23.y}, x3 = {p23.z, p23.w};
            const f32x2 a = x0 + x2, bb = x0 - x2, c = x1 + x3, d = x1 - x3;
            const f32x2 y0 = a + c, y1 = {bb.x - d.y, bb.y + d.x}, y2 = a - c, y3 = {bb.x + d.y, bb.y - d.x};
            *(LAS f32x4*)(X + i0) = (f32x4){y0.x, y0.y, y1.x, y1.y}; *(LAS f32x4*)(X + i0 + 2) = (f32x4){y2.x, y2.y, y3.x, y3.y}; }
        LDS_BARRIER();
        return;
    }
#pragma unroll 2
    for (int i = 0; i < 8; ++i) {
        const int b = tid + NTHREADS * i, j = b & (L - 1), i0 = (b - j) * 4 + j;
        f32x2 w1 = tw[j * tws]; w1.y = -w1.y; const f32x2 w2 = cmulf(w1, w1), w3 = cmulf(w2, w1);
        const f32x2 x0 = X[i0], x1 = cmulf(X[i0 + L], w1), x2 = cmulf(X[i0 + 2 * L], w2), x3 = cmulf(X[i0 + 3 * L], w3);
        const f32x2 a = x0 + x2, bb = x0 - x2, c = x1 + x3, d = x1 - x3;
        X[i0] = a + c; X[i0 + L] = (f32x2){bb.x - d.y, bb.y + d.x};
        if (!LOHALF) { X[i0 + 2 * L] = a - c; X[i0 + 3 * L] = (f32x2){bb.x + d.y, bb.y - d.x}; }
    }
    LDS_BARRIER();
}
template <int L>
__device__ __forceinline__ void fft_inv_pass16(LAS f32x2* X, const f32x2* tw, int tid) {
    constexpr int tws = 4096 / L, tws4 = 1024 / L;
    const int jq = tid & (L - 1);
    f32x2 v1 = tw[jq * tws]; v1.y = -v1.y; const f32x2 v2 = cmulf(v1, v1), v3 = cmulf(v2, v1);
    f32x2 wb[4][3];
#pragma unroll
    for (int mq = 0; mq < 4; ++mq) { f32x2 w1 = tw[(mq * L + jq) * tws4]; w1.y = -w1.y; wb[mq][0] = w1; wb[mq][1] = cmulf(w1, w1); wb[mq][2] = cmulf(wb[mq][1], w1); }
#pragma unroll
    for (int i = 0; i < 2; ++i) {
        const int u = tid + NTHREADS * i, base = (u / L) * 16 * L + jq;
        f32x2 pt[4][4];
#pragma unroll
        for (int M = 0; M < 4; ++M)
#pragma unroll
            for (int mq = 0; mq < 4; ++mq) pt[M][mq] = X[base + M * 4 * L + mq * L];
#pragma unroll
        for (int M = 0; M < 4; ++M) {
            const f32x2 x0 = pt[M][0], x1 = cmulf(pt[M][1], v1), x2 = cmulf(pt[M][2], v2), x3 = cmulf(pt[M][3], v3);
            const f32x2 a = x0 + x2, bb = x0 - x2, c = x1 + x3, d = x1 - x3;
            pt[M][0] = a + c; pt[M][1] = (f32x2){bb.x - d.y, bb.y + d.x}; pt[M][2] = a - c; pt[M][3] = (f32x2){bb.x + d.y, bb.y - d.x};
        }
#pragma unroll
        for (int mq = 0; mq < 4; ++mq) {
            const f32x2 x0 = pt[0][mq], x1 = cmulf(pt[1][mq], wb[mq][0]), x2 = cmulf(pt[2][mq], wb[mq][1]), x3 = cmulf(pt[3][mq], wb[mq][2]);
            const f32x2 a = x0 + x2, bb = x0 - x2, c = x1 + x3, d = x1 - x3;
            X[base + mq * L] = a + c; X[base + 4 * L + mq * L] = (f32x2){bb.x - d.y, bb.y + d.x}; X[base + 8 * L + mq * L] = a - c; X[base + 12 * L + mq * L] = (f32x2){bb.x + d.y, bb.y - d.x};
        }
    }
    LDS_BARRIER();
}
__device__ __forceinline__ void fft_inv(LAS f32x2* X, const f32x2* tw, int tid) {
    fft_inv_pass<1, false>(X, tw, tid); fft_inv_pass<4, false>(X, tw, tid); fft_inv_pass16<16>(X, tw, tid); fft_inv_pass16<256>(X, tw, tid);
    fft_inv_pass<4096, true>(X, tw, tid);
}
__device__ __forceinline__ void fft_untangle(const LAS f32x2* X, f32x2* K0g, f32x2* K1g, float sc0, float sc1, int tid) {
    const float h0 = 0.5f * sc0, h1 = 0.5f * sc1;
#pragma unroll 4
    for (int i = 0; i < 32; ++i) {
        const int p = tid + NTHREADS * i, f = drev14(p), pm = drev14((16384 - f) & 16383);
        const f32x2 A = X[p], B = X[pm];
        const f32x2 dd = {A.x - B.x, A.y + B.y};
        K0g[p] = (f32x2){(A.x + B.x) * h0, (A.y - B.y) * h0};
        K1g[p] = (f32x2){dd.y * h1, -dd.x * h1};
    }
    LDS_BARRIER();
}
__device__ __forceinline__ void fft_pointwise(LAS f32x2* X, const f32x2* Kg, int tid) {
#pragma unroll 8
    for (int i = 0; i < 32; ++i) { const int p = tid + NTHREADS * i; X[p] = cmulf(X[p], Kg[p]); }
    LDS_BARRIER();
}
__device__ __forceinline__ void hyena_fft_phase(Frame& F) {
    float* GT = WSP(float, WS_GT); const float* kT = WSP(float, WS_KT); const float* invn = WSP(float, WS_INVN); const f32x2* tw = WSP(f32x2, WS_TW);
    f32x2* K0g = WSP(f32x2, WS_FFTW) + (size_t)F.bid * 16384; f32x2* K1g = WSP(f32x2, WS_Y) + (size_t)F.bid * 16384;
    const float* hyb = INP(25);
    LAS f32x2* X = (LAS f32x2*)F.lds;
    const int tid = F.tid;
    for (int ch = F.bid; ch < 1024; ch += F.G) {
        { const float* f0 = kT + (size_t)ch * SEQ; const float* b0 = kT + (size_t)(1024 + ch) * SEQ; const float* f1 = kT + (size_t)(2048 + ch) * SEQ; const float* b1 = kT + (size_t)(3072 + ch) * SEQ;
          for (int n = tid; n < SEQ; n += NTHREADS) { X[n] = (f32x2){f0[n], f1[n]}; X[SEQ + n] = (n == 0) ? (f32x2){0.f, 0.f} : (f32x2){b0[SEQ - n], b1[SEQ - n]}; } }
        const float* v0 = GT + ((size_t)ch * 2) * SEQ; float* yo = WSP(float, WS_YHT) + ((size_t)ch * 2) * SEQ;
        const float* x1 = GT + ((size_t)(1024 + ch) * 2) * SEQ; const float* x2 = GT + ((size_t)(2048 + ch) * 2) * SEQ;
        float z0[16], z1[16];
#pragma unroll
        for (int j = 0; j < 16; ++j) { const int n = tid + NTHREADS * j; z0[j] = v0[n]; z1[j] = v0[SEQ + n]; }
        LDS_BARRIER();
        fft_fwd<false>(X, tw, tid);
        fft_untangle(X, K0g, K1g, invn[ch] * (1.0f / 16384.0f), invn[1024 + ch] * (1.0f / 16384.0f), tid);
#pragma unroll
        for (int o = 0; o < 2; ++o) {
            const float* xg = (o == 0) ? x1 : x2;
            float g0[16], g1[16];
#pragma unroll
            for (int j = 0; j < 16; ++j) { const int n = tid + NTHREADS * j; g0[j] = xg[n]; g1[j] = xg[SEQ + n]; }
#pragma unroll
            for (int j = 0; j < 16; ++j) { const int n = tid + NTHREADS * j; X[n] = (f32x2){z0[j], z1[j]}; }
            LDS_BARRIER();
            fft_fwd<true>(X, tw, tid);
            fft_pointwise(X, o == 0 ? K0g : K1g, tid);
            fft_inv(X, tw, tid);
            const float bias = hyb[o * 1024 + ch];
#pragma unroll
            for (int j = 0; j < 16; ++j) { const int n = tid + NTHREADS * j; const f32x2 y = X[n]; z0[j] = g0[j] * (y.x + bias * z0[j]); z1[j] = g1[j] * (y.y + bias * z1[j]); }
            LDS_BARRIER();
        }
#pragma unroll
        for (int j = 0; j < 16; ++j) { const int n = tid + NTHREADS * j; yo[n] = z0[j]; yo[SEQ + n] = z1[j]; }
    }
}
__device__ __forceinline__ void hyena_out_transpose(Frame& F) {
    const float* GT = WSP(float, WS_YHT); bf16* cat = WSP(bf16, WS_CAT);
    LAS float* scr = (LAS float*)(F.lds + F.wave * 17408);
    const int lane = F.lane;
    for (int it = F.gw; it < 2 * 128 * 16; it += F.NGW) {
        const int cbk = it & 15, tb = (it >> 4) & 127, b = it >> 11, t0 = tb * 64;
        for (int c = 0; c < 64; ++c) scr[c * 65 + lane] = GT[((size_t)(cbk * 64 + c) * 2 + b) * SEQ + t0 + lane];
        LDS_WAIT(); asm volatile("" ::: "memory");
#pragma unroll
        for (int i = 0; i < 8; ++i) { const int tt = 8 * i + (lane >> 3), c0 = (lane & 7) * 8; const LAS float* s = scr + c0 * 65 + tt;
            v4u o; o.x = cvt_pk_bf16(s[0], s[65]); o.y = cvt_pk_bf16(s[130], s[195]); o.z = cvt_pk_bf16(s[260], s[325]); o.w = cvt_pk_bf16(s[390], s[455]);
            *(v4u*)(cat + ((size_t)b * SEQ + t0 + tt) * 2048 + cbk * 64 + c0) = o; }
        LDS_WAIT(); asm volatile("" ::: "memory");
    }
}

__device__ __forceinline__ int s5_row(int di, int b, int s) {
    return (s < CTX) ? TL + b * CTX + (di == 0 ? s : CTX - 1 - s) : b * SEQ + (di == 0 ? s - CTX : SEQ - 1 - (s - CTX));
}
typedef float f32x4_t __attribute__((ext_vector_type(4)));
#define S5_KEEP8(acc, f) asm volatile("" : "+v"(acc) : "v"(f[0]), "v"(f[1]), "v"(f[2]), "v"(f[3]), "v"(f[4]), "v"(f[5]), "v"(f[6]), "v"(f[7]))
#define S5_KEEP4(acc, f) asm volatile("" : "+v"(acc) : "v"(f[0]), "v"(f[1]), "v"(f[2]), "v"(f[3]))
template <bool OUTPUT>
__device__ __forceinline__ void s5_chunk_phase(Frame& F) {
    const bf16* PJ = WSP(bf16, WS_PROJ1); float* YD = WSP(float, WS_YD);
    const f32x2* l16t = WSP(f32x2, WS_S5L16); const f32x2* l256 = WSP(f32x2, WS_S5L256); f32x2* Eb = WSP(f32x2, WS_S5E);
    const bf16* W1 = WSP(bf16, WS_S5W1); const bf16* W3 = WSP(bf16, WS_S5W3); const bf16* KT = WSP(bf16, WS_S5KT);
    const int lane = F.lane, fr = lane & 15, fq = lane >> 4;
    LAS unsigned* Xl = (LAS unsigned*)(F.lds + F.wave * 4608);
    f32x2 carry[4];
#pragma unroll
    for (int t = 0; t < 4; ++t) carry[t] = (f32x2){0.f, 0.f};
#pragma nounroll
    for (int j = 0;; ++j) {
        const int tq = F.wave * F.G + F.bid + (j >> 2) * F.NGW, sub4 = j & 3;
        if (tq >= 256 * 8) break;
        const int task = tq * 4 + sub4;
        const int dbg = task >> 5, seg = (task & 31) + (OUTPUT ? 1 : 0);
        const int di = dbg >> 7, b = (dbg >> 6) & 1, g = dbg & 63;
        const int dg = di * 64 + g;
        const int s0 = seg * 256;
        bf16x8 afr[8];
#pragma unroll
        for (int ks = 0; ks < 8; ++ks) afr[ks] = *(const bf16x8*)(PJ + (size_t)s5_row(di, b, s0 + 16 * fr + 2 * ks + (fq >> 1)) * 4096 + 3072 + g * 16 + 8 * (fq & 1));
        f32x4 ea[8];
        { const bf16* w1p = W1 + ((size_t)dg * 128 + fr) * 256 + 8 * fq;
#pragma unroll
          for (int nt = 0; nt < 8; ++nt) { f32x4 a = {0.f, 0.f, 0.f, 0.f}; bf16x8 bw[8];
#pragma unroll
              for (int ks = 0; ks < 8; ++ks) bw[ks] = *(const bf16x8*)(w1p + (size_t)nt * 16 * 256 + 32 * ks);
#pragma unroll
              for (int ks = 0; ks < 8; ++ks) a = __builtin_amdgcn_mfma_f32_16x16x32_bf16(afr[ks], bw[ks], a, 0, 0, 0);
              S5_KEEP8(a, bw); S5_KEEP8(a, afr);
              ea[nt] = a; } }
        f32x2 st[4];
#pragma unroll
        for (int t = 0; t < 4; ++t) st[t] = (f32x2){0.f, 0.f};
        if (OUTPUT) {
#pragma unroll
            for (int t = 0; t < 4; ++t) { const f32x2 lq = l256[dg * 64 + 16 * t + fr]; const f32x2* ep = Eb + ((size_t)dbg * 32) * 64 + 16 * t + fr;
                if (sub4 == 0) {
                    int k = 0;
                    for (; k + 8 <= seg; k += 8) { f32x2 e8[8];
#pragma unroll
                        for (int j = 0; j < 8; ++j) e8[j] = ep[(size_t)(k + j) * 64];
#pragma unroll
                        for (int j = 0; j < 8; ++j) st[t] = cmulf(lq, st[t]) + e8[j]; }
                    for (; k < seg; ++k) st[t] = cmulf(lq, st[t]) + ep[(size_t)k * 64];
                } else st[t] = cmulf(lq, carry[t]) + ep[(size_t)(seg - 1) * 64];
                carry[t] = st[t]; }
        }
#pragma unroll
        for (int t = 0; t < 4; ++t) {
            const f32x2 L1 = l16t[dg * 64 + 16 * t + fr], L2 = cmulf(L1, L1), L3 = cmulf(L2, L1), L4 = cmulf(L2, L2);
            const f32x2 x0 = {ea[t][0], ea[4 + t][0]}, x1 = cmulf(L1, x0) + (f32x2){ea[t][1], ea[4 + t][1]}, x2 = cmulf(L1, x1) + (f32x2){ea[t][2], ea[4 + t][2]}, x3 = cmulf(L1, x2) + (f32x2){ea[t][3], ea[4 + t][3]};
            f32x2 sin = st[t];
            f32x2 fin = x3 + cmulf(L4, (fq == 0) ? sin : (f32x2){0.f, 0.f});
#pragma unroll
            for (int rd = 1; rd < 4; ++rd) { const float vr = __shfl(fin.x, lane - 16), vi = __shfl(fin.y, lane - 16);
                if (fq == rd) { sin = (f32x2){vr, vi}; fin = x3 + cmulf(L4, sin); } }
            if (OUTPUT) {
                const f32x2 h1 = x0 + cmulf(L1, sin), h2 = x1 + cmulf(L2, sin), h3 = x2 + cmulf(L3, sin);
                Xl[(4 * fq + 0) * 68 + 16 * t + fr] = cvt_pk_bf16(sin.x, sin.y); Xl[(4 * fq + 1) * 68 + 16 * t + fr] = cvt_pk_bf16(h1.x, h1.y);
                Xl[(4 * fq + 2) * 68 + 16 * t + fr] = cvt_pk_bf16(h2.x, h2.y); Xl[(4 * fq + 3) * 68 + 16 * t + fr] = cvt_pk_bf16(h3.x, h3.y);
            } else {
                st[t] = (f32x2){__shfl(fin.x, 48 + fr), __shfl(fin.y, 48 + fr)};
            }
        }
        if (!OUTPUT) {
            if (fq == 0) {
#pragma unroll
                for (int t = 0; t < 4; ++t) Eb[((size_t)dbg * 32 + seg) * 64 + 16 * t + fr] = st[t];
            }
        } else {
            LDS_WAIT(); asm volatile("" ::: "memory");
            bf16x8 hfr[4];
#pragma unroll
            for (int ks = 0; ks < 4; ++ks) hfr[ks] = *(const LAS bf16x8*)(Xl + fr * 68 + 16 * ks + 4 * fq);
            LDS_WAIT(); asm volatile("" ::: "memory");
            const bf16* w3p = W3 + ((size_t)dg * 256 + fr) * 128 + 8 * fq;
            const bf16* ktp = KT + (size_t)dg * 17 * 256 + fr * 16 + 8 * (fq & 1);
#pragma unroll
            for (int tau = 0; tau < 16; ++tau) {
                f32x4 y = {0.f, 0.f, 0.f, 0.f}; bf16x8 b3[4], bk[8];
#pragma unroll
                for (int ks = 0; ks < 4; ++ks) b3[ks] = *(const bf16x8*)(w3p + (size_t)tau * 16 * 128 + 32 * ks);
#pragma unroll
                for (int ks = 0; ks < 8; ++ks) { const int d1 = (ks <= tau / 2) ? tau - 2 * ks - (fq >> 1) + 1 : 0;
                    bk[ks] = *(const bf16x8*)(ktp + (size_t)d1 * 256); }
#pragma unroll
                for (int ks = 0; ks < 4; ++ks) y = __builtin_amdgcn_mfma_f32_16x16x32_bf16(hfr[ks], b3[ks], y, 0, 0, 0);
#pragma unroll
                for (int ks = 0; ks <= tau / 2; ++ks) y = __builtin_amdgcn_mfma_f32_16x16x32_bf16(afr[ks], bk[ks], y, 0, 0, 0);
                S5_KEEP4(y, b3); S5_KEEP8(y, bk); S5_KEEP8(y, afr); S5_KEEP4(y, hfr);
#pragma unroll
                for (int r = 0; r < 4; ++r) { const int s = s0 + 16 * (4 * fq + r) + tau, tl = (di == 0) ? s - CTX : SEQ - 1 - (s - CTX);
                    YD[(((size_t)(di * 2 + b) * 64 + g) * SEQ + tl) * 16 + fr] = y[r]; }
            }
        }
    }
}


constexpr int NPHASES = 21;
#ifndef MK_SINGLE
#define MK_SINGLE 1
#endif

__device__ __forceinline__ unsigned long long launder_u64(unsigned long long v) {
    unsigned lo = (unsigned)v, hi = (unsigned)(v >> 32);
    asm volatile("" : "+v"(lo), "+v"(hi));
    lo = __builtin_amdgcn_readfirstlane(lo); hi = __builtin_amdgcn_readfirstlane(hi);
    return ((unsigned long long)hi << 32) | lo;
}
__device__ __forceinline__ const void* launder_ptr(const void* p) {
    unsigned long long v = (unsigned long long)p; unsigned lo = (unsigned)v, hi = (unsigned)(v >> 32);
    asm volatile("" : "+v"(lo), "+v"(hi));
    lo = __builtin_amdgcn_readfirstlane(lo); hi = __builtin_amdgcn_readfirstlane(hi);
    return (const void*)(((unsigned long long)hi << 32) | lo);
}
__device__ __forceinline__ void moe_blocks(Frame& F, int l, LAS int* bstart) {
    __syncthreads();
    if (F.tid < 64) {
        const int e = F.tid; const unsigned* cnt = WSP(unsigned, WS_CTL) + CW_CNT + l * 64 * CSTR;
        const int nb = ((int)cnt[e * CSTR] + 255) >> 8; int incl = nb;
#pragma unroll
        for (int o = 1; o < 64; o <<= 1) { const int v = __shfl_up(incl, o); if (e >= o) incl += v; }
        const int excl = incl - nb;
        bstart[e] = excl;
        for (int j = 0; j < nb; ++j) bstart[65 + excl + j] = e;
        if (e == 63) bstart[64] = incl;
    }
    __syncthreads();
}

template <int PHSEL>
__global__ void __launch_bounds__(NTHREADS, 2) mk_fwd(Args args) {
    extern __shared__ __attribute__((aligned(16))) unsigned char lds_raw[];
    Frame F;
    F.lds = (LAS unsigned char*)lds_raw; F.ws = (GAS unsigned char*)args.ws; F.kin = (const __attribute__((address_space(4))) unsigned long long*)__builtin_amdgcn_kernarg_segment_ptr();
    F.tid = threadIdx.x; F.lane = F.tid & 63; F.wave = __builtin_amdgcn_readfirstlane(F.tid >> 6); F.bid = blockIdx.x; F.G = gridDim.x;
    F.gw = F.bid * NWAVES + F.wave; F.NGW = F.G * NWAVES;
    volatile LAS unsigned* lctl = (volatile LAS unsigned*)(F.lds + LDS_CTL);
    LAS int* bstart = (LAS int*)(F.lds + LDS_CTL + 64);
    if (F.tid < 4) lctl[F.tid] = 0u;
    __syncthreads();
    const int lo = args.ph_lo, hi = args.ph_hi;
    XcdBarrier bar; bar.bar = WSP(unsigned, WS_CTL) + CW_BAR; bar.x = 0; bar.st = lctl;
    if (PHSEL < 0) bar = xcd_barrier_post(WSP(unsigned, WS_CTL) + CW_BAR, lctl);
#ifndef PH_MASK
#define PH_MASK 0xffffffffu
#endif
#define IN(k) (((PH_MASK >> (k)) & 1u) && (PHSEL < 0 || PHSEL == (k)))
#define INL(j) (((PH_MASK >> (6 + (j))) & 1u) && (PHSEL < 0 || (PHSEL == 6 + (j) && lo == pb + (j))))
#define PH_END(k) do { if (PHSEL < 0) xcd_barrier(bar); } while (0)
#ifndef PH_REPEAT
#define PH_REPEAT 0u
#endif
#define REP(k) for (int _rep = 0; _rep < (((PH_REPEAT >> (k)) & 1u) ? 2 : 1); ++_rep)
#define DUP(k) (((PH_REPEAT >> (k)) & 1u) != 0u)
#define PH_BEGIN() do { F.ws = (GAS unsigned char*)launder_u64((unsigned long long)F.ws); F.kin = (const __attribute__((address_space(4))) unsigned long long*)launder_u64((unsigned long long)F.kin); \
    { int _t = threadIdx.x; asm volatile("" : "+v"(_t)); F.tid = _t; F.lane = _t & 63; F.wave = __builtin_amdgcn_readfirstlane(_t >> 6); \
      int _b = blockIdx.x; asm volatile("" : "+v"(_b)); F.bid = __builtin_amdgcn_readfirstlane(_b); F.gw = F.bid * NWAVES + F.wave; } } while (0)
    LAS unsigned char* lds = F.lds;
    const int G = F.G, bid = F.bid;
    const int vcu = (G % 8 == 0) ? (bid % 8) * (G / 8) + bid / 8 : bid;
    constexpr long T2048 = 256L * 2048 * 2;

    if (IN(0)) { PH_BEGIN(); REP(0) { p0_prologue(F); __syncthreads(); } PH_END(0); }
    if (IN(1)) { PH_BEGIN(); p1_reduce(F); PH_END(1); }
#ifdef EXTRA_BARS
    xcd_barrier(bar); xcd_barrier(bar); xcd_barrier(bar); xcd_barrier(bar); xcd_barrier(bar); xcd_barrier(bar); xcd_barrier(bar); xcd_barrier(bar); xcd_barrier(bar); xcd_barrier(bar);
#endif
        if (IN(2)) { PH_BEGIN(); REP(2) norm_phase<0>(F, 0, nullptr); PH_END(2); }
        if (IN(3)) { PH_BEGIN();
#define BODY3 { pg8::Gemm g{(const bf16*)F.ws, (const bf16*)F.ws, 2048, 2048, 2048}; InProj0Order S; S.G = G; S.c = bid; \
              S.offA1 = (long)WS_HA; S.offB1 = (long)WS_WIN0; S.offA2 = (long)(WS_WIN0 + (size_t)3072 * 2048 * 2); S.offB2 = (long)WS_HA; \
              EpiInProj0 E{EpiQKP{WSP(bf16, WS_Q), WSP(bf16, WS_K), WSP(bf16, WS_P), WSP(f32x2, WS_ROPE)}, EpiVT{WSP(bf16, WS_VT)}}; pg8::gemm_phase<EpiInProj0, InProj0Order, false>(lds, g, S, E); }
            BODY3
            if constexpr (DUP(3)) { BODY3 }
#undef BODY3
            PH_END(3);
        }
        if (IN(4)) { PH_BEGIN();
            REP(4) attn_phase(F, (bid >> 3) % 5);
            __syncthreads(); REP(21) poold_phase(F); PH_END(4); }
        if (IN(5)) { PH_BEGIN();
            pg8::Gemm g{WSP(bf16, WS_PD), WSP(bf16, WS_WPOOL), 1024, 256, 256}; pg8::StaticOrder S; S.init(TT / 256, 4, G, bid, 256L * 1024 * 2, 256L * 2, 256L * 256 * 2);
            EpiScaleBf16 E{WSP(bf16, WS_CAT), 2048, 1024, INP(14)}; pg8::gemm_phase<EpiScaleBf16, pg8::StaticOrder, false>(lds, g, S, E);
            PH_END(5);
        }
    {
    constexpr int pb = 6; constexpr int l = 0;
    if (INL(0)) { PH_BEGIN();
        float* xbuf = WSP(float, WS_X);
        pg8::Gemm g{WSP(bf16, WS_CAT), WSP(bf16, l == 0 ? WS_WOUT0 : WS_WOUT1), 2048, 2048, 2048}; pg8::StaticOrder S; S.init(l == 0 ? TT / 256 : TL / 256, 8, G, bid, T2048, 0, T2048);
        EpiRes E{l == 0 ? INP(0) : xbuf, l == 0 ? INP(2) : xbuf + (size_t)TL * 2048, xbuf, modp(F, l, 0, 2)}; pg8::gemm_phase<EpiRes, pg8::StaticOrder, false>(lds, g, S, E);
        PH_END(pb);
    }
    if (INL(1)) { PH_BEGIN(); ffn_norm_router_phase(F, l); PH_END(pb + 1); }
    if (INL(2)) { PH_BEGIN(); REP(8) {
        moe_blocks(F, l, bstart);
        pg8::Gemm g{WSP(bf16, WS_HA), (const bf16*)(F.ws + WS_WMOE + (size_t)l * MOE_L_BYTES), 2048, 2048, 2048};
        MoeOrder S{bstart, WSP(unsigned, WS_CTL) + CW_CNT + l * 64 * CSTR, WSP(int, WS_TOKL), 4, G, vcu, bstart[64], T2048, 0, true};
        EpiMoeUp E{WSP(bf16, WS_H)}; pg8::gemm_phase<EpiMoeUp, MoeOrder, true>(lds, g, S, E); }
        PH_END(pb + 2);
    }
    if (INL(3)) { PH_BEGIN(); REP(9) {
        moe_blocks(F, l, bstart);
        pg8::Gemm g{WSP(bf16, WS_H), (const bf16*)(F.ws + WS_WMOE + (size_t)l * MOE_L_BYTES), 512, 512, 512};
        MoeOrder S{bstart, WSP(unsigned, WS_CTL) + CW_CNT + l * 64 * CSTR, WSP(int, WS_TOKL), 8, G, vcu, bstart[64], 256L * 512 * 2, (long)(4 * MiB), false};
        EpiMoeDown E{WSP(bf16, WS_Y), WSP(int, WS_TOKL), WSP(float, WS_GATEL), WSP(unsigned, WS_CTL) + CW_CNT + l * 64 * CSTR}; pg8::gemm_phase<EpiMoeDown, MoeOrder, false>(lds, g, S, E); }
        PH_END(pb + 3);
    }
    }
        if (IN(10)) { PH_BEGIN(); norm_phase<2>(F, 1, nullptr); PH_END(10); }
        if (IN(11)) { PH_BEGIN();
#define BODY11             pg8::Gemm g{WSP(bf16, WS_HA), WSP(bf16, WS_WIN1), 2048, 2048, 2048}; pg8::StaticOrder S; S.init(TT / 256, 16, G, bid, T2048, 0, T2048); \
            EpiBf16 E{WSP(bf16, WS_PROJ1), 4096}; pg8::gemm_phase<EpiBf16, pg8::StaticOrder, false>(lds, g, S, E);
            BODY11
            if constexpr (DUP(11)) { BODY11 }
#undef BODY11
            PH_END(11);
        }
        if (IN(12)) { PH_BEGIN(); REP(12) shortconv_phase(F); REP(22) s5_chunk_phase<false>(F);
 PH_END(12); }
        if (IN(13)) { PH_BEGIN();
            REP(23) s5_chunk_phase<true>(F); __syncthreads(); REP(13) hyena_fft_phase(F); PH_END(13); }
        if (IN(14)) { PH_BEGIN();
 REP(14) { s5_gelu_phase(F); hyena_out_transpose(F); } PH_END(14); }
        if (IN(15)) { PH_BEGIN();
            pg8::Gemm g{WSP(bf16, WS_PD), WSP(bf16, WS_WGLU), 1024, 1024, 1024}; pg8::StaticOrder S; S.init(TL / 256, 4, G, bid, 256L * 1024 * 2, 0, 256L * 1024 * 2);
            EpiGlu E{WSP(bf16, WS_CAT), 2048, 1024, WSP(bf16, WS_PD), INP(35)}; pg8::gemm_phase<EpiGlu, pg8::StaticOrder, false>(lds, g, S, E);
            PH_END(15);
        }
    {
    constexpr int pb = 16; constexpr int l = 1;
    if (INL(0)) { PH_BEGIN();
        float* xbuf = WSP(float, WS_X);
        pg8::Gemm g{WSP(bf16, WS_CAT), WSP(bf16, l == 0 ? WS_WOUT0 : WS_WOUT1), 2048, 2048, 2048}; pg8::StaticOrder S; S.init(l == 0 ? TT / 256 : TL / 256, 8, G, bid, T2048, 0, T2048);
        EpiRes E{l == 0 ? INP(0) : xbuf, l == 0 ? INP(2) : xbuf + (size_t)TL * 2048, xbuf, modp(F, l, 0, 2)}; pg8::gemm_phase<EpiRes, pg8::StaticOrder, false>(lds, g, S, E);
        PH_END(pb);
    }
    if (INL(1)) { PH_BEGIN(); ffn_norm_router_phase(F, l); PH_END(pb + 1); }
    if (INL(2)) { PH_BEGIN(); REP(8) {
        moe_blocks(F, l, bstart);
        pg8::Gemm g{WSP(bf16, WS_HA), (const bf16*)(F.ws + WS_WMOE + (size_t)l * MOE_L_BYTES), 2048, 2048, 2048};
        MoeOrder S{bstart, WSP(unsigned, WS_CTL) + CW_CNT + l * 64 * CSTR, WSP(int, WS_TOKL), 4, G, vcu, bstart[64], T2048, 0, true};
        EpiMoeUp E{WSP(bf16, WS_H)}; pg8::gemm_phase<EpiMoeUp, MoeOrder, true>(lds, g, S, E); }
        PH_END(pb + 2);
    }
    if (INL(3)) { PH_BEGIN(); REP(9) {
        moe_blocks(F, l, bstart);
        pg8::Gemm g{WSP(bf16, WS_H), (const bf16*)(F.ws + WS_WMOE + (size_t)l * MOE_L_BYTES), 512, 512, 512};
        MoeOrder S{bstart, WSP(unsigned, WS_CTL) + CW_CNT + l * 64 * CSTR, WSP(int, WS_TOKL), 8, G, vcu, bstart[64], 256L * 512 * 2, (long)(4 * MiB), false};
        EpiMoeDown E{WSP(bf16, WS_Y), WSP(int, WS_TOKL), WSP(float, WS_GATEL), WSP(unsigned, WS_CTL) + CW_CNT + l * 64 * CSTR}; pg8::gemm_phase<EpiMoeDown, MoeOrder, false>(lds, g, S, E); }
        PH_END(pb + 3);
    }
    }
    if (IN(20)) { PH_BEGIN(); norm_phase<3>(F, 1, args.out);
    }
#undef IN
#undef INL
#undef PH_END
}

typedef void (*kern_t)(Args);
template <int P> static void launch_phase(int grid, hipStream_t stream, Args a) { hipLaunchKernelGGL(mk_fwd<P>, dim3(grid), dim3(NTHREADS), LDS_BYTES, stream, a); }
template <int P> static bool prep_phase() { return hipFuncSetAttribute((const void*)mk_fwd<P>, hipFuncAttributeMaxDynamicSharedMemorySize, LDS_BYTES) == hipSuccess; }
extern "C" void kernel_launch(void* const* d_in, const int* in_sizes, int n_in, void* d_out, int out_size, void* d_ws, size_t ws_size, hipStream_t stream) {
    static int grid = 0;
    if (grid == 0) {
        if (n_in != 43 || out_size != TL * DM || ws_size < WS_END) { fprintf(stderr, "kernel_launch: unexpected shapes (n_in %d, out %d, ws %zu < %zu)\n", n_in, out_size, ws_size, (size_t)WS_END); grid = -1; return; }
        int dev = 0, cus = 0;
        if (hipGetDevice(&dev) != hipSuccess || hipDeviceGetAttribute(&cus, hipDeviceAttributeMultiprocessorCount, dev) != hipSuccess) { grid = -1; return; }
        bool ok = true;
#if MK_SINGLE
        ok = prep_phase<-1>();
#else
        ok = prep_phase<0>() && prep_phase<1>() && prep_phase<2>() && prep_phase<3>() && prep_phase<4>() && prep_phase<5>() && prep_phase<6>() && prep_phase<7>() && prep_phase<8>() && prep_phase<9>() &&
             prep_phase<10>() && prep_phase<11>() && prep_phase<12>() && prep_phase<13>() && prep_phase<14>() && prep_phase<15>() && prep_phase<20>();
#endif
        if (!ok) { fprintf(stderr, "kernel_launch: hipFuncSetAttribute failed\n"); grid = -1; return; }
        (void)hipGetLastError();
        grid = cus;
    }
    if (grid < 0) return;
    (void)hipMemsetAsync((char*)d_ws + WS_CTL, 0, CTL_BYTES, stream);
    Args a{};
    for (int i = 0; i < 43; ++i) a.in[i] = (const float*)d_in[i];
    a.out = (float*)d_out; a.ws = (unsigned char*)d_ws;
#if MK_SINGLE
    a.ph_lo = 0; a.ph_hi = NPHASES;
    launch_phase<-1>(grid, stream, a);
#else
#ifndef MK_DUP
#define MK_DUP -1
#endif
#define LP(k, P) a.ph_lo = (k); a.ph_hi = (k) + 1; launch_phase<P>(grid, stream, a); \
    if (MK_DUP == (k)) { if (P == 7) (void)hipMemsetAsync((char*)d_ws + WS_CTL + (size_t)(CW_CNT + ((k) > 10 ? 64 * CSTR : 0)) * 4, 0, 256 * CSTR, stream); launch_phase<P>(grid, stream, a); }
    LP(0, 0) LP(1, 1) LP(2, 2) LP(3, 3) LP(4, 4) LP(5, 5) LP(6, 6) LP(7, 7) LP(8, 8) LP(9, 9) LP(10, 10) LP(11, 11) LP(12, 12) LP(13, 13) LP(14, 14) LP(15, 15)
    LP(16, 6) LP(17, 7) LP(18, 8) LP(19, 9) LP(20, 20)
#undef LP
#endif
}
```

```cpp
#include <hip/hip_runtime.h>
#include <cstdio>
#include <cstdint>
#include <cmath>

#define GAS __attribute__((address_space(1)))
#define LAS __attribute__((address_space(3)))
typedef unsigned short bf16;
typedef unsigned v4u __attribute__((ext_vector_type(4)));
typedef unsigned v2u __attribute__((ext_vector_type(2)));
typedef float f32x4 __attribute__((ext_vector_type(4)));
typedef float f32x2 __attribute__((ext_vector_type(2)));
typedef float f32x16 __attribute__((ext_vector_type(16)));
typedef short bf16x8 __attribute__((ext_vector_type(8)));
#define LDS_WAIT() asm volatile("s_waitcnt lgkmcnt(0)" ::: "memory")
#define VM_WAIT() asm volatile("s_waitcnt vmcnt(0)" ::: "memory")

__device__ __forceinline__ unsigned f2bf(float f) { unsigned u = __builtin_bit_cast(unsigned, f); return (u + 0x7fffu + ((u >> 16) & 1u)) >> 16; }
__device__ __forceinline__ unsigned pk2(float lo, float hi) { return f2bf(lo) | (f2bf(hi) << 16); }
__device__ __forceinline__ unsigned cvt_pk_bf16(float lo, float hi) { unsigned r; asm volatile("v_cvt_pk_bf16_f32 %0, %1, %2" : "=v"(r) : "v"(lo), "v"(hi)); return r; }
__device__ __forceinline__ float bf2f(unsigned short b) { return __builtin_bit_cast(float, (unsigned)b << 16); }
__device__ __forceinline__ float bflo(unsigned w) { return __builtin_bit_cast(float, w << 16); }
__device__ __forceinline__ float bfhi(unsigned w) { return __builtin_bit_cast(float, w & 0xffff0000u); }
__device__ __forceinline__ float wave_sum(float v) {
#pragma unroll
    for (int o = 1; o < 64; o <<= 1) v += __shfl_xor(v, o);
    return v;
}

namespace pg8 {
typedef unsigned short bf16_t;
constexpr int BM = 256, BK = 64, HALF = 128, HTB = HALF * BK * 2, STAGE_BYTES = 8 * HTB;

__host__ __device__ __forceinline__ int lds_byte(int r, int c) { const int st = (r >> 4) * 2 + (c >> 5), rr = r & 15, cc = c & 31, ob = rr * 64 + cc * 2; return st * 1024 + (ob ^ (((ob >> 9) & 1) << 5)); }
__host__ __device__ __forceinline__ int perm32(int rho) { const int n = rho >> 4, i = rho & 15; return 8 * (i >> 2) + 4 * n + (i & 3); }
__host__ __device__ __forceinline__ void stage_rc(int b, int& R, int& C) { const int st = b / 1024, sb = b % 1024, swz = sb ^ (((sb >> 9) & 1) << 5); R = (st >> 1) * 16 + swz / 64; C = (st & 1) * 32 + (swz % 64) / 2; }

struct Unit { int pm, pn; long aoff, boff; int e, idx0; };
struct Gemm { const bf16_t* A; const bf16_t* Bt; int lda, ldb, K; };

template <class Epi, class Sched, bool GATHER>
__device__ __forceinline__ void gemm_phase(LAS unsigned char* lds, const Gemm g, const Sched& S, const Epi& E) {
    int tid_ = threadIdx.x; asm volatile("" : "+v"(tid_));
    const int tid = tid_, wid = __builtin_amdgcn_readfirstlane(tid >> 6), lane = tid & 63, wr = wid >> 2, wc = wid & 3, fr = lane & 15, fq = lane >> 4;
    const int K = g.K, nt = K / BK;
    unsigned voffA[2], voffB[2];
#pragma unroll
    for (int i = 0; i < 2; ++i) { int R, C; stage_rc(tid * 16 + i * 8192, R, C);
        const int Rb = Epi::PERM ? ((R & ~31) + perm32(R & 31)) : R;
        voffA[i] = (unsigned)(R * g.lda + C) * 2u; voffB[i] = (unsigned)(Rb * g.ldb + C) * 2u; }
    const size_t kstep = (size_t)(BK * 2);
    const size_t hstepA = GATHER ? 0 : (size_t)HALF * g.lda * 2, hstepB = (size_t)HALF * g.ldb * 2;
    const unsigned ldsw = (unsigned)wid * 1024u;
    const int aoff = lds_byte(wr * 64 + fr, fq * 8), boff = lds_byte(wc * 32 + fr, fq * 8);
#define PG8_SA(b, h) (((b) * 2 + (h)) * HTB)
#define PG8_SB(b, h) ((4 + (b) * 2 + (h)) * HTB)
#define PG8_STAGE(bufoff, gbase, voff) do { _Pragma("unroll") for (int _i = 0; _i < 2; ++_i) \
        __builtin_amdgcn_global_load_lds((const unsigned*)((const char*)(gbase) + (voff)[_i]), (LAS unsigned*)(lds + (bufoff) + ldsw + _i * 8192), 16, 0, 0); } while (0)
#define PG8_STAGE_A(bufoff, gbase, h, nx) do { if constexpr (GATHER) { unsigned _tv[2]; \
        if (nx) { int _tz = tid; asm volatile("" : "+v"(_tz)); _Pragma("unroll") for (int _j = 0; _j < 2; ++_j) { int _R, _C; stage_rc(_tz * 16 + _j * 8192, _R, _C); _tv[_j] = (unsigned)S.arow(nxt, (h) * HALF + _R) * (unsigned)(g.lda * 2) + (unsigned)(_C * 2); } } \
        else { _tv[0] = gvc[h][0]; _tv[1] = gvc[h][1]; } \
        PG8_STAGE(bufoff, gbase, _tv); } else { PG8_STAGE(bufoff, (gbase) + (h) * hstepA, voffA); } } while (0)
#define PG8_LDA(dst, b, h) do { _Pragma("unroll") for (int m = 0; m < 4; ++m) _Pragma("unroll") for (int k = 0; k < 2; ++k) dst[m][k] = *(const LAS bf16x8*)(lds + PG8_SA(b, h) + aoff + m * 2048 + k * 1024); } while (0)
#define PG8_LDB(dst, b, h) do { _Pragma("unroll") for (int n = 0; n < 2; ++n) _Pragma("unroll") for (int k = 0; k < 2; ++k) dst[n][k] = *(const LAS bf16x8*)(lds + PG8_SB(b, h) + boff + n * 2048 + k * 1024); } while (0)
#define PG8_MMA(ai, bj, At, Bt) do { __builtin_amdgcn_s_setprio(1); _Pragma("unroll") for (int m = 0; m < 4; ++m) _Pragma("unroll") for (int n = 0; n < 2; ++n) _Pragma("unroll") for (int k = 0; k < 2; ++k) \
        acc[ai][bj][m][n] = __builtin_amdgcn_mfma_f32_16x16x32_bf16(Bt[n][k], At[m][k], acc[ai][bj][m][n], 0, 0, 0); __builtin_amdgcn_s_setprio(0); } while (0)
#define PG8_WAIT_V(n) asm volatile("s_waitcnt vmcnt(" #n ")" ::: "memory")
#define PG8_WAIT_L(n) asm volatile("s_waitcnt lgkmcnt(" #n ")" ::: "memory")
#define PG8_BAR __builtin_amdgcn_s_barrier()
#define PG8_SCHED __builtin_amdgcn_sched_barrier(0)
    Unit cur, nxt; int ui = 0;
    if (!S.next(0, cur)) return;
    unsigned gvc[2][2];
#define PG8_GV(unit) do { if constexpr (GATHER) { int _tz = tid; asm volatile("" : "+v"(_tz)); _Pragma("unroll") for (int _h = 0; _h < 2; ++_h) _Pragma("unroll") for (int _j = 0; _j < 2; ++_j) { int _R, _C; stage_rc(_tz * 16 + _j * 8192, _R, _C); \
        gvc[_h][_j] = (unsigned)S.arow(unit, _h * HALF + _R) * (unsigned)(g.lda * 2) + (unsigned)(_C * 2); } } } while (0)
    PG8_GV(cur);
    f32x4 acc[2][2][4][2];
#pragma unroll
    for (int a = 0; a < 2; ++a)
#pragma unroll
        for (int b = 0; b < 2; ++b)
#pragma unroll
            for (int m = 0; m < 4; ++m)
#pragma unroll
                for (int n = 0; n < 2; ++n) acc[a][b][m][n] = (f32x4){0.f, 0.f, 0.f, 0.f};
    bf16x8 At[4][2], B0[2][2], B1[2][2];
    const char* cA = (const char*)g.A + cur.aoff; const char* cB = (const char*)g.Bt + cur.boff;
    PG8_STAGE(PG8_SB(0, 0), cB, voffB); PG8_STAGE(PG8_SB(0, 1), cB + hstepB, voffB); PG8_STAGE_A(PG8_SA(0, 0), cA, 0, false); PG8_STAGE_A(PG8_SA(0, 1), cA, 1, false);
    if (wr == 1) PG8_BAR;
    PG8_WAIT_V(2); PG8_BAR;
    PG8_STAGE(PG8_SB(1, 0), cB + kstep, voffB); PG8_STAGE_A(PG8_SA(1, 0), cA + kstep, 0, false); PG8_STAGE(PG8_SB(1, 1), cB + hstepB + kstep, voffB);
    PG8_WAIT_V(6); PG8_BAR;
    for (;;) {
        const bool has_next = S.next(ui + 1, nxt);
        const char* nA = has_next ? (const char*)g.A + nxt.aoff : cA; const char* nB = has_next ? (const char*)g.Bt + nxt.boff : cB;
#pragma nounroll
        for (int t = 0; t < nt; t += 2) {
            const bool last = (t == nt - 2);
            const char* a1 = cA + (size_t)(t + 1) * kstep;
            const char* a2 = last ? nA : cA + (size_t)(t + 2) * kstep; const char* b2 = last ? nB : cB + (size_t)(t + 2) * kstep;
            const char* a3 = a2 + kstep; const char* b3 = b2 + kstep;
            PG8_LDB(B0, 0, 0); PG8_LDB(B1, 0, 1); PG8_SCHED; PG8_LDA(At, 0, 0); PG8_STAGE_A(PG8_SA(1, 1), a1, 1, false);
            PG8_WAIT_V(8); PG8_WAIT_L(0); PG8_BAR; PG8_MMA(0, 0, At, B0); PG8_MMA(0, 1, At, B1); PG8_BAR; PG8_SCHED;
            PG8_LDA(At, 0, 1); PG8_STAGE(PG8_SB(0, 0), b2, voffB); PG8_STAGE(PG8_SB(0, 1), b2 + hstepB, voffB); PG8_STAGE_A(PG8_SA(0, 0), a2, 0, last);
            PG8_WAIT_V(8); PG8_WAIT_L(0); PG8_BAR; PG8_MMA(1, 0, At, B0); PG8_MMA(1, 1, At, B1); PG8_BAR; PG8_SCHED;
            PG8_LDB(B0, 1, 0); PG8_LDB(B1, 1, 1); PG8_SCHED; PG8_LDA(At, 1, 0); PG8_STAGE_A(PG8_SA(0, 1), a2, 1, last);
            PG8_WAIT_V(8); PG8_WAIT_L(0); PG8_BAR; PG8_MMA(0, 0, At, B0); PG8_MMA(0, 1, At, B1); PG8_BAR; PG8_SCHED;
            PG8_LDA(At, 1, 1); PG8_STAGE(PG8_SB(1, 0), b3, voffB); PG8_STAGE(PG8_SB(1, 1), b3 + hstepB, voffB); PG8_STAGE_A(PG8_SA(1, 0), a3, 0, last);
            PG8_WAIT_V(8); PG8_WAIT_L(0); PG8_BAR; PG8_MMA(1, 0, At, B0); PG8_MMA(1, 1, At, B1); PG8_BAR; PG8_SCHED;
        }
        if (wr == 0) PG8_BAR;
        E(acc, cur, wr, wc, fr, fq);
        if (!has_next) break;
#pragma unroll
        for (int a = 0; a < 2; ++a)
#pragma unroll
            for (int b = 0; b < 2; ++b)
#pragma unroll
                for (int m = 0; m < 4; ++m)
#pragma unroll
                    for (int n = 0; n < 2; ++n) acc[a][b][m][n] = (f32x4){0.f, 0.f, 0.f, 0.f};
        cur = nxt; cA = nA; cB = nB; ++ui;
        PG8_GV(cur);
        if (wr == 1) PG8_BAR;
    }
    PG8_WAIT_V(0);
    PG8_BAR;
#undef PG8_SA
#undef PG8_SB
#undef PG8_STAGE
#undef PG8_STAGE_A
#undef PG8_GV
#undef PG8_LDA
#undef PG8_LDB
#undef PG8_MMA
#undef PG8_WAIT_V
#undef PG8_WAIT_L
#undef PG8_BAR
#undef PG8_SCHED
}

struct StaticOrder {
    int nM, nN, nwg, G, c; long astride, apn, bstride;
    __device__ void init(int nM_, int nN_, int G_, int c_, long astride_, long apn_, long bstride_) { nM = nM_; nN = nN_; nwg = nM * nN; G = G_; c = c_; astride = astride_; apn = apn_; bstride = bstride_; }
    __device__ bool next(int i, Unit& u) const {
        const long Lx = (long)i * G + c; if (Lx >= nwg) return false;
        int wgid = (int)Lx; { const int q = nwg / 8, r = nwg % 8, xcd = wgid % 8, off = wgid / 8; wgid = (xcd < r ? xcd * (q + 1) : r * (q + 1) + (xcd - r) * q) + off; }
        const int nig = 8 * nN, gid = wgid / nig, fm = gid * 8, gsz = (nM - fm) < 8 ? (nM - fm) : 8;
        u.pm = fm + ((wgid % nig) % gsz); u.pn = (wgid % nig) / gsz; u.aoff = (long)u.pm * astride + (long)u.pn * apn; u.boff = (long)u.pn * bstride; u.e = 0; u.idx0 = 0; return true;
    }
    __device__ int arow(const Unit&, int) const { return 0; }
};
}

constexpr int DM = 2048, NBATCH = 2, SEQ = 8192, CTX = 256;
constexpr int TL = NBATCH * SEQ;
constexpr int TC = NBATCH * CTX;
constexpr int TT = TL + TC;
constexpr int KEYS = CTX + SEQ;
constexpr int NEXP = 64, DEXP = 512;
constexpr int LISTCAP = 2 * TT;
constexpr float EPS = 1e-6f;
constexpr float QSCALE = 0.125f * 1.4426950408889634f;
constexpr int NWAVES = 8, NTHREADS = 512;

constexpr size_t MiB = 1u << 20;
constexpr size_t WS_CTL = 0, CTL_BYTES = 64 * 1024;
constexpr size_t WS_WIN0 = 1 * MiB;
constexpr size_t WS_WOUT0 = WS_WIN0 + 16 * MiB;
constexpr size_t WS_WIN1 = WS_WOUT0 + 8 * MiB;
constexpr size_t WS_WOUT1 = WS_WIN1 + 16 * MiB;
constexpr size_t WS_WPOOL = WS_WOUT1 + 8 * MiB;
constexpr size_t WS_WGLU = WS_WPOOL + 1 * MiB;
constexpr size_t WS_WMOE = WS_WGLU + 2 * MiB;
constexpr size_t MOE_E_BYTES = 6 * MiB, MOE_L_BYTES = 64 * MOE_E_BYTES;
constexpr size_t WS_X = WS_WMOE + 2 * MOE_L_BYTES;
constexpr size_t WS_HA = WS_X + 132 * MiB;
constexpr size_t WS_Q = WS_HA + 67 * MiB;
constexpr size_t WS_K = WS_Q + 33 * MiB;
constexpr size_t WS_VT = WS_K + 33 * MiB;
constexpr size_t WS_P = WS_VT + 33 * MiB;
constexpr size_t WS_PROJ1 = WS_Q;
constexpr size_t WS_CAT = WS_P + 33 * MiB;
constexpr size_t WS_PD = WS_CAT + 66 * MiB;
constexpr size_t WS_H = WS_PD + 33 * MiB;
constexpr size_t WS_Y = WS_H + 49 * MiB;
constexpr size_t WS_GT = WS_Y + 132 * MiB;
constexpr size_t WS_KT = WS_GT + 192 * MiB;
constexpr size_t WS_YD = WS_KT + 128 * MiB;
constexpr size_t WS_MISC = WS_YD + 128 * MiB;
constexpr size_t WS_MOD = WS_MISC;
constexpr size_t WS_ADAP = WS_MOD + 1 * MiB;
constexpr size_t WS_ROPE = WS_ADAP + 10 * MiB;
constexpr size_t WS_NORMP = WS_ROPE + 1 * MiB;
constexpr size_t WS_INVN = WS_NORMP + 4 * MiB;
constexpr size_t WS_S5LAM = WS_INVN + 1 * MiB;
constexpr size_t WS_S5B = WS_S5LAM + 1 * MiB;
constexpr size_t WS_WRT = WS_S5B + 2 * MiB;
constexpr size_t WS_TOKL = WS_WRT + 2 * MiB;
constexpr size_t WS_GATEL = WS_TOKL + 9 * MiB;
constexpr size_t WS_TW = WS_GATEL + 9 * MiB;
constexpr size_t WS_FFTW = WS_TW + 1 * MiB;
constexpr size_t WS_S5L256 = WS_FFTW + 32 * MiB;
constexpr size_t WS_S5E = WS_S5L256 + 1 * MiB;
constexpr size_t WS_YHT = WS_S5E + 4 * MiB;
constexpr size_t WS_S5L16 = WS_YHT + 64 * MiB;
constexpr size_t WS_S5W1 = WS_S5L16 + 1 * MiB;
constexpr size_t WS_S5W3 = WS_S5W1 + 8 * MiB;
constexpr size_t WS_S5KT = WS_S5W3 + 8 * MiB;
constexpr size_t WS_END = WS_S5KT + 2 * MiB;
static_assert(WS_END <= 2040 * MiB, "d_ws map");
constexpr int CW_BAR = 1024;
constexpr int CW_CNT = 8192;
constexpr int CSTR = 32;

constexpr int LDS_PHASE = 131072;
constexpr int LDS_CTL = 147456 - 2048;
constexpr int LDS_BYTES = 147456;

#define XB_TMO      128
#define XB_XCNT(j)  (256  + 64 * (j))
#define XB_XSUB(j)  (1280 + 64 * (j))
#define XB_XGEN(j)  (2304 + 64 * (j))
#define XB_TOP      3328
#define XB_TOPGEN   3392
#define XCD_BAR_WORDS 3456
#define XB_SPIN_CAP (1u << 22)

__device__ __forceinline__ unsigned xb_ld(unsigned* p)              { return __hip_atomic_load(p, __ATOMIC_RELAXED, __HIP_MEMORY_SCOPE_AGENT); }
__device__ __forceinline__ unsigned xb_add(unsigned* p, unsigned v) { return __hip_atomic_fetch_add(p, v, __ATOMIC_RELAXED, __HIP_MEMORY_SCOPE_AGENT); }
__device__ __forceinline__ unsigned xb_xcc_id() { return (unsigned)__builtin_amdgcn_s_getreg((3 << 11) | 20) & 0xFu; }
#define XB_SPIN(cond, bar) do { unsigned _sp = 0; while (cond) { __builtin_amdgcn_s_sleep(1); \
    if ((++_sp & 255u) == 0u) { if (xb_ld(&(bar)[XB_TMO])) break; if (_sp > XB_SPIN_CAP) { atomicAdd(&(bar)[XB_TMO], 1u); break; } } } } while (0)

struct XcdBarrier { unsigned* bar; unsigned x; volatile LAS unsigned* st; };

__device__ __forceinline__ XcdBarrier xcd_barrier_post(unsigned* bar, volatile LAS unsigned* st) {
    XcdBarrier b; b.bar = bar; b.x = xb_xcc_id(); b.st = st;
    if (threadIdx.x == 0) (void)xb_add(&bar[XB_XCNT(b.x)], 1u);
    return b;
}
__device__ __forceinline__ void xcd_barrier_complete(unsigned* bar, unsigned x, unsigned& nloc, unsigned& nx) {
    const unsigned G = gridDim.x * gridDim.y * gridDim.z;
    unsigned sum, cnt, mine, sp = 0u;
    for (;;) {
        sum = 0u; cnt = 0u; mine = 0u;
#pragma unroll
        for (unsigned j = 0; j < 16; ++j) { const unsigned c = xb_ld(&bar[XB_XCNT(j)]); sum += c; cnt += (c > 0u) ? 1u : 0u; mine = (j == x) ? c : mine; }
        if (sum == G) break;
        __builtin_amdgcn_s_sleep(1);
        if ((++sp & 255u) == 0u) { if (xb_ld(&bar[XB_TMO])) break; if (sp > XB_SPIN_CAP) { atomicAdd(&bar[XB_TMO], 1u); break; } }
    }
    nloc = mine > 0u ? mine : 1u; nx = cnt > 0u ? cnt : 1u;
}
__device__ __forceinline__ void xcd_barrier(const XcdBarrier& b) {
    asm volatile("s_waitcnt vmcnt(0)" ::: "memory");
    __syncthreads();
    if (threadIdx.x == 0) {
        unsigned* bar = b.bar;
        __builtin_amdgcn_s_waitcnt(0);
        unsigned nloc = b.st[0], nx = b.st[1];
        if (nloc == 0u) { xcd_barrier_complete(bar, b.x, nloc, nx); b.st[0] = nloc; b.st[1] = nx; }
        const unsigned old = xb_add(&bar[XB_XSUB(b.x)], 1u);
        const unsigned gen = old / nloc;
        if (old + 1u == (gen + 1u) * nloc) {
            __builtin_amdgcn_fence(__ATOMIC_RELEASE, "agent");
            asm volatile("s_waitcnt vmcnt(0)" ::: "memory");
            const unsigned og = xb_add(&bar[XB_TOP], 1u);
            const unsigned tg = og / nx;
            if (og + 1u == (tg + 1u) * nx) xb_add(&bar[XB_TOPGEN], 1u);
            else XB_SPIN(xb_ld(&bar[XB_TOPGEN]) == tg, bar);
            __builtin_amdgcn_fence(__ATOMIC_ACQUIRE, "agent");
            xb_add(&bar[XB_XGEN(b.x)], 1u);
            asm volatile("s_waitcnt vmcnt(0)" ::: "memory");
        } else {
            XB_SPIN(xb_ld(&bar[XB_XGEN(b.x)]) == gen, bar);
            __builtin_amdgcn_fence(__ATOMIC_ACQUIRE, "agent");
            asm volatile("s_waitcnt vmcnt(0)" ::: "memory");
        }
    }
    __syncthreads();
}

__device__ __forceinline__ void sincos_2pi(double x, double& s, double& c) {
    const double q = __builtin_rint(x * 4.0);
    const double y = (x - q * 0.25) * 6.283185307179586476925;
    const double y2 = y * y;
    double sp = -7.6471637318198164759e-13; sp = sp * y2 + 1.6059043836821614599e-10; sp = sp * y2 - 2.5052108385441718775e-8; sp = sp * y2 + 2.7557319223985890653e-6;
    sp = sp * y2 - 1.9841269841269841270e-4; sp = sp * y2 + 8.3333333333333333333e-3; sp = sp * y2 - 1.6666666666666666667e-1; sp = sp * y2 * y + y;
    double cp = 4.7794773323873852974e-14; cp = cp * y2 - 1.1470745597729724714e-11; cp = cp * y2 + 2.0876756987868098979e-9; cp = cp * y2 - 2.7557319223985890653e-7;
    cp = cp * y2 + 2.4801587301587301587e-5; cp = cp * y2 - 1.3888888888888888889e-3; cp = cp * y2 + 4.1666666666666666667e-2; cp = cp * y2 - 0.5; cp = cp * y2 + 1.0;
    const int qi = ((int)q) & 3;
    s = (qi == 0) ? sp : (qi == 1) ? cp : (qi == 2) ? -sp : -cp;
    c = (qi == 0) ? cp : (qi == 1) ? -sp : (qi == 2) ? -cp : sp;
}
__device__ __forceinline__ void sincos_rad(double a, double& s, double& c) {
    double f = a * 0.15915494309189533576888; f -= __builtin_floor(f);
    if (f >= 1.0) f = 0.0;
    sincos_2pi(f, s, c);
}
__device__ __forceinline__ double exp_small(double x) {
    double r = 1.0 / 479001600.0;
    r = r * x + 1.0 / 39916800.0; r = r * x + 1.0 / 3628800.0; r = r * x + 1.0 / 362880.0; r = r * x + 1.0 / 40320.0; r = r * x + 1.0 / 5040.0;
    r = r * x + 1.0 / 720.0; r = r * x + 1.0 / 120.0; r = r * x + 1.0 / 24.0; r = r * x + 1.0 / 6.0; r = r * x + 0.5; r = r * x + 1.0; r = r * x + 1.0;
    return r;
}
__device__ __forceinline__ float fast_exp(float x) { return __builtin_amdgcn_exp2f(x * 1.4426950408889634f); }
__device__ __forceinline__ float sigmoidf_(float x) { return 1.0f / (1.0f + fast_exp(-x)); }
__device__ __forceinline__ float siluf_(float x) { return x * sigmoidf_(x); }
__device__ __forceinline__ float tanhf_(float x) { const float e = fast_exp(-2.0f * fabsf(x)); const float t = (1.0f - e) / (1.0f + e); return x < 0.f ? -t : t; }
__device__ __forceinline__ float gelu_tanh(float x) { return 0.5f * x * (1.0f + tanhf_(0.7978845608028654f * (x + 0.044715f * x * x * x))); }

#ifndef PH_REPEAT
#define PH_REPEAT 0u
#endif
struct Args { const float* in[43]; float* out; unsigned char* ws; int ph_lo, ph_hi; };

#define GAS __attribute__((address_space(1)))
struct Frame {
    LAS unsigned char* lds; GAS unsigned char* ws; int tid, lane, wave, bid, G, gw, NGW;
    const __attribute__((address_space(4))) unsigned long long* kin;
};
#define INP(i) ((const float*)(const GAS float*)F.kin[i])
#define WSP(T, off) ((T*)(GAS T*)(F.ws + (off)))

__device__ __forceinline__ void tr_item(const float* W, int ldw, int N, bf16* WT, int ldt, int row_off, int rs16, LAS float* scr, int item, int lane) {
    const int nblk = N / 64, kb = item / nblk, nb = item % nblk, k0 = 64 * kb, n0 = 64 * nb;
    const int la = lane & 15, lb = lane >> 4;
    f32x4 v[16];
#pragma unroll
    for (int i = 0; i < 16; ++i) v[i] = *(const f32x4*)(W + (size_t)(k0 + 4 * i + lb) * ldw + n0 + 4 * la);
#pragma unroll
    for (int i = 0; i < 16; ++i) { const int kk = 4 * i + lb; LAS float* d = scr + (4 * la) * 65 + kk; d[0] = v[i].x; d[65] = v[i].y; d[130] = v[i].z; d[195] = v[i].w; }
    LDS_WAIT(); asm volatile("" ::: "memory");
    const int c = lane & 7;
#pragma unroll
    for (int j = 0; j < 8; ++j) { const int n = (lane >> 3) + 8 * j; const LAS float* s = scr + n * 65 + 8 * c;
        v4u o; o.x = cvt_pk_bf16(s[0], s[1]); o.y = cvt_pk_bf16(s[2], s[3]); o.z = cvt_pk_bf16(s[4], s[5]); o.w = cvt_pk_bf16(s[6], s[7]);
        const int nn = n0 + n, drow = row_off + (nn >> 4) * rs16 + (nn & 15);
        *(v4u*)(WT + (size_t)drow * ldt + k0 + 8 * c) = o; }
    LDS_WAIT(); asm volatile("" ::: "memory");
}

__device__ __forceinline__ void hyfilt_item(Frame& F, int pb) {
    const float* w1 = INP(19); const float* b1 = INP(20); const float* fq = INP(21); const float* w2 = INP(22); const float* b2 = INP(23); const float* w3 = INP(24);
    LAS float* z = (LAS float*)F.lds;
    LAS float* h1 = z + 1088;
    LAS float* h2 = h1 + 2048;
    const int tid = F.tid;
    for (int idx = tid; idx < 32 * 33; idx += NTHREADS) {
        const int p = idx / 33, f = idx % 33, i = pb * 32 + p;
        float v;
        if (f == 0) v = (float)i * (1.0f / (float)(SEQ - 1));
        else { const int j = (f - 1) & 15; const float fj = 1e-4f + (float)j * ((15.0f - 1e-4f) / 15.0f);
            double fr = (double)fj * (double)i / (double)SEQ; fr -= __builtin_floor(fr); double s, c; sincos_2pi(fr, s, c); v = (f <= 16) ? (float)c : (float)(-s); }
        z[p * 33 + f] = v;
    }
    __syncthreads();
    for (int idx = tid; idx < 2048; idx += NTHREADS) {
        const int p = idx >> 6, j = idx & 63; float a = b1[j];
        for (int f = 0; f < 33; ++f) a += z[p * 33 + f] * w1[f * 64 + j];
        double s, c; sincos_rad((double)(fq[j] * a), s, c); h1[idx] = (float)s;
    }
    __syncthreads();
    for (int idx = tid; idx < 2048; idx += NTHREADS) {
        const int p = idx >> 6, j = idx & 63; float a = b2[j];
        for (int k = 0; k < 64; ++k) a += h1[p * 64 + k] * w2[k * 64 + j];
        double s, c; sincos_rad((double)(fq[64 + j] * a), s, c); h2[idx] = (float)s;
    }
    __syncthreads();
    float* kT = WSP(float, WS_KT); float* normp = WSP(float, WS_NORMP);
    {
        const int lane = F.lane, l31 = lane & 31, lh = lane >> 5;
        float af[32];
#pragma unroll
        for (int s = 0; s < 32; ++s) af[s] = h2[l31 * 64 + 2 * s + lh];
        float bn[32];
        { const unsigned vo = (unsigned)(lh * 4096 + F.wave * 32 + l31);
#pragma unroll
          for (int s = 0; s < 32; ++s) bn[s] = (w3 + s * 8192)[vo]; }
#pragma nounroll
        for (int ct = F.wave; ct < 128; ct += NWAVES) {
            const int col = ct * 32 + l31;
            f32x16 acc;
#pragma unroll
            for (int r = 0; r < 16; ++r) acc[r] = 0.f;
            float bv[32];
#pragma unroll
            for (int s = 0; s < 32; ++s) bv[s] = bn[s];
            { const unsigned vo = (unsigned)(lh * 4096 + (ct + NWAVES < 128 ? ct + NWAVES : ct) * 32 + l31);
#pragma unroll
              for (int s = 0; s < 32; ++s) bn[s] = (w3 + s * 8192)[vo]; }
#pragma unroll
            for (int s = 0; s < 32; ++s) acc = __builtin_amdgcn_mfma_f32_32x32x2f32(af[s], bv[s], acc, 0, 0, 0);
#pragma unroll
            for (int s = 0; s < 32; s += 8) asm volatile("" : "+v"(acc) : "v"(bv[s]), "v"(bv[s + 1]), "v"(bv[s + 2]), "v"(bv[s + 3]), "v"(bv[s + 4]), "v"(bv[s + 5]), "v"(bv[s + 6]), "v"(bv[s + 7]));
            const int ch = col & 1023, dir = (col >> 10) & 1;
            const float adel = 3.0701134573253946f + (float)ch * ((15.350567286626972f - 3.0701134573253946f) / 1023.0f);
            float sabs = 0.f;
#pragma unroll
            for (int r = 0; r < 16; ++r) { const int i = pb * 32 + (r & 3) + 8 * (r >> 2) + 4 * lh; const float t = (float)i * (1.0f / (float)(SEQ - 1)); acc[r] *= fast_exp(-t * adel); if (!(dir == 1 && i == 0)) sabs += fabsf(acc[r]); }
            sabs += __shfl_xor(sabs, 32);
#pragma unroll
            for (int q = 0; q < 4; ++q) *(f32x4*)(kT + (size_t)col * SEQ + pb * 32 + 8 * q + 4 * lh) = (f32x4){acc[4 * q], acc[4 * q + 1], acc[4 * q + 2], acc[4 * q + 3]};
            if (lh == 0) normp[(size_t)pb * 4096 + col] = sabs;
        }
    }
    __syncthreads();
}

#define LDS_BARRIER() do { asm volatile("s_waitcnt lgkmcnt(0)" ::: "memory"); __builtin_amdgcn_s_barrier(); asm volatile("" ::: "memory"); } while (0)
struct TrItem { const float* W; bf16* WT; int ldw, ldt, row_off, rs16, k0, n0; };
__device__ __forceinline__ TrItem moe_tr_item(Frame& F, int it) {
    const int le = it / 192, q = it % 192; TrItem r;
    bf16* wc = (bf16*)(GAS bf16*)(F.ws + WS_WMOE + (size_t)le * MOE_E_BYTES);
    if (q < 128) { r.W = (q < 64 ? INP(40) : INP(41)) + (size_t)le * (2048 * 512); r.ldw = 512; r.WT = wc; r.ldt = 2048; r.row_off = (q < 64) ? 0 : 16; r.rs16 = 32; r.k0 = 64 * ((q & 63) >> 1); r.n0 = 256 * (q & 1); }
    else { const int x = q - 128; r.W = INP(42) + (size_t)le * (512 * 2048); r.ldw = 2048; r.WT = wc + 1024 * 2048; r.ldt = 512; r.row_off = 0; r.rs16 = 16; r.k0 = 64 * (x >> 3); r.n0 = 256 * (x & 7); }
    return r;
}
__device__ __forceinline__ void moe_convert_items(Frame& F) {
    constexpr int NIT = 128 * 192;
    const int t = F.tid, lane = t & 63, w = __builtin_amdgcn_readfirstlane(t >> 6);
    const int kc = t & 7, nb = t >> 3;
    int first, step, count;
    if (F.G == 256) { first = F.bid * (NIT / 256); step = 1; count = NIT / 256; }
    else { first = F.bid; step = F.G; count = (NIT - F.bid + F.G - 1) / F.G; }
    if (count <= 0) return;
    LAS unsigned char* lds = F.lds;
#define CV_DMA(sidx, buf) do { const int s_ = (sidx) < count ? (sidx) : count - 1; const TrItem c_ = moe_tr_item(F, first + s_ * step); \
        const float* g_ = c_.W + (size_t)(c_.k0 + 8 * w) * c_.ldw + c_.n0 + 4 * (lane ^ w); \
        _Pragma("unroll") for (int j_ = 0; j_ < 8; ++j_) \
            __builtin_amdgcn_global_load_lds((const unsigned*)(g_ + (size_t)j_ * c_.ldw), (LAS unsigned*)(lds + (buf) * 65536 + (8 * w + j_) * 1024), 16, 0, 2); } while (0)
    CV_DMA(0, 0); CV_DMA(1, 1);
#pragma nounroll
    for (int s = 0; s < count; ++s) {
        const int buf = s & 1;
        if (s == 0) asm volatile("s_waitcnt vmcnt(8)" ::: "memory"); else asm volatile("s_waitcnt vmcnt(12)" ::: "memory");
        __builtin_amdgcn_s_barrier(); asm volatile("" ::: "memory");
        const TrItem c = moe_tr_item(F, first + s * step);
        const LAS float* T = (const LAS float*)(lds + buf * 65536);
#pragma unroll
        for (int q = 0; q < 4; ++q) { const int n = nb + 64 * q; const LAS float* src = T + (8 * kc) * 256 + 4 * ((n >> 2) ^ kc) + (n & 3);
            v4u o; o.x = cvt_pk_bf16(src[0], src[256]); o.y = cvt_pk_bf16(src[512], src[768]); o.z = cvt_pk_bf16(src[1024], src[1280]); o.w = cvt_pk_bf16(src[1536], src[1792]);
            const int nn = c.n0 + n, drow = c.row_off + (nn >> 4) * c.rs16 + (nn & 15);
            __builtin_nontemporal_store(o, (v4u*)(c.WT + (size_t)drow * c.ldt + c.k0 + 8 * kc)); }
        LDS_BARRIER();
        CV_DMA(s + 2, buf);
    }
    asm volatile("s_waitcnt vmcnt(0)" ::: "memory");
#undef CV_DMA
}

__device__ __forceinline__ void p0_prologue(Frame& F) {
    if ((F.bid & 1) == 0) { for (int pb = F.bid; pb < SEQ / 32; pb += F.G) hyfilt_item(F, pb); __syncthreads(); }
    const int gt = F.bid * NTHREADS + F.tid, NGT = F.G * NTHREADS;
    {
        f32x2* rope = WSP(f32x2, WS_ROPE);
        for (int idx = gt; idx < 128 * 16; idx += NGT) { const int pos = idx >> 4, i = idx & 15;
            double inv = (i & 3) == 0 ? 1.0 : (i & 3) == 1 ? 0.56234132519034908 : (i & 3) == 2 ? 0.31622776601683794 : 0.17782794100389228;
            inv *= (i >> 2) == 0 ? 1.0 : (i >> 2) == 1 ? 0.1 : (i >> 2) == 2 ? 0.01 : 0.001;
            const float ang = (float)pos * (float)inv; double s, c; sincos_rad((double)ang, s, c); rope[idx] = (f32x2){(float)c, (float)s}; }
    }
    {
        f32x2* tw = WSP(f32x2, WS_TW);
        for (int idx = gt; idx < 16384; idx += NGT) { double s, c; sincos_2pi((double)idx * (1.0 / 16384.0), s, c); tw[idx] = (f32x2){(float)c, (float)(-s)}; }
    }
    {
        const float* are = INP(26); const float* aim = INP(27); const float* ldt = INP(28); const float* bre = INP(29); const float* bim = INP(30);
        f32x2* lamb = WSP(f32x2, WS_S5LAM); f32x2* bb = WSP(f32x2, WS_S5B); f32x2* l256 = WSP(f32x2, WS_S5L256);
        for (int idx = gt; idx < 2 * 64 * 64; idx += NGT) { const int dg = idx >> 6;
            const float dt = expf(ldt[dg]); const float ar = are[idx], ai = aim[idx];
            const float zr = ar * dt, zi = ai * dt; double s, c; sincos_rad((double)zi, s, c); const double er = exp_small((double)zr);
            const double lr = er * c, li = er * s; lamb[idx] = (f32x2){(float)lr, (float)li};
            { double pr = lr, pi = li; for (int q = 0; q < 8; ++q) { const double tr = pr * pr - pi * pi, ti = 2.0 * pr * pi; pr = tr; pi = ti; } l256[idx] = (f32x2){(float)pr, (float)pi}; }
            const double nr = lr - 1.0, ni = li, den = (double)ar * ar + (double)ai * ai; const double qr = (nr * ar + ni * ai) / den, qi = (ni * ar - nr * ai) / den;
            for (int cc = 0; cc < 16; ++cc) { const double br = bre[(size_t)idx * 16 + cc], bi = bim[(size_t)idx * 16 + cc]; bb[(size_t)idx * 16 + cc] = (f32x2){(float)(qr * br - qi * bi), (float)(qr * bi + qi * br)}; } }
    }
    {
        float* wrt = WSP(float, WS_WRT);
        for (int idx = gt; idx < 2 * 72 * 2048; idx += NGT) { const int l = idx / (72 * 2048), r = idx % (72 * 2048), n = r / 2048, k = r % 2048;
            wrt[idx] = n < 8 ? INP(36)[((size_t)l * 2048 + k) * 8 + n] : INP(38)[((size_t)l * 2048 + k) * 64 + (n - 8)]; }
    }
    {
        bf16* ha = WSP(bf16, WS_HA);
        for (int idx = gt; idx < 2048; idx += NGT) ha[(size_t)TT * 2048 + idx] = 0;
    }
    LAS float* scr = (LAS float*)(F.lds + F.wave * 16896);
    {
        const float* c = INP(1); const float* cctx = INP(3); const float* adaw = INP(4); float* part = WSP(float, WS_ADAP);
        for (int rep = 0; rep < (((PH_REPEAT >> 26) & 1u) ? 2 : 1); ++rep)
        for (int it = F.gw; it < 2 * 32 * 48; it += F.NGW) {
            const int l = it / (32 * 48), r = it % (32 * 48), ks = r / 48, jb = r % 48, k0 = ks * 64, j0 = jb * 256 + F.lane * 4;
            const float c0 = c[k0 + F.lane], c1 = c[2048 + k0 + F.lane], c2 = cctx[k0 + F.lane];
            const float s0 = c0 / (1.0f + expf(-c0)), s1 = c1 / (1.0f + expf(-c1)), s2 = c2 / (1.0f + expf(-c2));
            f32x4 a0 = {0.f, 0.f, 0.f, 0.f}, a1 = a0, a2 = a0;
            const float* wp = adaw + ((size_t)l * 2048 + k0) * 12288 + j0;
#pragma unroll 8
            for (int kk = 0; kk < 64; ++kk) { const f32x4 w = *(const f32x4*)(wp + (size_t)kk * 12288);
                const float t0 = __builtin_bit_cast(float, __builtin_amdgcn_readlane(__builtin_bit_cast(int, s0), kk));
                const float t1 = __builtin_bit_cast(float, __builtin_amdgcn_readlane(__builtin_bit_cast(int, s1), kk));
                const float t2 = __builtin_bit_cast(float, __builtin_amdgcn_readlane(__builtin_bit_cast(int, s2), kk));
                a0 += w * t0; a1 += w * t1; a2 += w * t2; }
            float* pp = part + ((size_t)(l * 32 + ks) * 3) * 12288 + j0;
            *(f32x4*)(pp) = a0; *(f32x4*)(pp + 12288) = a1; *(f32x4*)(pp + 2 * 12288) = a2;
        }
    }
    {
        constexpr int I0 = 1024, I1 = 512, I2 = 512, I3 = 1024, I4 = 2048, I5 = 1024, I6 = 64, I7 = 256, IE = 768;
        constexpr int NSMALL = I0 + I1 + I2 + I3 + I4 + I5 + I6 + I7;
        const int NITEMS = NSMALL;
        for (int rep = 0; rep < (((PH_REPEAT >> 27) & 1u) ? 2 : 1); ++rep)
        for (int it = F.gw; it < NITEMS; it += F.NGW) {
            int r = it;
            if (r < I0) { tr_item(INP(9), 4096, 2048, WSP(bf16, WS_WIN0), 2048, 0, 16, scr, r, F.lane); continue; } r -= I0;
            if (r < I1) { tr_item(INP(9) + 2048, 4096, 1024, WSP(bf16, WS_WIN0), 2048, 3072, 16, scr, r, F.lane); continue; } r -= I1;
            if (r < I2) { tr_item(INP(9) + 3072, 4096, 1024, WSP(bf16, WS_WIN0), 2048, 2048, 16, scr, r, F.lane); continue; } r -= I2;
            if (r < I3) { tr_item(INP(10), 2048, 2048, WSP(bf16, WS_WOUT0), 2048, 0, 16, scr, r, F.lane); continue; } r -= I3;
            if (r < I4) { tr_item(INP(15), 4096, 4096, WSP(bf16, WS_WIN1), 2048, 0, 16, scr, r, F.lane); continue; } r -= I4;
            if (r < I5) { tr_item(INP(16), 2048, 2048, WSP(bf16, WS_WOUT1), 2048, 0, 16, scr, r, F.lane); continue; } r -= I5;
            if (r < I6) { const int g = r / 16; tr_item(INP(13) + (size_t)g * 65536, 256, 256, WSP(bf16, WS_WPOOL), 256, g * 256, 16, scr, r % 16, F.lane); continue; } r -= I6;
            if (r < I7) { tr_item(INP(34), 1024, 1024, WSP(bf16, WS_WGLU), 1024, 0, 16, scr, r, F.lane); continue; } r -= I7;
        }
    }
    if ((F.bid & 1) != 0) { __syncthreads(); for (int pb = F.bid; pb < SEQ / 32; pb += F.G) hyfilt_item(F, pb); }
}

__device__ __forceinline__ void p1_reduce(Frame& F) {
    const int gt = F.bid * NTHREADS + F.tid, NGT = F.G * NTHREADS;
    const float* part = WSP(float, WS_ADAP); float* mod = WSP(float, WS_MOD); const float* adab = INP(5);
    for (int idx = gt; idx < 2 * 3 * 12288; idx += NGT) { const int l = idx / (3 * 12288), r = idx % (3 * 12288), m = r / 12288, j = r % 12288;
        float a = adab[l * 12288 + j];
        for (int ks = 0; ks < 32; ++ks) a += part[((size_t)(l * 32 + ks) * 3 + m) * 12288 + j];
        mod[idx] = a; }
    const float* normp = WSP(float, WS_NORMP); float* invn = WSP(float, WS_INVN);
    {
        LAS float* red = (LAS float*)F.lds;
        for (int blk = F.bid; blk < 64; blk += F.G) {
            const int q = F.tid >> 5, chl = F.tid & 31, idx = blk * 32 + chl, o = idx >> 10, ch = idx & 1023; float a = 0.f;
#pragma unroll
            for (int i = 0; i < 16; ++i) { const int pb = q * 16 + i; a += normp[(size_t)pb * 4096 + o * 2048 + ch] + normp[(size_t)pb * 4096 + o * 2048 + 1024 + ch]; }
            red[q * 32 + chl] = a;
            __syncthreads();
            if (F.tid < 32) { float s = 0.f;
#pragma unroll
                for (int k = 0; k < 16; ++k) s += red[k * 32 + F.tid];
                invn[blk * 32 + F.tid] = 1.0f / s; }
            __syncthreads();
        }
    }
    {
        const f32x2* lamb = WSP(f32x2, WS_S5LAM); const f32x2* bbar = WSP(f32x2, WS_S5B); const float* cre = INP(31); const float* cim = INP(32);
        bf16* W1 = WSP(bf16, WS_S5W1); bf16* W3 = WSP(bf16, WS_S5W3); bf16* KT = WSP(bf16, WS_S5KT); f32x2* l16 = WSP(f32x2, WS_S5L16);
#define S5_POWF(l_, e_, pw_) do { pw_ = (f32x2){1.f, 0.f}; f32x2 b_ = l_; const int e__ = (e_);        \
        _Pragma("unroll") for (int q_ = 0; q_ < 5; ++q_) { const f32x2 m_ = {pw_.x * b_.x - pw_.y * b_.y, pw_.x * b_.y + pw_.y * b_.x}; const bool t_ = (e__ >> q_) & 1; pw_.x = t_ ? m_.x : pw_.x; pw_.y = t_ ? m_.y : pw_.y; \
            b_ = (f32x2){b_.x * b_.x - b_.y * b_.y, 2.f * b_.x * b_.y}; } } while (0)
        for (int idx = gt; idx < 128 * 64; idx += NGT) { f32x2 pw; S5_POWF(lamb[idx], 16, pw); l16[idx] = pw; }
        for (int idx = gt; idx < 128 * 128 * 32; idx += NGT) {
            const int k8 = idx & 31, n = (idx >> 5) & 127, dg = idx >> 12, sigma = k8 >> 1, h = k8 & 1, p = (n & 15) + 16 * ((n >> 4) & 3), im = n >> 6;
            f32x2 pw; S5_POWF(lamb[dg * 64 + p], 15 - sigma, pw);
            const f32x4* bp = (const f32x4*)(bbar + ((size_t)dg * 64 + p) * 16 + 8 * h); float o[8];
#pragma unroll
            for (int j = 0; j < 4; ++j) { const f32x4 q = bp[j]; o[2 * j] = im ? (pw.x * q.y + pw.y * q.x) : (pw.x * q.x - pw.y * q.y); o[2 * j + 1] = im ? (pw.x * q.w + pw.y * q.z) : (pw.x * q.z - pw.y * q.w); }
            v4u w; w.x = pk2(o[0], o[1]); w.y = pk2(o[2], o[3]); w.z = pk2(o[4], o[5]); w.w = pk2(o[6], o[7]);
            *(v4u*)(W1 + (size_t)idx * 8) = w; }
        for (int idx = gt; idx < 128 * 256 * 16; idx += NGT) {
            const int k8 = idx & 15, n = (idx >> 4) & 255, dg = idx >> 12, tau = n >> 4, cout = n & 15; float o[8];
#pragma unroll
            for (int j = 0; j < 4; ++j) { const int p = 4 * k8 + j; f32x2 pw; S5_POWF(lamb[dg * 64 + p], tau + 1, pw);
                const float cr = cre[((size_t)dg * 16 + cout) * 64 + p], ci = cim[((size_t)dg * 16 + cout) * 64 + p]; o[2 * j] = cr * pw.x - ci * pw.y; o[2 * j + 1] = -(cr * pw.y + ci * pw.x); }
            v4u w; w.x = pk2(o[0], o[1]); w.y = pk2(o[2], o[3]); w.z = pk2(o[4], o[5]); w.w = pk2(o[6], o[7]);
            *(v4u*)(W3 + (size_t)idx * 8) = w; }
        for (int idx = gt; idx < 128 * 17 * 16 * 2; idx += NGT) {
            const int h = idx & 1, cout = (idx >> 1) & 15, d1 = (idx >> 5) % 17, dg = (idx >> 5) / 17;
            float acc[8];
#pragma unroll
            for (int j = 0; j < 8; ++j) acc[j] = 0.f;
            if (d1 > 0) {
#pragma unroll 4
              for (int p = 0; p < 64; ++p) { f32x2 pw; S5_POWF(lamb[dg * 64 + p], d1 - 1, pw);
                const float cr = cre[((size_t)dg * 16 + cout) * 64 + p], ci = cim[((size_t)dg * 16 + cout) * 64 + p]; const float gr = cr * pw.x - ci * pw.y, gi = cr * pw.y + ci * pw.x;
                const f32x4* bp = (const f32x4*)(bbar + ((size_t)dg * 64 + p) * 16 + 8 * h);
#pragma unroll
                for (int j = 0; j < 4; ++j) { const f32x4 q = bp[j]; acc[2 * j] += gr * q.x - gi * q.y; acc[2 * j + 1] += gr * q.z - gi * q.w; } } }
            v4u w; w.x = pk2(acc[0], acc[1]); w.y = pk2(acc[2], acc[3]); w.z = pk2(acc[4], acc[5]); w.w = pk2(acc[6], acc[7]);
            *(v4u*)(KT + (size_t)idx * 8) = w; }
#undef S5_POWF
    }
}

__device__ __forceinline__ const float* modp(Frame& F, int l, int m, int c) { return WSP(float, WS_MOD) + ((size_t)(l * 3 + m) * 6 + c) * 2048; }
__device__ __forceinline__ int row_stream(int r) { return r < TL ? r / SEQ : 2; }

template <int MODE>
__device__ __forceinline__ void norm_phase(Frame& F, int l, float* dout) {
    const int nrows = (MODE == 3 || (MODE == 1 && l == 1)) ? TL : TT;
    float* xbuf = WSP(float, WS_X); bf16* ha = WSP(bf16, WS_HA); const bf16* Y = WSP(bf16, WS_Y);
    const float* gvec = (MODE == 0) ? INP(6) : (MODE == 1) ? INP(7) + l * 2048 : (MODE == 2) ? INP(6) + 2048 : INP(8);
    const int lane = F.lane;
    for (int r = F.gw; r < nrows; r += F.NGW) {
        const int m = row_stream(r);
        const float* src = (MODE == 0) ? (r < TL ? INP(0) + (size_t)r * 2048 : INP(2) + (size_t)(r - TL) * 2048) : xbuf + (size_t)r * 2048;
        f32x4 v[8]; float ss = 0.f;
#pragma unroll
        for (int j = 0; j < 8; ++j) v[j] = *(const f32x4*)(src + 4 * lane + 256 * j);
        if (MODE == 2 || MODE == 3) {
            const float* g2 = modp(F, MODE == 2 ? 0 : 1, m, 5);
            const bf16* y0 = Y + (size_t)(2 * r) * 2048; const bf16* y1 = y0 + 2048;
#pragma unroll
            for (int j = 0; j < 8; ++j) { const int c = 4 * lane + 256 * j; const v2u a = *(const v2u*)(y0 + c), b = *(const v2u*)(y1 + c); const f32x4 gg = *(const f32x4*)(g2 + c);
                v[j].x += gg.x * (bflo(a.x) + bflo(b.x)); v[j].y += gg.y * (bfhi(a.x) + bfhi(b.x)); v[j].z += gg.z * (bflo(a.y) + bflo(b.y)); v[j].w += gg.w * (bfhi(a.y) + bfhi(b.y)); }
            if (MODE == 2) {
#pragma unroll
                for (int j = 0; j < 8; ++j) *(f32x4*)(xbuf + (size_t)r * 2048 + 4 * lane + 256 * j) = v[j];
            }
        }
#pragma unroll
        for (int j = 0; j < 8; ++j) ss += (v[j].x * v[j].x + v[j].y * v[j].y) + (v[j].z * v[j].z + v[j].w * v[j].w);
        ss = wave_sum(ss);
        const float rs = 1.0f / sqrtf(ss * (1.0f / 2048.0f) + EPS);
        if (MODE == 3) {
#pragma unroll
            for (int j = 0; j < 8; ++j) { const int c = 4 * lane + 256 * j; const f32x4 gg = *(const f32x4*)(gvec + c); *(f32x4*)(dout + (size_t)r * 2048 + c) = v[j] * rs * gg; }
            continue;
        }
        const int lm = (MODE == 2) ? 1 : l;
        const float* sh = modp(F, lm, m, MODE == 1 ? 3 : 0); const float* sc = modp(F, lm, m, MODE == 1 ? 4 : 1);
#pragma unroll
        for (int j = 0; j < 8; ++j) { const int c = 4 * lane + 256 * j; const f32x4 gg = *(const f32x4*)(gvec + c), s1 = *(const f32x4*)(sc + c), s0 = *(const f32x4*)(sh + c);
            v[j] = (v[j] * rs * gg) * (1.0f + s1) + s0;
            v2u o; o.x = pk2(v[j].x, v[j].y); o.y = pk2(v[j].z, v[j].w); *(v2u*)(ha + (size_t)r * 2048 + c) = o; }
    }
}

__device__ __forceinline__ void ffn_norm_router_phase(Frame& F, int l) {
    const int nrows = (l == 1) ? TL : TT;
    const float* xbuf = WSP(float, WS_X); bf16* ha = WSP(bf16, WS_HA);
    const float* gvec = INP(7) + l * 2048;
    const float* wrt = WSP(float, WS_WRT) + (size_t)l * 72 * 2048;
    LAS float* hl = (LAS float*)F.lds;
    LAS float* lg = (LAS float*)(F.lds + 131584);
    const int lane = F.lane, tid = F.tid, l31 = lane & 31, lh = lane >> 5;
    for (int it = F.bid; it < nrows / 32; it += F.G) {
        const int r0 = it * 32 + F.wave * 4;
        f32x4 v[4][8];
#pragma unroll
        for (int rr = 0; rr < 4; ++rr)
#pragma unroll
            for (int j = 0; j < 8; ++j) v[rr][j] = *(const f32x4*)(xbuf + (size_t)(r0 + rr) * 2048 + 4 * lane + 256 * j);
        const int m = row_stream(r0);
        const float* sh = modp(F, l, m, 3); const float* sc = modp(F, l, m, 4);
        float rs[4];
#pragma unroll
        for (int rr = 0; rr < 4; ++rr) { float ss = 0.f;
#pragma unroll
            for (int j = 0; j < 8; ++j) ss += (v[rr][j].x * v[rr][j].x + v[rr][j].y * v[rr][j].y) + (v[rr][j].z * v[rr][j].z + v[rr][j].w * v[rr][j].w);
            ss = wave_sum(ss); rs[rr] = 1.0f / sqrtf(ss * (1.0f / 2048.0f) + EPS); }
#pragma unroll
        for (int j = 0; j < 8; ++j) { if ((j & 1) == 0) __builtin_amdgcn_sched_barrier(0); const int c = 4 * lane + 256 * j; const f32x4 gg = *(const f32x4*)(gvec + c), s1 = *(const f32x4*)(sc + c), s0 = *(const f32x4*)(sh + c);
#pragma unroll
            for (int rr = 0; rr < 4; ++rr) { v[rr][j] = (v[rr][j] * rs[rr] * gg) * (1.0f + s1) + s0;
                v2u o; o.x = cvt_pk_bf16(v[rr][j].x, v[rr][j].y); o.y = cvt_pk_bf16(v[rr][j].z, v[rr][j].w); *(v2u*)(ha + (size_t)(r0 + rr) * 2048 + c) = o; } }
        f32x16 acc[3];
#pragma unroll
        for (int nt = 0; nt < 3; ++nt)
#pragma unroll
            for (int r = 0; r < 16; ++r) acc[nt][r] = 0.f;
        const int nr2 = (64 + l31 < 72) ? 64 + l31 : 71;
#pragma unroll
        for (int hK = 0; hK < 2; ++hK) {
#pragma unroll
            for (int rr = 0; rr < 4; ++rr)
#pragma unroll
                for (int j = 0; j < 4; ++j) *(LAS f32x4*)(hl + (F.wave * 4 + rr) * 1028 + 256 * j + 4 * lane) = v[rr][4 * hK + j];
            __syncthreads();
            const LAS float* ap = hl + l31 * 1028 + 128 * F.wave + 4 * lh;
            const float* wp = wrt + 1024 * hK + 128 * F.wave + 4 * lh;
            const float* w0 = wp + (size_t)l31 * 2048; const float* w1 = wp + (size_t)(32 + l31) * 2048; const float* w2 = wp + (size_t)nr2 * 2048;
#pragma nounroll
            for (int jc = 0; jc < 4; ++jc) {
                f32x4 af[4], b0[4], b1[4], b2[4];
#pragma unroll
                for (int jj = 0; jj < 4; ++jj) { const int o = 8 * (4 * jc + jj); b0[jj] = *(const f32x4*)(w0 + o); b1[jj] = *(const f32x4*)(w1 + o); b2[jj] = *(const f32x4*)(w2 + o); af[jj] = *(const LAS f32x4*)(ap + o); }
#pragma unroll
                for (int jj = 0; jj < 4; ++jj)
#pragma unroll
                    for (int c = 0; c < 4; ++c) {
                        acc[0] = __builtin_amdgcn_mfma_f32_32x32x2f32(af[jj][c], b0[jj][c], acc[0], 0, 0, 0);
                        acc[1] = __builtin_amdgcn_mfma_f32_32x32x2f32(af[jj][c], b1[jj][c], acc[1], 0, 0, 0);
                        acc[2] = __builtin_amdgcn_mfma_f32_32x32x2f32(af[jj][c], b2[jj][c], acc[2], 0, 0, 0); }
                asm volatile("" : "+v"(acc[0]), "+v"(acc[1]), "+v"(acc[2]) : "v"(af[0]), "v"(af[1]), "v"(af[2]), "v"(af[3]), "v"(b0[0]), "v"(b0[1]), "v"(b0[2]), "v"(b0[3]),
                             "v"(b1[0]), "v"(b1[1]), "v"(b1[2]), "v"(b1[3]), "v"(b2[0]), "v"(b2[1]), "v"(b2[2]), "v"(b2[3]));
            }
            __syncthreads();
        }
        {
            LAS float* pw = hl + F.wave * (32 * 96);
#pragma unroll
            for (int nt = 0; nt < 3; ++nt)
#pragma unroll
                for (int r = 0; r < 16; ++r) pw[((r & 3) + 8 * (r >> 2) + 4 * lh) * 96 + 32 * nt + l31] = acc[nt][r];
        }
        __syncthreads();
        for (int idx = tid; idx < 32 * 72; idx += NTHREADS) { const int row = idx / 72, col = idx - row * 72; float s = 0.f;
#pragma unroll
            for (int w = 0; w < 8; ++w) s += hl[w * (32 * 96) + row * 96 + col];
            lg[row * 80 + col] = s; }
        __syncthreads();
        if (lane < 4) {
            const int r = r0 + lane; const LAS float* L = lg + (F.wave * 4 + lane) * 80;
            float gl[8]; float gmax = -INFINITY; int gi = 0;
#pragma unroll
            for (int j = 0; j < 8; ++j) { gl[j] = L[j] + INP(37)[l * 8 + j]; if (gl[j] > gmax) { gmax = gl[j]; gi = j; } }
            float gsum = 0.f;
#pragma unroll
            for (int j = 0; j < 8; ++j) gsum += expf(gl[j] - gmax);
            const float pg_top = 1.0f / gsum;
            float pe[8]; float emax = -INFINITY;
#pragma unroll
            for (int j = 0; j < 8; ++j) { pe[j] = L[8 + gi * 8 + j] + INP(39)[l * 64 + gi * 8 + j]; emax = fmaxf(emax, pe[j]); }
            float esum = 0.f;
#pragma unroll
            for (int j = 0; j < 8; ++j) { pe[j] = expf(pe[j] - emax); esum += pe[j]; }
            int e1 = 0; float p1 = -1.f;
#pragma unroll
            for (int j = 0; j < 8; ++j) { pe[j] /= esum; if (pe[j] > p1) { p1 = pe[j]; e1 = j; } }
            int e2 = 0; float p2 = -1.f;
#pragma unroll
            for (int j = 0; j < 8; ++j) { if (j != e1 && pe[j] > p2) { p2 = pe[j]; e2 = j; } }
            const float den = p1 + p2; const float g1 = pg_top * p1 / den, g2 = pg_top * p2 / den;
            unsigned* cnt = WSP(unsigned, WS_CTL) + CW_CNT + l * 64 * CSTR; int* tokl = WSP(int, WS_TOKL); float* gatel = WSP(float, WS_GATEL);
            const int ex1 = gi * 8 + e1, ex2 = gi * 8 + e2;
            const unsigned k1 = atomicAdd(cnt + ex1 * CSTR, 1u); tokl[(size_t)ex1 * LISTCAP + k1] = 2 * r; gatel[(size_t)ex1 * LISTCAP + k1] = g1;
            const unsigned k2 = atomicAdd(cnt + ex2 * CSTR, 1u); tokl[(size_t)ex2 * LISTCAP + k2] = 2 * r + 1; gatel[(size_t)ex2 * LISTCAP + k2] = g2;
        }
        __syncthreads();
    }
}

#define EPI_ARGS const f32x4 (&acc)[2][2][4][2], const pg8::Unit& u, int wr, int wc, int fr, int fq
__device__ __forceinline__ void st_bf4(bf16* p, f32x4 v) { v2u o; o.x = cvt_pk_bf16(v.x, v.y); o.y = cvt_pk_bf16(v.z, v.w); *(v2u*)p = o; }
__device__ __forceinline__ void st_bf8(bf16* p, f32x4 a, f32x4 b) { v4u o; o.x = cvt_pk_bf16(a.x, a.y); o.y = cvt_pk_bf16(a.z, a.w); o.z = cvt_pk_bf16(b.x, b.y); o.w = cvt_pk_bf16(b.z, b.w); *(v4u*)p = o; }

struct EpiQKP {
    static constexpr bool PERM = false;
    bf16* Q; bf16* Kb; bf16* P; const f32x2* rope;
    __device__ __forceinline__ void operator()(EPI_ARGS) const {
        const int sect = u.pn >> 2, cb = (u.pn & 3) * 256; const bool latent = u.pm < TL / 256;
#pragma unroll
        for (int ai = 0; ai < 2; ++ai)
#pragma unroll
            for (int m = 0; m < 4; ++m) {
                const int r = u.pm * 256 + ai * 128 + wr * 64 + m * 16 + fr;
                int b, t; if (latent) { b = r / SEQ; t = r % SEQ; } else { b = (r - TL) / CTX; t = (r - TL) % CTX; }
                f32x4 cs0 = {1.f, 0.f, 1.f, 0.f}, cs1 = cs0;
                if (latent && sect < 2) { const int pos = (wc & 1) ? (t & 63) : (t >> 6); const f32x4* rp = (const f32x4*)(rope + pos * 16 + 4 * fq); cs0 = rp[0]; cs1 = rp[1]; }
#pragma unroll
                for (int bj = 0; bj < 2; ++bj) {
                    const int c0 = cb + bj * 128 + wc * 32 + 4 * fq;
                    f32x4 a = acc[ai][bj][m][0], bb = acc[ai][bj][m][1];
                    if (sect < 2) {
                        const f32x4 co = {cs0.x, cs0.z, cs1.x, cs1.z}, si = {cs0.y, cs0.w, cs1.y, cs1.w};
                        const f32x4 oa = a * co - bb * si, ob = a * si + bb * co; a = oa; bb = ob;
                    }
                    if (sect == 0) { a = a * QSCALE; bb = bb * QSCALE; bf16* d = Q + (size_t)r * 1024 + c0; st_bf4(d, a); st_bf4(d + 16, bb); }
                    else if (sect == 1) { const size_t kr = (size_t)b * KEYS + (latent ? CTX + t : t); bf16* d = Kb + kr * 1024 + c0; st_bf4(d, a); st_bf4(d + 16, bb); }
                    else { bf16* d = P + (size_t)r * 1024 + c0; st_bf4(d, a); st_bf4(d + 16, bb); }
                }
            }
    }
};
struct EpiVT {
    static constexpr bool PERM = false;
    bf16* VT;
    __device__ __forceinline__ void operator()(EPI_ARGS) const {
        const bool latent = u.pn < TL / 256; const int b = latent ? u.pn / 32 : u.pn - TL / 256; const int key_t0 = latent ? CTX + (u.pn % 32) * 256 : 0;
        const int kperm = 8 * (fq & 1) + 4 * (fq >> 1);
#pragma unroll
        for (int ai = 0; ai < 2; ++ai)
#pragma unroll
            for (int m = 0; m < 4; ++m) {
                const int rr = u.pm * 256 + ai * 128 + wr * 64 + m * 16 + fr;
                bf16* rowp = VT + ((size_t)b * 1024 + rr) * KEYS + key_t0;
#pragma unroll
                for (int bj = 0; bj < 2; ++bj)
#pragma unroll
                    for (int n = 0; n < 2; ++n) st_bf4(rowp + bj * 128 + wc * 32 + 16 * n + kperm, acc[ai][bj][m][n]);
            }
    }
};
struct EpiScaleBf16 {
    static constexpr bool PERM = true;
    bf16* O; int ldo, coff; const float* cscale;
    __device__ __forceinline__ void operator()(EPI_ARGS) const {
#pragma unroll
        for (int bj = 0; bj < 2; ++bj) { const int c = u.pn * 256 + bj * 128 + wc * 32 + 8 * fq; const f32x4 s0 = *(const f32x4*)(cscale + c), s1 = *(const f32x4*)(cscale + c + 4);
#pragma unroll
            for (int ai = 0; ai < 2; ++ai)
#pragma unroll
                for (int m = 0; m < 4; ++m) { const int r = u.pm * 256 + ai * 128 + wr * 64 + m * 16 + fr; st_bf8(O + (size_t)r * ldo + coff + c, acc[ai][bj][m][0] * s0, acc[ai][bj][m][1] * s1); } }
    }
};
struct EpiBf16 {
    static constexpr bool PERM = true;
    bf16* O; int ldo;
    __device__ __forceinline__ void operator()(EPI_ARGS) const {
#pragma unroll
        for (int ai = 0; ai < 2; ++ai)
#pragma unroll
            for (int m = 0; m < 4; ++m) { const int r = u.pm * 256 + ai * 128 + wr * 64 + m * 16 + fr; bf16* rowp = O + (size_t)r * ldo + u.pn * 256 + wc * 32 + 8 * fq;
#pragma unroll
                for (int bj = 0; bj < 2; ++bj) st_bf8(rowp + bj * 128, acc[ai][bj][m][0], acc[ai][bj][m][1]); }
    }
};
struct EpiRes {
    static constexpr bool PERM = false;
    const float* xlat; const float* xctx; float* xout; const float* gate0;
    __device__ __forceinline__ void operator()(EPI_ARGS) const {
        const bool latent = u.pm < TL / 256;
#pragma unroll
        for (int ai = 0; ai < 2; ++ai)
#pragma unroll
            for (int m = 0; m < 4; ++m) { const int r = u.pm * 256 + ai * 128 + wr * 64 + m * 16 + fr; const int ms = latent ? r / SEQ : 2;
                const float* xi = latent ? xlat + (size_t)r * 2048 : xctx + (size_t)(r - TL) * 2048; const float* gp = gate0 + (size_t)ms * 12288;
#pragma unroll
                for (int bj = 0; bj < 2; ++bj)
#pragma unroll
                    for (int n = 0; n < 2; ++n) { const int c = u.pn * 256 + bj * 128 + wc * 32 + 16 * n + 4 * fq;
                        const f32x4 xv = *(const f32x4*)(xi + c), gv = *(const f32x4*)(gp + c); *(f32x4*)(xout + (size_t)r * 2048 + c) = xv + gv * acc[ai][bj][m][n]; } }
    }
};
struct EpiMoeUp {
    static constexpr bool PERM = false;
    bf16* H;
    __device__ __forceinline__ void operator()(EPI_ARGS) const {
#pragma unroll
        for (int ai = 0; ai < 2; ++ai)
#pragma unroll
            for (int m = 0; m < 4; ++m) { const size_t r = (size_t)u.pm * 256 + ai * 128 + wr * 64 + m * 16 + fr;
#pragma unroll
                for (int bj = 0; bj < 2; ++bj) { const int hc = (u.pn * 256 + bj * 128 + wc * 32) / 2 + 4 * fq; const f32x4 a = acc[ai][bj][m][0], b = acc[ai][bj][m][1];
                    const f32x4 h = {siluf_(a.x) * b.x, siluf_(a.y) * b.y, siluf_(a.z) * b.z, siluf_(a.w) * b.w}; st_bf4(H + r * 512 + hc, h); } }
    }
};
struct EpiMoeDown {
    static constexpr bool PERM = true;
    bf16* Y; const int* tokl; const float* gatel; const unsigned* cnt;
    __device__ __forceinline__ void operator()(EPI_ARGS) const {
        const int ce = (int)cnt[u.e * CSTR];
#pragma unroll
        for (int ai = 0; ai < 2; ++ai)
#pragma unroll
            for (int m = 0; m < 4; ++m) { const int idx = u.idx0 + ai * 128 + wr * 64 + m * 16 + fr;
                if (idx < ce) { const int pair = tokl[(size_t)u.e * LISTCAP + idx]; const float gt = gatel[(size_t)u.e * LISTCAP + idx]; bf16* rowp = Y + (size_t)pair * 2048 + u.pn * 256 + wc * 32 + 8 * fq;
#pragma unroll
                    for (int bj = 0; bj < 2; ++bj) st_bf8(rowp + bj * 128, acc[ai][bj][m][0] * gt, acc[ai][bj][m][1] * gt); } }
    }
};
struct EpiGlu {
    static constexpr bool PERM = true;
    bf16* O; int ldo, coff; const bf16* Gb; const float* bias;
    __device__ __forceinline__ void operator()(EPI_ARGS) const {
#pragma unroll
        for (int ai = 0; ai < 2; ++ai)
#pragma unroll
            for (int m = 0; m < 4; ++m) { const int r = u.pm * 256 + ai * 128 + wr * 64 + m * 16 + fr;
#pragma unroll
                for (int bj = 0; bj < 2; ++bj) { const int c = u.pn * 256 + bj * 128 + wc * 32 + 8 * fq; const f32x4 b0 = *(const f32x4*)(bias + c), b1 = *(const f32x4*)(bias + c + 4); const v4u gw = *(const v4u*)(Gb + (size_t)r * 1024 + c);
                    const f32x4 a0 = acc[ai][bj][m][0] + b0, a1 = acc[ai][bj][m][1] + b1;
                    const f32x4 o0 = {bflo(gw.x) * sigmoidf_(a0.x), bfhi(gw.x) * sigmoidf_(a0.y), bflo(gw.y) * sigmoidf_(a0.z), bfhi(gw.y) * sigmoidf_(a0.w)};
                    const f32x4 o1 = {bflo(gw.z) * sigmoidf_(a1.x), bfhi(gw.z) * sigmoidf_(a1.y), bflo(gw.w) * sigmoidf_(a1.z), bfhi(gw.w) * sigmoidf_(a1.w)};
                    st_bf8(O + (size_t)r * ldo + coff + c, o0, o1); } }
    }
};

struct MoeOrder {
    const LAS int* bstart;
    const unsigned* cnt; const int* tokl; int nN, G, c, nblk; long bstride, eoff; bool up;
    __device__ bool next(int i, pg8::Unit& u) const {
        const long Lx = (long)i * G + c; if (Lx >= (long)nblk * nN) return false;
        const int blk = (int)(Lx / nN); u.pn = (int)(Lx % nN); u.pm = blk;
        const int e = bstart[65 + blk];
        u.e = e; u.idx0 = (blk - bstart[e]) * 256;
        u.aoff = up ? 0 : (long)blk * 256 * 512 * 2;
        u.boff = (long)e * (long)MOE_E_BYTES + eoff + (long)u.pn * bstride;
        return true;
    }
    __device__ int arow(const pg8::Unit& u, int row) const { const int idx = u.idx0 + row; return idx < (int)cnt[u.e * CSTR] ? (tokl[(size_t)u.e * LISTCAP + idx] >> 1) : TT; }
};

__device__ __forceinline__ void tile_order(int wgid, int nM, int nN, int& pm, int& pn) {
    const int nwg = nM * nN; { const int q = nwg / 8, r = nwg % 8, xcd = wgid % 8, off = wgid / 8; wgid = (xcd < r ? xcd * (q + 1) : r * (q + 1) + (xcd - r) * q) + off; }
    const int nig = 8 * nN, gid = wgid / nig, fm = gid * 8, gsz = (nM - fm) < 8 ? (nM - fm) : 8;
    pm = fm + ((wgid % nig) % gsz); pn = (wgid % nig) / gsz;
}
struct InProj0Order {
    int G, c; long offA1, offB1, offA2, offB2;
    __device__ bool next(int i, pg8::Unit& u) const {
        const int Lx = i * G + c; constexpr int N1 = (TT / 256) * 12, N2 = 4 * (TT / 256); constexpr long TS = 256L * 2048 * 2;
        if (Lx >= N1 + N2) return false;
        u.idx0 = 0;
        if (Lx < N1) { tile_order(Lx, TT / 256, 12, u.pm, u.pn); u.aoff = offA1 + (long)u.pm * TS; u.boff = offB1 + (long)u.pn * TS; u.e = 0; }
        else { tile_order(Lx - N1, 4, TT / 256, u.pm, u.pn); u.aoff = offA2 + (long)u.pm * TS; u.boff = offB2 + (long)u.pn * TS; u.e = 1; }
        return true;
    }
    __device__ int arow(const pg8::Unit&, int) const { return 0; }
};
struct EpiInProj0 {
    static constexpr bool PERM = false;
    EpiQKP e1; EpiVT e2;
    __device__ __forceinline__ void operator()(EPI_ARGS) const { if (u.e == 0) e1(acc, u, wr, wc, fr, fq); else e2(acc, u, wr, wc, fr, fq); }
};

#ifdef ATT_NORARE
#define ATT_RARE(mx) false
#else
#define ATT_RARE(mx) __any(mx > 8.0f)
#endif
__device__ __forceinline__ float xhalf_max(float v) {
    const auto r = __builtin_amdgcn_permlane32_swap(__builtin_bit_cast(unsigned, v), __builtin_bit_cast(unsigned, v), false, false);
    return fmaxf(__builtin_bit_cast(float, r[0]), __builtin_bit_cast(float, r[1]));
}
__device__ __forceinline__ void attn_phase(Frame& F, const int cvslot) {
    const bf16* Q = WSP(bf16, WS_Q); const bf16* Kb = WSP(bf16, WS_K); const bf16* VT = WSP(bf16, WS_VT); bf16* cat = WSP(bf16, WS_CAT);
    LAS unsigned char* lds = F.lds;
    const int lane0 = F.lane;
    float lam;
    { const float* lv = INP(11); float a = lv[lane0] * lv[64 + lane0], b = lv[128 + lane0] * lv[192 + lane0]; a = wave_sum(a); b = wave_sum(b); lam = expf(a) - expf(b) + 0.2f; }
    const float* subg = INP(12);
    const int NU = 1024 + 32;
    const int xcd = F.bid & 7, jcu = F.bid >> 3;
    for (int it = 0;; ++it) {
        if (it == cvslot) { for (int rep_ = 0; rep_ < (((PH_REPEAT >> 26) & 1u) ? 2 : 1); ++rep_) { moe_convert_items(F); __syncthreads(); } }
        int tl_ = F.tid; asm volatile("" : "+v"(tl_));
        const int lane = tl_ & 63, w = __builtin_amdgcn_readfirstlane(tl_ >> 6), sub = w & 1, qw = w >> 1, r32 = lane & 31, hi = lane >> 5;
        int uidx;
        if (F.G == 256) { if (it < 4) uidx = 128 * xcd + it * 32 + jcu; else if (it == 4 && F.bid < 32) uidx = 1024 + F.bid; else break; }
        else { uidx = it * F.G + F.bid; if (uidx >= NU) break; }
        int b, head, q0row, nt; size_t kbase;
        if (uidx < 1024) { const int combo = uidx >> 6, qb = uidx & 63; b = combo >> 3; head = combo & 7; q0row = b * SEQ + qb * 128; nt = KEYS / 64; }
        else { const int v = uidx - 1024; b = v >> 4; head = (v >> 1) & 7; q0row = TL + b * CTX + (v & 1) * 128; nt = CTX / 64; }
        kbase = (size_t)b * KEYS;
        bf16x8 qf[4];
        { const bf16* qp = Q + (size_t)(q0row + qw * 32 + r32) * 1024 + head * 128 + sub * 64 + hi * 8;
#pragma unroll
          for (int ks = 0; ks < 4; ++ks) qf[ks] = *(const bf16x8*)(qp + ks * 16); }
        const char* gsrc[4];
#pragma unroll
        for (int j = 0; j < 4; ++j) { const int pi = w * 4 + j, rr = lane >> 3, pc = lane & 7;
            if (pi < 16) { const int key = (pi & 7) * 8 + rr, c = pc ^ ((key >> 1) & 7); gsrc[j] = (const char*)(Kb + (kbase + key) * 1024 + head * 128 + (pi >> 3) * 64 + c * 8); }
            else { const int dvr = (pi - 16) * 8 + rr, c = pc ^ ((dvr >> 1) & 7); gsrc[j] = (const char*)(VT + ((size_t)(b * 8 + head) * 128 + dvr) * KEYS + c * 8); } }
        const size_t gstep = (w < 4) ? (size_t)65536 * 2 : (size_t)64 * 2;
        const unsigned ldst = (unsigned)w * 4096u;
#define ATT_DMA(t, buf) do { _Pragma("unroll") for (int _j = 0; _j < 4; ++_j) \
            __builtin_amdgcn_global_load_lds((const unsigned*)(gsrc[_j] + (size_t)(t) * gstep), (LAS unsigned*)(lds + (buf) * 32768 + ldst + _j * 1024), 16, 0, 0); } while (0)
        ATT_DMA(0, 0); ATT_DMA(1, 1); ATT_DMA(2, 2);
        asm volatile("s_waitcnt vmcnt(4)" ::: "memory");
        __builtin_amdgcn_s_barrier();
        f32x16 o[4];
#pragma unroll
        for (int d = 0; d < 4; ++d)
#pragma unroll
            for (int r = 0; r < 16; ++r) o[d][r] = 0.f;
        float mref = 0.f, lrow = 0.f;
        f32x16 negm;
#pragma unroll
        for (int r = 0; r < 16; ++r) negm[r] = 0.f;
        const int rdoff = r32 * 128;
        const int swz = (r32 >> 1) & 7;
        f32x16 s0, s1; bf16x8 pf[4];
#define ATT_QK(bufidx) do { const LAS unsigned char* kp_ = lds + (bufidx) * 32768 + sub * 8192; bf16x8 kfa[4], kfb[4]; \
            _Pragma("unroll") for (int ks = 0; ks < 4; ++ks) { const int ch = ((2 * ks + hi) ^ swz) * 16; kfa[ks] = *(const LAS bf16x8*)(kp_ + rdoff + ch); kfb[ks] = *(const LAS bf16x8*)(kp_ + 4096 + rdoff + ch); } \
            s0 = negm; s1 = negm; \
            _Pragma("unroll") for (int ks = 0; ks < 4; ++ks) { s0 = __builtin_amdgcn_mfma_f32_32x32x16_bf16(kfa[ks], qf[ks], s0, 0, 0, 0); s1 = __builtin_amdgcn_mfma_f32_32x32x16_bf16(kfb[ks], qf[ks], s1, 0, 0, 0); } \
            asm volatile("" : "+v"(s0), "+v"(s1) : "v"(kfa[0]), "v"(kfa[1]), "v"(kfa[2]), "v"(kfa[3]), "v"(kfb[0]), "v"(kfb[1]), "v"(kfb[2]), "v"(kfb[3])); } while (0)
#define ATT_MAX(mx) do { float mxa = fmaxf(fmaxf(s0[0], s0[1]), s0[2]), mxb = fmaxf(fmaxf(s1[0], s1[1]), s1[2]); \
            _Pragma("unroll") for (int r = 3; r < 15; r += 2) { mxa = fmaxf(fmaxf(mxa, s0[r]), s0[r + 1]); mxb = fmaxf(fmaxf(mxb, s1[r]), s1[r + 1]); } \
            mx = fmaxf(fmaxf(mxa, mxb), fmaxf(s0[15], s1[15])); mx = xhalf_max(mx); } while (0)
#define ATT_FIX(mx) do { const float dl = fmaxf(mx, 0.f); mref += dl; const float alpha = __builtin_amdgcn_exp2f(-dl); lrow *= alpha; \
            _Pragma("unroll") for (int r = 0; r < 16; ++r) { s0[r] -= dl; s1[r] -= dl; negm[r] = -mref; } \
            _Pragma("unroll") for (int d = 0; d < 4; ++d) _Pragma("unroll") for (int r = 0; r < 16; ++r) o[d][r] *= alpha; } while (0)
#define ATT_EXP8(S, base, dst) do { float rs_ = 0.f; _Pragma("unroll") for (int r = 0; r < 8; ++r) { S[base + r] = __builtin_amdgcn_exp2f(S[base + r]); rs_ += S[base + r]; } lrow += rs_; \
            v4u pw_; pw_.x = cvt_pk_bf16(S[base + 0], S[base + 1]); pw_.y = cvt_pk_bf16(S[base + 2], S[base + 3]); pw_.z = cvt_pk_bf16(S[base + 4], S[base + 5]); pw_.w = cvt_pk_bf16(S[base + 6], S[base + 7]); dst = __builtin_bit_cast(bf16x8, pw_); } while (0)
#define ATT_VLD(dstv, vp_, s) do { _Pragma("unroll") for (int d = 0; d < 4; ++d) dstv[d] = *(const LAS bf16x8*)(vp_ + d * 4096 + rdoff + (((2 * (s) + hi) ^ swz) * 16)); } while (0)
#define ATT_PV4(srcv, pfrag) do { _Pragma("unroll") for (int d = 0; d < 4; ++d) o[d] = __builtin_amdgcn_mfma_f32_32x32x16_bf16(srcv[d], pfrag, o[d], 0, 0, 0); } while (0)
        { ATT_QK(0); float mx; ATT_MAX(mx); if (__any(mx > 8.0f)) ATT_FIX(mx);
          ATT_EXP8(s0, 0, pf[0]); ATT_EXP8(s0, 8, pf[1]); ATT_EXP8(s1, 0, pf[2]); ATT_EXP8(s1, 8, pf[3]); }
        int bcur = 0;
#pragma nounroll
        for (int t = 0; t < nt; ++t) {
            const int bn1 = (bcur + 1) & 3, bn3 = (bcur + 3) & 3;
            if (t + 3 < nt) ATT_DMA(t + 3, bn3);
            const LAS unsigned char* vp = lds + bcur * 32768 + 16384;
            bf16x8 vfa[4], vfb[4];
            if (t + 1 < nt) {
                __builtin_amdgcn_sched_barrier(0);
                ATT_QK(bn1);
                float mx; ATT_MAX(mx);
                __builtin_amdgcn_sched_barrier(0);
                if (__any(mx > 8.0f)) {
                    const float dl = fmaxf(mx, 0.f); mref += dl; const float alpha = __builtin_amdgcn_exp2f(-dl); lrow *= alpha;
#pragma unroll
                    for (int r = 0; r < 16; ++r) { s0[r] -= dl; s1[r] -= dl; negm[r] = -mref; }
#pragma unroll
                    for (int d = 0; d < 4; ++d)
#pragma unroll
                        for (int r = 0; r < 16; ++r) o[d][r] *= alpha;
#pragma unroll
                    for (int s = 0; s < 4; ++s) { v4u pw = __builtin_bit_cast(v4u, pf[s]);
                        pw.x = cvt_pk_bf16(bflo(pw.x) * alpha, bfhi(pw.x) * alpha); pw.y = cvt_pk_bf16(bflo(pw.y) * alpha, bfhi(pw.y) * alpha);
                        pw.z = cvt_pk_bf16(bflo(pw.z) * alpha, bfhi(pw.z) * alpha); pw.w = cvt_pk_bf16(bflo(pw.w) * alpha, bfhi(pw.w) * alpha); pf[s] = __builtin_bit_cast(bf16x8, pw); }
                }
                __builtin_amdgcn_sched_barrier(0);
                {
                    ATT_VLD(vfa, vp, 0);
                    __builtin_amdgcn_sched_barrier(0);
                    ATT_VLD(vfb, vp, 1); ATT_PV4(vfa, pf[0]); ATT_EXP8(s0, 0, pf[0]);
                    __builtin_amdgcn_sched_barrier(0);
                    ATT_VLD(vfa, vp, 2); ATT_PV4(vfb, pf[1]); ATT_EXP8(s0, 8, pf[1]);
                    __builtin_amdgcn_sched_barrier(0);
                    ATT_VLD(vfb, vp, 3); ATT_PV4(vfa, pf[2]); ATT_EXP8(s1, 0, pf[2]);
                    __builtin_amdgcn_sched_barrier(0);
                    ATT_PV4(vfb, pf[3]); ATT_EXP8(s1, 8, pf[3]);
                }
                __builtin_amdgcn_sched_barrier(0);
            } else {
#pragma unroll
                for (int s = 0; s < 4; ++s) { ATT_VLD(vfa, vp, s); ATT_PV4(vfa, pf[s]); }
            }
            if (t + 3 < nt) asm volatile("s_waitcnt vmcnt(4) lgkmcnt(0)" ::: "memory"); else asm volatile("s_waitcnt vmcnt(0) lgkmcnt(0)" ::: "memory");
            __builtin_amdgcn_s_barrier();
            bcur = bn1;
        }
#undef ATT_DMA
#undef ATT_QK
#undef ATT_MAX
#undef ATT_FIX
#undef ATT_EXP8
#undef ATT_VLD
#undef ATT_PV4
        const float ltot = lrow + __shfl_xor(lrow, 32); const float linv = 1.0f / ltot;
        LAS float* xch = (LAS float*)lds + (size_t)(qw * 32 + r32) * 132;
        if (sub == 1) {
#pragma unroll
            for (int d = 0; d < 4; ++d)
#pragma unroll
                for (int g = 0; g < 4; ++g) *(LAS f32x4*)(xch + 32 * d + 8 * g + 4 * hi) = (f32x4){o[d][4 * g] * linv, o[d][4 * g + 1] * linv, o[d][4 * g + 2] * linv, o[d][4 * g + 3] * linv};
        }
        __syncthreads();
        if (sub == 0) {
            float ss = 0.f;
#pragma unroll
            for (int d = 0; d < 4; ++d)
#pragma unroll
                for (int g = 0; g < 4; ++g) { const f32x4 o2 = *(const LAS f32x4*)(xch + 32 * d + 8 * g + 4 * hi);
#pragma unroll
                    for (int j = 0; j < 4; ++j) { const float v = o[d][4 * g + j] * linv - lam * o2[j]; o[d][4 * g + j] = v; ss += v * v; } }
            ss += __shfl_xor(ss, 32);
            const float rn = 0.8f / sqrtf(ss * (1.0f / 128.0f) + EPS);
            bf16* op = cat + (size_t)(q0row + qw * 32 + r32) * 2048 + head * 128;
#pragma unroll
            for (int d = 0; d < 4; ++d)
#pragma unroll
                for (int g = 0; g < 4; ++g) { const int dv = 32 * d + 8 * g + 4 * hi; const f32x4 gg = *(const f32x4*)(subg + dv);
                    st_bf4(op + dv, (f32x4){o[d][4 * g] * rn * gg.x, o[d][4 * g + 1] * rn * gg.y, o[d][4 * g + 2] * rn * gg.z, o[d][4 * g + 3] * rn * gg.w}); }
        }
        __syncthreads();
    }
}

__device__ __forceinline__ void poold_phase(Frame& F) {
    const bf16* P = WSP(bf16, WS_P); bf16* PD = WSP(bf16, WS_PD);
    const int gt = F.bid * NTHREADS + F.tid, NGT = F.G * NTHREADS;
    for (int idx = gt; idx < TT * 128; idx += NGT) {
        const int r = idx >> 7, cc = (idx & 127) * 8, g = cc >> 8, wdw = 2 << g;
        int sb, t, Ls; if (r < TL) { sb = (r / SEQ) * SEQ; t = r % SEQ; Ls = SEQ; } else { sb = TL + ((r - TL) / CTX) * CTX; t = (r - TL) % CTX; Ls = CTX; }
        const int lo0 = t - wdw / 2; int lo = lo0, hi = lo + wdw; lo = lo < 0 ? 0 : lo; hi = hi > Ls ? Ls : hi;
        float a[8];
#pragma unroll
        for (int j = 0; j < 8; ++j) a[j] = 0.f;
        v4u wv[16];
#pragma unroll
        for (int i = 0; i < 16; ++i) { const int s = lo0 + i; wv[i] = (v4u){0u, 0u, 0u, 0u}; if (i < wdw && s >= 0 && s < Ls) wv[i] = *(const v4u*)(P + (size_t)(sb + s) * 1024 + cc); }
#pragma unroll
        for (int i = 0; i < 16; ++i) { const v4u v = wv[i];
            a[0] += bflo(v.x); a[1] += bfhi(v.x); a[2] += bflo(v.y); a[3] += bfhi(v.y); a[4] += bflo(v.z); a[5] += bfhi(v.z); a[6] += bflo(v.w); a[7] += bfhi(v.w); }
        const float inv = 1.0f / (float)(hi - lo);
        const v4u me = *(const v4u*)(P + (size_t)r * 1024 + cc);
        v4u o; o.x = pk2(a[0] * inv - bflo(me.x), a[1] * inv - bfhi(me.x)); o.y = pk2(a[2] * inv - bflo(me.y), a[3] * inv - bfhi(me.y));
        o.z = pk2(a[4] * inv - bflo(me.z), a[5] * inv - bfhi(me.z)); o.w = pk2(a[6] * inv - bflo(me.w), a[7] * inv - bfhi(me.w));
        *(v4u*)(PD + (size_t)r * 1024 + cc) = o;
    }
}

__device__ __forceinline__ void shortconv_phase(Frame& F) {
    const bf16* PJ = WSP(bf16, WS_PROJ1); float* GT = WSP(float, WS_GT);
    const float* cw = INP(17); const float* cb = INP(18);
    LAS float* scr = (LAS float*)(F.lds + F.wave * 17408);
    const int lane = F.lane;
    for (int it = F.gw; it < 2 * 128 * 48; it += F.NGW) {
        const int cbk = it % 48, tb = (it / 48) % 128, b = it / (48 * 128), col = cbk * 64 + lane, t0 = tb * 64;
        const bf16* base = PJ + ((size_t)b * SEQ) * 4096 + cbk * 64 + (lane & 7) * 8;
#pragma unroll
        for (int i = 0; i < 9; ++i) { const int row = 8 * i + (lane >> 3); const int t = t0 - 1 + row;
            if (row < 66) { v4u v = {0u, 0u, 0u, 0u}; if (t >= 0 && t < SEQ) v = *(const v4u*)(base + (size_t)t * 4096);
                LAS float* d = scr + row * 65 + (lane & 7) * 8; d[0] = bflo(v.x); d[1] = bfhi(v.x); d[2] = bflo(v.y); d[3] = bfhi(v.y); d[4] = bflo(v.z); d[5] = bfhi(v.z); d[6] = bflo(v.w); d[7] = bfhi(v.w); } }
        LDS_WAIT(); asm volatile("" ::: "memory");
        const float w0 = cw[col], w1 = cw[3072 + col], w2 = cw[2 * 3072 + col], bias = cb[col];
        float prev = scr[lane], cur = scr[65 + lane];
#pragma unroll 8
        for (int tt = 0; tt < 64; ++tt) { const float nxt = scr[(tt + 2) * 65 + lane]; const float o = prev * w0 + cur * w1 + nxt * w2 + bias; scr[tt * 65 + lane] = o; prev = cur; cur = nxt; }
        LDS_WAIT(); asm volatile("" ::: "memory");
        for (int c = 0; c < 64; ++c) GT[((size_t)(cbk * 64 + c) * 2 + b) * SEQ + t0 + lane] = scr[lane * 65 + c];
        LDS_WAIT(); asm volatile("" ::: "memory");
    }
}

__device__ __forceinline__ void s5_gelu_phase(Frame& F) {
    const bf16* PJ = WSP(bf16, WS_PROJ1); const float* YD = WSP(float, WS_YD); bf16* Gb = WSP(bf16, WS_PD); const float* dd = INP(33);
    const int gt = F.bid * NTHREADS + F.tid, NGT = F.G * NTHREADS;
    for (int idx = gt; idx < TL * 256; idx += NGT) { const int r = idx >> 8, c = (idx & 255) * 4;
        const v2u uw = *(const v2u*)(PJ + (size_t)r * 4096 + 3072 + c); const f32x4 d4 = *(const f32x4*)(dd + c);
        const int bb = r / SEQ, tt = r % SEQ, gg = c >> 4, cc = c & 15;
        const f32x4 y0 = *(const f32x4*)(YD + (((size_t)(0 * 2 + bb) * 64 + gg) * SEQ + tt) * 16 + cc), y1 = *(const f32x4*)(YD + (((size_t)(1 * 2 + bb) * 64 + gg) * SEQ + tt) * 16 + cc);
        const f32x4 y = {bflo(uw.x) * d4.x + y0.x + y1.x, bfhi(uw.x) * d4.y + y0.y + y1.y, bflo(uw.y) * d4.z + y0.z + y1.z, bfhi(uw.y) * d4.w + y0.w + y1.w};
        st_bf4(Gb + (size_t)r * 1024 + c, (f32x4){gelu_tanh(y.x), gelu_tanh(y.y), gelu_tanh(y.z), gelu_tanh(y.w)}); }
}

__device__ __forceinline__ f32x2 cmulf(f32x2 a, f32x2 b) { return (f32x2){a.x * b.x - a.y * b.y, a.x * b.y + a.y * b.x}; }
__device__ __forceinline__ int drev14(int p) { const unsigned r = __builtin_bitreverse32((unsigned)p) >> 18; return (int)(((r & 0x2AAAu) >> 1) | ((r & 0x1555u) << 1)); }
template <int L, bool ZHI>
__device__ __forceinline__ void fft_fwd_pass(LAS f32x2* X, const f32x2* tw, int tid) {
    constexpr int tws = 4096 / L;
    if constexpr (L == 1) {
#pragma unroll 2
        for (int i = 0; i < 8; ++i) { const int i0 = (tid + NTHREADS * i) * 4;
            const f32x4 p01 = *(const LAS f32x4*)(X + i0), p23 = *(const LAS f32x4*)(X + i0 + 2);
            const f32x2 x0 = {p01.x, p01.y}, x1 = {p01.z, p01.w}, x2 = {p23.x, p23.y}, x3 = {p23.z, p23.w};
            const f32x2 a = x0 + x2, bb = x0 - x2, c = x1 + x3, d = x1 - x3;
            const f32x2 y0 = a + c, y1 = {bb.x + d.y, bb.y - d.x}, y2 = a - c, y3 = {bb.x - d.y, bb.y + d.x};
            *(LAS f32x4*)(X + i0) = (f32x4){y0.x, y0.y, y1.x, y1.y}; *(LAS f32x4*)(X + i0 + 2) = (f32x4){y2.x, y2.y, y3.x, y3.y}; }
        LDS_BARRIER();
        return;
    }
#pragma unroll 2
    for (int i = 0; i < 8; ++i) {
        const int b = tid + NTHREADS * i, j = b & (L - 1), i0 = (b - j) * 4 + j;
        const f32x2 w1 = tw[j * tws], w2 = cmulf(w1, w1), w3 = cmulf(w2, w1);
        const f32x2 x0 = X[i0], x1 = X[i0 + L];
        if (ZHI) {
            const f32x2 t1 = {x0.x + x1.y, x0.y - x1.x}, t3 = {x0.x - x1.y, x0.y + x1.x};
            X[i0] = x0 + x1; X[i0 + L] = cmulf(t1, w1); X[i0 + 2 * L] = cmulf(x0 - x1, w2); X[i0 + 3 * L] = cmulf(t3, w3);
        } else {
            const f32x2 x2 = X[i0 + 2 * L], x3 = X[i0 + 3 * L];
            const f32x2 a = x0 + x2, bb = x0 - x2, c = x1 + x3, d = x1 - x3;
            const f32x2 t1 = {bb.x + d.y, bb.y - d.x}, t3 = {bb.x - d.y, bb.y + d.x};
            X[i0] = a + c; X[i0 + L] = cmulf(t1, w1); X[i0 + 2 * L] = cmulf(a - c, w2); X[i0 + 3 * L] = cmulf(t3, w3);
        }
    }
    LDS_BARRIER();
}
template <int L>
__device__ __forceinline__ void fft_fwd_pass16(LAS f32x2* X, const f32x2* tw, int tid) {
    constexpr int Q = L / 4, tws = 4096 / L;
    const int jq = tid & (Q - 1);
    f32x2 wa[4][3];
#pragma unroll
    for (int mq = 0; mq < 4; ++mq) { const f32x2 w1 = tw[(mq * Q + jq) * tws]; wa[mq][0] = w1; wa[mq][1] = cmulf(w1, w1); wa[mq][2] = cmulf(wa[mq][1], w1); }
    const f32x2 v1 = tw[jq * 4 * tws], v2 = cmulf(v1, v1), v3 = cmulf(v2, v1);
#pragma unroll
    for (int i = 0; i < 2; ++i) {
        const int u = tid + NTHREADS * i, base = (u / Q) * 4 * L + jq;
        f32x2 pt[4][4];
#pragma unroll
        for (int m = 0; m < 4; ++m)
#pragma unroll
            for (int mq = 0; mq < 4; ++mq) pt[m][mq] = X[base + m * L + mq * Q];
#pragma unroll
        for (int mq = 0; mq < 4; ++mq) {
            const f32x2 x0 = pt[0][mq], x1 = pt[1][mq], x2 = pt[2][mq], x3 = pt[3][mq];
            const f32x2 a = x0 + x2, bb = x0 - x2, c = x1 + x3, d = x1 - x3;
            const f32x2 t1 = {bb.x + d.y, bb.y - d.x}, t3 = {bb.x - d.y, bb.y + d.x};
            pt[0][mq] = a + c; pt[1][mq] = cmulf(t1, wa[mq][0]); pt[2][mq] = cmulf(a - c, wa[mq][1]); pt[3][mq] = cmulf(t3, wa[mq][2]);
        }
#pragma unroll
        for (int m = 0; m < 4; ++m) {
            const f32x2 x0 = pt[m][0], x1 = pt[m][1], x2 = pt[m][2], x3 = pt[m][3];
            const f32x2 a = x0 + x2, bb = x0 - x2, c = x1 + x3, d = x1 - x3;
            const f32x2 t1 = {bb.x + d.y, bb.y - d.x}, t3 = {bb.x - d.y, bb.y + d.x};
            X[base + m * L] = a + c; X[base + m * L + Q] = cmulf(t1, v1); X[base + m * L + 2 * Q] = cmulf(a - c, v2); X[base + m * L + 3 * Q] = cmulf(t3, v3);
        }
    }
    LDS_BARRIER();
}
template <bool ZHI>
__device__ __forceinline__ void fft_fwd(LAS f32x2* X, const f32x2* tw, int tid) {
    fft_fwd_pass<4096, ZHI>(X, tw, tid); fft_fwd_pass16<1024>(X, tw, tid); fft_fwd_pass16<64>(X, tw, tid);
    fft_fwd_pass<4, false>(X, tw, tid); fft_fwd_pass<1, false>(X, tw, tid);
}
template <int L, bool LOHALF>
__device__ __forceinline__ void fft_inv_pass(LAS f32x2* X, const f32x2* tw, int tid) {
    constexpr int tws = 4096 / L;
    if constexpr (L == 1) {
#pragma unroll 2
        for (int i = 0; i < 8; ++i) { const int i0 = (tid + NTHREADS * i) * 4;
            const f32x4 p01 = *(const LAS f32x4*)(X + i0), p23 = *(const LAS f32x4*)(X + i0 + 2);
            const f32x2 x0 = {p01.x, p01.y}, x1 = {p01.z, p01.w}, x2 = {p23.x, p23.y}, x3 = {p23.z, p23.w};
            const f32x2 a = x0 + x2, bb = x0 - x2, c = x1 + x3, d = x1 - x3;
            const f32x2 y0 = a + c, y1 = {bb.x - d.y, bb.y + d.x}, y2 = a - c, y3 = {bb.x + d.y, bb.y - d.x};
            *(LAS f32x4*)(X + i0) = (f32x4){y0.x, y0.y, y1.x, y1.y}; *(LAS f32x4*)(X + i0 + 2) = (f32x4){y2.x, y2.y, y3.x, y3.y}; }
        LDS_BARRIER();
        return;
    }
#pragma unroll 2
    for (int i = 0; i < 8; ++i) {
        const int b = tid + NTHREADS * i, j = b & (L - 1), i0 = (b - j) * 4 + j;
        f32x2 w1 = tw[j * tws]; w1.y = -w1.y; const f32x2 w2 = cmulf(w1, w1), w3 = cmulf(w2, w1);
        const f32x2 x0 = X[i0], x1 = cmulf(X[i0 + L], w1), x2 = cmulf(X[i0 + 2 * L], w2), x3 = cmulf(X[i0 + 3 * L], w3);
        const f32x2 a = x0 + x2, bb = x0 - x2, c = x1 + x3, d = x1 - x3;
        X[i0] = a + c; X[i0 + L] = (f32x2){bb.x - d.y, bb.y + d.x};
        if (!LOHALF) { X[i0 + 2 * L] = a - c; X[i0 + 3 * L] = (f32x2){bb.x + d.y, bb.y - d.x}; }
    }
    LDS_BARRIER();
}
template <int L>
__device__ __forceinline__ void fft_inv_pass16(LAS f32x2* X, const f32x2* tw, int tid) {
    constexpr int tws = 4096 / L, tws4 = 1024 / L;
    const int jq = tid & (L - 1);
    f32x2 v1 = tw[jq * tws]; v1.y = -v1.y; const f32x2 v2 = cmulf(v1, v1), v3 = cmulf(v2, v1);
    f32x2 wb[4][3];
#pragma unroll
    for (int mq = 0; mq < 4; ++mq) { f32x2 w1 = tw[(mq * L + jq) * tws4]; w1.y = -w1.y; wb[mq][0] = w1; wb[mq][1] = cmulf(w1, w1); wb[mq][2] = cmulf(wb[mq][1], w1); }
#pragma unroll
    for (int i = 0; i < 2; ++i) {
        const int u = tid + NTHREADS * i, base = (u / L) * 16 * L + jq;
        f32x2 pt[4][4];
#pragma unroll
        for (int M = 0; M < 4; ++M)
#pragma unroll
            for (int mq = 0; mq < 4; ++mq) pt[M][mq] = X[base + M * 4 * L + mq * L];
#pragma unroll
        for (int M = 0; M < 4; ++M) {
            const f32x2 x0 = pt[M][0], x1 = cmulf(pt[M][1], v1), x2 = cmulf(pt[M][2], v2), x3 = cmulf(pt[M][3], v3);
            const f32x2 a = x0 + x2, bb = x0 - x2, c = x1 + x3, d = x1 - x3;
            pt[M][0] = a + c; pt[M][1] = (f32x2){bb.x - d.y, bb.y + d.x}; pt[M][2] = a - c; pt[M][3] = (f32x2){bb.x + d.y, bb.y - d.x};
        }
#pragma unroll
        for (int mq = 0; mq < 4; ++mq) {
            const f32x2 x0 = pt[0][mq], x1 = cmulf(pt[1][mq], wb[mq][0]), x2 = cmulf(pt[2][mq], wb[mq][1]), x3 = cmulf(pt[3][mq], wb[mq][2]);
            const f32x2 a = x0 + x2, bb = x0 - x2, c = x1 + x3, d = x1 - x3;
            X[base + mq * L] = a + c; X[base + 4 * L + mq * L] = (f32x2){bb.x - d.y, bb.y + d.x}; X[base + 8 * L + mq * L] = a - c; X[base + 12 * L + mq * L] = (f32x2){bb.x + d.y, bb.y - d.x};
        }
    }
    LDS_BARRIER();
}
__device__ __forceinline__ void fft_inv(LAS f32x2* X, const f32x2* tw, int tid) {
    fft_inv_pass<1, false>(X, tw, tid); fft_inv_pass<4, false>(X, tw, tid); fft_inv_pass16<16>(X, tw, tid); fft_inv_pass16<256>(X, tw, tid);
    fft_inv_pass<4096, true>(X, tw, tid);
}
__device__ __forceinline__ void fft_untangle(const LAS f32x2* X, f32x2* K0g, f32x2* K1g, float sc0, float sc1, int tid) {
    const float h0 = 0.5f * sc0, h1 = 0.5f * sc1;
#pragma unroll 4
    for (int i = 0; i < 32; ++i) {
        const int p = tid + NTHREADS * i, f = drev14(p), pm = drev14((16384 - f) & 16383);
        const f32x2 A = X[p], B = X[pm];
        const f32x2 dd = {A.x - B.x, A.y + B.y};
        K0g[p] = (f32x2){(A.x + B.x) * h0, (A.y - B.y) * h0};
        K1g[p] = (f32x2){dd.y * h1, -dd.x * h1};
    }
    LDS_BARRIER();
}
__device__ __forceinline__ void fft_pointwise(LAS f32x2* X, const f32x2* Kg, int tid) {
#pragma unroll 8
    for (int i = 0; i < 32; ++i) { const int p = tid + NTHREADS * i; X[p] = cmulf(X[p], Kg[p]); }
    LDS_BARRIER();
}
__device__ __forceinline__ void hyena_fft_phase(Frame& F) {
    float* GT = WSP(float, WS_GT); const float* kT = WSP(float, WS_KT); const float* invn = WSP(float, WS_INVN); const f32x2* tw = WSP(f32x2, WS_TW);
    f32x2* K0g = WSP(f32x2, WS_FFTW) + (size_t)F.bid * 16384; f32x2* K1g = WSP(f32x2, WS_Y) + (size_t)F.bid * 16384;
    const float* hyb = INP(25);
    LAS f32x2* X = (LAS f32x2*)F.lds;
    const int tid = F.tid;
    for (int ch = F.bid; ch < 1024; ch += F.G) {
        { const float* f0 = kT + (size_t)ch * SEQ; const float* b0 = kT + (size_t)(1024 + ch) * SEQ; const float* f1 = kT + (size_t)(2048 + ch) * SEQ; const float* b1 = kT + (size_t)(3072 + ch) * SEQ;
          for (int n = tid; n < SEQ; n += NTHREADS) { X[n] = (f32x2){f0[n], f1[n]}; X[SEQ + n] = (n == 0) ? (f32x2){0.f, 0.f} : (f32x2){b0[SEQ - n], b1[SEQ - n]}; } }
        const float* v0 = GT + ((size_t)ch * 2) * SEQ; float* yo = WSP(float, WS_YHT) + ((size_t)ch * 2) * SEQ;
        const float* x1 = GT + ((size_t)(1024 + ch) * 2) * SEQ; const float* x2 = GT + ((size_t)(2048 + ch) * 2) * SEQ;
        float z0[16], z1[16];
#pragma unroll
        for (int j = 0; j < 16; ++j) { const int n = tid + NTHREADS * j; z0[j] = v0[n]; z1[j] = v0[SEQ + n]; }
        LDS_BARRIER();
        fft_fwd<false>(X, tw, tid);
        fft_untangle(X, K0g, K1g, invn[ch] * (1.0f / 16384.0f), invn[1024 + ch] * (1.0f / 16384.0f), tid);
#pragma unroll
        for (int o = 0; o < 2; ++o) {
            const float* xg = (o == 0) ? x1 : x2;
            float g0[16], g1[16];
#pragma unroll
            for (int j = 0; j < 16; ++j) { const int n = tid + NTHREADS * j; g0[j] = xg[n]; g1[j] = xg[SEQ + n]; }
#pragma unroll
            for (int j = 0; j < 16; ++j) { const int n = tid + NTHREADS * j; X[n] = (f32x2){z0[j], z1[j]}; }
            LDS_BARRIER();
            fft_fwd<true>(X, tw, tid);
            fft_pointwise(X, o == 0 ? K0g : K1g, tid);
            fft_inv(X, tw, tid);
            const float bias = hyb[o * 1024 + ch];
#pragma unroll
            for (int j = 0; j < 16; ++j) { const int n = tid + NTHREADS * j; const f32x2 y = X[n]; z0[j] = g0[j] * (y.x + bias * z0[j]); z1[j] = g1[j] * (y.y + bias * z1[j]); }
            LDS_BARRIER();
        }
#pragma unroll
        for (int j = 0; j < 16; ++j) { const int n = tid + NTHREADS * j; yo[n] = z0[j]; yo[SEQ + n] = z1[j]; }
    }
}
__device__ __forceinline__ void hyena_out_transpose(Frame& F) {
    const float* GT = WSP(float, WS_YHT); bf16* cat = WSP(bf16, WS_CAT);
    LAS float* scr = (LAS float*)(F.lds + F.wave * 17408);
    const int lane = F.lane;
    for (int it = F.gw; it < 2 * 128 * 16; it += F.NGW) {
        const int cbk = it & 15, tb = (it >> 4) & 127, b = it >> 11, t0 = tb * 64;
        for (int c = 0; c < 64; ++c) scr[c * 65 + lane] = GT[((size_t)(cbk * 64 + c) * 2 + b) * SEQ + t0 + lane];
        LDS_WAIT(); asm volatile("" ::: "memory");
#pragma unroll
        for (int i = 0; i < 8; ++i) { const int tt = 8 * i + (lane >> 3), c0 = (lane & 7) * 8; const LAS float* s = scr + c0 * 65 + tt;
            v4u o; o.x = cvt_pk_bf16(s[0], s[65]); o.y = cvt_pk_bf16(s[130], s[195]); o.z = cvt_pk_bf16(s[260], s[325]); o.w = cvt_pk_bf16(s[390], s[455]);
            *(v4u*)(cat + ((size_t)b * SEQ + t0 + tt) * 2048 + cbk * 64 + c0) = o; }
        LDS_WAIT(); asm volatile("" ::: "memory");
    }
}

__device__ __forceinline__ int s5_row(int di, int b, int s) {
    return (s < CTX) ? TL + b * CTX + (di == 0 ? s : CTX - 1 - s) : b * SEQ + (di == 0 ? s - CTX : SEQ - 1 - (s - CTX));
}
typedef float f32x4_t __attribute__((ext_vector_type(4)));
#define S5_KEEP8(acc, f) asm volatile("" : "+v"(acc) : "v"(f[0]), "v"(f[1]), "v"(f[2]), "v"(f[3]), "v"(f[4]), "v"(f[5]), "v"(f[6]), "v"(f[7]))
#define S5_KEEP4(acc, f) asm volatile("" : "+v"(acc) : "v"(f[0]), "v"(f[1]), "v"(f[2]), "v"(f[3]))
template <bool OUTPUT>
__device__ __forceinline__ void s5_chunk_phase(Frame& F) {
    const bf16* PJ = WSP(bf16, WS_PROJ1); float* YD = WSP(float, WS_YD);
    const f32x2* l16t = WSP(f32x2, WS_S5L16); const f32x2* l256 = WSP(f32x2, WS_S5L256); f32x2* Eb = WSP(f32x2, WS_S5E);
    const bf16* W1 = WSP(bf16, WS_S5W1); const bf16* W3 = WSP(bf16, WS_S5W3); const bf16* KT = WSP(bf16, WS_S5KT);
    const int lane = F.lane, fr = lane & 15, fq = lane >> 4;
    LAS unsigned* Xl = (LAS unsigned*)(F.lds + F.wave * 4608);
    f32x2 carry[4];
#pragma unroll
    for (int t = 0; t < 4; ++t) carry[t] = (f32x2){0.f, 0.f};
#pragma nounroll
    for (int j = 0;; ++j) {
        const int tq = F.wave * F.G + F.bid + (j >> 2) * F.NGW, sub4 = j & 3;
        if (tq >= 256 * 8) break;
        const int task = tq * 4 + sub4;
        const int dbg = task >> 5, seg = (task & 31) + (OUTPUT ? 1 : 0);
        const int di = dbg >> 7, b = (dbg >> 6) & 1, g = dbg & 63;
        const int dg = di * 64 + g;
        const int s0 = seg * 256;
        bf16x8 afr[8];
#pragma unroll
        for (int ks = 0; ks < 8; ++ks) afr[ks] = *(const bf16x8*)(PJ + (size_t)s5_row(di, b, s0 + 16 * fr + 2 * ks + (fq >> 1)) * 4096 + 3072 + g * 16 + 8 * (fq & 1));
        f32x4 ea[8];
        { const bf16* w1p = W1 + ((size_t)dg * 128 + fr) * 256 + 8 * fq;
#pragma unroll
          for (int nt = 0; nt < 8; ++nt) { f32x4 a = {0.f, 0.f, 0.f, 0.f}; bf16x8 bw[8];
#pragma unroll
              for (int ks = 0; ks < 8; ++ks) bw[ks] = *(const bf16x8*)(w1p + (size_t)nt * 16 * 256 + 32 * ks);
#pragma unroll
              for (int ks = 0; ks < 8; ++ks) a = __builtin_amdgcn_mfma_f32_16x16x32_bf16(afr[ks], bw[ks], a, 0, 0, 0);
              S5_KEEP8(a, bw); S5_KEEP8(a, afr);
              ea[nt] = a; } }
        f32x2 st[4];
#pragma unroll
        for (int t = 0; t < 4; ++t) st[t] = (f32x2){0.f, 0.f};
        if (OUTPUT) {
#pragma unroll
            for (int t = 0; t < 4; ++t) { const f32x2 lq = l256[dg * 64 + 16 * t + fr]; const f32x2* ep = Eb + ((size_t)dbg * 32) * 64 + 16 * t + fr;
                if (sub4 == 0) {
                    int k = 0;
                    for (; k + 8 <= seg; k += 8) { f32x2 e8[8];
#pragma unroll
                        for (int j = 0; j < 8; ++j) e8[j] = ep[(size_t)(k + j) * 64];
#pragma unroll
                        for (int j = 0; j < 8; ++j) st[t] = cmulf(lq, st[t]) + e8[j]; }
                    for (; k < seg; ++k) st[t] = cmulf(lq, st[t]) + ep[(size_t)k * 64];
                } else st[t] = cmulf(lq, carry[t]) + ep[(size_t)(seg - 1) * 64];
                carry[t] = st[t]; }
        }
#pragma unroll
        for (int t = 0; t < 4; ++t) {
            const f32x2 L1 = l16t[dg * 64 + 16 * t + fr], L2 = cmulf(L1, L1), L3 = cmulf(L2, L1), L4 = cmulf(L2, L2);
            const f32x2 x0 = {ea[t][0], ea[4 + t][0]}, x1 = cmulf(L1, x0) + (f32x2){ea[t][1], ea[4 + t][1]}, x2 = cmulf(L1, x1) + (f32x2){ea[t][2], ea[4 + t][2]}, x3 = cmulf(L1, x2) + (f32x2){ea[t][3], ea[4 + t][3]};
            f32x2 sin = st[t];
            f32x2 fin = x3 + cmulf(L4, (fq == 0) ? sin : (f32x2){0.f, 0.f});
#pragma unroll
            for (int rd = 1; rd < 4; ++rd) { const float vr = __shfl(fin.x, lane - 16), vi = __shfl(fin.y, lane - 16);
                if (fq == rd) { sin = (f32x2){vr, vi}; fin = x3 + cmulf(L4, sin); } }
            if (OUTPUT) {
                const f32x2 h1 = x0 + cmulf(L1, sin), h2 = x1 + cmulf(L2, sin), h3 = x2 + cmulf(L3, sin);
                Xl[(4 * fq + 0) * 68 + 16 * t + fr] = cvt_pk_bf16(sin.x, sin.y); Xl[(4 * fq + 1) * 68 + 16 * t + fr] = cvt_pk_bf16(h1.x, h1.y);
                Xl[(4 * fq + 2) * 68 + 16 * t + fr] = cvt_pk_bf16(h2.x, h2.y); Xl[(4 * fq + 3) * 68 + 16 * t + fr] = cvt_pk_bf16(h3.x, h3.y);
            } else {
                st[t] = (f32x2){__shfl(fin.x, 48 + fr), __shfl(fin.y, 48 + fr)};
            }
        }
        if (!OUTPUT) {
            if (fq == 0) {
#pragma unroll
                for (int t = 0; t < 4; ++t) Eb[((size_t)dbg * 32 + seg) * 64 + 16 * t + fr] = st[t];
            }
        } else {
            LDS_WAIT(); asm volatile("" ::: "memory");
            bf16x8 hfr[4];
#pragma unroll
            for (int ks = 0; ks < 4; ++ks) hfr[ks] = *(const LAS bf16x8*)(Xl + fr * 68 + 16 * ks + 4 * fq);
            LDS_WAIT(); asm volatile("" ::: "memory");
            const bf16* w3p = W3 + ((size_t)dg * 256 + fr) * 128 + 8 * fq;
            const bf16* ktp = KT + (size_t)dg * 17 * 256 + fr * 16 + 8 * (fq & 1);
#pragma unroll
            for (int tau = 0; tau < 16; ++tau) {
                f32x4 y = {0.f, 0.f, 0.f, 0.f}; bf16x8 b3[4], bk[8];
#pragma unroll
                for (int ks = 0; ks < 4; ++ks) b3[ks] = *(const bf16x8*)(w3p + (size_t)tau * 16 * 128 + 32 * ks);
#pragma unroll
                for (int ks = 0; ks < 8; ++ks) { const int d1 = (ks <= tau / 2) ? tau - 2 * ks - (fq >> 1) + 1 : 0;
                    bk[ks] = *(const bf16x8*)(ktp + (size_t)d1 * 256); }
#pragma unroll
                for (int ks = 0; ks < 4; ++ks) y = __builtin_amdgcn_mfma_f32_16x16x32_bf16(hfr[ks], b3[ks], y, 0, 0, 0);
#pragma unroll
                for (int ks = 0; ks <= tau / 2; ++ks) y = __builtin_amdgcn_mfma_f32_16x16x32_bf16(afr[ks], bk[ks], y, 0, 0, 0);
                S5_KEEP4(y, b3); S5_KEEP8(y, bk); S5_KEEP8(y, afr); S5_KEEP4(y, hfr);
#pragma unroll
                for (int r = 0; r < 4; ++r) { const int s = s0 + 16 * (4 * fq + r) + tau, tl = (di == 0) ? s - CTX : SEQ - 1 - (s - CTX);
                    YD[(((size_t)(di * 2 + b) * 64 + g) * SEQ + tl) * 16 + fr] = y[r]; }
            }
        }
    }
}


constexpr int NPHASES = 21;
#ifndef MK_SINGLE
#define MK_SINGLE 1
#endif

__device__ __forceinline__ unsigned long long launder_u64(unsigned long long v) {
    unsigned lo = (unsigned)v, hi = (unsigned)(v >> 32);
    asm volatile("" : "+v"(lo), "+v"(hi));
    lo = __builtin_amdgcn_readfirstlane(lo); hi = __builtin_amdgcn_readfirstlane(hi);
    return ((unsigned long long)hi << 32) | lo;
}
__device__ __forceinline__ const void* launder_ptr(const void* p) {
    unsigned long long v = (unsigned long long)p; unsigned lo = (unsigned)v, hi = (unsigned)(v >> 32);
    asm volatile("" : "+v"(lo), "+v"(hi));
    lo = __builtin_amdgcn_readfirstlane(lo); hi = __builtin_amdgcn_readfirstlane(hi);
    return (const void*)(((unsigned long long)hi << 32) | lo);
}
__device__ __forceinline__ void moe_blocks(Frame& F, int l, LAS int* bstart) {
    __syncthreads();
    if (F.tid < 64) {
        const int e = F.tid; const unsigned* cnt = WSP(unsigned, WS_CTL) + CW_CNT + l * 64 * CSTR;
        const int nb = ((int)cnt[e * CSTR] + 255) >> 8; int incl = nb;
#pragma unroll
        for (int o = 1; o < 64; o <<= 1) { const int v = __shfl_up(incl, o); if (e >= o) incl += v; }
        const int excl = incl - nb;
        bstart[e] = excl;
        for (int j = 0; j < nb; ++j) bstart[65 + excl + j] = e;
        if (e == 63) bstart[64] = incl;
    }
    __syncthreads();
}

template <int PHSEL>
__global__ void __launch_bounds__(NTHREADS, 2) mk_fwd(Args args) {
    extern __shared__ __attribute__((aligned(16))) unsigned char lds_raw[];
    Frame F;
    F.lds = (LAS unsigned char*)lds_raw; F.ws = (GAS unsigned char*)args.ws; F.kin = (const __attribute__((address_space(4))) unsigned long long*)__builtin_amdgcn_kernarg_segment_ptr();
    F.tid = threadIdx.x; F.lane = F.tid & 63; F.wave = __builtin_amdgcn_readfirstlane(F.tid >> 6); F.bid = blockIdx.x; F.G = gridDim.x;
    F.gw = F.bid * NWAVES + F.wave; F.NGW = F.G * NWAVES;
    volatile LAS unsigned* lctl = (volatile LAS unsigned*)(F.lds + LDS_CTL);
    LAS int* bstart = (LAS int*)(F.lds + LDS_CTL + 64);
    if (F.tid < 4) lctl[F.tid] = 0u;
    __syncthreads();
    const int lo = args.ph_lo, hi = args.ph_hi;
    XcdBarrier bar; bar.bar = WSP(unsigned, WS_CTL) + CW_BAR; bar.x = 0; bar.st = lctl;
    if (PHSEL < 0) bar = xcd_barrier_post(WSP(unsigned, WS_CTL) + CW_BAR, lctl);
#ifndef PH_MASK
#define PH_MASK 0xffffffffu
#endif
#define IN(k) (((PH_MASK >> (k)) & 1u) && (PHSEL < 0 || PHSEL == (k)))
#define INL(j) (((PH_MASK >> (6 + (j))) & 1u) && (PHSEL < 0 || (PHSEL == 6 + (j) && lo == pb + (j))))
#define PH_END(k) do { if (PHSEL < 0) xcd_barrier(bar); } while (0)
#ifndef PH_REPEAT
#define PH_REPEAT 0u
#endif
#define REP(k) for (int _rep = 0; _rep < (((PH_REPEAT >> (k)) & 1u) ? 2 : 1); ++_rep)
#define DUP(k) (((PH_REPEAT >> (k)) & 1u) != 0u)
#define PH_BEGIN() do { F.ws = (GAS unsigned char*)launder_u64((unsigned long long)F.ws); F.kin = (const __attribute__((address_space(4))) unsigned long long*)launder_u64((unsigned long long)F.kin); \
    { int _t = threadIdx.x; asm volatile("" : "+v"(_t)); F.tid = _t; F.lane = _t & 63; F.wave = __builtin_amdgcn_readfirstlane(_t >> 6); \
      int _b = blockIdx.x; asm volatile("" : "+v"(_b)); F.bid = __builtin_amdgcn_readfirstlane(_b); F.gw = F.bid * NWAVES + F.wave; } } while (0)
    LAS unsigned char* lds = F.lds;
    const int G = F.G, bid = F.bid;
    const int vcu = (G % 8 == 0) ? (bid % 8) * (G / 8) + bid / 8 : bid;
    constexpr long T2048 = 256L * 2048 * 2;

    if (IN(0)) { PH_BEGIN(); REP(0) { p0_prologue(F); __syncthreads(); } PH_END(0); }
    if (IN(1)) { PH_BEGIN(); p1_reduce(F); PH_END(1); }
#ifdef EXTRA_BARS
    xcd_barrier(bar); xcd_barrier(bar); xcd_barrier(bar); xcd_barrier(bar); xcd_barrier(bar); xcd_barrier(bar); xcd_barrier(bar); xcd_barrier(bar); xcd_barrier(bar); xcd_barrier(bar);
#endif
        if (IN(2)) { PH_BEGIN(); REP(2) norm_phase<0>(F, 0, nullptr); PH_END(2); }
        if (IN(3)) { PH_BEGIN();
#define BODY3 { pg8::Gemm g{(const bf16*)F.ws, (const bf16*)F.ws, 2048, 2048, 2048}; InProj0Order S; S.G = G; S.c = bid; \
              S.offA1 = (long)WS_HA; S.offB1 = (long)WS_WIN0; S.offA2 = (long)(WS_WIN0 + (size_t)3072 * 2048 * 2); S.offB2 = (long)WS_HA; \
              EpiInProj0 E{EpiQKP{WSP(bf16, WS_Q), WSP(bf16, WS_K), WSP(bf16, WS_P), WSP(f32x2, WS_ROPE)}, EpiVT{WSP(bf16, WS_VT)}}; pg8::gemm_phase<EpiInProj0, InProj0Order, false>(lds, g, S, E); }
            BODY3
            if constexpr (DUP(3)) { BODY3 }
#undef BODY3
            PH_END(3);
        }
        if (IN(4)) { PH_BEGIN();
            REP(4) attn_phase(F, (bid >> 3) % 5);
            __syncthreads(); REP(21) poold_phase(F); PH_END(4); }
        if (IN(5)) { PH_BEGIN();
            pg8::Gemm g{WSP(bf16, WS_PD), WSP(bf16, WS_WPOOL), 1024, 256, 256}; pg8::StaticOrder S; S.init(TT / 256, 4, G, bid, 256L * 1024 * 2, 256L * 2, 256L * 256 * 2);
            EpiScaleBf16 E{WSP(bf16, WS_CAT), 2048, 1024, INP(14)}; pg8::gemm_phase<EpiScaleBf16, pg8::StaticOrder, false>(lds, g, S, E);
            PH_END(5);
        }
    {
    constexpr int pb = 6; constexpr int l = 0;
    if (INL(0)) { PH_BEGIN();
        float* xbuf = WSP(float, WS_X);
        pg8::Gemm g{WSP(bf16, WS_CAT), WSP(bf16, l == 0 ? WS_WOUT0 : WS_WOUT1), 2048, 2048, 2048}; pg8::StaticOrder S; S.init(l == 0 ? TT / 256 : TL / 256, 8, G, bid, T2048, 0, T2048);
        EpiRes E{l == 0 ? INP(0) : xbuf, l == 0 ? INP(2) : xbuf + (size_t)TL * 2048, xbuf, modp(F, l, 0, 2)}; pg8::gemm_phase<EpiRes, pg8::StaticOrder, false>(lds, g, S, E);
        PH_END(pb);
    }
    if (INL(1)) { PH_BEGIN(); ffn_norm_router_phase(F, l); PH_END(pb + 1); }
    if (INL(2)) { PH_BEGIN(); REP(8) {
        moe_blocks(F, l, bstart);
        pg8::Gemm g{WSP(bf16, WS_HA), (const bf16*)(F.ws + WS_WMOE + (size_t)l * MOE_L_BYTES), 2048, 2048, 2048};
        MoeOrder S{bstart, WSP(unsigned, WS_CTL) + CW_CNT + l * 64 * CSTR, WSP(int, WS_TOKL), 4, G, vcu, bstart[64], T2048, 0, true};
        EpiMoeUp E{WSP(bf16, WS_H)}; pg8::gemm_phase<EpiMoeUp, MoeOrder, true>(lds, g, S, E); }
        PH_END(pb + 2);
    }
    if (INL(3)) { PH_BEGIN(); REP(9) {
        moe_blocks(F, l, bstart);
        pg8::Gemm g{WSP(bf16, WS_H), (const bf16*)(F.ws + WS_WMOE + (size_t)l * MOE_L_BYTES), 512, 512, 512};
        MoeOrder S{bstart, WSP(unsigned, WS_CTL) + CW_CNT + l * 64 * CSTR, WSP(int, WS_TOKL), 8, G, vcu, bstart[64], 256L * 512 * 2, (long)(4 * MiB), false};
        EpiMoeDown E{WSP(bf16, WS_Y), WSP(int, WS_TOKL), WSP(float, WS_GATEL), WSP(unsigned, WS_CTL) + CW_CNT + l * 64 * CSTR}; pg8::gemm_phase<EpiMoeDown, MoeOrder, false>(lds, g, S, E); }
        PH_END(pb + 3);
    }
    }
        if (IN(10)) { PH_BEGIN(); norm_phase<2>(F, 1, nullptr); PH_END(10); }
        if (IN(11)) { PH_BEGIN();
#define BODY11             pg8::Gemm g{WSP(bf16, WS_HA), WSP(bf16, WS_WIN1), 2048, 2048, 2048}; pg8::StaticOrder S; S.init(TT / 256, 16, G, bid, T2048, 0, T2048); \
            EpiBf16 E{WSP(bf16, WS_PROJ1), 4096}; pg8::gemm_phase<EpiBf16, pg8::StaticOrder, false>(lds, g, S, E);
            BODY11
            if constexpr (DUP(11)) { BODY11 }
#undef BODY11
            PH_END(11);
        }
        if (IN(12)) { PH_BEGIN(); REP(12) shortconv_phase(F); REP(22) s5_chunk_phase<false>(F);
 PH_END(12); }
        if (IN(13)) { PH_BEGIN();
            REP(23) s5_chunk_phase<true>(F); __syncthreads(); REP(13) hyena_fft_phase(F); PH_END(13); }
        if (IN(14)) { PH_BEGIN();
 REP(14) { s5_gelu_phase(F); hyena_out_transpose(F); } PH_END(14); }
        if (IN(15)) { PH_BEGIN();
            pg8::Gemm g{WSP(bf16, WS_PD), WSP(bf16, WS_WGLU), 1024, 1024, 1024}; pg8::StaticOrder S; S.init(TL / 256, 4, G, bid, 256L * 1024 * 2, 0, 256L * 1024 * 2);
            EpiGlu E{WSP(bf16, WS_CAT), 2048, 1024, WSP(bf16, WS_PD), INP(35)}; pg8::gemm_phase<EpiGlu, pg8::StaticOrder, false>(lds, g, S, E);
            PH_END(15);
        }
    {
    constexpr int pb = 16; constexpr int l = 1;
    if (INL(0)) { PH_BEGIN();
        float* xbuf = WSP(float, WS_X);
        pg8::Gemm g{WSP(bf16, WS_CAT), WSP(bf16, l == 0 ? WS_WOUT0 : WS_WOUT1), 2048, 2048, 2048}; pg8::StaticOrder S; S.init(l == 0 ? TT / 256 : TL / 256, 8, G, bid, T2048, 0, T2048);
        EpiRes E{l == 0 ? INP(0) : xbuf, l == 0 ? INP(2) : xbuf + (size_t)TL * 2048, xbuf, modp(F, l, 0, 2)}; pg8::gemm_phase<EpiRes, pg8::StaticOrder, false>(lds, g, S, E);
        PH_END(pb);
    }
    if (INL(1)) { PH_BEGIN(); ffn_norm_router_phase(F, l); PH_END(pb + 1); }
    if (INL(2)) { PH_BEGIN(); REP(8) {
        moe_blocks(F, l, bstart);
        pg8::Gemm g{WSP(bf16, WS_HA), (const bf16*)(F.ws + WS_WMOE + (size_t)l * MOE_L_BYTES), 2048, 2048, 2048};
        MoeOrder S{bstart, WSP(unsigned, WS_CTL) + CW_CNT + l * 64 * CSTR, WSP(int, WS_TOKL), 4, G, vcu, bstart[64], T2048, 0, true};
        EpiMoeUp E{WSP(bf16, WS_H)}; pg8::gemm_phase<EpiMoeUp, MoeOrder, true>(lds, g, S, E); }
        PH_END(pb + 2);
    }
    if (INL(3)) { PH_BEGIN(); REP(9) {
        moe_blocks(F, l, bstart);
        pg8::Gemm g{WSP(bf16, WS_H), (const bf16*)(F.ws + WS_WMOE + (size_t)l * MOE_L_BYTES), 512, 512, 512};
        MoeOrder S{bstart, WSP(unsigned, WS_CTL) + CW_CNT + l * 64 * CSTR, WSP(int, WS_TOKL), 8, G, vcu, bstart[64], 256L * 512 * 2, (long)(4 * MiB), false};
        EpiMoeDown E{WSP(bf16, WS_Y), WSP(int, WS_TOKL), WSP(float, WS_GATEL), WSP(unsigned, WS_CTL) + CW_CNT + l * 64 * CSTR}; pg8::gemm_phase<EpiMoeDown, MoeOrder, false>(lds, g, S, E); }
        PH_END(pb + 3);
    }
    }
    if (IN(20)) { PH_BEGIN(); norm_phase<3>(F, 1, args.out);
    }
#undef IN
#undef INL
#undef PH_END
}

typedef void (*kern_t)(Args);
template <int P> static void launch_phase(int grid, hipStream_t stream, Args a) { hipLaunchKernelGGL(mk_fwd<P>, dim3(grid), dim3(NTHREADS), LDS_BYTES, stream, a); }
template <int P> static bool prep_phase() { return hipFuncSetAttribute((const void*)mk_fwd<P>, hipFuncAttributeMaxDynamicSharedMemorySize, LDS_BYTES) == hipSuccess; }
extern "C" void kernel_launch(void* const* d_in, const int* in_sizes, int n_in, void* d_out, int out_size, void* d_ws, size_t ws_size, hipStream_t stream) {
    static int grid = 0;
    if (grid == 0) {
        if (n_in != 43 || out_size != TL * DM || ws_size < WS_END) { fprintf(stderr, "kernel_launch: unexpected shapes (n_in %d, out %d, ws %zu < %zu)\n", n_in, out_size, ws_size, (size_t)WS_END); grid = -1; return; }
        int dev = 0, cus = 0;
        if (hipGetDevice(&dev) != hipSuccess || hipDeviceGetAttribute(&cus, hipDeviceAttributeMultiprocessorCount, dev) != hipSuccess) { grid = -1; return; }
        bool ok = true;
#if MK_SINGLE
        ok = prep_phase<-1>();
#else
        ok = prep_phase<0>() && prep_phase<1>() && prep_phase<2>() && prep_phase<3>() && prep_phase<4>() && prep_phase<5>() && prep_phase<6>() && prep_phase<7>() && prep_phase<8>() && prep_phase<9>() &&
             prep_phase<10>() && prep_phase<11>() && prep_phase<12>() && prep_phase<13>() && prep_phase<14>() && prep_phase<15>() && prep_phase<20>();
#endif
        if (!ok) { fprintf(stderr, "kernel_launch: hipFuncSetAttribute failed\n"); grid = -1; return; }
        (void)hipGetLastError();
        grid = cus;
    }
    if (grid < 0) return;
    (void)hipMemsetAsync((char*)d_ws + WS_CTL, 0, CTL_BYTES, stream);
    Args a{};
    for (int i = 0; i < 43; ++i) a.in[i] = (const float*)d_in[i];
    a.out = (float*)d_out; a.ws = (unsigned char*)d_ws;
#if MK_SINGLE
    a.ph_lo = 0; a.ph_hi = NPHASES;
    launch_phase<-1>(grid, stream, a);
#else
#ifndef MK_DUP
#define MK_DUP -1
#endif
#define LP(k, P) a.ph_lo = (k); a.ph_hi = (k) + 1; launch_phase<P>(grid, stream, a); \
    if (MK_DUP == (k)) { if (P == 7) (void)hipMemsetAsync((char*)d_ws + WS_CTL + (size_t)(CW_CNT + ((k) > 10 ? 64 * CSTR : 0)) * 4, 0, 256 * CSTR, stream); launch_phase<P>(grid, stream, a); }
    LP(0, 0) LP(1, 1) LP(2, 2) LP(3, 3) LP(4, 4) LP(5, 5) LP(6, 6) LP(7, 7) LP(8, 8) LP(9, 9) LP(10, 10) LP(11, 11) LP(12, 12) LP(13, 13) LP(14, 14) LP(15, 15)
    LP(16, 6) LP(17, 7) LP(18, 8) LP(19, 9) LP(20, 20)
#undef LP
#endif
}
```
